# Optimizing an MI355X kernel written in HIP

```python
import math
import jax, jax.numpy as jnp
from jax import lax
import numpy as np

D_MODEL = 2048
BATCH = 2
SEQ = 4096
DEPTH = 1

N_META = 16
RWKV_HEAD = 64
RWKV_HEADS = D_MODEL // RWKV_HEAD
RWKV_DIM = RWKV_HEADS * RWKV_HEAD
DECAY_LORA = 96
ICL_LORA = 96
GATE_LORA = 256
DECAY_SCALE = math.exp(-0.5)
GN_EPS = 64e-5
POOL_WINDOWS = (2, 4, 8, 16)
POOL_GROUPS = len(POOL_WINDOWS)
POOL_DIM = D_MODEL // 2
POOL_GROUP_DIM = POOL_DIM // POOL_GROUPS
N_BRANCHES = 2
RWKV_SPLITS = (RWKV_DIM, RWKV_DIM, RWKV_DIM, DECAY_LORA, ICL_LORA, GATE_LORA)
RWKV_COLS = sum(RWKV_SPLITS)
IN_COLS = RWKV_COLS + POOL_DIM + N_BRANCHES * D_MODEL
PEER_HEADS = 8
PEER_TOPK = 16
N_KEYS = 128
N_EXPERTS = N_KEYS * N_KEYS
PEER_KEY_DIM = 256
PEER_HALF = PEER_KEY_DIM // 2
PEER_BLOCK = 128
DN_ALPHA = (2.0 * DEPTH) ** 0.25
DN_BETA = (8.0 * DEPTH) ** -0.25
LN_EPS = 1e-5

kernel_name = 'hybrid_rwkv7_pool_peer_deepnorm'


def layer_norm(x, g, b):
    xf = x.astype(jnp.float32)
    mu = jnp.mean(xf, axis=-1, keepdims=True)
    var = jnp.mean(jnp.square(xf - mu), axis=-1, keepdims=True)
    return ((xf - mu) * lax.rsqrt(var + LN_EPS) * g + b).astype(x.dtype)


def token_shift(u):
    return jnp.pad(u[:, :-1], ((0, 0), (1, 0), (0, 0)))


def rwkv7_scan(r, w, k, v, kk, a):
    def step(S, inp):
        r_t, w_t, k_t, v_t, kk_t, a_t = inp
        sa = jnp.einsum('bhij,bhj->bhi', S, -kk_t)
        S = (S * w_t[:, :, None, :]
             + sa[..., None] * (kk_t * a_t)[:, :, None, :]
             + v_t[..., None] * k_t[:, :, None, :])
        y_t = jnp.einsum('bhij,bhj->bhi', S, r_t)
        return S, y_t
    B, T, H, N = r.shape
    xs = tuple(jnp.moveaxis(z, 1, 0) for z in (r, w, k, v, kk, a))
    S0 = jnp.zeros((B, H, N, N), jnp.float32)
    _, y = lax.scan(step, S0, xs)
    return jnp.moveaxis(y, 0, 1)


def rwkv7_branch(p, mu_shift, w0, w_w2, a0, w_a2, w_g2, k_k, k_a, r_k, gn_g, gn_b):
    B, T, _ = p.shape
    pf = p.astype(jnp.float32)
    pf = pf + (token_shift(pf) - pf) * mu_shift
    cuts = np.cumsum(RWKV_SPLITS)[:-1].tolist()
    r, k, v, wl, al, gl = jnp.split(pf, cuts, axis=-1)
    decay = jnp.exp(-DECAY_SCALE * jax.nn.sigmoid(w0 + jnp.tanh(wl) @ w_w2))
    a = jax.nn.sigmoid(a0 + al @ w_a2)
    g = jax.nn.sigmoid(gl) @ w_g2
    heads = lambda z: z.reshape(B, T, RWKV_HEADS, RWKV_HEAD)
    kk = heads(k * k_k)
    kk = kk / jnp.maximum(jnp.linalg.norm(kk, axis=-1, keepdims=True), 1e-12)
    k = k * (1.0 + (a - 1.0) * k_a)
    r_h, k_h, v_h, a_h, w_h = heads(r), heads(k), heads(v), heads(a), heads(decay)
    y = rwkv7_scan(r_h, w_h, k_h, v_h, kk, a_h)
    ym = jnp.mean(y, axis=-1, keepdims=True)
    yv = jnp.mean(jnp.square(y - ym), axis=-1, keepdims=True)
    y = ((y - ym) * lax.rsqrt(yv + GN_EPS)).reshape(B, T, RWKV_DIM) * gn_g + gn_b
    bonus = jnp.sum(r_h * k_h * r_k, axis=-1, keepdims=True) * v_h
    y = (y + bonus.reshape(B, T, RWKV_DIM)) * g
    return y.astype(p.dtype)


def causal_pool_minus_identity(u, window):
    T = u.shape[1]
    c = jnp.pad(jnp.cumsum(u, axis=1), ((0, 0), (1, 0), (0, 0)))
    t = jnp.arange(T)
    lo = jnp.maximum(t + 1 - window, 0)
    cnt = jnp.minimum(t + 1, window).astype(jnp.float32)
    return (c[:, 1:] - c[:, lo]) / cnt[None, :, None] - u


def pool_branch(u, w_pool, pool_scale):
    B, T, _ = u.shape
    ug = u.astype(jnp.float32).reshape(B, T, POOL_GROUPS, POOL_GROUP_DIM)
    pooled = jnp.stack([causal_pool_minus_identity(ug[:, :, gi], win)
                        for gi, win in enumerate(POOL_WINDOWS)], axis=2)
    mixed = jnp.einsum('btgc,gcd->btgd', pooled, w_pool).reshape(B, T, POOL_DIM)
    return (mixed * pool_scale).astype(u.dtype)


def peer_ffn(h, w_q, sub_keys, u_table, v_table):
    B, T, D = h.shape
    xt = h.reshape(B * T, D)
    n = xt.shape[0]
    q = (xt @ w_q).reshape(n, PEER_HEADS, 2, PEER_HALF)
    s = jnp.einsum('nhpc,pkc->nhpk', q, sub_keys).astype(jnp.float32)
    sv, si = lax.top_k(s, PEER_TOPK)
    cand = (sv[:, :, 0, :, None] + sv[:, :, 1, None, :]).reshape(n, PEER_HEADS, PEER_TOPK * PEER_TOPK)
    cand_idx = (si[:, :, 0, :, None] * N_KEYS + si[:, :, 1, None, :]).reshape(n, PEER_HEADS, PEER_TOPK * PEER_TOPK)
    top_s, pos = lax.top_k(cand, PEER_TOPK)
    experts = jnp.take_along_axis(cand_idx, pos, axis=-1)
    gates = jax.nn.softmax(top_s, axis=-1)
    n_pad = (-n) % PEER_BLOCK
    xb = jnp.pad(xt, ((0, n_pad), (0, 0))).reshape(-1, PEER_BLOCK, D)
    eb = jnp.pad(experts, ((0, n_pad), (0, 0), (0, 0))).reshape(-1, PEER_BLOCK, PEER_HEADS, PEER_TOPK)
    gb = jnp.pad(gates, ((0, n_pad), (0, 0), (0, 0))).reshape(-1, PEER_BLOCK, PEER_HEADS, PEER_TOPK)

    def block(args):
        xblk, eblk, gblk = args
        u = u_table[eblk]
        act = jax.nn.gelu(jnp.einsum('nd,nhkd->nhk', xblk, u).astype(jnp.float32), approximate=False) * gblk
        v = v_table[eblk]
        return jnp.einsum('nhk,nhkd->nd', act.astype(v.dtype), v)

    out = lax.map(block, (xb, eb, gb)).reshape(-1, D)[:n]
    return out.reshape(B, T, D).astype(h.dtype)


def setup_inputs(seed: int = 0) -> dict:
    key = jax.random.key(seed)
    ks = iter(jax.random.split(key, 40))
    nrm = lambda shape, scale: jax.random.normal(next(ks), shape, jnp.float32) * scale
    uni = lambda shape, lo, hi: jax.random.uniform(next(ks), shape, jnp.float32, lo, hi)
    L, D = DEPTH, D_MODEL
    return {
        'x': nrm((BATCH, SEQ, D), 1.0),
        'meta_tokens': nrm((N_META, D), 1.0),
        'ln_in_g': 1.0 + nrm((D,), 0.05),
        'ln_in_b': nrm((D,), 0.05),
        'w_in': nrm((L, D, IN_COLS), D ** -0.5),
        'mu_shift': uni((L, RWKV_COLS), 0.0, 1.0),
        'w0': uni((L, RWKV_DIM), -4.0, 2.0),
        'w_w2': nrm((L, DECAY_LORA, RWKV_DIM), DECAY_LORA ** -0.5),
        'a0': nrm((L, RWKV_DIM), 0.5),
        'w_a2': nrm((L, ICL_LORA, RWKV_DIM), ICL_LORA ** -0.5),
        'w_g2': nrm((L, GATE_LORA, RWKV_DIM), GATE_LORA ** -0.5),
        'k_k': 0.85 + nrm((L, RWKV_DIM), 0.05),
        'k_a': 1.0 + nrm((L, RWKV_DIM), 0.05),
        'r_k': nrm((L, RWKV_HEADS, RWKV_HEAD), 0.1),
        'gn_g': 1.0 + nrm((L, RWKV_DIM), 0.05),
        'gn_b': nrm((L, RWKV_DIM), 0.05),
        'w_pool': nrm((L, POOL_GROUPS, POOL_GROUP_DIM, POOL_GROUP_DIM), POOL_GROUP_DIM ** -0.5),
        'pool_scale': 1.0 + nrm((L, POOL_DIM), 0.1),
        'b_gate': nrm((L, N_BRANCHES, D), 0.1),
        'w_branch_a': nrm((L, RWKV_DIM, D), RWKV_DIM ** -0.5),
        'w_branch_b': nrm((L, POOL_DIM, D), POOL_DIM ** -0.5),
        'w_out': nrm((L, D, D), DN_BETA * D ** -0.5),
        'ln1_g': 1.0 + nrm((L, D), 0.05),
        'ln1_b': nrm((L, D), 0.05),
        'w_q_peer': nrm((L, D, PEER_HEADS * PEER_KEY_DIM), D ** -0.5),
        'sub_keys': nrm((L, 2, N_KEYS, PEER_HALF), PEER_HALF ** -0.5),
        'u_table': nrm((L, N_EXPERTS, D), D ** -0.5),
        'v_table': nrm((L, N_EXPERTS, D), DN_BETA),
        'ln2_g': 1.0 + nrm((L, D), 0.05),
        'ln2_b': nrm((L, D), 0.05),
    }


def reference(x, meta_tokens, ln_in_g, ln_in_b, w_in, mu_shift, w0, w_w2, a0, w_a2, w_g2,
              k_k, k_a, r_k, gn_g, gn_b, w_pool, pool_scale, b_gate, w_branch_a, w_branch_b,
              w_out, ln1_g, ln1_b, w_q_peer, sub_keys, u_table, v_table, ln2_g, ln2_b):
    B = x.shape[0]
    meta = jnp.broadcast_to(meta_tokens[None].astype(x.dtype), (B, N_META, D_MODEL))
    h = layer_norm(jnp.concatenate([meta, x], axis=1), ln_in_g, ln_in_b)
    T = h.shape[1]
    for l in range(DEPTH):
        p = h @ w_in[l]
        p_rwkv = p[..., :RWKV_COLS]
        p_pool = p[..., RWKV_COLS:RWKV_COLS + POOL_DIM]
        p_gate = p[..., RWKV_COLS + POOL_DIM:].reshape(B, T, N_BRANCHES, D_MODEL)
        ya = rwkv7_branch(p_rwkv, mu_shift[l], w0[l], w_w2[l], a0[l], w_a2[l], w_g2[l],
                          k_k[l], k_a[l], r_k[l], gn_g[l], gn_b[l])
        yb = pool_branch(p_pool, w_pool[l], pool_scale[l])
        gate = jax.nn.sigmoid(p_gate + b_gate[l])
        merged = gate[:, :, 0] * (ya @ w_branch_a[l]) + gate[:, :, 1] * (yb @ w_branch_b[l])
        h = layer_norm(DN_ALPHA * h + merged @ w_out[l], ln1_g[l], ln1_b[l])
        h = layer_norm(DN_ALPHA * h + peer_ffn(h, w_q_peer[l], sub_keys[l], u_table[l], v_table[l]),
                       ln2_g[l], ln2_b[l])
    return h[:, N_META:]
```

```cpp
#include <hip/hip_runtime.h>
#include <hip/hip_cooperative_groups.h>
#include <cstdio>
#include <cstdint>
namespace cg = cooperative_groups;
namespace pg8 {
#define PG8_LAS __attribute__((address_space(3)))
typedef unsigned short bf16_t;
typedef short bf16x8 __attribute__((ext_vector_type(8)));
typedef float f32x4 __attribute__((ext_vector_type(4)));
typedef unsigned u32x4 __attribute__((ext_vector_type(4)));
constexpr int BM = 256, BK = 64, HALF = 128, HTB = HALF * BK * 2  , STAGE_BYTES = 8 * HTB, NXCD = 8, WGM = 8;

__host__ __device__ __forceinline__ int lds_byte(int r, int c) { const int st = (r >> 4) * 2 + (c >> 5), rr = r & 15, cc = c & 31, ob = rr * 64 + cc * 2; return st * 1024 + (ob ^ (((ob >> 9) & 1) << 5)); }
__host__ __device__ __forceinline__ void stage_rc(int b, int& R, int& C) { const int st = b / 1024, sb = b % 1024, swz = sb ^ (((sb >> 9) & 1) << 5); R = (st >> 1) * 16 + swz / 64; C = (st & 1) * 32 + (swz % 64) / 2; }
__host__ __device__ __forceinline__ int perm32(int rho) { const int n = rho >> 4, i = rho & 15; return 8 * (i >> 2) + 4 * n + (i & 3); }

struct Unit { int pm, pn; };
struct Gemm { const bf16_t* A; const bf16_t* Bt; int M, N, K; };

struct StaticOrder {
    int nM, nN, nwg, G, c;
    __host__ __device__ void init(int M, int N, int G_, int c_) { nM = M / BM; nN = N / BM; nwg = nM * nN; G = G_; c = c_; }
    __host__ __device__ bool next(int i, Unit& u) const {
        const long L = (long)i * G + c; if (L >= nwg) return false;
        int wgid = (int)L; { const int q = nwg / NXCD, r = nwg % NXCD, xcd = wgid % NXCD, off = wgid / NXCD; wgid = (xcd < r ? xcd * (q + 1) : r * (q + 1) + (xcd - r) * q) + off; }
        const int nig = WGM * nN, gid = wgid / nig, fm = gid * WGM, gsz = (nM - fm) < WGM ? (nM - fm) : WGM;
        u.pm = fm + ((wgid % nig) % gsz); u.pn = (wgid % nig) / gsz; return true;
    }
    __device__ __forceinline__ void a_ready(const Unit&) const {}
    __device__ __forceinline__ void done(const Unit&) const {}
};
struct CountedOrder : StaticOrder {
    const unsigned* ready; unsigned need; unsigned* tmo;
    __device__ __forceinline__ void a_ready(const Unit& u) const {
        if (threadIdx.x < 64) {
            const unsigned long long t0 = __builtin_amdgcn_s_memrealtime(); unsigned polls = 0;
            while ((unsigned)__builtin_amdgcn_readfirstlane(__hip_atomic_load(ready + 64 * u.pm, __ATOMIC_RELAXED, __HIP_MEMORY_SCOPE_AGENT)) < need) {
                if ((++polls & 255u) == 0u && __builtin_amdgcn_readfirstlane(__hip_atomic_load(tmo, __ATOMIC_RELAXED, __HIP_MEMORY_SCOPE_AGENT)) != 0u) break;
                if (__builtin_amdgcn_s_memrealtime() - t0 > 2000000ull) {
                    if (threadIdx.x == 0) { unsigned expect = 0u; __hip_atomic_compare_exchange_strong(tmo + 1, &expect, 0x600u | (unsigned)(u.pm & 0xff), __ATOMIC_RELAXED, __ATOMIC_RELAXED, __HIP_MEMORY_SCOPE_AGENT); __hip_atomic_store(tmo, 1u, __ATOMIC_RELAXED, __HIP_MEMORY_SCOPE_AGENT); }
                    break; }
                __builtin_amdgcn_s_sleep(2); }
            __builtin_amdgcn_fence(__ATOMIC_ACQUIRE, "agent");
            asm volatile("s_waitcnt vmcnt(0)" ::: "memory");
        }
#if !defined(BROKEN_HOOK_NO_BARRIER)
        asm volatile("" ::: "memory"); __builtin_amdgcn_s_barrier(); asm volatile("" ::: "memory");
#endif
    }
};

typedef float cvt_f32x2 __attribute__((ext_vector_type(2))); typedef __bf16 cvt_bf16x2 __attribute__((ext_vector_type(2)));
__device__ __forceinline__ unsigned cvt_pk_bf16(float lo, float hi) { const cvt_f32x2 v = {lo, hi}; const cvt_bf16x2 b = __builtin_convertvector(v, cvt_bf16x2); return __builtin_bit_cast(unsigned, b); }
typedef float f32x2 __attribute__((ext_vector_type(2)));
__device__ __forceinline__ f32x2 gelu_pk(f32x2 v) {
    const f32x2 av = __builtin_elementwise_abs(v), d = av * 0.2316418882f + 1.0f;
    f32x2 t; t.x = __builtin_amdgcn_rcpf(d.x); t.y = __builtin_amdgcn_rcpf(d.y);
    f32x2 q = t * 0.5307027145f + (-0.7265760135f); q = q * t + 0.7107068705f; q = q * t + (-0.142248368f); q = q * t + 0.127414796f; q = q * t;
    const f32x2 s = (v * v) * (-0.72134752044f);
    f32x2 e; e.x = __builtin_amdgcn_exp2f(s.x); e.y = __builtin_amdgcn_exp2f(s.y);
    const f32x2 m = v * (q * e), r = v - m;
    f32x2 o; o.x = v.x < 0.f ? m.x : r.x; o.y = v.y < 0.f ? m.y : r.y; return o;
}

struct EpiF32 {
    static constexpr bool PERM = false, AFTER_DRAIN = false;
    float* C; int ldc; const float* bias;
    __device__ __forceinline__ void operator()(const f32x4 (&acc)[2][2][4][2], const Unit& u, int wr, int wc, int fr, int fq) const {
        const int row0 = u.pm * BM + wr * 64 + fr, col0 = u.pn * BM + wc * 32 + 4 * fq;
        f32x4 bv[2][2];
#pragma unroll
        for (int bj = 0; bj < 2; ++bj)
#pragma unroll
            for (int n = 0; n < 2; ++n) bv[bj][n] = bias ? *(const f32x4*)(bias + col0 + bj * HALF + n * 16) : (f32x4){0.f, 0.f, 0.f, 0.f};
#pragma unroll
        for (int ai = 0; ai < 2; ++ai)
#pragma unroll
            for (int m = 0; m < 4; ++m) { float* rowp = C + (size_t)(row0 + ai * HALF + m * 16) * ldc + col0;
#pragma unroll
                for (int bj = 0; bj < 2; ++bj)
#pragma unroll
                    for (int n = 0; n < 2; ++n) *(f32x4*)(rowp + bj * HALF + n * 16) = acc[ai][bj][m][n] + bv[bj][n]; }
    }
};
template <int ACT  > struct EpiBf16 {
    static constexpr bool PERM = true, AFTER_DRAIN = false;
    bf16_t* O; int ldc; const float* bias; int split_cols; size_t split_stride;
    __device__ __forceinline__ void operator()(const f32x4 (&acc)[2][2][4][2], const Unit& u, int wr, int wc, int fr, int fq) const {
        const int row0 = u.pm * BM + wr * 64 + fr; int colt = u.pn * BM; bf16_t* base = O;
        if (split_cols) { const int t = colt / split_cols; base += (size_t)t * split_stride; colt -= t * split_cols; }
        const int col0 = colt + wc * 32 + 8 * fq, bcol0 = u.pn * BM + wc * 32 + 8 * fq;
        f32x4 bv[2][2];
#pragma unroll
        for (int bj = 0; bj < 2; ++bj)
#pragma unroll
            for (int n = 0; n < 2; ++n) bv[bj][n] = bias ? *(const f32x4*)(bias + bcol0 + bj * HALF + 4 * n) : (f32x4){0.f, 0.f, 0.f, 0.f};
#pragma unroll
        for (int ai = 0; ai < 2; ++ai)
#pragma unroll
            for (int m = 0; m < 4; ++m) { bf16_t* rowp = base + (size_t)(row0 + ai * HALF + m * 16) * ldc + col0;
#pragma unroll
                for (int bj = 0; bj < 2; ++bj) { f32x4 v0 = acc[ai][bj][m][0] + bv[bj][0], v1 = acc[ai][bj][m][1] + bv[bj][1];
                    if (ACT == 1) { f32x2 a = gelu_pk((f32x2){v0[0], v0[1]}), b = gelu_pk((f32x2){v0[2], v0[3]}), c = gelu_pk((f32x2){v1[0], v1[1]}), d = gelu_pk((f32x2){v1[2], v1[3]});
                        v0 = (f32x4){a.x, a.y, b.x, b.y}; v1 = (f32x4){c.x, c.y, d.x, d.y}; }
                    if (ACT == 2) {
#pragma unroll
                        for (int j = 0; j < 4; ++j) { v0[j] = 0.5f * v0[j] * (1.0f + erff(v0[j] * 0.70710678f)); v1[j] = 0.5f * v1[j] * (1.0f + erff(v1[j] * 0.70710678f)); } }
                    u32x4 w; w.x = cvt_pk_bf16(v0[0], v0[1]); w.y = cvt_pk_bf16(v0[2], v0[3]); w.z = cvt_pk_bf16(v1[0], v1[1]); w.w = cvt_pk_bf16(v1[2], v1[3]);
                    *(u32x4*)(rowp + bj * HALF) = w; } }
    }
};
template <class Epi, class Sched, bool STAMP = false>
__device__ __forceinline__ void gemm_phase(PG8_LAS unsigned char* lds, const Gemm g, const Sched& S, const Epi& E, unsigned long long* stamps) {
    const int tid = threadIdx.x, wid = __builtin_amdgcn_readfirstlane(tid >> 6), lane = tid & 63, wr = wid >> 2, wc = wid & 3, fr = lane & 15, fq = lane >> 4;
    const int K = g.K, nt = K / BK;
    int ts_lo = 0, ts_hi = 0, nts = 0; const unsigned long long rt_entry = STAMP ? (unsigned long long)wall_clock64() : 0ull;
#define PG8_STAMP() do { if (STAMP && wid == 0 && nts < 64) { const unsigned long long _c = (unsigned long long)clock64(); \
        ts_lo = (lane == nts) ? (int)(unsigned)_c : ts_lo; ts_hi = (lane == nts) ? (int)(unsigned)(_c >> 32) : ts_hi; ++nts; } } while (0)
    PG8_STAMP();
    unsigned voffA[2], voffB[2];
#pragma unroll
    for (int i = 0; i < 2; ++i) { int R, C; stage_rc(tid * 16 + i * 8192, R, C); const int Rb = Epi::PERM ? ((R & ~31) + perm32(R & 31)) : R;
        voffA[i] = (unsigned)(R * K + C) * 2u; voffB[i] = (unsigned)(Rb * K + C) * 2u; }
    const size_t kstep = (size_t)(BK * 2);
    const size_t hstep = (size_t)HALF * K * 2;
    const size_t tstep = 2 * hstep;
    const unsigned ldsw = (unsigned)wid * 1024u;
    const int aoff = lds_byte(wr * 64 + fr, fq * 8), boff = lds_byte(wc * 32 + fr, fq * 8);
#define PG8_SA(b, h) (((b) * 2 + (h)) * HTB)
#define PG8_SB(b, h) ((4 + (b) * 2 + (h)) * HTB)
#define PG8_STAGE(bufoff, gbase, voff) do { _Pragma("unroll") for (int _i = 0; _i < 2; ++_i) \
        __builtin_amdgcn_global_load_lds((const unsigned*)((const char*)(gbase) + (voff)[_i]), (PG8_LAS unsigned*)(lds + (bufoff) + ldsw + _i * 8192), 16, 0, 0); } while (0)
#define PG8_LDA(dst, b, h) do { _Pragma("unroll") for (int m = 0; m < 4; ++m) _Pragma("unroll") for (int k = 0; k < 2; ++k) dst[m][k] = *(const PG8_LAS bf16x8*)(lds + PG8_SA(b, h) + aoff + m * 2048 + k * 1024); } while (0)
#define PG8_LDB(dst, b, h) do { _Pragma("unroll") for (int n = 0; n < 2; ++n) _Pragma("unroll") for (int k = 0; k < 2; ++k) dst[n][k] = *(const PG8_LAS bf16x8*)(lds + PG8_SB(b, h) + boff + n * 2048 + k * 1024); } while (0)
#define PG8_MMA(ai, bj, At, Bt) do { __builtin_amdgcn_s_setprio(1); _Pragma("unroll") for (int m = 0; m < 4; ++m) _Pragma("unroll") for (int n = 0; n < 2; ++n) _Pragma("unroll") for (int k = 0; k < 2; ++k) \
        acc[ai][bj][m][n] = __builtin_amdgcn_mfma_f32_16x16x32_bf16(Bt[n][k], At[m][k], acc[ai][bj][m][n], 0, 0, 0); __builtin_amdgcn_s_setprio(0); } while (0)
#define PG8_WAIT_V(n) asm volatile("s_waitcnt vmcnt(" #n ")" ::: "memory")
#define PG8_WAIT_L(n) asm volatile("s_waitcnt lgkmcnt(" #n ")" ::: "memory")
#define PG8_BAR __builtin_amdgcn_s_barrier()
#define PG8_SCHED __builtin_amdgcn_sched_barrier(0)
    Unit cur, nxt; int ui = 0;
    if (!S.next(0, cur)) return;
    f32x4 acc[2][2][4][2];
#pragma unroll
    for (int a = 0; a < 2; ++a)
#pragma unroll
        for (int b = 0; b < 2; ++b)
#pragma unroll
            for (int m = 0; m < 4; ++m)
#pragma unroll
                for (int n = 0; n < 2; ++n) acc[a][b][m][n] = (f32x4){0.f, 0.f, 0.f, 0.f};
    bf16x8 At[4][2], B0[2][2], B1[2][2];
    const char* cA = (const char*)g.A + (size_t)cur.pm * tstep; const char* cB = (const char*)g.Bt + (size_t)cur.pn * tstep;
    S.a_ready(cur);
    PG8_STAGE(PG8_SB(0, 0), cB, voffB); PG8_STAGE(PG8_SA(0, 0), cA, voffA); PG8_STAGE(PG8_SB(0, 1), cB + hstep, voffB); PG8_STAGE(PG8_SA(0, 1), cA + hstep, voffA);
    if (wr == 1) PG8_BAR;
    PG8_WAIT_V(4); PG8_BAR;
    PG8_STAGE(PG8_SB(1, 0), cB + kstep, voffB); PG8_STAGE(PG8_SA(1, 0), cA + kstep, voffA); PG8_STAGE(PG8_SB(1, 1), cB + hstep + kstep, voffB);
    PG8_WAIT_V(6); PG8_BAR;
    PG8_STAMP();
    for (;;) {
        const bool has_next = S.next(ui + 1, nxt);
        const char* nA = has_next ? (const char*)g.A + (size_t)nxt.pm * tstep : cA; const char* nB = has_next ? (const char*)g.Bt + (size_t)nxt.pn * tstep : cB;
        for (int t = 0; t < nt; t += 2) {
            const bool last = (t == nt - 2);
            const char* a1 = cA + (size_t)(t + 1) * kstep;
            const char* a2 = last ? nA : cA + (size_t)(t + 2) * kstep; const char* b2 = last ? nB : cB + (size_t)(t + 2) * kstep;
            const char* a3 = a2 + kstep; const char* b3 = b2 + kstep;
            if (last && has_next) S.a_ready(nxt);
            PG8_LDB(B0, 0, 0); PG8_SCHED; PG8_LDA(At, 0, 0); PG8_STAGE(PG8_SA(1, 1), a1 + hstep, voffA);
            PG8_WAIT_L(8); PG8_BAR; PG8_WAIT_L(0); PG8_MMA(0, 0, At, B0); PG8_BAR; PG8_SCHED;
            PG8_LDB(B1, 0, 1); PG8_STAGE(PG8_SB(0, 0), b2, voffB);
            PG8_BAR; PG8_WAIT_L(0); PG8_MMA(0, 1, At, B1); PG8_BAR;
            PG8_LDA(At, 0, 1); PG8_STAGE(PG8_SA(0, 0), a2, voffA);
            PG8_BAR; PG8_WAIT_L(0); PG8_MMA(1, 0, At, B0); PG8_BAR; PG8_SCHED;
            PG8_STAGE(PG8_SB(0, 1), b2 + hstep, voffB);
            PG8_WAIT_V(6); PG8_BAR; PG8_MMA(1, 1, At, B1); PG8_BAR;
            PG8_LDB(B0, 1, 0); PG8_SCHED; PG8_LDA(At, 1, 0); PG8_STAGE(PG8_SA(0, 1), a2 + hstep, voffA);
            PG8_WAIT_L(8); PG8_BAR; PG8_WAIT_L(0); PG8_MMA(0, 0, At, B0); PG8_BAR; PG8_SCHED;
            PG8_LDB(B1, 1, 1); PG8_STAGE(PG8_SB(1, 0), b3, voffB);
            PG8_BAR; PG8_WAIT_L(0); PG8_MMA(0, 1, At, B1); PG8_BAR;
            PG8_LDA(At, 1, 1); PG8_STAGE(PG8_SA(1, 0), a3, voffA);
            PG8_BAR; PG8_WAIT_L(0); PG8_MMA(1, 0, At, B0); PG8_BAR; PG8_SCHED;
            PG8_STAGE(PG8_SB(1, 1), b3 + hstep, voffB);
            PG8_WAIT_V(6); PG8_BAR; PG8_MMA(1, 1, At, B1); PG8_BAR;
        }
        PG8_STAMP();
        if constexpr (!Epi::AFTER_DRAIN) { E(acc, cur, wr, wc, fr, fq); S.done(cur); }
        PG8_STAMP();
        if (!has_next) break;
#pragma unroll
        for (int a = 0; a < 2; ++a)
#pragma unroll
            for (int b = 0; b < 2; ++b)
#pragma unroll
                for (int m = 0; m < 4; ++m)
#pragma unroll
                    for (int n = 0; n < 2; ++n) acc[a][b][m][n] = (f32x4){0.f, 0.f, 0.f, 0.f};
        cur = nxt; cA = nA; cB = nB; ++ui;
    }
    PG8_WAIT_V(0);
    if (wr == 0) PG8_BAR;
    PG8_BAR;
    if constexpr (Epi::AFTER_DRAIN) { E.fused(acc, cur, wr, wc, fr, fq, lds, wid, lane); S.done(cur); }
    PG8_STAMP();
    if (STAMP && wid == 0) { stamps[lane] = lane < nts ? (((unsigned long long)(unsigned)ts_hi << 32) | (unsigned)ts_lo) : 0ull;
        if (lane == 62) stamps[62] = rt_entry; if (lane == 63) stamps[63] = (unsigned long long)wall_clock64(); }
#undef PG8_STAMP
#undef PG8_SA
#undef PG8_SB
#undef PG8_STAGE
#undef PG8_LDA
#undef PG8_LDB
#undef PG8_MMA
#undef PG8_WAIT_V
#undef PG8_WAIT_L
#undef PG8_BAR
#undef PG8_SCHED
}
}
#define LAS __attribute__((address_space(3)))
typedef unsigned short bf16_t;
typedef short bf16x8 __attribute__((ext_vector_type(8)));
typedef float f32x4 __attribute__((ext_vector_type(4)));
typedef float f32x2 __attribute__((ext_vector_type(2)));
typedef unsigned u32x4 __attribute__((ext_vector_type(4)));
typedef unsigned u32x2 __attribute__((ext_vector_type(2)));
typedef LAS unsigned char* ldsp;

constexpr int D = 2048, NTOK = 8192, SEQ = 4096, MROWS = 8448, ROW_META = 8192;
constexpr int INC = 11712, NPAD = 11776;
constexpr int C_R = 0, C_K = 2048, C_V = 4096, C_WL = 6144, C_AL = 6240, C_GL = 6336, C_POOL = 6592, C_G0 = 7616, C_G1 = 9664;
constexpr int NUNITS = 4128;
constexpr float DSCALE = 0.6065306597126334f;
constexpr float DN_ALPHA = 1.189207115002721f;
constexpr float GN_EPS = 64e-5f, LN_EPS = 1e-5f;

constexpr size_t WS_P = 0;
constexpr size_t WS_UB = 0;
constexpr size_t WS_VB = 67108864;
constexpr size_t WS_H0B = 198967296;
constexpr size_t WS_WTA = WS_H0B + 34603008;
constexpr size_t WS_WTB = WS_WTA + 8388608;
constexpr size_t WS_WTOUT = WS_WTB + 4194304;
constexpr size_t WS_WTQ = WS_WTOUT + 8388608;
constexpr size_t WS_WTPOOL = WS_WTQ + 8388608;
constexpr size_t WS_WTW2 = WS_WTPOOL + 524288;
constexpr size_t WS_WTA2 = WS_WTW2 + 393216;
constexpr size_t WS_WTG2 = WS_WTA2 + 393216;
constexpr size_t WS_SUBK = WS_WTG2 + 1048576;
constexpr size_t WS_BONUS = WS_SUBK + 65536;
constexpr size_t WS_REGC = WS_BONUS + 1048576;
constexpr size_t WS_WTIN = WS_REGC;
constexpr size_t UNITB = (size_t)NUNITS * 4096 * 2;
constexpr size_t WS_G = WS_REGC;
constexpr size_t WS_H0T = WS_REGC + UNITB;
constexpr size_t WS_RT = WS_REGC + 2 * UNITB;
constexpr size_t WS_Y0 = WS_REGC + 3 * UNITB;
constexpr size_t WS_S0T = WS_REGC + 4 * UNITB;
constexpr size_t WS_MERGED = WS_REGC;
constexpr size_t WS_MPART = WS_REGC + 33554432;
constexpr size_t WS_X1 = WS_REGC + 33554432;
constexpr size_t WS_H1B = WS_REGC + 100663296;
constexpr size_t WS_Q = WS_REGC + 134217728;
constexpr size_t WS_YA = WS_REGC + 5 * UNITB;
constexpr size_t WS_YB = WS_YA + 33554432;
constexpr size_t WS_EXP = WS_YB + 16777216;
constexpr size_t WS_GATE = WS_EXP + 4194304;
constexpr size_t WS_END = WS_GATE + 4194304;
static_assert(WS_Q + 33554432 <= WS_YA, "overlay");
static_assert(WS_VB + 67108864 <= WS_H0B, "overlay");

constexpr int LDS_BYTES = 163840;
constexpr int NPHASE = 10;

struct Params {
    const float* in[30];
    float* out;
    unsigned char* ws;
    int ph_lo, ph_hi;
};
enum { I_X = 0, I_META, I_LNIN_G, I_LNIN_B, I_WIN, I_MU, I_W0, I_WW2, I_A0, I_WA2, I_WG2, I_KK, I_KA, I_RK, I_GNG, I_GNB, I_WPOOL, I_PSCALE, I_BGATE,
       I_WBA, I_WBB, I_WOUT, I_LN1G, I_LN1B, I_WQ, I_SUBK, I_UT, I_VT, I_LN2G, I_LN2B };

__device__ __forceinline__ unsigned pk2(float lo, float hi) { return pg8::cvt_pk_bf16(lo, hi); }
__device__ __forceinline__ float bflo(unsigned w) { return __uint_as_float(w << 16); }
__device__ __forceinline__ float bfhi(unsigned w) { return __uint_as_float(w & 0xffff0000u); }
__device__ __forceinline__ float bf1(bf16_t h) { return __uint_as_float(((unsigned)h) << 16); }
__device__ __forceinline__ bf16_t f2bf1(float f) { return (bf16_t)(pk2(f, f) & 0xffffu); }
__device__ __forceinline__ float wave_sum(float v) {
#pragma unroll
    for (int o = 1; o < 64; o <<= 1) v += __shfl_xor(v, o);
    return v;
}
__device__ __forceinline__ float sigmoidf_(float x) { return 1.0f / (1.0f + __expf(-x)); }
__device__ __forceinline__ f32x4 mfma16(bf16x8 a, bf16x8 b, f32x4 c) { return __builtin_amdgcn_mfma_f32_16x16x32_bf16(a, b, c, 0, 0, 0); }
__device__ __forceinline__ void unpack8(const u32x4 w, float* f) {
    f[0] = bflo(w.x); f[1] = bfhi(w.x); f[2] = bflo(w.y); f[3] = bfhi(w.y); f[4] = bflo(w.z); f[5] = bfhi(w.z); f[6] = bflo(w.w); f[7] = bfhi(w.w);
}
__device__ __forceinline__ u32x4 pack8(const float* f) { u32x4 w; w.x = pk2(f[0], f[1]); w.y = pk2(f[2], f[3]); w.z = pk2(f[4], f[5]); w.w = pk2(f[6], f[7]); return w; }
#define BLOCK_SYNC() __syncthreads()
__device__ __forceinline__ void ln_row_bf16(const float* src, const float* g, const float* b, bf16_t* dst, int lane) {
    f32x4 v[8]; float s = 0.f;
#pragma unroll
    for (int j = 0; j < 8; ++j) { v[j] = ((const f32x4*)src)[lane + 64 * j]; s += (v[j].x + v[j].y) + (v[j].z + v[j].w); }
    const float mean = wave_sum(s) * (1.0f / D); float s2 = 0.f;
#pragma unroll
    for (int j = 0; j < 8; ++j) { v[j] = v[j] - mean; s2 += (v[j].x * v[j].x + v[j].y * v[j].y) + (v[j].z * v[j].z + v[j].w * v[j].w); }
    const float rstd = 1.0f / sqrtf(wave_sum(s2) * (1.0f / D) + LN_EPS);
#pragma unroll
    for (int j = 0; j < 8; ++j) {
        const f32x4 gg = ((const f32x4*)g)[lane + 64 * j], bb = ((const f32x4*)b)[lane + 64 * j];
        const f32x4 o = v[j] * rstd * gg + bb;
        u32x2 w; w.x = pk2(o.x, o.y); w.y = pk2(o.z, o.w);
        ((u32x2*)dst)[lane + 64 * j] = w;
    }
}
__device__ __forceinline__ void transpose_item(const float* W, int K, int N, int Npad, bf16_t* Wt, int item, int lane) {
    const int nblk = Npad >> 6, kb = item / nblk, nb = item - kb * nblk, n = nb * 64 + lane, k0 = kb * 32;
    float v[32];
    if (n < N) {
#pragma unroll
        for (int i = 0; i < 32; ++i) v[i] = W[(size_t)(k0 + i) * N + n];
    } else {
#pragma unroll
        for (int i = 0; i < 32; ++i) v[i] = 0.f;
    }
    u32x4* o = (u32x4*)(Wt + (size_t)n * K + k0);
#pragma unroll
    for (int c = 0; c < 4; ++c) { u32x4 w; w.x = pk2(v[8 * c], v[8 * c + 1]); w.y = pk2(v[8 * c + 2], v[8 * c + 3]); w.z = pk2(v[8 * c + 4], v[8 * c + 5]); w.w = pk2(v[8 * c + 6], v[8 * c + 7]); o[c] = w; }
}
__device__ __forceinline__ void phase0(const Params& P) {
    const int lane = threadIdx.x & 63, wave = threadIdx.x >> 6;
    const int gw = blockIdx.x * 8 + wave, NGW = gridDim.x * 8;
    unsigned char* ws = P.ws;
    constexpr int T_IN = 64 * 184, T_A = 64 * 32, T_B = 32 * 32, T_O = 64 * 32, T_Q = 64 * 32, T_POOL = 4 * 32, T_W2 = 3 * 32, T_A2 = 3 * 32, T_G2 = 8 * 32;
    constexpr int T_LN = MROWS, T_SK = 64;
    constexpr int NIT = T_IN + T_A + T_B + T_O + T_Q + T_POOL + T_W2 + T_A2 + T_G2 + T_LN + T_SK;
    for (int it = gw; it < NIT; it += NGW) {
        int r = it;
        if (r < T_IN) { transpose_item(P.in[I_WIN], 2048, INC, NPAD, (bf16_t*)(ws + WS_WTIN), r, lane); continue; } r -= T_IN;
        if (r < T_A) { transpose_item(P.in[I_WBA], 2048, 2048, 2048, (bf16_t*)(ws + WS_WTA), r, lane); continue; } r -= T_A;
        if (r < T_B) { transpose_item(P.in[I_WBB], 1024, 2048, 2048, (bf16_t*)(ws + WS_WTB), r, lane); continue; } r -= T_B;
        if (r < T_O) { transpose_item(P.in[I_WOUT], 2048, 2048, 2048, (bf16_t*)(ws + WS_WTOUT), r, lane); continue; } r -= T_O;
        if (r < T_Q) { transpose_item(P.in[I_WQ], 2048, 2048, 2048, (bf16_t*)(ws + WS_WTQ), r, lane); continue; } r -= T_Q;
        if (r < T_POOL) { const int g = r >> 5; transpose_item(P.in[I_WPOOL] + g * 65536, 256, 256, 256, (bf16_t*)(ws + WS_WTPOOL) + g * 65536, r & 31, lane); continue; } r -= T_POOL;
        if (r < T_W2) { transpose_item(P.in[I_WW2], 96, 2048, 2048, (bf16_t*)(ws + WS_WTW2), r, lane); continue; } r -= T_W2;
        if (r < T_A2) { transpose_item(P.in[I_WA2], 96, 2048, 2048, (bf16_t*)(ws + WS_WTA2), r, lane); continue; } r -= T_A2;
        if (r < T_G2) { transpose_item(P.in[I_WG2], 256, 2048, 2048, (bf16_t*)(ws + WS_WTG2), r, lane); continue; } r -= T_G2;
        if (r < T_LN) {
            bf16_t* dst = (bf16_t*)(ws + WS_H0B) + (size_t)r * D;
            if (r < NTOK) ln_row_bf16(P.in[I_X] + (size_t)r * D, P.in[I_LNIN_G], P.in[I_LNIN_B], dst, lane);
            else if (r < NTOK + 16) ln_row_bf16(P.in[I_META] + (size_t)(r - NTOK) * D, P.in[I_LNIN_G], P.in[I_LNIN_B], dst, lane);
            else {
#pragma unroll
                for (int j = 0; j < 8; ++j) ((u32x2*)dst)[lane + 64 * j] = (u32x2){0u, 0u};
            }
            continue;
        }
        r -= T_LN;
        {
            const float* s = P.in[I_SUBK] + r * 512 + lane * 8; float f[8];
#pragma unroll
            for (int i = 0; i < 8; ++i) f[i] = s[i];
            *(u32x4*)((bf16_t*)(ws + WS_SUBK) + r * 512 + lane * 8) = pack8(f);
        }
    }
}
namespace pg8 {
struct EpiGateA {
    static constexpr bool PERM = false, AFTER_DRAIN = false;
    float* C; const bf16_t* p; const float* bgate;
    __device__ __forceinline__ void operator()(const f32x4 (&acc)[2][2][4][2], const Unit& u, int wr, int wc, int fr, int fq) const {
        const int row0 = u.pm * BM + wr * 64 + fr, col0 = u.pn * BM + wc * 32 + 4 * fq;
#pragma unroll
        for (int ai = 0; ai < 2; ++ai)
#pragma unroll
            for (int m = 0; m < 4; ++m) { const size_t row = (size_t)(row0 + ai * HALF + m * 16);
#pragma unroll
                for (int bj = 0; bj < 2; ++bj)
#pragma unroll
                    for (int n = 0; n < 2; ++n) { const int col = col0 + bj * HALF + n * 16;
                        const u32x2 pw = *(const u32x2*)(p + row * NPAD + C_G0 + col); const f32x4 bg = *(const f32x4*)(bgate + col);
                        f32x4 g; g.x = sigmoidf_(bflo(pw.x) + bg.x); g.y = sigmoidf_(bfhi(pw.x) + bg.y); g.z = sigmoidf_(bflo(pw.y) + bg.z); g.w = sigmoidf_(bfhi(pw.y) + bg.w);
                        *(f32x4*)(C + row * D + col) = acc[ai][bj][m][n] * g; } }
    }
};
struct EpiGateB {
    static constexpr bool PERM = false, AFTER_DRAIN = false;
    const float* C; bf16_t* O; const bf16_t* p; const float* bgate;
    __device__ __forceinline__ void operator()(const f32x4 (&acc)[2][2][4][2], const Unit& u, int wr, int wc, int fr, int fq) const {
        const int row0 = u.pm * BM + wr * 64 + fr, col0 = u.pn * BM + wc * 32 + 4 * fq;
#pragma unroll
        for (int ai = 0; ai < 2; ++ai)
#pragma unroll
            for (int m = 0; m < 4; ++m) { const size_t row = (size_t)(row0 + ai * HALF + m * 16);
#pragma unroll
                for (int bj = 0; bj < 2; ++bj)
#pragma unroll
                    for (int n = 0; n < 2; ++n) { const int col = col0 + bj * HALF + n * 16;
                        const u32x2 pw = *(const u32x2*)(p + row * NPAD + C_G1 + col); const f32x4 bg = *(const f32x4*)(bgate + D + col);
                        f32x4 g; g.x = sigmoidf_(bflo(pw.x) + bg.x); g.y = sigmoidf_(bfhi(pw.x) + bg.y); g.z = sigmoidf_(bflo(pw.y) + bg.z); g.w = sigmoidf_(bfhi(pw.y) + bg.w);
                        const f32x4 o = *(const f32x4*)(C + row * D + col) + acc[ai][bj][m][n] * g;
                        u32x2 w; w.x = cvt_pk_bf16(o.x, o.y); w.y = cvt_pk_bf16(o.z, o.w);
                        *(u32x2*)(O + row * D + col) = w; } }
    }
};
struct EpiResid {
    static constexpr bool PERM = false, AFTER_DRAIN = false;
    float* C; const bf16_t* h0; float alpha;
    __device__ __forceinline__ void operator()(const f32x4 (&acc)[2][2][4][2], const Unit& u, int wr, int wc, int fr, int fq) const {
        const int row0 = u.pm * BM + wr * 64 + fr, col0 = u.pn * BM + wc * 32 + 4 * fq;
#pragma unroll
        for (int ai = 0; ai < 2; ++ai)
#pragma unroll
            for (int m = 0; m < 4; ++m) { const size_t row = (size_t)(row0 + ai * HALF + m * 16);
#pragma unroll
                for (int bj = 0; bj < 2; ++bj)
#pragma unroll
                    for (int n = 0; n < 2; ++n) { const int col = col0 + bj * HALF + n * 16;
                        const u32x2 hw = *(const u32x2*)(h0 + row * D + col);
                        f32x4 hv; hv.x = bflo(hw.x); hv.y = bfhi(hw.x); hv.z = bflo(hw.y); hv.w = bfhi(hw.y);
                        *(f32x4*)(C + row * D + col) = hv * alpha + acc[ai][bj][m][n]; } }
    }
};
}
template <class Epi>
__device__ __forceinline__ void run_gemm(ldsp lds, const bf16_t* A, const bf16_t* Bt, int M, int N, int K, const Epi& E) {
    pg8::Gemm g; g.A = A; g.Bt = Bt; g.M = M; g.N = N; g.K = K;
    pg8::StaticOrder S; S.init(M, N, (int)gridDim.x, (int)blockIdx.x);
    pg8::gemm_phase<Epi, pg8::StaticOrder, false>(lds, g, S, E, nullptr);
}
constexpr int LD64 = 72, MATB = 64 * LD64 * 2, LDK = 104;
constexpr int O_AB = 0, O_RB = 1 * MATB, O_BH = 2 * MATB, O_KH = 3 * MATB, O_ABT = 4 * MATB, O_BTT = 5 * MATB, O_KTT = 6 * MATB, O_VT = 7 * MATB;
constexpr int O_M0 = 8 * MATB, O_M0T = 9 * MATB, O_M1 = 10 * MATB, O_M1T = 11 * MATB, O_PA = 12 * MATB, O_PB = 13 * MATB, O_MAK = 14 * MATB, O_MRB = 15 * MATB, O_MRK = 16 * MATB;
constexpr int O_ELEND = 17 * MATB;
constexpr int O_WL = 8 * MATB, O_AL = O_WL + 64 * LDK * 2, O_Z = O_AL + 64 * LDK * 2, O_AZ = O_Z + 64 * 68 * 4;
static_assert(O_AZ + 64 * 68 * 4 <= O_ELEND, "lds");
static_assert(O_ELEND + 256 <= LDS_BYTES, "lds");

__device__ __forceinline__ bf16x8 ldsfrag(ldsp lds, int off, int ld, int row, int kofs) { return *(const LAS bf16x8*)(lds + off + (row * ld + kofs) * 2); }
__device__ __forceinline__ void st4(ldsp lds, int off, int row, int col, const f32x4 v) {
    u32x2 w; w.x = pk2(v.x, v.y); w.y = pk2(v.z, v.w); *(LAS u32x2*)(lds + off + (row * LD64 + col) * 2) = w; }
__device__ __forceinline__ void st1(ldsp lds, int off, int row, int col, float v) { *(LAS bf16_t*)(lds + off + (row * LD64 + col) * 2) = f2bf1(v); }

__device__ __forceinline__ void shift8(const bf16_t* pcur, const bf16_t* pprev, const float* mu, float* x) {
    float c[8], q[8];
    if (pcur) unpack8(*(const u32x4*)pcur, c); else {
#pragma unroll
        for (int i = 0; i < 8; ++i) c[i] = 0.f; }
    if (pprev) unpack8(*(const u32x4*)pprev, q); else {
#pragma unroll
        for (int i = 0; i < 8; ++i) q[i] = 0.f; }
    const f32x4 m0 = *(const f32x4*)mu, m1 = *(const f32x4*)(mu + 4);
    const float mm[8] = {m0.x, m0.y, m0.z, m0.w, m1.x, m1.y, m1.z, m1.w};
#pragma unroll
    for (int i = 0; i < 8; ++i) x[i] = c[i] + (q[i] - c[i]) * mm[i];
}

template <bool DO_P, bool DO_SQ>
__device__ __forceinline__ void dbl_step(ldsp lds, int sN, int sT, int dN, int dT, int pC, int pN, int tm, int tn0, int fr, int fq) {
    bf16x8 a[2];
#pragma unroll
    for (int ks = 0; ks < 2; ++ks) a[ks] = ldsfrag(lds, sT, LD64, 16 * tm + fr, ks * 32 + fq * 8);
#pragma unroll
    for (int t2 = 0; t2 < 2; ++t2) {
        const int nt = tn0 + t2, t = 16 * nt + fr, s0 = 16 * tm + 4 * fq;
        if (DO_P) {
            f32x4 acc = {0.f, 0.f, 0.f, 0.f};
#pragma unroll
            for (int ks = 0; ks < 2; ++ks) acc = mfma16(a[ks], ldsfrag(lds, pC, LD64, t, ks * 32 + fq * 8), acc);
            const u32x2 pw = *(const LAS u32x2*)(lds + pC + (t * LD64 + s0) * 2);
            acc.x += bflo(pw.x); acc.y += bfhi(pw.x); acc.z += bflo(pw.y); acc.w += bfhi(pw.y);
            st4(lds, pN, t, s0, acc);
        }
        if (DO_SQ) {
            f32x4 acc = {0.f, 0.f, 0.f, 0.f};
#pragma unroll
            for (int ks = 0; ks < 2; ++ks) acc = mfma16(a[ks], ldsfrag(lds, sN, LD64, t, ks * 32 + fq * 8), acc);
            st4(lds, dN, t, s0, acc);
            st1(lds, dT, s0 + 0, t, acc.x); st1(lds, dT, s0 + 1, t, acc.y); st1(lds, dT, s0 + 2, t, acc.z); st1(lds, dT, s0 + 3, t, acc.w);
        }
    }
}


#ifdef DBG_STAGE
constexpr size_t DBG_STRIDE = (size_t)NUNITS * 512 * 4;
__device__ __forceinline__ void dbgsum(const Params& P, ldsp lds, int u, int stage, const int* offs, int nmat) {
    unsigned acc = 0;
    for (int m = 0; m < nmat; ++m)
        for (int k = 0; k < 4; ++k) { const int idx = threadIdx.x + 512 * k, row = idx >> 5, cp = idx & 31; const unsigned x = *(const LAS unsigned*)(lds + offs[m] + row * (LD64 * 2) + cp * 4); acc += (x & 0xffffu) + (x >> 16); }
    ((unsigned*)(P.ws + WS_S0T + (size_t)stage * DBG_STRIDE))[(size_t)u * 512 + threadIdx.x] = acc;
}
#define DBGSUM(stage, ...) do { const int offs_[] = {__VA_ARGS__}; dbgsum(P, lds, u, stage, offs_, (int)(sizeof(offs_) / sizeof(int))); } while (0)
#else
#define DBGSUM(stage, ...) do { } while (0)
#endif
__device__ __forceinline__ void rwkv_unit(const Params& P, ldsp lds, int u) {
    const int tid = threadIdx.x, lane = tid & 63, wave = tid >> 6, fr = lane & 15, fq = lane >> 4, tm = wave >> 1, tn0 = (wave & 1) * 2;
    unsigned char* ws = P.ws;
    const bf16_t* pp = (const bf16_t*)(ws + WS_P);
    const bool meta = u >= 4096;
    int b = 0, h, c = 0;
    if (meta) { h = u - 4096; } else { const int bh = u >> 6; c = u & 63; b = bh >> 5; h = bh & 31; }
    auto rowof = [&](int tl) -> int {
        if (meta) return (tl >= 48) ? (ROW_META + tl - 48) : -1;
        if (tl >= 0 || c > 0) return b * SEQ + c * 64 + tl;
        return ROW_META + 15;
    };
    auto rowp = [&](int tl, int col) -> const bf16_t* { const int r = rowof(tl); return r < 0 ? (const bf16_t*)nullptr : pp + (size_t)r * NPAD + col; };
    const float* mu = P.in[I_MU];
    for (int idx = tid; idx < 1536; idx += 512) {
        const int mat = idx / 768, rem = idx - mat * 768, t = rem / 12, ch = rem - t * 12, col = (mat ? C_AL : C_WL) + ch * 8;
        float x[8]; shift8(rowp(t, col), rowp(t - 1, col), mu + col, x);
        if (mat == 0) {
#pragma unroll
            for (int i = 0; i < 8; ++i) x[i] = tanhf(x[i]);
        }
        *(LAS u32x4*)(lds + (mat ? O_AL : O_WL) + (t * LDK + ch * 8) * 2) = pack8(x);
    }
    BLOCK_SYNC();
    {
        const bf16_t* ww2 = (const bf16_t*)(ws + WS_WTW2) + (size_t)(h * 64 + 16 * tm + fr) * 96 + fq * 8;
        const bf16_t* wa2 = (const bf16_t*)(ws + WS_WTA2) + (size_t)(h * 64 + 16 * tm + fr) * 96 + fq * 8;
        f32x4 z[2] = {{0.f, 0.f, 0.f, 0.f}, {0.f, 0.f, 0.f, 0.f}}, az[2] = {{0.f, 0.f, 0.f, 0.f}, {0.f, 0.f, 0.f, 0.f}};
#pragma unroll
        for (int ks = 0; ks < 3; ++ks) {
            const bf16x8 aw = *(const bf16x8*)(ww2 + ks * 32), aa = *(const bf16x8*)(wa2 + ks * 32);
#pragma unroll
            for (int t2 = 0; t2 < 2; ++t2) {
                const int t = 16 * (tn0 + t2) + fr;
                z[t2] = mfma16(aw, ldsfrag(lds, O_WL, LDK, t, ks * 32 + fq * 8), z[t2]);
                az[t2] = mfma16(aa, ldsfrag(lds, O_AL, LDK, t, ks * 32 + fq * 8), az[t2]);
            }
        }
#pragma unroll
        for (int t2 = 0; t2 < 2; ++t2) {
            const int t = 16 * (tn0 + t2) + fr, j0 = 16 * tm + 4 * fq;
            *(LAS f32x4*)(lds + O_Z + (t * 68 + j0) * 4) = z[t2];
            *(LAS f32x4*)(lds + O_AZ + (t * 68 + j0) * 4) = az[t2];
        }
    }
    BLOCK_SYNC();
    const int t = tid >> 3, jq = tid & 7, j0 = 8 * jq, hj = h * 64 + j0;
    const bool nulltok = meta && t < 48;
    float lw[8], av[8], rv[8], kv[8], vv[8], kk[8], km[8];
    {
        const f32x4 z0 = *(const LAS f32x4*)(lds + O_Z + (t * 68 + j0) * 4), z1 = *(const LAS f32x4*)(lds + O_Z + (t * 68 + j0 + 4) * 4);
        const f32x4 y0 = *(const LAS f32x4*)(lds + O_AZ + (t * 68 + j0) * 4), y1 = *(const LAS f32x4*)(lds + O_AZ + (t * 68 + j0 + 4) * 4);
        const float zz[8] = {z0.x, z0.y, z0.z, z0.w, z1.x, z1.y, z1.z, z1.w}, yy[8] = {y0.x, y0.y, y0.z, y0.w, y1.x, y1.y, y1.z, y1.w};
        const float* w0 = P.in[I_W0] + hj; const float* a0 = P.in[I_A0] + hj;
#pragma unroll
        for (int i = 0; i < 8; ++i) { lw[i] = nulltok ? 0.f : -DSCALE * sigmoidf_(w0[i] + zz[i]); av[i] = sigmoidf_(a0[i] + yy[i]); }
        shift8(rowp(t, C_R + hj), rowp(t - 1, C_R + hj), mu + C_R + hj, rv);
        shift8(rowp(t, C_K + hj), rowp(t - 1, C_K + hj), mu + C_K + hj, kv);
        shift8(rowp(t, C_V + hj), rowp(t - 1, C_V + hj), mu + C_V + hj, vv);
        if (nulltok) {
#pragma unroll
            for (int i = 0; i < 8; ++i) { rv[i] = 0.f; kv[i] = 0.f; vv[i] = 0.f; }
        }
        const float* kkw = P.in[I_KK] + hj; const float* kaw = P.in[I_KA] + hj; const float* rkw = P.in[I_RK] + hj;
        float n2 = 0.f, bon = 0.f;
#pragma unroll
        for (int i = 0; i < 8; ++i) { kk[i] = kv[i] * kkw[i]; n2 += kk[i] * kk[i]; km[i] = kv[i] * (1.0f + (av[i] - 1.0f) * kaw[i]); bon += rv[i] * km[i] * rkw[i]; }
        n2 += __shfl_xor(n2, 1); n2 += __shfl_xor(n2, 2); n2 += __shfl_xor(n2, 4);
        bon += __shfl_xor(bon, 1); bon += __shfl_xor(bon, 2); bon += __shfl_xor(bon, 4);
        const float inv = 1.0f / fmaxf(sqrtf(n2), 1e-12f);
#pragma unroll
        for (int i = 0; i < 8; ++i) kk[i] *= inv;
        if (!meta && jq == 0) ((float*)(ws + WS_BONUS))[(size_t)(b * SEQ + c * 64 + t) * 32 + h] = bon;
        *(LAS f32x4*)(lds + O_Z + (t * 68 + j0) * 4) = (f32x4){lw[0], lw[1], lw[2], lw[3]};
        *(LAS f32x4*)(lds + O_Z + (t * 68 + j0 + 4) * 4) = (f32x4){lw[4], lw[5], lw[6], lw[7]};
    }
    BLOCK_SYNC();
    {
        float Lc[8], Le[8];
#pragma unroll
        for (int i = 0; i < 8; ++i) { Lc[i] = 0.f; Le[i] = 0.f; }
        for (int tau = 0; tau < 64; ++tau) {
            const f32x4 x0 = *(const LAS f32x4*)(lds + O_Z + (tau * 68 + j0) * 4), x1 = *(const LAS f32x4*)(lds + O_Z + (tau * 68 + j0 + 4) * 4);
            const float xx[8] = {x0.x, x0.y, x0.z, x0.w, x1.x, x1.y, x1.z, x1.w};
            const float msk = tau <= t ? 1.0f : 0.0f;
#pragma unroll
            for (int i = 0; i < 8; ++i) { Le[i] += xx[i]; Lc[i] += msk * xx[i]; }
        }
        float Ab[8], Rb[8], Bh[8], Kh[8], Bt[8], Kt[8];
#pragma unroll
        for (int i = 0; i < 8; ++i) {
            const float eP = __expf(Lc[i] - lw[i]), eC = __expf(Lc[i]), eN = __expf(-Lc[i]), eE = __expf(Le[i] - Lc[i]);
            const float ka = kk[i] * av[i];
            Ab[i] = -kk[i] * eP; Rb[i] = rv[i] * eC; Bh[i] = ka * eN; Kh[i] = km[i] * eN; Bt[i] = ka * eE; Kt[i] = km[i] * eE;
        }
        *(LAS u32x4*)(lds + O_AB + (t * LD64 + j0) * 2) = pack8(Ab);
        *(LAS u32x4*)(lds + O_RB + (t * LD64 + j0) * 2) = pack8(Rb);
        *(LAS u32x4*)(lds + O_BH + (t * LD64 + j0) * 2) = pack8(Bh);
        *(LAS u32x4*)(lds + O_KH + (t * LD64 + j0) * 2) = pack8(Kh);
#pragma unroll
        for (int i = 0; i < 8; ++i) { st1(lds, O_ABT, j0 + i, t, Ab[i]); st1(lds, O_BTT, j0 + i, t, Bt[i]); st1(lds, O_KTT, j0 + i, t, Kt[i]); st1(lds, O_VT, j0 + i, t, vv[i]); }
        if (t == 63) {
#pragma unroll
            for (int i = 0; i < 8; ++i) *(LAS float*)(lds + O_ELEND + (j0 + i) * 4) = __expf(Le[i]);
        }
    }
    BLOCK_SYNC();
    DBGSUM(0, O_AB, O_RB, O_BH, O_KH, O_ABT, O_BTT, O_KTT, O_VT);
    {
        bf16x8 abh[2], akh[2];
#pragma unroll
        for (int ks = 0; ks < 2; ++ks) { abh[ks] = ldsfrag(lds, O_BH, LD64, 16 * tm + fr, ks * 32 + fq * 8); akh[ks] = ldsfrag(lds, O_KH, LD64, 16 * tm + fr, ks * 32 + fq * 8); }
#pragma unroll
        for (int t2 = 0; t2 < 2; ++t2) {
            const int tt = 16 * (tn0 + t2) + fr, s0 = 16 * tm + 4 * fq;
            f32x4 mab = {0.f, 0.f, 0.f, 0.f}, mak = mab, mrb = mab, mrk = mab;
#pragma unroll
            for (int ks = 0; ks < 2; ++ks) {
                const bf16x8 bab = ldsfrag(lds, O_AB, LD64, tt, ks * 32 + fq * 8), brb = ldsfrag(lds, O_RB, LD64, tt, ks * 32 + fq * 8);
                mab = mfma16(abh[ks], bab, mab); mak = mfma16(akh[ks], bab, mak); mrb = mfma16(abh[ks], brb, mrb); mrk = mfma16(akh[ks], brb, mrk);
            }
            float vab[4] = {mab.x, mab.y, mab.z, mab.w}, vak[4] = {mak.x, mak.y, mak.z, mak.w}, vrb[4] = {mrb.x, mrb.y, mrb.z, mrb.w}, vrk[4] = {mrk.x, mrk.y, mrk.z, mrk.w}, vp[4];
#pragma unroll
            for (int r = 0; r < 4; ++r) { const int s = s0 + r; const bool st = s < tt, le = s <= tt;
                vab[r] = st ? vab[r] : 0.f; vak[r] = st ? vak[r] : 0.f; vrb[r] = le ? vrb[r] : 0.f; vrk[r] = le ? vrk[r] : 0.f; vp[r] = vab[r] + (s == tt ? 1.0f : 0.f); }
            st4(lds, O_M0, tt, s0, (f32x4){vab[0], vab[1], vab[2], vab[3]});
#pragma unroll
            for (int r = 0; r < 4; ++r) st1(lds, O_M0T, s0 + r, tt, vab[r]);
            st4(lds, O_PA, tt, s0, (f32x4){vp[0], vp[1], vp[2], vp[3]});
            st4(lds, O_MAK, tt, s0, (f32x4){vak[0], vak[1], vak[2], vak[3]});
            st4(lds, O_MRB, tt, s0, (f32x4){vrb[0], vrb[1], vrb[2], vrb[3]});
            st4(lds, O_MRK, tt, s0, (f32x4){vrk[0], vrk[1], vrk[2], vrk[3]});
        }
    }
    BLOCK_SYNC();
    DBGSUM(1, O_M0, O_M0T, O_PA, O_MAK, O_MRB, O_MRK);
    dbl_step<false, true>(lds, O_M0, O_M0T, O_M1, O_M1T, 0, 0, tm, tn0, fr, fq); BLOCK_SYNC();
    dbl_step<true, true>(lds, O_M1, O_M1T, O_M0, O_M0T, O_PA, O_PB, tm, tn0, fr, fq); BLOCK_SYNC();
    dbl_step<true, true>(lds, O_M0, O_M0T, O_M1, O_M1T, O_PB, O_PA, tm, tn0, fr, fq); BLOCK_SYNC();
    dbl_step<true, true>(lds, O_M1, O_M1T, O_M0, O_M0T, O_PA, O_PB, tm, tn0, fr, fq); BLOCK_SYNC();
    dbl_step<true, true>(lds, O_M0, O_M0T, O_M1, O_M1T, O_PB, O_PA, tm, tn0, fr, fq); BLOCK_SYNC();
    dbl_step<true, false>(lds, O_M1, O_M1T, 0, 0, O_PA, O_PB, tm, tn0, fr, fq); BLOCK_SYNC();
    DBGSUM(2, O_PB);
    {
        bf16x8 aT[2], aMak[2];
#pragma unroll
        for (int ks = 0; ks < 2; ++ks) { aT[ks] = ldsfrag(lds, O_PB, LD64, 16 * tm + fr, ks * 32 + fq * 8); aMak[ks] = ldsfrag(lds, O_MAK, LD64, 16 * tm + fr, ks * 32 + fq * 8); }
#pragma unroll
        for (int t2 = 0; t2 < 2; ++t2) {
            const int n = 16 * (tn0 + t2) + fr, t0 = 16 * tm + 4 * fq;
            f32x4 at = {0.f, 0.f, 0.f, 0.f}, xt = at;
#pragma unroll
            for (int ks = 0; ks < 2; ++ks) { at = mfma16(aT[ks], ldsfrag(lds, O_ABT, LD64, n, ks * 32 + fq * 8), at); xt = mfma16(aMak[ks], ldsfrag(lds, O_VT, LD64, n, ks * 32 + fq * 8), xt); }
            st4(lds, O_M0, n, t0, at); st4(lds, O_M0T, n, t0, xt);
        }
    }
    BLOCK_SYNC();
    DBGSUM(3, O_M0, O_M0T);
    const size_t ub = (size_t)u * 4096;
    {
        bf16x8 aT[2], aAt[2];
#pragma unroll
        for (int ks = 0; ks < 2; ++ks) { aT[ks] = ldsfrag(lds, O_PB, LD64, 16 * tm + fr, ks * 32 + fq * 8); aAt[ks] = ldsfrag(lds, O_M0, LD64, 16 * tm + fr, ks * 32 + fq * 8); }
        bf16_t* Rt = (bf16_t*)(ws + WS_RT) + ub; bf16_t* Gp = (bf16_t*)(ws + WS_G) + ub;
#pragma unroll
        for (int t2 = 0; t2 < 2; ++t2) {
            const int n = 16 * (tn0 + t2) + fr, m0 = 16 * tm + 4 * fq;
            f32x4 u0 = {0.f, 0.f, 0.f, 0.f}, rt = u0, g = u0;
#pragma unroll
            for (int ks = 0; ks < 2; ++ks) {
                u0 = mfma16(aT[ks], ldsfrag(lds, O_M0T, LD64, n, ks * 32 + fq * 8), u0);
                rt = mfma16(aAt[ks], ldsfrag(lds, O_MRB, LD64, n, ks * 32 + fq * 8), rt);
                g = mfma16(aAt[ks], ldsfrag(lds, O_BTT, LD64, n, ks * 32 + fq * 8), g);
            }
            st4(lds, O_M1, n, m0, u0);
            const u32x2 rw = *(const LAS u32x2*)(lds + O_RB + (n * LD64 + m0) * 2);
            rt.x += bflo(rw.x); rt.y += bfhi(rw.x); rt.z += bflo(rw.y); rt.w += bfhi(rw.y);
            { u32x2 w; w.x = pk2(rt.x, rt.y); w.y = pk2(rt.z, rt.w); *(u32x2*)(Rt + n * 64 + m0) = w; }
            if ((n >> 2) == (m0 >> 2)) { const float e = *(const LAS float*)(lds + O_ELEND + n * 4); const int r = n & 3;
                g.x += (r == 0) ? e : 0.f; g.y += (r == 1) ? e : 0.f; g.z += (r == 2) ? e : 0.f; g.w += (r == 3) ? e : 0.f; }
            { const int pos0 = 32 * (tm >> 1) + 8 * fq + 4 * (tm & 1); u32x2 w; w.x = pk2(g.x, g.y); w.y = pk2(g.z, g.w); *(u32x2*)(Gp + n * 64 + pos0) = w; }
        }
    }
    BLOCK_SYNC();
    DBGSUM(4, O_M1);
    {
        bf16x8 aB[2], aK[2], aU[2], aV[2];
#pragma unroll
        for (int ks = 0; ks < 2; ++ks) { const int row = 16 * tm + fr, ko = ks * 32 + fq * 8;
            aB[ks] = ldsfrag(lds, O_BTT, LD64, row, ko); aK[ks] = ldsfrag(lds, O_KTT, LD64, row, ko); aU[ks] = ldsfrag(lds, O_M1, LD64, row, ko); aV[ks] = ldsfrag(lds, O_VT, LD64, row, ko); }
        bf16_t* H0t = (bf16_t*)(ws + WS_H0T) + ub; bf16_t* Y0s = (bf16_t*)(ws + WS_Y0) + ub;
#pragma unroll
        for (int t2 = 0; t2 < 2; ++t2) {
            const int n = 16 * (tn0 + t2) + fr, m0 = 16 * tm + 4 * fq;
            f32x4 hh = {0.f, 0.f, 0.f, 0.f}, yy = hh;
#pragma unroll
            for (int ks = 0; ks < 2; ++ks) { const int ko = ks * 32 + fq * 8;
                const bf16x8 bU = ldsfrag(lds, O_M1, LD64, n, ko), bV = ldsfrag(lds, O_VT, LD64, n, ko), bRb = ldsfrag(lds, O_MRB, LD64, n, ko), bRk = ldsfrag(lds, O_MRK, LD64, n, ko);
                hh = mfma16(aB[ks], bU, hh); hh = mfma16(aK[ks], bV, hh);
                yy = mfma16(aU[ks], bRb, yy); yy = mfma16(aV[ks], bRk, yy); }
            { u32x2 w; w.x = pk2(hh.x, hh.y); w.y = pk2(hh.z, hh.w); *(u32x2*)(H0t + n * 64 + m0) = w; }
            { u32x2 w; w.x = pk2(yy.x, yy.y); w.y = pk2(yy.z, yy.w); *(u32x2*)(Y0s + n * 64 + m0) = w; }
        }
    }
    BLOCK_SYNC();
}

constexpr int LDU = 264;
__device__ __forceinline__ void pool_unit(const Params& P, ldsp lds, int pu) {
    const int tid = threadIdx.x, lane = tid & 63, wave = tid >> 6, fr = lane & 15, fq = lane >> 4;
    unsigned char* ws = P.ws;
    const bf16_t* pp = (const bf16_t*)(ws + WS_P);
    const int g = pu & 3, tt = pu >> 2, b = tt >> 6, ti0 = (tt & 63) * 64;
    constexpr int O_U = 0, O_PL = 79 * LDU * 2;
    for (int idx = tid; idx < 79 * 32; idx += 512) {
        const int lr = idx >> 5, ch = idx & 31, ti = ti0 + lr - 15;
        const int row = ti >= 0 ? b * SEQ + ti : ROW_META + 16 + ti;
        *(LAS u32x4*)(lds + O_U + (lr * LDU + ch * 8) * 2) = *(const u32x4*)(pp + (size_t)row * NPAD + C_POOL + g * 256 + ch * 8);
    }
    BLOCK_SYNC();
    {
        const int t = tid >> 3, cq = tid & 7, win = 2 << g; const float inv = 1.0f / (float)win;
#pragma unroll
        for (int cc = 0; cc < 4; ++cc) {
            const int c0 = cq * 32 + cc * 8; float s[8], own[8];
            unpack8(*(const LAS u32x4*)(lds + O_U + ((15 + t) * LDU + c0) * 2), own);
#pragma unroll
            for (int i = 0; i < 8; ++i) s[i] = own[i];
            for (int d = 1; d < win; ++d) { float x[8]; unpack8(*(const LAS u32x4*)(lds + O_U + ((15 + t - d) * LDU + c0) * 2), x);
#pragma unroll
                for (int i = 0; i < 8; ++i) s[i] += x[i]; }
#pragma unroll
            for (int i = 0; i < 8; ++i) s[i] = s[i] * inv - own[i];
            *(LAS u32x4*)(lds + O_PL + (t * LDU + c0) * 2) = pack8(s);
        }
    }
    BLOCK_SYNC();
    {
        const bf16_t* wt = (const bf16_t*)(ws + WS_WTPOOL) + (size_t)g * 65536;
        f32x4 acc[2][4];
#pragma unroll
        for (int a = 0; a < 2; ++a)
#pragma unroll
            for (int n = 0; n < 4; ++n) acc[a][n] = (f32x4){0.f, 0.f, 0.f, 0.f};
#pragma unroll 2
        for (int ks = 0; ks < 8; ++ks) {
            bf16x8 af[2];
#pragma unroll
            for (int a = 0; a < 2; ++a) af[a] = *(const bf16x8*)(wt + (size_t)(32 * wave + 16 * a + fr) * 256 + ks * 32 + fq * 8);
#pragma unroll
            for (int n = 0; n < 4; ++n) { const bf16x8 bf = ldsfrag(lds, O_PL, LDU, 16 * n + fr, ks * 32 + fq * 8);
#pragma unroll
                for (int a = 0; a < 2; ++a) acc[a][n] = mfma16(af[a], bf, acc[a][n]); }
        }
        bf16_t* yb = (bf16_t*)(ws + WS_YB);
        const float* psc = P.in[I_PSCALE] + g * 256;
#pragma unroll
        for (int a = 0; a < 2; ++a) { const int d0 = 32 * wave + 16 * a + 4 * fq; const f32x4 sc = *(const f32x4*)(psc + d0);
#pragma unroll
            for (int n = 0; n < 4; ++n) { const int t = 16 * n + fr; const f32x4 o = acc[a][n] * sc;
                u32x2 w; w.x = pk2(o.x, o.y); w.y = pk2(o.z, o.w);
                *(u32x2*)(yb + (size_t)(b * SEQ + ti0 + t) * 1024 + g * 256 + d0) = w; } }
    }
    BLOCK_SYNC();
}
__device__ __forceinline__ void phase2(const Params& P, ldsp lds) {
    for (int u = blockIdx.x; u < NUNITS + 512; u += gridDim.x) {
        if (u < NUNITS) rwkv_unit(P, lds, u); else pool_unit(P, lds, u - NUNITS);
    }
}
__device__ __forceinline__ void phase3(const Params& P) {
    const int lane = threadIdx.x & 63, wave = threadIdx.x >> 6, fr = lane & 15, fq = lane >> 4;
    if (wave != 0) return;
    unsigned char* ws = P.ws;
    const bf16_t* Gp = (const bf16_t*)(ws + WS_G); const bf16_t* H0t = (const bf16_t*)(ws + WS_H0T); bf16_t* S0t = (bf16_t*)(ws + WS_S0T);
    for (int item = blockIdx.x; item < 256; item += gridDim.x) {
        const int bh = item >> 2, vq = item & 3, h = bh & 31;
        bf16x8 Sb[2];
#pragma unroll
        for (int ks = 0; ks < 2; ++ks)
#pragma unroll
            for (int i = 0; i < 8; ++i) Sb[ks][i] = 0;
        bf16x8 gA[4][2]; u32x2 hF[4];
        auto load = [&](int step, bf16x8 (&ga)[4][2], u32x2 (&hf)[4]) {
            const int u = (step == 0) ? (4096 + h) : (bh * 64 + step - 1);
            const bf16_t* g = Gp + (size_t)u * 4096; const bf16_t* hh = H0t + (size_t)u * 4096;
#pragma unroll
            for (int mt = 0; mt < 4; ++mt) {
#pragma unroll
                for (int ks = 0; ks < 2; ++ks) ga[mt][ks] = *(const bf16x8*)(g + (16 * mt + fr) * 64 + ks * 32 + fq * 8);
                hf[mt] = *(const u32x2*)(hh + (16 * vq + fr) * 64 + 16 * mt + 4 * fq);
            }
        };
        load(0, gA, hF);
        for (int step = 0; step < 64; ++step) {
            bf16x8 gN[4][2]; u32x2 hN[4];
            if (step + 1 < 64) load(step + 1, gN, hN);
            f32x4 acc[4];
#pragma unroll
            for (int mt = 0; mt < 4; ++mt) {
                acc[mt] = (f32x4){bflo(hF[mt].x), bfhi(hF[mt].x), bflo(hF[mt].y), bfhi(hF[mt].y)};
                acc[mt] = mfma16(gA[mt][0], Sb[0], acc[mt]);
                acc[mt] = mfma16(gA[mt][1], Sb[1], acc[mt]);
            }
            bf16_t* so = S0t + (size_t)(bh * 64 + step) * 4096 + (16 * vq + fr) * 64 + 4 * fq;
            u32x2 w[4];
#pragma unroll
            for (int mt = 0; mt < 4; ++mt) { w[mt].x = pk2(acc[mt].x, acc[mt].y); w[mt].y = pk2(acc[mt].z, acc[mt].w); *(u32x2*)(so + 16 * mt) = w[mt]; }
#pragma unroll
            for (int ks = 0; ks < 2; ++ks) {
                const u32x4 q = (u32x4){w[2 * ks].x, w[2 * ks].y, w[2 * ks + 1].x, w[2 * ks + 1].y};
                Sb[ks] = __builtin_bit_cast(bf16x8, q);
            }
            if (step + 1 < 64) {
#pragma unroll
                for (int mt = 0; mt < 4; ++mt) { gA[mt][0] = gN[mt][0]; gA[mt][1] = gN[mt][1]; hF[mt] = hN[mt]; }
            }
        }
    }
}

constexpr int LDG = 264;
__device__ __forceinline__ void phase3b(const Params& P, ldsp lds) {
    const int tid = threadIdx.x, lane = tid & 63, wave = tid >> 6, fr = lane & 15, fq = lane >> 4, wq = wave & 3;
    unsigned char* ws = P.ws;
    const bf16_t* pp = (const bf16_t*)(ws + WS_P);
    const float* mu = P.in[I_MU];
    ldsp gl = lds + wave * (16 * LDG * 2);
    for (int pair = blockIdx.x; pair < 2048; pair += gridDim.x) {
        const int u = pair * 2 + (wave >> 2), bh = u >> 6, c = u & 63, b = bh >> 5, h = bh & 31;
        const int trow0 = b * SEQ + c * 64 + 16 * wq;
#pragma unroll
        for (int it = 0; it < 8; ++it) {
            const int idx = it * 64 + lane, tl = idx >> 5, ch = idx & 31, col = C_GL + ch * 8;
            const int row = trow0 + tl; const int prow = (c == 0 && wq == 0 && tl == 0) ? (ROW_META + 15) : row - 1;
            float x[8]; shift8(pp + (size_t)row * NPAD + col, pp + (size_t)prow * NPAD + col, mu + col, x);
#pragma unroll
            for (int i = 0; i < 8; ++i) x[i] = sigmoidf_(x[i]);
            *(LAS u32x4*)(gl + (tl * LDG + ch * 8) * 2) = pack8(x);
        }
        BLOCK_SYNC();
        f32x4 gacc[4];
#pragma unroll
        for (int mt = 0; mt < 4; ++mt) gacc[mt] = (f32x4){0.f, 0.f, 0.f, 0.f};
        {
            const bf16_t* wg = (const bf16_t*)(ws + WS_WTG2) + (size_t)(h * 64 + fr) * 256 + fq * 8;
#pragma unroll 2
            for (int ks = 0; ks < 8; ++ks) {
                const bf16x8 bf = *(const LAS bf16x8*)(gl + (fr * LDG + ks * 32 + fq * 8) * 2);
#pragma unroll
                for (int mt = 0; mt < 4; ++mt) gacc[mt] = mfma16(*(const bf16x8*)(wg + (size_t)(16 * mt) * 256 + ks * 32), bf, gacc[mt]);
            }
        }
        f32x4 y[4];
        {
            const size_t ub = (size_t)u * 4096;
            const bf16_t* S0t = (const bf16_t*)(ws + WS_S0T) + ub; const bf16_t* Rt = (const bf16_t*)(ws + WS_RT) + ub; const bf16_t* Y0s = (const bf16_t*)(ws + WS_Y0) + ub;
            bf16x8 bR[2];
#pragma unroll
            for (int ks = 0; ks < 2; ++ks) bR[ks] = *(const bf16x8*)(Rt + (16 * wq + fr) * 64 + ks * 32 + fq * 8);
#pragma unroll
            for (int mt = 0; mt < 4; ++mt) {
                const u32x2 yw = *(const u32x2*)(Y0s + (16 * wq + fr) * 64 + 16 * mt + 4 * fq);
                y[mt] = (f32x4){bflo(yw.x), bfhi(yw.x), bflo(yw.y), bfhi(yw.y)};
#pragma unroll
                for (int ks = 0; ks < 2; ++ks) y[mt] = mfma16(*(const bf16x8*)(S0t + (16 * mt + fr) * 64 + ks * 32 + fq * 8), bR[ks], y[mt]);
            }
        }
        float s = 0.f;
#pragma unroll
        for (int mt = 0; mt < 4; ++mt) s += (y[mt].x + y[mt].y) + (y[mt].z + y[mt].w);
        s += __shfl_xor(s, 16); s += __shfl_xor(s, 32);
        const float mean = s * (1.0f / 64.0f); float q = 0.f;
#pragma unroll
        for (int mt = 0; mt < 4; ++mt) { y[mt] = y[mt] - mean; q += (y[mt].x * y[mt].x + y[mt].y * y[mt].y) + (y[mt].z * y[mt].z + y[mt].w * y[mt].w); }
        q += __shfl_xor(q, 16); q += __shfl_xor(q, 32);
        const float rstd = 1.0f / sqrtf(q * (1.0f / 64.0f) + GN_EPS);
        const int row = trow0 + fr; const int prow = (c == 0 && wq == 0 && fr == 0) ? (ROW_META + 15) : row - 1;
        const float bon = ((const float*)(ws + WS_BONUS))[(size_t)row * 32 + h];
        bf16_t* ya = (bf16_t*)(ws + WS_YA) + (size_t)row * D + h * 64;
#pragma unroll
        for (int mt = 0; mt < 4; ++mt) {
            const int i0 = 16 * mt + 4 * fq, hc = h * 64 + i0;
            const f32x4 gg = *(const f32x4*)(P.in[I_GNG] + hc), gb = *(const f32x4*)(P.in[I_GNB] + hc), mv = *(const f32x4*)(mu + C_V + hc);
            const u32x2 vc = *(const u32x2*)(pp + (size_t)row * NPAD + C_V + hc), vp = *(const u32x2*)(pp + (size_t)prow * NPAD + C_V + hc);
            f32x4 cv = (f32x4){bflo(vc.x), bfhi(vc.x), bflo(vc.y), bfhi(vc.y)}, pv = (f32x4){bflo(vp.x), bfhi(vp.x), bflo(vp.y), bfhi(vp.y)};
            const f32x4 v = cv + (pv - cv) * mv;
            const f32x4 o = (y[mt] * rstd * gg + gb + v * bon) * gacc[mt];
            u32x2 w; w.x = pk2(o.x, o.y); w.y = pk2(o.z, o.w);
            *(u32x2*)(ya + i0) = w;
        }
        BLOCK_SYNC();
    }
}
__device__ __forceinline__ void phase5b(const Params& P) {
    const int lane = threadIdx.x & 63, wave = threadIdx.x >> 6;
    const int gw = blockIdx.x * 8 + wave, NGW = gridDim.x * 8;
    unsigned char* ws = P.ws;
    for (int r = gw; r < NTOK; r += NGW)
        ln_row_bf16((const float*)(ws + WS_X1) + (size_t)r * D, P.in[I_LN1G], P.in[I_LN1B], (bf16_t*)(ws + WS_H1B) + (size_t)r * D, lane);
    for (int r = gw; r < 32768; r += NGW) {
        const float* src = (r < 16384 ? P.in[I_UT] : P.in[I_VT]) + (size_t)(r & 16383) * D;
        bf16_t* dst = (bf16_t*)(ws + (r < 16384 ? WS_UB : WS_VB)) + (size_t)(r & 16383) * D;
        f32x4 v[8];
#pragma unroll
        for (int j = 0; j < 8; ++j) v[j] = ((const f32x4*)src)[lane + 64 * j];
#pragma unroll
        for (int j = 0; j < 8; ++j) { u32x2 w; w.x = pk2(v[j].x, v[j].y); w.y = pk2(v[j].z, v[j].w); ((u32x2*)dst)[lane + 64 * j] = w; }
    }
}

__device__ __forceinline__ void phase7(const Params& P, ldsp lds) {
    const int tid = threadIdx.x, lane = tid & 63, wave = tid >> 6, fr = lane & 15, fq = lane >> 4;
    unsigned char* ws = P.ws;
    const bf16_t* qb = (const bf16_t*)(ws + WS_Q); const bf16_t* sk = (const bf16_t*)(ws + WS_SUBK);
    int* eout = (int*)(ws + WS_EXP); float* gout = (float*)(ws + WS_GATE);
    constexpr int O_SC = 0, O_SV = 64 * 132 * 4, O_SI = O_SV + 64 * 16 * 4;
    const float NEG = -3.0e38f;
    for (int tile = blockIdx.x; tile < 256; tile += gridDim.x) {
        const int tok0 = tile * 32;
        for (int h = 0; h < 8; ++h) {
            {
                f32x4 acc[2][2];
#pragma unroll
                for (int p = 0; p < 2; ++p)
#pragma unroll
                    for (int nt = 0; nt < 2; ++nt) acc[p][nt] = (f32x4){0.f, 0.f, 0.f, 0.f};
#pragma unroll
                for (int ks = 0; ks < 4; ++ks) {
#pragma unroll
                    for (int p = 0; p < 2; ++p) {
                        const bf16x8 a = *(const bf16x8*)(sk + (size_t)(p * 128 + 16 * wave + fr) * 128 + ks * 32 + fq * 8);
#pragma unroll
                        for (int nt = 0; nt < 2; ++nt) {
                            const bf16x8 bq = *(const bf16x8*)(qb + (size_t)(tok0 + 16 * nt + fr) * D + h * 256 + p * 128 + ks * 32 + fq * 8);
                            acc[p][nt] = mfma16(a, bq, acc[p][nt]);
                        }
                    }
                }
#pragma unroll
                for (int p = 0; p < 2; ++p)
#pragma unroll
                    for (int nt = 0; nt < 2; ++nt) *(LAS f32x4*)(lds + O_SC + (((16 * nt + fr) * 2 + p) * 132 + 16 * wave + 4 * fq) * 4) = acc[p][nt];
            }
            BLOCK_SYNC();
            {
                const int row = tid >> 3, sub = tid & 7;
                float v[16];
#pragma unroll
                for (int c4 = 0; c4 < 4; ++c4) { const f32x4 x = *(const LAS f32x4*)(lds + O_SC + (row * 132 + sub * 16 + c4 * 4) * 4); v[4 * c4] = x.x; v[4 * c4 + 1] = x.y; v[4 * c4 + 2] = x.z; v[4 * c4 + 3] = x.w; }
                float rv0 = 0.f, rv1 = 0.f; int ri0 = 0, ri1 = 0;
                for (int round = 0; round < 16; ++round) {
                    float bv = v[0]; int bi = 0;
#pragma unroll
                    for (int i = 1; i < 16; ++i) { const bool gt = v[i] > bv; bv = gt ? v[i] : bv; bi = gt ? i : bi; }
                    int gi = sub * 16 + bi;
#pragma unroll
                    for (int o = 1; o < 8; o <<= 1) { const float ov = __shfl_xor(bv, o); const int oi = __shfl_xor(gi, o); const bool tk = (ov > bv) || (ov == bv && oi < gi); bv = tk ? ov : bv; gi = tk ? oi : gi; }
                    if ((round & 7) == sub) { if (round < 8) { rv0 = bv; ri0 = gi; } else { rv1 = bv; ri1 = gi; } }
                    const int li = ((gi >> 4) == sub) ? (gi & 15) : -1;
#pragma unroll
                    for (int i = 0; i < 16; ++i) v[i] = (i == li) ? NEG : v[i];
                }
                *(LAS float*)(lds + O_SV + (row * 16 + sub) * 4) = rv0; *(LAS float*)(lds + O_SV + (row * 16 + sub + 8) * 4) = rv1;
                *(LAS int*)(lds + O_SI + (row * 16 + sub) * 4) = ri0; *(LAS int*)(lds + O_SI + (row * 16 + sub + 8) * 4) = ri1;
            }
            BLOCK_SYNC();
            {
                const int tok = tid >> 4, a = tid & 15;
                const float s0 = *(const LAS float*)(lds + O_SV + ((tok * 2 + 0) * 16 + a) * 4); const int i0 = *(const LAS int*)(lds + O_SI + ((tok * 2 + 0) * 16 + a) * 4);
                float cnd[16]; int i1[16];
#pragma unroll
                for (int c4 = 0; c4 < 4; ++c4) {
                    const f32x4 x = *(const LAS f32x4*)(lds + O_SV + ((tok * 2 + 1) * 16 + c4 * 4) * 4);
                    cnd[4 * c4] = s0 + x.x; cnd[4 * c4 + 1] = s0 + x.y; cnd[4 * c4 + 2] = s0 + x.z; cnd[4 * c4 + 3] = s0 + x.w;
#pragma unroll
                    for (int i = 0; i < 4; ++i) i1[4 * c4 + i] = *(const LAS int*)(lds + O_SI + ((tok * 2 + 1) * 16 + c4 * 4 + i) * 4);
                }
                float myv = 0.f; int mye = 0;
                for (int round = 0; round < 16; ++round) {
                    float bv = cnd[0]; int bi = 0, be = i1[0];
#pragma unroll
                    for (int i = 1; i < 16; ++i) { const bool gt = cnd[i] > bv; bv = gt ? cnd[i] : bv; bi = gt ? i : bi; be = gt ? i1[i] : be; }
                    int gi = a * 16 + bi, ge = i0 * 128 + be;
#pragma unroll
                    for (int o = 1; o < 16; o <<= 1) { const float ov = __shfl_xor(bv, o); const int oi = __shfl_xor(gi, o), oe = __shfl_xor(ge, o); const bool tk = (ov > bv) || (ov == bv && oi < gi); bv = tk ? ov : bv; gi = tk ? oi : gi; ge = tk ? oe : ge; }
                    if (round == a) { myv = bv; mye = ge; }
                    const int li = ((gi >> 4) == a) ? (gi & 15) : -1;
#pragma unroll
                    for (int i = 0; i < 16; ++i) cnd[i] = (i == li) ? NEG : cnd[i];
                }
                float mx = myv;
#pragma unroll
                for (int o = 1; o < 16; o <<= 1) mx = fmaxf(mx, __shfl_xor(mx, o));
                const float ex = __expf(myv - mx); float sm = ex;
#pragma unroll
                for (int o = 1; o < 16; o <<= 1) sm += __shfl_xor(sm, o);
                eout[(size_t)(tok0 + tok) * 128 + h * 16 + a] = mye;
                gout[(size_t)(tok0 + tok) * 128 + h * 16 + a] = ex / sm;
            }
            BLOCK_SYNC();
        }
    }
}
__device__ __forceinline__ float gelu_exact(float x) { return 0.5f * x * (1.0f + erff(x * 0.70710678118654752f)); }
__device__ __forceinline__ float dot8(const u32x4 w, const float* x) {
    return (bflo(w.x) * x[0] + bfhi(w.x) * x[1]) + (bflo(w.y) * x[2] + bfhi(w.y) * x[3]) + (bflo(w.z) * x[4] + bfhi(w.z) * x[5]) + (bflo(w.w) * x[6] + bfhi(w.w) * x[7]);
}
__device__ __forceinline__ void axpy8(const u32x4 w, float a, float* o) {
    o[0] += a * bflo(w.x); o[1] += a * bfhi(w.x); o[2] += a * bflo(w.y); o[3] += a * bfhi(w.y); o[4] += a * bflo(w.z); o[5] += a * bfhi(w.z); o[6] += a * bflo(w.w); o[7] += a * bfhi(w.w);
}
__device__ __forceinline__ void phase8(const Params& P) {
    const int lane = threadIdx.x & 63, wave = threadIdx.x >> 6;
    const int gw = blockIdx.x * 8 + wave, NGW = gridDim.x * 8;
    unsigned char* ws = P.ws;
    const bf16_t* Ub = (const bf16_t*)(ws + WS_UB); const bf16_t* Vb = (const bf16_t*)(ws + WS_VB);
    const int* eidx = (const int*)(ws + WS_EXP); const float* gts = (const float*)(ws + WS_GATE);
    for (int tok = gw; tok < NTOK; tok += NGW) {
        float x[32], o[32];
        {
            const bf16_t* hr = (const bf16_t*)(ws + WS_H1B) + (size_t)tok * D + lane * 8;
#pragma unroll
            for (int i = 0; i < 4; ++i) unpack8(*(const u32x4*)(hr + 512 * i), x + 8 * i);
#pragma unroll
            for (int i = 0; i < 32; ++i) o[i] = 0.f;
        }
        const int e_lo = eidx[(size_t)tok * 128 + lane], e_hi = eidx[(size_t)tok * 128 + 64 + lane];
        const float g_lo = gts[(size_t)tok * 128 + lane], g_hi = gts[(size_t)tok * 128 + 64 + lane];
        u32x4 ua[4], va[4], ub[4], vb[4];
        auto issue = [&](int k, u32x4 (&uu)[4], u32x4 (&vv)[4]) {
            const int e = __shfl(k < 64 ? e_lo : e_hi, k & 63);
            const bf16_t* up = Ub + (size_t)e * D + lane * 8; const bf16_t* vp = Vb + (size_t)e * D + lane * 8;
#pragma unroll
            for (int i = 0; i < 4; ++i) { uu[i] = *(const u32x4*)(up + 512 * i); vv[i] = *(const u32x4*)(vp + 512 * i); }
        };
        auto consume = [&](int k, const u32x4 (&uu)[4], const u32x4 (&vv)[4]) {
            float d = 0.f;
#pragma unroll
            for (int i = 0; i < 4; ++i) d += dot8(uu[i], x + 8 * i);
            d = wave_sum(d);
            const float a = gelu_exact(d) * __shfl(k < 64 ? g_lo : g_hi, k & 63);
#pragma unroll
            for (int i = 0; i < 4; ++i) axpy8(vv[i], a, o + 8 * i);
        };
        issue(0, ua, va);
        for (int k = 0; k < 128; k += 2) {
            issue(k + 1, ub, vb);
            consume(k, ua, va);
            if (k + 2 < 128) issue(k + 2, ua, va);
            consume(k + 1, ub, vb);
        }
        float s = 0.f;
#pragma unroll
        for (int i = 0; i < 32; ++i) { o[i] += DN_ALPHA * x[i]; s += o[i]; }
        const float mean = wave_sum(s) * (1.0f / D); float q = 0.f;
#pragma unroll
        for (int i = 0; i < 32; ++i) { o[i] -= mean; q += o[i] * o[i]; }
        const float rstd = 1.0f / sqrtf(wave_sum(q) * (1.0f / D) + LN_EPS);
        float* orow = P.out + (size_t)tok * D + lane * 8;
#pragma unroll
        for (int i = 0; i < 4; ++i) {
            const float* gp = P.in[I_LN2G] + 512 * i + lane * 8; const float* bp = P.in[I_LN2B] + 512 * i + lane * 8;
            const f32x4 g0 = *(const f32x4*)gp, g1 = *(const f32x4*)(gp + 4), b0 = *(const f32x4*)bp, b1 = *(const f32x4*)(bp + 4);
            f32x4 r0, r1;
            r0.x = o[8 * i + 0] * rstd * g0.x + b0.x; r0.y = o[8 * i + 1] * rstd * g0.y + b0.y; r0.z = o[8 * i + 2] * rstd * g0.z + b0.z; r0.w = o[8 * i + 3] * rstd * g0.w + b0.w;
            r1.x = o[8 * i + 4] * rstd * g1.x + b1.x; r1.y = o[8 * i + 5] * rstd * g1.y + b1.y; r1.z = o[8 * i + 6] * rstd * g1.z + b1.z; r1.w = o[8 * i + 7] * rstd * g1.w + b1.w;
            *(f32x4*)(orow + 512 * i) = r0; *(f32x4*)(orow + 512 * i + 4) = r1;
        }
    }
}
#ifndef MK_MULTI
#define MK_MULTI 0
#endif
__global__ __launch_bounds__(512, 2) void hybrid_fwd(Params P) {
    extern __shared__ __attribute__((aligned(16))) unsigned char shm[];
    ldsp lds = (ldsp)shm;
    cg::grid_group grid = cg::this_grid();
    unsigned char* ws = P.ws;
    const int lo = P.ph_lo, hi = P.ph_hi;
#define PHASE(k) if (lo <= (k) && (k) < hi)
#define SEAM(k) do { if (lo <= (k) && (k) + 1 < hi) { __threadfence_system(); asm volatile("s_waitcnt vmcnt(0) lgkmcnt(0)" ::: "memory"); __syncthreads(); grid.sync(); __threadfence_system(); } } while (0)
    PHASE(0) phase0(P);
    SEAM(0);
    PHASE(1) { pg8::EpiBf16<0> E; E.O = (bf16_t*)(ws + WS_P); E.ldc = NPAD; E.bias = nullptr; E.split_cols = 0; E.split_stride = 0;
        run_gemm(lds, (const bf16_t*)(ws + WS_H0B), (const bf16_t*)(ws + WS_WTIN), MROWS, NPAD, 2048, E); }
    SEAM(1);
    PHASE(2) phase2(P, lds);
    SEAM(2);
    PHASE(3) phase3(P);
    SEAM(3);
    PHASE(4) phase3b(P, lds);
    SEAM(4);
    PHASE(5) {
        { pg8::EpiGateA E; E.C = (float*)(ws + WS_MPART); E.p = (const bf16_t*)(ws + WS_P); E.bgate = P.in[I_BGATE];
          run_gemm(lds, (const bf16_t*)(ws + WS_YA), (const bf16_t*)(ws + WS_WTA), NTOK, 2048, 2048, E); }
        { pg8::EpiGateB E; E.C = (const float*)(ws + WS_MPART); E.O = (bf16_t*)(ws + WS_MERGED); E.p = (const bf16_t*)(ws + WS_P); E.bgate = P.in[I_BGATE];
          run_gemm(lds, (const bf16_t*)(ws + WS_YB), (const bf16_t*)(ws + WS_WTB), NTOK, 2048, 1024, E); }
    }
    SEAM(5);
    PHASE(6) { pg8::EpiResid E; E.C = (float*)(ws + WS_X1); E.h0 = (const bf16_t*)(ws + WS_H0B); E.alpha = DN_ALPHA;
        run_gemm(lds, (const bf16_t*)(ws + WS_MERGED), (const bf16_t*)(ws + WS_WTOUT), NTOK, 2048, 2048, E); }
    SEAM(6);
    PHASE(7) phase5b(P);
    SEAM(7);
    PHASE(8) { pg8::EpiBf16<0> E; E.O = (bf16_t*)(ws + WS_Q); E.ldc = D; E.bias = nullptr; E.split_cols = 0; E.split_stride = 0;
        run_gemm(lds, (const bf16_t*)(ws + WS_H1B), (const bf16_t*)(ws + WS_WTQ), NTOK, 2048, 2048, E); }
    SEAM(8);
    PHASE(9) phase7(P, lds);
    SEAM(9);
    PHASE(10) phase8(P);
#ifdef DBG_STOP
    {
        __threadfence_system(); asm volatile("s_waitcnt vmcnt(0) lgkmcnt(0)" ::: "memory"); __syncthreads(); grid.sync(); __threadfence_system();
        const size_t a = DBG_A, b = DBG_B; const unsigned* w = (const unsigned*)(ws + a); const size_t nw = (b - a) / 4, NO = (size_t)NTOK * D;
        for (size_t i = (size_t)blockIdx.x * 512 + threadIdx.x; i < NO; i += (size_t)gridDim.x * 512) {
            unsigned acc = 0; for (size_t j = i; j < nw; j += NO) { const unsigned x = w[j]; acc += (x & 0xffffu) + (x >> 16); }
            P.out[i] = (float)(acc & 0xfffffu);
        }
    }
#endif
#undef PHASE
#undef SEAM
}

extern "C" void kernel_launch(void* const* d_in, const int* in_sizes, int n_in, void* d_out, int out_size, void* d_ws, size_t ws_size, hipStream_t stream) {
    static int grid = 0;
    if (grid == 0) {
        if (n_in != 30 || out_size != NTOK * D || ws_size < WS_END) { fprintf(stderr, "kernel_launch: unexpected shapes (n_in %d, out %d, ws %zu < %zu)\n", n_in, out_size, ws_size, (size_t)WS_END); grid = -1; return; }
        int dev = 0, cus = 0, per_cu = 0;
        if (hipGetDevice(&dev) != hipSuccess || hipDeviceGetAttribute(&cus, hipDeviceAttributeMultiprocessorCount, dev) != hipSuccess) { grid = -1; return; }
        if (hipFuncSetAttribute((const void*)hybrid_fwd, hipFuncAttributeMaxDynamicSharedMemorySize, LDS_BYTES) != hipSuccess) { fprintf(stderr, "kernel_launch: hipFuncSetAttribute failed\n"); grid = -1; return; }
        if (hipOccupancyMaxActiveBlocksPerMultiprocessor(&per_cu, (const void*)hybrid_fwd, 512, LDS_BYTES) != hipSuccess || per_cu < 1) { fprintf(stderr, "kernel_launch: occupancy query says %d\n", per_cu); grid = -1; return; }
        (void)hipGetLastError();
        grid = cus;
    }
    if (grid < 0) return;
    Params p{};
    for (int i = 0; i < 30; ++i) p.in[i] = (const float*)d_in[i];
    p.out = (float*)d_out; p.ws = (unsigned char*)d_ws;
#if MK_MULTI
    for (int ph = 0; ph <= NPHASE; ++ph) { p.ph_lo = ph; p.ph_hi = ph + 1; hipLaunchKernelGGL(hybrid_fwd, dim3(grid), dim3(512), LDS_BYTES, stream, p); }
#else
    p.ph_lo = 0; p.ph_hi = NPHASE + 1;
#ifdef DBG_STOP
    p.ph_hi = DBG_STOP + 1;
#endif
    void* args[] = {&p};
    hipError_t e = hipLaunchCooperativeKernel((const void*)hybrid_fwd, dim3(grid), dim3(512), args, LDS_BYTES, stream);
    if (e != hipSuccess) fprintf(stderr, "kernel_launch: cooperative launch failed: %s (grid %d)\n", hipGetErrorString(e), grid);
#endif
}
```

```cpp
#include <hip/hip_runtime.h>
#include <hip/hip_cooperative_groups.h>
#include <cstdio>
#include <cstdint>
namespace cg = cooperative_groups;
namespace pg8 {
#define PG8_LAS __attribute__((address_space(3)))
typedef unsigned short bf16_t;
typedef short bf16x8 __attribute__((ext_vector_type(8)));
typedef float f32x4 __attribute__((ext_vector_type(4)));
typedef unsigned u32x4 __attribute__((ext_vector_type(4)));
constexpr int BM = 256, BK = 64, HALF = 128, HTB = HALF * BK * 2  , STAGE_BYTES = 8 * HTB, NXCD = 8, WGM = 8;

__host__ __device__ __forceinline__ int lds_byte(int r, int c) { const int st = (r >> 4) * 2 + (c >> 5), rr = r & 15, cc = c & 31, ob = rr * 64 + cc * 2; return st * 1024 + (ob ^ (((ob >> 9) & 1) << 5)); }
__host__ __device__ __forceinline__ void stage_rc(int b, int& R, int& C) { const int st = b / 1024, sb = b % 1024, swz = sb ^ (((sb >> 9) & 1) << 5); R = (st >> 1) * 16 + swz / 64; C = (st & 1) * 32 + (swz % 64) / 2; }
__host__ __device__ __forceinline__ int perm32(int rho) { const int n = rho >> 4, i = rho & 15; return 8 * (i >> 2) + 4 * n + (i & 3); }

struct Unit { int pm, pn; };
struct Gemm { const bf16_t* A; const bf16_t* Bt; int M, N, K; };

struct StaticOrder {
    int nM, nN, nwg, G, c;
    __host__ __device__ void init(int M, int N, int G_, int c_) { nM = M / BM; nN = N / BM; nwg = nM * nN; G = G_; c = c_; }
    __host__ __device__ bool next(int i, Unit& u) const {
        const long L = (long)i * G + c; if (L >= nwg) return false;
        int wgid = (int)L; { const int q = nwg / NXCD, r = nwg % NXCD, xcd = wgid % NXCD, off = wgid / NXCD; wgid = (xcd < r ? xcd * (q + 1) : r * (q + 1) + (xcd - r) * q) + off; }
        const int nig = WGM * nN, gid = wgid / nig, fm = gid * WGM, gsz = (nM - fm) < WGM ? (nM - fm) : WGM;
        u.pm = fm + ((wgid % nig) % gsz); u.pn = (wgid % nig) / gsz; return true;
    }
    __device__ __forceinline__ void a_ready(const Unit&) const {}
    __device__ __forceinline__ void done(const Unit&) const {}
};
struct CountedOrder : StaticOrder {
    const unsigned* ready; unsigned need; unsigned* tmo;
    __device__ __forceinline__ void a_ready(const Unit& u) const {
        if (threadIdx.x < 64) {
            const unsigned long long t0 = __builtin_amdgcn_s_memrealtime(); unsigned polls = 0;
            while ((unsigned)__builtin_amdgcn_readfirstlane(__hip_atomic_load(ready + 64 * u.pm, __ATOMIC_RELAXED, __HIP_MEMORY_SCOPE_AGENT)) < need) {
                if ((++polls & 255u) == 0u && __builtin_amdgcn_readfirstlane(__hip_atomic_load(tmo, __ATOMIC_RELAXED, __HIP_MEMORY_SCOPE_AGENT)) != 0u) break;
                if (__builtin_amdgcn_s_memrealtime() - t0 > 2000000ull) {
                    if (threadIdx.x == 0) { unsigned expect = 0u; __hip_atomic_compare_exchange_strong(tmo + 1, &expect, 0x600u | (unsigned)(u.pm & 0xff), __ATOMIC_RELAXED, __ATOMIC_RELAXED, __HIP_MEMORY_SCOPE_AGENT); __hip_atomic_store(tmo, 1u, __ATOMIC_RELAXED, __HIP_MEMORY_SCOPE_AGENT); }
                    break; }
                __builtin_amdgcn_s_sleep(2); }
            __builtin_amdgcn_fence(__ATOMIC_ACQUIRE, "agent");
            asm volatile("s_waitcnt vmcnt(0)" ::: "memory");
        }
#if !defined(BROKEN_HOOK_NO_BARRIER)
        asm volatile("" ::: "memory"); __builtin_amdgcn_s_barrier(); asm volatile("" ::: "memory");
#endif
    }
};

typedef float cvt_f32x2 __attribute__((ext_vector_type(2))); typedef __bf16 cvt_bf16x2 __attribute__((ext_vector_type(2)));
__device__ __forceinline__ unsigned cvt_pk_bf16(float lo, float hi) { const cvt_f32x2 v = {lo, hi}; const cvt_bf16x2 b = __builtin_convertvector(v, cvt_bf16x2); return __builtin_bit_cast(unsigned, b); }
typedef float f32x2 __attribute__((ext_vector_type(2)));
__device__ __forceinline__ f32x2 gelu_pk(f32x2 v) {
    const f32x2 av = __builtin_elementwise_abs(v), d = av * 0.2316418882f + 1.0f;
    f32x2 t; t.x = __builtin_amdgcn_rcpf(d.x); t.y = __builtin_amdgcn_rcpf(d.y);
    f32x2 q = t * 0.5307027145f + (-0.7265760135f); q = q * t + 0.7107068705f; q = q * t + (-0.142248368f); q = q * t + 0.127414796f; q = q * t;
    const f32x2 s = (v * v) * (-0.72134752044f);
    f32x2 e; e.x = __builtin_amdgcn_exp2f(s.x); e.y = __builtin_amdgcn_exp2f(s.y);
    const f32x2 m = v * (q * e), r = v - m;
    f32x2 o; o.x = v.x < 0.f ? m.x : r.x; o.y = v.y < 0.f ? m.y : r.y; return o;
}

struct EpiF32 {
    static constexpr bool PERM = false, AFTER_DRAIN = false;
    float* C; int ldc; const float* bias;
    __device__ __forceinline__ void operator()(const f32x4 (&acc)[2][2][4][2], const Unit& u, int wr, int wc, int fr, int fq) const {
        const int row0 = u.pm * BM + wr * 64 + fr, col0 = u.pn * BM + wc * 32 + 4 * fq;
        f32x4 bv[2][2];
#pragma unroll
        for (int bj = 0; bj < 2; ++bj)
#pragma unroll
            for (int n = 0; n < 2; ++n) bv[bj][n] = bias ? *(const f32x4*)(bias + col0 + bj * HALF + n * 16) : (f32x4){0.f, 0.f, 0.f, 0.f};
#pragma unroll
        for (int ai = 0; ai < 2; ++ai)
#pragma unroll
            for (int m = 0; m < 4; ++m) { float* rowp = C + (size_t)(row0 + ai * HALF + m * 16) * ldc + col0;
#pragma unroll
                for (int bj = 0; bj < 2; ++bj)
#pragma unroll
                    for (int n = 0; n < 2; ++n) *(f32x4*)(rowp + bj * HALF + n * 16) = acc[ai][bj][m][n] + bv[bj][n]; }
    }
};
template <int ACT  > struct EpiBf16 {
    static constexpr bool PERM = true, AFTER_DRAIN = false;
    bf16_t* O; int ldc; const float* bias; int split_cols; size_t split_stride;
    __device__ __forceinline__ void operator()(const f32x4 (&acc)[2][2][4][2], const Unit& u, int wr, int wc, int fr, int fq) const {
        const int row0 = u.pm * BM + wr * 64 + fr; int colt = u.pn * BM; bf16_t* base = O;
        if (split_cols) { const int t = colt / split_cols; base += (size_t)t * split_stride; colt -= t * split_cols; }
        const int col0 = colt + wc * 32 + 8 * fq, bcol0 = u.pn * BM + wc * 32 + 8 * fq;
        f32x4 bv[2][2];
#pragma unroll
        for (int bj = 0; bj < 2; ++bj)
#pragma unroll
            for (int n = 0; n < 2; ++n) bv[bj][n] = bias ? *(const f32x4*)(bias + bcol0 + bj * HALF + 4 * n) : (f32x4){0.f, 0.f, 0.f, 0.f};
#pragma unroll
        for (int ai = 0; ai < 2; ++ai)
#pragma unroll
            for (int m = 0; m < 4; ++m) { bf16_t* rowp = base + (size_t)(row0 + ai * HALF + m * 16) * ldc + col0;
#pragma unroll
                for (int bj = 0; bj < 2; ++bj) { f32x4 v0 = acc[ai][bj][m][0] + bv[bj][0], v1 = acc[ai][bj][m][1] + bv[bj][1];
                    if (ACT == 1) { f32x2 a = gelu_pk((f32x2){v0[0], v0[1]}), b = gelu_pk((f32x2){v0[2], v0[3]}), c = gelu_pk((f32x2){v1[0], v1[1]}), d = gelu_pk((f32x2){v1[2], v1[3]});
                        v0 = (f32x4){a.x, a.y, b.x, b.y}; v1 = (f32x4){c.x, c.y, d.x, d.y}; }
                    if (ACT == 2) {
#pragma unroll
                        for (int j = 0; j < 4; ++j) { v0[j] = 0.5f * v0[j] * (1.0f + erff(v0[j] * 0.70710678f)); v1[j] = 0.5f * v1[j] * (1.0f + erff(v1[j] * 0.70710678f)); } }
                    u32x4 w; w.x = cvt_pk_bf16(v0[0], v0[1]); w.y = cvt_pk_bf16(v0[2], v0[3]); w.z = cvt_pk_bf16(v1[0], v1[1]); w.w = cvt_pk_bf16(v1[2], v1[3]);
                    *(u32x4*)(rowp + bj * HALF) = w; } }
    }
};
template <class Epi, class Sched, bool STAMP = false>
__device__ __forceinline__ void gemm_phase(PG8_LAS unsigned char* lds, const Gemm g, const Sched& S, const Epi& E, unsigned long long* stamps) {
    const int tid = threadIdx.x, wid = __builtin_amdgcn_readfirstlane(tid >> 6), lane = tid & 63, wr = wid >> 2, wc = wid & 3, fr = lane & 15, fq = lane >> 4;
    const int K = g.K, nt = K / BK;
    int ts_lo = 0, ts_hi = 0, nts = 0; const unsigned long long rt_entry = STAMP ? (unsigned long long)wall_clock64() : 0ull;
#define PG8_STAMP() do { if (STAMP && wid == 0 && nts < 64) { const unsigned long long _c = (unsigned long long)clock64(); \
        ts_lo = (lane == nts) ? (int)(unsigned)_c : ts_lo; ts_hi = (lane == nts) ? (int)(unsigned)(_c >> 32) : ts_hi; ++nts; } } while (0)
    PG8_STAMP();
    unsigned voffA[2], voffB[2];
#pragma unroll
    for (int i = 0; i < 2; ++i) { int R, C; stage_rc(tid * 16 + i * 8192, R, C); const int Rb = Epi::PERM ? ((R & ~31) + perm32(R & 31)) : R;
        voffA[i] = (unsigned)(R * K + C) * 2u; voffB[i] = (unsigned)(Rb * K + C) * 2u; }
    const size_t kstep = (size_t)(BK * 2);
    const size_t hstep = (size_t)HALF * K * 2;
    const size_t tstep = 2 * hstep;
    const unsigned ldsw = (unsigned)wid * 1024u;
    const int aoff = lds_byte(wr * 64 + fr, fq * 8), boff = lds_byte(wc * 32 + fr, fq * 8);
#define PG8_SA(b, h) (((b) * 2 + (h)) * HTB)
#define PG8_SB(b, h) ((4 + (b) * 2 + (h)) * HTB)
#define PG8_STAGE(bufoff, gbase, voff) do { _Pragma("unroll") for (int _i = 0; _i < 2; ++_i) \
        __builtin_amdgcn_global_load_lds((const unsigned*)((const char*)(gbase) + (voff)[_i]), (PG8_LAS unsigned*)(lds + (bufoff) + ldsw + _i * 8192), 16, 0, 0); } while (0)
#define PG8_LDA(dst, b, h) do { _Pragma("unroll") for (int m = 0; m < 4; ++m) _Pragma("unroll") for (int k = 0; k < 2; ++k) dst[m][k] = *(const PG8_LAS bf16x8*)(lds + PG8_SA(b, h) + aoff + m * 2048 + k * 1024); } while (0)
#define PG8_LDB(dst, b, h) do { _Pragma("unroll") for (int n = 0; n < 2; ++n) _Pragma("unroll") for (int k = 0; k < 2; ++k) dst[n][k] = *(const PG8_LAS bf16x8*)(lds + PG8_SB(b, h) + boff + n * 2048 + k * 1024); } while (0)
#define PG8_MMA(ai, bj, At, Bt) do { __builtin_amdgcn_s_setprio(1); _Pragma("unroll") for (int m = 0; m < 4; ++m) _Pragma("unroll") for (int n = 0; n < 2; ++n) _Pragma("unroll") for (int k = 0; k < 2; ++k) \
        acc[ai][bj][m][n] = __builtin_amdgcn_mfma_f32_16x16x32_bf16(Bt[n][k], At[m][k], acc[ai][bj][m][n], 0, 0, 0); __builtin_amdgcn_s_setprio(0); } while (0)
#define PG8_WAIT_V(n) asm volatile("s_waitcnt vmcnt(" #n ")" ::: "memory")
#define PG8_WAIT_L(n) asm volatile("s_waitcnt lgkmcnt(" #n ")" ::: "memory")
#define PG8_BAR __builtin_amdgcn_s_barrier()
#define PG8_SCHED __builtin_amdgcn_sched_barrier(0)
    Unit cur, nxt; int ui = 0;
    if (!S.next(0, cur)) return;
    f32x4 acc[2][2][4][2];
#pragma unroll
    for (int a = 0; a < 2; ++a)
#pragma unroll
        for (int b = 0; b < 2; ++b)
#pragma unroll
            for (int m = 0; m < 4; ++m)
#pragma unroll
                for (int n = 0; n < 2; ++n) acc[a][b][m][n] = (f32x4){0.f, 0.f, 0.f, 0.f};
    bf16x8 At[4][2], B0[2][2], B1[2][2];
    const char* cA = (const char*)g.A + (size_t)cur.pm * tstep; const char* cB = (const char*)g.Bt + (size_t)cur.pn * tstep;
    S.a_ready(cur);
    PG8_STAGE(PG8_SB(0, 0), cB, voffB); PG8_STAGE(PG8_SA(0, 0), cA, voffA); PG8_STAGE(PG8_SB(0, 1), cB + hstep, voffB); PG8_STAGE(PG8_SA(0, 1), cA + hstep, voffA);
    if (wr == 1) PG8_BAR;
    PG8_WAIT_V(4); PG8_BAR;
    PG8_STAGE(PG8_SB(1, 0), cB + kstep, voffB); PG8_STAGE(PG8_SA(1, 0), cA + kstep, voffA); PG8_STAGE(PG8_SB(1, 1), cB + hstep + kstep, voffB);
    PG8_WAIT_V(6); PG8_BAR;
    PG8_STAMP();
    for (;;) {
        const bool has_next = S.next(ui + 1, nxt);
        const char* nA = has_next ? (const char*)g.A + (size_t)nxt.pm * tstep : cA; const char* nB = has_next ? (const char*)g.Bt + (size_t)nxt.pn * tstep : cB;
        for (int t = 0; t < nt; t += 2) {
            const bool last = (t == nt - 2);
            const char* a1 = cA + (size_t)(t + 1) * kstep;
            const char* a2 = last ? nA : cA + (size_t)(t + 2) * kstep; const char* b2 = last ? nB : cB + (size_t)(t + 2) * kstep;
            const char* a3 = a2 + kstep; const char* b3 = b2 + kstep;
            if (last && has_next) S.a_ready(nxt);
            PG8_LDB(B0, 0, 0); PG8_SCHED; PG8_LDA(At, 0, 0); PG8_STAGE(PG8_SA(1, 1), a1 + hstep, voffA);
            PG8_WAIT_L(8); PG8_BAR; PG8_WAIT_L(0); PG8_MMA(0, 0, At, B0); PG8_BAR; PG8_SCHED;
            PG8_LDB(B1, 0, 1); PG8_STAGE(PG8_SB(0, 0), b2, voffB);
            PG8_BAR; PG8_WAIT_L(0); PG8_MMA(0, 1, At, B1); PG8_BAR;
            PG8_LDA(At, 0, 1); PG8_STAGE(PG8_SA(0, 0), a2, voffA);
            PG8_BAR; PG8_WAIT_L(0); PG8_MMA(1, 0, At, B0); PG8_BAR; PG8_SCHED;
            PG8_STAGE(PG8_SB(0, 1), b2 + hstep, voffB);
            PG8_WAIT_V(6); PG8_BAR; PG8_MMA(1, 1, At, B1); PG8_BAR;
            PG8_LDB(B0, 1, 0); PG8_SCHED; PG8_LDA(At, 1, 0); PG8_STAGE(PG8_SA(0, 1), a2 + hstep, voffA);
            PG8_WAIT_L(8); PG8_BAR; PG8_WAIT_L(0); PG8_MMA(0, 0, At, B0); PG8_BAR; PG8_SCHED;
            PG8_LDB(B1, 1, 1); PG8_STAGE(PG8_SB(1, 0), b3, voffB);
            PG8_BAR; PG8_WAIT_L(0); PG8_MMA(0, 1, At, B1); PG8_BAR;
            PG8_LDA(At, 1, 1); PG8_STAGE(PG8_SA(1, 0), a3, voffA);
            PG8_BAR; PG8_WAIT_L(0); PG8_MMA(1, 0, At, B0); PG8_BAR; PG8_SCHED;
            PG8_STAGE(PG8_SB(1, 1), b3 + hstep, voffB);
            PG8_WAIT_V(6); PG8_BAR; PG8_MMA(1, 1, At, B1); PG8_BAR;
        }
        PG8_STAMP();
        if constexpr (!Epi::AFTER_DRAIN) { E(acc, cur, wr, wc, fr, fq); S.done(cur); }
        PG8_STAMP();
        if (!has_next) break;
#pragma unroll
        for (int a = 0; a < 2; ++a)
#pragma unroll
            for (int b = 0; b < 2; ++b)
#pragma unroll
                for (int m = 0; m < 4; ++m)
#pragma unroll
                    for (int n = 0; n < 2; ++n) acc[a][b][m][n] = (f32x4){0.f, 0.f, 0.f, 0.f};
        cur = nxt; cA = nA; cB = nB; ++ui;
    }
    PG8_WAIT_V(0);
    if (wr == 0) PG8_BAR;
    PG8_BAR;
    if constexpr (Epi::AFTER_DRAIN) { E.fused(acc, cur, wr, wc, fr, fq, lds, wid, lane); S.done(cur); }
    PG8_STAMP();
    if (STAMP && wid == 0) { stamps[lane] = lane < nts ? (((unsigned long long)(unsigned)ts_hi << 32) | (unsigned)ts_lo) : 0ull;
        if (lane == 62) stamps[62] = rt_entry; if (lane == 63) stamps[63] = (unsigned long long)wall_clock64(); }
#undef PG8_STAMP
#undef PG8_SA
#undef PG8_SB
#undef PG8_STAGE
#undef PG8_LDA
#undef PG8_LDB
#undef PG8_MMA
#undef PG8_WAIT_V
#undef PG8_WAIT_L
#undef PG8_BAR
#undef PG8_SCHED
}
}
#define LAS __attribute__((address_space(3)))
typedef unsigned short bf16_t;
typedef short bf16x8 __attribute__((ext_vector_type(8)));
typedef float f32x4 __attribute__((ext_vector_type(4)));
typedef float f32x2 __attribute__((ext_vector_type(2)));
typedef unsigned u32x4 __attribute__((ext_vector_type(4)));
typedef unsigned u32x2 __attribute__((ext_vector_type(2)));
typedef LAS unsigned char* ldsp;

constexpr int D = 2048, NTOK = 8192, SEQ = 4096, MROWS = 8448, ROW_META = 8192;
constexpr int INC = 11712, NPAD = 11776;
constexpr int C_R = 0, C_K = 2048, C_V = 4096, C_WL = 6144, C_AL = 6240, C_GL = 6336, C_POOL = 6592, C_G0 = 7616, C_G1 = 9664;
constexpr int NUNITS = 4128;
constexpr float DSCALE = 0.6065306597126334f;
constexpr float DN_ALPHA = 1.189207115002721f;
constexpr float GN_EPS = 64e-5f, LN_EPS = 1e-5f;

constexpr size_t WS_P = 0;
constexpr size_t WS_UB = 0;
constexpr size_t WS_VB = 67108864;
constexpr size_t WS_H0B = 198967296;
constexpr size_t WS_WTA = WS_H0B + 34603008;
constexpr size_t WS_WTB = WS_WTA + 8388608;
constexpr size_t WS_WTOUT = WS_WTB + 4194304;
constexpr size_t WS_WTQ = WS_WTOUT + 8388608;
constexpr size_t WS_WTPOOL = WS_WTQ + 8388608;
constexpr size_t WS_WTW2 = WS_WTPOOL + 524288;
constexpr size_t WS_WTA2 = WS_WTW2 + 393216;
constexpr size_t WS_WTG2 = WS_WTA2 + 393216;
constexpr size_t WS_SUBK = WS_WTG2 + 1048576;
constexpr size_t WS_BONUS = WS_SUBK + 65536;
constexpr size_t WS_REGC = WS_BONUS + 1048576;
constexpr size_t WS_WTIN = WS_REGC;
constexpr size_t UNITB = (size_t)NUNITS * 4096 * 2;
constexpr size_t WS_G = WS_REGC;
constexpr size_t WS_H0T = WS_REGC + UNITB;
constexpr size_t WS_RT = WS_REGC + 2 * UNITB;
constexpr size_t WS_Y0 = WS_REGC + 3 * UNITB;
constexpr size_t WS_S0T = WS_REGC + 4 * UNITB;
constexpr size_t WS_MERGED = WS_REGC;
constexpr size_t WS_MPART = WS_REGC + 33554432;
constexpr size_t WS_X1 = WS_REGC + 33554432;
constexpr size_t WS_H1B = WS_REGC + 100663296;
constexpr size_t WS_Q = WS_REGC + 134217728;
constexpr size_t WS_YA = WS_REGC + 5 * UNITB;
constexpr size_t WS_YB = WS_YA + 33554432;
constexpr size_t WS_EXP = WS_YB + 16777216;
constexpr size_t WS_GATE = WS_EXP + 4194304;
constexpr size_t WS_BAR = WS_GATE + 4194304;
constexpr size_t WS_END = WS_BAR + 16384;
static_assert(WS_Q + 33554432 <= WS_YA, "overlay");
static_assert(WS_VB + 67108864 <= WS_H0B, "overlay");

constexpr int LDS_BYTES = 163840;
constexpr int NPHASE = 10;

struct Params {
    const float* in[30];
    float* out;
    unsigned char* ws;
    int ph_lo, ph_hi;
};
enum { I_X = 0, I_META, I_LNIN_G, I_LNIN_B, I_WIN, I_MU, I_W0, I_WW2, I_A0, I_WA2, I_WG2, I_KK, I_KA, I_RK, I_GNG, I_GNB, I_WPOOL, I_PSCALE, I_BGATE,
       I_WBA, I_WBB, I_WOUT, I_LN1G, I_LN1B, I_WQ, I_SUBK, I_UT, I_VT, I_LN2G, I_LN2B };

__device__ __forceinline__ unsigned pk2(float lo, float hi) { return pg8::cvt_pk_bf16(lo, hi); }
__device__ __forceinline__ float bflo(unsigned w) { return __uint_as_float(w << 16); }
__device__ __forceinline__ float bfhi(unsigned w) { return __uint_as_float(w & 0xffff0000u); }
__device__ __forceinline__ float bf1(bf16_t h) { return __uint_as_float(((unsigned)h) << 16); }
__device__ __forceinline__ bf16_t f2bf1(float f) { return (bf16_t)(pk2(f, f) & 0xffffu); }
__device__ __forceinline__ float wave_sum(float v) {
#pragma unroll
    for (int o = 1; o < 64; o <<= 1) v += __shfl_xor(v, o);
    return v;
}
__device__ __forceinline__ float sigmoidf_(float x) { return 1.0f / (1.0f + __expf(-x)); }
__device__ __forceinline__ f32x4 mfma16(bf16x8 a, bf16x8 b, f32x4 c) { return __builtin_amdgcn_mfma_f32_16x16x32_bf16(a, b, c, 0, 0, 0); }
__device__ __forceinline__ void unpack8(const u32x4 w, float* f) {
    f[0] = bflo(w.x); f[1] = bfhi(w.x); f[2] = bflo(w.y); f[3] = bfhi(w.y); f[4] = bflo(w.z); f[5] = bfhi(w.z); f[6] = bflo(w.w); f[7] = bfhi(w.w);
}
__device__ __forceinline__ u32x4 pack8(const float* f) { u32x4 w; w.x = pk2(f[0], f[1]); w.y = pk2(f[2], f[3]); w.z = pk2(f[4], f[5]); w.w = pk2(f[6], f[7]); return w; }
#define BLOCK_SYNC() __syncthreads()
#define XB_TMO      128
#define XB_XCNT(j)  (256  + 64 * (j))
#define XB_XSUB(j)  (1280 + 64 * (j))
#define XB_XGEN(j)  (2304 + 64 * (j))
#define XB_TOP      3328
#define XB_TOPGEN   3392
#define XCD_BAR_WORDS 3456
#define XB_SPIN_CAP (1u << 18)

__device__ __forceinline__ unsigned xb_ld(unsigned* p)              { return __hip_atomic_load(p, __ATOMIC_RELAXED, __HIP_MEMORY_SCOPE_AGENT); }
__device__ __forceinline__ unsigned xb_add(unsigned* p, unsigned v) { return __hip_atomic_fetch_add(p, v, __ATOMIC_RELAXED, __HIP_MEMORY_SCOPE_AGENT); }
__device__ __forceinline__ unsigned xb_xcc_id() { return (unsigned)__builtin_amdgcn_s_getreg((3 << 11) | 20) & 0xFu; }
#define XB_SPIN(cond, bar) do { unsigned _sp = 0; while (cond) { __builtin_amdgcn_s_sleep(1); \
    if ((++_sp & 255u) == 0u) { if (xb_ld(&(bar)[XB_TMO])) break; if (_sp > XB_SPIN_CAP) { atomicAdd(&(bar)[XB_TMO], 1u); break; } } } } while (0)

struct XcdBarrier {
    unsigned* bar; unsigned x;
    volatile LAS unsigned* st;
};

__device__ __forceinline__ XcdBarrier xcd_barrier_post(unsigned* bar, volatile LAS unsigned* st) {
    XcdBarrier b; b.bar = bar; b.x = xb_xcc_id(); b.st = st;
    if (threadIdx.x == 0) (void)xb_add(&bar[XB_XCNT(b.x)], 1u);
    return b;
}
__device__ __forceinline__ void xcd_barrier_complete(unsigned* bar, unsigned x, unsigned& nloc, unsigned& nx) {
    const unsigned G = gridDim.x * gridDim.y * gridDim.z;
    unsigned sum, cnt, mine, sp = 0u;
    for (;;) {
        sum = 0u; cnt = 0u; mine = 0u;
#pragma unroll
        for (unsigned j = 0; j < 16; ++j) { const unsigned c = xb_ld(&bar[XB_XCNT(j)]); sum += c; cnt += (c > 0u) ? 1u : 0u; mine = (j == x) ? c : mine; }
        if (sum == G) break;
        __builtin_amdgcn_s_sleep(1);
        if ((++sp & 255u) == 0u) { if (xb_ld(&bar[XB_TMO])) break; if (sp > XB_SPIN_CAP) { atomicAdd(&bar[XB_TMO], 1u); break; } }
    }
    nloc = mine > 0u ? mine : 1u; nx = cnt > 0u ? cnt : 1u;
}

__device__ __forceinline__ void xcd_barrier(const XcdBarrier& b) {
    asm volatile("s_waitcnt vmcnt(0)" ::: "memory");
    __syncthreads();
    if (threadIdx.x == 0) {
        unsigned* bar = b.bar;
        __builtin_amdgcn_s_waitcnt(0);
        unsigned nloc = b.st[0], nx = b.st[1];
        if (nloc == 0u) { xcd_barrier_complete(bar, b.x, nloc, nx); b.st[0] = nloc; b.st[1] = nx; }
        const unsigned old = xb_add(&bar[XB_XSUB(b.x)], 1u);
        const unsigned gen = old / nloc;
        if (old + 1u == (gen + 1u) * nloc) {
            __builtin_amdgcn_fence(__ATOMIC_RELEASE, "agent");
            asm volatile("s_waitcnt vmcnt(0)" ::: "memory");
            const unsigned og = xb_add(&bar[XB_TOP], 1u);
            const unsigned tg = og / nx;
            if (og + 1u == (tg + 1u) * nx) xb_add(&bar[XB_TOPGEN], 1u);
            else XB_SPIN(xb_ld(&bar[XB_TOPGEN]) == tg, bar);
            __builtin_amdgcn_fence(__ATOMIC_ACQUIRE, "agent");
            xb_add(&bar[XB_XGEN(b.x)], 1u);
            asm volatile("s_waitcnt vmcnt(0)" ::: "memory");
        } else {
            XB_SPIN(xb_ld(&bar[XB_XGEN(b.x)]) == gen, bar);
            __builtin_amdgcn_fence(__ATOMIC_ACQUIRE, "agent");
            asm volatile("s_waitcnt vmcnt(0)" ::: "memory");
        }
    }
    __syncthreads();
}

__device__ __forceinline__ void ln_row_bf16(const float* src, const float* g, const float* b, bf16_t* dst, int lane) {
    f32x4 v[8]; float s = 0.f;
#pragma unroll
    for (int j = 0; j < 8; ++j) { v[j] = ((const f32x4*)src)[lane + 64 * j]; s += (v[j].x + v[j].y) + (v[j].z + v[j].w); }
    const float mean = wave_sum(s) * (1.0f / D); float s2 = 0.f;
#pragma unroll
    for (int j = 0; j < 8; ++j) { v[j] = v[j] - mean; s2 += (v[j].x * v[j].x + v[j].y * v[j].y) + (v[j].z * v[j].z + v[j].w * v[j].w); }
    const float rstd = 1.0f / sqrtf(wave_sum(s2) * (1.0f / D) + LN_EPS);
#pragma unroll
    for (int j = 0; j < 8; ++j) {
        const f32x4 gg = ((const f32x4*)g)[lane + 64 * j], bb = ((const f32x4*)b)[lane + 64 * j];
        const f32x4 o = v[j] * rstd * gg + bb;
        u32x2 w; w.x = pk2(o.x, o.y); w.y = pk2(o.z, o.w);
        ((u32x2*)dst)[lane + 64 * j] = w;
    }
}
__device__ __forceinline__ void transpose_item(const float* W, int K, int N, int Npad, bf16_t* Wt, int item, int lane) {
    const int nblk = Npad >> 6, kb = item / nblk, nb = item - kb * nblk, n = nb * 64 + lane, k0 = kb * 32;
    float v[32];
    if (n < N) {
#pragma unroll
        for (int i = 0; i < 32; ++i) v[i] = W[(size_t)(k0 + i) * N + n];
    } else {
#pragma unroll
        for (int i = 0; i < 32; ++i) v[i] = 0.f;
    }
    u32x4* o = (u32x4*)(Wt + (size_t)n * K + k0);
#pragma unroll
    for (int c = 0; c < 4; ++c) { u32x4 w; w.x = pk2(v[8 * c], v[8 * c + 1]); w.y = pk2(v[8 * c + 2], v[8 * c + 3]); w.z = pk2(v[8 * c + 4], v[8 * c + 5]); w.w = pk2(v[8 * c + 6], v[8 * c + 7]); o[c] = w; }
}
__device__ __forceinline__ void phase0(const Params& P) {
    const int lane = threadIdx.x & 63, wave = threadIdx.x >> 6;
    const int gw = blockIdx.x * 8 + wave, NGW = gridDim.x * 8;
    unsigned char* ws = P.ws;
    constexpr int T_IN = 64 * 184, T_A = 64 * 32, T_B = 32 * 32, T_O = 64 * 32, T_Q = 64 * 32, T_POOL = 4 * 32, T_W2 = 3 * 32, T_A2 = 3 * 32, T_G2 = 8 * 32;
    constexpr int T_LN = MROWS, T_SK = 64;
    constexpr int NIT = T_IN + T_A + T_B + T_O + T_Q + T_POOL + T_W2 + T_A2 + T_G2 + T_LN + T_SK;
    for (int it = gw; it < NIT; it += NGW) {
        int r = it;
        if (r < T_IN) { transpose_item(P.in[I_WIN], 2048, INC, NPAD, (bf16_t*)(ws + WS_WTIN), r, lane); continue; } r -= T_IN;
        if (r < T_A) { transpose_item(P.in[I_WBA], 2048, 2048, 2048, (bf16_t*)(ws + WS_WTA), r, lane); continue; } r -= T_A;
        if (r < T_B) { transpose_item(P.in[I_WBB], 1024, 2048, 2048, (bf16_t*)(ws + WS_WTB), r, lane); continue; } r -= T_B;
        if (r < T_O) { transpose_item(P.in[I_WOUT], 2048, 2048, 2048, (bf16_t*)(ws + WS_WTOUT), r, lane); continue; } r -= T_O;
        if (r < T_Q) { transpose_item(P.in[I_WQ], 2048, 2048, 2048, (bf16_t*)(ws + WS_WTQ), r, lane); continue; } r -= T_Q;
        if (r < T_POOL) { const int g = r >> 5; transpose_item(P.in[I_WPOOL] + g * 65536, 256, 256, 256, (bf16_t*)(ws + WS_WTPOOL) + g * 65536, r & 31, lane); continue; } r -= T_POOL;
        if (r < T_W2) { transpose_item(P.in[I_WW2], 96, 2048, 2048, (bf16_t*)(ws + WS_WTW2), r, lane); continue; } r -= T_W2;
        if (r < T_A2) { transpose_item(P.in[I_WA2], 96, 2048, 2048, (bf16_t*)(ws + WS_WTA2), r, lane); continue; } r -= T_A2;
        if (r < T_G2) { transpose_item(P.in[I_WG2], 256, 2048, 2048, (bf16_t*)(ws + WS_WTG2), r, lane); continue; } r -= T_G2;
        if (r < T_LN) {
            bf16_t* dst = (bf16_t*)(ws + WS_H0B) + (size_t)r * D;
            if (r < NTOK) ln_row_bf16(P.in[I_X] + (size_t)r * D, P.in[I_LNIN_G], P.in[I_LNIN_B], dst, lane);
            else if (r < NTOK + 16) ln_row_bf16(P.in[I_META] + (size_t)(r - NTOK) * D, P.in[I_LNIN_G], P.in[I_LNIN_B], dst, lane);
            else {
#pragma unroll
                for (int j = 0; j < 8; ++j) ((u32x2*)dst)[lane + 64 * j] = (u32x2){0u, 0u};
            }
            continue;
        }
        r -= T_LN;
        {
            const float* s = P.in[I_SUBK] + r * 512 + lane * 8; float f[8];
#pragma unroll
            for (int i = 0; i < 8; ++i) f[i] = s[i];
            *(u32x4*)((bf16_t*)(ws + WS_SUBK) + r * 512 + lane * 8) = pack8(f);
        }
    }
}
namespace pg8 {
struct EpiGateA {
    static constexpr bool PERM = false, AFTER_DRAIN = false;
    float* C; const bf16_t* p; const float* bgate;
    __device__ __forceinline__ void operator()(const f32x4 (&acc)[2][2][4][2], const Unit& u, int wr, int wc, int fr, int fq) const {
        const int row0 = u.pm * BM + wr * 64 + fr, col0 = u.pn * BM + wc * 32 + 4 * fq;
#pragma unroll
        for (int ai = 0; ai < 2; ++ai)
#pragma unroll
            for (int m = 0; m < 4; ++m) { const size_t row = (size_t)(row0 + ai * HALF + m * 16);
#pragma unroll
                for (int bj = 0; bj < 2; ++bj)
#pragma unroll
                    for (int n = 0; n < 2; ++n) { const int col = col0 + bj * HALF + n * 16;
                        const u32x2 pw = *(const u32x2*)(p + row * NPAD + C_G0 + col); const f32x4 bg = *(const f32x4*)(bgate + col);
                        f32x4 g; g.x = sigmoidf_(bflo(pw.x) + bg.x); g.y = sigmoidf_(bfhi(pw.x) + bg.y); g.z = sigmoidf_(bflo(pw.y) + bg.z); g.w = sigmoidf_(bfhi(pw.y) + bg.w);
                        *(f32x4*)(C + row * D + col) = acc[ai][bj][m][n] * g; } }
    }
};
struct EpiGateB {
    static constexpr bool PERM = false, AFTER_DRAIN = false;
    const float* C; bf16_t* O; const bf16_t* p; const float* bgate;
    __device__ __forceinline__ void operator()(const f32x4 (&acc)[2][2][4][2], const Unit& u, int wr, int wc, int fr, int fq) const {
        const int row0 = u.pm * BM + wr * 64 + fr, col0 = u.pn * BM + wc * 32 + 4 * fq;
#pragma unroll
        for (int ai = 0; ai < 2; ++ai)
#pragma unroll
            for (int m = 0; m < 4; ++m) { const size_t row = (size_t)(row0 + ai * HALF + m * 16);
#pragma unroll
                for (int bj = 0; bj < 2; ++bj)
#pragma unroll
                    for (int n = 0; n < 2; ++n) { const int col = col0 + bj * HALF + n * 16;
                        const u32x2 pw = *(const u32x2*)(p + row * NPAD + C_G1 + col); const f32x4 bg = *(const f32x4*)(bgate + D + col);
                        f32x4 g; g.x = sigmoidf_(bflo(pw.x) + bg.x); g.y = sigmoidf_(bfhi(pw.x) + bg.y); g.z = sigmoidf_(bflo(pw.y) + bg.z); g.w = sigmoidf_(bfhi(pw.y) + bg.w);
                        const f32x4 o = *(const f32x4*)(C + row * D + col) + acc[ai][bj][m][n] * g;
                        u32x2 w; w.x = cvt_pk_bf16(o.x, o.y); w.y = cvt_pk_bf16(o.z, o.w);
                        *(u32x2*)(O + row * D + col) = w; } }
    }
};
struct EpiResid {
    static constexpr bool PERM = false, AFTER_DRAIN = false;
    float* C; const bf16_t* h0; float alpha;
    __device__ __forceinline__ void operator()(const f32x4 (&acc)[2][2][4][2], const Unit& u, int wr, int wc, int fr, int fq) const {
        const int row0 = u.pm * BM + wr * 64 + fr, col0 = u.pn * BM + wc * 32 + 4 * fq;
#pragma unroll
        for (int ai = 0; ai < 2; ++ai)
#pragma unroll
            for (int m = 0; m < 4; ++m) { const size_t row = (size_t)(row0 + ai * HALF + m * 16);
#pragma unroll
                for (int bj = 0; bj < 2; ++bj)
#pragma unroll
                    for (int n = 0; n < 2; ++n) { const int col = col0 + bj * HALF + n * 16;
                        const u32x2 hw = *(const u32x2*)(h0 + row * D + col);
                        f32x4 hv; hv.x = bflo(hw.x); hv.y = bfhi(hw.x); hv.z = bflo(hw.y); hv.w = bfhi(hw.y);
                        *(f32x4*)(C + row * D + col) = hv * alpha + acc[ai][bj][m][n]; } }
    }
};
}
template <class Epi>
__device__ __forceinline__ void run_gemm(ldsp lds, const bf16_t* A, const bf16_t* Bt, int M, int N, int K, const Epi& E) {
    pg8::Gemm g; g.A = A; g.Bt = Bt; g.M = M; g.N = N; g.K = K;
    pg8::StaticOrder S; S.init(M, N, (int)gridDim.x, (int)blockIdx.x);
    pg8::gemm_phase<Epi, pg8::StaticOrder, false>(lds, g, S, E, nullptr);
}
constexpr int LD64 = 72, MATB = 64 * LD64 * 2, LDK = 104;
constexpr int O_AB = 0, O_RB = 1 * MATB, O_BH = 2 * MATB, O_KH = 3 * MATB, O_ABT = 4 * MATB, O_BTT = 5 * MATB, O_KTT = 6 * MATB, O_VT = 7 * MATB;
constexpr int O_M0 = 8 * MATB, O_M0T = 9 * MATB, O_M1 = 10 * MATB, O_M1T = 11 * MATB, O_PA = 12 * MATB, O_PB = 13 * MATB, O_MAK = 14 * MATB, O_MRB = 15 * MATB, O_MRK = 16 * MATB;
constexpr int O_ELEND = 17 * MATB;
constexpr int O_WL = 8 * MATB, O_AL = O_WL + 64 * LDK * 2, O_Z = O_AL + 64 * LDK * 2, O_AZ = O_Z + 64 * 68 * 4;
static_assert(O_AZ + 64 * 68 * 4 <= O_ELEND, "lds");
static_assert(O_ELEND + 256 <= LDS_BYTES, "lds");

__device__ __forceinline__ bf16x8 ldsfrag(ldsp lds, int off, int ld, int row, int kofs) { return *(const LAS bf16x8*)(lds + off + (row * ld + kofs) * 2); }
__device__ __forceinline__ void st4(ldsp lds, int off, int row, int col, const f32x4 v) {
    u32x2 w; w.x = pk2(v.x, v.y); w.y = pk2(v.z, v.w); *(LAS u32x2*)(lds + off + (row * LD64 + col) * 2) = w; }
__device__ __forceinline__ void st1(ldsp lds, int off, int row, int col, float v) { *(LAS bf16_t*)(lds + off + (row * LD64 + col) * 2) = f2bf1(v); }

__device__ __forceinline__ void shift8(const bf16_t* pcur, const bf16_t* pprev, const float* mu, float* x) {
    float c[8], q[8];
    if (pcur) unpack8(*(const u32x4*)pcur, c); else {
#pragma unroll
        for (int i = 0; i < 8; ++i) c[i] = 0.f; }
    if (pprev) unpack8(*(const u32x4*)pprev, q); else {
#pragma unroll
        for (int i = 0; i < 8; ++i) q[i] = 0.f; }
    const f32x4 m0 = *(const f32x4*)mu, m1 = *(const f32x4*)(mu + 4);
    const float mm[8] = {m0.x, m0.y, m0.z, m0.w, m1.x, m1.y, m1.z, m1.w};
#pragma unroll
    for (int i = 0; i < 8; ++i) x[i] = c[i] + (q[i] - c[i]) * mm[i];
}

template <bool DO_P, bool DO_SQ>
__device__ __forceinline__ void dbl_step(ldsp lds, int sN, int sT, int dN, int dT, int pC, int pN, int tm, int tn0, int fr, int fq) {
    bf16x8 a[2];
#pragma unroll
    for (int ks = 0; ks < 2; ++ks) a[ks] = ldsfrag(lds, sT, LD64, 16 * tm + fr, ks * 32 + fq * 8);
#pragma unroll
    for (int t2 = 0; t2 < 2; ++t2) {
        const int nt = tn0 + t2, t = 16 * nt + fr, s0 = 16 * tm + 4 * fq;
        if (DO_P) {
            f32x4 acc = {0.f, 0.f, 0.f, 0.f};
#pragma unroll
            for (int ks = 0; ks < 2; ++ks) acc = mfma16(a[ks], ldsfrag(lds, pC, LD64, t, ks * 32 + fq * 8), acc);
            const u32x2 pw = *(const LAS u32x2*)(lds + pC + (t * LD64 + s0) * 2);
            acc.x += bflo(pw.x); acc.y += bfhi(pw.x); acc.z += bflo(pw.y); acc.w += bfhi(pw.y);
            st4(lds, pN, t, s0, acc);
        }
        if (DO_SQ) {
            f32x4 acc = {0.f, 0.f, 0.f, 0.f};
#pragma unroll
            for (int ks = 0; ks < 2; ++ks) acc = mfma16(a[ks], ldsfrag(lds, sN, LD64, t, ks * 32 + fq * 8), acc);
            st4(lds, dN, t, s0, acc);
            st1(lds, dT, s0 + 0, t, acc.x); st1(lds, dT, s0 + 1, t, acc.y); st1(lds, dT, s0 + 2, t, acc.z); st1(lds, dT, s0 + 3, t, acc.w);
        }
    }
}


#ifdef DBG_STAGE
constexpr size_t DBG_STRIDE = (size_t)NUNITS * 512 * 4;
__device__ __forceinline__ void dbgsum(const Params& P, ldsp lds, int u, int stage, const int* offs, int nmat) {
    unsigned acc = 0;
    for (int m = 0; m < nmat; ++m)
        for (int k = 0; k < 4; ++k) { const int idx = threadIdx.x + 512 * k, row = idx >> 5, cp = idx & 31; const unsigned x = *(const LAS unsigned*)(lds + offs[m] + row * (LD64 * 2) + cp * 4); acc += (x & 0xffffu) + (x >> 16); }
    ((unsigned*)(P.ws + WS_S0T + (size_t)stage * DBG_STRIDE))[(size_t)u * 512 + threadIdx.x] = acc;
}
#define DBGSUM(stage, ...) do { const int offs_[] = {__VA_ARGS__}; dbgsum(P, lds, u, stage, offs_, (int)(sizeof(offs_) / sizeof(int))); } while (0)
#else
#define DBGSUM(stage, ...) do { } while (0)
#endif
__device__ __forceinline__ void rwkv_unit(const Params& P, ldsp lds, int u) {
    const int tid = threadIdx.x, lane = tid & 63, wave = tid >> 6, fr = lane & 15, fq = lane >> 4, tm = wave >> 1, tn0 = (wave & 1) * 2;
    unsigned char* ws = P.ws;
    const bf16_t* pp = (const bf16_t*)(ws + WS_P);
    const bool meta = u >= 4096;
    int b = 0, h, c = 0;
    if (meta) { h = u - 4096; } else { const int bh = u >> 6; c = u & 63; b = bh >> 5; h = bh & 31; }
    auto rowof = [&](int tl) -> int {
        if (meta) return (tl >= 48) ? (ROW_META + tl - 48) : -1;
        if (tl >= 0 || c > 0) return b * SEQ + c * 64 + tl;
        return ROW_META + 15;
    };
    auto rowp = [&](int tl, int col) -> const bf16_t* { const int r = rowof(tl); return r < 0 ? (const bf16_t*)nullptr : pp + (size_t)r * NPAD + col; };
    const float* mu = P.in[I_MU];
    for (int idx = tid; idx < 1536; idx += 512) {
        const int mat = idx / 768, rem = idx - mat * 768, t = rem / 12, ch = rem - t * 12, col = (mat ? C_AL : C_WL) + ch * 8;
        float x[8]; shift8(rowp(t, col), rowp(t - 1, col), mu + col, x);
        if (mat == 0) {
#pragma unroll
            for (int i = 0; i < 8; ++i) x[i] = tanhf(x[i]);
        }
        *(LAS u32x4*)(lds + (mat ? O_AL : O_WL) + (t * LDK + ch * 8) * 2) = pack8(x);
    }
    BLOCK_SYNC();
    {
        const bf16_t* ww2 = (const bf16_t*)(ws + WS_WTW2) + (size_t)(h * 64 + 16 * tm + fr) * 96 + fq * 8;
        const bf16_t* wa2 = (const bf16_t*)(ws + WS_WTA2) + (size_t)(h * 64 + 16 * tm + fr) * 96 + fq * 8;
        f32x4 z[2] = {{0.f, 0.f, 0.f, 0.f}, {0.f, 0.f, 0.f, 0.f}}, az[2] = {{0.f, 0.f, 0.f, 0.f}, {0.f, 0.f, 0.f, 0.f}};
#pragma unroll
        for (int ks = 0; ks < 3; ++ks) {
            const bf16x8 aw = *(const bf16x8*)(ww2 + ks * 32), aa = *(const bf16x8*)(wa2 + ks * 32);
#pragma unroll
            for (int t2 = 0; t2 < 2; ++t2) {
                const int t = 16 * (tn0 + t2) + fr;
                z[t2] = mfma16(aw, ldsfrag(lds, O_WL, LDK, t, ks * 32 + fq * 8), z[t2]);
                az[t2] = mfma16(aa, ldsfrag(lds, O_AL, LDK, t, ks * 32 + fq * 8), az[t2]);
            }
        }
#pragma unroll
        for (int t2 = 0; t2 < 2; ++t2) {
            const int t = 16 * (tn0 + t2) + fr, j0 = 16 * tm + 4 * fq;
            *(LAS f32x4*)(lds + O_Z + (t * 68 + j0) * 4) = z[t2];
            *(LAS f32x4*)(lds + O_AZ + (t * 68 + j0) * 4) = az[t2];
        }
    }
    BLOCK_SYNC();
    const int t = tid >> 3, jq = tid & 7, j0 = 8 * jq, hj = h * 64 + j0;
    const bool nulltok = meta && t < 48;
    float lw[8], av[8], rv[8], kv[8], vv[8], kk[8], km[8];
    {
        const f32x4 z0 = *(const LAS f32x4*)(lds + O_Z + (t * 68 + j0) * 4), z1 = *(const LAS f32x4*)(lds + O_Z + (t * 68 + j0 + 4) * 4);
        const f32x4 y0 = *(const LAS f32x4*)(lds + O_AZ + (t * 68 + j0) * 4), y1 = *(const LAS f32x4*)(lds + O_AZ + (t * 68 + j0 + 4) * 4);
        const float zz[8] = {z0.x, z0.y, z0.z, z0.w, z1.x, z1.y, z1.z, z1.w}, yy[8] = {y0.x, y0.y, y0.z, y0.w, y1.x, y1.y, y1.z, y1.w};
        const float* w0 = P.in[I_W0] + hj; const float* a0 = P.in[I_A0] + hj;
#pragma unroll
        for (int i = 0; i < 8; ++i) { lw[i] = nulltok ? 0.f : -DSCALE * sigmoidf_(w0[i] + zz[i]); av[i] = sigmoidf_(a0[i] + yy[i]); }
        shift8(rowp(t, C_R + hj), rowp(t - 1, C_R + hj), mu + C_R + hj, rv);
        shift8(rowp(t, C_K + hj), rowp(t - 1, C_K + hj), mu + C_K + hj, kv);
        shift8(rowp(t, C_V + hj), rowp(t - 1, C_V + hj), mu + C_V + hj, vv);
        if (nulltok) {
#pragma unroll
            for (int i = 0; i < 8; ++i) { rv[i] = 0.f; kv[i] = 0.f; vv[i] = 0.f; }
        }
        const float* kkw = P.in[I_KK] + hj; const float* kaw = P.in[I_KA] + hj; const float* rkw = P.in[I_RK] + hj;
        float n2 = 0.f, bon = 0.f;
#pragma unroll
        for (int i = 0; i < 8; ++i) { kk[i] = kv[i] * kkw[i]; n2 += kk[i] * kk[i]; km[i] = kv[i] * (1.0f + (av[i] - 1.0f) * kaw[i]); bon += rv[i] * km[i] * rkw[i]; }
        n2 += __shfl_xor(n2, 1); n2 += __shfl_xor(n2, 2); n2 += __shfl_xor(n2, 4);
        bon += __shfl_xor(bon, 1); bon += __shfl_xor(bon, 2); bon += __shfl_xor(bon, 4);
        const float inv = 1.0f / fmaxf(sqrtf(n2), 1e-12f);
#pragma unroll
        for (int i = 0; i < 8; ++i) kk[i] *= inv;
        if (!meta && jq == 0) ((float*)(ws + WS_BONUS))[(size_t)(b * SEQ + c * 64 + t) * 32 + h] = bon;
        *(LAS f32x4*)(lds + O_Z + (t * 68 + j0) * 4) = (f32x4){lw[0], lw[1], lw[2], lw[3]};
        *(LAS f32x4*)(lds + O_Z + (t * 68 + j0 + 4) * 4) = (f32x4){lw[4], lw[5], lw[6], lw[7]};
    }
    BLOCK_SYNC();
    {
        float Lc[8], Le[8];
#pragma unroll
        for (int i = 0; i < 8; ++i) { Lc[i] = 0.f; Le[i] = 0.f; }
        for (int tau = 0; tau < 64; ++tau) {
            const f32x4 x0 = *(const LAS f32x4*)(lds + O_Z + (tau * 68 + j0) * 4), x1 = *(const LAS f32x4*)(lds + O_Z + (tau * 68 + j0 + 4) * 4);
            const float xx[8] = {x0.x, x0.y, x0.z, x0.w, x1.x, x1.y, x1.z, x1.w};
            const float msk = tau <= t ? 1.0f : 0.0f;
#pragma unroll
            for (int i = 0; i < 8; ++i) { Le[i] += xx[i]; Lc[i] += msk * xx[i]; }
        }
        float Ab[8], Rb[8], Bh[8], Kh[8], Bt[8], Kt[8];
#pragma unroll
        for (int i = 0; i < 8; ++i) {
            const float eP = __expf(Lc[i] - lw[i]), eC = __expf(Lc[i]), eN = __expf(-Lc[i]), eE = __expf(Le[i] - Lc[i]);
            const float ka = kk[i] * av[i];
            Ab[i] = -kk[i] * eP; Rb[i] = rv[i] * eC; Bh[i] = ka * eN; Kh[i] = km[i] * eN; Bt[i] = ka * eE; Kt[i] = km[i] * eE;
        }
        *(LAS u32x4*)(lds + O_AB + (t * LD64 + j0) * 2) = pack8(Ab);
        *(LAS u32x4*)(lds + O_RB + (t * LD64 + j0) * 2) = pack8(Rb);
        *(LAS u32x4*)(lds + O_BH + (t * LD64 + j0) * 2) = pack8(Bh);
        *(LAS u32x4*)(lds + O_KH + (t * LD64 + j0) * 2) = pack8(Kh);
#pragma unroll
        for (int i = 0; i < 8; ++i) { st1(lds, O_ABT, j0 + i, t, Ab[i]); st1(lds, O_BTT, j0 + i, t, Bt[i]); st1(lds, O_KTT, j0 + i, t, Kt[i]); st1(lds, O_VT, j0 + i, t, vv[i]); }
        if (t == 63) {
#pragma unroll
            for (int i = 0; i < 8; ++i) *(LAS float*)(lds + O_ELEND + (j0 + i) * 4) = __expf(Le[i]);
        }
    }
    BLOCK_SYNC();
    DBGSUM(0, O_AB, O_RB, O_BH, O_KH, O_ABT, O_BTT, O_KTT, O_VT);
    {
        bf16x8 abh[2], akh[2];
#pragma unroll
        for (int ks = 0; ks < 2; ++ks) { abh[ks] = ldsfrag(lds, O_BH, LD64, 16 * tm + fr, ks * 32 + fq * 8); akh[ks] = ldsfrag(lds, O_KH, LD64, 16 * tm + fr, ks * 32 + fq * 8); }
#pragma unroll
        for (int t2 = 0; t2 < 2; ++t2) {
            const int tt = 16 * (tn0 + t2) + fr, s0 = 16 * tm + 4 * fq;
            f32x4 mab = {0.f, 0.f, 0.f, 0.f}, mak = mab, mrb = mab, mrk = mab;
#pragma unroll
            for (int ks = 0; ks < 2; ++ks) {
                const bf16x8 bab = ldsfrag(lds, O_AB, LD64, tt, ks * 32 + fq * 8), brb = ldsfrag(lds, O_RB, LD64, tt, ks * 32 + fq * 8);
                mab = mfma16(abh[ks], bab, mab); mak = mfma16(akh[ks], bab, mak); mrb = mfma16(abh[ks], brb, mrb); mrk = mfma16(akh[ks], brb, mrk);
            }
            float vab[4] = {mab.x, mab.y, mab.z, mab.w}, vak[4] = {mak.x, mak.y, mak.z, mak.w}, vrb[4] = {mrb.x, mrb.y, mrb.z, mrb.w}, vrk[4] = {mrk.x, mrk.y, mrk.z, mrk.w}, vp[4];
#pragma unroll
            for (int r = 0; r < 4; ++r) { const int s = s0 + r; const bool st = s < tt, le = s <= tt;
                vab[r] = st ? vab[r] : 0.f; vak[r] = st ? vak[r] : 0.f; vrb[r] = le ? vrb[r] : 0.f; vrk[r] = le ? vrk[r] : 0.f; vp[r] = vab[r] + (s == tt ? 1.0f : 0.f); }
            st4(lds, O_M0, tt, s0, (f32x4){vab[0], vab[1], vab[2], vab[3]});
#pragma unroll
            for (int r = 0; r < 4; ++r) st1(lds, O_M0T, s0 + r, tt, vab[r]);
            st4(lds, O_PA, tt, s0, (f32x4){vp[0], vp[1], vp[2], vp[3]});
            st4(lds, O_MAK, tt, s0, (f32x4){vak[0], vak[1], vak[2], vak[3]});
            st4(lds, O_MRB, tt, s0, (f32x4){vrb[0], vrb[1], vrb[2], vrb[3]});
            st4(lds, O_MRK, tt, s0, (f32x4){vrk[0], vrk[1], vrk[2], vrk[3]});
        }
    }
    BLOCK_SYNC();
    DBGSUM(1, O_M0, O_M0T, O_PA, O_MAK, O_MRB, O_MRK);
    dbl_step<false, true>(lds, O_M0, O_M0T, O_M1, O_M1T, 0, 0, tm, tn0, fr, fq); BLOCK_SYNC();
    dbl_step<true, true>(lds, O_M1, O_M1T, O_M0, O_M0T, O_PA, O_PB, tm, tn0, fr, fq); BLOCK_SYNC();
    dbl_step<true, true>(lds, O_M0, O_M0T, O_M1, O_M1T, O_PB, O_PA, tm, tn0, fr, fq); BLOCK_SYNC();
    dbl_step<true, true>(lds, O_M1, O_M1T, O_M0, O_M0T, O_PA, O_PB, tm, tn0, fr, fq); BLOCK_SYNC();
    dbl_step<true, true>(lds, O_M0, O_M0T, O_M1, O_M1T, O_PB, O_PA, tm, tn0, fr, fq); BLOCK_SYNC();
    dbl_step<true, false>(lds, O_M1, O_M1T, 0, 0, O_PA, O_PB, tm, tn0, fr, fq); BLOCK_SYNC();
    DBGSUM(2, O_PB);
    {
        bf16x8 aT[2], aMak[2];
#pragma unroll
        for (int ks = 0; ks < 2; ++ks) { aT[ks] = ldsfrag(lds, O_PB, LD64, 16 * tm + fr, ks * 32 + fq * 8); aMak[ks] = ldsfrag(lds, O_MAK, LD64, 16 * tm + fr, ks * 32 + fq * 8); }
#pragma unroll
        for (int t2 = 0; t2 < 2; ++t2) {
            const int n = 16 * (tn0 + t2) + fr, t0 = 16 * tm + 4 * fq;
            f32x4 at = {0.f, 0.f, 0.f, 0.f}, xt = at;
#pragma unroll
            for (int ks = 0; ks < 2; ++ks) { at = mfma16(aT[ks], ldsfrag(lds, O_ABT, LD64, n, ks * 32 + fq * 8), at); xt = mfma16(aMak[ks], ldsfrag(lds, O_VT, LD64, n, ks * 32 + fq * 8), xt); }
            st4(lds, O_M0, n, t0, at); st4(lds, O_M0T, n, t0, xt);
        }
    }
    BLOCK_SYNC();
    DBGSUM(3, O_M0, O_M0T);
    const size_t ub = (size_t)u * 4096;
    {
        bf16x8 aT[2], aAt[2];
#pragma unroll
        for (int ks = 0; ks < 2; ++ks) { aT[ks] = ldsfrag(lds, O_PB, LD64, 16 * tm + fr, ks * 32 + fq * 8); aAt[ks] = ldsfrag(lds, O_M0, LD64, 16 * tm + fr, ks * 32 + fq * 8); }
        bf16_t* Rt = (bf16_t*)(ws + WS_RT) + ub; bf16_t* Gp = (bf16_t*)(ws + WS_G) + ub;
#pragma unroll
        for (int t2 = 0; t2 < 2; ++t2) {
            const int n = 16 * (tn0 + t2) + fr, m0 = 16 * tm + 4 * fq;
            f32x4 u0 = {0.f, 0.f, 0.f, 0.f}, rt = u0, g = u0;
#pragma unroll
            for (int ks = 0; ks < 2; ++ks) {
                u0 = mfma16(aT[ks], ldsfrag(lds, O_M0T, LD64, n, ks * 32 + fq * 8), u0);
                rt = mfma16(aAt[ks], ldsfrag(lds, O_MRB, LD64, n, ks * 32 + fq * 8), rt);
                g = mfma16(aAt[ks], ldsfrag(lds, O_BTT, LD64, n, ks * 32 + fq * 8), g);
            }
            st4(lds, O_M1, n, m0, u0);
            const u32x2 rw = *(const LAS u32x2*)(lds + O_RB + (n * LD64 + m0) * 2);
            rt.x += bflo(rw.x); rt.y += bfhi(rw.x); rt.z += bflo(rw.y); rt.w += bfhi(rw.y);
            { u32x2 w; w.x = pk2(rt.x, rt.y); w.y = pk2(rt.z, rt.w); *(u32x2*)(Rt + n * 64 + m0) = w; }
            if ((n >> 2) == (m0 >> 2)) { const float e = *(const LAS float*)(lds + O_ELEND + n * 4); const int r = n & 3;
                g.x += (r == 0) ? e : 0.f; g.y += (r == 1) ? e : 0.f; g.z += (r == 2) ? e : 0.f; g.w += (r == 3) ? e : 0.f; }
            { const int pos0 = 32 * (tm >> 1) + 8 * fq + 4 * (tm & 1); u32x2 w; w.x = pk2(g.x, g.y); w.y = pk2(g.z, g.w); *(u32x2*)(Gp + n * 64 + pos0) = w; }
        }
    }
    BLOCK_SYNC();
    DBGSUM(4, O_M1);
    {
        bf16x8 aB[2], aK[2], aU[2], aV[2];
#pragma unroll
        for (int ks = 0; ks < 2; ++ks) { const int row = 16 * tm + fr, ko = ks * 32 + fq * 8;
            aB[ks] = ldsfrag(lds, O_BTT, LD64, row, ko); aK[ks] = ldsfrag(lds, O_KTT, LD64, row, ko); aU[ks] = ldsfrag(lds, O_M1, LD64, row, ko); aV[ks] = ldsfrag(lds, O_VT, LD64, row, ko); }
        bf16_t* H0t = (bf16_t*)(ws + WS_H0T) + ub; bf16_t* Y0s = (bf16_t*)(ws + WS_Y0) + ub;
#pragma unroll
        for (int t2 = 0; t2 < 2; ++t2) {
            const int n = 16 * (tn0 + t2) + fr, m0 = 16 * tm + 4 * fq;
            f32x4 hh = {0.f, 0.f, 0.f, 0.f}, yy = hh;
#pragma unroll
            for (int ks = 0; ks < 2; ++ks) { const int ko = ks * 32 + fq * 8;
                const bf16x8 bU = ldsfrag(lds, O_M1, LD64, n, ko), bV = ldsfrag(lds, O_VT, LD64, n, ko), bRb = ldsfrag(lds, O_MRB, LD64, n, ko), bRk = ldsfrag(lds, O_MRK, LD64, n, ko);
                hh = mfma16(aB[ks], bU, hh); hh = mfma16(aK[ks], bV, hh);
                yy = mfma16(aU[ks], bRb, yy); yy = mfma16(aV[ks], bRk, yy); }
            { u32x2 w; w.x = pk2(hh.x, hh.y); w.y = pk2(hh.z, hh.w); *(u32x2*)(H0t + n * 64 + m0) = w; }
            { u32x2 w; w.x = pk2(yy.x, yy.y); w.y = pk2(yy.z, yy.w); *(u32x2*)(Y0s + n * 64 + m0) = w; }
        }
    }
    BLOCK_SYNC();
}

constexpr int LDU = 264;
__device__ __forceinline__ void pool_unit(const Params& P, ldsp lds, int pu) {
    const int tid = threadIdx.x, lane = tid & 63, wave = tid >> 6, fr = lane & 15, fq = lane >> 4;
    unsigned char* ws = P.ws;
    const bf16_t* pp = (const bf16_t*)(ws + WS_P);
    const int g = pu & 3, tt = pu >> 2, b = tt >> 6, ti0 = (tt & 63) * 64;
    constexpr int O_U = 0, O_PL = 79 * LDU * 2;
    for (int idx = tid; idx < 79 * 32; idx += 512) {
        const int lr = idx >> 5, ch = idx & 31, ti = ti0 + lr - 15;
        const int row = ti >= 0 ? b * SEQ + ti : ROW_META + 16 + ti;
        *(LAS u32x4*)(lds + O_U + (lr * LDU + ch * 8) * 2) = *(const u32x4*)(pp + (size_t)row * NPAD + C_POOL + g * 256 + ch * 8);
    }
    BLOCK_SYNC();
    {
        const int t = tid >> 3, cq = tid & 7, win = 2 << g; const float inv = 1.0f / (float)win;
#pragma unroll
        for (int cc = 0; cc < 4; ++cc) {
            const int c0 = cq * 32 + cc * 8; float s[8], own[8];
            unpack8(*(const LAS u32x4*)(lds + O_U + ((15 + t) * LDU + c0) * 2), own);
#pragma unroll
            for (int i = 0; i < 8; ++i) s[i] = own[i];
            for (int d = 1; d < win; ++d) { float x[8]; unpack8(*(const LAS u32x4*)(lds + O_U + ((15 + t - d) * LDU + c0) * 2), x);
#pragma unroll
                for (int i = 0; i < 8; ++i) s[i] += x[i]; }
#pragma unroll
            for (int i = 0; i < 8; ++i) s[i] = s[i] * inv - own[i];
            *(LAS u32x4*)(lds + O_PL + (t * LDU + c0) * 2) = pack8(s);
        }
    }
    BLOCK_SYNC();
    {
        const bf16_t* wt = (const bf16_t*)(ws + WS_WTPOOL) + (size_t)g * 65536;
        f32x4 acc[2][4];
#pragma unroll
        for (int a = 0; a < 2; ++a)
#pragma unroll
            for (int n = 0; n < 4; ++n) acc[a][n] = (f32x4){0.f, 0.f, 0.f, 0.f};
#pragma unroll 2
        for (int ks = 0; ks < 8; ++ks) {
            bf16x8 af[2];
#pragma unroll
            for (int a = 0; a < 2; ++a) af[a] = *(const bf16x8*)(wt + (size_t)(32 * wave + 16 * a + fr) * 256 + ks * 32 + fq * 8);
#pragma unroll
            for (int n = 0; n < 4; ++n) { const bf16x8 bf = ldsfrag(lds, O_PL, LDU, 16 * n + fr, ks * 32 + fq * 8);
#pragma unroll
                for (int a = 0; a < 2; ++a) acc[a][n] = mfma16(af[a], bf, acc[a][n]); }
        }
        bf16_t* yb = (bf16_t*)(ws + WS_YB);
        const float* psc = P.in[I_PSCALE] + g * 256;
#pragma unroll
        for (int a = 0; a < 2; ++a) { const int d0 = 32 * wave + 16 * a + 4 * fq; const f32x4 sc = *(const f32x4*)(psc + d0);
#pragma unroll
            for (int n = 0; n < 4; ++n) { const int t = 16 * n + fr; const f32x4 o = acc[a][n] * sc;
                u32x2 w; w.x = pk2(o.x, o.y); w.y = pk2(o.z, o.w);
                *(u32x2*)(yb + (size_t)(b * SEQ + ti0 + t) * 1024 + g * 256 + d0) = w; } }
    }
    BLOCK_SYNC();
}
__device__ __forceinline__ void phase2(const Params& P, ldsp lds) {
    for (int u = blockIdx.x; u < NUNITS + 512; u += gridDim.x) {
        if (u < NUNITS) rwkv_unit(P, lds, u); else pool_unit(P, lds, u - NUNITS);
    }
}
__device__ __forceinline__ void phase3(const Params& P) {
    const int lane = threadIdx.x & 63, wave = threadIdx.x >> 6, fr = lane & 15, fq = lane >> 4;
    if (wave != 0) return;
    unsigned char* ws = P.ws;
    const bf16_t* Gp = (const bf16_t*)(ws + WS_G); const bf16_t* H0t = (const bf16_t*)(ws + WS_H0T); bf16_t* S0t = (bf16_t*)(ws + WS_S0T);
    for (int item = blockIdx.x; item < 256; item += gridDim.x) {
        const int bh = item >> 2, vq = item & 3, h = bh & 31;
        bf16x8 Sb[2];
#pragma unroll
        for (int ks = 0; ks < 2; ++ks)
#pragma unroll
            for (int i = 0; i < 8; ++i) Sb[ks][i] = 0;
        bf16x8 gA[4][2]; u32x2 hF[4];
        auto load = [&](int step, bf16x8 (&ga)[4][2], u32x2 (&hf)[4]) {
            const int u = (step == 0) ? (4096 + h) : (bh * 64 + step - 1);
            const bf16_t* g = Gp + (size_t)u * 4096; const bf16_t* hh = H0t + (size_t)u * 4096;
#pragma unroll
            for (int mt = 0; mt < 4; ++mt) {
#pragma unroll
                for (int ks = 0; ks < 2; ++ks) ga[mt][ks] = *(const bf16x8*)(g + (16 * mt + fr) * 64 + ks * 32 + fq * 8);
                hf[mt] = *(const u32x2*)(hh + (16 * vq + fr) * 64 + 16 * mt + 4 * fq);
            }
        };
        load(0, gA, hF);
        for (int step = 0; step < 64; ++step) {
            bf16x8 gN[4][2]; u32x2 hN[4];
            if (step + 1 < 64) load(step + 1, gN, hN);
            f32x4 acc[4];
#pragma unroll
            for (int mt = 0; mt < 4; ++mt) {
                acc[mt] = (f32x4){bflo(hF[mt].x), bfhi(hF[mt].x), bflo(hF[mt].y), bfhi(hF[mt].y)};
                acc[mt] = mfma16(gA[mt][0], Sb[0], acc[mt]);
                acc[mt] = mfma16(gA[mt][1], Sb[1], acc[mt]);
            }
            bf16_t* so = S0t + (size_t)(bh * 64 + step) * 4096 + (16 * vq + fr) * 64 + 4 * fq;
            u32x2 w[4];
#pragma unroll
            for (int mt = 0; mt < 4; ++mt) { w[mt].x = pk2(acc[mt].x, acc[mt].y); w[mt].y = pk2(acc[mt].z, acc[mt].w); *(u32x2*)(so + 16 * mt) = w[mt]; }
#pragma unroll
            for (int ks = 0; ks < 2; ++ks) {
                const u32x4 q = (u32x4){w[2 * ks].x, w[2 * ks].y, w[2 * ks + 1].x, w[2 * ks + 1].y};
                Sb[ks] = __builtin_bit_cast(bf16x8, q);
            }
            if (step + 1 < 64) {
#pragma unroll
                for (int mt = 0; mt < 4; ++mt) { gA[mt][0] = gN[mt][0]; gA[mt][1] = gN[mt][1]; hF[mt] = hN[mt]; }
            }
        }
    }
}

constexpr int LDG = 264;
__device__ __forceinline__ void phase3b(const Params& P, ldsp lds) {
    const int tid = threadIdx.x, lane = tid & 63, wave = tid >> 6, fr = lane & 15, fq = lane >> 4, wq = wave & 3;
    unsigned char* ws = P.ws;
    const bf16_t* pp = (const bf16_t*)(ws + WS_P);
    const float* mu = P.in[I_MU];
    ldsp gl = lds + wave * (16 * LDG * 2);
    for (int pair = blockIdx.x; pair < 2048; pair += gridDim.x) {
        const int u = pair * 2 + (wave >> 2), bh = u >> 6, c = u & 63, b = bh >> 5, h = bh & 31;
        const int trow0 = b * SEQ + c * 64 + 16 * wq;
#pragma unroll
        for (int it = 0; it < 8; ++it) {
            const int idx = it * 64 + lane, tl = idx >> 5, ch = idx & 31, col = C_GL + ch * 8;
            const int row = trow0 + tl; const int prow = (c == 0 && wq == 0 && tl == 0) ? (ROW_META + 15) : row - 1;
            float x[8]; shift8(pp + (size_t)row * NPAD + col, pp + (size_t)prow * NPAD + col, mu + col, x);
#pragma unroll
            for (int i = 0; i < 8; ++i) x[i] = sigmoidf_(x[i]);
            *(LAS u32x4*)(gl + (tl * LDG + ch * 8) * 2) = pack8(x);
        }
        BLOCK_SYNC();
        f32x4 gacc[4];
#pragma unroll
        for (int mt = 0; mt < 4; ++mt) gacc[mt] = (f32x4){0.f, 0.f, 0.f, 0.f};
        {
            const bf16_t* wg = (const bf16_t*)(ws + WS_WTG2) + (size_t)(h * 64 + fr) * 256 + fq * 8;
#pragma unroll 2
            for (int ks = 0; ks < 8; ++ks) {
                const bf16x8 bf = *(const LAS bf16x8*)(gl + (fr * LDG + ks * 32 + fq * 8) * 2);
#pragma unroll
                for (int mt = 0; mt < 4; ++mt) gacc[mt] = mfma16(*(const bf16x8*)(wg + (size_t)(16 * mt) * 256 + ks * 32), bf, gacc[mt]);
            }
        }
        f32x4 y[4];
        {
            const size_t ub = (size_t)u * 4096;
            const bf16_t* S0t = (const bf16_t*)(ws + WS_S0T) + ub; const bf16_t* Rt = (const bf16_t*)(ws + WS_RT) + ub; const bf16_t* Y0s = (const bf16_t*)(ws + WS_Y0) + ub;
            bf16x8 bR[2];
#pragma unroll
            for (int ks = 0; ks < 2; ++ks) bR[ks] = *(const bf16x8*)(Rt + (16 * wq + fr) * 64 + ks * 32 + fq * 8);
#pragma unroll
            for (int mt = 0; mt < 4; ++mt) {
                const u32x2 yw = *(const u32x2*)(Y0s + (16 * wq + fr) * 64 + 16 * mt + 4 * fq);
                y[mt] = (f32x4){bflo(yw.x), bfhi(yw.x), bflo(yw.y), bfhi(yw.y)};
#pragma unroll
                for (int ks = 0; ks < 2; ++ks) y[mt] = mfma16(*(const bf16x8*)(S0t + (16 * mt + fr) * 64 + ks * 32 + fq * 8), bR[ks], y[mt]);
            }
        }
        float s = 0.f;
#pragma unroll
        for (int mt = 0; mt < 4; ++mt) s += (y[mt].x + y[mt].y) + (y[mt].z + y[mt].w);
        s += __shfl_xor(s, 16); s += __shfl_xor(s, 32);
        const float mean = s * (1.0f / 64.0f); float q = 0.f;
#pragma unroll
        for (int mt = 0; mt < 4; ++mt) { y[mt] = y[mt] - mean; q += (y[mt].x * y[mt].x + y[mt].y * y[mt].y) + (y[mt].z * y[mt].z + y[mt].w * y[mt].w); }
        q += __shfl_xor(q, 16); q += __shfl_xor(q, 32);
        const float rstd = 1.0f / sqrtf(q * (1.0f / 64.0f) + GN_EPS);
        const int row = trow0 + fr; const int prow = (c == 0 && wq == 0 && fr == 0) ? (ROW_META + 15) : row - 1;
        const float bon = ((const float*)(ws + WS_BONUS))[(size_t)row * 32 + h];
        bf16_t* ya = (bf16_t*)(ws + WS_YA) + (size_t)row * D + h * 64;
#pragma unroll
        for (int mt = 0; mt < 4; ++mt) {
            const int i0 = 16 * mt + 4 * fq, hc = h * 64 + i0;
            const f32x4 gg = *(const f32x4*)(P.in[I_GNG] + hc), gb = *(const f32x4*)(P.in[I_GNB] + hc), mv = *(const f32x4*)(mu + C_V + hc);
            const u32x2 vc = *(const u32x2*)(pp + (size_t)row * NPAD + C_V + hc), vp = *(const u32x2*)(pp + (size_t)prow * NPAD + C_V + hc);
            f32x4 cv = (f32x4){bflo(vc.x), bfhi(vc.x), bflo(vc.y), bfhi(vc.y)}, pv = (f32x4){bflo(vp.x), bfhi(vp.x), bflo(vp.y), bfhi(vp.y)};
            const f32x4 v = cv + (pv - cv) * mv;
            const f32x4 o = (y[mt] * rstd * gg + gb + v * bon) * gacc[mt];
            u32x2 w; w.x = pk2(o.x, o.y); w.y = pk2(o.z, o.w);
            *(u32x2*)(ya + i0) = w;
        }
        BLOCK_SYNC();
    }
}
__device__ __forceinline__ void phase5b(const Params& P) {
    const int lane = threadIdx.x & 63, wave = threadIdx.x >> 6;
    const int gw = blockIdx.x * 8 + wave, NGW = gridDim.x * 8;
    unsigned char* ws = P.ws;
    for (int r = gw; r < NTOK; r += NGW)
        ln_row_bf16((const float*)(ws + WS_X1) + (size_t)r * D, P.in[I_LN1G], P.in[I_LN1B], (bf16_t*)(ws + WS_H1B) + (size_t)r * D, lane);
    for (int r = gw; r < 32768; r += NGW) {
        const float* src = (r < 16384 ? P.in[I_UT] : P.in[I_VT]) + (size_t)(r & 16383) * D;
        bf16_t* dst = (bf16_t*)(ws + (r < 16384 ? WS_UB : WS_VB)) + (size_t)(r & 16383) * D;
        f32x4 v[8];
#pragma unroll
        for (int j = 0; j < 8; ++j) v[j] = ((const f32x4*)src)[lane + 64 * j];
#pragma unroll
        for (int j = 0; j < 8; ++j) { u32x2 w; w.x = pk2(v[j].x, v[j].y); w.y = pk2(v[j].z, v[j].w); ((u32x2*)dst)[lane + 64 * j] = w; }
    }
}

__device__ __forceinline__ void phase7(const Params& P, ldsp lds) {
    const int tid = threadIdx.x, lane = tid & 63, wave = tid >> 6, fr = lane & 15, fq = lane >> 4;
    unsigned char* ws = P.ws;
    const bf16_t* qb = (const bf16_t*)(ws + WS_Q); const bf16_t* sk = (const bf16_t*)(ws + WS_SUBK);
    int* eout = (int*)(ws + WS_EXP); float* gout = (float*)(ws + WS_GATE);
    constexpr int O_SC = 0, O_SV = 64 * 132 * 4, O_SI = O_SV + 64 * 16 * 4;
    const float NEG = -3.0e38f;
    for (int tile = blockIdx.x; tile < 256; tile += gridDim.x) {
        const int tok0 = tile * 32;
        for (int h = 0; h < 8; ++h) {
            {
                f32x4 acc[2][2];
#pragma unroll
                for (int p = 0; p < 2; ++p)
#pragma unroll
                    for (int nt = 0; nt < 2; ++nt) acc[p][nt] = (f32x4){0.f, 0.f, 0.f, 0.f};
#pragma unroll
                for (int ks = 0; ks < 4; ++ks) {
#pragma unroll
                    for (int p = 0; p < 2; ++p) {
                        const bf16x8 a = *(const bf16x8*)(sk + (size_t)(p * 128 + 16 * wave + fr) * 128 + ks * 32 + fq * 8);
#pragma unroll
                        for (int nt = 0; nt < 2; ++nt) {
                            const bf16x8 bq = *(const bf16x8*)(qb + (size_t)(tok0 + 16 * nt + fr) * D + h * 256 + p * 128 + ks * 32 + fq * 8);
                            acc[p][nt] = mfma16(a, bq, acc[p][nt]);
                        }
                    }
                }
#pragma unroll
                for (int p = 0; p < 2; ++p)
#pragma unroll
                    for (int nt = 0; nt < 2; ++nt) *(LAS f32x4*)(lds + O_SC + (((16 * nt + fr) * 2 + p) * 132 + 16 * wave + 4 * fq) * 4) = acc[p][nt];
            }
            BLOCK_SYNC();
            {
                const int row = tid >> 3, sub = tid & 7;
                float v[16];
#pragma unroll
                for (int c4 = 0; c4 < 4; ++c4) { const f32x4 x = *(const LAS f32x4*)(lds + O_SC + (row * 132 + sub * 16 + c4 * 4) * 4); v[4 * c4] = x.x; v[4 * c4 + 1] = x.y; v[4 * c4 + 2] = x.z; v[4 * c4 + 3] = x.w; }
                float rv0 = 0.f, rv1 = 0.f; int ri0 = 0, ri1 = 0;
                for (int round = 0; round < 16; ++round) {
                    float bv = v[0]; int bi = 0;
#pragma unroll
                    for (int i = 1; i < 16; ++i) { const bool gt = v[i] > bv; bv = gt ? v[i] : bv; bi = gt ? i : bi; }
                    int gi = sub * 16 + bi;
#pragma unroll
                    for (int o = 1; o < 8; o <<= 1) { const float ov = __shfl_xor(bv, o); const int oi = __shfl_xor(gi, o); const bool tk = (ov > bv) || (ov == bv && oi < gi); bv = tk ? ov : bv; gi = tk ? oi : gi; }
                    if ((round & 7) == sub) { if (round < 8) { rv0 = bv; ri0 = gi; } else { rv1 = bv; ri1 = gi; } }
                    const int li = ((gi >> 4) == sub) ? (gi & 15) : -1;
#pragma unroll
                    for (int i = 0; i < 16; ++i) v[i] = (i == li) ? NEG : v[i];
                }
                *(LAS float*)(lds + O_SV + (row * 16 + sub) * 4) = rv0; *(LAS float*)(lds + O_SV + (row * 16 + sub + 8) * 4) = rv1;
                *(LAS int*)(lds + O_SI + (row * 16 + sub) * 4) = ri0; *(LAS int*)(lds + O_SI + (row * 16 + sub + 8) * 4) = ri1;
            }
            BLOCK_SYNC();
            {
                const int tok = tid >> 4, a = tid & 15;
                const float s0 = *(const LAS float*)(lds + O_SV + ((tok * 2 + 0) * 16 + a) * 4); const int i0 = *(const LAS int*)(lds + O_SI + ((tok * 2 + 0) * 16 + a) * 4);
                float cnd[16]; int i1[16];
#pragma unroll
                for (int c4 = 0; c4 < 4; ++c4) {
                    const f32x4 x = *(const LAS f32x4*)(lds + O_SV + ((tok * 2 + 1) * 16 + c4 * 4) * 4);
                    cnd[4 * c4] = s0 + x.x; cnd[4 * c4 + 1] = s0 + x.y; cnd[4 * c4 + 2] = s0 + x.z; cnd[4 * c4 + 3] = s0 + x.w;
#pragma unroll
                    for (int i = 0; i < 4; ++i) i1[4 * c4 + i] = *(const LAS int*)(lds + O_SI + ((tok * 2 + 1) * 16 + c4 * 4 + i) * 4);
                }
                float myv = 0.f; int mye = 0;
                for (int round = 0; round < 16; ++round) {
                    float bv = cnd[0]; int bi = 0, be = i1[0];
#pragma unroll
                    for (int i = 1; i < 16; ++i) { const bool gt = cnd[i] > bv; bv = gt ? cnd[i] : bv; bi = gt ? i : bi; be = gt ? i1[i] : be; }
                    int gi = a * 16 + bi, ge = i0 * 128 + be;
#pragma unroll
                    for (int o = 1; o < 16; o <<= 1) { const float ov = __shfl_xor(bv, o); const int oi = __shfl_xor(gi, o), oe = __shfl_xor(ge, o); const bool tk = (ov > bv) || (ov == bv && oi < gi); bv = tk ? ov : bv; gi = tk ? oi : gi; ge = tk ? oe : ge; }
                    if (round == a) { myv = bv; mye = ge; }
                    const int li = ((gi >> 4) == a) ? (gi & 15) : -1;
#pragma unroll
                    for (int i = 0; i < 16; ++i) cnd[i] = (i == li) ? NEG : cnd[i];
                }
                float mx = myv;
#pragma unroll
                for (int o = 1; o < 16; o <<= 1) mx = fmaxf(mx, __shfl_xor(mx, o));
                const float ex = __expf(myv - mx); float sm = ex;
#pragma unroll
                for (int o = 1; o < 16; o <<= 1) sm += __shfl_xor(sm, o);
                eout[(size_t)(tok0 + tok) * 128 + h * 16 + a] = mye;
                gout[(size_t)(tok0 + tok) * 128 + h * 16 + a] = ex / sm;
            }
            BLOCK_SYNC();
        }
    }
}
__device__ __forceinline__ float gelu_exact(float x) { return 0.5f * x * (1.0f + erff(x * 0.70710678118654752f)); }
__device__ __forceinline__ float dot8(const u32x4 w, const float* x) {
    return (bflo(w.x) * x[0] + bfhi(w.x) * x[1]) + (bflo(w.y) * x[2] + bfhi(w.y) * x[3]) + (bflo(w.z) * x[4] + bfhi(w.z) * x[5]) + (bflo(w.w) * x[6] + bfhi(w.w) * x[7]);
}
__device__ __forceinline__ void axpy8(const u32x4 w, float a, float* o) {
    o[0] += a * bflo(w.x); o[1] += a * bfhi(w.x); o[2] += a * bflo(w.y); o[3] += a * bfhi(w.y); o[4] += a * bflo(w.z); o[5] += a * bfhi(w.z); o[6] += a * bflo(w.w); o[7] += a * bfhi(w.w);
}
__device__ __forceinline__ void phase8(const Params& P) {
    const int lane = threadIdx.x & 63, wave = threadIdx.x >> 6;
    const int gw = blockIdx.x * 8 + wave, NGW = gridDim.x * 8;
    unsigned char* ws = P.ws;
    const bf16_t* Ub = (const bf16_t*)(ws + WS_UB); const bf16_t* Vb = (const bf16_t*)(ws + WS_VB);
    const int* eidx = (const int*)(ws + WS_EXP); const float* gts = (const float*)(ws + WS_GATE);
    for (int tok = gw; tok < NTOK; tok += NGW) {
        float x[32], o[32];
        {
            const bf16_t* hr = (const bf16_t*)(ws + WS_H1B) + (size_t)tok * D + lane * 8;
#pragma unroll
            for (int i = 0; i < 4; ++i) unpack8(*(const u32x4*)(hr + 512 * i), x + 8 * i);
#pragma unroll
            for (int i = 0; i < 32; ++i) o[i] = 0.f;
        }
        const int e_lo = eidx[(size_t)tok * 128 + lane], e_hi = eidx[(size_t)tok * 128 + 64 + lane];
        const float g_lo = gts[(size_t)tok * 128 + lane], g_hi = gts[(size_t)tok * 128 + 64 + lane];
        u32x4 ua[4], va[4], ub[4], vb[4];
        auto issue = [&](int k, u32x4 (&uu)[4], u32x4 (&vv)[4]) {
            const int e = __shfl(k < 64 ? e_lo : e_hi, k & 63);
            const bf16_t* up = Ub + (size_t)e * D + lane * 8; const bf16_t* vp = Vb + (size_t)e * D + lane * 8;
#pragma unroll
            for (int i = 0; i < 4; ++i) { uu[i] = *(const u32x4*)(up + 512 * i); vv[i] = *(const u32x4*)(vp + 512 * i); }
        };
        auto consume = [&](int k, const u32x4 (&uu)[4], const u32x4 (&vv)[4]) {
            float d = 0.f;
#pragma unroll
            for (int i = 0; i < 4; ++i) d += dot8(uu[i], x + 8 * i);
            d = wave_sum(d);
            const float a = gelu_exact(d) * __shfl(k < 64 ? g_lo : g_hi, k & 63);
#pragma unroll
            for (int i = 0; i < 4; ++i) axpy8(vv[i], a, o + 8 * i);
        };
        issue(0, ua, va);
        for (int k = 0; k < 128; k += 2) {
            issue(k + 1, ub, vb);
            consume(k, ua, va);
            if (k + 2 < 128) issue(k + 2, ua, va);
            consume(k + 1, ub, vb);
        }
        float s = 0.f;
#pragma unroll
        for (int i = 0; i < 32; ++i) { o[i] += DN_ALPHA * x[i]; s += o[i]; }
        const float mean = wave_sum(s) * (1.0f / D); float q = 0.f;
#pragma unroll
        for (int i = 0; i < 32; ++i) { o[i] -= mean; q += o[i] * o[i]; }
        const float rstd = 1.0f / sqrtf(wave_sum(q) * (1.0f / D) + LN_EPS);
        float* orow = P.out + (size_t)tok * D + lane * 8;
#pragma unroll
        for (int i = 0; i < 4; ++i) {
            const float* gp = P.in[I_LN2G] + 512 * i + lane * 8; const float* bp = P.in[I_LN2B] + 512 * i + lane * 8;
            const f32x4 g0 = *(const f32x4*)gp, g1 = *(const f32x4*)(gp + 4), b0 = *(const f32x4*)bp, b1 = *(const f32x4*)(bp + 4);
            f32x4 r0, r1;
            r0.x = o[8 * i + 0] * rstd * g0.x + b0.x; r0.y = o[8 * i + 1] * rstd * g0.y + b0.y; r0.z = o[8 * i + 2] * rstd * g0.z + b0.z; r0.w = o[8 * i + 3] * rstd * g0.w + b0.w;
            r1.x = o[8 * i + 4] * rstd * g1.x + b1.x; r1.y = o[8 * i + 5] * rstd * g1.y + b1.y; r1.z = o[8 * i + 6] * rstd * g1.z + b1.z; r1.w = o[8 * i + 7] * rstd * g1.w + b1.w;
            *(f32x4*)(orow + 512 * i) = r0; *(f32x4*)(orow + 512 * i + 4) = r1;
        }
    }
}
#ifndef MK_MULTI
#define MK_MULTI 0
#endif
__global__ __launch_bounds__(512, 2) void hybrid_fwd(Params P) {
    extern __shared__ __attribute__((aligned(16))) unsigned char shm[];
    ldsp lds = (ldsp)shm;
    cg::grid_group grid = cg::this_grid();
    unsigned char* ws = P.ws;
    volatile LAS unsigned* xst = (volatile LAS unsigned*)(lds + LDS_BYTES - 16);
    if (threadIdx.x == 0) { xst[0] = 0u; xst[1] = 0u; }
    __syncthreads();
    const XcdBarrier xbar = xcd_barrier_post((unsigned*)(ws + WS_BAR), xst);
    const int lo = P.ph_lo, hi = P.ph_hi;
#ifdef DBG_TA
    unsigned long long ts0 = 0, ts1 = 0, ts2 = 0, ts3 = 0, ts4 = 0, ts5 = 0, ts6 = 0, ts7 = 0, ts8 = 0, ts9 = 0, ts10 = 0, ts11 = 0;
#define STAMP(k) ts##k = __builtin_amdgcn_s_memrealtime()
#else
#define STAMP(k) do { } while (0)
#endif
    STAMP(0);
#define PHASE(k) if (lo <= (k) && (k) < hi)
#define SEAM(k) do { if (lo <= (k) && (k) + 1 < hi) { if ((k) == 0) { asm volatile("s_waitcnt vmcnt(0) lgkmcnt(0)" ::: "memory"); __syncthreads(); grid.sync(); } xcd_barrier(xbar); } } while (0)
    PHASE(0) phase0(P);
    SEAM(0); STAMP(1);
    PHASE(1) { pg8::EpiBf16<0> E; E.O = (bf16_t*)(ws + WS_P); E.ldc = NPAD; E.bias = nullptr; E.split_cols = 0; E.split_stride = 0;
        run_gemm(lds, (const bf16_t*)(ws + WS_H0B), (const bf16_t*)(ws + WS_WTIN), MROWS, NPAD, 2048, E); }
    SEAM(1); STAMP(2);
    PHASE(2) phase2(P, lds);
    SEAM(2); STAMP(3);
    PHASE(3) phase3(P);
    SEAM(3); STAMP(4);
    PHASE(4) phase3b(P, lds);
    SEAM(4); STAMP(5);
    PHASE(5) {
        { pg8::EpiGateA E; E.C = (float*)(ws + WS_MPART); E.p = (const bf16_t*)(ws + WS_P); E.bgate = P.in[I_BGATE];
          run_gemm(lds, (const bf16_t*)(ws + WS_YA), (const bf16_t*)(ws + WS_WTA), NTOK, 2048, 2048, E); }
        { pg8::EpiGateB E; E.C = (const float*)(ws + WS_MPART); E.O = (bf16_t*)(ws + WS_MERGED); E.p = (const bf16_t*)(ws + WS_P); E.bgate = P.in[I_BGATE];
          run_gemm(lds, (const bf16_t*)(ws + WS_YB), (const bf16_t*)(ws + WS_WTB), NTOK, 2048, 1024, E); }
    }
    SEAM(5); STAMP(6);
    PHASE(6) { pg8::EpiResid E; E.C = (float*)(ws + WS_X1); E.h0 = (const bf16_t*)(ws + WS_H0B); E.alpha = DN_ALPHA;
        run_gemm(lds, (const bf16_t*)(ws + WS_MERGED), (const bf16_t*)(ws + WS_WTOUT), NTOK, 2048, 2048, E); }
    SEAM(6); STAMP(7);
    PHASE(7) phase5b(P);
    SEAM(7); STAMP(8);
    PHASE(8) { pg8::EpiBf16<0> E; E.O = (bf16_t*)(ws + WS_Q); E.ldc = D; E.bias = nullptr; E.split_cols = 0; E.split_stride = 0;
        run_gemm(lds, (const bf16_t*)(ws + WS_H1B), (const bf16_t*)(ws + WS_WTQ), NTOK, 2048, 2048, E); }
    SEAM(8); STAMP(9);
    PHASE(9) phase7(P, lds);
    SEAM(9); STAMP(10);
    PHASE(10) phase8(P);
#ifdef DBG_TA
    {
        __threadfence_system(); asm volatile("s_waitcnt vmcnt(0) lgkmcnt(0)" ::: "memory"); __syncthreads(); grid.sync(); __threadfence_system();
        STAMP(11);
        const unsigned long long tt[12] = {ts0, ts1, ts2, ts3, ts4, ts5, ts6, ts7, ts8, ts9, ts10, ts11};
        const float ta = (float)(tt[DBG_TA + 1] - tt[DBG_TA]) * 0.01f, tb = (float)(tt[DBG_TB + 1] - tt[DBG_TB]) * 0.01f;
        if (blockIdx.x == 0) { for (int i = threadIdx.x + 1; i <= 1000000; i += 512) P.out[i] = tb; if (threadIdx.x == 0) P.out[0] = 1000.0f * ta; }
    }
#endif
#ifdef DBG_STOP
    {
        __threadfence_system(); asm volatile("s_waitcnt vmcnt(0) lgkmcnt(0)" ::: "memory"); __syncthreads(); grid.sync(); __threadfence_system();
        const size_t a = DBG_A, b = DBG_B; const unsigned* w = (const unsigned*)(ws + a); const size_t nw = (b - a) / 4, NO = (size_t)NTOK * D;
        for (size_t i = (size_t)blockIdx.x * 512 + threadIdx.x; i < NO; i += (size_t)gridDim.x * 512) {
            unsigned acc = 0; for (size_t j = i; j < nw; j += NO) { const unsigned x = w[j]; acc += (x & 0xffffu) + (x >> 16); }
            P.out[i] = (float)(acc & 0xfffffu);
        }
    }
#endif
#undef PHASE
#undef SEAM
}

extern "C" void kernel_launch(void* const* d_in, const int* in_sizes, int n_in, void* d_out, int out_size, void* d_ws, size_t ws_size, hipStream_t stream) {
    static int grid = 0;
    if (grid == 0) {
        if (n_in != 30 || out_size != NTOK * D || ws_size < WS_END) { fprintf(stderr, "kernel_launch: unexpected shapes (n_in %d, out %d, ws %zu < %zu)\n", n_in, out_size, ws_size, (size_t)WS_END); grid = -1; return; }
        int dev = 0, cus = 0, per_cu = 0;
        if (hipGetDevice(&dev) != hipSuccess || hipDeviceGetAttribute(&cus, hipDeviceAttributeMultiprocessorCount, dev) != hipSuccess) { grid = -1; return; }
        if (hipFuncSetAttribute((const void*)hybrid_fwd, hipFuncAttributeMaxDynamicSharedMemorySize, LDS_BYTES) != hipSuccess) { fprintf(stderr, "kernel_launch: hipFuncSetAttribute failed\n"); grid = -1; return; }
        if (hipOccupancyMaxActiveBlocksPerMultiprocessor(&per_cu, (const void*)hybrid_fwd, 512, LDS_BYTES) != hipSuccess || per_cu < 1) { fprintf(stderr, "kernel_launch: occupancy query says %d\n", per_cu); grid = -1; return; }
        (void)hipGetLastError();
        grid = cus;
    }
    if (grid < 0) return;
    if (hipMemsetAsync((unsigned char*)d_ws + WS_BAR, 0, XCD_BAR_WORDS * 4, stream) != hipSuccess) { fprintf(stderr, "kernel_launch: memset failed\n"); return; }
    Params p{};
    for (int i = 0; i < 30; ++i) p.in[i] = (const float*)d_in[i];
    p.out = (float*)d_out; p.ws = (unsigned char*)d_ws;
#if MK_MULTI
    for (int ph = 0; ph <= NPHASE; ++ph) { p.ph_lo = ph; p.ph_hi = ph + 1; hipLaunchKernelGGL(hybrid_fwd, dim3(grid), dim3(512), LDS_BYTES, stream, p); }
#else
    p.ph_lo = 0; p.ph_hi = NPHASE + 1;
#ifdef DBG_STOP
    p.ph_hi = DBG_STOP + 1;
#endif
    void* args[] = {&p};
    hipError_t e = hipLaunchCooperativeKernel((const void*)hybrid_fwd, dim3(grid), dim3(512), args, LDS_BYTES, stream);
    if (e != hipSuccess) fprintf(stderr, "kernel_launch: cooperative launch failed: %s (grid %d)\n", hipGetErrorString(e), grid);
#endif
}
```

```cpp
#include <hip/hip_runtime.h>
#include <hip/hip_cooperative_groups.h>
#include <cstdio>
#include <cstdint>
namespace cg = cooperative_groups;
namespace pg8 {
#define PG8_LAS __attribute__((address_space(3)))
typedef unsigned short bf16_t;
typedef short bf16x8 __attribute__((ext_vector_type(8)));
typedef float f32x4 __attribute__((ext_vector_type(4)));
typedef unsigned u32x4 __attribute__((ext_vector_type(4)));
constexpr int BM = 256, BK = 64, HALF = 128, HTB = HALF * BK * 2  , STAGE_BYTES = 8 * HTB, NXCD = 8, WGM = 8;

__host__ __device__ __forceinline__ int lds_byte(int r, int c) { const int st = (r >> 4) * 2 + (c >> 5), rr = r & 15, cc = c & 31, ob = rr * 64 + cc * 2; return st * 1024 + (ob ^ (((ob >> 9) & 1) << 5)); }
__host__ __device__ __forceinline__ void stage_rc(int b, int& R, int& C) { const int st = b / 1024, sb = b % 1024, swz = sb ^ (((sb >> 9) & 1) << 5); R = (st >> 1) * 16 + swz / 64; C = (st & 1) * 32 + (swz % 64) / 2; }
__host__ __device__ __forceinline__ int perm32(int rho) { const int n = rho >> 4, i = rho & 15; return 8 * (i >> 2) + 4 * n + (i & 3); }

struct Unit { int pm, pn; };
struct Gemm { const bf16_t* A; const bf16_t* Bt; int M, N, K; };

struct StaticOrder {
    int nM, nN, nwg, G, c;
    __host__ __device__ void init(int M, int N, int G_, int c_) { nM = M / BM; nN = N / BM; nwg = nM * nN; G = G_; c = c_; }
    __host__ __device__ bool next(int i, Unit& u) const {
        const long L = (long)i * G + c; if (L >= nwg) return false;
        int wgid = (int)L; { const int q = nwg / NXCD, r = nwg % NXCD, xcd = wgid % NXCD, off = wgid / NXCD; wgid = (xcd < r ? xcd * (q + 1) : r * (q + 1) + (xcd - r) * q) + off; }
        const int nig = WGM * nN, gid = wgid / nig, fm = gid * WGM, gsz = (nM - fm) < WGM ? (nM - fm) : WGM;
        u.pm = fm + ((wgid % nig) % gsz); u.pn = (wgid % nig) / gsz; return true;
    }
    __device__ __forceinline__ void a_ready(const Unit&) const {}
    __device__ __forceinline__ void done(const Unit&) const {}
};
struct CountedOrder : StaticOrder {
    const unsigned* ready; unsigned need; unsigned* tmo;
    __device__ __forceinline__ void a_ready(const Unit& u) const {
        if (threadIdx.x < 64) {
            const unsigned long long t0 = __builtin_amdgcn_s_memrealtime(); unsigned polls = 0;
            while ((unsigned)__builtin_amdgcn_readfirstlane(__hip_atomic_load(ready + 64 * u.pm, __ATOMIC_RELAXED, __HIP_MEMORY_SCOPE_AGENT)) < need) {
                if ((++polls & 255u) == 0u && __builtin_amdgcn_readfirstlane(__hip_atomic_load(tmo, __ATOMIC_RELAXED, __HIP_MEMORY_SCOPE_AGENT)) != 0u) break;
                if (__builtin_amdgcn_s_memrealtime() - t0 > 2000000ull) {
                    if (threadIdx.x == 0) { unsigned expect = 0u; __hip_atomic_compare_exchange_strong(tmo + 1, &expect, 0x600u | (unsigned)(u.pm & 0xff), __ATOMIC_RELAXED, __ATOMIC_RELAXED, __HIP_MEMORY_SCOPE_AGENT); __hip_atomic_store(tmo, 1u, __ATOMIC_RELAXED, __HIP_MEMORY_SCOPE_AGENT); }
                    break; }
                __builtin_amdgcn_s_sleep(2); }
            __builtin_amdgcn_fence(__ATOMIC_ACQUIRE, "agent");
            asm volatile("s_waitcnt vmcnt(0)" ::: "memory");
        }
#if !defined(BROKEN_HOOK_NO_BARRIER)
        asm volatile("" ::: "memory"); __builtin_amdgcn_s_barrier(); asm volatile("" ::: "memory");
#endif
    }
};

typedef float cvt_f32x2 __attribute__((ext_vector_type(2))); typedef __bf16 cvt_bf16x2 __attribute__((ext_vector_type(2)));
__device__ __forceinline__ unsigned cvt_pk_bf16(float lo, float hi) { const cvt_f32x2 v = {lo, hi}; const cvt_bf16x2 b = __builtin_convertvector(v, cvt_bf16x2); return __builtin_bit_cast(unsigned, b); }
typedef float f32x2 __attribute__((ext_vector_type(2)));
__device__ __forceinline__ f32x2 gelu_pk(f32x2 v) {
    const f32x2 av = __builtin_elementwise_abs(v), d = av * 0.2316418882f + 1.0f;
    f32x2 t; t.x = __builtin_amdgcn_rcpf(d.x); t.y = __builtin_amdgcn_rcpf(d.y);
    f32x2 q = t * 0.5307027145f + (-0.7265760135f); q = q * t + 0.7107068705f; q = q * t + (-0.142248368f); q = q * t + 0.127414796f; q = q * t;
    const f32x2 s = (v * v) * (-0.72134752044f);
    f32x2 e; e.x = __builtin_amdgcn_exp2f(s.x); e.y = __builtin_amdgcn_exp2f(s.y);
    const f32x2 m = v * (q * e), r = v - m;
    f32x2 o; o.x = v.x < 0.f ? m.x : r.x; o.y = v.y < 0.f ? m.y : r.y; return o;
}

struct EpiF32 {
    static constexpr bool PERM = false, AFTER_DRAIN = false;
    float* C; int ldc; const float* bias;
    __device__ __forceinline__ void operator()(const f32x4 (&acc)[2][2][4][2], const Unit& u, int wr, int wc, int fr, int fq) const {
        const int row0 = u.pm * BM + wr * 64 + fr, col0 = u.pn * BM + wc * 32 + 4 * fq;
        f32x4 bv[2][2];
#pragma unroll
        for (int bj = 0; bj < 2; ++bj)
#pragma unroll
            for (int n = 0; n < 2; ++n) bv[bj][n] = bias ? *(const f32x4*)(bias + col0 + bj * HALF + n * 16) : (f32x4){0.f, 0.f, 0.f, 0.f};
#pragma unroll
        for (int ai = 0; ai < 2; ++ai)
#pragma unroll
            for (int m = 0; m < 4; ++m) { float* rowp = C + (size_t)(row0 + ai * HALF + m * 16) * ldc + col0;
#pragma unroll
                for (int bj = 0; bj < 2; ++bj)
#pragma unroll
                    for (int n = 0; n < 2; ++n) *(f32x4*)(rowp + bj * HALF + n * 16) = acc[ai][bj][m][n] + bv[bj][n]; }
    }
};
template <int ACT  > struct EpiBf16 {
    static constexpr bool PERM = true, AFTER_DRAIN = false;
    bf16_t* O; int ldc; const float* bias; int split_cols; size_t split_stride;
    __device__ __forceinline__ void operator()(const f32x4 (&acc)[2][2][4][2], const Unit& u, int wr, int wc, int fr, int fq) const {
        const int row0 = u.pm * BM + wr * 64 + fr; int colt = u.pn * BM; bf16_t* base = O;
        if (split_cols) { const int t = colt / split_cols; base += (size_t)t * split_stride; colt -= t * split_cols; }
        const int col0 = colt + wc * 32 + 8 * fq, bcol0 = u.pn * BM + wc * 32 + 8 * fq;
        f32x4 bv[2][2];
#pragma unroll
        for (int bj = 0; bj < 2; ++bj)
#pragma unroll
            for (int n = 0; n < 2; ++n) bv[bj][n] = bias ? *(const f32x4*)(bias + bcol0 + bj * HALF + 4 * n) : (f32x4){0.f, 0.f, 0.f, 0.f};
#pragma unroll
        for (int ai = 0; ai < 2; ++ai)
#pragma unroll
            for (int m = 0; m < 4; ++m) { bf16_t* rowp = base + (size_t)(row0 + ai * HALF + m * 16) * ldc + col0;
#pragma unroll
                for (int bj = 0; bj < 2; ++bj) { f32x4 v0 = acc[ai][bj][m][0] + bv[bj][0], v1 = acc[ai][bj][m][1] + bv[bj][1];
                    if (ACT == 1) { f32x2 a = gelu_pk((f32x2){v0[0], v0[1]}), b = gelu_pk((f32x2){v0[2], v0[3]}), c = gelu_pk((f32x2){v1[0], v1[1]}), d = gelu_pk((f32x2){v1[2], v1[3]});
                        v0 = (f32x4){a.x, a.y, b.x, b.y}; v1 = (f32x4){c.x, c.y, d.x, d.y}; }
                    if (ACT == 2) {
#pragma unroll
                        for (int j = 0; j < 4; ++j) { v0[j] = 0.5f * v0[j] * (1.0f + erff(v0[j] * 0.70710678f)); v1[j] = 0.5f * v1[j] * (1.0f + erff(v1[j] * 0.70710678f)); } }
                    u32x4 w; w.x = cvt_pk_bf16(v0[0], v0[1]); w.y = cvt_pk_bf16(v0[2], v0[3]); w.z = cvt_pk_bf16(v1[0], v1[1]); w.w = cvt_pk_bf16(v1[2], v1[3]);
                    *(u32x4*)(rowp + bj * HALF) = w; } }
    }
};
template <class Epi, class Sched, bool STAMP = false>
__device__ __forceinline__ void gemm_phase(PG8_LAS unsigned char* lds, const Gemm g, const Sched& S, const Epi& E, unsigned long long* stamps) {
    const int tid = threadIdx.x, wid = __builtin_amdgcn_readfirstlane(tid >> 6), lane = tid & 63, wr = wid >> 2, wc = wid & 3, fr = lane & 15, fq = lane >> 4;
    const int K = g.K, nt = K / BK;
    int ts_lo = 0, ts_hi = 0, nts = 0; const unsigned long long rt_entry = STAMP ? (unsigned long long)wall_clock64() : 0ull;
#define PG8_STAMP() do { if (STAMP && wid == 0 && nts < 64) { const unsigned long long _c = (unsigned long long)clock64(); \
        ts_lo = (lane == nts) ? (int)(unsigned)_c : ts_lo; ts_hi = (lane == nts) ? (int)(unsigned)(_c >> 32) : ts_hi; ++nts; } } while (0)
    PG8_STAMP();
    unsigned voffA[2], voffB[2];
#pragma unroll
    for (int i = 0; i < 2; ++i) { int R, C; stage_rc(tid * 16 + i * 8192, R, C); const int Rb = Epi::PERM ? ((R & ~31) + perm32(R & 31)) : R;
        voffA[i] = (unsigned)(R * K + C) * 2u; voffB[i] = (unsigned)(Rb * K + C) * 2u; }
    const size_t kstep = (size_t)(BK * 2);
    const size_t hstep = (size_t)HALF * K * 2;
    const size_t tstep = 2 * hstep;
    const unsigned ldsw = (unsigned)wid * 1024u;
    const int aoff = lds_byte(wr * 64 + fr, fq * 8), boff = lds_byte(wc * 32 + fr, fq * 8);
#define PG8_SA(b, h) (((b) * 2 + (h)) * HTB)
#define PG8_SB(b, h) ((4 + (b) * 2 + (h)) * HTB)
#define PG8_STAGE(bufoff, gbase, voff) do { _Pragma("unroll") for (int _i = 0; _i < 2; ++_i) \
        __builtin_amdgcn_global_load_lds((const unsigned*)((const char*)(gbase) + (voff)[_i]), (PG8_LAS unsigned*)(lds + (bufoff) + ldsw + _i * 8192), 16, 0, 0); } while (0)
#define PG8_LDA(dst, b, h) do { _Pragma("unroll") for (int m = 0; m < 4; ++m) _Pragma("unroll") for (int k = 0; k < 2; ++k) dst[m][k] = *(const PG8_LAS bf16x8*)(lds + PG8_SA(b, h) + aoff + m * 2048 + k * 1024); } while (0)
#define PG8_LDB(dst, b, h) do { _Pragma("unroll") for (int n = 0; n < 2; ++n) _Pragma("unroll") for (int k = 0; k < 2; ++k) dst[n][k] = *(const PG8_LAS bf16x8*)(lds + PG8_SB(b, h) + boff + n * 2048 + k * 1024); } while (0)
#define PG8_MMA(ai, bj, At, Bt) do { __builtin_amdgcn_s_setprio(1); _Pragma("unroll") for (int m = 0; m < 4; ++m) _Pragma("unroll") for (int n = 0; n < 2; ++n) _Pragma("unroll") for (int k = 0; k < 2; ++k) \
        acc[ai][bj][m][n] = __builtin_amdgcn_mfma_f32_16x16x32_bf16(Bt[n][k], At[m][k], acc[ai][bj][m][n], 0, 0, 0); __builtin_amdgcn_s_setprio(0); } while (0)
#define PG8_WAIT_V(n) asm volatile("s_waitcnt vmcnt(" #n ")" ::: "memory")
#define PG8_WAIT_L(n) asm volatile("s_waitcnt lgkmcnt(" #n ")" ::: "memory")
#define PG8_BAR __builtin_amdgcn_s_barrier()
#define PG8_SCHED __builtin_amdgcn_sched_barrier(0)
    Unit cur, nxt; int ui = 0;
    if (!S.next(0, cur)) return;
    f32x4 acc[2][2][4][2];
#pragma unroll
    for (int a = 0; a < 2; ++a)
#pragma unroll
        for (int b = 0; b < 2; ++b)
#pragma unroll
            for (int m = 0; m < 4; ++m)
#pragma unroll
                for (int n = 0; n < 2; ++n) acc[a][b][m][n] = (f32x4){0.f, 0.f, 0.f, 0.f};
    bf16x8 At[4][2], B0[2][2], B1[2][2];
    const char* cA = (const char*)g.A + (size_t)cur.pm * tstep; const char* cB = (const char*)g.Bt + (size_t)cur.pn * tstep;
    S.a_ready(cur);
    PG8_STAGE(PG8_SB(0, 0), cB, voffB); PG8_STAGE(PG8_SA(0, 0), cA, voffA); PG8_STAGE(PG8_SB(0, 1), cB + hstep, voffB); PG8_STAGE(PG8_SA(0, 1), cA + hstep, voffA);
    if (wr == 1) PG8_BAR;
    PG8_WAIT_V(4); PG8_BAR;
    PG8_STAGE(PG8_SB(1, 0), cB + kstep, voffB); PG8_STAGE(PG8_SA(1, 0), cA + kstep, voffA); PG8_STAGE(PG8_SB(1, 1), cB + hstep + kstep, voffB);
    PG8_WAIT_V(6); PG8_BAR;
    PG8_STAMP();
    for (;;) {
        const bool has_next = S.next(ui + 1, nxt);
        const char* nA = has_next ? (const char*)g.A + (size_t)nxt.pm * tstep : cA; const char* nB = has_next ? (const char*)g.Bt + (size_t)nxt.pn * tstep : cB;
        for (int t = 0; t < nt; t += 2) {
            const bool last = (t == nt - 2);
            const char* a1 = cA + (size_t)(t + 1) * kstep;
            const char* a2 = last ? nA : cA + (size_t)(t + 2) * kstep; const char* b2 = last ? nB : cB + (size_t)(t + 2) * kstep;
            const char* a3 = a2 + kstep; const char* b3 = b2 + kstep;
            if (last && has_next) S.a_ready(nxt);
            PG8_LDB(B0, 0, 0); PG8_SCHED; PG8_LDA(At, 0, 0); PG8_STAGE(PG8_SA(1, 1), a1 + hstep, voffA);
            PG8_WAIT_L(8); PG8_BAR; PG8_WAIT_L(0); PG8_MMA(0, 0, At, B0); PG8_BAR; PG8_SCHED;
            PG8_LDB(B1, 0, 1); PG8_STAGE(PG8_SB(0, 0), b2, voffB);
            PG8_BAR; PG8_WAIT_L(0); PG8_MMA(0, 1, At, B1); PG8_BAR;
            PG8_LDA(At, 0, 1); PG8_STAGE(PG8_SA(0, 0), a2, voffA);
            PG8_BAR; PG8_WAIT_L(0); PG8_MMA(1, 0, At, B0); PG8_BAR; PG8_SCHED;
            PG8_STAGE(PG8_SB(0, 1), b2 + hstep, voffB);
            PG8_WAIT_V(6); PG8_BAR; PG8_MMA(1, 1, At, B1); PG8_BAR;
            PG8_LDB(B0, 1, 0); PG8_SCHED; PG8_LDA(At, 1, 0); PG8_STAGE(PG8_SA(0, 1), a2 + hstep, voffA);
            PG8_WAIT_L(8); PG8_BAR; PG8_WAIT_L(0); PG8_MMA(0, 0, At, B0); PG8_BAR; PG8_SCHED;
            PG8_LDB(B1, 1, 1); PG8_STAGE(PG8_SB(1, 0), b3, voffB);
            PG8_BAR; PG8_WAIT_L(0); PG8_MMA(0, 1, At, B1); PG8_BAR;
            PG8_LDA(At, 1, 1); PG8_STAGE(PG8_SA(1, 0), a3, voffA);
            PG8_BAR; PG8_WAIT_L(0); PG8_MMA(1, 0, At, B0); PG8_BAR; PG8_SCHED;
            PG8_STAGE(PG8_SB(1, 1), b3 + hstep, voffB);
            PG8_WAIT_V(6); PG8_BAR; PG8_MMA(1, 1, At, B1); PG8_BAR;
        }
        PG8_STAMP();
        if constexpr (!Epi::AFTER_DRAIN) { E(acc, cur, wr, wc, fr, fq); S.done(cur); }
        PG8_STAMP();
        if (!has_next) break;
#pragma unroll
        for (int a = 0; a < 2; ++a)
#pragma unroll
            for (int b = 0; b < 2; ++b)
#pragma unroll
                for (int m = 0; m < 4; ++m)
#pragma unroll
                    for (int n = 0; n < 2; ++n) acc[a][b][m][n] = (f32x4){0.f, 0.f, 0.f, 0.f};
        cur = nxt; cA = nA; cB = nB; ++ui;
    }
    PG8_WAIT_V(0);
    if (wr == 0) PG8_BAR;
    PG8_BAR;
    if constexpr (Epi::AFTER_DRAIN) { E.fused(acc, cur, wr, wc, fr, fq, lds, wid, lane); S.done(cur); }
    PG8_STAMP();
    if (STAMP && wid == 0) { stamps[lane] = lane < nts ? (((unsigned long long)(unsigned)ts_hi << 32) | (unsigned)ts_lo) : 0ull;
        if (lane == 62) stamps[62] = rt_entry; if (lane == 63) stamps[63] = (unsigned long long)wall_clock64(); }
#undef PG8_STAMP
#undef PG8_SA
#undef PG8_SB
#undef PG8_STAGE
#undef PG8_LDA
#undef PG8_LDB
#undef PG8_MMA
#undef PG8_WAIT_V
#undef PG8_WAIT_L
#undef PG8_BAR
#undef PG8_SCHED
}
}
#define LAS __attribute__((address_space(3)))
typedef unsigned short bf16_t;
typedef short bf16x8 __attribute__((ext_vector_type(8)));
typedef float f32x4 __attribute__((ext_vector_type(4)));
typedef float f32x2 __attribute__((ext_vector_type(2)));
typedef unsigned u32x4 __attribute__((ext_vector_type(4)));
typedef unsigned u32x2 __attribute__((ext_vector_type(2)));
typedef LAS unsigned char* ldsp;

constexpr int D = 2048, NTOK = 8192, SEQ = 4096, MROWS = 8448, ROW_META = 8192;
constexpr int INC = 11712, NPAD = 11776;
constexpr int C_R = 0, C_K = 2048, C_V = 4096, C_WL = 6144, C_AL = 6240, C_GL = 6336, C_POOL = 6592, C_G0 = 7616, C_G1 = 9664;
constexpr int NUNITS = 4128;
constexpr float DSCALE = 0.6065306597126334f;
constexpr float DN_ALPHA = 1.189207115002721f;
constexpr float GN_EPS = 64e-5f, LN_EPS = 1e-5f;

constexpr size_t WS_P = 0;
constexpr size_t WS_UB = 0;
constexpr size_t WS_VB = 33554432;
constexpr size_t WS_H0B = 198967296;
constexpr size_t WS_WTA = WS_H0B + 34603008;
constexpr size_t WS_WTB = WS_WTA + 8388608;
constexpr size_t WS_WTOUT = WS_WTB + 4194304;
constexpr size_t WS_WTQ = WS_WTOUT + 8388608;
constexpr size_t WS_WTPOOL = WS_WTQ + 8388608;
constexpr size_t WS_WTW2 = WS_WTPOOL + 524288;
constexpr size_t WS_WTA2 = WS_WTW2 + 393216;
constexpr size_t WS_WTG2 = WS_WTA2 + 393216;
constexpr size_t WS_SUBK = WS_WTG2 + 1048576;
constexpr size_t WS_BONUS = WS_SUBK + 65536;
constexpr size_t WS_REGC = WS_BONUS + 1048576;
constexpr size_t WS_WTIN = WS_REGC;
constexpr size_t UNITB = (size_t)NUNITS * 4096 * 2;
constexpr size_t WS_G = WS_REGC;
constexpr size_t WS_H0T = WS_REGC + UNITB;
constexpr size_t WS_RT = WS_REGC + 2 * UNITB;
constexpr size_t WS_Y0 = WS_REGC + 3 * UNITB;
constexpr size_t WS_S0T = WS_REGC + 4 * UNITB;
constexpr size_t WS_MERGED = WS_REGC;
constexpr size_t WS_MPART = WS_REGC + 33554432;
constexpr size_t WS_X1 = WS_REGC + 33554432;
constexpr size_t WS_H1B = WS_REGC + 100663296;
constexpr size_t WS_Q = WS_REGC + 134217728;
constexpr size_t WS_YA = WS_REGC + 5 * UNITB;
constexpr size_t WS_YB = WS_YA + 33554432;
constexpr size_t WS_EXP = WS_YB + 16777216;
constexpr size_t WS_GATE = WS_EXP + 4194304;
constexpr size_t WS_BAR = WS_GATE + 4194304;
constexpr size_t WS_TSC = WS_BAR + 16384;
constexpr size_t WS_END = WS_TSC + 131072;
static_assert(WS_Q + 33554432 <= WS_YA, "overlay");
static_assert(WS_VB + 33554432 <= WS_H0B, "overlay");

constexpr int LDS_BYTES = 163840;
constexpr int NPHASE = 10;

struct Params {
    const float* in[30];
    float* out;
    unsigned char* ws;
    int ph_lo, ph_hi;
};
enum { I_X = 0, I_META, I_LNIN_G, I_LNIN_B, I_WIN, I_MU, I_W0, I_WW2, I_A0, I_WA2, I_WG2, I_KK, I_KA, I_RK, I_GNG, I_GNB, I_WPOOL, I_PSCALE, I_BGATE,
       I_WBA, I_WBB, I_WOUT, I_LN1G, I_LN1B, I_WQ, I_SUBK, I_UT, I_VT, I_LN2G, I_LN2B };

__device__ __forceinline__ unsigned pk2(float lo, float hi) { return pg8::cvt_pk_bf16(lo, hi); }
__device__ __forceinline__ float bflo(unsigned w) { return __uint_as_float(w << 16); }
__device__ __forceinline__ float bfhi(unsigned w) { return __uint_as_float(w & 0xffff0000u); }
__device__ __forceinline__ float bf1(bf16_t h) { return __uint_as_float(((unsigned)h) << 16); }
__device__ __forceinline__ bf16_t f2bf1(float f) { return (bf16_t)(pk2(f, f) & 0xffffu); }
__device__ __forceinline__ float wave_sum(float v) {
#pragma unroll
    for (int o = 1; o < 64; o <<= 1) v += __shfl_xor(v, o);
    return v;
}
__device__ __forceinline__ float sigmoidf_(float x) { return 1.0f / (1.0f + __expf(-x)); }
__device__ __forceinline__ f32x4 mfma16(bf16x8 a, bf16x8 b, f32x4 c) { return __builtin_amdgcn_mfma_f32_16x16x32_bf16(a, b, c, 0, 0, 0); }
__device__ __forceinline__ void unpack8(const u32x4 w, float* f) {
    f[0] = bflo(w.x); f[1] = bfhi(w.x); f[2] = bflo(w.y); f[3] = bfhi(w.y); f[4] = bflo(w.z); f[5] = bfhi(w.z); f[6] = bflo(w.w); f[7] = bfhi(w.w);
}
__device__ __forceinline__ u32x4 pack8(const float* f) { u32x4 w; w.x = pk2(f[0], f[1]); w.y = pk2(f[2], f[3]); w.z = pk2(f[4], f[5]); w.w = pk2(f[6], f[7]); return w; }
#define DPPF(v, ctrl) __builtin_bit_cast(float, __builtin_amdgcn_update_dpp(0, __builtin_bit_cast(int, (v)), (ctrl), 0xF, 0xF, true))
__device__ __forceinline__ float readlane_f(float v, int l) { return __builtin_bit_cast(float, __builtin_amdgcn_readlane(__builtin_bit_cast(int, v), l)); }
__device__ __forceinline__ float wave_sum_dpp(float v) {
    v += DPPF(v, 0xB1); v += DPPF(v, 0x4E); v += DPPF(v, 0x141); v += DPPF(v, 0x140);
    return (readlane_f(v, 0) + readlane_f(v, 16)) + (readlane_f(v, 32) + readlane_f(v, 48));
}
__device__ __forceinline__ float wave_max_dpp(float v) {
    v = fmaxf(v, DPPF(v, 0xB1)); v = fmaxf(v, DPPF(v, 0x4E)); v = fmaxf(v, DPPF(v, 0x141)); v = fmaxf(v, DPPF(v, 0x140));
    return fmaxf(fmaxf(readlane_f(v, 0), readlane_f(v, 16)), fmaxf(readlane_f(v, 32), readlane_f(v, 48)));
}
#define BLOCK_SYNC() __syncthreads()
#define XB_TMO      128
#define XB_XCNT(j)  (256  + 64 * (j))
#define XB_XSUB(j)  (1280 + 64 * (j))
#define XB_XGEN(j)  (2304 + 64 * (j))
#define XB_TOP      3328
#define XB_TOPGEN   3392
#define XCD_BAR_WORDS 3456
#define XB_SPIN_CAP (1u << 18)

__device__ __forceinline__ unsigned xb_ld(unsigned* p)              { return __hip_atomic_load(p, __ATOMIC_RELAXED, __HIP_MEMORY_SCOPE_AGENT); }
__device__ __forceinline__ unsigned xb_add(unsigned* p, unsigned v) { return __hip_atomic_fetch_add(p, v, __ATOMIC_RELAXED, __HIP_MEMORY_SCOPE_AGENT); }
__device__ __forceinline__ unsigned xb_xcc_id() { return (unsigned)__builtin_amdgcn_s_getreg((3 << 11) | 20) & 0xFu; }
#define XB_SPIN(cond, bar) do { unsigned _sp = 0; while (cond) { __builtin_amdgcn_s_sleep(1); \
    if ((++_sp & 255u) == 0u) { if (xb_ld(&(bar)[XB_TMO])) break; if (_sp > XB_SPIN_CAP) { atomicAdd(&(bar)[XB_TMO], 1u); break; } } } } while (0)

struct XcdBarrier {
    unsigned* bar; unsigned x;
    volatile LAS unsigned* st;
};

__device__ __forceinline__ XcdBarrier xcd_barrier_post(unsigned* bar, volatile LAS unsigned* st) {
    XcdBarrier b; b.bar = bar; b.x = xb_xcc_id(); b.st = st;
    if (threadIdx.x == 0) (void)xb_add(&bar[XB_XCNT(b.x)], 1u);
    return b;
}
__device__ __forceinline__ void xcd_barrier_complete(unsigned* bar, unsigned x, unsigned& nloc, unsigned& nx) {
    const unsigned G = gridDim.x * gridDim.y * gridDim.z;
    unsigned sum, cnt, mine, sp = 0u;
    for (;;) {
        sum = 0u; cnt = 0u; mine = 0u;
#pragma unroll
        for (unsigned j = 0; j < 16; ++j) { const unsigned c = xb_ld(&bar[XB_XCNT(j)]); sum += c; cnt += (c > 0u) ? 1u : 0u; mine = (j == x) ? c : mine; }
        if (sum == G) break;
        __builtin_amdgcn_s_sleep(1);
        if ((++sp & 255u) == 0u) { if (xb_ld(&bar[XB_TMO])) break; if (sp > XB_SPIN_CAP) { atomicAdd(&bar[XB_TMO], 1u); break; } }
    }
    nloc = mine > 0u ? mine : 1u; nx = cnt > 0u ? cnt : 1u;
}

__device__ __forceinline__ void xcd_barrier(const XcdBarrier& b) {
    asm volatile("s_waitcnt vmcnt(0)" ::: "memory");
    __syncthreads();
    if (threadIdx.x == 0) {
        unsigned* bar = b.bar;
        __builtin_amdgcn_s_waitcnt(0);
        unsigned nloc = b.st[0], nx = b.st[1];
        if (nloc == 0u) { xcd_barrier_complete(bar, b.x, nloc, nx); b.st[0] = nloc; b.st[1] = nx; }
        const unsigned old = xb_add(&bar[XB_XSUB(b.x)], 1u);
        const unsigned gen = old / nloc;
        if (old + 1u == (gen + 1u) * nloc) {
            __builtin_amdgcn_fence(__ATOMIC_RELEASE, "agent");
            asm volatile("s_waitcnt vmcnt(0)" ::: "memory");
            const unsigned og = xb_add(&bar[XB_TOP], 1u);
            const unsigned tg = og / nx;
            if (og + 1u == (tg + 1u) * nx) xb_add(&bar[XB_TOPGEN], 1u);
            else XB_SPIN(xb_ld(&bar[XB_TOPGEN]) == tg, bar);
            __builtin_amdgcn_fence(__ATOMIC_ACQUIRE, "agent");
            xb_add(&bar[XB_XGEN(b.x)], 1u);
            asm volatile("s_waitcnt vmcnt(0)" ::: "memory");
        } else {
            XB_SPIN(xb_ld(&bar[XB_XGEN(b.x)]) == gen, bar);
            __builtin_amdgcn_fence(__ATOMIC_ACQUIRE, "agent");
            asm volatile("s_waitcnt vmcnt(0)" ::: "memory");
        }
    }
    __syncthreads();
}

__device__ __forceinline__ void ln_row_bf16(const float* src, const float* g, const float* b, bf16_t* dst, int lane) {
    f32x4 v[8]; float s = 0.f;
#pragma unroll
    for (int j = 0; j < 8; ++j) { v[j] = ((const f32x4*)src)[lane + 64 * j]; s += (v[j].x + v[j].y) + (v[j].z + v[j].w); }
    const float mean = wave_sum(s) * (1.0f / D); float s2 = 0.f;
#pragma unroll
    for (int j = 0; j < 8; ++j) { v[j] = v[j] - mean; s2 += (v[j].x * v[j].x + v[j].y * v[j].y) + (v[j].z * v[j].z + v[j].w * v[j].w); }
    const float rstd = 1.0f / sqrtf(wave_sum(s2) * (1.0f / D) + LN_EPS);
#pragma unroll
    for (int j = 0; j < 8; ++j) {
        const f32x4 gg = ((const f32x4*)g)[lane + 64 * j], bb = ((const f32x4*)b)[lane + 64 * j];
        const f32x4 o = v[j] * rstd * gg + bb;
        u32x2 w; w.x = pk2(o.x, o.y); w.y = pk2(o.z, o.w);
        ((u32x2*)dst)[lane + 64 * j] = w;
    }
}
__device__ __forceinline__ void transpose_item(const float* W, int K, int N, int Npad, bf16_t* Wt, int item, int lane) {
    const int nblk = Npad >> 6, kb = item / nblk, nb = item - kb * nblk, n = nb * 64 + lane, k0 = kb * 32;
    float v[32];
    if (n < N) {
#pragma unroll
        for (int i = 0; i < 32; ++i) v[i] = W[(size_t)(k0 + i) * N + n];
    } else {
#pragma unroll
        for (int i = 0; i < 32; ++i) v[i] = 0.f;
    }
    u32x4* o = (u32x4*)(Wt + (size_t)n * K + k0);
#pragma unroll
    for (int c = 0; c < 4; ++c) { u32x4 w; w.x = pk2(v[8 * c], v[8 * c + 1]); w.y = pk2(v[8 * c + 2], v[8 * c + 3]); w.z = pk2(v[8 * c + 4], v[8 * c + 5]); w.w = pk2(v[8 * c + 6], v[8 * c + 7]); o[c] = w; }
}
__device__ __forceinline__ void phase0(const Params& P) {
    const int lane = threadIdx.x & 63, wave = threadIdx.x >> 6;
    const int gw = blockIdx.x * 8 + wave, NGW = gridDim.x * 8;
    unsigned char* ws = P.ws;
    constexpr int T_IN = 64 * 184, T_A = 64 * 32, T_B = 32 * 32, T_O = 64 * 32, T_Q = 64 * 32, T_POOL = 4 * 32, T_W2 = 3 * 32, T_A2 = 3 * 32, T_G2 = 8 * 32;
    constexpr int T_LN = MROWS, T_SK = 64;
    constexpr int NIT = T_IN + T_A + T_B + T_O + T_Q + T_POOL + T_W2 + T_A2 + T_G2 + T_LN + T_SK;
    for (int it = gw; it < NIT; it += NGW) {
        int r = it;
        if (r < T_IN) { transpose_item(P.in[I_WIN], 2048, INC, NPAD, (bf16_t*)(ws + WS_WTIN), r, lane); continue; } r -= T_IN;
        if (r < T_A) { transpose_item(P.in[I_WBA], 2048, 2048, 2048, (bf16_t*)(ws + WS_WTA), r, lane); continue; } r -= T_A;
        if (r < T_B) { transpose_item(P.in[I_WBB], 1024, 2048, 2048, (bf16_t*)(ws + WS_WTB), r, lane); continue; } r -= T_B;
        if (r < T_O) { transpose_item(P.in[I_WOUT], 2048, 2048, 2048, (bf16_t*)(ws + WS_WTOUT), r, lane); continue; } r -= T_O;
        if (r < T_Q) { transpose_item(P.in[I_WQ], 2048, 2048, 2048, (bf16_t*)(ws + WS_WTQ), r, lane); continue; } r -= T_Q;
        if (r < T_POOL) { const int g = r >> 5; transpose_item(P.in[I_WPOOL] + g * 65536, 256, 256, 256, (bf16_t*)(ws + WS_WTPOOL) + g * 65536, r & 31, lane); continue; } r -= T_POOL;
        if (r < T_W2) { transpose_item(P.in[I_WW2], 96, 2048, 2048, (bf16_t*)(ws + WS_WTW2), r, lane); continue; } r -= T_W2;
        if (r < T_A2) { transpose_item(P.in[I_WA2], 96, 2048, 2048, (bf16_t*)(ws + WS_WTA2), r, lane); continue; } r -= T_A2;
        if (r < T_G2) { transpose_item(P.in[I_WG2], 256, 2048, 2048, (bf16_t*)(ws + WS_WTG2), r, lane); continue; } r -= T_G2;
        if (r < T_LN) {
            bf16_t* dst = (bf16_t*)(ws + WS_H0B) + (size_t)r * D;
            if (r < NTOK) ln_row_bf16(P.in[I_X] + (size_t)r * D, P.in[I_LNIN_G], P.in[I_LNIN_B], dst, lane);
            else if (r < NTOK + 16) ln_row_bf16(P.in[I_META] + (size_t)(r - NTOK) * D, P.in[I_LNIN_G], P.in[I_LNIN_B], dst, lane);
            else {
#pragma unroll
                for (int j = 0; j < 8; ++j) ((u32x2*)dst)[lane + 64 * j] = (u32x2){0u, 0u};
            }
            continue;
        }
        r -= T_LN;
        {
            const float* s = P.in[I_SUBK] + r * 512 + lane * 8; float f[8];
#pragma unroll
            for (int i = 0; i < 8; ++i) f[i] = s[i];
            *(u32x4*)((bf16_t*)(ws + WS_SUBK) + r * 512 + lane * 8) = pack8(f);
        }
    }
}
namespace pg8 {
struct EpiGateA {
    static constexpr bool PERM = false, AFTER_DRAIN = false;
    float* C; const bf16_t* p; const float* bgate;
    __device__ __forceinline__ void operator()(const f32x4 (&acc)[2][2][4][2], const Unit& u, int wr, int wc, int fr, int fq) const {
        const int row0 = u.pm * BM + wr * 64 + fr, col0 = u.pn * BM + wc * 32 + 4 * fq;
#pragma unroll
        for (int ai = 0; ai < 2; ++ai)
#pragma unroll
            for (int m = 0; m < 4; ++m) { const size_t row = (size_t)(row0 + ai * HALF + m * 16);
#pragma unroll
                for (int bj = 0; bj < 2; ++bj)
#pragma unroll
                    for (int n = 0; n < 2; ++n) { const int col = col0 + bj * HALF + n * 16;
                        const u32x2 pw = *(const u32x2*)(p + row * NPAD + C_G0 + col); const f32x4 bg = *(const f32x4*)(bgate + col);
                        f32x4 g; g.x = sigmoidf_(bflo(pw.x) + bg.x); g.y = sigmoidf_(bfhi(pw.x) + bg.y); g.z = sigmoidf_(bflo(pw.y) + bg.z); g.w = sigmoidf_(bfhi(pw.y) + bg.w);
                        *(f32x4*)(C + row * D + col) = acc[ai][bj][m][n] * g; } }
    }
};
struct EpiGateB {
    static constexpr bool PERM = false, AFTER_DRAIN = false;
    const float* C; bf16_t* O; const bf16_t* p; const float* bgate;
    __device__ __forceinline__ void operator()(const f32x4 (&acc)[2][2][4][2], const Unit& u, int wr, int wc, int fr, int fq) const {
        const int row0 = u.pm * BM + wr * 64 + fr, col0 = u.pn * BM + wc * 32 + 4 * fq;
#pragma unroll
        for (int ai = 0; ai < 2; ++ai)
#pragma unroll
            for (int m = 0; m < 4; ++m) { const size_t row = (size_t)(row0 + ai * HALF + m * 16);
#pragma unroll
                for (int bj = 0; bj < 2; ++bj)
#pragma unroll
                    for (int n = 0; n < 2; ++n) { const int col = col0 + bj * HALF + n * 16;
                        const u32x2 pw = *(const u32x2*)(p + row * NPAD + C_G1 + col); const f32x4 bg = *(const f32x4*)(bgate + D + col);
                        f32x4 g; g.x = sigmoidf_(bflo(pw.x) + bg.x); g.y = sigmoidf_(bfhi(pw.x) + bg.y); g.z = sigmoidf_(bflo(pw.y) + bg.z); g.w = sigmoidf_(bfhi(pw.y) + bg.w);
                        const f32x4 o = *(const f32x4*)(C + row * D + col) + acc[ai][bj][m][n] * g;
                        u32x2 w; w.x = cvt_pk_bf16(o.x, o.y); w.y = cvt_pk_bf16(o.z, o.w);
                        *(u32x2*)(O + row * D + col) = w; } }
    }
};
struct EpiResid {
    static constexpr bool PERM = false, AFTER_DRAIN = false;
    float* C; const bf16_t* h0; float alpha;
    __device__ __forceinline__ void operator()(const f32x4 (&acc)[2][2][4][2], const Unit& u, int wr, int wc, int fr, int fq) const {
        const int row0 = u.pm * BM + wr * 64 + fr, col0 = u.pn * BM + wc * 32 + 4 * fq;
#pragma unroll
        for (int ai = 0; ai < 2; ++ai)
#pragma unroll
            for (int m = 0; m < 4; ++m) { const size_t row = (size_t)(row0 + ai * HALF + m * 16);
#pragma unroll
                for (int bj = 0; bj < 2; ++bj)
#pragma unroll
                    for (int n = 0; n < 2; ++n) { const int col = col0 + bj * HALF + n * 16;
                        const u32x2 hw = *(const u32x2*)(h0 + row * D + col);
                        f32x4 hv; hv.x = bflo(hw.x); hv.y = bfhi(hw.x); hv.z = bflo(hw.y); hv.w = bfhi(hw.y);
                        *(f32x4*)(C + row * D + col) = hv * alpha + acc[ai][bj][m][n]; } }
    }
};
}
template <class Epi>
__device__ __forceinline__ void run_gemm(ldsp lds, const bf16_t* A, const bf16_t* Bt, int M, int N, int K, const Epi& E) {
    pg8::Gemm g; g.A = A; g.Bt = Bt; g.M = M; g.N = N; g.K = K;
    pg8::StaticOrder S; S.init(M, N, (int)gridDim.x, (int)blockIdx.x);
    pg8::gemm_phase<Epi, pg8::StaticOrder, false>(lds, g, S, E, nullptr);
}
constexpr int LD64 = 72, MATB = 64 * LD64 * 2, LDK = 104;
constexpr int O_AB = 0, O_RB = 1 * MATB, O_BH = 2 * MATB, O_KH = 3 * MATB, O_ABT = 4 * MATB, O_BTT = 5 * MATB, O_KTT = 6 * MATB, O_VT = 7 * MATB;
constexpr int O_M0 = 8 * MATB, O_M0T = 9 * MATB, O_M1 = 10 * MATB, O_M1T = 11 * MATB, O_PA = 12 * MATB, O_PB = 13 * MATB, O_MAK = 14 * MATB, O_MRB = 15 * MATB, O_MRK = 16 * MATB;
constexpr int O_ELEND = 17 * MATB;
constexpr int O_WL = 8 * MATB, O_AL = O_WL + 64 * LDK * 2, O_Z = O_AL + 64 * LDK * 2, O_AZ = O_Z + 64 * 68 * 4;
static_assert(O_AZ + 64 * 68 * 4 <= O_ELEND, "lds");
static_assert(O_ELEND + 256 <= LDS_BYTES, "lds");

__device__ __forceinline__ bf16x8 ldsfrag(ldsp lds, int off, int ld, int row, int kofs) { return *(const LAS bf16x8*)(lds + off + (row * ld + kofs) * 2); }
__device__ __forceinline__ void st4(ldsp lds, int off, int row, int col, const f32x4 v) {
    u32x2 w; w.x = pk2(v.x, v.y); w.y = pk2(v.z, v.w); *(LAS u32x2*)(lds + off + (row * LD64 + col) * 2) = w; }
__device__ __forceinline__ void st1(ldsp lds, int off, int row, int col, float v) { *(LAS bf16_t*)(lds + off + (row * LD64 + col) * 2) = f2bf1(v); }

__device__ __forceinline__ void shift8(const bf16_t* pcur, const bf16_t* pprev, const float* mu, float* x) {
    float c[8], q[8];
    if (pcur) unpack8(*(const u32x4*)pcur, c); else {
#pragma unroll
        for (int i = 0; i < 8; ++i) c[i] = 0.f; }
    if (pprev) unpack8(*(const u32x4*)pprev, q); else {
#pragma unroll
        for (int i = 0; i < 8; ++i) q[i] = 0.f; }
    const f32x4 m0 = *(const f32x4*)mu, m1 = *(const f32x4*)(mu + 4);
    const float mm[8] = {m0.x, m0.y, m0.z, m0.w, m1.x, m1.y, m1.z, m1.w};
#pragma unroll
    for (int i = 0; i < 8; ++i) x[i] = c[i] + (q[i] - c[i]) * mm[i];
}

template <bool DO_P, bool DO_SQ>
__device__ __forceinline__ void dbl_step(ldsp lds, int sN, int sT, int dN, int dT, int pC, int pN, int tm, int tn0, int fr, int fq) {
    bf16x8 a[2];
#pragma unroll
    for (int ks = 0; ks < 2; ++ks) a[ks] = ldsfrag(lds, sT, LD64, 16 * tm + fr, ks * 32 + fq * 8);
#pragma unroll
    for (int t2 = 0; t2 < 2; ++t2) {
        const int nt = tn0 + t2, t = 16 * nt + fr, s0 = 16 * tm + 4 * fq;
        if (DO_P) {
            f32x4 acc = {0.f, 0.f, 0.f, 0.f};
#pragma unroll
            for (int ks = 0; ks < 2; ++ks) acc = mfma16(a[ks], ldsfrag(lds, pC, LD64, t, ks * 32 + fq * 8), acc);
            const u32x2 pw = *(const LAS u32x2*)(lds + pC + (t * LD64 + s0) * 2);
            acc.x += bflo(pw.x); acc.y += bfhi(pw.x); acc.z += bflo(pw.y); acc.w += bfhi(pw.y);
            st4(lds, pN, t, s0, acc);
        }
        if (DO_SQ) {
            f32x4 acc = {0.f, 0.f, 0.f, 0.f};
#pragma unroll
            for (int ks = 0; ks < 2; ++ks) acc = mfma16(a[ks], ldsfrag(lds, sN, LD64, t, ks * 32 + fq * 8), acc);
            st4(lds, dN, t, s0, acc);
            st1(lds, dT, s0 + 0, t, acc.x); st1(lds, dT, s0 + 1, t, acc.y); st1(lds, dT, s0 + 2, t, acc.z); st1(lds, dT, s0 + 3, t, acc.w);
        }
    }
}


#ifdef DBG_STAGE
constexpr size_t DBG_STRIDE = (size_t)NUNITS * 512 * 4;
__device__ __forceinline__ void dbgsum(const Params& P, ldsp lds, int u, int stage, const int* offs, int nmat) {
    unsigned acc = 0;
    for (int m = 0; m < nmat; ++m)
        for (int k = 0; k < 4; ++k) { const int idx = threadIdx.x + 512 * k, row = idx >> 5, cp = idx & 31; const unsigned x = *(const LAS unsigned*)(lds + offs[m] + row * (LD64 * 2) + cp * 4); acc += (x & 0xffffu) + (x >> 16); }
    ((unsigned*)(P.ws + WS_S0T + (size_t)stage * DBG_STRIDE))[(size_t)u * 512 + threadIdx.x] = acc;
}
#define DBGSUM(stage, ...) do { const int offs_[] = {__VA_ARGS__}; dbgsum(P, lds, u, stage, offs_, (int)(sizeof(offs_) / sizeof(int))); } while (0)
#else
#define DBGSUM(stage, ...) do { } while (0)
#endif
__device__ __forceinline__ void rwkv_unit(const Params& P, ldsp lds, int u) {
    const int tid = threadIdx.x, lane = tid & 63, wave = tid >> 6, fr = lane & 15, fq = lane >> 4, tm = wave >> 1, tn0 = (wave & 1) * 2;
    unsigned char* ws = P.ws;
    const bf16_t* pp = (const bf16_t*)(ws + WS_P);
    const bool meta = u >= 4096;
    int b = 0, h, c = 0;
    if (meta) { h = u - 4096; } else { const int bh = u >> 6; c = u & 63; b = bh >> 5; h = bh & 31; }
    auto rowof = [&](int tl) -> int {
        if (meta) return (tl >= 48) ? (ROW_META + tl - 48) : -1;
        if (tl >= 0 || c > 0) return b * SEQ + c * 64 + tl;
        return ROW_META + 15;
    };
    auto rowp = [&](int tl, int col) -> const bf16_t* { const int r = rowof(tl); return r < 0 ? (const bf16_t*)nullptr : pp + (size_t)r * NPAD + col; };
    const float* mu = P.in[I_MU];
    for (int idx = tid; idx < 1536; idx += 512) {
        const int mat = idx / 768, rem = idx - mat * 768, t = rem / 12, ch = rem - t * 12, col = (mat ? C_AL : C_WL) + ch * 8;
        float x[8]; shift8(rowp(t, col), rowp(t - 1, col), mu + col, x);
        if (mat == 0) {
#pragma unroll
            for (int i = 0; i < 8; ++i) x[i] = tanhf(x[i]);
        }
        *(LAS u32x4*)(lds + (mat ? O_AL : O_WL) + (t * LDK + ch * 8) * 2) = pack8(x);
    }
    BLOCK_SYNC();
    {
        const bf16_t* ww2 = (const bf16_t*)(ws + WS_WTW2) + (size_t)(h * 64 + 16 * tm + fr) * 96 + fq * 8;
        const bf16_t* wa2 = (const bf16_t*)(ws + WS_WTA2) + (size_t)(h * 64 + 16 * tm + fr) * 96 + fq * 8;
        f32x4 z[2] = {{0.f, 0.f, 0.f, 0.f}, {0.f, 0.f, 0.f, 0.f}}, az[2] = {{0.f, 0.f, 0.f, 0.f}, {0.f, 0.f, 0.f, 0.f}};
#pragma unroll
        for (int ks = 0; ks < 3; ++ks) {
            const bf16x8 aw = *(const bf16x8*)(ww2 + ks * 32), aa = *(const bf16x8*)(wa2 + ks * 32);
#pragma unroll
            for (int t2 = 0; t2 < 2; ++t2) {
                const int t = 16 * (tn0 + t2) + fr;
                z[t2] = mfma16(aw, ldsfrag(lds, O_WL, LDK, t, ks * 32 + fq * 8), z[t2]);
                az[t2] = mfma16(aa, ldsfrag(lds, O_AL, LDK, t, ks * 32 + fq * 8), az[t2]);
            }
        }
#pragma unroll
        for (int t2 = 0; t2 < 2; ++t2) {
            const int t = 16 * (tn0 + t2) + fr, j0 = 16 * tm + 4 * fq;
            *(LAS f32x4*)(lds + O_Z + (t * 68 + j0) * 4) = z[t2];
            *(LAS f32x4*)(lds + O_AZ + (t * 68 + j0) * 4) = az[t2];
        }
    }
    BLOCK_SYNC();
    const int t = tid >> 3, jq = tid & 7, j0 = 8 * jq, hj = h * 64 + j0;
    const bool nulltok = meta && t < 48;
    float lw[8], av[8], rv[8], kv[8], vv[8], kk[8], km[8];
    {
        const f32x4 z0 = *(const LAS f32x4*)(lds + O_Z + (t * 68 + j0) * 4), z1 = *(const LAS f32x4*)(lds + O_Z + (t * 68 + j0 + 4) * 4);
        const f32x4 y0 = *(const LAS f32x4*)(lds + O_AZ + (t * 68 + j0) * 4), y1 = *(const LAS f32x4*)(lds + O_AZ + (t * 68 + j0 + 4) * 4);
        const float zz[8] = {z0.x, z0.y, z0.z, z0.w, z1.x, z1.y, z1.z, z1.w}, yy[8] = {y0.x, y0.y, y0.z, y0.w, y1.x, y1.y, y1.z, y1.w};
        const float* w0 = P.in[I_W0] + hj; const float* a0 = P.in[I_A0] + hj;
#pragma unroll
        for (int i = 0; i < 8; ++i) { lw[i] = nulltok ? 0.f : -DSCALE * sigmoidf_(w0[i] + zz[i]); av[i] = sigmoidf_(a0[i] + yy[i]); }
        shift8(rowp(t, C_R + hj), rowp(t - 1, C_R + hj), mu + C_R + hj, rv);
        shift8(rowp(t, C_K + hj), rowp(t - 1, C_K + hj), mu + C_K + hj, kv);
        shift8(rowp(t, C_V + hj), rowp(t - 1, C_V + hj), mu + C_V + hj, vv);
        if (nulltok) {
#pragma unroll
            for (int i = 0; i < 8; ++i) { rv[i] = 0.f; kv[i] = 0.f; vv[i] = 0.f; }
        }
        const float* kkw = P.in[I_KK] + hj; const float* kaw = P.in[I_KA] + hj; const float* rkw = P.in[I_RK] + hj;
        float n2 = 0.f, bon = 0.f;
#pragma unroll
        for (int i = 0; i < 8; ++i) { kk[i] = kv[i] * kkw[i]; n2 += kk[i] * kk[i]; km[i] = kv[i] * (1.0f + (av[i] - 1.0f) * kaw[i]); bon += rv[i] * km[i] * rkw[i]; }
        n2 += __shfl_xor(n2, 1); n2 += __shfl_xor(n2, 2); n2 += __shfl_xor(n2, 4);
        bon += __shfl_xor(bon, 1); bon += __shfl_xor(bon, 2); bon += __shfl_xor(bon, 4);
        const float inv = 1.0f / fmaxf(sqrtf(n2), 1e-12f);
#pragma unroll
        for (int i = 0; i < 8; ++i) kk[i] *= inv;
        if (!meta && jq == 0) ((float*)(ws + WS_BONUS))[(size_t)(b * SEQ + c * 64 + t) * 32 + h] = bon;
        *(LAS f32x4*)(lds + O_Z + (t * 68 + j0) * 4) = (f32x4){lw[0], lw[1], lw[2], lw[3]};
        *(LAS f32x4*)(lds + O_Z + (t * 68 + j0 + 4) * 4) = (f32x4){lw[4], lw[5], lw[6], lw[7]};
    }
    BLOCK_SYNC();
    {
        float Lc[8], Le[8];
#pragma unroll
        for (int i = 0; i < 8; ++i) { Lc[i] = 0.f; Le[i] = 0.f; }
        for (int tau = 0; tau < 64; ++tau) {
            const f32x4 x0 = *(const LAS f32x4*)(lds + O_Z + (tau * 68 + j0) * 4), x1 = *(const LAS f32x4*)(lds + O_Z + (tau * 68 + j0 + 4) * 4);
            const float xx[8] = {x0.x, x0.y, x0.z, x0.w, x1.x, x1.y, x1.z, x1.w};
            const float msk = tau <= t ? 1.0f : 0.0f;
#pragma unroll
            for (int i = 0; i < 8; ++i) { Le[i] += xx[i]; Lc[i] += msk * xx[i]; }
        }
        float Ab[8], Rb[8], Bh[8], Kh[8], Bt[8], Kt[8];
#pragma unroll
        for (int i = 0; i < 8; ++i) {
            const float eP = __expf(Lc[i] - lw[i]), eC = __expf(Lc[i]), eN = __expf(-Lc[i]), eE = __expf(Le[i] - Lc[i]);
            const float ka = kk[i] * av[i];
            Ab[i] = -kk[i] * eP; Rb[i] = rv[i] * eC; Bh[i] = ka * eN; Kh[i] = km[i] * eN; Bt[i] = ka * eE; Kt[i] = km[i] * eE;
        }
        *(LAS u32x4*)(lds + O_AB + (t * LD64 + j0) * 2) = pack8(Ab);
        *(LAS u32x4*)(lds + O_RB + (t * LD64 + j0) * 2) = pack8(Rb);
        *(LAS u32x4*)(lds + O_BH + (t * LD64 + j0) * 2) = pack8(Bh);
        *(LAS u32x4*)(lds + O_KH + (t * LD64 + j0) * 2) = pack8(Kh);
#pragma unroll
        for (int i = 0; i < 8; ++i) { st1(lds, O_ABT, j0 + i, t, Ab[i]); st1(lds, O_BTT, j0 + i, t, Bt[i]); st1(lds, O_KTT, j0 + i, t, Kt[i]); st1(lds, O_VT, j0 + i, t, vv[i]); }
        if (t == 63) {
#pragma unroll
            for (int i = 0; i < 8; ++i) *(LAS float*)(lds + O_ELEND + (j0 + i) * 4) = __expf(Le[i]);
        }
    }
    BLOCK_SYNC();
    DBGSUM(0, O_AB, O_RB, O_BH, O_KH, O_ABT, O_BTT, O_KTT, O_VT);
    {
        bf16x8 abh[2], akh[2];
#pragma unroll
        for (int ks = 0; ks < 2; ++ks) { abh[ks] = ldsfrag(lds, O_BH, LD64, 16 * tm + fr, ks * 32 + fq * 8); akh[ks] = ldsfrag(lds, O_KH, LD64, 16 * tm + fr, ks * 32 + fq * 8); }
#pragma unroll
        for (int t2 = 0; t2 < 2; ++t2) {
            const int tt = 16 * (tn0 + t2) + fr, s0 = 16 * tm + 4 * fq;
            f32x4 mab = {0.f, 0.f, 0.f, 0.f}, mak = mab, mrb = mab, mrk = mab;
#pragma unroll
            for (int ks = 0; ks < 2; ++ks) {
                const bf16x8 bab = ldsfrag(lds, O_AB, LD64, tt, ks * 32 + fq * 8), brb = ldsfrag(lds, O_RB, LD64, tt, ks * 32 + fq * 8);
                mab = mfma16(abh[ks], bab, mab); mak = mfma16(akh[ks], bab, mak); mrb = mfma16(abh[ks], brb, mrb); mrk = mfma16(akh[ks], brb, mrk);
            }
            float vab[4] = {mab.x, mab.y, mab.z, mab.w}, vak[4] = {mak.x, mak.y, mak.z, mak.w}, vrb[4] = {mrb.x, mrb.y, mrb.z, mrb.w}, vrk[4] = {mrk.x, mrk.y, mrk.z, mrk.w}, vp[4];
#pragma unroll
            for (int r = 0; r < 4; ++r) { const int s = s0 + r; const bool st = s < tt, le = s <= tt;
                vab[r] = st ? vab[r] : 0.f; vak[r] = st ? vak[r] : 0.f; vrb[r] = le ? vrb[r] : 0.f; vrk[r] = le ? vrk[r] : 0.f; vp[r] = vab[r] + (s == tt ? 1.0f : 0.f); }
            st4(lds, O_M0, tt, s0, (f32x4){vab[0], vab[1], vab[2], vab[3]});
#pragma unroll
            for (int r = 0; r < 4; ++r) st1(lds, O_M0T, s0 + r, tt, vab[r]);
            st4(lds, O_PA, tt, s0, (f32x4){vp[0], vp[1], vp[2], vp[3]});
            st4(lds, O_MAK, tt, s0, (f32x4){vak[0], vak[1], vak[2], vak[3]});
            st4(lds, O_MRB, tt, s0, (f32x4){vrb[0], vrb[1], vrb[2], vrb[3]});
            st4(lds, O_MRK, tt, s0, (f32x4){vrk[0], vrk[1], vrk[2], vrk[3]});
        }
    }
    BLOCK_SYNC();
    DBGSUM(1, O_M0, O_M0T, O_PA, O_MAK, O_MRB, O_MRK);
    dbl_step<false, true>(lds, O_M0, O_M0T, O_M1, O_M1T, 0, 0, tm, tn0, fr, fq); BLOCK_SYNC();
    dbl_step<true, true>(lds, O_M1, O_M1T, O_M0, O_M0T, O_PA, O_PB, tm, tn0, fr, fq); BLOCK_SYNC();
    dbl_step<true, true>(lds, O_M0, O_M0T, O_M1, O_M1T, O_PB, O_PA, tm, tn0, fr, fq); BLOCK_SYNC();
    dbl_step<true, true>(lds, O_M1, O_M1T, O_M0, O_M0T, O_PA, O_PB, tm, tn0, fr, fq); BLOCK_SYNC();
    dbl_step<true, true>(lds, O_M0, O_M0T, O_M1, O_M1T, O_PB, O_PA, tm, tn0, fr, fq); BLOCK_SYNC();
    dbl_step<true, false>(lds, O_M1, O_M1T, 0, 0, O_PA, O_PB, tm, tn0, fr, fq); BLOCK_SYNC();
    DBGSUM(2, O_PB);
    {
        bf16x8 aT[2], aMak[2];
#pragma unroll
        for (int ks = 0; ks < 2; ++ks) { aT[ks] = ldsfrag(lds, O_PB, LD64, 16 * tm + fr, ks * 32 + fq * 8); aMak[ks] = ldsfrag(lds, O_MAK, LD64, 16 * tm + fr, ks * 32 + fq * 8); }
#pragma unroll
        for (int t2 = 0; t2 < 2; ++t2) {
            const int n = 16 * (tn0 + t2) + fr, t0 = 16 * tm + 4 * fq;
            f32x4 at = {0.f, 0.f, 0.f, 0.f}, xt = at;
#pragma unroll
            for (int ks = 0; ks < 2; ++ks) { at = mfma16(aT[ks], ldsfrag(lds, O_ABT, LD64, n, ks * 32 + fq * 8), at); xt = mfma16(aMak[ks], ldsfrag(lds, O_VT, LD64, n, ks * 32 + fq * 8), xt); }
            st4(lds, O_M0, n, t0, at); st4(lds, O_M0T, n, t0, xt);
        }
    }
    BLOCK_SYNC();
    DBGSUM(3, O_M0, O_M0T);
    const size_t ub = (size_t)u * 4096;
    {
        bf16x8 aT[2], aAt[2];
#pragma unroll
        for (int ks = 0; ks < 2; ++ks) { aT[ks] = ldsfrag(lds, O_PB, LD64, 16 * tm + fr, ks * 32 + fq * 8); aAt[ks] = ldsfrag(lds, O_M0, LD64, 16 * tm + fr, ks * 32 + fq * 8); }
        bf16_t* Rt = (bf16_t*)(ws + WS_RT) + ub; bf16_t* Gp = (bf16_t*)(ws + WS_G) + ub;
#pragma unroll
        for (int t2 = 0; t2 < 2; ++t2) {
            const int n = 16 * (tn0 + t2) + fr, m0 = 16 * tm + 4 * fq;
            f32x4 u0 = {0.f, 0.f, 0.f, 0.f}, rt = u0, g = u0;
#pragma unroll
            for (int ks = 0; ks < 2; ++ks) {
                u0 = mfma16(aT[ks], ldsfrag(lds, O_M0T, LD64, n, ks * 32 + fq * 8), u0);
                rt = mfma16(aAt[ks], ldsfrag(lds, O_MRB, LD64, n, ks * 32 + fq * 8), rt);
                g = mfma16(aAt[ks], ldsfrag(lds, O_BTT, LD64, n, ks * 32 + fq * 8), g);
            }
            st4(lds, O_M1, n, m0, u0);
            const u32x2 rw = *(const LAS u32x2*)(lds + O_RB + (n * LD64 + m0) * 2);
            rt.x += bflo(rw.x); rt.y += bfhi(rw.x); rt.z += bflo(rw.y); rt.w += bfhi(rw.y);
            { u32x2 w; w.x = pk2(rt.x, rt.y); w.y = pk2(rt.z, rt.w); *(u32x2*)(Rt + n * 64 + m0) = w; }
            if ((n >> 2) == (m0 >> 2)) { const float e = *(const LAS float*)(lds + O_ELEND + n * 4); const int r = n & 3;
                g.x += (r == 0) ? e : 0.f; g.y += (r == 1) ? e : 0.f; g.z += (r == 2) ? e : 0.f; g.w += (r == 3) ? e : 0.f; }
            { const int pos0 = 32 * (tm >> 1) + 8 * fq + 4 * (tm & 1); u32x2 w; w.x = pk2(g.x, g.y); w.y = pk2(g.z, g.w); *(u32x2*)(Gp + n * 64 + pos0) = w; }
        }
    }
    BLOCK_SYNC();
    DBGSUM(4, O_M1);
    {
        bf16x8 aB[2], aK[2], aU[2], aV[2];
#pragma unroll
        for (int ks = 0; ks < 2; ++ks) { const int row = 16 * tm + fr, ko = ks * 32 + fq * 8;
            aB[ks] = ldsfrag(lds, O_BTT, LD64, row, ko); aK[ks] = ldsfrag(lds, O_KTT, LD64, row, ko); aU[ks] = ldsfrag(lds, O_M1, LD64, row, ko); aV[ks] = ldsfrag(lds, O_VT, LD64, row, ko); }
        bf16_t* H0t = (bf16_t*)(ws + WS_H0T) + ub; bf16_t* Y0s = (bf16_t*)(ws + WS_Y0) + ub;
#pragma unroll
        for (int t2 = 0; t2 < 2; ++t2) {
            const int n = 16 * (tn0 + t2) + fr, m0 = 16 * tm + 4 * fq;
            f32x4 hh = {0.f, 0.f, 0.f, 0.f}, yy = hh;
#pragma unroll
            for (int ks = 0; ks < 2; ++ks) { const int ko = ks * 32 + fq * 8;
                const bf16x8 bU = ldsfrag(lds, O_M1, LD64, n, ko), bV = ldsfrag(lds, O_VT, LD64, n, ko), bRb = ldsfrag(lds, O_MRB, LD64, n, ko), bRk = ldsfrag(lds, O_MRK, LD64, n, ko);
                hh = mfma16(aB[ks], bU, hh); hh = mfma16(aK[ks], bV, hh);
                yy = mfma16(aU[ks], bRb, yy); yy = mfma16(aV[ks], bRk, yy); }
            { u32x2 w; w.x = pk2(hh.x, hh.y); w.y = pk2(hh.z, hh.w); *(u32x2*)(H0t + n * 64 + m0) = w; }
            { u32x2 w; w.x = pk2(yy.x, yy.y); w.y = pk2(yy.z, yy.w); *(u32x2*)(Y0s + n * 64 + m0) = w; }
        }
    }
    BLOCK_SYNC();
}

constexpr int LDU = 264;
__device__ __forceinline__ void pool_unit(const Params& P, ldsp lds, int pu) {
    const int tid = threadIdx.x, lane = tid & 63, wave = tid >> 6, fr = lane & 15, fq = lane >> 4;
    unsigned char* ws = P.ws;
    const bf16_t* pp = (const bf16_t*)(ws + WS_P);
    const int g = pu & 3, tt = pu >> 2, b = tt >> 6, ti0 = (tt & 63) * 64;
    constexpr int O_U = 0, O_PL = 79 * LDU * 2;
    for (int idx = tid; idx < 79 * 32; idx += 512) {
        const int lr = idx >> 5, ch = idx & 31, ti = ti0 + lr - 15;
        const int row = ti >= 0 ? b * SEQ + ti : ROW_META + 16 + ti;
        *(LAS u32x4*)(lds + O_U + (lr * LDU + ch * 8) * 2) = *(const u32x4*)(pp + (size_t)row * NPAD + C_POOL + g * 256 + ch * 8);
    }
    BLOCK_SYNC();
    {
        const int t = tid >> 3, cq = tid & 7, win = 2 << g; const float inv = 1.0f / (float)win;
#pragma unroll
        for (int cc = 0; cc < 4; ++cc) {
            const int c0 = cq * 32 + cc * 8; float s[8], own[8];
            unpack8(*(const LAS u32x4*)(lds + O_U + ((15 + t) * LDU + c0) * 2), own);
#pragma unroll
            for (int i = 0; i < 8; ++i) s[i] = own[i];
            for (int d = 1; d < win; ++d) { float x[8]; unpack8(*(const LAS u32x4*)(lds + O_U + ((15 + t - d) * LDU + c0) * 2), x);
#pragma unroll
                for (int i = 0; i < 8; ++i) s[i] += x[i]; }
#pragma unroll
            for (int i = 0; i < 8; ++i) s[i] = s[i] * inv - own[i];
            *(LAS u32x4*)(lds + O_PL + (t * LDU + c0) * 2) = pack8(s);
        }
    }
    BLOCK_SYNC();
    {
        const bf16_t* wt = (const bf16_t*)(ws + WS_WTPOOL) + (size_t)g * 65536;
        f32x4 acc[2][4];
#pragma unroll
        for (int a = 0; a < 2; ++a)
#pragma unroll
            for (int n = 0; n < 4; ++n) acc[a][n] = (f32x4){0.f, 0.f, 0.f, 0.f};
#pragma unroll 2
        for (int ks = 0; ks < 8; ++ks) {
            bf16x8 af[2];
#pragma unroll
            for (int a = 0; a < 2; ++a) af[a] = *(const bf16x8*)(wt + (size_t)(32 * wave + 16 * a + fr) * 256 + ks * 32 + fq * 8);
#pragma unroll
            for (int n = 0; n < 4; ++n) { const bf16x8 bf = ldsfrag(lds, O_PL, LDU, 16 * n + fr, ks * 32 + fq * 8);
#pragma unroll
                for (int a = 0; a < 2; ++a) acc[a][n] = mfma16(af[a], bf, acc[a][n]); }
        }
        bf16_t* yb = (bf16_t*)(ws + WS_YB);
        const float* psc = P.in[I_PSCALE] + g * 256;
#pragma unroll
        for (int a = 0; a < 2; ++a) { const int d0 = 32 * wave + 16 * a + 4 * fq; const f32x4 sc = *(const f32x4*)(psc + d0);
#pragma unroll
            for (int n = 0; n < 4; ++n) { const int t = 16 * n + fr; const f32x4 o = acc[a][n] * sc;
                u32x2 w; w.x = pk2(o.x, o.y); w.y = pk2(o.z, o.w);
                *(u32x2*)(yb + (size_t)(b * SEQ + ti0 + t) * 1024 + g * 256 + d0) = w; } }
    }
    BLOCK_SYNC();
}
__device__ __forceinline__ void phase2(const Params& P, ldsp lds) {
    for (int u = blockIdx.x; u < NUNITS + 512; u += gridDim.x) {
        if (u < NUNITS) rwkv_unit(P, lds, u); else pool_unit(P, lds, u - NUNITS);
    }
}
__device__ __forceinline__ void phase3(const Params& P) {
    const int lane = threadIdx.x & 63, wave = threadIdx.x >> 6, fr = lane & 15, fq = lane >> 4;
    if (wave != 0) return;
    unsigned char* ws = P.ws;
    const bf16_t* Gp = (const bf16_t*)(ws + WS_G); const bf16_t* H0t = (const bf16_t*)(ws + WS_H0T); bf16_t* S0t = (bf16_t*)(ws + WS_S0T);
    for (int item = blockIdx.x; item < 256; item += gridDim.x) {
        const int bh = item >> 2, vq = item & 3, h = bh & 31;
        bf16x8 Sb[2];
#pragma unroll
        for (int ks = 0; ks < 2; ++ks)
#pragma unroll
            for (int i = 0; i < 8; ++i) Sb[ks][i] = 0;
        bf16x8 gA[4][2]; u32x2 hF[4];
        auto load = [&](int step, bf16x8 (&ga)[4][2], u32x2 (&hf)[4]) {
            const int u = (step == 0) ? (4096 + h) : (bh * 64 + step - 1);
            const bf16_t* g = Gp + (size_t)u * 4096; const bf16_t* hh = H0t + (size_t)u * 4096;
#pragma unroll
            for (int mt = 0; mt < 4; ++mt) {
#pragma unroll
                for (int ks = 0; ks < 2; ++ks) ga[mt][ks] = *(const bf16x8*)(g + (16 * mt + fr) * 64 + ks * 32 + fq * 8);
                hf[mt] = *(const u32x2*)(hh + (16 * vq + fr) * 64 + 16 * mt + 4 * fq);
            }
        };
        load(0, gA, hF);
        for (int step = 0; step < 64; ++step) {
            bf16x8 gN[4][2]; u32x2 hN[4];
            if (step + 1 < 64) load(step + 1, gN, hN);
            f32x4 acc[4];
#pragma unroll
            for (int mt = 0; mt < 4; ++mt) {
                acc[mt] = (f32x4){bflo(hF[mt].x), bfhi(hF[mt].x), bflo(hF[mt].y), bfhi(hF[mt].y)};
                acc[mt] = mfma16(gA[mt][0], Sb[0], acc[mt]);
                acc[mt] = mfma16(gA[mt][1], Sb[1], acc[mt]);
            }
            bf16_t* so = S0t + (size_t)(bh * 64 + step) * 4096 + (16 * vq + fr) * 64 + 4 * fq;
            u32x2 w[4];
#pragma unroll
            for (int mt = 0; mt < 4; ++mt) { w[mt].x = pk2(acc[mt].x, acc[mt].y); w[mt].y = pk2(acc[mt].z, acc[mt].w); *(u32x2*)(so + 16 * mt) = w[mt]; }
#pragma unroll
            for (int ks = 0; ks < 2; ++ks) {
                const u32x4 q = (u32x4){w[2 * ks].x, w[2 * ks].y, w[2 * ks + 1].x, w[2 * ks + 1].y};
                Sb[ks] = __builtin_bit_cast(bf16x8, q);
            }
            if (step + 1 < 64) {
#pragma unroll
                for (int mt = 0; mt < 4; ++mt) { gA[mt][0] = gN[mt][0]; gA[mt][1] = gN[mt][1]; hF[mt] = hN[mt]; }
            }
        }
    }
}

constexpr int LDG = 264;
__device__ __forceinline__ void phase3b(const Params& P, ldsp lds) {
    const int tid = threadIdx.x, lane = tid & 63, wave = tid >> 6, fr = lane & 15, fq = lane >> 4, wq = wave & 3;
    unsigned char* ws = P.ws;
    const bf16_t* pp = (const bf16_t*)(ws + WS_P);
    const float* mu = P.in[I_MU];
    ldsp gl = lds + wave * (16 * LDG * 2);
    for (int pair = blockIdx.x; pair < 2048; pair += gridDim.x) {
        const int u = pair * 2 + (wave >> 2), bh = u >> 6, c = u & 63, b = bh >> 5, h = bh & 31;
        const int trow0 = b * SEQ + c * 64 + 16 * wq;
#pragma unroll
        for (int it = 0; it < 8; ++it) {
            const int idx = it * 64 + lane, tl = idx >> 5, ch = idx & 31, col = C_GL + ch * 8;
            const int row = trow0 + tl; const int prow = (c == 0 && wq == 0 && tl == 0) ? (ROW_META + 15) : row - 1;
            float x[8]; shift8(pp + (size_t)row * NPAD + col, pp + (size_t)prow * NPAD + col, mu + col, x);
#pragma unroll
            for (int i = 0; i < 8; ++i) x[i] = sigmoidf_(x[i]);
            *(LAS u32x4*)(gl + (tl * LDG + ch * 8) * 2) = pack8(x);
        }
        BLOCK_SYNC();
        f32x4 gacc[4];
#pragma unroll
        for (int mt = 0; mt < 4; ++mt) gacc[mt] = (f32x4){0.f, 0.f, 0.f, 0.f};
        {
            const bf16_t* wg = (const bf16_t*)(ws + WS_WTG2) + (size_t)(h * 64 + fr) * 256 + fq * 8;
#pragma unroll 2
            for (int ks = 0; ks < 8; ++ks) {
                const bf16x8 bf = *(const LAS bf16x8*)(gl + (fr * LDG + ks * 32 + fq * 8) * 2);
#pragma unroll
                for (int mt = 0; mt < 4; ++mt) gacc[mt] = mfma16(*(const bf16x8*)(wg + (size_t)(16 * mt) * 256 + ks * 32), bf, gacc[mt]);
            }
        }
        f32x4 y[4];
        {
            const size_t ub = (size_t)u * 4096;
            const bf16_t* S0t = (const bf16_t*)(ws + WS_S0T) + ub; const bf16_t* Rt = (const bf16_t*)(ws + WS_RT) + ub; const bf16_t* Y0s = (const bf16_t*)(ws + WS_Y0) + ub;
            bf16x8 bR[2];
#pragma unroll
            for (int ks = 0; ks < 2; ++ks) bR[ks] = *(const bf16x8*)(Rt + (16 * wq + fr) * 64 + ks * 32 + fq * 8);
#pragma unroll
            for (int mt = 0; mt < 4; ++mt) {
                const u32x2 yw = *(const u32x2*)(Y0s + (16 * wq + fr) * 64 + 16 * mt + 4 * fq);
                y[mt] = (f32x4){bflo(yw.x), bfhi(yw.x), bflo(yw.y), bfhi(yw.y)};
#pragma unroll
                for (int ks = 0; ks < 2; ++ks) y[mt] = mfma16(*(const bf16x8*)(S0t + (16 * mt + fr) * 64 + ks * 32 + fq * 8), bR[ks], y[mt]);
            }
        }
        float s = 0.f;
#pragma unroll
        for (int mt = 0; mt < 4; ++mt) s += (y[mt].x + y[mt].y) + (y[mt].z + y[mt].w);
        s += __shfl_xor(s, 16); s += __shfl_xor(s, 32);
        const float mean = s * (1.0f / 64.0f); float q = 0.f;
#pragma unroll
        for (int mt = 0; mt < 4; ++mt) { y[mt] = y[mt] - mean; q += (y[mt].x * y[mt].x + y[mt].y * y[mt].y) + (y[mt].z * y[mt].z + y[mt].w * y[mt].w); }
        q += __shfl_xor(q, 16); q += __shfl_xor(q, 32);
        const float rstd = 1.0f / sqrtf(q * (1.0f / 64.0f) + GN_EPS);
        const int row = trow0 + fr; const int prow = (c == 0 && wq == 0 && fr == 0) ? (ROW_META + 15) : row - 1;
        const float bon = ((const float*)(ws + WS_BONUS))[(size_t)row * 32 + h];
        bf16_t* ya = (bf16_t*)(ws + WS_YA) + (size_t)row * D + h * 64;
#pragma unroll
        for (int mt = 0; mt < 4; ++mt) {
            const int i0 = 16 * mt + 4 * fq, hc = h * 64 + i0;
            const f32x4 gg = *(const f32x4*)(P.in[I_GNG] + hc), gb = *(const f32x4*)(P.in[I_GNB] + hc), mv = *(const f32x4*)(mu + C_V + hc);
            const u32x2 vc = *(const u32x2*)(pp + (size_t)row * NPAD + C_V + hc), vp = *(const u32x2*)(pp + (size_t)prow * NPAD + C_V + hc);
            f32x4 cv = (f32x4){bflo(vc.x), bfhi(vc.x), bflo(vc.y), bfhi(vc.y)}, pv = (f32x4){bflo(vp.x), bfhi(vp.x), bflo(vp.y), bfhi(vp.y)};
            const f32x4 v = cv + (pv - cv) * mv;
            const f32x4 o = (y[mt] * rstd * gg + gb + v * bon) * gacc[mt];
            u32x2 w; w.x = pk2(o.x, o.y); w.y = pk2(o.z, o.w);
            *(u32x2*)(ya + i0) = w;
        }
        BLOCK_SYNC();
    }
}
__device__ __forceinline__ void phase5b(const Params& P) {
    const int lane = threadIdx.x & 63, wave = threadIdx.x >> 6;
    const int gw = blockIdx.x * 8 + wave, NGW = gridDim.x * 8;
    unsigned char* ws = P.ws;
    for (int r = gw; r < NTOK; r += NGW)
        ln_row_bf16((const float*)(ws + WS_X1) + (size_t)r * D, P.in[I_LN1G], P.in[I_LN1B], (bf16_t*)(ws + WS_H1B) + (size_t)r * D, lane);
    for (int r = gw; r < 32768; r += NGW) {
        const float* src = (r < 16384 ? P.in[I_UT] : P.in[I_VT]) + (size_t)(r & 16383) * D;
        int* dst = (int*)(ws + (r < 16384 ? WS_UB : WS_VB) + (size_t)(r & 16383) * D);
        f32x4 v[8]; float am = 0.f;
#pragma unroll
        for (int j = 0; j < 8; ++j) { v[j] = ((const f32x4*)src)[lane + 64 * j]; am = fmaxf(am, fmaxf(fmaxf(fabsf(v[j].x), fabsf(v[j].y)), fmaxf(fabsf(v[j].z), fabsf(v[j].w)))); }
        am = wave_max_dpp(am);
        const float s = am > 0.f ? 256.0f / am : 1.0f;
#pragma unroll
        for (int j = 0; j < 8; ++j) { int w = 0; w = __builtin_amdgcn_cvt_pk_fp8_f32(v[j].x * s, v[j].y * s, w, false); w = __builtin_amdgcn_cvt_pk_fp8_f32(v[j].z * s, v[j].w * s, w, true); dst[lane + 64 * j] = w; }
        if (lane == 0) ((float*)(ws + WS_TSC))[r] = am > 0.f ? am * (1.0f / 256.0f) : 1.0f;
    }
}

__device__ __forceinline__ void phase7(const Params& P, ldsp lds) {
    const int tid = threadIdx.x, lane = tid & 63, wave = tid >> 6, fr = lane & 15, fq = lane >> 4;
    unsigned char* ws = P.ws;
    const bf16_t* qb = (const bf16_t*)(ws + WS_Q); const bf16_t* sk = (const bf16_t*)(ws + WS_SUBK);
    int* eout = (int*)(ws + WS_EXP); float* gout = (float*)(ws + WS_GATE);
    constexpr int O_SC = 0, O_SV = 64 * 132 * 4, O_SI = O_SV + 64 * 16 * 4;
    const float NEG = -3.0e38f;
    for (int tile = blockIdx.x; tile < 256; tile += gridDim.x) {
        const int tok0 = tile * 32;
        for (int h = 0; h < 8; ++h) {
            {
                f32x4 acc[2][2];
#pragma unroll
                for (int p = 0; p < 2; ++p)
#pragma unroll
                    for (int nt = 0; nt < 2; ++nt) acc[p][nt] = (f32x4){0.f, 0.f, 0.f, 0.f};
#pragma unroll
                for (int ks = 0; ks < 4; ++ks) {
#pragma unroll
                    for (int p = 0; p < 2; ++p) {
                        const bf16x8 a = *(const bf16x8*)(sk + (size_t)(p * 128 + 16 * wave + fr) * 128 + ks * 32 + fq * 8);
#pragma unroll
                        for (int nt = 0; nt < 2; ++nt) {
                            const bf16x8 bq = *(const bf16x8*)(qb + (size_t)(tok0 + 16 * nt + fr) * D + h * 256 + p * 128 + ks * 32 + fq * 8);
                            acc[p][nt] = mfma16(a, bq, acc[p][nt]);
                        }
                    }
                }
#pragma unroll
                for (int p = 0; p < 2; ++p)
#pragma unroll
                    for (int nt = 0; nt < 2; ++nt) *(LAS f32x4*)(lds + O_SC + (((16 * nt + fr) * 2 + p) * 132 + 16 * wave + 4 * fq) * 4) = acc[p][nt];
            }
            BLOCK_SYNC();
            {
                const int row = tid >> 3, sub = tid & 7;
                float v[16];
#pragma unroll
                for (int c4 = 0; c4 < 4; ++c4) { const f32x4 x = *(const LAS f32x4*)(lds + O_SC + (row * 132 + sub * 16 + c4 * 4) * 4); v[4 * c4] = x.x; v[4 * c4 + 1] = x.y; v[4 * c4 + 2] = x.z; v[4 * c4 + 3] = x.w; }
                float rv0 = 0.f, rv1 = 0.f; int ri0 = 0, ri1 = 0;
                for (int round = 0; round < 16; ++round) {
                    float bv = v[0]; int bi = 0;
#pragma unroll
                    for (int i = 1; i < 16; ++i) { const bool gt = v[i] > bv; bv = gt ? v[i] : bv; bi = gt ? i : bi; }
                    int gi = sub * 16 + bi;
#pragma unroll
                    for (int o = 1; o < 8; o <<= 1) { const float ov = __shfl_xor(bv, o); const int oi = __shfl_xor(gi, o); const bool tk = (ov > bv) || (ov == bv && oi < gi); bv = tk ? ov : bv; gi = tk ? oi : gi; }
                    if ((round & 7) == sub) { if (round < 8) { rv0 = bv; ri0 = gi; } else { rv1 = bv; ri1 = gi; } }
                    const int li = ((gi >> 4) == sub) ? (gi & 15) : -1;
#pragma unroll
                    for (int i = 0; i < 16; ++i) v[i] = (i == li) ? NEG : v[i];
                }
                *(LAS float*)(lds + O_SV + (row * 16 + sub) * 4) = rv0; *(LAS float*)(lds + O_SV + (row * 16 + sub + 8) * 4) = rv1;
                *(LAS int*)(lds + O_SI + (row * 16 + sub) * 4) = ri0; *(LAS int*)(lds + O_SI + (row * 16 + sub + 8) * 4) = ri1;
            }
            BLOCK_SYNC();
            {
                const int tok = tid >> 4, a = tid & 15;
                const float s0 = *(const LAS float*)(lds + O_SV + ((tok * 2 + 0) * 16 + a) * 4); const int i0 = *(const LAS int*)(lds + O_SI + ((tok * 2 + 0) * 16 + a) * 4);
                float cnd[16]; int i1[16];
#pragma unroll
                for (int c4 = 0; c4 < 4; ++c4) {
                    const f32x4 x = *(const LAS f32x4*)(lds + O_SV + ((tok * 2 + 1) * 16 + c4 * 4) * 4);
                    cnd[4 * c4] = s0 + x.x; cnd[4 * c4 + 1] = s0 + x.y; cnd[4 * c4 + 2] = s0 + x.z; cnd[4 * c4 + 3] = s0 + x.w;
#pragma unroll
                    for (int i = 0; i < 4; ++i) i1[4 * c4 + i] = *(const LAS int*)(lds + O_SI + ((tok * 2 + 1) * 16 + c4 * 4 + i) * 4);
                }
                float myv = 0.f; int mye = 0;
                for (int round = 0; round < 16; ++round) {
                    float bv = cnd[0]; int bi = 0, be = i1[0];
#pragma unroll
                    for (int i = 1; i < 16; ++i) { const bool gt = cnd[i] > bv; bv = gt ? cnd[i] : bv; bi = gt ? i : bi; be = gt ? i1[i] : be; }
                    int gi = a * 16 + bi, ge = i0 * 128 + be;
#pragma unroll
                    for (int o = 1; o < 16; o <<= 1) { const float ov = __shfl_xor(bv, o); const int oi = __shfl_xor(gi, o), oe = __shfl_xor(ge, o); const bool tk = (ov > bv) || (ov == bv && oi < gi); bv = tk ? ov : bv; gi = tk ? oi : gi; ge = tk ? oe : ge; }
                    if (round == a) { myv = bv; mye = ge; }
                    const int li = ((gi >> 4) == a) ? (gi & 15) : -1;
#pragma unroll
                    for (int i = 0; i < 16; ++i) cnd[i] = (i == li) ? NEG : cnd[i];
                }
                float mx = myv;
#pragma unroll
                for (int o = 1; o < 16; o <<= 1) mx = fmaxf(mx, __shfl_xor(mx, o));
                const float ex = __expf(myv - mx); float sm = ex;
#pragma unroll
                for (int o = 1; o < 16; o <<= 1) sm += __shfl_xor(sm, o);
                eout[(size_t)(tok0 + tok) * 128 + h * 16 + a] = mye;
                gout[(size_t)(tok0 + tok) * 128 + h * 16 + a] = ex / sm;
            }
            BLOCK_SYNC();
        }
    }
}
__device__ __forceinline__ float gelu_exact(float x) { return 0.5f * x * (1.0f + erff(x * 0.70710678118654752f)); }
__device__ __forceinline__ float dot16_fp8(const u32x4 w, const float* x) {
    float s0 = 0.f, s1 = 0.f;
    const int ww[4] = {(int)w.x, (int)w.y, (int)w.z, (int)w.w};
#pragma unroll
    for (int q = 0; q < 4; ++q) { const f32x2 lo = __builtin_amdgcn_cvt_pk_f32_fp8(ww[q], false), hi = __builtin_amdgcn_cvt_pk_f32_fp8(ww[q], true);
        s0 += lo.x * x[4 * q] + hi.x * x[4 * q + 2]; s1 += lo.y * x[4 * q + 1] + hi.y * x[4 * q + 3]; }
    return s0 + s1;
}
__device__ __forceinline__ void axpy16_fp8(const u32x4 w, float a, float* o) {
    const int ww[4] = {(int)w.x, (int)w.y, (int)w.z, (int)w.w};
#pragma unroll
    for (int q = 0; q < 4; ++q) { const f32x2 lo = __builtin_amdgcn_cvt_pk_f32_fp8(ww[q], false), hi = __builtin_amdgcn_cvt_pk_f32_fp8(ww[q], true);
        o[4 * q] += a * lo.x; o[4 * q + 1] += a * lo.y; o[4 * q + 2] += a * hi.x; o[4 * q + 3] += a * hi.y; }
}
__device__ __forceinline__ void phase8(const Params& P) {
    const int lane = threadIdx.x & 63, wave = threadIdx.x >> 6;
    const int gw = blockIdx.x * 8 + wave, NGW = gridDim.x * 8;
    unsigned char* ws = P.ws;
    const unsigned char* Ub = ws + WS_UB; const unsigned char* Vb = ws + WS_VB;
    const int* eidx = (const int*)(ws + WS_EXP); const float* gts = (const float*)(ws + WS_GATE); const float* tsc = (const float*)(ws + WS_TSC);
    for (int tok = gw; tok < NTOK; tok += NGW) {
        int lo16 = lane * 16; asm volatile("" : "+v"(lo16));
        float x[32], o[32];
        {
            const bf16_t* hr = (const bf16_t*)(ws + WS_H1B) + (size_t)tok * D + lo16;
#pragma unroll
            for (int i = 0; i < 2; ++i) { unpack8(*(const u32x4*)(hr + 1024 * i), x + 16 * i); unpack8(*(const u32x4*)(hr + 1024 * i + 8), x + 16 * i + 8); }
#pragma unroll
            for (int i = 0; i < 32; ++i) o[i] = 0.f;
        }
        const int e_lo = eidx[(size_t)tok * 128 + lane], e_hi = eidx[(size_t)tok * 128 + 64 + lane];
        const float su_lo = tsc[e_lo], su_hi = tsc[e_hi];
        const float gv_lo = gts[(size_t)tok * 128 + lane] * tsc[16384 + e_lo], gv_hi = gts[(size_t)tok * 128 + 64 + lane] * tsc[16384 + e_hi];
        u32x4 ua[2][2], va[2][2], ub[2][2], vb[2][2];
        auto issue = [&](int g, u32x4 (&uu)[2][2], u32x4 (&vv)[2][2]) {
            const int ev = (g < 32) ? e_lo : e_hi;
#pragma unroll
            for (int j = 0; j < 2; ++j) {
                const int e = __builtin_amdgcn_readlane(ev, (2 * g + j) & 63);
                const unsigned char* up = Ub + (size_t)e * D + lo16; const unsigned char* vp = Vb + (size_t)e * D + lo16;
#pragma unroll
                for (int i = 0; i < 2; ++i) { uu[j][i] = *(const u32x4*)(up + 1024 * i); vv[j][i] = *(const u32x4*)(vp + 1024 * i); }
            }
        };
        auto consume = [&](int g, const u32x4 (&uu)[2][2], const u32x4 (&vv)[2][2]) {
            const float suv = (g < 32) ? su_lo : su_hi, gvv = (g < 32) ? gv_lo : gv_hi;
            float dd[2];
#pragma unroll
            for (int j = 0; j < 2; ++j) dd[j] = dot16_fp8(uu[j][0], x) + dot16_fp8(uu[j][1], x + 16);
#pragma unroll
            for (int j = 0; j < 2; ++j) dd[j] = wave_sum_dpp(dd[j]);
            const int l0 = (2 * g) & 63;
            const pg8::f32x2 ge = pg8::gelu_pk((pg8::f32x2){dd[0] * readlane_f(suv, l0), dd[1] * readlane_f(suv, l0 + 1)});
            const float a0 = ge.x * readlane_f(gvv, l0), a1 = ge.y * readlane_f(gvv, l0 + 1);
            axpy16_fp8(vv[0][0], a0, o); axpy16_fp8(vv[0][1], a0, o + 16);
            axpy16_fp8(vv[1][0], a1, o); axpy16_fp8(vv[1][1], a1, o + 16);
        };
        issue(0, ua, va);
        for (int g = 0; g < 64; g += 2) {
            issue(g + 1, ub, vb);
            consume(g, ua, va);
            if (g + 2 < 64) issue(g + 2, ua, va);
            consume(g + 1, ub, vb);
        }
        float s = 0.f;
#pragma unroll
        for (int i = 0; i < 32; ++i) { o[i] += DN_ALPHA * x[i]; s += o[i]; }
        const float mean = wave_sum_dpp(s) * (1.0f / D); float q = 0.f;
#pragma unroll
        for (int i = 0; i < 32; ++i) { o[i] -= mean; q += o[i] * o[i]; }
        const float rstd = 1.0f / sqrtf(wave_sum_dpp(q) * (1.0f / D) + LN_EPS);
        float* orow = P.out + (size_t)tok * D + lo16;
#pragma unroll
        for (int i = 0; i < 2; ++i)
#pragma unroll
            for (int c = 0; c < 4; ++c) {
                const int off = 1024 * i + lo16 + 4 * c;
                const f32x4 g0 = *(const f32x4*)(P.in[I_LN2G] + off), b0 = *(const f32x4*)(P.in[I_LN2B] + off);
                f32x4 r0;
                r0.x = o[16 * i + 4 * c + 0] * rstd * g0.x + b0.x; r0.y = o[16 * i + 4 * c + 1] * rstd * g0.y + b0.y; r0.z = o[16 * i + 4 * c + 2] * rstd * g0.z + b0.z; r0.w = o[16 * i + 4 * c + 3] * rstd * g0.w + b0.w;
                *(f32x4*)(orow + 1024 * i + 4 * c) = r0;
            }
    }
}
#ifndef MK_MULTI
#define MK_MULTI 0
#endif
__global__ __launch_bounds__(512, 2) void hybrid_fwd(Params P) {
    extern __shared__ __attribute__((aligned(16))) unsigned char shm[];
    ldsp lds = (ldsp)shm;
    cg::grid_group grid = cg::this_grid();
    unsigned char* ws = P.ws;
    volatile LAS unsigned* xst = (volatile LAS unsigned*)(lds + LDS_BYTES - 16);
    if (threadIdx.x == 0) { xst[0] = 0u; xst[1] = 0u; }
    __syncthreads();
    const XcdBarrier xbar = xcd_barrier_post((unsigned*)(ws + WS_BAR), xst);
    const int lo = P.ph_lo, hi = P.ph_hi;
#ifdef DBG_TA
    unsigned long long ts0 = 0, ts1 = 0, ts2 = 0, ts3 = 0, ts4 = 0, ts5 = 0, ts6 = 0, ts7 = 0, ts8 = 0, ts9 = 0, ts10 = 0, ts11 = 0;
#define STAMP(k) ts##k = __builtin_amdgcn_s_memrealtime()
#else
#define STAMP(k) do { } while (0)
#endif
    STAMP(0);
#ifndef REPEAT_PHASE
#define REPEAT_PHASE -1
#define REPEAT_N 1
#endif
#define PHASE(k) if (lo <= (k) && (k) < hi) for (int rep_ = 0; rep_ < ((k) == REPEAT_PHASE ? REPEAT_N : 1); ++rep_)
#define SEAM(k) do { if (lo <= (k) && (k) + 1 < hi) { if ((k) == 0) { asm volatile("s_waitcnt vmcnt(0) lgkmcnt(0)" ::: "memory"); __syncthreads(); grid.sync(); } xcd_barrier(xbar); } } while (0)
    PHASE(0) phase0(P);
    SEAM(0); STAMP(1);
    PHASE(1) { pg8::EpiBf16<0> E; E.O = (bf16_t*)(ws + WS_P); E.ldc = NPAD; E.bias = nullptr; E.split_cols = 0; E.split_stride = 0;
        run_gemm(lds, (const bf16_t*)(ws + WS_H0B), (const bf16_t*)(ws + WS_WTIN), MROWS, NPAD, 2048, E); }
    SEAM(1); STAMP(2);
    PHASE(2) phase2(P, lds);
    SEAM(2); STAMP(3);
    PHASE(3) phase3(P);
    SEAM(3); STAMP(4);
    PHASE(4) phase3b(P, lds);
    SEAM(4); STAMP(5);
    PHASE(5) {
        { pg8::EpiGateA E; E.C = (float*)(ws + WS_MPART); E.p = (const bf16_t*)(ws + WS_P); E.bgate = P.in[I_BGATE];
          run_gemm(lds, (const bf16_t*)(ws + WS_YA), (const bf16_t*)(ws + WS_WTA), NTOK, 2048, 2048, E); }
        { pg8::EpiGateB E; E.C = (const float*)(ws + WS_MPART); E.O = (bf16_t*)(ws + WS_MERGED); E.p = (const bf16_t*)(ws + WS_P); E.bgate = P.in[I_BGATE];
          run_gemm(lds, (const bf16_t*)(ws + WS_YB), (const bf16_t*)(ws + WS_WTB), NTOK, 2048, 1024, E); }
    }
    SEAM(5); STAMP(6);
    PHASE(6) { pg8::EpiResid E; E.C = (float*)(ws + WS_X1); E.h0 = (const bf16_t*)(ws + WS_H0B); E.alpha = DN_ALPHA;
        run_gemm(lds, (const bf16_t*)(ws + WS_MERGED), (const bf16_t*)(ws + WS_WTOUT), NTOK, 2048, 2048, E); }
    SEAM(6); STAMP(7);
    PHASE(7) phase5b(P);
    SEAM(7); STAMP(8);
    PHASE(8) { pg8::EpiBf16<0> E; E.O = (bf16_t*)(ws + WS_Q); E.ldc = D; E.bias = nullptr; E.split_cols = 0; E.split_stride = 0;
        run_gemm(lds, (const bf16_t*)(ws + WS_H1B), (const bf16_t*)(ws + WS_WTQ), NTOK, 2048, 2048, E); }
    SEAM(8); STAMP(9);
    PHASE(9) phase7(P, lds);
    SEAM(9); STAMP(10);
    PHASE(10) phase8(P);
#ifdef DBG_TA
    {
        __threadfence_system(); asm volatile("s_waitcnt vmcnt(0) lgkmcnt(0)" ::: "memory"); __syncthreads(); grid.sync(); __threadfence_system();
        STAMP(11);
        const unsigned long long tt[12] = {ts0, ts1, ts2, ts3, ts4, ts5, ts6, ts7, ts8, ts9, ts10, ts11};
        const float ta = (float)(tt[DBG_TA + 1] - tt[DBG_TA]) * 0.01f, tb = (float)(tt[DBG_TB + 1] - tt[DBG_TB]) * 0.01f;
        if (blockIdx.x == 0) { for (int i = threadIdx.x + 1; i <= 1000000; i += 512) P.out[i] = tb; if (threadIdx.x == 0) P.out[0] = 1000.0f * ta; }
    }
#endif
#ifdef DBG_STOP
    {
        __threadfence_system(); asm volatile("s_waitcnt vmcnt(0) lgkmcnt(0)" ::: "memory"); __syncthreads(); grid.sync(); __threadfence_system();
        const size_t a = DBG_A, b = DBG_B; const unsigned* w = (const unsigned*)(ws + a); const size_t nw = (b - a) / 4, NO = (size_t)NTOK * D;
        for (size_t i = (size_t)blockIdx.x * 512 + threadIdx.x; i < NO; i += (size_t)gridDim.x * 512) {
            unsigned acc = 0; for (size_t j = i; j < nw; j += NO) { const unsigned x = w[j]; acc += (x & 0xffffu) + (x >> 16); }
            P.out[i] = (float)(acc & 0xfffffu);
        }
    }
#endif
#undef PHASE
#undef SEAM
}

extern "C" void kernel_launch(void* const* d_in, const int* in_sizes, int n_in, void* d_out, int out_size, void* d_ws, size_t ws_size, hipStream_t stream) {
    static int grid = 0;
    if (grid == 0) {
        if (n_in != 30 || out_size != NTOK * D || ws_size < WS_END) { fprintf(stderr, "kernel_launch: unexpected shapes (n_in %d, out %d, ws %zu < %zu)\n", n_in, out_size, ws_size, (size_t)WS_END); grid = -1; return; }
        int dev = 0, cus = 0, per_cu = 0;
        if (hipGetDevice(&dev) != hipSuccess || hipDeviceGetAttribute(&cus, hipDeviceAttributeMultiprocessorCount, dev) != hipSuccess) { grid = -1; return; }
        if (hipFuncSetAttribute((const void*)hybrid_fwd, hipFuncAttributeMaxDynamicSharedMemorySize, LDS_BYTES) != hipSuccess) { fprintf(stderr, "kernel_launch: hipFuncSetAttribute failed\n"); grid = -1; return; }
        if (hipOccupancyMaxActiveBlocksPerMultiprocessor(&per_cu, (const void*)hybrid_fwd, 512, LDS_BYTES) != hipSuccess || per_cu < 1) { fprintf(stderr, "kernel_launch: occupancy query says %d\n", per_cu); grid = -1; return; }
        (void)hipGetLastError();
        grid = cus;
    }
    if (grid < 0) return;
    if (hipMemsetAsync((unsigned char*)d_ws + WS_BAR, 0, XCD_BAR_WORDS * 4, stream) != hipSuccess) { fprintf(stderr, "kernel_launch: memset failed\n"); return; }
    Params p{};
    for (int i = 0; i < 30; ++i) p.in[i] = (const float*)d_in[i];
    p.out = (float*)d_out; p.ws = (unsigned char*)d_ws;
#if MK_MULTI
    for (int ph = 0; ph <= NPHASE; ++ph) { p.ph_lo = ph; p.ph_hi = ph + 1; hipLaunchKernelGGL(hybrid_fwd, dim3(grid), dim3(512), LDS_BYTES, stream, p); }
#else
    p.ph_lo = 0; p.ph_hi = NPHASE + 1;
#ifdef DBG_STOP
    p.ph_hi = DBG_STOP + 1;
#endif
    void* args[] = {&p};
    hipError_t e = hipLaunchCooperativeKernel((const void*)hybrid_fwd, dim3(grid), dim3(512), args, LDS_BYTES, stream);
    if (e != hipSuccess) fprintf(stderr, "kernel_launch: cooperative launch failed: %s (grid %d)\n", hipGetErrorString(e), grid);
#endif
}
```

```cpp
#include <hip/hip_runtime.h>
#include <hip/hip_cooperative_groups.h>
#include <cstdio>
#include <cstdint>
namespace cg = cooperative_groups;
namespace pg8 {
#define PG8_LAS __attribute__((address_space(3)))
typedef unsigned short bf16_t;
typedef short bf16x8 __attribute__((ext_vector_type(8)));
typedef float f32x4 __attribute__((ext_vector_type(4)));
typedef unsigned u32x4 __attribute__((ext_vector_type(4)));
constexpr int BM = 256, BK = 64, HALF = 128, HTB = HALF * BK * 2  , STAGE_BYTES = 8 * HTB, NXCD = 8, WGM = 8;

__host__ __device__ __forceinline__ int lds_byte(int r, int c) { const int st = (r >> 4) * 2 + (c >> 5), rr = r & 15, cc = c & 31, ob = rr * 64 + cc * 2; return st * 1024 + (ob ^ (((ob >> 9) & 1) << 5)); }
__host__ __device__ __forceinline__ void stage_rc(int b, int& R, int& C) { const int st = b / 1024, sb = b % 1024, swz = sb ^ (((sb >> 9) & 1) << 5); R = (st >> 1) * 16 + swz / 64; C = (st & 1) * 32 + (swz % 64) / 2; }
__host__ __device__ __forceinline__ int perm32(int rho) { const int n = rho >> 4, i = rho & 15; return 8 * (i >> 2) + 4 * n + (i & 3); }

struct Unit { int pm, pn; };
struct Gemm { const bf16_t* A; const bf16_t* Bt; int M, N, K; };

struct StaticOrder {
    int nM, nN, nwg, G, c;
    __host__ __device__ void init(int M, int N, int G_, int c_) { nM = M / BM; nN = N / BM; nwg = nM * nN; G = G_; c = c_; }
    __host__ __device__ bool next(int i, Unit& u) const {
        const long L = (long)i * G + c; if (L >= nwg) return false;
        int wgid = (int)L; { const int q = nwg / NXCD, r = nwg % NXCD, xcd = wgid % NXCD, off = wgid / NXCD; wgid = (xcd < r ? xcd * (q + 1) : r * (q + 1) + (xcd - r) * q) + off; }
        const int nig = WGM * nN, gid = wgid / nig, fm = gid * WGM, gsz = (nM - fm) < WGM ? (nM - fm) : WGM;
        u.pm = fm + ((wgid % nig) % gsz); u.pn = (wgid % nig) / gsz; return true;
    }
    __device__ __forceinline__ void a_ready(const Unit&) const {}
    __device__ __forceinline__ void done(const Unit&) const {}
};
struct CountedOrder : StaticOrder {
    const unsigned* ready; unsigned need; unsigned* tmo;
    __device__ __forceinline__ void a_ready(const Unit& u) const {
        if (threadIdx.x < 64) {
            const unsigned long long t0 = __builtin_amdgcn_s_memrealtime(); unsigned polls = 0;
            while ((unsigned)__builtin_amdgcn_readfirstlane(__hip_atomic_load(ready + 64 * u.pm, __ATOMIC_RELAXED, __HIP_MEMORY_SCOPE_AGENT)) < need) {
                if ((++polls & 255u) == 0u && __builtin_amdgcn_readfirstlane(__hip_atomic_load(tmo, __ATOMIC_RELAXED, __HIP_MEMORY_SCOPE_AGENT)) != 0u) break;
                if (__builtin_amdgcn_s_memrealtime() - t0 > 2000000ull) {
                    if (threadIdx.x == 0) { unsigned expect = 0u; __hip_atomic_compare_exchange_strong(tmo + 1, &expect, 0x600u | (unsigned)(u.pm & 0xff), __ATOMIC_RELAXED, __ATOMIC_RELAXED, __HIP_MEMORY_SCOPE_AGENT); __hip_atomic_store(tmo, 1u, __ATOMIC_RELAXED, __HIP_MEMORY_SCOPE_AGENT); }
                    break; }
                __builtin_amdgcn_s_sleep(2); }
            __builtin_amdgcn_fence(__ATOMIC_ACQUIRE, "agent");
            asm volatile("s_waitcnt vmcnt(0)" ::: "memory");
        }
#if !defined(BROKEN_HOOK_NO_BARRIER)
        asm volatile("" ::: "memory"); __builtin_amdgcn_s_barrier(); asm volatile("" ::: "memory");
#endif
    }
};

typedef float cvt_f32x2 __attribute__((ext_vector_type(2))); typedef __bf16 cvt_bf16x2 __attribute__((ext_vector_type(2)));
__device__ __forceinline__ unsigned cvt_pk_bf16(float lo, float hi) { const cvt_f32x2 v = {lo, hi}; const cvt_bf16x2 b = __builtin_convertvector(v, cvt_bf16x2); return __builtin_bit_cast(unsigned, b); }
typedef float f32x2 __attribute__((ext_vector_type(2)));
__device__ __forceinline__ f32x2 gelu_pk(f32x2 v) {
    const f32x2 av = __builtin_elementwise_abs(v), d = av * 0.2316418882f + 1.0f;
    f32x2 t; t.x = __builtin_amdgcn_rcpf(d.x); t.y = __builtin_amdgcn_rcpf(d.y);
    f32x2 q = t * 0.5307027145f + (-0.7265760135f); q = q * t + 0.7107068705f; q = q * t + (-0.142248368f); q = q * t + 0.127414796f; q = q * t;
    const f32x2 s = (v * v) * (-0.72134752044f);
    f32x2 e; e.x = __builtin_amdgcn_exp2f(s.x); e.y = __builtin_amdgcn_exp2f(s.y);
    const f32x2 m = v * (q * e), r = v - m;
    f32x2 o; o.x = v.x < 0.f ? m.x : r.x; o.y = v.y < 0.f ? m.y : r.y; return o;
}

struct EpiF32 {
    static constexpr bool PERM = false, AFTER_DRAIN = false;
    float* C; int ldc; const float* bias;
    __device__ __forceinline__ void operator()(const f32x4 (&acc)[2][2][4][2], const Unit& u, int wr, int wc, int fr, int fq) const {
        const int row0 = u.pm * BM + wr * 64 + fr, col0 = u.pn * BM + wc * 32 + 4 * fq;
        f32x4 bv[2][2];
#pragma unroll
        for (int bj = 0; bj < 2; ++bj)
#pragma unroll
            for (int n = 0; n < 2; ++n) bv[bj][n] = bias ? *(const f32x4*)(bias + col0 + bj * HALF + n * 16) : (f32x4){0.f, 0.f, 0.f, 0.f};
#pragma unroll
        for (int ai = 0; ai < 2; ++ai)
#pragma unroll
            for (int m = 0; m < 4; ++m) { float* rowp = C + (size_t)(row0 + ai * HALF + m * 16) * ldc + col0;
#pragma unroll
                for (int bj = 0; bj < 2; ++bj)
#pragma unroll
                    for (int n = 0; n < 2; ++n) *(f32x4*)(rowp + bj * HALF + n * 16) = acc[ai][bj][m][n] + bv[bj][n]; }
    }
};
template <int ACT  > struct EpiBf16 {
    static constexpr bool PERM = true, AFTER_DRAIN = false;
    bf16_t* O; int ldc; const float* bias; int split_cols; size_t split_stride;
    __device__ __forceinline__ void operator()(const f32x4 (&acc)[2][2][4][2], const Unit& u, int wr, int wc, int fr, int fq) const {
        const int row0 = u.pm * BM + wr * 64 + fr; int colt = u.pn * BM; bf16_t* base = O;
        if (split_cols) { const int t = colt / split_cols; base += (size_t)t * split_stride; colt -= t * split_cols; }
        const int col0 = colt + wc * 32 + 8 * fq, bcol0 = u.pn * BM + wc * 32 + 8 * fq;
        f32x4 bv[2][2];
#pragma unroll
        for (int bj = 0; bj < 2; ++bj)
#pragma unroll
            for (int n = 0; n < 2; ++n) bv[bj][n] = bias ? *(const f32x4*)(bias + bcol0 + bj * HALF + 4 * n) : (f32x4){0.f, 0.f, 0.f, 0.f};
#pragma unroll
        for (int ai = 0; ai < 2; ++ai)
#pragma unroll
            for (int m = 0; m < 4; ++m) { bf16_t* rowp = base + (size_t)(row0 + ai * HALF + m * 16) * ldc + col0;
#pragma unroll
                for (int bj = 0; bj < 2; ++bj) { f32x4 v0 = acc[ai][bj][m][0] + bv[bj][0], v1 = acc[ai][bj][m][1] + bv[bj][1];
                    if (ACT == 1) { f32x2 a = gelu_pk((f32x2){v0[0], v0[1]}), b = gelu_pk((f32x2){v0[2], v0[3]}), c = gelu_pk((f32x2){v1[0], v1[1]}), d = gelu_pk((f32x2){v1[2], v1[3]});
                        v0 = (f32x4){a.x, a.y, b.x, b.y}; v1 = (f32x4){c.x, c.y, d.x, d.y}; }
                    if (ACT == 2) {
#pragma unroll
                        for (int j = 0; j < 4; ++j) { v0[j] = 0.5f * v0[j] * (1.0f + erff(v0[j] * 0.70710678f)); v1[j] = 0.5f * v1[j] * (1.0f + erff(v1[j] * 0.70710678f)); } }
                    u32x4 w; w.x = cvt_pk_bf16(v0[0], v0[1]); w.y = cvt_pk_bf16(v0[2], v0[3]); w.z = cvt_pk_bf16(v1[0], v1[1]); w.w = cvt_pk_bf16(v1[2], v1[3]);
                    *(u32x4*)(rowp + bj * HALF) = w; } }
    }
};
template <class Epi, class Sched, bool STAMP = false>
__device__ __forceinline__ void gemm_phase(PG8_LAS unsigned char* lds, const Gemm g, const Sched& S, const Epi& E, unsigned long long* stamps) {
    const int tid = threadIdx.x, wid = __builtin_amdgcn_readfirstlane(tid >> 6), lane = tid & 63, wr = wid >> 2, wc = wid & 3, fr = lane & 15, fq = lane >> 4;
    const int K = g.K, nt = K / BK;
    int ts_lo = 0, ts_hi = 0, nts = 0; const unsigned long long rt_entry = STAMP ? (unsigned long long)wall_clock64() : 0ull;
#define PG8_STAMP() do { if (STAMP && wid == 0 && nts < 64) { const unsigned long long _c = (unsigned long long)clock64(); \
        ts_lo = (lane == nts) ? (int)(unsigned)_c : ts_lo; ts_hi = (lane == nts) ? (int)(unsigned)(_c >> 32) : ts_hi; ++nts; } } while (0)
    PG8_STAMP();
    unsigned voffA[2], voffB[2];
#pragma unroll
    for (int i = 0; i < 2; ++i) { int R, C; stage_rc(tid * 16 + i * 8192, R, C); const int Rb = Epi::PERM ? ((R & ~31) + perm32(R & 31)) : R;
        voffA[i] = (unsigned)(R * K + C) * 2u; voffB[i] = (unsigned)(Rb * K + C) * 2u; }
    const size_t kstep = (size_t)(BK * 2);
    const size_t hstep = (size_t)HALF * K * 2;
    const size_t tstep = 2 * hstep;
    const unsigned ldsw = (unsigned)wid * 1024u;
    const int aoff = lds_byte(wr * 64 + fr, fq * 8), boff = lds_byte(wc * 32 + fr, fq * 8);
#define PG8_SA(b, h) (((b) * 2 + (h)) * HTB)
#define PG8_SB(b, h) ((4 + (b) * 2 + (h)) * HTB)
#define PG8_STAGE(bufoff, gbase, voff) do { _Pragma("unroll") for (int _i = 0; _i < 2; ++_i) \
        __builtin_amdgcn_global_load_lds((const unsigned*)((const char*)(gbase) + (voff)[_i]), (PG8_LAS unsigned*)(lds + (bufoff) + ldsw + _i * 8192), 16, 0, 0); } while (0)
#define PG8_LDA(dst, b, h) do { _Pragma("unroll") for (int m = 0; m < 4; ++m) _Pragma("unroll") for (int k = 0; k < 2; ++k) dst[m][k] = *(const PG8_LAS bf16x8*)(lds + PG8_SA(b, h) + aoff + m * 2048 + k * 1024); } while (0)
#define PG8_LDB(dst, b, h) do { _Pragma("unroll") for (int n = 0; n < 2; ++n) _Pragma("unroll") for (int k = 0; k < 2; ++k) dst[n][k] = *(const PG8_LAS bf16x8*)(lds + PG8_SB(b, h) + boff + n * 2048 + k * 1024); } while (0)
#define PG8_MMA(ai, bj, At, Bt) do { __builtin_amdgcn_s_setprio(1); _Pragma("unroll") for (int m = 0; m < 4; ++m) _Pragma("unroll") for (int n = 0; n < 2; ++n) _Pragma("unroll") for (int k = 0; k < 2; ++k) \
        acc[ai][bj][m][n] = __builtin_amdgcn_mfma_f32_16x16x32_bf16(Bt[n][k], At[m][k], acc[ai][bj][m][n], 0, 0, 0); __builtin_amdgcn_s_setprio(0); } while (0)
#define PG8_WAIT_V(n) asm volatile("s_waitcnt vmcnt(" #n ")" ::: "memory")
#define PG8_WAIT_L(n) asm volatile("s_waitcnt lgkmcnt(" #n ")" ::: "memory")
#define PG8_BAR __builtin_amdgcn_s_barrier()
#define PG8_SCHED __builtin_amdgcn_sched_barrier(0)
    Unit cur, nxt; int ui = 0;
    if (!S.next(0, cur)) return;
    f32x4 acc[2][2][4][2];
#pragma unroll
    for (int a = 0; a < 2; ++a)
#pragma unroll
        for (int b = 0; b < 2; ++b)
#pragma unroll
            for (int m = 0; m < 4; ++m)
#pragma unroll
                for (int n = 0; n < 2; ++n) acc[a][b][m][n] = (f32x4){0.f, 0.f, 0.f, 0.f};
    bf16x8 At[4][2], B0[2][2], B1[2][2];
    const char* cA = (const char*)g.A + (size_t)cur.pm * tstep; const char* cB = (const char*)g.Bt + (size_t)cur.pn * tstep;
    S.a_ready(cur);
    PG8_STAGE(PG8_SB(0, 0), cB, voffB); PG8_STAGE(PG8_SA(0, 0), cA, voffA); PG8_STAGE(PG8_SB(0, 1), cB + hstep, voffB); PG8_STAGE(PG8_SA(0, 1), cA + hstep, voffA);
    if (wr == 1) PG8_BAR;
    PG8_WAIT_V(4); PG8_BAR;
    PG8_STAGE(PG8_SB(1, 0), cB + kstep, voffB); PG8_STAGE(PG8_SA(1, 0), cA + kstep, voffA); PG8_STAGE(PG8_SB(1, 1), cB + hstep + kstep, voffB);
    PG8_WAIT_V(6); PG8_BAR;
    PG8_STAMP();
    for (;;) {
        const bool has_next = S.next(ui + 1, nxt);
        const char* nA = has_next ? (const char*)g.A + (size_t)nxt.pm * tstep : cA; const char* nB = has_next ? (const char*)g.Bt + (size_t)nxt.pn * tstep : cB;
        for (int t = 0; t < nt; t += 2) {
            const bool last = (t == nt - 2);
            const char* a1 = cA + (size_t)(t + 1) * kstep;
            const char* a2 = last ? nA : cA + (size_t)(t + 2) * kstep; const char* b2 = last ? nB : cB + (size_t)(t + 2) * kstep;
            const char* a3 = a2 + kstep; const char* b3 = b2 + kstep;
            if (last && has_next) S.a_ready(nxt);
            PG8_LDB(B0, 0, 0); PG8_SCHED; PG8_LDA(At, 0, 0); PG8_STAGE(PG8_SA(1, 1), a1 + hstep, voffA);
            PG8_WAIT_L(8); PG8_BAR; PG8_WAIT_L(0); PG8_MMA(0, 0, At, B0); PG8_BAR; PG8_SCHED;
            PG8_LDB(B1, 0, 1); PG8_STAGE(PG8_SB(0, 0), b2, voffB);
            PG8_BAR; PG8_WAIT_L(0); PG8_MMA(0, 1, At, B1); PG8_BAR;
            PG8_LDA(At, 0, 1); PG8_STAGE(PG8_SA(0, 0), a2, voffA);
            PG8_BAR; PG8_WAIT_L(0); PG8_MMA(1, 0, At, B0); PG8_BAR; PG8_SCHED;
            PG8_STAGE(PG8_SB(0, 1), b2 + hstep, voffB);
            PG8_WAIT_V(6); PG8_BAR; PG8_MMA(1, 1, At, B1); PG8_BAR;
            PG8_LDB(B0, 1, 0); PG8_SCHED; PG8_LDA(At, 1, 0); PG8_STAGE(PG8_SA(0, 1), a2 + hstep, voffA);
            PG8_WAIT_L(8); PG8_BAR; PG8_WAIT_L(0); PG8_MMA(0, 0, At, B0); PG8_BAR; PG8_SCHED;
            PG8_LDB(B1, 1, 1); PG8_STAGE(PG8_SB(1, 0), b3, voffB);
            PG8_BAR; PG8_WAIT_L(0); PG8_MMA(0, 1, At, B1); PG8_BAR;
            PG8_LDA(At, 1, 1); PG8_STAGE(PG8_SA(1, 0), a3, voffA);
            PG8_BAR; PG8_WAIT_L(0); PG8_MMA(1, 0, At, B0); PG8_BAR; PG8_SCHED;
            PG8_STAGE(PG8_SB(1, 1), b3 + hstep, voffB);
            PG8_WAIT_V(6); PG8_BAR; PG8_MMA(1, 1, At, B1); PG8_BAR;
        }
        PG8_STAMP();
        if constexpr (!Epi::AFTER_DRAIN) { E(acc, cur, wr, wc, fr, fq); S.done(cur); }
        PG8_STAMP();
        if (!has_next) break;
#pragma unroll
        for (int a = 0; a < 2; ++a)
#pragma unroll
            for (int b = 0; b < 2; ++b)
#pragma unroll
                for (int m = 0; m < 4; ++m)
#pragma unroll
                    for (int n = 0; n < 2; ++n) acc[a][b][m][n] = (f32x4){0.f, 0.f, 0.f, 0.f};
        cur = nxt; cA = nA; cB = nB; ++ui;
    }
    PG8_WAIT_V(0);
    if (wr == 0) PG8_BAR;
    PG8_BAR;
    if constexpr (Epi::AFTER_DRAIN) { E.fused(acc, cur, wr, wc, fr, fq, lds, wid, lane); S.done(cur); }
    PG8_STAMP();
    if (STAMP && wid == 0) { stamps[lane] = lane < nts ? (((unsigned long long)(unsigned)ts_hi << 32) | (unsigned)ts_lo) : 0ull;
        if (lane == 62) stamps[62] = rt_entry; if (lane == 63) stamps[63] = (unsigned long long)wall_clock64(); }
#undef PG8_STAMP
#undef PG8_SA
#undef PG8_SB
#undef PG8_STAGE
#undef PG8_LDA
#undef PG8_LDB
#undef PG8_MMA
#undef PG8_WAIT_V
#undef PG8_WAIT_L
#undef PG8_BAR
#undef PG8_SCHED
}
}
#define LAS __attribute__((address_space(3)))
typedef unsigned short bf16_t;
typedef short bf16x8 __attribute__((ext_vector_type(8)));
typedef float f32x4 __attribute__((ext_vector_type(4)));
typedef float f32x2 __attribute__((ext_vector_type(2)));
typedef unsigned u32x4 __attribute__((ext_vector_type(4)));
typedef unsigned u32x2 __attribute__((ext_vector_type(2)));
typedef LAS unsigned char* ldsp;

constexpr int D = 2048, NTOK = 8192, SEQ = 4096, MROWS = 8448, ROW_META = 8192;
constexpr int INC = 11712, NPAD = 11776;
constexpr int C_R = 0, C_K = 2048, C_V = 4096, C_WL = 6144, C_AL = 6240, C_GL = 6336, C_POOL = 6592, C_G0 = 7616, C_G1 = 9664;
constexpr int NUNITS = 4128;
constexpr float DSCALE = 0.6065306597126334f;
constexpr float DN_ALPHA = 1.189207115002721f;
constexpr float GN_EPS = 64e-5f, LN_EPS = 1e-5f;

constexpr size_t WS_P = 0;
constexpr size_t WS_UB = 0;
constexpr size_t WS_VB = 33554432;
constexpr size_t WS_H0B = 198967296;
constexpr size_t WS_WTA = WS_H0B + 34603008;
constexpr size_t WS_WTB = WS_WTA + 8388608;
constexpr size_t WS_WTOUT = WS_WTB + 4194304;
constexpr size_t WS_WTQ = WS_WTOUT + 8388608;
constexpr size_t WS_WTPOOL = WS_WTQ + 8388608;
constexpr size_t WS_WTW2 = WS_WTPOOL + 524288;
constexpr size_t WS_WTA2 = WS_WTW2 + 393216;
constexpr size_t WS_WTG2 = WS_WTA2 + 393216;
constexpr size_t WS_SUBK = WS_WTG2 + 1048576;
constexpr size_t WS_BONUS = WS_SUBK + 65536;
constexpr size_t WS_REGC = WS_BONUS + 1048576;
constexpr size_t WS_WTIN = WS_REGC;
constexpr size_t UNITB = (size_t)NUNITS * 4096 * 2;
constexpr size_t WS_G = WS_REGC;
constexpr size_t WS_H0T = WS_REGC + UNITB;
constexpr size_t WS_RT = WS_REGC + 2 * UNITB;
constexpr size_t WS_Y0 = WS_REGC + 3 * UNITB;
constexpr size_t WS_S0T = WS_REGC + 4 * UNITB;
constexpr size_t WS_MERGED = WS_REGC;
constexpr size_t WS_MPART = WS_REGC + 33554432;
constexpr size_t WS_X1 = WS_REGC + 33554432;
constexpr size_t WS_H1B = WS_REGC + 100663296;
constexpr size_t WS_Q = WS_REGC + 134217728;
constexpr size_t WS_YA = WS_REGC + 5 * UNITB;
constexpr size_t WS_YB = WS_YA + 33554432;
constexpr size_t WS_EXP = WS_YB + 16777216;
constexpr size_t WS_GATE = WS_EXP + 4194304;
constexpr size_t WS_BAR = WS_GATE + 4194304;
constexpr size_t WS_TSC = WS_BAR + 16384;
constexpr size_t WS_END = WS_TSC + 131072;
static_assert(WS_Q + 33554432 <= WS_YA, "overlay");
static_assert(WS_VB + 33554432 <= WS_H0B, "overlay");

constexpr int LDS_BYTES = 163840;
constexpr int NPHASE = 10;

struct Params {
    const float* in[30];
    float* out;
    unsigned char* ws;
    int ph_lo, ph_hi;
};
enum { I_X = 0, I_META, I_LNIN_G, I_LNIN_B, I_WIN, I_MU, I_W0, I_WW2, I_A0, I_WA2, I_WG2, I_KK, I_KA, I_RK, I_GNG, I_GNB, I_WPOOL, I_PSCALE, I_BGATE,
       I_WBA, I_WBB, I_WOUT, I_LN1G, I_LN1B, I_WQ, I_SUBK, I_UT, I_VT, I_LN2G, I_LN2B };

__device__ __forceinline__ unsigned pk2(float lo, float hi) { return pg8::cvt_pk_bf16(lo, hi); }
__device__ __forceinline__ float bflo(unsigned w) { return __uint_as_float(w << 16); }
__device__ __forceinline__ float bfhi(unsigned w) { return __uint_as_float(w & 0xffff0000u); }
__device__ __forceinline__ float bf1(bf16_t h) { return __uint_as_float(((unsigned)h) << 16); }
__device__ __forceinline__ bf16_t f2bf1(float f) { return (bf16_t)(pk2(f, f) & 0xffffu); }
__device__ __forceinline__ float wave_sum(float v) {
#pragma unroll
    for (int o = 1; o < 64; o <<= 1) v += __shfl_xor(v, o);
    return v;
}
__device__ __forceinline__ float sigmoidf_(float x) { return 1.0f / (1.0f + __expf(-x)); }
__device__ __forceinline__ f32x4 mfma16(bf16x8 a, bf16x8 b, f32x4 c) { return __builtin_amdgcn_mfma_f32_16x16x32_bf16(a, b, c, 0, 0, 0); }
__device__ __forceinline__ void unpack8(const u32x4 w, float* f) {
    f[0] = bflo(w.x); f[1] = bfhi(w.x); f[2] = bflo(w.y); f[3] = bfhi(w.y); f[4] = bflo(w.z); f[5] = bfhi(w.z); f[6] = bflo(w.w); f[7] = bfhi(w.w);
}
__device__ __forceinline__ u32x4 pack8(const float* f) { u32x4 w; w.x = pk2(f[0], f[1]); w.y = pk2(f[2], f[3]); w.z = pk2(f[4], f[5]); w.w = pk2(f[6], f[7]); return w; }
#define DPPF(v, ctrl) __builtin_bit_cast(float, __builtin_amdgcn_update_dpp(0, __builtin_bit_cast(int, (v)), (ctrl), 0xF, 0xF, true))
__device__ __forceinline__ float readlane_f(float v, int l) { return __builtin_bit_cast(float, __builtin_amdgcn_readlane(__builtin_bit_cast(int, v), l)); }
__device__ __forceinline__ float wave_sum_dpp(float v) {
    v += DPPF(v, 0xB1); v += DPPF(v, 0x4E); v += DPPF(v, 0x141); v += DPPF(v, 0x140);
    return (readlane_f(v, 0) + readlane_f(v, 16)) + (readlane_f(v, 32) + readlane_f(v, 48));
}
__device__ __forceinline__ float wave_max_dpp(float v) {
    v = fmaxf(v, DPPF(v, 0xB1)); v = fmaxf(v, DPPF(v, 0x4E)); v = fmaxf(v, DPPF(v, 0x141)); v = fmaxf(v, DPPF(v, 0x140));
    return fmaxf(fmaxf(readlane_f(v, 0), readlane_f(v, 16)), fmaxf(readlane_f(v, 32), readlane_f(v, 48)));
}
#define BLOCK_SYNC() __syncthreads()
#define XB_TMO      128
#define XB_XCNT(j)  (256  + 64 * (j))
#define XB_XSUB(j)  (1280 + 64 * (j))
#define XB_XGEN(j)  (2304 + 64 * (j))
#define XB_TOP      3328
#define XB_TOPGEN   3392
#define XCD_BAR_WORDS 3456
#define XB_SPIN_CAP (1u << 18)

__device__ __forceinline__ unsigned xb_ld(unsigned* p)              { return __hip_atomic_load(p, __ATOMIC_RELAXED, __HIP_MEMORY_SCOPE_AGENT); }
__device__ __forceinline__ unsigned xb_add(unsigned* p, unsigned v) { return __hip_atomic_fetch_add(p, v, __ATOMIC_RELAXED, __HIP_MEMORY_SCOPE_AGENT); }
__device__ __forceinline__ unsigned xb_xcc_id() { return (unsigned)__builtin_amdgcn_s_getreg((3 << 11) | 20) & 0xFu; }
#define XB_SPIN(cond, bar) do { unsigned _sp = 0; while (cond) { __builtin_amdgcn_s_sleep(1); \
    if ((++_sp & 255u) == 0u) { if (xb_ld(&(bar)[XB_TMO])) break; if (_sp > XB_SPIN_CAP) { atomicAdd(&(bar)[XB_TMO], 1u); break; } } } } while (0)

struct XcdBarrier {
    unsigned* bar; unsigned x;
    volatile LAS unsigned* st;
};

__device__ __forceinline__ XcdBarrier xcd_barrier_post(unsigned* bar, volatile LAS unsigned* st) {
    XcdBarrier b; b.bar = bar; b.x = xb_xcc_id(); b.st = st;
    if (threadIdx.x == 0) (void)xb_add(&bar[XB_XCNT(b.x)], 1u);
    return b;
}
__device__ __forceinline__ void xcd_barrier_complete(unsigned* bar, unsigned x, unsigned& nloc, unsigned& nx) {
    const unsigned G = gridDim.x * gridDim.y * gridDim.z;
    unsigned sum, cnt, mine, sp = 0u;
    for (;;) {
        sum = 0u; cnt = 0u; mine = 0u;
#pragma unroll
        for (unsigned j = 0; j < 16; ++j) { const unsigned c = xb_ld(&bar[XB_XCNT(j)]); sum += c; cnt += (c > 0u) ? 1u : 0u; mine = (j == x) ? c : mine; }
        if (sum == G) break;
        __builtin_amdgcn_s_sleep(1);
        if ((++sp & 255u) == 0u) { if (xb_ld(&bar[XB_TMO])) break; if (sp > XB_SPIN_CAP) { atomicAdd(&bar[XB_TMO], 1u); break; } }
    }
    nloc = mine > 0u ? mine : 1u; nx = cnt > 0u ? cnt : 1u;
}

__device__ __forceinline__ void xcd_barrier(const XcdBarrier& b) {
    asm volatile("s_waitcnt vmcnt(0)" ::: "memory");
    __syncthreads();
    if (threadIdx.x == 0) {
        unsigned* bar = b.bar;
        __builtin_amdgcn_s_waitcnt(0);
        unsigned nloc = b.st[0], nx = b.st[1];
        if (nloc == 0u) { xcd_barrier_complete(bar, b.x, nloc, nx); b.st[0] = nloc; b.st[1] = nx; }
        const unsigned old = xb_add(&bar[XB_XSUB(b.x)], 1u);
        const unsigned gen = old / nloc;
        if (old + 1u == (gen + 1u) * nloc) {
            __builtin_amdgcn_fence(__ATOMIC_RELEASE, "agent");
            asm volatile("s_waitcnt vmcnt(0)" ::: "memory");
            const unsigned og = xb_add(&bar[XB_TOP], 1u);
            const unsigned tg = og / nx;
            if (og + 1u == (tg + 1u) * nx) xb_add(&bar[XB_TOPGEN], 1u);
            else XB_SPIN(xb_ld(&bar[XB_TOPGEN]) == tg, bar);
            __builtin_amdgcn_fence(__ATOMIC_ACQUIRE, "agent");
            xb_add(&bar[XB_XGEN(b.x)], 1u);
            asm volatile("s_waitcnt vmcnt(0)" ::: "memory");
        } else {
            XB_SPIN(xb_ld(&bar[XB_XGEN(b.x)]) == gen, bar);
            __builtin_amdgcn_fence(__ATOMIC_ACQUIRE, "agent");
            asm volatile("s_waitcnt vmcnt(0)" ::: "memory");
        }
    }
    __syncthreads();
}

__device__ __forceinline__ void ln_row_bf16(const float* src, const float* g, const float* b, bf16_t* dst, int lane) {
    f32x4 v[8]; float s = 0.f;
#pragma unroll
    for (int j = 0; j < 8; ++j) { v[j] = ((const f32x4*)src)[lane + 64 * j]; s += (v[j].x + v[j].y) + (v[j].z + v[j].w); }
    const float mean = wave_sum(s) * (1.0f / D); float s2 = 0.f;
#pragma unroll
    for (int j = 0; j < 8; ++j) { v[j] = v[j] - mean; s2 += (v[j].x * v[j].x + v[j].y * v[j].y) + (v[j].z * v[j].z + v[j].w * v[j].w); }
    const float rstd = 1.0f / sqrtf(wave_sum(s2) * (1.0f / D) + LN_EPS);
#pragma unroll
    for (int j = 0; j < 8; ++j) {
        const f32x4 gg = ((const f32x4*)g)[lane + 64 * j], bb = ((const f32x4*)b)[lane + 64 * j];
        const f32x4 o = v[j] * rstd * gg + bb;
        u32x2 w; w.x = pk2(o.x, o.y); w.y = pk2(o.z, o.w);
        ((u32x2*)dst)[lane + 64 * j] = w;
    }
}
__device__ __forceinline__ void transpose_item(const float* W, int K, int N, int Npad, bf16_t* Wt, int item, int lane) {
    const int nblk = Npad >> 6, kb = item / nblk, nb = item - kb * nblk, n = nb * 64 + lane, k0 = kb * 32;
    float v[32];
    if (n < N) {
#pragma unroll
        for (int i = 0; i < 32; ++i) v[i] = W[(size_t)(k0 + i) * N + n];
    } else {
#pragma unroll
        for (int i = 0; i < 32; ++i) v[i] = 0.f;
    }
    u32x4* o = (u32x4*)(Wt + (size_t)n * K + k0);
#pragma unroll
    for (int c = 0; c < 4; ++c) { u32x4 w; w.x = pk2(v[8 * c], v[8 * c + 1]); w.y = pk2(v[8 * c + 2], v[8 * c + 3]); w.z = pk2(v[8 * c + 4], v[8 * c + 5]); w.w = pk2(v[8 * c + 6], v[8 * c + 7]); o[c] = w; }
}
__device__ __forceinline__ void phase0(const Params& P) {
    const int lane = threadIdx.x & 63, wave = threadIdx.x >> 6;
    const int gw = blockIdx.x * 8 + wave, NGW = gridDim.x * 8;
    unsigned char* ws = P.ws;
    constexpr int T_IN = 64 * 184, T_A = 64 * 32, T_B = 32 * 32, T_O = 64 * 32, T_Q = 64 * 32, T_POOL = 4 * 32, T_W2 = 3 * 32, T_A2 = 3 * 32, T_G2 = 8 * 32;
    constexpr int T_LN = MROWS, T_SK = 64;
    constexpr int NIT = T_IN + T_A + T_B + T_O + T_Q + T_POOL + T_W2 + T_A2 + T_G2 + T_LN + T_SK;
    for (int it = gw; it < NIT; it += NGW) {
        int r = it;
        if (r < T_IN) { transpose_item(P.in[I_WIN], 2048, INC, NPAD, (bf16_t*)(ws + WS_WTIN), r, lane); continue; } r -= T_IN;
        if (r < T_A) { transpose_item(P.in[I_WBA], 2048, 2048, 2048, (bf16_t*)(ws + WS_WTA), r, lane); continue; } r -= T_A;
        if (r < T_B) { transpose_item(P.in[I_WBB], 1024, 2048, 2048, (bf16_t*)(ws + WS_WTB), r, lane); continue; } r -= T_B;
        if (r < T_O) { transpose_item(P.in[I_WOUT], 2048, 2048, 2048, (bf16_t*)(ws + WS_WTOUT), r, lane); continue; } r -= T_O;
        if (r < T_Q) { transpose_item(P.in[I_WQ], 2048, 2048, 2048, (bf16_t*)(ws + WS_WTQ), r, lane); continue; } r -= T_Q;
        if (r < T_POOL) { const int g = r >> 5; transpose_item(P.in[I_WPOOL] + g * 65536, 256, 256, 256, (bf16_t*)(ws + WS_WTPOOL) + g * 65536, r & 31, lane); continue; } r -= T_POOL;
        if (r < T_W2) { transpose_item(P.in[I_WW2], 96, 2048, 2048, (bf16_t*)(ws + WS_WTW2), r, lane); continue; } r -= T_W2;
        if (r < T_A2) { transpose_item(P.in[I_WA2], 96, 2048, 2048, (bf16_t*)(ws + WS_WTA2), r, lane); continue; } r -= T_A2;
        if (r < T_G2) { transpose_item(P.in[I_WG2], 256, 2048, 2048, (bf16_t*)(ws + WS_WTG2), r, lane); continue; } r -= T_G2;
        if (r < T_LN) {
            bf16_t* dst = (bf16_t*)(ws + WS_H0B) + (size_t)r * D;
            if (r < NTOK) ln_row_bf16(P.in[I_X] + (size_t)r * D, P.in[I_LNIN_G], P.in[I_LNIN_B], dst, lane);
            else if (r < NTOK + 16) ln_row_bf16(P.in[I_META] + (size_t)(r - NTOK) * D, P.in[I_LNIN_G], P.in[I_LNIN_B], dst, lane);
            else {
#pragma unroll
                for (int j = 0; j < 8; ++j) ((u32x2*)dst)[lane + 64 * j] = (u32x2){0u, 0u};
            }
            continue;
        }
        r -= T_LN;
        {
            const float* s = P.in[I_SUBK] + r * 512 + lane * 8; float f[8];
#pragma unroll
            for (int i = 0; i < 8; ++i) f[i] = s[i];
            *(u32x4*)((bf16_t*)(ws + WS_SUBK) + r * 512 + lane * 8) = pack8(f);
        }
    }
}
namespace pg8 {
struct EpiGateA {
    static constexpr bool PERM = false, AFTER_DRAIN = false;
    float* C; const bf16_t* p; const float* bgate;
    __device__ __forceinline__ void operator()(const f32x4 (&acc)[2][2][4][2], const Unit& u, int wr, int wc, int fr, int fq) const {
        const int row0 = u.pm * BM + wr * 64 + fr, col0 = u.pn * BM + wc * 32 + 4 * fq;
#pragma unroll
        for (int ai = 0; ai < 2; ++ai)
#pragma unroll
            for (int m = 0; m < 4; ++m) { const size_t row = (size_t)(row0 + ai * HALF + m * 16);
#pragma unroll
                for (int bj = 0; bj < 2; ++bj)
#pragma unroll
                    for (int n = 0; n < 2; ++n) { const int col = col0 + bj * HALF + n * 16;
                        const u32x2 pw = *(const u32x2*)(p + row * NPAD + C_G0 + col); const f32x4 bg = *(const f32x4*)(bgate + col);
                        f32x4 g; g.x = sigmoidf_(bflo(pw.x) + bg.x); g.y = sigmoidf_(bfhi(pw.x) + bg.y); g.z = sigmoidf_(bflo(pw.y) + bg.z); g.w = sigmoidf_(bfhi(pw.y) + bg.w);
                        *(f32x4*)(C + row * D + col) = acc[ai][bj][m][n] * g; } }
    }
};
struct EpiGateB {
    static constexpr bool PERM = false, AFTER_DRAIN = false;
    const float* C; bf16_t* O; const bf16_t* p; const float* bgate;
    __device__ __forceinline__ void operator()(const f32x4 (&acc)[2][2][4][2], const Unit& u, int wr, int wc, int fr, int fq) const {
        const int row0 = u.pm * BM + wr * 64 + fr, col0 = u.pn * BM + wc * 32 + 4 * fq;
#pragma unroll
        for (int ai = 0; ai < 2; ++ai)
#pragma unroll
            for (int m = 0; m < 4; ++m) { const size_t row = (size_t)(row0 + ai * HALF + m * 16);
#pragma unroll
                for (int bj = 0; bj < 2; ++bj)
#pragma unroll
                    for (int n = 0; n < 2; ++n) { const int col = col0 + bj * HALF + n * 16;
                        const u32x2 pw = *(const u32x2*)(p + row * NPAD + C_G1 + col); const f32x4 bg = *(const f32x4*)(bgate + D + col);
                        f32x4 g; g.x = sigmoidf_(bflo(pw.x) + bg.x); g.y = sigmoidf_(bfhi(pw.x) + bg.y); g.z = sigmoidf_(bflo(pw.y) + bg.z); g.w = sigmoidf_(bfhi(pw.y) + bg.w);
                        const f32x4 o = *(const f32x4*)(C + row * D + col) + acc[ai][bj][m][n] * g;
                        u32x2 w; w.x = cvt_pk_bf16(o.x, o.y); w.y = cvt_pk_bf16(o.z, o.w);
                        *(u32x2*)(O + row * D + col) = w; } }
    }
};
struct EpiResid {
    static constexpr bool PERM = false, AFTER_DRAIN = false;
    float* C; const bf16_t* h0; float alpha;
    __device__ __forceinline__ void operator()(const f32x4 (&acc)[2][2][4][2], const Unit& u, int wr, int wc, int fr, int fq) const {
        const int row0 = u.pm * BM + wr * 64 + fr, col0 = u.pn * BM + wc * 32 + 4 * fq;
#pragma unroll
        for (int ai = 0; ai < 2; ++ai)
#pragma unroll
            for (int m = 0; m < 4; ++m) { const size_t row = (size_t)(row0 + ai * HALF + m * 16);
#pragma unroll
                for (int bj = 0; bj < 2; ++bj)
#pragma unroll
                    for (int n = 0; n < 2; ++n) { const int col = col0 + bj * HALF + n * 16;
                        const u32x2 hw = *(const u32x2*)(h0 + row * D + col);
                        f32x4 hv; hv.x = bflo(hw.x); hv.y = bfhi(hw.x); hv.z = bflo(hw.y); hv.w = bfhi(hw.y);
                        *(f32x4*)(C + row * D + col) = hv * alpha + acc[ai][bj][m][n]; } }
    }
};
}
template <class Epi>
__device__ __forceinline__ void run_gemm(ldsp lds, const bf16_t* A, const bf16_t* Bt, int M, int N, int K, const Epi& E) {
    pg8::Gemm g; g.A = A; g.Bt = Bt; g.M = M; g.N = N; g.K = K;
    pg8::StaticOrder S; S.init(M, N, (int)gridDim.x, (int)blockIdx.x);
    pg8::gemm_phase<Epi, pg8::StaticOrder, false>(lds, g, S, E, nullptr);
}
constexpr int LD64 = 72, MATB = 64 * LD64 * 2, LDK = 104;
constexpr int O_AB = 0, O_RB = 1 * MATB, O_BH = 2 * MATB, O_KH = 3 * MATB, O_ABT = 4 * MATB, O_BTT = 5 * MATB, O_KTT = 6 * MATB, O_VT = 7 * MATB;
constexpr int O_M0 = 8 * MATB, O_M0T = 9 * MATB, O_M1 = 10 * MATB, O_M1T = 11 * MATB, O_PA = 12 * MATB, O_PB = 13 * MATB, O_MAK = 14 * MATB, O_MRB = 15 * MATB, O_MRK = 16 * MATB;
constexpr int O_ELEND = 17 * MATB;
constexpr int O_WL = 8 * MATB, O_AL = O_WL + 64 * LDK * 2, O_Z = O_AL + 64 * LDK * 2, O_AZ = O_Z + 64 * 68 * 4;
static_assert(O_AZ + 64 * 68 * 4 <= O_ELEND, "lds");
static_assert(O_ELEND + 256 <= LDS_BYTES, "lds");

__device__ __forceinline__ bf16x8 ldsfrag(ldsp lds, int off, int ld, int row, int kofs) { return *(const LAS bf16x8*)(lds + off + (row * ld + kofs) * 2); }
__device__ __forceinline__ void st4(ldsp lds, int off, int row, int col, const f32x4 v) {
    u32x2 w; w.x = pk2(v.x, v.y); w.y = pk2(v.z, v.w); *(LAS u32x2*)(lds + off + (row * LD64 + col) * 2) = w; }
__device__ __forceinline__ void st1(ldsp lds, int off, int row, int col, float v) { *(LAS bf16_t*)(lds + off + (row * LD64 + col) * 2) = f2bf1(v); }

__device__ __forceinline__ void shift8(const bf16_t* pcur, const bf16_t* pprev, const float* mu, float* x) {
    float c[8], q[8];
    if (pcur) unpack8(*(const u32x4*)pcur, c); else {
#pragma unroll
        for (int i = 0; i < 8; ++i) c[i] = 0.f; }
    if (pprev) unpack8(*(const u32x4*)pprev, q); else {
#pragma unroll
        for (int i = 0; i < 8; ++i) q[i] = 0.f; }
    const f32x4 m0 = *(const f32x4*)mu, m1 = *(const f32x4*)(mu + 4);
    const float mm[8] = {m0.x, m0.y, m0.z, m0.w, m1.x, m1.y, m1.z, m1.w};
#pragma unroll
    for (int i = 0; i < 8; ++i) x[i] = c[i] + (q[i] - c[i]) * mm[i];
}

template <bool DO_P, bool DO_SQ>
__device__ __forceinline__ void dbl_step(ldsp lds, int sN, int sT, int dN, int dT, int pC, int pN, int tm, int tn0, int fr, int fq) {
    bf16x8 a[2];
#pragma unroll
    for (int ks = 0; ks < 2; ++ks) a[ks] = ldsfrag(lds, sT, LD64, 16 * tm + fr, ks * 32 + fq * 8);
#pragma unroll
    for (int t2 = 0; t2 < 2; ++t2) {
        const int nt = tn0 + t2, t = 16 * nt + fr, s0 = 16 * tm + 4 * fq;
        if (DO_P) {
            f32x4 acc = {0.f, 0.f, 0.f, 0.f};
#pragma unroll
            for (int ks = 0; ks < 2; ++ks) acc = mfma16(a[ks], ldsfrag(lds, pC, LD64, t, ks * 32 + fq * 8), acc);
            const u32x2 pw = *(const LAS u32x2*)(lds + pC + (t * LD64 + s0) * 2);
            acc.x += bflo(pw.x); acc.y += bfhi(pw.x); acc.z += bflo(pw.y); acc.w += bfhi(pw.y);
            st4(lds, pN, t, s0, acc);
        }
        if (DO_SQ) {
            f32x4 acc = {0.f, 0.f, 0.f, 0.f};
#pragma unroll
            for (int ks = 0; ks < 2; ++ks) acc = mfma16(a[ks], ldsfrag(lds, sN, LD64, t, ks * 32 + fq * 8), acc);
            st4(lds, dN, t, s0, acc);
            st1(lds, dT, s0 + 0, t, acc.x); st1(lds, dT, s0 + 1, t, acc.y); st1(lds, dT, s0 + 2, t, acc.z); st1(lds, dT, s0 + 3, t, acc.w);
        }
    }
}


#ifdef DBG_STAGE
constexpr size_t DBG_STRIDE = (size_t)NUNITS * 512 * 4;
__device__ __forceinline__ void dbgsum(const Params& P, ldsp lds, int u, int stage, const int* offs, int nmat) {
    unsigned acc = 0;
    for (int m = 0; m < nmat; ++m)
        for (int k = 0; k < 4; ++k) { const int idx = threadIdx.x + 512 * k, row = idx >> 5, cp = idx & 31; const unsigned x = *(const LAS unsigned*)(lds + offs[m] + row * (LD64 * 2) + cp * 4); acc += (x & 0xffffu) + (x >> 16); }
    ((unsigned*)(P.ws + WS_S0T + (size_t)stage * DBG_STRIDE))[(size_t)u * 512 + threadIdx.x] = acc;
}
#define DBGSUM(stage, ...) do { const int offs_[] = {__VA_ARGS__}; dbgsum(P, lds, u, stage, offs_, (int)(sizeof(offs_) / sizeof(int))); } while (0)
#else
#define DBGSUM(stage, ...) do { } while (0)
#endif
__device__ __forceinline__ void rwkv_unit(const Params& P, ldsp lds, int u) {
    const int tid = threadIdx.x, lane = tid & 63, wave = tid >> 6, fr = lane & 15, fq = lane >> 4, tm = wave >> 1, tn0 = (wave & 1) * 2;
    unsigned char* ws = P.ws;
    const bf16_t* pp = (const bf16_t*)(ws + WS_P);
    const bool meta = u >= 4096;
    int b = 0, h, c = 0;
    if (meta) { h = u - 4096; } else { const int bh = u >> 6; c = u & 63; b = bh >> 5; h = bh & 31; }
    auto rowof = [&](int tl) -> int {
        if (meta) return (tl >= 48) ? (ROW_META + tl - 48) : -1;
        if (tl >= 0 || c > 0) return b * SEQ + c * 64 + tl;
        return ROW_META + 15;
    };
    auto rowp = [&](int tl, int col) -> const bf16_t* { const int r = rowof(tl); return r < 0 ? (const bf16_t*)nullptr : pp + (size_t)r * NPAD + col; };
    const float* mu = P.in[I_MU];
    for (int idx = tid; idx < 1536; idx += 512) {
        const int mat = idx / 768, rem = idx - mat * 768, t = rem / 12, ch = rem - t * 12, col = (mat ? C_AL : C_WL) + ch * 8;
        float x[8]; shift8(rowp(t, col), rowp(t - 1, col), mu + col, x);
        if (mat == 0) {
#pragma unroll
            for (int i = 0; i < 8; ++i) x[i] = tanhf(x[i]);
        }
        *(LAS u32x4*)(lds + (mat ? O_AL : O_WL) + (t * LDK + ch * 8) * 2) = pack8(x);
    }
    BLOCK_SYNC();
    {
        const bf16_t* ww2 = (const bf16_t*)(ws + WS_WTW2) + (size_t)(h * 64 + 16 * tm + fr) * 96 + fq * 8;
        const bf16_t* wa2 = (const bf16_t*)(ws + WS_WTA2) + (size_t)(h * 64 + 16 * tm + fr) * 96 + fq * 8;
        f32x4 z[2] = {{0.f, 0.f, 0.f, 0.f}, {0.f, 0.f, 0.f, 0.f}}, az[2] = {{0.f, 0.f, 0.f, 0.f}, {0.f, 0.f, 0.f, 0.f}};
#pragma unroll
        for (int ks = 0; ks < 3; ++ks) {
            const bf16x8 aw = *(const bf16x8*)(ww2 + ks * 32), aa = *(const bf16x8*)(wa2 + ks * 32);
#pragma unroll
            for (int t2 = 0; t2 < 2; ++t2) {
                const int t = 16 * (tn0 + t2) + fr;
                z[t2] = mfma16(aw, ldsfrag(lds, O_WL, LDK, t, ks * 32 + fq * 8), z[t2]);
                az[t2] = mfma16(aa, ldsfrag(lds, O_AL, LDK, t, ks * 32 + fq * 8), az[t2]);
            }
        }
#pragma unroll
        for (int t2 = 0; t2 < 2; ++t2) {
            const int t = 16 * (tn0 + t2) + fr, j0 = 16 * tm + 4 * fq;
            *(LAS f32x4*)(lds + O_Z + (t * 68 + j0) * 4) = z[t2];
            *(LAS f32x4*)(lds + O_AZ + (t * 68 + j0) * 4) = az[t2];
        }
    }
    BLOCK_SYNC();
    const int t = tid >> 3, jq = tid & 7, j0 = 8 * jq, hj = h * 64 + j0;
    const bool nulltok = meta && t < 48;
    float lw[8], av[8], rv[8], kv[8], vv[8], kk[8], km[8];
    {
        const f32x4 z0 = *(const LAS f32x4*)(lds + O_Z + (t * 68 + j0) * 4), z1 = *(const LAS f32x4*)(lds + O_Z + (t * 68 + j0 + 4) * 4);
        const f32x4 y0 = *(const LAS f32x4*)(lds + O_AZ + (t * 68 + j0) * 4), y1 = *(const LAS f32x4*)(lds + O_AZ + (t * 68 + j0 + 4) * 4);
        const float zz[8] = {z0.x, z0.y, z0.z, z0.w, z1.x, z1.y, z1.z, z1.w}, yy[8] = {y0.x, y0.y, y0.z, y0.w, y1.x, y1.y, y1.z, y1.w};
        const float* w0 = P.in[I_W0] + hj; const float* a0 = P.in[I_A0] + hj;
#pragma unroll
        for (int i = 0; i < 8; ++i) { lw[i] = nulltok ? 0.f : -DSCALE * sigmoidf_(w0[i] + zz[i]); av[i] = sigmoidf_(a0[i] + yy[i]); }
        shift8(rowp(t, C_R + hj), rowp(t - 1, C_R + hj), mu + C_R + hj, rv);
        shift8(rowp(t, C_K + hj), rowp(t - 1, C_K + hj), mu + C_K + hj, kv);
        shift8(rowp(t, C_V + hj), rowp(t - 1, C_V + hj), mu + C_V + hj, vv);
        if (nulltok) {
#pragma unroll
            for (int i = 0; i < 8; ++i) { rv[i] = 0.f; kv[i] = 0.f; vv[i] = 0.f; }
        }
        const float* kkw = P.in[I_KK] + hj; const float* kaw = P.in[I_KA] + hj; const float* rkw = P.in[I_RK] + hj;
        float n2 = 0.f, bon = 0.f;
#pragma unroll
        for (int i = 0; i < 8; ++i) { kk[i] = kv[i] * kkw[i]; n2 += kk[i] * kk[i]; km[i] = kv[i] * (1.0f + (av[i] - 1.0f) * kaw[i]); bon += rv[i] * km[i] * rkw[i]; }
        n2 += __shfl_xor(n2, 1); n2 += __shfl_xor(n2, 2); n2 += __shfl_xor(n2, 4);
        bon += __shfl_xor(bon, 1); bon += __shfl_xor(bon, 2); bon += __shfl_xor(bon, 4);
        const float inv = 1.0f / fmaxf(sqrtf(n2), 1e-12f);
#pragma unroll
        for (int i = 0; i < 8; ++i) kk[i] *= inv;
        if (!meta && jq == 0) ((float*)(ws + WS_BONUS))[(size_t)(b * SEQ + c * 64 + t) * 32 + h] = bon;
        *(LAS f32x4*)(lds + O_Z + (t * 68 + j0) * 4) = (f32x4){lw[0], lw[1], lw[2], lw[3]};
        *(LAS f32x4*)(lds + O_Z + (t * 68 + j0 + 4) * 4) = (f32x4){lw[4], lw[5], lw[6], lw[7]};
    }
    BLOCK_SYNC();
    {
        float Lc[8], Le[8];
#pragma unroll
        for (int i = 0; i < 8; ++i) { Lc[i] = 0.f; Le[i] = 0.f; }
        for (int tau = 0; tau < 64; ++tau) {
            const f32x4 x0 = *(const LAS f32x4*)(lds + O_Z + (tau * 68 + j0) * 4), x1 = *(const LAS f32x4*)(lds + O_Z + (tau * 68 + j0 + 4) * 4);
            const float xx[8] = {x0.x, x0.y, x0.z, x0.w, x1.x, x1.y, x1.z, x1.w};
            const float msk = tau <= t ? 1.0f : 0.0f;
#pragma unroll
            for (int i = 0; i < 8; ++i) { Le[i] += xx[i]; Lc[i] += msk * xx[i]; }
        }
        float Ab[8], Rb[8], Bh[8], Kh[8], Bt[8], Kt[8];
#pragma unroll
        for (int i = 0; i < 8; ++i) {
            const float eP = __expf(Lc[i] - lw[i]), eC = __expf(Lc[i]), eN = __expf(-Lc[i]), eE = __expf(Le[i] - Lc[i]);
            const float ka = kk[i] * av[i];
            Ab[i] = -kk[i] * eP; Rb[i] = rv[i] * eC; Bh[i] = ka * eN; Kh[i] = km[i] * eN; Bt[i] = ka * eE; Kt[i] = km[i] * eE;
        }
        *(LAS u32x4*)(lds + O_AB + (t * LD64 + j0) * 2) = pack8(Ab);
        *(LAS u32x4*)(lds + O_RB + (t * LD64 + j0) * 2) = pack8(Rb);
        *(LAS u32x4*)(lds + O_BH + (t * LD64 + j0) * 2) = pack8(Bh);
        *(LAS u32x4*)(lds + O_KH + (t * LD64 + j0) * 2) = pack8(Kh);
#pragma unroll
        for (int i = 0; i < 8; ++i) { st1(lds, O_ABT, j0 + i, t, Ab[i]); st1(lds, O_BTT, j0 + i, t, Bt[i]); st1(lds, O_KTT, j0 + i, t, Kt[i]); st1(lds, O_VT, j0 + i, t, vv[i]); }
        if (t == 63) {
#pragma unroll
            for (int i = 0; i < 8; ++i) *(LAS float*)(lds + O_ELEND + (j0 + i) * 4) = __expf(Le[i]);
        }
    }
    BLOCK_SYNC();
    DBGSUM(0, O_AB, O_RB, O_BH, O_KH, O_ABT, O_BTT, O_KTT, O_VT);
    {
        bf16x8 abh[2], akh[2];
#pragma unroll
        for (int ks = 0; ks < 2; ++ks) { abh[ks] = ldsfrag(lds, O_BH, LD64, 16 * tm + fr, ks * 32 + fq * 8); akh[ks] = ldsfrag(lds, O_KH, LD64, 16 * tm + fr, ks * 32 + fq * 8); }
#pragma unroll
        for (int t2 = 0; t2 < 2; ++t2) {
            const int tt = 16 * (tn0 + t2) + fr, s0 = 16 * tm + 4 * fq;
            f32x4 mab = {0.f, 0.f, 0.f, 0.f}, mak = mab, mrb = mab, mrk = mab;
#pragma unroll
            for (int ks = 0; ks < 2; ++ks) {
                const bf16x8 bab = ldsfrag(lds, O_AB, LD64, tt, ks * 32 + fq * 8), brb = ldsfrag(lds, O_RB, LD64, tt, ks * 32 + fq * 8);
                mab = mfma16(abh[ks], bab, mab); mak = mfma16(akh[ks], bab, mak); mrb = mfma16(abh[ks], brb, mrb); mrk = mfma16(akh[ks], brb, mrk);
            }
            float vab[4] = {mab.x, mab.y, mab.z, mab.w}, vak[4] = {mak.x, mak.y, mak.z, mak.w}, vrb[4] = {mrb.x, mrb.y, mrb.z, mrb.w}, vrk[4] = {mrk.x, mrk.y, mrk.z, mrk.w}, vp[4];
#pragma unroll
            for (int r = 0; r < 4; ++r) { const int s = s0 + r; const bool st = s < tt, le = s <= tt;
                vab[r] = st ? vab[r] : 0.f; vak[r] = st ? vak[r] : 0.f; vrb[r] = le ? vrb[r] : 0.f; vrk[r] = le ? vrk[r] : 0.f; vp[r] = vab[r] + (s == tt ? 1.0f : 0.f); }
            st4(lds, O_M0, tt, s0, (f32x4){vab[0], vab[1], vab[2], vab[3]});
#pragma unroll
            for (int r = 0; r < 4; ++r) st1(lds, O_M0T, s0 + r, tt, vab[r]);
            st4(lds, O_PA, tt, s0, (f32x4){vp[0], vp[1], vp[2], vp[3]});
            st4(lds, O_MAK, tt, s0, (f32x4){vak[0], vak[1], vak[2], vak[3]});
            st4(lds, O_MRB, tt, s0, (f32x4){vrb[0], vrb[1], vrb[2], vrb[3]});
            st4(lds, O_MRK, tt, s0, (f32x4){vrk[0], vrk[1], vrk[2], vrk[3]});
        }
    }
    BLOCK_SYNC();
    DBGSUM(1, O_M0, O_M0T, O_PA, O_MAK, O_MRB, O_MRK);
    dbl_step<false, true>(lds, O_M0, O_M0T, O_M1, O_M1T, 0, 0, tm, tn0, fr, fq); BLOCK_SYNC();
    dbl_step<true, true>(lds, O_M1, O_M1T, O_M0, O_M0T, O_PA, O_PB, tm, tn0, fr, fq); BLOCK_SYNC();
    dbl_step<true, true>(lds, O_M0, O_M0T, O_M1, O_M1T, O_PB, O_PA, tm, tn0, fr, fq); BLOCK_SYNC();
    dbl_step<true, true>(lds, O_M1, O_M1T, O_M0, O_M0T, O_PA, O_PB, tm, tn0, fr, fq); BLOCK_SYNC();
    dbl_step<true, true>(lds, O_M0, O_M0T, O_M1, O_M1T, O_PB, O_PA, tm, tn0, fr, fq); BLOCK_SYNC();
    dbl_step<true, false>(lds, O_M1, O_M1T, 0, 0, O_PA, O_PB, tm, tn0, fr, fq); BLOCK_SYNC();
    DBGSUM(2, O_PB);
    {
        bf16x8 aT[2], aMak[2];
#pragma unroll
        for (int ks = 0; ks < 2; ++ks) { aT[ks] = ldsfrag(lds, O_PB, LD64, 16 * tm + fr, ks * 32 + fq * 8); aMak[ks] = ldsfrag(lds, O_MAK, LD64, 16 * tm + fr, ks * 32 + fq * 8); }
#pragma unroll
        for (int t2 = 0; t2 < 2; ++t2) {
            const int n = 16 * (tn0 + t2) + fr, t0 = 16 * tm + 4 * fq;
            f32x4 at = {0.f, 0.f, 0.f, 0.f}, xt = at;
#pragma unroll
            for (int ks = 0; ks < 2; ++ks) { at = mfma16(aT[ks], ldsfrag(lds, O_ABT, LD64, n, ks * 32 + fq * 8), at); xt = mfma16(aMak[ks], ldsfrag(lds, O_VT, LD64, n, ks * 32 + fq * 8), xt); }
            st4(lds, O_M0, n, t0, at); st4(lds, O_M0T, n, t0, xt);
        }
    }
    BLOCK_SYNC();
    DBGSUM(3, O_M0, O_M0T);
    const size_t ub = (size_t)u * 4096;
    {
        bf16x8 aT[2], aAt[2];
#pragma unroll
        for (int ks = 0; ks < 2; ++ks) { aT[ks] = ldsfrag(lds, O_PB, LD64, 16 * tm + fr, ks * 32 + fq * 8); aAt[ks] = ldsfrag(lds, O_M0, LD64, 16 * tm + fr, ks * 32 + fq * 8); }
        bf16_t* Rt = (bf16_t*)(ws + WS_RT) + ub; bf16_t* Gp = (bf16_t*)(ws + WS_G) + ub;
#pragma unroll
        for (int t2 = 0; t2 < 2; ++t2) {
            const int n = 16 * (tn0 + t2) + fr, m0 = 16 * tm + 4 * fq;
            f32x4 u0 = {0.f, 0.f, 0.f, 0.f}, rt = u0, g = u0;
#pragma unroll
            for (int ks = 0; ks < 2; ++ks) {
                u0 = mfma16(aT[ks], ldsfrag(lds, O_M0T, LD64, n, ks * 32 + fq * 8), u0);
                rt = mfma16(aAt[ks], ldsfrag(lds, O_MRB, LD64, n, ks * 32 + fq * 8), rt);
                g = mfma16(aAt[ks], ldsfrag(lds, O_BTT, LD64, n, ks * 32 + fq * 8), g);
            }
            st4(lds, O_M1, n, m0, u0);
            const u32x2 rw = *(const LAS u32x2*)(lds + O_RB + (n * LD64 + m0) * 2);
            rt.x += bflo(rw.x); rt.y += bfhi(rw.x); rt.z += bflo(rw.y); rt.w += bfhi(rw.y);
            { u32x2 w; w.x = pk2(rt.x, rt.y); w.y = pk2(rt.z, rt.w); *(u32x2*)(Rt + n * 64 + m0) = w; }
            if ((n >> 2) == (m0 >> 2)) { const float e = *(const LAS float*)(lds + O_ELEND + n * 4); const int r = n & 3;
                g.x += (r == 0) ? e : 0.f; g.y += (r == 1) ? e : 0.f; g.z += (r == 2) ? e : 0.f; g.w += (r == 3) ? e : 0.f; }
            { const int pos0 = 32 * (tm >> 1) + 8 * fq + 4 * (tm & 1); u32x2 w; w.x = pk2(g.x, g.y); w.y = pk2(g.z, g.w); *(u32x2*)(Gp + n * 64 + pos0) = w; }
        }
    }
    BLOCK_SYNC();
    DBGSUM(4, O_M1);
    {
        bf16x8 aB[2], aK[2], aU[2], aV[2];
#pragma unroll
        for (int ks = 0; ks < 2; ++ks) { const int row = 16 * tm + fr, ko = ks * 32 + fq * 8;
            aB[ks] = ldsfrag(lds, O_BTT, LD64, row, ko); aK[ks] = ldsfrag(lds, O_KTT, LD64, row, ko); aU[ks] = ldsfrag(lds, O_M1, LD64, row, ko); aV[ks] = ldsfrag(lds, O_VT, LD64, row, ko); }
        bf16_t* H0t = (bf16_t*)(ws + WS_H0T) + ub; bf16_t* Y0s = (bf16_t*)(ws + WS_Y0) + ub;
#pragma unroll
        for (int t2 = 0; t2 < 2; ++t2) {
            const int n = 16 * (tn0 + t2) + fr, m0 = 16 * tm + 4 * fq;
            f32x4 hh = {0.f, 0.f, 0.f, 0.f}, yy = hh;
#pragma unroll
            for (int ks = 0; ks < 2; ++ks) { const int ko = ks * 32 + fq * 8;
                const bf16x8 bU = ldsfrag(lds, O_M1, LD64, n, ko), bV = ldsfrag(lds, O_VT, LD64, n, ko), bRb = ldsfrag(lds, O_MRB, LD64, n, ko), bRk = ldsfrag(lds, O_MRK, LD64, n, ko);
                hh = mfma16(aB[ks], bU, hh); hh = mfma16(aK[ks], bV, hh);
                yy = mfma16(aU[ks], bRb, yy); yy = mfma16(aV[ks], bRk, yy); }
            { u32x2 w; w.x = pk2(hh.x, hh.y); w.y = pk2(hh.z, hh.w); *(u32x2*)(H0t + n * 64 + m0) = w; }
            { u32x2 w; w.x = pk2(yy.x, yy.y); w.y = pk2(yy.z, yy.w); *(u32x2*)(Y0s + n * 64 + m0) = w; }
        }
    }
    BLOCK_SYNC();
}

constexpr int LDU = 264;
__device__ __forceinline__ void pool_unit(const Params& P, ldsp lds, int pu) {
    const int tid = threadIdx.x, lane = tid & 63, wave = tid >> 6, fr = lane & 15, fq = lane >> 4;
    unsigned char* ws = P.ws;
    const bf16_t* pp = (const bf16_t*)(ws + WS_P);
    const int g = pu & 3, tt = pu >> 2, b = tt >> 6, ti0 = (tt & 63) * 64;
    constexpr int O_U = 0, O_PL = 79 * LDU * 2;
    for (int idx = tid; idx < 79 * 32; idx += 512) {
        const int lr = idx >> 5, ch = idx & 31, ti = ti0 + lr - 15;
        const int row = ti >= 0 ? b * SEQ + ti : ROW_META + 16 + ti;
        *(LAS u32x4*)(lds + O_U + (lr * LDU + ch * 8) * 2) = *(const u32x4*)(pp + (size_t)row * NPAD + C_POOL + g * 256 + ch * 8);
    }
    BLOCK_SYNC();
    {
        const int t = tid >> 3, cq = tid & 7, win = 2 << g; const float inv = 1.0f / (float)win;
#pragma unroll
        for (int cc = 0; cc < 4; ++cc) {
            const int c0 = cq * 32 + cc * 8; float s[8], own[8];
            unpack8(*(const LAS u32x4*)(lds + O_U + ((15 + t) * LDU + c0) * 2), own);
#pragma unroll
            for (int i = 0; i < 8; ++i) s[i] = own[i];
            for (int d = 1; d < win; ++d) { float x[8]; unpack8(*(const LAS u32x4*)(lds + O_U + ((15 + t - d) * LDU + c0) * 2), x);
#pragma unroll
                for (int i = 0; i < 8; ++i) s[i] += x[i]; }
#pragma unroll
            for (int i = 0; i < 8; ++i) s[i] = s[i] * inv - own[i];
            *(LAS u32x4*)(lds + O_PL + (t * LDU + c0) * 2) = pack8(s);
        }
    }
    BLOCK_SYNC();
    {
        const bf16_t* wt = (const bf16_t*)(ws + WS_WTPOOL) + (size_t)g * 65536;
        f32x4 acc[2][4];
#pragma unroll
        for (int a = 0; a < 2; ++a)
#pragma unroll
            for (int n = 0; n < 4; ++n) acc[a][n] = (f32x4){0.f, 0.f, 0.f, 0.f};
#pragma unroll 2
        for (int ks = 0; ks < 8; ++ks) {
            bf16x8 af[2];
#pragma unroll
            for (int a = 0; a < 2; ++a) af[a] = *(const bf16x8*)(wt + (size_t)(32 * wave + 16 * a + fr) * 256 + ks * 32 + fq * 8);
#pragma unroll
            for (int n = 0; n < 4; ++n) { const bf16x8 bf = ldsfrag(lds, O_PL, LDU, 16 * n + fr, ks * 32 + fq * 8);
#pragma unroll
                for (int a = 0; a < 2; ++a) acc[a][n] = mfma16(af[a], bf, acc[a][n]); }
        }
        bf16_t* yb = (bf16_t*)(ws + WS_YB);
        const float* psc = P.in[I_PSCALE] + g * 256;
#pragma unroll
        for (int a = 0; a < 2; ++a) { const int d0 = 32 * wave + 16 * a + 4 * fq; const f32x4 sc = *(const f32x4*)(psc + d0);
#pragma unroll
            for (int n = 0; n < 4; ++n) { const int t = 16 * n + fr; const f32x4 o = acc[a][n] * sc;
                u32x2 w; w.x = pk2(o.x, o.y); w.y = pk2(o.z, o.w);
                *(u32x2*)(yb + (size_t)(b * SEQ + ti0 + t) * 1024 + g * 256 + d0) = w; } }
    }
    BLOCK_SYNC();
}
__device__ __forceinline__ void phase2(const Params& P, ldsp lds) {
    for (int u = blockIdx.x; u < NUNITS + 512; u += gridDim.x) {
        if (u < NUNITS) rwkv_unit(P, lds, u); else pool_unit(P, lds, u - NUNITS);
    }
}
__device__ __forceinline__ void phase3(const Params& P) {
    const int lane = threadIdx.x & 63, wave = threadIdx.x >> 6, fr = lane & 15, fq = lane >> 4;
    if (wave != 0) return;
    unsigned char* ws = P.ws;
    const bf16_t* Gp = (const bf16_t*)(ws + WS_G); const bf16_t* H0t = (const bf16_t*)(ws + WS_H0T); bf16_t* S0t = (bf16_t*)(ws + WS_S0T);
    for (int item = blockIdx.x; item < 256; item += gridDim.x) {
        const int bh = item >> 2, vq = item & 3, h = bh & 31;
        bf16x8 Sb[2];
#pragma unroll
        for (int ks = 0; ks < 2; ++ks)
#pragma unroll
            for (int i = 0; i < 8; ++i) Sb[ks][i] = 0;
        bf16x8 gA[4][2]; u32x2 hF[4];
        auto load = [&](int step, bf16x8 (&ga)[4][2], u32x2 (&hf)[4]) {
            const int u = (step == 0) ? (4096 + h) : (bh * 64 + step - 1);
            const bf16_t* g = Gp + (size_t)u * 4096; const bf16_t* hh = H0t + (size_t)u * 4096;
#pragma unroll
            for (int mt = 0; mt < 4; ++mt) {
#pragma unroll
                for (int ks = 0; ks < 2; ++ks) ga[mt][ks] = *(const bf16x8*)(g + (16 * mt + fr) * 64 + ks * 32 + fq * 8);
                hf[mt] = *(const u32x2*)(hh + (16 * vq + fr) * 64 + 16 * mt + 4 * fq);
            }
        };
        load(0, gA, hF);
        for (int step = 0; step < 64; ++step) {
            bf16x8 gN[4][2]; u32x2 hN[4];
            if (step + 1 < 64) load(step + 1, gN, hN);
            f32x4 acc[4];
#pragma unroll
            for (int mt = 0; mt < 4; ++mt) {
                acc[mt] = (f32x4){bflo(hF[mt].x), bfhi(hF[mt].x), bflo(hF[mt].y), bfhi(hF[mt].y)};
                acc[mt] = mfma16(gA[mt][0], Sb[0], acc[mt]);
                acc[mt] = mfma16(gA[mt][1], Sb[1], acc[mt]);
            }
            bf16_t* so = S0t + (size_t)(bh * 64 + step) * 4096 + (16 * vq + fr) * 64 + 4 * fq;
            u32x2 w[4];
#pragma unroll
            for (int mt = 0; mt < 4; ++mt) { w[mt].x = pk2(acc[mt].x, acc[mt].y); w[mt].y = pk2(acc[mt].z, acc[mt].w); *(u32x2*)(so + 16 * mt) = w[mt]; }
#pragma unroll
            for (int ks = 0; ks < 2; ++ks) {
                const u32x4 q = (u32x4){w[2 * ks].x, w[2 * ks].y, w[2 * ks + 1].x, w[2 * ks + 1].y};
                Sb[ks] = __builtin_bit_cast(bf16x8, q);
            }
            if (step + 1 < 64) {
#pragma unroll
                for (int mt = 0; mt < 4; ++mt) { gA[mt][0] = gN[mt][0]; gA[mt][1] = gN[mt][1]; hF[mt] = hN[mt]; }
            }
        }
    }
}

constexpr int LDG = 264;
__device__ __forceinline__ void phase3b(const Params& P, ldsp lds) {
    const int tid = threadIdx.x, lane = tid & 63, wave = tid >> 6, fr = lane & 15, fq = lane >> 4, wq = wave & 3;
    unsigned char* ws = P.ws;
    const bf16_t* pp = (const bf16_t*)(ws + WS_P);
    const float* mu = P.in[I_MU];
    ldsp gl = lds + wave * (16 * LDG * 2);
    for (int pair = blockIdx.x; pair < 2048; pair += gridDim.x) {
        const int u = pair * 2 + (wave >> 2), bh = u >> 6, c = u & 63, b = bh >> 5, h = bh & 31;
        const int trow0 = b * SEQ + c * 64 + 16 * wq;
#pragma unroll
        for (int it = 0; it < 8; ++it) {
            const int idx = it * 64 + lane, tl = idx >> 5, ch = idx & 31, col = C_GL + ch * 8;
            const int row = trow0 + tl; const int prow = (c == 0 && wq == 0 && tl == 0) ? (ROW_META + 15) : row - 1;
            float x[8]; shift8(pp + (size_t)row * NPAD + col, pp + (size_t)prow * NPAD + col, mu + col, x);
#pragma unroll
            for (int i = 0; i < 8; ++i) x[i] = sigmoidf_(x[i]);
            *(LAS u32x4*)(gl + (tl * LDG + ch * 8) * 2) = pack8(x);
        }
        BLOCK_SYNC();
        f32x4 gacc[4];
#pragma unroll
        for (int mt = 0; mt < 4; ++mt) gacc[mt] = (f32x4){0.f, 0.f, 0.f, 0.f};
        {
            const bf16_t* wg = (const bf16_t*)(ws + WS_WTG2) + (size_t)(h * 64 + fr) * 256 + fq * 8;
#pragma unroll 2
            for (int ks = 0; ks < 8; ++ks) {
                const bf16x8 bf = *(const LAS bf16x8*)(gl + (fr * LDG + ks * 32 + fq * 8) * 2);
#pragma unroll
                for (int mt = 0; mt < 4; ++mt) gacc[mt] = mfma16(*(const bf16x8*)(wg + (size_t)(16 * mt) * 256 + ks * 32), bf, gacc[mt]);
            }
        }
        f32x4 y[4];
        {
            const size_t ub = (size_t)u * 4096;
            const bf16_t* S0t = (const bf16_t*)(ws + WS_S0T) + ub; const bf16_t* Rt = (const bf16_t*)(ws + WS_RT) + ub; const bf16_t* Y0s = (const bf16_t*)(ws + WS_Y0) + ub;
            bf16x8 bR[2];
#pragma unroll
            for (int ks = 0; ks < 2; ++ks) bR[ks] = *(const bf16x8*)(Rt + (16 * wq + fr) * 64 + ks * 32 + fq * 8);
#pragma unroll
            for (int mt = 0; mt < 4; ++mt) {
                const u32x2 yw = *(const u32x2*)(Y0s + (16 * wq + fr) * 64 + 16 * mt + 4 * fq);
                y[mt] = (f32x4){bflo(yw.x), bfhi(yw.x), bflo(yw.y), bfhi(yw.y)};
#pragma unroll
                for (int ks = 0; ks < 2; ++ks) y[mt] = mfma16(*(const bf16x8*)(S0t + (16 * mt + fr) * 64 + ks * 32 + fq * 8), bR[ks], y[mt]);
            }
        }
        float s = 0.f;
#pragma unroll
        for (int mt = 0; mt < 4; ++mt) s += (y[mt].x + y[mt].y) + (y[mt].z + y[mt].w);
        s += __shfl_xor(s, 16); s += __shfl_xor(s, 32);
        const float mean = s * (1.0f / 64.0f); float q = 0.f;
#pragma unroll
        for (int mt = 0; mt < 4; ++mt) { y[mt] = y[mt] - mean; q += (y[mt].x * y[mt].x + y[mt].y * y[mt].y) + (y[mt].z * y[mt].z + y[mt].w * y[mt].w); }
        q += __shfl_xor(q, 16); q += __shfl_xor(q, 32);
        const float rstd = 1.0f / sqrtf(q * (1.0f / 64.0f) + GN_EPS);
        const int row = trow0 + fr; const int prow = (c == 0 && wq == 0 && fr == 0) ? (ROW_META + 15) : row - 1;
        const float bon = ((const float*)(ws + WS_BONUS))[(size_t)row * 32 + h];
        bf16_t* ya = (bf16_t*)(ws + WS_YA) + (size_t)row * D + h * 64;
#pragma unroll
        for (int mt = 0; mt < 4; ++mt) {
            const int i0 = 16 * mt + 4 * fq, hc = h * 64 + i0;
            const f32x4 gg = *(const f32x4*)(P.in[I_GNG] + hc), gb = *(const f32x4*)(P.in[I_GNB] + hc), mv = *(const f32x4*)(mu + C_V + hc);
            const u32x2 vc = *(const u32x2*)(pp + (size_t)row * NPAD + C_V + hc), vp = *(const u32x2*)(pp + (size_t)prow * NPAD + C_V + hc);
            f32x4 cv = (f32x4){bflo(vc.x), bfhi(vc.x), bflo(vc.y), bfhi(vc.y)}, pv = (f32x4){bflo(vp.x), bfhi(vp.x), bflo(vp.y), bfhi(vp.y)};
            const f32x4 v = cv + (pv - cv) * mv;
            const f32x4 o = (y[mt] * rstd * gg + gb + v * bon) * gacc[mt];
            u32x2 w; w.x = pk2(o.x, o.y); w.y = pk2(o.z, o.w);
            *(u32x2*)(ya + i0) = w;
        }
        BLOCK_SYNC();
    }
}
__device__ __forceinline__ void phase5b(const Params& P) {
    const int lane = threadIdx.x & 63, wave = threadIdx.x >> 6;
    const int gw = blockIdx.x * 8 + wave, NGW = gridDim.x * 8;
    unsigned char* ws = P.ws;
    for (int r = gw; r < NTOK; r += NGW)
        ln_row_bf16((const float*)(ws + WS_X1) + (size_t)r * D, P.in[I_LN1G], P.in[I_LN1B], (bf16_t*)(ws + WS_H1B) + (size_t)r * D, lane);
    for (int r = gw; r < 32768; r += NGW) {
        const float* src = (r < 16384 ? P.in[I_UT] : P.in[I_VT]) + (size_t)(r & 16383) * D;
        int* dst = (int*)(ws + (r < 16384 ? WS_UB : WS_VB) + (size_t)(r & 16383) * D);
        f32x4 v[8]; float am = 0.f;
#pragma unroll
        for (int j = 0; j < 8; ++j) { v[j] = ((const f32x4*)src)[lane + 64 * j]; am = fmaxf(am, fmaxf(fmaxf(fabsf(v[j].x), fabsf(v[j].y)), fmaxf(fabsf(v[j].z), fabsf(v[j].w)))); }
        am = wave_max_dpp(am);
        const float s = am > 0.f ? 256.0f / am : 1.0f;
#pragma unroll
        for (int j = 0; j < 8; ++j) { int w = 0; w = __builtin_amdgcn_cvt_pk_fp8_f32(v[j].x * s, v[j].y * s, w, false); w = __builtin_amdgcn_cvt_pk_fp8_f32(v[j].z * s, v[j].w * s, w, true); dst[lane + 64 * j] = w; }
        if (lane == 0) ((float*)(ws + WS_TSC))[r] = am > 0.f ? am * (1.0f / 256.0f) : 1.0f;
    }
}

#define CE_DESC(a, b) do { const float h_ = fmaxf((a), (b)), l_ = fminf((a), (b)); (a) = h_; (b) = l_; } while (0)
template <int N> __device__ __forceinline__ void bitonic_sort_desc(float (&v)[N]) {
#pragma unroll
    for (int k = 2; k <= N; k <<= 1)
#pragma unroll
        for (int j = k >> 1; j > 0; j >>= 1)
#pragma unroll
            for (int i = 0; i < N; ++i) { const int l = i ^ j; if (l > i) { if ((i & k) == 0) CE_DESC(v[i], v[l]); else CE_DESC(v[l], v[i]); } }
}
template <int N> __device__ __forceinline__ void bitonic_merge_desc(float (&v)[N]) {
#pragma unroll
    for (int j = N >> 1; j > 0; j >>= 1)
#pragma unroll
        for (int i = 0; i < N; ++i) { const int l = i ^ j; if (l > i) CE_DESC(v[i], v[l]); }
}
__device__ __forceinline__ void top16_merge(float (&a)[16], const float (&brev)[16]) {
#pragma unroll
    for (int i = 0; i < 16; ++i) a[i] = fmaxf(a[i], brev[i]);
    bitonic_merge_desc<16>(a);
}
__device__ __forceinline__ float embed_bits(float v, unsigned code, unsigned mask) { return __uint_as_float((__float_as_uint(v) & ~mask) | code); }

__device__ __forceinline__ void phase7(const Params& P, ldsp lds) {
    const int tid = threadIdx.x, lane = tid & 63, wave = tid >> 6, fr = lane & 15, fq = lane >> 4;
    unsigned char* ws = P.ws;
    const bf16_t* qb = (const bf16_t*)(ws + WS_Q); const bf16_t* sk = (const bf16_t*)(ws + WS_SUBK);
    int* eout = (int*)(ws + WS_EXP); float* gout = (float*)(ws + WS_GATE);
    constexpr int LDSK = 136, O_SK = 0, O_SV = 2 * 128 * LDSK * 2;
    for (int idx = tid; idx < 2 * 128 * 16; idx += 512) { const int row = idx >> 4, ch = idx & 15;
        *(LAS u32x4*)(lds + O_SK + (row * LDSK + ch * 8) * 2) = *(const u32x4*)(sk + row * 128 + ch * 8); }
    BLOCK_SYNC();
    for (int tile = blockIdx.x; tile < 256; tile += gridDim.x) {
        const int tok0 = tile * 32, h = wave;
#pragma unroll 1
        for (int cb = 0; cb < 4; ++cb) {
            const int nt = cb >> 1, p = cb & 1;
            f32x4 acc[8];
#pragma unroll
            for (int mt = 0; mt < 8; ++mt) acc[mt] = (f32x4){0.f, 0.f, 0.f, 0.f};
            const bf16_t* qrow = qb + (size_t)(tok0 + 16 * nt + fr) * D + h * 256 + p * 128 + fq * 8;
#pragma unroll
            for (int ks = 0; ks < 4; ++ks) {
                const bf16x8 bq = *(const bf16x8*)(qrow + ks * 32);
#pragma unroll
                for (int mt = 0; mt < 8; ++mt) acc[mt] = mfma16(*(const LAS bf16x8*)(lds + O_SK + ((p * 128 + 16 * mt + fr) * LDSK + ks * 32 + fq * 8) * 2), bq, acc[mt]);
            }
            float a[16], b[16];
#pragma unroll
            for (int mt = 0; mt < 4; ++mt) {
                a[4 * mt + 0] = embed_bits(acc[mt].x, 16 * mt + 4 * fq + 0, 127u); a[4 * mt + 1] = embed_bits(acc[mt].y, 16 * mt + 4 * fq + 1, 127u);
                a[4 * mt + 2] = embed_bits(acc[mt].z, 16 * mt + 4 * fq + 2, 127u); a[4 * mt + 3] = embed_bits(acc[mt].w, 16 * mt + 4 * fq + 3, 127u);
                b[4 * mt + 0] = embed_bits(acc[mt + 4].x, 16 * (mt + 4) + 4 * fq + 0, 127u); b[4 * mt + 1] = embed_bits(acc[mt + 4].y, 16 * (mt + 4) + 4 * fq + 1, 127u);
                b[4 * mt + 2] = embed_bits(acc[mt + 4].z, 16 * (mt + 4) + 4 * fq + 2, 127u); b[4 * mt + 3] = embed_bits(acc[mt + 4].w, 16 * (mt + 4) + 4 * fq + 3, 127u);
            }
            bitonic_sort_desc<16>(a); bitonic_sort_desc<16>(b);
            { float br[16];
#pragma unroll
              for (int i = 0; i < 16; ++i) br[i] = b[15 - i];
              top16_merge(a, br); }
#pragma unroll
            for (int x = 16; x <= 32; x <<= 1) { float br[16];
#pragma unroll
                for (int i = 0; i < 16; ++i) br[i] = __shfl_xor(a[15 - i], x);
                top16_merge(a, br); }
            if (fq == 0) { LAS f32x4* o = (LAS f32x4*)(lds + O_SV + ((((16 * nt + fr) * 8 + h) * 2 + p) * 16) * 4);
                o[0] = (f32x4){a[0], a[1], a[2], a[3]}; o[1] = (f32x4){a[4], a[5], a[6], a[7]}; o[2] = (f32x4){a[8], a[9], a[10], a[11]}; o[3] = (f32x4){a[12], a[13], a[14], a[15]}; }
        }
        BLOCK_SYNC();
        if (tid < 256) {
            const int tok = tid >> 3, hh = tid & 7;
            const LAS f32x4* s = (const LAS f32x4*)(lds + O_SV + (((tok * 8 + hh) * 2) * 16) * 4);
            float s0[16], s1[16];
#pragma unroll
            for (int c4 = 0; c4 < 4; ++c4) { const f32x4 x = s[c4], y = s[4 + c4]; s0[4 * c4] = x.x; s0[4 * c4 + 1] = x.y; s0[4 * c4 + 2] = x.z; s0[4 * c4 + 3] = x.w; s1[4 * c4] = y.x; s1[4 * c4 + 1] = y.y; s1[4 * c4 + 2] = y.z; s1[4 * c4 + 3] = y.w; }
            float g0[16], g1[16], g2[16], g3[16];
            const float NEG = -3.0e38f;
#pragma unroll
            for (int bq = 0; bq < 16; ++bq) g0[bq] = embed_bits(s0[0] + s1[bq], bq, 255u);
            {
                int n1 = 0, n2 = 0, n3 = 0;
#pragma unroll
                for (int aa = 1; aa < 16; ++aa)
#pragma unroll
                    for (int bb = 0; bb < 16; ++bb) if ((aa + 1) * (bb + 1) <= 16) {
                        const float c = embed_bits(s0[aa] + s1[bb], aa * 16 + bb, 255u);
                        if (n1 < 16) g1[n1++] = c; else if (n2 < 16) g2[n2++] = c; else g3[n3++] = c;
                    }
#pragma unroll
                for (int i = 0; i < 16; ++i) if (i >= n3) g3[i] = NEG;
            }
            bitonic_sort_desc<16>(g1); bitonic_sort_desc<16>(g2); bitonic_sort_desc<16>(g3);
            { float r1[16], r3[16];
#pragma unroll
              for (int i = 0; i < 16; ++i) { r1[i] = g1[15 - i]; r3[i] = g3[15 - i]; }
              top16_merge(g0, r1); top16_merge(g2, r3);
#pragma unroll
              for (int i = 0; i < 16; ++i) g0[i] = fmaxf(g0[i], g2[15 - i]); }
            float mx = g0[0];
#pragma unroll
            for (int i = 1; i < 16; ++i) mx = fmaxf(mx, g0[i]);
            float ex[16], sm = 0.f; int ee[16];
#pragma unroll
            for (int i = 0; i < 16; ++i) {
                ex[i] = __expf(g0[i] - mx); sm += ex[i];
                const unsigned code = __float_as_uint(g0[i]) & 255u;
                const unsigned i0 = __float_as_uint(*(const LAS float*)(lds + O_SV + ((((tok * 8 + hh) * 2 + 0) * 16) + (code >> 4)) * 4)) & 127u;
                const unsigned i1 = __float_as_uint(*(const LAS float*)(lds + O_SV + ((((tok * 8 + hh) * 2 + 1) * 16) + (code & 15u)) * 4)) & 127u;
                ee[i] = (int)(i0 * 128u + i1);
            }
            const float inv = 1.0f / sm;
            int* eo = eout + (size_t)(tok0 + tok) * 128 + hh * 16; float* go = gout + (size_t)(tok0 + tok) * 128 + hh * 16;
#pragma unroll
            for (int c4 = 0; c4 < 4; ++c4) {
                *(u32x4*)(eo + 4 * c4) = (u32x4){(unsigned)ee[4 * c4], (unsigned)ee[4 * c4 + 1], (unsigned)ee[4 * c4 + 2], (unsigned)ee[4 * c4 + 3]};
                *(f32x4*)(go + 4 * c4) = (f32x4){ex[4 * c4] * inv, ex[4 * c4 + 1] * inv, ex[4 * c4 + 2] * inv, ex[4 * c4 + 3] * inv};
            }
        }
        BLOCK_SYNC();
    }
}
__device__ __forceinline__ float gelu_exact(float x) { return 0.5f * x * (1.0f + erff(x * 0.70710678118654752f)); }
__device__ __forceinline__ float dot16_fp8(const u32x4 w, const float* x) {
    float s0 = 0.f, s1 = 0.f;
    const int ww[4] = {(int)w.x, (int)w.y, (int)w.z, (int)w.w};
#pragma unroll
    for (int q = 0; q < 4; ++q) { const f32x2 lo = __builtin_amdgcn_cvt_pk_f32_fp8(ww[q], false), hi = __builtin_amdgcn_cvt_pk_f32_fp8(ww[q], true);
        s0 += lo.x * x[4 * q] + hi.x * x[4 * q + 2]; s1 += lo.y * x[4 * q + 1] + hi.y * x[4 * q + 3]; }
    return s0 + s1;
}
__device__ __forceinline__ void axpy16_fp8(const u32x4 w, float a, float* o) {
    const int ww[4] = {(int)w.x, (int)w.y, (int)w.z, (int)w.w};
#pragma unroll
    for (int q = 0; q < 4; ++q) { const f32x2 lo = __builtin_amdgcn_cvt_pk_f32_fp8(ww[q], false), hi = __builtin_amdgcn_cvt_pk_f32_fp8(ww[q], true);
        o[4 * q] += a * lo.x; o[4 * q + 1] += a * lo.y; o[4 * q + 2] += a * hi.x; o[4 * q + 3] += a * hi.y; }
}
__device__ __forceinline__ void phase8(const Params& P) {
    const int lane = threadIdx.x & 63, wave = threadIdx.x >> 6;
    const int gw = blockIdx.x * 8 + wave, NGW = gridDim.x * 8;
    unsigned char* ws = P.ws;
    const unsigned char* Ub = ws + WS_UB; const unsigned char* Vb = ws + WS_VB;
    const int* eidx = (const int*)(ws + WS_EXP); const float* gts = (const float*)(ws + WS_GATE); const float* tsc = (const float*)(ws + WS_TSC);
    for (int tok = gw; tok < NTOK; tok += NGW) {
        int lo16 = lane * 16; asm volatile("" : "+v"(lo16));
        float x[32], o[32];
        {
            const bf16_t* hr = (const bf16_t*)(ws + WS_H1B) + (size_t)tok * D + lo16;
#pragma unroll
            for (int i = 0; i < 2; ++i) { unpack8(*(const u32x4*)(hr + 1024 * i), x + 16 * i); unpack8(*(const u32x4*)(hr + 1024 * i + 8), x + 16 * i + 8); }
#pragma unroll
            for (int i = 0; i < 32; ++i) o[i] = 0.f;
        }
        const int e_lo = eidx[(size_t)tok * 128 + lane], e_hi = eidx[(size_t)tok * 128 + 64 + lane];
        const float su_lo = tsc[e_lo], su_hi = tsc[e_hi];
        const float gv_lo = gts[(size_t)tok * 128 + lane] * tsc[16384 + e_lo], gv_hi = gts[(size_t)tok * 128 + 64 + lane] * tsc[16384 + e_hi];
        u32x4 ua[2][2], va[2][2], ub[2][2], vb[2][2];
        auto issue = [&](int g, u32x4 (&uu)[2][2], u32x4 (&vv)[2][2]) {
            const int ev = (g < 32) ? e_lo : e_hi;
#pragma unroll
            for (int j = 0; j < 2; ++j) {
                const int e = __builtin_amdgcn_readlane(ev, (2 * g + j) & 63);
                const unsigned char* up = Ub + (size_t)e * D + lo16; const unsigned char* vp = Vb + (size_t)e * D + lo16;
#pragma unroll
                for (int i = 0; i < 2; ++i) { uu[j][i] = *(const u32x4*)(up + 1024 * i); vv[j][i] = *(const u32x4*)(vp + 1024 * i); }
            }
        };
        auto consume = [&](int g, const u32x4 (&uu)[2][2], const u32x4 (&vv)[2][2]) {
            const float suv = (g < 32) ? su_lo : su_hi, gvv = (g < 32) ? gv_lo : gv_hi;
            float dd[2];
#pragma unroll
            for (int j = 0; j < 2; ++j) dd[j] = dot16_fp8(uu[j][0], x) + dot16_fp8(uu[j][1], x + 16);
#pragma unroll
            for (int j = 0; j < 2; ++j) dd[j] = wave_sum_dpp(dd[j]);
            const int l0 = (2 * g) & 63;
            const pg8::f32x2 ge = pg8::gelu_pk((pg8::f32x2){dd[0] * readlane_f(suv, l0), dd[1] * readlane_f(suv, l0 + 1)});
            const float a0 = ge.x * readlane_f(gvv, l0), a1 = ge.y * readlane_f(gvv, l0 + 1);
            axpy16_fp8(vv[0][0], a0, o); axpy16_fp8(vv[0][1], a0, o + 16);
            axpy16_fp8(vv[1][0], a1, o); axpy16_fp8(vv[1][1], a1, o + 16);
        };
        issue(0, ua, va);
        for (int g = 0; g < 64; g += 2) {
            issue(g + 1, ub, vb);
            consume(g, ua, va);
            if (g + 2 < 64) issue(g + 2, ua, va);
            consume(g + 1, ub, vb);
        }
        float s = 0.f;
#pragma unroll
        for (int i = 0; i < 32; ++i) { o[i] += DN_ALPHA * x[i]; s += o[i]; }
        const float mean = wave_sum_dpp(s) * (1.0f / D); float q = 0.f;
#pragma unroll
        for (int i = 0; i < 32; ++i) { o[i] -= mean; q += o[i] * o[i]; }
        const float rstd = 1.0f / sqrtf(wave_sum_dpp(q) * (1.0f / D) + LN_EPS);
        float* orow = P.out + (size_t)tok * D + lo16;
#pragma unroll
        for (int i = 0; i < 2; ++i)
#pragma unroll
            for (int c = 0; c < 4; ++c) {
                const int off = 1024 * i + lo16 + 4 * c;
                const f32x4 g0 = *(const f32x4*)(P.in[I_LN2G] + off), b0 = *(const f32x4*)(P.in[I_LN2B] + off);
                f32x4 r0;
                r0.x = o[16 * i + 4 * c + 0] * rstd * g0.x + b0.x; r0.y = o[16 * i + 4 * c + 1] * rstd * g0.y + b0.y; r0.z = o[16 * i + 4 * c + 2] * rstd * g0.z + b0.z; r0.w = o[16 * i + 4 * c + 3] * rstd * g0.w + b0.w;
                *(f32x4*)(orow + 1024 * i + 4 * c) = r0;
            }
    }
}
#ifndef MK_MULTI
#define MK_MULTI 0
#endif
__global__ __launch_bounds__(512, 2) void hybrid_fwd(Params P) {
    extern __shared__ __attribute__((aligned(16))) unsigned char shm[];
    ldsp lds = (ldsp)shm;
    cg::grid_group grid = cg::this_grid();
    unsigned char* ws = P.ws;
    volatile LAS unsigned* xst = (volatile LAS unsigned*)(lds + LDS_BYTES - 16);
    if (threadIdx.x == 0) { xst[0] = 0u; xst[1] = 0u; }
    __syncthreads();
    const XcdBarrier xbar = xcd_barrier_post((unsigned*)(ws + WS_BAR), xst);
    const int lo = P.ph_lo, hi = P.ph_hi;
#ifdef DBG_TA
    unsigned long long ts0 = 0, ts1 = 0, ts2 = 0, ts3 = 0, ts4 = 0, ts5 = 0, ts6 = 0, ts7 = 0, ts8 = 0, ts9 = 0, ts10 = 0, ts11 = 0;
#define STAMP(k) ts##k = __builtin_amdgcn_s_memrealtime()
#else
#define STAMP(k) do { } while (0)
#endif
    STAMP(0);
#ifndef REPEAT_PHASE
#define REPEAT_PHASE -1
#define REPEAT_N 1
#endif
#define PHASE(k) if (lo <= (k) && (k) < hi) for (int rep_ = 0; rep_ < ((k) == REPEAT_PHASE ? REPEAT_N : 1); ++rep_)
#define SEAM(k) do { if (lo <= (k) && (k) + 1 < hi) { if ((k) == 0) { asm volatile("s_waitcnt vmcnt(0) lgkmcnt(0)" ::: "memory"); __syncthreads(); grid.sync(); } xcd_barrier(xbar); } } while (0)
    PHASE(0) phase0(P);
    SEAM(0); STAMP(1);
    PHASE(1) { pg8::EpiBf16<0> E; E.O = (bf16_t*)(ws + WS_P); E.ldc = NPAD; E.bias = nullptr; E.split_cols = 0; E.split_stride = 0;
        run_gemm(lds, (const bf16_t*)(ws + WS_H0B), (const bf16_t*)(ws + WS_WTIN), MROWS, NPAD, 2048, E); }
    SEAM(1); STAMP(2);
    PHASE(2) phase2(P, lds);
    SEAM(2); STAMP(3);
    PHASE(3) phase3(P);
    SEAM(3); STAMP(4);
    PHASE(4) phase3b(P, lds);
    SEAM(4); STAMP(5);
    PHASE(5) {
        { pg8::EpiGateA E; E.C = (float*)(ws + WS_MPART); E.p = (const bf16_t*)(ws + WS_P); E.bgate = P.in[I_BGATE];
          run_gemm(lds, (const bf16_t*)(ws + WS_YA), (const bf16_t*)(ws + WS_WTA), NTOK, 2048, 2048, E); }
        { pg8::EpiGateB E; E.C = (const float*)(ws + WS_MPART); E.O = (bf16_t*)(ws + WS_MERGED); E.p = (const bf16_t*)(ws + WS_P); E.bgate = P.in[I_BGATE];
          run_gemm(lds, (const bf16_t*)(ws + WS_YB), (const bf16_t*)(ws + WS_WTB), NTOK, 2048, 1024, E); }
    }
    SEAM(5); STAMP(6);
    PHASE(6) { pg8::EpiResid E; E.C = (float*)(ws + WS_X1); E.h0 = (const bf16_t*)(ws + WS_H0B); E.alpha = DN_ALPHA;
        run_gemm(lds, (const bf16_t*)(ws + WS_MERGED), (const bf16_t*)(ws + WS_WTOUT), NTOK, 2048, 2048, E); }
    SEAM(6); STAMP(7);
    PHASE(7) phase5b(P);
    SEAM(7); STAMP(8);
    PHASE(8) { pg8::EpiBf16<0> E; E.O = (bf16_t*)(ws + WS_Q); E.ldc = D; E.bias = nullptr; E.split_cols = 0; E.split_stride = 0;
        run_gemm(lds, (const bf16_t*)(ws + WS_H1B), (const bf16_t*)(ws + WS_WTQ), NTOK, 2048, 2048, E); }
    SEAM(8); STAMP(9);
    PHASE(9) phase7(P, lds);
    SEAM(9); STAMP(10);
    PHASE(10) phase8(P);
#ifdef DBG_TA
    {
        __threadfence_system(); asm volatile("s_waitcnt vmcnt(0) lgkmcnt(0)" ::: "memory"); __syncthreads(); grid.sync(); __threadfence_system();
        STAMP(11);
        const unsigned long long tt[12] = {ts0, ts1, ts2, ts3, ts4, ts5, ts6, ts7, ts8, ts9, ts10, ts11};
        const float ta = (float)(tt[DBG_TA + 1] - tt[DBG_TA]) * 0.01f, tb = (float)(tt[DBG_TB + 1] - tt[DBG_TB]) * 0.01f;
        if (blockIdx.x == 0) { for (int i = threadIdx.x + 1; i <= 1000000; i += 512) P.out[i] = tb; if (threadIdx.x == 0) P.out[0] = 1000.0f * ta; }
    }
#endif
#ifdef DBG_STOP
    {
        __threadfence_system(); asm volatile("s_waitcnt vmcnt(0) lgkmcnt(0)" ::: "memory"); __syncthreads(); grid.sync(); __threadfence_system();
        const size_t a = DBG_A, b = DBG_B; const unsigned* w = (const unsigned*)(ws + a); const size_t nw = (b - a) / 4, NO = (size_t)NTOK * D;
        for (size_t i = (size_t)blockIdx.x * 512 + threadIdx.x; i < NO; i += (size_t)gridDim.x * 512) {
            unsigned acc = 0; for (size_t j = i; j < nw; j += NO) { const unsigned x = w[j]; acc += (x & 0xffffu) + (x >> 16); }
            P.out[i] = (float)(acc & 0xfffffu);
        }
    }
#endif
#undef PHASE
#undef SEAM
}

extern "C" void kernel_launch(void* const* d_in, const int* in_sizes, int n_in, void* d_out, int out_size, void* d_ws, size_t ws_size, hipStream_t stream) {
    static int grid = 0;
    if (grid == 0) {
        if (n_in != 30 || out_size != NTOK * D || ws_size < WS_END) { fprintf(stderr, "kernel_launch: unexpected shapes (n_in %d, out %d, ws %zu < %zu)\n", n_in, out_size, ws_size, (size_t)WS_END); grid = -1; return; }
        int dev = 0, cus = 0, per_cu = 0;
        if (hipGetDevice(&dev) != hipSuccess || hipDeviceGetAttribute(&cus, hipDeviceAttributeMultiprocessorCount, dev) != hipSuccess) { grid = -1; return; }
        if (hipFuncSetAttribute((const void*)hybrid_fwd, hipFuncAttributeMaxDynamicSharedMemorySize, LDS_BYTES) != hipSuccess) { fprintf(stderr, "kernel_launch: hipFuncSetAttribute failed\n"); grid = -1; return; }
        if (hipOccupancyMaxActiveBlocksPerMultiprocessor(&per_cu, (const void*)hybrid_fwd, 512, LDS_BYTES) != hipSuccess || per_cu < 1) { fprintf(stderr, "kernel_launch: occupancy query says %d\n", per_cu); grid = -1; return; }
        (void)hipGetLastError();
        grid = cus;
    }
    if (grid < 0) return;
    if (hipMemsetAsync((unsigned char*)d_ws + WS_BAR, 0, XCD_BAR_WORDS * 4, stream) != hipSuccess) { fprintf(stderr, "kernel_launch: memset failed\n"); return; }
    Params p{};
    for (int i = 0; i < 30; ++i) p.in[i] = (const float*)d_in[i];
    p.out = (float*)d_out; p.ws = (unsigned char*)d_ws;
#if MK_MULTI
    for (int ph = 0; ph <= NPHASE; ++ph) { p.ph_lo = ph; p.ph_hi = ph + 1; hipLaunchKernelGGL(hybrid_fwd, dim3(grid), dim3(512), LDS_BYTES, stream, p); }
#else
    p.ph_lo = 0; p.ph_hi = NPHASE + 1;
#ifdef DBG_STOP
    p.ph_hi = DBG_STOP + 1;
#endif
    void* args[] = {&p};
    hipError_t e = hipLaunchCooperativeKernel((const void*)hybrid_fwd, dim3(grid), dim3(512), args, LDS_BYTES, stream);
    if (e != hipSuccess) fprintf(stderr, "kernel_launch: cooperative launch failed: %s (grid %d)\n", hipGetErrorString(e), grid);
#endif
}
```

```cpp
#include <hip/hip_runtime.h>
#include <hip/hip_cooperative_groups.h>
#include <cstdio>
#include <cstdint>
namespace cg = cooperative_groups;
namespace pg8 {
#define PG8_LAS __attribute__((address_space(3)))
typedef unsigned short bf16_t;
typedef short bf16x8 __attribute__((ext_vector_type(8)));
typedef float f32x4 __attribute__((ext_vector_type(4)));
typedef unsigned u32x4 __attribute__((ext_vector_type(4)));
constexpr int BM = 256, BK = 64, HALF = 128, HTB = HALF * BK * 2  , STAGE_BYTES = 8 * HTB, NXCD = 8, WGM = 8;

__host__ __device__ __forceinline__ int lds_byte(int r, int c) { const int st = (r >> 4) * 2 + (c >> 5), rr = r & 15, cc = c & 31, ob = rr * 64 + cc * 2; return st * 1024 + (ob ^ (((ob >> 9) & 1) << 5)); }
__host__ __device__ __forceinline__ void stage_rc(int b, int& R, int& C) { const int st = b / 1024, sb = b % 1024, swz = sb ^ (((sb >> 9) & 1) << 5); R = (st >> 1) * 16 + swz / 64; C = (st & 1) * 32 + (swz % 64) / 2; }
__host__ __device__ __forceinline__ int perm32(int rho) { const int n = rho >> 4, i = rho & 15; return 8 * (i >> 2) + 4 * n + (i & 3); }

struct Unit { int pm, pn; };
struct Gemm { const bf16_t* A; const bf16_t* Bt; int M, N, K; };

struct StaticOrder {
    int nM, nN, nwg, G, c;
    __host__ __device__ void init(int M, int N, int G_, int c_) { nM = M / BM; nN = N / BM; nwg = nM * nN; G = G_; c = c_; }
    __host__ __device__ bool next(int i, Unit& u) const {
        const long L = (long)i * G + c; if (L >= nwg) return false;
        int wgid = (int)L; { const int q = nwg / NXCD, r = nwg % NXCD, xcd = wgid % NXCD, off = wgid / NXCD; wgid = (xcd < r ? xcd * (q + 1) : r * (q + 1) + (xcd - r) * q) + off; }
        const int nig = WGM * nN, gid = wgid / nig, fm = gid * WGM, gsz = (nM - fm) < WGM ? (nM - fm) : WGM;
        u.pm = fm + ((wgid % nig) % gsz); u.pn = (wgid % nig) / gsz; return true;
    }
    __device__ __forceinline__ void a_ready(const Unit&) const {}
    __device__ __forceinline__ void done(const Unit&) const {}
};
struct CountedOrder : StaticOrder {
    const unsigned* ready; unsigned need; unsigned* tmo;
    __device__ __forceinline__ void a_ready(const Unit& u) const {
        if (threadIdx.x < 64) {
            const unsigned long long t0 = __builtin_amdgcn_s_memrealtime(); unsigned polls = 0;
            while ((unsigned)__builtin_amdgcn_readfirstlane(__hip_atomic_load(ready + 64 * u.pm, __ATOMIC_RELAXED, __HIP_MEMORY_SCOPE_AGENT)) < need) {
                if ((++polls & 255u) == 0u && __builtin_amdgcn_readfirstlane(__hip_atomic_load(tmo, __ATOMIC_RELAXED, __HIP_MEMORY_SCOPE_AGENT)) != 0u) break;
                if (__builtin_amdgcn_s_memrealtime() - t0 > 2000000ull) {
                    if (threadIdx.x == 0) { unsigned expect = 0u; __hip_atomic_compare_exchange_strong(tmo + 1, &expect, 0x600u | (unsigned)(u.pm & 0xff), __ATOMIC_RELAXED, __ATOMIC_RELAXED, __HIP_MEMORY_SCOPE_AGENT); __hip_atomic_store(tmo, 1u, __ATOMIC_RELAXED, __HIP_MEMORY_SCOPE_AGENT); }
                    break; }
                __builtin_amdgcn_s_sleep(2); }
            __builtin_amdgcn_fence(__ATOMIC_ACQUIRE, "agent");
            asm volatile("s_waitcnt vmcnt(0)" ::: "memory");
        }
#if !defined(BROKEN_HOOK_NO_BARRIER)
        asm volatile("" ::: "memory"); __builtin_amdgcn_s_barrier(); asm volatile("" ::: "memory");
#endif
    }
};

typedef float cvt_f32x2 __attribute__((ext_vector_type(2))); typedef __bf16 cvt_bf16x2 __attribute__((ext_vector_type(2)));
__device__ __forceinline__ unsigned cvt_pk_bf16(float lo, float hi) { const cvt_f32x2 v = {lo, hi}; const cvt_bf16x2 b = __builtin_convertvector(v, cvt_bf16x2); return __builtin_bit_cast(unsigned, b); }
typedef float f32x2 __attribute__((ext_vector_type(2)));
__device__ __forceinline__ f32x2 gelu_pk(f32x2 v) {
    const f32x2 av = __builtin_elementwise_abs(v), d = av * 0.2316418882f + 1.0f;
    f32x2 t; t.x = __builtin_amdgcn_rcpf(d.x); t.y = __builtin_amdgcn_rcpf(d.y);
    f32x2 q = t * 0.5307027145f + (-0.7265760135f); q = q * t + 0.7107068705f; q = q * t + (-0.142248368f); q = q * t + 0.127414796f; q = q * t;
    const f32x2 s = (v * v) * (-0.72134752044f);
    f32x2 e; e.x = __builtin_amdgcn_exp2f(s.x); e.y = __builtin_amdgcn_exp2f(s.y);
    const f32x2 m = v * (q * e), r = v - m;
    f32x2 o; o.x = v.x < 0.f ? m.x : r.x; o.y = v.y < 0.f ? m.y : r.y; return o;
}

struct EpiF32 {
    static constexpr bool PERM = false, AFTER_DRAIN = false;
    float* C; int ldc; const float* bias;
    __device__ __forceinline__ void operator()(const f32x4 (&acc)[2][2][4][2], const Unit& u, int wr, int wc, int fr, int fq) const {
        const int row0 = u.pm * BM + wr * 64 + fr, col0 = u.pn * BM + wc * 32 + 4 * fq;
        f32x4 bv[2][2];
#pragma unroll
        for (int bj = 0; bj < 2; ++bj)
#pragma unroll
            for (int n = 0; n < 2; ++n) bv[bj][n] = bias ? *(const f32x4*)(bias + col0 + bj * HALF + n * 16) : (f32x4){0.f, 0.f, 0.f, 0.f};
#pragma unroll
        for (int ai = 0; ai < 2; ++ai)
#pragma unroll
            for (int m = 0; m < 4; ++m) { float* rowp = C + (size_t)(row0 + ai * HALF + m * 16) * ldc + col0;
#pragma unroll
                for (int bj = 0; bj < 2; ++bj)
#pragma unroll
                    for (int n = 0; n < 2; ++n) *(f32x4*)(rowp + bj * HALF + n * 16) = acc[ai][bj][m][n] + bv[bj][n]; }
    }
};
template <int ACT  > struct EpiBf16 {
    static constexpr bool PERM = true, AFTER_DRAIN = false;
    bf16_t* O; int ldc; const float* bias; int split_cols; size_t split_stride;
    __device__ __forceinline__ void operator()(const f32x4 (&acc)[2][2][4][2], const Unit& u, int wr, int wc, int fr, int fq) const {
        const int row0 = u.pm * BM + wr * 64 + fr; int colt = u.pn * BM; bf16_t* base = O;
        if (split_cols) { const int t = colt / split_cols; base += (size_t)t * split_stride; colt -= t * split_cols; }
        const int col0 = colt + wc * 32 + 8 * fq, bcol0 = u.pn * BM + wc * 32 + 8 * fq;
        f32x4 bv[2][2];
#pragma unroll
        for (int bj = 0; bj < 2; ++bj)
#pragma unroll
            for (int n = 0; n < 2; ++n) bv[bj][n] = bias ? *(const f32x4*)(bias + bcol0 + bj * HALF + 4 * n) : (f32x4){0.f, 0.f, 0.f, 0.f};
#pragma unroll
        for (int ai = 0; ai < 2; ++ai)
#pragma unroll
            for (int m = 0; m < 4; ++m) { bf16_t* rowp = base + (size_t)(row0 + ai * HALF + m * 16) * ldc + col0;
#pragma unroll
                for (int bj = 0; bj < 2; ++bj) { f32x4 v0 = acc[ai][bj][m][0] + bv[bj][0], v1 = acc[ai][bj][m][1] + bv[bj][1];
                    if (ACT == 1) { f32x2 a = gelu_pk((f32x2){v0[0], v0[1]}), b = gelu_pk((f32x2){v0[2], v0[3]}), c = gelu_pk((f32x2){v1[0], v1[1]}), d = gelu_pk((f32x2){v1[2], v1[3]});
                        v0 = (f32x4){a.x, a.y, b.x, b.y}; v1 = (f32x4){c.x, c.y, d.x, d.y}; }
                    if (ACT == 2) {
#pragma unroll
                        for (int j = 0; j < 4; ++j) { v0[j] = 0.5f * v0[j] * (1.0f + erff(v0[j] * 0.70710678f)); v1[j] = 0.5f * v1[j] * (1.0f + erff(v1[j] * 0.70710678f)); } }
                    u32x4 w; w.x = cvt_pk_bf16(v0[0], v0[1]); w.y = cvt_pk_bf16(v0[2], v0[3]); w.z = cvt_pk_bf16(v1[0], v1[1]); w.w = cvt_pk_bf16(v1[2], v1[3]);
                    *(u32x4*)(rowp + bj * HALF) = w; } }
    }
};
template <class Epi, class Sched, bool STAMP = false>
__device__ __forceinline__ void gemm_phase(PG8_LAS unsigned char* lds, const Gemm g, const Sched& S, const Epi& E, unsigned long long* stamps) {
    const int tid = threadIdx.x, wid = __builtin_amdgcn_readfirstlane(tid >> 6), lane = tid & 63, wr = wid >> 2, wc = wid & 3, fr = lane & 15, fq = lane >> 4;
    const int K = g.K, nt = K / BK;
    int ts_lo = 0, ts_hi = 0, nts = 0; const unsigned long long rt_entry = STAMP ? (unsigned long long)wall_clock64() : 0ull;
#define PG8_STAMP() do { if (STAMP && wid == 0 && nts < 64) { const unsigned long long _c = (unsigned long long)clock64(); \
        ts_lo = (lane == nts) ? (int)(unsigned)_c : ts_lo; ts_hi = (lane == nts) ? (int)(unsigned)(_c >> 32) : ts_hi; ++nts; } } while (0)
    PG8_STAMP();
    unsigned voffA[2], voffB[2];
#pragma unroll
    for (int i = 0; i < 2; ++i) { int R, C; stage_rc(tid * 16 + i * 8192, R, C); const int Rb = Epi::PERM ? ((R & ~31) + perm32(R & 31)) : R;
        voffA[i] = (unsigned)(R * K + C) * 2u; voffB[i] = (unsigned)(Rb * K + C) * 2u; }
    const size_t kstep = (size_t)(BK * 2);
    const size_t hstep = (size_t)HALF * K * 2;
    const size_t tstep = 2 * hstep;
    const unsigned ldsw = (unsigned)wid * 1024u;
    const int aoff = lds_byte(wr * 64 + fr, fq * 8), boff = lds_byte(wc * 32 + fr, fq * 8);
#define PG8_SA(b, h) (((b) * 2 + (h)) * HTB)
#define PG8_SB(b, h) ((4 + (b) * 2 + (h)) * HTB)
#define PG8_STAGE(bufoff, gbase, voff) do { _Pragma("unroll") for (int _i = 0; _i < 2; ++_i) \
        __builtin_amdgcn_global_load_lds((const unsigned*)((const char*)(gbase) + (voff)[_i]), (PG8_LAS unsigned*)(lds + (bufoff) + ldsw + _i * 8192), 16, 0, 0); } while (0)
#define PG8_LDA(dst, b, h) do { _Pragma("unroll") for (int m = 0; m < 4; ++m) _Pragma("unroll") for (int k = 0; k < 2; ++k) dst[m][k] = *(const PG8_LAS bf16x8*)(lds + PG8_SA(b, h) + aoff + m * 2048 + k * 1024); } while (0)
#define PG8_LDB(dst, b, h) do { _Pragma("unroll") for (int n = 0; n < 2; ++n) _Pragma("unroll") for (int k = 0; k < 2; ++k) dst[n][k] = *(const PG8_LAS bf16x8*)(lds + PG8_SB(b, h) + boff + n * 2048 + k * 1024); } while (0)
#define PG8_MMA(ai, bj, At, Bt) do { __builtin_amdgcn_s_setprio(1); _Pragma("unroll") for (int m = 0; m < 4; ++m) _Pragma("unroll") for (int n = 0; n < 2; ++n) _Pragma("unroll") for (int k = 0; k < 2; ++k) \
        acc[ai][bj][m][n] = __builtin_amdgcn_mfma_f32_16x16x32_bf16(Bt[n][k], At[m][k], acc[ai][bj][m][n], 0, 0, 0); __builtin_amdgcn_s_setprio(0); } while (0)
#define PG8_WAIT_V(n) asm volatile("s_waitcnt vmcnt(" #n ")" ::: "memory")
#define PG8_WAIT_L(n) asm volatile("s_waitcnt lgkmcnt(" #n ")" ::: "memory")
#define PG8_BAR __builtin_amdgcn_s_barrier()
#define PG8_SCHED __builtin_amdgcn_sched_barrier(0)
    Unit cur, nxt; int ui = 0;
    if (!S.next(0, cur)) return;
    f32x4 acc[2][2][4][2];
#pragma unroll
    for (int a = 0; a < 2; ++a)
#pragma unroll
        for (int b = 0; b < 2; ++b)
#pragma unroll
            for (int m = 0; m < 4; ++m)
#pragma unroll
                for (int n = 0; n < 2; ++n) acc[a][b][m][n] = (f32x4){0.f, 0.f, 0.f, 0.f};
    bf16x8 At[4][2], B0[2][2], B1[2][2];
    const char* cA = (const char*)g.A + (size_t)cur.pm * tstep; const char* cB = (const char*)g.Bt + (size_t)cur.pn * tstep;
    S.a_ready(cur);
    PG8_STAGE(PG8_SB(0, 0), cB, voffB); PG8_STAGE(PG8_SA(0, 0), cA, voffA); PG8_STAGE(PG8_SB(0, 1), cB + hstep, voffB); PG8_STAGE(PG8_SA(0, 1), cA + hstep, voffA);
    if (wr == 1) PG8_BAR;
    PG8_WAIT_V(4); PG8_BAR;
    PG8_STAGE(PG8_SB(1, 0), cB + kstep, voffB); PG8_STAGE(PG8_SA(1, 0), cA + kstep, voffA); PG8_STAGE(PG8_SB(1, 1), cB + hstep + kstep, voffB);
    PG8_WAIT_V(6); PG8_BAR;
    PG8_STAMP();
    for (;;) {
        const bool has_next = S.next(ui + 1, nxt);
        const char* nA = has_next ? (const char*)g.A + (size_t)nxt.pm * tstep : cA; const char* nB = has_next ? (const char*)g.Bt + (size_t)nxt.pn * tstep : cB;
        for (int t = 0; t < nt; t += 2) {
            const bool last = (t == nt - 2);
            const char* a1 = cA + (size_t)(t + 1) * kstep;
            const char* a2 = last ? nA : cA + (size_t)(t + 2) * kstep; const char* b2 = last ? nB : cB + (size_t)(t + 2) * kstep;
            const char* a3 = a2 + kstep; const char* b3 = b2 + kstep;
            if (last && has_next) S.a_ready(nxt);
            PG8_LDB(B0, 0, 0); PG8_SCHED; PG8_LDA(At, 0, 0); PG8_STAGE(PG8_SA(1, 1), a1 + hstep, voffA);
            PG8_WAIT_L(8); PG8_BAR; PG8_WAIT_L(0); PG8_MMA(0, 0, At, B0); PG8_BAR; PG8_SCHED;
            PG8_LDB(B1, 0, 1); PG8_STAGE(PG8_SB(0, 0), b2, voffB);
            PG8_BAR; PG8_WAIT_L(0); PG8_MMA(0, 1, At, B1); PG8_BAR;
            PG8_LDA(At, 0, 1); PG8_STAGE(PG8_SA(0, 0), a2, voffA);
            PG8_BAR; PG8_WAIT_L(0); PG8_MMA(1, 0, At, B0); PG8_BAR; PG8_SCHED;
            PG8_STAGE(PG8_SB(0, 1), b2 + hstep, voffB);
            PG8_WAIT_V(6); PG8_BAR; PG8_MMA(1, 1, At, B1); PG8_BAR;
            PG8_LDB(B0, 1, 0); PG8_SCHED; PG8_LDA(At, 1, 0); PG8_STAGE(PG8_SA(0, 1), a2 + hstep, voffA);
            PG8_WAIT_L(8); PG8_BAR; PG8_WAIT_L(0); PG8_MMA(0, 0, At, B0); PG8_BAR; PG8_SCHED;
            PG8_LDB(B1, 1, 1); PG8_STAGE(PG8_SB(1, 0), b3, voffB);
            PG8_BAR; PG8_WAIT_L(0); PG8_MMA(0, 1, At, B1); PG8_BAR;
            PG8_LDA(At, 1, 1); PG8_STAGE(PG8_SA(1, 0), a3, voffA);
            PG8_BAR; PG8_WAIT_L(0); PG8_MMA(1, 0, At, B0); PG8_BAR; PG8_SCHED;
            PG8_STAGE(PG8_SB(1, 1), b3 + hstep, voffB);
            PG8_WAIT_V(6); PG8_BAR; PG8_MMA(1, 1, At, B1); PG8_BAR;
        }
        PG8_STAMP();
        if constexpr (!Epi::AFTER_DRAIN) { E(acc, cur, wr, wc, fr, fq); S.done(cur); }
        PG8_STAMP();
        if (!has_next) break;
#pragma unroll
        for (int a = 0; a < 2; ++a)
#pragma unroll
            for (int b = 0; b < 2; ++b)
#pragma unroll
                for (int m = 0; m < 4; ++m)
#pragma unroll
                    for (int n = 0; n < 2; ++n) acc[a][b][m][n] = (f32x4){0.f, 0.f, 0.f, 0.f};
        cur = nxt; cA = nA; cB = nB; ++ui;
    }
    PG8_WAIT_V(0);
    if (wr == 0) PG8_BAR;
    PG8_BAR;
    if constexpr (Epi::AFTER_DRAIN) { E.fused(acc, cur, wr, wc, fr, fq, lds, wid, lane); S.done(cur); }
    PG8_STAMP();
    if (STAMP && wid == 0) { stamps[lane] = lane < nts ? (((unsigned long long)(unsigned)ts_hi << 32) | (unsigned)ts_lo) : 0ull;
        if (lane == 62) stamps[62] = rt_entry; if (lane == 63) stamps[63] = (unsigned long long)wall_clock64(); }
#undef PG8_STAMP
#undef PG8_SA
#undef PG8_SB
#undef PG8_STAGE
#undef PG8_LDA
#undef PG8_LDB
#undef PG8_MMA
#undef PG8_WAIT_V
#undef PG8_WAIT_L
#undef PG8_BAR
#undef PG8_SCHED
}
}
#define LAS __attribute__((address_space(3)))
typedef unsigned short bf16_t;
typedef short bf16x8 __attribute__((ext_vector_type(8)));
typedef float f32x4 __attribute__((ext_vector_type(4)));
typedef float f32x2 __attribute__((ext_vector_type(2)));
typedef unsigned u32x4 __attribute__((ext_vector_type(4)));
typedef unsigned u32x2 __attribute__((ext_vector_type(2)));
typedef LAS unsigned char* ldsp;

constexpr int D = 2048, NTOK = 8192, SEQ = 4096, MROWS = 8448, ROW_META = 8192;
constexpr int INC = 11712, NPAD = 11776;
constexpr int C_R = 0, C_K = 2048, C_V = 4096, C_WL = 6144, C_AL = 6240, C_GL = 6336, C_POOL = 6592, C_G0 = 7616, C_G1 = 9664;
constexpr int NUNITS = 4128;
constexpr float DSCALE = 0.6065306597126334f;
constexpr float DN_ALPHA = 1.189207115002721f;
constexpr float GN_EPS = 64e-5f, LN_EPS = 1e-5f;

constexpr size_t WS_P = 0;
constexpr size_t WS_UB = 0;
constexpr size_t WS_VB = 33554432;
constexpr size_t WS_H0B = 198967296;
constexpr size_t WS_WTA = WS_H0B + 34603008;
constexpr size_t WS_WTB = WS_WTA + 8388608;
constexpr size_t WS_WTOUT = WS_WTB + 4194304;
constexpr size_t WS_WTQ = WS_WTOUT + 8388608;
constexpr size_t WS_WTPOOL = WS_WTQ + 8388608;
constexpr size_t WS_WTW2 = WS_WTPOOL + 524288;
constexpr size_t WS_WTA2 = WS_WTW2 + 393216;
constexpr size_t WS_WTG2 = WS_WTA2 + 393216;
constexpr size_t WS_SUBK = WS_WTG2 + 1048576;
constexpr size_t WS_BONUS = WS_SUBK + 65536;
constexpr size_t WS_REGC = WS_BONUS + 1048576;
constexpr size_t WS_WTIN = WS_REGC;
constexpr size_t UNITB = (size_t)NUNITS * 4096 * 2;
constexpr size_t WS_G = WS_REGC;
constexpr size_t WS_H0T = WS_REGC + UNITB;
constexpr size_t WS_RT = WS_REGC + 2 * UNITB;
constexpr size_t WS_Y0 = WS_REGC + 3 * UNITB;
constexpr size_t WS_S0T = WS_REGC + 4 * UNITB;
constexpr size_t WS_MERGED = WS_REGC;
constexpr size_t WS_MPART = WS_REGC + 33554432;
constexpr size_t WS_X1 = WS_REGC + 33554432;
constexpr size_t WS_H1B = WS_REGC + 100663296;
constexpr size_t WS_Q = WS_REGC + 134217728;
constexpr size_t WS_YA = WS_REGC + 5 * UNITB;
constexpr size_t WS_YB = WS_YA + 33554432;
constexpr size_t WS_EXP = WS_YB + 16777216;
constexpr size_t WS_GATE = WS_EXP + 4194304;
constexpr size_t WS_BAR = WS_GATE + 4194304;
constexpr size_t WS_TSC = WS_BAR + 16384;
constexpr size_t WS_END = WS_TSC + 131072;
static_assert(WS_Q + 33554432 <= WS_YA, "overlay");
static_assert(WS_VB + 33554432 <= WS_H0B, "overlay");

constexpr int LDS_BYTES = 163840;
constexpr int NPHASE = 10;

struct Params {
    const float* in[30];
    float* out;
    unsigned char* ws;
    int ph_lo, ph_hi;
};
enum { I_X = 0, I_META, I_LNIN_G, I_LNIN_B, I_WIN, I_MU, I_W0, I_WW2, I_A0, I_WA2, I_WG2, I_KK, I_KA, I_RK, I_GNG, I_GNB, I_WPOOL, I_PSCALE, I_BGATE,
       I_WBA, I_WBB, I_WOUT, I_LN1G, I_LN1B, I_WQ, I_SUBK, I_UT, I_VT, I_LN2G, I_LN2B };

__device__ __forceinline__ unsigned pk2(float lo, float hi) { return pg8::cvt_pk_bf16(lo, hi); }
__device__ __forceinline__ float bflo(unsigned w) { return __uint_as_float(w << 16); }
__device__ __forceinline__ float bfhi(unsigned w) { return __uint_as_float(w & 0xffff0000u); }
__device__ __forceinline__ float bf1(bf16_t h) { return __uint_as_float(((unsigned)h) << 16); }
__device__ __forceinline__ bf16_t f2bf1(float f) { return (bf16_t)(pk2(f, f) & 0xffffu); }
__device__ __forceinline__ float wave_sum(float v) {
#pragma unroll
    for (int o = 1; o < 64; o <<= 1) v += __shfl_xor(v, o);
    return v;
}
__device__ __forceinline__ float sigmoidf_(float x) { return 1.0f / (1.0f + __expf(-x)); }
__device__ __forceinline__ f32x4 mfma16(bf16x8 a, bf16x8 b, f32x4 c) { return __builtin_amdgcn_mfma_f32_16x16x32_bf16(a, b, c, 0, 0, 0); }
__device__ __forceinline__ void unpack8(const u32x4 w, float* f) {
    f[0] = bflo(w.x); f[1] = bfhi(w.x); f[2] = bflo(w.y); f[3] = bfhi(w.y); f[4] = bflo(w.z); f[5] = bfhi(w.z); f[6] = bflo(w.w); f[7] = bfhi(w.w);
}
__device__ __forceinline__ u32x4 pack8(const float* f) { u32x4 w; w.x = pk2(f[0], f[1]); w.y = pk2(f[2], f[3]); w.z = pk2(f[4], f[5]); w.w = pk2(f[6], f[7]); return w; }
#define DPPF(v, ctrl) __builtin_bit_cast(float, __builtin_amdgcn_update_dpp(0, __builtin_bit_cast(int, (v)), (ctrl), 0xF, 0xF, true))
__device__ __forceinline__ float readlane_f(float v, int l) { return __builtin_bit_cast(float, __builtin_amdgcn_readlane(__builtin_bit_cast(int, v), l)); }
__device__ __forceinline__ float wave_sum_dpp(float v) {
    v += DPPF(v, 0xB1); v += DPPF(v, 0x4E); v += DPPF(v, 0x141); v += DPPF(v, 0x140);
    return (readlane_f(v, 0) + readlane_f(v, 16)) + (readlane_f(v, 32) + readlane_f(v, 48));
}
__device__ __forceinline__ float wave_max_dpp(float v) {
    v = fmaxf(v, DPPF(v, 0xB1)); v = fmaxf(v, DPPF(v, 0x4E)); v = fmaxf(v, DPPF(v, 0x141)); v = fmaxf(v, DPPF(v, 0x140));
    return fmaxf(fmaxf(readlane_f(v, 0), readlane_f(v, 16)), fmaxf(readlane_f(v, 32), readlane_f(v, 48)));
}
#define BLOCK_SYNC() __syncthreads()
#define XB_TMO      128
#define XB_XCNT(j)  (256  + 64 * (j))
#define XB_XSUB(j)  (1280 + 64 * (j))
#define XB_XGEN(j)  (2304 + 64 * (j))
#define XB_TOP      3328
#define XB_TOPGEN   3392
#define XCD_BAR_WORDS 3456
#define XB_SPIN_CAP (1u << 18)

__device__ __forceinline__ unsigned xb_ld(unsigned* p)              { return __hip_atomic_load(p, __ATOMIC_RELAXED, __HIP_MEMORY_SCOPE_AGENT); }
__device__ __forceinline__ unsigned xb_add(unsigned* p, unsigned v) { return __hip_atomic_fetch_add(p, v, __ATOMIC_RELAXED, __HIP_MEMORY_SCOPE_AGENT); }
__device__ __forceinline__ unsigned xb_xcc_id() { return (unsigned)__builtin_amdgcn_s_getreg((3 << 11) | 20) & 0xFu; }
#define XB_SPIN(cond, bar) do { unsigned _sp = 0; while (cond) { __builtin_amdgcn_s_sleep(1); \
    if ((++_sp & 255u) == 0u) { if (xb_ld(&(bar)[XB_TMO])) break; if (_sp > XB_SPIN_CAP) { atomicAdd(&(bar)[XB_TMO], 1u); break; } } } } while (0)

struct XcdBarrier {
    unsigned* bar; unsigned x;
    volatile LAS unsigned* st;
};

__device__ __forceinline__ XcdBarrier xcd_barrier_post(unsigned* bar, volatile LAS unsigned* st) {
    XcdBarrier b; b.bar = bar; b.x = xb_xcc_id(); b.st = st;
    if (threadIdx.x == 0) (void)xb_add(&bar[XB_XCNT(b.x)], 1u);
    return b;
}
__device__ __forceinline__ void xcd_barrier_complete(unsigned* bar, unsigned x, unsigned& nloc, unsigned& nx) {
    const unsigned G = gridDim.x * gridDim.y * gridDim.z;
    unsigned sum, cnt, mine, sp = 0u;
    for (;;) {
        sum = 0u; cnt = 0u; mine = 0u;
#pragma unroll
        for (unsigned j = 0; j < 16; ++j) { const unsigned c = xb_ld(&bar[XB_XCNT(j)]); sum += c; cnt += (c > 0u) ? 1u : 0u; mine = (j == x) ? c : mine; }
        if (sum == G) break;
        __builtin_amdgcn_s_sleep(1);
        if ((++sp & 255u) == 0u) { if (xb_ld(&bar[XB_TMO])) break; if (sp > XB_SPIN_CAP) { atomicAdd(&bar[XB_TMO], 1u); break; } }
    }
    nloc = mine > 0u ? mine : 1u; nx = cnt > 0u ? cnt : 1u;
}

__device__ __forceinline__ void xcd_barrier(const XcdBarrier& b) {
    asm volatile("s_waitcnt vmcnt(0)" ::: "memory");
    __syncthreads();
    if (threadIdx.x == 0) {
        unsigned* bar = b.bar;
        __builtin_amdgcn_s_waitcnt(0);
        unsigned nloc = b.st[0], nx = b.st[1];
        if (nloc == 0u) { xcd_barrier_complete(bar, b.x, nloc, nx); b.st[0] = nloc; b.st[1] = nx; }
        const unsigned old = xb_add(&bar[XB_XSUB(b.x)], 1u);
        const unsigned gen = old / nloc;
        if (old + 1u == (gen + 1u) * nloc) {
            __builtin_amdgcn_fence(__ATOMIC_RELEASE, "agent");
            asm volatile("s_waitcnt vmcnt(0)" ::: "memory");
            const unsigned og = xb_add(&bar[XB_TOP], 1u);
            const unsigned tg = og / nx;
            if (og + 1u == (tg + 1u) * nx) xb_add(&bar[XB_TOPGEN], 1u);
            else XB_SPIN(xb_ld(&bar[XB_TOPGEN]) == tg, bar);
            __builtin_amdgcn_fence(__ATOMIC_ACQUIRE, "agent");
            xb_add(&bar[XB_XGEN(b.x)], 1u);
            asm volatile("s_waitcnt vmcnt(0)" ::: "memory");
        } else {
            XB_SPIN(xb_ld(&bar[XB_XGEN(b.x)]) == gen, bar);
            __builtin_amdgcn_fence(__ATOMIC_ACQUIRE, "agent");
            asm volatile("s_waitcnt vmcnt(0)" ::: "memory");
        }
    }
    __syncthreads();
}

__device__ __forceinline__ void ln_row_bf16(const float* src, const float* g, const float* b, bf16_t* dst, int lane) {
    f32x4 v[8]; float s = 0.f;
#pragma unroll
    for (int j = 0; j < 8; ++j) { v[j] = ((const f32x4*)src)[lane + 64 * j]; s += (v[j].x + v[j].y) + (v[j].z + v[j].w); }
    const float mean = wave_sum(s) * (1.0f / D); float s2 = 0.f;
#pragma unroll
    for (int j = 0; j < 8; ++j) { v[j] = v[j] - mean; s2 += (v[j].x * v[j].x + v[j].y * v[j].y) + (v[j].z * v[j].z + v[j].w * v[j].w); }
    const float rstd = 1.0f / sqrtf(wave_sum(s2) * (1.0f / D) + LN_EPS);
#pragma unroll
    for (int j = 0; j < 8; ++j) {
        const f32x4 gg = ((const f32x4*)g)[lane + 64 * j], bb = ((const f32x4*)b)[lane + 64 * j];
        const f32x4 o = v[j] * rstd * gg + bb;
        u32x2 w; w.x = pk2(o.x, o.y); w.y = pk2(o.z, o.w);
        ((u32x2*)dst)[lane + 64 * j] = w;
    }
}
__device__ __forceinline__ void transpose_item(const float* W, int K, int N, int Npad, bf16_t* Wt, int item, int lane) {
    const int nblk = Npad >> 6, kb = item / nblk, nb = item - kb * nblk, n = nb * 64 + lane, k0 = kb * 32;
    float v[32];
    if (n < N) {
#pragma unroll
        for (int i = 0; i < 32; ++i) v[i] = W[(size_t)(k0 + i) * N + n];
    } else {
#pragma unroll
        for (int i = 0; i < 32; ++i) v[i] = 0.f;
    }
    u32x4* o = (u32x4*)(Wt + (size_t)n * K + k0);
#pragma unroll
    for (int c = 0; c < 4; ++c) { u32x4 w; w.x = pk2(v[8 * c], v[8 * c + 1]); w.y = pk2(v[8 * c + 2], v[8 * c + 3]); w.z = pk2(v[8 * c + 4], v[8 * c + 5]); w.w = pk2(v[8 * c + 6], v[8 * c + 7]); o[c] = w; }
}
__device__ __forceinline__ void phase0(const Params& P) {
    const int lane = threadIdx.x & 63, wave = threadIdx.x >> 6;
    const int gw = blockIdx.x * 8 + wave, NGW = gridDim.x * 8;
    unsigned char* ws = P.ws;
    constexpr int T_IN = 64 * 184, T_A = 64 * 32, T_B = 32 * 32, T_O = 64 * 32, T_Q = 64 * 32, T_POOL = 4 * 32, T_W2 = 3 * 32, T_A2 = 3 * 32, T_G2 = 8 * 32;
    constexpr int T_LN = MROWS, T_SK = 64;
    constexpr int NIT = T_IN + T_A + T_B + T_O + T_Q + T_POOL + T_W2 + T_A2 + T_G2 + T_LN + T_SK;
    for (int it = gw; it < NIT; it += NGW) {
        int r = it;
        if (r < T_IN) { transpose_item(P.in[I_WIN], 2048, INC, NPAD, (bf16_t*)(ws + WS_WTIN), r, lane); continue; } r -= T_IN;
        if (r < T_A) { transpose_item(P.in[I_WBA], 2048, 2048, 2048, (bf16_t*)(ws + WS_WTA), r, lane); continue; } r -= T_A;
        if (r < T_B) { transpose_item(P.in[I_WBB], 1024, 2048, 2048, (bf16_t*)(ws + WS_WTB), r, lane); continue; } r -= T_B;
        if (r < T_O) { transpose_item(P.in[I_WOUT], 2048, 2048, 2048, (bf16_t*)(ws + WS_WTOUT), r, lane); continue; } r -= T_O;
        if (r < T_Q) { transpose_item(P.in[I_WQ], 2048, 2048, 2048, (bf16_t*)(ws + WS_WTQ), r, lane); continue; } r -= T_Q;
        if (r < T_POOL) { const int g = r >> 5; transpose_item(P.in[I_WPOOL] + g * 65536, 256, 256, 256, (bf16_t*)(ws + WS_WTPOOL) + g * 65536, r & 31, lane); continue; } r -= T_POOL;
        if (r < T_W2) { transpose_item(P.in[I_WW2], 96, 2048, 2048, (bf16_t*)(ws + WS_WTW2), r, lane); continue; } r -= T_W2;
        if (r < T_A2) { transpose_item(P.in[I_WA2], 96, 2048, 2048, (bf16_t*)(ws + WS_WTA2), r, lane); continue; } r -= T_A2;
        if (r < T_G2) { transpose_item(P.in[I_WG2], 256, 2048, 2048, (bf16_t*)(ws + WS_WTG2), r, lane); continue; } r -= T_G2;
        if (r < T_LN) {
            bf16_t* dst = (bf16_t*)(ws + WS_H0B) + (size_t)r * D;
            if (r < NTOK) ln_row_bf16(P.in[I_X] + (size_t)r * D, P.in[I_LNIN_G], P.in[I_LNIN_B], dst, lane);
            else if (r < NTOK + 16) ln_row_bf16(P.in[I_META] + (size_t)(r - NTOK) * D, P.in[I_LNIN_G], P.in[I_LNIN_B], dst, lane);
            else {
#pragma unroll
                for (int j = 0; j < 8; ++j) ((u32x2*)dst)[lane + 64 * j] = (u32x2){0u, 0u};
            }
            continue;
        }
        r -= T_LN;
        {
            const float* s = P.in[I_SUBK] + r * 512 + lane * 8; float f[8];
#pragma unroll
            for (int i = 0; i < 8; ++i) f[i] = s[i];
            *(u32x4*)((bf16_t*)(ws + WS_SUBK) + r * 512 + lane * 8) = pack8(f);
        }
    }
}
namespace pg8 {
struct EpiGateA {
    static constexpr bool PERM = false, AFTER_DRAIN = false;
    float* C; const bf16_t* p; const float* bgate;
    __device__ __forceinline__ void operator()(const f32x4 (&acc)[2][2][4][2], const Unit& u, int wr, int wc, int fr, int fq) const {
        const int row0 = u.pm * BM + wr * 64 + fr, col0 = u.pn * BM + wc * 32 + 4 * fq;
#pragma unroll
        for (int ai = 0; ai < 2; ++ai)
#pragma unroll
            for (int m = 0; m < 4; ++m) { const size_t row = (size_t)(row0 + ai * HALF + m * 16);
#pragma unroll
                for (int bj = 0; bj < 2; ++bj)
#pragma unroll
                    for (int n = 0; n < 2; ++n) { const int col = col0 + bj * HALF + n * 16;
                        const u32x2 pw = *(const u32x2*)(p + row * NPAD + C_G0 + col); const f32x4 bg = *(const f32x4*)(bgate + col);
                        f32x4 g; g.x = sigmoidf_(bflo(pw.x) + bg.x); g.y = sigmoidf_(bfhi(pw.x) + bg.y); g.z = sigmoidf_(bflo(pw.y) + bg.z); g.w = sigmoidf_(bfhi(pw.y) + bg.w);
                        *(f32x4*)(C + row * D + col) = acc[ai][bj][m][n] * g; } }
    }
};
struct EpiGateB {
    static constexpr bool PERM = false, AFTER_DRAIN = false;
    const float* C; bf16_t* O; const bf16_t* p; const float* bgate;
    __device__ __forceinline__ void operator()(const f32x4 (&acc)[2][2][4][2], const Unit& u, int wr, int wc, int fr, int fq) const {
        const int row0 = u.pm * BM + wr * 64 + fr, col0 = u.pn * BM + wc * 32 + 4 * fq;
#pragma unroll
        for (int ai = 0; ai < 2; ++ai)
#pragma unroll
            for (int m = 0; m < 4; ++m) { const size_t row = (size_t)(row0 + ai * HALF + m * 16);
#pragma unroll
                for (int bj = 0; bj < 2; ++bj)
#pragma unroll
                    for (int n = 0; n < 2; ++n) { const int col = col0 + bj * HALF + n * 16;
                        const u32x2 pw = *(const u32x2*)(p + row * NPAD + C_G1 + col); const f32x4 bg = *(const f32x4*)(bgate + D + col);
                        f32x4 g; g.x = sigmoidf_(bflo(pw.x) + bg.x); g.y = sigmoidf_(bfhi(pw.x) + bg.y); g.z = sigmoidf_(bflo(pw.y) + bg.z); g.w = sigmoidf_(bfhi(pw.y) + bg.w);
                        const f32x4 o = *(const f32x4*)(C + row * D + col) + acc[ai][bj][m][n] * g;
                        u32x2 w; w.x = cvt_pk_bf16(o.x, o.y); w.y = cvt_pk_bf16(o.z, o.w);
                        *(u32x2*)(O + row * D + col) = w; } }
    }
};
struct EpiResid {
    static constexpr bool PERM = false, AFTER_DRAIN = false;
    float* C; const bf16_t* h0; float alpha;
    __device__ __forceinline__ void operator()(const f32x4 (&acc)[2][2][4][2], const Unit& u, int wr, int wc, int fr, int fq) const {
        const int row0 = u.pm * BM + wr * 64 + fr, col0 = u.pn * BM + wc * 32 + 4 * fq;
#pragma unroll
        for (int ai = 0; ai < 2; ++ai)
#pragma unroll
            for (int m = 0; m < 4; ++m) { const size_t row = (size_t)(row0 + ai * HALF + m * 16);
#pragma unroll
                for (int bj = 0; bj < 2; ++bj)
#pragma unroll
                    for (int n = 0; n < 2; ++n) { const int col = col0 + bj * HALF + n * 16;
                        const u32x2 hw = *(const u32x2*)(h0 + row * D + col);
                        f32x4 hv; hv.x = bflo(hw.x); hv.y = bfhi(hw.x); hv.z = bflo(hw.y); hv.w = bfhi(hw.y);
                        *(f32x4*)(C + row * D + col) = hv * alpha + acc[ai][bj][m][n]; } }
    }
};
}
template <class Epi>
__device__ __forceinline__ void run_gemm(ldsp lds, const bf16_t* A, const bf16_t* Bt, int M, int N, int K, const Epi& E) {
    pg8::Gemm g; g.A = A; g.Bt = Bt; g.M = M; g.N = N; g.K = K;
    pg8::StaticOrder S; S.init(M, N, (int)gridDim.x, (int)blockIdx.x);
    pg8::gemm_phase<Epi, pg8::StaticOrder, false>(lds, g, S, E, nullptr);
}
constexpr int LD64 = 72, MATB = 64 * LD64 * 2, LDK = 104;
constexpr int O_AB = 0, O_RB = 1 * MATB, O_BH = 2 * MATB, O_KH = 3 * MATB, O_ABT = 4 * MATB, O_BTT = 5 * MATB, O_KTT = 6 * MATB, O_VT = 7 * MATB;
constexpr int O_M0 = 8 * MATB, O_M0T = 9 * MATB, O_M1 = 10 * MATB, O_M1T = 11 * MATB, O_PA = 12 * MATB, O_PB = 13 * MATB, O_MAK = 14 * MATB, O_MRB = 15 * MATB, O_MRK = 16 * MATB;
constexpr int O_ELEND = 17 * MATB, O_WT = O_ELEND + 256;
constexpr int O_WL = 8 * MATB, O_AL = O_WL + 64 * LDK * 2, O_Z = O_AL + 64 * LDK * 2, O_AZ = O_Z + 64 * 68 * 4;
static_assert(O_AZ + 64 * 68 * 4 <= O_ELEND, "lds");
static_assert(O_WT + 2048 <= LDS_BYTES - 16, "lds");

__device__ __forceinline__ bf16x8 ldsfrag(ldsp lds, int off, int ld, int row, int kofs) { return *(const LAS bf16x8*)(lds + off + (row * ld + kofs) * 2); }
__device__ __forceinline__ void st4(ldsp lds, int off, int row, int col, const f32x4 v) {
    u32x2 w; w.x = pk2(v.x, v.y); w.y = pk2(v.z, v.w); *(LAS u32x2*)(lds + off + (row * LD64 + col) * 2) = w; }
__device__ __forceinline__ void st1(ldsp lds, int off, int row, int col, float v) { *(LAS bf16_t*)(lds + off + (row * LD64 + col) * 2) = f2bf1(v); }

__device__ __forceinline__ float fast_rcp(float x) { return __builtin_amdgcn_rcpf(x); }
__device__ __forceinline__ float fast_sigmoid(float x) { return fast_rcp(1.0f + __expf(-x)); }
__device__ __forceinline__ float fast_tanh(float x) { return 1.0f - 2.0f * fast_rcp(1.0f + __expf(2.0f * x)); }
__device__ __forceinline__ u32x4 ld8(const bf16_t* p) { return p ? *(const u32x4*)p : (u32x4){0u, 0u, 0u, 0u}; }
__device__ __forceinline__ void shift8r(const u32x4 cw, const u32x4 pw, const float* mu, float* x) {
    float c[8], q[8]; unpack8(cw, c); unpack8(pw, q);
    const f32x4 m0 = *(const f32x4*)mu, m1 = *(const f32x4*)(mu + 4);
    const float mm[8] = {m0.x, m0.y, m0.z, m0.w, m1.x, m1.y, m1.z, m1.w};
#pragma unroll
    for (int i = 0; i < 8; ++i) x[i] = c[i] + (q[i] - c[i]) * mm[i];
}
__device__ __forceinline__ int tcol(int row, int col) { return ((((col >> 3) ^ (row >> 3)) & 7) << 3) | (col & 7); }
__device__ __forceinline__ bf16x8 ldsfragT(ldsp lds, int off, int row, int kofs) { return *(const LAS bf16x8*)(lds + off + (row * LD64 + tcol(row, kofs)) * 2); }
__device__ __forceinline__ void st1T(ldsp lds, int off, int row, int col, float v) { *(LAS bf16_t*)(lds + off + (row * LD64 + tcol(row, col)) * 2) = f2bf1(v); }
__device__ __forceinline__ void shift8(const bf16_t* pcur, const bf16_t* pprev, const float* mu, float* x) {
    float c[8], q[8];
    if (pcur) unpack8(*(const u32x4*)pcur, c); else {
#pragma unroll
        for (int i = 0; i < 8; ++i) c[i] = 0.f; }
    if (pprev) unpack8(*(const u32x4*)pprev, q); else {
#pragma unroll
        for (int i = 0; i < 8; ++i) q[i] = 0.f; }
    const f32x4 m0 = *(const f32x4*)mu, m1 = *(const f32x4*)(mu + 4);
    const float mm[8] = {m0.x, m0.y, m0.z, m0.w, m1.x, m1.y, m1.z, m1.w};
#pragma unroll
    for (int i = 0; i < 8; ++i) x[i] = c[i] + (q[i] - c[i]) * mm[i];
}

template <bool DO_P, bool DO_SQ>
__device__ __forceinline__ void dbl_step(ldsp lds, int sN, int sT, int dN, int dT, int pC, int pN, int tm, int tn0, int fr, int fq) {
    bf16x8 a[2];
#pragma unroll
    for (int ks = 0; ks < 2; ++ks) a[ks] = ldsfrag(lds, sT, LD64, 16 * tm + fr, ks * 32 + fq * 8);
#pragma unroll
    for (int t2 = 0; t2 < 2; ++t2) {
        const int nt = tn0 + t2, t = 16 * nt + fr, s0 = 16 * tm + 4 * fq;
        if (DO_P) {
            f32x4 acc = {0.f, 0.f, 0.f, 0.f};
#pragma unroll
            for (int ks = 0; ks < 2; ++ks) acc = mfma16(a[ks], ldsfrag(lds, pC, LD64, t, ks * 32 + fq * 8), acc);
            const u32x2 pw = *(const LAS u32x2*)(lds + pC + (t * LD64 + s0) * 2);
            acc.x += bflo(pw.x); acc.y += bfhi(pw.x); acc.z += bflo(pw.y); acc.w += bfhi(pw.y);
            st4(lds, pN, t, s0, acc);
        }
        if (DO_SQ) {
            f32x4 acc = {0.f, 0.f, 0.f, 0.f};
#pragma unroll
            for (int ks = 0; ks < 2; ++ks) acc = mfma16(a[ks], ldsfrag(lds, sN, LD64, t, ks * 32 + fq * 8), acc);
            st4(lds, dN, t, s0, acc);
            st1(lds, dT, s0 + 0, t, acc.x); st1(lds, dT, s0 + 1, t, acc.y); st1(lds, dT, s0 + 2, t, acc.z); st1(lds, dT, s0 + 3, t, acc.w);
        }
    }
}


#ifdef DBG_STAGE
constexpr size_t DBG_STRIDE = (size_t)NUNITS * 512 * 4;
__device__ __forceinline__ void dbgsum(const Params& P, ldsp lds, int u, int stage, const int* offs, int nmat) {
    unsigned acc = 0;
    for (int m = 0; m < nmat; ++m)
        for (int k = 0; k < 4; ++k) { const int idx = threadIdx.x + 512 * k, row = idx >> 5, cp = idx & 31; const unsigned x = *(const LAS unsigned*)(lds + offs[m] + row * (LD64 * 2) + cp * 4); acc += (x & 0xffffu) + (x >> 16); }
    ((unsigned*)(P.ws + WS_S0T + (size_t)stage * DBG_STRIDE))[(size_t)u * 512 + threadIdx.x] = acc;
}
#define DBGSUM(stage, ...) do { const int offs_[] = {__VA_ARGS__}; dbgsum(P, lds, u, stage, offs_, (int)(sizeof(offs_) / sizeof(int))); } while (0)
#else
#define DBGSUM(stage, ...) do { } while (0)
#endif
__device__ __forceinline__ void rwkv_unit(const Params& P, ldsp lds, int u) {
    const int tid = threadIdx.x, lane = tid & 63, wave = tid >> 6, fr = lane & 15, fq = lane >> 4, tm = wave >> 1, tn0 = (wave & 1) * 2;
    unsigned char* ws = P.ws;
    const bf16_t* pp = (const bf16_t*)(ws + WS_P);
    const bool meta = u >= 4096;
    int b = 0, h, c = 0;
    if (meta) { h = u - 4096; } else { const int bh = u >> 6; c = u & 63; b = bh >> 5; h = bh & 31; }
    auto rowof = [&](int tl) -> int {
        if (meta) return (tl >= 48) ? (ROW_META + tl - 48) : -1;
        if (tl >= 0 || c > 0) return b * SEQ + c * 64 + tl;
        return ROW_META + 15;
    };
    auto rowp = [&](int tl, int col) -> const bf16_t* { const int r = rowof(tl); return r < 0 ? (const bf16_t*)nullptr : pp + (size_t)r * NPAD + col; };
    const float* mu = P.in[I_MU];
#ifndef RPT_AD
#define RPT_AD 1
#define RPT_E12 1
#define RPT_E35 1
#endif
    float lw[8], av[8], rv[8], kv[8], vv[8], kk[8], km[8];
    const int t = tid >> 3, jq = tid & 7, j0 = 8 * jq, hj = h * 64 + j0;
    const bool nulltok = meta && t < 48;
    for (int rpt_ = 0; rpt_ < RPT_AD; ++rpt_) {
    const u32x4 rc = ld8(rowp(t, C_R + hj)), rq = ld8(rowp(t - 1, C_R + hj)), kc = ld8(rowp(t, C_K + hj)), kq = ld8(rowp(t - 1, C_K + hj)), vc = ld8(rowp(t, C_V + hj)), vq = ld8(rowp(t - 1, C_V + hj));
    {
        u32x4 cw[3], pw[3];
#pragma unroll
        for (int it = 0; it < 3; ++it) { const int idx = tid + 512 * it, mat = idx / 768, rem = idx - mat * 768, tt = rem / 12, ch = rem - tt * 12, col = (mat ? C_AL : C_WL) + ch * 8;
            cw[it] = ld8(rowp(tt, col)); pw[it] = ld8(rowp(tt - 1, col)); }
#pragma unroll
        for (int it = 0; it < 3; ++it) { const int idx = tid + 512 * it, mat = idx / 768, rem = idx - mat * 768, tt = rem / 12, ch = rem - tt * 12, col = (mat ? C_AL : C_WL) + ch * 8;
            float x[8]; shift8r(cw[it], pw[it], mu + col, x);
            if (mat == 0) {
#pragma unroll
                for (int i = 0; i < 8; ++i) x[i] = fast_tanh(x[i]);
            }
            *(LAS u32x4*)(lds + (mat ? O_AL : O_WL) + (tt * LDK + ch * 8) * 2) = pack8(x); }
    }
    BLOCK_SYNC();
    {
        const bf16_t* ww2 = (const bf16_t*)(ws + WS_WTW2) + (size_t)(h * 64 + 16 * tm + fr) * 96 + fq * 8;
        const bf16_t* wa2 = (const bf16_t*)(ws + WS_WTA2) + (size_t)(h * 64 + 16 * tm + fr) * 96 + fq * 8;
        f32x4 z[2] = {{0.f, 0.f, 0.f, 0.f}, {0.f, 0.f, 0.f, 0.f}}, az[2] = {{0.f, 0.f, 0.f, 0.f}, {0.f, 0.f, 0.f, 0.f}};
#pragma unroll
        for (int ks = 0; ks < 3; ++ks) {
            const bf16x8 aw = *(const bf16x8*)(ww2 + ks * 32), aa = *(const bf16x8*)(wa2 + ks * 32);
#pragma unroll
            for (int t2 = 0; t2 < 2; ++t2) {
                const int t = 16 * (tn0 + t2) + fr;
                z[t2] = mfma16(aw, ldsfrag(lds, O_WL, LDK, t, ks * 32 + fq * 8), z[t2]);
                az[t2] = mfma16(aa, ldsfrag(lds, O_AL, LDK, t, ks * 32 + fq * 8), az[t2]);
            }
        }
#pragma unroll
        for (int t2 = 0; t2 < 2; ++t2) {
            const int t = 16 * (tn0 + t2) + fr, j0 = 16 * tm + 4 * fq;
            *(LAS f32x4*)(lds + O_Z + (t * 68 + j0) * 4) = z[t2];
            *(LAS f32x4*)(lds + O_AZ + (t * 68 + j0) * 4) = az[t2];
        }
    }
    BLOCK_SYNC();
    float cs[8];
    {
        const f32x4 z0 = *(const LAS f32x4*)(lds + O_Z + (t * 68 + j0) * 4), z1 = *(const LAS f32x4*)(lds + O_Z + (t * 68 + j0 + 4) * 4);
        const f32x4 y0 = *(const LAS f32x4*)(lds + O_AZ + (t * 68 + j0) * 4), y1 = *(const LAS f32x4*)(lds + O_AZ + (t * 68 + j0 + 4) * 4);
        const float zz[8] = {z0.x, z0.y, z0.z, z0.w, z1.x, z1.y, z1.z, z1.w}, yy[8] = {y0.x, y0.y, y0.z, y0.w, y1.x, y1.y, y1.z, y1.w};
        const f32x4 w0a = *(const f32x4*)(P.in[I_W0] + hj), w0b = *(const f32x4*)(P.in[I_W0] + hj + 4), a0a = *(const f32x4*)(P.in[I_A0] + hj), a0b = *(const f32x4*)(P.in[I_A0] + hj + 4);
        const float w0[8] = {w0a.x, w0a.y, w0a.z, w0a.w, w0b.x, w0b.y, w0b.z, w0b.w}, a0[8] = {a0a.x, a0a.y, a0a.z, a0a.w, a0b.x, a0b.y, a0b.z, a0b.w};
#pragma unroll
        for (int i = 0; i < 8; ++i) { lw[i] = nulltok ? 0.f : -DSCALE * fast_sigmoid(w0[i] + zz[i]); av[i] = fast_sigmoid(a0[i] + yy[i]); cs[i] = lw[i]; }
#pragma unroll
        for (int d = 8; d < 64; d <<= 1) {
#pragma unroll
            for (int i = 0; i < 8; ++i) { const float o = __shfl_up(cs[i], d); cs[i] += (lane >= d) ? o : 0.f; }
        }
        if (lane >= 56) { *(LAS f32x4*)(lds + O_WT + (wave * 64 + j0) * 4) = (f32x4){cs[0], cs[1], cs[2], cs[3]}; *(LAS f32x4*)(lds + O_WT + (wave * 64 + j0 + 4) * 4) = (f32x4){cs[4], cs[5], cs[6], cs[7]}; }
        shift8r(rc, rq, mu + C_R + hj, rv); shift8r(kc, kq, mu + C_K + hj, kv); shift8r(vc, vq, mu + C_V + hj, vv);
        if (nulltok) {
#pragma unroll
            for (int i = 0; i < 8; ++i) { rv[i] = 0.f; kv[i] = 0.f; vv[i] = 0.f; }
        }
        const f32x4 kka = *(const f32x4*)(P.in[I_KK] + hj), kkb = *(const f32x4*)(P.in[I_KK] + hj + 4), kaa = *(const f32x4*)(P.in[I_KA] + hj), kab = *(const f32x4*)(P.in[I_KA] + hj + 4);
        const f32x4 rka = *(const f32x4*)(P.in[I_RK] + hj), rkb = *(const f32x4*)(P.in[I_RK] + hj + 4);
        const float kkw[8] = {kka.x, kka.y, kka.z, kka.w, kkb.x, kkb.y, kkb.z, kkb.w}, kaw[8] = {kaa.x, kaa.y, kaa.z, kaa.w, kab.x, kab.y, kab.z, kab.w}, rkw[8] = {rka.x, rka.y, rka.z, rka.w, rkb.x, rkb.y, rkb.z, rkb.w};
        float n2 = 0.f, bon = 0.f;
#pragma unroll
        for (int i = 0; i < 8; ++i) { kk[i] = kv[i] * kkw[i]; n2 += kk[i] * kk[i]; km[i] = kv[i] * (1.0f + (av[i] - 1.0f) * kaw[i]); bon += rv[i] * km[i] * rkw[i]; }
        n2 += DPPF(n2, 0xB1); n2 += DPPF(n2, 0x4E); n2 += DPPF(n2, 0x141);
        bon += DPPF(bon, 0xB1); bon += DPPF(bon, 0x4E); bon += DPPF(bon, 0x141);
        const float inv = 1.0f / fmaxf(sqrtf(n2), 1e-12f);
#pragma unroll
        for (int i = 0; i < 8; ++i) kk[i] *= inv;
        if (!meta && jq == 0) ((float*)(ws + WS_BONUS))[(size_t)(b * SEQ + c * 64 + t) * 32 + h] = bon;
    }
    BLOCK_SYNC();
    {
        float Lc[8], Le[8];
#pragma unroll
        for (int i = 0; i < 8; ++i) { Lc[i] = cs[i]; Le[i] = 0.f; }
#pragma unroll
        for (int w = 0; w < 8; ++w) {
            const f32x4 x0 = *(const LAS f32x4*)(lds + O_WT + (w * 64 + j0) * 4), x1 = *(const LAS f32x4*)(lds + O_WT + (w * 64 + j0 + 4) * 4);
            const float xx[8] = {x0.x, x0.y, x0.z, x0.w, x1.x, x1.y, x1.z, x1.w};
            const float msk = w < wave ? 1.0f : 0.0f;
#pragma unroll
            for (int i = 0; i < 8; ++i) { Le[i] += xx[i]; Lc[i] += msk * xx[i]; }
        }
        float Ab[8], Rb[8], Bh[8], Kh[8], Bt[8], Kt[8];
#pragma unroll
        for (int i = 0; i < 8; ++i) {
            const float eP = __expf(Lc[i] - lw[i]), eC = __expf(Lc[i]), eN = __expf(-Lc[i]), eE = __expf(Le[i] - Lc[i]);
            const float ka = kk[i] * av[i];
            Ab[i] = -kk[i] * eP; Rb[i] = rv[i] * eC; Bh[i] = ka * eN; Kh[i] = km[i] * eN; Bt[i] = ka * eE; Kt[i] = km[i] * eE;
        }
        *(LAS u32x4*)(lds + O_AB + (t * LD64 + j0) * 2) = pack8(Ab);
        *(LAS u32x4*)(lds + O_RB + (t * LD64 + j0) * 2) = pack8(Rb);
        *(LAS u32x4*)(lds + O_BH + (t * LD64 + j0) * 2) = pack8(Bh);
        *(LAS u32x4*)(lds + O_KH + (t * LD64 + j0) * 2) = pack8(Kh);
#pragma unroll
        for (int i = 0; i < 8; ++i) { st1T(lds, O_ABT, j0 + i, t, Ab[i]); st1T(lds, O_BTT, j0 + i, t, Bt[i]); st1T(lds, O_KTT, j0 + i, t, Kt[i]); st1T(lds, O_VT, j0 + i, t, vv[i]); }
        if (t == 63) {
#pragma unroll
            for (int i = 0; i < 8; ++i) *(LAS float*)(lds + O_ELEND + (j0 + i) * 4) = __expf(Le[i]);
        }
    }
    BLOCK_SYNC();
    }
    DBGSUM(0, O_AB, O_RB, O_BH, O_KH, O_ABT, O_BTT, O_KTT, O_VT);
    for (int rpt_ = 0; rpt_ < RPT_E12; ++rpt_) {
    {
        bf16x8 abh[2], akh[2];
#pragma unroll
        for (int ks = 0; ks < 2; ++ks) { abh[ks] = ldsfrag(lds, O_BH, LD64, 16 * tm + fr, ks * 32 + fq * 8); akh[ks] = ldsfrag(lds, O_KH, LD64, 16 * tm + fr, ks * 32 + fq * 8); }
#pragma unroll
        for (int t2 = 0; t2 < 2; ++t2) {
            const int tt = 16 * (tn0 + t2) + fr, s0 = 16 * tm + 4 * fq;
            f32x4 mab = {0.f, 0.f, 0.f, 0.f}, mak = mab, mrb = mab, mrk = mab;
#pragma unroll
            for (int ks = 0; ks < 2; ++ks) {
                const bf16x8 bab = ldsfrag(lds, O_AB, LD64, tt, ks * 32 + fq * 8), brb = ldsfrag(lds, O_RB, LD64, tt, ks * 32 + fq * 8);
                mab = mfma16(abh[ks], bab, mab); mak = mfma16(akh[ks], bab, mak); mrb = mfma16(abh[ks], brb, mrb); mrk = mfma16(akh[ks], brb, mrk);
            }
            float vab[4] = {mab.x, mab.y, mab.z, mab.w}, vak[4] = {mak.x, mak.y, mak.z, mak.w}, vrb[4] = {mrb.x, mrb.y, mrb.z, mrb.w}, vrk[4] = {mrk.x, mrk.y, mrk.z, mrk.w}, vp[4];
#pragma unroll
            for (int r = 0; r < 4; ++r) { const int s = s0 + r; const bool st = s < tt, le = s <= tt;
                vab[r] = st ? vab[r] : 0.f; vak[r] = st ? vak[r] : 0.f; vrb[r] = le ? vrb[r] : 0.f; vrk[r] = le ? vrk[r] : 0.f; vp[r] = vab[r] + (s == tt ? 1.0f : 0.f); }
            st4(lds, O_M0, tt, s0, (f32x4){vab[0], vab[1], vab[2], vab[3]});
#pragma unroll
            for (int r = 0; r < 4; ++r) st1(lds, O_M0T, s0 + r, tt, vab[r]);
            st4(lds, O_PA, tt, s0, (f32x4){vp[0], vp[1], vp[2], vp[3]});
            st4(lds, O_MAK, tt, s0, (f32x4){vak[0], vak[1], vak[2], vak[3]});
            st4(lds, O_MRB, tt, s0, (f32x4){vrb[0], vrb[1], vrb[2], vrb[3]});
            st4(lds, O_MRK, tt, s0, (f32x4){vrk[0], vrk[1], vrk[2], vrk[3]});
        }
    }
    BLOCK_SYNC();
    DBGSUM(1, O_M0, O_M0T, O_PA, O_MAK, O_MRB, O_MRK);
    dbl_step<false, true>(lds, O_M0, O_M0T, O_M1, O_M1T, 0, 0, tm, tn0, fr, fq); BLOCK_SYNC();
    dbl_step<true, true>(lds, O_M1, O_M1T, O_M0, O_M0T, O_PA, O_PB, tm, tn0, fr, fq); BLOCK_SYNC();
    dbl_step<true, true>(lds, O_M0, O_M0T, O_M1, O_M1T, O_PB, O_PA, tm, tn0, fr, fq); BLOCK_SYNC();
    dbl_step<true, true>(lds, O_M1, O_M1T, O_M0, O_M0T, O_PA, O_PB, tm, tn0, fr, fq); BLOCK_SYNC();
    dbl_step<true, true>(lds, O_M0, O_M0T, O_M1, O_M1T, O_PB, O_PA, tm, tn0, fr, fq); BLOCK_SYNC();
    dbl_step<true, false>(lds, O_M1, O_M1T, 0, 0, O_PA, O_PB, tm, tn0, fr, fq); BLOCK_SYNC();
    }
    DBGSUM(2, O_PB);
    const size_t ub = (size_t)u * 4096;
    for (int rpt_ = 0; rpt_ < RPT_E35; ++rpt_) {
    {
        bf16x8 aT[2], aMak[2];
#pragma unroll
        for (int ks = 0; ks < 2; ++ks) { aT[ks] = ldsfrag(lds, O_PB, LD64, 16 * tm + fr, ks * 32 + fq * 8); aMak[ks] = ldsfrag(lds, O_MAK, LD64, 16 * tm + fr, ks * 32 + fq * 8); }
#pragma unroll
        for (int t2 = 0; t2 < 2; ++t2) {
            const int n = 16 * (tn0 + t2) + fr, t0 = 16 * tm + 4 * fq;
            f32x4 at = {0.f, 0.f, 0.f, 0.f}, xt = at;
#pragma unroll
            for (int ks = 0; ks < 2; ++ks) { at = mfma16(aT[ks], ldsfragT(lds, O_ABT, n, ks * 32 + fq * 8), at); xt = mfma16(aMak[ks], ldsfragT(lds, O_VT, n, ks * 32 + fq * 8), xt); }
            st4(lds, O_M0, n, t0, at); st4(lds, O_M0T, n, t0, xt);
        }
    }
    BLOCK_SYNC();
    DBGSUM(3, O_M0, O_M0T);
    {
        bf16x8 aT[2], aAt[2];
#pragma unroll
        for (int ks = 0; ks < 2; ++ks) { aT[ks] = ldsfrag(lds, O_PB, LD64, 16 * tm + fr, ks * 32 + fq * 8); aAt[ks] = ldsfrag(lds, O_M0, LD64, 16 * tm + fr, ks * 32 + fq * 8); }
        bf16_t* Rt = (bf16_t*)(ws + WS_RT) + ub; bf16_t* Gp = (bf16_t*)(ws + WS_G) + ub;
#pragma unroll
        for (int t2 = 0; t2 < 2; ++t2) {
            const int n = 16 * (tn0 + t2) + fr, m0 = 16 * tm + 4 * fq;
            f32x4 u0 = {0.f, 0.f, 0.f, 0.f}, rt = u0, g = u0;
#pragma unroll
            for (int ks = 0; ks < 2; ++ks) {
                u0 = mfma16(aT[ks], ldsfrag(lds, O_M0T, LD64, n, ks * 32 + fq * 8), u0);
                rt = mfma16(aAt[ks], ldsfrag(lds, O_MRB, LD64, n, ks * 32 + fq * 8), rt);
                g = mfma16(aAt[ks], ldsfragT(lds, O_BTT, n, ks * 32 + fq * 8), g);
            }
            st4(lds, O_M1, n, m0, u0);
            const u32x2 rw = *(const LAS u32x2*)(lds + O_RB + (n * LD64 + m0) * 2);
            rt.x += bflo(rw.x); rt.y += bfhi(rw.x); rt.z += bflo(rw.y); rt.w += bfhi(rw.y);
            { u32x2 w; w.x = pk2(rt.x, rt.y); w.y = pk2(rt.z, rt.w); *(u32x2*)(Rt + n * 64 + m0) = w; }
            if ((n >> 2) == (m0 >> 2)) { const float e = *(const LAS float*)(lds + O_ELEND + n * 4); const int r = n & 3;
                g.x += (r == 0) ? e : 0.f; g.y += (r == 1) ? e : 0.f; g.z += (r == 2) ? e : 0.f; g.w += (r == 3) ? e : 0.f; }
            { const int pos0 = 32 * (tm >> 1) + 8 * fq + 4 * (tm & 1); u32x2 w; w.x = pk2(g.x, g.y); w.y = pk2(g.z, g.w); *(u32x2*)(Gp + n * 64 + pos0) = w; }
        }
    }
    BLOCK_SYNC();
    DBGSUM(4, O_M1);
    {
        bf16x8 aB[2], aK[2], aU[2], aV[2];
#pragma unroll
        for (int ks = 0; ks < 2; ++ks) { const int row = 16 * tm + fr, ko = ks * 32 + fq * 8;
            aB[ks] = ldsfragT(lds, O_BTT, row, ko); aK[ks] = ldsfragT(lds, O_KTT, row, ko); aU[ks] = ldsfrag(lds, O_M1, LD64, row, ko); aV[ks] = ldsfragT(lds, O_VT, row, ko); }
        bf16_t* H0t = (bf16_t*)(ws + WS_H0T) + ub; bf16_t* Y0s = (bf16_t*)(ws + WS_Y0) + ub;
#pragma unroll
        for (int t2 = 0; t2 < 2; ++t2) {
            const int n = 16 * (tn0 + t2) + fr, m0 = 16 * tm + 4 * fq;
            f32x4 hh = {0.f, 0.f, 0.f, 0.f}, yy = hh;
#pragma unroll
            for (int ks = 0; ks < 2; ++ks) { const int ko = ks * 32 + fq * 8;
                const bf16x8 bU = ldsfrag(lds, O_M1, LD64, n, ko), bV = ldsfragT(lds, O_VT, n, ko), bRb = ldsfrag(lds, O_MRB, LD64, n, ko), bRk = ldsfrag(lds, O_MRK, LD64, n, ko);
                hh = mfma16(aB[ks], bU, hh); hh = mfma16(aK[ks], bV, hh);
                yy = mfma16(aU[ks], bRb, yy); yy = mfma16(aV[ks], bRk, yy); }
            { u32x2 w; w.x = pk2(hh.x, hh.y); w.y = pk2(hh.z, hh.w); *(u32x2*)(H0t + n * 64 + m0) = w; }
            { u32x2 w; w.x = pk2(yy.x, yy.y); w.y = pk2(yy.z, yy.w); *(u32x2*)(Y0s + n * 64 + m0) = w; }
        }
    }
    BLOCK_SYNC();
    }
}

constexpr int LDU = 264;
__device__ __forceinline__ void pool_unit(const Params& P, ldsp lds, int pu) {
    const int tid = threadIdx.x, lane = tid & 63, wave = tid >> 6, fr = lane & 15, fq = lane >> 4;
    unsigned char* ws = P.ws;
    const bf16_t* pp = (const bf16_t*)(ws + WS_P);
    const int g = pu & 3, tt = pu >> 2, b = tt >> 6, ti0 = (tt & 63) * 64;
    constexpr int O_U = 0, O_PL = 79 * LDU * 2;
    for (int idx = tid; idx < 79 * 32; idx += 512) {
        const int lr = idx >> 5, ch = idx & 31, ti = ti0 + lr - 15;
        const int row = ti >= 0 ? b * SEQ + ti : ROW_META + 16 + ti;
        *(LAS u32x4*)(lds + O_U + (lr * LDU + ch * 8) * 2) = *(const u32x4*)(pp + (size_t)row * NPAD + C_POOL + g * 256 + ch * 8);
    }
    BLOCK_SYNC();
    {
        const int t = tid >> 3, cq = tid & 7, win = 2 << g; const float inv = 1.0f / (float)win;
#pragma unroll
        for (int cc = 0; cc < 4; ++cc) {
            const int c0 = cq * 32 + cc * 8; float s[8], own[8];
            unpack8(*(const LAS u32x4*)(lds + O_U + ((15 + t) * LDU + c0) * 2), own);
#pragma unroll
            for (int i = 0; i < 8; ++i) s[i] = own[i];
            for (int d = 1; d < win; ++d) { float x[8]; unpack8(*(const LAS u32x4*)(lds + O_U + ((15 + t - d) * LDU + c0) * 2), x);
#pragma unroll
                for (int i = 0; i < 8; ++i) s[i] += x[i]; }
#pragma unroll
            for (int i = 0; i < 8; ++i) s[i] = s[i] * inv - own[i];
            *(LAS u32x4*)(lds + O_PL + (t * LDU + c0) * 2) = pack8(s);
        }
    }
    BLOCK_SYNC();
    {
        const bf16_t* wt = (const bf16_t*)(ws + WS_WTPOOL) + (size_t)g * 65536;
        f32x4 acc[2][4];
#pragma unroll
        for (int a = 0; a < 2; ++a)
#pragma unroll
            for (int n = 0; n < 4; ++n) acc[a][n] = (f32x4){0.f, 0.f, 0.f, 0.f};
#pragma unroll 4
        for (int ks = 0; ks < 8; ++ks) {
            bf16x8 af[2];
#pragma unroll
            for (int a = 0; a < 2; ++a) af[a] = *(const bf16x8*)(wt + (size_t)(32 * wave + 16 * a + fr) * 256 + ks * 32 + fq * 8);
#pragma unroll
            for (int n = 0; n < 4; ++n) { const bf16x8 bf = ldsfrag(lds, O_PL, LDU, 16 * n + fr, ks * 32 + fq * 8);
#pragma unroll
                for (int a = 0; a < 2; ++a) acc[a][n] = mfma16(af[a], bf, acc[a][n]); }
        }
        bf16_t* yb = (bf16_t*)(ws + WS_YB);
        const float* psc = P.in[I_PSCALE] + g * 256;
#pragma unroll
        for (int a = 0; a < 2; ++a) { const int d0 = 32 * wave + 16 * a + 4 * fq; const f32x4 sc = *(const f32x4*)(psc + d0);
#pragma unroll
            for (int n = 0; n < 4; ++n) { const int t = 16 * n + fr; const f32x4 o = acc[a][n] * sc;
                u32x2 w; w.x = pk2(o.x, o.y); w.y = pk2(o.z, o.w);
                *(u32x2*)(yb + (size_t)(b * SEQ + ti0 + t) * 1024 + g * 256 + d0) = w; } }
    }
    BLOCK_SYNC();
}
__device__ __forceinline__ void phase2(const Params& P, ldsp lds) {
    for (int u = blockIdx.x; u < NUNITS + 512; u += gridDim.x) {
        if (u < NUNITS) rwkv_unit(P, lds, u); else pool_unit(P, lds, u - NUNITS);
    }
}
__device__ __forceinline__ void phase3(const Params& P) {
    const int lane = threadIdx.x & 63, wave = threadIdx.x >> 6, fr = lane & 15, fq = lane >> 4;
    if (wave != 0) return;
    unsigned char* ws = P.ws;
    const bf16_t* Gp = (const bf16_t*)(ws + WS_G); const bf16_t* H0t = (const bf16_t*)(ws + WS_H0T); bf16_t* S0t = (bf16_t*)(ws + WS_S0T);
    for (int item = blockIdx.x; item < 256; item += gridDim.x) {
        const int bh = item >> 2, vq = item & 3, h = bh & 31;
        bf16x8 Sb[2];
#pragma unroll
        for (int ks = 0; ks < 2; ++ks)
#pragma unroll
            for (int i = 0; i < 8; ++i) Sb[ks][i] = 0;
        bf16x8 gA[4][2]; u32x2 hF[4];
        auto load = [&](int step, bf16x8 (&ga)[4][2], u32x2 (&hf)[4]) {
            const int u = (step == 0) ? (4096 + h) : (bh * 64 + step - 1);
            const bf16_t* g = Gp + (size_t)u * 4096; const bf16_t* hh = H0t + (size_t)u * 4096;
#pragma unroll
            for (int mt = 0; mt < 4; ++mt) {
#pragma unroll
                for (int ks = 0; ks < 2; ++ks) ga[mt][ks] = *(const bf16x8*)(g + (16 * mt + fr) * 64 + ks * 32 + fq * 8);
                hf[mt] = *(const u32x2*)(hh + (16 * vq + fr) * 64 + 16 * mt + 4 * fq);
            }
        };
        load(0, gA, hF);
        for (int step = 0; step < 64; ++step) {
            bf16x8 gN[4][2]; u32x2 hN[4];
            if (step + 1 < 64) load(step + 1, gN, hN);
            f32x4 acc[4];
#pragma unroll
            for (int mt = 0; mt < 4; ++mt) {
                acc[mt] = (f32x4){bflo(hF[mt].x), bfhi(hF[mt].x), bflo(hF[mt].y), bfhi(hF[mt].y)};
                acc[mt] = mfma16(gA[mt][0], Sb[0], acc[mt]);
                acc[mt] = mfma16(gA[mt][1], Sb[1], acc[mt]);
            }
            bf16_t* so = S0t + (size_t)(bh * 64 + step) * 4096 + (16 * vq + fr) * 64 + 4 * fq;
            u32x2 w[4];
#pragma unroll
            for (int mt = 0; mt < 4; ++mt) { w[mt].x = pk2(acc[mt].x, acc[mt].y); w[mt].y = pk2(acc[mt].z, acc[mt].w); *(u32x2*)(so + 16 * mt) = w[mt]; }
#pragma unroll
            for (int ks = 0; ks < 2; ++ks) {
                const u32x4 q = (u32x4){w[2 * ks].x, w[2 * ks].y, w[2 * ks + 1].x, w[2 * ks + 1].y};
                Sb[ks] = __builtin_bit_cast(bf16x8, q);
            }
            if (step + 1 < 64) {
#pragma unroll
                for (int mt = 0; mt < 4; ++mt) { gA[mt][0] = gN[mt][0]; gA[mt][1] = gN[mt][1]; hF[mt] = hN[mt]; }
            }
        }
    }
}

constexpr int LDG = 264;
__device__ __forceinline__ void phase3b(const Params& P, ldsp lds) {
    const int tid = threadIdx.x, lane = tid & 63, wave = tid >> 6, fr = lane & 15, fq = lane >> 4, wq = wave & 3;
    unsigned char* ws = P.ws;
    const bf16_t* pp = (const bf16_t*)(ws + WS_P);
    const float* mu = P.in[I_MU];
    ldsp gl = lds + wave * (16 * LDG * 2);
    for (int pair = blockIdx.x; pair < 2048; pair += gridDim.x) {
        const int u = pair * 2 + (wave >> 2), bh = u >> 6, c = u & 63, b = bh >> 5, h = bh & 31;
        const int trow0 = b * SEQ + c * 64 + 16 * wq;
#pragma unroll
        for (int it = 0; it < 8; ++it) {
            const int idx = it * 64 + lane, tl = idx >> 5, ch = idx & 31, col = C_GL + ch * 8;
            const int row = trow0 + tl; const int prow = (c == 0 && wq == 0 && tl == 0) ? (ROW_META + 15) : row - 1;
            float x[8]; shift8(pp + (size_t)row * NPAD + col, pp + (size_t)prow * NPAD + col, mu + col, x);
#pragma unroll
            for (int i = 0; i < 8; ++i) x[i] = sigmoidf_(x[i]);
            *(LAS u32x4*)(gl + (tl * LDG + ch * 8) * 2) = pack8(x);
        }
        BLOCK_SYNC();
        f32x4 gacc[4];
#pragma unroll
        for (int mt = 0; mt < 4; ++mt) gacc[mt] = (f32x4){0.f, 0.f, 0.f, 0.f};
        {
            const bf16_t* wg = (const bf16_t*)(ws + WS_WTG2) + (size_t)(h * 64 + fr) * 256 + fq * 8;
#pragma unroll 2
            for (int ks = 0; ks < 8; ++ks) {
                const bf16x8 bf = *(const LAS bf16x8*)(gl + (fr * LDG + ks * 32 + fq * 8) * 2);
#pragma unroll
                for (int mt = 0; mt < 4; ++mt) gacc[mt] = mfma16(*(const bf16x8*)(wg + (size_t)(16 * mt) * 256 + ks * 32), bf, gacc[mt]);
            }
        }
        f32x4 y[4];
        {
            const size_t ub = (size_t)u * 4096;
            const bf16_t* S0t = (const bf16_t*)(ws + WS_S0T) + ub; const bf16_t* Rt = (const bf16_t*)(ws + WS_RT) + ub; const bf16_t* Y0s = (const bf16_t*)(ws + WS_Y0) + ub;
            bf16x8 bR[2];
#pragma unroll
            for (int ks = 0; ks < 2; ++ks) bR[ks] = *(const bf16x8*)(Rt + (16 * wq + fr) * 64 + ks * 32 + fq * 8);
#pragma unroll
            for (int mt = 0; mt < 4; ++mt) {
                const u32x2 yw = *(const u32x2*)(Y0s + (16 * wq + fr) * 64 + 16 * mt + 4 * fq);
                y[mt] = (f32x4){bflo(yw.x), bfhi(yw.x), bflo(yw.y), bfhi(yw.y)};
#pragma unroll
                for (int ks = 0; ks < 2; ++ks) y[mt] = mfma16(*(const bf16x8*)(S0t + (16 * mt + fr) * 64 + ks * 32 + fq * 8), bR[ks], y[mt]);
            }
        }
        float s = 0.f;
#pragma unroll
        for (int mt = 0; mt < 4; ++mt) s += (y[mt].x + y[mt].y) + (y[mt].z + y[mt].w);
        s += __shfl_xor(s, 16); s += __shfl_xor(s, 32);
        const float mean = s * (1.0f / 64.0f); float q = 0.f;
#pragma unroll
        for (int mt = 0; mt < 4; ++mt) { y[mt] = y[mt] - mean; q += (y[mt].x * y[mt].x + y[mt].y * y[mt].y) + (y[mt].z * y[mt].z + y[mt].w * y[mt].w); }
        q += __shfl_xor(q, 16); q += __shfl_xor(q, 32);
        const float rstd = 1.0f / sqrtf(q * (1.0f / 64.0f) + GN_EPS);
        const int row = trow0 + fr; const int prow = (c == 0 && wq == 0 && fr == 0) ? (ROW_META + 15) : row - 1;
        const float bon = ((const float*)(ws + WS_BONUS))[(size_t)row * 32 + h];
        bf16_t* ya = (bf16_t*)(ws + WS_YA) + (size_t)row * D + h * 64;
#pragma unroll
        for (int mt = 0; mt < 4; ++mt) {
            const int i0 = 16 * mt + 4 * fq, hc = h * 64 + i0;
            const f32x4 gg = *(const f32x4*)(P.in[I_GNG] + hc), gb = *(const f32x4*)(P.in[I_GNB] + hc), mv = *(const f32x4*)(mu + C_V + hc);
            const u32x2 vc = *(const u32x2*)(pp + (size_t)row * NPAD + C_V + hc), vp = *(const u32x2*)(pp + (size_t)prow * NPAD + C_V + hc);
            f32x4 cv = (f32x4){bflo(vc.x), bfhi(vc.x), bflo(vc.y), bfhi(vc.y)}, pv = (f32x4){bflo(vp.x), bfhi(vp.x), bflo(vp.y), bfhi(vp.y)};
            const f32x4 v = cv + (pv - cv) * mv;
            const f32x4 o = (y[mt] * rstd * gg + gb + v * bon) * gacc[mt];
            u32x2 w; w.x = pk2(o.x, o.y); w.y = pk2(o.z, o.w);
            *(u32x2*)(ya + i0) = w;
        }
        BLOCK_SYNC();
    }
}
__device__ __forceinline__ void phase5b(const Params& P) {
    const int lane = threadIdx.x & 63, wave = threadIdx.x >> 6;
    const int gw = blockIdx.x * 8 + wave, NGW = gridDim.x * 8;
    unsigned char* ws = P.ws;
    for (int r = gw; r < NTOK; r += NGW)
        ln_row_bf16((const float*)(ws + WS_X1) + (size_t)r * D, P.in[I_LN1G], P.in[I_LN1B], (bf16_t*)(ws + WS_H1B) + (size_t)r * D, lane);
    for (int r = gw; r < 32768; r += NGW) {
        const float* src = (r < 16384 ? P.in[I_UT] : P.in[I_VT]) + (size_t)(r & 16383) * D;
        int* dst = (int*)(ws + (r < 16384 ? WS_UB : WS_VB) + (size_t)(r & 16383) * D);
        f32x4 v[8]; float am = 0.f;
#pragma unroll
        for (int j = 0; j < 8; ++j) { v[j] = ((const f32x4*)src)[lane + 64 * j]; am = fmaxf(am, fmaxf(fmaxf(fabsf(v[j].x), fabsf(v[j].y)), fmaxf(fabsf(v[j].z), fabsf(v[j].w)))); }
        am = wave_max_dpp(am);
        const float s = am > 0.f ? 256.0f / am : 1.0f;
#pragma unroll
        for (int j = 0; j < 8; ++j) { int w = 0; w = __builtin_amdgcn_cvt_pk_fp8_f32(v[j].x * s, v[j].y * s, w, false); w = __builtin_amdgcn_cvt_pk_fp8_f32(v[j].z * s, v[j].w * s, w, true); dst[lane + 64 * j] = w; }
        if (lane == 0) ((float*)(ws + WS_TSC))[r] = am > 0.f ? am * (1.0f / 256.0f) : 1.0f;
    }
}

#define CE_DESC(a, b) do { const float h_ = fmaxf((a), (b)), l_ = fminf((a), (b)); (a) = h_; (b) = l_; } while (0)
template <int N> __device__ __forceinline__ void bitonic_sort_desc(float (&v)[N]) {
#pragma unroll
    for (int k = 2; k <= N; k <<= 1)
#pragma unroll
        for (int j = k >> 1; j > 0; j >>= 1)
#pragma unroll
            for (int i = 0; i < N; ++i) { const int l = i ^ j; if (l > i) { if ((i & k) == 0) CE_DESC(v[i], v[l]); else CE_DESC(v[l], v[i]); } }
}
template <int N> __device__ __forceinline__ void bitonic_merge_desc(float (&v)[N]) {
#pragma unroll
    for (int j = N >> 1; j > 0; j >>= 1)
#pragma unroll
        for (int i = 0; i < N; ++i) { const int l = i ^ j; if (l > i) CE_DESC(v[i], v[l]); }
}
__device__ __forceinline__ void top16_merge(float (&a)[16], const float (&brev)[16]) {
#pragma unroll
    for (int i = 0; i < 16; ++i) a[i] = fmaxf(a[i], brev[i]);
    bitonic_merge_desc<16>(a);
}
__device__ __forceinline__ float embed_bits(float v, unsigned code, unsigned mask) { return __uint_as_float((__float_as_uint(v) & ~mask) | code); }

__device__ __forceinline__ void phase7(const Params& P, ldsp lds) {
    const int tid = threadIdx.x, lane = tid & 63, wave = tid >> 6, fr = lane & 15, fq = lane >> 4;
    unsigned char* ws = P.ws;
    const bf16_t* qb = (const bf16_t*)(ws + WS_Q); const bf16_t* sk = (const bf16_t*)(ws + WS_SUBK);
    int* eout = (int*)(ws + WS_EXP); float* gout = (float*)(ws + WS_GATE);
    constexpr int LDSK = 136, O_SK = 0, O_SV = 2 * 128 * LDSK * 2;
    for (int idx = tid; idx < 2 * 128 * 16; idx += 512) { const int row = idx >> 4, ch = idx & 15;
        *(LAS u32x4*)(lds + O_SK + (row * LDSK + ch * 8) * 2) = *(const u32x4*)(sk + row * 128 + ch * 8); }
    BLOCK_SYNC();
    for (int tile = blockIdx.x; tile < 256; tile += gridDim.x) {
        const int tok0 = tile * 32, h = wave;
#pragma unroll 1
        for (int cb = 0; cb < 4; ++cb) {
            const int nt = cb >> 1, p = cb & 1;
            f32x4 acc[8];
#pragma unroll
            for (int mt = 0; mt < 8; ++mt) acc[mt] = (f32x4){0.f, 0.f, 0.f, 0.f};
            const bf16_t* qrow = qb + (size_t)(tok0 + 16 * nt + fr) * D + h * 256 + p * 128 + fq * 8;
#pragma unroll
            for (int ks = 0; ks < 4; ++ks) {
                const bf16x8 bq = *(const bf16x8*)(qrow + ks * 32);
#pragma unroll
                for (int mt = 0; mt < 8; ++mt) acc[mt] = mfma16(*(const LAS bf16x8*)(lds + O_SK + ((p * 128 + 16 * mt + fr) * LDSK + ks * 32 + fq * 8) * 2), bq, acc[mt]);
            }
            float a[16], b[16];
#pragma unroll
            for (int mt = 0; mt < 4; ++mt) {
                a[4 * mt + 0] = embed_bits(acc[mt].x, 16 * mt + 4 * fq + 0, 127u); a[4 * mt + 1] = embed_bits(acc[mt].y, 16 * mt + 4 * fq + 1, 127u);
                a[4 * mt + 2] = embed_bits(acc[mt].z, 16 * mt + 4 * fq + 2, 127u); a[4 * mt + 3] = embed_bits(acc[mt].w, 16 * mt + 4 * fq + 3, 127u);
                b[4 * mt + 0] = embed_bits(acc[mt + 4].x, 16 * (mt + 4) + 4 * fq + 0, 127u); b[4 * mt + 1] = embed_bits(acc[mt + 4].y, 16 * (mt + 4) + 4 * fq + 1, 127u);
                b[4 * mt + 2] = embed_bits(acc[mt + 4].z, 16 * (mt + 4) + 4 * fq + 2, 127u); b[4 * mt + 3] = embed_bits(acc[mt + 4].w, 16 * (mt + 4) + 4 * fq + 3, 127u);
            }
            bitonic_sort_desc<16>(a); bitonic_sort_desc<16>(b);
            { float br[16];
#pragma unroll
              for (int i = 0; i < 16; ++i) br[i] = b[15 - i];
              top16_merge(a, br); }
#pragma unroll
            for (int x = 16; x <= 32; x <<= 1) { float br[16];
#pragma unroll
                for (int i = 0; i < 16; ++i) br[i] = __shfl_xor(a[15 - i], x);
                top16_merge(a, br); }
            if (fq == 0) { LAS f32x4* o = (LAS f32x4*)(lds + O_SV + ((((16 * nt + fr) * 8 + h) * 2 + p) * 16) * 4);
                o[0] = (f32x4){a[0], a[1], a[2], a[3]}; o[1] = (f32x4){a[4], a[5], a[6], a[7]}; o[2] = (f32x4){a[8], a[9], a[10], a[11]}; o[3] = (f32x4){a[12], a[13], a[14], a[15]}; }
        }
        BLOCK_SYNC();
        if (tid < 256) {
            const int tok = tid >> 3, hh = tid & 7;
            const LAS f32x4* s = (const LAS f32x4*)(lds + O_SV + (((tok * 8 + hh) * 2) * 16) * 4);
            float s0[16], s1[16];
#pragma unroll
            for (int c4 = 0; c4 < 4; ++c4) { const f32x4 x = s[c4], y = s[4 + c4]; s0[4 * c4] = x.x; s0[4 * c4 + 1] = x.y; s0[4 * c4 + 2] = x.z; s0[4 * c4 + 3] = x.w; s1[4 * c4] = y.x; s1[4 * c4 + 1] = y.y; s1[4 * c4 + 2] = y.z; s1[4 * c4 + 3] = y.w; }
            float g0[16], g1[16], g2[16], g3[16];
            const float NEG = -3.0e38f;
#pragma unroll
            for (int bq = 0; bq < 16; ++bq) g0[bq] = embed_bits(s0[0] + s1[bq], bq, 255u);
            {
                int n1 = 0, n2 = 0, n3 = 0;
#pragma unroll
                for (int aa = 1; aa < 16; ++aa)
#pragma unroll
                    for (int bb = 0; bb < 16; ++bb) if ((aa + 1) * (bb + 1) <= 16) {
                        const float c = embed_bits(s0[aa] + s1[bb], aa * 16 + bb, 255u);
                        if (n1 < 16) g1[n1++] = c; else if (n2 < 16) g2[n2++] = c; else g3[n3++] = c;
                    }
#pragma unroll
                for (int i = 0; i < 16; ++i) if (i >= n3) g3[i] = NEG;
            }
            bitonic_sort_desc<16>(g1); bitonic_sort_desc<16>(g2); bitonic_sort_desc<16>(g3);
            { float r1[16], r3[16];
#pragma unroll
              for (int i = 0; i < 16; ++i) { r1[i] = g1[15 - i]; r3[i] = g3[15 - i]; }
              top16_merge(g0, r1); top16_merge(g2, r3);
#pragma unroll
              for (int i = 0; i < 16; ++i) g0[i] = fmaxf(g0[i], g2[15 - i]); }
            float mx = g0[0];
#pragma unroll
            for (int i = 1; i < 16; ++i) mx = fmaxf(mx, g0[i]);
            float ex[16], sm = 0.f; int ee[16];
#pragma unroll
            for (int i = 0; i < 16; ++i) {
                ex[i] = __expf(g0[i] - mx); sm += ex[i];
                const unsigned code = __float_as_uint(g0[i]) & 255u;
                const unsigned i0 = __float_as_uint(*(const LAS float*)(lds + O_SV + ((((tok * 8 + hh) * 2 + 0) * 16) + (code >> 4)) * 4)) & 127u;
                const unsigned i1 = __float_as_uint(*(const LAS float*)(lds + O_SV + ((((tok * 8 + hh) * 2 + 1) * 16) + (code & 15u)) * 4)) & 127u;
                ee[i] = (int)(i0 * 128u + i1);
            }
            const float inv = 1.0f / sm;
            int* eo = eout + (size_t)(tok0 + tok) * 128 + hh * 16; float* go = gout + (size_t)(tok0 + tok) * 128 + hh * 16;
#pragma unroll
            for (int c4 = 0; c4 < 4; ++c4) {
                *(u32x4*)(eo + 4 * c4) = (u32x4){(unsigned)ee[4 * c4], (unsigned)ee[4 * c4 + 1], (unsigned)ee[4 * c4 + 2], (unsigned)ee[4 * c4 + 3]};
                *(f32x4*)(go + 4 * c4) = (f32x4){ex[4 * c4] * inv, ex[4 * c4 + 1] * inv, ex[4 * c4 + 2] * inv, ex[4 * c4 + 3] * inv};
            }
        }
        BLOCK_SYNC();
    }
}
__device__ __forceinline__ float gelu_exact(float x) { return 0.5f * x * (1.0f + erff(x * 0.70710678118654752f)); }
__device__ __forceinline__ float dot16_fp8(const u32x4 w, const float* x) {
    float s0 = 0.f, s1 = 0.f;
    const int ww[4] = {(int)w.x, (int)w.y, (int)w.z, (int)w.w};
#pragma unroll
    for (int q = 0; q < 4; ++q) { const f32x2 lo = __builtin_amdgcn_cvt_pk_f32_fp8(ww[q], false), hi = __builtin_amdgcn_cvt_pk_f32_fp8(ww[q], true);
        s0 += lo.x * x[4 * q] + hi.x * x[4 * q + 2]; s1 += lo.y * x[4 * q + 1] + hi.y * x[4 * q + 3]; }
    return s0 + s1;
}
__device__ __forceinline__ void axpy16_fp8(const u32x4 w, float a, float* o) {
    const int ww[4] = {(int)w.x, (int)w.y, (int)w.z, (int)w.w};
#pragma unroll
    for (int q = 0; q < 4; ++q) { const f32x2 lo = __builtin_amdgcn_cvt_pk_f32_fp8(ww[q], false), hi = __builtin_amdgcn_cvt_pk_f32_fp8(ww[q], true);
        o[4 * q] += a * lo.x; o[4 * q + 1] += a * lo.y; o[4 * q + 2] += a * hi.x; o[4 * q + 3] += a * hi.y; }
}
__device__ __forceinline__ void phase8(const Params& P) {
    const int lane = threadIdx.x & 63, wave = threadIdx.x >> 6;
    const int gw = blockIdx.x * 8 + wave, NGW = gridDim.x * 8;
    unsigned char* ws = P.ws;
    const unsigned char* Ub = ws + WS_UB; const unsigned char* Vb = ws + WS_VB;
    const int* eidx = (const int*)(ws + WS_EXP); const float* gts = (const float*)(ws + WS_GATE); const float* tsc = (const float*)(ws + WS_TSC);
    for (int tok = gw; tok < NTOK; tok += NGW) {
        int lo16 = lane * 16; asm volatile("" : "+v"(lo16));
        float x[32], o[32];
        {
            const bf16_t* hr = (const bf16_t*)(ws + WS_H1B) + (size_t)tok * D + lo16;
#pragma unroll
            for (int i = 0; i < 2; ++i) { unpack8(*(const u32x4*)(hr + 1024 * i), x + 16 * i); unpack8(*(const u32x4*)(hr + 1024 * i + 8), x + 16 * i + 8); }
#pragma unroll
            for (int i = 0; i < 32; ++i) o[i] = 0.f;
        }
        const int e_lo = eidx[(size_t)tok * 128 + lane], e_hi = eidx[(size_t)tok * 128 + 64 + lane];
        const float su_lo = tsc[e_lo], su_hi = tsc[e_hi];
        const float gv_lo = gts[(size_t)tok * 128 + lane] * tsc[16384 + e_lo], gv_hi = gts[(size_t)tok * 128 + 64 + lane] * tsc[16384 + e_hi];
        u32x4 ua[2][2], va[2][2], ub[2][2], vb[2][2];
        auto issue = [&](int g, u32x4 (&uu)[2][2], u32x4 (&vv)[2][2]) {
            const int ev = (g < 32) ? e_lo : e_hi;
#pragma unroll
            for (int j = 0; j < 2; ++j) {
                const int e = __builtin_amdgcn_readlane(ev, (2 * g + j) & 63);
                const unsigned char* up = Ub + (size_t)e * D + lo16; const unsigned char* vp = Vb + (size_t)e * D + lo16;
#pragma unroll
                for (int i = 0; i < 2; ++i) { uu[j][i] = *(const u32x4*)(up + 1024 * i); vv[j][i] = *(const u32x4*)(vp + 1024 * i); }
            }
        };
        auto consume = [&](int g, const u32x4 (&uu)[2][2], const u32x4 (&vv)[2][2]) {
            const float suv = (g < 32) ? su_lo : su_hi, gvv = (g < 32) ? gv_lo : gv_hi;
            float dd[2];
#pragma unroll
            for (int j = 0; j < 2; ++j) dd[j] = dot16_fp8(uu[j][0], x) + dot16_fp8(uu[j][1], x + 16);
#pragma unroll
            for (int j = 0; j < 2; ++j) dd[j] = wave_sum_dpp(dd[j]);
            const int l0 = (2 * g) & 63;
            const pg8::f32x2 ge = pg8::gelu_pk((pg8::f32x2){dd[0] * readlane_f(suv, l0), dd[1] * readlane_f(suv, l0 + 1)});
            const float a0 = ge.x * readlane_f(gvv, l0), a1 = ge.y * readlane_f(gvv, l0 + 1);
            axpy16_fp8(vv[0][0], a0, o); axpy16_fp8(vv[0][1], a0, o + 16);
            axpy16_fp8(vv[1][0], a1, o); axpy16_fp8(vv[1][1], a1, o + 16);
        };
        issue(0, ua, va);
        for (int g = 0; g < 64; g += 2) {
            issue(g + 1, ub, vb);
            consume(g, ua, va);
            if (g + 2 < 64) issue(g + 2, ua, va);
            consume(g + 1, ub, vb);
        }
        float s = 0.f;
#pragma unroll
        for (int i = 0; i < 32; ++i) { o[i] += DN_ALPHA * x[i]; s += o[i]; }
        const float mean = wave_sum_dpp(s) * (1.0f / D); float q = 0.f;
#pragma unroll
        for (int i = 0; i < 32; ++i) { o[i] -= mean; q += o[i] * o[i]; }
        const float rstd = 1.0f / sqrtf(wave_sum_dpp(q) * (1.0f / D) + LN_EPS);
        float* orow = P.out + (size_t)tok * D + lo16;
#pragma unroll
        for (int i = 0; i < 2; ++i)
#pragma unroll
            for (int c = 0; c < 4; ++c) {
                const int off = 1024 * i + lo16 + 4 * c;
                const f32x4 g0 = *(const f32x4*)(P.in[I_LN2G] + off), b0 = *(const f32x4*)(P.in[I_LN2B] + off);
                f32x4 r0;
                r0.x = o[16 * i + 4 * c + 0] * rstd * g0.x + b0.x; r0.y = o[16 * i + 4 * c + 1] * rstd * g0.y + b0.y; r0.z = o[16 * i + 4 * c + 2] * rstd * g0.z + b0.z; r0.w = o[16 * i + 4 * c + 3] * rstd * g0.w + b0.w;
                *(f32x4*)(orow + 1024 * i + 4 * c) = r0;
            }
    }
}
#ifndef MK_MULTI
#define MK_MULTI 0
#endif
__global__ __launch_bounds__(512, 2) void hybrid_fwd(Params P) {
    extern __shared__ __attribute__((aligned(16))) unsigned char shm[];
    ldsp lds = (ldsp)shm;
    cg::grid_group grid = cg::this_grid();
    unsigned char* ws = P.ws;
    volatile LAS unsigned* xst = (volatile LAS unsigned*)(lds + LDS_BYTES - 16);
    if (threadIdx.x == 0) { xst[0] = 0u; xst[1] = 0u; }
    __syncthreads();
    const XcdBarrier xbar = xcd_barrier_post((unsigned*)(ws + WS_BAR), xst);
    const int lo = P.ph_lo, hi = P.ph_hi;
#ifdef DBG_TA
    unsigned long long ts0 = 0, ts1 = 0, ts2 = 0, ts3 = 0, ts4 = 0, ts5 = 0, ts6 = 0, ts7 = 0, ts8 = 0, ts9 = 0, ts10 = 0, ts11 = 0;
#define STAMP(k) ts##k = __builtin_amdgcn_s_memrealtime()
#else
#define STAMP(k) do { } while (0)
#endif
    STAMP(0);
#ifndef REPEAT_PHASE
#define REPEAT_PHASE -1
#define REPEAT_N 1
#endif
#define PHASE(k) if (lo <= (k) && (k) < hi) for (int rep_ = 0; rep_ < ((k) == REPEAT_PHASE ? REPEAT_N : 1); ++rep_)
#define SEAM(k) do { if (lo <= (k) && (k) + 1 < hi) { if ((k) == 0) { asm volatile("s_waitcnt vmcnt(0) lgkmcnt(0)" ::: "memory"); __syncthreads(); grid.sync(); } xcd_barrier(xbar); } } while (0)
    PHASE(0) phase0(P);
    SEAM(0); STAMP(1);
    PHASE(1) { pg8::EpiBf16<0> E; E.O = (bf16_t*)(ws + WS_P); E.ldc = NPAD; E.bias = nullptr; E.split_cols = 0; E.split_stride = 0;
        run_gemm(lds, (const bf16_t*)(ws + WS_H0B), (const bf16_t*)(ws + WS_WTIN), MROWS, NPAD, 2048, E); }
    SEAM(1); STAMP(2);
    PHASE(2) phase2(P, lds);
    SEAM(2); STAMP(3);
    PHASE(3) phase3(P);
    SEAM(3); STAMP(4);
    PHASE(4) phase3b(P, lds);
    SEAM(4); STAMP(5);
    PHASE(5) {
        { pg8::EpiGateA E; E.C = (float*)(ws + WS_MPART); E.p = (const bf16_t*)(ws + WS_P); E.bgate = P.in[I_BGATE];
          run_gemm(lds, (const bf16_t*)(ws + WS_YA), (const bf16_t*)(ws + WS_WTA), NTOK, 2048, 2048, E); }
        { pg8::EpiGateB E; E.C = (const float*)(ws + WS_MPART); E.O = (bf16_t*)(ws + WS_MERGED); E.p = (const bf16_t*)(ws + WS_P); E.bgate = P.in[I_BGATE];
          run_gemm(lds, (const bf16_t*)(ws + WS_YB), (const bf16_t*)(ws + WS_WTB), NTOK, 2048, 1024, E); }
    }
    SEAM(5); STAMP(6);
    PHASE(6) { pg8::EpiResid E; E.C = (float*)(ws + WS_X1); E.h0 = (const bf16_t*)(ws + WS_H0B); E.alpha = DN_ALPHA;
        run_gemm(lds, (const bf16_t*)(ws + WS_MERGED), (const bf16_t*)(ws + WS_WTOUT), NTOK, 2048, 2048, E); }
    SEAM(6); STAMP(7);
    PHASE(7) phase5b(P);
    SEAM(7); STAMP(8);
    PHASE(8) { pg8::EpiBf16<0> E; E.O = (bf16_t*)(ws + WS_Q); E.ldc = D; E.bias = nullptr; E.split_cols = 0; E.split_stride = 0;
        run_gemm(lds, (const bf16_t*)(ws + WS_H1B), (const bf16_t*)(ws + WS_WTQ), NTOK, 2048, 2048, E); }
    SEAM(8); STAMP(9);
    PHASE(9) phase7(P, lds);
    SEAM(9); STAMP(10);
    PHASE(10) phase8(P);
#ifdef DBG_TA
    {
        __threadfence_system(); asm volatile("s_waitcnt vmcnt(0) lgkmcnt(0)" ::: "memory"); __syncthreads(); grid.sync(); __threadfence_system();
        STAMP(11);
        const unsigned long long tt[12] = {ts0, ts1, ts2, ts3, ts4, ts5, ts6, ts7, ts8, ts9, ts10, ts11};
        const float ta = (float)(tt[DBG_TA + 1] - tt[DBG_TA]) * 0.01f, tb = (float)(tt[DBG_TB + 1] - tt[DBG_TB]) * 0.01f;
        if (blockIdx.x == 0) { for (int i = threadIdx.x + 1; i <= 1000000; i += 512) P.out[i] = tb; if (threadIdx.x == 0) P.out[0] = 1000.0f * ta; }
    }
#endif
#ifdef DBG_STOP
    {
        __threadfence_system(); asm volatile("s_waitcnt vmcnt(0) lgkmcnt(0)" ::: "memory"); __syncthreads(); grid.sync(); __threadfence_system();
        const size_t a = DBG_A, b = DBG_B; const unsigned* w = (const unsigned*)(ws + a); const size_t nw = (b - a) / 4, NO = (size_t)NTOK * D;
        for (size_t i = (size_t)blockIdx.x * 512 + threadIdx.x; i < NO; i += (size_t)gridDim.x * 512) {
            unsigned acc = 0; for (size_t j = i; j < nw; j += NO) { const unsigned x = w[j]; acc += (x & 0xffffu) + (x >> 16); }
            P.out[i] = (float)(acc & 0xfffffu);
        }
    }
#endif
#undef PHASE
#undef SEAM
}

extern "C" void kernel_launch(void* const* d_in, const int* in_sizes, int n_in, void* d_out, int out_size, void* d_ws, size_t ws_size, hipStream_t stream) {
    static int grid = 0;
    if (grid == 0) {
        if (n_in != 30 || out_size != NTOK * D || ws_size < WS_END) { fprintf(stderr, "kernel_launch: unexpected shapes (n_in %d, out %d, ws %zu < %zu)\n", n_in, out_size, ws_size, (size_t)WS_END); grid = -1; return; }
        int dev = 0, cus = 0, per_cu = 0;
        if (hipGetDevice(&dev) != hipSuccess || hipDeviceGetAttribute(&cus, hipDeviceAttributeMultiprocessorCount, dev) != hipSuccess) { grid = -1; return; }
        if (hipFuncSetAttribute((const void*)hybrid_fwd, hipFuncAttributeMaxDynamicSharedMemorySize, LDS_BYTES) != hipSuccess) { fprintf(stderr, "kernel_launch: hipFuncSetAttribute failed\n"); grid = -1; return; }
        if (hipOccupancyMaxActiveBlocksPerMultiprocessor(&per_cu, (const void*)hybrid_fwd, 512, LDS_BYTES) != hipSuccess || per_cu < 1) { fprintf(stderr, "kernel_launch: occupancy query says %d\n", per_cu); grid = -1; return; }
        (void)hipGetLastError();
        grid = cus;
    }
    if (grid < 0) return;
    if (hipMemsetAsync((unsigned char*)d_ws + WS_BAR, 0, XCD_BAR_WORDS * 4, stream) != hipSuccess) { fprintf(stderr, "kernel_launch: memset failed\n"); return; }
    Params p{};
    for (int i = 0; i < 30; ++i) p.in[i] = (const float*)d_in[i];
    p.out = (float*)d_out; p.ws = (unsigned char*)d_ws;
#if MK_MULTI
    for (int ph = 0; ph <= NPHASE; ++ph) { p.ph_lo = ph; p.ph_hi = ph + 1; hipLaunchKernelGGL(hybrid_fwd, dim3(grid), dim3(512), LDS_BYTES, stream, p); }
#else
    p.ph_lo = 0; p.ph_hi = NPHASE + 1;
#ifdef DBG_STOP
    p.ph_hi = DBG_STOP + 1;
#endif
    void* args[] = {&p};
    hipError_t e = hipLaunchCooperativeKernel((const void*)hybrid_fwd, dim3(grid), dim3(512), args, LDS_BYTES, stream);
    if (e != hipSuccess) fprintf(stderr, "kernel_launch: cooperative launch failed: %s (grid %d)\n", hipGetErrorString(e), grid);
#endif
}
```

```cpp
#include <hip/hip_runtime.h>
#include <hip/hip_cooperative_groups.h>
#include <cstdio>
#include <cstdint>
namespace cg = cooperative_groups;
namespace pg8 {
#define PG8_LAS __attribute__((address_space(3)))
typedef unsigned short bf16_t;
typedef short bf16x8 __attribute__((ext_vector_type(8)));
typedef float f32x4 __attribute__((ext_vector_type(4)));
typedef unsigned u32x4 __attribute__((ext_vector_type(4)));
constexpr int BM = 256, BK = 64, HALF = 128, HTB = HALF * BK * 2  , STAGE_BYTES = 8 * HTB, NXCD = 8, WGM = 8;

__host__ __device__ __forceinline__ int lds_byte(int r, int c) { const int st = (r >> 4) * 2 + (c >> 5), rr = r & 15, cc = c & 31, ob = rr * 64 + cc * 2; return st * 1024 + (ob ^ (((ob >> 9) & 1) << 5)); }
__host__ __device__ __forceinline__ void stage_rc(int b, int& R, int& C) { const int st = b / 1024, sb = b % 1024, swz = sb ^ (((sb >> 9) & 1) << 5); R = (st >> 1) * 16 + swz / 64; C = (st & 1) * 32 + (swz % 64) / 2; }
__host__ __device__ __forceinline__ int perm32(int rho) { const int n = rho >> 4, i = rho & 15; return 8 * (i >> 2) + 4 * n + (i & 3); }

struct Unit { int pm, pn; };
struct Gemm { const bf16_t* A; const bf16_t* Bt; int M, N, K; };

struct StaticOrder {
    int nM, nN, nwg, G, c;
    __host__ __device__ void init(int M, int N, int G_, int c_) { nM = M / BM; nN = N / BM; nwg = nM * nN; G = G_; c = c_; }
    __host__ __device__ bool next(int i, Unit& u) const {
        const long L = (long)i * G + c; if (L >= nwg) return false;
        int wgid = (int)L; { const int q = nwg / NXCD, r = nwg % NXCD, xcd = wgid % NXCD, off = wgid / NXCD; wgid = (xcd < r ? xcd * (q + 1) : r * (q + 1) + (xcd - r) * q) + off; }
        const int nig = WGM * nN, gid = wgid / nig, fm = gid * WGM, gsz = (nM - fm) < WGM ? (nM - fm) : WGM;
        u.pm = fm + ((wgid % nig) % gsz); u.pn = (wgid % nig) / gsz; return true;
    }
    __device__ __forceinline__ void a_ready(const Unit&) const {}
    __device__ __forceinline__ void done(const Unit&) const {}
};
struct CountedOrder : StaticOrder {
    const unsigned* ready; unsigned need; unsigned* tmo;
    __device__ __forceinline__ void a_ready(const Unit& u) const {
        if (threadIdx.x < 64) {
            const unsigned long long t0 = __builtin_amdgcn_s_memrealtime(); unsigned polls = 0;
            while ((unsigned)__builtin_amdgcn_readfirstlane(__hip_atomic_load(ready + 64 * u.pm, __ATOMIC_RELAXED, __HIP_MEMORY_SCOPE_AGENT)) < need) {
                if ((++polls & 255u) == 0u && __builtin_amdgcn_readfirstlane(__hip_atomic_load(tmo, __ATOMIC_RELAXED, __HIP_MEMORY_SCOPE_AGENT)) != 0u) break;
                if (__builtin_amdgcn_s_memrealtime() - t0 > 2000000ull) {
                    if (threadIdx.x == 0) { unsigned expect = 0u; __hip_atomic_compare_exchange_strong(tmo + 1, &expect, 0x600u | (unsigned)(u.pm & 0xff), __ATOMIC_RELAXED, __ATOMIC_RELAXED, __HIP_MEMORY_SCOPE_AGENT); __hip_atomic_store(tmo, 1u, __ATOMIC_RELAXED, __HIP_MEMORY_SCOPE_AGENT); }
                    break; }
                __builtin_amdgcn_s_sleep(2); }
            __builtin_amdgcn_fence(__ATOMIC_ACQUIRE, "agent");
            asm volatile("s_waitcnt vmcnt(0)" ::: "memory");
        }
#if !defined(BROKEN_HOOK_NO_BARRIER)
        asm volatile("" ::: "memory"); __builtin_amdgcn_s_barrier(); asm volatile("" ::: "memory");
#endif
    }
};

typedef float cvt_f32x2 __attribute__((ext_vector_type(2))); typedef __bf16 cvt_bf16x2 __attribute__((ext_vector_type(2)));
__device__ __forceinline__ unsigned cvt_pk_bf16(float lo, float hi) { const cvt_f32x2 v = {lo, hi}; const cvt_bf16x2 b = __builtin_convertvector(v, cvt_bf16x2); return __builtin_bit_cast(unsigned, b); }
typedef float f32x2 __attribute__((ext_vector_type(2)));
__device__ __forceinline__ f32x2 gelu_pk(f32x2 v) {
    const f32x2 av = __builtin_elementwise_abs(v), d = av * 0.2316418882f + 1.0f;
    f32x2 t; t.x = __builtin_amdgcn_rcpf(d.x); t.y = __builtin_amdgcn_rcpf(d.y);
    f32x2 q = t * 0.5307027145f + (-0.7265760135f); q = q * t + 0.7107068705f; q = q * t + (-0.142248368f); q = q * t + 0.127414796f; q = q * t;
    const f32x2 s = (v * v) * (-0.72134752044f);
    f32x2 e; e.x = __builtin_amdgcn_exp2f(s.x); e.y = __builtin_amdgcn_exp2f(s.y);
    const f32x2 m = v * (q * e), r = v - m;
    f32x2 o; o.x = v.x < 0.f ? m.x : r.x; o.y = v.y < 0.f ? m.y : r.y; return o;
}

struct EpiF32 {
    static constexpr bool PERM = false, AFTER_DRAIN = false;
    float* C; int ldc; const float* bias;
    __device__ __forceinline__ void operator()(const f32x4 (&acc)[2][2][4][2], const Unit& u, int wr, int wc, int fr, int fq) const {
        const int row0 = u.pm * BM + wr * 64 + fr, col0 = u.pn * BM + wc * 32 + 4 * fq;
        f32x4 bv[2][2];
#pragma unroll
        for (int bj = 0; bj < 2; ++bj)
#pragma unroll
            for (int n = 0; n < 2; ++n) bv[bj][n] = bias ? *(const f32x4*)(bias + col0 + bj * HALF + n * 16) : (f32x4){0.f, 0.f, 0.f, 0.f};
#pragma unroll
        for (int ai = 0; ai < 2; ++ai)
#pragma unroll
            for (int m = 0; m < 4; ++m) { float* rowp = C + (size_t)(row0 + ai * HALF + m * 16) * ldc + col0;
#pragma unroll
                for (int bj = 0; bj < 2; ++bj)
#pragma unroll
                    for (int n = 0; n < 2; ++n) *(f32x4*)(rowp + bj * HALF + n * 16) = acc[ai][bj][m][n] + bv[bj][n]; }
    }
};
template <int ACT  > struct EpiBf16 {
    static constexpr bool PERM = true, AFTER_DRAIN = false;
    bf16_t* O; int ldc; const float* bias; int split_cols; size_t split_stride;
    __device__ __forceinline__ void operator()(const f32x4 (&acc)[2][2][4][2], const Unit& u, int wr, int wc, int fr, int fq) const {
        const int row0 = u.pm * BM + wr * 64 + fr; int colt = u.pn * BM; bf16_t* base = O;
        if (split_cols) { const int t = colt / split_cols; base += (size_t)t * split_stride; colt -= t * split_cols; }
        const int col0 = colt + wc * 32 + 8 * fq, bcol0 = u.pn * BM + wc * 32 + 8 * fq;
        f32x4 bv[2][2];
#pragma unroll
        for (int bj = 0; bj < 2; ++bj)
#pragma unroll
            for (int n = 0; n < 2; ++n) bv[bj][n] = bias ? *(const f32x4*)(bias + bcol0 + bj * HALF + 4 * n) : (f32x4){0.f, 0.f, 0.f, 0.f};
#pragma unroll
        for (int ai = 0; ai < 2; ++ai)
#pragma unroll
            for (int m = 0; m < 4; ++m) { bf16_t* rowp = base + (size_t)(row0 + ai * HALF + m * 16) * ldc + col0;
#pragma unroll
                for (int bj = 0; bj < 2; ++bj) { f32x4 v0 = acc[ai][bj][m][0] + bv[bj][0], v1 = acc[ai][bj][m][1] + bv[bj][1];
                    if (ACT == 1) { f32x2 a = gelu_pk((f32x2){v0[0], v0[1]}), b = gelu_pk((f32x2){v0[2], v0[3]}), c = gelu_pk((f32x2){v1[0], v1[1]}), d = gelu_pk((f32x2){v1[2], v1[3]});
                        v0 = (f32x4){a.x, a.y, b.x, b.y}; v1 = (f32x4){c.x, c.y, d.x, d.y}; }
                    if (ACT == 2) {
#pragma unroll
                        for (int j = 0; j < 4; ++j) { v0[j] = 0.5f * v0[j] * (1.0f + erff(v0[j] * 0.70710678f)); v1[j] = 0.5f * v1[j] * (1.0f + erff(v1[j] * 0.70710678f)); } }
                    u32x4 w; w.x = cvt_pk_bf16(v0[0], v0[1]); w.y = cvt_pk_bf16(v0[2], v0[3]); w.z = cvt_pk_bf16(v1[0], v1[1]); w.w = cvt_pk_bf16(v1[2], v1[3]);
                    *(u32x4*)(rowp + bj * HALF) = w; } }
    }
};
template <class Epi, class Sched, bool STAMP = false>
__device__ __forceinline__ void gemm_phase(PG8_LAS unsigned char* lds, const Gemm g, const Sched& S, const Epi& E, unsigned long long* stamps) {
    const int tid = threadIdx.x, wid = __builtin_amdgcn_readfirstlane(tid >> 6), lane = tid & 63, wr = wid >> 2, wc = wid & 3, fr = lane & 15, fq = lane >> 4;
    const int K = g.K, nt = K / BK;
    int ts_lo = 0, ts_hi = 0, nts = 0; const unsigned long long rt_entry = STAMP ? (unsigned long long)wall_clock64() : 0ull;
#define PG8_STAMP() do { if (STAMP && wid == 0 && nts < 64) { const unsigned long long _c = (unsigned long long)clock64(); \
        ts_lo = (lane == nts) ? (int)(unsigned)_c : ts_lo; ts_hi = (lane == nts) ? (int)(unsigned)(_c >> 32) : ts_hi; ++nts; } } while (0)
    PG8_STAMP();
    unsigned voffA[2], voffB[2];
#pragma unroll
    for (int i = 0; i < 2; ++i) { int R, C; stage_rc(tid * 16 + i * 8192, R, C); const int Rb = Epi::PERM ? ((R & ~31) + perm32(R & 31)) : R;
        voffA[i] = (unsigned)(R * K + C) * 2u; voffB[i] = (unsigned)(Rb * K + C) * 2u; }
    const size_t kstep = (size_t)(BK * 2);
    const size_t hstep = (size_t)HALF * K * 2;
    const size_t tstep = 2 * hstep;
    const unsigned ldsw = (unsigned)wid * 1024u;
    const int aoff = lds_byte(wr * 64 + fr, fq * 8), boff = lds_byte(wc * 32 + fr, fq * 8);
#define PG8_SA(b, h) (((b) * 2 + (h)) * HTB)
#define PG8_SB(b, h) ((4 + (b) * 2 + (h)) * HTB)
#define PG8_STAGE(bufoff, gbase, voff) do { _Pragma("unroll") for (int _i = 0; _i < 2; ++_i) \
        __builtin_amdgcn_global_load_lds((const unsigned*)((const char*)(gbase) + (voff)[_i]), (PG8_LAS unsigned*)(lds + (bufoff) + ldsw + _i * 8192), 16, 0, 0); } while (0)
#define PG8_LDA(dst, b, h) do { _Pragma("unroll") for (int m = 0; m < 4; ++m) _Pragma("unroll") for (int k = 0; k < 2; ++k) dst[m][k] = *(const PG8_LAS bf16x8*)(lds + PG8_SA(b, h) + aoff + m * 2048 + k * 1024); } while (0)
#define PG8_LDB(dst, b, h) do { _Pragma("unroll") for (int n = 0; n < 2; ++n) _Pragma("unroll") for (int k = 0; k < 2; ++k) dst[n][k] = *(const PG8_LAS bf16x8*)(lds + PG8_SB(b, h) + boff + n * 2048 + k * 1024); } while (0)
#define PG8_MMA(ai, bj, At, Bt) do { __builtin_amdgcn_s_setprio(1); _Pragma("unroll") for (int m = 0; m < 4; ++m) _Pragma("unroll") for (int n = 0; n < 2; ++n) _Pragma("unroll") for (int k = 0; k < 2; ++k) \
        acc[ai][bj][m][n] = __builtin_amdgcn_mfma_f32_16x16x32_bf16(Bt[n][k], At[m][k], acc[ai][bj][m][n], 0, 0, 0); __builtin_amdgcn_s_setprio(0); } while (0)
#define PG8_WAIT_V(n) asm volatile("s_waitcnt vmcnt(" #n ")" ::: "memory")
#define PG8_WAIT_L(n) asm volatile("s_waitcnt lgkmcnt(" #n ")" ::: "memory")
#define PG8_BAR __builtin_amdgcn_s_barrier()
#define PG8_SCHED __builtin_amdgcn_sched_barrier(0)
    Unit cur, nxt; int ui = 0;
    if (!S.next(0, cur)) return;
    f32x4 acc[2][2][4][2];
#pragma unroll
    for (int a = 0; a < 2; ++a)
#pragma unroll
        for (int b = 0; b < 2; ++b)
#pragma unroll
            for (int m = 0; m < 4; ++m)
#pragma unroll
                for (int n = 0; n < 2; ++n) acc[a][b][m][n] = (f32x4){0.f, 0.f, 0.f, 0.f};
    bf16x8 At[4][2], B0[2][2], B1[2][2];
    const char* cA = (const char*)g.A + (size_t)cur.pm * tstep; const char* cB = (const char*)g.Bt + (size_t)cur.pn * tstep;
    S.a_ready(cur);
    PG8_STAGE(PG8_SB(0, 0), cB, voffB); PG8_STAGE(PG8_SA(0, 0), cA, voffA); PG8_STAGE(PG8_SB(0, 1), cB + hstep, voffB); PG8_STAGE(PG8_SA(0, 1), cA + hstep, voffA);
    if (wr == 1) PG8_BAR;
    PG8_WAIT_V(4); PG8_BAR;
    PG8_STAGE(PG8_SB(1, 0), cB + kstep, voffB); PG8_STAGE(PG8_SA(1, 0), cA + kstep, voffA); PG8_STAGE(PG8_SB(1, 1), cB + hstep + kstep, voffB);
    PG8_WAIT_V(6); PG8_BAR;
    PG8_STAMP();
    for (;;) {
        const bool has_next = S.next(ui + 1, nxt);
        const char* nA = has_next ? (const char*)g.A + (size_t)nxt.pm * tstep : cA; const char* nB = has_next ? (const char*)g.Bt + (size_t)nxt.pn * tstep : cB;
        for (int t = 0; t < nt; t += 2) {
            const bool last = (t == nt - 2);
            const char* a1 = cA + (size_t)(t + 1) * kstep;
            const char* a2 = last ? nA : cA + (size_t)(t + 2) * kstep; const char* b2 = last ? nB : cB + (size_t)(t + 2) * kstep;
            const char* a3 = a2 + kstep; const char* b3 = b2 + kstep;
            if (last && has_next) S.a_ready(nxt);
            PG8_LDB(B0, 0, 0); PG8_SCHED; PG8_LDA(At, 0, 0); PG8_STAGE(PG8_SA(1, 1), a1 + hstep, voffA);
            PG8_WAIT_L(8); PG8_BAR; PG8_WAIT_L(0); PG8_MMA(0, 0, At, B0); PG8_BAR; PG8_SCHED;
            PG8_LDB(B1, 0, 1); PG8_STAGE(PG8_SB(0, 0), b2, voffB);
            PG8_BAR; PG8_WAIT_L(0); PG8_MMA(0, 1, At, B1); PG8_BAR;
            PG8_LDA(At, 0, 1); PG8_STAGE(PG8_SA(0, 0), a2, voffA);
            PG8_BAR; PG8_WAIT_L(0); PG8_MMA(1, 0, At, B0); PG8_BAR; PG8_SCHED;
            PG8_STAGE(PG8_SB(0, 1), b2 + hstep, voffB);
            PG8_WAIT_V(6); PG8_BAR; PG8_MMA(1, 1, At, B1); PG8_BAR;
            PG8_LDB(B0, 1, 0); PG8_SCHED; PG8_LDA(At, 1, 0); PG8_STAGE(PG8_SA(0, 1), a2 + hstep, voffA);
            PG8_WAIT_L(8); PG8_BAR; PG8_WAIT_L(0); PG8_MMA(0, 0, At, B0); PG8_BAR; PG8_SCHED;
            PG8_LDB(B1, 1, 1); PG8_STAGE(PG8_SB(1, 0), b3, voffB);
            PG8_BAR; PG8_WAIT_L(0); PG8_MMA(0, 1, At, B1); PG8_BAR;
            PG8_LDA(At, 1, 1); PG8_STAGE(PG8_SA(1, 0), a3, voffA);
            PG8_BAR; PG8_WAIT_L(0); PG8_MMA(1, 0, At, B0); PG8_BAR; PG8_SCHED;
            PG8_STAGE(PG8_SB(1, 1), b3 + hstep, voffB);
            PG8_WAIT_V(6); PG8_BAR; PG8_MMA(1, 1, At, B1); PG8_BAR;
        }
        PG8_STAMP();
        if constexpr (!Epi::AFTER_DRAIN) { E(acc, cur, wr, wc, fr, fq); S.done(cur); }
        PG8_STAMP();
        if (!has_next) break;
#pragma unroll
        for (int a = 0; a < 2; ++a)
#pragma unroll
            for (int b = 0; b < 2; ++b)
#pragma unroll
                for (int m = 0; m < 4; ++m)
#pragma unroll
                    for (int n = 0; n < 2; ++n) acc[a][b][m][n] = (f32x4){0.f, 0.f, 0.f, 0.f};
        cur = nxt; cA = nA; cB = nB; ++ui;
    }
    PG8_WAIT_V(0);
    if (wr == 0) PG8_BAR;
    PG8_BAR;
    if constexpr (Epi::AFTER_DRAIN) { E.fused(acc, cur, wr, wc, fr, fq, lds, wid, lane); S.done(cur); }
    PG8_STAMP();
    if (STAMP && wid == 0) { stamps[lane] = lane < nts ? (((unsigned long long)(unsigned)ts_hi << 32) | (unsigned)ts_lo) : 0ull;
        if (lane == 62) stamps[62] = rt_entry; if (lane == 63) stamps[63] = (unsigned long long)wall_clock64(); }
#undef PG8_STAMP
#undef PG8_SA
#undef PG8_SB
#undef PG8_STAGE
#undef PG8_LDA
#undef PG8_LDB
#undef PG8_MMA
#undef PG8_WAIT_V
#undef PG8_WAIT_L
#undef PG8_BAR
#undef PG8_SCHED
}
}
#define LAS __attribute__((address_space(3)))
typedef unsigned short bf16_t;
typedef short bf16x8 __attribute__((ext_vector_type(8)));
typedef float f32x4 __attribute__((ext_vector_type(4)));
typedef float f32x2 __attribute__((ext_vector_type(2)));
typedef unsigned u32x4 __attribute__((ext_vector_type(4)));
typedef unsigned u32x2 __attribute__((ext_vector_type(2)));
typedef LAS unsigned char* ldsp;

constexpr int D = 2048, NTOK = 8192, SEQ = 4096, MROWS = 8448, ROW_META = 8192;
constexpr int INC = 11712, NPAD = 11776;
constexpr int C_R = 0, C_K = 2048, C_V = 4096, C_WL = 6144, C_AL = 6240, C_GL = 6336, C_POOL = 6592, C_G0 = 7616, C_G1 = 9664;
constexpr int NUNITS = 4128;
constexpr float DSCALE = 0.6065306597126334f;
constexpr float DN_ALPHA = 1.189207115002721f;
constexpr float GN_EPS = 64e-5f, LN_EPS = 1e-5f;

constexpr size_t WS_P = 0;
constexpr size_t WS_UB = 0;
constexpr size_t WS_VB = 33554432;
constexpr size_t WS_H0B = 198967296;
constexpr size_t WS_WTA = WS_H0B + 34603008;
constexpr size_t WS_WTB = WS_WTA + 8388608;
constexpr size_t WS_WTOUT = WS_WTB + 4194304;
constexpr size_t WS_WTQ = WS_WTOUT + 8388608;
constexpr size_t WS_WTPOOL = WS_WTQ + 8388608;
constexpr size_t WS_WTW2 = WS_WTPOOL + 524288;
constexpr size_t WS_WTA2 = WS_WTW2 + 393216;
constexpr size_t WS_WTG2 = WS_WTA2 + 393216;
constexpr size_t WS_SUBK = WS_WTG2 + 1048576;
constexpr size_t WS_BONUS = WS_SUBK + 65536;
constexpr size_t WS_REGC = WS_BONUS + 1048576;
constexpr size_t WS_WTIN = WS_REGC;
constexpr size_t UNITB = (size_t)NUNITS * 4096 * 2;
constexpr size_t WS_G = WS_REGC;
constexpr size_t WS_H0T = WS_REGC + UNITB;
constexpr size_t WS_RT = WS_REGC + 2 * UNITB;
constexpr size_t WS_Y0 = WS_REGC + 3 * UNITB;
constexpr size_t WS_S0T = WS_REGC + 4 * UNITB;
constexpr size_t WS_MERGED = WS_REGC;
constexpr size_t WS_MPART = WS_REGC + 33554432;
constexpr size_t WS_X1 = WS_REGC + 33554432;
constexpr size_t WS_H1B = WS_REGC + 100663296;
constexpr size_t WS_Q = WS_REGC + 134217728;
constexpr size_t WS_YA = WS_REGC + 5 * UNITB;
constexpr size_t WS_YB = WS_YA + 33554432;
constexpr size_t WS_EXP = WS_YB + 16777216;
constexpr size_t WS_GATE = WS_EXP + 4194304;
constexpr size_t WS_BAR = WS_GATE + 4194304;
constexpr size_t WS_TSC = WS_BAR + 16384;
constexpr size_t WS_END = WS_TSC + 131072;
static_assert(WS_Q + 33554432 <= WS_YA, "overlay");
static_assert(WS_VB + 33554432 <= WS_H0B, "overlay");

constexpr int LDS_BYTES = 163840;
constexpr int NPHASE = 9;

struct Params {
    const float* in[30];
    float* out;
    unsigned char* ws;
    int ph_lo, ph_hi;
};
enum { I_X = 0, I_META, I_LNIN_G, I_LNIN_B, I_WIN, I_MU, I_W0, I_WW2, I_A0, I_WA2, I_WG2, I_KK, I_KA, I_RK, I_GNG, I_GNB, I_WPOOL, I_PSCALE, I_BGATE,
       I_WBA, I_WBB, I_WOUT, I_LN1G, I_LN1B, I_WQ, I_SUBK, I_UT, I_VT, I_LN2G, I_LN2B };

__device__ __forceinline__ unsigned pk2(float lo, float hi) { return pg8::cvt_pk_bf16(lo, hi); }
__device__ __forceinline__ float bflo(unsigned w) { return __uint_as_float(w << 16); }
__device__ __forceinline__ float bfhi(unsigned w) { return __uint_as_float(w & 0xffff0000u); }
__device__ __forceinline__ float bf1(bf16_t h) { return __uint_as_float(((unsigned)h) << 16); }
__device__ __forceinline__ bf16_t f2bf1(float f) { return (bf16_t)(pk2(f, f) & 0xffffu); }
__device__ __forceinline__ float wave_sum(float v) {
#pragma unroll
    for (int o = 1; o < 64; o <<= 1) v += __shfl_xor(v, o);
    return v;
}
__device__ __forceinline__ float sigmoidf_(float x) { return 1.0f / (1.0f + __expf(-x)); }
__device__ __forceinline__ f32x4 mfma16(bf16x8 a, bf16x8 b, f32x4 c) { return __builtin_amdgcn_mfma_f32_16x16x32_bf16(a, b, c, 0, 0, 0); }
__device__ __forceinline__ void unpack8(const u32x4 w, float* f) {
    f[0] = bflo(w.x); f[1] = bfhi(w.x); f[2] = bflo(w.y); f[3] = bfhi(w.y); f[4] = bflo(w.z); f[5] = bfhi(w.z); f[6] = bflo(w.w); f[7] = bfhi(w.w);
}
__device__ __forceinline__ u32x4 pack8(const float* f) { u32x4 w; w.x = pk2(f[0], f[1]); w.y = pk2(f[2], f[3]); w.z = pk2(f[4], f[5]); w.w = pk2(f[6], f[7]); return w; }
#define DPPF(v, ctrl) __builtin_bit_cast(float, __builtin_amdgcn_update_dpp(0, __builtin_bit_cast(int, (v)), (ctrl), 0xF, 0xF, true))
__device__ __forceinline__ float readlane_f(float v, int l) { return __builtin_bit_cast(float, __builtin_amdgcn_readlane(__builtin_bit_cast(int, v), l)); }
__device__ __forceinline__ float wave_sum_dpp(float v) {
    v += DPPF(v, 0xB1); v += DPPF(v, 0x4E); v += DPPF(v, 0x141); v += DPPF(v, 0x140);
    return (readlane_f(v, 0) + readlane_f(v, 16)) + (readlane_f(v, 32) + readlane_f(v, 48));
}
__device__ __forceinline__ float wave_max_dpp(float v) {
    v = fmaxf(v, DPPF(v, 0xB1)); v = fmaxf(v, DPPF(v, 0x4E)); v = fmaxf(v, DPPF(v, 0x141)); v = fmaxf(v, DPPF(v, 0x140));
    return fmaxf(fmaxf(readlane_f(v, 0), readlane_f(v, 16)), fmaxf(readlane_f(v, 32), readlane_f(v, 48)));
}
#define BLOCK_SYNC() __syncthreads()
#define XB_TMO      128
#define XB_XCNT(j)  (256  + 64 * (j))
#define XB_XSUB(j)  (1280 + 64 * (j))
#define XB_XGEN(j)  (2304 + 64 * (j))
#define XB_TOP      3328
#define XB_TOPGEN   3392
#define XCD_BAR_WORDS 3456
#define XB_SPIN_CAP (1u << 18)

__device__ __forceinline__ unsigned xb_ld(unsigned* p)              { return __hip_atomic_load(p, __ATOMIC_RELAXED, __HIP_MEMORY_SCOPE_AGENT); }
__device__ __forceinline__ unsigned xb_add(unsigned* p, unsigned v) { return __hip_atomic_fetch_add(p, v, __ATOMIC_RELAXED, __HIP_MEMORY_SCOPE_AGENT); }
__device__ __forceinline__ unsigned xb_xcc_id() { return (unsigned)__builtin_amdgcn_s_getreg((3 << 11) | 20) & 0xFu; }
#define XB_SPIN(cond, bar) do { unsigned _sp = 0; while (cond) { __builtin_amdgcn_s_sleep(1); \
    if ((++_sp & 255u) == 0u) { if (xb_ld(&(bar)[XB_TMO])) break; if (_sp > XB_SPIN_CAP) { atomicAdd(&(bar)[XB_TMO], 1u); break; } } } } while (0)

struct XcdBarrier {
    unsigned* bar; unsigned x;
    volatile LAS unsigned* st;
};

__device__ __forceinline__ XcdBarrier xcd_barrier_post(unsigned* bar, volatile LAS unsigned* st) {
    XcdBarrier b; b.bar = bar; b.x = xb_xcc_id(); b.st = st;
    if (threadIdx.x == 0) (void)xb_add(&bar[XB_XCNT(b.x)], 1u);
    return b;
}
__device__ __forceinline__ void xcd_barrier_complete(unsigned* bar, unsigned x, unsigned& nloc, unsigned& nx) {
    const unsigned G = gridDim.x * gridDim.y * gridDim.z;
    unsigned sum, cnt, mine, sp = 0u;
    for (;;) {
        sum = 0u; cnt = 0u; mine = 0u;
#pragma unroll
        for (unsigned j = 0; j < 16; ++j) { const unsigned c = xb_ld(&bar[XB_XCNT(j)]); sum += c; cnt += (c > 0u) ? 1u : 0u; mine = (j == x) ? c : mine; }
        if (sum == G) break;
        __builtin_amdgcn_s_sleep(1);
        if ((++sp & 255u) == 0u) { if (xb_ld(&bar[XB_TMO])) break; if (sp > XB_SPIN_CAP) { atomicAdd(&bar[XB_TMO], 1u); break; } }
    }
    nloc = mine > 0u ? mine : 1u; nx = cnt > 0u ? cnt : 1u;
}

__device__ __forceinline__ void xcd_barrier(const XcdBarrier& b) {
    asm volatile("s_waitcnt vmcnt(0)" ::: "memory");
    __syncthreads();
    if (threadIdx.x == 0) {
        unsigned* bar = b.bar;
        __builtin_amdgcn_s_waitcnt(0);
        unsigned nloc = b.st[0], nx = b.st[1];
        if (nloc == 0u) { xcd_barrier_complete(bar, b.x, nloc, nx); b.st[0] = nloc; b.st[1] = nx; }
        const unsigned old = xb_add(&bar[XB_XSUB(b.x)], 1u);
        const unsigned gen = old / nloc;
        if (old + 1u == (gen + 1u) * nloc) {
            __builtin_amdgcn_fence(__ATOMIC_RELEASE, "agent");
            asm volatile("s_waitcnt vmcnt(0)" ::: "memory");
            const unsigned og = xb_add(&bar[XB_TOP], 1u);
            const unsigned tg = og / nx;
            if (og + 1u == (tg + 1u) * nx) xb_add(&bar[XB_TOPGEN], 1u);
            else XB_SPIN(xb_ld(&bar[XB_TOPGEN]) == tg, bar);
            __builtin_amdgcn_fence(__ATOMIC_ACQUIRE, "agent");
            xb_add(&bar[XB_XGEN(b.x)], 1u);
            asm volatile("s_waitcnt vmcnt(0)" ::: "memory");
        } else {
            XB_SPIN(xb_ld(&bar[XB_XGEN(b.x)]) == gen, bar);
            __builtin_amdgcn_fence(__ATOMIC_ACQUIRE, "agent");
            asm volatile("s_waitcnt vmcnt(0)" ::: "memory");
        }
    }
    __syncthreads();
}

__device__ __forceinline__ void ln_row_bf16(const float* src, const float* g, const float* b, bf16_t* dst, int lane) {
    f32x4 v[8]; float s = 0.f;
#pragma unroll
    for (int j = 0; j < 8; ++j) { v[j] = ((const f32x4*)src)[lane + 64 * j]; s += (v[j].x + v[j].y) + (v[j].z + v[j].w); }
    const float mean = wave_sum(s) * (1.0f / D); float s2 = 0.f;
#pragma unroll
    for (int j = 0; j < 8; ++j) { v[j] = v[j] - mean; s2 += (v[j].x * v[j].x + v[j].y * v[j].y) + (v[j].z * v[j].z + v[j].w * v[j].w); }
    const float rstd = 1.0f / sqrtf(wave_sum(s2) * (1.0f / D) + LN_EPS);
#pragma unroll
    for (int j = 0; j < 8; ++j) {
        const f32x4 gg = ((const f32x4*)g)[lane + 64 * j], bb = ((const f32x4*)b)[lane + 64 * j];
        const f32x4 o = v[j] * rstd * gg + bb;
        u32x2 w; w.x = pk2(o.x, o.y); w.y = pk2(o.z, o.w);
        ((u32x2*)dst)[lane + 64 * j] = w;
    }
}
__device__ __forceinline__ void transpose_item(const float* W, int K, int N, int Npad, bf16_t* Wt, int item, int lane) {
    const int nblk = Npad >> 6, kb = item / nblk, nb = item - kb * nblk, n = nb * 64 + lane, k0 = kb * 32;
    float v[32];
    if (n < N) {
#pragma unroll
        for (int i = 0; i < 32; ++i) v[i] = W[(size_t)(k0 + i) * N + n];
    } else {
#pragma unroll
        for (int i = 0; i < 32; ++i) v[i] = 0.f;
    }
    u32x4* o = (u32x4*)(Wt + (size_t)n * K + k0);
#pragma unroll
    for (int c = 0; c < 4; ++c) { u32x4 w; w.x = pk2(v[8 * c], v[8 * c + 1]); w.y = pk2(v[8 * c + 2], v[8 * c + 3]); w.z = pk2(v[8 * c + 4], v[8 * c + 5]); w.w = pk2(v[8 * c + 6], v[8 * c + 7]); o[c] = w; }
}
__device__ __forceinline__ void phase0(const Params& P) {
    const int lane = threadIdx.x & 63, wave = threadIdx.x >> 6;
    const int gw = blockIdx.x * 8 + wave, NGW = gridDim.x * 8;
    unsigned char* ws = P.ws;
    constexpr int T_IN = 64 * 184, T_A = 64 * 32, T_B = 32 * 32, T_O = 64 * 32, T_Q = 64 * 32, T_POOL = 4 * 32, T_W2 = 3 * 32, T_A2 = 3 * 32, T_G2 = 8 * 32;
    constexpr int T_LN = MROWS, T_SK = 64;
    constexpr int NIT = T_IN + T_A + T_B + T_O + T_Q + T_POOL + T_W2 + T_A2 + T_G2 + T_LN + T_SK;
    for (int it = gw; it < NIT; it += NGW) {
        int r = it;
        if (r < T_IN) { transpose_item(P.in[I_WIN], 2048, INC, NPAD, (bf16_t*)(ws + WS_WTIN), r, lane); continue; } r -= T_IN;
        if (r < T_A) { transpose_item(P.in[I_WBA], 2048, 2048, 2048, (bf16_t*)(ws + WS_WTA), r, lane); continue; } r -= T_A;
        if (r < T_B) { transpose_item(P.in[I_WBB], 1024, 2048, 2048, (bf16_t*)(ws + WS_WTB), r, lane); continue; } r -= T_B;
        if (r < T_O) { transpose_item(P.in[I_WOUT], 2048, 2048, 2048, (bf16_t*)(ws + WS_WTOUT), r, lane); continue; } r -= T_O;
        if (r < T_Q) { transpose_item(P.in[I_WQ], 2048, 2048, 2048, (bf16_t*)(ws + WS_WTQ), r, lane); continue; } r -= T_Q;
        if (r < T_POOL) { const int g = r >> 5; transpose_item(P.in[I_WPOOL] + g * 65536, 256, 256, 256, (bf16_t*)(ws + WS_WTPOOL) + g * 65536, r & 31, lane); continue; } r -= T_POOL;
        if (r < T_W2) { transpose_item(P.in[I_WW2], 96, 2048, 2048, (bf16_t*)(ws + WS_WTW2), r, lane); continue; } r -= T_W2;
        if (r < T_A2) { transpose_item(P.in[I_WA2], 96, 2048, 2048, (bf16_t*)(ws + WS_WTA2), r, lane); continue; } r -= T_A2;
        if (r < T_G2) { transpose_item(P.in[I_WG2], 256, 2048, 2048, (bf16_t*)(ws + WS_WTG2), r, lane); continue; } r -= T_G2;
        if (r < T_LN) {
            bf16_t* dst = (bf16_t*)(ws + WS_H0B) + (size_t)r * D;
            if (r < NTOK) ln_row_bf16(P.in[I_X] + (size_t)r * D, P.in[I_LNIN_G], P.in[I_LNIN_B], dst, lane);
            else if (r < NTOK + 16) ln_row_bf16(P.in[I_META] + (size_t)(r - NTOK) * D, P.in[I_LNIN_G], P.in[I_LNIN_B], dst, lane);
            else {
#pragma unroll
                for (int j = 0; j < 8; ++j) ((u32x2*)dst)[lane + 64 * j] = (u32x2){0u, 0u};
            }
            continue;
        }
        r -= T_LN;
        {
            const float* s = P.in[I_SUBK] + r * 512 + lane * 8; float f[8];
#pragma unroll
            for (int i = 0; i < 8; ++i) f[i] = s[i];
            *(u32x4*)((bf16_t*)(ws + WS_SUBK) + r * 512 + lane * 8) = pack8(f);
        }
    }
}
namespace pg8 {
struct EpiGateA {
    static constexpr bool PERM = false, AFTER_DRAIN = false;
    float* C; const bf16_t* p; const float* bgate;
    __device__ __forceinline__ void operator()(const f32x4 (&acc)[2][2][4][2], const Unit& u, int wr, int wc, int fr, int fq) const {
        const int row0 = u.pm * BM + wr * 64 + fr, col0 = u.pn * BM + wc * 32 + 4 * fq;
#pragma unroll
        for (int ai = 0; ai < 2; ++ai)
#pragma unroll
            for (int m = 0; m < 4; ++m) { const size_t row = (size_t)(row0 + ai * HALF + m * 16);
#pragma unroll
                for (int bj = 0; bj < 2; ++bj)
#pragma unroll
                    for (int n = 0; n < 2; ++n) { const int col = col0 + bj * HALF + n * 16;
                        const u32x2 pw = *(const u32x2*)(p + row * NPAD + C_G0 + col); const f32x4 bg = *(const f32x4*)(bgate + col);
                        f32x4 g; g.x = sigmoidf_(bflo(pw.x) + bg.x); g.y = sigmoidf_(bfhi(pw.x) + bg.y); g.z = sigmoidf_(bflo(pw.y) + bg.z); g.w = sigmoidf_(bfhi(pw.y) + bg.w);
                        *(f32x4*)(C + row * D + col) = acc[ai][bj][m][n] * g; } }
    }
};
struct EpiGateB {
    static constexpr bool PERM = false, AFTER_DRAIN = false;
    const float* C; bf16_t* O; const bf16_t* p; const float* bgate;
    __device__ __forceinline__ void operator()(const f32x4 (&acc)[2][2][4][2], const Unit& u, int wr, int wc, int fr, int fq) const {
        const int row0 = u.pm * BM + wr * 64 + fr, col0 = u.pn * BM + wc * 32 + 4 * fq;
#pragma unroll
        for (int ai = 0; ai < 2; ++ai)
#pragma unroll
            for (int m = 0; m < 4; ++m) { const size_t row = (size_t)(row0 + ai * HALF + m * 16);
#pragma unroll
                for (int bj = 0; bj < 2; ++bj)
#pragma unroll
                    for (int n = 0; n < 2; ++n) { const int col = col0 + bj * HALF + n * 16;
                        const u32x2 pw = *(const u32x2*)(p + row * NPAD + C_G1 + col); const f32x4 bg = *(const f32x4*)(bgate + D + col);
                        f32x4 g; g.x = sigmoidf_(bflo(pw.x) + bg.x); g.y = sigmoidf_(bfhi(pw.x) + bg.y); g.z = sigmoidf_(bflo(pw.y) + bg.z); g.w = sigmoidf_(bfhi(pw.y) + bg.w);
                        const f32x4 o = *(const f32x4*)(C + row * D + col) + acc[ai][bj][m][n] * g;
                        u32x2 w; w.x = cvt_pk_bf16(o.x, o.y); w.y = cvt_pk_bf16(o.z, o.w);
                        *(u32x2*)(O + row * D + col) = w; } }
    }
};
struct EpiResid {
    static constexpr bool PERM = false, AFTER_DRAIN = false;
    float* C; const bf16_t* h0; float alpha;
    __device__ __forceinline__ void operator()(const f32x4 (&acc)[2][2][4][2], const Unit& u, int wr, int wc, int fr, int fq) const {
        const int row0 = u.pm * BM + wr * 64 + fr, col0 = u.pn * BM + wc * 32 + 4 * fq;
#pragma unroll
        for (int ai = 0; ai < 2; ++ai)
#pragma unroll
            for (int m = 0; m < 4; ++m) { const size_t row = (size_t)(row0 + ai * HALF + m * 16);
#pragma unroll
                for (int bj = 0; bj < 2; ++bj)
#pragma unroll
                    for (int n = 0; n < 2; ++n) { const int col = col0 + bj * HALF + n * 16;
                        const u32x2 hw = *(const u32x2*)(h0 + row * D + col);
                        f32x4 hv; hv.x = bflo(hw.x); hv.y = bfhi(hw.x); hv.z = bflo(hw.y); hv.w = bfhi(hw.y);
                        *(f32x4*)(C + row * D + col) = hv * alpha + acc[ai][bj][m][n]; } }
    }
};
}
template <class Epi>
__device__ __forceinline__ void run_gemm(ldsp lds, const bf16_t* A, const bf16_t* Bt, int M, int N, int K, const Epi& E) {
    pg8::Gemm g; g.A = A; g.Bt = Bt; g.M = M; g.N = N; g.K = K;
    pg8::StaticOrder S; S.init(M, N, (int)gridDim.x, (int)blockIdx.x);
    pg8::gemm_phase<Epi, pg8::StaticOrder, false>(lds, g, S, E, nullptr);
}
constexpr int LD64 = 72, MATB = 64 * LD64 * 2, LDK = 104;
constexpr int O_AB = 0, O_RB = 1 * MATB, O_BH = 2 * MATB, O_KH = 3 * MATB, O_ABT = 4 * MATB, O_BTT = 5 * MATB, O_KTT = 6 * MATB, O_VT = 7 * MATB;
constexpr int O_M0 = 8 * MATB, O_M0T = 9 * MATB, O_M1 = 10 * MATB, O_M1T = 11 * MATB, O_PA = 12 * MATB, O_PB = 13 * MATB, O_MAK = 14 * MATB, O_MRB = 15 * MATB, O_MRK = 16 * MATB;
constexpr int O_ELEND = 17 * MATB, O_WT = O_ELEND + 256;
constexpr int O_WL = 8 * MATB, O_AL = O_WL + 64 * LDK * 2, O_Z = O_AL + 64 * LDK * 2, O_AZ = O_Z + 64 * 68 * 4;
static_assert(O_AZ + 64 * 68 * 4 <= O_ELEND, "lds");
static_assert(O_WT + 2048 <= LDS_BYTES - 16, "lds");

__device__ __forceinline__ bf16x8 ldsfrag(ldsp lds, int off, int ld, int row, int kofs) { return *(const LAS bf16x8*)(lds + off + (row * ld + kofs) * 2); }
__device__ __forceinline__ void st4(ldsp lds, int off, int row, int col, const f32x4 v) {
    u32x2 w; w.x = pk2(v.x, v.y); w.y = pk2(v.z, v.w); *(LAS u32x2*)(lds + off + (row * LD64 + col) * 2) = w; }
__device__ __forceinline__ void st1(ldsp lds, int off, int row, int col, float v) { *(LAS bf16_t*)(lds + off + (row * LD64 + col) * 2) = f2bf1(v); }

__device__ __forceinline__ float fast_rcp(float x) { return __builtin_amdgcn_rcpf(x); }
__device__ __forceinline__ float fast_sigmoid(float x) { return fast_rcp(1.0f + __expf(-x)); }
__device__ __forceinline__ float fast_tanh(float x) { return 1.0f - 2.0f * fast_rcp(1.0f + __expf(2.0f * x)); }
__device__ __forceinline__ u32x4 ld8(const bf16_t* p) { return p ? *(const u32x4*)p : (u32x4){0u, 0u, 0u, 0u}; }
__device__ __forceinline__ void shift8r(const u32x4 cw, const u32x4 pw, const float* mu, float* x) {
    float c[8], q[8]; unpack8(cw, c); unpack8(pw, q);
    const f32x4 m0 = *(const f32x4*)mu, m1 = *(const f32x4*)(mu + 4);
    const float mm[8] = {m0.x, m0.y, m0.z, m0.w, m1.x, m1.y, m1.z, m1.w};
#pragma unroll
    for (int i = 0; i < 8; ++i) x[i] = c[i] + (q[i] - c[i]) * mm[i];
}
__device__ __forceinline__ int tcol(int row, int col) { return ((((col >> 3) ^ (row >> 3)) & 7) << 3) | (col & 7); }
__device__ __forceinline__ bf16x8 ldsfragT(ldsp lds, int off, int row, int kofs) { return *(const LAS bf16x8*)(lds + off + (row * LD64 + tcol(row, kofs)) * 2); }
__device__ __forceinline__ void st1T(ldsp lds, int off, int row, int col, float v) { *(LAS bf16_t*)(lds + off + (row * LD64 + tcol(row, col)) * 2) = f2bf1(v); }
__device__ __forceinline__ void shift8(const bf16_t* pcur, const bf16_t* pprev, const float* mu, float* x) {
    float c[8], q[8];
    if (pcur) unpack8(*(const u32x4*)pcur, c); else {
#pragma unroll
        for (int i = 0; i < 8; ++i) c[i] = 0.f; }
    if (pprev) unpack8(*(const u32x4*)pprev, q); else {
#pragma unroll
        for (int i = 0; i < 8; ++i) q[i] = 0.f; }
    const f32x4 m0 = *(const f32x4*)mu, m1 = *(const f32x4*)(mu + 4);
    const float mm[8] = {m0.x, m0.y, m0.z, m0.w, m1.x, m1.y, m1.z, m1.w};
#pragma unroll
    for (int i = 0; i < 8; ++i) x[i] = c[i] + (q[i] - c[i]) * mm[i];
}

template <bool DO_P, bool DO_SQ>
__device__ __forceinline__ void dbl_step(ldsp lds, int sN, int sT, int dN, int dT, int pC, int pN, int tm, int tn0, int fr, int fq) {
    bf16x8 a[2];
#pragma unroll
    for (int ks = 0; ks < 2; ++ks) a[ks] = ldsfrag(lds, sT, LD64, 16 * tm + fr, ks * 32 + fq * 8);
#pragma unroll
    for (int t2 = 0; t2 < 2; ++t2) {
        const int nt = tn0 + t2, t = 16 * nt + fr, s0 = 16 * tm + 4 * fq;
        if (DO_P) {
            f32x4 acc = {0.f, 0.f, 0.f, 0.f};
#pragma unroll
            for (int ks = 0; ks < 2; ++ks) acc = mfma16(a[ks], ldsfrag(lds, pC, LD64, t, ks * 32 + fq * 8), acc);
            const u32x2 pw = *(const LAS u32x2*)(lds + pC + (t * LD64 + s0) * 2);
            acc.x += bflo(pw.x); acc.y += bfhi(pw.x); acc.z += bflo(pw.y); acc.w += bfhi(pw.y);
            st4(lds, pN, t, s0, acc);
        }
        if (DO_SQ) {
            f32x4 acc = {0.f, 0.f, 0.f, 0.f};
#pragma unroll
            for (int ks = 0; ks < 2; ++ks) acc = mfma16(a[ks], ldsfrag(lds, sN, LD64, t, ks * 32 + fq * 8), acc);
            st4(lds, dN, t, s0, acc);
            st1(lds, dT, s0 + 0, t, acc.x); st1(lds, dT, s0 + 1, t, acc.y); st1(lds, dT, s0 + 2, t, acc.z); st1(lds, dT, s0 + 3, t, acc.w);
        }
    }
}


#ifdef DBG_STAGE
constexpr size_t DBG_STRIDE = (size_t)NUNITS * 512 * 4;
__device__ __forceinline__ void dbgsum(const Params& P, ldsp lds, int u, int stage, const int* offs, int nmat) {
    unsigned acc = 0;
    for (int m = 0; m < nmat; ++m)
        for (int k = 0; k < 4; ++k) { const int idx = threadIdx.x + 512 * k, row = idx >> 5, cp = idx & 31; const unsigned x = *(const LAS unsigned*)(lds + offs[m] + row * (LD64 * 2) + cp * 4); acc += (x & 0xffffu) + (x >> 16); }
    ((unsigned*)(P.ws + WS_S0T + (size_t)stage * DBG_STRIDE))[(size_t)u * 512 + threadIdx.x] = acc;
}
#define DBGSUM(stage, ...) do { const int offs_[] = {__VA_ARGS__}; dbgsum(P, lds, u, stage, offs_, (int)(sizeof(offs_) / sizeof(int))); } while (0)
#else
#define DBGSUM(stage, ...) do { } while (0)
#endif
struct PL { u32x4 rc, rq, kc, kq, vc, vq, cw[3], pw[3]; bf16x8 aw[3], aa[3]; };
__device__ __forceinline__ const bf16_t* unit_rowp(const bf16_t* pp, int u, int tl, int col) {
    int r;
    if (u >= 4096) r = (tl >= 48) ? (ROW_META + tl - 48) : -1;
    else { const int bh = u >> 6, c = u & 63, b = bh >> 5; r = (tl >= 0 || c > 0) ? (b * SEQ + c * 64 + tl) : (ROW_META + 15); }
    return r < 0 ? (const bf16_t*)nullptr : pp + (size_t)r * NPAD + col;
}
__device__ __forceinline__ void pl_load(const Params& P, int u, PL& L) {
    int tid = threadIdx.x; asm volatile("" : "+v"(tid));
    const int lane = tid & 63, wave = tid >> 6, fr = lane & 15, fq = lane >> 4, tm = wave >> 1;
    const bf16_t* pp = (const bf16_t*)(P.ws + WS_P);
    const int h = (u >= 4096) ? (u - 4096) : ((u >> 6) & 31);
    const int t = tid >> 3, hj = h * 64 + 8 * (tid & 7);
    L.rc = ld8(unit_rowp(pp, u, t, C_R + hj)); L.rq = ld8(unit_rowp(pp, u, t - 1, C_R + hj));
    L.kc = ld8(unit_rowp(pp, u, t, C_K + hj)); L.kq = ld8(unit_rowp(pp, u, t - 1, C_K + hj));
    L.vc = ld8(unit_rowp(pp, u, t, C_V + hj)); L.vq = ld8(unit_rowp(pp, u, t - 1, C_V + hj));
#pragma unroll
    for (int it = 0; it < 3; ++it) { const int idx = tid + 512 * it, mat = idx / 768, rem = idx - mat * 768, tt = rem / 12, ch = rem - tt * 12, col = (mat ? C_AL : C_WL) + ch * 8;
        L.cw[it] = ld8(unit_rowp(pp, u, tt, col)); L.pw[it] = ld8(unit_rowp(pp, u, tt - 1, col)); }
    const bf16_t* ww2 = (const bf16_t*)(P.ws + WS_WTW2) + (size_t)(h * 64 + 16 * tm + fr) * 96 + fq * 8;
    const bf16_t* wa2 = (const bf16_t*)(P.ws + WS_WTA2) + (size_t)(h * 64 + 16 * tm + fr) * 96 + fq * 8;
#pragma unroll
    for (int ks = 0; ks < 3; ++ks) { L.aw[ks] = *(const bf16x8*)(ww2 + ks * 32); L.aa[ks] = *(const bf16x8*)(wa2 + ks * 32); }
}
__device__ __forceinline__ void rwkv_unit(const Params& P, ldsp lds, int u, PL& L, int next_u) {
    int tid = threadIdx.x; asm volatile("" : "+v"(tid));
    const int lane = tid & 63, wave = tid >> 6, fr = lane & 15, fq = lane >> 4, tm = wave >> 1, tn0 = (wave & 1) * 2;
    unsigned char* ws = P.ws;
    const bf16_t* pp = (const bf16_t*)(ws + WS_P);
    const bool meta = u >= 4096;
    int b = 0, h, c = 0;
    if (meta) { h = u - 4096; } else { const int bh = u >> 6; c = u & 63; b = bh >> 5; h = bh & 31; }
    auto rowof = [&](int tl) -> int {
        if (meta) return (tl >= 48) ? (ROW_META + tl - 48) : -1;
        if (tl >= 0 || c > 0) return b * SEQ + c * 64 + tl;
        return ROW_META + 15;
    };
    auto rowp = [&](int tl, int col) -> const bf16_t* { const int r = rowof(tl); return r < 0 ? (const bf16_t*)nullptr : pp + (size_t)r * NPAD + col; };
    const float* mu = P.in[I_MU];
#ifndef RPT_AD
#define RPT_AD 1
#define RPT_E12 1
#define RPT_E35 1
#endif
    float lw[8], av[8], rv[8], kv[8], vv[8], kk[8], km[8];
    const int t = tid >> 3, jq = tid & 7, j0 = 8 * jq, hj = h * 64 + j0;
    const bool nulltok = meta && t < 48;
    for (int rpt_ = 0; rpt_ < RPT_AD; ++rpt_) {
    {
#pragma unroll
        for (int it = 0; it < 3; ++it) { const int idx = tid + 512 * it, mat = idx / 768, rem = idx - mat * 768, tt = rem / 12, ch = rem - tt * 12, col = (mat ? C_AL : C_WL) + ch * 8;
            float x[8]; shift8r(L.cw[it], L.pw[it], mu + col, x);
            if (mat == 0) {
#pragma unroll
                for (int i = 0; i < 8; ++i) x[i] = fast_tanh(x[i]);
            }
            *(LAS u32x4*)(lds + (mat ? O_AL : O_WL) + (tt * LDK + ch * 8) * 2) = pack8(x); }
    }
    BLOCK_SYNC();
    {
        f32x4 z[2] = {{0.f, 0.f, 0.f, 0.f}, {0.f, 0.f, 0.f, 0.f}}, az[2] = {{0.f, 0.f, 0.f, 0.f}, {0.f, 0.f, 0.f, 0.f}};
#pragma unroll
        for (int ks = 0; ks < 3; ++ks) {
            const bf16x8 aw = L.aw[ks], aa = L.aa[ks];
#pragma unroll
            for (int t2 = 0; t2 < 2; ++t2) {
                const int t = 16 * (tn0 + t2) + fr;
                z[t2] = mfma16(aw, ldsfrag(lds, O_WL, LDK, t, ks * 32 + fq * 8), z[t2]);
                az[t2] = mfma16(aa, ldsfrag(lds, O_AL, LDK, t, ks * 32 + fq * 8), az[t2]);
            }
        }
#pragma unroll
        for (int t2 = 0; t2 < 2; ++t2) {
            const int t = 16 * (tn0 + t2) + fr, j0 = 16 * tm + 4 * fq;
            *(LAS f32x4*)(lds + O_Z + (t * 68 + j0) * 4) = z[t2];
            *(LAS f32x4*)(lds + O_AZ + (t * 68 + j0) * 4) = az[t2];
        }
    }
    BLOCK_SYNC();
    float cs[8];
    {
        const f32x4 z0 = *(const LAS f32x4*)(lds + O_Z + (t * 68 + j0) * 4), z1 = *(const LAS f32x4*)(lds + O_Z + (t * 68 + j0 + 4) * 4);
        const f32x4 y0 = *(const LAS f32x4*)(lds + O_AZ + (t * 68 + j0) * 4), y1 = *(const LAS f32x4*)(lds + O_AZ + (t * 68 + j0 + 4) * 4);
        const float zz[8] = {z0.x, z0.y, z0.z, z0.w, z1.x, z1.y, z1.z, z1.w}, yy[8] = {y0.x, y0.y, y0.z, y0.w, y1.x, y1.y, y1.z, y1.w};
        const f32x4 w0a = *(const f32x4*)(P.in[I_W0] + hj), w0b = *(const f32x4*)(P.in[I_W0] + hj + 4), a0a = *(const f32x4*)(P.in[I_A0] + hj), a0b = *(const f32x4*)(P.in[I_A0] + hj + 4);
        const float w0[8] = {w0a.x, w0a.y, w0a.z, w0a.w, w0b.x, w0b.y, w0b.z, w0b.w}, a0[8] = {a0a.x, a0a.y, a0a.z, a0a.w, a0b.x, a0b.y, a0b.z, a0b.w};
#pragma unroll
        for (int i = 0; i < 8; ++i) { lw[i] = nulltok ? 0.f : -DSCALE * fast_sigmoid(w0[i] + zz[i]); av[i] = fast_sigmoid(a0[i] + yy[i]); cs[i] = lw[i]; }
#pragma unroll
        for (int d = 8; d < 64; d <<= 1) {
#pragma unroll
            for (int i = 0; i < 8; ++i) { const float o = __shfl_up(cs[i], d); cs[i] += (lane >= d) ? o : 0.f; }
        }
        if (lane >= 56) { *(LAS f32x4*)(lds + O_WT + (wave * 64 + j0) * 4) = (f32x4){cs[0], cs[1], cs[2], cs[3]}; *(LAS f32x4*)(lds + O_WT + (wave * 64 + j0 + 4) * 4) = (f32x4){cs[4], cs[5], cs[6], cs[7]}; }
        shift8r(L.rc, L.rq, mu + C_R + hj, rv); shift8r(L.kc, L.kq, mu + C_K + hj, kv); shift8r(L.vc, L.vq, mu + C_V + hj, vv);
        if (nulltok) {
#pragma unroll
            for (int i = 0; i < 8; ++i) { rv[i] = 0.f; kv[i] = 0.f; vv[i] = 0.f; }
        }
        const f32x4 kka = *(const f32x4*)(P.in[I_KK] + hj), kkb = *(const f32x4*)(P.in[I_KK] + hj + 4), kaa = *(const f32x4*)(P.in[I_KA] + hj), kab = *(const f32x4*)(P.in[I_KA] + hj + 4);
        const f32x4 rka = *(const f32x4*)(P.in[I_RK] + hj), rkb = *(const f32x4*)(P.in[I_RK] + hj + 4);
        const float kkw[8] = {kka.x, kka.y, kka.z, kka.w, kkb.x, kkb.y, kkb.z, kkb.w}, kaw[8] = {kaa.x, kaa.y, kaa.z, kaa.w, kab.x, kab.y, kab.z, kab.w}, rkw[8] = {rka.x, rka.y, rka.z, rka.w, rkb.x, rkb.y, rkb.z, rkb.w};
        float n2 = 0.f, bon = 0.f;
#pragma unroll
        for (int i = 0; i < 8; ++i) { kk[i] = kv[i] * kkw[i]; n2 += kk[i] * kk[i]; km[i] = kv[i] * (1.0f + (av[i] - 1.0f) * kaw[i]); bon += rv[i] * km[i] * rkw[i]; }
        n2 += DPPF(n2, 0xB1); n2 += DPPF(n2, 0x4E); n2 += DPPF(n2, 0x141);
        bon += DPPF(bon, 0xB1); bon += DPPF(bon, 0x4E); bon += DPPF(bon, 0x141);
        const float inv = 1.0f / fmaxf(sqrtf(n2), 1e-12f);
#pragma unroll
        for (int i = 0; i < 8; ++i) kk[i] *= inv;
        if (!meta && jq == 0) ((float*)(ws + WS_BONUS))[(size_t)(b * SEQ + c * 64 + t) * 32 + h] = bon;
    }
    BLOCK_SYNC();
    {
        float Lc[8], Le[8];
#pragma unroll
        for (int i = 0; i < 8; ++i) { Lc[i] = cs[i]; Le[i] = 0.f; }
#pragma unroll
        for (int w = 0; w < 8; ++w) {
            const f32x4 x0 = *(const LAS f32x4*)(lds + O_WT + (w * 64 + j0) * 4), x1 = *(const LAS f32x4*)(lds + O_WT + (w * 64 + j0 + 4) * 4);
            const float xx[8] = {x0.x, x0.y, x0.z, x0.w, x1.x, x1.y, x1.z, x1.w};
            const float msk = w < wave ? 1.0f : 0.0f;
#pragma unroll
            for (int i = 0; i < 8; ++i) { Le[i] += xx[i]; Lc[i] += msk * xx[i]; }
        }
        float Ab[8], Rb[8], Bh[8], Kh[8], Bt[8], Kt[8];
#pragma unroll
        for (int i = 0; i < 8; ++i) {
            const float eP = __expf(Lc[i] - lw[i]), eC = __expf(Lc[i]), eN = __expf(-Lc[i]), eE = __expf(Le[i] - Lc[i]);
            const float ka = kk[i] * av[i];
            Ab[i] = -kk[i] * eP; Rb[i] = rv[i] * eC; Bh[i] = ka * eN; Kh[i] = km[i] * eN; Bt[i] = ka * eE; Kt[i] = km[i] * eE;
        }
        *(LAS u32x4*)(lds + O_AB + (t * LD64 + j0) * 2) = pack8(Ab);
        *(LAS u32x4*)(lds + O_RB + (t * LD64 + j0) * 2) = pack8(Rb);
        *(LAS u32x4*)(lds + O_BH + (t * LD64 + j0) * 2) = pack8(Bh);
        *(LAS u32x4*)(lds + O_KH + (t * LD64 + j0) * 2) = pack8(Kh);
#pragma unroll
        for (int i = 0; i < 8; ++i) { st1T(lds, O_ABT, j0 + i, t, Ab[i]); st1T(lds, O_BTT, j0 + i, t, Bt[i]); st1T(lds, O_KTT, j0 + i, t, Kt[i]); st1T(lds, O_VT, j0 + i, t, vv[i]); }
        if (t == 63) {
#pragma unroll
            for (int i = 0; i < 8; ++i) *(LAS float*)(lds + O_ELEND + (j0 + i) * 4) = __expf(Le[i]);
        }
    }
    BLOCK_SYNC();
    }
    if (next_u >= 0) pl_load(P, next_u, L);
    DBGSUM(0, O_AB, O_RB, O_BH, O_KH, O_ABT, O_BTT, O_KTT, O_VT);
    for (int rpt_ = 0; rpt_ < RPT_E12; ++rpt_) {
    {
        bf16x8 abh[2], akh[2];
#pragma unroll
        for (int ks = 0; ks < 2; ++ks) { abh[ks] = ldsfrag(lds, O_BH, LD64, 16 * tm + fr, ks * 32 + fq * 8); akh[ks] = ldsfrag(lds, O_KH, LD64, 16 * tm + fr, ks * 32 + fq * 8); }
#pragma unroll
        for (int t2 = 0; t2 < 2; ++t2) {
            const int tt = 16 * (tn0 + t2) + fr, s0 = 16 * tm + 4 * fq;
            f32x4 mab = {0.f, 0.f, 0.f, 0.f}, mak = mab, mrb = mab, mrk = mab;
#pragma unroll
            for (int ks = 0; ks < 2; ++ks) {
                const bf16x8 bab = ldsfrag(lds, O_AB, LD64, tt, ks * 32 + fq * 8), brb = ldsfrag(lds, O_RB, LD64, tt, ks * 32 + fq * 8);
                mab = mfma16(abh[ks], bab, mab); mak = mfma16(akh[ks], bab, mak); mrb = mfma16(abh[ks], brb, mrb); mrk = mfma16(akh[ks], brb, mrk);
            }
            float vab[4] = {mab.x, mab.y, mab.z, mab.w}, vak[4] = {mak.x, mak.y, mak.z, mak.w}, vrb[4] = {mrb.x, mrb.y, mrb.z, mrb.w}, vrk[4] = {mrk.x, mrk.y, mrk.z, mrk.w}, vp[4];
#pragma unroll
            for (int r = 0; r < 4; ++r) { const int s = s0 + r; const bool st = s < tt, le = s <= tt;
                vab[r] = st ? vab[r] : 0.f; vak[r] = st ? vak[r] : 0.f; vrb[r] = le ? vrb[r] : 0.f; vrk[r] = le ? vrk[r] : 0.f; vp[r] = vab[r] + (s == tt ? 1.0f : 0.f); }
            st4(lds, O_M0, tt, s0, (f32x4){vab[0], vab[1], vab[2], vab[3]});
#pragma unroll
            for (int r = 0; r < 4; ++r) st1(lds, O_M0T, s0 + r, tt, vab[r]);
            st4(lds, O_PA, tt, s0, (f32x4){vp[0], vp[1], vp[2], vp[3]});
            st4(lds, O_MAK, tt, s0, (f32x4){vak[0], vak[1], vak[2], vak[3]});
            st4(lds, O_MRB, tt, s0, (f32x4){vrb[0], vrb[1], vrb[2], vrb[3]});
            st4(lds, O_MRK, tt, s0, (f32x4){vrk[0], vrk[1], vrk[2], vrk[3]});
        }
    }
    BLOCK_SYNC();
    DBGSUM(1, O_M0, O_M0T, O_PA, O_MAK, O_MRB, O_MRK);
    dbl_step<false, true>(lds, O_M0, O_M0T, O_M1, O_M1T, 0, 0, tm, tn0, fr, fq); BLOCK_SYNC();
    dbl_step<true, true>(lds, O_M1, O_M1T, O_M0, O_M0T, O_PA, O_PB, tm, tn0, fr, fq); BLOCK_SYNC();
    dbl_step<true, true>(lds, O_M0, O_M0T, O_M1, O_M1T, O_PB, O_PA, tm, tn0, fr, fq); BLOCK_SYNC();
    dbl_step<true, true>(lds, O_M1, O_M1T, O_M0, O_M0T, O_PA, O_PB, tm, tn0, fr, fq); BLOCK_SYNC();
    dbl_step<true, true>(lds, O_M0, O_M0T, O_M1, O_M1T, O_PB, O_PA, tm, tn0, fr, fq); BLOCK_SYNC();
    dbl_step<true, false>(lds, O_M1, O_M1T, 0, 0, O_PA, O_PB, tm, tn0, fr, fq); BLOCK_SYNC();
    }
    DBGSUM(2, O_PB);
    const size_t ub = (size_t)u * 4096;
    for (int rpt_ = 0; rpt_ < RPT_E35; ++rpt_) {
    {
        bf16x8 aT[2], aMak[2];
#pragma unroll
        for (int ks = 0; ks < 2; ++ks) { aT[ks] = ldsfrag(lds, O_PB, LD64, 16 * tm + fr, ks * 32 + fq * 8); aMak[ks] = ldsfrag(lds, O_MAK, LD64, 16 * tm + fr, ks * 32 + fq * 8); }
#pragma unroll
        for (int t2 = 0; t2 < 2; ++t2) {
            const int n = 16 * (tn0 + t2) + fr, t0 = 16 * tm + 4 * fq;
            f32x4 at = {0.f, 0.f, 0.f, 0.f}, xt = at;
#pragma unroll
            for (int ks = 0; ks < 2; ++ks) { at = mfma16(aT[ks], ldsfragT(lds, O_ABT, n, ks * 32 + fq * 8), at); xt = mfma16(aMak[ks], ldsfragT(lds, O_VT, n, ks * 32 + fq * 8), xt); }
            st4(lds, O_M0, n, t0, at); st4(lds, O_M0T, n, t0, xt);
        }
    }
    BLOCK_SYNC();
    DBGSUM(3, O_M0, O_M0T);
    {
        bf16x8 aT[2], aAt[2];
#pragma unroll
        for (int ks = 0; ks < 2; ++ks) { aT[ks] = ldsfrag(lds, O_PB, LD64, 16 * tm + fr, ks * 32 + fq * 8); aAt[ks] = ldsfrag(lds, O_M0, LD64, 16 * tm + fr, ks * 32 + fq * 8); }
        bf16_t* Rt = (bf16_t*)(ws + WS_RT) + ub; bf16_t* Gp = (bf16_t*)(ws + WS_G) + ub;
#pragma unroll
        for (int t2 = 0; t2 < 2; ++t2) {
            const int n = 16 * (tn0 + t2) + fr, m0 = 16 * tm + 4 * fq;
            f32x4 u0 = {0.f, 0.f, 0.f, 0.f}, rt = u0, g = u0;
#pragma unroll
            for (int ks = 0; ks < 2; ++ks) {
                u0 = mfma16(aT[ks], ldsfrag(lds, O_M0T, LD64, n, ks * 32 + fq * 8), u0);
                rt = mfma16(aAt[ks], ldsfrag(lds, O_MRB, LD64, n, ks * 32 + fq * 8), rt);
                g = mfma16(aAt[ks], ldsfragT(lds, O_BTT, n, ks * 32 + fq * 8), g);
            }
            st4(lds, O_M1, n, m0, u0);
            const u32x2 rw = *(const LAS u32x2*)(lds + O_RB + (n * LD64 + m0) * 2);
            rt.x += bflo(rw.x); rt.y += bfhi(rw.x); rt.z += bflo(rw.y); rt.w += bfhi(rw.y);
            { u32x2 w; w.x = pk2(rt.x, rt.y); w.y = pk2(rt.z, rt.w); *(u32x2*)(Rt + n * 64 + m0) = w; }
            if ((n >> 2) == (m0 >> 2)) { const float e = *(const LAS float*)(lds + O_ELEND + n * 4); const int r = n & 3;
                g.x += (r == 0) ? e : 0.f; g.y += (r == 1) ? e : 0.f; g.z += (r == 2) ? e : 0.f; g.w += (r == 3) ? e : 0.f; }
            { const int pos0 = 32 * (tm >> 1) + 8 * fq + 4 * (tm & 1); u32x2 w; w.x = pk2(g.x, g.y); w.y = pk2(g.z, g.w); *(u32x2*)(Gp + n * 64 + pos0) = w; }
        }
    }
    BLOCK_SYNC();
    DBGSUM(4, O_M1);
    {
        bf16x8 aB[2], aK[2], aU[2], aV[2];
#pragma unroll
        for (int ks = 0; ks < 2; ++ks) { const int row = 16 * tm + fr, ko = ks * 32 + fq * 8;
            aB[ks] = ldsfragT(lds, O_BTT, row, ko); aK[ks] = ldsfragT(lds, O_KTT, row, ko); aU[ks] = ldsfrag(lds, O_M1, LD64, row, ko); aV[ks] = ldsfragT(lds, O_VT, row, ko); }
        bf16_t* H0t = (bf16_t*)(ws + WS_H0T) + ub; bf16_t* Y0s = (bf16_t*)(ws + WS_Y0) + ub;
#pragma unroll
        for (int t2 = 0; t2 < 2; ++t2) {
            const int n = 16 * (tn0 + t2) + fr, m0 = 16 * tm + 4 * fq;
            f32x4 hh = {0.f, 0.f, 0.f, 0.f}, yy = hh;
#pragma unroll
            for (int ks = 0; ks < 2; ++ks) { const int ko = ks * 32 + fq * 8;
                const bf16x8 bU = ldsfrag(lds, O_M1, LD64, n, ko), bV = ldsfragT(lds, O_VT, n, ko), bRb = ldsfrag(lds, O_MRB, LD64, n, ko), bRk = ldsfrag(lds, O_MRK, LD64, n, ko);
                hh = mfma16(aB[ks], bU, hh); hh = mfma16(aK[ks], bV, hh);
                yy = mfma16(aU[ks], bRb, yy); yy = mfma16(aV[ks], bRk, yy); }
            { u32x2 w; w.x = pk2(hh.x, hh.y); w.y = pk2(hh.z, hh.w); *(u32x2*)(H0t + n * 64 + m0) = w; }
            { u32x2 w; w.x = pk2(yy.x, yy.y); w.y = pk2(yy.z, yy.w); *(u32x2*)(Y0s + n * 64 + m0) = w; }
        }
    }
    BLOCK_SYNC();
    }
}

constexpr int LDU = 264;
__device__ __forceinline__ void pool_unit(const Params& P, ldsp lds, int pu) {
    int tid = threadIdx.x; asm volatile("" : "+v"(tid));
    const int lane = tid & 63, wave = tid >> 6, fr = lane & 15, fq = lane >> 4;
    unsigned char* ws = P.ws;
    const bf16_t* pp = (const bf16_t*)(ws + WS_P);
    const int g = pu & 3, tt = pu >> 2, b = tt >> 6, ti0 = (tt & 63) * 64;
    constexpr int O_U = 0, O_PL = 79 * LDU * 2;
    for (int idx = tid; idx < 79 * 32; idx += 512) {
        const int lr = idx >> 5, ch = idx & 31, ti = ti0 + lr - 15;
        const int row = ti >= 0 ? b * SEQ + ti : ROW_META + 16 + ti;
        *(LAS u32x4*)(lds + O_U + (lr * LDU + ch * 8) * 2) = *(const u32x4*)(pp + (size_t)row * NPAD + C_POOL + g * 256 + ch * 8);
    }
    BLOCK_SYNC();
    {
        const int t = tid >> 3, cq = tid & 7, win = 2 << g; const float inv = 1.0f / (float)win;
#pragma unroll
        for (int cc = 0; cc < 4; ++cc) {
            const int c0 = cq * 32 + cc * 8; float s[8], own[8];
            unpack8(*(const LAS u32x4*)(lds + O_U + ((15 + t) * LDU + c0) * 2), own);
#pragma unroll
            for (int i = 0; i < 8; ++i) s[i] = own[i];
            for (int d = 1; d < win; ++d) { float x[8]; unpack8(*(const LAS u32x4*)(lds + O_U + ((15 + t - d) * LDU + c0) * 2), x);
#pragma unroll
                for (int i = 0; i < 8; ++i) s[i] += x[i]; }
#pragma unroll
            for (int i = 0; i < 8; ++i) s[i] = s[i] * inv - own[i];
            *(LAS u32x4*)(lds + O_PL + (t * LDU + c0) * 2) = pack8(s);
        }
    }
    BLOCK_SYNC();
    {
        const bf16_t* wt = (const bf16_t*)(ws + WS_WTPOOL) + (size_t)g * 65536;
        f32x4 acc[2][4];
#pragma unroll
        for (int a = 0; a < 2; ++a)
#pragma unroll
            for (int n = 0; n < 4; ++n) acc[a][n] = (f32x4){0.f, 0.f, 0.f, 0.f};
#pragma unroll 4
        for (int ks = 0; ks < 8; ++ks) {
            bf16x8 af[2];
#pragma unroll
            for (int a = 0; a < 2; ++a) af[a] = *(const bf16x8*)(wt + (size_t)(32 * wave + 16 * a + fr) * 256 + ks * 32 + fq * 8);
#pragma unroll
            for (int n = 0; n < 4; ++n) { const bf16x8 bf = ldsfrag(lds, O_PL, LDU, 16 * n + fr, ks * 32 + fq * 8);
#pragma unroll
                for (int a = 0; a < 2; ++a) acc[a][n] = mfma16(af[a], bf, acc[a][n]); }
        }
        bf16_t* yb = (bf16_t*)(ws + WS_YB);
        const float* psc = P.in[I_PSCALE] + g * 256;
#pragma unroll
        for (int a = 0; a < 2; ++a) { const int d0 = 32 * wave + 16 * a + 4 * fq; const f32x4 sc = *(const f32x4*)(psc + d0);
#pragma unroll
            for (int n = 0; n < 4; ++n) { const int t = 16 * n + fr; const f32x4 o = acc[a][n] * sc;
                u32x2 w; w.x = pk2(o.x, o.y); w.y = pk2(o.z, o.w);
                *(u32x2*)(yb + (size_t)(b * SEQ + ti0 + t) * 1024 + g * 256 + d0) = w; } }
    }
    BLOCK_SYNC();
}
__device__ __forceinline__ void phase2(const Params& P, ldsp lds) {
    PL L;
    if ((int)blockIdx.x < NUNITS) pl_load(P, blockIdx.x, L);
    for (int u = blockIdx.x; u < NUNITS + 512; u += gridDim.x) {
        if (u < NUNITS) { const int nu = u + (int)gridDim.x; rwkv_unit(P, lds, u, L, nu < NUNITS ? nu : -1); } else pool_unit(P, lds, u - NUNITS);
    }
}
__device__ __forceinline__ void phase3(const Params& P) {
    const int lane = threadIdx.x & 63, wave = threadIdx.x >> 6, fr = lane & 15, fq = lane >> 4;
    if (wave != 0) return;
    unsigned char* ws = P.ws;
    const bf16_t* Gp = (const bf16_t*)(ws + WS_G); const bf16_t* H0t = (const bf16_t*)(ws + WS_H0T); bf16_t* S0t = (bf16_t*)(ws + WS_S0T);
    for (int item = blockIdx.x; item < 256; item += gridDim.x) {
        const int bh = item >> 2, vq = item & 3, h = bh & 31;
        bf16x8 Sb[2];
#pragma unroll
        for (int ks = 0; ks < 2; ++ks)
#pragma unroll
            for (int i = 0; i < 8; ++i) Sb[ks][i] = 0;
        bf16x8 gA[4][2]; u32x2 hF[4];
        auto load = [&](int step, bf16x8 (&ga)[4][2], u32x2 (&hf)[4]) {
            const int u = (step == 0) ? (4096 + h) : (bh * 64 + step - 1);
            const bf16_t* g = Gp + (size_t)u * 4096; const bf16_t* hh = H0t + (size_t)u * 4096;
#pragma unroll
            for (int mt = 0; mt < 4; ++mt) {
#pragma unroll
                for (int ks = 0; ks < 2; ++ks) ga[mt][ks] = *(const bf16x8*)(g + (16 * mt + fr) * 64 + ks * 32 + fq * 8);
                hf[mt] = *(const u32x2*)(hh + (16 * vq + fr) * 64 + 16 * mt + 4 * fq);
            }
        };
        load(0, gA, hF);
        for (int step = 0; step < 64; ++step) {
            bf16x8 gN[4][2]; u32x2 hN[4];
            if (step + 1 < 64) load(step + 1, gN, hN);
            f32x4 acc[4];
#pragma unroll
            for (int mt = 0; mt < 4; ++mt) {
                acc[mt] = (f32x4){bflo(hF[mt].x), bfhi(hF[mt].x), bflo(hF[mt].y), bfhi(hF[mt].y)};
                acc[mt] = mfma16(gA[mt][0], Sb[0], acc[mt]);
                acc[mt] = mfma16(gA[mt][1], Sb[1], acc[mt]);
            }
            bf16_t* so = S0t + (size_t)(bh * 64 + step) * 4096 + (16 * vq + fr) * 64 + 4 * fq;
            u32x2 w[4];
#pragma unroll
            for (int mt = 0; mt < 4; ++mt) { w[mt].x = pk2(acc[mt].x, acc[mt].y); w[mt].y = pk2(acc[mt].z, acc[mt].w); *(u32x2*)(so + 16 * mt) = w[mt]; }
#pragma unroll
            for (int ks = 0; ks < 2; ++ks) {
                const u32x4 q = (u32x4){w[2 * ks].x, w[2 * ks].y, w[2 * ks + 1].x, w[2 * ks + 1].y};
                Sb[ks] = __builtin_bit_cast(bf16x8, q);
            }
            if (step + 1 < 64) {
#pragma unroll
                for (int mt = 0; mt < 4; ++mt) { gA[mt][0] = gN[mt][0]; gA[mt][1] = gN[mt][1]; hF[mt] = hN[mt]; }
            }
        }
    }
}

constexpr int LDG = 264;
__device__ __forceinline__ void phase3b(const Params& P, ldsp lds) {
    const int tid = threadIdx.x, lane = tid & 63, wave = tid >> 6, fr = lane & 15, fq = lane >> 4, wq = wave & 3;
    unsigned char* ws = P.ws;
    const bf16_t* pp = (const bf16_t*)(ws + WS_P);
    const float* mu = P.in[I_MU];
    ldsp gl = lds + wave * (16 * LDG * 2);
    for (int pair = blockIdx.x; pair < 2048; pair += gridDim.x) {
        const int u = pair * 2 + (wave >> 2), bh = u >> 6, c = u & 63, b = bh >> 5, h = bh & 31;
        const int trow0 = b * SEQ + c * 64 + 16 * wq;
#pragma unroll
        for (int it = 0; it < 8; ++it) {
            const int idx = it * 64 + lane, tl = idx >> 5, ch = idx & 31, col = C_GL + ch * 8;
            const int row = trow0 + tl; const int prow = (c == 0 && wq == 0 && tl == 0) ? (ROW_META + 15) : row - 1;
            float x[8]; shift8(pp + (size_t)row * NPAD + col, pp + (size_t)prow * NPAD + col, mu + col, x);
#pragma unroll
            for (int i = 0; i < 8; ++i) x[i] = sigmoidf_(x[i]);
            *(LAS u32x4*)(gl + (tl * LDG + ch * 8) * 2) = pack8(x);
        }
        BLOCK_SYNC();
        f32x4 gacc[4];
#pragma unroll
        for (int mt = 0; mt < 4; ++mt) gacc[mt] = (f32x4){0.f, 0.f, 0.f, 0.f};
        {
            const bf16_t* wg = (const bf16_t*)(ws + WS_WTG2) + (size_t)(h * 64 + fr) * 256 + fq * 8;
#pragma unroll 2
            for (int ks = 0; ks < 8; ++ks) {
                const bf16x8 bf = *(const LAS bf16x8*)(gl + (fr * LDG + ks * 32 + fq * 8) * 2);
#pragma unroll
                for (int mt = 0; mt < 4; ++mt) gacc[mt] = mfma16(*(const bf16x8*)(wg + (size_t)(16 * mt) * 256 + ks * 32), bf, gacc[mt]);
            }
        }
        f32x4 y[4];
        {
            const size_t ub = (size_t)u * 4096;
            const bf16_t* S0t = (const bf16_t*)(ws + WS_S0T) + ub; const bf16_t* Rt = (const bf16_t*)(ws + WS_RT) + ub; const bf16_t* Y0s = (const bf16_t*)(ws + WS_Y0) + ub;
            bf16x8 bR[2];
#pragma unroll
            for (int ks = 0; ks < 2; ++ks) bR[ks] = *(const bf16x8*)(Rt + (16 * wq + fr) * 64 + ks * 32 + fq * 8);
#pragma unroll
            for (int mt = 0; mt < 4; ++mt) {
                const u32x2 yw = *(const u32x2*)(Y0s + (16 * wq + fr) * 64 + 16 * mt + 4 * fq);
                y[mt] = (f32x4){bflo(yw.x), bfhi(yw.x), bflo(yw.y), bfhi(yw.y)};
#pragma unroll
                for (int ks = 0; ks < 2; ++ks) y[mt] = mfma16(*(const bf16x8*)(S0t + (16 * mt + fr) * 64 + ks * 32 + fq * 8), bR[ks], y[mt]);
            }
        }
        float s = 0.f;
#pragma unroll
        for (int mt = 0; mt < 4; ++mt) s += (y[mt].x + y[mt].y) + (y[mt].z + y[mt].w);
        s += __shfl_xor(s, 16); s += __shfl_xor(s, 32);
        const float mean = s * (1.0f / 64.0f); float q = 0.f;
#pragma unroll
        for (int mt = 0; mt < 4; ++mt) { y[mt] = y[mt] - mean; q += (y[mt].x * y[mt].x + y[mt].y * y[mt].y) + (y[mt].z * y[mt].z + y[mt].w * y[mt].w); }
        q += __shfl_xor(q, 16); q += __shfl_xor(q, 32);
        const float rstd = 1.0f / sqrtf(q * (1.0f / 64.0f) + GN_EPS);
        const int row = trow0 + fr; const int prow = (c == 0 && wq == 0 && fr == 0) ? (ROW_META + 15) : row - 1;
        const float bon = ((const float*)(ws + WS_BONUS))[(size_t)row * 32 + h];
        bf16_t* ya = (bf16_t*)(ws + WS_YA) + (size_t)row * D + h * 64;
#pragma unroll
        for (int mt = 0; mt < 4; ++mt) {
            const int i0 = 16 * mt + 4 * fq, hc = h * 64 + i0;
            const f32x4 gg = *(const f32x4*)(P.in[I_GNG] + hc), gb = *(const f32x4*)(P.in[I_GNB] + hc), mv = *(const f32x4*)(mu + C_V + hc);
            const u32x2 vc = *(const u32x2*)(pp + (size_t)row * NPAD + C_V + hc), vp = *(const u32x2*)(pp + (size_t)prow * NPAD + C_V + hc);
            f32x4 cv = (f32x4){bflo(vc.x), bfhi(vc.x), bflo(vc.y), bfhi(vc.y)}, pv = (f32x4){bflo(vp.x), bfhi(vp.x), bflo(vp.y), bfhi(vp.y)};
            const f32x4 v = cv + (pv - cv) * mv;
            const f32x4 o = (y[mt] * rstd * gg + gb + v * bon) * gacc[mt];
            u32x2 w; w.x = pk2(o.x, o.y); w.y = pk2(o.z, o.w);
            *(u32x2*)(ya + i0) = w;
        }
        BLOCK_SYNC();
    }
}
__device__ __forceinline__ float gelu_exact(float x) { return 0.5f * x * (1.0f + erff(x * 0.70710678118654752f)); }
__device__ __forceinline__ float dot16_fp8(const u32x4 w, const float* x) {
    float s0 = 0.f, s1 = 0.f;
    const int ww[4] = {(int)w.x, (int)w.y, (int)w.z, (int)w.w};
#pragma unroll
    for (int q = 0; q < 4; ++q) { const f32x2 lo = __builtin_amdgcn_cvt_pk_f32_fp8(ww[q], false), hi = __builtin_amdgcn_cvt_pk_f32_fp8(ww[q], true);
        s0 += lo.x * x[4 * q] + hi.x * x[4 * q + 2]; s1 += lo.y * x[4 * q + 1] + hi.y * x[4 * q + 3]; }
    return s0 + s1;
}
__device__ __forceinline__ void axpy16_fp8(const u32x4 w, float a, float* o) {
    const int ww[4] = {(int)w.x, (int)w.y, (int)w.z, (int)w.w};
#pragma unroll
    for (int q = 0; q < 4; ++q) { const f32x2 lo = __builtin_amdgcn_cvt_pk_f32_fp8(ww[q], false), hi = __builtin_amdgcn_cvt_pk_f32_fp8(ww[q], true);
        o[4 * q] += a * lo.x; o[4 * q + 1] += a * lo.y; o[4 * q + 2] += a * hi.x; o[4 * q + 3] += a * hi.y; }
}
__device__ __forceinline__ void peer_token(const Params& P, int tok, const LAS int* eidx, const LAS float* gts) {
    const int lane = threadIdx.x & 63;
    unsigned char* ws = P.ws;
    const unsigned char* Ub = ws + WS_UB; const unsigned char* Vb = ws + WS_VB;
    const float* tsc = (const float*)(ws + WS_TSC);
    {
        int lo16 = lane * 16; asm volatile("" : "+v"(lo16));
        float x[32], o[32];
        {
            const bf16_t* hr = (const bf16_t*)(ws + WS_H1B) + (size_t)tok * D + lo16;
#pragma unroll
            for (int i = 0; i < 2; ++i) { unpack8(*(const u32x4*)(hr + 1024 * i), x + 16 * i); unpack8(*(const u32x4*)(hr + 1024 * i + 8), x + 16 * i + 8); }
#pragma unroll
            for (int i = 0; i < 32; ++i) o[i] = 0.f;
        }
        const int e_lo = eidx[lane], e_hi = eidx[64 + lane];
        const float su_lo = tsc[e_lo], su_hi = tsc[e_hi];
        const float gv_lo = gts[lane] * tsc[16384 + e_lo], gv_hi = gts[64 + lane] * tsc[16384 + e_hi];
        u32x4 ua[2][2], va[2][2], ub[2][2], vb[2][2];
        auto issue = [&](int g, u32x4 (&uu)[2][2], u32x4 (&vv)[2][2]) {
            const int ev = (g < 32) ? e_lo : e_hi;
#pragma unroll
            for (int j = 0; j < 2; ++j) {
                const int e = __builtin_amdgcn_readlane(ev, (2 * g + j) & 63);
                const unsigned char* up = Ub + (size_t)e * D + lo16; const unsigned char* vp = Vb + (size_t)e * D + lo16;
#pragma unroll
                for (int i = 0; i < 2; ++i) { uu[j][i] = *(const u32x4*)(up + 1024 * i); vv[j][i] = *(const u32x4*)(vp + 1024 * i); }
            }
        };
        auto consume = [&](int g, const u32x4 (&uu)[2][2], const u32x4 (&vv)[2][2]) {
            const float suv = (g < 32) ? su_lo : su_hi, gvv = (g < 32) ? gv_lo : gv_hi;
            float dd[2];
#pragma unroll
            for (int j = 0; j < 2; ++j) dd[j] = dot16_fp8(uu[j][0], x) + dot16_fp8(uu[j][1], x + 16);
#pragma unroll
            for (int j = 0; j < 2; ++j) dd[j] = wave_sum_dpp(dd[j]);
            const int l0 = (2 * g) & 63;
            const pg8::f32x2 ge = pg8::gelu_pk((pg8::f32x2){dd[0] * readlane_f(suv, l0), dd[1] * readlane_f(suv, l0 + 1)});
            const float a0 = ge.x * readlane_f(gvv, l0), a1 = ge.y * readlane_f(gvv, l0 + 1);
            axpy16_fp8(vv[0][0], a0, o); axpy16_fp8(vv[0][1], a0, o + 16);
            axpy16_fp8(vv[1][0], a1, o); axpy16_fp8(vv[1][1], a1, o + 16);
        };
        issue(0, ua, va);
        for (int g = 0; g < 64; g += 2) {
            issue(g + 1, ub, vb);
            consume(g, ua, va);
            if (g + 2 < 64) issue(g + 2, ua, va);
            consume(g + 1, ub, vb);
        }
        float s = 0.f;
#pragma unroll
        for (int i = 0; i < 32; ++i) { o[i] += DN_ALPHA * x[i]; s += o[i]; }
        const float mean = wave_sum_dpp(s) * (1.0f / D); float q = 0.f;
#pragma unroll
        for (int i = 0; i < 32; ++i) { o[i] -= mean; q += o[i] * o[i]; }
        const float rstd = 1.0f / sqrtf(wave_sum_dpp(q) * (1.0f / D) + LN_EPS);
        float* orow = P.out + (size_t)tok * D + lo16;
#pragma unroll
        for (int i = 0; i < 2; ++i)
#pragma unroll
            for (int c = 0; c < 4; ++c) {
                const int off = 1024 * i + lo16 + 4 * c;
                const f32x4 g0 = *(const f32x4*)(P.in[I_LN2G] + off), b0 = *(const f32x4*)(P.in[I_LN2B] + off);
                f32x4 r0;
                r0.x = o[16 * i + 4 * c + 0] * rstd * g0.x + b0.x; r0.y = o[16 * i + 4 * c + 1] * rstd * g0.y + b0.y; r0.z = o[16 * i + 4 * c + 2] * rstd * g0.z + b0.z; r0.w = o[16 * i + 4 * c + 3] * rstd * g0.w + b0.w;
                *(f32x4*)(orow + 1024 * i + 4 * c) = r0;
            }
    }
}
__device__ __forceinline__ void phase5b(const Params& P) {
    const int lane = threadIdx.x & 63, wave = threadIdx.x >> 6;
    const int gw = blockIdx.x * 8 + wave, NGW = gridDim.x * 8;
    unsigned char* ws = P.ws;
    for (int r = gw; r < NTOK; r += NGW)
        ln_row_bf16((const float*)(ws + WS_X1) + (size_t)r * D, P.in[I_LN1G], P.in[I_LN1B], (bf16_t*)(ws + WS_H1B) + (size_t)r * D, lane);
    for (int r = gw; r < 32768; r += NGW) {
        const float* src = (r < 16384 ? P.in[I_UT] : P.in[I_VT]) + (size_t)(r & 16383) * D;
        int* dst = (int*)(ws + (r < 16384 ? WS_UB : WS_VB) + (size_t)(r & 16383) * D);
        f32x4 v[8]; float am = 0.f;
#pragma unroll
        for (int j = 0; j < 8; ++j) { v[j] = ((const f32x4*)src)[lane + 64 * j]; am = fmaxf(am, fmaxf(fmaxf(fabsf(v[j].x), fabsf(v[j].y)), fmaxf(fabsf(v[j].z), fabsf(v[j].w)))); }
        am = wave_max_dpp(am);
        const float s = am > 0.f ? 256.0f / am : 1.0f;
#pragma unroll
        for (int j = 0; j < 8; ++j) { int w = 0; w = __builtin_amdgcn_cvt_pk_fp8_f32(v[j].x * s, v[j].y * s, w, false); w = __builtin_amdgcn_cvt_pk_fp8_f32(v[j].z * s, v[j].w * s, w, true); dst[lane + 64 * j] = w; }
        if (lane == 0) ((float*)(ws + WS_TSC))[r] = am > 0.f ? am * (1.0f / 256.0f) : 1.0f;
    }
}

#define CE_DESC(a, b) do { const float h_ = fmaxf((a), (b)), l_ = fminf((a), (b)); (a) = h_; (b) = l_; } while (0)
template <int N> __device__ __forceinline__ void bitonic_sort_desc(float (&v)[N]) {
#pragma unroll
    for (int k = 2; k <= N; k <<= 1)
#pragma unroll
        for (int j = k >> 1; j > 0; j >>= 1)
#pragma unroll
            for (int i = 0; i < N; ++i) { const int l = i ^ j; if (l > i) { if ((i & k) == 0) CE_DESC(v[i], v[l]); else CE_DESC(v[l], v[i]); } }
}
template <int N> __device__ __forceinline__ void bitonic_merge_desc(float (&v)[N]) {
#pragma unroll
    for (int j = N >> 1; j > 0; j >>= 1)
#pragma unroll
        for (int i = 0; i < N; ++i) { const int l = i ^ j; if (l > i) CE_DESC(v[i], v[l]); }
}
__device__ __forceinline__ void top16_merge(float (&a)[16], const float (&brev)[16]) {
#pragma unroll
    for (int i = 0; i < 16; ++i) a[i] = fmaxf(a[i], brev[i]);
    bitonic_merge_desc<16>(a);
}
__device__ __forceinline__ float embed_bits(float v, unsigned code, unsigned mask) { return __uint_as_float((__float_as_uint(v) & ~mask) | code); }

__device__ __forceinline__ void phase7(const Params& P, ldsp lds) {
    const int tid = threadIdx.x, lane = tid & 63, wave = tid >> 6, fr = lane & 15, fq = lane >> 4;
    unsigned char* ws = P.ws;
    const bf16_t* qb = (const bf16_t*)(ws + WS_Q); const bf16_t* sk = (const bf16_t*)(ws + WS_SUBK);
    constexpr int LDSK = 136, O_SK = 0, O_SV = 2 * 128 * LDSK * 2, O_EX = O_SV + 32768, O_GT = O_EX + 16384;
    for (int idx = tid; idx < 2 * 128 * 16; idx += 512) { const int row = idx >> 4, ch = idx & 15;
        *(LAS u32x4*)(lds + O_SK + (row * LDSK + ch * 8) * 2) = *(const u32x4*)(sk + row * 128 + ch * 8); }
    BLOCK_SYNC();
    for (int tile = blockIdx.x; tile < 256; tile += gridDim.x) {
        const int tok0 = tile * 32, h = wave;
#pragma unroll 1
        for (int cb = 0; cb < 4; ++cb) {
            const int nt = cb >> 1, p = cb & 1;
            f32x4 acc[8];
#pragma unroll
            for (int mt = 0; mt < 8; ++mt) acc[mt] = (f32x4){0.f, 0.f, 0.f, 0.f};
            const bf16_t* qrow = qb + (size_t)(tok0 + 16 * nt + fr) * D + h * 256 + p * 128 + fq * 8;
#pragma unroll
            for (int ks = 0; ks < 4; ++ks) {
                const bf16x8 bq = *(const bf16x8*)(qrow + ks * 32);
#pragma unroll
                for (int mt = 0; mt < 8; ++mt) acc[mt] = mfma16(*(const LAS bf16x8*)(lds + O_SK + ((p * 128 + 16 * mt + fr) * LDSK + ks * 32 + fq * 8) * 2), bq, acc[mt]);
            }
            float a[16], b[16];
#pragma unroll
            for (int mt = 0; mt < 4; ++mt) {
                a[4 * mt + 0] = embed_bits(acc[mt].x, 16 * mt + 4 * fq + 0, 127u); a[4 * mt + 1] = embed_bits(acc[mt].y, 16 * mt + 4 * fq + 1, 127u);
                a[4 * mt + 2] = embed_bits(acc[mt].z, 16 * mt + 4 * fq + 2, 127u); a[4 * mt + 3] = embed_bits(acc[mt].w, 16 * mt + 4 * fq + 3, 127u);
                b[4 * mt + 0] = embed_bits(acc[mt + 4].x, 16 * (mt + 4) + 4 * fq + 0, 127u); b[4 * mt + 1] = embed_bits(acc[mt + 4].y, 16 * (mt + 4) + 4 * fq + 1, 127u);
                b[4 * mt + 2] = embed_bits(acc[mt + 4].z, 16 * (mt + 4) + 4 * fq + 2, 127u); b[4 * mt + 3] = embed_bits(acc[mt + 4].w, 16 * (mt + 4) + 4 * fq + 3, 127u);
            }
            bitonic_sort_desc<16>(a); bitonic_sort_desc<16>(b);
            { float br[16];
#pragma unroll
              for (int i = 0; i < 16; ++i) br[i] = b[15 - i];
              top16_merge(a, br); }
#pragma unroll
            for (int x = 16; x <= 32; x <<= 1) { float br[16];
#pragma unroll
                for (int i = 0; i < 16; ++i) br[i] = __shfl_xor(a[15 - i], x);
                top16_merge(a, br); }
            if (fq == 0) { LAS f32x4* o = (LAS f32x4*)(lds + O_SV + ((((16 * nt + fr) * 8 + h) * 2 + p) * 16) * 4);
                o[0] = (f32x4){a[0], a[1], a[2], a[3]}; o[1] = (f32x4){a[4], a[5], a[6], a[7]}; o[2] = (f32x4){a[8], a[9], a[10], a[11]}; o[3] = (f32x4){a[12], a[13], a[14], a[15]}; }
        }
        BLOCK_SYNC();
        if (tid < 256) {
            const int tok = tid >> 3, hh = tid & 7;
            const LAS f32x4* s = (const LAS f32x4*)(lds + O_SV + (((tok * 8 + hh) * 2) * 16) * 4);
            float s0[16], s1[16];
#pragma unroll
            for (int c4 = 0; c4 < 4; ++c4) { const f32x4 x = s[c4], y = s[4 + c4]; s0[4 * c4] = x.x; s0[4 * c4 + 1] = x.y; s0[4 * c4 + 2] = x.z; s0[4 * c4 + 3] = x.w; s1[4 * c4] = y.x; s1[4 * c4 + 1] = y.y; s1[4 * c4 + 2] = y.z; s1[4 * c4 + 3] = y.w; }
            float g0[16], g1[16], g2[16], g3[16];
            const float NEG = -3.0e38f;
#pragma unroll
            for (int bq = 0; bq < 16; ++bq) g0[bq] = embed_bits(s0[0] + s1[bq], bq, 255u);
            {
                int n1 = 0, n2 = 0, n3 = 0;
#pragma unroll
                for (int aa = 1; aa < 16; ++aa)
#pragma unroll
                    for (int bb = 0; bb < 16; ++bb) if ((aa + 1) * (bb + 1) <= 16) {
                        const float c = embed_bits(s0[aa] + s1[bb], aa * 16 + bb, 255u);
                        if (n1 < 16) g1[n1++] = c; else if (n2 < 16) g2[n2++] = c; else g3[n3++] = c;
                    }
#pragma unroll
                for (int i = 0; i < 16; ++i) if (i >= n3) g3[i] = NEG;
            }
            bitonic_sort_desc<16>(g1); bitonic_sort_desc<16>(g2); bitonic_sort_desc<16>(g3);
            { float r1[16], r3[16];
#pragma unroll
              for (int i = 0; i < 16; ++i) { r1[i] = g1[15 - i]; r3[i] = g3[15 - i]; }
              top16_merge(g0, r1); top16_merge(g2, r3);
#pragma unroll
              for (int i = 0; i < 16; ++i) g0[i] = fmaxf(g0[i], g2[15 - i]); }
            float mx = g0[0];
#pragma unroll
            for (int i = 1; i < 16; ++i) mx = fmaxf(mx, g0[i]);
            float ex[16], sm = 0.f; int ee[16];
#pragma unroll
            for (int i = 0; i < 16; ++i) {
                ex[i] = __expf(g0[i] - mx); sm += ex[i];
                const unsigned code = __float_as_uint(g0[i]) & 255u;
                const unsigned i0 = __float_as_uint(*(const LAS float*)(lds + O_SV + ((((tok * 8 + hh) * 2 + 0) * 16) + (code >> 4)) * 4)) & 127u;
                const unsigned i1 = __float_as_uint(*(const LAS float*)(lds + O_SV + ((((tok * 8 + hh) * 2 + 1) * 16) + (code & 15u)) * 4)) & 127u;
                ee[i] = (int)(i0 * 128u + i1);
            }
            const float inv = 1.0f / sm;
            LAS int* eo = (LAS int*)(lds + O_EX) + tok * 128 + hh * 16; LAS float* go = (LAS float*)(lds + O_GT) + tok * 128 + hh * 16;
#pragma unroll
            for (int c4 = 0; c4 < 4; ++c4) {
                *(LAS u32x4*)(eo + 4 * c4) = (u32x4){(unsigned)ee[4 * c4], (unsigned)ee[4 * c4 + 1], (unsigned)ee[4 * c4 + 2], (unsigned)ee[4 * c4 + 3]};
                *(LAS f32x4*)(go + 4 * c4) = (f32x4){ex[4 * c4] * inv, ex[4 * c4 + 1] * inv, ex[4 * c4 + 2] * inv, ex[4 * c4 + 3] * inv};
            }
        }
        BLOCK_SYNC();
#pragma unroll 1
        for (int i = 0; i < 4; ++i) peer_token(P, tok0 + wave * 4 + i, (const LAS int*)(lds + O_EX) + (wave * 4 + i) * 128, (const LAS float*)(lds + O_GT) + (wave * 4 + i) * 128);
        BLOCK_SYNC();
    }
}
#ifndef MK_MULTI
#define MK_MULTI 0
#endif
__global__ __launch_bounds__(512, 2) void hybrid_fwd(Params P) {
    extern __shared__ __attribute__((aligned(16))) unsigned char shm[];
    ldsp lds = (ldsp)shm;
    cg::grid_group grid = cg::this_grid();
    unsigned char* ws = P.ws;
    volatile LAS unsigned* xst = (volatile LAS unsigned*)(lds + LDS_BYTES - 16);
    if (threadIdx.x == 0) { xst[0] = 0u; xst[1] = 0u; }
    __syncthreads();
    const XcdBarrier xbar = xcd_barrier_post((unsigned*)(ws + WS_BAR), xst);
    const int lo = P.ph_lo, hi = P.ph_hi;
#ifdef DBG_TA
    unsigned long long ts0 = 0, ts1 = 0, ts2 = 0, ts3 = 0, ts4 = 0, ts5 = 0, ts6 = 0, ts7 = 0, ts8 = 0, ts9 = 0, ts10 = 0, ts11 = 0;
#define STAMP(k) ts##k = __builtin_amdgcn_s_memrealtime()
#else
#define STAMP(k) do { } while (0)
#endif
    STAMP(0);
#ifndef REPEAT_PHASE
#define REPEAT_PHASE -1
#define REPEAT_N 1
#endif
#define PHASE(k) if (lo <= (k) && (k) < hi) for (int rep_ = 0; rep_ < ((k) == REPEAT_PHASE ? REPEAT_N : 1); ++rep_)
#define SEAM(k) do { if (lo <= (k) && (k) + 1 < hi) { if ((k) == 0) { asm volatile("s_waitcnt vmcnt(0) lgkmcnt(0)" ::: "memory"); __syncthreads(); grid.sync(); } xcd_barrier(xbar); } } while (0)
    PHASE(0) phase0(P);
    SEAM(0); STAMP(1);
    PHASE(1) { pg8::EpiBf16<0> E; E.O = (bf16_t*)(ws + WS_P); E.ldc = NPAD; E.bias = nullptr; E.split_cols = 0; E.split_stride = 0;
        run_gemm(lds, (const bf16_t*)(ws + WS_H0B), (const bf16_t*)(ws + WS_WTIN), MROWS, NPAD, 2048, E); }
    SEAM(1); STAMP(2);
    PHASE(2) phase2(P, lds);
    SEAM(2); STAMP(3);
    PHASE(3) phase3(P);
    SEAM(3); STAMP(4);
    PHASE(4) phase3b(P, lds);
    SEAM(4); STAMP(5);
    PHASE(5) {
        { pg8::EpiGateA E; E.C = (float*)(ws + WS_MPART); E.p = (const bf16_t*)(ws + WS_P); E.bgate = P.in[I_BGATE];
          run_gemm(lds, (const bf16_t*)(ws + WS_YA), (const bf16_t*)(ws + WS_WTA), NTOK, 2048, 2048, E); }
        { pg8::EpiGateB E; E.C = (const float*)(ws + WS_MPART); E.O = (bf16_t*)(ws + WS_MERGED); E.p = (const bf16_t*)(ws + WS_P); E.bgate = P.in[I_BGATE];
          run_gemm(lds, (const bf16_t*)(ws + WS_YB), (const bf16_t*)(ws + WS_WTB), NTOK, 2048, 1024, E); }
    }
    SEAM(5); STAMP(6);
    PHASE(6) { pg8::EpiResid E; E.C = (float*)(ws + WS_X1); E.h0 = (const bf16_t*)(ws + WS_H0B); E.alpha = DN_ALPHA;
        run_gemm(lds, (const bf16_t*)(ws + WS_MERGED), (const bf16_t*)(ws + WS_WTOUT), NTOK, 2048, 2048, E); }
    SEAM(6); STAMP(7);
    PHASE(7) phase5b(P);
    SEAM(7); STAMP(8);
    PHASE(8) { pg8::EpiBf16<0> E; E.O = (bf16_t*)(ws + WS_Q); E.ldc = D; E.bias = nullptr; E.split_cols = 0; E.split_stride = 0;
        run_gemm(lds, (const bf16_t*)(ws + WS_H1B), (const bf16_t*)(ws + WS_WTQ), NTOK, 2048, 2048, E); }
    SEAM(8); STAMP(9);
    PHASE(9) phase7(P, lds);
#ifdef DBG_TA
    {
        __threadfence_system(); asm volatile("s_waitcnt vmcnt(0) lgkmcnt(0)" ::: "memory"); __syncthreads(); grid.sync(); __threadfence_system();
        STAMP(11);
        const unsigned long long tt[12] = {ts0, ts1, ts2, ts3, ts4, ts5, ts6, ts7, ts8, ts9, ts9, ts11};
        const float ta = (float)(tt[DBG_TA + 1] - tt[DBG_TA]) * 0.01f, tb = (float)(tt[DBG_TB + 1] - tt[DBG_TB]) * 0.01f;
        if (blockIdx.x == 0) { for (int i = threadIdx.x + 1; i <= 1000000; i += 512) P.out[i] = tb; if (threadIdx.x == 0) P.out[0] = 1000.0f * ta; }
    }
#endif
#ifdef DBG_STOP
    {
        __threadfence_system(); asm volatile("s_waitcnt vmcnt(0) lgkmcnt(0)" ::: "memory"); __syncthreads(); grid.sync(); __threadfence_system();
        const size_t a = DBG_A, b = DBG_B; const unsigned* w = (const unsigned*)(ws + a); const size_t nw = (b - a) / 4, NO = (size_t)NTOK * D;
        for (size_t i = (size_t)blockIdx.x * 512 + threadIdx.x; i < NO; i += (size_t)gridDim.x * 512) {
            unsigned acc = 0; for (size_t j = i; j < nw; j += NO) { const unsigned x = w[j]; acc += (x & 0xffffu) + (x >> 16); }
            P.out[i] = (float)(acc & 0xfffffu);
        }
    }
#endif
#undef PHASE
#undef SEAM
}

extern "C" void kernel_launch(void* const* d_in, const int* in_sizes, int n_in, void* d_out, int out_size, void* d_ws, size_t ws_size, hipStream_t stream) {
    static int grid = 0;
    if (grid == 0) {
        if (n_in != 30 || out_size != NTOK * D || ws_size < WS_END) { fprintf(stderr, "kernel_launch: unexpected shapes (n_in %d, out %d, ws %zu < %zu)\n", n_in, out_size, ws_size, (size_t)WS_END); grid = -1; return; }
        int dev = 0, cus = 0, per_cu = 0;
        if (hipGetDevice(&dev) != hipSuccess || hipDeviceGetAttribute(&cus, hipDeviceAttributeMultiprocessorCount, dev) != hipSuccess) { grid = -1; return; }
        if (hipFuncSetAttribute((const void*)hybrid_fwd, hipFuncAttributeMaxDynamicSharedMemorySize, LDS_BYTES) != hipSuccess) { fprintf(stderr, "kernel_launch: hipFuncSetAttribute failed\n"); grid = -1; return; }
        if (hipOccupancyMaxActiveBlocksPerMultiprocessor(&per_cu, (const void*)hybrid_fwd, 512, LDS_BYTES) != hipSuccess || per_cu < 1) { fprintf(stderr, "kernel_launch: occupancy query says %d\n", per_cu); grid = -1; return; }
        (void)hipGetLastError();
        grid = cus;
    }
    if (grid < 0) return;
    if (hipMemsetAsync((unsigned char*)d_ws + WS_BAR, 0, XCD_BAR_WORDS * 4, stream) != hipSuccess) { fprintf(stderr, "kernel_launch: memset failed\n"); return; }
    Params p{};
    for (int i = 0; i < 30; ++i) p.in[i] = (const float*)d_in[i];
    p.out = (float*)d_out; p.ws = (unsigned char*)d_ws;
#if MK_MULTI
    for (int ph = 0; ph <= NPHASE; ++ph) { p.ph_lo = ph; p.ph_hi = ph + 1; hipLaunchKernelGGL(hybrid_fwd, dim3(grid), dim3(512), LDS_BYTES, stream, p); }
#else
    p.ph_lo = 0; p.ph_hi = NPHASE + 1;
#ifdef DBG_STOP
    p.ph_hi = DBG_STOP + 1;
#endif
    void* args[] = {&p};
    hipError_t e = hipLaunchCooperativeKernel((const void*)hybrid_fwd, dim3(grid), dim3(512), args, LDS_BYTES, stream);
    if (e != hipSuccess) fprintf(stderr, "kernel_launch: cooperative launch failed: %s (grid %d)\n", hipGetErrorString(e), grid);
#endif
}
```

```cpp
#include <hip/hip_runtime.h>
#include <hip/hip_cooperative_groups.h>
#include <cstdio>
#include <cstdint>
namespace cg = cooperative_groups;
namespace pg8 {
#define PG8_LAS __attribute__((address_space(3)))
typedef unsigned short bf16_t;
typedef short bf16x8 __attribute__((ext_vector_type(8)));
typedef float f32x4 __attribute__((ext_vector_type(4)));
typedef unsigned u32x4 __attribute__((ext_vector_type(4)));
constexpr int BM = 256, BK = 64, HALF = 128, HTB = HALF * BK * 2  , STAGE_BYTES = 8 * HTB, NXCD = 8, WGM = 8;

__host__ __device__ __forceinline__ int lds_byte(int r, int c) { const int st = (r >> 4) * 2 + (c >> 5), rr = r & 15, cc = c & 31, ob = rr * 64 + cc * 2; return st * 1024 + (ob ^ (((ob >> 9) & 1) << 5)); }
__host__ __device__ __forceinline__ void stage_rc(int b, int& R, int& C) { const int st = b / 1024, sb = b % 1024, swz = sb ^ (((sb >> 9) & 1) << 5); R = (st >> 1) * 16 + swz / 64; C = (st & 1) * 32 + (swz % 64) / 2; }
__host__ __device__ __forceinline__ int perm32(int rho) { const int n = rho >> 4, i = rho & 15; return 8 * (i >> 2) + 4 * n + (i & 3); }

struct Unit { int pm, pn; };
struct Gemm { const bf16_t* A; const bf16_t* Bt; int M, N, K; };

struct StaticOrder {
    int nM, nN, nwg, G, c;
    __host__ __device__ void init(int M, int N, int G_, int c_) { nM = M / BM; nN = N / BM; nwg = nM * nN; G = G_; c = c_; }
    __host__ __device__ bool next(int i, Unit& u) const {
        const long L = (long)i * G + c; if (L >= nwg) return false;
        int wgid = (int)L; { const int q = nwg / NXCD, r = nwg % NXCD, xcd = wgid % NXCD, off = wgid / NXCD; wgid = (xcd < r ? xcd * (q + 1) : r * (q + 1) + (xcd - r) * q) + off; }
        const int nig = WGM * nN, gid = wgid / nig, fm = gid * WGM, gsz = (nM - fm) < WGM ? (nM - fm) : WGM;
        u.pm = fm + ((wgid % nig) % gsz); u.pn = (wgid % nig) / gsz; return true;
    }
    __device__ __forceinline__ void a_ready(const Unit&) const {}
    __device__ __forceinline__ void done(const Unit&) const {}
};
struct CountedOrder : StaticOrder {
    const unsigned* ready; unsigned need; unsigned* tmo;
    __device__ __forceinline__ void a_ready(const Unit& u) const {
        if (threadIdx.x < 64) {
            const unsigned long long t0 = __builtin_amdgcn_s_memrealtime(); unsigned polls = 0;
            while ((unsigned)__builtin_amdgcn_readfirstlane(__hip_atomic_load(ready + 64 * u.pm, __ATOMIC_RELAXED, __HIP_MEMORY_SCOPE_AGENT)) < need) {
                if ((++polls & 255u) == 0u && __builtin_amdgcn_readfirstlane(__hip_atomic_load(tmo, __ATOMIC_RELAXED, __HIP_MEMORY_SCOPE_AGENT)) != 0u) break;
                if (__builtin_amdgcn_s_memrealtime() - t0 > 2000000ull) {
                    if (threadIdx.x == 0) { unsigned expect = 0u; __hip_atomic_compare_exchange_strong(tmo + 1, &expect, 0x600u | (unsigned)(u.pm & 0xff), __ATOMIC_RELAXED, __ATOMIC_RELAXED, __HIP_MEMORY_SCOPE_AGENT); __hip_atomic_store(tmo, 1u, __ATOMIC_RELAXED, __HIP_MEMORY_SCOPE_AGENT); }
                    break; }
                __builtin_amdgcn_s_sleep(2); }
            __builtin_amdgcn_fence(__ATOMIC_ACQUIRE, "agent");
            asm volatile("s_waitcnt vmcnt(0)" ::: "memory");
        }
#if !defined(BROKEN_HOOK_NO_BARRIER)
        asm volatile("" ::: "memory"); __builtin_amdgcn_s_barrier(); asm volatile("" ::: "memory");
#endif
    }
};

typedef float cvt_f32x2 __attribute__((ext_vector_type(2))); typedef __bf16 cvt_bf16x2 __attribute__((ext_vector_type(2)));
__device__ __forceinline__ unsigned cvt_pk_bf16(float lo, float hi) { const cvt_f32x2 v = {lo, hi}; const cvt_bf16x2 b = __builtin_convertvector(v, cvt_bf16x2); return __builtin_bit_cast(unsigned, b); }
typedef float f32x2 __attribute__((ext_vector_type(2)));
__device__ __forceinline__ f32x2 gelu_pk(f32x2 v) {
    const f32x2 av = __builtin_elementwise_abs(v), d = av * 0.2316418882f + 1.0f;
    f32x2 t; t.x = __builtin_amdgcn_rcpf(d.x); t.y = __builtin_amdgcn_rcpf(d.y);
    f32x2 q = t * 0.5307027145f + (-0.7265760135f); q = q * t + 0.7107068705f; q = q * t + (-0.142248368f); q = q * t + 0.127414796f; q = q * t;
    const f32x2 s = (v * v) * (-0.72134752044f);
    f32x2 e; e.x = __builtin_amdgcn_exp2f(s.x); e.y = __builtin_amdgcn_exp2f(s.y);
    const f32x2 m = v * (q * e), r = v - m;
    f32x2 o; o.x = v.x < 0.f ? m.x : r.x; o.y = v.y < 0.f ? m.y : r.y; return o;
}

struct EpiF32 {
    static constexpr bool PERM = false, AFTER_DRAIN = false;
    float* C; int ldc; const float* bias;
    __device__ __forceinline__ void operator()(const f32x4 (&acc)[2][2][4][2], const Unit& u, int wr, int wc, int fr, int fq) const {
        const int row0 = u.pm * BM + wr * 64 + fr, col0 = u.pn * BM + wc * 32 + 4 * fq;
        f32x4 bv[2][2];
#pragma unroll
        for (int bj = 0; bj < 2; ++bj)
#pragma unroll
            for (int n = 0; n < 2; ++n) bv[bj][n] = bias ? *(const f32x4*)(bias + col0 + bj * HALF + n * 16) : (f32x4){0.f, 0.f, 0.f, 0.f};
#pragma unroll
        for (int ai = 0; ai < 2; ++ai)
#pragma unroll
            for (int m = 0; m < 4; ++m) { float* rowp = C + (size_t)(row0 + ai * HALF + m * 16) * ldc + col0;
#pragma unroll
                for (int bj = 0; bj < 2; ++bj)
#pragma unroll
                    for (int n = 0; n < 2; ++n) *(f32x4*)(rowp + bj * HALF + n * 16) = acc[ai][bj][m][n] + bv[bj][n]; }
    }
};
template <int ACT  > struct EpiBf16 {
    static constexpr bool PERM = true, AFTER_DRAIN = false;
    bf16_t* O; int ldc; const float* bias; int split_cols; size_t split_stride;
    __device__ __forceinline__ void operator()(const f32x4 (&acc)[2][2][4][2], const Unit& u, int wr, int wc, int fr, int fq) const {
        const int row0 = u.pm * BM + wr * 64 + fr; int colt = u.pn * BM; bf16_t* base = O;
        if (split_cols) { const int t = colt / split_cols; base += (size_t)t * split_stride; colt -= t * split_cols; }
        const int col0 = colt + wc * 32 + 8 * fq, bcol0 = u.pn * BM + wc * 32 + 8 * fq;
        f32x4 bv[2][2];
#pragma unroll
        for (int bj = 0; bj < 2; ++bj)
#pragma unroll
            for (int n = 0; n < 2; ++n) bv[bj][n] = bias ? *(const f32x4*)(bias + bcol0 + bj * HALF + 4 * n) : (f32x4){0.f, 0.f, 0.f, 0.f};
#pragma unroll
        for (int ai = 0; ai < 2; ++ai)
#pragma unroll
            for (int m = 0; m < 4; ++m) { bf16_t* rowp = base + (size_t)(row0 + ai * HALF + m * 16) * ldc + col0;
#pragma unroll
                for (int bj = 0; bj < 2; ++bj) { f32x4 v0 = acc[ai][bj][m][0] + bv[bj][0], v1 = acc[ai][bj][m][1] + bv[bj][1];
                    if (ACT == 1) { f32x2 a = gelu_pk((f32x2){v0[0], v0[1]}), b = gelu_pk((f32x2){v0[2], v0[3]}), c = gelu_pk((f32x2){v1[0], v1[1]}), d = gelu_pk((f32x2){v1[2], v1[3]});
                        v0 = (f32x4){a.x, a.y, b.x, b.y}; v1 = (f32x4){c.x, c.y, d.x, d.y}; }
                    if (ACT == 2) {
#pragma unroll
                        for (int j = 0; j < 4; ++j) { v0[j] = 0.5f * v0[j] * (1.0f + erff(v0[j] * 0.70710678f)); v1[j] = 0.5f * v1[j] * (1.0f + erff(v1[j] * 0.70710678f)); } }
                    u32x4 w; w.x = cvt_pk_bf16(v0[0], v0[1]); w.y = cvt_pk_bf16(v0[2], v0[3]); w.z = cvt_pk_bf16(v1[0], v1[1]); w.w = cvt_pk_bf16(v1[2], v1[3]);
                    *(u32x4*)(rowp + bj * HALF) = w; } }
    }
};
template <class Epi, class Sched, bool STAMP = false>
__device__ __forceinline__ void gemm_phase(PG8_LAS unsigned char* lds, const Gemm g, const Sched& S, const Epi& E, unsigned long long* stamps) {
    const int tid = threadIdx.x, wid = __builtin_amdgcn_readfirstlane(tid >> 6), lane = tid & 63, wr = wid >> 2, wc = wid & 3, fr = lane & 15, fq = lane >> 4;
    const int K = g.K, nt = K / BK;
    int ts_lo = 0, ts_hi = 0, nts = 0; const unsigned long long rt_entry = STAMP ? (unsigned long long)wall_clock64() : 0ull;
#define PG8_STAMP() do { if (STAMP && wid == 0 && nts < 64) { const unsigned long long _c = (unsigned long long)clock64(); \
        ts_lo = (lane == nts) ? (int)(unsigned)_c : ts_lo; ts_hi = (lane == nts) ? (int)(unsigned)(_c >> 32) : ts_hi; ++nts; } } while (0)
    PG8_STAMP();
    unsigned voffA[2], voffB[2];
#pragma unroll
    for (int i = 0; i < 2; ++i) { int R, C; stage_rc(tid * 16 + i * 8192, R, C); const int Rb = Epi::PERM ? ((R & ~31) + perm32(R & 31)) : R;
        voffA[i] = (unsigned)(R * K + C) * 2u; voffB[i] = (unsigned)(Rb * K + C) * 2u; }
    const size_t kstep = (size_t)(BK * 2);
    const size_t hstep = (size_t)HALF * K * 2;
    const size_t tstep = 2 * hstep;
    const unsigned ldsw = (unsigned)wid * 1024u;
    const int aoff = lds_byte(wr * 64 + fr, fq * 8), boff = lds_byte(wc * 32 + fr, fq * 8);
#define PG8_SA(b, h) (((b) * 2 + (h)) * HTB)
#define PG8_SB(b, h) ((4 + (b) * 2 + (h)) * HTB)
#define PG8_STAGE(bufoff, gbase, voff) do { _Pragma("unroll") for (int _i = 0; _i < 2; ++_i) \
        __builtin_amdgcn_global_load_lds((const unsigned*)((const char*)(gbase) + (voff)[_i]), (PG8_LAS unsigned*)(lds + (bufoff) + ldsw + _i * 8192), 16, 0, 0); } while (0)
#define PG8_LDA(dst, b, h) do { _Pragma("unroll") for (int m = 0; m < 4; ++m) _Pragma("unroll") for (int k = 0; k < 2; ++k) dst[m][k] = *(const PG8_LAS bf16x8*)(lds + PG8_SA(b, h) + aoff + m * 2048 + k * 1024); } while (0)
#define PG8_LDB(dst, b, h) do { _Pragma("unroll") for (int n = 0; n < 2; ++n) _Pragma("unroll") for (int k = 0; k < 2; ++k) dst[n][k] = *(const PG8_LAS bf16x8*)(lds + PG8_SB(b, h) + boff + n * 2048 + k * 1024); } while (0)
#define PG8_MMA(ai, bj, At, Bt) do { __builtin_amdgcn_s_setprio(1); _Pragma("unroll") for (int m = 0; m < 4; ++m) _Pragma("unroll") for (int n = 0; n < 2; ++n) _Pragma("unroll") for (int k = 0; k < 2; ++k) \
        acc[ai][bj][m][n] = __builtin_amdgcn_mfma_f32_16x16x32_bf16(Bt[n][k], At[m][k], acc[ai][bj][m][n], 0, 0, 0); __builtin_amdgcn_s_setprio(0); } while (0)
#define PG8_WAIT_V(n) asm volatile("s_waitcnt vmcnt(" #n ")" ::: "memory")
#define PG8_WAIT_L(n) asm volatile("s_waitcnt lgkmcnt(" #n ")" ::: "memory")
#define PG8_BAR __builtin_amdgcn_s_barrier()
#define PG8_SCHED __builtin_amdgcn_sched_barrier(0)
    Unit cur, nxt; int ui = 0;
    if (!S.next(0, cur)) return;
    f32x4 acc[2][2][4][2];
#pragma unroll
    for (int a = 0; a < 2; ++a)
#pragma unroll
        for (int b = 0; b < 2; ++b)
#pragma unroll
            for (int m = 0; m < 4; ++m)
#pragma unroll
                for (int n = 0; n < 2; ++n) acc[a][b][m][n] = (f32x4){0.f, 0.f, 0.f, 0.f};
    bf16x8 At[4][2], B0[2][2], B1[2][2];
    const char* cA = (const char*)g.A + (size_t)cur.pm * tstep; const char* cB = (const char*)g.Bt + (size_t)cur.pn * tstep;
    S.a_ready(cur);
    PG8_STAGE(PG8_SB(0, 0), cB, voffB); PG8_STAGE(PG8_SA(0, 0), cA, voffA); PG8_STAGE(PG8_SB(0, 1), cB + hstep, voffB); PG8_STAGE(PG8_SA(0, 1), cA + hstep, voffA);
    if (wr == 1) PG8_BAR;
    PG8_WAIT_V(4); PG8_BAR;
    PG8_STAGE(PG8_SB(1, 0), cB + kstep, voffB); PG8_STAGE(PG8_SA(1, 0), cA + kstep, voffA); PG8_STAGE(PG8_SB(1, 1), cB + hstep + kstep, voffB);
    PG8_WAIT_V(6); PG8_BAR;
    PG8_STAMP();
    for (;;) {
        const bool has_next = S.next(ui + 1, nxt);
        const char* nA = has_next ? (const char*)g.A + (size_t)nxt.pm * tstep : cA; const char* nB = has_next ? (const char*)g.Bt + (size_t)nxt.pn * tstep : cB;
        for (int t = 0; t < nt; t += 2) {
            const bool last = (t == nt - 2);
            const char* a1 = cA + (size_t)(t + 1) * kstep;
            const char* a2 = last ? nA : cA + (size_t)(t + 2) * kstep; const char* b2 = last ? nB : cB + (size_t)(t + 2) * kstep;
            const char* a3 = a2 + kstep; const char* b3 = b2 + kstep;
            if (last && has_next) S.a_ready(nxt);
            PG8_LDB(B0, 0, 0); PG8_SCHED; PG8_LDA(At, 0, 0); PG8_STAGE(PG8_SA(1, 1), a1 + hstep, voffA);
            PG8_WAIT_L(8); PG8_BAR; PG8_WAIT_L(0); PG8_MMA(0, 0, At, B0); PG8_BAR; PG8_SCHED;
            PG8_LDB(B1, 0, 1); PG8_STAGE(PG8_SB(0, 0), b2, voffB);
            PG8_BAR; PG8_WAIT_L(0); PG8_MMA(0, 1, At, B1); PG8_BAR;
            PG8_LDA(At, 0, 1); PG8_STAGE(PG8_SA(0, 0), a2, voffA);
            PG8_BAR; PG8_WAIT_L(0); PG8_MMA(1, 0, At, B0); PG8_BAR; PG8_SCHED;
            PG8_STAGE(PG8_SB(0, 1), b2 + hstep, voffB);
            PG8_WAIT_V(6); PG8_BAR; PG8_MMA(1, 1, At, B1); PG8_BAR;
            PG8_LDB(B0, 1, 0); PG8_SCHED; PG8_LDA(At, 1, 0); PG8_STAGE(PG8_SA(0, 1), a2 + hstep, voffA);
            PG8_WAIT_L(8); PG8_BAR; PG8_WAIT_L(0); PG8_MMA(0, 0, At, B0); PG8_BAR; PG8_SCHED;
            PG8_LDB(B1, 1, 1); PG8_STAGE(PG8_SB(1, 0), b3, voffB);
            PG8_BAR; PG8_WAIT_L(0); PG8_MMA(0, 1, At, B1); PG8_BAR;
            PG8_LDA(At, 1, 1); PG8_STAGE(PG8_SA(1, 0), a3, voffA);
            PG8_BAR; PG8_WAIT_L(0); PG8_MMA(1, 0, At, B0); PG8_BAR; PG8_SCHED;
            PG8_STAGE(PG8_SB(1, 1), b3 + hstep, voffB);
            PG8_WAIT_V(6); PG8_BAR; PG8_MMA(1, 1, At, B1); PG8_BAR;
        }
        PG8_STAMP();
        if constexpr (!Epi::AFTER_DRAIN) { E(acc, cur, wr, wc, fr, fq); S.done(cur); }
        PG8_STAMP();
        if (!has_next) break;
#pragma unroll
        for (int a = 0; a < 2; ++a)
#pragma unroll
            for (int b = 0; b < 2; ++b)
#pragma unroll
                for (int m = 0; m < 4; ++m)
#pragma unroll
                    for (int n = 0; n < 2; ++n) acc[a][b][m][n] = (f32x4){0.f, 0.f, 0.f, 0.f};
        cur = nxt; cA = nA; cB = nB; ++ui;
    }
    PG8_WAIT_V(0);
    if (wr == 0) PG8_BAR;
    PG8_BAR;
    if constexpr (Epi::AFTER_DRAIN) { E.fused(acc, cur, wr, wc, fr, fq, lds, wid, lane); S.done(cur); }
    PG8_STAMP();
    if (STAMP && wid == 0) { stamps[lane] = lane < nts ? (((unsigned long long)(unsigned)ts_hi << 32) | (unsigned)ts_lo) : 0ull;
        if (lane == 62) stamps[62] = rt_entry; if (lane == 63) stamps[63] = (unsigned long long)wall_clock64(); }
#undef PG8_STAMP
#undef PG8_SA
#undef PG8_SB
#undef PG8_STAGE
#undef PG8_LDA
#undef PG8_LDB
#undef PG8_MMA
#undef PG8_WAIT_V
#undef PG8_WAIT_L
#undef PG8_BAR
#undef PG8_SCHED
}
}
#define LAS __attribute__((address_space(3)))
typedef unsigned short bf16_t;
typedef short bf16x8 __attribute__((ext_vector_type(8)));
typedef float f32x4 __attribute__((ext_vector_type(4)));
typedef float f32x2 __attribute__((ext_vector_type(2)));
typedef unsigned u32x4 __attribute__((ext_vector_type(4)));
typedef unsigned u32x2 __attribute__((ext_vector_type(2)));
typedef LAS unsigned char* ldsp;

constexpr int D = 2048, NTOK = 8192, SEQ = 4096, MROWS = 8448, ROW_META = 8192;
constexpr int INC = 11712, NPAD = 11776;
constexpr int C_R = 0, C_K = 2048, C_V = 4096, C_WL = 6144, C_AL = 6240, C_GL = 6336, C_POOL = 6592, C_G0 = 7616, C_G1 = 9664;
constexpr int NUNITS = 4128;
constexpr float DSCALE = 0.6065306597126334f;
constexpr float DN_ALPHA = 1.189207115002721f;
constexpr float GN_EPS = 64e-5f, LN_EPS = 1e-5f;

constexpr size_t WS_P = 0;
constexpr size_t WS_UB = 0;
constexpr size_t WS_VB = 33554432;
constexpr size_t WS_H0B = 198967296;
constexpr size_t WS_WTA = WS_H0B + 34603008;
constexpr size_t WS_WTB = WS_WTA + 8388608;
constexpr size_t WS_WTOUT = WS_WTB + 4194304;
constexpr size_t WS_WTQ = WS_WTOUT + 8388608;
constexpr size_t WS_WTPOOL = WS_WTQ + 8388608;
constexpr size_t WS_WTW2 = WS_WTPOOL + 524288;
constexpr size_t WS_WTA2 = WS_WTW2 + 393216;
constexpr size_t WS_WTG2 = WS_WTA2 + 393216;
constexpr size_t WS_SUBK = WS_WTG2 + 1048576;
constexpr size_t WS_BONUS = WS_SUBK + 65536;
constexpr size_t WS_REGC = WS_BONUS + 1048576;
constexpr size_t WS_WTIN = WS_REGC;
constexpr size_t UNITB = (size_t)NUNITS * 4096 * 2;
constexpr size_t WS_G = WS_REGC;
constexpr size_t WS_H0T = WS_REGC + UNITB;
constexpr size_t WS_RT = WS_REGC + 2 * UNITB;
constexpr size_t WS_Y0 = WS_REGC + 3 * UNITB;
constexpr size_t WS_S0T = WS_REGC + 4 * UNITB;
constexpr size_t WS_MERGED = WS_REGC;
constexpr size_t WS_MPART = WS_REGC + 33554432;
constexpr size_t WS_X1 = WS_REGC + 33554432;
constexpr size_t WS_H1B = WS_REGC + 100663296;
constexpr size_t WS_Q = WS_REGC + 134217728;
constexpr size_t WS_YA = WS_REGC + 5 * UNITB;
constexpr size_t WS_YB = WS_YA + 33554432;
constexpr size_t WS_EXP = WS_YB + 16777216;
constexpr size_t WS_GSIG = WS_EXP;
constexpr size_t WS_GATE = WS_EXP + 4194304;
constexpr size_t WS_BAR = WS_GATE + 4194304;
constexpr size_t WS_TSC = WS_BAR + 16384;
constexpr size_t WS_END = WS_TSC + 131072;
static_assert(WS_Q + 33554432 <= WS_YA, "overlay");
static_assert(WS_VB + 33554432 <= WS_H0B, "overlay");

constexpr int LDS_BYTES = 163840;
constexpr int NPHASE = 9;

struct Params {
    const float* in[30];
    float* out;
    unsigned char* ws;
    int ph_lo, ph_hi;
};
enum { I_X = 0, I_META, I_LNIN_G, I_LNIN_B, I_WIN, I_MU, I_W0, I_WW2, I_A0, I_WA2, I_WG2, I_KK, I_KA, I_RK, I_GNG, I_GNB, I_WPOOL, I_PSCALE, I_BGATE,
       I_WBA, I_WBB, I_WOUT, I_LN1G, I_LN1B, I_WQ, I_SUBK, I_UT, I_VT, I_LN2G, I_LN2B };

__device__ __forceinline__ unsigned pk2(float lo, float hi) { return pg8::cvt_pk_bf16(lo, hi); }
__device__ __forceinline__ float bflo(unsigned w) { return __uint_as_float(w << 16); }
__device__ __forceinline__ float bfhi(unsigned w) { return __uint_as_float(w & 0xffff0000u); }
__device__ __forceinline__ float bf1(bf16_t h) { return __uint_as_float(((unsigned)h) << 16); }
__device__ __forceinline__ bf16_t f2bf1(float f) { return (bf16_t)(pk2(f, f) & 0xffffu); }
__device__ __forceinline__ float wave_sum(float v) {
#pragma unroll
    for (int o = 1; o < 64; o <<= 1) v += __shfl_xor(v, o);
    return v;
}
__device__ __forceinline__ float sigmoidf_(float x) { return 1.0f / (1.0f + __expf(-x)); }
__device__ __forceinline__ f32x4 mfma16(bf16x8 a, bf16x8 b, f32x4 c) { return __builtin_amdgcn_mfma_f32_16x16x32_bf16(a, b, c, 0, 0, 0); }
__device__ __forceinline__ void unpack8(const u32x4 w, float* f) {
    f[0] = bflo(w.x); f[1] = bfhi(w.x); f[2] = bflo(w.y); f[3] = bfhi(w.y); f[4] = bflo(w.z); f[5] = bfhi(w.z); f[6] = bflo(w.w); f[7] = bfhi(w.w);
}
__device__ __forceinline__ u32x4 pack8(const float* f) { u32x4 w; w.x = pk2(f[0], f[1]); w.y = pk2(f[2], f[3]); w.z = pk2(f[4], f[5]); w.w = pk2(f[6], f[7]); return w; }
#define DPPF(v, ctrl) __builtin_bit_cast(float, __builtin_amdgcn_update_dpp(0, __builtin_bit_cast(int, (v)), (ctrl), 0xF, 0xF, true))
__device__ __forceinline__ float readlane_f(float v, int l) { return __builtin_bit_cast(float, __builtin_amdgcn_readlane(__builtin_bit_cast(int, v), l)); }
__device__ __forceinline__ float wave_sum_dpp(float v) {
    v += DPPF(v, 0xB1); v += DPPF(v, 0x4E); v += DPPF(v, 0x141); v += DPPF(v, 0x140);
    return (readlane_f(v, 0) + readlane_f(v, 16)) + (readlane_f(v, 32) + readlane_f(v, 48));
}
__device__ __forceinline__ float wave_max_dpp(float v) {
    v = fmaxf(v, DPPF(v, 0xB1)); v = fmaxf(v, DPPF(v, 0x4E)); v = fmaxf(v, DPPF(v, 0x141)); v = fmaxf(v, DPPF(v, 0x140));
    return fmaxf(fmaxf(readlane_f(v, 0), readlane_f(v, 16)), fmaxf(readlane_f(v, 32), readlane_f(v, 48)));
}
#define BLOCK_SYNC() __syncthreads()
#define XB_TMO      128
#define XB_XCNT(j)  (256  + 64 * (j))
#define XB_XSUB(j)  (1280 + 64 * (j))
#define XB_XGEN(j)  (2304 + 64 * (j))
#define XB_TOP      3328
#define XB_TOPGEN   3392
#define XCD_BAR_WORDS 3456
#define XB_SPIN_CAP (1u << 18)

__device__ __forceinline__ unsigned xb_ld(unsigned* p)              { return __hip_atomic_load(p, __ATOMIC_RELAXED, __HIP_MEMORY_SCOPE_AGENT); }
__device__ __forceinline__ unsigned xb_add(unsigned* p, unsigned v) { return __hip_atomic_fetch_add(p, v, __ATOMIC_RELAXED, __HIP_MEMORY_SCOPE_AGENT); }
__device__ __forceinline__ unsigned xb_xcc_id() { return (unsigned)__builtin_amdgcn_s_getreg((3 << 11) | 20) & 0xFu; }
#define XB_SPIN(cond, bar) do { unsigned _sp = 0; while (cond) { __builtin_amdgcn_s_sleep(1); \
    if ((++_sp & 255u) == 0u) { if (xb_ld(&(bar)[XB_TMO])) break; if (_sp > XB_SPIN_CAP) { atomicAdd(&(bar)[XB_TMO], 1u); break; } } } } while (0)

struct XcdBarrier {
    unsigned* bar; unsigned x;
    volatile LAS unsigned* st;
};

__device__ __forceinline__ XcdBarrier xcd_barrier_post(unsigned* bar, volatile LAS unsigned* st) {
    XcdBarrier b; b.bar = bar; b.x = xb_xcc_id(); b.st = st;
    if (threadIdx.x == 0) (void)xb_add(&bar[XB_XCNT(b.x)], 1u);
    return b;
}
__device__ __forceinline__ void xcd_barrier_complete(unsigned* bar, unsigned x, unsigned& nloc, unsigned& nx) {
    const unsigned G = gridDim.x * gridDim.y * gridDim.z;
    unsigned sum, cnt, mine, sp = 0u;
    for (;;) {
        sum = 0u; cnt = 0u; mine = 0u;
#pragma unroll
        for (unsigned j = 0; j < 16; ++j) { const unsigned c = xb_ld(&bar[XB_XCNT(j)]); sum += c; cnt += (c > 0u) ? 1u : 0u; mine = (j == x) ? c : mine; }
        if (sum == G) break;
        __builtin_amdgcn_s_sleep(1);
        if ((++sp & 255u) == 0u) { if (xb_ld(&bar[XB_TMO])) break; if (sp > XB_SPIN_CAP) { atomicAdd(&bar[XB_TMO], 1u); break; } }
    }
    nloc = mine > 0u ? mine : 1u; nx = cnt > 0u ? cnt : 1u;
}

__device__ __forceinline__ void xcd_barrier(const XcdBarrier& b) {
    asm volatile("s_waitcnt vmcnt(0)" ::: "memory");
    __syncthreads();
    if (threadIdx.x == 0) {
        unsigned* bar = b.bar;
        __builtin_amdgcn_s_waitcnt(0);
        unsigned nloc = b.st[0], nx = b.st[1];
        if (nloc == 0u) { xcd_barrier_complete(bar, b.x, nloc, nx); b.st[0] = nloc; b.st[1] = nx; }
        const unsigned old = xb_add(&bar[XB_XSUB(b.x)], 1u);
        const unsigned gen = old / nloc;
        if (old + 1u == (gen + 1u) * nloc) {
            __builtin_amdgcn_fence(__ATOMIC_RELEASE, "agent");
            asm volatile("s_waitcnt vmcnt(0)" ::: "memory");
            const unsigned og = xb_add(&bar[XB_TOP], 1u);
            const unsigned tg = og / nx;
            if (og + 1u == (tg + 1u) * nx) xb_add(&bar[XB_TOPGEN], 1u);
            else XB_SPIN(xb_ld(&bar[XB_TOPGEN]) == tg, bar);
            __builtin_amdgcn_fence(__ATOMIC_ACQUIRE, "agent");
            xb_add(&bar[XB_XGEN(b.x)], 1u);
            asm volatile("s_waitcnt vmcnt(0)" ::: "memory");
        } else {
            XB_SPIN(xb_ld(&bar[XB_XGEN(b.x)]) == gen, bar);
            __builtin_amdgcn_fence(__ATOMIC_ACQUIRE, "agent");
            asm volatile("s_waitcnt vmcnt(0)" ::: "memory");
        }
    }
    __syncthreads();
}

__device__ __forceinline__ void ln_row_bf16(const float* src, const float* g, const float* b, bf16_t* dst, int lane) {
    f32x4 v[8]; float s = 0.f;
#pragma unroll
    for (int j = 0; j < 8; ++j) { v[j] = ((const f32x4*)src)[lane + 64 * j]; s += (v[j].x + v[j].y) + (v[j].z + v[j].w); }
    const float mean = wave_sum(s) * (1.0f / D); float s2 = 0.f;
#pragma unroll
    for (int j = 0; j < 8; ++j) { v[j] = v[j] - mean; s2 += (v[j].x * v[j].x + v[j].y * v[j].y) + (v[j].z * v[j].z + v[j].w * v[j].w); }
    const float rstd = 1.0f / sqrtf(wave_sum(s2) * (1.0f / D) + LN_EPS);
#pragma unroll
    for (int j = 0; j < 8; ++j) {
        const f32x4 gg = ((const f32x4*)g)[lane + 64 * j], bb = ((const f32x4*)b)[lane + 64 * j];
        const f32x4 o = v[j] * rstd * gg + bb;
        u32x2 w; w.x = pk2(o.x, o.y); w.y = pk2(o.z, o.w);
        ((u32x2*)dst)[lane + 64 * j] = w;
    }
}
__device__ __forceinline__ void transpose_item(const float* W, int K, int N, int Npad, bf16_t* Wt, int item, int lane) {
    const int nblk = Npad >> 6, kb = item / nblk, nb = item - kb * nblk, n = nb * 64 + lane, k0 = kb * 32;
    float v[32];
    if (n < N) {
#pragma unroll
        for (int i = 0; i < 32; ++i) v[i] = W[(size_t)(k0 + i) * N + n];
    } else {
#pragma unroll
        for (int i = 0; i < 32; ++i) v[i] = 0.f;
    }
    u32x4* o = (u32x4*)(Wt + (size_t)n * K + k0);
#pragma unroll
    for (int c = 0; c < 4; ++c) { u32x4 w; w.x = pk2(v[8 * c], v[8 * c + 1]); w.y = pk2(v[8 * c + 2], v[8 * c + 3]); w.z = pk2(v[8 * c + 4], v[8 * c + 5]); w.w = pk2(v[8 * c + 6], v[8 * c + 7]); o[c] = w; }
}
__device__ __forceinline__ void phase0(const Params& P) {
    const int lane = threadIdx.x & 63, wave = threadIdx.x >> 6;
    const int gw = blockIdx.x * 8 + wave, NGW = gridDim.x * 8;
    unsigned char* ws = P.ws;
    constexpr int T_IN = 64 * 184, T_A = 64 * 32, T_B = 32 * 32, T_O = 64 * 32, T_Q = 64 * 32, T_POOL = 4 * 32, T_W2 = 3 * 32, T_A2 = 3 * 32, T_G2 = 8 * 32;
    constexpr int T_LN = MROWS, T_SK = 64;
    constexpr int NIT = T_IN + T_A + T_B + T_O + T_Q + T_POOL + T_W2 + T_A2 + T_G2 + T_LN + T_SK;
    for (int it = gw; it < NIT; it += NGW) {
        int r = it;
        if (r < T_IN) { transpose_item(P.in[I_WIN], 2048, INC, NPAD, (bf16_t*)(ws + WS_WTIN), r, lane); continue; } r -= T_IN;
        if (r < T_A) { transpose_item(P.in[I_WBA], 2048, 2048, 2048, (bf16_t*)(ws + WS_WTA), r, lane); continue; } r -= T_A;
        if (r < T_B) { transpose_item(P.in[I_WBB], 1024, 2048, 2048, (bf16_t*)(ws + WS_WTB), r, lane); continue; } r -= T_B;
        if (r < T_O) { transpose_item(P.in[I_WOUT], 2048, 2048, 2048, (bf16_t*)(ws + WS_WTOUT), r, lane); continue; } r -= T_O;
        if (r < T_Q) { transpose_item(P.in[I_WQ], 2048, 2048, 2048, (bf16_t*)(ws + WS_WTQ), r, lane); continue; } r -= T_Q;
        if (r < T_POOL) { const int g = r >> 5; transpose_item(P.in[I_WPOOL] + g * 65536, 256, 256, 256, (bf16_t*)(ws + WS_WTPOOL) + g * 65536, r & 31, lane); continue; } r -= T_POOL;
        if (r < T_W2) { transpose_item(P.in[I_WW2], 96, 2048, 2048, (bf16_t*)(ws + WS_WTW2), r, lane); continue; } r -= T_W2;
        if (r < T_A2) { transpose_item(P.in[I_WA2], 96, 2048, 2048, (bf16_t*)(ws + WS_WTA2), r, lane); continue; } r -= T_A2;
        if (r < T_G2) { transpose_item(P.in[I_WG2], 256, 2048, 2048, (bf16_t*)(ws + WS_WTG2), r, lane); continue; } r -= T_G2;
        if (r < T_LN) {
            bf16_t* dst = (bf16_t*)(ws + WS_H0B) + (size_t)r * D;
            if (r < NTOK) ln_row_bf16(P.in[I_X] + (size_t)r * D, P.in[I_LNIN_G], P.in[I_LNIN_B], dst, lane);
            else if (r < NTOK + 16) ln_row_bf16(P.in[I_META] + (size_t)(r - NTOK) * D, P.in[I_LNIN_G], P.in[I_LNIN_B], dst, lane);
            else {
#pragma unroll
                for (int j = 0; j < 8; ++j) ((u32x2*)dst)[lane + 64 * j] = (u32x2){0u, 0u};
            }
            continue;
        }
        r -= T_LN;
        {
            const float* s = P.in[I_SUBK] + r * 512 + lane * 8; float f[8];
#pragma unroll
            for (int i = 0; i < 8; ++i) f[i] = s[i];
            *(u32x4*)((bf16_t*)(ws + WS_SUBK) + r * 512 + lane * 8) = pack8(f);
        }
    }
}
namespace pg8 {
struct EpiGateA {
    static constexpr bool PERM = false, AFTER_DRAIN = false;
    float* C; const bf16_t* p; const float* bgate;
    __device__ __forceinline__ void operator()(const f32x4 (&acc)[2][2][4][2], const Unit& u, int wr, int wc, int fr, int fq) const {
        const int row0 = u.pm * BM + wr * 64 + fr, col0 = u.pn * BM + wc * 32 + 4 * fq;
#pragma unroll
        for (int ai = 0; ai < 2; ++ai)
#pragma unroll
            for (int m = 0; m < 4; ++m) { const size_t row = (size_t)(row0 + ai * HALF + m * 16);
#pragma unroll
                for (int bj = 0; bj < 2; ++bj)
#pragma unroll
                    for (int n = 0; n < 2; ++n) { const int col = col0 + bj * HALF + n * 16;
                        const u32x2 pw = *(const u32x2*)(p + row * NPAD + C_G0 + col); const f32x4 bg = *(const f32x4*)(bgate + col);
                        f32x4 g; g.x = sigmoidf_(bflo(pw.x) + bg.x); g.y = sigmoidf_(bfhi(pw.x) + bg.y); g.z = sigmoidf_(bflo(pw.y) + bg.z); g.w = sigmoidf_(bfhi(pw.y) + bg.w);
                        *(f32x4*)(C + row * D + col) = acc[ai][bj][m][n] * g; } }
    }
};
struct EpiGateB {
    static constexpr bool PERM = false, AFTER_DRAIN = false;
    const float* C; bf16_t* O; const bf16_t* p; const float* bgate;
    __device__ __forceinline__ void operator()(const f32x4 (&acc)[2][2][4][2], const Unit& u, int wr, int wc, int fr, int fq) const {
        const int row0 = u.pm * BM + wr * 64 + fr, col0 = u.pn * BM + wc * 32 + 4 * fq;
#pragma unroll
        for (int ai = 0; ai < 2; ++ai)
#pragma unroll
            for (int m = 0; m < 4; ++m) { const size_t row = (size_t)(row0 + ai * HALF + m * 16);
#pragma unroll
                for (int bj = 0; bj < 2; ++bj)
#pragma unroll
                    for (int n = 0; n < 2; ++n) { const int col = col0 + bj * HALF + n * 16;
                        const u32x2 pw = *(const u32x2*)(p + row * NPAD + C_G1 + col); const f32x4 bg = *(const f32x4*)(bgate + D + col);
                        f32x4 g; g.x = sigmoidf_(bflo(pw.x) + bg.x); g.y = sigmoidf_(bfhi(pw.x) + bg.y); g.z = sigmoidf_(bflo(pw.y) + bg.z); g.w = sigmoidf_(bfhi(pw.y) + bg.w);
                        const f32x4 o = *(const f32x4*)(C + row * D + col) + acc[ai][bj][m][n] * g;
                        u32x2 w; w.x = cvt_pk_bf16(o.x, o.y); w.y = cvt_pk_bf16(o.z, o.w);
                        *(u32x2*)(O + row * D + col) = w; } }
    }
};
struct EpiResid {
    static constexpr bool PERM = false, AFTER_DRAIN = false;
    float* C; const bf16_t* h0; float alpha;
    __device__ __forceinline__ void operator()(const f32x4 (&acc)[2][2][4][2], const Unit& u, int wr, int wc, int fr, int fq) const {
        const int row0 = u.pm * BM + wr * 64 + fr, col0 = u.pn * BM + wc * 32 + 4 * fq;
#pragma unroll
        for (int ai = 0; ai < 2; ++ai)
#pragma unroll
            for (int m = 0; m < 4; ++m) { const size_t row = (size_t)(row0 + ai * HALF + m * 16);
#pragma unroll
                for (int bj = 0; bj < 2; ++bj)
#pragma unroll
                    for (int n = 0; n < 2; ++n) { const int col = col0 + bj * HALF + n * 16;
                        const u32x2 hw = *(const u32x2*)(h0 + row * D + col);
                        f32x4 hv; hv.x = bflo(hw.x); hv.y = bfhi(hw.x); hv.z = bflo(hw.y); hv.w = bfhi(hw.y);
                        *(f32x4*)(C + row * D + col) = hv * alpha + acc[ai][bj][m][n]; } }
    }
};
}
template <class Epi>
__device__ __forceinline__ void run_gemm(ldsp lds, const bf16_t* A, const bf16_t* Bt, int M, int N, int K, const Epi& E) {
    pg8::Gemm g; g.A = A; g.Bt = Bt; g.M = M; g.N = N; g.K = K;
    pg8::StaticOrder S; S.init(M, N, (int)gridDim.x, (int)blockIdx.x);
    pg8::gemm_phase<Epi, pg8::StaticOrder, false>(lds, g, S, E, nullptr);
}
constexpr int LD64 = 72, MATB = 64 * LD64 * 2, LDK = 104;
constexpr int O_AB = 0, O_RB = 1 * MATB, O_BH = 2 * MATB, O_KH = 3 * MATB, O_ABT = 4 * MATB, O_BTT = 5 * MATB, O_KTT = 6 * MATB, O_VT = 7 * MATB;
constexpr int O_M0 = 8 * MATB, O_M0T = 9 * MATB, O_M1 = 10 * MATB, O_M1T = 11 * MATB, O_PA = 12 * MATB, O_PB = 13 * MATB, O_MAK = 14 * MATB, O_MRB = 15 * MATB, O_MRK = 16 * MATB;
constexpr int O_ELEND = 17 * MATB, O_WT = O_ELEND + 256;
constexpr int O_WL = 8 * MATB, O_AL = O_WL + 64 * LDK * 2, O_Z = O_AL + 64 * LDK * 2, O_AZ = O_Z + 64 * 68 * 4;
static_assert(O_AZ + 64 * 68 * 4 <= O_ELEND, "lds");
static_assert(O_WT + 2048 <= LDS_BYTES - 16, "lds");

__device__ __forceinline__ bf16x8 ldsfrag(ldsp lds, int off, int ld, int row, int kofs) { return *(const LAS bf16x8*)(lds + off + (row * ld + kofs) * 2); }
__device__ __forceinline__ void st4(ldsp lds, int off, int row, int col, const f32x4 v) {
    u32x2 w; w.x = pk2(v.x, v.y); w.y = pk2(v.z, v.w); *(LAS u32x2*)(lds + off + (row * LD64 + col) * 2) = w; }
__device__ __forceinline__ void st1(ldsp lds, int off, int row, int col, float v) { *(LAS bf16_t*)(lds + off + (row * LD64 + col) * 2) = f2bf1(v); }

__device__ __forceinline__ float fast_rcp(float x) { return __builtin_amdgcn_rcpf(x); }
__device__ __forceinline__ float fast_sigmoid(float x) { return fast_rcp(1.0f + __expf(-x)); }
__device__ __forceinline__ float fast_tanh(float x) { return 1.0f - 2.0f * fast_rcp(1.0f + __expf(2.0f * x)); }
__device__ __forceinline__ u32x4 ld8(const bf16_t* p) { return p ? *(const u32x4*)p : (u32x4){0u, 0u, 0u, 0u}; }
__device__ __forceinline__ void shift8r(const u32x4 cw, const u32x4 pw, const float* mu, float* x) {
    float c[8], q[8]; unpack8(cw, c); unpack8(pw, q);
    const f32x4 m0 = *(const f32x4*)mu, m1 = *(const f32x4*)(mu + 4);
    const float mm[8] = {m0.x, m0.y, m0.z, m0.w, m1.x, m1.y, m1.z, m1.w};
#pragma unroll
    for (int i = 0; i < 8; ++i) x[i] = c[i] + (q[i] - c[i]) * mm[i];
}
__device__ __forceinline__ int tcol(int row, int col) { return ((((col >> 3) ^ (row >> 3)) & 7) << 3) | (col & 7); }
__device__ __forceinline__ bf16x8 ldsfragT(ldsp lds, int off, int row, int kofs) { return *(const LAS bf16x8*)(lds + off + (row * LD64 + tcol(row, kofs)) * 2); }
__device__ __forceinline__ void st1T(ldsp lds, int off, int row, int col, float v) { *(LAS bf16_t*)(lds + off + (row * LD64 + tcol(row, col)) * 2) = f2bf1(v); }
__device__ __forceinline__ void shift8(const bf16_t* pcur, const bf16_t* pprev, const float* mu, float* x) {
    float c[8], q[8];
    if (pcur) unpack8(*(const u32x4*)pcur, c); else {
#pragma unroll
        for (int i = 0; i < 8; ++i) c[i] = 0.f; }
    if (pprev) unpack8(*(const u32x4*)pprev, q); else {
#pragma unroll
        for (int i = 0; i < 8; ++i) q[i] = 0.f; }
    const f32x4 m0 = *(const f32x4*)mu, m1 = *(const f32x4*)(mu + 4);
    const float mm[8] = {m0.x, m0.y, m0.z, m0.w, m1.x, m1.y, m1.z, m1.w};
#pragma unroll
    for (int i = 0; i < 8; ++i) x[i] = c[i] + (q[i] - c[i]) * mm[i];
}

template <bool DO_P, bool DO_SQ>
__device__ __forceinline__ void dbl_step(ldsp lds, int sN, int sT, int dN, int dT, int pC, int pN, int tm, int tn0, int fr, int fq) {
    bf16x8 a[2];
#pragma unroll
    for (int ks = 0; ks < 2; ++ks) a[ks] = ldsfrag(lds, sT, LD64, 16 * tm + fr, ks * 32 + fq * 8);
#pragma unroll
    for (int t2 = 0; t2 < 2; ++t2) {
        const int nt = tn0 + t2, t = 16 * nt + fr, s0 = 16 * tm + 4 * fq;
        if (DO_P) {
            f32x4 acc = {0.f, 0.f, 0.f, 0.f};
#pragma unroll
            for (int ks = 0; ks < 2; ++ks) acc = mfma16(a[ks], ldsfrag(lds, pC, LD64, t, ks * 32 + fq * 8), acc);
            const u32x2 pw = *(const LAS u32x2*)(lds + pC + (t * LD64 + s0) * 2);
            acc.x += bflo(pw.x); acc.y += bfhi(pw.x); acc.z += bflo(pw.y); acc.w += bfhi(pw.y);
            st4(lds, pN, t, s0, acc);
        }
        if (DO_SQ) {
            f32x4 acc = {0.f, 0.f, 0.f, 0.f};
#pragma unroll
            for (int ks = 0; ks < 2; ++ks) acc = mfma16(a[ks], ldsfrag(lds, sN, LD64, t, ks * 32 + fq * 8), acc);
            st4(lds, dN, t, s0, acc);
            st1(lds, dT, s0 + 0, t, acc.x); st1(lds, dT, s0 + 1, t, acc.y); st1(lds, dT, s0 + 2, t, acc.z); st1(lds, dT, s0 + 3, t, acc.w);
        }
    }
}


#ifdef DBG_STAGE
constexpr size_t DBG_STRIDE = (size_t)NUNITS * 512 * 4;
__device__ __forceinline__ void dbgsum(const Params& P, ldsp lds, int u, int stage, const int* offs, int nmat) {
    unsigned acc = 0;
    for (int m = 0; m < nmat; ++m)
        for (int k = 0; k < 4; ++k) { const int idx = threadIdx.x + 512 * k, row = idx >> 5, cp = idx & 31; const unsigned x = *(const LAS unsigned*)(lds + offs[m] + row * (LD64 * 2) + cp * 4); acc += (x & 0xffffu) + (x >> 16); }
    ((unsigned*)(P.ws + WS_S0T + (size_t)stage * DBG_STRIDE))[(size_t)u * 512 + threadIdx.x] = acc;
}
#define DBGSUM(stage, ...) do { const int offs_[] = {__VA_ARGS__}; dbgsum(P, lds, u, stage, offs_, (int)(sizeof(offs_) / sizeof(int))); } while (0)
#else
#define DBGSUM(stage, ...) do { } while (0)
#endif
struct PL { u32x4 rc, rq, kc, kq, vc, vq, cw[3], pw[3]; bf16x8 aw[3], aa[3]; };
__device__ __forceinline__ const bf16_t* unit_rowp(const bf16_t* pp, int u, int tl, int col) {
    int r;
    if (u >= 4096) r = (tl >= 48) ? (ROW_META + tl - 48) : -1;
    else { const int bh = u >> 6, c = u & 63, b = bh >> 5; r = (tl >= 0 || c > 0) ? (b * SEQ + c * 64 + tl) : (ROW_META + 15); }
    return r < 0 ? (const bf16_t*)nullptr : pp + (size_t)r * NPAD + col;
}
__device__ __forceinline__ void pl_load(const Params& P, int u, PL& L) {
    int tid = threadIdx.x; asm volatile("" : "+v"(tid));
    const int lane = tid & 63, wave = tid >> 6, fr = lane & 15, fq = lane >> 4, tm = wave >> 1;
    const bf16_t* pp = (const bf16_t*)(P.ws + WS_P);
    const int h = (u >= 4096) ? (u - 4096) : ((u >> 6) & 31);
    const int t = tid >> 3, hj = h * 64 + 8 * (tid & 7);
    L.rc = ld8(unit_rowp(pp, u, t, C_R + hj)); L.rq = ld8(unit_rowp(pp, u, t - 1, C_R + hj));
    L.kc = ld8(unit_rowp(pp, u, t, C_K + hj)); L.kq = ld8(unit_rowp(pp, u, t - 1, C_K + hj));
    L.vc = ld8(unit_rowp(pp, u, t, C_V + hj)); L.vq = ld8(unit_rowp(pp, u, t - 1, C_V + hj));
#pragma unroll
    for (int it = 0; it < 3; ++it) { const int idx = tid + 512 * it, mat = idx / 768, rem = idx - mat * 768, tt = rem / 12, ch = rem - tt * 12, col = (mat ? C_AL : C_WL) + ch * 8;
        L.cw[it] = ld8(unit_rowp(pp, u, tt, col)); L.pw[it] = ld8(unit_rowp(pp, u, tt - 1, col)); }
    const bf16_t* ww2 = (const bf16_t*)(P.ws + WS_WTW2) + (size_t)(h * 64 + 16 * tm + fr) * 96 + fq * 8;
    const bf16_t* wa2 = (const bf16_t*)(P.ws + WS_WTA2) + (size_t)(h * 64 + 16 * tm + fr) * 96 + fq * 8;
#pragma unroll
    for (int ks = 0; ks < 3; ++ks) { L.aw[ks] = *(const bf16x8*)(ww2 + ks * 32); L.aa[ks] = *(const bf16x8*)(wa2 + ks * 32); }
}
__device__ __forceinline__ void rwkv_unit(const Params& P, ldsp lds, int u, PL& L, int next_u) {
    int tid = threadIdx.x; asm volatile("" : "+v"(tid));
    const int lane = tid & 63, wave = tid >> 6, fr = lane & 15, fq = lane >> 4, tm = wave >> 1, tn0 = (wave & 1) * 2;
    unsigned char* ws = P.ws;
    const bf16_t* pp = (const bf16_t*)(ws + WS_P);
    const bool meta = u >= 4096;
    int b = 0, h, c = 0;
    if (meta) { h = u - 4096; } else { const int bh = u >> 6; c = u & 63; b = bh >> 5; h = bh & 31; }
    auto rowof = [&](int tl) -> int {
        if (meta) return (tl >= 48) ? (ROW_META + tl - 48) : -1;
        if (tl >= 0 || c > 0) return b * SEQ + c * 64 + tl;
        return ROW_META + 15;
    };
    auto rowp = [&](int tl, int col) -> const bf16_t* { const int r = rowof(tl); return r < 0 ? (const bf16_t*)nullptr : pp + (size_t)r * NPAD + col; };
    const float* mu = P.in[I_MU];
#ifndef RPT_AD
#define RPT_AD 1
#define RPT_E12 1
#define RPT_E35 1
#endif
    float lw[8], av[8], rv[8], kv[8], vv[8], kk[8], km[8];
    const int t = tid >> 3, jq = tid & 7, j0 = 8 * jq, hj = h * 64 + j0;
    const bool nulltok = meta && t < 48;
    for (int rpt_ = 0; rpt_ < RPT_AD; ++rpt_) {
    {
#pragma unroll
        for (int it = 0; it < 3; ++it) { const int idx = tid + 512 * it, mat = idx / 768, rem = idx - mat * 768, tt = rem / 12, ch = rem - tt * 12, col = (mat ? C_AL : C_WL) + ch * 8;
            float x[8]; shift8r(L.cw[it], L.pw[it], mu + col, x);
            if (mat == 0) {
#pragma unroll
                for (int i = 0; i < 8; ++i) x[i] = fast_tanh(x[i]);
            }
            *(LAS u32x4*)(lds + (mat ? O_AL : O_WL) + (tt * LDK + ch * 8) * 2) = pack8(x); }
    }
    BLOCK_SYNC();
    {
        f32x4 z[2] = {{0.f, 0.f, 0.f, 0.f}, {0.f, 0.f, 0.f, 0.f}}, az[2] = {{0.f, 0.f, 0.f, 0.f}, {0.f, 0.f, 0.f, 0.f}};
#pragma unroll
        for (int ks = 0; ks < 3; ++ks) {
            const bf16x8 aw = L.aw[ks], aa = L.aa[ks];
#pragma unroll
            for (int t2 = 0; t2 < 2; ++t2) {
                const int t = 16 * (tn0 + t2) + fr;
                z[t2] = mfma16(aw, ldsfrag(lds, O_WL, LDK, t, ks * 32 + fq * 8), z[t2]);
                az[t2] = mfma16(aa, ldsfrag(lds, O_AL, LDK, t, ks * 32 + fq * 8), az[t2]);
            }
        }
#pragma unroll
        for (int t2 = 0; t2 < 2; ++t2) {
            const int t = 16 * (tn0 + t2) + fr, j0 = 16 * tm + 4 * fq;
            *(LAS f32x4*)(lds + O_Z + (t * 68 + j0) * 4) = z[t2];
            *(LAS f32x4*)(lds + O_AZ + (t * 68 + j0) * 4) = az[t2];
        }
    }
    BLOCK_SYNC();
    float cs[8];
    {
        const f32x4 z0 = *(const LAS f32x4*)(lds + O_Z + (t * 68 + j0) * 4), z1 = *(const LAS f32x4*)(lds + O_Z + (t * 68 + j0 + 4) * 4);
        const f32x4 y0 = *(const LAS f32x4*)(lds + O_AZ + (t * 68 + j0) * 4), y1 = *(const LAS f32x4*)(lds + O_AZ + (t * 68 + j0 + 4) * 4);
        const float zz[8] = {z0.x, z0.y, z0.z, z0.w, z1.x, z1.y, z1.z, z1.w}, yy[8] = {y0.x, y0.y, y0.z, y0.w, y1.x, y1.y, y1.z, y1.w};
        const f32x4 w0a = *(const f32x4*)(P.in[I_W0] + hj), w0b = *(const f32x4*)(P.in[I_W0] + hj + 4), a0a = *(const f32x4*)(P.in[I_A0] + hj), a0b = *(const f32x4*)(P.in[I_A0] + hj + 4);
        const float w0[8] = {w0a.x, w0a.y, w0a.z, w0a.w, w0b.x, w0b.y, w0b.z, w0b.w}, a0[8] = {a0a.x, a0a.y, a0a.z, a0a.w, a0b.x, a0b.y, a0b.z, a0b.w};
#pragma unroll
        for (int i = 0; i < 8; ++i) { lw[i] = nulltok ? 0.f : -DSCALE * fast_sigmoid(w0[i] + zz[i]); av[i] = fast_sigmoid(a0[i] + yy[i]); cs[i] = lw[i]; }
#pragma unroll
        for (int d = 8; d < 64; d <<= 1) {
#pragma unroll
            for (int i = 0; i < 8; ++i) { const float o = __shfl_up(cs[i], d); cs[i] += (lane >= d) ? o : 0.f; }
        }
        if (lane >= 56) { *(LAS f32x4*)(lds + O_WT + (wave * 64 + j0) * 4) = (f32x4){cs[0], cs[1], cs[2], cs[3]}; *(LAS f32x4*)(lds + O_WT + (wave * 64 + j0 + 4) * 4) = (f32x4){cs[4], cs[5], cs[6], cs[7]}; }
        shift8r(L.rc, L.rq, mu + C_R + hj, rv); shift8r(L.kc, L.kq, mu + C_K + hj, kv); shift8r(L.vc, L.vq, mu + C_V + hj, vv);
        if (nulltok) {
#pragma unroll
            for (int i = 0; i < 8; ++i) { rv[i] = 0.f; kv[i] = 0.f; vv[i] = 0.f; }
        }
        const f32x4 kka = *(const f32x4*)(P.in[I_KK] + hj), kkb = *(const f32x4*)(P.in[I_KK] + hj + 4), kaa = *(const f32x4*)(P.in[I_KA] + hj), kab = *(const f32x4*)(P.in[I_KA] + hj + 4);
        const f32x4 rka = *(const f32x4*)(P.in[I_RK] + hj), rkb = *(const f32x4*)(P.in[I_RK] + hj + 4);
        const float kkw[8] = {kka.x, kka.y, kka.z, kka.w, kkb.x, kkb.y, kkb.z, kkb.w}, kaw[8] = {kaa.x, kaa.y, kaa.z, kaa.w, kab.x, kab.y, kab.z, kab.w}, rkw[8] = {rka.x, rka.y, rka.z, rka.w, rkb.x, rkb.y, rkb.z, rkb.w};
        float n2 = 0.f, bon = 0.f;
#pragma unroll
        for (int i = 0; i < 8; ++i) { kk[i] = kv[i] * kkw[i]; n2 += kk[i] * kk[i]; km[i] = kv[i] * (1.0f + (av[i] - 1.0f) * kaw[i]); bon += rv[i] * km[i] * rkw[i]; }
        n2 += DPPF(n2, 0xB1); n2 += DPPF(n2, 0x4E); n2 += DPPF(n2, 0x141);
        bon += DPPF(bon, 0xB1); bon += DPPF(bon, 0x4E); bon += DPPF(bon, 0x141);
        const float inv = 1.0f / fmaxf(sqrtf(n2), 1e-12f);
#pragma unroll
        for (int i = 0; i < 8; ++i) kk[i] *= inv;
        if (!meta && jq == 0) ((float*)(ws + WS_BONUS))[(size_t)(b * SEQ + c * 64 + t) * 32 + h] = bon;
    }
    BLOCK_SYNC();
    {
        float Lc[8], Le[8];
#pragma unroll
        for (int i = 0; i < 8; ++i) { Lc[i] = cs[i]; Le[i] = 0.f; }
#pragma unroll
        for (int w = 0; w < 8; ++w) {
            const f32x4 x0 = *(const LAS f32x4*)(lds + O_WT + (w * 64 + j0) * 4), x1 = *(const LAS f32x4*)(lds + O_WT + (w * 64 + j0 + 4) * 4);
            const float xx[8] = {x0.x, x0.y, x0.z, x0.w, x1.x, x1.y, x1.z, x1.w};
            const float msk = w < wave ? 1.0f : 0.0f;
#pragma unroll
            for (int i = 0; i < 8; ++i) { Le[i] += xx[i]; Lc[i] += msk * xx[i]; }
        }
        float Ab[8], Rb[8], Bh[8], Kh[8], Bt[8], Kt[8];
#pragma unroll
        for (int i = 0; i < 8; ++i) {
            const float eP = __expf(Lc[i] - lw[i]), eC = __expf(Lc[i]), eN = __expf(-Lc[i]), eE = __expf(Le[i] - Lc[i]);
            const float ka = kk[i] * av[i];
            Ab[i] = -kk[i] * eP; Rb[i] = rv[i] * eC; Bh[i] = ka * eN; Kh[i] = km[i] * eN; Bt[i] = ka * eE; Kt[i] = km[i] * eE;
        }
        *(LAS u32x4*)(lds + O_AB + (t * LD64 + j0) * 2) = pack8(Ab);
        *(LAS u32x4*)(lds + O_RB + (t * LD64 + j0) * 2) = pack8(Rb);
        *(LAS u32x4*)(lds + O_BH + (t * LD64 + j0) * 2) = pack8(Bh);
        *(LAS u32x4*)(lds + O_KH + (t * LD64 + j0) * 2) = pack8(Kh);
#pragma unroll
        for (int i = 0; i < 8; ++i) { st1T(lds, O_ABT, j0 + i, t, Ab[i]); st1T(lds, O_BTT, j0 + i, t, Bt[i]); st1T(lds, O_KTT, j0 + i, t, Kt[i]); st1T(lds, O_VT, j0 + i, t, vv[i]); }
        if (t == 63) {
#pragma unroll
            for (int i = 0; i < 8; ++i) *(LAS float*)(lds + O_ELEND + (j0 + i) * 4) = __expf(Le[i]);
        }
    }
    BLOCK_SYNC();
    }
    if (next_u >= 0) pl_load(P, next_u, L);
    DBGSUM(0, O_AB, O_RB, O_BH, O_KH, O_ABT, O_BTT, O_KTT, O_VT);
    for (int rpt_ = 0; rpt_ < RPT_E12; ++rpt_) {
    {
        bf16x8 abh[2], akh[2];
#pragma unroll
        for (int ks = 0; ks < 2; ++ks) { abh[ks] = ldsfrag(lds, O_BH, LD64, 16 * tm + fr, ks * 32 + fq * 8); akh[ks] = ldsfrag(lds, O_KH, LD64, 16 * tm + fr, ks * 32 + fq * 8); }
#pragma unroll
        for (int t2 = 0; t2 < 2; ++t2) {
            const int tt = 16 * (tn0 + t2) + fr, s0 = 16 * tm + 4 * fq;
            f32x4 mab = {0.f, 0.f, 0.f, 0.f}, mak = mab, mrb = mab, mrk = mab;
#pragma unroll
            for (int ks = 0; ks < 2; ++ks) {
                const bf16x8 bab = ldsfrag(lds, O_AB, LD64, tt, ks * 32 + fq * 8), brb = ldsfrag(lds, O_RB, LD64, tt, ks * 32 + fq * 8);
                mab = mfma16(abh[ks], bab, mab); mak = mfma16(akh[ks], bab, mak); mrb = mfma16(abh[ks], brb, mrb); mrk = mfma16(akh[ks], brb, mrk);
            }
            float vab[4] = {mab.x, mab.y, mab.z, mab.w}, vak[4] = {mak.x, mak.y, mak.z, mak.w}, vrb[4] = {mrb.x, mrb.y, mrb.z, mrb.w}, vrk[4] = {mrk.x, mrk.y, mrk.z, mrk.w}, vp[4];
#pragma unroll
            for (int r = 0; r < 4; ++r) { const int s = s0 + r; const bool st = s < tt, le = s <= tt;
                vab[r] = st ? vab[r] : 0.f; vak[r] = st ? vak[r] : 0.f; vrb[r] = le ? vrb[r] : 0.f; vrk[r] = le ? vrk[r] : 0.f; vp[r] = vab[r] + (s == tt ? 1.0f : 0.f); }
            st4(lds, O_M0, tt, s0, (f32x4){vab[0], vab[1], vab[2], vab[3]});
#pragma unroll
            for (int r = 0; r < 4; ++r) st1(lds, O_M0T, s0 + r, tt, vab[r]);
            st4(lds, O_PA, tt, s0, (f32x4){vp[0], vp[1], vp[2], vp[3]});
            st4(lds, O_MAK, tt, s0, (f32x4){vak[0], vak[1], vak[2], vak[3]});
            st4(lds, O_MRB, tt, s0, (f32x4){vrb[0], vrb[1], vrb[2], vrb[3]});
            st4(lds, O_MRK, tt, s0, (f32x4){vrk[0], vrk[1], vrk[2], vrk[3]});
        }
    }
    BLOCK_SYNC();
    DBGSUM(1, O_M0, O_M0T, O_PA, O_MAK, O_MRB, O_MRK);
    dbl_step<false, true>(lds, O_M0, O_M0T, O_M1, O_M1T, 0, 0, tm, tn0, fr, fq); BLOCK_SYNC();
    dbl_step<true, true>(lds, O_M1, O_M1T, O_M0, O_M0T, O_PA, O_PB, tm, tn0, fr, fq); BLOCK_SYNC();
    dbl_step<true, true>(lds, O_M0, O_M0T, O_M1, O_M1T, O_PB, O_PA, tm, tn0, fr, fq); BLOCK_SYNC();
    dbl_step<true, true>(lds, O_M1, O_M1T, O_M0, O_M0T, O_PA, O_PB, tm, tn0, fr, fq); BLOCK_SYNC();
    dbl_step<true, true>(lds, O_M0, O_M0T, O_M1, O_M1T, O_PB, O_PA, tm, tn0, fr, fq); BLOCK_SYNC();
    dbl_step<true, false>(lds, O_M1, O_M1T, 0, 0, O_PA, O_PB, tm, tn0, fr, fq); BLOCK_SYNC();
    }
    DBGSUM(2, O_PB);
    const size_t ub = (size_t)u * 4096;
    for (int rpt_ = 0; rpt_ < RPT_E35; ++rpt_) {
    {
        bf16x8 aT[2], aMak[2];
#pragma unroll
        for (int ks = 0; ks < 2; ++ks) { aT[ks] = ldsfrag(lds, O_PB, LD64, 16 * tm + fr, ks * 32 + fq * 8); aMak[ks] = ldsfrag(lds, O_MAK, LD64, 16 * tm + fr, ks * 32 + fq * 8); }
#pragma unroll
        for (int t2 = 0; t2 < 2; ++t2) {
            const int n = 16 * (tn0 + t2) + fr, t0 = 16 * tm + 4 * fq;
            f32x4 at = {0.f, 0.f, 0.f, 0.f}, xt = at;
#pragma unroll
            for (int ks = 0; ks < 2; ++ks) { at = mfma16(aT[ks], ldsfragT(lds, O_ABT, n, ks * 32 + fq * 8), at); xt = mfma16(aMak[ks], ldsfragT(lds, O_VT, n, ks * 32 + fq * 8), xt); }
            st4(lds, O_M0, n, t0, at); st4(lds, O_M0T, n, t0, xt);
        }
    }
    BLOCK_SYNC();
    DBGSUM(3, O_M0, O_M0T);
    {
        bf16x8 aT[2], aAt[2];
#pragma unroll
        for (int ks = 0; ks < 2; ++ks) { aT[ks] = ldsfrag(lds, O_PB, LD64, 16 * tm + fr, ks * 32 + fq * 8); aAt[ks] = ldsfrag(lds, O_M0, LD64, 16 * tm + fr, ks * 32 + fq * 8); }
        bf16_t* Rt = (bf16_t*)(ws + WS_RT) + ub; bf16_t* Gp = (bf16_t*)(ws + WS_G) + ub;
#pragma unroll
        for (int t2 = 0; t2 < 2; ++t2) {
            const int n = 16 * (tn0 + t2) + fr, m0 = 16 * tm + 4 * fq;
            f32x4 u0 = {0.f, 0.f, 0.f, 0.f}, rt = u0, g = u0;
#pragma unroll
            for (int ks = 0; ks < 2; ++ks) {
                u0 = mfma16(aT[ks], ldsfrag(lds, O_M0T, LD64, n, ks * 32 + fq * 8), u0);
                rt = mfma16(aAt[ks], ldsfrag(lds, O_MRB, LD64, n, ks * 32 + fq * 8), rt);
                g = mfma16(aAt[ks], ldsfragT(lds, O_BTT, n, ks * 32 + fq * 8), g);
            }
            st4(lds, O_M1, n, m0, u0);
            const u32x2 rw = *(const LAS u32x2*)(lds + O_RB + (n * LD64 + m0) * 2);
            rt.x += bflo(rw.x); rt.y += bfhi(rw.x); rt.z += bflo(rw.y); rt.w += bfhi(rw.y);
            { u32x2 w; w.x = pk2(rt.x, rt.y); w.y = pk2(rt.z, rt.w); *(u32x2*)(Rt + n * 64 + m0) = w; }
            if ((n >> 2) == (m0 >> 2)) { const float e = *(const LAS float*)(lds + O_ELEND + n * 4); const int r = n & 3;
                g.x += (r == 0) ? e : 0.f; g.y += (r == 1) ? e : 0.f; g.z += (r == 2) ? e : 0.f; g.w += (r == 3) ? e : 0.f; }
            { const int pos0 = 32 * (tm >> 1) + 8 * fq + 4 * (tm & 1); u32x2 w; w.x = pk2(g.x, g.y); w.y = pk2(g.z, g.w); *(u32x2*)(Gp + n * 64 + pos0) = w; }
        }
    }
    BLOCK_SYNC();
    DBGSUM(4, O_M1);
    {
        bf16x8 aB[2], aK[2], aU[2], aV[2];
#pragma unroll
        for (int ks = 0; ks < 2; ++ks) { const int row = 16 * tm + fr, ko = ks * 32 + fq * 8;
            aB[ks] = ldsfragT(lds, O_BTT, row, ko); aK[ks] = ldsfragT(lds, O_KTT, row, ko); aU[ks] = ldsfrag(lds, O_M1, LD64, row, ko); aV[ks] = ldsfragT(lds, O_VT, row, ko); }
        bf16_t* H0t = (bf16_t*)(ws + WS_H0T) + ub; bf16_t* Y0s = (bf16_t*)(ws + WS_Y0) + ub;
#pragma unroll
        for (int t2 = 0; t2 < 2; ++t2) {
            const int n = 16 * (tn0 + t2) + fr, m0 = 16 * tm + 4 * fq;
            f32x4 hh = {0.f, 0.f, 0.f, 0.f}, yy = hh;
#pragma unroll
            for (int ks = 0; ks < 2; ++ks) { const int ko = ks * 32 + fq * 8;
                const bf16x8 bU = ldsfrag(lds, O_M1, LD64, n, ko), bV = ldsfragT(lds, O_VT, n, ko), bRb = ldsfrag(lds, O_MRB, LD64, n, ko), bRk = ldsfrag(lds, O_MRK, LD64, n, ko);
                hh = mfma16(aB[ks], bU, hh); hh = mfma16(aK[ks], bV, hh);
                yy = mfma16(aU[ks], bRb, yy); yy = mfma16(aV[ks], bRk, yy); }
            { u32x2 w; w.x = pk2(hh.x, hh.y); w.y = pk2(hh.z, hh.w); *(u32x2*)(H0t + n * 64 + m0) = w; }
            { u32x2 w; w.x = pk2(yy.x, yy.y); w.y = pk2(yy.z, yy.w); *(u32x2*)(Y0s + n * 64 + m0) = w; }
        }
    }
    BLOCK_SYNC();
    }
}

constexpr int LDU = 264;
__device__ __forceinline__ void pool_unit(const Params& P, ldsp lds, int pu) {
    int tid = threadIdx.x; asm volatile("" : "+v"(tid));
    const int lane = tid & 63, wave = tid >> 6, fr = lane & 15, fq = lane >> 4;
    unsigned char* ws = P.ws;
    const bf16_t* pp = (const bf16_t*)(ws + WS_P);
    const int g = pu & 3, tt = pu >> 2, b = tt >> 6, ti0 = (tt & 63) * 64;
    constexpr int O_U = 0, O_PL = 79 * LDU * 2;
    for (int idx = tid; idx < 79 * 32; idx += 512) {
        const int lr = idx >> 5, ch = idx & 31, ti = ti0 + lr - 15;
        const int row = ti >= 0 ? b * SEQ + ti : ROW_META + 16 + ti;
        *(LAS u32x4*)(lds + O_U + (lr * LDU + ch * 8) * 2) = *(const u32x4*)(pp + (size_t)row * NPAD + C_POOL + g * 256 + ch * 8);
    }
    BLOCK_SYNC();
    {
        const int t = tid >> 3, cq = tid & 7, win = 2 << g; const float inv = 1.0f / (float)win;
#pragma unroll
        for (int cc = 0; cc < 4; ++cc) {
            const int c0 = cq * 32 + cc * 8; float s[8], own[8];
            unpack8(*(const LAS u32x4*)(lds + O_U + ((15 + t) * LDU + c0) * 2), own);
#pragma unroll
            for (int i = 0; i < 8; ++i) s[i] = own[i];
            for (int d = 1; d < win; ++d) { float x[8]; unpack8(*(const LAS u32x4*)(lds + O_U + ((15 + t - d) * LDU + c0) * 2), x);
#pragma unroll
                for (int i = 0; i < 8; ++i) s[i] += x[i]; }
#pragma unroll
            for (int i = 0; i < 8; ++i) s[i] = s[i] * inv - own[i];
            *(LAS u32x4*)(lds + O_PL + (t * LDU + c0) * 2) = pack8(s);
        }
    }
    BLOCK_SYNC();
    {
        const bf16_t* wt = (const bf16_t*)(ws + WS_WTPOOL) + (size_t)g * 65536;
        f32x4 acc[2][4];
#pragma unroll
        for (int a = 0; a < 2; ++a)
#pragma unroll
            for (int n = 0; n < 4; ++n) acc[a][n] = (f32x4){0.f, 0.f, 0.f, 0.f};
#pragma unroll 4
        for (int ks = 0; ks < 8; ++ks) {
            bf16x8 af[2];
#pragma unroll
            for (int a = 0; a < 2; ++a) af[a] = *(const bf16x8*)(wt + (size_t)(32 * wave + 16 * a + fr) * 256 + ks * 32 + fq * 8);
#pragma unroll
            for (int n = 0; n < 4; ++n) { const bf16x8 bf = ldsfrag(lds, O_PL, LDU, 16 * n + fr, ks * 32 + fq * 8);
#pragma unroll
                for (int a = 0; a < 2; ++a) acc[a][n] = mfma16(af[a], bf, acc[a][n]); }
        }
        bf16_t* yb = (bf16_t*)(ws + WS_YB);
        const float* psc = P.in[I_PSCALE] + g * 256;
#pragma unroll
        for (int a = 0; a < 2; ++a) { const int d0 = 32 * wave + 16 * a + 4 * fq; const f32x4 sc = *(const f32x4*)(psc + d0);
#pragma unroll
            for (int n = 0; n < 4; ++n) { const int t = 16 * n + fr; const f32x4 o = acc[a][n] * sc;
                u32x2 w; w.x = pk2(o.x, o.y); w.y = pk2(o.z, o.w);
                *(u32x2*)(yb + (size_t)(b * SEQ + ti0 + t) * 1024 + g * 256 + d0) = w; } }
    }
    BLOCK_SYNC();
}
__device__ __forceinline__ void gsig_unit(const Params& P, int gu) {
    int tid = threadIdx.x; asm volatile("" : "+v"(tid));
    const bf16_t* pp = (const bf16_t*)(P.ws + WS_P); bf16_t* gs = (bf16_t*)(P.ws + WS_GSIG);
    const float* mu = P.in[I_MU];
#pragma unroll
    for (int it = 0; it < 4; ++it) {
        const int idx = tid + 512 * it, tl = idx >> 5, ch = idx & 31, col = C_GL + ch * 8;
        const int row = gu * 64 + tl; const int prow = ((row & (SEQ - 1)) == 0) ? (ROW_META + 15) : row - 1;
        float x[8]; shift8r(*(const u32x4*)(pp + (size_t)row * NPAD + col), *(const u32x4*)(pp + (size_t)prow * NPAD + col), mu + col, x);
#pragma unroll
        for (int i = 0; i < 8; ++i) x[i] = fast_sigmoid(x[i]);
        *(u32x4*)(gs + (size_t)row * 256 + ch * 8) = pack8(x);
    }
}
__device__ __forceinline__ void phase2(const Params& P, ldsp lds) {
    PL L;
    if ((int)blockIdx.x < NUNITS) pl_load(P, blockIdx.x, L);
    for (int u = blockIdx.x; u < NUNITS + 512 + 128; u += gridDim.x) {
        if (u < NUNITS) { const int nu = u + (int)gridDim.x; rwkv_unit(P, lds, u, L, nu < NUNITS ? nu : -1); }
        else if (u < NUNITS + 512) pool_unit(P, lds, u - NUNITS);
        else gsig_unit(P, u - NUNITS - 512);
    }
}
__device__ __forceinline__ void phase3(const Params& P) {
    const int lane = threadIdx.x & 63, wave = threadIdx.x >> 6, fr = lane & 15, fq = lane >> 4;
    if (wave != 0) return;
    unsigned char* ws = P.ws;
    const bf16_t* Gp = (const bf16_t*)(ws + WS_G); const bf16_t* H0t = (const bf16_t*)(ws + WS_H0T); bf16_t* S0t = (bf16_t*)(ws + WS_S0T);
    for (int item = blockIdx.x; item < 256; item += gridDim.x) {
        const int bh = item >> 2, vq = item & 3, h = bh & 31;
        bf16x8 Sb[2];
#pragma unroll
        for (int ks = 0; ks < 2; ++ks)
#pragma unroll
            for (int i = 0; i < 8; ++i) Sb[ks][i] = 0;
        bf16x8 gA[4][2]; u32x2 hF[4];
        auto load = [&](int step, bf16x8 (&ga)[4][2], u32x2 (&hf)[4]) {
            const int u = (step == 0) ? (4096 + h) : (bh * 64 + step - 1);
            const bf16_t* g = Gp + (size_t)u * 4096; const bf16_t* hh = H0t + (size_t)u * 4096;
#pragma unroll
            for (int mt = 0; mt < 4; ++mt) {
#pragma unroll
                for (int ks = 0; ks < 2; ++ks) ga[mt][ks] = *(const bf16x8*)(g + (16 * mt + fr) * 64 + ks * 32 + fq * 8);
                hf[mt] = *(const u32x2*)(hh + (16 * vq + fr) * 64 + 16 * mt + 4 * fq);
            }
        };
        load(0, gA, hF);
        for (int step = 0; step < 64; ++step) {
            bf16x8 gN[4][2]; u32x2 hN[4];
            if (step + 1 < 64) load(step + 1, gN, hN);
            f32x4 acc[4];
#pragma unroll
            for (int mt = 0; mt < 4; ++mt) {
                acc[mt] = (f32x4){bflo(hF[mt].x), bfhi(hF[mt].x), bflo(hF[mt].y), bfhi(hF[mt].y)};
                acc[mt] = mfma16(gA[mt][0], Sb[0], acc[mt]);
                acc[mt] = mfma16(gA[mt][1], Sb[1], acc[mt]);
            }
            bf16_t* so = S0t + (size_t)(bh * 64 + step) * 4096 + (16 * vq + fr) * 64 + 4 * fq;
            u32x2 w[4];
#pragma unroll
            for (int mt = 0; mt < 4; ++mt) { w[mt].x = pk2(acc[mt].x, acc[mt].y); w[mt].y = pk2(acc[mt].z, acc[mt].w); *(u32x2*)(so + 16 * mt) = w[mt]; }
#pragma unroll
            for (int ks = 0; ks < 2; ++ks) {
                const u32x4 q = (u32x4){w[2 * ks].x, w[2 * ks].y, w[2 * ks + 1].x, w[2 * ks + 1].y};
                Sb[ks] = __builtin_bit_cast(bf16x8, q);
            }
            if (step + 1 < 64) {
#pragma unroll
                for (int mt = 0; mt < 4; ++mt) { gA[mt][0] = gN[mt][0]; gA[mt][1] = gN[mt][1]; hF[mt] = hN[mt]; }
            }
        }
    }
}

constexpr int LDG = 264;
__device__ __forceinline__ void phase3b(const Params& P, ldsp lds) {
    int tid = threadIdx.x; asm volatile("" : "+v"(tid));
    const int lane = tid & 63, wave = tid >> 6, fr = lane & 15, fq = lane >> 4, wq = wave & 3;
    unsigned char* ws = P.ws;
    const bf16_t* pp = (const bf16_t*)(ws + WS_P);
    const float* mu = P.in[I_MU];
    constexpr int O_G2 = 0;
    for (int w = blockIdx.x; w < 256; w += gridDim.x) {
        const int h = w & 31;
        BLOCK_SYNC();
        for (int idx = tid; idx < 64 * 32; idx += 512) { const int row = idx >> 5, ch = idx & 31;
            *(LAS u32x4*)(lds + O_G2 + (row * LDG + ch * 8) * 2) = *(const u32x4*)((const bf16_t*)(ws + WS_WTG2) + (size_t)(h * 64 + row) * 256 + ch * 8); }
        BLOCK_SYNC();
        bf16x8 bG[8], bR[2], aS[4][2]; u32x2 yw[4], vc[4], vp[4]; float bon;
        auto unit_of = [&](int it, int& b, int& c) { const int q = (w >> 5) + 8 * (2 * it + (wave >> 2)); b = q >> 6; c = q & 63; };
        auto issue = [&](int it) {
            int b, c; unit_of(it, b, c); const int u = (b * 32 + h) * 64 + c, trow0 = b * SEQ + c * 64 + 16 * wq;
            const size_t ub = (size_t)u * 4096;
            const bf16_t* S0t = (const bf16_t*)(ws + WS_S0T) + ub; const bf16_t* Rt = (const bf16_t*)(ws + WS_RT) + ub; const bf16_t* Y0s = (const bf16_t*)(ws + WS_Y0) + ub;
            const int row = trow0 + fr; const int prow = (c == 0 && wq == 0 && fr == 0) ? (ROW_META + 15) : row - 1;
            const bf16_t* gsr = (const bf16_t*)(ws + WS_GSIG) + (size_t)row * 256 + fq * 8;
#pragma unroll
            for (int ks = 0; ks < 8; ++ks) bG[ks] = *(const bf16x8*)(gsr + ks * 32);
#pragma unroll
            for (int ks = 0; ks < 2; ++ks) bR[ks] = *(const bf16x8*)(Rt + (16 * wq + fr) * 64 + ks * 32 + fq * 8);
#pragma unroll
            for (int mt = 0; mt < 4; ++mt) {
                yw[mt] = *(const u32x2*)(Y0s + (16 * wq + fr) * 64 + 16 * mt + 4 * fq);
#pragma unroll
                for (int ks = 0; ks < 2; ++ks) aS[mt][ks] = *(const bf16x8*)(S0t + (16 * mt + fr) * 64 + ks * 32 + fq * 8);
                const int hc = h * 64 + 16 * mt + 4 * fq;
                vc[mt] = *(const u32x2*)(pp + (size_t)row * NPAD + C_V + hc); vp[mt] = *(const u32x2*)(pp + (size_t)prow * NPAD + C_V + hc);
            }
            bon = ((const float*)(ws + WS_BONUS))[(size_t)row * 32 + h];
        };
        issue(0);
#pragma unroll 1
        for (int it = 0; it < 8; ++it) {
            int b, c; unit_of(it, b, c);
            const int row = b * SEQ + c * 64 + 16 * wq + fr;
            f32x4 gacc[4];
#pragma unroll
            for (int mt = 0; mt < 4; ++mt) gacc[mt] = (f32x4){0.f, 0.f, 0.f, 0.f};
#pragma unroll
            for (int ks = 0; ks < 8; ++ks)
#pragma unroll
                for (int mt = 0; mt < 4; ++mt) gacc[mt] = mfma16(*(const LAS bf16x8*)(lds + O_G2 + ((16 * mt + fr) * LDG + ks * 32 + fq * 8) * 2), bG[ks], gacc[mt]);
            f32x4 y[4], vv[4]; const float bonc = bon;
#pragma unroll
            for (int mt = 0; mt < 4; ++mt) {
                y[mt] = (f32x4){bflo(yw[mt].x), bfhi(yw[mt].x), bflo(yw[mt].y), bfhi(yw[mt].y)};
#pragma unroll
                for (int ks = 0; ks < 2; ++ks) y[mt] = mfma16(aS[mt][ks], bR[ks], y[mt]);
                const f32x4 mv = *(const f32x4*)(mu + C_V + h * 64 + 16 * mt + 4 * fq);
                const f32x4 cv = (f32x4){bflo(vc[mt].x), bfhi(vc[mt].x), bflo(vc[mt].y), bfhi(vc[mt].y)}, pv = (f32x4){bflo(vp[mt].x), bfhi(vp[mt].x), bflo(vp[mt].y), bfhi(vp[mt].y)};
                vv[mt] = cv + (pv - cv) * mv;
            }
#pragma unroll
            for (int mt = 0; mt < 4; ++mt) asm volatile("" : "+v"(y[mt]), "+v"(vv[mt]), "+v"(gacc[mt]));
            if (it + 1 < 8) issue(it + 1);
            float s = 0.f;
#pragma unroll
            for (int mt = 0; mt < 4; ++mt) s += (y[mt].x + y[mt].y) + (y[mt].z + y[mt].w);
            s += __shfl_xor(s, 16); s += __shfl_xor(s, 32);
            const float mean = s * (1.0f / 64.0f); float qq = 0.f;
#pragma unroll
            for (int mt = 0; mt < 4; ++mt) { y[mt] = y[mt] - mean; qq += (y[mt].x * y[mt].x + y[mt].y * y[mt].y) + (y[mt].z * y[mt].z + y[mt].w * y[mt].w); }
            qq += __shfl_xor(qq, 16); qq += __shfl_xor(qq, 32);
            const float rstd = 1.0f / sqrtf(qq * (1.0f / 64.0f) + GN_EPS);
            bf16_t* ya = (bf16_t*)(ws + WS_YA) + (size_t)row * D + h * 64;
#pragma unroll
            for (int mt = 0; mt < 4; ++mt) {
                const int i0 = 16 * mt + 4 * fq, hc = h * 64 + i0;
                const f32x4 gg = *(const f32x4*)(P.in[I_GNG] + hc), gb = *(const f32x4*)(P.in[I_GNB] + hc);
                const f32x4 o = (y[mt] * rstd * gg + gb + vv[mt] * bonc) * gacc[mt];
                u32x2 wv; wv.x = pk2(o.x, o.y); wv.y = pk2(o.z, o.w);
                *(u32x2*)(ya + i0) = wv;
            }
        }
    }
}
__device__ __forceinline__ float gelu_exact(float x) { return 0.5f * x * (1.0f + erff(x * 0.70710678118654752f)); }
__device__ __forceinline__ float dot16_fp8(const u32x4 w, const float* x) {
    float s0 = 0.f, s1 = 0.f;
    const int ww[4] = {(int)w.x, (int)w.y, (int)w.z, (int)w.w};
#pragma unroll
    for (int q = 0; q < 4; ++q) { const f32x2 lo = __builtin_amdgcn_cvt_pk_f32_fp8(ww[q], false), hi = __builtin_amdgcn_cvt_pk_f32_fp8(ww[q], true);
        s0 += lo.x * x[4 * q] + hi.x * x[4 * q + 2]; s1 += lo.y * x[4 * q + 1] + hi.y * x[4 * q + 3]; }
    return s0 + s1;
}
__device__ __forceinline__ void axpy16_fp8(const u32x4 w, float a, float* o) {
    const int ww[4] = {(int)w.x, (int)w.y, (int)w.z, (int)w.w};
#pragma unroll
    for (int q = 0; q < 4; ++q) { const f32x2 lo = __builtin_amdgcn_cvt_pk_f32_fp8(ww[q], false), hi = __builtin_amdgcn_cvt_pk_f32_fp8(ww[q], true);
        o[4 * q] += a * lo.x; o[4 * q + 1] += a * lo.y; o[4 * q + 2] += a * hi.x; o[4 * q + 3] += a * hi.y; }
}
__device__ __forceinline__ void peer_token(const Params& P, int tok, const LAS int* eidx, const LAS float* gts) {
    const int lane = threadIdx.x & 63;
    unsigned char* ws = P.ws;
    const unsigned char* Ub = ws + WS_UB; const unsigned char* Vb = ws + WS_VB;
    const float* tsc = (const float*)(ws + WS_TSC);
    {
        int lo16 = lane * 16; asm volatile("" : "+v"(lo16));
        float x[32], o[32];
        {
            const bf16_t* hr = (const bf16_t*)(ws + WS_H1B) + (size_t)tok * D + lo16;
#pragma unroll
            for (int i = 0; i < 2; ++i) { unpack8(*(const u32x4*)(hr + 1024 * i), x + 16 * i); unpack8(*(const u32x4*)(hr + 1024 * i + 8), x + 16 * i + 8); }
#pragma unroll
            for (int i = 0; i < 32; ++i) o[i] = 0.f;
        }
        const int e_lo = eidx[lane], e_hi = eidx[64 + lane];
        const float su_lo = tsc[e_lo], su_hi = tsc[e_hi];
        const float gv_lo = gts[lane] * tsc[16384 + e_lo], gv_hi = gts[64 + lane] * tsc[16384 + e_hi];
        u32x4 ua[2][2], va[2][2], ub[2][2], vb[2][2];
        auto issue = [&](int g, u32x4 (&uu)[2][2], u32x4 (&vv)[2][2]) {
            const int ev = (g < 32) ? e_lo : e_hi;
#pragma unroll
            for (int j = 0; j < 2; ++j) {
                const int e = __builtin_amdgcn_readlane(ev, (2 * g + j) & 63);
                const unsigned char* up = Ub + (size_t)e * D + lo16; const unsigned char* vp = Vb + (size_t)e * D + lo16;
#pragma unroll
                for (int i = 0; i < 2; ++i) { uu[j][i] = *(const u32x4*)(up + 1024 * i); vv[j][i] = *(const u32x4*)(vp + 1024 * i); }
            }
        };
        auto consume = [&](int g, const u32x4 (&uu)[2][2], const u32x4 (&vv)[2][2]) {
            const float suv = (g < 32) ? su_lo : su_hi, gvv = (g < 32) ? gv_lo : gv_hi;
            float dd[2];
#pragma unroll
            for (int j = 0; j < 2; ++j) dd[j] = dot16_fp8(uu[j][0], x) + dot16_fp8(uu[j][1], x + 16);
#pragma unroll
            for (int j = 0; j < 2; ++j) dd[j] = wave_sum_dpp(dd[j]);
            const int l0 = (2 * g) & 63;
            const pg8::f32x2 ge = pg8::gelu_pk((pg8::f32x2){dd[0] * readlane_f(suv, l0), dd[1] * readlane_f(suv, l0 + 1)});
            const float a0 = ge.x * readlane_f(gvv, l0), a1 = ge.y * readlane_f(gvv, l0 + 1);
            axpy16_fp8(vv[0][0], a0, o); axpy16_fp8(vv[0][1], a0, o + 16);
            axpy16_fp8(vv[1][0], a1, o); axpy16_fp8(vv[1][1], a1, o + 16);
        };
        issue(0, ua, va);
        for (int g = 0; g < 64; g += 2) {
            issue(g + 1, ub, vb);
            consume(g, ua, va);
            if (g + 2 < 64) issue(g + 2, ua, va);
            consume(g + 1, ub, vb);
        }
        float s = 0.f;
#pragma unroll
        for (int i = 0; i < 32; ++i) { o[i] += DN_ALPHA * x[i]; s += o[i]; }
        const float mean = wave_sum_dpp(s) * (1.0f / D); float q = 0.f;
#pragma unroll
        for (int i = 0; i < 32; ++i) { o[i] -= mean; q += o[i] * o[i]; }
        const float rstd = 1.0f / sqrtf(wave_sum_dpp(q) * (1.0f / D) + LN_EPS);
        float* orow = P.out + (size_t)tok * D + lo16;
#pragma unroll
        for (int i = 0; i < 2; ++i)
#pragma unroll
            for (int c = 0; c < 4; ++c) {
                const int off = 1024 * i + lo16 + 4 * c;
                const f32x4 g0 = *(const f32x4*)(P.in[I_LN2G] + off), b0 = *(const f32x4*)(P.in[I_LN2B] + off);
                f32x4 r0;
                r0.x = o[16 * i + 4 * c + 0] * rstd * g0.x + b0.x; r0.y = o[16 * i + 4 * c + 1] * rstd * g0.y + b0.y; r0.z = o[16 * i + 4 * c + 2] * rstd * g0.z + b0.z; r0.w = o[16 * i + 4 * c + 3] * rstd * g0.w + b0.w;
                *(f32x4*)(orow + 1024 * i + 4 * c) = r0;
            }
    }
}
__device__ __forceinline__ void phase5b(const Params& P) {
    const int lane = threadIdx.x & 63, wave = threadIdx.x >> 6;
    const int gw = blockIdx.x * 8 + wave, NGW = gridDim.x * 8;
    unsigned char* ws = P.ws;
    for (int r = gw; r < NTOK; r += NGW)
        ln_row_bf16((const float*)(ws + WS_X1) + (size_t)r * D, P.in[I_LN1G], P.in[I_LN1B], (bf16_t*)(ws + WS_H1B) + (size_t)r * D, lane);
    for (int r = gw; r < 32768; r += NGW) {
        const float* src = (r < 16384 ? P.in[I_UT] : P.in[I_VT]) + (size_t)(r & 16383) * D;
        int* dst = (int*)(ws + (r < 16384 ? WS_UB : WS_VB) + (size_t)(r & 16383) * D);
        f32x4 v[8]; float am = 0.f;
#pragma unroll
        for (int j = 0; j < 8; ++j) { v[j] = ((const f32x4*)src)[lane + 64 * j]; am = fmaxf(am, fmaxf(fmaxf(fabsf(v[j].x), fabsf(v[j].y)), fmaxf(fabsf(v[j].z), fabsf(v[j].w)))); }
        am = wave_max_dpp(am);
        const float s = am > 0.f ? 256.0f / am : 1.0f;
#pragma unroll
        for (int j = 0; j < 8; ++j) { int w = 0; w = __builtin_amdgcn_cvt_pk_fp8_f32(v[j].x * s, v[j].y * s, w, false); w = __builtin_amdgcn_cvt_pk_fp8_f32(v[j].z * s, v[j].w * s, w, true); dst[lane + 64 * j] = w; }
        if (lane == 0) ((float*)(ws + WS_TSC))[r] = am > 0.f ? am * (1.0f / 256.0f) : 1.0f;
    }
}

#define CE_DESC(a, b) do { const float h_ = fmaxf((a), (b)), l_ = fminf((a), (b)); (a) = h_; (b) = l_; } while (0)
template <int N> __device__ __forceinline__ void bitonic_sort_desc(float (&v)[N]) {
#pragma unroll
    for (int k = 2; k <= N; k <<= 1)
#pragma unroll
        for (int j = k >> 1; j > 0; j >>= 1)
#pragma unroll
            for (int i = 0; i < N; ++i) { const int l = i ^ j; if (l > i) { if ((i & k) == 0) CE_DESC(v[i], v[l]); else CE_DESC(v[l], v[i]); } }
}
template <int N> __device__ __forceinline__ void bitonic_merge_desc(float (&v)[N]) {
#pragma unroll
    for (int j = N >> 1; j > 0; j >>= 1)
#pragma unroll
        for (int i = 0; i < N; ++i) { const int l = i ^ j; if (l > i) CE_DESC(v[i], v[l]); }
}
__device__ __forceinline__ void top16_merge(float (&a)[16], const float (&brev)[16]) {
#pragma unroll
    for (int i = 0; i < 16; ++i) a[i] = fmaxf(a[i], brev[i]);
    bitonic_merge_desc<16>(a);
}
__device__ __forceinline__ float embed_bits(float v, unsigned code, unsigned mask) { return __uint_as_float((__float_as_uint(v) & ~mask) | code); }

__device__ __forceinline__ void phase7(const Params& P, ldsp lds) {
    int tid = threadIdx.x; asm volatile("" : "+v"(tid));
    const int lane = tid & 63, wave = tid >> 6, fr = lane & 15, fq = lane >> 4;
    unsigned char* ws = P.ws;
    const bf16_t* qb = (const bf16_t*)(ws + WS_Q); const bf16_t* sk = (const bf16_t*)(ws + WS_SUBK);
    constexpr int LDSK = 136, O_SK = 0, O_SV = 2 * 128 * LDSK * 2, O_EX = O_SV + 32768, O_GT = O_EX + 16384;
    for (int idx = tid; idx < 2 * 128 * 16; idx += 512) { const int row = idx >> 4, ch = idx & 15;
        *(LAS u32x4*)(lds + O_SK + (row * LDSK + ch * 8) * 2) = *(const u32x4*)(sk + row * 128 + ch * 8); }
    BLOCK_SYNC();
    for (int tile = blockIdx.x; tile < 256; tile += gridDim.x) {
        const int tok0 = tile * 32, h = wave;
        int fro = fr, fqo = fq; asm volatile("" : "+v"(fro), "+v"(fqo));
#pragma unroll 1
        for (int cb = 0; cb < 4; ++cb) {
            const int nt = cb >> 1, p = cb & 1;
            f32x4 acc[8];
#pragma unroll
            for (int mt = 0; mt < 8; ++mt) acc[mt] = (f32x4){0.f, 0.f, 0.f, 0.f};
            const bf16_t* qrow = qb + (size_t)(tok0 + 16 * nt + fro) * D + h * 256 + p * 128 + fqo * 8;
#pragma unroll
            for (int ks = 0; ks < 4; ++ks) {
                const bf16x8 bq = *(const bf16x8*)(qrow + ks * 32);
#pragma unroll
                for (int mt = 0; mt < 8; ++mt) acc[mt] = mfma16(*(const LAS bf16x8*)(lds + O_SK + ((p * 128 + 16 * mt + fro) * LDSK + ks * 32 + fqo * 8) * 2), bq, acc[mt]);
            }
            float a[16], b[16];
#pragma unroll
            for (int mt = 0; mt < 4; ++mt) {
                a[4 * mt + 0] = embed_bits(acc[mt].x, 16 * mt + 4 * fq + 0, 127u); a[4 * mt + 1] = embed_bits(acc[mt].y, 16 * mt + 4 * fq + 1, 127u);
                a[4 * mt + 2] = embed_bits(acc[mt].z, 16 * mt + 4 * fq + 2, 127u); a[4 * mt + 3] = embed_bits(acc[mt].w, 16 * mt + 4 * fq + 3, 127u);
                b[4 * mt + 0] = embed_bits(acc[mt + 4].x, 16 * (mt + 4) + 4 * fq + 0, 127u); b[4 * mt + 1] = embed_bits(acc[mt + 4].y, 16 * (mt + 4) + 4 * fq + 1, 127u);
                b[4 * mt + 2] = embed_bits(acc[mt + 4].z, 16 * (mt + 4) + 4 * fq + 2, 127u); b[4 * mt + 3] = embed_bits(acc[mt + 4].w, 16 * (mt + 4) + 4 * fq + 3, 127u);
            }
            bitonic_sort_desc<16>(a); bitonic_sort_desc<16>(b);
            { float br[16];
#pragma unroll
              for (int i = 0; i < 16; ++i) br[i] = b[15 - i];
              top16_merge(a, br); }
#pragma unroll
            for (int x = 16; x <= 32; x <<= 1) { float br[16];
#pragma unroll
                for (int i = 0; i < 16; ++i) br[i] = __shfl_xor(a[15 - i], x);
                top16_merge(a, br); }
            if (fq == 0) { LAS f32x4* o = (LAS f32x4*)(lds + O_SV + ((((16 * nt + fr) * 8 + h) * 2 + p) * 16) * 4);
                o[0] = (f32x4){a[0], a[1], a[2], a[3]}; o[1] = (f32x4){a[4], a[5], a[6], a[7]}; o[2] = (f32x4){a[8], a[9], a[10], a[11]}; o[3] = (f32x4){a[12], a[13], a[14], a[15]}; }
        }
        BLOCK_SYNC();
        if (tid < 256) {
            const int tok = tid >> 3, hh = tid & 7;
            const LAS f32x4* s = (const LAS f32x4*)(lds + O_SV + (((tok * 8 + hh) * 2) * 16) * 4);
            float s0[16], s1[16];
#pragma unroll
            for (int c4 = 0; c4 < 4; ++c4) { const f32x4 x = s[c4], y = s[4 + c4]; s0[4 * c4] = x.x; s0[4 * c4 + 1] = x.y; s0[4 * c4 + 2] = x.z; s0[4 * c4 + 3] = x.w; s1[4 * c4] = y.x; s1[4 * c4 + 1] = y.y; s1[4 * c4 + 2] = y.z; s1[4 * c4 + 3] = y.w; }
            float g0[16], g1[16], g2[16], g3[16];
            const float NEG = -3.0e38f;
#pragma unroll
            for (int bq = 0; bq < 16; ++bq) g0[bq] = embed_bits(s0[0] + s1[bq], bq, 255u);
            {
                int n1 = 0, n2 = 0, n3 = 0;
#pragma unroll
                for (int aa = 1; aa < 16; ++aa)
#pragma unroll
                    for (int bb = 0; bb < 16; ++bb) if ((aa + 1) * (bb + 1) <= 16) {
                        const float c = embed_bits(s0[aa] + s1[bb], aa * 16 + bb, 255u);
                        if (n1 < 16) g1[n1++] = c; else if (n2 < 16) g2[n2++] = c; else g3[n3++] = c;
                    }
#pragma unroll
                for (int i = 0; i < 16; ++i) if (i >= n3) g3[i] = NEG;
            }
            bitonic_sort_desc<16>(g1); bitonic_sort_desc<16>(g2); bitonic_sort_desc<16>(g3);
            { float r1[16], r3[16];
#pragma unroll
              for (int i = 0; i < 16; ++i) { r1[i] = g1[15 - i]; r3[i] = g3[15 - i]; }
              top16_merge(g0, r1); top16_merge(g2, r3);
#pragma unroll
              for (int i = 0; i < 16; ++i) g0[i] = fmaxf(g0[i], g2[15 - i]); }
            float mx = g0[0];
#pragma unroll
            for (int i = 1; i < 16; ++i) mx = fmaxf(mx, g0[i]);
            float ex[16], sm = 0.f; int ee[16];
#pragma unroll
            for (int i = 0; i < 16; ++i) {
                ex[i] = __expf(g0[i] - mx); sm += ex[i];
                const unsigned code = __float_as_uint(g0[i]) & 255u;
                const unsigned i0 = __float_as_uint(*(const LAS float*)(lds + O_SV + ((((tok * 8 + hh) * 2 + 0) * 16) + (code >> 4)) * 4)) & 127u;
                const unsigned i1 = __float_as_uint(*(const LAS float*)(lds + O_SV + ((((tok * 8 + hh) * 2 + 1) * 16) + (code & 15u)) * 4)) & 127u;
                ee[i] = (int)(i0 * 128u + i1);
            }
            const float inv = 1.0f / sm;
            LAS int* eo = (LAS int*)(lds + O_EX) + tok * 128 + hh * 16; LAS float* go = (LAS float*)(lds + O_GT) + tok * 128 + hh * 16;
#pragma unroll
            for (int c4 = 0; c4 < 4; ++c4) {
                *(LAS u32x4*)(eo + 4 * c4) = (u32x4){(unsigned)ee[4 * c4], (unsigned)ee[4 * c4 + 1], (unsigned)ee[4 * c4 + 2], (unsigned)ee[4 * c4 + 3]};
                *(LAS f32x4*)(go + 4 * c4) = (f32x4){ex[4 * c4] * inv, ex[4 * c4 + 1] * inv, ex[4 * c4 + 2] * inv, ex[4 * c4 + 3] * inv};
            }
        }
        BLOCK_SYNC();
#pragma unroll 1
        for (int i = 0; i < 4; ++i) peer_token(P, tok0 + wave * 4 + i, (const LAS int*)(lds + O_EX) + (wave * 4 + i) * 128, (const LAS float*)(lds + O_GT) + (wave * 4 + i) * 128);
        BLOCK_SYNC();
    }
}
#ifndef MK_MULTI
#define MK_MULTI 0
#endif
__global__ __launch_bounds__(512, 2) void hybrid_fwd(Params P) {
    extern __shared__ __attribute__((aligned(16))) unsigned char shm[];
    ldsp lds = (ldsp)shm;
    unsigned char* ws = P.ws;
    volatile LAS unsigned* xst = (volatile LAS unsigned*)(lds + LDS_BYTES - 16);
    if (threadIdx.x == 0) { xst[0] = 0u; xst[1] = 0u; }
    __syncthreads();
    const XcdBarrier xbar = xcd_barrier_post((unsigned*)(ws + WS_BAR), xst);
    const int lo = P.ph_lo, hi = P.ph_hi;
#ifdef DBG_TA
    unsigned long long ts0 = 0, ts1 = 0, ts2 = 0, ts3 = 0, ts4 = 0, ts5 = 0, ts6 = 0, ts7 = 0, ts8 = 0, ts9 = 0, ts10 = 0, ts11 = 0;
#define STAMP(k) ts##k = __builtin_amdgcn_s_memrealtime()
#else
#define STAMP(k) do { } while (0)
#endif
    STAMP(0);
#ifndef REPEAT_PHASE
#define REPEAT_PHASE -1
#define REPEAT_N 1
#endif
#define PHASE(k) if (lo <= (k) && (k) < hi) for (int rep_ = 0; rep_ < ((k) == REPEAT_PHASE ? REPEAT_N : 1); ++rep_)
#define SEAM(k) do { if (lo <= (k) && (k) + 1 < hi) xcd_barrier(xbar); } while (0)
    PHASE(0) phase0(P);
    SEAM(0); STAMP(1);
    PHASE(1) { pg8::EpiBf16<0> E; E.O = (bf16_t*)(ws + WS_P); E.ldc = NPAD; E.bias = nullptr; E.split_cols = 0; E.split_stride = 0;
        run_gemm(lds, (const bf16_t*)(ws + WS_H0B), (const bf16_t*)(ws + WS_WTIN), MROWS, NPAD, 2048, E); }
    SEAM(1); STAMP(2);
    PHASE(2) phase2(P, lds);
    SEAM(2); STAMP(3);
    PHASE(3) phase3(P);
    SEAM(3); STAMP(4);
    PHASE(4) phase3b(P, lds);
    SEAM(4); STAMP(5);
    PHASE(5) {
        { pg8::EpiGateA E; E.C = (float*)(ws + WS_MPART); E.p = (const bf16_t*)(ws + WS_P); E.bgate = P.in[I_BGATE];
          run_gemm(lds, (const bf16_t*)(ws + WS_YA), (const bf16_t*)(ws + WS_WTA), NTOK, 2048, 2048, E); }
        { pg8::EpiGateB E; E.C = (const float*)(ws + WS_MPART); E.O = (bf16_t*)(ws + WS_MERGED); E.p = (const bf16_t*)(ws + WS_P); E.bgate = P.in[I_BGATE];
          run_gemm(lds, (const bf16_t*)(ws + WS_YB), (const bf16_t*)(ws + WS_WTB), NTOK, 2048, 1024, E); }
    }
    SEAM(5); STAMP(6);
    PHASE(6) { pg8::EpiResid E; E.C = (float*)(ws + WS_X1); E.h0 = (const bf16_t*)(ws + WS_H0B); E.alpha = DN_ALPHA;
        run_gemm(lds, (const bf16_t*)(ws + WS_MERGED), (const bf16_t*)(ws + WS_WTOUT), NTOK, 2048, 2048, E); }
    SEAM(6); STAMP(7);
    PHASE(7) phase5b(P);
    SEAM(7); STAMP(8);
    PHASE(8) { pg8::EpiBf16<0> E; E.O = (bf16_t*)(ws + WS_Q); E.ldc = D; E.bias = nullptr; E.split_cols = 0; E.split_stride = 0;
        run_gemm(lds, (const bf16_t*)(ws + WS_H1B), (const bf16_t*)(ws + WS_WTQ), NTOK, 2048, 2048, E); }
    SEAM(8); STAMP(9);
    PHASE(9) phase7(P, lds);
#ifdef DBG_TA
    {
        __threadfence_system(); asm volatile("s_waitcnt vmcnt(0) lgkmcnt(0)" ::: "memory"); __syncthreads(); grid.sync(); __threadfence_system();
        STAMP(11);
        const unsigned long long tt[12] = {ts0, ts1, ts2, ts3, ts4, ts5, ts6, ts7, ts8, ts9, ts9, ts11};
        const float ta = (float)(tt[DBG_TA + 1] - tt[DBG_TA]) * 0.01f, tb = (float)(tt[DBG_TB + 1] - tt[DBG_TB]) * 0.01f;
        if (blockIdx.x == 0) { for (int i = threadIdx.x + 1; i <= 1000000; i += 512) P.out[i] = tb; if (threadIdx.x == 0) P.out[0] = 1000.0f * ta; }
    }
#endif
#ifdef DBG_STOP
    {
        __threadfence_system(); asm volatile("s_waitcnt vmcnt(0) lgkmcnt(0)" ::: "memory"); __syncthreads(); grid.sync(); __threadfence_system();
        const size_t a = DBG_A, b = DBG_B; const unsigned* w = (const unsigned*)(ws + a); const size_t nw = (b - a) / 4, NO = (size_t)NTOK * D;
        for (size_t i = (size_t)blockIdx.x * 512 + threadIdx.x; i < NO; i += (size_t)gridDim.x * 512) {
            unsigned acc = 0; for (size_t j = i; j < nw; j += NO) { const unsigned x = w[j]; acc += (x & 0xffffu) + (x >> 16); }
            P.out[i] = (float)(acc & 0xfffffu);
        }
    }
#endif
#undef PHASE
#undef SEAM
}

extern "C" void kernel_launch(void* const* d_in, const int* in_sizes, int n_in, void* d_out, int out_size, void* d_ws, size_t ws_size, hipStream_t stream) {
    static int grid = 0;
    if (grid == 0) {
        if (n_in != 30 || out_size != NTOK * D || ws_size < WS_END) { fprintf(stderr, "kernel_launch: unexpected shapes (n_in %d, out %d, ws %zu < %zu)\n", n_in, out_size, ws_size, (size_t)WS_END); grid = -1; return; }
        int dev = 0, cus = 0, per_cu = 0;
        if (hipGetDevice(&dev) != hipSuccess || hipDeviceGetAttribute(&cus, hipDeviceAttributeMultiprocessorCount, dev) != hipSuccess) { grid = -1; return; }
        if (hipFuncSetAttribute((const void*)hybrid_fwd, hipFuncAttributeMaxDynamicSharedMemorySize, LDS_BYTES) != hipSuccess) { fprintf(stderr, "kernel_launch: hipFuncSetAttribute failed\n"); grid = -1; return; }
        if (hipOccupancyMaxActiveBlocksPerMultiprocessor(&per_cu, (const void*)hybrid_fwd, 512, LDS_BYTES) != hipSuccess || per_cu < 1) { fprintf(stderr, "kernel_launch: occupancy query says %d\n", per_cu); grid = -1; return; }
        (void)hipGetLastError();
        grid = cus;
    }
    if (grid < 0) return;
    if (hipMemsetAsync((unsigned char*)d_ws + WS_BAR, 0, XCD_BAR_WORDS * 4, stream) != hipSuccess) { fprintf(stderr, "kernel_launch: memset failed\n"); return; }
    Params p{};
    for (int i = 0; i < 30; ++i) p.in[i] = (const float*)d_in[i];
    p.out = (float*)d_out; p.ws = (unsigned char*)d_ws;
#if MK_MULTI
    for (int ph = 0; ph <= NPHASE; ++ph) { p.ph_lo = ph; p.ph_hi = ph + 1; hipLaunchKernelGGL(hybrid_fwd, dim3(grid), dim3(512), LDS_BYTES, stream, p); }
#else
    p.ph_lo = 0; p.ph_hi = NPHASE + 1;
#ifdef DBG_STOP
    p.ph_hi = DBG_STOP + 1;
#endif
    void* args[] = {&p};
    hipError_t e = hipLaunchCooperativeKernel((const void*)hybrid_fwd, dim3(grid), dim3(512), args, LDS_BYTES, stream);
    if (e != hipSuccess) fprintf(stderr, "kernel_launch: cooperative launch failed: %s (grid %d)\n", hipGetErrorString(e), grid);
#endif
}
```

```cpp
#include <hip/hip_runtime.h>
#include <hip/hip_cooperative_groups.h>
#include <cstdio>
#include <cstdint>
namespace cg = cooperative_groups;
namespace pg8 {
#define PG8_LAS __attribute__((address_space(3)))
typedef unsigned short bf16_t;
typedef short bf16x8 __attribute__((ext_vector_type(8)));
typedef float f32x4 __attribute__((ext_vector_type(4)));
typedef unsigned u32x4 __attribute__((ext_vector_type(4)));
constexpr int BM = 256, BK = 64, HALF = 128, HTB = HALF * BK * 2  , STAGE_BYTES = 8 * HTB, NXCD = 8, WGM = 8;

__host__ __device__ __forceinline__ int lds_byte(int r, int c) { const int st = (r >> 4) * 2 + (c >> 5), rr = r & 15, cc = c & 31, ob = rr * 64 + cc * 2; return st * 1024 + (ob ^ (((ob >> 9) & 1) << 5)); }
__host__ __device__ __forceinline__ void stage_rc(int b, int& R, int& C) { const int st = b / 1024, sb = b % 1024, swz = sb ^ (((sb >> 9) & 1) << 5); R = (st >> 1) * 16 + swz / 64; C = (st & 1) * 32 + (swz % 64) / 2; }
__host__ __device__ __forceinline__ int perm32(int rho) { const int n = rho >> 4, i = rho & 15; return 8 * (i >> 2) + 4 * n + (i & 3); }

struct Unit { int pm, pn; };
struct Gemm { const bf16_t* A; const bf16_t* Bt; int M, N, K; };

struct StaticOrder {
    int nM, nN, nwg, G, c;
    __host__ __device__ void init(int M, int N, int G_, int c_) { nM = M / BM; nN = N / BM; nwg = nM * nN; G = G_; c = c_; }
    __host__ __device__ bool next(int i, Unit& u) const {
        const long L = (long)i * G + c; if (L >= nwg) return false;
        int wgid = (int)L; { const int q = nwg / NXCD, r = nwg % NXCD, xcd = wgid % NXCD, off = wgid / NXCD; wgid = (xcd < r ? xcd * (q + 1) : r * (q + 1) + (xcd - r) * q) + off; }
        const int nig = WGM * nN, gid = wgid / nig, fm = gid * WGM, gsz = (nM - fm) < WGM ? (nM - fm) : WGM;
        u.pm = fm + ((wgid % nig) % gsz); u.pn = (wgid % nig) / gsz; return true;
    }
    __device__ __forceinline__ void a_ready(const Unit&) const {}
    __device__ __forceinline__ void done(const Unit&) const {}
};
struct CountedOrder : StaticOrder {
    const unsigned* ready; unsigned need; unsigned* tmo;
    __device__ __forceinline__ void a_ready(const Unit& u) const {
        if (threadIdx.x < 64) {
            const unsigned long long t0 = __builtin_amdgcn_s_memrealtime(); unsigned polls = 0;
            while ((unsigned)__builtin_amdgcn_readfirstlane(__hip_atomic_load(ready + 64 * u.pm, __ATOMIC_RELAXED, __HIP_MEMORY_SCOPE_AGENT)) < need) {
                if ((++polls & 255u) == 0u && __builtin_amdgcn_readfirstlane(__hip_atomic_load(tmo, __ATOMIC_RELAXED, __HIP_MEMORY_SCOPE_AGENT)) != 0u) break;
                if (__builtin_amdgcn_s_memrealtime() - t0 > 2000000ull) {
                    if (threadIdx.x == 0) { unsigned expect = 0u; __hip_atomic_compare_exchange_strong(tmo + 1, &expect, 0x600u | (unsigned)(u.pm & 0xff), __ATOMIC_RELAXED, __ATOMIC_RELAXED, __HIP_MEMORY_SCOPE_AGENT); __hip_atomic_store(tmo, 1u, __ATOMIC_RELAXED, __HIP_MEMORY_SCOPE_AGENT); }
                    break; }
                __builtin_amdgcn_s_sleep(2); }
            __builtin_amdgcn_fence(__ATOMIC_ACQUIRE, "agent");
            asm volatile("s_waitcnt vmcnt(0)" ::: "memory");
        }
#if !defined(BROKEN_HOOK_NO_BARRIER)
        asm volatile("" ::: "memory"); __builtin_amdgcn_s_barrier(); asm volatile("" ::: "memory");
#endif
    }
};

typedef float cvt_f32x2 __attribute__((ext_vector_type(2))); typedef __bf16 cvt_bf16x2 __attribute__((ext_vector_type(2)));
__device__ __forceinline__ unsigned cvt_pk_bf16(float lo, float hi) { const cvt_f32x2 v = {lo, hi}; const cvt_bf16x2 b = __builtin_convertvector(v, cvt_bf16x2); return __builtin_bit_cast(unsigned, b); }
typedef float f32x2 __attribute__((ext_vector_type(2)));
__device__ __forceinline__ f32x2 gelu_pk(f32x2 v) {
    const f32x2 av = __builtin_elementwise_abs(v), d = av * 0.2316418882f + 1.0f;
    f32x2 t; t.x = __builtin_amdgcn_rcpf(d.x); t.y = __builtin_amdgcn_rcpf(d.y);
    f32x2 q = t * 0.5307027145f + (-0.7265760135f); q = q * t + 0.7107068705f; q = q * t + (-0.142248368f); q = q * t + 0.127414796f; q = q * t;
    const f32x2 s = (v * v) * (-0.72134752044f);
    f32x2 e; e.x = __builtin_amdgcn_exp2f(s.x); e.y = __builtin_amdgcn_exp2f(s.y);
    const f32x2 m = v * (q * e), r = v - m;
    f32x2 o; o.x = v.x < 0.f ? m.x : r.x; o.y = v.y < 0.f ? m.y : r.y; return o;
}

struct EpiF32 {
    static constexpr bool PERM = false, AFTER_DRAIN = false;
    float* C; int ldc; const float* bias;
    __device__ __forceinline__ void operator()(const f32x4 (&acc)[2][2][4][2], const Unit& u, int wr, int wc, int fr, int fq) const {
        const int row0 = u.pm * BM + wr * 64 + fr, col0 = u.pn * BM + wc * 32 + 4 * fq;
        f32x4 bv[2][2];
#pragma unroll
        for (int bj = 0; bj < 2; ++bj)
#pragma unroll
            for (int n = 0; n < 2; ++n) bv[bj][n] = bias ? *(const f32x4*)(bias + col0 + bj * HALF + n * 16) : (f32x4){0.f, 0.f, 0.f, 0.f};
#pragma unroll
        for (int ai = 0; ai < 2; ++ai)
#pragma unroll
            for (int m = 0; m < 4; ++m) { float* rowp = C + (size_t)(row0 + ai * HALF + m * 16) * ldc + col0;
#pragma unroll
                for (int bj = 0; bj < 2; ++bj)
#pragma unroll
                    for (int n = 0; n < 2; ++n) *(f32x4*)(rowp + bj * HALF + n * 16) = acc[ai][bj][m][n] + bv[bj][n]; }
    }
};
template <int ACT  > struct EpiBf16 {
    static constexpr bool PERM = true, AFTER_DRAIN = false;
    bf16_t* O; int ldc; const float* bias; int split_cols; size_t split_stride;
    __device__ __forceinline__ void operator()(const f32x4 (&acc)[2][2][4][2], const Unit& u, int wr, int wc, int fr, int fq) const {
        const int row0 = u.pm * BM + wr * 64 + fr; int colt = u.pn * BM; bf16_t* base = O;
        if (split_cols) { const int t = colt / split_cols; base += (size_t)t * split_stride; colt -= t * split_cols; }
        const int col0 = colt + wc * 32 + 8 * fq, bcol0 = u.pn * BM + wc * 32 + 8 * fq;
        f32x4 bv[2][2];
#pragma unroll
        for (int bj = 0; bj < 2; ++bj)
#pragma unroll
            for (int n = 0; n < 2; ++n) bv[bj][n] = bias ? *(const f32x4*)(bias + bcol0 + bj * HALF + 4 * n) : (f32x4){0.f, 0.f, 0.f, 0.f};
#pragma unroll
        for (int ai = 0; ai < 2; ++ai)
#pragma unroll
            for (int m = 0; m < 4; ++m) { bf16_t* rowp = base + (size_t)(row0 + ai * HALF + m * 16) * ldc + col0;
#pragma unroll
                for (int bj = 0; bj < 2; ++bj) { f32x4 v0 = acc[ai][bj][m][0] + bv[bj][0], v1 = acc[ai][bj][m][1] + bv[bj][1];
                    if (ACT == 1) { f32x2 a = gelu_pk((f32x2){v0[0], v0[1]}), b = gelu_pk((f32x2){v0[2], v0[3]}), c = gelu_pk((f32x2){v1[0], v1[1]}), d = gelu_pk((f32x2){v1[2], v1[3]});
                        v0 = (f32x4){a.x, a.y, b.x, b.y}; v1 = (f32x4){c.x, c.y, d.x, d.y}; }
                    if (ACT == 2) {
#pragma unroll
                        for (int j = 0; j < 4; ++j) { v0[j] = 0.5f * v0[j] * (1.0f + erff(v0[j] * 0.70710678f)); v1[j] = 0.5f * v1[j] * (1.0f + erff(v1[j] * 0.70710678f)); } }
                    u32x4 w; w.x = cvt_pk_bf16(v0[0], v0[1]); w.y = cvt_pk_bf16(v0[2], v0[3]); w.z = cvt_pk_bf16(v1[0], v1[1]); w.w = cvt_pk_bf16(v1[2], v1[3]);
                    *(u32x4*)(rowp + bj * HALF) = w; } }
    }
};
template <class Epi, class Sched, bool STAMP = false>
__device__ __forceinline__ void gemm_phase(PG8_LAS unsigned char* lds, const Gemm g, const Sched& S, const Epi& E, unsigned long long* stamps) {
    const int tid = threadIdx.x, wid = __builtin_amdgcn_readfirstlane(tid >> 6), lane = tid & 63, wr = wid >> 2, wc = wid & 3, fr = lane & 15, fq = lane >> 4;
    const int K = g.K, nt = K / BK;
    int ts_lo = 0, ts_hi = 0, nts = 0; const unsigned long long rt_entry = STAMP ? (unsigned long long)wall_clock64() : 0ull;
#define PG8_STAMP() do { if (STAMP && wid == 0 && nts < 64) { const unsigned long long _c = (unsigned long long)clock64(); \
        ts_lo = (lane == nts) ? (int)(unsigned)_c : ts_lo; ts_hi = (lane == nts) ? (int)(unsigned)(_c >> 32) : ts_hi; ++nts; } } while (0)
    PG8_STAMP();
    unsigned voffA[2], voffB[2];
#pragma unroll
    for (int i = 0; i < 2; ++i) { int R, C; stage_rc(tid * 16 + i * 8192, R, C); const int Rb = Epi::PERM ? ((R & ~31) + perm32(R & 31)) : R;
        voffA[i] = (unsigned)(R * K + C) * 2u; voffB[i] = (unsigned)(Rb * K + C) * 2u; }
    const size_t kstep = (size_t)(BK * 2);
    const size_t hstep = (size_t)HALF * K * 2;
    const size_t tstep = 2 * hstep;
    const unsigned ldsw = (unsigned)wid * 1024u;
    const int aoff = lds_byte(wr * 64 + fr, fq * 8), boff = lds_byte(wc * 32 + fr, fq * 8);
#define PG8_SA(b, h) (((b) * 2 + (h)) * HTB)
#define PG8_SB(b, h) ((4 + (b) * 2 + (h)) * HTB)
#define PG8_STAGE(bufoff, gbase, voff) do { _Pragma("unroll") for (int _i = 0; _i < 2; ++_i) \
        __builtin_amdgcn_global_load_lds((const unsigned*)((const char*)(gbase) + (voff)[_i]), (PG8_LAS unsigned*)(lds + (bufoff) + ldsw + _i * 8192), 16, 0, 0); } while (0)
#define PG8_LDA(dst, b, h) do { _Pragma("unroll") for (int m = 0; m < 4; ++m) _Pragma("unroll") for (int k = 0; k < 2; ++k) dst[m][k] = *(const PG8_LAS bf16x8*)(lds + PG8_SA(b, h) + aoff + m * 2048 + k * 1024); } while (0)
#define PG8_LDB(dst, b, h) do { _Pragma("unroll") for (int n = 0; n < 2; ++n) _Pragma("unroll") for (int k = 0; k < 2; ++k) dst[n][k] = *(const PG8_LAS bf16x8*)(lds + PG8_SB(b, h) + boff + n * 2048 + k * 1024); } while (0)
#define PG8_MMA(ai, bj, At, Bt) do { __builtin_amdgcn_s_setprio(1); _Pragma("unroll") for (int m = 0; m < 4; ++m) _Pragma("unroll") for (int n = 0; n < 2; ++n) _Pragma("unroll") for (int k = 0; k < 2; ++k) \
        acc[ai][bj][m][n] = __builtin_amdgcn_mfma_f32_16x16x32_bf16(Bt[n][k], At[m][k], acc[ai][bj][m][n], 0, 0, 0); __builtin_amdgcn_s_setprio(0); } while (0)
#define PG8_WAIT_V(n) asm volatile("s_waitcnt vmcnt(" #n ")" ::: "memory")
#define PG8_WAIT_L(n) asm volatile("s_waitcnt lgkmcnt(" #n ")" ::: "memory")
#define PG8_BAR __builtin_amdgcn_s_barrier()
#define PG8_SCHED __builtin_amdgcn_sched_barrier(0)
    Unit cur, nxt; int ui = 0;
    if (!S.next(0, cur)) return;
    f32x4 acc[2][2][4][2];
#pragma unroll
    for (int a = 0; a < 2; ++a)
#pragma unroll
        for (int b = 0; b < 2; ++b)
#pragma unroll
            for (int m = 0; m < 4; ++m)
#pragma unroll
                for (int n = 0; n < 2; ++n) acc[a][b][m][n] = (f32x4){0.f, 0.f, 0.f, 0.f};
    bf16x8 At[4][2], B0[2][2], B1[2][2];
    const char* cA = (const char*)g.A + (size_t)cur.pm * tstep; const char* cB = (const char*)g.Bt + (size_t)cur.pn * tstep;
    S.a_ready(cur);
    PG8_STAGE(PG8_SB(0, 0), cB, voffB); PG8_STAGE(PG8_SA(0, 0), cA, voffA); PG8_STAGE(PG8_SB(0, 1), cB + hstep, voffB); PG8_STAGE(PG8_SA(0, 1), cA + hstep, voffA);
    if (wr == 1) PG8_BAR;
    PG8_WAIT_V(4); PG8_BAR;
    PG8_STAGE(PG8_SB(1, 0), cB + kstep, voffB); PG8_STAGE(PG8_SA(1, 0), cA + kstep, voffA); PG8_STAGE(PG8_SB(1, 1), cB + hstep + kstep, voffB);
    PG8_WAIT_V(6); PG8_BAR;
    PG8_STAMP();
    for (;;) {
        const bool has_next = S.next(ui + 1, nxt);
        const char* nA = has_next ? (const char*)g.A + (size_t)nxt.pm * tstep : cA; const char* nB = has_next ? (const char*)g.Bt + (size_t)nxt.pn * tstep : cB;
        for (int t = 0; t < nt; t += 2) {
            const bool last = (t == nt - 2);
            const char* a1 = cA + (size_t)(t + 1) * kstep;
            const char* a2 = last ? nA : cA + (size_t)(t + 2) * kstep; const char* b2 = last ? nB : cB + (size_t)(t + 2) * kstep;
            const char* a3 = a2 + kstep; const char* b3 = b2 + kstep;
            if (last && has_next) S.a_ready(nxt);
            PG8_LDB(B0, 0, 0); PG8_SCHED; PG8_LDA(At, 0, 0); PG8_STAGE(PG8_SA(1, 1), a1 + hstep, voffA);
            PG8_WAIT_L(8); PG8_BAR; PG8_WAIT_L(0); PG8_MMA(0, 0, At, B0); PG8_BAR; PG8_SCHED;
            PG8_LDB(B1, 0, 1); PG8_STAGE(PG8_SB(0, 0), b2, voffB);
            PG8_BAR; PG8_WAIT_L(0); PG8_MMA(0, 1, At, B1); PG8_BAR;
            PG8_LDA(At, 0, 1); PG8_STAGE(PG8_SA(0, 0), a2, voffA);
            PG8_BAR; PG8_WAIT_L(0); PG8_MMA(1, 0, At, B0); PG8_BAR; PG8_SCHED;
            PG8_STAGE(PG8_SB(0, 1), b2 + hstep, voffB);
            PG8_WAIT_V(6); PG8_BAR; PG8_MMA(1, 1, At, B1); PG8_BAR;
            PG8_LDB(B0, 1, 0); PG8_SCHED; PG8_LDA(At, 1, 0); PG8_STAGE(PG8_SA(0, 1), a2 + hstep, voffA);
            PG8_WAIT_L(8); PG8_BAR; PG8_WAIT_L(0); PG8_MMA(0, 0, At, B0); PG8_BAR; PG8_SCHED;
            PG8_LDB(B1, 1, 1); PG8_STAGE(PG8_SB(1, 0), b3, voffB);
            PG8_BAR; PG8_WAIT_L(0); PG8_MMA(0, 1, At, B1); PG8_BAR;
            PG8_LDA(At, 1, 1); PG8_STAGE(PG8_SA(1, 0), a3, voffA);
            PG8_BAR; PG8_WAIT_L(0); PG8_MMA(1, 0, At, B0); PG8_BAR; PG8_SCHED;
            PG8_STAGE(PG8_SB(1, 1), b3 + hstep, voffB);
            PG8_WAIT_V(6); PG8_BAR; PG8_MMA(1, 1, At, B1); PG8_BAR;
        }
        PG8_STAMP();
        if constexpr (!Epi::AFTER_DRAIN) { E(acc, cur, wr, wc, fr, fq); S.done(cur); }
        PG8_STAMP();
        if (!has_next) break;
#pragma unroll
        for (int a = 0; a < 2; ++a)
#pragma unroll
            for (int b = 0; b < 2; ++b)
#pragma unroll
                for (int m = 0; m < 4; ++m)
#pragma unroll
                    for (int n = 0; n < 2; ++n) acc[a][b][m][n] = (f32x4){0.f, 0.f, 0.f, 0.f};
        cur = nxt; cA = nA; cB = nB; ++ui;
    }
    PG8_WAIT_V(0);
    if (wr == 0) PG8_BAR;
    PG8_BAR;
    if constexpr (Epi::AFTER_DRAIN) { E.fused(acc, cur, wr, wc, fr, fq, lds, wid, lane); S.done(cur); }
    PG8_STAMP();
    if (STAMP && wid == 0) { stamps[lane] = lane < nts ? (((unsigned long long)(unsigned)ts_hi << 32) | (unsigned)ts_lo) : 0ull;
        if (lane == 62) stamps[62] = rt_entry; if (lane == 63) stamps[63] = (unsigned long long)wall_clock64(); }
#undef PG8_STAMP
#undef PG8_SA
#undef PG8_SB
#undef PG8_STAGE
#undef PG8_LDA
#undef PG8_LDB
#undef PG8_MMA
#undef PG8_WAIT_V
#undef PG8_WAIT_L
#undef PG8_BAR
#undef PG8_SCHED
}
}
#define LAS __attribute__((address_space(3)))
typedef unsigned short bf16_t;
typedef short bf16x8 __attribute__((ext_vector_type(8)));
typedef float f32x4 __attribute__((ext_vector_type(4)));
typedef float f32x2 __attribute__((ext_vector_type(2)));
typedef unsigned u32x4 __attribute__((ext_vector_type(4)));
typedef unsigned u32x2 __attribute__((ext_vector_type(2)));
typedef LAS unsigned char* ldsp;

constexpr int D = 2048, NTOK = 8192, SEQ = 4096, MROWS = 8448, ROW_META = 8192;
constexpr int INC = 11712, NPAD = 11776;
constexpr int C_R = 0, C_K = 2048, C_V = 4096, C_WL = 6144, C_AL = 6240, C_GL = 6336, C_POOL = 6592, C_G0 = 7616, C_G1 = 9664;
constexpr int NUNITS = 4128;
constexpr float DSCALE = 0.6065306597126334f;
constexpr float DN_ALPHA = 1.189207115002721f;
constexpr float GN_EPS = 64e-5f, LN_EPS = 1e-5f;

constexpr size_t WS_P = 0;
constexpr size_t WS_H0B = 198967296;
constexpr size_t WS_WTA = WS_H0B + 34603008;
constexpr size_t WS_WTB = WS_WTA + 8388608;
constexpr size_t WS_WTOUT = WS_WTB + 4194304;
constexpr size_t WS_WTQ = WS_WTOUT + 8388608;
constexpr size_t WS_WTPOOL = WS_WTQ + 8388608;
constexpr size_t WS_WTW2 = WS_WTPOOL + 524288;
constexpr size_t WS_WTA2 = WS_WTW2 + 393216;
constexpr size_t WS_WTG2 = WS_WTA2 + 393216;
constexpr size_t WS_SUBK = WS_WTG2 + 1048576;
constexpr size_t WS_BONUS = WS_SUBK + 65536;
constexpr size_t WS_REGC = WS_BONUS + 1048576;
constexpr size_t WS_WTIN = WS_REGC;
constexpr size_t UNITB = (size_t)NUNITS * 4096 * 2;
constexpr size_t WS_G = WS_REGC;
constexpr size_t WS_H0T = WS_REGC + UNITB;
constexpr size_t WS_RT = WS_REGC + 2 * UNITB;
constexpr size_t WS_Y0 = WS_REGC + 3 * UNITB;
constexpr size_t WS_S0T = WS_REGC + 4 * UNITB;
constexpr size_t WS_YA = WS_REGC;
constexpr size_t WS_MERGED = WS_REGC + UNITB;
constexpr size_t WS_MPART = WS_REGC + 2 * UNITB;
constexpr size_t WS_X1 = WS_REGC + 2 * UNITB;
constexpr size_t WS_H1B = WS_REGC;
constexpr size_t WS_Q = WS_REGC + 4 * UNITB;
constexpr size_t WS_VB = WS_REGC + 5 * UNITB;
constexpr size_t WS_YB = WS_VB + 33554432;
constexpr size_t WS_GSIG = WS_YB + 16777216;
constexpr size_t WS_BAR = WS_GSIG + 4194304;
constexpr size_t WS_TSC = WS_BAR + 16384;
constexpr size_t WS_UB = WS_TSC + 131072;
constexpr size_t WS_END = WS_UB + 33554432;
static_assert(WS_X1 + 67108864 <= WS_Q, "overlay");
static_assert(WS_MPART + 67108864 <= WS_S0T, "overlay");

constexpr int LDS_BYTES = 163840;
constexpr int NPHASE = 9;

struct Params {
    const float* in[30];
    float* out;
    unsigned char* ws;
    int ph_lo, ph_hi;
};
enum { I_X = 0, I_META, I_LNIN_G, I_LNIN_B, I_WIN, I_MU, I_W0, I_WW2, I_A0, I_WA2, I_WG2, I_KK, I_KA, I_RK, I_GNG, I_GNB, I_WPOOL, I_PSCALE, I_BGATE,
       I_WBA, I_WBB, I_WOUT, I_LN1G, I_LN1B, I_WQ, I_SUBK, I_UT, I_VT, I_LN2G, I_LN2B };

__device__ __forceinline__ unsigned pk2(float lo, float hi) { return pg8::cvt_pk_bf16(lo, hi); }
__device__ __forceinline__ float bflo(unsigned w) { return __uint_as_float(w << 16); }
__device__ __forceinline__ float bfhi(unsigned w) { return __uint_as_float(w & 0xffff0000u); }
__device__ __forceinline__ float bf1(bf16_t h) { return __uint_as_float(((unsigned)h) << 16); }
__device__ __forceinline__ bf16_t f2bf1(float f) { return (bf16_t)(pk2(f, f) & 0xffffu); }
__device__ __forceinline__ float wave_sum(float v) {
#pragma unroll
    for (int o = 1; o < 64; o <<= 1) v += __shfl_xor(v, o);
    return v;
}
__device__ __forceinline__ float sigmoidf_(float x) { return 1.0f / (1.0f + __expf(-x)); }
__device__ __forceinline__ f32x4 mfma16(bf16x8 a, bf16x8 b, f32x4 c) { return __builtin_amdgcn_mfma_f32_16x16x32_bf16(a, b, c, 0, 0, 0); }
__device__ __forceinline__ void unpack8(const u32x4 w, float* f) {
    f[0] = bflo(w.x); f[1] = bfhi(w.x); f[2] = bflo(w.y); f[3] = bfhi(w.y); f[4] = bflo(w.z); f[5] = bfhi(w.z); f[6] = bflo(w.w); f[7] = bfhi(w.w);
}
__device__ __forceinline__ u32x4 pack8(const float* f) { u32x4 w; w.x = pk2(f[0], f[1]); w.y = pk2(f[2], f[3]); w.z = pk2(f[4], f[5]); w.w = pk2(f[6], f[7]); return w; }
#define DPPF(v, ctrl) __builtin_bit_cast(float, __builtin_amdgcn_update_dpp(0, __builtin_bit_cast(int, (v)), (ctrl), 0xF, 0xF, true))
__device__ __forceinline__ float readlane_f(float v, int l) { return __builtin_bit_cast(float, __builtin_amdgcn_readlane(__builtin_bit_cast(int, v), l)); }
__device__ __forceinline__ float wave_sum_dpp(float v) {
    v += DPPF(v, 0xB1); v += DPPF(v, 0x4E); v += DPPF(v, 0x141); v += DPPF(v, 0x140);
    return (readlane_f(v, 0) + readlane_f(v, 16)) + (readlane_f(v, 32) + readlane_f(v, 48));
}
__device__ __forceinline__ float wave_max_dpp(float v) {
    v = fmaxf(v, DPPF(v, 0xB1)); v = fmaxf(v, DPPF(v, 0x4E)); v = fmaxf(v, DPPF(v, 0x141)); v = fmaxf(v, DPPF(v, 0x140));
    return fmaxf(fmaxf(readlane_f(v, 0), readlane_f(v, 16)), fmaxf(readlane_f(v, 32), readlane_f(v, 48)));
}
#define BLOCK_SYNC() __syncthreads()
#define XB_TMO      128
#define XB_XCNT(j)  (256  + 64 * (j))
#define XB_XSUB(j)  (1280 + 64 * (j))
#define XB_XGEN(j)  (2304 + 64 * (j))
#define XB_TOP      3328
#define XB_TOPGEN   3392
#define XCD_BAR_WORDS 3456
#define XB_SPIN_CAP (1u << 18)

__device__ __forceinline__ unsigned xb_ld(unsigned* p)              { return __hip_atomic_load(p, __ATOMIC_RELAXED, __HIP_MEMORY_SCOPE_AGENT); }
__device__ __forceinline__ unsigned xb_add(unsigned* p, unsigned v) { return __hip_atomic_fetch_add(p, v, __ATOMIC_RELAXED, __HIP_MEMORY_SCOPE_AGENT); }
__device__ __forceinline__ unsigned xb_xcc_id() { return (unsigned)__builtin_amdgcn_s_getreg((3 << 11) | 20) & 0xFu; }
#define XB_SPIN(cond, bar) do { unsigned _sp = 0; while (cond) { __builtin_amdgcn_s_sleep(1); \
    if ((++_sp & 255u) == 0u) { if (xb_ld(&(bar)[XB_TMO])) break; if (_sp > XB_SPIN_CAP) { atomicAdd(&(bar)[XB_TMO], 1u); break; } } } } while (0)

struct XcdBarrier {
    unsigned* bar; unsigned x;
    volatile LAS unsigned* st;
};

__device__ __forceinline__ XcdBarrier xcd_barrier_post(unsigned* bar, volatile LAS unsigned* st) {
    XcdBarrier b; b.bar = bar; b.x = xb_xcc_id(); b.st = st;
    if (threadIdx.x == 0) (void)xb_add(&bar[XB_XCNT(b.x)], 1u);
    return b;
}
__device__ __forceinline__ void xcd_barrier_complete(unsigned* bar, unsigned x, unsigned& nloc, unsigned& nx) {
    const unsigned G = gridDim.x * gridDim.y * gridDim.z;
    unsigned sum, cnt, mine, sp = 0u;
    for (;;) {
        sum = 0u; cnt = 0u; mine = 0u;
#pragma unroll
        for (unsigned j = 0; j < 16; ++j) { const unsigned c = xb_ld(&bar[XB_XCNT(j)]); sum += c; cnt += (c > 0u) ? 1u : 0u; mine = (j == x) ? c : mine; }
        if (sum == G) break;
        __builtin_amdgcn_s_sleep(1);
        if ((++sp & 255u) == 0u) { if (xb_ld(&bar[XB_TMO])) break; if (sp > XB_SPIN_CAP) { atomicAdd(&bar[XB_TMO], 1u); break; } }
    }
    nloc = mine > 0u ? mine : 1u; nx = cnt > 0u ? cnt : 1u;
}

__device__ __forceinline__ void xcd_barrier(const XcdBarrier& b) {
    asm volatile("s_waitcnt vmcnt(0)" ::: "memory");
    __syncthreads();
    if (threadIdx.x == 0) {
        unsigned* bar = b.bar;
        __builtin_amdgcn_s_waitcnt(0);
        unsigned nloc = b.st[0], nx = b.st[1];
        if (nloc == 0u) { xcd_barrier_complete(bar, b.x, nloc, nx); b.st[0] = nloc; b.st[1] = nx; }
        const unsigned old = xb_add(&bar[XB_XSUB(b.x)], 1u);
        const unsigned gen = old / nloc;
        if (old + 1u == (gen + 1u) * nloc) {
            __builtin_amdgcn_fence(__ATOMIC_RELEASE, "agent");
            asm volatile("s_waitcnt vmcnt(0)" ::: "memory");
            const unsigned og = xb_add(&bar[XB_TOP], 1u);
            const unsigned tg = og / nx;
            if (og + 1u == (tg + 1u) * nx) xb_add(&bar[XB_TOPGEN], 1u);
            else XB_SPIN(xb_ld(&bar[XB_TOPGEN]) == tg, bar);
            __builtin_amdgcn_fence(__ATOMIC_ACQUIRE, "agent");
            xb_add(&bar[XB_XGEN(b.x)], 1u);
            asm volatile("s_waitcnt vmcnt(0)" ::: "memory");
        } else {
            XB_SPIN(xb_ld(&bar[XB_XGEN(b.x)]) == gen, bar);
            __builtin_amdgcn_fence(__ATOMIC_ACQUIRE, "agent");
            asm volatile("s_waitcnt vmcnt(0)" ::: "memory");
        }
    }
    __syncthreads();
}

__device__ __forceinline__ void ln_row_bf16(const float* src, const float* g, const float* b, bf16_t* dst, int lane) {
    f32x4 v[8]; float s = 0.f;
#pragma unroll
    for (int j = 0; j < 8; ++j) { v[j] = ((const f32x4*)src)[lane + 64 * j]; s += (v[j].x + v[j].y) + (v[j].z + v[j].w); }
    const float mean = wave_sum(s) * (1.0f / D); float s2 = 0.f;
#pragma unroll
    for (int j = 0; j < 8; ++j) { v[j] = v[j] - mean; s2 += (v[j].x * v[j].x + v[j].y * v[j].y) + (v[j].z * v[j].z + v[j].w * v[j].w); }
    const float rstd = 1.0f / sqrtf(wave_sum(s2) * (1.0f / D) + LN_EPS);
#pragma unroll
    for (int j = 0; j < 8; ++j) {
        const f32x4 gg = ((const f32x4*)g)[lane + 64 * j], bb = ((const f32x4*)b)[lane + 64 * j];
        const f32x4 o = v[j] * rstd * gg + bb;
        u32x2 w; w.x = pk2(o.x, o.y); w.y = pk2(o.z, o.w);
        ((u32x2*)dst)[lane + 64 * j] = w;
    }
}
__device__ __forceinline__ void transpose_item(const float* W, int K, int N, int Npad, bf16_t* Wt, int item, int lane) {
    const int nblk = Npad >> 6, kb = item / nblk, nb = item - kb * nblk, n = nb * 64 + lane, k0 = kb * 32;
    float v[32];
    if (n < N) {
#pragma unroll
        for (int i = 0; i < 32; ++i) v[i] = W[(size_t)(k0 + i) * N + n];
    } else {
#pragma unroll
        for (int i = 0; i < 32; ++i) v[i] = 0.f;
    }
    u32x4* o = (u32x4*)(Wt + (size_t)n * K + k0);
#pragma unroll
    for (int c = 0; c < 4; ++c) { u32x4 w; w.x = pk2(v[8 * c], v[8 * c + 1]); w.y = pk2(v[8 * c + 2], v[8 * c + 3]); w.z = pk2(v[8 * c + 4], v[8 * c + 5]); w.w = pk2(v[8 * c + 6], v[8 * c + 7]); o[c] = w; }
}
__device__ __forceinline__ void phase0(const Params& P) {
    const int lane = threadIdx.x & 63, wave = threadIdx.x >> 6;
    const int gw = blockIdx.x * 8 + wave, NGW = gridDim.x * 8;
    unsigned char* ws = P.ws;
    constexpr int T_IN = 64 * 184, T_A = 64 * 32, T_B = 32 * 32, T_O = 64 * 32, T_Q = 64 * 32, T_POOL = 4 * 32, T_W2 = 3 * 32, T_A2 = 3 * 32, T_G2 = 8 * 32;
    constexpr int T_LN = MROWS, T_SK = 64;
    constexpr int NIT = T_IN + T_A + T_B + T_O + T_Q + T_POOL + T_W2 + T_A2 + T_G2 + T_LN + T_SK;
    for (int it = gw; it < NIT; it += NGW) {
        int r = it;
        if (r < T_IN) { transpose_item(P.in[I_WIN], 2048, INC, NPAD, (bf16_t*)(ws + WS_WTIN), r, lane); continue; } r -= T_IN;
        if (r < T_A) { transpose_item(P.in[I_WBA], 2048, 2048, 2048, (bf16_t*)(ws + WS_WTA), r, lane); continue; } r -= T_A;
        if (r < T_B) { transpose_item(P.in[I_WBB], 1024, 2048, 2048, (bf16_t*)(ws + WS_WTB), r, lane); continue; } r -= T_B;
        if (r < T_O) { transpose_item(P.in[I_WOUT], 2048, 2048, 2048, (bf16_t*)(ws + WS_WTOUT), r, lane); continue; } r -= T_O;
        if (r < T_Q) { transpose_item(P.in[I_WQ], 2048, 2048, 2048, (bf16_t*)(ws + WS_WTQ), r, lane); continue; } r -= T_Q;
        if (r < T_POOL) { const int g = r >> 5; transpose_item(P.in[I_WPOOL] + g * 65536, 256, 256, 256, (bf16_t*)(ws + WS_WTPOOL) + g * 65536, r & 31, lane); continue; } r -= T_POOL;
        if (r < T_W2) { transpose_item(P.in[I_WW2], 96, 2048, 2048, (bf16_t*)(ws + WS_WTW2), r, lane); continue; } r -= T_W2;
        if (r < T_A2) { transpose_item(P.in[I_WA2], 96, 2048, 2048, (bf16_t*)(ws + WS_WTA2), r, lane); continue; } r -= T_A2;
        if (r < T_G2) { transpose_item(P.in[I_WG2], 256, 2048, 2048, (bf16_t*)(ws + WS_WTG2), r, lane); continue; } r -= T_G2;
        if (r < T_LN) {
            bf16_t* dst = (bf16_t*)(ws + WS_H0B) + (size_t)r * D;
            if (r < NTOK) ln_row_bf16(P.in[I_X] + (size_t)r * D, P.in[I_LNIN_G], P.in[I_LNIN_B], dst, lane);
            else if (r < NTOK + 16) ln_row_bf16(P.in[I_META] + (size_t)(r - NTOK) * D, P.in[I_LNIN_G], P.in[I_LNIN_B], dst, lane);
            else {
#pragma unroll
                for (int j = 0; j < 8; ++j) ((u32x2*)dst)[lane + 64 * j] = (u32x2){0u, 0u};
            }
            continue;
        }
        r -= T_LN;
        {
            const float* s = P.in[I_SUBK] + r * 512 + lane * 8; float f[8];
#pragma unroll
            for (int i = 0; i < 8; ++i) f[i] = s[i];
            *(u32x4*)((bf16_t*)(ws + WS_SUBK) + r * 512 + lane * 8) = pack8(f);
        }
    }
}
namespace pg8 {
struct EpiGateA {
    static constexpr bool PERM = false, AFTER_DRAIN = false;
    float* C; const bf16_t* p; const float* bgate;
    __device__ __forceinline__ void operator()(const f32x4 (&acc)[2][2][4][2], const Unit& u, int wr, int wc, int fr, int fq) const {
        const int row0 = u.pm * BM + wr * 64 + fr, col0 = u.pn * BM + wc * 32 + 4 * fq;
#pragma unroll
        for (int ai = 0; ai < 2; ++ai)
#pragma unroll
            for (int m = 0; m < 4; ++m) { const size_t row = (size_t)(row0 + ai * HALF + m * 16);
#pragma unroll
                for (int bj = 0; bj < 2; ++bj)
#pragma unroll
                    for (int n = 0; n < 2; ++n) { const int col = col0 + bj * HALF + n * 16;
                        const u32x2 pw = *(const u32x2*)(p + row * NPAD + C_G0 + col); const f32x4 bg = *(const f32x4*)(bgate + col);
                        f32x4 g; g.x = sigmoidf_(bflo(pw.x) + bg.x); g.y = sigmoidf_(bfhi(pw.x) + bg.y); g.z = sigmoidf_(bflo(pw.y) + bg.z); g.w = sigmoidf_(bfhi(pw.y) + bg.w);
                        *(f32x4*)(C + row * D + col) = acc[ai][bj][m][n] * g; } }
    }
};
struct EpiGateB {
    static constexpr bool PERM = false, AFTER_DRAIN = false;
    const float* C; bf16_t* O; const bf16_t* p; const float* bgate;
    __device__ __forceinline__ void operator()(const f32x4 (&acc)[2][2][4][2], const Unit& u, int wr, int wc, int fr, int fq) const {
        const int row0 = u.pm * BM + wr * 64 + fr, col0 = u.pn * BM + wc * 32 + 4 * fq;
#pragma unroll
        for (int ai = 0; ai < 2; ++ai)
#pragma unroll
            for (int m = 0; m < 4; ++m) { const size_t row = (size_t)(row0 + ai * HALF + m * 16);
#pragma unroll
                for (int bj = 0; bj < 2; ++bj)
#pragma unroll
                    for (int n = 0; n < 2; ++n) { const int col = col0 + bj * HALF + n * 16;
                        const u32x2 pw = *(const u32x2*)(p + row * NPAD + C_G1 + col); const f32x4 bg = *(const f32x4*)(bgate + D + col);
                        f32x4 g; g.x = sigmoidf_(bflo(pw.x) + bg.x); g.y = sigmoidf_(bfhi(pw.x) + bg.y); g.z = sigmoidf_(bflo(pw.y) + bg.z); g.w = sigmoidf_(bfhi(pw.y) + bg.w);
                        const f32x4 o = *(const f32x4*)(C + row * D + col) + acc[ai][bj][m][n] * g;
                        u32x2 w; w.x = cvt_pk_bf16(o.x, o.y); w.y = cvt_pk_bf16(o.z, o.w);
                        *(u32x2*)(O + row * D + col) = w; } }
    }
};
struct EpiResid {
    static constexpr bool PERM = false, AFTER_DRAIN = false;
    float* C; const bf16_t* h0; float alpha;
    __device__ __forceinline__ void operator()(const f32x4 (&acc)[2][2][4][2], const Unit& u, int wr, int wc, int fr, int fq) const {
        const int row0 = u.pm * BM + wr * 64 + fr, col0 = u.pn * BM + wc * 32 + 4 * fq;
#pragma unroll
        for (int ai = 0; ai < 2; ++ai)
#pragma unroll
            for (int m = 0; m < 4; ++m) { const size_t row = (size_t)(row0 + ai * HALF + m * 16);
#pragma unroll
                for (int bj = 0; bj < 2; ++bj)
#pragma unroll
                    for (int n = 0; n < 2; ++n) { const int col = col0 + bj * HALF + n * 16;
                        const u32x2 hw = *(const u32x2*)(h0 + row * D + col);
                        f32x4 hv; hv.x = bflo(hw.x); hv.y = bfhi(hw.x); hv.z = bflo(hw.y); hv.w = bfhi(hw.y);
                        *(f32x4*)(C + row * D + col) = hv * alpha + acc[ai][bj][m][n]; } }
    }
};
}
template <class Epi>
__device__ __forceinline__ void run_gemm(ldsp lds, const bf16_t* A, const bf16_t* Bt, int M, int N, int K, const Epi& E) {
    pg8::Gemm g; g.A = A; g.Bt = Bt; g.M = M; g.N = N; g.K = K;
    pg8::StaticOrder S; S.init(M, N, (int)gridDim.x, (int)blockIdx.x);
    pg8::gemm_phase<Epi, pg8::StaticOrder, false>(lds, g, S, E, nullptr);
}
constexpr int LD64 = 72, MATB = 64 * LD64 * 2, LDK = 104;
constexpr int O_AB = 0, O_RB = 1 * MATB, O_BH = 2 * MATB, O_KH = 3 * MATB, O_ABT = 4 * MATB, O_BTT = 5 * MATB, O_KTT = 6 * MATB, O_VT = 7 * MATB;
constexpr int O_M0 = 8 * MATB, O_M0T = 9 * MATB, O_M1 = 10 * MATB, O_M1T = 11 * MATB, O_PA = 12 * MATB, O_PB = 13 * MATB, O_MAK = 14 * MATB, O_MRB = 15 * MATB, O_MRK = 16 * MATB;
constexpr int O_ELEND = 17 * MATB, O_WT = O_ELEND + 256;
constexpr int O_WL = 8 * MATB, O_AL = O_WL + 64 * LDK * 2, O_Z = O_AL + 64 * LDK * 2, O_AZ = O_Z + 64 * 68 * 4;
static_assert(O_AZ + 64 * 68 * 4 <= O_ELEND, "lds");
static_assert(O_WT + 2048 <= LDS_BYTES - 16, "lds");

__device__ __forceinline__ bf16x8 ldsfrag(ldsp lds, int off, int ld, int row, int kofs) { return *(const LAS bf16x8*)(lds + off + (row * ld + kofs) * 2); }
__device__ __forceinline__ void st4(ldsp lds, int off, int row, int col, const f32x4 v) {
    u32x2 w; w.x = pk2(v.x, v.y); w.y = pk2(v.z, v.w); *(LAS u32x2*)(lds + off + (row * LD64 + col) * 2) = w; }
__device__ __forceinline__ void st1(ldsp lds, int off, int row, int col, float v) { *(LAS bf16_t*)(lds + off + (row * LD64 + col) * 2) = f2bf1(v); }

__device__ __forceinline__ float fast_rcp(float x) { return __builtin_amdgcn_rcpf(x); }
__device__ __forceinline__ float fast_sigmoid(float x) { return fast_rcp(1.0f + __expf(-x)); }
__device__ __forceinline__ float fast_tanh(float x) { return 1.0f - 2.0f * fast_rcp(1.0f + __expf(2.0f * x)); }
__device__ __forceinline__ u32x4 ld8(const bf16_t* p) { return p ? *(const u32x4*)p : (u32x4){0u, 0u, 0u, 0u}; }
__device__ __forceinline__ void shift8r(const u32x4 cw, const u32x4 pw, const float* mu, float* x) {
    float c[8], q[8]; unpack8(cw, c); unpack8(pw, q);
    const f32x4 m0 = *(const f32x4*)mu, m1 = *(const f32x4*)(mu + 4);
    const float mm[8] = {m0.x, m0.y, m0.z, m0.w, m1.x, m1.y, m1.z, m1.w};
#pragma unroll
    for (int i = 0; i < 8; ++i) x[i] = c[i] + (q[i] - c[i]) * mm[i];
}
__device__ __forceinline__ int tcol(int row, int col) { return ((((col >> 3) ^ (row >> 3)) & 7) << 3) | (col & 7); }
__device__ __forceinline__ bf16x8 ldsfragT(ldsp lds, int off, int row, int kofs) { return *(const LAS bf16x8*)(lds + off + (row * LD64 + tcol(row, kofs)) * 2); }
__device__ __forceinline__ void st1T(ldsp lds, int off, int row, int col, float v) { *(LAS bf16_t*)(lds + off + (row * LD64 + tcol(row, col)) * 2) = f2bf1(v); }
__device__ __forceinline__ void shift8(const bf16_t* pcur, const bf16_t* pprev, const float* mu, float* x) {
    float c[8], q[8];
    if (pcur) unpack8(*(const u32x4*)pcur, c); else {
#pragma unroll
        for (int i = 0; i < 8; ++i) c[i] = 0.f; }
    if (pprev) unpack8(*(const u32x4*)pprev, q); else {
#pragma unroll
        for (int i = 0; i < 8; ++i) q[i] = 0.f; }
    const f32x4 m0 = *(const f32x4*)mu, m1 = *(const f32x4*)(mu + 4);
    const float mm[8] = {m0.x, m0.y, m0.z, m0.w, m1.x, m1.y, m1.z, m1.w};
#pragma unroll
    for (int i = 0; i < 8; ++i) x[i] = c[i] + (q[i] - c[i]) * mm[i];
}

template <bool DO_P, bool DO_SQ>
__device__ __forceinline__ void dbl_step(ldsp lds, int sN, int sT, int dN, int dT, int pC, int pN, int tm, int tn0, int fr, int fq) {
    bf16x8 a[2];
#pragma unroll
    for (int ks = 0; ks < 2; ++ks) a[ks] = ldsfrag(lds, sT, LD64, 16 * tm + fr, ks * 32 + fq * 8);
#pragma unroll
    for (int t2 = 0; t2 < 2; ++t2) {
        const int nt = tn0 + t2, t = 16 * nt + fr, s0 = 16 * tm + 4 * fq;
        if (DO_P) {
            f32x4 acc = {0.f, 0.f, 0.f, 0.f};
#pragma unroll
            for (int ks = 0; ks < 2; ++ks) acc = mfma16(a[ks], ldsfrag(lds, pC, LD64, t, ks * 32 + fq * 8), acc);
            const u32x2 pw = *(const LAS u32x2*)(lds + pC + (t * LD64 + s0) * 2);
            acc.x += bflo(pw.x); acc.y += bfhi(pw.x); acc.z += bflo(pw.y); acc.w += bfhi(pw.y);
            st4(lds, pN, t, s0, acc);
        }
        if (DO_SQ) {
            f32x4 acc = {0.f, 0.f, 0.f, 0.f};
#pragma unroll
            for (int ks = 0; ks < 2; ++ks) acc = mfma16(a[ks], ldsfrag(lds, sN, LD64, t, ks * 32 + fq * 8), acc);
            st4(lds, dN, t, s0, acc);
            st1(lds, dT, s0 + 0, t, acc.x); st1(lds, dT, s0 + 1, t, acc.y); st1(lds, dT, s0 + 2, t, acc.z); st1(lds, dT, s0 + 3, t, acc.w);
        }
    }
}


#ifdef DBG_STAGE
constexpr size_t DBG_STRIDE = (size_t)NUNITS * 512 * 4;
__device__ __forceinline__ void dbgsum(const Params& P, ldsp lds, int u, int stage, const int* offs, int nmat) {
    unsigned acc = 0;
    for (int m = 0; m < nmat; ++m)
        for (int k = 0; k < 4; ++k) { const int idx = threadIdx.x + 512 * k, row = idx >> 5, cp = idx & 31; const unsigned x = *(const LAS unsigned*)(lds + offs[m] + row * (LD64 * 2) + cp * 4); acc += (x & 0xffffu) + (x >> 16); }
    ((unsigned*)(P.ws + WS_S0T + (size_t)stage * DBG_STRIDE))[(size_t)u * 512 + threadIdx.x] = acc;
}
#define DBGSUM(stage, ...) do { const int offs_[] = {__VA_ARGS__}; dbgsum(P, lds, u, stage, offs_, (int)(sizeof(offs_) / sizeof(int))); } while (0)
#else
#define DBGSUM(stage, ...) do { } while (0)
#endif
struct PL { u32x4 rc, rq, kc, kq, vc, vq, cw[3], pw[3]; bf16x8 aw[3], aa[3]; };
__device__ __forceinline__ const bf16_t* unit_rowp(const bf16_t* pp, int u, int tl, int col) {
    int r;
    if (u >= 4096) r = (tl >= 48) ? (ROW_META + tl - 48) : -1;
    else { const int bh = u >> 6, c = u & 63, b = bh >> 5; r = (tl >= 0 || c > 0) ? (b * SEQ + c * 64 + tl) : (ROW_META + 15); }
    return r < 0 ? (const bf16_t*)nullptr : pp + (size_t)r * NPAD + col;
}
__device__ __forceinline__ void pl_load(const Params& P, int u, PL& L) {
    int tid = threadIdx.x; asm volatile("" : "+v"(tid));
    const int lane = tid & 63, wave = tid >> 6, fr = lane & 15, fq = lane >> 4, tm = wave >> 1;
    const bf16_t* pp = (const bf16_t*)(P.ws + WS_P);
    const int h = (u >= 4096) ? (u - 4096) : ((u >> 6) & 31);
    const int t = tid >> 3, hj = h * 64 + 8 * (tid & 7);
    L.rc = ld8(unit_rowp(pp, u, t, C_R + hj)); L.rq = ld8(unit_rowp(pp, u, t - 1, C_R + hj));
    L.kc = ld8(unit_rowp(pp, u, t, C_K + hj)); L.kq = ld8(unit_rowp(pp, u, t - 1, C_K + hj));
    L.vc = ld8(unit_rowp(pp, u, t, C_V + hj)); L.vq = ld8(unit_rowp(pp, u, t - 1, C_V + hj));
#pragma unroll
    for (int it = 0; it < 3; ++it) { const int idx = tid + 512 * it, mat = idx / 768, rem = idx - mat * 768, tt = rem / 12, ch = rem - tt * 12, col = (mat ? C_AL : C_WL) + ch * 8;
        L.cw[it] = ld8(unit_rowp(pp, u, tt, col)); L.pw[it] = ld8(unit_rowp(pp, u, tt - 1, col)); }
    const bf16_t* ww2 = (const bf16_t*)(P.ws + WS_WTW2) + (size_t)(h * 64 + 16 * tm + fr) * 96 + fq * 8;
    const bf16_t* wa2 = (const bf16_t*)(P.ws + WS_WTA2) + (size_t)(h * 64 + 16 * tm + fr) * 96 + fq * 8;
#pragma unroll
    for (int ks = 0; ks < 3; ++ks) { L.aw[ks] = *(const bf16x8*)(ww2 + ks * 32); L.aa[ks] = *(const bf16x8*)(wa2 + ks * 32); }
}
__device__ __forceinline__ void rwkv_unit(const Params& P, ldsp lds, int u, PL& L, int next_u) {
    int tid = threadIdx.x; asm volatile("" : "+v"(tid));
    const int lane = tid & 63, wave = tid >> 6, fr = lane & 15, fq = lane >> 4, tm = wave >> 1, tn0 = (wave & 1) * 2;
    unsigned char* ws = P.ws;
    const bf16_t* pp = (const bf16_t*)(ws + WS_P);
    const bool meta = u >= 4096;
    int b = 0, h, c = 0;
    if (meta) { h = u - 4096; } else { const int bh = u >> 6; c = u & 63; b = bh >> 5; h = bh & 31; }
    auto rowof = [&](int tl) -> int {
        if (meta) return (tl >= 48) ? (ROW_META + tl - 48) : -1;
        if (tl >= 0 || c > 0) return b * SEQ + c * 64 + tl;
        return ROW_META + 15;
    };
    auto rowp = [&](int tl, int col) -> const bf16_t* { const int r = rowof(tl); return r < 0 ? (const bf16_t*)nullptr : pp + (size_t)r * NPAD + col; };
    const float* mu = P.in[I_MU];
#ifndef RPT_AD
#define RPT_AD 1
#define RPT_E12 1
#define RPT_E35 1
#endif
    float lw[8], av[8], rv[8], kv[8], vv[8], kk[8], km[8];
    const int t = tid >> 3, jq = tid & 7, j0 = 8 * jq, hj = h * 64 + j0;
    const bool nulltok = meta && t < 48;
    for (int rpt_ = 0; rpt_ < RPT_AD; ++rpt_) {
    {
#pragma unroll
        for (int it = 0; it < 3; ++it) { const int idx = tid + 512 * it, mat = idx / 768, rem = idx - mat * 768, tt = rem / 12, ch = rem - tt * 12, col = (mat ? C_AL : C_WL) + ch * 8;
            float x[8]; shift8r(L.cw[it], L.pw[it], mu + col, x);
            if (mat == 0) {
#pragma unroll
                for (int i = 0; i < 8; ++i) x[i] = fast_tanh(x[i]);
            }
            *(LAS u32x4*)(lds + (mat ? O_AL : O_WL) + (tt * LDK + ch * 8) * 2) = pack8(x); }
    }
    BLOCK_SYNC();
    {
        f32x4 z[2] = {{0.f, 0.f, 0.f, 0.f}, {0.f, 0.f, 0.f, 0.f}}, az[2] = {{0.f, 0.f, 0.f, 0.f}, {0.f, 0.f, 0.f, 0.f}};
#pragma unroll
        for (int ks = 0; ks < 3; ++ks) {
            const bf16x8 aw = L.aw[ks], aa = L.aa[ks];
#pragma unroll
            for (int t2 = 0; t2 < 2; ++t2) {
                const int t = 16 * (tn0 + t2) + fr;
                z[t2] = mfma16(aw, ldsfrag(lds, O_WL, LDK, t, ks * 32 + fq * 8), z[t2]);
                az[t2] = mfma16(aa, ldsfrag(lds, O_AL, LDK, t, ks * 32 + fq * 8), az[t2]);
            }
        }
#pragma unroll
        for (int t2 = 0; t2 < 2; ++t2) {
            const int t = 16 * (tn0 + t2) + fr, j0 = 16 * tm + 4 * fq;
            *(LAS f32x4*)(lds + O_Z + (t * 68 + j0) * 4) = z[t2];
            *(LAS f32x4*)(lds + O_AZ + (t * 68 + j0) * 4) = az[t2];
        }
    }
    BLOCK_SYNC();
    float cs[8];
    {
        const f32x4 z0 = *(const LAS f32x4*)(lds + O_Z + (t * 68 + j0) * 4), z1 = *(const LAS f32x4*)(lds + O_Z + (t * 68 + j0 + 4) * 4);
        const f32x4 y0 = *(const LAS f32x4*)(lds + O_AZ + (t * 68 + j0) * 4), y1 = *(const LAS f32x4*)(lds + O_AZ + (t * 68 + j0 + 4) * 4);
        const float zz[8] = {z0.x, z0.y, z0.z, z0.w, z1.x, z1.y, z1.z, z1.w}, yy[8] = {y0.x, y0.y, y0.z, y0.w, y1.x, y1.y, y1.z, y1.w};
        const f32x4 w0a = *(const f32x4*)(P.in[I_W0] + hj), w0b = *(const f32x4*)(P.in[I_W0] + hj + 4), a0a = *(const f32x4*)(P.in[I_A0] + hj), a0b = *(const f32x4*)(P.in[I_A0] + hj + 4);
        const float w0[8] = {w0a.x, w0a.y, w0a.z, w0a.w, w0b.x, w0b.y, w0b.z, w0b.w}, a0[8] = {a0a.x, a0a.y, a0a.z, a0a.w, a0b.x, a0b.y, a0b.z, a0b.w};
#pragma unroll
        for (int i = 0; i < 8; ++i) { lw[i] = nulltok ? 0.f : -DSCALE * fast_sigmoid(w0[i] + zz[i]); av[i] = fast_sigmoid(a0[i] + yy[i]); cs[i] = lw[i]; }
#pragma unroll
        for (int d = 8; d < 64; d <<= 1) {
#pragma unroll
            for (int i = 0; i < 8; ++i) { const float o = __shfl_up(cs[i], d); cs[i] += (lane >= d) ? o : 0.f; }
        }
        if (lane >= 56) { *(LAS f32x4*)(lds + O_WT + (wave * 64 + j0) * 4) = (f32x4){cs[0], cs[1], cs[2], cs[3]}; *(LAS f32x4*)(lds + O_WT + (wave * 64 + j0 + 4) * 4) = (f32x4){cs[4], cs[5], cs[6], cs[7]}; }
        shift8r(L.rc, L.rq, mu + C_R + hj, rv); shift8r(L.kc, L.kq, mu + C_K + hj, kv); shift8r(L.vc, L.vq, mu + C_V + hj, vv);
        if (nulltok) {
#pragma unroll
            for (int i = 0; i < 8; ++i) { rv[i] = 0.f; kv[i] = 0.f; vv[i] = 0.f; }
        }
        const f32x4 kka = *(const f32x4*)(P.in[I_KK] + hj), kkb = *(const f32x4*)(P.in[I_KK] + hj + 4), kaa = *(const f32x4*)(P.in[I_KA] + hj), kab = *(const f32x4*)(P.in[I_KA] + hj + 4);
        const f32x4 rka = *(const f32x4*)(P.in[I_RK] + hj), rkb = *(const f32x4*)(P.in[I_RK] + hj + 4);
        const float kkw[8] = {kka.x, kka.y, kka.z, kka.w, kkb.x, kkb.y, kkb.z, kkb.w}, kaw[8] = {kaa.x, kaa.y, kaa.z, kaa.w, kab.x, kab.y, kab.z, kab.w}, rkw[8] = {rka.x, rka.y, rka.z, rka.w, rkb.x, rkb.y, rkb.z, rkb.w};
        float n2 = 0.f, bon = 0.f;
#pragma unroll
        for (int i = 0; i < 8; ++i) { kk[i] = kv[i] * kkw[i]; n2 += kk[i] * kk[i]; km[i] = kv[i] * (1.0f + (av[i] - 1.0f) * kaw[i]); bon += rv[i] * km[i] * rkw[i]; }
        n2 += DPPF(n2, 0xB1); n2 += DPPF(n2, 0x4E); n2 += DPPF(n2, 0x141);
        bon += DPPF(bon, 0xB1); bon += DPPF(bon, 0x4E); bon += DPPF(bon, 0x141);
        const float inv = 1.0f / fmaxf(sqrtf(n2), 1e-12f);
#pragma unroll
        for (int i = 0; i < 8; ++i) kk[i] *= inv;
        if (!meta && jq == 0) ((float*)(ws + WS_BONUS))[(size_t)(b * SEQ + c * 64 + t) * 32 + h] = bon;
    }
    BLOCK_SYNC();
    {
        float Lc[8], Le[8];
#pragma unroll
        for (int i = 0; i < 8; ++i) { Lc[i] = cs[i]; Le[i] = 0.f; }
#pragma unroll
        for (int w = 0; w < 8; ++w) {
            const f32x4 x0 = *(const LAS f32x4*)(lds + O_WT + (w * 64 + j0) * 4), x1 = *(const LAS f32x4*)(lds + O_WT + (w * 64 + j0 + 4) * 4);
            const float xx[8] = {x0.x, x0.y, x0.z, x0.w, x1.x, x1.y, x1.z, x1.w};
            const float msk = w < wave ? 1.0f : 0.0f;
#pragma unroll
            for (int i = 0; i < 8; ++i) { Le[i] += xx[i]; Lc[i] += msk * xx[i]; }
        }
        float Ab[8], Rb[8], Bh[8], Kh[8], Bt[8], Kt[8];
#pragma unroll
        for (int i = 0; i < 8; ++i) {
            const float eP = __expf(Lc[i] - lw[i]), eC = __expf(Lc[i]), eN = __expf(-Lc[i]), eE = __expf(Le[i] - Lc[i]);
            const float ka = kk[i] * av[i];
            Ab[i] = -kk[i] * eP; Rb[i] = rv[i] * eC; Bh[i] = ka * eN; Kh[i] = km[i] * eN; Bt[i] = ka * eE; Kt[i] = km[i] * eE;
        }
        *(LAS u32x4*)(lds + O_AB + (t * LD64 + j0) * 2) = pack8(Ab);
        *(LAS u32x4*)(lds + O_RB + (t * LD64 + j0) * 2) = pack8(Rb);
        *(LAS u32x4*)(lds + O_BH + (t * LD64 + j0) * 2) = pack8(Bh);
        *(LAS u32x4*)(lds + O_KH + (t * LD64 + j0) * 2) = pack8(Kh);
#pragma unroll
        for (int i = 0; i < 8; ++i) { st1T(lds, O_ABT, j0 + i, t, Ab[i]); st1T(lds, O_BTT, j0 + i, t, Bt[i]); st1T(lds, O_KTT, j0 + i, t, Kt[i]); st1T(lds, O_VT, j0 + i, t, vv[i]); }
        if (t == 63) {
#pragma unroll
            for (int i = 0; i < 8; ++i) *(LAS float*)(lds + O_ELEND + (j0 + i) * 4) = __expf(Le[i]);
        }
    }
    BLOCK_SYNC();
    }
    if (next_u >= 0) pl_load(P, next_u, L);
    DBGSUM(0, O_AB, O_RB, O_BH, O_KH, O_ABT, O_BTT, O_KTT, O_VT);
    for (int rpt_ = 0; rpt_ < RPT_E12; ++rpt_) {
    {
        bf16x8 abh[2], akh[2];
#pragma unroll
        for (int ks = 0; ks < 2; ++ks) { abh[ks] = ldsfrag(lds, O_BH, LD64, 16 * tm + fr, ks * 32 + fq * 8); akh[ks] = ldsfrag(lds, O_KH, LD64, 16 * tm + fr, ks * 32 + fq * 8); }
#pragma unroll
        for (int t2 = 0; t2 < 2; ++t2) {
            const int tt = 16 * (tn0 + t2) + fr, s0 = 16 * tm + 4 * fq;
            f32x4 mab = {0.f, 0.f, 0.f, 0.f}, mak = mab, mrb = mab, mrk = mab;
#pragma unroll
            for (int ks = 0; ks < 2; ++ks) {
                const bf16x8 bab = ldsfrag(lds, O_AB, LD64, tt, ks * 32 + fq * 8), brb = ldsfrag(lds, O_RB, LD64, tt, ks * 32 + fq * 8);
                mab = mfma16(abh[ks], bab, mab); mak = mfma16(akh[ks], bab, mak); mrb = mfma16(abh[ks], brb, mrb); mrk = mfma16(akh[ks], brb, mrk);
            }
            float vab[4] = {mab.x, mab.y, mab.z, mab.w}, vak[4] = {mak.x, mak.y, mak.z, mak.w}, vrb[4] = {mrb.x, mrb.y, mrb.z, mrb.w}, vrk[4] = {mrk.x, mrk.y, mrk.z, mrk.w}, vp[4];
#pragma unroll
            for (int r = 0; r < 4; ++r) { const int s = s0 + r; const bool st = s < tt, le = s <= tt;
                vab[r] = st ? vab[r] : 0.f; vak[r] = st ? vak[r] : 0.f; vrb[r] = le ? vrb[r] : 0.f; vrk[r] = le ? vrk[r] : 0.f; vp[r] = vab[r] + (s == tt ? 1.0f : 0.f); }
            st4(lds, O_M0, tt, s0, (f32x4){vab[0], vab[1], vab[2], vab[3]});
#pragma unroll
            for (int r = 0; r < 4; ++r) st1(lds, O_M0T, s0 + r, tt, vab[r]);
            st4(lds, O_PA, tt, s0, (f32x4){vp[0], vp[1], vp[2], vp[3]});
            st4(lds, O_MAK, tt, s0, (f32x4){vak[0], vak[1], vak[2], vak[3]});
            st4(lds, O_MRB, tt, s0, (f32x4){vrb[0], vrb[1], vrb[2], vrb[3]});
            st4(lds, O_MRK, tt, s0, (f32x4){vrk[0], vrk[1], vrk[2], vrk[3]});
        }
    }
    BLOCK_SYNC();
    DBGSUM(1, O_M0, O_M0T, O_PA, O_MAK, O_MRB, O_MRK);
    dbl_step<false, true>(lds, O_M0, O_M0T, O_M1, O_M1T, 0, 0, tm, tn0, fr, fq); BLOCK_SYNC();
    dbl_step<true, true>(lds, O_M1, O_M1T, O_M0, O_M0T, O_PA, O_PB, tm, tn0, fr, fq); BLOCK_SYNC();
    dbl_step<true, true>(lds, O_M0, O_M0T, O_M1, O_M1T, O_PB, O_PA, tm, tn0, fr, fq); BLOCK_SYNC();
    dbl_step<true, true>(lds, O_M1, O_M1T, O_M0, O_M0T, O_PA, O_PB, tm, tn0, fr, fq); BLOCK_SYNC();
    dbl_step<true, true>(lds, O_M0, O_M0T, O_M1, O_M1T, O_PB, O_PA, tm, tn0, fr, fq); BLOCK_SYNC();
    dbl_step<true, false>(lds, O_M1, O_M1T, 0, 0, O_PA, O_PB, tm, tn0, fr, fq); BLOCK_SYNC();
    }
    DBGSUM(2, O_PB);
    const size_t ub = (size_t)u * 4096;
    for (int rpt_ = 0; rpt_ < RPT_E35; ++rpt_) {
    {
        bf16x8 aT[2], aMak[2];
#pragma unroll
        for (int ks = 0; ks < 2; ++ks) { aT[ks] = ldsfrag(lds, O_PB, LD64, 16 * tm + fr, ks * 32 + fq * 8); aMak[ks] = ldsfrag(lds, O_MAK, LD64, 16 * tm + fr, ks * 32 + fq * 8); }
#pragma unroll
        for (int t2 = 0; t2 < 2; ++t2) {
            const int n = 16 * (tn0 + t2) + fr, t0 = 16 * tm + 4 * fq;
            f32x4 at = {0.f, 0.f, 0.f, 0.f}, xt = at;
#pragma unroll
            for (int ks = 0; ks < 2; ++ks) { at = mfma16(aT[ks], ldsfragT(lds, O_ABT, n, ks * 32 + fq * 8), at); xt = mfma16(aMak[ks], ldsfragT(lds, O_VT, n, ks * 32 + fq * 8), xt); }
            st4(lds, O_M0, n, t0, at); st4(lds, O_M0T, n, t0, xt);
        }
    }
    BLOCK_SYNC();
    DBGSUM(3, O_M0, O_M0T);
    {
        bf16x8 aT[2], aAt[2];
#pragma unroll
        for (int ks = 0; ks < 2; ++ks) { aT[ks] = ldsfrag(lds, O_PB, LD64, 16 * tm + fr, ks * 32 + fq * 8); aAt[ks] = ldsfrag(lds, O_M0, LD64, 16 * tm + fr, ks * 32 + fq * 8); }
        bf16_t* Rt = (bf16_t*)(ws + WS_RT) + ub; bf16_t* Gp = (bf16_t*)(ws + WS_G) + ub;
#pragma unroll
        for (int t2 = 0; t2 < 2; ++t2) {
            const int n = 16 * (tn0 + t2) + fr, m0 = 16 * tm + 4 * fq;
            f32x4 u0 = {0.f, 0.f, 0.f, 0.f}, rt = u0, g = u0;
#pragma unroll
            for (int ks = 0; ks < 2; ++ks) {
                u0 = mfma16(aT[ks], ldsfrag(lds, O_M0T, LD64, n, ks * 32 + fq * 8), u0);
                rt = mfma16(aAt[ks], ldsfrag(lds, O_MRB, LD64, n, ks * 32 + fq * 8), rt);
                g = mfma16(aAt[ks], ldsfragT(lds, O_BTT, n, ks * 32 + fq * 8), g);
            }
            st4(lds, O_M1, n, m0, u0);
            const u32x2 rw = *(const LAS u32x2*)(lds + O_RB + (n * LD64 + m0) * 2);
            rt.x += bflo(rw.x); rt.y += bfhi(rw.x); rt.z += bflo(rw.y); rt.w += bfhi(rw.y);
            { u32x2 w; w.x = pk2(rt.x, rt.y); w.y = pk2(rt.z, rt.w); *(u32x2*)(Rt + n * 64 + m0) = w; }
            if ((n >> 2) == (m0 >> 2)) { const float e = *(const LAS float*)(lds + O_ELEND + n * 4); const int r = n & 3;
                g.x += (r == 0) ? e : 0.f; g.y += (r == 1) ? e : 0.f; g.z += (r == 2) ? e : 0.f; g.w += (r == 3) ? e : 0.f; }
            { const int pos0 = 32 * (tm >> 1) + 8 * fq + 4 * (tm & 1); u32x2 w; w.x = pk2(g.x, g.y); w.y = pk2(g.z, g.w); *(u32x2*)(Gp + n * 64 + pos0) = w; }
        }
    }
    BLOCK_SYNC();
    DBGSUM(4, O_M1);
    {
        bf16x8 aB[2], aK[2], aU[2], aV[2];
#pragma unroll
        for (int ks = 0; ks < 2; ++ks) { const int row = 16 * tm + fr, ko = ks * 32 + fq * 8;
            aB[ks] = ldsfragT(lds, O_BTT, row, ko); aK[ks] = ldsfragT(lds, O_KTT, row, ko); aU[ks] = ldsfrag(lds, O_M1, LD64, row, ko); aV[ks] = ldsfragT(lds, O_VT, row, ko); }
        bf16_t* H0t = (bf16_t*)(ws + WS_H0T) + ub; bf16_t* Y0s = (bf16_t*)(ws + WS_Y0) + ub;
#pragma unroll
        for (int t2 = 0; t2 < 2; ++t2) {
            const int n = 16 * (tn0 + t2) + fr, m0 = 16 * tm + 4 * fq;
            f32x4 hh = {0.f, 0.f, 0.f, 0.f}, yy = hh;
#pragma unroll
            for (int ks = 0; ks < 2; ++ks) { const int ko = ks * 32 + fq * 8;
                const bf16x8 bU = ldsfrag(lds, O_M1, LD64, n, ko), bV = ldsfragT(lds, O_VT, n, ko), bRb = ldsfrag(lds, O_MRB, LD64, n, ko), bRk = ldsfrag(lds, O_MRK, LD64, n, ko);
                hh = mfma16(aB[ks], bU, hh); hh = mfma16(aK[ks], bV, hh);
                yy = mfma16(aU[ks], bRb, yy); yy = mfma16(aV[ks], bRk, yy); }
            { u32x2 w; w.x = pk2(hh.x, hh.y); w.y = pk2(hh.z, hh.w); *(u32x2*)(H0t + n * 64 + m0) = w; }
            { u32x2 w; w.x = pk2(yy.x, yy.y); w.y = pk2(yy.z, yy.w); *(u32x2*)(Y0s + n * 64 + m0) = w; }
        }
    }
    BLOCK_SYNC();
    }
}

constexpr int LDU = 264;
__device__ __forceinline__ void pool_unit(const Params& P, ldsp lds, int pu) {
    int tid = threadIdx.x; asm volatile("" : "+v"(tid));
    const int lane = tid & 63, wave = tid >> 6, fr = lane & 15, fq = lane >> 4;
    unsigned char* ws = P.ws;
    const bf16_t* pp = (const bf16_t*)(ws + WS_P);
    const int g = pu & 3, tt = pu >> 2, b = tt >> 6, ti0 = (tt & 63) * 64;
    constexpr int O_U = 0, O_PL = 79 * LDU * 2;
    for (int idx = tid; idx < 79 * 32; idx += 512) {
        const int lr = idx >> 5, ch = idx & 31, ti = ti0 + lr - 15;
        const int row = ti >= 0 ? b * SEQ + ti : ROW_META + 16 + ti;
        *(LAS u32x4*)(lds + O_U + (lr * LDU + ch * 8) * 2) = *(const u32x4*)(pp + (size_t)row * NPAD + C_POOL + g * 256 + ch * 8);
    }
    BLOCK_SYNC();
    {
        const int t = tid >> 3, cq = tid & 7, win = 2 << g; const float inv = 1.0f / (float)win;
#pragma unroll
        for (int cc = 0; cc < 4; ++cc) {
            const int c0 = cq * 32 + cc * 8; float s[8], own[8];
            unpack8(*(const LAS u32x4*)(lds + O_U + ((15 + t) * LDU + c0) * 2), own);
#pragma unroll
            for (int i = 0; i < 8; ++i) s[i] = own[i];
            for (int d = 1; d < win; ++d) { float x[8]; unpack8(*(const LAS u32x4*)(lds + O_U + ((15 + t - d) * LDU + c0) * 2), x);
#pragma unroll
                for (int i = 0; i < 8; ++i) s[i] += x[i]; }
#pragma unroll
            for (int i = 0; i < 8; ++i) s[i] = s[i] * inv - own[i];
            *(LAS u32x4*)(lds + O_PL + (t * LDU + c0) * 2) = pack8(s);
        }
    }
    BLOCK_SYNC();
    {
        const bf16_t* wt = (const bf16_t*)(ws + WS_WTPOOL) + (size_t)g * 65536;
        f32x4 acc[2][4];
#pragma unroll
        for (int a = 0; a < 2; ++a)
#pragma unroll
            for (int n = 0; n < 4; ++n) acc[a][n] = (f32x4){0.f, 0.f, 0.f, 0.f};
#pragma unroll 4
        for (int ks = 0; ks < 8; ++ks) {
            bf16x8 af[2];
#pragma unroll
            for (int a = 0; a < 2; ++a) af[a] = *(const bf16x8*)(wt + (size_t)(32 * wave + 16 * a + fr) * 256 + ks * 32 + fq * 8);
#pragma unroll
            for (int n = 0; n < 4; ++n) { const bf16x8 bf = ldsfrag(lds, O_PL, LDU, 16 * n + fr, ks * 32 + fq * 8);
#pragma unroll
                for (int a = 0; a < 2; ++a) acc[a][n] = mfma16(af[a], bf, acc[a][n]); }
        }
        bf16_t* yb = (bf16_t*)(ws + WS_YB);
        const float* psc = P.in[I_PSCALE] + g * 256;
#pragma unroll
        for (int a = 0; a < 2; ++a) { const int d0 = 32 * wave + 16 * a + 4 * fq; const f32x4 sc = *(const f32x4*)(psc + d0);
#pragma unroll
            for (int n = 0; n < 4; ++n) { const int t = 16 * n + fr; const f32x4 o = acc[a][n] * sc;
                u32x2 w; w.x = pk2(o.x, o.y); w.y = pk2(o.z, o.w);
                *(u32x2*)(yb + (size_t)(b * SEQ + ti0 + t) * 1024 + g * 256 + d0) = w; } }
    }
    BLOCK_SYNC();
}
__device__ __forceinline__ void gsig_unit(const Params& P, int gu) {
    int tid = threadIdx.x; asm volatile("" : "+v"(tid));
    const bf16_t* pp = (const bf16_t*)(P.ws + WS_P); bf16_t* gs = (bf16_t*)(P.ws + WS_GSIG);
    const float* mu = P.in[I_MU];
#pragma unroll
    for (int it = 0; it < 4; ++it) {
        const int idx = tid + 512 * it, tl = idx >> 5, ch = idx & 31, col = C_GL + ch * 8;
        const int row = gu * 64 + tl; const int prow = ((row & (SEQ - 1)) == 0) ? (ROW_META + 15) : row - 1;
        float x[8]; shift8r(*(const u32x4*)(pp + (size_t)row * NPAD + col), *(const u32x4*)(pp + (size_t)prow * NPAD + col), mu + col, x);
#pragma unroll
        for (int i = 0; i < 8; ++i) x[i] = fast_sigmoid(x[i]);
        *(u32x4*)(gs + (size_t)row * 256 + ch * 8) = pack8(x);
    }
}
__device__ __forceinline__ void phase2(const Params& P, ldsp lds) {
    PL L;
    if ((int)blockIdx.x < NUNITS) pl_load(P, blockIdx.x, L);
    for (int u = blockIdx.x; u < NUNITS + 512 + 128; u += gridDim.x) {
        if (u < NUNITS) { const int nu = u + (int)gridDim.x; rwkv_unit(P, lds, u, L, nu < NUNITS ? nu : -1); }
        else if (u < NUNITS + 512) pool_unit(P, lds, u - NUNITS);
        else gsig_unit(P, u - NUNITS - 512);
    }
}
__device__ __forceinline__ void convert_tables(const Params& P, int r0, int stride) {
    const int lane = threadIdx.x & 63;
    unsigned char* ws = P.ws;
    for (int r = r0; r < 32768; r += stride) {
        const float* src = (r < 16384 ? P.in[I_UT] : P.in[I_VT]) + (size_t)(r & 16383) * D;
        int* dst = (int*)(ws + (r < 16384 ? WS_UB : WS_VB) + (size_t)(r & 16383) * D);
        f32x4 v[8]; float am = 0.f;
#pragma unroll
        for (int j = 0; j < 8; ++j) { v[j] = ((const f32x4*)src)[lane + 64 * j]; am = fmaxf(am, fmaxf(fmaxf(fabsf(v[j].x), fabsf(v[j].y)), fmaxf(fabsf(v[j].z), fabsf(v[j].w)))); }
        am = wave_max_dpp(am);
        const float s = am > 0.f ? 256.0f / am : 1.0f;
#pragma unroll
        for (int j = 0; j < 8; ++j) { int w = 0; w = __builtin_amdgcn_cvt_pk_fp8_f32(v[j].x * s, v[j].y * s, w, false); w = __builtin_amdgcn_cvt_pk_fp8_f32(v[j].z * s, v[j].w * s, w, true); dst[lane + 64 * j] = w; }
        if (lane == 0) ((float*)(ws + WS_TSC))[r] = am > 0.f ? am * (1.0f / 256.0f) : 1.0f;
    }
}
__device__ __forceinline__ void phase3(const Params& P) {
    const int lane = threadIdx.x & 63, wave = threadIdx.x >> 6, fr = lane & 15, fq = lane >> 4;
    if (wave != 0) { convert_tables(P, blockIdx.x * 7 + (wave - 1), gridDim.x * 7); return; }
    unsigned char* ws = P.ws;
    const bf16_t* Gp = (const bf16_t*)(ws + WS_G); const bf16_t* H0t = (const bf16_t*)(ws + WS_H0T); bf16_t* S0t = (bf16_t*)(ws + WS_S0T);
    for (int item = blockIdx.x; item < 256; item += gridDim.x) {
        const int bh = item >> 2, vq = item & 3, h = bh & 31;
        bf16x8 Sb[2];
#pragma unroll
        for (int ks = 0; ks < 2; ++ks)
#pragma unroll
            for (int i = 0; i < 8; ++i) Sb[ks][i] = 0;
        bf16x8 g0[4][2], g1[4][2], g2[4][2], g3[4][2]; u32x2 h0[4], h1[4], h2[4], h3[4];
        auto load = [&](int step, bf16x8 (&ga)[4][2], u32x2 (&hf)[4]) {
            const int u = (step == 0) ? (4096 + h) : (bh * 64 + step - 1);
            const bf16_t* g = Gp + (size_t)u * 4096; const bf16_t* hh = H0t + (size_t)u * 4096;
#pragma unroll
            for (int mt = 0; mt < 4; ++mt) {
#pragma unroll
                for (int ks = 0; ks < 2; ++ks) ga[mt][ks] = *(const bf16x8*)(g + (16 * mt + fr) * 64 + ks * 32 + fq * 8);
                hf[mt] = *(const u32x2*)(hh + (16 * vq + fr) * 64 + 16 * mt + 4 * fq);
            }
        };
        auto apply = [&](int step, const bf16x8 (&ga)[4][2], const u32x2 (&hf)[4]) {
            f32x4 acc[4];
#pragma unroll
            for (int mt = 0; mt < 4; ++mt) {
                acc[mt] = (f32x4){bflo(hf[mt].x), bfhi(hf[mt].x), bflo(hf[mt].y), bfhi(hf[mt].y)};
                acc[mt] = mfma16(ga[mt][0], Sb[0], acc[mt]);
                acc[mt] = mfma16(ga[mt][1], Sb[1], acc[mt]);
            }
            bf16_t* so = S0t + (size_t)(bh * 64 + step) * 4096 + (16 * vq + fr) * 64 + 4 * fq;
            u32x2 w[4];
#pragma unroll
            for (int mt = 0; mt < 4; ++mt) { w[mt].x = pk2(acc[mt].x, acc[mt].y); w[mt].y = pk2(acc[mt].z, acc[mt].w); *(u32x2*)(so + 16 * mt) = w[mt]; }
#pragma unroll
            for (int ks = 0; ks < 2; ++ks) {
                const u32x4 q4 = (u32x4){w[2 * ks].x, w[2 * ks].y, w[2 * ks + 1].x, w[2 * ks + 1].y};
                Sb[ks] = __builtin_bit_cast(bf16x8, q4);
            }
        };
        load(0, g0, h0); load(1, g1, h1); load(2, g2, h2);
#pragma unroll 1
        for (int step = 0; step < 64; step += 4) {
            load(step + 3, g3, h3); apply(step, g0, h0);
            if (step + 4 < 64) load(step + 4, g0, h0);
            apply(step + 1, g1, h1);
            if (step + 5 < 64) load(step + 5, g1, h1);
            apply(step + 2, g2, h2);
            if (step + 6 < 64) load(step + 6, g2, h2);
            apply(step + 3, g3, h3);
        }
    }
}

constexpr int LDG = 264;
__device__ __forceinline__ void phase3b(const Params& P, ldsp lds) {
    int tid = threadIdx.x; asm volatile("" : "+v"(tid));
    const int lane = tid & 63, wave = tid >> 6, fr = lane & 15, fq = lane >> 4, wq = wave & 3;
    unsigned char* ws = P.ws;
    const bf16_t* pp = (const bf16_t*)(ws + WS_P);
    const float* mu = P.in[I_MU];
    constexpr int O_G2 = 0;
    for (int w = blockIdx.x; w < 256; w += gridDim.x) {
        const int h = w & 31;
        BLOCK_SYNC();
        for (int idx = tid; idx < 64 * 32; idx += 512) { const int row = idx >> 5, ch = idx & 31;
            *(LAS u32x4*)(lds + O_G2 + (row * LDG + ch * 8) * 2) = *(const u32x4*)((const bf16_t*)(ws + WS_WTG2) + (size_t)(h * 64 + row) * 256 + ch * 8); }
        BLOCK_SYNC();
        bf16x8 bG[8], bR[2], aS[4][2]; u32x2 yw[4], vc[4], vp[4]; float bon;
        auto unit_of = [&](int it, int& b, int& c) { const int q = (w >> 5) + 8 * (2 * it + (wave >> 2)); b = q >> 6; c = q & 63; };
        auto issue = [&](int it) {
            int b, c; unit_of(it, b, c); const int u = (b * 32 + h) * 64 + c, trow0 = b * SEQ + c * 64 + 16 * wq;
            const size_t ub = (size_t)u * 4096;
            const bf16_t* S0t = (const bf16_t*)(ws + WS_S0T) + ub; const bf16_t* Rt = (const bf16_t*)(ws + WS_RT) + ub; const bf16_t* Y0s = (const bf16_t*)(ws + WS_Y0) + ub;
            const int row = trow0 + fr; const int prow = (c == 0 && wq == 0 && fr == 0) ? (ROW_META + 15) : row - 1;
            const bf16_t* gsr = (const bf16_t*)(ws + WS_GSIG) + (size_t)row * 256 + fq * 8;
#pragma unroll
            for (int ks = 0; ks < 8; ++ks) bG[ks] = *(const bf16x8*)(gsr + ks * 32);
#pragma unroll
            for (int ks = 0; ks < 2; ++ks) bR[ks] = *(const bf16x8*)(Rt + (16 * wq + fr) * 64 + ks * 32 + fq * 8);
#pragma unroll
            for (int mt = 0; mt < 4; ++mt) {
                yw[mt] = *(const u32x2*)(Y0s + (16 * wq + fr) * 64 + 16 * mt + 4 * fq);
#pragma unroll
                for (int ks = 0; ks < 2; ++ks) aS[mt][ks] = *(const bf16x8*)(S0t + (16 * mt + fr) * 64 + ks * 32 + fq * 8);
                const int hc = h * 64 + 16 * mt + 4 * fq;
                vc[mt] = *(const u32x2*)(pp + (size_t)row * NPAD + C_V + hc); vp[mt] = *(const u32x2*)(pp + (size_t)prow * NPAD + C_V + hc);
            }
            bon = ((const float*)(ws + WS_BONUS))[(size_t)row * 32 + h];
        };
        issue(0);
#pragma unroll 1
        for (int it = 0; it < 8; ++it) {
            int b, c; unit_of(it, b, c);
            const int row = b * SEQ + c * 64 + 16 * wq + fr;
            f32x4 gacc[4];
#pragma unroll
            for (int mt = 0; mt < 4; ++mt) gacc[mt] = (f32x4){0.f, 0.f, 0.f, 0.f};
#pragma unroll
            for (int ks = 0; ks < 8; ++ks)
#pragma unroll
                for (int mt = 0; mt < 4; ++mt) gacc[mt] = mfma16(*(const LAS bf16x8*)(lds + O_G2 + ((16 * mt + fr) * LDG + ks * 32 + fq * 8) * 2), bG[ks], gacc[mt]);
            f32x4 y[4], vv[4]; const float bonc = bon;
#pragma unroll
            for (int mt = 0; mt < 4; ++mt) {
                y[mt] = (f32x4){bflo(yw[mt].x), bfhi(yw[mt].x), bflo(yw[mt].y), bfhi(yw[mt].y)};
#pragma unroll
                for (int ks = 0; ks < 2; ++ks) y[mt] = mfma16(aS[mt][ks], bR[ks], y[mt]);
                const f32x4 mv = *(const f32x4*)(mu + C_V + h * 64 + 16 * mt + 4 * fq);
                const f32x4 cv = (f32x4){bflo(vc[mt].x), bfhi(vc[mt].x), bflo(vc[mt].y), bfhi(vc[mt].y)}, pv = (f32x4){bflo(vp[mt].x), bfhi(vp[mt].x), bflo(vp[mt].y), bfhi(vp[mt].y)};
                vv[mt] = cv + (pv - cv) * mv;
            }
#pragma unroll
            for (int mt = 0; mt < 4; ++mt) asm volatile("" : "+v"(y[mt]), "+v"(vv[mt]), "+v"(gacc[mt]));
            if (it + 1 < 8) issue(it + 1);
            float s = 0.f;
#pragma unroll
            for (int mt = 0; mt < 4; ++mt) s += (y[mt].x + y[mt].y) + (y[mt].z + y[mt].w);
            s += __shfl_xor(s, 16); s += __shfl_xor(s, 32);
            const float mean = s * (1.0f / 64.0f); float qq = 0.f;
#pragma unroll
            for (int mt = 0; mt < 4; ++mt) { y[mt] = y[mt] - mean; qq += (y[mt].x * y[mt].x + y[mt].y * y[mt].y) + (y[mt].z * y[mt].z + y[mt].w * y[mt].w); }
            qq += __shfl_xor(qq, 16); qq += __shfl_xor(qq, 32);
            const float rstd = 1.0f / sqrtf(qq * (1.0f / 64.0f) + GN_EPS);
            bf16_t* ya = (bf16_t*)(ws + WS_YA) + (size_t)row * D + h * 64;
#pragma unroll
            for (int mt = 0; mt < 4; ++mt) {
                const int i0 = 16 * mt + 4 * fq, hc = h * 64 + i0;
                const f32x4 gg = *(const f32x4*)(P.in[I_GNG] + hc), gb = *(const f32x4*)(P.in[I_GNB] + hc);
                const f32x4 o = (y[mt] * rstd * gg + gb + vv[mt] * bonc) * gacc[mt];
                u32x2 wv; wv.x = pk2(o.x, o.y); wv.y = pk2(o.z, o.w);
                *(u32x2*)(ya + i0) = wv;
            }
        }
    }
}
__device__ __forceinline__ float gelu_exact(float x) { return 0.5f * x * (1.0f + erff(x * 0.70710678118654752f)); }
__device__ __forceinline__ float dot16_fp8(const u32x4 w, const float* x) {
    float s0 = 0.f, s1 = 0.f;
    const int ww[4] = {(int)w.x, (int)w.y, (int)w.z, (int)w.w};
#pragma unroll
    for (int q = 0; q < 4; ++q) { const f32x2 lo = __builtin_amdgcn_cvt_pk_f32_fp8(ww[q], false), hi = __builtin_amdgcn_cvt_pk_f32_fp8(ww[q], true);
        s0 += lo.x * x[4 * q] + hi.x * x[4 * q + 2]; s1 += lo.y * x[4 * q + 1] + hi.y * x[4 * q + 3]; }
    return s0 + s1;
}
__device__ __forceinline__ void axpy16_fp8(const u32x4 w, float a, float* o) {
    const int ww[4] = {(int)w.x, (int)w.y, (int)w.z, (int)w.w};
#pragma unroll
    for (int q = 0; q < 4; ++q) { const f32x2 lo = __builtin_amdgcn_cvt_pk_f32_fp8(ww[q], false), hi = __builtin_amdgcn_cvt_pk_f32_fp8(ww[q], true);
        o[4 * q] += a * lo.x; o[4 * q + 1] += a * lo.y; o[4 * q + 2] += a * hi.x; o[4 * q + 3] += a * hi.y; }
}
__device__ __forceinline__ void peer_token(const Params& P, int tok, const LAS int* eidx, const LAS float* gts) {
    const int lane = threadIdx.x & 63;
    unsigned char* ws = P.ws;
    const unsigned char* Ub = ws + WS_UB; const unsigned char* Vb = ws + WS_VB;
    const float* tsc = (const float*)(ws + WS_TSC);
    {
        int lo16 = lane * 16; asm volatile("" : "+v"(lo16));
        float x[32], o[32];
        {
            const bf16_t* hr = (const bf16_t*)(ws + WS_H1B) + (size_t)tok * D + lo16;
#pragma unroll
            for (int i = 0; i < 2; ++i) { unpack8(*(const u32x4*)(hr + 1024 * i), x + 16 * i); unpack8(*(const u32x4*)(hr + 1024 * i + 8), x + 16 * i + 8); }
#pragma unroll
            for (int i = 0; i < 32; ++i) o[i] = 0.f;
        }
        const int e_lo = eidx[lane], e_hi = eidx[64 + lane];
        const float su_lo = tsc[e_lo], su_hi = tsc[e_hi];
        const float gv_lo = gts[lane] * tsc[16384 + e_lo], gv_hi = gts[64 + lane] * tsc[16384 + e_hi];
        u32x4 ua[2][2], va[2][2], ub[2][2], vb[2][2];
        auto issue = [&](int g, u32x4 (&uu)[2][2], u32x4 (&vv)[2][2]) {
            const int ev = (g < 32) ? e_lo : e_hi;
#pragma unroll
            for (int j = 0; j < 2; ++j) {
                const int e = __builtin_amdgcn_readlane(ev, (2 * g + j) & 63);
                const unsigned char* up = Ub + (size_t)e * D + lo16; const unsigned char* vp = Vb + (size_t)e * D + lo16;
#pragma unroll
                for (int i = 0; i < 2; ++i) { uu[j][i] = *(const u32x4*)(up + 1024 * i); vv[j][i] = *(const u32x4*)(vp + 1024 * i); }
            }
        };
        auto consume = [&](int g, const u32x4 (&uu)[2][2], const u32x4 (&vv)[2][2]) {
            const float suv = (g < 32) ? su_lo : su_hi, gvv = (g < 32) ? gv_lo : gv_hi;
            float dd[2];
#pragma unroll
            for (int j = 0; j < 2; ++j) dd[j] = dot16_fp8(uu[j][0], x) + dot16_fp8(uu[j][1], x + 16);
#pragma unroll
            for (int j = 0; j < 2; ++j) dd[j] = wave_sum_dpp(dd[j]);
            const int l0 = (2 * g) & 63;
            const pg8::f32x2 ge = pg8::gelu_pk((pg8::f32x2){dd[0] * readlane_f(suv, l0), dd[1] * readlane_f(suv, l0 + 1)});
            const float a0 = ge.x * readlane_f(gvv, l0), a1 = ge.y * readlane_f(gvv, l0 + 1);
            axpy16_fp8(vv[0][0], a0, o); axpy16_fp8(vv[0][1], a0, o + 16);
            axpy16_fp8(vv[1][0], a1, o); axpy16_fp8(vv[1][1], a1, o + 16);
        };
        issue(0, ua, va);
        for (int g = 0; g < 64; g += 2) {
            issue(g + 1, ub, vb);
            consume(g, ua, va);
            if (g + 2 < 64) issue(g + 2, ua, va);
            consume(g + 1, ub, vb);
        }
        float s = 0.f;
#pragma unroll
        for (int i = 0; i < 32; ++i) { o[i] += DN_ALPHA * x[i]; s += o[i]; }
        const float mean = wave_sum_dpp(s) * (1.0f / D); float q = 0.f;
#pragma unroll
        for (int i = 0; i < 32; ++i) { o[i] -= mean; q += o[i] * o[i]; }
        const float rstd = 1.0f / sqrtf(wave_sum_dpp(q) * (1.0f / D) + LN_EPS);
        float* orow = P.out + (size_t)tok * D + lo16;
#pragma unroll
        for (int i = 0; i < 2; ++i)
#pragma unroll
            for (int c = 0; c < 4; ++c) {
                const int off = 1024 * i + lo16 + 4 * c;
                const f32x4 g0 = *(const f32x4*)(P.in[I_LN2G] + off), b0 = *(const f32x4*)(P.in[I_LN2B] + off);
                f32x4 r0;
                r0.x = o[16 * i + 4 * c + 0] * rstd * g0.x + b0.x; r0.y = o[16 * i + 4 * c + 1] * rstd * g0.y + b0.y; r0.z = o[16 * i + 4 * c + 2] * rstd * g0.z + b0.z; r0.w = o[16 * i + 4 * c + 3] * rstd * g0.w + b0.w;
                *(f32x4*)(orow + 1024 * i + 4 * c) = r0;
            }
    }
}
__device__ __forceinline__ void phase5b(const Params& P) {
    const int lane = threadIdx.x & 63, wave = threadIdx.x >> 6;
    const int gw = blockIdx.x * 8 + wave, NGW = gridDim.x * 8;
    unsigned char* ws = P.ws;
    for (int r = gw; r < NTOK; r += NGW)
        ln_row_bf16((const float*)(ws + WS_X1) + (size_t)r * D, P.in[I_LN1G], P.in[I_LN1B], (bf16_t*)(ws + WS_H1B) + (size_t)r * D, lane);
}

#define CE_DESC(a, b) do { const float h_ = fmaxf((a), (b)), l_ = fminf((a), (b)); (a) = h_; (b) = l_; } while (0)
template <int N> __device__ __forceinline__ void bitonic_sort_desc(float (&v)[N]) {
#pragma unroll
    for (int k = 2; k <= N; k <<= 1)
#pragma unroll
        for (int j = k >> 1; j > 0; j >>= 1)
#pragma unroll
            for (int i = 0; i < N; ++i) { const int l = i ^ j; if (l > i) { if ((i & k) == 0) CE_DESC(v[i], v[l]); else CE_DESC(v[l], v[i]); } }
}
template <int N> __device__ __forceinline__ void bitonic_merge_desc(float (&v)[N]) {
#pragma unroll
    for (int j = N >> 1; j > 0; j >>= 1)
#pragma unroll
        for (int i = 0; i < N; ++i) { const int l = i ^ j; if (l > i) CE_DESC(v[i], v[l]); }
}
__device__ __forceinline__ void top16_merge(float (&a)[16], const float (&brev)[16]) {
#pragma unroll
    for (int i = 0; i < 16; ++i) a[i] = fmaxf(a[i], brev[i]);
    bitonic_merge_desc<16>(a);
}
__device__ __forceinline__ float embed_bits(float v, unsigned code, unsigned mask) { return __uint_as_float((__float_as_uint(v) & ~mask) | code); }

__device__ __forceinline__ void phase7(const Params& P, ldsp lds) {
    int tid = threadIdx.x; asm volatile("" : "+v"(tid));
    const int lane = tid & 63, wave = tid >> 6, fr = lane & 15, fq = lane >> 4;
    unsigned char* ws = P.ws;
    const bf16_t* qb = (const bf16_t*)(ws + WS_Q); const bf16_t* sk = (const bf16_t*)(ws + WS_SUBK);
    constexpr int LDSK = 136, O_SK = 0, O_SV = 2 * 128 * LDSK * 2, O_EX = O_SV + 32768, O_GT = O_EX + 16384;
    for (int idx = tid; idx < 2 * 128 * 16; idx += 512) { const int row = idx >> 4, ch = idx & 15;
        *(LAS u32x4*)(lds + O_SK + (row * LDSK + ch * 8) * 2) = *(const u32x4*)(sk + row * 128 + ch * 8); }
    BLOCK_SYNC();
    for (int tile = blockIdx.x; tile < 256; tile += gridDim.x) {
        const int tok0 = tile * 32, h = wave;
        int fro = fr, fqo = fq; asm volatile("" : "+v"(fro), "+v"(fqo));
#pragma unroll 1
        for (int cb = 0; cb < 4; ++cb) {
            const int nt = cb >> 1, p = cb & 1;
            f32x4 acc[8];
#pragma unroll
            for (int mt = 0; mt < 8; ++mt) acc[mt] = (f32x4){0.f, 0.f, 0.f, 0.f};
            const bf16_t* qrow = qb + (size_t)(tok0 + 16 * nt + fro) * D + h * 256 + p * 128 + fqo * 8;
#pragma unroll
            for (int ks = 0; ks < 4; ++ks) {
                const bf16x8 bq = *(const bf16x8*)(qrow + ks * 32);
#pragma unroll
                for (int mt = 0; mt < 8; ++mt) acc[mt] = mfma16(*(const LAS bf16x8*)(lds + O_SK + ((p * 128 + 16 * mt + fro) * LDSK + ks * 32 + fqo * 8) * 2), bq, acc[mt]);
            }
            float a[16], b[16];
#pragma unroll
            for (int mt = 0; mt < 4; ++mt) {
                a[4 * mt + 0] = embed_bits(acc[mt].x, 16 * mt + 4 * fq + 0, 127u); a[4 * mt + 1] = embed_bits(acc[mt].y, 16 * mt + 4 * fq + 1, 127u);
                a[4 * mt + 2] = embed_bits(acc[mt].z, 16 * mt + 4 * fq + 2, 127u); a[4 * mt + 3] = embed_bits(acc[mt].w, 16 * mt + 4 * fq + 3, 127u);
                b[4 * mt + 0] = embed_bits(acc[mt + 4].x, 16 * (mt + 4) + 4 * fq + 0, 127u); b[4 * mt + 1] = embed_bits(acc[mt + 4].y, 16 * (mt + 4) + 4 * fq + 1, 127u);
                b[4 * mt + 2] = embed_bits(acc[mt + 4].z, 16 * (mt + 4) + 4 * fq + 2, 127u); b[4 * mt + 3] = embed_bits(acc[mt + 4].w, 16 * (mt + 4) + 4 * fq + 3, 127u);
            }
            bitonic_sort_desc<16>(a); bitonic_sort_desc<16>(b);
            { float br[16];
#pragma unroll
              for (int i = 0; i < 16; ++i) br[i] = b[15 - i];
              top16_merge(a, br); }
#pragma unroll
            for (int x = 16; x <= 32; x <<= 1) { float br[16];
#pragma unroll
                for (int i = 0; i < 16; ++i) br[i] = __shfl_xor(a[15 - i], x);
                top16_merge(a, br); }
            if (fq == 0) { LAS f32x4* o = (LAS f32x4*)(lds + O_SV + ((((16 * nt + fr) * 8 + h) * 2 + p) * 16) * 4);
                o[0] = (f32x4){a[0], a[1], a[2], a[3]}; o[1] = (f32x4){a[4], a[5], a[6], a[7]}; o[2] = (f32x4){a[8], a[9], a[10], a[11]}; o[3] = (f32x4){a[12], a[13], a[14], a[15]}; }
        }
        BLOCK_SYNC();
        if (tid < 256) {
            const int tok = tid >> 3, hh = tid & 7;
            const LAS f32x4* s = (const LAS f32x4*)(lds + O_SV + (((tok * 8 + hh) * 2) * 16) * 4);
            float s0[16], s1[16];
#pragma unroll
            for (int c4 = 0; c4 < 4; ++c4) { const f32x4 x = s[c4], y = s[4 + c4]; s0[4 * c4] = x.x; s0[4 * c4 + 1] = x.y; s0[4 * c4 + 2] = x.z; s0[4 * c4 + 3] = x.w; s1[4 * c4] = y.x; s1[4 * c4 + 1] = y.y; s1[4 * c4 + 2] = y.z; s1[4 * c4 + 3] = y.w; }
            float g0[16], g1[16], g2[16], g3[16];
            const float NEG = -3.0e38f;
#pragma unroll
            for (int bq = 0; bq < 16; ++bq) g0[bq] = embed_bits(s0[0] + s1[bq], bq, 255u);
            {
                int n1 = 0, n2 = 0, n3 = 0;
#pragma unroll
                for (int aa = 1; aa < 16; ++aa)
#pragma unroll
                    for (int bb = 0; bb < 16; ++bb) if ((aa + 1) * (bb + 1) <= 16) {
                        const float c = embed_bits(s0[aa] + s1[bb], aa * 16 + bb, 255u);
                        if (n1 < 16) g1[n1++] = c; else if (n2 < 16) g2[n2++] = c; else g3[n3++] = c;
                    }
#pragma unroll
                for (int i = 0; i < 16; ++i) if (i >= n3) g3[i] = NEG;
            }
            bitonic_sort_desc<16>(g1); bitonic_sort_desc<16>(g2); bitonic_sort_desc<16>(g3);
            { float r1[16], r3[16];
#pragma unroll
              for (int i = 0; i < 16; ++i) { r1[i] = g1[15 - i]; r3[i] = g3[15 - i]; }
              top16_merge(g0, r1); top16_merge(g2, r3);
#pragma unroll
              for (int i = 0; i < 16; ++i) g0[i] = fmaxf(g0[i], g2[15 - i]); }
            float mx = g0[0];
#pragma unroll
            for (int i = 1; i < 16; ++i) mx = fmaxf(mx, g0[i]);
            float ex[16], sm = 0.f; int ee[16];
#pragma unroll
            for (int i = 0; i < 16; ++i) {
                ex[i] = __expf(g0[i] - mx); sm += ex[i];
                const unsigned code = __float_as_uint(g0[i]) & 255u;
                const unsigned i0 = __float_as_uint(*(const LAS float*)(lds + O_SV + ((((tok * 8 + hh) * 2 + 0) * 16) + (code >> 4)) * 4)) & 127u;
                const unsigned i1 = __float_as_uint(*(const LAS float*)(lds + O_SV + ((((tok * 8 + hh) * 2 + 1) * 16) + (code & 15u)) * 4)) & 127u;
                ee[i] = (int)(i0 * 128u + i1);
            }
            const float inv = 1.0f / sm;
            LAS int* eo = (LAS int*)(lds + O_EX) + tok * 128 + hh * 16; LAS float* go = (LAS float*)(lds + O_GT) + tok * 128 + hh * 16;
#pragma unroll
            for (int c4 = 0; c4 < 4; ++c4) {
                *(LAS u32x4*)(eo + 4 * c4) = (u32x4){(unsigned)ee[4 * c4], (unsigned)ee[4 * c4 + 1], (unsigned)ee[4 * c4 + 2], (unsigned)ee[4 * c4 + 3]};
                *(LAS f32x4*)(go + 4 * c4) = (f32x4){ex[4 * c4] * inv, ex[4 * c4 + 1] * inv, ex[4 * c4 + 2] * inv, ex[4 * c4 + 3] * inv};
            }
        }
        BLOCK_SYNC();
#pragma unroll 1
        for (int i = 0; i < 4; ++i) peer_token(P, tok0 + wave * 4 + i, (const LAS int*)(lds + O_EX) + (wave * 4 + i) * 128, (const LAS float*)(lds + O_GT) + (wave * 4 + i) * 128);
        BLOCK_SYNC();
    }
}
#ifndef MK_MULTI
#define MK_MULTI 0
#endif
__global__ __launch_bounds__(512, 2) void hybrid_fwd(Params P) {
    extern __shared__ __attribute__((aligned(16))) unsigned char shm[];
    ldsp lds = (ldsp)shm;
    unsigned char* ws = P.ws;
    volatile LAS unsigned* xst = (volatile LAS unsigned*)(lds + LDS_BYTES - 16);
    if (threadIdx.x == 0) { xst[0] = 0u; xst[1] = 0u; }
    __syncthreads();
    const XcdBarrier xbar = xcd_barrier_post((unsigned*)(ws + WS_BAR), xst);
    const int lo = P.ph_lo, hi = P.ph_hi;
#ifdef DBG_TA
    unsigned long long ts0 = 0, ts1 = 0, ts2 = 0, ts3 = 0, ts4 = 0, ts5 = 0, ts6 = 0, ts7 = 0, ts8 = 0, ts9 = 0, ts10 = 0, ts11 = 0;
#define STAMP(k) ts##k = __builtin_amdgcn_s_memrealtime()
#else
#define STAMP(k) do { } while (0)
#endif
    STAMP(0);
#ifndef REPEAT_PHASE
#define REPEAT_PHASE -1
#define REPEAT_N 1
#endif
#define PHASE(k) if (lo <= (k) && (k) < hi) for (int rep_ = 0; rep_ < ((k) == REPEAT_PHASE ? REPEAT_N : 1); ++rep_)
#define SEAM(k) do { if (lo <= (k) && (k) + 1 < hi) xcd_barrier(xbar); } while (0)
    PHASE(0) phase0(P);
    SEAM(0); STAMP(1);
    PHASE(1) { pg8::EpiBf16<0> E; E.O = (bf16_t*)(ws + WS_P); E.ldc = NPAD; E.bias = nullptr; E.split_cols = 0; E.split_stride = 0;
        run_gemm(lds, (const bf16_t*)(ws + WS_H0B), (const bf16_t*)(ws + WS_WTIN), MROWS, NPAD, 2048, E); }
    SEAM(1); STAMP(2);
    PHASE(2) phase2(P, lds);
    SEAM(2); STAMP(3);
    PHASE(3) phase3(P);
    SEAM(3); STAMP(4);
    PHASE(4) phase3b(P, lds);
    SEAM(4); STAMP(5);
    PHASE(5) {
        { pg8::EpiGateA E; E.C = (float*)(ws + WS_MPART); E.p = (const bf16_t*)(ws + WS_P); E.bgate = P.in[I_BGATE];
          run_gemm(lds, (const bf16_t*)(ws + WS_YA), (const bf16_t*)(ws + WS_WTA), NTOK, 2048, 2048, E); }
        { pg8::EpiGateB E; E.C = (const float*)(ws + WS_MPART); E.O = (bf16_t*)(ws + WS_MERGED); E.p = (const bf16_t*)(ws + WS_P); E.bgate = P.in[I_BGATE];
          run_gemm(lds, (const bf16_t*)(ws + WS_YB), (const bf16_t*)(ws + WS_WTB), NTOK, 2048, 1024, E); }
    }
    SEAM(5); STAMP(6);
    PHASE(6) { pg8::EpiResid E; E.C = (float*)(ws + WS_X1); E.h0 = (const bf16_t*)(ws + WS_H0B); E.alpha = DN_ALPHA;
        run_gemm(lds, (const bf16_t*)(ws + WS_MERGED), (const bf16_t*)(ws + WS_WTOUT), NTOK, 2048, 2048, E); }
    SEAM(6); STAMP(7);
    PHASE(7) phase5b(P);
    SEAM(7); STAMP(8);
    PHASE(8) { pg8::EpiBf16<0> E; E.O = (bf16_t*)(ws + WS_Q); E.ldc = D; E.bias = nullptr; E.split_cols = 0; E.split_stride = 0;
        run_gemm(lds, (const bf16_t*)(ws + WS_H1B), (const bf16_t*)(ws + WS_WTQ), NTOK, 2048, 2048, E); }
    SEAM(8); STAMP(9);
    PHASE(9) phase7(P, lds);
#ifdef DBG_TA
    {
        __threadfence_system(); asm volatile("s_waitcnt vmcnt(0) lgkmcnt(0)" ::: "memory"); __syncthreads(); grid.sync(); __threadfence_system();
        STAMP(11);
        const unsigned long long tt[12] = {ts0, ts1, ts2, ts3, ts4, ts5, ts6, ts7, ts8, ts9, ts9, ts11};
        const float ta = (float)(tt[DBG_TA + 1] - tt[DBG_TA]) * 0.01f, tb = (float)(tt[DBG_TB + 1] - tt[DBG_TB]) * 0.01f;
        if (blockIdx.x == 0) { for (int i = threadIdx.x + 1; i <= 1000000; i += 512) P.out[i] = tb; if (threadIdx.x == 0) P.out[0] = 1000.0f * ta; }
    }
#endif
#ifdef DBG_STOP
    {
        __threadfence_system(); asm volatile("s_waitcnt vmcnt(0) lgkmcnt(0)" ::: "memory"); __syncthreads(); grid.sync(); __threadfence_system();
        const size_t a = DBG_A, b = DBG_B; const unsigned* w = (const unsigned*)(ws + a); const size_t nw = (b - a) / 4, NO = (size_t)NTOK * D;
        for (size_t i = (size_t)blockIdx.x * 512 + threadIdx.x; i < NO; i += (size_t)gridDim.x * 512) {
            unsigned acc = 0; for (size_t j = i; j < nw; j += NO) { const unsigned x = w[j]; acc += (x & 0xffffu) + (x >> 16); }
            P.out[i] = (float)(acc & 0xfffffu);
        }
    }
#endif
#undef PHASE
#undef SEAM
}

extern "C" void kernel_launch(void* const* d_in, const int* in_sizes, int n_in, void* d_out, int out_size, void* d_ws, size_t ws_size, hipStream_t stream) {
    static int grid = 0;
    if (grid == 0) {
        if (n_in != 30 || out_size != NTOK * D || ws_size < WS_END) { fprintf(stderr, "kernel_launch: unexpected shapes (n_in %d, out %d, ws %zu < %zu)\n", n_in, out_size, ws_size, (size_t)WS_END); grid = -1; return; }
        int dev = 0, cus = 0, per_cu = 0;
        if (hipGetDevice(&dev) != hipSuccess || hipDeviceGetAttribute(&cus, hipDeviceAttributeMultiprocessorCount, dev) != hipSuccess) { grid = -1; return; }
        if (hipFuncSetAttribute((const void*)hybrid_fwd, hipFuncAttributeMaxDynamicSharedMemorySize, LDS_BYTES) != hipSuccess) { fprintf(stderr, "kernel_launch: hipFuncSetAttribute failed\n"); grid = -1; return; }
        if (hipOccupancyMaxActiveBlocksPerMultiprocessor(&per_cu, (const void*)hybrid_fwd, 512, LDS_BYTES) != hipSuccess || per_cu < 1) { fprintf(stderr, "kernel_launch: occupancy query says %d\n", per_cu); grid = -1; return; }
        (void)hipGetLastError();
        grid = cus;
    }
    if (grid < 0) return;
    if (hipMemsetAsync((unsigned char*)d_ws + WS_BAR, 0, XCD_BAR_WORDS * 4, stream) != hipSuccess) { fprintf(stderr, "kernel_launch: memset failed\n"); return; }
    Params p{};
    for (int i = 0; i < 30; ++i) p.in[i] = (const float*)d_in[i];
    p.out = (float*)d_out; p.ws = (unsigned char*)d_ws;
#if MK_MULTI
    for (int ph = 0; ph <= NPHASE; ++ph) { p.ph_lo = ph; p.ph_hi = ph + 1; hipLaunchKernelGGL(hybrid_fwd, dim3(grid), dim3(512), LDS_BYTES, stream, p); }
#else
    p.ph_lo = 0; p.ph_hi = NPHASE + 1;
#ifdef DBG_STOP
    p.ph_hi = DBG_STOP + 1;
#endif
    void* args[] = {&p};
    hipError_t e = hipLaunchCooperativeKernel((const void*)hybrid_fwd, dim3(grid), dim3(512), args, LDS_BYTES, stream);
    if (e != hipSuccess) fprintf(stderr, "kernel_launch: cooperative launch failed: %s (grid %d)\n", hipGetErrorString(e), grid);
#endif
}
```

```cpp
#include <hip/hip_runtime.h>
#include <hip/hip_cooperative_groups.h>
#include <cstdio>
#include <cstdint>
namespace cg = cooperative_groups;
namespace pg8 {
#define PG8_LAS __attribute__((address_space(3)))
typedef unsigned short bf16_t;
typedef short bf16x8 __attribute__((ext_vector_type(8)));
typedef float f32x4 __attribute__((ext_vector_type(4)));
typedef unsigned u32x4 __attribute__((ext_vector_type(4)));
constexpr int BM = 256, BK = 64, HALF = 128, HTB = HALF * BK * 2  , STAGE_BYTES = 8 * HTB, NXCD = 8, WGM = 8;

__host__ __device__ __forceinline__ int lds_byte(int r, int c) { const int st = (r >> 4) * 2 + (c >> 5), rr = r & 15, cc = c & 31, ob = rr * 64 + cc * 2; return st * 1024 + (ob ^ (((ob >> 9) & 1) << 5)); }
__host__ __device__ __forceinline__ void stage_rc(int b, int& R, int& C) { const int st = b / 1024, sb = b % 1024, swz = sb ^ (((sb >> 9) & 1) << 5); R = (st >> 1) * 16 + swz / 64; C = (st & 1) * 32 + (swz % 64) / 2; }
__host__ __device__ __forceinline__ int perm32(int rho) { const int n = rho >> 4, i = rho & 15; return 8 * (i >> 2) + 4 * n + (i & 3); }

struct Unit { int pm, pn; };
struct Gemm { const bf16_t* A; const bf16_t* Bt; int M, N, K; };

struct StaticOrder {
    int nM, nN, nwg, G, c;
    __host__ __device__ void init(int M, int N, int G_, int c_) { nM = M / BM; nN = N / BM; nwg = nM * nN; G = G_; c = c_; }
    __host__ __device__ bool next(int i, Unit& u) const {
        const long L = (long)i * G + c; if (L >= nwg) return false;
        int wgid = (int)L; { const int q = nwg / NXCD, r = nwg % NXCD, xcd = wgid % NXCD, off = wgid / NXCD; wgid = (xcd < r ? xcd * (q + 1) : r * (q + 1) + (xcd - r) * q) + off; }
        const int nig = WGM * nN, gid = wgid / nig, fm = gid * WGM, gsz = (nM - fm) < WGM ? (nM - fm) : WGM;
        u.pm = fm + ((wgid % nig) % gsz); u.pn = (wgid % nig) / gsz; return true;
    }
    __device__ __forceinline__ void a_ready(const Unit&) const {}
    __device__ __forceinline__ void done(const Unit&) const {}
};
struct CountedOrder : StaticOrder {
    const unsigned* ready; unsigned need; unsigned* tmo;
    __device__ __forceinline__ void a_ready(const Unit& u) const {
        if (threadIdx.x < 64) {
            const unsigned long long t0 = __builtin_amdgcn_s_memrealtime(); unsigned polls = 0;
            while ((unsigned)__builtin_amdgcn_readfirstlane(__hip_atomic_load(ready + 64 * u.pm, __ATOMIC_RELAXED, __HIP_MEMORY_SCOPE_AGENT)) < need) {
                if ((++polls & 255u) == 0u && __builtin_amdgcn_readfirstlane(__hip_atomic_load(tmo, __ATOMIC_RELAXED, __HIP_MEMORY_SCOPE_AGENT)) != 0u) break;
                if (__builtin_amdgcn_s_memrealtime() - t0 > 2000000ull) {
                    if (threadIdx.x == 0) { unsigned expect = 0u; __hip_atomic_compare_exchange_strong(tmo + 1, &expect, 0x600u | (unsigned)(u.pm & 0xff), __ATOMIC_RELAXED, __ATOMIC_RELAXED, __HIP_MEMORY_SCOPE_AGENT); __hip_atomic_store(tmo, 1u, __ATOMIC_RELAXED, __HIP_MEMORY_SCOPE_AGENT); }
                    break; }
                __builtin_amdgcn_s_sleep(2); }
            __builtin_amdgcn_fence(__ATOMIC_ACQUIRE, "agent");
            asm volatile("s_waitcnt vmcnt(0)" ::: "memory");
        }
#if !defined(BROKEN_HOOK_NO_BARRIER)
        asm volatile("" ::: "memory"); __builtin_amdgcn_s_barrier(); asm volatile("" ::: "memory");
#endif
    }
};

typedef float cvt_f32x2 __attribute__((ext_vector_type(2))); typedef __bf16 cvt_bf16x2 __attribute__((ext_vector_type(2)));
__device__ __forceinline__ unsigned cvt_pk_bf16(float lo, float hi) { const cvt_f32x2 v = {lo, hi}; const cvt_bf16x2 b = __builtin_convertvector(v, cvt_bf16x2); return __builtin_bit_cast(unsigned, b); }
typedef float f32x2 __attribute__((ext_vector_type(2)));
__device__ __forceinline__ f32x2 gelu_pk(f32x2 v) {
    const f32x2 av = __builtin_elementwise_abs(v), d = av * 0.2316418882f + 1.0f;
    f32x2 t; t.x = __builtin_amdgcn_rcpf(d.x); t.y = __builtin_amdgcn_rcpf(d.y);
    f32x2 q = t * 0.5307027145f + (-0.7265760135f); q = q * t + 0.7107068705f; q = q * t + (-0.142248368f); q = q * t + 0.127414796f; q = q * t;
    const f32x2 s = (v * v) * (-0.72134752044f);
    f32x2 e; e.x = __builtin_amdgcn_exp2f(s.x); e.y = __builtin_amdgcn_exp2f(s.y);
    const f32x2 m = v * (q * e), r = v - m;
    f32x2 o; o.x = v.x < 0.f ? m.x : r.x; o.y = v.y < 0.f ? m.y : r.y; return o;
}

struct EpiF32 {
    static constexpr bool PERM = false, AFTER_DRAIN = false;
    float* C; int ldc; const float* bias;
    __device__ __forceinline__ void operator()(const f32x4 (&acc)[2][2][4][2], const Unit& u, int wr, int wc, int fr, int fq) const {
        const int row0 = u.pm * BM + wr * 64 + fr, col0 = u.pn * BM + wc * 32 + 4 * fq;
        f32x4 bv[2][2];
#pragma unroll
        for (int bj = 0; bj < 2; ++bj)
#pragma unroll
            for (int n = 0; n < 2; ++n) bv[bj][n] = bias ? *(const f32x4*)(bias + col0 + bj * HALF + n * 16) : (f32x4){0.f, 0.f, 0.f, 0.f};
#pragma unroll
        for (int ai = 0; ai < 2; ++ai)
#pragma unroll
            for (int m = 0; m < 4; ++m) { float* rowp = C + (size_t)(row0 + ai * HALF + m * 16) * ldc + col0;
#pragma unroll
                for (int bj = 0; bj < 2; ++bj)
#pragma unroll
                    for (int n = 0; n < 2; ++n) *(f32x4*)(rowp + bj * HALF + n * 16) = acc[ai][bj][m][n] + bv[bj][n]; }
    }
};
template <int ACT  > struct EpiBf16 {
    static constexpr bool PERM = true, AFTER_DRAIN = false;
    bf16_t* O; int ldc; const float* bias; int split_cols; size_t split_stride;
    __device__ __forceinline__ void operator()(const f32x4 (&acc)[2][2][4][2], const Unit& u, int wr, int wc, int fr, int fq) const {
        const int row0 = u.pm * BM + wr * 64 + fr; int colt = u.pn * BM; bf16_t* base = O;
        if (split_cols) { const int t = colt / split_cols; base += (size_t)t * split_stride; colt -= t * split_cols; }
        const int col0 = colt + wc * 32 + 8 * fq, bcol0 = u.pn * BM + wc * 32 + 8 * fq;
        f32x4 bv[2][2];
#pragma unroll
        for (int bj = 0; bj < 2; ++bj)
#pragma unroll
            for (int n = 0; n < 2; ++n) bv[bj][n] = bias ? *(const f32x4*)(bias + bcol0 + bj * HALF + 4 * n) : (f32x4){0.f, 0.f, 0.f, 0.f};
#pragma unroll
        for (int ai = 0; ai < 2; ++ai)
#pragma unroll
            for (int m = 0; m < 4; ++m) { bf16_t* rowp = base + (size_t)(row0 + ai * HALF + m * 16) * ldc + col0;
#pragma unroll
                for (int bj = 0; bj < 2; ++bj) { f32x4 v0 = acc[ai][bj][m][0] + bv[bj][0], v1 = acc[ai][bj][m][1] + bv[bj][1];
                    if (ACT == 1) { f32x2 a = gelu_pk((f32x2){v0[0], v0[1]}), b = gelu_pk((f32x2){v0[2], v0[3]}), c = gelu_pk((f32x2){v1[0], v1[1]}), d = gelu_pk((f32x2){v1[2], v1[3]});
                        v0 = (f32x4){a.x, a.y, b.x, b.y}; v1 = (f32x4){c.x, c.y, d.x, d.y}; }
                    if (ACT == 2) {
#pragma unroll
                        for (int j = 0; j < 4; ++j) { v0[j] = 0.5f * v0[j] * (1.0f + erff(v0[j] * 0.70710678f)); v1[j] = 0.5f * v1[j] * (1.0f + erff(v1[j] * 0.70710678f)); } }
                    u32x4 w; w.x = cvt_pk_bf16(v0[0], v0[1]); w.y = cvt_pk_bf16(v0[2], v0[3]); w.z = cvt_pk_bf16(v1[0], v1[1]); w.w = cvt_pk_bf16(v1[2], v1[3]);
                    *(u32x4*)(rowp + bj * HALF) = w; } }
    }
};
template <class Epi, class Sched, bool STAMP = false>
__device__ __forceinline__ void gemm_phase(PG8_LAS unsigned char* lds, const Gemm g, const Sched& S, const Epi& E, unsigned long long* stamps) {
    const int tid = threadIdx.x, wid = __builtin_amdgcn_readfirstlane(tid >> 6), lane = tid & 63, wr = wid >> 2, wc = wid & 3, fr = lane & 15, fq = lane >> 4;
    const int K = g.K, nt = K / BK;
    int ts_lo = 0, ts_hi = 0, nts = 0; const unsigned long long rt_entry = STAMP ? (unsigned long long)wall_clock64() : 0ull;
#define PG8_STAMP() do { if (STAMP && wid == 0 && nts < 64) { const unsigned long long _c = (unsigned long long)clock64(); \
        ts_lo = (lane == nts) ? (int)(unsigned)_c : ts_lo; ts_hi = (lane == nts) ? (int)(unsigned)(_c >> 32) : ts_hi; ++nts; } } while (0)
    PG8_STAMP();
    unsigned voffA[2], voffB[2];
#pragma unroll
    for (int i = 0; i < 2; ++i) { int R, C; stage_rc(tid * 16 + i * 8192, R, C); const int Rb = Epi::PERM ? ((R & ~31) + perm32(R & 31)) : R;
        voffA[i] = (unsigned)(R * K + C) * 2u; voffB[i] = (unsigned)(Rb * K + C) * 2u; }
    const size_t kstep = (size_t)(BK * 2);
    const size_t hstep = (size_t)HALF * K * 2;
    const size_t tstep = 2 * hstep;
    const unsigned ldsw = (unsigned)wid * 1024u;
    const int aoff = lds_byte(wr * 64 + fr, fq * 8), boff = lds_byte(wc * 32 + fr, fq * 8);
#define PG8_SA(b, h) (((b) * 2 + (h)) * HTB)
#define PG8_SB(b, h) ((4 + (b) * 2 + (h)) * HTB)
#define PG8_STAGE(bufoff, gbase, voff) do { _Pragma("unroll") for (int _i = 0; _i < 2; ++_i) \
        __builtin_amdgcn_global_load_lds((const unsigned*)((const char*)(gbase) + (voff)[_i]), (PG8_LAS unsigned*)(lds + (bufoff) + ldsw + _i * 8192), 16, 0, 0); } while (0)
#define PG8_LDA(dst, b, h) do { _Pragma("unroll") for (int m = 0; m < 4; ++m) _Pragma("unroll") for (int k = 0; k < 2; ++k) dst[m][k] = *(const PG8_LAS bf16x8*)(lds + PG8_SA(b, h) + aoff + m * 2048 + k * 1024); } while (0)
#define PG8_LDB(dst, b, h) do { _Pragma("unroll") for (int n = 0; n < 2; ++n) _Pragma("unroll") for (int k = 0; k < 2; ++k) dst[n][k] = *(const PG8_LAS bf16x8*)(lds + PG8_SB(b, h) + boff + n * 2048 + k * 1024); } while (0)
#define PG8_MMA(ai, bj, At, Bt) do { __builtin_amdgcn_s_setprio(1); _Pragma("unroll") for (int m = 0; m < 4; ++m) _Pragma("unroll") for (int n = 0; n < 2; ++n) _Pragma("unroll") for (int k = 0; k < 2; ++k) \
        acc[ai][bj][m][n] = __builtin_amdgcn_mfma_f32_16x16x32_bf16(Bt[n][k], At[m][k], acc[ai][bj][m][n], 0, 0, 0); __builtin_amdgcn_s_setprio(0); } while (0)
#define PG8_WAIT_V(n) asm volatile("s_waitcnt vmcnt(" #n ")" ::: "memory")
#define PG8_WAIT_L(n) asm volatile("s_waitcnt lgkmcnt(" #n ")" ::: "memory")
#define PG8_BAR __builtin_amdgcn_s_barrier()
#define PG8_SCHED __builtin_amdgcn_sched_barrier(0)
    Unit cur, nxt; int ui = 0;
    if (!S.next(0, cur)) return;
    f32x4 acc[2][2][4][2];
#pragma unroll
    for (int a = 0; a < 2; ++a)
#pragma unroll
        for (int b = 0; b < 2; ++b)
#pragma unroll
            for (int m = 0; m < 4; ++m)
#pragma unroll
                for (int n = 0; n < 2; ++n) acc[a][b][m][n] = (f32x4){0.f, 0.f, 0.f, 0.f};
    bf16x8 At[4][2], B0[2][2], B1[2][2];
    const char* cA = (const char*)g.A + (size_t)cur.pm * tstep; const char* cB = (const char*)g.Bt + (size_t)cur.pn * tstep;
    S.a_ready(cur);
    PG8_STAGE(PG8_SB(0, 0), cB, voffB); PG8_STAGE(PG8_SA(0, 0), cA, voffA); PG8_STAGE(PG8_SB(0, 1), cB + hstep, voffB); PG8_STAGE(PG8_SA(0, 1), cA + hstep, voffA);
    if (wr == 1) PG8_BAR;
    PG8_WAIT_V(4); PG8_BAR;
    PG8_STAGE(PG8_SB(1, 0), cB + kstep, voffB); PG8_STAGE(PG8_SA(1, 0), cA + kstep, voffA); PG8_STAGE(PG8_SB(1, 1), cB + hstep + kstep, voffB);
    PG8_WAIT_V(6); PG8_BAR;
    PG8_STAMP();
    for (;;) {
        const bool has_next = S.next(ui + 1, nxt);
        const char* nA = has_next ? (const char*)g.A + (size_t)nxt.pm * tstep : cA; const char* nB = has_next ? (const char*)g.Bt + (size_t)nxt.pn * tstep : cB;
        for (int t = 0; t < nt; t += 2) {
            const bool last = (t == nt - 2);
            const char* a1 = cA + (size_t)(t + 1) * kstep;
            const char* a2 = last ? nA : cA + (size_t)(t + 2) * kstep; const char* b2 = last ? nB : cB + (size_t)(t + 2) * kstep;
            const char* a3 = a2 + kstep; const char* b3 = b2 + kstep;
            if (last && has_next) S.a_ready(nxt);
            PG8_LDB(B0, 0, 0); PG8_SCHED; PG8_LDA(At, 0, 0); PG8_STAGE(PG8_SA(1, 1), a1 + hstep, voffA);
            PG8_WAIT_L(8); PG8_BAR; PG8_WAIT_L(0); PG8_MMA(0, 0, At, B0); PG8_BAR; PG8_SCHED;
            PG8_LDB(B1, 0, 1); PG8_STAGE(PG8_SB(0, 0), b2, voffB);
            PG8_BAR; PG8_WAIT_L(0); PG8_MMA(0, 1, At, B1); PG8_BAR;
            PG8_LDA(At, 0, 1); PG8_STAGE(PG8_SA(0, 0), a2, voffA);
            PG8_BAR; PG8_WAIT_L(0); PG8_MMA(1, 0, At, B0); PG8_BAR; PG8_SCHED;
            PG8_STAGE(PG8_SB(0, 1), b2 + hstep, voffB);
            PG8_WAIT_V(6); PG8_BAR; PG8_MMA(1, 1, At, B1); PG8_BAR;
            PG8_LDB(B0, 1, 0); PG8_SCHED; PG8_LDA(At, 1, 0); PG8_STAGE(PG8_SA(0, 1), a2 + hstep, voffA);
            PG8_WAIT_L(8); PG8_BAR; PG8_WAIT_L(0); PG8_MMA(0, 0, At, B0); PG8_BAR; PG8_SCHED;
            PG8_LDB(B1, 1, 1); PG8_STAGE(PG8_SB(1, 0), b3, voffB);
            PG8_BAR; PG8_WAIT_L(0); PG8_MMA(0, 1, At, B1); PG8_BAR;
            PG8_LDA(At, 1, 1); PG8_STAGE(PG8_SA(1, 0), a3, voffA);
            PG8_BAR; PG8_WAIT_L(0); PG8_MMA(1, 0, At, B0); PG8_BAR; PG8_SCHED;
            PG8_STAGE(PG8_SB(1, 1), b3 + hstep, voffB);
            PG8_WAIT_V(6); PG8_BAR; PG8_MMA(1, 1, At, B1); PG8_BAR;
        }
        PG8_STAMP();
        if constexpr (!Epi::AFTER_DRAIN) { E(acc, cur, wr, wc, fr, fq); S.done(cur); }
        PG8_STAMP();
        if (!has_next) break;
#pragma unroll
        for (int a = 0; a < 2; ++a)
#pragma unroll
            for (int b = 0; b < 2; ++b)
#pragma unroll
                for (int m = 0; m < 4; ++m)
#pragma unroll
                    for (int n = 0; n < 2; ++n) acc[a][b][m][n] = (f32x4){0.f, 0.f, 0.f, 0.f};
        cur = nxt; cA = nA; cB = nB; ++ui;
    }
    PG8_WAIT_V(0);
    if (wr == 0) PG8_BAR;
    PG8_BAR;
    if constexpr (Epi::AFTER_DRAIN) { E.fused(acc, cur, wr, wc, fr, fq, lds, wid, lane); S.done(cur); }
    PG8_STAMP();
    if (STAMP && wid == 0) { stamps[lane] = lane < nts ? (((unsigned long long)(unsigned)ts_hi << 32) | (unsigned)ts_lo) : 0ull;
        if (lane == 62) stamps[62] = rt_entry; if (lane == 63) stamps[63] = (unsigned long long)wall_clock64(); }
#undef PG8_STAMP
#undef PG8_SA
#undef PG8_SB
#undef PG8_STAGE
#undef PG8_LDA
#undef PG8_LDB
#undef PG8_MMA
#undef PG8_WAIT_V
#undef PG8_WAIT_L
#undef PG8_BAR
#undef PG8_SCHED
}
}
#define LAS __attribute__((address_space(3)))
typedef unsigned short bf16_t;
typedef short bf16x8 __attribute__((ext_vector_type(8)));
typedef float f32x4 __attribute__((ext_vector_type(4)));
typedef float f32x2 __attribute__((ext_vector_type(2)));
typedef unsigned u32x4 __attribute__((ext_vector_type(4)));
typedef unsigned u32x2 __attribute__((ext_vector_type(2)));
typedef LAS unsigned char* ldsp;
typedef float f32x32 __attribute__((ext_vector_type(32)));
typedef float f32x16 __attribute__((ext_vector_type(16)));
typedef unsigned u32x6 __attribute__((ext_vector_type(6)));

constexpr int D = 2048, NTOK = 8192, SEQ = 4096, MROWS = 8448, ROW_META = 8192;
constexpr int INC = 11712, NPAD = 11776;
constexpr int C_R = 0, C_K = 2048, C_V = 4096, C_WL = 6144, C_AL = 6240, C_GL = 6336, C_POOL = 6592, C_G0 = 7616, C_G1 = 9664;
constexpr int NUNITS = 4128;
constexpr float DSCALE = 0.6065306597126334f;
constexpr float DN_ALPHA = 1.189207115002721f;
constexpr float GN_EPS = 64e-5f, LN_EPS = 1e-5f;

constexpr size_t WS_P = 0;
constexpr size_t WS_H0B = 198967296;
constexpr size_t WS_WTA = WS_H0B + 34603008;
constexpr size_t WS_WTB = WS_WTA + 8388608;
constexpr size_t WS_WTOUT = WS_WTB + 4194304;
constexpr size_t WS_WTQ = WS_WTOUT + 8388608;
constexpr size_t WS_WTPOOL = WS_WTQ + 8388608;
constexpr size_t WS_WTW2 = WS_WTPOOL + 524288;
constexpr size_t WS_WTA2 = WS_WTW2 + 393216;
constexpr size_t WS_WTG2 = WS_WTA2 + 393216;
constexpr size_t WS_SUBK = WS_WTG2 + 1048576;
constexpr size_t WS_BONUS = WS_SUBK + 65536;
constexpr size_t WS_REGC = WS_BONUS + 1048576;
constexpr size_t WS_WTIN = WS_REGC;
constexpr size_t UNITB = (size_t)NUNITS * 4096 * 2;
constexpr size_t WS_G = WS_REGC;
constexpr size_t WS_H0T = WS_REGC + UNITB;
constexpr size_t WS_RT = WS_REGC + 2 * UNITB;
constexpr size_t WS_Y0 = WS_REGC + 3 * UNITB;
constexpr size_t WS_S0T = WS_REGC + 4 * UNITB;
constexpr size_t WS_YA = WS_REGC;
constexpr size_t WS_MERGED = WS_REGC + UNITB;
constexpr size_t WS_MPART = WS_REGC + 2 * UNITB;
constexpr size_t WS_X1 = WS_REGC + 2 * UNITB;
constexpr size_t WS_H1B = WS_REGC;
constexpr size_t WS_Q = WS_REGC + 4 * UNITB;
constexpr size_t TROW = 1536;
constexpr size_t WS_VB = WS_REGC + 5 * UNITB;
constexpr size_t WS_YB = WS_VB + 16384 * TROW;
constexpr size_t WS_GSIG = WS_YB + 16777216;
constexpr size_t WS_BAR = WS_GSIG + 4194304;
constexpr size_t WS_TSC = WS_BAR + 16384;
constexpr size_t WS_UB = WS_TSC + 131072;
constexpr size_t WS_END = WS_UB + 16384 * TROW;
static_assert(WS_X1 + 67108864 <= WS_Q, "overlay");
static_assert(WS_MPART + 67108864 <= WS_S0T, "overlay");

constexpr int LDS_BYTES = 163840;
constexpr int NPHASE = 9;

struct Params {
    const float* in[30];
    float* out;
    unsigned char* ws;
    int ph_lo, ph_hi;
};
enum { I_X = 0, I_META, I_LNIN_G, I_LNIN_B, I_WIN, I_MU, I_W0, I_WW2, I_A0, I_WA2, I_WG2, I_KK, I_KA, I_RK, I_GNG, I_GNB, I_WPOOL, I_PSCALE, I_BGATE,
       I_WBA, I_WBB, I_WOUT, I_LN1G, I_LN1B, I_WQ, I_SUBK, I_UT, I_VT, I_LN2G, I_LN2B };

__device__ __forceinline__ unsigned pk2(float lo, float hi) { return pg8::cvt_pk_bf16(lo, hi); }
__device__ __forceinline__ float bflo(unsigned w) { return __uint_as_float(w << 16); }
__device__ __forceinline__ float bfhi(unsigned w) { return __uint_as_float(w & 0xffff0000u); }
__device__ __forceinline__ float bf1(bf16_t h) { return __uint_as_float(((unsigned)h) << 16); }
__device__ __forceinline__ bf16_t f2bf1(float f) { return (bf16_t)(pk2(f, f) & 0xffffu); }
__device__ __forceinline__ float wave_sum(float v) {
#pragma unroll
    for (int o = 1; o < 64; o <<= 1) v += __shfl_xor(v, o);
    return v;
}
__device__ __forceinline__ float sigmoidf_(float x) { return 1.0f / (1.0f + __expf(-x)); }
__device__ __forceinline__ f32x4 mfma16(bf16x8 a, bf16x8 b, f32x4 c) { return __builtin_amdgcn_mfma_f32_16x16x32_bf16(a, b, c, 0, 0, 0); }
__device__ __forceinline__ void unpack8(const u32x4 w, float* f) {
    f[0] = bflo(w.x); f[1] = bfhi(w.x); f[2] = bflo(w.y); f[3] = bfhi(w.y); f[4] = bflo(w.z); f[5] = bfhi(w.z); f[6] = bflo(w.w); f[7] = bfhi(w.w);
}
__device__ __forceinline__ u32x4 pack8(const float* f) { u32x4 w; w.x = pk2(f[0], f[1]); w.y = pk2(f[2], f[3]); w.z = pk2(f[4], f[5]); w.w = pk2(f[6], f[7]); return w; }
#define DPPF(v, ctrl) __builtin_bit_cast(float, __builtin_amdgcn_update_dpp(0, __builtin_bit_cast(int, (v)), (ctrl), 0xF, 0xF, true))
__device__ __forceinline__ float readlane_f(float v, int l) { return __builtin_bit_cast(float, __builtin_amdgcn_readlane(__builtin_bit_cast(int, v), l)); }
__device__ __forceinline__ float wave_sum_dpp(float v) {
    v += DPPF(v, 0xB1); v += DPPF(v, 0x4E); v += DPPF(v, 0x141); v += DPPF(v, 0x140);
    return (readlane_f(v, 0) + readlane_f(v, 16)) + (readlane_f(v, 32) + readlane_f(v, 48));
}
__device__ __forceinline__ float wave_max_dpp(float v) {
    v = fmaxf(v, DPPF(v, 0xB1)); v = fmaxf(v, DPPF(v, 0x4E)); v = fmaxf(v, DPPF(v, 0x141)); v = fmaxf(v, DPPF(v, 0x140));
    return fmaxf(fmaxf(readlane_f(v, 0), readlane_f(v, 16)), fmaxf(readlane_f(v, 32), readlane_f(v, 48)));
}
#define BLOCK_SYNC() __syncthreads()
#define XB_TMO      128
#define XB_XCNT(j)  (256  + 64 * (j))
#define XB_XSUB(j)  (1280 + 64 * (j))
#define XB_XGEN(j)  (2304 + 64 * (j))
#define XB_TOP      3328
#define XB_TOPGEN   3392
#define XCD_BAR_WORDS 3456
#define XB_SPIN_CAP (1u << 18)

__device__ __forceinline__ unsigned xb_ld(unsigned* p)              { return __hip_atomic_load(p, __ATOMIC_RELAXED, __HIP_MEMORY_SCOPE_AGENT); }
__device__ __forceinline__ unsigned xb_add(unsigned* p, unsigned v) { return __hip_atomic_fetch_add(p, v, __ATOMIC_RELAXED, __HIP_MEMORY_SCOPE_AGENT); }
__device__ __forceinline__ unsigned xb_xcc_id() { return (unsigned)__builtin_amdgcn_s_getreg((3 << 11) | 20) & 0xFu; }
#define XB_SPIN(cond, bar) do { unsigned _sp = 0; while (cond) { __builtin_amdgcn_s_sleep(1); \
    if ((++_sp & 255u) == 0u) { if (xb_ld(&(bar)[XB_TMO])) break; if (_sp > XB_SPIN_CAP) { atomicAdd(&(bar)[XB_TMO], 1u); break; } } } } while (0)

struct XcdBarrier {
    unsigned* bar; unsigned x;
    volatile LAS unsigned* st;
};

__device__ __forceinline__ XcdBarrier xcd_barrier_post(unsigned* bar, volatile LAS unsigned* st) {
    XcdBarrier b; b.bar = bar; b.x = xb_xcc_id(); b.st = st;
    if (threadIdx.x == 0) (void)xb_add(&bar[XB_XCNT(b.x)], 1u);
    return b;
}
__device__ __forceinline__ void xcd_barrier_complete(unsigned* bar, unsigned x, unsigned& nloc, unsigned& nx) {
    const unsigned G = gridDim.x * gridDim.y * gridDim.z;
    unsigned sum, cnt, mine, sp = 0u;
    for (;;) {
        sum = 0u; cnt = 0u; mine = 0u;
#pragma unroll
        for (unsigned j = 0; j < 16; ++j) { const unsigned c = xb_ld(&bar[XB_XCNT(j)]); sum += c; cnt += (c > 0u) ? 1u : 0u; mine = (j == x) ? c : mine; }
        if (sum == G) break;
        __builtin_amdgcn_s_sleep(1);
        if ((++sp & 255u) == 0u) { if (xb_ld(&bar[XB_TMO])) break; if (sp > XB_SPIN_CAP) { atomicAdd(&bar[XB_TMO], 1u); break; } }
    }
    nloc = mine > 0u ? mine : 1u; nx = cnt > 0u ? cnt : 1u;
}

__device__ __forceinline__ void xcd_barrier(const XcdBarrier& b) {
    asm volatile("s_waitcnt vmcnt(0)" ::: "memory");
    __syncthreads();
    if (threadIdx.x == 0) {
        unsigned* bar = b.bar;
        __builtin_amdgcn_s_waitcnt(0);
        unsigned nloc = b.st[0], nx = b.st[1];
        if (nloc == 0u) { xcd_barrier_complete(bar, b.x, nloc, nx); b.st[0] = nloc; b.st[1] = nx; }
        const unsigned old = xb_add(&bar[XB_XSUB(b.x)], 1u);
        const unsigned gen = old / nloc;
        if (old + 1u == (gen + 1u) * nloc) {
            __builtin_amdgcn_fence(__ATOMIC_RELEASE, "agent");
            asm volatile("s_waitcnt vmcnt(0)" ::: "memory");
            const unsigned og = xb_add(&bar[XB_TOP], 1u);
            const unsigned tg = og / nx;
            if (og + 1u == (tg + 1u) * nx) xb_add(&bar[XB_TOPGEN], 1u);
            else XB_SPIN(xb_ld(&bar[XB_TOPGEN]) == tg, bar);
            __builtin_amdgcn_fence(__ATOMIC_ACQUIRE, "agent");
            xb_add(&bar[XB_XGEN(b.x)], 1u);
            asm volatile("s_waitcnt vmcnt(0)" ::: "memory");
        } else {
            XB_SPIN(xb_ld(&bar[XB_XGEN(b.x)]) == gen, bar);
            __builtin_amdgcn_fence(__ATOMIC_ACQUIRE, "agent");
            asm volatile("s_waitcnt vmcnt(0)" ::: "memory");
        }
    }
    __syncthreads();
}

__device__ __forceinline__ void ln_row_bf16(const float* src, const float* g, const float* b, bf16_t* dst, int lane) {
    f32x4 v[8]; float s = 0.f;
#pragma unroll
    for (int j = 0; j < 8; ++j) { v[j] = ((const f32x4*)src)[lane + 64 * j]; s += (v[j].x + v[j].y) + (v[j].z + v[j].w); }
    const float mean = wave_sum(s) * (1.0f / D); float s2 = 0.f;
#pragma unroll
    for (int j = 0; j < 8; ++j) { v[j] = v[j] - mean; s2 += (v[j].x * v[j].x + v[j].y * v[j].y) + (v[j].z * v[j].z + v[j].w * v[j].w); }
    const float rstd = 1.0f / sqrtf(wave_sum(s2) * (1.0f / D) + LN_EPS);
#pragma unroll
    for (int j = 0; j < 8; ++j) {
        const f32x4 gg = ((const f32x4*)g)[lane + 64 * j], bb = ((const f32x4*)b)[lane + 64 * j];
        const f32x4 o = v[j] * rstd * gg + bb;
        u32x2 w; w.x = pk2(o.x, o.y); w.y = pk2(o.z, o.w);
        ((u32x2*)dst)[lane + 64 * j] = w;
    }
}
__device__ __forceinline__ void transpose_item(const float* W, int K, int N, int Npad, bf16_t* Wt, int item, int lane) {
    const int nblk = Npad >> 6, kb = item / nblk, nb = item - kb * nblk, n = nb * 64 + lane, k0 = kb * 32;
    float v[32];
    if (n < N) {
#pragma unroll
        for (int i = 0; i < 32; ++i) v[i] = W[(size_t)(k0 + i) * N + n];
    } else {
#pragma unroll
        for (int i = 0; i < 32; ++i) v[i] = 0.f;
    }
    u32x4* o = (u32x4*)(Wt + (size_t)n * K + k0);
#pragma unroll
    for (int c = 0; c < 4; ++c) { u32x4 w; w.x = pk2(v[8 * c], v[8 * c + 1]); w.y = pk2(v[8 * c + 2], v[8 * c + 3]); w.z = pk2(v[8 * c + 4], v[8 * c + 5]); w.w = pk2(v[8 * c + 6], v[8 * c + 7]); o[c] = w; }
}
__device__ __forceinline__ void phase0(const Params& P) {
    const int lane = threadIdx.x & 63, wave = threadIdx.x >> 6;
    const int gw = blockIdx.x * 8 + wave, NGW = gridDim.x * 8;
    unsigned char* ws = P.ws;
    constexpr int T_IN = 64 * 184, T_A = 64 * 32, T_B = 32 * 32, T_O = 64 * 32, T_Q = 64 * 32, T_POOL = 4 * 32, T_W2 = 3 * 32, T_A2 = 3 * 32, T_G2 = 8 * 32;
    constexpr int T_LN = MROWS, T_SK = 64;
    constexpr int NIT = T_IN + T_A + T_B + T_O + T_Q + T_POOL + T_W2 + T_A2 + T_G2 + T_LN + T_SK;
    for (int it = gw; it < NIT; it += NGW) {
        int r = it;
        if (r < T_IN) { transpose_item(P.in[I_WIN], 2048, INC, NPAD, (bf16_t*)(ws + WS_WTIN), r, lane); continue; } r -= T_IN;
        if (r < T_A) { transpose_item(P.in[I_WBA], 2048, 2048, 2048, (bf16_t*)(ws + WS_WTA), r, lane); continue; } r -= T_A;
        if (r < T_B) { transpose_item(P.in[I_WBB], 1024, 2048, 2048, (bf16_t*)(ws + WS_WTB), r, lane); continue; } r -= T_B;
        if (r < T_O) { transpose_item(P.in[I_WOUT], 2048, 2048, 2048, (bf16_t*)(ws + WS_WTOUT), r, lane); continue; } r -= T_O;
        if (r < T_Q) { transpose_item(P.in[I_WQ], 2048, 2048, 2048, (bf16_t*)(ws + WS_WTQ), r, lane); continue; } r -= T_Q;
        if (r < T_POOL) { const int g = r >> 5; transpose_item(P.in[I_WPOOL] + g * 65536, 256, 256, 256, (bf16_t*)(ws + WS_WTPOOL) + g * 65536, r & 31, lane); continue; } r -= T_POOL;
        if (r < T_W2) { transpose_item(P.in[I_WW2], 96, 2048, 2048, (bf16_t*)(ws + WS_WTW2), r, lane); continue; } r -= T_W2;
        if (r < T_A2) { transpose_item(P.in[I_WA2], 96, 2048, 2048, (bf16_t*)(ws + WS_WTA2), r, lane); continue; } r -= T_A2;
        if (r < T_G2) { transpose_item(P.in[I_WG2], 256, 2048, 2048, (bf16_t*)(ws + WS_WTG2), r, lane); continue; } r -= T_G2;
        if (r < T_LN) {
            bf16_t* dst = (bf16_t*)(ws + WS_H0B) + (size_t)r * D;
            if (r < NTOK) ln_row_bf16(P.in[I_X] + (size_t)r * D, P.in[I_LNIN_G], P.in[I_LNIN_B], dst, lane);
            else if (r < NTOK + 16) ln_row_bf16(P.in[I_META] + (size_t)(r - NTOK) * D, P.in[I_LNIN_G], P.in[I_LNIN_B], dst, lane);
            else {
#pragma unroll
                for (int j = 0; j < 8; ++j) ((u32x2*)dst)[lane + 64 * j] = (u32x2){0u, 0u};
            }
            continue;
        }
        r -= T_LN;
        {
            const float* s = P.in[I_SUBK] + r * 512 + lane * 8; float f[8];
#pragma unroll
            for (int i = 0; i < 8; ++i) f[i] = s[i];
            *(u32x4*)((bf16_t*)(ws + WS_SUBK) + r * 512 + lane * 8) = pack8(f);
        }
    }
}
namespace pg8 {
struct EpiGateA {
    static constexpr bool PERM = false, AFTER_DRAIN = false;
    float* C; const bf16_t* p; const float* bgate;
    __device__ __forceinline__ void operator()(const f32x4 (&acc)[2][2][4][2], const Unit& u, int wr, int wc, int fr, int fq) const {
        const int row0 = u.pm * BM + wr * 64 + fr, col0 = u.pn * BM + wc * 32 + 4 * fq;
#pragma unroll
        for (int ai = 0; ai < 2; ++ai)
#pragma unroll
            for (int m = 0; m < 4; ++m) { const size_t row = (size_t)(row0 + ai * HALF + m * 16);
#pragma unroll
                for (int bj = 0; bj < 2; ++bj)
#pragma unroll
                    for (int n = 0; n < 2; ++n) { const int col = col0 + bj * HALF + n * 16;
                        const u32x2 pw = *(const u32x2*)(p + row * NPAD + C_G0 + col); const f32x4 bg = *(const f32x4*)(bgate + col);
                        f32x4 g; g.x = sigmoidf_(bflo(pw.x) + bg.x); g.y = sigmoidf_(bfhi(pw.x) + bg.y); g.z = sigmoidf_(bflo(pw.y) + bg.z); g.w = sigmoidf_(bfhi(pw.y) + bg.w);
                        *(f32x4*)(C + row * D + col) = acc[ai][bj][m][n] * g; } }
    }
};
struct EpiGateB {
    static constexpr bool PERM = false, AFTER_DRAIN = false;
    const float* C; bf16_t* O; const bf16_t* p; const float* bgate;
    __device__ __forceinline__ void operator()(const f32x4 (&acc)[2][2][4][2], const Unit& u, int wr, int wc, int fr, int fq) const {
        const int row0 = u.pm * BM + wr * 64 + fr, col0 = u.pn * BM + wc * 32 + 4 * fq;
#pragma unroll
        for (int ai = 0; ai < 2; ++ai)
#pragma unroll
            for (int m = 0; m < 4; ++m) { const size_t row = (size_t)(row0 + ai * HALF + m * 16);
#pragma unroll
                for (int bj = 0; bj < 2; ++bj)
#pragma unroll
                    for (int n = 0; n < 2; ++n) { const int col = col0 + bj * HALF + n * 16;
                        const u32x2 pw = *(const u32x2*)(p + row * NPAD + C_G1 + col); const f32x4 bg = *(const f32x4*)(bgate + D + col);
                        f32x4 g; g.x = sigmoidf_(bflo(pw.x) + bg.x); g.y = sigmoidf_(bfhi(pw.x) + bg.y); g.z = sigmoidf_(bflo(pw.y) + bg.z); g.w = sigmoidf_(bfhi(pw.y) + bg.w);
                        const f32x4 o = *(const f32x4*)(C + row * D + col) + acc[ai][bj][m][n] * g;
                        u32x2 w; w.x = cvt_pk_bf16(o.x, o.y); w.y = cvt_pk_bf16(o.z, o.w);
                        *(u32x2*)(O + row * D + col) = w; } }
    }
};
struct EpiResid {
    static constexpr bool PERM = false, AFTER_DRAIN = false;
    float* C; const bf16_t* h0; float alpha;
    __device__ __forceinline__ void operator()(const f32x4 (&acc)[2][2][4][2], const Unit& u, int wr, int wc, int fr, int fq) const {
        const int row0 = u.pm * BM + wr * 64 + fr, col0 = u.pn * BM + wc * 32 + 4 * fq;
#pragma unroll
        for (int ai = 0; ai < 2; ++ai)
#pragma unroll
            for (int m = 0; m < 4; ++m) { const size_t row = (size_t)(row0 + ai * HALF + m * 16);
#pragma unroll
                for (int bj = 0; bj < 2; ++bj)
#pragma unroll
                    for (int n = 0; n < 2; ++n) { const int col = col0 + bj * HALF + n * 16;
                        const u32x2 hw = *(const u32x2*)(h0 + row * D + col);
                        f32x4 hv; hv.x = bflo(hw.x); hv.y = bfhi(hw.x); hv.z = bflo(hw.y); hv.w = bfhi(hw.y);
                        *(f32x4*)(C + row * D + col) = hv * alpha + acc[ai][bj][m][n]; } }
    }
};
}
template <class Epi>
__device__ __forceinline__ void run_gemm(ldsp lds, const bf16_t* A, const bf16_t* Bt, int M, int N, int K, const Epi& E) {
    pg8::Gemm g; g.A = A; g.Bt = Bt; g.M = M; g.N = N; g.K = K;
    pg8::StaticOrder S; S.init(M, N, (int)gridDim.x, (int)blockIdx.x);
    pg8::gemm_phase<Epi, pg8::StaticOrder, false>(lds, g, S, E, nullptr);
}
constexpr int LD64 = 72, MATB = 64 * LD64 * 2, LDK = 104;
constexpr int O_AB = 0, O_RB = 1 * MATB, O_BH = 2 * MATB, O_KH = 3 * MATB, O_ABT = 4 * MATB, O_BTT = 5 * MATB, O_KTT = 6 * MATB, O_VT = 7 * MATB;
constexpr int O_M0 = 8 * MATB, O_M0T = 9 * MATB, O_M1 = 10 * MATB, O_M1T = 11 * MATB, O_PA = 12 * MATB, O_PB = 13 * MATB, O_MAK = 14 * MATB, O_MRB = 15 * MATB, O_MRK = 16 * MATB;
constexpr int O_ELEND = 17 * MATB, O_WT = O_ELEND + 256;
constexpr int O_WL = 8 * MATB, O_AL = O_WL + 64 * LDK * 2, O_Z = O_AL + 64 * LDK * 2, O_AZ = O_Z + 64 * 68 * 4;
static_assert(O_AZ + 64 * 68 * 4 <= O_ELEND, "lds");
static_assert(O_WT + 2048 <= LDS_BYTES - 16, "lds");

__device__ __forceinline__ bf16x8 ldsfrag(ldsp lds, int off, int ld, int row, int kofs) { return *(const LAS bf16x8*)(lds + off + (row * ld + kofs) * 2); }
__device__ __forceinline__ void st4(ldsp lds, int off, int row, int col, const f32x4 v) {
    u32x2 w; w.x = pk2(v.x, v.y); w.y = pk2(v.z, v.w); *(LAS u32x2*)(lds + off + (row * LD64 + col) * 2) = w; }
__device__ __forceinline__ void st1(ldsp lds, int off, int row, int col, float v) { *(LAS bf16_t*)(lds + off + (row * LD64 + col) * 2) = f2bf1(v); }

__device__ __forceinline__ float fast_rcp(float x) { return __builtin_amdgcn_rcpf(x); }
__device__ __forceinline__ float fast_sigmoid(float x) { return fast_rcp(1.0f + __expf(-x)); }
__device__ __forceinline__ float fast_tanh(float x) { return 1.0f - 2.0f * fast_rcp(1.0f + __expf(2.0f * x)); }
__device__ __forceinline__ u32x4 ld8(const bf16_t* p) { return p ? *(const u32x4*)p : (u32x4){0u, 0u, 0u, 0u}; }
__device__ __forceinline__ void shift8r(const u32x4 cw, const u32x4 pw, const float* mu, float* x) {
    float c[8], q[8]; unpack8(cw, c); unpack8(pw, q);
    const f32x4 m0 = *(const f32x4*)mu, m1 = *(const f32x4*)(mu + 4);
    const float mm[8] = {m0.x, m0.y, m0.z, m0.w, m1.x, m1.y, m1.z, m1.w};
#pragma unroll
    for (int i = 0; i < 8; ++i) x[i] = c[i] + (q[i] - c[i]) * mm[i];
}
__device__ __forceinline__ int tcol(int row, int col) { return ((((col >> 3) ^ (row >> 3)) & 7) << 3) | (col & 7); }
__device__ __forceinline__ bf16x8 ldsfragT(ldsp lds, int off, int row, int kofs) { return *(const LAS bf16x8*)(lds + off + (row * LD64 + tcol(row, kofs)) * 2); }
__device__ __forceinline__ void st1T(ldsp lds, int off, int row, int col, float v) { *(LAS bf16_t*)(lds + off + (row * LD64 + tcol(row, col)) * 2) = f2bf1(v); }
__device__ __forceinline__ void shift8(const bf16_t* pcur, const bf16_t* pprev, const float* mu, float* x) {
    float c[8], q[8];
    if (pcur) unpack8(*(const u32x4*)pcur, c); else {
#pragma unroll
        for (int i = 0; i < 8; ++i) c[i] = 0.f; }
    if (pprev) unpack8(*(const u32x4*)pprev, q); else {
#pragma unroll
        for (int i = 0; i < 8; ++i) q[i] = 0.f; }
    const f32x4 m0 = *(const f32x4*)mu, m1 = *(const f32x4*)(mu + 4);
    const float mm[8] = {m0.x, m0.y, m0.z, m0.w, m1.x, m1.y, m1.z, m1.w};
#pragma unroll
    for (int i = 0; i < 8; ++i) x[i] = c[i] + (q[i] - c[i]) * mm[i];
}

template <bool DO_P, bool DO_SQ>
__device__ __forceinline__ void dbl_step(ldsp lds, int sN, int sT, int dN, int dT, int pC, int pN, int tm, int tn0, int fr, int fq) {
    bf16x8 a[2];
#pragma unroll
    for (int ks = 0; ks < 2; ++ks) a[ks] = ldsfrag(lds, sT, LD64, 16 * tm + fr, ks * 32 + fq * 8);
#pragma unroll
    for (int t2 = 0; t2 < 2; ++t2) {
        const int nt = tn0 + t2, t = 16 * nt + fr, s0 = 16 * tm + 4 * fq;
        if (DO_P) {
            f32x4 acc = {0.f, 0.f, 0.f, 0.f};
#pragma unroll
            for (int ks = 0; ks < 2; ++ks) acc = mfma16(a[ks], ldsfrag(lds, pC, LD64, t, ks * 32 + fq * 8), acc);
            const u32x2 pw = *(const LAS u32x2*)(lds + pC + (t * LD64 + s0) * 2);
            acc.x += bflo(pw.x); acc.y += bfhi(pw.x); acc.z += bflo(pw.y); acc.w += bfhi(pw.y);
            st4(lds, pN, t, s0, acc);
        }
        if (DO_SQ) {
            f32x4 acc = {0.f, 0.f, 0.f, 0.f};
#pragma unroll
            for (int ks = 0; ks < 2; ++ks) acc = mfma16(a[ks], ldsfrag(lds, sN, LD64, t, ks * 32 + fq * 8), acc);
            st4(lds, dN, t, s0, acc);
            st1(lds, dT, s0 + 0, t, acc.x); st1(lds, dT, s0 + 1, t, acc.y); st1(lds, dT, s0 + 2, t, acc.z); st1(lds, dT, s0 + 3, t, acc.w);
        }
    }
}


#ifdef DBG_STAGE
constexpr size_t DBG_STRIDE = (size_t)NUNITS * 512 * 4;
__device__ __forceinline__ void dbgsum(const Params& P, ldsp lds, int u, int stage, const int* offs, int nmat) {
    unsigned acc = 0;
    for (int m = 0; m < nmat; ++m)
        for (int k = 0; k < 4; ++k) { const int idx = threadIdx.x + 512 * k, row = idx >> 5, cp = idx & 31; const unsigned x = *(const LAS unsigned*)(lds + offs[m] + row * (LD64 * 2) + cp * 4); acc += (x & 0xffffu) + (x >> 16); }
    ((unsigned*)(P.ws + WS_S0T + (size_t)stage * DBG_STRIDE))[(size_t)u * 512 + threadIdx.x] = acc;
}
#define DBGSUM(stage, ...) do { const int offs_[] = {__VA_ARGS__}; dbgsum(P, lds, u, stage, offs_, (int)(sizeof(offs_) / sizeof(int))); } while (0)
#else
#define DBGSUM(stage, ...) do { } while (0)
#endif
struct PL { u32x4 rc, rq, kc, kq, vc, vq, cw[3], pw[3]; bf16x8 aw[3], aa[3]; };
__device__ __forceinline__ const bf16_t* unit_rowp(const bf16_t* pp, int u, int tl, int col) {
    int r;
    if (u >= 4096) r = (tl >= 48) ? (ROW_META + tl - 48) : -1;
    else { const int bh = u >> 6, c = u & 63, b = bh >> 5; r = (tl >= 0 || c > 0) ? (b * SEQ + c * 64 + tl) : (ROW_META + 15); }
    return r < 0 ? (const bf16_t*)nullptr : pp + (size_t)r * NPAD + col;
}
__device__ __forceinline__ void pl_load(const Params& P, int u, PL& L) {
    int tid = threadIdx.x; asm volatile("" : "+v"(tid));
    const int lane = tid & 63, wave = tid >> 6, fr = lane & 15, fq = lane >> 4, tm = wave >> 1;
    const bf16_t* pp = (const bf16_t*)(P.ws + WS_P);
    const int h = (u >= 4096) ? (u - 4096) : ((u >> 6) & 31);
    const int t = tid >> 3, hj = h * 64 + 8 * (tid & 7);
    L.rc = ld8(unit_rowp(pp, u, t, C_R + hj)); L.rq = ld8(unit_rowp(pp, u, t - 1, C_R + hj));
    L.kc = ld8(unit_rowp(pp, u, t, C_K + hj)); L.kq = ld8(unit_rowp(pp, u, t - 1, C_K + hj));
    L.vc = ld8(unit_rowp(pp, u, t, C_V + hj)); L.vq = ld8(unit_rowp(pp, u, t - 1, C_V + hj));
#pragma unroll
    for (int it = 0; it < 3; ++it) { const int idx = tid + 512 * it, mat = idx / 768, rem = idx - mat * 768, tt = rem / 12, ch = rem - tt * 12, col = (mat ? C_AL : C_WL) + ch * 8;
        L.cw[it] = ld8(unit_rowp(pp, u, tt, col)); L.pw[it] = ld8(unit_rowp(pp, u, tt - 1, col)); }
    const bf16_t* ww2 = (const bf16_t*)(P.ws + WS_WTW2) + (size_t)(h * 64 + 16 * tm + fr) * 96 + fq * 8;
    const bf16_t* wa2 = (const bf16_t*)(P.ws + WS_WTA2) + (size_t)(h * 64 + 16 * tm + fr) * 96 + fq * 8;
#pragma unroll
    for (int ks = 0; ks < 3; ++ks) { L.aw[ks] = *(const bf16x8*)(ww2 + ks * 32); L.aa[ks] = *(const bf16x8*)(wa2 + ks * 32); }
}
__device__ __forceinline__ void rwkv_unit(const Params& P, ldsp lds, int u, PL& L, int next_u) {
    int tid = threadIdx.x; asm volatile("" : "+v"(tid));
    const int lane = tid & 63, wave = tid >> 6, fr = lane & 15, fq = lane >> 4, tm = wave >> 1, tn0 = (wave & 1) * 2;
    unsigned char* ws = P.ws;
    const bf16_t* pp = (const bf16_t*)(ws + WS_P);
    const bool meta = u >= 4096;
    int b = 0, h, c = 0;
    if (meta) { h = u - 4096; } else { const int bh = u >> 6; c = u & 63; b = bh >> 5; h = bh & 31; }
    auto rowof = [&](int tl) -> int {
        if (meta) return (tl >= 48) ? (ROW_META + tl - 48) : -1;
        if (tl >= 0 || c > 0) return b * SEQ + c * 64 + tl;
        return ROW_META + 15;
    };
    auto rowp = [&](int tl, int col) -> const bf16_t* { const int r = rowof(tl); return r < 0 ? (const bf16_t*)nullptr : pp + (size_t)r * NPAD + col; };
    const float* mu = P.in[I_MU];
#ifndef RPT_AD
#define RPT_AD 1
#define RPT_E12 1
#define RPT_E35 1
#endif
    float lw[8], av[8], rv[8], kv[8], vv[8], kk[8], km[8];
    const int t = tid >> 3, jq = tid & 7, j0 = 8 * jq, hj = h * 64 + j0;
    const bool nulltok = meta && t < 48;
    for (int rpt_ = 0; rpt_ < RPT_AD; ++rpt_) {
    {
#pragma unroll
        for (int it = 0; it < 3; ++it) { const int idx = tid + 512 * it, mat = idx / 768, rem = idx - mat * 768, tt = rem / 12, ch = rem - tt * 12, col = (mat ? C_AL : C_WL) + ch * 8;
            float x[8]; shift8r(L.cw[it], L.pw[it], mu + col, x);
            if (mat == 0) {
#pragma unroll
                for (int i = 0; i < 8; ++i) x[i] = fast_tanh(x[i]);
            }
            *(LAS u32x4*)(lds + (mat ? O_AL : O_WL) + (tt * LDK + ch * 8) * 2) = pack8(x); }
    }
    BLOCK_SYNC();
    {
        f32x4 z[2] = {{0.f, 0.f, 0.f, 0.f}, {0.f, 0.f, 0.f, 0.f}}, az[2] = {{0.f, 0.f, 0.f, 0.f}, {0.f, 0.f, 0.f, 0.f}};
#pragma unroll
        for (int ks = 0; ks < 3; ++ks) {
            const bf16x8 aw = L.aw[ks], aa = L.aa[ks];
#pragma unroll
            for (int t2 = 0; t2 < 2; ++t2) {
                const int t = 16 * (tn0 + t2) + fr;
                z[t2] = mfma16(aw, ldsfrag(lds, O_WL, LDK, t, ks * 32 + fq * 8), z[t2]);
                az[t2] = mfma16(aa, ldsfrag(lds, O_AL, LDK, t, ks * 32 + fq * 8), az[t2]);
            }
        }
#pragma unroll
        for (int t2 = 0; t2 < 2; ++t2) {
            const int t = 16 * (tn0 + t2) + fr, j0 = 16 * tm + 4 * fq;
            *(LAS f32x4*)(lds + O_Z + (t * 68 + j0) * 4) = z[t2];
            *(LAS f32x4*)(lds + O_AZ + (t * 68 + j0) * 4) = az[t2];
        }
    }
    BLOCK_SYNC();
    float cs[8];
    {
        const f32x4 z0 = *(const LAS f32x4*)(lds + O_Z + (t * 68 + j0) * 4), z1 = *(const LAS f32x4*)(lds + O_Z + (t * 68 + j0 + 4) * 4);
        const f32x4 y0 = *(const LAS f32x4*)(lds + O_AZ + (t * 68 + j0) * 4), y1 = *(const LAS f32x4*)(lds + O_AZ + (t * 68 + j0 + 4) * 4);
        const float zz[8] = {z0.x, z0.y, z0.z, z0.w, z1.x, z1.y, z1.z, z1.w}, yy[8] = {y0.x, y0.y, y0.z, y0.w, y1.x, y1.y, y1.z, y1.w};
        const f32x4 w0a = *(const f32x4*)(P.in[I_W0] + hj), w0b = *(const f32x4*)(P.in[I_W0] + hj + 4), a0a = *(const f32x4*)(P.in[I_A0] + hj), a0b = *(const f32x4*)(P.in[I_A0] + hj + 4);
        const float w0[8] = {w0a.x, w0a.y, w0a.z, w0a.w, w0b.x, w0b.y, w0b.z, w0b.w}, a0[8] = {a0a.x, a0a.y, a0a.z, a0a.w, a0b.x, a0b.y, a0b.z, a0b.w};
#pragma unroll
        for (int i = 0; i < 8; ++i) { lw[i] = nulltok ? 0.f : -DSCALE * fast_sigmoid(w0[i] + zz[i]); av[i] = fast_sigmoid(a0[i] + yy[i]); cs[i] = lw[i]; }
#pragma unroll
        for (int d = 8; d < 64; d <<= 1) {
#pragma unroll
            for (int i = 0; i < 8; ++i) { const float o = __shfl_up(cs[i], d); cs[i] += (lane >= d) ? o : 0.f; }
        }
        if (lane >= 56) { *(LAS f32x4*)(lds + O_WT + (wave * 64 + j0) * 4) = (f32x4){cs[0], cs[1], cs[2], cs[3]}; *(LAS f32x4*)(lds + O_WT + (wave * 64 + j0 + 4) * 4) = (f32x4){cs[4], cs[5], cs[6], cs[7]}; }
        shift8r(L.rc, L.rq, mu + C_R + hj, rv); shift8r(L.kc, L.kq, mu + C_K + hj, kv); shift8r(L.vc, L.vq, mu + C_V + hj, vv);
        if (nulltok) {
#pragma unroll
            for (int i = 0; i < 8; ++i) { rv[i] = 0.f; kv[i] = 0.f; vv[i] = 0.f; }
        }
        const f32x4 kka = *(const f32x4*)(P.in[I_KK] + hj), kkb = *(const f32x4*)(P.in[I_KK] + hj + 4), kaa = *(const f32x4*)(P.in[I_KA] + hj), kab = *(const f32x4*)(P.in[I_KA] + hj + 4);
        const f32x4 rka = *(const f32x4*)(P.in[I_RK] + hj), rkb = *(const f32x4*)(P.in[I_RK] + hj + 4);
        const float kkw[8] = {kka.x, kka.y, kka.z, kka.w, kkb.x, kkb.y, kkb.z, kkb.w}, kaw[8] = {kaa.x, kaa.y, kaa.z, kaa.w, kab.x, kab.y, kab.z, kab.w}, rkw[8] = {rka.x, rka.y, rka.z, rka.w, rkb.x, rkb.y, rkb.z, rkb.w};
        float n2 = 0.f, bon = 0.f;
#pragma unroll
        for (int i = 0; i < 8; ++i) { kk[i] = kv[i] * kkw[i]; n2 += kk[i] * kk[i]; km[i] = kv[i] * (1.0f + (av[i] - 1.0f) * kaw[i]); bon += rv[i] * km[i] * rkw[i]; }
        n2 += DPPF(n2, 0xB1); n2 += DPPF(n2, 0x4E); n2 += DPPF(n2, 0x141);
        bon += DPPF(bon, 0xB1); bon += DPPF(bon, 0x4E); bon += DPPF(bon, 0x141);
        const float inv = 1.0f / fmaxf(sqrtf(n2), 1e-12f);
#pragma unroll
        for (int i = 0; i < 8; ++i) kk[i] *= inv;
        if (!meta && jq == 0) ((float*)(ws + WS_BONUS))[(size_t)(b * SEQ + c * 64 + t) * 32 + h] = bon;
    }
    BLOCK_SYNC();
    {
        float Lc[8], Le[8];
#pragma unroll
        for (int i = 0; i < 8; ++i) { Lc[i] = cs[i]; Le[i] = 0.f; }
#pragma unroll
        for (int w = 0; w < 8; ++w) {
            const f32x4 x0 = *(const LAS f32x4*)(lds + O_WT + (w * 64 + j0) * 4), x1 = *(const LAS f32x4*)(lds + O_WT + (w * 64 + j0 + 4) * 4);
            const float xx[8] = {x0.x, x0.y, x0.z, x0.w, x1.x, x1.y, x1.z, x1.w};
            const float msk = w < wave ? 1.0f : 0.0f;
#pragma unroll
            for (int i = 0; i < 8; ++i) { Le[i] += xx[i]; Lc[i] += msk * xx[i]; }
        }
        float Ab[8], Rb[8], Bh[8], Kh[8], Bt[8], Kt[8];
#pragma unroll
        for (int i = 0; i < 8; ++i) {
            const float eP = __expf(Lc[i] - lw[i]), eC = __expf(Lc[i]), eN = __expf(-Lc[i]), eE = __expf(Le[i] - Lc[i]);
            const float ka = kk[i] * av[i];
            Ab[i] = -kk[i] * eP; Rb[i] = rv[i] * eC; Bh[i] = ka * eN; Kh[i] = km[i] * eN; Bt[i] = ka * eE; Kt[i] = km[i] * eE;
        }
        *(LAS u32x4*)(lds + O_AB + (t * LD64 + j0) * 2) = pack8(Ab);
        *(LAS u32x4*)(lds + O_RB + (t * LD64 + j0) * 2) = pack8(Rb);
        *(LAS u32x4*)(lds + O_BH + (t * LD64 + j0) * 2) = pack8(Bh);
        *(LAS u32x4*)(lds + O_KH + (t * LD64 + j0) * 2) = pack8(Kh);
#pragma unroll
        for (int i = 0; i < 8; ++i) { st1T(lds, O_ABT, j0 + i, t, Ab[i]); st1T(lds, O_BTT, j0 + i, t, Bt[i]); st1T(lds, O_KTT, j0 + i, t, Kt[i]); st1T(lds, O_VT, j0 + i, t, vv[i]); }
        if (t == 63) {
#pragma unroll
            for (int i = 0; i < 8; ++i) *(LAS float*)(lds + O_ELEND + (j0 + i) * 4) = __expf(Le[i]);
        }
    }
    BLOCK_SYNC();
    }
    if (next_u >= 0) pl_load(P, next_u, L);
    DBGSUM(0, O_AB, O_RB, O_BH, O_KH, O_ABT, O_BTT, O_KTT, O_VT);
    for (int rpt_ = 0; rpt_ < RPT_E12; ++rpt_) {
    {
        bf16x8 abh[2], akh[2];
#pragma unroll
        for (int ks = 0; ks < 2; ++ks) { abh[ks] = ldsfrag(lds, O_BH, LD64, 16 * tm + fr, ks * 32 + fq * 8); akh[ks] = ldsfrag(lds, O_KH, LD64, 16 * tm + fr, ks * 32 + fq * 8); }
#pragma unroll
        for (int t2 = 0; t2 < 2; ++t2) {
            const int tt = 16 * (tn0 + t2) + fr, s0 = 16 * tm + 4 * fq;
            f32x4 mab = {0.f, 0.f, 0.f, 0.f}, mak = mab, mrb = mab, mrk = mab;
#pragma unroll
            for (int ks = 0; ks < 2; ++ks) {
                const bf16x8 bab = ldsfrag(lds, O_AB, LD64, tt, ks * 32 + fq * 8), brb = ldsfrag(lds, O_RB, LD64, tt, ks * 32 + fq * 8);
                mab = mfma16(abh[ks], bab, mab); mak = mfma16(akh[ks], bab, mak); mrb = mfma16(abh[ks], brb, mrb); mrk = mfma16(akh[ks], brb, mrk);
            }
            float vab[4] = {mab.x, mab.y, mab.z, mab.w}, vak[4] = {mak.x, mak.y, mak.z, mak.w}, vrb[4] = {mrb.x, mrb.y, mrb.z, mrb.w}, vrk[4] = {mrk.x, mrk.y, mrk.z, mrk.w}, vp[4];
#pragma unroll
            for (int r = 0; r < 4; ++r) { const int s = s0 + r; const bool st = s < tt, le = s <= tt;
                vab[r] = st ? vab[r] : 0.f; vak[r] = st ? vak[r] : 0.f; vrb[r] = le ? vrb[r] : 0.f; vrk[r] = le ? vrk[r] : 0.f; vp[r] = vab[r] + (s == tt ? 1.0f : 0.f); }
            st4(lds, O_M0, tt, s0, (f32x4){vab[0], vab[1], vab[2], vab[3]});
#pragma unroll
            for (int r = 0; r < 4; ++r) st1(lds, O_M0T, s0 + r, tt, vab[r]);
            st4(lds, O_PA, tt, s0, (f32x4){vp[0], vp[1], vp[2], vp[3]});
            st4(lds, O_MAK, tt, s0, (f32x4){vak[0], vak[1], vak[2], vak[3]});
            st4(lds, O_MRB, tt, s0, (f32x4){vrb[0], vrb[1], vrb[2], vrb[3]});
            st4(lds, O_MRK, tt, s0, (f32x4){vrk[0], vrk[1], vrk[2], vrk[3]});
        }
    }
    BLOCK_SYNC();
    DBGSUM(1, O_M0, O_M0T, O_PA, O_MAK, O_MRB, O_MRK);
    dbl_step<false, true>(lds, O_M0, O_M0T, O_M1, O_M1T, 0, 0, tm, tn0, fr, fq); BLOCK_SYNC();
    dbl_step<true, true>(lds, O_M1, O_M1T, O_M0, O_M0T, O_PA, O_PB, tm, tn0, fr, fq); BLOCK_SYNC();
    dbl_step<true, true>(lds, O_M0, O_M0T, O_M1, O_M1T, O_PB, O_PA, tm, tn0, fr, fq); BLOCK_SYNC();
    dbl_step<true, true>(lds, O_M1, O_M1T, O_M0, O_M0T, O_PA, O_PB, tm, tn0, fr, fq); BLOCK_SYNC();
    dbl_step<true, true>(lds, O_M0, O_M0T, O_M1, O_M1T, O_PB, O_PA, tm, tn0, fr, fq); BLOCK_SYNC();
    dbl_step<true, false>(lds, O_M1, O_M1T, 0, 0, O_PA, O_PB, tm, tn0, fr, fq); BLOCK_SYNC();
    }
    DBGSUM(2, O_PB);
    const size_t ub = (size_t)u * 4096;
    for (int rpt_ = 0; rpt_ < RPT_E35; ++rpt_) {
    {
        bf16x8 aT[2], aMak[2];
#pragma unroll
        for (int ks = 0; ks < 2; ++ks) { aT[ks] = ldsfrag(lds, O_PB, LD64, 16 * tm + fr, ks * 32 + fq * 8); aMak[ks] = ldsfrag(lds, O_MAK, LD64, 16 * tm + fr, ks * 32 + fq * 8); }
#pragma unroll
        for (int t2 = 0; t2 < 2; ++t2) {
            const int n = 16 * (tn0 + t2) + fr, t0 = 16 * tm + 4 * fq;
            f32x4 at = {0.f, 0.f, 0.f, 0.f}, xt = at;
#pragma unroll
            for (int ks = 0; ks < 2; ++ks) { at = mfma16(aT[ks], ldsfragT(lds, O_ABT, n, ks * 32 + fq * 8), at); xt = mfma16(aMak[ks], ldsfragT(lds, O_VT, n, ks * 32 + fq * 8), xt); }
            st4(lds, O_M0, n, t0, at); st4(lds, O_M0T, n, t0, xt);
        }
    }
    BLOCK_SYNC();
    DBGSUM(3, O_M0, O_M0T);
    {
        bf16x8 aT[2], aAt[2];
#pragma unroll
        for (int ks = 0; ks < 2; ++ks) { aT[ks] = ldsfrag(lds, O_PB, LD64, 16 * tm + fr, ks * 32 + fq * 8); aAt[ks] = ldsfrag(lds, O_M0, LD64, 16 * tm + fr, ks * 32 + fq * 8); }
        bf16_t* Rt = (bf16_t*)(ws + WS_RT) + ub; bf16_t* Gp = (bf16_t*)(ws + WS_G) + ub;
#pragma unroll
        for (int t2 = 0; t2 < 2; ++t2) {
            const int n = 16 * (tn0 + t2) + fr, m0 = 16 * tm + 4 * fq;
            f32x4 u0 = {0.f, 0.f, 0.f, 0.f}, rt = u0, g = u0;
#pragma unroll
            for (int ks = 0; ks < 2; ++ks) {
                u0 = mfma16(aT[ks], ldsfrag(lds, O_M0T, LD64, n, ks * 32 + fq * 8), u0);
                rt = mfma16(aAt[ks], ldsfrag(lds, O_MRB, LD64, n, ks * 32 + fq * 8), rt);
                g = mfma16(aAt[ks], ldsfragT(lds, O_BTT, n, ks * 32 + fq * 8), g);
            }
            st4(lds, O_M1, n, m0, u0);
            const u32x2 rw = *(const LAS u32x2*)(lds + O_RB + (n * LD64 + m0) * 2);
            rt.x += bflo(rw.x); rt.y += bfhi(rw.x); rt.z += bflo(rw.y); rt.w += bfhi(rw.y);
            { u32x2 w; w.x = pk2(rt.x, rt.y); w.y = pk2(rt.z, rt.w); *(u32x2*)(Rt + n * 64 + m0) = w; }
            if ((n >> 2) == (m0 >> 2)) { const float e = *(const LAS float*)(lds + O_ELEND + n * 4); const int r = n & 3;
                g.x += (r == 0) ? e : 0.f; g.y += (r == 1) ? e : 0.f; g.z += (r == 2) ? e : 0.f; g.w += (r == 3) ? e : 0.f; }
            { const int pos0 = 32 * (tm >> 1) + 8 * fq + 4 * (tm & 1); u32x2 w; w.x = pk2(g.x, g.y); w.y = pk2(g.z, g.w); *(u32x2*)(Gp + n * 64 + pos0) = w; }
        }
    }
    BLOCK_SYNC();
    DBGSUM(4, O_M1);
    {
        bf16x8 aB[2], aK[2], aU[2], aV[2];
#pragma unroll
        for (int ks = 0; ks < 2; ++ks) { const int row = 16 * tm + fr, ko = ks * 32 + fq * 8;
            aB[ks] = ldsfragT(lds, O_BTT, row, ko); aK[ks] = ldsfragT(lds, O_KTT, row, ko); aU[ks] = ldsfrag(lds, O_M1, LD64, row, ko); aV[ks] = ldsfragT(lds, O_VT, row, ko); }
        bf16_t* H0t = (bf16_t*)(ws + WS_H0T) + ub; bf16_t* Y0s = (bf16_t*)(ws + WS_Y0) + ub;
#pragma unroll
        for (int t2 = 0; t2 < 2; ++t2) {
            const int n = 16 * (tn0 + t2) + fr, m0 = 16 * tm + 4 * fq;
            f32x4 hh = {0.f, 0.f, 0.f, 0.f}, yy = hh;
#pragma unroll
            for (int ks = 0; ks < 2; ++ks) { const int ko = ks * 32 + fq * 8;
                const bf16x8 bU = ldsfrag(lds, O_M1, LD64, n, ko), bV = ldsfragT(lds, O_VT, n, ko), bRb = ldsfrag(lds, O_MRB, LD64, n, ko), bRk = ldsfrag(lds, O_MRK, LD64, n, ko);
                hh = mfma16(aB[ks], bU, hh); hh = mfma16(aK[ks], bV, hh);
                yy = mfma16(aU[ks], bRb, yy); yy = mfma16(aV[ks], bRk, yy); }
            { u32x2 w; w.x = pk2(hh.x, hh.y); w.y = pk2(hh.z, hh.w); *(u32x2*)(H0t + n * 64 + m0) = w; }
            { u32x2 w; w.x = pk2(yy.x, yy.y); w.y = pk2(yy.z, yy.w); *(u32x2*)(Y0s + n * 64 + m0) = w; }
        }
    }
    BLOCK_SYNC();
    }
}

constexpr int LDU = 264;
__device__ __forceinline__ void pool_unit(const Params& P, ldsp lds, int pu) {
    int tid = threadIdx.x; asm volatile("" : "+v"(tid));
    const int lane = tid & 63, wave = tid >> 6, fr = lane & 15, fq = lane >> 4;
    unsigned char* ws = P.ws;
    const bf16_t* pp = (const bf16_t*)(ws + WS_P);
    const int g = pu & 3, tt = pu >> 2, b = tt >> 6, ti0 = (tt & 63) * 64;
    constexpr int O_U = 0, O_PL = 79 * LDU * 2;
    for (int idx = tid; idx < 79 * 32; idx += 512) {
        const int lr = idx >> 5, ch = idx & 31, ti = ti0 + lr - 15;
        const int row = ti >= 0 ? b * SEQ + ti : ROW_META + 16 + ti;
        *(LAS u32x4*)(lds + O_U + (lr * LDU + ch * 8) * 2) = *(const u32x4*)(pp + (size_t)row * NPAD + C_POOL + g * 256 + ch * 8);
    }
    BLOCK_SYNC();
    {
        const int t = tid >> 3, cq = tid & 7, win = 2 << g; const float inv = 1.0f / (float)win;
#pragma unroll
        for (int cc = 0; cc < 4; ++cc) {
            const int c0 = cq * 32 + cc * 8; float s[8], own[8];
            unpack8(*(const LAS u32x4*)(lds + O_U + ((15 + t) * LDU + c0) * 2), own);
#pragma unroll
            for (int i = 0; i < 8; ++i) s[i] = own[i];
            for (int d = 1; d < win; ++d) { float x[8]; unpack8(*(const LAS u32x4*)(lds + O_U + ((15 + t - d) * LDU + c0) * 2), x);
#pragma unroll
                for (int i = 0; i < 8; ++i) s[i] += x[i]; }
#pragma unroll
            for (int i = 0; i < 8; ++i) s[i] = s[i] * inv - own[i];
            *(LAS u32x4*)(lds + O_PL + (t * LDU + c0) * 2) = pack8(s);
        }
    }
    BLOCK_SYNC();
    {
        const bf16_t* wt = (const bf16_t*)(ws + WS_WTPOOL) + (size_t)g * 65536;
        f32x4 acc[2][4];
#pragma unroll
        for (int a = 0; a < 2; ++a)
#pragma unroll
            for (int n = 0; n < 4; ++n) acc[a][n] = (f32x4){0.f, 0.f, 0.f, 0.f};
#pragma unroll 4
        for (int ks = 0; ks < 8; ++ks) {
            bf16x8 af[2];
#pragma unroll
            for (int a = 0; a < 2; ++a) af[a] = *(const bf16x8*)(wt + (size_t)(32 * wave + 16 * a + fr) * 256 + ks * 32 + fq * 8);
#pragma unroll
            for (int n = 0; n < 4; ++n) { const bf16x8 bf = ldsfrag(lds, O_PL, LDU, 16 * n + fr, ks * 32 + fq * 8);
#pragma unroll
                for (int a = 0; a < 2; ++a) acc[a][n] = mfma16(af[a], bf, acc[a][n]); }
        }
        bf16_t* yb = (bf16_t*)(ws + WS_YB);
        const float* psc = P.in[I_PSCALE] + g * 256;
#pragma unroll
        for (int a = 0; a < 2; ++a) { const int d0 = 32 * wave + 16 * a + 4 * fq; const f32x4 sc = *(const f32x4*)(psc + d0);
#pragma unroll
            for (int n = 0; n < 4; ++n) { const int t = 16 * n + fr; const f32x4 o = acc[a][n] * sc;
                u32x2 w; w.x = pk2(o.x, o.y); w.y = pk2(o.z, o.w);
                *(u32x2*)(yb + (size_t)(b * SEQ + ti0 + t) * 1024 + g * 256 + d0) = w; } }
    }
    BLOCK_SYNC();
}
__device__ __forceinline__ void gsig_unit(const Params& P, int gu) {
    int tid = threadIdx.x; asm volatile("" : "+v"(tid));
    const bf16_t* pp = (const bf16_t*)(P.ws + WS_P); bf16_t* gs = (bf16_t*)(P.ws + WS_GSIG);
    const float* mu = P.in[I_MU];
#pragma unroll
    for (int it = 0; it < 4; ++it) {
        const int idx = tid + 512 * it, tl = idx >> 5, ch = idx & 31, col = C_GL + ch * 8;
        const int row = gu * 64 + tl; const int prow = ((row & (SEQ - 1)) == 0) ? (ROW_META + 15) : row - 1;
        float x[8]; shift8r(*(const u32x4*)(pp + (size_t)row * NPAD + col), *(const u32x4*)(pp + (size_t)prow * NPAD + col), mu + col, x);
#pragma unroll
        for (int i = 0; i < 8; ++i) x[i] = fast_sigmoid(x[i]);
        *(u32x4*)(gs + (size_t)row * 256 + ch * 8) = pack8(x);
    }
}
__device__ __forceinline__ void phase2(const Params& P, ldsp lds) {
    PL L;
    if ((int)blockIdx.x < NUNITS) pl_load(P, blockIdx.x, L);
    for (int u = blockIdx.x; u < NUNITS + 512 + 128; u += gridDim.x) {
        if (u < NUNITS) { const int nu = u + (int)gridDim.x; rwkv_unit(P, lds, u, L, nu < NUNITS ? nu : -1); }
        else if (u < NUNITS + 512) pool_unit(P, lds, u - NUNITS);
        else gsig_unit(P, u - NUNITS - 512);
    }
}
__device__ __forceinline__ void convert_tables(const Params& P, int r0, int stride) {
    const int lane = threadIdx.x & 63;
    unsigned char* ws = P.ws;
    for (int r = r0; r < 32768; r += stride) {
        const float* src = (r < 16384 ? P.in[I_UT] : P.in[I_VT]) + (size_t)(r & 16383) * D + lane * 32;
        unsigned char* dst = ws + (r < 16384 ? WS_UB : WS_VB) + (size_t)(r & 16383) * TROW + lane * 24;
        f32x4 v[8]; float am = 0.f;
#pragma unroll
        for (int j = 0; j < 8; ++j) { v[j] = ((const f32x4*)src)[j]; am = fmaxf(am, fmaxf(fmaxf(fabsf(v[j].x), fabsf(v[j].y)), fmaxf(fabsf(v[j].z), fabsf(v[j].w)))); }
        am = wave_max_dpp(am);
        const float s = am > 0.f ? 7.5f / am : 1.0f;
        f32x16 ev, od;
#pragma unroll
        for (int j = 0; j < 8; ++j) { ev[2 * j] = v[j].x * s; od[2 * j] = v[j].y * s; ev[2 * j + 1] = v[j].z * s; od[2 * j + 1] = v[j].w * s; }
        const u32x6 p6 = __builtin_amdgcn_cvt_scalef32_2xpk16_fp6_f32(ev, od, 1.0f);
        ((u32x2*)dst)[0] = (u32x2){p6[0], p6[1]}; ((u32x2*)dst)[1] = (u32x2){p6[2], p6[3]}; ((u32x2*)dst)[2] = (u32x2){p6[4], p6[5]};
        if (lane == 0) ((float*)(ws + WS_TSC))[r] = am > 0.f ? am * (1.0f / 7.5f) : 1.0f;
    }
}
__device__ __forceinline__ void phase3(const Params& P) {
    const int lane = threadIdx.x & 63, wave = threadIdx.x >> 6, fr = lane & 15, fq = lane >> 4;
    if (wave != 0) { convert_tables(P, blockIdx.x * 7 + (wave - 1), gridDim.x * 7); return; }
    unsigned char* ws = P.ws;
    const bf16_t* Gp = (const bf16_t*)(ws + WS_G); const bf16_t* H0t = (const bf16_t*)(ws + WS_H0T); bf16_t* S0t = (bf16_t*)(ws + WS_S0T);
    for (int item = blockIdx.x; item < 256; item += gridDim.x) {
        const int bh = item >> 2, vq = item & 3, h = bh & 31;
        bf16x8 Sb[2];
#pragma unroll
        for (int ks = 0; ks < 2; ++ks)
#pragma unroll
            for (int i = 0; i < 8; ++i) Sb[ks][i] = 0;
        bf16x8 g0[4][2], g1[4][2], g2[4][2], g3[4][2]; u32x2 h0[4], h1[4], h2[4], h3[4];
        auto load = [&](int step, bf16x8 (&ga)[4][2], u32x2 (&hf)[4]) {
            const int u = (step == 0) ? (4096 + h) : (bh * 64 + step - 1);
            const bf16_t* g = Gp + (size_t)u * 4096; const bf16_t* hh = H0t + (size_t)u * 4096;
#pragma unroll
            for (int mt = 0; mt < 4; ++mt) {
#pragma unroll
                for (int ks = 0; ks < 2; ++ks) ga[mt][ks] = *(const bf16x8*)(g + (16 * mt + fr) * 64 + ks * 32 + fq * 8);
                hf[mt] = *(const u32x2*)(hh + (16 * vq + fr) * 64 + 16 * mt + 4 * fq);
            }
        };
        auto apply = [&](int step, const bf16x8 (&ga)[4][2], const u32x2 (&hf)[4]) {
            f32x4 acc[4];
#pragma unroll
            for (int mt = 0; mt < 4; ++mt) {
                acc[mt] = (f32x4){bflo(hf[mt].x), bfhi(hf[mt].x), bflo(hf[mt].y), bfhi(hf[mt].y)};
                acc[mt] = mfma16(ga[mt][0], Sb[0], acc[mt]);
                acc[mt] = mfma16(ga[mt][1], Sb[1], acc[mt]);
            }
            bf16_t* so = S0t + (size_t)(bh * 64 + step) * 4096 + (16 * vq + fr) * 64 + 4 * fq;
            u32x2 w[4];
#pragma unroll
            for (int mt = 0; mt < 4; ++mt) { w[mt].x = pk2(acc[mt].x, acc[mt].y); w[mt].y = pk2(acc[mt].z, acc[mt].w); *(u32x2*)(so + 16 * mt) = w[mt]; }
#pragma unroll
            for (int ks = 0; ks < 2; ++ks) {
                const u32x4 q4 = (u32x4){w[2 * ks].x, w[2 * ks].y, w[2 * ks + 1].x, w[2 * ks + 1].y};
                Sb[ks] = __builtin_bit_cast(bf16x8, q4);
            }
        };
        load(0, g0, h0); load(1, g1, h1); load(2, g2, h2);
#pragma unroll 1
        for (int step = 0; step < 64; step += 4) {
            load(step + 3, g3, h3); apply(step, g0, h0);
            if (step + 4 < 64) load(step + 4, g0, h0);
            apply(step + 1, g1, h1);
            if (step + 5 < 64) load(step + 5, g1, h1);
            apply(step + 2, g2, h2);
            if (step + 6 < 64) load(step + 6, g2, h2);
            apply(step + 3, g3, h3);
        }
    }
}

constexpr int LDG = 264;
__device__ __forceinline__ void phase3b(const Params& P, ldsp lds) {
    int tid = threadIdx.x; asm volatile("" : "+v"(tid));
    const int lane = tid & 63, wave = tid >> 6, fr = lane & 15, fq = lane >> 4, wq = wave & 3;
    unsigned char* ws = P.ws;
    const bf16_t* pp = (const bf16_t*)(ws + WS_P);
    const float* mu = P.in[I_MU];
    constexpr int O_G2 = 0;
    for (int w = blockIdx.x; w < 256; w += gridDim.x) {
        const int h = w & 31;
        BLOCK_SYNC();
        for (int idx = tid; idx < 64 * 32; idx += 512) { const int row = idx >> 5, ch = idx & 31;
            *(LAS u32x4*)(lds + O_G2 + (row * LDG + ch * 8) * 2) = *(const u32x4*)((const bf16_t*)(ws + WS_WTG2) + (size_t)(h * 64 + row) * 256 + ch * 8); }
        BLOCK_SYNC();
        bf16x8 bG[8], bR[2], aS[4][2]; u32x2 yw[4], vc[4], vp[4]; float bon;
        auto unit_of = [&](int it, int& b, int& c) { const int q = (w >> 5) + 8 * (2 * it + (wave >> 2)); b = q >> 6; c = q & 63; };
        auto issue = [&](int it) {
            int b, c; unit_of(it, b, c); const int u = (b * 32 + h) * 64 + c, trow0 = b * SEQ + c * 64 + 16 * wq;
            const size_t ub = (size_t)u * 4096;
            const bf16_t* S0t = (const bf16_t*)(ws + WS_S0T) + ub; const bf16_t* Rt = (const bf16_t*)(ws + WS_RT) + ub; const bf16_t* Y0s = (const bf16_t*)(ws + WS_Y0) + ub;
            const int row = trow0 + fr; const int prow = (c == 0 && wq == 0 && fr == 0) ? (ROW_META + 15) : row - 1;
            const bf16_t* gsr = (const bf16_t*)(ws + WS_GSIG) + (size_t)row * 256 + fq * 8;
#pragma unroll
            for (int ks = 0; ks < 8; ++ks) bG[ks] = *(const bf16x8*)(gsr + ks * 32);
#pragma unroll
            for (int ks = 0; ks < 2; ++ks) bR[ks] = *(const bf16x8*)(Rt + (16 * wq + fr) * 64 + ks * 32 + fq * 8);
#pragma unroll
            for (int mt = 0; mt < 4; ++mt) {
                yw[mt] = *(const u32x2*)(Y0s + (16 * wq + fr) * 64 + 16 * mt + 4 * fq);
#pragma unroll
                for (int ks = 0; ks < 2; ++ks) aS[mt][ks] = *(const bf16x8*)(S0t + (16 * mt + fr) * 64 + ks * 32 + fq * 8);
                const int hc = h * 64 + 16 * mt + 4 * fq;
                vc[mt] = *(const u32x2*)(pp + (size_t)row * NPAD + C_V + hc); vp[mt] = *(const u32x2*)(pp + (size_t)prow * NPAD + C_V + hc);
            }
            bon = ((const float*)(ws + WS_BONUS))[(size_t)row * 32 + h];
        };
        issue(0);
#pragma unroll 1
        for (int it = 0; it < 8; ++it) {
            int b, c; unit_of(it, b, c);
            const int row = b * SEQ + c * 64 + 16 * wq + fr;
            f32x4 gacc[4];
#pragma unroll
            for (int mt = 0; mt < 4; ++mt) gacc[mt] = (f32x4){0.f, 0.f, 0.f, 0.f};
#pragma unroll
            for (int ks = 0; ks < 8; ++ks)
#pragma unroll
                for (int mt = 0; mt < 4; ++mt) gacc[mt] = mfma16(*(const LAS bf16x8*)(lds + O_G2 + ((16 * mt + fr) * LDG + ks * 32 + fq * 8) * 2), bG[ks], gacc[mt]);
            f32x4 y[4], vv[4]; const float bonc = bon;
#pragma unroll
            for (int mt = 0; mt < 4; ++mt) {
                y[mt] = (f32x4){bflo(yw[mt].x), bfhi(yw[mt].x), bflo(yw[mt].y), bfhi(yw[mt].y)};
#pragma unroll
                for (int ks = 0; ks < 2; ++ks) y[mt] = mfma16(aS[mt][ks], bR[ks], y[mt]);
                const f32x4 mv = *(const f32x4*)(mu + C_V + h * 64 + 16 * mt + 4 * fq);
                const f32x4 cv = (f32x4){bflo(vc[mt].x), bfhi(vc[mt].x), bflo(vc[mt].y), bfhi(vc[mt].y)}, pv = (f32x4){bflo(vp[mt].x), bfhi(vp[mt].x), bflo(vp[mt].y), bfhi(vp[mt].y)};
                vv[mt] = cv + (pv - cv) * mv;
            }
#pragma unroll
            for (int mt = 0; mt < 4; ++mt) asm volatile("" : "+v"(y[mt]), "+v"(vv[mt]), "+v"(gacc[mt]));
            if (it + 1 < 8) issue(it + 1);
            float s = 0.f;
#pragma unroll
            for (int mt = 0; mt < 4; ++mt) s += (y[mt].x + y[mt].y) + (y[mt].z + y[mt].w);
            s += __shfl_xor(s, 16); s += __shfl_xor(s, 32);
            const float mean = s * (1.0f / 64.0f); float qq = 0.f;
#pragma unroll
            for (int mt = 0; mt < 4; ++mt) { y[mt] = y[mt] - mean; qq += (y[mt].x * y[mt].x + y[mt].y * y[mt].y) + (y[mt].z * y[mt].z + y[mt].w * y[mt].w); }
            qq += __shfl_xor(qq, 16); qq += __shfl_xor(qq, 32);
            const float rstd = 1.0f / sqrtf(qq * (1.0f / 64.0f) + GN_EPS);
            bf16_t* ya = (bf16_t*)(ws + WS_YA) + (size_t)row * D + h * 64;
#pragma unroll
            for (int mt = 0; mt < 4; ++mt) {
                const int i0 = 16 * mt + 4 * fq, hc = h * 64 + i0;
                const f32x4 gg = *(const f32x4*)(P.in[I_GNG] + hc), gb = *(const f32x4*)(P.in[I_GNB] + hc);
                const f32x4 o = (y[mt] * rstd * gg + gb + vv[mt] * bonc) * gacc[mt];
                u32x2 wv; wv.x = pk2(o.x, o.y); wv.y = pk2(o.z, o.w);
                *(u32x2*)(ya + i0) = wv;
            }
        }
    }
}
__device__ __forceinline__ u32x6 ld_row6(const unsigned char* p) { const u32x2 a = ((const u32x2*)p)[0], b = ((const u32x2*)p)[1], c = ((const u32x2*)p)[2]; return (u32x6){a.x, a.y, b.x, b.y, c.x, c.y}; }
__device__ __forceinline__ void peer_token(const Params& P, int tok, const LAS int* eidx, const LAS float* gts) {
    const int lane = threadIdx.x & 63;
    unsigned char* ws = P.ws;
    const unsigned char* Ub = ws + WS_UB; const unsigned char* Vb = ws + WS_VB;
    const float* tsc = (const float*)(ws + WS_TSC);
    {
        int lo = lane; asm volatile("" : "+v"(lo));
        float x[32], o[32];
        {
            const bf16_t* hr = (const bf16_t*)(ws + WS_H1B) + (size_t)tok * D + lo * 32;
#pragma unroll
            for (int i = 0; i < 4; ++i) unpack8(*(const u32x4*)(hr + 8 * i), x + 8 * i);
#pragma unroll
            for (int i = 0; i < 32; ++i) o[i] = 0.f;
        }
        const int e_lo = eidx[lo], e_hi = eidx[64 + lo];
        const float su_lo = tsc[e_lo], su_hi = tsc[e_hi];
        const float gv_lo = gts[lo] * tsc[16384 + e_lo], gv_hi = gts[64 + lo] * tsc[16384 + e_hi];
        u32x6 ua[2], va[2], ub[2], vb[2];
        auto issue = [&](int g, u32x6 (&uu)[2], u32x6 (&vv)[2]) {
            const int ev = (g < 32) ? e_lo : e_hi;
#pragma unroll
            for (int j = 0; j < 2; ++j) {
                const int e = __builtin_amdgcn_readlane(ev, (2 * g + j) & 63);
                uu[j] = ld_row6(Ub + (size_t)e * TROW + lo * 24); vv[j] = ld_row6(Vb + (size_t)e * TROW + lo * 24);
            }
        };
        auto consume = [&](int g, const u32x6 (&uu)[2], const u32x6 (&vv)[2]) {
            const float suv = (g < 32) ? su_lo : su_hi, gvv = (g < 32) ? gv_lo : gv_hi;
            float dd[2];
#pragma unroll
            for (int j = 0; j < 2; ++j) { const f32x32 r = __builtin_amdgcn_cvt_scalef32_pk32_f32_fp6(uu[j], 1.0f); float s0 = 0.f, s1 = 0.f;
#pragma unroll
                for (int i = 0; i < 16; ++i) { s0 += r[2 * i] * x[2 * i]; s1 += r[2 * i + 1] * x[2 * i + 1]; }
                dd[j] = s0 + s1; }
#pragma unroll
            for (int j = 0; j < 2; ++j) dd[j] = wave_sum_dpp(dd[j]);
            const int l0 = (2 * g) & 63;
            const pg8::f32x2 ge = pg8::gelu_pk((pg8::f32x2){dd[0] * readlane_f(suv, l0), dd[1] * readlane_f(suv, l0 + 1)});
            const float a0 = ge.x * readlane_f(gvv, l0), a1 = ge.y * readlane_f(gvv, l0 + 1);
            { const f32x32 r = __builtin_amdgcn_cvt_scalef32_pk32_f32_fp6(vv[0], 1.0f);
#pragma unroll
              for (int i = 0; i < 32; ++i) o[i] += a0 * r[i]; }
            { const f32x32 r = __builtin_amdgcn_cvt_scalef32_pk32_f32_fp6(vv[1], 1.0f);
#pragma unroll
              for (int i = 0; i < 32; ++i) o[i] += a1 * r[i]; }
        };
        issue(0, ua, va);
        for (int g = 0; g < 64; g += 2) {
            issue(g + 1, ub, vb);
            consume(g, ua, va);
            if (g + 2 < 64) issue(g + 2, ua, va);
            consume(g + 1, ub, vb);
        }
        float s = 0.f;
#pragma unroll
        for (int i = 0; i < 32; ++i) { o[i] += DN_ALPHA * x[i]; s += o[i]; }
        const float mean = wave_sum_dpp(s) * (1.0f / D); float q = 0.f;
#pragma unroll
        for (int i = 0; i < 32; ++i) { o[i] -= mean; q += o[i] * o[i]; }
        const float rstd = 1.0f / sqrtf(wave_sum_dpp(q) * (1.0f / D) + LN_EPS);
        float* orow = P.out + (size_t)tok * D + lo * 32;
#pragma unroll
        for (int c = 0; c < 8; ++c) {
            const int off = lo * 32 + 4 * c;
            const f32x4 g0 = *(const f32x4*)(P.in[I_LN2G] + off), b0 = *(const f32x4*)(P.in[I_LN2B] + off);
            f32x4 r0;
            r0.x = o[4 * c + 0] * rstd * g0.x + b0.x; r0.y = o[4 * c + 1] * rstd * g0.y + b0.y; r0.z = o[4 * c + 2] * rstd * g0.z + b0.z; r0.w = o[4 * c + 3] * rstd * g0.w + b0.w;
            *(f32x4*)(orow + 4 * c) = r0;
        }
    }
}
__device__ __forceinline__ void phase5b(const Params& P) {
    const int lane = threadIdx.x & 63, wave = threadIdx.x >> 6;
    const int gw = blockIdx.x * 8 + wave, NGW = gridDim.x * 8;
    unsigned char* ws = P.ws;
    for (int r = gw; r < NTOK; r += NGW)
        ln_row_bf16((const float*)(ws + WS_X1) + (size_t)r * D, P.in[I_LN1G], P.in[I_LN1B], (bf16_t*)(ws + WS_H1B) + (size_t)r * D, lane);
}

#define CE_DESC(a, b) do { const float h_ = fmaxf((a), (b)), l_ = fminf((a), (b)); (a) = h_; (b) = l_; } while (0)
template <int N> __device__ __forceinline__ void bitonic_sort_desc(float (&v)[N]) {
#pragma unroll
    for (int k = 2; k <= N; k <<= 1)
#pragma unroll
        for (int j = k >> 1; j > 0; j >>= 1)
#pragma unroll
            for (int i = 0; i < N; ++i) { const int l = i ^ j; if (l > i) { if ((i & k) == 0) CE_DESC(v[i], v[l]); else CE_DESC(v[l], v[i]); } }
}
template <int N> __device__ __forceinline__ void bitonic_merge_desc(float (&v)[N]) {
#pragma unroll
    for (int j = N >> 1; j > 0; j >>= 1)
#pragma unroll
        for (int i = 0; i < N; ++i) { const int l = i ^ j; if (l > i) CE_DESC(v[i], v[l]); }
}
__device__ __forceinline__ void top16_merge(float (&a)[16], const float (&brev)[16]) {
#pragma unroll
    for (int i = 0; i < 16; ++i) a[i] = fmaxf(a[i], brev[i]);
    bitonic_merge_desc<16>(a);
}
__device__ __forceinline__ float embed_bits(float v, unsigned code, unsigned mask) { return __uint_as_float((__float_as_uint(v) & ~mask) | code); }

__device__ __forceinline__ void phase7(const Params& P, ldsp lds) {
    const int tid0 = threadIdx.x;
    unsigned char* ws = P.ws;
    const bf16_t* qb = (const bf16_t*)(ws + WS_Q); const bf16_t* sk = (const bf16_t*)(ws + WS_SUBK);
    constexpr int LDSK = 136, O_SK = 0, O_SV = 2 * 128 * LDSK * 2, O_EX = O_SV + 32768, O_GT = O_EX + 16384;
    for (int idx = tid0; idx < 2 * 128 * 16; idx += 512) { const int row = idx >> 4, ch = idx & 15;
        *(LAS u32x4*)(lds + O_SK + (row * LDSK + ch * 8) * 2) = *(const u32x4*)(sk + row * 128 + ch * 8); }
    BLOCK_SYNC();
    for (int tile = blockIdx.x; tile < 256; tile += gridDim.x) {
        int tid = tid0; asm volatile("" : "+v"(tid));
        const int lane = tid & 63, wave = tid >> 6, fr = lane & 15, fq = lane >> 4, fro = fr, fqo = fq;
        const int tok0 = tile * 32, h = wave;
#pragma unroll 1
        for (int cb = 0; cb < 4; ++cb) {
            const int nt = cb >> 1, p = cb & 1;
            f32x4 acc[8];
#pragma unroll
            for (int mt = 0; mt < 8; ++mt) acc[mt] = (f32x4){0.f, 0.f, 0.f, 0.f};
            const bf16_t* qrow = qb + (size_t)(tok0 + 16 * nt + fro) * D + h * 256 + p * 128 + fqo * 8;
#pragma unroll
            for (int ks = 0; ks < 4; ++ks) {
                const bf16x8 bq = *(const bf16x8*)(qrow + ks * 32);
#pragma unroll
                for (int mt = 0; mt < 8; ++mt) acc[mt] = mfma16(*(const LAS bf16x8*)(lds + O_SK + ((p * 128 + 16 * mt + fro) * LDSK + ks * 32 + fqo * 8) * 2), bq, acc[mt]);
            }
            float a[16], b[16];
#pragma unroll
            for (int mt = 0; mt < 4; ++mt) {
                a[4 * mt + 0] = embed_bits(acc[mt].x, 16 * mt + 4 * fq + 0, 127u); a[4 * mt + 1] = embed_bits(acc[mt].y, 16 * mt + 4 * fq + 1, 127u);
                a[4 * mt + 2] = embed_bits(acc[mt].z, 16 * mt + 4 * fq + 2, 127u); a[4 * mt + 3] = embed_bits(acc[mt].w, 16 * mt + 4 * fq + 3, 127u);
                b[4 * mt + 0] = embed_bits(acc[mt + 4].x, 16 * (mt + 4) + 4 * fq + 0, 127u); b[4 * mt + 1] = embed_bits(acc[mt + 4].y, 16 * (mt + 4) + 4 * fq + 1, 127u);
                b[4 * mt + 2] = embed_bits(acc[mt + 4].z, 16 * (mt + 4) + 4 * fq + 2, 127u); b[4 * mt + 3] = embed_bits(acc[mt + 4].w, 16 * (mt + 4) + 4 * fq + 3, 127u);
            }
            bitonic_sort_desc<16>(a); bitonic_sort_desc<16>(b);
            { float br[16];
#pragma unroll
              for (int i = 0; i < 16; ++i) br[i] = b[15 - i];
              top16_merge(a, br); }
#pragma unroll
            for (int x = 16; x <= 32; x <<= 1) { float br[16];
#pragma unroll
                for (int i = 0; i < 16; ++i) br[i] = __shfl_xor(a[15 - i], x);
                top16_merge(a, br); }
            if (fq == 0) { LAS f32x4* o = (LAS f32x4*)(lds + O_SV + ((((16 * nt + fr) * 8 + h) * 2 + p) * 16) * 4);
                o[0] = (f32x4){a[0], a[1], a[2], a[3]}; o[1] = (f32x4){a[4], a[5], a[6], a[7]}; o[2] = (f32x4){a[8], a[9], a[10], a[11]}; o[3] = (f32x4){a[12], a[13], a[14], a[15]}; }
        }
        BLOCK_SYNC();
        if (tid < 256) {
            const int tok = tid >> 3, hh = tid & 7;
            const LAS f32x4* s = (const LAS f32x4*)(lds + O_SV + (((tok * 8 + hh) * 2) * 16) * 4);
            float s0[16], s1[16];
#pragma unroll
            for (int c4 = 0; c4 < 4; ++c4) { const f32x4 x = s[c4], y = s[4 + c4]; s0[4 * c4] = x.x; s0[4 * c4 + 1] = x.y; s0[4 * c4 + 2] = x.z; s0[4 * c4 + 3] = x.w; s1[4 * c4] = y.x; s1[4 * c4 + 1] = y.y; s1[4 * c4 + 2] = y.z; s1[4 * c4 + 3] = y.w; }
            float g0[16], g1[16], g2[16], g3[16];
            const float NEG = -3.0e38f;
#pragma unroll
            for (int bq = 0; bq < 16; ++bq) g0[bq] = embed_bits(s0[0] + s1[bq], bq, 255u);
            {
                int n1 = 0, n2 = 0, n3 = 0;
#pragma unroll
                for (int aa = 1; aa < 16; ++aa)
#pragma unroll
                    for (int bb = 0; bb < 16; ++bb) if ((aa + 1) * (bb + 1) <= 16) {
                        const float c = embed_bits(s0[aa] + s1[bb], aa * 16 + bb, 255u);
                        if (n1 < 16) g1[n1++] = c; else if (n2 < 16) g2[n2++] = c; else g3[n3++] = c;
                    }
#pragma unroll
                for (int i = 0; i < 16; ++i) if (i >= n3) g3[i] = NEG;
            }
            bitonic_sort_desc<16>(g1); bitonic_sort_desc<16>(g2); bitonic_sort_desc<16>(g3);
            { float r1[16], r3[16];
#pragma unroll
              for (int i = 0; i < 16; ++i) { r1[i] = g1[15 - i]; r3[i] = g3[15 - i]; }
              top16_merge(g0, r1); top16_merge(g2, r3);
#pragma unroll
              for (int i = 0; i < 16; ++i) g0[i] = fmaxf(g0[i], g2[15 - i]); }
            float mx = g0[0];
#pragma unroll
            for (int i = 1; i < 16; ++i) mx = fmaxf(mx, g0[i]);
            float ex[16], sm = 0.f; int ee[16];
#pragma unroll
            for (int i = 0; i < 16; ++i) {
                ex[i] = __expf(g0[i] - mx); sm += ex[i];
                const unsigned code = __float_as_uint(g0[i]) & 255u;
                const unsigned i0 = __float_as_uint(*(const LAS float*)(lds + O_SV + ((((tok * 8 + hh) * 2 + 0) * 16) + (code >> 4)) * 4)) & 127u;
                const unsigned i1 = __float_as_uint(*(const LAS float*)(lds + O_SV + ((((tok * 8 + hh) * 2 + 1) * 16) + (code & 15u)) * 4)) & 127u;
                ee[i] = (int)(i0 * 128u + i1);
            }
            const float inv = 1.0f / sm;
            LAS int* eo = (LAS int*)(lds + O_EX) + tok * 128 + hh * 16; LAS float* go = (LAS float*)(lds + O_GT) + tok * 128 + hh * 16;
#pragma unroll
            for (int c4 = 0; c4 < 4; ++c4) {
                *(LAS u32x4*)(eo + 4 * c4) = (u32x4){(unsigned)ee[4 * c4], (unsigned)ee[4 * c4 + 1], (unsigned)ee[4 * c4 + 2], (unsigned)ee[4 * c4 + 3]};
                *(LAS f32x4*)(go + 4 * c4) = (f32x4){ex[4 * c4] * inv, ex[4 * c4 + 1] * inv, ex[4 * c4 + 2] * inv, ex[4 * c4 + 3] * inv};
            }
        }
        BLOCK_SYNC();
#pragma unroll 1
        for (int i = 0; i < 4; ++i) peer_token(P, tok0 + wave * 4 + i, (const LAS int*)(lds + O_EX) + (wave * 4 + i) * 128, (const LAS float*)(lds + O_GT) + (wave * 4 + i) * 128);
        BLOCK_SYNC();
    }
}
#ifndef MK_MULTI
#define MK_MULTI 0
#endif
__global__ __launch_bounds__(512, 2) void hybrid_fwd(Params P) {
    extern __shared__ __attribute__((aligned(16))) unsigned char shm[];
    ldsp lds = (ldsp)shm;
    unsigned char* ws = P.ws;
    volatile LAS unsigned* xst = (volatile LAS unsigned*)(lds + LDS_BYTES - 16);
    if (threadIdx.x == 0) { xst[0] = 0u; xst[1] = 0u; }
    __syncthreads();
    const XcdBarrier xbar = xcd_barrier_post((unsigned*)(ws + WS_BAR), xst);
    const int lo = P.ph_lo, hi = P.ph_hi;
#ifdef DBG_TA
    unsigned long long ts0 = 0, ts1 = 0, ts2 = 0, ts3 = 0, ts4 = 0, ts5 = 0, ts6 = 0, ts7 = 0, ts8 = 0, ts9 = 0, ts10 = 0, ts11 = 0;
#define STAMP(k) ts##k = __builtin_amdgcn_s_memrealtime()
#else
#define STAMP(k) do { } while (0)
#endif
    STAMP(0);
#ifndef REPEAT_PHASE
#define REPEAT_PHASE -1
#define REPEAT_N 1
#endif
#define PHASE(k) if (lo <= (k) && (k) < hi) for (int rep_ = 0; rep_ < ((k) == REPEAT_PHASE ? REPEAT_N : 1); ++rep_)
#define SEAM(k) do { if (lo <= (k) && (k) + 1 < hi) xcd_barrier(xbar); } while (0)
    PHASE(0) phase0(P);
    SEAM(0); STAMP(1);
    PHASE(1) { pg8::EpiBf16<0> E; E.O = (bf16_t*)(ws + WS_P); E.ldc = NPAD; E.bias = nullptr; E.split_cols = 0; E.split_stride = 0;
        run_gemm(lds, (const bf16_t*)(ws + WS_H0B), (const bf16_t*)(ws + WS_WTIN), MROWS, NPAD, 2048, E); }
    SEAM(1); STAMP(2);
    PHASE(2) phase2(P, lds);
    SEAM(2); STAMP(3);
    PHASE(3) phase3(P);
    SEAM(3); STAMP(4);
    PHASE(4) phase3b(P, lds);
    SEAM(4); STAMP(5);
    PHASE(5) {
        { pg8::EpiGateA E; E.C = (float*)(ws + WS_MPART); E.p = (const bf16_t*)(ws + WS_P); E.bgate = P.in[I_BGATE];
          run_gemm(lds, (const bf16_t*)(ws + WS_YA), (const bf16_t*)(ws + WS_WTA), NTOK, 2048, 2048, E); }
        { pg8::EpiGateB E; E.C = (const float*)(ws + WS_MPART); E.O = (bf16_t*)(ws + WS_MERGED); E.p = (const bf16_t*)(ws + WS_P); E.bgate = P.in[I_BGATE];
          run_gemm(lds, (const bf16_t*)(ws + WS_YB), (const bf16_t*)(ws + WS_WTB), NTOK, 2048, 1024, E); }
    }
    SEAM(5); STAMP(6);
    PHASE(6) { pg8::EpiResid E; E.C = (float*)(ws + WS_X1); E.h0 = (const bf16_t*)(ws + WS_H0B); E.alpha = DN_ALPHA;
        run_gemm(lds, (const bf16_t*)(ws + WS_MERGED), (const bf16_t*)(ws + WS_WTOUT), NTOK, 2048, 2048, E); }
    SEAM(6); STAMP(7);
    PHASE(7) phase5b(P);
    SEAM(7); STAMP(8);
    PHASE(8) { pg8::EpiBf16<0> E; E.O = (bf16_t*)(ws + WS_Q); E.ldc = D; E.bias = nullptr; E.split_cols = 0; E.split_stride = 0;
        run_gemm(lds, (const bf16_t*)(ws + WS_H1B), (const bf16_t*)(ws + WS_WTQ), NTOK, 2048, 2048, E); }
    SEAM(8); STAMP(9);
    PHASE(9) phase7(P, lds);
#ifdef DBG_TA
    {
        __threadfence_system(); asm volatile("s_waitcnt vmcnt(0) lgkmcnt(0)" ::: "memory"); __syncthreads(); grid.sync(); __threadfence_system();
        STAMP(11);
        const unsigned long long tt[12] = {ts0, ts1, ts2, ts3, ts4, ts5, ts6, ts7, ts8, ts9, ts9, ts11};
        const float ta = (float)(tt[DBG_TA + 1] - tt[DBG_TA]) * 0.01f, tb = (float)(tt[DBG_TB + 1] - tt[DBG_TB]) * 0.01f;
        if (blockIdx.x == 0) { for (int i = threadIdx.x + 1; i <= 1000000; i += 512) P.out[i] = tb; if (threadIdx.x == 0) P.out[0] = 1000.0f * ta; }
    }
#endif
#ifdef DBG_STOP
    {
        __threadfence_system(); asm volatile("s_waitcnt vmcnt(0) lgkmcnt(0)" ::: "memory"); __syncthreads(); grid.sync(); __threadfence_system();
        const size_t a = DBG_A, b = DBG_B; const unsigned* w = (const unsigned*)(ws + a); const size_t nw = (b - a) / 4, NO = (size_t)NTOK * D;
        for (size_t i = (size_t)blockIdx.x * 512 + threadIdx.x; i < NO; i += (size_t)gridDim.x * 512) {
            unsigned acc = 0; for (size_t j = i; j < nw; j += NO) { const unsigned x = w[j]; acc += (x & 0xffffu) + (x >> 16); }
            P.out[i] = (float)(acc & 0xfffffu);
        }
    }
#endif
#undef PHASE
#undef SEAM
}

extern "C" void kernel_launch(void* const* d_in, const int* in_sizes, int n_in, void* d_out, int out_size, void* d_ws, size_t ws_size, hipStream_t stream) {
    static int grid = 0;
    if (grid == 0) {
        if (n_in != 30 || out_size != NTOK * D || ws_size < WS_END) { fprintf(stderr, "kernel_launch: unexpected shapes (n_in %d, out %d, ws %zu < %zu)\n", n_in, out_size, ws_size, (size_t)WS_END); grid = -1; return; }
        int dev = 0, cus = 0, per_cu = 0;
        if (hipGetDevice(&dev) != hipSuccess || hipDeviceGetAttribute(&cus, hipDeviceAttributeMultiprocessorCount, dev) != hipSuccess) { grid = -1; return; }
        if (hipFuncSetAttribute((const void*)hybrid_fwd, hipFuncAttributeMaxDynamicSharedMemorySize, LDS_BYTES) != hipSuccess) { fprintf(stderr, "kernel_launch: hipFuncSetAttribute failed\n"); grid = -1; return; }
        if (hipOccupancyMaxActiveBlocksPerMultiprocessor(&per_cu, (const void*)hybrid_fwd, 512, LDS_BYTES) != hipSuccess || per_cu < 1) { fprintf(stderr, "kernel_launch: occupancy query says %d\n", per_cu); grid = -1; return; }
        (void)hipGetLastError();
        grid = cus;
    }
    if (grid < 0) return;
    if (hipMemsetAsync((unsigned char*)d_ws + WS_BAR, 0, XCD_BAR_WORDS * 4, stream) != hipSuccess) { fprintf(stderr, "kernel_launch: memset failed\n"); return; }
    Params p{};
    for (int i = 0; i < 30; ++i) p.in[i] = (const float*)d_in[i];
    p.out = (float*)d_out; p.ws = (unsigned char*)d_ws;
#if MK_MULTI
    for (int ph = 0; ph <= NPHASE; ++ph) { p.ph_lo = ph; p.ph_hi = ph + 1; hipLaunchKernelGGL(hybrid_fwd, dim3(grid), dim3(512), LDS_BYTES, stream, p); }
#else
    p.ph_lo = 0; p.ph_hi = NPHASE + 1;
#ifdef DBG_STOP
    p.ph_hi = DBG_STOP + 1;
#endif
    void* args[] = {&p};
    hipError_t e = hipLaunchCooperativeKernel((const void*)hybrid_fwd, dim3(grid), dim3(512), args, LDS_BYTES, stream);
    if (e != hipSuccess) fprintf(stderr, "kernel_launch: cooperative launch failed: %s (grid %d)\n", hipGetErrorString(e), grid);
#endif
}
```

```cpp
#include <hip/hip_runtime.h>
#include <hip/hip_cooperative_groups.h>
#include <cstdio>
#include <cstdint>
namespace cg = cooperative_groups;
namespace pg8 {
#define PG8_LAS __attribute__((address_space(3)))
typedef unsigned short bf16_t;
typedef short bf16x8 __attribute__((ext_vector_type(8)));
typedef float f32x4 __attribute__((ext_vector_type(4)));
typedef unsigned u32x4 __attribute__((ext_vector_type(4)));
constexpr int BM = 256, BK = 64, HALF = 128, HTB = HALF * BK * 2  , STAGE_BYTES = 8 * HTB, NXCD = 8, WGM = 8;

__host__ __device__ __forceinline__ int lds_byte(int r, int c) { const int st = (r >> 4) * 2 + (c >> 5), rr = r & 15, cc = c & 31, ob = rr * 64 + cc * 2; return st * 1024 + (ob ^ (((ob >> 9) & 1) << 5)); }
__host__ __device__ __forceinline__ void stage_rc(int b, int& R, int& C) { const int st = b / 1024, sb = b % 1024, swz = sb ^ (((sb >> 9) & 1) << 5); R = (st >> 1) * 16 + swz / 64; C = (st & 1) * 32 + (swz % 64) / 2; }
__host__ __device__ __forceinline__ int perm32(int rho) { const int n = rho >> 4, i = rho & 15; return 8 * (i >> 2) + 4 * n + (i & 3); }

struct Unit { int pm, pn; };
struct Gemm { const bf16_t* A; const bf16_t* Bt; int M, N, K; };

struct StaticOrder {
    int nM, nN, nwg, G, c;
    __host__ __device__ void init(int M, int N, int G_, int c_) { nM = M / BM; nN = N / BM; nwg = nM * nN; G = G_; c = c_; }
    __host__ __device__ bool next(int i, Unit& u) const {
        const long L = (long)i * G + c; if (L >= nwg) return false;
        int wgid = (int)L; { const int q = nwg / NXCD, r = nwg % NXCD, xcd = wgid % NXCD, off = wgid / NXCD; wgid = (xcd < r ? xcd * (q + 1) : r * (q + 1) + (xcd - r) * q) + off; }
        const int nig = WGM * nN, gid = wgid / nig, fm = gid * WGM, gsz = (nM - fm) < WGM ? (nM - fm) : WGM;
        u.pm = fm + ((wgid % nig) % gsz); u.pn = (wgid % nig) / gsz; return true;
    }
    __device__ __forceinline__ void a_ready(const Unit&) const {}
    __device__ __forceinline__ void done(const Unit&) const {}
};
struct CountedOrder : StaticOrder {
    const unsigned* ready; unsigned need; unsigned* tmo;
    __device__ __forceinline__ void a_ready(const Unit& u) const {
        if (threadIdx.x < 64) {
            const unsigned long long t0 = __builtin_amdgcn_s_memrealtime(); unsigned polls = 0;
            while ((unsigned)__builtin_amdgcn_readfirstlane(__hip_atomic_load(ready + 64 * u.pm, __ATOMIC_RELAXED, __HIP_MEMORY_SCOPE_AGENT)) < need) {
                if ((++polls & 255u) == 0u && __builtin_amdgcn_readfirstlane(__hip_atomic_load(tmo, __ATOMIC_RELAXED, __HIP_MEMORY_SCOPE_AGENT)) != 0u) break;
                if (__builtin_amdgcn_s_memrealtime() - t0 > 2000000ull) {
                    if (threadIdx.x == 0) { unsigned expect = 0u; __hip_atomic_compare_exchange_strong(tmo + 1, &expect, 0x600u | (unsigned)(u.pm & 0xff), __ATOMIC_RELAXED, __ATOMIC_RELAXED, __HIP_MEMORY_SCOPE_AGENT); __hip_atomic_store(tmo, 1u, __ATOMIC_RELAXED, __HIP_MEMORY_SCOPE_AGENT); }
                    break; }
                __builtin_amdgcn_s_sleep(2); }
            __builtin_amdgcn_fence(__ATOMIC_ACQUIRE, "agent");
            asm volatile("s_waitcnt vmcnt(0)" ::: "memory");
        }
#if !defined(BROKEN_HOOK_NO_BARRIER)
        asm volatile("" ::: "memory"); __builtin_amdgcn_s_barrier(); asm volatile("" ::: "memory");
#endif
    }
};

typedef float cvt_f32x2 __attribute__((ext_vector_type(2))); typedef __bf16 cvt_bf16x2 __attribute__((ext_vector_type(2)));
__device__ __forceinline__ unsigned cvt_pk_bf16(float lo, float hi) { const cvt_f32x2 v = {lo, hi}; const cvt_bf16x2 b = __builtin_convertvector(v, cvt_bf16x2); return __builtin_bit_cast(unsigned, b); }
typedef float f32x2 __attribute__((ext_vector_type(2)));
__device__ __forceinline__ f32x2 gelu_pk(f32x2 v) {
    const f32x2 av = __builtin_elementwise_abs(v), d = av * 0.2316418882f + 1.0f;
    f32x2 t; t.x = __builtin_amdgcn_rcpf(d.x); t.y = __builtin_amdgcn_rcpf(d.y);
    f32x2 q = t * 0.5307027145f + (-0.7265760135f); q = q * t + 0.7107068705f; q = q * t + (-0.142248368f); q = q * t + 0.127414796f; q = q * t;
    const f32x2 s = (v * v) * (-0.72134752044f);
    f32x2 e; e.x = __builtin_amdgcn_exp2f(s.x); e.y = __builtin_amdgcn_exp2f(s.y);
    const f32x2 m = v * (q * e), r = v - m;
    f32x2 o; o.x = v.x < 0.f ? m.x : r.x; o.y = v.y < 0.f ? m.y : r.y; return o;
}

struct EpiF32 {
    static constexpr bool PERM = false, AFTER_DRAIN = false;
    float* C; int ldc; const float* bias;
    __device__ __forceinline__ void operator()(const f32x4 (&acc)[2][2][4][2], const Unit& u, int wr, int wc, int fr, int fq) const {
        const int row0 = u.pm * BM + wr * 64 + fr, col0 = u.pn * BM + wc * 32 + 4 * fq;
        f32x4 bv[2][2];
#pragma unroll
        for (int bj = 0; bj < 2; ++bj)
#pragma unroll
            for (int n = 0; n < 2; ++n) bv[bj][n] = bias ? *(const f32x4*)(bias + col0 + bj * HALF + n * 16) : (f32x4){0.f, 0.f, 0.f, 0.f};
#pragma unroll
        for (int ai = 0; ai < 2; ++ai)
#pragma unroll
            for (int m = 0; m < 4; ++m) { float* rowp = C + (size_t)(row0 + ai * HALF + m * 16) * ldc + col0;
#pragma unroll
                for (int bj = 0; bj < 2; ++bj)
#pragma unroll
                    for (int n = 0; n < 2; ++n) *(f32x4*)(rowp + bj * HALF + n * 16) = acc[ai][bj][m][n] + bv[bj][n]; }
    }
};
template <int ACT  > struct EpiBf16 {
    static constexpr bool PERM = true, AFTER_DRAIN = false;
    bf16_t* O; int ldc; const float* bias; int split_cols; size_t split_stride;
    __device__ __forceinline__ void operator()(const f32x4 (&acc)[2][2][4][2], const Unit& u, int wr, int wc, int fr, int fq) const {
        const int row0 = u.pm * BM + wr * 64 + fr; int colt = u.pn * BM; bf16_t* base = O;
        if (split_cols) { const int t = colt / split_cols; base += (size_t)t * split_stride; colt -= t * split_cols; }
        const int col0 = colt + wc * 32 + 8 * fq, bcol0 = u.pn * BM + wc * 32 + 8 * fq;
        f32x4 bv[2][2];
#pragma unroll
        for (int bj = 0; bj < 2; ++bj)
#pragma unroll
            for (int n = 0; n < 2; ++n) bv[bj][n] = bias ? *(const f32x4*)(bias + bcol0 + bj * HALF + 4 * n) : (f32x4){0.f, 0.f, 0.f, 0.f};
#pragma unroll
        for (int ai = 0; ai < 2; ++ai)
#pragma unroll
            for (int m = 0; m < 4; ++m) { bf16_t* rowp = base + (size_t)(row0 + ai * HALF + m * 16) * ldc + col0;
#pragma unroll
                for (int bj = 0; bj < 2; ++bj) { f32x4 v0 = acc[ai][bj][m][0] + bv[bj][0], v1 = acc[ai][bj][m][1] + bv[bj][1];
                    if (ACT == 1) { f32x2 a = gelu_pk((f32x2){v0[0], v0[1]}), b = gelu_pk((f32x2){v0[2], v0[3]}), c = gelu_pk((f32x2){v1[0], v1[1]}), d = gelu_pk((f32x2){v1[2], v1[3]});
                        v0 = (f32x4){a.x, a.y, b.x, b.y}; v1 = (f32x4){c.x, c.y, d.x, d.y}; }
                    if (ACT == 2) {
#pragma unroll
                        for (int j = 0; j < 4; ++j) { v0[j] = 0.5f * v0[j] * (1.0f + erff(v0[j] * 0.70710678f)); v1[j] = 0.5f * v1[j] * (1.0f + erff(v1[j] * 0.70710678f)); } }
                    u32x4 w; w.x = cvt_pk_bf16(v0[0], v0[1]); w.y = cvt_pk_bf16(v0[2], v0[3]); w.z = cvt_pk_bf16(v1[0], v1[1]); w.w = cvt_pk_bf16(v1[2], v1[3]);
                    *(u32x4*)(rowp + bj * HALF) = w; } }
    }
};
template <class Epi, class Sched, bool STAMP = false>
__device__ __forceinline__ void gemm_phase(PG8_LAS unsigned char* lds, const Gemm g, const Sched& S, const Epi& E, unsigned long long* stamps) {
    const int tid = threadIdx.x, wid = __builtin_amdgcn_readfirstlane(tid >> 6), lane = tid & 63, wr = wid >> 2, wc = wid & 3, fr = lane & 15, fq = lane >> 4;
    const int K = g.K, nt = K / BK;
    int ts_lo = 0, ts_hi = 0, nts = 0; const unsigned long long rt_entry = STAMP ? (unsigned long long)wall_clock64() : 0ull;
#define PG8_STAMP() do { if (STAMP && wid == 0 && nts < 64) { const unsigned long long _c = (unsigned long long)clock64(); \
        ts_lo = (lane == nts) ? (int)(unsigned)_c : ts_lo; ts_hi = (lane == nts) ? (int)(unsigned)(_c >> 32) : ts_hi; ++nts; } } while (0)
    PG8_STAMP();
    unsigned voffA[2], voffB[2];
#pragma unroll
    for (int i = 0; i < 2; ++i) { int R, C; stage_rc(tid * 16 + i * 8192, R, C); const int Rb = Epi::PERM ? ((R & ~31) + perm32(R & 31)) : R;
        voffA[i] = (unsigned)(R * K + C) * 2u; voffB[i] = (unsigned)(Rb * K + C) * 2u; }
    const size_t kstep = (size_t)(BK * 2);
    const size_t hstep = (size_t)HALF * K * 2;
    const size_t tstep = 2 * hstep;
    const unsigned ldsw = (unsigned)wid * 1024u;
    const int aoff = lds_byte(wr * 64 + fr, fq * 8), boff = lds_byte(wc * 32 + fr, fq * 8);
#define PG8_SA(b, h) (((b) * 2 + (h)) * HTB)
#define PG8_SB(b, h) ((4 + (b) * 2 + (h)) * HTB)
#define PG8_STAGE(bufoff, gbase, voff) do { _Pragma("unroll") for (int _i = 0; _i < 2; ++_i) \
        __builtin_amdgcn_global_load_lds((const unsigned*)((const char*)(gbase) + (voff)[_i]), (PG8_LAS unsigned*)(lds + (bufoff) + ldsw + _i * 8192), 16, 0, 0); } while (0)
#define PG8_LDA(dst, b, h) do { _Pragma("unroll") for (int m = 0; m < 4; ++m) _Pragma("unroll") for (int k = 0; k < 2; ++k) dst[m][k] = *(const PG8_LAS bf16x8*)(lds + PG8_SA(b, h) + aoff + m * 2048 + k * 1024); } while (0)
#define PG8_LDB(dst, b, h) do { _Pragma("unroll") for (int n = 0; n < 2; ++n) _Pragma("unroll") for (int k = 0; k < 2; ++k) dst[n][k] = *(const PG8_LAS bf16x8*)(lds + PG8_SB(b, h) + boff + n * 2048 + k * 1024); } while (0)
#define PG8_MMA(ai, bj, At, Bt) do { __builtin_amdgcn_s_setprio(1); _Pragma("unroll") for (int m = 0; m < 4; ++m) _Pragma("unroll") for (int n = 0; n < 2; ++n) _Pragma("unroll") for (int k = 0; k < 2; ++k) \
        acc[ai][bj][m][n] = __builtin_amdgcn_mfma_f32_16x16x32_bf16(Bt[n][k], At[m][k], acc[ai][bj][m][n], 0, 0, 0); __builtin_amdgcn_s_setprio(0); } while (0)
#define PG8_WAIT_V(n) asm volatile("s_waitcnt vmcnt(" #n ")" ::: "memory")
#define PG8_WAIT_L(n) asm volatile("s_waitcnt lgkmcnt(" #n ")" ::: "memory")
#define PG8_BAR __builtin_amdgcn_s_barrier()
#define PG8_SCHED __builtin_amdgcn_sched_barrier(0)
    Unit cur, nxt; int ui = 0;
    if (!S.next(0, cur)) return;
    f32x4 acc[2][2][4][2];
#pragma unroll
    for (int a = 0; a < 2; ++a)
#pragma unroll
        for (int b = 0; b < 2; ++b)
#pragma unroll
            for (int m = 0; m < 4; ++m)
#pragma unroll
                for (int n = 0; n < 2; ++n) acc[a][b][m][n] = (f32x4){0.f, 0.f, 0.f, 0.f};
    bf16x8 At[4][2], B0[2][2], B1[2][2];
    const char* cA = (const char*)g.A + (size_t)cur.pm * tstep; const char* cB = (const char*)g.Bt + (size_t)cur.pn * tstep;
    S.a_ready(cur);
    PG8_STAGE(PG8_SB(0, 0), cB, voffB); PG8_STAGE(PG8_SA(0, 0), cA, voffA); PG8_STAGE(PG8_SB(0, 1), cB + hstep, voffB); PG8_STAGE(PG8_SA(0, 1), cA + hstep, voffA);
    if (wr == 1) PG8_BAR;
    PG8_WAIT_V(4); PG8_BAR;
    PG8_STAGE(PG8_SB(1, 0), cB + kstep, voffB); PG8_STAGE(PG8_SA(1, 0), cA + kstep, voffA); PG8_STAGE(PG8_SB(1, 1), cB + hstep + kstep, voffB);
    PG8_WAIT_V(6); PG8_BAR;
    PG8_STAMP();
    for (;;) {
        const bool has_next = S.next(ui + 1, nxt);
        const char* nA = has_next ? (const char*)g.A + (size_t)nxt.pm * tstep : cA; const char* nB = has_next ? (const char*)g.Bt + (size_t)nxt.pn * tstep : cB;
        for (int t = 0; t < nt; t += 2) {
            const bool last = (t == nt - 2);
            const char* a1 = cA + (size_t)(t + 1) * kstep;
            const char* a2 = last ? nA : cA + (size_t)(t + 2) * kstep; const char* b2 = last ? nB : cB + (size_t)(t + 2) * kstep;
            const char* a3 = a2 + kstep; const char* b3 = b2 + kstep;
            if (last && has_next) S.a_ready(nxt);
            PG8_LDB(B0, 0, 0); PG8_SCHED; PG8_LDA(At, 0, 0); PG8_STAGE(PG8_SA(1, 1), a1 + hstep, voffA);
            PG8_WAIT_L(8); PG8_BAR; PG8_WAIT_L(0); PG8_MMA(0, 0, At, B0); PG8_BAR; PG8_SCHED;
            PG8_LDB(B1, 0, 1); PG8_STAGE(PG8_SB(0, 0), b2, voffB);
            PG8_BAR; PG8_WAIT_L(0); PG8_MMA(0, 1, At, B1); PG8_BAR;
            PG8_LDA(At, 0, 1); PG8_STAGE(PG8_SA(0, 0), a2, voffA);
            PG8_BAR; PG8_WAIT_L(0); PG8_MMA(1, 0, At, B0); PG8_BAR; PG8_SCHED;
            PG8_STAGE(PG8_SB(0, 1), b2 + hstep, voffB);
            PG8_WAIT_V(6); PG8_BAR; PG8_MMA(1, 1, At, B1); PG8_BAR;
            PG8_LDB(B0, 1, 0); PG8_SCHED; PG8_LDA(At, 1, 0); PG8_STAGE(PG8_SA(0, 1), a2 + hstep, voffA);
            PG8_WAIT_L(8); PG8_BAR; PG8_WAIT_L(0); PG8_MMA(0, 0, At, B0); PG8_BAR; PG8_SCHED;
            PG8_LDB(B1, 1, 1); PG8_STAGE(PG8_SB(1, 0), b3, voffB);
            PG8_BAR; PG8_WAIT_L(0); PG8_MMA(0, 1, At, B1); PG8_BAR;
            PG8_LDA(At, 1, 1); PG8_STAGE(PG8_SA(1, 0), a3, voffA);
            PG8_BAR; PG8_WAIT_L(0); PG8_MMA(1, 0, At, B0); PG8_BAR; PG8_SCHED;
            PG8_STAGE(PG8_SB(1, 1), b3 + hstep, voffB);
            PG8_WAIT_V(6); PG8_BAR; PG8_MMA(1, 1, At, B1); PG8_BAR;
        }
        PG8_STAMP();
        if constexpr (!Epi::AFTER_DRAIN) { E(acc, cur, wr, wc, fr, fq); S.done(cur); }
        PG8_STAMP();
        if (!has_next) break;
#pragma unroll
        for (int a = 0; a < 2; ++a)
#pragma unroll
            for (int b = 0; b < 2; ++b)
#pragma unroll
                for (int m = 0; m < 4; ++m)
#pragma unroll
                    for (int n = 0; n < 2; ++n) acc[a][b][m][n] = (f32x4){0.f, 0.f, 0.f, 0.f};
        cur = nxt; cA = nA; cB = nB; ++ui;
    }
    PG8_WAIT_V(0);
    if (wr == 0) PG8_BAR;
    PG8_BAR;
    if constexpr (Epi::AFTER_DRAIN) { E.fused(acc, cur, wr, wc, fr, fq, lds, wid, lane); S.done(cur); }
    PG8_STAMP();
    if (STAMP && wid == 0) { stamps[lane] = lane < nts ? (((unsigned long long)(unsigned)ts_hi << 32) | (unsigned)ts_lo) : 0ull;
        if (lane == 62) stamps[62] = rt_entry; if (lane == 63) stamps[63] = (unsigned long long)wall_clock64(); }
#undef PG8_STAMP
#undef PG8_SA
#undef PG8_SB
#undef PG8_STAGE
#undef PG8_LDA
#undef PG8_LDB
#undef PG8_MMA
#undef PG8_WAIT_V
#undef PG8_WAIT_L
#undef PG8_BAR
#undef PG8_SCHED
}
}
#define LAS __attribute__((address_space(3)))
typedef unsigned short bf16_t;
typedef short bf16x8 __attribute__((ext_vector_type(8)));
typedef float f32x4 __attribute__((ext_vector_type(4)));
typedef float f32x2 __attribute__((ext_vector_type(2)));
typedef unsigned u32x4 __attribute__((ext_vector_type(4)));
typedef unsigned u32x2 __attribute__((ext_vector_type(2)));
typedef LAS unsigned char* ldsp;
typedef float f32x32 __attribute__((ext_vector_type(32)));
typedef float f32x16 __attribute__((ext_vector_type(16)));
typedef unsigned u32x6 __attribute__((ext_vector_type(6)));

constexpr int D = 2048, NTOK = 8192, SEQ = 4096, MROWS = 8448, ROW_META = 8192;
constexpr int INC = 11712, NPAD = 11776;
constexpr int C_R = 0, C_K = 2048, C_V = 4096, C_WL = 6144, C_AL = 6240, C_GL = 6336, C_POOL = 6592, C_G0 = 7616, C_G1 = 9664;
constexpr int NUNITS = 4128;
constexpr float DSCALE = 0.6065306597126334f;
constexpr float DN_ALPHA = 1.189207115002721f;
constexpr float GN_EPS = 64e-5f, LN_EPS = 1e-5f;

constexpr size_t WS_P = 0;
constexpr size_t WS_H0B = 198967296;
constexpr size_t WS_WTA = WS_H0B + 34603008;
constexpr size_t WS_WTB = WS_WTA + 8388608;
constexpr size_t WS_WTOUT = WS_WTB + 4194304;
constexpr size_t WS_WTQ = WS_WTOUT + 8388608;
constexpr size_t WS_WTPOOL = WS_WTQ + 8388608;
constexpr size_t WS_WTW2 = WS_WTPOOL + 524288;
constexpr size_t WS_WTA2 = WS_WTW2 + 393216;
constexpr size_t WS_WTG2 = WS_WTA2 + 393216;
constexpr size_t WS_SUBK = WS_WTG2 + 1048576;
constexpr size_t WS_BONUS = WS_SUBK + 65536;
constexpr size_t WS_REGC = WS_BONUS + 1048576;
constexpr size_t WS_WTIN = WS_REGC;
constexpr size_t UNITB = (size_t)NUNITS * 4096 * 2;
constexpr size_t WS_G = WS_REGC;
constexpr size_t WS_H0T = WS_REGC + UNITB;
constexpr size_t WS_RT = WS_REGC + 2 * UNITB;
constexpr size_t WS_Y0 = WS_REGC + 3 * UNITB;
constexpr size_t WS_S0T = WS_REGC + 4 * UNITB;
constexpr size_t WS_YA = WS_REGC;
constexpr size_t WS_MERGED = WS_REGC + UNITB;
constexpr size_t WS_MPART = WS_REGC + 2 * UNITB;
constexpr size_t WS_X1 = WS_REGC + 2 * UNITB;
constexpr size_t WS_H1B = WS_REGC;
constexpr size_t WS_Q = WS_REGC + 4 * UNITB;
constexpr size_t TROW = 1536;
constexpr size_t WS_VB = WS_REGC + 5 * UNITB;
constexpr size_t WS_YB = WS_VB + 16384 * TROW;
constexpr size_t WS_GSIG = WS_YB + 16777216;
constexpr size_t WS_BAR = WS_GSIG + 4194304;
constexpr size_t WS_TSC = WS_BAR + 16384;
constexpr size_t UROW = 1024;
constexpr size_t WS_UB = WS_TSC + 131072;
constexpr size_t WS_END = WS_UB + 16384 * UROW;
static_assert(WS_X1 + 67108864 <= WS_Q, "overlay");
static_assert(WS_MPART + 67108864 <= WS_S0T, "overlay");

constexpr int LDS_BYTES = 163840;
constexpr int NPHASE = 9;

struct Params {
    const float* in[30];
    float* out;
    unsigned char* ws;
    int ph_lo, ph_hi;
};
enum { I_X = 0, I_META, I_LNIN_G, I_LNIN_B, I_WIN, I_MU, I_W0, I_WW2, I_A0, I_WA2, I_WG2, I_KK, I_KA, I_RK, I_GNG, I_GNB, I_WPOOL, I_PSCALE, I_BGATE,
       I_WBA, I_WBB, I_WOUT, I_LN1G, I_LN1B, I_WQ, I_SUBK, I_UT, I_VT, I_LN2G, I_LN2B };

__device__ __forceinline__ unsigned pk2(float lo, float hi) { return pg8::cvt_pk_bf16(lo, hi); }
__device__ __forceinline__ float bflo(unsigned w) { return __uint_as_float(w << 16); }
__device__ __forceinline__ float bfhi(unsigned w) { return __uint_as_float(w & 0xffff0000u); }
__device__ __forceinline__ float bf1(bf16_t h) { return __uint_as_float(((unsigned)h) << 16); }
__device__ __forceinline__ bf16_t f2bf1(float f) { return (bf16_t)(pk2(f, f) & 0xffffu); }
__device__ __forceinline__ float wave_sum(float v) {
#pragma unroll
    for (int o = 1; o < 64; o <<= 1) v += __shfl_xor(v, o);
    return v;
}
__device__ __forceinline__ float sigmoidf_(float x) { return 1.0f / (1.0f + __expf(-x)); }
__device__ __forceinline__ f32x4 mfma16(bf16x8 a, bf16x8 b, f32x4 c) { return __builtin_amdgcn_mfma_f32_16x16x32_bf16(a, b, c, 0, 0, 0); }
__device__ __forceinline__ void unpack8(const u32x4 w, float* f) {
    f[0] = bflo(w.x); f[1] = bfhi(w.x); f[2] = bflo(w.y); f[3] = bfhi(w.y); f[4] = bflo(w.z); f[5] = bfhi(w.z); f[6] = bflo(w.w); f[7] = bfhi(w.w);
}
__device__ __forceinline__ u32x4 pack8(const float* f) { u32x4 w; w.x = pk2(f[0], f[1]); w.y = pk2(f[2], f[3]); w.z = pk2(f[4], f[5]); w.w = pk2(f[6], f[7]); return w; }
#define DPPF(v, ctrl) __builtin_bit_cast(float, __builtin_amdgcn_update_dpp(0, __builtin_bit_cast(int, (v)), (ctrl), 0xF, 0xF, true))
__device__ __forceinline__ float readlane_f(float v, int l) { return __builtin_bit_cast(float, __builtin_amdgcn_readlane(__builtin_bit_cast(int, v), l)); }
__device__ __forceinline__ float wave_sum_dpp(float v) {
    v += DPPF(v, 0xB1); v += DPPF(v, 0x4E); v += DPPF(v, 0x141); v += DPPF(v, 0x140);
    return (readlane_f(v, 0) + readlane_f(v, 16)) + (readlane_f(v, 32) + readlane_f(v, 48));
}
__device__ __forceinline__ float wave_max_dpp(float v) {
    v = fmaxf(v, DPPF(v, 0xB1)); v = fmaxf(v, DPPF(v, 0x4E)); v = fmaxf(v, DPPF(v, 0x141)); v = fmaxf(v, DPPF(v, 0x140));
    return fmaxf(fmaxf(readlane_f(v, 0), readlane_f(v, 16)), fmaxf(readlane_f(v, 32), readlane_f(v, 48)));
}
#define BLOCK_SYNC() __syncthreads()
#define XB_TMO      128
#define XB_XCNT(j)  (256  + 64 * (j))
#define XB_XSUB(j)  (1280 + 64 * (j))
#define XB_XGEN(j)  (2304 + 64 * (j))
#define XB_TOP      3328
#define XB_TOPGEN   3392
#define XCD_BAR_WORDS 3456
#define XB_SPIN_CAP (1u << 18)

__device__ __forceinline__ unsigned xb_ld(unsigned* p)              { return __hip_atomic_load(p, __ATOMIC_RELAXED, __HIP_MEMORY_SCOPE_AGENT); }
__device__ __forceinline__ unsigned xb_add(unsigned* p, unsigned v) { return __hip_atomic_fetch_add(p, v, __ATOMIC_RELAXED, __HIP_MEMORY_SCOPE_AGENT); }
__device__ __forceinline__ unsigned xb_xcc_id() { return (unsigned)__builtin_amdgcn_s_getreg((3 << 11) | 20) & 0xFu; }
#define XB_SPIN(cond, bar) do { unsigned _sp = 0; while (cond) { __builtin_amdgcn_s_sleep(1); \
    if ((++_sp & 255u) == 0u) { if (xb_ld(&(bar)[XB_TMO])) break; if (_sp > XB_SPIN_CAP) { atomicAdd(&(bar)[XB_TMO], 1u); break; } } } } while (0)

struct XcdBarrier {
    unsigned* bar; unsigned x;
    volatile LAS unsigned* st;
};

__device__ __forceinline__ XcdBarrier xcd_barrier_post(unsigned* bar, volatile LAS unsigned* st) {
    XcdBarrier b; b.bar = bar; b.x = xb_xcc_id(); b.st = st;
    if (threadIdx.x == 0) (void)xb_add(&bar[XB_XCNT(b.x)], 1u);
    return b;
}
__device__ __forceinline__ void xcd_barrier_complete(unsigned* bar, unsigned x, unsigned& nloc, unsigned& nx) {
    const unsigned G = gridDim.x * gridDim.y * gridDim.z;
    unsigned sum, cnt, mine, sp = 0u;
    for (;;) {
        sum = 0u; cnt = 0u; mine = 0u;
#pragma unroll
        for (unsigned j = 0; j < 16; ++j) { const unsigned c = xb_ld(&bar[XB_XCNT(j)]); sum += c; cnt += (c > 0u) ? 1u : 0u; mine = (j == x) ? c : mine; }
        if (sum == G) break;
        __builtin_amdgcn_s_sleep(1);
        if ((++sp & 255u) == 0u) { if (xb_ld(&bar[XB_TMO])) break; if (sp > XB_SPIN_CAP) { atomicAdd(&bar[XB_TMO], 1u); break; } }
    }
    nloc = mine > 0u ? mine : 1u; nx = cnt > 0u ? cnt : 1u;
}

__device__ __forceinline__ void xcd_barrier(const XcdBarrier& b) {
    asm volatile("s_waitcnt vmcnt(0)" ::: "memory");
    __syncthreads();
    if (threadIdx.x == 0) {
        unsigned* bar = b.bar;
        __builtin_amdgcn_s_waitcnt(0);
        unsigned nloc = b.st[0], nx = b.st[1];
        if (nloc == 0u) { xcd_barrier_complete(bar, b.x, nloc, nx); b.st[0] = nloc; b.st[1] = nx; }
        const unsigned old = xb_add(&bar[XB_XSUB(b.x)], 1u);
        const unsigned gen = old / nloc;
        if (old + 1u == (gen + 1u) * nloc) {
            __builtin_amdgcn_fence(__ATOMIC_RELEASE, "agent");
            asm volatile("s_waitcnt vmcnt(0)" ::: "memory");
            const unsigned og = xb_add(&bar[XB_TOP], 1u);
            const unsigned tg = og / nx;
            if (og + 1u == (tg + 1u) * nx) xb_add(&bar[XB_TOPGEN], 1u);
            else XB_SPIN(xb_ld(&bar[XB_TOPGEN]) == tg, bar);
            __builtin_amdgcn_fence(__ATOMIC_ACQUIRE, "agent");
            xb_add(&bar[XB_XGEN(b.x)], 1u);
            asm volatile("s_waitcnt vmcnt(0)" ::: "memory");
        } else {
            XB_SPIN(xb_ld(&bar[XB_XGEN(b.x)]) == gen, bar);
            __builtin_amdgcn_fence(__ATOMIC_ACQUIRE, "agent");
            asm volatile("s_waitcnt vmcnt(0)" ::: "memory");
        }
    }
    __syncthreads();
}

__device__ __forceinline__ void ln_row_bf16(const float* src, const float* g, const float* b, bf16_t* dst, int lane) {
    f32x4 v[8]; float s = 0.f;
#pragma unroll
    for (int j = 0; j < 8; ++j) { v[j] = ((const f32x4*)src)[lane + 64 * j]; s += (v[j].x + v[j].y) + (v[j].z + v[j].w); }
    const float mean = wave_sum(s) * (1.0f / D); float s2 = 0.f;
#pragma unroll
    for (int j = 0; j < 8; ++j) { v[j] = v[j] - mean; s2 += (v[j].x * v[j].x + v[j].y * v[j].y) + (v[j].z * v[j].z + v[j].w * v[j].w); }
    const float rstd = 1.0f / sqrtf(wave_sum(s2) * (1.0f / D) + LN_EPS);
#pragma unroll
    for (int j = 0; j < 8; ++j) {
        const f32x4 gg = ((const f32x4*)g)[lane + 64 * j], bb = ((const f32x4*)b)[lane + 64 * j];
        const f32x4 o = v[j] * rstd * gg + bb;
        u32x2 w; w.x = pk2(o.x, o.y); w.y = pk2(o.z, o.w);
        ((u32x2*)dst)[lane + 64 * j] = w;
    }
}
__device__ __forceinline__ void transpose_item(const float* W, int K, int N, int Npad, bf16_t* Wt, int item, int lane) {
    const int nblk = Npad >> 6, kb = item / nblk, nb = item - kb * nblk, n = nb * 64 + lane, k0 = kb * 32;
    float v[32];
    if (n < N) {
#pragma unroll
        for (int i = 0; i < 32; ++i) v[i] = W[(size_t)(k0 + i) * N + n];
    } else {
#pragma unroll
        for (int i = 0; i < 32; ++i) v[i] = 0.f;
    }
    u32x4* o = (u32x4*)(Wt + (size_t)n * K + k0);
#pragma unroll
    for (int c = 0; c < 4; ++c) { u32x4 w; w.x = pk2(v[8 * c], v[8 * c + 1]); w.y = pk2(v[8 * c + 2], v[8 * c + 3]); w.z = pk2(v[8 * c + 4], v[8 * c + 5]); w.w = pk2(v[8 * c + 6], v[8 * c + 7]); o[c] = w; }
}
__device__ __forceinline__ void phase0(const Params& P) {
    const int lane = threadIdx.x & 63, wave = threadIdx.x >> 6;
    const int gw = blockIdx.x * 8 + wave, NGW = gridDim.x * 8;
    unsigned char* ws = P.ws;
    constexpr int T_IN = 64 * 184, T_A = 64 * 32, T_B = 32 * 32, T_O = 64 * 32, T_Q = 64 * 32, T_POOL = 4 * 32, T_W2 = 3 * 32, T_A2 = 3 * 32, T_G2 = 8 * 32;
    constexpr int T_LN = MROWS, T_SK = 64;
    constexpr int NIT = T_IN + T_A + T_B + T_O + T_Q + T_POOL + T_W2 + T_A2 + T_G2 + T_LN + T_SK;
    for (int it = gw; it < NIT; it += NGW) {
        int r = it;
        if (r < T_IN) { transpose_item(P.in[I_WIN], 2048, INC, NPAD, (bf16_t*)(ws + WS_WTIN), r, lane); continue; } r -= T_IN;
        if (r < T_A) { transpose_item(P.in[I_WBA], 2048, 2048, 2048, (bf16_t*)(ws + WS_WTA), r, lane); continue; } r -= T_A;
        if (r < T_B) { transpose_item(P.in[I_WBB], 1024, 2048, 2048, (bf16_t*)(ws + WS_WTB), r, lane); continue; } r -= T_B;
        if (r < T_O) { transpose_item(P.in[I_WOUT], 2048, 2048, 2048, (bf16_t*)(ws + WS_WTOUT), r, lane); continue; } r -= T_O;
        if (r < T_Q) { transpose_item(P.in[I_WQ], 2048, 2048, 2048, (bf16_t*)(ws + WS_WTQ), r, lane); continue; } r -= T_Q;
        if (r < T_POOL) { const int g = r >> 5; transpose_item(P.in[I_WPOOL] + g * 65536, 256, 256, 256, (bf16_t*)(ws + WS_WTPOOL) + g * 65536, r & 31, lane); continue; } r -= T_POOL;
        if (r < T_W2) { transpose_item(P.in[I_WW2], 96, 2048, 2048, (bf16_t*)(ws + WS_WTW2), r, lane); continue; } r -= T_W2;
        if (r < T_A2) { transpose_item(P.in[I_WA2], 96, 2048, 2048, (bf16_t*)(ws + WS_WTA2), r, lane); continue; } r -= T_A2;
        if (r < T_G2) { transpose_item(P.in[I_WG2], 256, 2048, 2048, (bf16_t*)(ws + WS_WTG2), r, lane); continue; } r -= T_G2;
        if (r < T_LN) {
            bf16_t* dst = (bf16_t*)(ws + WS_H0B) + (size_t)r * D;
            if (r < NTOK) ln_row_bf16(P.in[I_X] + (size_t)r * D, P.in[I_LNIN_G], P.in[I_LNIN_B], dst, lane);
            else if (r < NTOK + 16) ln_row_bf16(P.in[I_META] + (size_t)(r - NTOK) * D, P.in[I_LNIN_G], P.in[I_LNIN_B], dst, lane);
            else {
#pragma unroll
                for (int j = 0; j < 8; ++j) ((u32x2*)dst)[lane + 64 * j] = (u32x2){0u, 0u};
            }
            continue;
        }
        r -= T_LN;
        {
            const float* s = P.in[I_SUBK] + r * 512 + lane * 8; float f[8];
#pragma unroll
            for (int i = 0; i < 8; ++i) f[i] = s[i];
            *(u32x4*)((bf16_t*)(ws + WS_SUBK) + r * 512 + lane * 8) = pack8(f);
        }
    }
}
namespace pg8 {
struct EpiGateA {
    static constexpr bool PERM = false, AFTER_DRAIN = false;
    float* C; const bf16_t* p; const float* bgate;
    __device__ __forceinline__ void operator()(const f32x4 (&acc)[2][2][4][2], const Unit& u, int wr, int wc, int fr, int fq) const {
        const int row0 = u.pm * BM + wr * 64 + fr, col0 = u.pn * BM + wc * 32 + 4 * fq;
#pragma unroll
        for (int ai = 0; ai < 2; ++ai)
#pragma unroll
            for (int m = 0; m < 4; ++m) { const size_t row = (size_t)(row0 + ai * HALF + m * 16);
#pragma unroll
                for (int bj = 0; bj < 2; ++bj)
#pragma unroll
                    for (int n = 0; n < 2; ++n) { const int col = col0 + bj * HALF + n * 16;
                        const u32x2 pw = *(const u32x2*)(p + row * NPAD + C_G0 + col); const f32x4 bg = *(const f32x4*)(bgate + col);
                        f32x4 g; g.x = sigmoidf_(bflo(pw.x) + bg.x); g.y = sigmoidf_(bfhi(pw.x) + bg.y); g.z = sigmoidf_(bflo(pw.y) + bg.z); g.w = sigmoidf_(bfhi(pw.y) + bg.w);
                        *(f32x4*)(C + row * D + col) = acc[ai][bj][m][n] * g; } }
    }
};
struct EpiGateB {
    static constexpr bool PERM = false, AFTER_DRAIN = false;
    const float* C; bf16_t* O; const bf16_t* p; const float* bgate;
    __device__ __forceinline__ void operator()(const f32x4 (&acc)[2][2][4][2], const Unit& u, int wr, int wc, int fr, int fq) const {
        const int row0 = u.pm * BM + wr * 64 + fr, col0 = u.pn * BM + wc * 32 + 4 * fq;
#pragma unroll
        for (int ai = 0; ai < 2; ++ai)
#pragma unroll
            for (int m = 0; m < 4; ++m) { const size_t row = (size_t)(row0 + ai * HALF + m * 16);
#pragma unroll
                for (int bj = 0; bj < 2; ++bj)
#pragma unroll
                    for (int n = 0; n < 2; ++n) { const int col = col0 + bj * HALF + n * 16;
                        const u32x2 pw = *(const u32x2*)(p + row * NPAD + C_G1 + col); const f32x4 bg = *(const f32x4*)(bgate + D + col);
                        f32x4 g; g.x = sigmoidf_(bflo(pw.x) + bg.x); g.y = sigmoidf_(bfhi(pw.x) + bg.y); g.z = sigmoidf_(bflo(pw.y) + bg.z); g.w = sigmoidf_(bfhi(pw.y) + bg.w);
                        const f32x4 o = *(const f32x4*)(C + row * D + col) + acc[ai][bj][m][n] * g;
                        u32x2 w; w.x = cvt_pk_bf16(o.x, o.y); w.y = cvt_pk_bf16(o.z, o.w);
                        *(u32x2*)(O + row * D + col) = w; } }
    }
};
struct EpiResid {
    static constexpr bool PERM = false, AFTER_DRAIN = false;
    float* C; const bf16_t* h0; float alpha;
    __device__ __forceinline__ void operator()(const f32x4 (&acc)[2][2][4][2], const Unit& u, int wr, int wc, int fr, int fq) const {
        const int row0 = u.pm * BM + wr * 64 + fr, col0 = u.pn * BM + wc * 32 + 4 * fq;
#pragma unroll
        for (int ai = 0; ai < 2; ++ai)
#pragma unroll
            for (int m = 0; m < 4; ++m) { const size_t row = (size_t)(row0 + ai * HALF + m * 16);
#pragma unroll
                for (int bj = 0; bj < 2; ++bj)
#pragma unroll
                    for (int n = 0; n < 2; ++n) { const int col = col0 + bj * HALF + n * 16;
                        const u32x2 hw = *(const u32x2*)(h0 + row * D + col);
                        f32x4 hv; hv.x = bflo(hw.x); hv.y = bfhi(hw.x); hv.z = bflo(hw.y); hv.w = bfhi(hw.y);
                        *(f32x4*)(C + row * D + col) = hv * alpha + acc[ai][bj][m][n]; } }
    }
};
}
template <class Epi>
__device__ __forceinline__ void run_gemm(ldsp lds, const bf16_t* A, const bf16_t* Bt, int M, int N, int K, const Epi& E) {
    pg8::Gemm g; g.A = A; g.Bt = Bt; g.M = M; g.N = N; g.K = K;
    pg8::StaticOrder S; S.init(M, N, (int)gridDim.x, (int)blockIdx.x);
    pg8::gemm_phase<Epi, pg8::StaticOrder, false>(lds, g, S, E, nullptr);
}
constexpr int CONV_P2_ROWS = 0;
__device__ __forceinline__ void convert_tables(const Params& P, int r0, int rend, int stride) {
    const int lane = threadIdx.x & 63;
    unsigned char* ws = P.ws;
    for (int r = r0; r < rend; r += stride) {
        const float* src = (r < 16384 ? P.in[I_UT] : P.in[I_VT]) + (size_t)(r & 16383) * D + lane * 32;
        f32x4 v[8]; float am = 0.f;
#pragma unroll
        for (int j = 0; j < 8; ++j) { v[j] = ((const f32x4*)src)[j]; am = fmaxf(am, fmaxf(fmaxf(fabsf(v[j].x), fabsf(v[j].y)), fmaxf(fabsf(v[j].z), fabsf(v[j].w)))); }
        am = wave_max_dpp(am);
        const float qmax = r < 16384 ? 6.0f : 7.5f;
        const float s = am > 0.f ? qmax / am : 1.0f;
        if (r < 16384) {
            unsigned w[4];
#pragma unroll
            for (int j = 0; j < 4; ++j) { unsigned t = 0;
                t = __builtin_amdgcn_cvt_scalef32_pk_fp4_f32(t, v[2 * j].x * s, v[2 * j].y * s, 1.0f, 0); t = __builtin_amdgcn_cvt_scalef32_pk_fp4_f32(t, v[2 * j].z * s, v[2 * j].w * s, 1.0f, 1);
                t = __builtin_amdgcn_cvt_scalef32_pk_fp4_f32(t, v[2 * j + 1].x * s, v[2 * j + 1].y * s, 1.0f, 2); t = __builtin_amdgcn_cvt_scalef32_pk_fp4_f32(t, v[2 * j + 1].z * s, v[2 * j + 1].w * s, 1.0f, 3);
                w[j] = t; }
            *(u32x4*)(ws + WS_UB + (size_t)r * UROW + lane * 16) = (u32x4){w[0], w[1], w[2], w[3]};
        } else {
            unsigned char* dst = ws + WS_VB + (size_t)(r & 16383) * TROW + lane * 24;
            f32x16 ev, od;
#pragma unroll
            for (int j = 0; j < 8; ++j) { ev[2 * j] = v[j].x * s; od[2 * j] = v[j].y * s; ev[2 * j + 1] = v[j].z * s; od[2 * j + 1] = v[j].w * s; }
            const u32x6 p6 = __builtin_amdgcn_cvt_scalef32_2xpk16_fp6_f32(ev, od, 1.0f);
            ((u32x2*)dst)[0] = (u32x2){p6[0], p6[1]}; ((u32x2*)dst)[1] = (u32x2){p6[2], p6[3]}; ((u32x2*)dst)[2] = (u32x2){p6[4], p6[5]};
        }
        if (lane == 0) ((float*)(ws + WS_TSC))[r] = am > 0.f ? am / qmax : 1.0f;
    }
}
constexpr int LD64 = 72, MATB = 64 * LD64 * 2, LDK = 104;
constexpr int O_AB = 0, O_RB = 1 * MATB, O_BH = 2 * MATB, O_KH = 3 * MATB, O_ABT = 4 * MATB, O_BTT = 5 * MATB, O_KTT = 6 * MATB, O_VT = 7 * MATB;
constexpr int O_M0 = 8 * MATB, O_M0T = 9 * MATB, O_M1 = 10 * MATB, O_M1T = 11 * MATB, O_PA = 12 * MATB, O_PB = 13 * MATB, O_MAK = 14 * MATB, O_MRB = 15 * MATB, O_MRK = 16 * MATB;
constexpr int O_ELEND = 17 * MATB, O_WT = O_ELEND + 256;
constexpr int O_WL = 8 * MATB, O_AL = O_WL + 64 * LDK * 2, O_Z = O_AL + 64 * LDK * 2, O_AZ = O_Z + 64 * 68 * 4;
static_assert(O_AZ + 64 * 68 * 4 <= O_ELEND, "lds");
static_assert(O_WT + 2048 <= LDS_BYTES - 16, "lds");

__device__ __forceinline__ bf16x8 ldsfrag(ldsp lds, int off, int ld, int row, int kofs) { return *(const LAS bf16x8*)(lds + off + (row * ld + kofs) * 2); }
__device__ __forceinline__ void st4(ldsp lds, int off, int row, int col, const f32x4 v) {
    u32x2 w; w.x = pk2(v.x, v.y); w.y = pk2(v.z, v.w); *(LAS u32x2*)(lds + off + (row * LD64 + col) * 2) = w; }
__device__ __forceinline__ void st1(ldsp lds, int off, int row, int col, float v) { *(LAS bf16_t*)(lds + off + (row * LD64 + col) * 2) = f2bf1(v); }

__device__ __forceinline__ float fast_rcp(float x) { return __builtin_amdgcn_rcpf(x); }
__device__ __forceinline__ float fast_sigmoid(float x) { return fast_rcp(1.0f + __expf(-x)); }
__device__ __forceinline__ float fast_tanh(float x) { return 1.0f - 2.0f * fast_rcp(1.0f + __expf(2.0f * x)); }
__device__ __forceinline__ u32x4 ld8(const bf16_t* p) { return p ? *(const u32x4*)p : (u32x4){0u, 0u, 0u, 0u}; }
__device__ __forceinline__ void shift8r(const u32x4 cw, const u32x4 pw, const float* mu, float* x) {
    float c[8], q[8]; unpack8(cw, c); unpack8(pw, q);
    const f32x4 m0 = *(const f32x4*)mu, m1 = *(const f32x4*)(mu + 4);
    const float mm[8] = {m0.x, m0.y, m0.z, m0.w, m1.x, m1.y, m1.z, m1.w};
#pragma unroll
    for (int i = 0; i < 8; ++i) x[i] = c[i] + (q[i] - c[i]) * mm[i];
}
__device__ __forceinline__ int tcol(int row, int col) { return ((((col >> 3) ^ (row >> 3)) & 7) << 3) | (col & 7); }
__device__ __forceinline__ bf16x8 ldsfragT(ldsp lds, int off, int row, int kofs) { return *(const LAS bf16x8*)(lds + off + (row * LD64 + tcol(row, kofs)) * 2); }
__device__ __forceinline__ void st1T(ldsp lds, int off, int row, int col, float v) { *(LAS bf16_t*)(lds + off + (row * LD64 + tcol(row, col)) * 2) = f2bf1(v); }
__device__ __forceinline__ void shift8(const bf16_t* pcur, const bf16_t* pprev, const float* mu, float* x) {
    float c[8], q[8];
    if (pcur) unpack8(*(const u32x4*)pcur, c); else {
#pragma unroll
        for (int i = 0; i < 8; ++i) c[i] = 0.f; }
    if (pprev) unpack8(*(const u32x4*)pprev, q); else {
#pragma unroll
        for (int i = 0; i < 8; ++i) q[i] = 0.f; }
    const f32x4 m0 = *(const f32x4*)mu, m1 = *(const f32x4*)(mu + 4);
    const float mm[8] = {m0.x, m0.y, m0.z, m0.w, m1.x, m1.y, m1.z, m1.w};
#pragma unroll
    for (int i = 0; i < 8; ++i) x[i] = c[i] + (q[i] - c[i]) * mm[i];
}

template <bool DO_P, bool DO_SQ>
__device__ __forceinline__ void dbl_step(ldsp lds, int sN, int sT, int dN, int dT, int pC, int pN, int tm, int tn0, int fr, int fq) {
    bf16x8 a[2];
#pragma unroll
    for (int ks = 0; ks < 2; ++ks) a[ks] = ldsfrag(lds, sT, LD64, 16 * tm + fr, ks * 32 + fq * 8);
#pragma unroll
    for (int t2 = 0; t2 < 2; ++t2) {
        const int nt = tn0 + t2, t = 16 * nt + fr, s0 = 16 * tm + 4 * fq;
        if (DO_P) {
            f32x4 acc = {0.f, 0.f, 0.f, 0.f};
#pragma unroll
            for (int ks = 0; ks < 2; ++ks) acc = mfma16(a[ks], ldsfrag(lds, pC, LD64, t, ks * 32 + fq * 8), acc);
            const u32x2 pw = *(const LAS u32x2*)(lds + pC + (t * LD64 + s0) * 2);
            acc.x += bflo(pw.x); acc.y += bfhi(pw.x); acc.z += bflo(pw.y); acc.w += bfhi(pw.y);
            st4(lds, pN, t, s0, acc);
        }
        if (DO_SQ) {
            f32x4 acc = {0.f, 0.f, 0.f, 0.f};
#pragma unroll
            for (int ks = 0; ks < 2; ++ks) acc = mfma16(a[ks], ldsfrag(lds, sN, LD64, t, ks * 32 + fq * 8), acc);
            st4(lds, dN, t, s0, acc);
            st1(lds, dT, s0 + 0, t, acc.x); st1(lds, dT, s0 + 1, t, acc.y); st1(lds, dT, s0 + 2, t, acc.z); st1(lds, dT, s0 + 3, t, acc.w);
        }
    }
}


#ifdef DBG_STAGE
constexpr size_t DBG_STRIDE = (size_t)NUNITS * 512 * 4;
__device__ __forceinline__ void dbgsum(const Params& P, ldsp lds, int u, int stage, const int* offs, int nmat) {
    unsigned acc = 0;
    for (int m = 0; m < nmat; ++m)
        for (int k = 0; k < 4; ++k) { const int idx = threadIdx.x + 512 * k, row = idx >> 5, cp = idx & 31; const unsigned x = *(const LAS unsigned*)(lds + offs[m] + row * (LD64 * 2) + cp * 4); acc += (x & 0xffffu) + (x >> 16); }
    ((unsigned*)(P.ws + WS_S0T + (size_t)stage * DBG_STRIDE))[(size_t)u * 512 + threadIdx.x] = acc;
}
#define DBGSUM(stage, ...) do { const int offs_[] = {__VA_ARGS__}; dbgsum(P, lds, u, stage, offs_, (int)(sizeof(offs_) / sizeof(int))); } while (0)
#else
#define DBGSUM(stage, ...) do { } while (0)
#endif
struct PL { u32x4 rc, rq, kc, kq, vc, vq, cw[3], pw[3]; bf16x8 aw[3], aa[3]; };
__device__ __forceinline__ const bf16_t* unit_rowp(const bf16_t* pp, int u, int tl, int col) {
    int r;
    if (u >= 4096) r = (tl >= 48) ? (ROW_META + tl - 48) : -1;
    else { const int bh = u >> 6, c = u & 63, b = bh >> 5; r = (tl >= 0 || c > 0) ? (b * SEQ + c * 64 + tl) : (ROW_META + 15); }
    return r < 0 ? (const bf16_t*)nullptr : pp + (size_t)r * NPAD + col;
}
__device__ __forceinline__ void pl_load(const Params& P, int u, PL& L) {
    int tid = threadIdx.x; asm volatile("" : "+v"(tid));
    const int lane = tid & 63, wave = tid >> 6, fr = lane & 15, fq = lane >> 4, tm = wave >> 1;
    const bf16_t* pp = (const bf16_t*)(P.ws + WS_P);
    const int h = (u >= 4096) ? (u - 4096) : ((u >> 6) & 31);
    const int t = tid >> 3, hj = h * 64 + 8 * (tid & 7);
    L.rc = ld8(unit_rowp(pp, u, t, C_R + hj)); L.rq = ld8(unit_rowp(pp, u, t - 1, C_R + hj));
    L.kc = ld8(unit_rowp(pp, u, t, C_K + hj)); L.kq = ld8(unit_rowp(pp, u, t - 1, C_K + hj));
    L.vc = ld8(unit_rowp(pp, u, t, C_V + hj)); L.vq = ld8(unit_rowp(pp, u, t - 1, C_V + hj));
#pragma unroll
    for (int it = 0; it < 3; ++it) { const int idx = tid + 512 * it, mat = idx / 768, rem = idx - mat * 768, tt = rem / 12, ch = rem - tt * 12, col = (mat ? C_AL : C_WL) + ch * 8;
        L.cw[it] = ld8(unit_rowp(pp, u, tt, col)); L.pw[it] = ld8(unit_rowp(pp, u, tt - 1, col)); }
    const bf16_t* ww2 = (const bf16_t*)(P.ws + WS_WTW2) + (size_t)(h * 64 + 16 * tm + fr) * 96 + fq * 8;
    const bf16_t* wa2 = (const bf16_t*)(P.ws + WS_WTA2) + (size_t)(h * 64 + 16 * tm + fr) * 96 + fq * 8;
#pragma unroll
    for (int ks = 0; ks < 3; ++ks) { L.aw[ks] = *(const bf16x8*)(ww2 + ks * 32); L.aa[ks] = *(const bf16x8*)(wa2 + ks * 32); }
}
__device__ __forceinline__ void rwkv_unit(const Params& P, ldsp lds, int u, PL& L, int next_u) {
    int tid = threadIdx.x; asm volatile("" : "+v"(tid));
    const int lane = tid & 63, wave = tid >> 6, fr = lane & 15, fq = lane >> 4, tm = wave >> 1, tn0 = (wave & 1) * 2;
    unsigned char* ws = P.ws;
    const bf16_t* pp = (const bf16_t*)(ws + WS_P);
    const bool meta = u >= 4096;
    int b = 0, h, c = 0;
    if (meta) { h = u - 4096; } else { const int bh = u >> 6; c = u & 63; b = bh >> 5; h = bh & 31; }
    auto rowof = [&](int tl) -> int {
        if (meta) return (tl >= 48) ? (ROW_META + tl - 48) : -1;
        if (tl >= 0 || c > 0) return b * SEQ + c * 64 + tl;
        return ROW_META + 15;
    };
    auto rowp = [&](int tl, int col) -> const bf16_t* { const int r = rowof(tl); return r < 0 ? (const bf16_t*)nullptr : pp + (size_t)r * NPAD + col; };
    const float* mu = P.in[I_MU];
#ifndef RPT_AD
#define RPT_AD 1
#define RPT_E12 1
#define RPT_E35 1
#endif
    float lw[8], av[8], rv[8], kv[8], vv[8], kk[8], km[8];
    const int t = tid >> 3, jq = tid & 7, j0 = 8 * jq, hj = h * 64 + j0;
    const bool nulltok = meta && t < 48;
    for (int rpt_ = 0; rpt_ < RPT_AD; ++rpt_) {
    {
#pragma unroll
        for (int it = 0; it < 3; ++it) { const int idx = tid + 512 * it, mat = idx / 768, rem = idx - mat * 768, tt = rem / 12, ch = rem - tt * 12, col = (mat ? C_AL : C_WL) + ch * 8;
            float x[8]; shift8r(L.cw[it], L.pw[it], mu + col, x);
            if (mat == 0) {
#pragma unroll
                for (int i = 0; i < 8; ++i) x[i] = fast_tanh(x[i]);
            }
            *(LAS u32x4*)(lds + (mat ? O_AL : O_WL) + (tt * LDK + ch * 8) * 2) = pack8(x); }
    }
    BLOCK_SYNC();
    {
        f32x4 z[2] = {{0.f, 0.f, 0.f, 0.f}, {0.f, 0.f, 0.f, 0.f}}, az[2] = {{0.f, 0.f, 0.f, 0.f}, {0.f, 0.f, 0.f, 0.f}};
#pragma unroll
        for (int ks = 0; ks < 3; ++ks) {
            const bf16x8 aw = L.aw[ks], aa = L.aa[ks];
#pragma unroll
            for (int t2 = 0; t2 < 2; ++t2) {
                const int t = 16 * (tn0 + t2) + fr;
                z[t2] = mfma16(aw, ldsfrag(lds, O_WL, LDK, t, ks * 32 + fq * 8), z[t2]);
                az[t2] = mfma16(aa, ldsfrag(lds, O_AL, LDK, t, ks * 32 + fq * 8), az[t2]);
            }
        }
#pragma unroll
        for (int t2 = 0; t2 < 2; ++t2) {
            const int t = 16 * (tn0 + t2) + fr, j0 = 16 * tm + 4 * fq;
            *(LAS f32x4*)(lds + O_Z + (t * 68 + j0) * 4) = z[t2];
            *(LAS f32x4*)(lds + O_AZ + (t * 68 + j0) * 4) = az[t2];
        }
    }
    BLOCK_SYNC();
    float cs[8];
    {
        const f32x4 z0 = *(const LAS f32x4*)(lds + O_Z + (t * 68 + j0) * 4), z1 = *(const LAS f32x4*)(lds + O_Z + (t * 68 + j0 + 4) * 4);
        const f32x4 y0 = *(const LAS f32x4*)(lds + O_AZ + (t * 68 + j0) * 4), y1 = *(const LAS f32x4*)(lds + O_AZ + (t * 68 + j0 + 4) * 4);
        const float zz[8] = {z0.x, z0.y, z0.z, z0.w, z1.x, z1.y, z1.z, z1.w}, yy[8] = {y0.x, y0.y, y0.z, y0.w, y1.x, y1.y, y1.z, y1.w};
        const f32x4 w0a = *(const f32x4*)(P.in[I_W0] + hj), w0b = *(const f32x4*)(P.in[I_W0] + hj + 4), a0a = *(const f32x4*)(P.in[I_A0] + hj), a0b = *(const f32x4*)(P.in[I_A0] + hj + 4);
        const float w0[8] = {w0a.x, w0a.y, w0a.z, w0a.w, w0b.x, w0b.y, w0b.z, w0b.w}, a0[8] = {a0a.x, a0a.y, a0a.z, a0a.w, a0b.x, a0b.y, a0b.z, a0b.w};
#pragma unroll
        for (int i = 0; i < 8; ++i) { lw[i] = nulltok ? 0.f : -DSCALE * fast_sigmoid(w0[i] + zz[i]); av[i] = fast_sigmoid(a0[i] + yy[i]); cs[i] = lw[i]; }
#pragma unroll
        for (int d = 8; d < 64; d <<= 1) {
#pragma unroll
            for (int i = 0; i < 8; ++i) { const float o = __shfl_up(cs[i], d); cs[i] += (lane >= d) ? o : 0.f; }
        }
        if (lane >= 56) { *(LAS f32x4*)(lds + O_WT + (wave * 64 + j0) * 4) = (f32x4){cs[0], cs[1], cs[2], cs[3]}; *(LAS f32x4*)(lds + O_WT + (wave * 64 + j0 + 4) * 4) = (f32x4){cs[4], cs[5], cs[6], cs[7]}; }
        shift8r(L.rc, L.rq, mu + C_R + hj, rv); shift8r(L.kc, L.kq, mu + C_K + hj, kv); shift8r(L.vc, L.vq, mu + C_V + hj, vv);
        if (nulltok) {
#pragma unroll
            for (int i = 0; i < 8; ++i) { rv[i] = 0.f; kv[i] = 0.f; vv[i] = 0.f; }
        }
        const f32x4 kka = *(const f32x4*)(P.in[I_KK] + hj), kkb = *(const f32x4*)(P.in[I_KK] + hj + 4), kaa = *(const f32x4*)(P.in[I_KA] + hj), kab = *(const f32x4*)(P.in[I_KA] + hj + 4);
        const f32x4 rka = *(const f32x4*)(P.in[I_RK] + hj), rkb = *(const f32x4*)(P.in[I_RK] + hj + 4);
        const float kkw[8] = {kka.x, kka.y, kka.z, kka.w, kkb.x, kkb.y, kkb.z, kkb.w}, kaw[8] = {kaa.x, kaa.y, kaa.z, kaa.w, kab.x, kab.y, kab.z, kab.w}, rkw[8] = {rka.x, rka.y, rka.z, rka.w, rkb.x, rkb.y, rkb.z, rkb.w};
        float n2 = 0.f, bon = 0.f;
#pragma unroll
        for (int i = 0; i < 8; ++i) { kk[i] = kv[i] * kkw[i]; n2 += kk[i] * kk[i]; km[i] = kv[i] * (1.0f + (av[i] - 1.0f) * kaw[i]); bon += rv[i] * km[i] * rkw[i]; }
        n2 += DPPF(n2, 0xB1); n2 += DPPF(n2, 0x4E); n2 += DPPF(n2, 0x141);
        bon += DPPF(bon, 0xB1); bon += DPPF(bon, 0x4E); bon += DPPF(bon, 0x141);
        const float inv = 1.0f / fmaxf(sqrtf(n2), 1e-12f);
#pragma unroll
        for (int i = 0; i < 8; ++i) kk[i] *= inv;
        if (!meta && jq == 0) ((float*)(ws + WS_BONUS))[(size_t)(b * SEQ + c * 64 + t) * 32 + h] = bon;
    }
    BLOCK_SYNC();
    {
        float Lc[8], Le[8];
#pragma unroll
        for (int i = 0; i < 8; ++i) { Lc[i] = cs[i]; Le[i] = 0.f; }
#pragma unroll
        for (int w = 0; w < 8; ++w) {
            const f32x4 x0 = *(const LAS f32x4*)(lds + O_WT + (w * 64 + j0) * 4), x1 = *(const LAS f32x4*)(lds + O_WT + (w * 64 + j0 + 4) * 4);
            const float xx[8] = {x0.x, x0.y, x0.z, x0.w, x1.x, x1.y, x1.z, x1.w};
            const float msk = w < wave ? 1.0f : 0.0f;
#pragma unroll
            for (int i = 0; i < 8; ++i) { Le[i] += xx[i]; Lc[i] += msk * xx[i]; }
        }
        float Ab[8], Rb[8], Bh[8], Kh[8], Bt[8], Kt[8];
#pragma unroll
        for (int i = 0; i < 8; ++i) {
            const float eP = __expf(Lc[i] - lw[i]), eC = __expf(Lc[i]), eN = __expf(-Lc[i]), eE = __expf(Le[i] - Lc[i]);
            const float ka = kk[i] * av[i];
            Ab[i] = -kk[i] * eP; Rb[i] = rv[i] * eC; Bh[i] = ka * eN; Kh[i] = km[i] * eN; Bt[i] = ka * eE; Kt[i] = km[i] * eE;
        }
        *(LAS u32x4*)(lds + O_AB + (t * LD64 + j0) * 2) = pack8(Ab);
        *(LAS u32x4*)(lds + O_RB + (t * LD64 + j0) * 2) = pack8(Rb);
        *(LAS u32x4*)(lds + O_BH + (t * LD64 + j0) * 2) = pack8(Bh);
        *(LAS u32x4*)(lds + O_KH + (t * LD64 + j0) * 2) = pack8(Kh);
#pragma unroll
        for (int i = 0; i < 8; ++i) { st1T(lds, O_ABT, j0 + i, t, Ab[i]); st1T(lds, O_BTT, j0 + i, t, Bt[i]); st1T(lds, O_KTT, j0 + i, t, Kt[i]); st1T(lds, O_VT, j0 + i, t, vv[i]); }
        if (t == 63) {
#pragma unroll
            for (int i = 0; i < 8; ++i) *(LAS float*)(lds + O_ELEND + (j0 + i) * 4) = __expf(Le[i]);
        }
    }
    BLOCK_SYNC();
    }
    if (next_u >= 0) pl_load(P, next_u, L);
    DBGSUM(0, O_AB, O_RB, O_BH, O_KH, O_ABT, O_BTT, O_KTT, O_VT);
    for (int rpt_ = 0; rpt_ < RPT_E12; ++rpt_) {
    {
        bf16x8 abh[2], akh[2];
#pragma unroll
        for (int ks = 0; ks < 2; ++ks) { abh[ks] = ldsfrag(lds, O_BH, LD64, 16 * tm + fr, ks * 32 + fq * 8); akh[ks] = ldsfrag(lds, O_KH, LD64, 16 * tm + fr, ks * 32 + fq * 8); }
#pragma unroll
        for (int t2 = 0; t2 < 2; ++t2) {
            const int tt = 16 * (tn0 + t2) + fr, s0 = 16 * tm + 4 * fq;
            f32x4 mab = {0.f, 0.f, 0.f, 0.f}, mak = mab, mrb = mab, mrk = mab;
#pragma unroll
            for (int ks = 0; ks < 2; ++ks) {
                const bf16x8 bab = ldsfrag(lds, O_AB, LD64, tt, ks * 32 + fq * 8), brb = ldsfrag(lds, O_RB, LD64, tt, ks * 32 + fq * 8);
                mab = mfma16(abh[ks], bab, mab); mak = mfma16(akh[ks], bab, mak); mrb = mfma16(abh[ks], brb, mrb); mrk = mfma16(akh[ks], brb, mrk);
            }
            float vab[4] = {mab.x, mab.y, mab.z, mab.w}, vak[4] = {mak.x, mak.y, mak.z, mak.w}, vrb[4] = {mrb.x, mrb.y, mrb.z, mrb.w}, vrk[4] = {mrk.x, mrk.y, mrk.z, mrk.w}, vp[4];
#pragma unroll
            for (int r = 0; r < 4; ++r) { const int s = s0 + r; const bool st = s < tt, le = s <= tt;
                vab[r] = st ? vab[r] : 0.f; vak[r] = st ? vak[r] : 0.f; vrb[r] = le ? vrb[r] : 0.f; vrk[r] = le ? vrk[r] : 0.f; vp[r] = vab[r] + (s == tt ? 1.0f : 0.f); }
            st4(lds, O_M0, tt, s0, (f32x4){vab[0], vab[1], vab[2], vab[3]});
#pragma unroll
            for (int r = 0; r < 4; ++r) st1(lds, O_M0T, s0 + r, tt, vab[r]);
            st4(lds, O_PA, tt, s0, (f32x4){vp[0], vp[1], vp[2], vp[3]});
            st4(lds, O_MAK, tt, s0, (f32x4){vak[0], vak[1], vak[2], vak[3]});
            st4(lds, O_MRB, tt, s0, (f32x4){vrb[0], vrb[1], vrb[2], vrb[3]});
            st4(lds, O_MRK, tt, s0, (f32x4){vrk[0], vrk[1], vrk[2], vrk[3]});
        }
    }
    BLOCK_SYNC();
    DBGSUM(1, O_M0, O_M0T, O_PA, O_MAK, O_MRB, O_MRK);
    dbl_step<false, true>(lds, O_M0, O_M0T, O_M1, O_M1T, 0, 0, tm, tn0, fr, fq); BLOCK_SYNC();
    dbl_step<true, true>(lds, O_M1, O_M1T, O_M0, O_M0T, O_PA, O_PB, tm, tn0, fr, fq); BLOCK_SYNC();
    dbl_step<true, true>(lds, O_M0, O_M0T, O_M1, O_M1T, O_PB, O_PA, tm, tn0, fr, fq); BLOCK_SYNC();
    dbl_step<true, true>(lds, O_M1, O_M1T, O_M0, O_M0T, O_PA, O_PB, tm, tn0, fr, fq); BLOCK_SYNC();
    dbl_step<true, true>(lds, O_M0, O_M0T, O_M1, O_M1T, O_PB, O_PA, tm, tn0, fr, fq); BLOCK_SYNC();
    dbl_step<true, false>(lds, O_M1, O_M1T, 0, 0, O_PA, O_PB, tm, tn0, fr, fq); BLOCK_SYNC();
    }
    DBGSUM(2, O_PB);
    const size_t ub = (size_t)u * 4096;
    for (int rpt_ = 0; rpt_ < RPT_E35; ++rpt_) {
    {
        bf16x8 aT[2], aMak[2];
#pragma unroll
        for (int ks = 0; ks < 2; ++ks) { aT[ks] = ldsfrag(lds, O_PB, LD64, 16 * tm + fr, ks * 32 + fq * 8); aMak[ks] = ldsfrag(lds, O_MAK, LD64, 16 * tm + fr, ks * 32 + fq * 8); }
#pragma unroll
        for (int t2 = 0; t2 < 2; ++t2) {
            const int n = 16 * (tn0 + t2) + fr, t0 = 16 * tm + 4 * fq;
            f32x4 at = {0.f, 0.f, 0.f, 0.f}, xt = at;
#pragma unroll
            for (int ks = 0; ks < 2; ++ks) { at = mfma16(aT[ks], ldsfragT(lds, O_ABT, n, ks * 32 + fq * 8), at); xt = mfma16(aMak[ks], ldsfragT(lds, O_VT, n, ks * 32 + fq * 8), xt); }
            st4(lds, O_M0, n, t0, at); st4(lds, O_M0T, n, t0, xt);
        }
    }
    BLOCK_SYNC();
    DBGSUM(3, O_M0, O_M0T);
    {
        bf16x8 aT[2], aAt[2];
#pragma unroll
        for (int ks = 0; ks < 2; ++ks) { aT[ks] = ldsfrag(lds, O_PB, LD64, 16 * tm + fr, ks * 32 + fq * 8); aAt[ks] = ldsfrag(lds, O_M0, LD64, 16 * tm + fr, ks * 32 + fq * 8); }
        bf16_t* Rt = (bf16_t*)(ws + WS_RT) + ub; bf16_t* Gp = (bf16_t*)(ws + WS_G) + ub;
#pragma unroll
        for (int t2 = 0; t2 < 2; ++t2) {
            const int n = 16 * (tn0 + t2) + fr, m0 = 16 * tm + 4 * fq;
            f32x4 u0 = {0.f, 0.f, 0.f, 0.f}, rt = u0, g = u0;
#pragma unroll
            for (int ks = 0; ks < 2; ++ks) {
                u0 = mfma16(aT[ks], ldsfrag(lds, O_M0T, LD64, n, ks * 32 + fq * 8), u0);
                rt = mfma16(aAt[ks], ldsfrag(lds, O_MRB, LD64, n, ks * 32 + fq * 8), rt);
                g = mfma16(aAt[ks], ldsfragT(lds, O_BTT, n, ks * 32 + fq * 8), g);
            }
            st4(lds, O_M1, n, m0, u0);
            const u32x2 rw = *(const LAS u32x2*)(lds + O_RB + (n * LD64 + m0) * 2);
            rt.x += bflo(rw.x); rt.y += bfhi(rw.x); rt.z += bflo(rw.y); rt.w += bfhi(rw.y);
            { u32x2 w; w.x = pk2(rt.x, rt.y); w.y = pk2(rt.z, rt.w); *(u32x2*)(Rt + n * 64 + m0) = w; }
            if ((n >> 2) == (m0 >> 2)) { const float e = *(const LAS float*)(lds + O_ELEND + n * 4); const int r = n & 3;
                g.x += (r == 0) ? e : 0.f; g.y += (r == 1) ? e : 0.f; g.z += (r == 2) ? e : 0.f; g.w += (r == 3) ? e : 0.f; }
            { const int pos0 = 32 * (tm >> 1) + 8 * fq + 4 * (tm & 1); u32x2 w; w.x = pk2(g.x, g.y); w.y = pk2(g.z, g.w); *(u32x2*)(Gp + n * 64 + pos0) = w; }
        }
    }
    BLOCK_SYNC();
    DBGSUM(4, O_M1);
    {
        bf16x8 aB[2], aK[2], aU[2], aV[2];
#pragma unroll
        for (int ks = 0; ks < 2; ++ks) { const int row = 16 * tm + fr, ko = ks * 32 + fq * 8;
            aB[ks] = ldsfragT(lds, O_BTT, row, ko); aK[ks] = ldsfragT(lds, O_KTT, row, ko); aU[ks] = ldsfrag(lds, O_M1, LD64, row, ko); aV[ks] = ldsfragT(lds, O_VT, row, ko); }
        bf16_t* H0t = (bf16_t*)(ws + WS_H0T) + ub; bf16_t* Y0s = (bf16_t*)(ws + WS_Y0) + ub;
#pragma unroll
        for (int t2 = 0; t2 < 2; ++t2) {
            const int n = 16 * (tn0 + t2) + fr, m0 = 16 * tm + 4 * fq;
            f32x4 hh = {0.f, 0.f, 0.f, 0.f}, yy = hh;
#pragma unroll
            for (int ks = 0; ks < 2; ++ks) { const int ko = ks * 32 + fq * 8;
                const bf16x8 bU = ldsfrag(lds, O_M1, LD64, n, ko), bV = ldsfragT(lds, O_VT, n, ko), bRb = ldsfrag(lds, O_MRB, LD64, n, ko), bRk = ldsfrag(lds, O_MRK, LD64, n, ko);
                hh = mfma16(aB[ks], bU, hh); hh = mfma16(aK[ks], bV, hh);
                yy = mfma16(aU[ks], bRb, yy); yy = mfma16(aV[ks], bRk, yy); }
            { u32x2 w; w.x = pk2(hh.x, hh.y); w.y = pk2(hh.z, hh.w); *(u32x2*)(H0t + n * 64 + m0) = w; }
            { u32x2 w; w.x = pk2(yy.x, yy.y); w.y = pk2(yy.z, yy.w); *(u32x2*)(Y0s + n * 64 + m0) = w; }
        }
    }
    BLOCK_SYNC();
    }
}

constexpr int LDU = 264;
__device__ __forceinline__ void pool_unit(const Params& P, ldsp lds, int pu) {
    int tid = threadIdx.x; asm volatile("" : "+v"(tid));
    const int lane = tid & 63, wave = tid >> 6, fr = lane & 15, fq = lane >> 4;
    unsigned char* ws = P.ws;
    const bf16_t* pp = (const bf16_t*)(ws + WS_P);
    const int g = pu & 3, tt = pu >> 2, b = tt >> 6, ti0 = (tt & 63) * 64;
    constexpr int O_U = 0, O_PL = 79 * LDU * 2;
    for (int idx = tid; idx < 79 * 32; idx += 512) {
        const int lr = idx >> 5, ch = idx & 31, ti = ti0 + lr - 15;
        const int row = ti >= 0 ? b * SEQ + ti : ROW_META + 16 + ti;
        *(LAS u32x4*)(lds + O_U + (lr * LDU + ch * 8) * 2) = *(const u32x4*)(pp + (size_t)row * NPAD + C_POOL + g * 256 + ch * 8);
    }
    BLOCK_SYNC();
    {
        const int t = tid >> 3, cq = tid & 7, win = 2 << g; const float inv = 1.0f / (float)win;
#pragma unroll
        for (int cc = 0; cc < 4; ++cc) {
            const int c0 = cq * 32 + cc * 8; float s[8], own[8];
            unpack8(*(const LAS u32x4*)(lds + O_U + ((15 + t) * LDU + c0) * 2), own);
#pragma unroll
            for (int i = 0; i < 8; ++i) s[i] = own[i];
            for (int d = 1; d < win; ++d) { float x[8]; unpack8(*(const LAS u32x4*)(lds + O_U + ((15 + t - d) * LDU + c0) * 2), x);
#pragma unroll
                for (int i = 0; i < 8; ++i) s[i] += x[i]; }
#pragma unroll
            for (int i = 0; i < 8; ++i) s[i] = s[i] * inv - own[i];
            *(LAS u32x4*)(lds + O_PL + (t * LDU + c0) * 2) = pack8(s);
        }
    }
    BLOCK_SYNC();
    {
        const bf16_t* wt = (const bf16_t*)(ws + WS_WTPOOL) + (size_t)g * 65536;
        f32x4 acc[2][4];
#pragma unroll
        for (int a = 0; a < 2; ++a)
#pragma unroll
            for (int n = 0; n < 4; ++n) acc[a][n] = (f32x4){0.f, 0.f, 0.f, 0.f};
#pragma unroll 4
        for (int ks = 0; ks < 8; ++ks) {
            bf16x8 af[2];
#pragma unroll
            for (int a = 0; a < 2; ++a) af[a] = *(const bf16x8*)(wt + (size_t)(32 * wave + 16 * a + fr) * 256 + ks * 32 + fq * 8);
#pragma unroll
            for (int n = 0; n < 4; ++n) { const bf16x8 bf = ldsfrag(lds, O_PL, LDU, 16 * n + fr, ks * 32 + fq * 8);
#pragma unroll
                for (int a = 0; a < 2; ++a) acc[a][n] = mfma16(af[a], bf, acc[a][n]); }
        }
        bf16_t* yb = (bf16_t*)(ws + WS_YB);
        const float* psc = P.in[I_PSCALE] + g * 256;
#pragma unroll
        for (int a = 0; a < 2; ++a) { const int d0 = 32 * wave + 16 * a + 4 * fq; const f32x4 sc = *(const f32x4*)(psc + d0);
#pragma unroll
            for (int n = 0; n < 4; ++n) { const int t = 16 * n + fr; const f32x4 o = acc[a][n] * sc;
                u32x2 w; w.x = pk2(o.x, o.y); w.y = pk2(o.z, o.w);
                *(u32x2*)(yb + (size_t)(b * SEQ + ti0 + t) * 1024 + g * 256 + d0) = w; } }
    }
    BLOCK_SYNC();
}
__device__ __forceinline__ void gsig_unit(const Params& P, int gu) {
    int tid = threadIdx.x; asm volatile("" : "+v"(tid));
    const bf16_t* pp = (const bf16_t*)(P.ws + WS_P); bf16_t* gs = (bf16_t*)(P.ws + WS_GSIG);
    const float* mu = P.in[I_MU];
#pragma unroll
    for (int it = 0; it < 4; ++it) {
        const int idx = tid + 512 * it, tl = idx >> 5, ch = idx & 31, col = C_GL + ch * 8;
        const int row = gu * 64 + tl; const int prow = ((row & (SEQ - 1)) == 0) ? (ROW_META + 15) : row - 1;
        float x[8]; shift8r(*(const u32x4*)(pp + (size_t)row * NPAD + col), *(const u32x4*)(pp + (size_t)prow * NPAD + col), mu + col, x);
#pragma unroll
        for (int i = 0; i < 8; ++i) x[i] = fast_sigmoid(x[i]);
        *(u32x4*)(gs + (size_t)row * 256 + ch * 8) = pack8(x);
    }
}
__device__ __forceinline__ void phase2(const Params& P, ldsp lds) {
    PL L;
    if ((int)blockIdx.x < NUNITS) pl_load(P, blockIdx.x, L);
    for (int u = blockIdx.x; u < NUNITS + 512 + 128; u += gridDim.x) {
        if (u < NUNITS) { const int nu = u + (int)gridDim.x; rwkv_unit(P, lds, u, L, nu < NUNITS ? nu : -1); }
        else if (u < NUNITS + 512) pool_unit(P, lds, u - NUNITS);
        else gsig_unit(P, u - NUNITS - 512);
    }

}
__device__ __forceinline__ void phase3(const Params& P) {
    const int lane = threadIdx.x & 63, wave = threadIdx.x >> 6, fr = lane & 15, fq = lane >> 4;
    if (wave != 0) { convert_tables(P, CONV_P2_ROWS + blockIdx.x * 7 + (wave - 1), 32768, gridDim.x * 7); return; }
    unsigned char* ws = P.ws;
    const bf16_t* Gp = (const bf16_t*)(ws + WS_G); const bf16_t* H0t = (const bf16_t*)(ws + WS_H0T); bf16_t* S0t = (bf16_t*)(ws + WS_S0T);
    for (int item = blockIdx.x; item < 256; item += gridDim.x) {
        const int bh = item >> 2, vq = item & 3, h = bh & 31;
        bf16x8 Sb[2];
#pragma unroll
        for (int ks = 0; ks < 2; ++ks)
#pragma unroll
            for (int i = 0; i < 8; ++i) Sb[ks][i] = 0;
        bf16x8 g0[4][2], g1[4][2], g2[4][2], g3[4][2]; u32x2 h0[4], h1[4], h2[4], h3[4];
        auto load = [&](int step, bf16x8 (&ga)[4][2], u32x2 (&hf)[4]) {
            const int u = (step == 0) ? (4096 + h) : (bh * 64 + step - 1);
            const bf16_t* g = Gp + (size_t)u * 4096; const bf16_t* hh = H0t + (size_t)u * 4096;
#pragma unroll
            for (int mt = 0; mt < 4; ++mt) {
#pragma unroll
                for (int ks = 0; ks < 2; ++ks) ga[mt][ks] = *(const bf16x8*)(g + (16 * mt + fr) * 64 + ks * 32 + fq * 8);
                hf[mt] = *(const u32x2*)(hh + (16 * vq + fr) * 64 + 16 * mt + 4 * fq);
            }
        };
        auto apply = [&](int step, const bf16x8 (&ga)[4][2], const u32x2 (&hf)[4]) {
            f32x4 acc[4];
#pragma unroll
            for (int mt = 0; mt < 4; ++mt) {
                acc[mt] = (f32x4){bflo(hf[mt].x), bfhi(hf[mt].x), bflo(hf[mt].y), bfhi(hf[mt].y)};
                acc[mt] = mfma16(ga[mt][0], Sb[0], acc[mt]);
                acc[mt] = mfma16(ga[mt][1], Sb[1], acc[mt]);
            }
            bf16_t* so = S0t + (size_t)(bh * 64 + step) * 4096 + (16 * vq + fr) * 64 + 4 * fq;
            u32x2 w[4];
#pragma unroll
            for (int mt = 0; mt < 4; ++mt) { w[mt].x = pk2(acc[mt].x, acc[mt].y); w[mt].y = pk2(acc[mt].z, acc[mt].w); *(u32x2*)(so + 16 * mt) = w[mt]; }
#pragma unroll
            for (int ks = 0; ks < 2; ++ks) {
                const u32x4 q4 = (u32x4){w[2 * ks].x, w[2 * ks].y, w[2 * ks + 1].x, w[2 * ks + 1].y};
                Sb[ks] = __builtin_bit_cast(bf16x8, q4);
            }
        };
        load(0, g0, h0); load(1, g1, h1); load(2, g2, h2);
#pragma unroll 1
        for (int step = 0; step < 64; step += 4) {
            load(step + 3, g3, h3); apply(step, g0, h0);
            if (step + 4 < 64) load(step + 4, g0, h0);
            apply(step + 1, g1, h1);
            if (step + 5 < 64) load(step + 5, g1, h1);
            apply(step + 2, g2, h2);
            if (step + 6 < 64) load(step + 6, g2, h2);
            apply(step + 3, g3, h3);
        }
    }
}

constexpr int LDG = 264;
__device__ __forceinline__ void phase3b(const Params& P, ldsp lds) {
    int tid = threadIdx.x; asm volatile("" : "+v"(tid));
    const int lane = tid & 63, wave = tid >> 6, fr = lane & 15, fq = lane >> 4, wq = wave & 3;
    unsigned char* ws = P.ws;
    const bf16_t* pp = (const bf16_t*)(ws + WS_P);
    const float* mu = P.in[I_MU];
    constexpr int O_G2 = 0;
    for (int w = blockIdx.x; w < 256; w += gridDim.x) {
        const int h = w & 31;
        BLOCK_SYNC();
        for (int idx = tid; idx < 64 * 32; idx += 512) { const int row = idx >> 5, ch = idx & 31;
            *(LAS u32x4*)(lds + O_G2 + (row * LDG + ch * 8) * 2) = *(const u32x4*)((const bf16_t*)(ws + WS_WTG2) + (size_t)(h * 64 + row) * 256 + ch * 8); }
        BLOCK_SYNC();
        bf16x8 bG[8], bR[2], aS[4][2]; u32x2 yw[4], vc[4], vp[4]; float bon;
        auto unit_of = [&](int it, int& b, int& c) { const int q = (w >> 5) + 8 * (2 * it + (wave >> 2)); b = q >> 6; c = q & 63; };
        auto issue = [&](int it) {
            int b, c; unit_of(it, b, c); const int u = (b * 32 + h) * 64 + c, trow0 = b * SEQ + c * 64 + 16 * wq;
            const size_t ub = (size_t)u * 4096;
            const bf16_t* S0t = (const bf16_t*)(ws + WS_S0T) + ub; const bf16_t* Rt = (const bf16_t*)(ws + WS_RT) + ub; const bf16_t* Y0s = (const bf16_t*)(ws + WS_Y0) + ub;
            const int row = trow0 + fr; const int prow = (c == 0 && wq == 0 && fr == 0) ? (ROW_META + 15) : row - 1;
            const bf16_t* gsr = (const bf16_t*)(ws + WS_GSIG) + (size_t)row * 256 + fq * 8;
#pragma unroll
            for (int ks = 0; ks < 8; ++ks) bG[ks] = *(const bf16x8*)(gsr + ks * 32);
#pragma unroll
            for (int ks = 0; ks < 2; ++ks) bR[ks] = *(const bf16x8*)(Rt + (16 * wq + fr) * 64 + ks * 32 + fq * 8);
#pragma unroll
            for (int mt = 0; mt < 4; ++mt) {
                yw[mt] = *(const u32x2*)(Y0s + (16 * wq + fr) * 64 + 16 * mt + 4 * fq);
#pragma unroll
                for (int ks = 0; ks < 2; ++ks) aS[mt][ks] = *(const bf16x8*)(S0t + (16 * mt + fr) * 64 + ks * 32 + fq * 8);
                const int hc = h * 64 + 16 * mt + 4 * fq;
                vc[mt] = *(const u32x2*)(pp + (size_t)row * NPAD + C_V + hc); vp[mt] = *(const u32x2*)(pp + (size_t)prow * NPAD + C_V + hc);
            }
            bon = ((const float*)(ws + WS_BONUS))[(size_t)row * 32 + h];
        };
        issue(0);
#pragma unroll 1
        for (int it = 0; it < 8; ++it) {
            int b, c; unit_of(it, b, c);
            const int row = b * SEQ + c * 64 + 16 * wq + fr;
            f32x4 gacc[4];
#pragma unroll
            for (int mt = 0; mt < 4; ++mt) gacc[mt] = (f32x4){0.f, 0.f, 0.f, 0.f};
#pragma unroll
            for (int ks = 0; ks < 8; ++ks)
#pragma unroll
                for (int mt = 0; mt < 4; ++mt) gacc[mt] = mfma16(*(const LAS bf16x8*)(lds + O_G2 + ((16 * mt + fr) * LDG + ks * 32 + fq * 8) * 2), bG[ks], gacc[mt]);
            f32x4 y[4], vv[4]; const float bonc = bon;
#pragma unroll
            for (int mt = 0; mt < 4; ++mt) {
                y[mt] = (f32x4){bflo(yw[mt].x), bfhi(yw[mt].x), bflo(yw[mt].y), bfhi(yw[mt].y)};
#pragma unroll
                for (int ks = 0; ks < 2; ++ks) y[mt] = mfma16(aS[mt][ks], bR[ks], y[mt]);
                const f32x4 mv = *(const f32x4*)(mu + C_V + h * 64 + 16 * mt + 4 * fq);
                const f32x4 cv = (f32x4){bflo(vc[mt].x), bfhi(vc[mt].x), bflo(vc[mt].y), bfhi(vc[mt].y)}, pv = (f32x4){bflo(vp[mt].x), bfhi(vp[mt].x), bflo(vp[mt].y), bfhi(vp[mt].y)};
                vv[mt] = cv + (pv - cv) * mv;
            }
#pragma unroll
            for (int mt = 0; mt < 4; ++mt) asm volatile("" : "+v"(y[mt]), "+v"(vv[mt]), "+v"(gacc[mt]));
            if (it + 1 < 8) issue(it + 1);
            float s = 0.f;
#pragma unroll
            for (int mt = 0; mt < 4; ++mt) s += (y[mt].x + y[mt].y) + (y[mt].z + y[mt].w);
            s += __shfl_xor(s, 16); s += __shfl_xor(s, 32);
            const float mean = s * (1.0f / 64.0f); float qq = 0.f;
#pragma unroll
            for (int mt = 0; mt < 4; ++mt) { y[mt] = y[mt] - mean; qq += (y[mt].x * y[mt].x + y[mt].y * y[mt].y) + (y[mt].z * y[mt].z + y[mt].w * y[mt].w); }
            qq += __shfl_xor(qq, 16); qq += __shfl_xor(qq, 32);
            const float rstd = 1.0f / sqrtf(qq * (1.0f / 64.0f) + GN_EPS);
            bf16_t* ya = (bf16_t*)(ws + WS_YA) + (size_t)row * D + h * 64;
#pragma unroll
            for (int mt = 0; mt < 4; ++mt) {
                const int i0 = 16 * mt + 4 * fq, hc = h * 64 + i0;
                const f32x4 gg = *(const f32x4*)(P.in[I_GNG] + hc), gb = *(const f32x4*)(P.in[I_GNB] + hc);
                const f32x4 o = (y[mt] * rstd * gg + gb + vv[mt] * bonc) * gacc[mt];
                u32x2 wv; wv.x = pk2(o.x, o.y); wv.y = pk2(o.z, o.w);
                *(u32x2*)(ya + i0) = wv;
            }
        }
    }
}
__device__ __forceinline__ u32x6 ld_row6(const unsigned char* p) { const u32x2 a = ((const u32x2*)p)[0], b = ((const u32x2*)p)[1], c = ((const u32x2*)p)[2]; return (u32x6){a.x, a.y, b.x, b.y, c.x, c.y}; }
__device__ __forceinline__ void peer_token(const Params& P, int tok, const LAS int* eidx, const LAS float* gts) {
    const int lane = threadIdx.x & 63;
    unsigned char* ws = P.ws;
    const unsigned char* Ub = ws + WS_UB; const unsigned char* Vb = ws + WS_VB;
    const float* tsc = (const float*)(ws + WS_TSC);
    {
        int lo = lane; asm volatile("" : "+v"(lo));
        float x[32], o[32];
        {
            const bf16_t* hr = (const bf16_t*)(ws + WS_H1B) + (size_t)tok * D + lo * 32;
#pragma unroll
            for (int i = 0; i < 4; ++i) unpack8(*(const u32x4*)(hr + 8 * i), x + 8 * i);
#pragma unroll
            for (int i = 0; i < 32; ++i) o[i] = 0.f;
        }
        const int e_lo = eidx[lo], e_hi = eidx[64 + lo];
        const float su_lo = tsc[e_lo], su_hi = tsc[e_hi];
        const float gv_lo = gts[lo] * tsc[16384 + e_lo], gv_hi = gts[64 + lo] * tsc[16384 + e_hi];
        u32x4 ua[2], ub[2]; u32x6 va[2], vb[2];
        auto issue = [&](int g, u32x4 (&uu)[2], u32x6 (&vv)[2]) {
            const int ev = (g < 32) ? e_lo : e_hi;
#pragma unroll
            for (int j = 0; j < 2; ++j) {
                const int e = __builtin_amdgcn_readlane(ev, (2 * g + j) & 63);
                uu[j] = *(const u32x4*)(Ub + (size_t)e * UROW + lo * 16); vv[j] = ld_row6(Vb + (size_t)e * TROW + lo * 24);
            }
        };
        auto consume = [&](int g, const u32x4 (&uu)[2], const u32x6 (&vv)[2]) {
            const float suv = (g < 32) ? su_lo : su_hi, gvv = (g < 32) ? gv_lo : gv_hi;
            float dd[2];
#pragma unroll
            for (int j = 0; j < 2; ++j) { float s0 = 0.f, s1 = 0.f; const unsigned ww[4] = {uu[j].x, uu[j].y, uu[j].z, uu[j].w};
#pragma unroll
                for (int q4 = 0; q4 < 4; ++q4) {
                    const f32x2 r0 = __builtin_amdgcn_cvt_scalef32_pk_f32_fp4(ww[q4], 1.0f, 0), r1 = __builtin_amdgcn_cvt_scalef32_pk_f32_fp4(ww[q4], 1.0f, 1), r2 = __builtin_amdgcn_cvt_scalef32_pk_f32_fp4(ww[q4], 1.0f, 2), r3 = __builtin_amdgcn_cvt_scalef32_pk_f32_fp4(ww[q4], 1.0f, 3);
                    s0 += r0.x * x[8 * q4] + r1.x * x[8 * q4 + 2] + r2.x * x[8 * q4 + 4] + r3.x * x[8 * q4 + 6];
                    s1 += r0.y * x[8 * q4 + 1] + r1.y * x[8 * q4 + 3] + r2.y * x[8 * q4 + 5] + r3.y * x[8 * q4 + 7]; }
                dd[j] = s0 + s1; }
#pragma unroll
            for (int j = 0; j < 2; ++j) dd[j] = wave_sum_dpp(dd[j]);
            const int l0 = (2 * g) & 63;
            const pg8::f32x2 ge = pg8::gelu_pk((pg8::f32x2){dd[0] * readlane_f(suv, l0), dd[1] * readlane_f(suv, l0 + 1)});
            const float a0 = ge.x * readlane_f(gvv, l0), a1 = ge.y * readlane_f(gvv, l0 + 1);
            { const f32x32 r = __builtin_amdgcn_cvt_scalef32_pk32_f32_fp6(vv[0], 1.0f);
#pragma unroll
              for (int i = 0; i < 32; ++i) o[i] += a0 * r[i]; }
            { const f32x32 r = __builtin_amdgcn_cvt_scalef32_pk32_f32_fp6(vv[1], 1.0f);
#pragma unroll
              for (int i = 0; i < 32; ++i) o[i] += a1 * r[i]; }
        };
        issue(0, ua, va);
        for (int g = 0; g < 64; g += 2) {
            issue(g + 1, ub, vb);
            consume(g, ua, va);
            if (g + 2 < 64) issue(g + 2, ua, va);
            consume(g + 1, ub, vb);
        }
        float s = 0.f;
#pragma unroll
        for (int i = 0; i < 32; ++i) { o[i] += DN_ALPHA * x[i]; s += o[i]; }
        const float mean = wave_sum_dpp(s) * (1.0f / D); float q = 0.f;
#pragma unroll
        for (int i = 0; i < 32; ++i) { o[i] -= mean; q += o[i] * o[i]; }
        const float rstd = 1.0f / sqrtf(wave_sum_dpp(q) * (1.0f / D) + LN_EPS);
        float* orow = P.out + (size_t)tok * D + lo * 32;
#pragma unroll
        for (int c = 0; c < 8; ++c) {
            const int off = lo * 32 + 4 * c;
            const f32x4 g0 = *(const f32x4*)(P.in[I_LN2G] + off), b0 = *(const f32x4*)(P.in[I_LN2B] + off);
            f32x4 r0;
            r0.x = o[4 * c + 0] * rstd * g0.x + b0.x; r0.y = o[4 * c + 1] * rstd * g0.y + b0.y; r0.z = o[4 * c + 2] * rstd * g0.z + b0.z; r0.w = o[4 * c + 3] * rstd * g0.w + b0.w;
            *(f32x4*)(orow + 4 * c) = r0;
        }
    }
}
__device__ __forceinline__ void phase5b(const Params& P) {
    const int lane = threadIdx.x & 63, wave = threadIdx.x >> 6;
    const int gw = blockIdx.x * 8 + wave, NGW = gridDim.x * 8;
    unsigned char* ws = P.ws;
    for (int r = gw; r < NTOK; r += NGW)
        ln_row_bf16((const float*)(ws + WS_X1) + (size_t)r * D, P.in[I_LN1G], P.in[I_LN1B], (bf16_t*)(ws + WS_H1B) + (size_t)r * D, lane);
}

#define CE_DESC(a, b) do { const float h_ = fmaxf((a), (b)), l_ = fminf((a), (b)); (a) = h_; (b) = l_; } while (0)
template <int N> __device__ __forceinline__ void bitonic_sort_desc(float (&v)[N]) {
#pragma unroll
    for (int k = 2; k <= N; k <<= 1)
#pragma unroll
        for (int j = k >> 1; j > 0; j >>= 1)
#pragma unroll
            for (int i = 0; i < N; ++i) { const int l = i ^ j; if (l > i) { if ((i & k) == 0) CE_DESC(v[i], v[l]); else CE_DESC(v[l], v[i]); } }
}
template <int N> __device__ __forceinline__ void bitonic_merge_desc(float (&v)[N]) {
#pragma unroll
    for (int j = N >> 1; j > 0; j >>= 1)
#pragma unroll
        for (int i = 0; i < N; ++i) { const int l = i ^ j; if (l > i) CE_DESC(v[i], v[l]); }
}
__device__ __forceinline__ void top16_merge(float (&a)[16], const float (&brev)[16]) {
#pragma unroll
    for (int i = 0; i < 16; ++i) a[i] = fmaxf(a[i], brev[i]);
    bitonic_merge_desc<16>(a);
}
__device__ __forceinline__ float embed_bits(float v, unsigned code, unsigned mask) { return __uint_as_float((__float_as_uint(v) & ~mask) | code); }

__device__ __forceinline__ void phase7(const Params& P, ldsp lds) {
    const int tid0 = threadIdx.x;
    unsigned char* ws = P.ws;
    const bf16_t* qb = (const bf16_t*)(ws + WS_Q); const bf16_t* sk = (const bf16_t*)(ws + WS_SUBK);
    constexpr int LDSK = 136, O_SK = 0, O_SV = 2 * 128 * LDSK * 2, O_EX = O_SV + 32768, O_GT = O_EX + 16384;
    for (int idx = tid0; idx < 2 * 128 * 16; idx += 512) { const int row = idx >> 4, ch = idx & 15;
        *(LAS u32x4*)(lds + O_SK + (row * LDSK + ch * 8) * 2) = *(const u32x4*)(sk + row * 128 + ch * 8); }
    BLOCK_SYNC();
    for (int tile = blockIdx.x; tile < 256; tile += gridDim.x) {
        int tid = tid0; asm volatile("" : "+v"(tid));
        const int lane = tid & 63, wave = tid >> 6, fr = lane & 15, fq = lane >> 4, fro = fr, fqo = fq;
        const int tok0 = tile * 32, h = wave;
#pragma unroll 1
        for (int cb = 0; cb < 4; ++cb) {
            const int nt = cb >> 1, p = cb & 1;
            f32x4 acc[8];
#pragma unroll
            for (int mt = 0; mt < 8; ++mt) acc[mt] = (f32x4){0.f, 0.f, 0.f, 0.f};
            const bf16_t* qrow = qb + (size_t)(tok0 + 16 * nt + fro) * D + h * 256 + p * 128 + fqo * 8;
#pragma unroll
            for (int ks = 0; ks < 4; ++ks) {
                const bf16x8 bq = *(const bf16x8*)(qrow + ks * 32);
#pragma unroll
                for (int mt = 0; mt < 8; ++mt) acc[mt] = mfma16(*(const LAS bf16x8*)(lds + O_SK + ((p * 128 + 16 * mt + fro) * LDSK + ks * 32 + fqo * 8) * 2), bq, acc[mt]);
            }
            float a[16], b[16];
#pragma unroll
            for (int mt = 0; mt < 4; ++mt) {
                a[4 * mt + 0] = embed_bits(acc[mt].x, 16 * mt + 4 * fq + 0, 127u); a[4 * mt + 1] = embed_bits(acc[mt].y, 16 * mt + 4 * fq + 1, 127u);
                a[4 * mt + 2] = embed_bits(acc[mt].z, 16 * mt + 4 * fq + 2, 127u); a[4 * mt + 3] = embed_bits(acc[mt].w, 16 * mt + 4 * fq + 3, 127u);
                b[4 * mt + 0] = embed_bits(acc[mt + 4].x, 16 * (mt + 4) + 4 * fq + 0, 127u); b[4 * mt + 1] = embed_bits(acc[mt + 4].y, 16 * (mt + 4) + 4 * fq + 1, 127u);
                b[4 * mt + 2] = embed_bits(acc[mt + 4].z, 16 * (mt + 4) + 4 * fq + 2, 127u); b[4 * mt + 3] = embed_bits(acc[mt + 4].w, 16 * (mt + 4) + 4 * fq + 3, 127u);
            }
            bitonic_sort_desc<16>(a); bitonic_sort_desc<16>(b);
            { float br[16];
#pragma unroll
              for (int i = 0; i < 16; ++i) br[i] = b[15 - i];
              top16_merge(a, br); }
#pragma unroll
            for (int x = 16; x <= 32; x <<= 1) { float br[16];
#pragma unroll
                for (int i = 0; i < 16; ++i) br[i] = __shfl_xor(a[15 - i], x);
                top16_merge(a, br); }
            if (fq == 0) { LAS f32x4* o = (LAS f32x4*)(lds + O_SV + ((((16 * nt + fr) * 8 + h) * 2 + p) * 16) * 4);
                o[0] = (f32x4){a[0], a[1], a[2], a[3]}; o[1] = (f32x4){a[4], a[5], a[6], a[7]}; o[2] = (f32x4){a[8], a[9], a[10], a[11]}; o[3] = (f32x4){a[12], a[13], a[14], a[15]}; }
        }
        BLOCK_SYNC();
        if (tid < 256) {
            const int tok = tid >> 3, hh = tid & 7;
            const LAS f32x4* s = (const LAS f32x4*)(lds + O_SV + (((tok * 8 + hh) * 2) * 16) * 4);
            float s0[16], s1[16];
#pragma unroll
            for (int c4 = 0; c4 < 4; ++c4) { const f32x4 x = s[c4], y = s[4 + c4]; s0[4 * c4] = x.x; s0[4 * c4 + 1] = x.y; s0[4 * c4 + 2] = x.z; s0[4 * c4 + 3] = x.w; s1[4 * c4] = y.x; s1[4 * c4 + 1] = y.y; s1[4 * c4 + 2] = y.z; s1[4 * c4 + 3] = y.w; }
            float g0[16], g1[16], g2[16], g3[16];
            const float NEG = -3.0e38f;
#pragma unroll
            for (int bq = 0; bq < 16; ++bq) g0[bq] = embed_bits(s0[0] + s1[bq], bq, 255u);
            {
                int n1 = 0, n2 = 0, n3 = 0;
#pragma unroll
                for (int aa = 1; aa < 16; ++aa)
#pragma unroll
                    for (int bb = 0; bb < 16; ++bb) if ((aa + 1) * (bb + 1) <= 16) {
                        const float c = embed_bits(s0[aa] + s1[bb], aa * 16 + bb, 255u);
                        if (n1 < 16) g1[n1++] = c; else if (n2 < 16) g2[n2++] = c; else g3[n3++] = c;
                    }
#pragma unroll
                for (int i = 0; i < 16; ++i) if (i >= n3) g3[i] = NEG;
            }
            bitonic_sort_desc<16>(g1); bitonic_sort_desc<16>(g2); bitonic_sort_desc<16>(g3);
            { float r1[16], r3[16];
#pragma unroll
              for (int i = 0; i < 16; ++i) { r1[i] = g1[15 - i]; r3[i] = g3[15 - i]; }
              top16_merge(g0, r1); top16_merge(g2, r3);
#pragma unroll
              for (int i = 0; i < 16; ++i) g0[i] = fmaxf(g0[i], g2[15 - i]); }
            float mx = g0[0];
#pragma unroll
            for (int i = 1; i < 16; ++i) mx = fmaxf(mx, g0[i]);
            float ex[16], sm = 0.f; int ee[16];
#pragma unroll
            for (int i = 0; i < 16; ++i) {
                ex[i] = __expf(g0[i] - mx); sm += ex[i];
                const unsigned code = __float_as_uint(g0[i]) & 255u;
                const unsigned i0 = __float_as_uint(*(const LAS float*)(lds + O_SV + ((((tok * 8 + hh) * 2 + 0) * 16) + (code >> 4)) * 4)) & 127u;
                const unsigned i1 = __float_as_uint(*(const LAS float*)(lds + O_SV + ((((tok * 8 + hh) * 2 + 1) * 16) + (code & 15u)) * 4)) & 127u;
                ee[i] = (int)(i0 * 128u + i1);
            }
            const float inv = 1.0f / sm;
            LAS int* eo = (LAS int*)(lds + O_EX) + tok * 128 + hh * 16; LAS float* go = (LAS float*)(lds + O_GT) + tok * 128 + hh * 16;
#pragma unroll
            for (int c4 = 0; c4 < 4; ++c4) {
                *(LAS u32x4*)(eo + 4 * c4) = (u32x4){(unsigned)ee[4 * c4], (unsigned)ee[4 * c4 + 1], (unsigned)ee[4 * c4 + 2], (unsigned)ee[4 * c4 + 3]};
                *(LAS f32x4*)(go + 4 * c4) = (f32x4){ex[4 * c4] * inv, ex[4 * c4 + 1] * inv, ex[4 * c4 + 2] * inv, ex[4 * c4 + 3] * inv};
            }
        }
        BLOCK_SYNC();
#pragma unroll 1
        for (int i = 0; i < 4; ++i) peer_token(P, tok0 + wave * 4 + i, (const LAS int*)(lds + O_EX) + (wave * 4 + i) * 128, (const LAS float*)(lds + O_GT) + (wave * 4 + i) * 128);
        BLOCK_SYNC();
    }
}
#ifndef MK_MULTI
#define MK_MULTI 0
#endif
__global__ __launch_bounds__(512, 2) void hybrid_fwd(Params P) {
    extern __shared__ __attribute__((aligned(16))) unsigned char shm[];
    ldsp lds = (ldsp)shm;
    unsigned char* ws = P.ws;
    volatile LAS unsigned* xst = (volatile LAS unsigned*)(lds + LDS_BYTES - 16);
    if (threadIdx.x == 0) { xst[0] = 0u; xst[1] = 0u; }
    __syncthreads();
    const XcdBarrier xbar = xcd_barrier_post((unsigned*)(ws + WS_BAR), xst);
    const int lo = P.ph_lo, hi = P.ph_hi;
#ifdef DBG_TA
    unsigned long long ts0 = 0, ts1 = 0, ts2 = 0, ts3 = 0, ts4 = 0, ts5 = 0, ts6 = 0, ts7 = 0, ts8 = 0, ts9 = 0, ts10 = 0, ts11 = 0;
#define STAMP(k) ts##k = __builtin_amdgcn_s_memrealtime()
#else
#define STAMP(k) do { } while (0)
#endif
    STAMP(0);
#ifndef REPEAT_PHASE
#define REPEAT_PHASE -1
#define REPEAT_N 1
#endif
#define PHASE(k) if (lo <= (k) && (k) < hi) for (int rep_ = 0; rep_ < ((k) == REPEAT_PHASE ? REPEAT_N : 1); ++rep_)
#define SEAM(k) do { if (lo <= (k) && (k) + 1 < hi) xcd_barrier(xbar); } while (0)
    PHASE(0) phase0(P);
    SEAM(0); STAMP(1);
    PHASE(1) { pg8::EpiBf16<0> E; E.O = (bf16_t*)(ws + WS_P); E.ldc = NPAD; E.bias = nullptr; E.split_cols = 0; E.split_stride = 0;
        run_gemm(lds, (const bf16_t*)(ws + WS_H0B), (const bf16_t*)(ws + WS_WTIN), MROWS, NPAD, 2048, E); }
    SEAM(1); STAMP(2);
    PHASE(2) phase2(P, lds);
    SEAM(2); STAMP(3);
    PHASE(3) phase3(P);
    SEAM(3); STAMP(4);
    PHASE(4) phase3b(P, lds);
    SEAM(4); STAMP(5);
    PHASE(5) {
        { pg8::EpiGateA E; E.C = (float*)(ws + WS_MPART); E.p = (const bf16_t*)(ws + WS_P); E.bgate = P.in[I_BGATE];
          run_gemm(lds, (const bf16_t*)(ws + WS_YA), (const bf16_t*)(ws + WS_WTA), NTOK, 2048, 2048, E); }
        { pg8::EpiGateB E; E.C = (const float*)(ws + WS_MPART); E.O = (bf16_t*)(ws + WS_MERGED); E.p = (const bf16_t*)(ws + WS_P); E.bgate = P.in[I_BGATE];
          run_gemm(lds, (const bf16_t*)(ws + WS_YB), (const bf16_t*)(ws + WS_WTB), NTOK, 2048, 1024, E); }
    }
    SEAM(5); STAMP(6);
    PHASE(6) { pg8::EpiResid E; E.C = (float*)(ws + WS_X1); E.h0 = (const bf16_t*)(ws + WS_H0B); E.alpha = DN_ALPHA;
        run_gemm(lds, (const bf16_t*)(ws + WS_MERGED), (const bf16_t*)(ws + WS_WTOUT), NTOK, 2048, 2048, E); }
    SEAM(6); STAMP(7);
    PHASE(7) phase5b(P);
    SEAM(7); STAMP(8);
    PHASE(8) { pg8::EpiBf16<0> E; E.O = (bf16_t*)(ws + WS_Q); E.ldc = D; E.bias = nullptr; E.split_cols = 0; E.split_stride = 0;
        run_gemm(lds, (const bf16_t*)(ws + WS_H1B), (const bf16_t*)(ws + WS_WTQ), NTOK, 2048, 2048, E); }
    SEAM(8); STAMP(9);
    PHASE(9) phase7(P, lds);
#ifdef DBG_TA
    {
        __threadfence_system(); asm volatile("s_waitcnt vmcnt(0) lgkmcnt(0)" ::: "memory"); __syncthreads(); grid.sync(); __threadfence_system();
        STAMP(11);
        const unsigned long long tt[12] = {ts0, ts1, ts2, ts3, ts4, ts5, ts6, ts7, ts8, ts9, ts9, ts11};
        const float ta = (float)(tt[DBG_TA + 1] - tt[DBG_TA]) * 0.01f, tb = (float)(tt[DBG_TB + 1] - tt[DBG_TB]) * 0.01f;
        if (blockIdx.x == 0) { for (int i = threadIdx.x + 1; i <= 1000000; i += 512) P.out[i] = tb; if (threadIdx.x == 0) P.out[0] = 1000.0f * ta; }
    }
#endif
#ifdef DBG_STOP
    {
        __threadfence_system(); asm volatile("s_waitcnt vmcnt(0) lgkmcnt(0)" ::: "memory"); __syncthreads(); grid.sync(); __threadfence_system();
        const size_t a = DBG_A, b = DBG_B; const unsigned* w = (const unsigned*)(ws + a); const size_t nw = (b - a) / 4, NO = (size_t)NTOK * D;
        for (size_t i = (size_t)blockIdx.x * 512 + threadIdx.x; i < NO; i += (size_t)gridDim.x * 512) {
            unsigned acc = 0; for (size_t j = i; j < nw; j += NO) { const unsigned x = w[j]; acc += (x & 0xffffu) + (x >> 16); }
            P.out[i] = (float)(acc & 0xfffffu);
        }
    }
#endif
#undef PHASE
#undef SEAM
}

extern "C" void kernel_launch(void* const* d_in, const int* in_sizes, int n_in, void* d_out, int out_size, void* d_ws, size_t ws_size, hipStream_t stream) {
    static int grid = 0;
    if (grid == 0) {
        if (n_in != 30 || out_size != NTOK * D || ws_size < WS_END) { fprintf(stderr, "kernel_launch: unexpected shapes (n_in %d, out %d, ws %zu < %zu)\n", n_in, out_size, ws_size, (size_t)WS_END); grid = -1; return; }
        int dev = 0, cus = 0, per_cu = 0;
        if (hipGetDevice(&dev) != hipSuccess || hipDeviceGetAttribute(&cus, hipDeviceAttributeMultiprocessorCount, dev) != hipSuccess) { grid = -1; return; }
        if (hipFuncSetAttribute((const void*)hybrid_fwd, hipFuncAttributeMaxDynamicSharedMemorySize, LDS_BYTES) != hipSuccess) { fprintf(stderr, "kernel_launch: hipFuncSetAttribute failed\n"); grid = -1; return; }
        if (hipOccupancyMaxActiveBlocksPerMultiprocessor(&per_cu, (const void*)hybrid_fwd, 512, LDS_BYTES) != hipSuccess || per_cu < 1) { fprintf(stderr, "kernel_launch: occupancy query says %d\n", per_cu); grid = -1; return; }
        (void)hipGetLastError();
        grid = cus;
    }
    if (grid < 0) return;
    if (hipMemsetAsync((unsigned char*)d_ws + WS_BAR, 0, XCD_BAR_WORDS * 4, stream) != hipSuccess) { fprintf(stderr, "kernel_launch: memset failed\n"); return; }
    Params p{};
    for (int i = 0; i < 30; ++i) p.in[i] = (const float*)d_in[i];
    p.out = (float*)d_out; p.ws = (unsigned char*)d_ws;
#if MK_MULTI
    for (int ph = 0; ph <= NPHASE; ++ph) { p.ph_lo = ph; p.ph_hi = ph + 1; hipLaunchKernelGGL(hybrid_fwd, dim3(grid), dim3(512), LDS_BYTES, stream, p); }
#else
    p.ph_lo = 0; p.ph_hi = NPHASE + 1;
#ifdef DBG_STOP
    p.ph_hi = DBG_STOP + 1;
#endif
    void* args[] = {&p};
    hipError_t e = hipLaunchCooperativeKernel((const void*)hybrid_fwd, dim3(grid), dim3(512), args, LDS_BYTES, stream);
    if (e != hipSuccess) fprintf(stderr, "kernel_launch: cooperative launch failed: %s (grid %d)\n", hipGetErrorString(e), grid);
#endif
}
```

```cpp
#include <hip/hip_runtime.h>
#include <hip/hip_cooperative_groups.h>
#include <cstdio>
#include <cstdint>
namespace cg = cooperative_groups;
namespace pg8 {
#define PG8_LAS __attribute__((address_space(3)))
typedef unsigned short bf16_t;
typedef short bf16x8 __attribute__((ext_vector_type(8)));
typedef float f32x4 __attribute__((ext_vector_type(4)));
typedef unsigned u32x4 __attribute__((ext_vector_type(4)));
constexpr int BM = 256, BK = 64, HALF = 128, HTB = HALF * BK * 2  , STAGE_BYTES = 8 * HTB, NXCD = 8, WGM = 8;

__host__ __device__ __forceinline__ int lds_byte(int r, int c) { const int st = (r >> 4) * 2 + (c >> 5), rr = r & 15, cc = c & 31, ob = rr * 64 + cc * 2; return st * 1024 + (ob ^ (((ob >> 9) & 1) << 5)); }
__host__ __device__ __forceinline__ void stage_rc(int b, int& R, int& C) { const int st = b / 1024, sb = b % 1024, swz = sb ^ (((sb >> 9) & 1) << 5); R = (st >> 1) * 16 + swz / 64; C = (st & 1) * 32 + (swz % 64) / 2; }
__host__ __device__ __forceinline__ int perm32(int rho) { const int n = rho >> 4, i = rho & 15; return 8 * (i >> 2) + 4 * n + (i & 3); }

struct Unit { int pm, pn; };
struct Gemm { const bf16_t* A; const bf16_t* Bt; int M, N, K; };

struct StaticOrder {
    int nM, nN, nwg, G, c;
    __host__ __device__ void init(int M, int N, int G_, int c_) { nM = M / BM; nN = N / BM; nwg = nM * nN; G = G_; c = c_; }
    __host__ __device__ bool next(int i, Unit& u) const {
        const long L = (long)i * G + c; if (L >= nwg) return false;
        int wgid = (int)L; { const int q = nwg / NXCD, r = nwg % NXCD, xcd = wgid % NXCD, off = wgid / NXCD; wgid = (xcd < r ? xcd * (q + 1) : r * (q + 1) + (xcd - r) * q) + off; }
        const int nig = WGM * nN, gid = wgid / nig, fm = gid * WGM, gsz = (nM - fm) < WGM ? (nM - fm) : WGM;
        u.pm = fm + ((wgid % nig) % gsz); u.pn = (wgid % nig) / gsz; return true;
    }
    __device__ __forceinline__ void a_ready(const Unit&) const {}
    __device__ __forceinline__ void done(const Unit&) const {}
};
struct CountedOrder : StaticOrder {
    const unsigned* ready; unsigned need; unsigned* tmo;
    __device__ __forceinline__ void a_ready(const Unit& u) const {
        if (threadIdx.x < 64) {
            const unsigned long long t0 = __builtin_amdgcn_s_memrealtime(); unsigned polls = 0;
            while ((unsigned)__builtin_amdgcn_readfirstlane(__hip_atomic_load(ready + 64 * u.pm, __ATOMIC_RELAXED, __HIP_MEMORY_SCOPE_AGENT)) < need) {
                if ((++polls & 255u) == 0u && __builtin_amdgcn_readfirstlane(__hip_atomic_load(tmo, __ATOMIC_RELAXED, __HIP_MEMORY_SCOPE_AGENT)) != 0u) break;
                if (__builtin_amdgcn_s_memrealtime() - t0 > 2000000ull) {
                    if (threadIdx.x == 0) { unsigned expect = 0u; __hip_atomic_compare_exchange_strong(tmo + 1, &expect, 0x600u | (unsigned)(u.pm & 0xff), __ATOMIC_RELAXED, __ATOMIC_RELAXED, __HIP_MEMORY_SCOPE_AGENT); __hip_atomic_store(tmo, 1u, __ATOMIC_RELAXED, __HIP_MEMORY_SCOPE_AGENT); }
                    break; }
                __builtin_amdgcn_s_sleep(2); }
            __builtin_amdgcn_fence(__ATOMIC_ACQUIRE, "agent");
            asm volatile("s_waitcnt vmcnt(0)" ::: "memory");
        }
#if !defined(BROKEN_HOOK_NO_BARRIER)
        asm volatile("" ::: "memory"); __builtin_amdgcn_s_barrier(); asm volatile("" ::: "memory");
#endif
    }
};

typedef float cvt_f32x2 __attribute__((ext_vector_type(2))); typedef __bf16 cvt_bf16x2 __attribute__((ext_vector_type(2)));
__device__ __forceinline__ unsigned cvt_pk_bf16(float lo, float hi) { const cvt_f32x2 v = {lo, hi}; const cvt_bf16x2 b = __builtin_convertvector(v, cvt_bf16x2); return __builtin_bit_cast(unsigned, b); }
typedef float f32x2 __attribute__((ext_vector_type(2)));
__device__ __forceinline__ f32x2 gelu_pk(f32x2 v) {
    const f32x2 av = __builtin_elementwise_abs(v), d = av * 0.2316418882f + 1.0f;
    f32x2 t; t.x = __builtin_amdgcn_rcpf(d.x); t.y = __builtin_amdgcn_rcpf(d.y);
    f32x2 q = t * 0.5307027145f + (-0.7265760135f); q = q * t + 0.7107068705f; q = q * t + (-0.142248368f); q = q * t + 0.127414796f; q = q * t;
    const f32x2 s = (v * v) * (-0.72134752044f);
    f32x2 e; e.x = __builtin_amdgcn_exp2f(s.x); e.y = __builtin_amdgcn_exp2f(s.y);
    const f32x2 m = v * (q * e), r = v - m;
    f32x2 o; o.x = v.x < 0.f ? m.x : r.x; o.y = v.y < 0.f ? m.y : r.y; return o;
}

struct EpiF32 {
    static constexpr bool PERM = false, AFTER_DRAIN = false; static constexpr int MID_T = -1;
    float* C; int ldc; const float* bias;
    __device__ __forceinline__ void operator()(const f32x4 (&acc)[2][2][4][2], const Unit& u, int wr, int wc, int fr, int fq) const {
        const int row0 = u.pm * BM + wr * 64 + fr, col0 = u.pn * BM + wc * 32 + 4 * fq;
        f32x4 bv[2][2];
#pragma unroll
        for (int bj = 0; bj < 2; ++bj)
#pragma unroll
            for (int n = 0; n < 2; ++n) bv[bj][n] = bias ? *(const f32x4*)(bias + col0 + bj * HALF + n * 16) : (f32x4){0.f, 0.f, 0.f, 0.f};
#pragma unroll
        for (int ai = 0; ai < 2; ++ai)
#pragma unroll
            for (int m = 0; m < 4; ++m) { float* rowp = C + (size_t)(row0 + ai * HALF + m * 16) * ldc + col0;
#pragma unroll
                for (int bj = 0; bj < 2; ++bj)
#pragma unroll
                    for (int n = 0; n < 2; ++n) *(f32x4*)(rowp + bj * HALF + n * 16) = acc[ai][bj][m][n] + bv[bj][n]; }
    }
};
template <int ACT  > struct EpiBf16 {
    static constexpr bool PERM = true, AFTER_DRAIN = false; static constexpr int MID_T = -1;
    bf16_t* O; int ldc; const float* bias; int split_cols; size_t split_stride;
    __device__ __forceinline__ void operator()(const f32x4 (&acc)[2][2][4][2], const Unit& u, int wr, int wc, int fr, int fq) const {
        const int row0 = u.pm * BM + wr * 64 + fr; int colt = u.pn * BM; bf16_t* base = O;
        if (split_cols) { const int t = colt / split_cols; base += (size_t)t * split_stride; colt -= t * split_cols; }
        const int col0 = colt + wc * 32 + 8 * fq, bcol0 = u.pn * BM + wc * 32 + 8 * fq;
        f32x4 bv[2][2];
#pragma unroll
        for (int bj = 0; bj < 2; ++bj)
#pragma unroll
            for (int n = 0; n < 2; ++n) bv[bj][n] = bias ? *(const f32x4*)(bias + bcol0 + bj * HALF + 4 * n) : (f32x4){0.f, 0.f, 0.f, 0.f};
#pragma unroll
        for (int ai = 0; ai < 2; ++ai)
#pragma unroll
            for (int m = 0; m < 4; ++m) { bf16_t* rowp = base + (size_t)(row0 + ai * HALF + m * 16) * ldc + col0;
#pragma unroll
                for (int bj = 0; bj < 2; ++bj) { f32x4 v0 = acc[ai][bj][m][0] + bv[bj][0], v1 = acc[ai][bj][m][1] + bv[bj][1];
                    if (ACT == 1) { f32x2 a = gelu_pk((f32x2){v0[0], v0[1]}), b = gelu_pk((f32x2){v0[2], v0[3]}), c = gelu_pk((f32x2){v1[0], v1[1]}), d = gelu_pk((f32x2){v1[2], v1[3]});
                        v0 = (f32x4){a.x, a.y, b.x, b.y}; v1 = (f32x4){c.x, c.y, d.x, d.y}; }
                    if (ACT == 2) {
#pragma unroll
                        for (int j = 0; j < 4; ++j) { v0[j] = 0.5f * v0[j] * (1.0f + erff(v0[j] * 0.70710678f)); v1[j] = 0.5f * v1[j] * (1.0f + erff(v1[j] * 0.70710678f)); } }
                    u32x4 w; w.x = cvt_pk_bf16(v0[0], v0[1]); w.y = cvt_pk_bf16(v0[2], v0[3]); w.z = cvt_pk_bf16(v1[0], v1[1]); w.w = cvt_pk_bf16(v1[2], v1[3]);
                    *(u32x4*)(rowp + bj * HALF) = w; } }
    }
};
template <class Epi, class Sched, bool STAMP = false>
__device__ __forceinline__ void gemm_phase(PG8_LAS unsigned char* lds, const Gemm g, const Sched& S, const Epi& E, unsigned long long* stamps) {
    const int tid = threadIdx.x, wid = __builtin_amdgcn_readfirstlane(tid >> 6), lane = tid & 63, wr = wid >> 2, wc = wid & 3, fr = lane & 15, fq = lane >> 4;
    const int K = g.K, nt = K / BK;
    int ts_lo = 0, ts_hi = 0, nts = 0; const unsigned long long rt_entry = STAMP ? (unsigned long long)wall_clock64() : 0ull;
#define PG8_STAMP() do { if (STAMP && wid == 0 && nts < 64) { const unsigned long long _c = (unsigned long long)clock64(); \
        ts_lo = (lane == nts) ? (int)(unsigned)_c : ts_lo; ts_hi = (lane == nts) ? (int)(unsigned)(_c >> 32) : ts_hi; ++nts; } } while (0)
    PG8_STAMP();
    unsigned voffA[2], voffB[2];
#pragma unroll
    for (int i = 0; i < 2; ++i) { int R, C; stage_rc(tid * 16 + i * 8192, R, C); const int Rb = Epi::PERM ? ((R & ~31) + perm32(R & 31)) : R;
        voffA[i] = (unsigned)(R * K + C) * 2u; voffB[i] = (unsigned)(Rb * K + C) * 2u; }
    const size_t kstep = (size_t)(BK * 2);
    const size_t hstep = (size_t)HALF * K * 2;
    const size_t tstep = 2 * hstep;
    const unsigned ldsw = (unsigned)wid * 1024u;
    const int aoff = lds_byte(wr * 64 + fr, fq * 8), boff = lds_byte(wc * 32 + fr, fq * 8);
#define PG8_SA(b, h) (((b) * 2 + (h)) * HTB)
#define PG8_SB(b, h) ((4 + (b) * 2 + (h)) * HTB)
#define PG8_STAGE(bufoff, gbase, voff) do { _Pragma("unroll") for (int _i = 0; _i < 2; ++_i) \
        __builtin_amdgcn_global_load_lds((const unsigned*)((const char*)(gbase) + (voff)[_i]), (PG8_LAS unsigned*)(lds + (bufoff) + ldsw + _i * 8192), 16, 0, 0); } while (0)
#define PG8_LDA(dst, b, h) do { _Pragma("unroll") for (int m = 0; m < 4; ++m) _Pragma("unroll") for (int k = 0; k < 2; ++k) dst[m][k] = *(const PG8_LAS bf16x8*)(lds + PG8_SA(b, h) + aoff + m * 2048 + k * 1024); } while (0)
#define PG8_LDB(dst, b, h) do { _Pragma("unroll") for (int n = 0; n < 2; ++n) _Pragma("unroll") for (int k = 0; k < 2; ++k) dst[n][k] = *(const PG8_LAS bf16x8*)(lds + PG8_SB(b, h) + boff + n * 2048 + k * 1024); } while (0)
#define PG8_MMA(ai, bj, At, Bt) do { __builtin_amdgcn_s_setprio(1); _Pragma("unroll") for (int m = 0; m < 4; ++m) _Pragma("unroll") for (int n = 0; n < 2; ++n) _Pragma("unroll") for (int k = 0; k < 2; ++k) \
        acc[ai][bj][m][n] = __builtin_amdgcn_mfma_f32_16x16x32_bf16(Bt[n][k], At[m][k], acc[ai][bj][m][n], 0, 0, 0); __builtin_amdgcn_s_setprio(0); } while (0)
#define PG8_WAIT_V(n) asm volatile("s_waitcnt vmcnt(" #n ")" ::: "memory")
#define PG8_WAIT_L(n) asm volatile("s_waitcnt lgkmcnt(" #n ")" ::: "memory")
#define PG8_BAR __builtin_amdgcn_s_barrier()
#define PG8_SCHED __builtin_amdgcn_sched_barrier(0)
    Unit cur, nxt; int ui = 0;
    if (!S.next(0, cur)) return;
    f32x4 acc[2][2][4][2];
#pragma unroll
    for (int a = 0; a < 2; ++a)
#pragma unroll
        for (int b = 0; b < 2; ++b)
#pragma unroll
            for (int m = 0; m < 4; ++m)
#pragma unroll
                for (int n = 0; n < 2; ++n) acc[a][b][m][n] = (f32x4){0.f, 0.f, 0.f, 0.f};
    bf16x8 At[4][2], B0[2][2], B1[2][2];
    const char* cA = (const char*)g.A + (size_t)cur.pm * tstep; const char* cB = (const char*)g.Bt + (size_t)cur.pn * tstep;
    S.a_ready(cur);
    PG8_STAGE(PG8_SB(0, 0), cB, voffB); PG8_STAGE(PG8_SA(0, 0), cA, voffA); PG8_STAGE(PG8_SB(0, 1), cB + hstep, voffB); PG8_STAGE(PG8_SA(0, 1), cA + hstep, voffA);
    if (wr == 1) PG8_BAR;
    PG8_WAIT_V(4); PG8_BAR;
    PG8_STAGE(PG8_SB(1, 0), cB + kstep, voffB); PG8_STAGE(PG8_SA(1, 0), cA + kstep, voffA); PG8_STAGE(PG8_SB(1, 1), cB + hstep + kstep, voffB);
    PG8_WAIT_V(6); PG8_BAR;
    PG8_STAMP();
    for (;;) {
        const bool has_next = S.next(ui + 1, nxt);
        const char* nA = has_next ? (const char*)g.A + (size_t)nxt.pm * tstep : cA; const char* nB = has_next ? (const char*)g.Bt + (size_t)nxt.pn * tstep : cB;
        for (int t = 0; t < nt; t += 2) {
            const bool last = (t == nt - 2);
            const char* a1 = cA + (size_t)(t + 1) * kstep;
            const char* a2 = last ? nA : cA + (size_t)(t + 2) * kstep; const char* b2 = last ? nB : cB + (size_t)(t + 2) * kstep;
            const char* a3 = a2 + kstep; const char* b3 = b2 + kstep;
            if (last && has_next) S.a_ready(nxt);
            if constexpr (Epi::MID_T >= 0) { if (t == Epi::MID_T) E.mid(acc, cur, wr, wc, fr, fq); }
            PG8_LDB(B0, 0, 0); PG8_SCHED; PG8_LDA(At, 0, 0); PG8_STAGE(PG8_SA(1, 1), a1 + hstep, voffA);
            PG8_WAIT_L(8); PG8_BAR; PG8_WAIT_L(0); PG8_MMA(0, 0, At, B0); PG8_BAR; PG8_SCHED;
            PG8_LDB(B1, 0, 1); PG8_STAGE(PG8_SB(0, 0), b2, voffB);
            PG8_BAR; PG8_WAIT_L(0); PG8_MMA(0, 1, At, B1); PG8_BAR;
            PG8_LDA(At, 0, 1); PG8_STAGE(PG8_SA(0, 0), a2, voffA);
            PG8_BAR; PG8_WAIT_L(0); PG8_MMA(1, 0, At, B0); PG8_BAR; PG8_SCHED;
            PG8_STAGE(PG8_SB(0, 1), b2 + hstep, voffB);
            PG8_WAIT_V(6); PG8_BAR; PG8_MMA(1, 1, At, B1); PG8_BAR;
            PG8_LDB(B0, 1, 0); PG8_SCHED; PG8_LDA(At, 1, 0); PG8_STAGE(PG8_SA(0, 1), a2 + hstep, voffA);
            PG8_WAIT_L(8); PG8_BAR; PG8_WAIT_L(0); PG8_MMA(0, 0, At, B0); PG8_BAR; PG8_SCHED;
            PG8_LDB(B1, 1, 1); PG8_STAGE(PG8_SB(1, 0), b3, voffB);
            PG8_BAR; PG8_WAIT_L(0); PG8_MMA(0, 1, At, B1); PG8_BAR;
            PG8_LDA(At, 1, 1); PG8_STAGE(PG8_SA(1, 0), a3, voffA);
            PG8_BAR; PG8_WAIT_L(0); PG8_MMA(1, 0, At, B0); PG8_BAR; PG8_SCHED;
            PG8_STAGE(PG8_SB(1, 1), b3 + hstep, voffB);
            PG8_WAIT_V(6); PG8_BAR; PG8_MMA(1, 1, At, B1); PG8_BAR;
        }
        PG8_STAMP();
        if constexpr (!Epi::AFTER_DRAIN) { E(acc, cur, wr, wc, fr, fq); S.done(cur); }
        PG8_STAMP();
        if (!has_next) break;
#pragma unroll
        for (int a = 0; a < 2; ++a)
#pragma unroll
            for (int b = 0; b < 2; ++b)
#pragma unroll
                for (int m = 0; m < 4; ++m)
#pragma unroll
                    for (int n = 0; n < 2; ++n) acc[a][b][m][n] = (f32x4){0.f, 0.f, 0.f, 0.f};
        cur = nxt; cA = nA; cB = nB; ++ui;
    }
    PG8_WAIT_V(0);
    if (wr == 0) PG8_BAR;
    PG8_BAR;
    if constexpr (Epi::AFTER_DRAIN) { E.fused(acc, cur, wr, wc, fr, fq, lds, wid, lane); S.done(cur); }
    PG8_STAMP();
    if (STAMP && wid == 0) { stamps[lane] = lane < nts ? (((unsigned long long)(unsigned)ts_hi << 32) | (unsigned)ts_lo) : 0ull;
        if (lane == 62) stamps[62] = rt_entry; if (lane == 63) stamps[63] = (unsigned long long)wall_clock64(); }
#undef PG8_STAMP
#undef PG8_SA
#undef PG8_SB
#undef PG8_STAGE
#undef PG8_LDA
#undef PG8_LDB
#undef PG8_MMA
#undef PG8_WAIT_V
#undef PG8_WAIT_L
#undef PG8_BAR
#undef PG8_SCHED
}
}
#define LAS __attribute__((address_space(3)))
typedef unsigned short bf16_t;
typedef short bf16x8 __attribute__((ext_vector_type(8)));
typedef float f32x4 __attribute__((ext_vector_type(4)));
typedef float f32x2 __attribute__((ext_vector_type(2)));
typedef unsigned u32x4 __attribute__((ext_vector_type(4)));
typedef unsigned u32x2 __attribute__((ext_vector_type(2)));
typedef LAS unsigned char* ldsp;
typedef float f32x32 __attribute__((ext_vector_type(32)));
typedef float f32x16 __attribute__((ext_vector_type(16)));
typedef unsigned u32x6 __attribute__((ext_vector_type(6)));

constexpr int D = 2048, NTOK = 8192, SEQ = 4096, MROWS = 8448, ROW_META = 8192;
constexpr int INC = 11712, NPAD = 11776;
constexpr int C_R = 0, C_K = 2048, C_V = 4096, C_WL = 6144, C_AL = 6240, C_GL = 6336, C_POOL = 6592, C_G0 = 7616, C_G1 = 9664;
constexpr int NUNITS = 4128;
constexpr float DSCALE = 0.6065306597126334f;
constexpr float DN_ALPHA = 1.189207115002721f;
constexpr float GN_EPS = 64e-5f, LN_EPS = 1e-5f;

constexpr size_t WS_P = 0;
constexpr size_t WS_H0B = 198967296;
constexpr size_t WS_WTAB = WS_H0B + 34603008;
constexpr size_t WS_WTOUT = WS_WTAB + 12582912;
constexpr size_t WS_WTQ = WS_WTOUT + 8388608;
constexpr size_t WS_WTPOOL = WS_WTQ + 8388608;
constexpr size_t WS_WTW2 = WS_WTPOOL + 524288;
constexpr size_t WS_WTA2 = WS_WTW2 + 393216;
constexpr size_t WS_WTG2 = WS_WTA2 + 393216;
constexpr size_t WS_SUBK = WS_WTG2 + 1048576;
constexpr size_t WS_BONUS = WS_SUBK + 65536;
constexpr size_t WS_REGC = WS_BONUS + 1048576;
constexpr size_t WS_WTIN = WS_REGC;
constexpr size_t UNITB = (size_t)NUNITS * 4096 * 2;
constexpr size_t WS_G = WS_REGC;
constexpr size_t WS_H0T = WS_REGC + UNITB;
constexpr size_t WS_RT = WS_REGC + 2 * UNITB;
constexpr size_t WS_Y0 = WS_REGC + 3 * UNITB;
constexpr size_t WS_S0T = WS_REGC + 4 * UNITB;
constexpr size_t WS_YAB = WS_REGC;
constexpr int LDAB = 3072;
constexpr size_t WS_MERGED = WS_REGC + 2 * UNITB;
constexpr size_t WS_X1B = WS_REGC + 3 * UNITB;
constexpr size_t WS_Q = WS_REGC + UNITB;
constexpr size_t TROW = 1536;
constexpr size_t WS_VB = WS_REGC + 5 * UNITB;
constexpr size_t WS_GSIG = WS_VB + 16384 * TROW;
constexpr size_t WS_BAR = WS_GSIG + 4194304;
constexpr size_t WS_STAT = WS_BAR + 16384;
constexpr size_t STAT_BYTES = (8192 * 2 + 2048 * 2) * 4;
constexpr size_t WS_TSC = WS_STAT + STAT_BYTES;
constexpr size_t UROW = 1024;
constexpr size_t WS_UB = WS_TSC + 131072;
constexpr size_t WS_END = WS_UB + 16384 * UROW;
static_assert(WS_YAB + 50331648 <= WS_MERGED, "overlay");

constexpr int LDS_BYTES = 163840;
constexpr int NPHASE = 8;

struct Params {
    const float* in[30];
    float* out;
    unsigned char* ws;
    int ph_lo, ph_hi;
};
enum { I_X = 0, I_META, I_LNIN_G, I_LNIN_B, I_WIN, I_MU, I_W0, I_WW2, I_A0, I_WA2, I_WG2, I_KK, I_KA, I_RK, I_GNG, I_GNB, I_WPOOL, I_PSCALE, I_BGATE,
       I_WBA, I_WBB, I_WOUT, I_LN1G, I_LN1B, I_WQ, I_SUBK, I_UT, I_VT, I_LN2G, I_LN2B };

__device__ __forceinline__ unsigned pk2(float lo, float hi) { return pg8::cvt_pk_bf16(lo, hi); }
__device__ __forceinline__ float bflo(unsigned w) { return __uint_as_float(w << 16); }
__device__ __forceinline__ float bfhi(unsigned w) { return __uint_as_float(w & 0xffff0000u); }
__device__ __forceinline__ float bf1(bf16_t h) { return __uint_as_float(((unsigned)h) << 16); }
__device__ __forceinline__ bf16_t f2bf1(float f) { return (bf16_t)(pk2(f, f) & 0xffffu); }
__device__ __forceinline__ float wave_sum(float v) {
#pragma unroll
    for (int o = 1; o < 64; o <<= 1) v += __shfl_xor(v, o);
    return v;
}
__device__ __forceinline__ float sigmoidf_(float x) { return 1.0f / (1.0f + __expf(-x)); }
__device__ __forceinline__ f32x4 mfma16(bf16x8 a, bf16x8 b, f32x4 c) { return __builtin_amdgcn_mfma_f32_16x16x32_bf16(a, b, c, 0, 0, 0); }
__device__ __forceinline__ void unpack8(const u32x4 w, float* f) {
    f[0] = bflo(w.x); f[1] = bfhi(w.x); f[2] = bflo(w.y); f[3] = bfhi(w.y); f[4] = bflo(w.z); f[5] = bfhi(w.z); f[6] = bflo(w.w); f[7] = bfhi(w.w);
}
__device__ __forceinline__ u32x4 pack8(const float* f) { u32x4 w; w.x = pk2(f[0], f[1]); w.y = pk2(f[2], f[3]); w.z = pk2(f[4], f[5]); w.w = pk2(f[6], f[7]); return w; }
#define DPPF(v, ctrl) __builtin_bit_cast(float, __builtin_amdgcn_update_dpp(0, __builtin_bit_cast(int, (v)), (ctrl), 0xF, 0xF, true))
__device__ __forceinline__ float readlane_f(float v, int l) { return __builtin_bit_cast(float, __builtin_amdgcn_readlane(__builtin_bit_cast(int, v), l)); }
__device__ __forceinline__ float wave_sum_dpp(float v) {
    v += DPPF(v, 0xB1); v += DPPF(v, 0x4E); v += DPPF(v, 0x141); v += DPPF(v, 0x140);
    return (readlane_f(v, 0) + readlane_f(v, 16)) + (readlane_f(v, 32) + readlane_f(v, 48));
}
__device__ __forceinline__ float wave_max_dpp(float v) {
    v = fmaxf(v, DPPF(v, 0xB1)); v = fmaxf(v, DPPF(v, 0x4E)); v = fmaxf(v, DPPF(v, 0x141)); v = fmaxf(v, DPPF(v, 0x140));
    return fmaxf(fmaxf(readlane_f(v, 0), readlane_f(v, 16)), fmaxf(readlane_f(v, 32), readlane_f(v, 48)));
}
#define BLOCK_SYNC() __syncthreads()
#define XB_TMO      128
#define XB_XCNT(j)  (256  + 64 * (j))
#define XB_XSUB(j)  (1280 + 64 * (j))
#define XB_XGEN(j)  (2304 + 64 * (j))
#define XB_TOP      3328
#define XB_TOPGEN   3392
#define XCD_BAR_WORDS 3456
#define XB_SPIN_CAP (1u << 18)

__device__ __forceinline__ unsigned xb_ld(unsigned* p)              { return __hip_atomic_load(p, __ATOMIC_RELAXED, __HIP_MEMORY_SCOPE_AGENT); }
__device__ __forceinline__ unsigned xb_add(unsigned* p, unsigned v) { return __hip_atomic_fetch_add(p, v, __ATOMIC_RELAXED, __HIP_MEMORY_SCOPE_AGENT); }
__device__ __forceinline__ unsigned xb_xcc_id() { return (unsigned)__builtin_amdgcn_s_getreg((3 << 11) | 20) & 0xFu; }
#define XB_SPIN(cond, bar) do { unsigned _sp = 0; while (cond) { __builtin_amdgcn_s_sleep(1); \
    if ((++_sp & 255u) == 0u) { if (xb_ld(&(bar)[XB_TMO])) break; if (_sp > XB_SPIN_CAP) { atomicAdd(&(bar)[XB_TMO], 1u); break; } } } } while (0)

struct XcdBarrier {
    unsigned* bar; unsigned x;
    volatile LAS unsigned* st;
};

__device__ __forceinline__ XcdBarrier xcd_barrier_post(unsigned* bar, volatile LAS unsigned* st) {
    XcdBarrier b; b.bar = bar; b.x = xb_xcc_id(); b.st = st;
    if (threadIdx.x == 0) (void)xb_add(&bar[XB_XCNT(b.x)], 1u);
    return b;
}
__device__ __forceinline__ void xcd_barrier_complete(unsigned* bar, unsigned x, unsigned& nloc, unsigned& nx) {
    const unsigned G = gridDim.x * gridDim.y * gridDim.z;
    unsigned sum, cnt, mine, sp = 0u;
    for (;;) {
        sum = 0u; cnt = 0u; mine = 0u;
#pragma unroll
        for (unsigned j = 0; j < 16; ++j) { const unsigned c = xb_ld(&bar[XB_XCNT(j)]); sum += c; cnt += (c > 0u) ? 1u : 0u; mine = (j == x) ? c : mine; }
        if (sum == G) break;
        __builtin_amdgcn_s_sleep(1);
        if ((++sp & 255u) == 0u) { if (xb_ld(&bar[XB_TMO])) break; if (sp > XB_SPIN_CAP) { atomicAdd(&bar[XB_TMO], 1u); break; } }
    }
    nloc = mine > 0u ? mine : 1u; nx = cnt > 0u ? cnt : 1u;
}

__device__ __forceinline__ void xcd_barrier(const XcdBarrier& b) {
    asm volatile("s_waitcnt vmcnt(0)" ::: "memory");
    __syncthreads();
    if (threadIdx.x == 0) {
        unsigned* bar = b.bar;
        __builtin_amdgcn_s_waitcnt(0);
        unsigned nloc = b.st[0], nx = b.st[1];
        if (nloc == 0u) { xcd_barrier_complete(bar, b.x, nloc, nx); b.st[0] = nloc; b.st[1] = nx; }
        const unsigned old = xb_add(&bar[XB_XSUB(b.x)], 1u);
        const unsigned gen = old / nloc;
        if (old + 1u == (gen + 1u) * nloc) {
            __builtin_amdgcn_fence(__ATOMIC_RELEASE, "agent");
            asm volatile("s_waitcnt vmcnt(0)" ::: "memory");
            const unsigned og = xb_add(&bar[XB_TOP], 1u);
            const unsigned tg = og / nx;
            if (og + 1u == (tg + 1u) * nx) xb_add(&bar[XB_TOPGEN], 1u);
            else XB_SPIN(xb_ld(&bar[XB_TOPGEN]) == tg, bar);
            __builtin_amdgcn_fence(__ATOMIC_ACQUIRE, "agent");
            xb_add(&bar[XB_XGEN(b.x)], 1u);
            asm volatile("s_waitcnt vmcnt(0)" ::: "memory");
        } else {
            XB_SPIN(xb_ld(&bar[XB_XGEN(b.x)]) == gen, bar);
            __builtin_amdgcn_fence(__ATOMIC_ACQUIRE, "agent");
            asm volatile("s_waitcnt vmcnt(0)" ::: "memory");
        }
    }
    __syncthreads();
}

__device__ __forceinline__ void ln_row_bf16(const float* src, const float* g, const float* b, bf16_t* dst, int lane) {
    f32x4 v[8]; float s = 0.f;
#pragma unroll
    for (int j = 0; j < 8; ++j) { v[j] = ((const f32x4*)src)[lane + 64 * j]; s += (v[j].x + v[j].y) + (v[j].z + v[j].w); }
    const float mean = wave_sum(s) * (1.0f / D); float s2 = 0.f;
#pragma unroll
    for (int j = 0; j < 8; ++j) { v[j] = v[j] - mean; s2 += (v[j].x * v[j].x + v[j].y * v[j].y) + (v[j].z * v[j].z + v[j].w * v[j].w); }
    const float rstd = 1.0f / sqrtf(wave_sum(s2) * (1.0f / D) + LN_EPS);
#pragma unroll
    for (int j = 0; j < 8; ++j) {
        const f32x4 gg = ((const f32x4*)g)[lane + 64 * j], bb = ((const f32x4*)b)[lane + 64 * j];
        const f32x4 o = v[j] * rstd * gg + bb;
        u32x2 w; w.x = pk2(o.x, o.y); w.y = pk2(o.z, o.w);
        ((u32x2*)dst)[lane + 64 * j] = w;
    }
}
__device__ __forceinline__ void transpose_item(const float* W, int K, int N, int Npad, bf16_t* Wt, int item, int lane, int ldw = 0) {
    const int nblk = Npad >> 6, kb = item / nblk, nb = item - kb * nblk, n = nb * 64 + lane, k0 = kb * 32;
    float v[32];
    if (n < N) {
#pragma unroll
        for (int i = 0; i < 32; ++i) v[i] = W[(size_t)(k0 + i) * N + n];
    } else {
#pragma unroll
        for (int i = 0; i < 32; ++i) v[i] = 0.f;
    }
    u32x4* o = (u32x4*)(Wt + (size_t)n * (ldw ? ldw : K) + k0);
#pragma unroll
    for (int c = 0; c < 4; ++c) { u32x4 w; w.x = pk2(v[8 * c], v[8 * c + 1]); w.y = pk2(v[8 * c + 2], v[8 * c + 3]); w.z = pk2(v[8 * c + 4], v[8 * c + 5]); w.w = pk2(v[8 * c + 6], v[8 * c + 7]); o[c] = w; }
}
__device__ __forceinline__ void transpose_item_q(const float* W, const float* g, const float* b, bf16_t* Wt, float* c1, float* c2, int item, int lane) {
    const int kb = item >> 5, nb = item & 31, n = nb * 64 + lane, k0 = kb * 32;
    float v[32], s1 = 0.f, s2 = 0.f;
#pragma unroll
    for (int i = 0; i < 32; ++i) { const float w = W[(size_t)(k0 + i) * 2048 + n]; const float gw = g[k0 + i] * w; s1 += gw; s2 += b[k0 + i] * w; v[i] = gw; }
    u32x4* o = (u32x4*)(Wt + (size_t)n * 2048 + k0);
#pragma unroll
    for (int c = 0; c < 4; ++c) { u32x4 w; w.x = pk2(v[8 * c], v[8 * c + 1]); w.y = pk2(v[8 * c + 2], v[8 * c + 3]); w.z = pk2(v[8 * c + 4], v[8 * c + 5]); w.w = pk2(v[8 * c + 6], v[8 * c + 7]); o[c] = w; }
    atomicAdd(c1 + n, s1); atomicAdd(c2 + n, s2);
}
__device__ __forceinline__ void phase0(const Params& P) {
    const int lane = threadIdx.x & 63, wave = threadIdx.x >> 6;
    const int gw = blockIdx.x * 8 + wave, NGW = gridDim.x * 8;
    unsigned char* ws = P.ws;
    constexpr int T_IN = 64 * 184, T_A = 64 * 32, T_B = 32 * 32, T_O = 64 * 32, T_Q = 64 * 32, T_POOL = 4 * 32, T_W2 = 3 * 32, T_A2 = 3 * 32, T_G2 = 8 * 32;
    constexpr int T_LN = MROWS, T_SK = 64;
    constexpr int NIT = T_IN + T_A + T_B + T_O + T_Q + T_POOL + T_W2 + T_A2 + T_G2 + T_LN + T_SK;
    for (int it = gw; it < NIT; it += NGW) {
        int r = it;
        if (r < T_IN) { transpose_item(P.in[I_WIN], 2048, INC, NPAD, (bf16_t*)(ws + WS_WTIN), r, lane); continue; } r -= T_IN;
        if (r < T_A) { transpose_item(P.in[I_WBA], 2048, 2048, 2048, (bf16_t*)(ws + WS_WTAB), r, lane, LDAB); continue; } r -= T_A;
        if (r < T_B) { transpose_item(P.in[I_WBB], 1024, 2048, 2048, (bf16_t*)(ws + WS_WTAB) + 2048, r, lane, LDAB); continue; } r -= T_B;
        if (r < T_O) { transpose_item(P.in[I_WOUT], 2048, 2048, 2048, (bf16_t*)(ws + WS_WTOUT), r, lane); continue; } r -= T_O;
        if (r < T_Q) { float* st = (float*)(ws + WS_STAT); transpose_item_q(P.in[I_WQ], P.in[I_LN1G], P.in[I_LN1B], (bf16_t*)(ws + WS_WTQ), st + 16384, st + 18432, r, lane); continue; } r -= T_Q;
        if (r < T_POOL) { const int g = r >> 5; transpose_item(P.in[I_WPOOL] + g * 65536, 256, 256, 256, (bf16_t*)(ws + WS_WTPOOL) + g * 65536, r & 31, lane); continue; } r -= T_POOL;
        if (r < T_W2) { transpose_item(P.in[I_WW2], 96, 2048, 2048, (bf16_t*)(ws + WS_WTW2), r, lane); continue; } r -= T_W2;
        if (r < T_A2) { transpose_item(P.in[I_WA2], 96, 2048, 2048, (bf16_t*)(ws + WS_WTA2), r, lane); continue; } r -= T_A2;
        if (r < T_G2) { transpose_item(P.in[I_WG2], 256, 2048, 2048, (bf16_t*)(ws + WS_WTG2), r, lane); continue; } r -= T_G2;
        if (r < T_LN) {
            bf16_t* dst = (bf16_t*)(ws + WS_H0B) + (size_t)r * D;
            if (r < NTOK) ln_row_bf16(P.in[I_X] + (size_t)r * D, P.in[I_LNIN_G], P.in[I_LNIN_B], dst, lane);
            else if (r < NTOK + 16) ln_row_bf16(P.in[I_META] + (size_t)(r - NTOK) * D, P.in[I_LNIN_G], P.in[I_LNIN_B], dst, lane);
            else {
#pragma unroll
                for (int j = 0; j < 8; ++j) ((u32x2*)dst)[lane + 64 * j] = (u32x2){0u, 0u};
            }
            continue;
        }
        r -= T_LN;
        {
            const float* s = P.in[I_SUBK] + r * 512 + lane * 8; float f[8];
#pragma unroll
            for (int i = 0; i < 8; ++i) f[i] = s[i];
            *(u32x4*)((bf16_t*)(ws + WS_SUBK) + r * 512 + lane * 8) = pack8(f);
        }
    }
}
namespace pg8 {
constexpr float LN_EPS_ = 1e-5f;
struct EpiGate35 {
    static constexpr bool PERM = false, AFTER_DRAIN = false; static constexpr int MID_T = 32;
    bf16_t* O; const bf16_t* p; const float* bgate;
    __device__ __forceinline__ void mid(f32x4 (&acc)[2][2][4][2], const Unit& u, int wr, int wc, int fr, int fq) const {
        asm volatile("" : "+v"(fr), "+v"(fq));
        const int row0 = u.pm * BM + wr * 64 + fr, col0 = u.pn * BM + wc * 32 + 4 * fq;
#pragma unroll
        for (int ai = 0; ai < 2; ++ai)
#pragma unroll
            for (int m = 0; m < 4; ++m) { const size_t row = (size_t)(row0 + ai * HALF + m * 16);
#pragma unroll
                for (int bj = 0; bj < 2; ++bj)
#pragma unroll
                    for (int n = 0; n < 2; ++n) { const int col = col0 + bj * HALF + n * 16;
                        const u32x2 p0 = *(const u32x2*)(p + row * NPAD + C_G0 + col), p1 = *(const u32x2*)(p + row * NPAD + C_G1 + col);
                        const f32x4 b0 = *(const f32x4*)(bgate + col), b1 = *(const f32x4*)(bgate + D + col);
                        f32x4 r;
                        r.x = (1.0f + __expf(-fmaxf(bflo(p1.x) + b1.x, -80.f))) * __builtin_amdgcn_rcpf(1.0f + __expf(-(bflo(p0.x) + b0.x)));
                        r.y = (1.0f + __expf(-fmaxf(bfhi(p1.x) + b1.y, -80.f))) * __builtin_amdgcn_rcpf(1.0f + __expf(-(bfhi(p0.x) + b0.y)));
                        r.z = (1.0f + __expf(-fmaxf(bflo(p1.y) + b1.z, -80.f))) * __builtin_amdgcn_rcpf(1.0f + __expf(-(bflo(p0.y) + b0.z)));
                        r.w = (1.0f + __expf(-fmaxf(bfhi(p1.y) + b1.w, -80.f))) * __builtin_amdgcn_rcpf(1.0f + __expf(-(bfhi(p0.y) + b0.w)));
                        acc[ai][bj][m][n] = acc[ai][bj][m][n] * r; }
                asm volatile("" ::: "memory"); }
    }
    __device__ __forceinline__ void operator()(const f32x4 (&acc)[2][2][4][2], const Unit& u, int wr, int wc, int fr, int fq) const {
        const int row0 = u.pm * BM + wr * 64 + fr, col0 = u.pn * BM + wc * 32 + 4 * fq;
#pragma unroll
        for (int ai = 0; ai < 2; ++ai)
#pragma unroll
            for (int m = 0; m < 4; ++m) { const size_t row = (size_t)(row0 + ai * HALF + m * 16);
#pragma unroll
                for (int bj = 0; bj < 2; ++bj)
#pragma unroll
                    for (int n = 0; n < 2; ++n) { const int col = col0 + bj * HALF + n * 16;
                        const u32x2 p1 = *(const u32x2*)(p + row * NPAD + C_G1 + col); const f32x4 b1 = *(const f32x4*)(bgate + D + col);
                        f32x4 g;
                        g.x = __builtin_amdgcn_rcpf(1.0f + __expf(-fmaxf(bflo(p1.x) + b1.x, -80.f))); g.y = __builtin_amdgcn_rcpf(1.0f + __expf(-fmaxf(bfhi(p1.x) + b1.y, -80.f)));
                        g.z = __builtin_amdgcn_rcpf(1.0f + __expf(-fmaxf(bflo(p1.y) + b1.z, -80.f))); g.w = __builtin_amdgcn_rcpf(1.0f + __expf(-fmaxf(bfhi(p1.y) + b1.w, -80.f)));
                        const f32x4 o = acc[ai][bj][m][n] * g;
                        u32x2 w; w.x = cvt_pk_bf16(o.x, o.y); w.y = cvt_pk_bf16(o.z, o.w);
                        *(u32x2*)(O + row * D + col) = w; } }
    }
};
struct EpiResidStats {
    static constexpr bool PERM = false, AFTER_DRAIN = false; static constexpr int MID_T = -1;
    bf16_t* O; const bf16_t* h0; float alpha; float* rsum; float* rsq;
    __device__ __forceinline__ void operator()(const f32x4 (&acc)[2][2][4][2], const Unit& u, int wr, int wc, int fr, int fq) const {
        const int row0 = u.pm * BM + wr * 64 + fr, col0 = u.pn * BM + wc * 32 + 4 * fq;
#pragma unroll
        for (int ai = 0; ai < 2; ++ai)
#pragma unroll
            for (int m = 0; m < 4; ++m) { const size_t row = (size_t)(row0 + ai * HALF + m * 16); float s = 0.f, q = 0.f;
#pragma unroll
                for (int bj = 0; bj < 2; ++bj)
#pragma unroll
                    for (int n = 0; n < 2; ++n) { const int col = col0 + bj * HALF + n * 16;
                        const u32x2 hw = *(const u32x2*)(h0 + row * D + col);
                        f32x4 hv; hv.x = bflo(hw.x); hv.y = bfhi(hw.x); hv.z = bflo(hw.y); hv.w = bfhi(hw.y);
                        const f32x4 x = hv * alpha + acc[ai][bj][m][n];
                        s += (x.x + x.y) + (x.z + x.w); q += (x.x * x.x + x.y * x.y) + (x.z * x.z + x.w * x.w);
                        u32x2 w; w.x = cvt_pk_bf16(x.x, x.y); w.y = cvt_pk_bf16(x.z, x.w);
                        *(u32x2*)(O + row * D + col) = w; }
                s += __shfl_xor(s, 16); s += __shfl_xor(s, 32); q += __shfl_xor(q, 16); q += __shfl_xor(q, 32);
                if (fq == 0) { atomicAdd(rsum + row, s); atomicAdd(rsq + row, q); } }
    }
};
struct EpiQ {
    static constexpr bool PERM = true, AFTER_DRAIN = false; static constexpr int MID_T = -1;
    bf16_t* O; const float* rsum; const float* rsq; const float* c1; const float* c2;
    __device__ __forceinline__ void operator()(const f32x4 (&acc)[2][2][4][2], const Unit& u, int wr, int wc, int fr, int fq) const {
        const int row0 = u.pm * BM + wr * 64 + fr, col0 = u.pn * BM + wc * 32 + 8 * fq;
        f32x4 k1[2][2], k2[2][2];
#pragma unroll
        for (int bj = 0; bj < 2; ++bj)
#pragma unroll
            for (int n = 0; n < 2; ++n) { k1[bj][n] = *(const f32x4*)(c1 + col0 + bj * HALF + 4 * n); k2[bj][n] = *(const f32x4*)(c2 + col0 + bj * HALF + 4 * n); }
#pragma unroll
        for (int ai = 0; ai < 2; ++ai)
#pragma unroll
            for (int m = 0; m < 4; ++m) { const int row = row0 + ai * HALF + m * 16;
                const float mean = rsum[row] * (1.0f / D), rstd = 1.0f / sqrtf(fmaxf(rsq[row] * (1.0f / D) - mean * mean, 0.f) + LN_EPS_);
                bf16_t* rowp = O + (size_t)row * D + col0;
#pragma unroll
                for (int bj = 0; bj < 2; ++bj) {
                    const f32x4 v0 = (acc[ai][bj][m][0] - k1[bj][0] * mean) * rstd + k2[bj][0], v1 = (acc[ai][bj][m][1] - k1[bj][1] * mean) * rstd + k2[bj][1];
                    u32x4 w; w.x = cvt_pk_bf16(v0[0], v0[1]); w.y = cvt_pk_bf16(v0[2], v0[3]); w.z = cvt_pk_bf16(v1[0], v1[1]); w.w = cvt_pk_bf16(v1[2], v1[3]);
                    *(u32x4*)(rowp + bj * HALF) = w; } }
    }
};
}
template <class Epi>
__device__ __forceinline__ void run_gemm(ldsp lds, const bf16_t* A, const bf16_t* Bt, int M, int N, int K, const Epi& E) {
    pg8::Gemm g; g.A = A; g.Bt = Bt; g.M = M; g.N = N; g.K = K;
    pg8::StaticOrder S; S.init(M, N, (int)gridDim.x, (int)blockIdx.x);
    pg8::gemm_phase<Epi, pg8::StaticOrder, false>(lds, g, S, E, nullptr);
}
constexpr int CONV_P2_ROWS = 0;
__device__ __forceinline__ void convert_tables(const Params& P, int r0, int rend, int stride) {
    const int lane = threadIdx.x & 63;
    unsigned char* ws = P.ws;
    for (int r = r0; r < rend; r += stride) {
        const float* src = (r < 16384 ? P.in[I_UT] : P.in[I_VT]) + (size_t)(r & 16383) * D + lane * 32;
        f32x4 v[8]; float am = 0.f;
#pragma unroll
        for (int j = 0; j < 8; ++j) { v[j] = ((const f32x4*)src)[j]; am = fmaxf(am, fmaxf(fmaxf(fabsf(v[j].x), fabsf(v[j].y)), fmaxf(fabsf(v[j].z), fabsf(v[j].w)))); }
        am = wave_max_dpp(am);
        const float qmax = r < 16384 ? 6.0f : 7.5f;
        const float s = am > 0.f ? qmax / am : 1.0f;
        if (r < 16384) {
            unsigned w[4];
#pragma unroll
            for (int j = 0; j < 4; ++j) { unsigned t = 0;
                t = __builtin_amdgcn_cvt_scalef32_pk_fp4_f32(t, v[2 * j].x * s, v[2 * j].y * s, 1.0f, 0); t = __builtin_amdgcn_cvt_scalef32_pk_fp4_f32(t, v[2 * j].z * s, v[2 * j].w * s, 1.0f, 1);
                t = __builtin_amdgcn_cvt_scalef32_pk_fp4_f32(t, v[2 * j + 1].x * s, v[2 * j + 1].y * s, 1.0f, 2); t = __builtin_amdgcn_cvt_scalef32_pk_fp4_f32(t, v[2 * j + 1].z * s, v[2 * j + 1].w * s, 1.0f, 3);
                w[j] = t; }
            *(u32x4*)(ws + WS_UB + (size_t)r * UROW + lane * 16) = (u32x4){w[0], w[1], w[2], w[3]};
        } else {
            unsigned char* dst = ws + WS_VB + (size_t)(r & 16383) * TROW + lane * 24;
            f32x16 ev, od;
#pragma unroll
            for (int j = 0; j < 8; ++j) { ev[2 * j] = v[j].x * s; od[2 * j] = v[j].y * s; ev[2 * j + 1] = v[j].z * s; od[2 * j + 1] = v[j].w * s; }
            const u32x6 p6 = __builtin_amdgcn_cvt_scalef32_2xpk16_fp6_f32(ev, od, 1.0f);
            ((u32x2*)dst)[0] = (u32x2){p6[0], p6[1]}; ((u32x2*)dst)[1] = (u32x2){p6[2], p6[3]}; ((u32x2*)dst)[2] = (u32x2){p6[4], p6[5]};
        }
        if (lane == 0) ((float*)(ws + WS_TSC))[r] = am > 0.f ? am / qmax : 1.0f;
    }
}
constexpr int LD64 = 72, MATB = 64 * LD64 * 2, LDK = 104;
constexpr int O_AB = 0, O_RB = 1 * MATB, O_BH = 2 * MATB, O_KH = 3 * MATB, O_ABT = 4 * MATB, O_BTT = 5 * MATB, O_KTT = 6 * MATB, O_VT = 7 * MATB;
constexpr int O_M0 = 8 * MATB, O_M0T = 9 * MATB, O_M1 = 10 * MATB, O_M1T = 11 * MATB, O_PA = 12 * MATB, O_PB = 13 * MATB, O_MAK = 14 * MATB, O_MRB = 15 * MATB, O_MRK = 16 * MATB;
constexpr int O_ELEND = 17 * MATB, O_WT = O_ELEND + 256;
constexpr int O_WL = 8 * MATB, O_AL = O_WL + 64 * LDK * 2, O_Z = O_AL + 64 * LDK * 2, O_AZ = O_Z + 64 * 68 * 4;
static_assert(O_AZ + 64 * 68 * 4 <= O_ELEND, "lds");
static_assert(O_WT + 2048 <= LDS_BYTES - 16, "lds");

__device__ __forceinline__ bf16x8 ldsfrag(ldsp lds, int off, int ld, int row, int kofs) { return *(const LAS bf16x8*)(lds + off + (row * ld + kofs) * 2); }
__device__ __forceinline__ void st4(ldsp lds, int off, int row, int col, const f32x4 v) {
    u32x2 w; w.x = pk2(v.x, v.y); w.y = pk2(v.z, v.w); *(LAS u32x2*)(lds + off + (row * LD64 + col) * 2) = w; }
__device__ __forceinline__ void st1(ldsp lds, int off, int row, int col, float v) { *(LAS bf16_t*)(lds + off + (row * LD64 + col) * 2) = f2bf1(v); }

__device__ __forceinline__ float fast_rcp(float x) { return __builtin_amdgcn_rcpf(x); }
__device__ __forceinline__ float fast_sigmoid(float x) { return fast_rcp(1.0f + __expf(-x)); }
__device__ __forceinline__ float fast_tanh(float x) { return 1.0f - 2.0f * fast_rcp(1.0f + __expf(2.0f * x)); }
__device__ __forceinline__ u32x4 ld8(const bf16_t* p) { return p ? *(const u32x4*)p : (u32x4){0u, 0u, 0u, 0u}; }
__device__ __forceinline__ void shift8r(const u32x4 cw, const u32x4 pw, const float* mu, float* x) {
    float c[8], q[8]; unpack8(cw, c); unpack8(pw, q);
    const f32x4 m0 = *(const f32x4*)mu, m1 = *(const f32x4*)(mu + 4);
    const float mm[8] = {m0.x, m0.y, m0.z, m0.w, m1.x, m1.y, m1.z, m1.w};
#pragma unroll
    for (int i = 0; i < 8; ++i) x[i] = c[i] + (q[i] - c[i]) * mm[i];
}
__device__ __forceinline__ int tcol(int row, int col) { return ((((col >> 3) ^ (row >> 3)) & 7) << 3) | (col & 7); }
__device__ __forceinline__ bf16x8 ldsfragT(ldsp lds, int off, int row, int kofs) { return *(const LAS bf16x8*)(lds + off + (row * LD64 + tcol(row, kofs)) * 2); }
__device__ __forceinline__ void st1T(ldsp lds, int off, int row, int col, float v) { *(LAS bf16_t*)(lds + off + (row * LD64 + tcol(row, col)) * 2) = f2bf1(v); }
__device__ __forceinline__ void shift8(const bf16_t* pcur, const bf16_t* pprev, const float* mu, float* x) {
    float c[8], q[8];
    if (pcur) unpack8(*(const u32x4*)pcur, c); else {
#pragma unroll
        for (int i = 0; i < 8; ++i) c[i] = 0.f; }
    if (pprev) unpack8(*(const u32x4*)pprev, q); else {
#pragma unroll
        for (int i = 0; i < 8; ++i) q[i] = 0.f; }
    const f32x4 m0 = *(const f32x4*)mu, m1 = *(const f32x4*)(mu + 4);
    const float mm[8] = {m0.x, m0.y, m0.z, m0.w, m1.x, m1.y, m1.z, m1.w};
#pragma unroll
    for (int i = 0; i < 8; ++i) x[i] = c[i] + (q[i] - c[i]) * mm[i];
}

template <bool DO_P, bool DO_SQ>
__device__ __forceinline__ void dbl_step(ldsp lds, int sN, int sT, int dN, int dT, int pC, int pN, int tm, int tn0, int fr, int fq) {
    bf16x8 a[2];
#pragma unroll
    for (int ks = 0; ks < 2; ++ks) a[ks] = ldsfrag(lds, sT, LD64, 16 * tm + fr, ks * 32 + fq * 8);
#pragma unroll
    for (int t2 = 0; t2 < 2; ++t2) {
        const int nt = tn0 + t2, t = 16 * nt + fr, s0 = 16 * tm + 4 * fq;
        if (DO_P) {
            f32x4 acc = {0.f, 0.f, 0.f, 0.f};
#pragma unroll
            for (int ks = 0; ks < 2; ++ks) acc = mfma16(a[ks], ldsfrag(lds, pC, LD64, t, ks * 32 + fq * 8), acc);
            const u32x2 pw = *(const LAS u32x2*)(lds + pC + (t * LD64 + s0) * 2);
            acc.x += bflo(pw.x); acc.y += bfhi(pw.x); acc.z += bflo(pw.y); acc.w += bfhi(pw.y);
            st4(lds, pN, t, s0, acc);
        }
        if (DO_SQ) {
            f32x4 acc = {0.f, 0.f, 0.f, 0.f};
#pragma unroll
            for (int ks = 0; ks < 2; ++ks) acc = mfma16(a[ks], ldsfrag(lds, sN, LD64, t, ks * 32 + fq * 8), acc);
            st4(lds, dN, t, s0, acc);
            st1(lds, dT, s0 + 0, t, acc.x); st1(lds, dT, s0 + 1, t, acc.y); st1(lds, dT, s0 + 2, t, acc.z); st1(lds, dT, s0 + 3, t, acc.w);
        }
    }
}


#ifdef DBG_STAGE
constexpr size_t DBG_STRIDE = (size_t)NUNITS * 512 * 4;
__device__ __forceinline__ void dbgsum(const Params& P, ldsp lds, int u, int stage, const int* offs, int nmat) {
    unsigned acc = 0;
    for (int m = 0; m < nmat; ++m)
        for (int k = 0; k < 4; ++k) { const int idx = threadIdx.x + 512 * k, row = idx >> 5, cp = idx & 31; const unsigned x = *(const LAS unsigned*)(lds + offs[m] + row * (LD64 * 2) + cp * 4); acc += (x & 0xffffu) + (x >> 16); }
    ((unsigned*)(P.ws + WS_S0T + (size_t)stage * DBG_STRIDE))[(size_t)u * 512 + threadIdx.x] = acc;
}
#define DBGSUM(stage, ...) do { const int offs_[] = {__VA_ARGS__}; dbgsum(P, lds, u, stage, offs_, (int)(sizeof(offs_) / sizeof(int))); } while (0)
#else
#define DBGSUM(stage, ...) do { } while (0)
#endif
struct PL { u32x4 rc, rq, kc, kq, vc, vq, cw[3], pw[3]; bf16x8 aw[3], aa[3]; };
__device__ __forceinline__ const bf16_t* unit_rowp(const bf16_t* pp, int u, int tl, int col) {
    int r;
    if (u >= 4096) r = (tl >= 48) ? (ROW_META + tl - 48) : -1;
    else { const int bh = u >> 6, c = u & 63, b = bh >> 5; r = (tl >= 0 || c > 0) ? (b * SEQ + c * 64 + tl) : (ROW_META + 15); }
    return r < 0 ? (const bf16_t*)nullptr : pp + (size_t)r * NPAD + col;
}
__device__ __forceinline__ void pl_load(const Params& P, int u, PL& L) {
    int tid = threadIdx.x; asm volatile("" : "+v"(tid));
    const int lane = tid & 63, wave = tid >> 6, fr = lane & 15, fq = lane >> 4, tm = wave >> 1;
    const bf16_t* pp = (const bf16_t*)(P.ws + WS_P);
    const int h = (u >= 4096) ? (u - 4096) : ((u >> 6) & 31);
    const int t = tid >> 3, hj = h * 64 + 8 * (tid & 7);
    L.rc = ld8(unit_rowp(pp, u, t, C_R + hj)); L.rq = ld8(unit_rowp(pp, u, t - 1, C_R + hj));
    L.kc = ld8(unit_rowp(pp, u, t, C_K + hj)); L.kq = ld8(unit_rowp(pp, u, t - 1, C_K + hj));
    L.vc = ld8(unit_rowp(pp, u, t, C_V + hj)); L.vq = ld8(unit_rowp(pp, u, t - 1, C_V + hj));
#pragma unroll
    for (int it = 0; it < 3; ++it) { const int idx = tid + 512 * it, mat = idx / 768, rem = idx - mat * 768, tt = rem / 12, ch = rem - tt * 12, col = (mat ? C_AL : C_WL) + ch * 8;
        L.cw[it] = ld8(unit_rowp(pp, u, tt, col)); L.pw[it] = ld8(unit_rowp(pp, u, tt - 1, col)); }
    const bf16_t* ww2 = (const bf16_t*)(P.ws + WS_WTW2) + (size_t)(h * 64 + 16 * tm + fr) * 96 + fq * 8;
    const bf16_t* wa2 = (const bf16_t*)(P.ws + WS_WTA2) + (size_t)(h * 64 + 16 * tm + fr) * 96 + fq * 8;
#pragma unroll
    for (int ks = 0; ks < 3; ++ks) { L.aw[ks] = *(const bf16x8*)(ww2 + ks * 32); L.aa[ks] = *(const bf16x8*)(wa2 + ks * 32); }
}
__device__ __forceinline__ void rwkv_unit(const Params& P, ldsp lds, int u, PL& L, int next_u) {
    int tid = threadIdx.x; asm volatile("" : "+v"(tid));
    const int lane = tid & 63, wave = tid >> 6, fr = lane & 15, fq = lane >> 4, tm = wave >> 1, tn0 = (wave & 1) * 2;
    unsigned char* ws = P.ws;
    const bf16_t* pp = (const bf16_t*)(ws + WS_P);
    const bool meta = u >= 4096;
    int b = 0, h, c = 0;
    if (meta) { h = u - 4096; } else { const int bh = u >> 6; c = u & 63; b = bh >> 5; h = bh & 31; }
    auto rowof = [&](int tl) -> int {
        if (meta) return (tl >= 48) ? (ROW_META + tl - 48) : -1;
        if (tl >= 0 || c > 0) return b * SEQ + c * 64 + tl;
        return ROW_META + 15;
    };
    auto rowp = [&](int tl, int col) -> const bf16_t* { const int r = rowof(tl); return r < 0 ? (const bf16_t*)nullptr : pp + (size_t)r * NPAD + col; };
    const float* mu = P.in[I_MU];
#ifndef RPT_AD
#define RPT_AD 1
#define RPT_E12 1
#define RPT_E35 1
#endif
    float lw[8], av[8], rv[8], kv[8], vv[8], kk[8], km[8];
    const int t = tid >> 3, jq = tid & 7, j0 = 8 * jq, hj = h * 64 + j0;
    const bool nulltok = meta && t < 48;
    for (int rpt_ = 0; rpt_ < RPT_AD; ++rpt_) {
    {
#pragma unroll
        for (int it = 0; it < 3; ++it) { const int idx = tid + 512 * it, mat = idx / 768, rem = idx - mat * 768, tt = rem / 12, ch = rem - tt * 12, col = (mat ? C_AL : C_WL) + ch * 8;
            float x[8]; shift8r(L.cw[it], L.pw[it], mu + col, x);
            if (mat == 0) {
#pragma unroll
                for (int i = 0; i < 8; ++i) x[i] = fast_tanh(x[i]);
            }
            *(LAS u32x4*)(lds + (mat ? O_AL : O_WL) + (tt * LDK + ch * 8) * 2) = pack8(x); }
    }
    BLOCK_SYNC();
    {
        f32x4 z[2] = {{0.f, 0.f, 0.f, 0.f}, {0.f, 0.f, 0.f, 0.f}}, az[2] = {{0.f, 0.f, 0.f, 0.f}, {0.f, 0.f, 0.f, 0.f}};
#pragma unroll
        for (int ks = 0; ks < 3; ++ks) {
            const bf16x8 aw = L.aw[ks], aa = L.aa[ks];
#pragma unroll
            for (int t2 = 0; t2 < 2; ++t2) {
                const int t = 16 * (tn0 + t2) + fr;
                z[t2] = mfma16(aw, ldsfrag(lds, O_WL, LDK, t, ks * 32 + fq * 8), z[t2]);
                az[t2] = mfma16(aa, ldsfrag(lds, O_AL, LDK, t, ks * 32 + fq * 8), az[t2]);
            }
        }
#pragma unroll
        for (int t2 = 0; t2 < 2; ++t2) {
            const int t = 16 * (tn0 + t2) + fr, j0 = 16 * tm + 4 * fq;
            *(LAS f32x4*)(lds + O_Z + (t * 68 + j0) * 4) = z[t2];
            *(LAS f32x4*)(lds + O_AZ + (t * 68 + j0) * 4) = az[t2];
        }
    }
    BLOCK_SYNC();
    float cs[8];
    {
        const f32x4 z0 = *(const LAS f32x4*)(lds + O_Z + (t * 68 + j0) * 4), z1 = *(const LAS f32x4*)(lds + O_Z + (t * 68 + j0 + 4) * 4);
        const f32x4 y0 = *(const LAS f32x4*)(lds + O_AZ + (t * 68 + j0) * 4), y1 = *(const LAS f32x4*)(lds + O_AZ + (t * 68 + j0 + 4) * 4);
        const float zz[8] = {z0.x, z0.y, z0.z, z0.w, z1.x, z1.y, z1.z, z1.w}, yy[8] = {y0.x, y0.y, y0.z, y0.w, y1.x, y1.y, y1.z, y1.w};
        const f32x4 w0a = *(const f32x4*)(P.in[I_W0] + hj), w0b = *(const f32x4*)(P.in[I_W0] + hj + 4), a0a = *(const f32x4*)(P.in[I_A0] + hj), a0b = *(const f32x4*)(P.in[I_A0] + hj + 4);
        const float w0[8] = {w0a.x, w0a.y, w0a.z, w0a.w, w0b.x, w0b.y, w0b.z, w0b.w}, a0[8] = {a0a.x, a0a.y, a0a.z, a0a.w, a0b.x, a0b.y, a0b.z, a0b.w};
#pragma unroll
        for (int i = 0; i < 8; ++i) { lw[i] = nulltok ? 0.f : -DSCALE * fast_sigmoid(w0[i] + zz[i]); av[i] = fast_sigmoid(a0[i] + yy[i]); cs[i] = lw[i]; }
#pragma unroll
        for (int d = 8; d < 64; d <<= 1) {
#pragma unroll
            for (int i = 0; i < 8; ++i) { const float o = __shfl_up(cs[i], d); cs[i] += (lane >= d) ? o : 0.f; }
        }
        if (lane >= 56) { *(LAS f32x4*)(lds + O_WT + (wave * 64 + j0) * 4) = (f32x4){cs[0], cs[1], cs[2], cs[3]}; *(LAS f32x4*)(lds + O_WT + (wave * 64 + j0 + 4) * 4) = (f32x4){cs[4], cs[5], cs[6], cs[7]}; }
        shift8r(L.rc, L.rq, mu + C_R + hj, rv); shift8r(L.kc, L.kq, mu + C_K + hj, kv); shift8r(L.vc, L.vq, mu + C_V + hj, vv);
        if (nulltok) {
#pragma unroll
            for (int i = 0; i < 8; ++i) { rv[i] = 0.f; kv[i] = 0.f; vv[i] = 0.f; }
        }
        const f32x4 kka = *(const f32x4*)(P.in[I_KK] + hj), kkb = *(const f32x4*)(P.in[I_KK] + hj + 4), kaa = *(const f32x4*)(P.in[I_KA] + hj), kab = *(const f32x4*)(P.in[I_KA] + hj + 4);
        const f32x4 rka = *(const f32x4*)(P.in[I_RK] + hj), rkb = *(const f32x4*)(P.in[I_RK] + hj + 4);
        const float kkw[8] = {kka.x, kka.y, kka.z, kka.w, kkb.x, kkb.y, kkb.z, kkb.w}, kaw[8] = {kaa.x, kaa.y, kaa.z, kaa.w, kab.x, kab.y, kab.z, kab.w}, rkw[8] = {rka.x, rka.y, rka.z, rka.w, rkb.x, rkb.y, rkb.z, rkb.w};
        float n2 = 0.f, bon = 0.f;
#pragma unroll
        for (int i = 0; i < 8; ++i) { kk[i] = kv[i] * kkw[i]; n2 += kk[i] * kk[i]; km[i] = kv[i] * (1.0f + (av[i] - 1.0f) * kaw[i]); bon += rv[i] * km[i] * rkw[i]; }
        n2 += DPPF(n2, 0xB1); n2 += DPPF(n2, 0x4E); n2 += DPPF(n2, 0x141);
        bon += DPPF(bon, 0xB1); bon += DPPF(bon, 0x4E); bon += DPPF(bon, 0x141);
        const float inv = 1.0f / fmaxf(sqrtf(n2), 1e-12f);
#pragma unroll
        for (int i = 0; i < 8; ++i) kk[i] *= inv;
        if (!meta && jq == 0) ((float*)(ws + WS_BONUS))[(size_t)(b * SEQ + c * 64 + t) * 32 + h] = bon;
    }
    BLOCK_SYNC();
    {
        float Lc[8], Le[8];
#pragma unroll
        for (int i = 0; i < 8; ++i) { Lc[i] = cs[i]; Le[i] = 0.f; }
#pragma unroll
        for (int w = 0; w < 8; ++w) {
            const f32x4 x0 = *(const LAS f32x4*)(lds + O_WT + (w * 64 + j0) * 4), x1 = *(const LAS f32x4*)(lds + O_WT + (w * 64 + j0 + 4) * 4);
            const float xx[8] = {x0.x, x0.y, x0.z, x0.w, x1.x, x1.y, x1.z, x1.w};
            const float msk = w < wave ? 1.0f : 0.0f;
#pragma unroll
            for (int i = 0; i < 8; ++i) { Le[i] += xx[i]; Lc[i] += msk * xx[i]; }
        }
        float Ab[8], Rb[8], Bh[8], Kh[8], Bt[8], Kt[8];
#pragma unroll
        for (int i = 0; i < 8; ++i) {
            const float eP = __expf(Lc[i] - lw[i]), eC = __expf(Lc[i]), eN = __expf(-Lc[i]), eE = __expf(Le[i] - Lc[i]);
            const float ka = kk[i] * av[i];
            Ab[i] = -kk[i] * eP; Rb[i] = rv[i] * eC; Bh[i] = ka * eN; Kh[i] = km[i] * eN; Bt[i] = ka * eE; Kt[i] = km[i] * eE;
        }
        *(LAS u32x4*)(lds + O_AB + (t * LD64 + j0) * 2) = pack8(Ab);
        *(LAS u32x4*)(lds + O_RB + (t * LD64 + j0) * 2) = pack8(Rb);
        *(LAS u32x4*)(lds + O_BH + (t * LD64 + j0) * 2) = pack8(Bh);
        *(LAS u32x4*)(lds + O_KH + (t * LD64 + j0) * 2) = pack8(Kh);
#pragma unroll
        for (int i = 0; i < 8; ++i) { st1T(lds, O_ABT, j0 + i, t, Ab[i]); st1T(lds, O_BTT, j0 + i, t, Bt[i]); st1T(lds, O_KTT, j0 + i, t, Kt[i]); st1T(lds, O_VT, j0 + i, t, vv[i]); }
        if (t == 63) {
#pragma unroll
            for (int i = 0; i < 8; ++i) *(LAS float*)(lds + O_ELEND + (j0 + i) * 4) = __expf(Le[i]);
        }
    }
    BLOCK_SYNC();
    }
    if (next_u >= 0) pl_load(P, next_u, L);
    DBGSUM(0, O_AB, O_RB, O_BH, O_KH, O_ABT, O_BTT, O_KTT, O_VT);
    for (int rpt_ = 0; rpt_ < RPT_E12; ++rpt_) {
    {
        bf16x8 abh[2], akh[2];
#pragma unroll
        for (int ks = 0; ks < 2; ++ks) { abh[ks] = ldsfrag(lds, O_BH, LD64, 16 * tm + fr, ks * 32 + fq * 8); akh[ks] = ldsfrag(lds, O_KH, LD64, 16 * tm + fr, ks * 32 + fq * 8); }
#pragma unroll
        for (int t2 = 0; t2 < 2; ++t2) {
            const int tt = 16 * (tn0 + t2) + fr, s0 = 16 * tm + 4 * fq;
            f32x4 mab = {0.f, 0.f, 0.f, 0.f}, mak = mab, mrb = mab, mrk = mab;
#pragma unroll
            for (int ks = 0; ks < 2; ++ks) {
                const bf16x8 bab = ldsfrag(lds, O_AB, LD64, tt, ks * 32 + fq * 8), brb = ldsfrag(lds, O_RB, LD64, tt, ks * 32 + fq * 8);
                mab = mfma16(abh[ks], bab, mab); mak = mfma16(akh[ks], bab, mak); mrb = mfma16(abh[ks], brb, mrb); mrk = mfma16(akh[ks], brb, mrk);
            }
            float vab[4] = {mab.x, mab.y, mab.z, mab.w}, vak[4] = {mak.x, mak.y, mak.z, mak.w}, vrb[4] = {mrb.x, mrb.y, mrb.z, mrb.w}, vrk[4] = {mrk.x, mrk.y, mrk.z, mrk.w}, vp[4];
#pragma unroll
            for (int r = 0; r < 4; ++r) { const int s = s0 + r; const bool st = s < tt, le = s <= tt;
                vab[r] = st ? vab[r] : 0.f; vak[r] = st ? vak[r] : 0.f; vrb[r] = le ? vrb[r] : 0.f; vrk[r] = le ? vrk[r] : 0.f; vp[r] = vab[r] + (s == tt ? 1.0f : 0.f); }
            st4(lds, O_M0, tt, s0, (f32x4){vab[0], vab[1], vab[2], vab[3]});
#pragma unroll
            for (int r = 0; r < 4; ++r) st1(lds, O_M0T, s0 + r, tt, vab[r]);
            st4(lds, O_PA, tt, s0, (f32x4){vp[0], vp[1], vp[2], vp[3]});
            st4(lds, O_MAK, tt, s0, (f32x4){vak[0], vak[1], vak[2], vak[3]});
            st4(lds, O_MRB, tt, s0, (f32x4){vrb[0], vrb[1], vrb[2], vrb[3]});
            st4(lds, O_MRK, tt, s0, (f32x4){vrk[0], vrk[1], vrk[2], vrk[3]});
        }
    }
    BLOCK_SYNC();
    DBGSUM(1, O_M0, O_M0T, O_PA, O_MAK, O_MRB, O_MRK);
    dbl_step<false, true>(lds, O_M0, O_M0T, O_M1, O_M1T, 0, 0, tm, tn0, fr, fq); BLOCK_SYNC();
    dbl_step<true, true>(lds, O_M1, O_M1T, O_M0, O_M0T, O_PA, O_PB, tm, tn0, fr, fq); BLOCK_SYNC();
    dbl_step<true, true>(lds, O_M0, O_M0T, O_M1, O_M1T, O_PB, O_PA, tm, tn0, fr, fq); BLOCK_SYNC();
    dbl_step<true, true>(lds, O_M1, O_M1T, O_M0, O_M0T, O_PA, O_PB, tm, tn0, fr, fq); BLOCK_SYNC();
    dbl_step<true, true>(lds, O_M0, O_M0T, O_M1, O_M1T, O_PB, O_PA, tm, tn0, fr, fq); BLOCK_SYNC();
    dbl_step<true, false>(lds, O_M1, O_M1T, 0, 0, O_PA, O_PB, tm, tn0, fr, fq); BLOCK_SYNC();
    }
    DBGSUM(2, O_PB);
    const size_t ub = (size_t)u * 4096;
    for (int rpt_ = 0; rpt_ < RPT_E35; ++rpt_) {
    {
        bf16x8 aT[2], aMak[2];
#pragma unroll
        for (int ks = 0; ks < 2; ++ks) { aT[ks] = ldsfrag(lds, O_PB, LD64, 16 * tm + fr, ks * 32 + fq * 8); aMak[ks] = ldsfrag(lds, O_MAK, LD64, 16 * tm + fr, ks * 32 + fq * 8); }
#pragma unroll
        for (int t2 = 0; t2 < 2; ++t2) {
            const int n = 16 * (tn0 + t2) + fr, t0 = 16 * tm + 4 * fq;
            f32x4 at = {0.f, 0.f, 0.f, 0.f}, xt = at;
#pragma unroll
            for (int ks = 0; ks < 2; ++ks) { at = mfma16(aT[ks], ldsfragT(lds, O_ABT, n, ks * 32 + fq * 8), at); xt = mfma16(aMak[ks], ldsfragT(lds, O_VT, n, ks * 32 + fq * 8), xt); }
            st4(lds, O_M0, n, t0, at); st4(lds, O_M0T, n, t0, xt);
        }
    }
    BLOCK_SYNC();
    DBGSUM(3, O_M0, O_M0T);
    {
        bf16x8 aT[2], aAt[2];
#pragma unroll
        for (int ks = 0; ks < 2; ++ks) { aT[ks] = ldsfrag(lds, O_PB, LD64, 16 * tm + fr, ks * 32 + fq * 8); aAt[ks] = ldsfrag(lds, O_M0, LD64, 16 * tm + fr, ks * 32 + fq * 8); }
        bf16_t* Rt = (bf16_t*)(ws + WS_RT) + ub; bf16_t* Gp = (bf16_t*)(ws + WS_G) + ub;
#pragma unroll
        for (int t2 = 0; t2 < 2; ++t2) {
            const int n = 16 * (tn0 + t2) + fr, m0 = 16 * tm + 4 * fq;
            f32x4 u0 = {0.f, 0.f, 0.f, 0.f}, rt = u0, g = u0;
#pragma unroll
            for (int ks = 0; ks < 2; ++ks) {
                u0 = mfma16(aT[ks], ldsfrag(lds, O_M0T, LD64, n, ks * 32 + fq * 8), u0);
                rt = mfma16(aAt[ks], ldsfrag(lds, O_MRB, LD64, n, ks * 32 + fq * 8), rt);
                g = mfma16(aAt[ks], ldsfragT(lds, O_BTT, n, ks * 32 + fq * 8), g);
            }
            st4(lds, O_M1, n, m0, u0);
            const u32x2 rw = *(const LAS u32x2*)(lds + O_RB + (n * LD64 + m0) * 2);
            rt.x += bflo(rw.x); rt.y += bfhi(rw.x); rt.z += bflo(rw.y); rt.w += bfhi(rw.y);
            { u32x2 w; w.x = pk2(rt.x, rt.y); w.y = pk2(rt.z, rt.w); *(u32x2*)(Rt + n * 64 + m0) = w; }
            if ((n >> 2) == (m0 >> 2)) { const float e = *(const LAS float*)(lds + O_ELEND + n * 4); const int r = n & 3;
                g.x += (r == 0) ? e : 0.f; g.y += (r == 1) ? e : 0.f; g.z += (r == 2) ? e : 0.f; g.w += (r == 3) ? e : 0.f; }
            { const int pos0 = 32 * (tm >> 1) + 8 * fq + 4 * (tm & 1); u32x2 w; w.x = pk2(g.x, g.y); w.y = pk2(g.z, g.w); *(u32x2*)(Gp + n * 64 + pos0) = w; }
        }
    }
    BLOCK_SYNC();
    DBGSUM(4, O_M1);
    {
        bf16x8 aB[2], aK[2], aU[2], aV[2];
#pragma unroll
        for (int ks = 0; ks < 2; ++ks) { const int row = 16 * tm + fr, ko = ks * 32 + fq * 8;
            aB[ks] = ldsfragT(lds, O_BTT, row, ko); aK[ks] = ldsfragT(lds, O_KTT, row, ko); aU[ks] = ldsfrag(lds, O_M1, LD64, row, ko); aV[ks] = ldsfragT(lds, O_VT, row, ko); }
        bf16_t* H0t = (bf16_t*)(ws + WS_H0T) + ub; bf16_t* Y0s = (bf16_t*)(ws + WS_Y0) + ub;
#pragma unroll
        for (int t2 = 0; t2 < 2; ++t2) {
            const int n = 16 * (tn0 + t2) + fr, m0 = 16 * tm + 4 * fq;
            f32x4 hh = {0.f, 0.f, 0.f, 0.f}, yy = hh;
#pragma unroll
            for (int ks = 0; ks < 2; ++ks) { const int ko = ks * 32 + fq * 8;
                const bf16x8 bU = ldsfrag(lds, O_M1, LD64, n, ko), bV = ldsfragT(lds, O_VT, n, ko), bRb = ldsfrag(lds, O_MRB, LD64, n, ko), bRk = ldsfrag(lds, O_MRK, LD64, n, ko);
                hh = mfma16(aB[ks], bU, hh); hh = mfma16(aK[ks], bV, hh);
                yy = mfma16(aU[ks], bRb, yy); yy = mfma16(aV[ks], bRk, yy); }
            { u32x2 w; w.x = pk2(hh.x, hh.y); w.y = pk2(hh.z, hh.w); *(u32x2*)(H0t + n * 64 + m0) = w; }
            { u32x2 w; w.x = pk2(yy.x, yy.y); w.y = pk2(yy.z, yy.w); *(u32x2*)(Y0s + n * 64 + m0) = w; }
        }
    }
    BLOCK_SYNC();
    }
}

constexpr int LDU = 264;
__device__ __forceinline__ void pool_unit(const Params& P, ldsp lds, int pu) {
    int tid = threadIdx.x; asm volatile("" : "+v"(tid));
    const int lane = tid & 63, wave = tid >> 6, fr = lane & 15, fq = lane >> 4;
    unsigned char* ws = P.ws;
    const bf16_t* pp = (const bf16_t*)(ws + WS_P);
    const int g = pu & 3, tt = pu >> 2, b = tt >> 6, ti0 = (tt & 63) * 64;
    constexpr int O_U = 0, O_PL = 79 * LDU * 2;
    for (int idx = tid; idx < 79 * 32; idx += 512) {
        const int lr = idx >> 5, ch = idx & 31, ti = ti0 + lr - 15;
        const int row = ti >= 0 ? b * SEQ + ti : ROW_META + 16 + ti;
        *(LAS u32x4*)(lds + O_U + (lr * LDU + ch * 8) * 2) = *(const u32x4*)(pp + (size_t)row * NPAD + C_POOL + g * 256 + ch * 8);
    }
    BLOCK_SYNC();
    {
        const int t = tid >> 3, cq = tid & 7, win = 2 << g; const float inv = 1.0f / (float)win;
#pragma unroll
        for (int cc = 0; cc < 4; ++cc) {
            const int c0 = cq * 32 + cc * 8; float s[8], own[8];
            unpack8(*(const LAS u32x4*)(lds + O_U + ((15 + t) * LDU + c0) * 2), own);
#pragma unroll
            for (int i = 0; i < 8; ++i) s[i] = own[i];
            for (int d = 1; d < win; ++d) { float x[8]; unpack8(*(const LAS u32x4*)(lds + O_U + ((15 + t - d) * LDU + c0) * 2), x);
#pragma unroll
                for (int i = 0; i < 8; ++i) s[i] += x[i]; }
#pragma unroll
            for (int i = 0; i < 8; ++i) s[i] = s[i] * inv - own[i];
            *(LAS u32x4*)(lds + O_PL + (t * LDU + c0) * 2) = pack8(s);
        }
    }
    BLOCK_SYNC();
    {
        const bf16_t* wt = (const bf16_t*)(ws + WS_WTPOOL) + (size_t)g * 65536;
        f32x4 acc[2][4];
#pragma unroll
        for (int a = 0; a < 2; ++a)
#pragma unroll
            for (int n = 0; n < 4; ++n) acc[a][n] = (f32x4){0.f, 0.f, 0.f, 0.f};
#pragma unroll 4
        for (int ks = 0; ks < 8; ++ks) {
            bf16x8 af[2];
#pragma unroll
            for (int a = 0; a < 2; ++a) af[a] = *(const bf16x8*)(wt + (size_t)(32 * wave + 16 * a + fr) * 256 + ks * 32 + fq * 8);
#pragma unroll
            for (int n = 0; n < 4; ++n) { const bf16x8 bf = ldsfrag(lds, O_PL, LDU, 16 * n + fr, ks * 32 + fq * 8);
#pragma unroll
                for (int a = 0; a < 2; ++a) acc[a][n] = mfma16(af[a], bf, acc[a][n]); }
        }
        bf16_t* yb = (bf16_t*)(ws + WS_YAB) + 2048;
        const float* psc = P.in[I_PSCALE] + g * 256;
#pragma unroll
        for (int a = 0; a < 2; ++a) { const int d0 = 32 * wave + 16 * a + 4 * fq; const f32x4 sc = *(const f32x4*)(psc + d0);
#pragma unroll
            for (int n = 0; n < 4; ++n) { const int t = 16 * n + fr; const f32x4 o = acc[a][n] * sc;
                u32x2 w; w.x = pk2(o.x, o.y); w.y = pk2(o.z, o.w);
                *(u32x2*)(yb + (size_t)(b * SEQ + ti0 + t) * LDAB + g * 256 + d0) = w; } }
    }
    BLOCK_SYNC();
}
__device__ __forceinline__ void gsig_unit(const Params& P, int gu) {
    int tid = threadIdx.x; asm volatile("" : "+v"(tid));
    const bf16_t* pp = (const bf16_t*)(P.ws + WS_P); bf16_t* gs = (bf16_t*)(P.ws + WS_GSIG);
    const float* mu = P.in[I_MU];
#pragma unroll
    for (int it = 0; it < 4; ++it) {
        const int idx = tid + 512 * it, tl = idx >> 5, ch = idx & 31, col = C_GL + ch * 8;
        const int row = gu * 64 + tl; const int prow = ((row & (SEQ - 1)) == 0) ? (ROW_META + 15) : row - 1;
        float x[8]; shift8r(*(const u32x4*)(pp + (size_t)row * NPAD + col), *(const u32x4*)(pp + (size_t)prow * NPAD + col), mu + col, x);
#pragma unroll
        for (int i = 0; i < 8; ++i) x[i] = fast_sigmoid(x[i]);
        *(u32x4*)(gs + (size_t)row * 256 + ch * 8) = pack8(x);
    }
}
__device__ __forceinline__ void phase2(const Params& P, ldsp lds) {
    PL L;
    if ((int)blockIdx.x < NUNITS) pl_load(P, blockIdx.x, L);
    for (int u = blockIdx.x; u < NUNITS + 128; u += gridDim.x) {
        if (u < NUNITS) { const int nu = u + (int)gridDim.x; rwkv_unit(P, lds, u, L, nu < NUNITS ? nu : -1); }
        else gsig_unit(P, u - NUNITS);
    }

}
__device__ __forceinline__ void phase3(const Params& P) {
    const int lane = threadIdx.x & 63, wave = threadIdx.x >> 6, fr = lane & 15, fq = lane >> 4;
    if (wave != 0) { convert_tables(P, CONV_P2_ROWS + blockIdx.x * 7 + (wave - 1), 32768, gridDim.x * 7); return; }
    unsigned char* ws = P.ws;
    const bf16_t* Gp = (const bf16_t*)(ws + WS_G); const bf16_t* H0t = (const bf16_t*)(ws + WS_H0T); bf16_t* S0t = (bf16_t*)(ws + WS_S0T);
    for (int item = blockIdx.x; item < 256; item += gridDim.x) {
        const int bh = item >> 2, vq = item & 3, h = bh & 31;
        bf16x8 Sb[2];
#pragma unroll
        for (int ks = 0; ks < 2; ++ks)
#pragma unroll
            for (int i = 0; i < 8; ++i) Sb[ks][i] = 0;
        bf16x8 g0[4][2], g1[4][2], g2[4][2], g3[4][2]; u32x2 h0[4], h1[4], h2[4], h3[4];
        auto load = [&](int step, bf16x8 (&ga)[4][2], u32x2 (&hf)[4]) {
            const int u = (step == 0) ? (4096 + h) : (bh * 64 + step - 1);
            const bf16_t* g = Gp + (size_t)u * 4096; const bf16_t* hh = H0t + (size_t)u * 4096;
#pragma unroll
            for (int mt = 0; mt < 4; ++mt) {
#pragma unroll
                for (int ks = 0; ks < 2; ++ks) ga[mt][ks] = *(const bf16x8*)(g + (16 * mt + fr) * 64 + ks * 32 + fq * 8);
                hf[mt] = *(const u32x2*)(hh + (16 * vq + fr) * 64 + 16 * mt + 4 * fq);
            }
        };
        auto apply = [&](int step, const bf16x8 (&ga)[4][2], const u32x2 (&hf)[4]) {
            f32x4 acc[4];
#pragma unroll
            for (int mt = 0; mt < 4; ++mt) {
                acc[mt] = (f32x4){bflo(hf[mt].x), bfhi(hf[mt].x), bflo(hf[mt].y), bfhi(hf[mt].y)};
                acc[mt] = mfma16(ga[mt][0], Sb[0], acc[mt]);
                acc[mt] = mfma16(ga[mt][1], Sb[1], acc[mt]);
            }
            bf16_t* so = S0t + (size_t)(bh * 64 + step) * 4096 + (16 * vq + fr) * 64 + 4 * fq;
            u32x2 w[4];
#pragma unroll
            for (int mt = 0; mt < 4; ++mt) { w[mt].x = pk2(acc[mt].x, acc[mt].y); w[mt].y = pk2(acc[mt].z, acc[mt].w); *(u32x2*)(so + 16 * mt) = w[mt]; }
#pragma unroll
            for (int ks = 0; ks < 2; ++ks) {
                const u32x4 q4 = (u32x4){w[2 * ks].x, w[2 * ks].y, w[2 * ks + 1].x, w[2 * ks + 1].y};
                Sb[ks] = __builtin_bit_cast(bf16x8, q4);
            }
        };
        load(0, g0, h0); load(1, g1, h1); load(2, g2, h2);
#pragma unroll 1
        for (int step = 0; step < 64; step += 4) {
            load(step + 3, g3, h3); apply(step, g0, h0);
            if (step + 4 < 64) load(step + 4, g0, h0);
            apply(step + 1, g1, h1);
            if (step + 5 < 64) load(step + 5, g1, h1);
            apply(step + 2, g2, h2);
            if (step + 6 < 64) load(step + 6, g2, h2);
            apply(step + 3, g3, h3);
        }
    }
}

constexpr int LDG = 264;
__device__ __forceinline__ void phase3b(const Params& P, ldsp lds) {
    int tid = threadIdx.x; asm volatile("" : "+v"(tid));
    const int lane = tid & 63, wave = tid >> 6, fr = lane & 15, fq = lane >> 4, wq = wave & 3;
    unsigned char* ws = P.ws;
    const bf16_t* pp = (const bf16_t*)(ws + WS_P);
    const float* mu = P.in[I_MU];
    constexpr int O_G2 = 0;
    for (int pu = blockIdx.x; pu < 512; pu += gridDim.x) pool_unit(P, lds, pu);
    for (int w = blockIdx.x; w < 256; w += gridDim.x) {
        const int h = w & 31;
        BLOCK_SYNC();
        for (int idx = tid; idx < 64 * 32; idx += 512) { const int row = idx >> 5, ch = idx & 31;
            *(LAS u32x4*)(lds + O_G2 + (row * LDG + ch * 8) * 2) = *(const u32x4*)((const bf16_t*)(ws + WS_WTG2) + (size_t)(h * 64 + row) * 256 + ch * 8); }
        BLOCK_SYNC();
        bf16x8 bG[8], bR[2], aS[4][2]; u32x2 yw[4], vc[4], vp[4]; float bon;
        auto unit_of = [&](int it, int& b, int& c) { const int q = (w >> 5) + 8 * (2 * it + (wave >> 2)); b = q >> 6; c = q & 63; };
        auto issue = [&](int it) {
            int b, c; unit_of(it, b, c); const int u = (b * 32 + h) * 64 + c, trow0 = b * SEQ + c * 64 + 16 * wq;
            const size_t ub = (size_t)u * 4096;
            const bf16_t* S0t = (const bf16_t*)(ws + WS_S0T) + ub; const bf16_t* Rt = (const bf16_t*)(ws + WS_RT) + ub; const bf16_t* Y0s = (const bf16_t*)(ws + WS_Y0) + ub;
            const int row = trow0 + fr; const int prow = (c == 0 && wq == 0 && fr == 0) ? (ROW_META + 15) : row - 1;
            const bf16_t* gsr = (const bf16_t*)(ws + WS_GSIG) + (size_t)row * 256 + fq * 8;
#pragma unroll
            for (int ks = 0; ks < 8; ++ks) bG[ks] = *(const bf16x8*)(gsr + ks * 32);
#pragma unroll
            for (int ks = 0; ks < 2; ++ks) bR[ks] = *(const bf16x8*)(Rt + (16 * wq + fr) * 64 + ks * 32 + fq * 8);
#pragma unroll
            for (int mt = 0; mt < 4; ++mt) {
                yw[mt] = *(const u32x2*)(Y0s + (16 * wq + fr) * 64 + 16 * mt + 4 * fq);
#pragma unroll
                for (int ks = 0; ks < 2; ++ks) aS[mt][ks] = *(const bf16x8*)(S0t + (16 * mt + fr) * 64 + ks * 32 + fq * 8);
                const int hc = h * 64 + 16 * mt + 4 * fq;
                vc[mt] = *(const u32x2*)(pp + (size_t)row * NPAD + C_V + hc); vp[mt] = *(const u32x2*)(pp + (size_t)prow * NPAD + C_V + hc);
            }
            bon = ((const float*)(ws + WS_BONUS))[(size_t)row * 32 + h];
        };
        issue(0);
#pragma unroll 1
        for (int it = 0; it < 8; ++it) {
            int b, c; unit_of(it, b, c);
            const int row = b * SEQ + c * 64 + 16 * wq + fr;
            f32x4 gacc[4];
#pragma unroll
            for (int mt = 0; mt < 4; ++mt) gacc[mt] = (f32x4){0.f, 0.f, 0.f, 0.f};
#pragma unroll
            for (int ks = 0; ks < 8; ++ks)
#pragma unroll
                for (int mt = 0; mt < 4; ++mt) gacc[mt] = mfma16(*(const LAS bf16x8*)(lds + O_G2 + ((16 * mt + fr) * LDG + ks * 32 + fq * 8) * 2), bG[ks], gacc[mt]);
            f32x4 y[4], vv[4]; const float bonc = bon;
#pragma unroll
            for (int mt = 0; mt < 4; ++mt) {
                y[mt] = (f32x4){bflo(yw[mt].x), bfhi(yw[mt].x), bflo(yw[mt].y), bfhi(yw[mt].y)};
#pragma unroll
                for (int ks = 0; ks < 2; ++ks) y[mt] = mfma16(aS[mt][ks], bR[ks], y[mt]);
                const f32x4 mv = *(const f32x4*)(mu + C_V + h * 64 + 16 * mt + 4 * fq);
                const f32x4 cv = (f32x4){bflo(vc[mt].x), bfhi(vc[mt].x), bflo(vc[mt].y), bfhi(vc[mt].y)}, pv = (f32x4){bflo(vp[mt].x), bfhi(vp[mt].x), bflo(vp[mt].y), bfhi(vp[mt].y)};
                vv[mt] = cv + (pv - cv) * mv;
            }
#pragma unroll
            for (int mt = 0; mt < 4; ++mt) asm volatile("" : "+v"(y[mt]), "+v"(vv[mt]), "+v"(gacc[mt]));
            if (it + 1 < 8) issue(it + 1);
            float s = 0.f;
#pragma unroll
            for (int mt = 0; mt < 4; ++mt) s += (y[mt].x + y[mt].y) + (y[mt].z + y[mt].w);
            s += __shfl_xor(s, 16); s += __shfl_xor(s, 32);
            const float mean = s * (1.0f / 64.0f); float qq = 0.f;
#pragma unroll
            for (int mt = 0; mt < 4; ++mt) { y[mt] = y[mt] - mean; qq += (y[mt].x * y[mt].x + y[mt].y * y[mt].y) + (y[mt].z * y[mt].z + y[mt].w * y[mt].w); }
            qq += __shfl_xor(qq, 16); qq += __shfl_xor(qq, 32);
            const float rstd = 1.0f / sqrtf(qq * (1.0f / 64.0f) + GN_EPS);
            bf16_t* ya = (bf16_t*)(ws + WS_YAB) + (size_t)row * LDAB + h * 64;
#pragma unroll
            for (int mt = 0; mt < 4; ++mt) {
                const int i0 = 16 * mt + 4 * fq, hc = h * 64 + i0;
                const f32x4 gg = *(const f32x4*)(P.in[I_GNG] + hc), gb = *(const f32x4*)(P.in[I_GNB] + hc);
                const f32x4 o = (y[mt] * rstd * gg + gb + vv[mt] * bonc) * gacc[mt];
                u32x2 wv; wv.x = pk2(o.x, o.y); wv.y = pk2(o.z, o.w);
                *(u32x2*)(ya + i0) = wv;
            }
        }
    }
}
__device__ __forceinline__ u32x6 ld_row6(const unsigned char* p) { const u32x2 a = ((const u32x2*)p)[0], b = ((const u32x2*)p)[1], c = ((const u32x2*)p)[2]; return (u32x6){a.x, a.y, b.x, b.y, c.x, c.y}; }
__device__ __forceinline__ void peer_token(const Params& P, int tok, const LAS int* eidx, const LAS float* gts) {
    const int lane = threadIdx.x & 63;
    unsigned char* ws = P.ws;
    const unsigned char* Ub = ws + WS_UB; const unsigned char* Vb = ws + WS_VB;
    const float* tsc = (const float*)(ws + WS_TSC);
    {
        int lo = lane; asm volatile("" : "+v"(lo));
        float x[32], o[32];
        {
            const bf16_t* hr = (const bf16_t*)(ws + WS_X1B) + (size_t)tok * D + lo * 32;
#pragma unroll
            for (int i = 0; i < 4; ++i) unpack8(*(const u32x4*)(hr + 8 * i), x + 8 * i);
            const float* st = (const float*)(ws + WS_STAT);
            const float mean1 = st[tok] * (1.0f / D), rstd1 = 1.0f / sqrtf(fmaxf(st[8192 + tok] * (1.0f / D) - mean1 * mean1, 0.f) + LN_EPS);
#pragma unroll
            for (int c = 0; c < 8; ++c) { const f32x4 g1 = *(const f32x4*)(P.in[I_LN1G] + lo * 32 + 4 * c), b1 = *(const f32x4*)(P.in[I_LN1B] + lo * 32 + 4 * c);
                x[4 * c] = (x[4 * c] - mean1) * rstd1 * g1.x + b1.x; x[4 * c + 1] = (x[4 * c + 1] - mean1) * rstd1 * g1.y + b1.y; x[4 * c + 2] = (x[4 * c + 2] - mean1) * rstd1 * g1.z + b1.z; x[4 * c + 3] = (x[4 * c + 3] - mean1) * rstd1 * g1.w + b1.w; }
#pragma unroll
            for (int i = 0; i < 32; ++i) o[i] = 0.f;
        }
        const int e_lo = eidx[lo], e_hi = eidx[64 + lo];
        const float su_lo = tsc[e_lo], su_hi = tsc[e_hi];
        const float gv_lo = gts[lo] * tsc[16384 + e_lo], gv_hi = gts[64 + lo] * tsc[16384 + e_hi];
        u32x4 ua[2], ub[2]; u32x6 va[2], vb[2];
        auto issue = [&](int g, u32x4 (&uu)[2], u32x6 (&vv)[2]) {
            const int ev = (g < 32) ? e_lo : e_hi;
#pragma unroll
            for (int j = 0; j < 2; ++j) {
                const int e = __builtin_amdgcn_readlane(ev, (2 * g + j) & 63);
                uu[j] = *(const u32x4*)(Ub + (size_t)e * UROW + lo * 16); vv[j] = ld_row6(Vb + (size_t)e * TROW + lo * 24);
            }
        };
        auto consume = [&](int g, const u32x4 (&uu)[2], const u32x6 (&vv)[2]) {
            const float suv = (g < 32) ? su_lo : su_hi, gvv = (g < 32) ? gv_lo : gv_hi;
            float dd[2];
#pragma unroll
            for (int j = 0; j < 2; ++j) { float s0 = 0.f, s1 = 0.f; const unsigned ww[4] = {uu[j].x, uu[j].y, uu[j].z, uu[j].w};
#pragma unroll
                for (int q4 = 0; q4 < 4; ++q4) {
                    const f32x2 r0 = __builtin_amdgcn_cvt_scalef32_pk_f32_fp4(ww[q4], 1.0f, 0), r1 = __builtin_amdgcn_cvt_scalef32_pk_f32_fp4(ww[q4], 1.0f, 1), r2 = __builtin_amdgcn_cvt_scalef32_pk_f32_fp4(ww[q4], 1.0f, 2), r3 = __builtin_amdgcn_cvt_scalef32_pk_f32_fp4(ww[q4], 1.0f, 3);
                    s0 += r0.x * x[8 * q4] + r1.x * x[8 * q4 + 2] + r2.x * x[8 * q4 + 4] + r3.x * x[8 * q4 + 6];
                    s1 += r0.y * x[8 * q4 + 1] + r1.y * x[8 * q4 + 3] + r2.y * x[8 * q4 + 5] + r3.y * x[8 * q4 + 7]; }
                dd[j] = s0 + s1; }
#pragma unroll
            for (int j = 0; j < 2; ++j) dd[j] = wave_sum_dpp(dd[j]);
            const int l0 = (2 * g) & 63;
            const pg8::f32x2 ge = pg8::gelu_pk((pg8::f32x2){dd[0] * readlane_f(suv, l0), dd[1] * readlane_f(suv, l0 + 1)});
            const float a0 = ge.x * readlane_f(gvv, l0), a1 = ge.y * readlane_f(gvv, l0 + 1);
            { const f32x32 r = __builtin_amdgcn_cvt_scalef32_pk32_f32_fp6(vv[0], 1.0f);
#pragma unroll
              for (int i = 0; i < 32; ++i) o[i] += a0 * r[i]; }
            { const f32x32 r = __builtin_amdgcn_cvt_scalef32_pk32_f32_fp6(vv[1], 1.0f);
#pragma unroll
              for (int i = 0; i < 32; ++i) o[i] += a1 * r[i]; }
        };
        issue(0, ua, va);
        for (int g = 0; g < 64; g += 2) {
            issue(g + 1, ub, vb);
            consume(g, ua, va);
            if (g + 2 < 64) issue(g + 2, ua, va);
            consume(g + 1, ub, vb);
        }
        float s = 0.f;
#pragma unroll
        for (int i = 0; i < 32; ++i) { o[i] += DN_ALPHA * x[i]; s += o[i]; }
        const float mean = wave_sum_dpp(s) * (1.0f / D); float q = 0.f;
#pragma unroll
        for (int i = 0; i < 32; ++i) { o[i] -= mean; q += o[i] * o[i]; }
        const float rstd = 1.0f / sqrtf(wave_sum_dpp(q) * (1.0f / D) + LN_EPS);
        float* orow = P.out + (size_t)tok * D + lo * 32;
#pragma unroll
        for (int c = 0; c < 8; ++c) {
            const int off = lo * 32 + 4 * c;
            const f32x4 g0 = *(const f32x4*)(P.in[I_LN2G] + off), b0 = *(const f32x4*)(P.in[I_LN2B] + off);
            f32x4 r0;
            r0.x = o[4 * c + 0] * rstd * g0.x + b0.x; r0.y = o[4 * c + 1] * rstd * g0.y + b0.y; r0.z = o[4 * c + 2] * rstd * g0.z + b0.z; r0.w = o[4 * c + 3] * rstd * g0.w + b0.w;
            *(f32x4*)(orow + 4 * c) = r0;
        }
    }
}
#define CE_DESC(a, b) do { const float h_ = fmaxf((a), (b)), l_ = fminf((a), (b)); (a) = h_; (b) = l_; } while (0)
template <int N> __device__ __forceinline__ void bitonic_sort_desc(float (&v)[N]) {
#pragma unroll
    for (int k = 2; k <= N; k <<= 1)
#pragma unroll
        for (int j = k >> 1; j > 0; j >>= 1)
#pragma unroll
            for (int i = 0; i < N; ++i) { const int l = i ^ j; if (l > i) { if ((i & k) == 0) CE_DESC(v[i], v[l]); else CE_DESC(v[l], v[i]); } }
}
template <int N> __device__ __forceinline__ void bitonic_merge_desc(float (&v)[N]) {
#pragma unroll
    for (int j = N >> 1; j > 0; j >>= 1)
#pragma unroll
        for (int i = 0; i < N; ++i) { const int l = i ^ j; if (l > i) CE_DESC(v[i], v[l]); }
}
__device__ __forceinline__ void top16_merge(float (&a)[16], const float (&brev)[16]) {
#pragma unroll
    for (int i = 0; i < 16; ++i) a[i] = fmaxf(a[i], brev[i]);
    bitonic_merge_desc<16>(a);
}
__device__ __forceinline__ float embed_bits(float v, unsigned code, unsigned mask) { return __uint_as_float((__float_as_uint(v) & ~mask) | code); }

__device__ __forceinline__ void phase7(const Params& P, ldsp lds) {
    const int tid0 = threadIdx.x;
    unsigned char* ws = P.ws;
    const bf16_t* qb = (const bf16_t*)(ws + WS_Q); const bf16_t* sk = (const bf16_t*)(ws + WS_SUBK);
    constexpr int LDSK = 136, O_SK = 0, O_SV = 2 * 128 * LDSK * 2, O_EX = O_SV + 32768, O_GT = O_EX + 16384;
    for (int idx = tid0; idx < 2 * 128 * 16; idx += 512) { const int row = idx >> 4, ch = idx & 15;
        *(LAS u32x4*)(lds + O_SK + (row * LDSK + ch * 8) * 2) = *(const u32x4*)(sk + row * 128 + ch * 8); }
    BLOCK_SYNC();
    for (int tile = blockIdx.x; tile < 256; tile += gridDim.x) {
        int tid = tid0; asm volatile("" : "+v"(tid));
        const int lane = tid & 63, wave = tid >> 6, fr = lane & 15, fq = lane >> 4, fro = fr, fqo = fq;
        const int tok0 = tile * 32, h = wave;
#pragma unroll 1
        for (int cb = 0; cb < 4; ++cb) {
            const int nt = cb >> 1, p = cb & 1;
            f32x4 acc[8];
#pragma unroll
            for (int mt = 0; mt < 8; ++mt) acc[mt] = (f32x4){0.f, 0.f, 0.f, 0.f};
            const bf16_t* qrow = qb + (size_t)(tok0 + 16 * nt + fro) * D + h * 256 + p * 128 + fqo * 8;
#pragma unroll
            for (int ks = 0; ks < 4; ++ks) {
                const bf16x8 bq = *(const bf16x8*)(qrow + ks * 32);
#pragma unroll
                for (int mt = 0; mt < 8; ++mt) acc[mt] = mfma16(*(const LAS bf16x8*)(lds + O_SK + ((p * 128 + 16 * mt + fro) * LDSK + ks * 32 + fqo * 8) * 2), bq, acc[mt]);
            }
            float a[16], b[16];
#pragma unroll
            for (int mt = 0; mt < 4; ++mt) {
                a[4 * mt + 0] = embed_bits(acc[mt].x, 16 * mt + 4 * fq + 0, 127u); a[4 * mt + 1] = embed_bits(acc[mt].y, 16 * mt + 4 * fq + 1, 127u);
                a[4 * mt + 2] = embed_bits(acc[mt].z, 16 * mt + 4 * fq + 2, 127u); a[4 * mt + 3] = embed_bits(acc[mt].w, 16 * mt + 4 * fq + 3, 127u);
                b[4 * mt + 0] = embed_bits(acc[mt + 4].x, 16 * (mt + 4) + 4 * fq + 0, 127u); b[4 * mt + 1] = embed_bits(acc[mt + 4].y, 16 * (mt + 4) + 4 * fq + 1, 127u);
                b[4 * mt + 2] = embed_bits(acc[mt + 4].z, 16 * (mt + 4) + 4 * fq + 2, 127u); b[4 * mt + 3] = embed_bits(acc[mt + 4].w, 16 * (mt + 4) + 4 * fq + 3, 127u);
            }
            bitonic_sort_desc<16>(a); bitonic_sort_desc<16>(b);
            { float br[16];
#pragma unroll
              for (int i = 0; i < 16; ++i) br[i] = b[15 - i];
              top16_merge(a, br); }
#pragma unroll
            for (int x = 16; x <= 32; x <<= 1) { float br[16];
#pragma unroll
                for (int i = 0; i < 16; ++i) br[i] = __shfl_xor(a[15 - i], x);
                top16_merge(a, br); }
            if (fq == 0) { LAS f32x4* o = (LAS f32x4*)(lds + O_SV + ((((16 * nt + fr) * 8 + h) * 2 + p) * 16) * 4);
                o[0] = (f32x4){a[0], a[1], a[2], a[3]}; o[1] = (f32x4){a[4], a[5], a[6], a[7]}; o[2] = (f32x4){a[8], a[9], a[10], a[11]}; o[3] = (f32x4){a[12], a[13], a[14], a[15]}; }
        }
        BLOCK_SYNC();
        if (tid < 256) {
            const int tok = tid >> 3, hh = tid & 7;
            const LAS f32x4* s = (const LAS f32x4*)(lds + O_SV + (((tok * 8 + hh) * 2) * 16) * 4);
            float s0[16], s1[16];
#pragma unroll
            for (int c4 = 0; c4 < 4; ++c4) { const f32x4 x = s[c4], y = s[4 + c4]; s0[4 * c4] = x.x; s0[4 * c4 + 1] = x.y; s0[4 * c4 + 2] = x.z; s0[4 * c4 + 3] = x.w; s1[4 * c4] = y.x; s1[4 * c4 + 1] = y.y; s1[4 * c4 + 2] = y.z; s1[4 * c4 + 3] = y.w; }
            float g0[16], g1[16], g2[16], g3[16];
            const float NEG = -3.0e38f;
#pragma unroll
            for (int bq = 0; bq < 16; ++bq) g0[bq] = embed_bits(s0[0] + s1[bq], bq, 255u);
            {
                int n1 = 0, n2 = 0, n3 = 0;
#pragma unroll
                for (int aa = 1; aa < 16; ++aa)
#pragma unroll
                    for (int bb = 0; bb < 16; ++bb) if ((aa + 1) * (bb + 1) <= 16) {
                        const float c = embed_bits(s0[aa] + s1[bb], aa * 16 + bb, 255u);
                        if (n1 < 16) g1[n1++] = c; else if (n2 < 16) g2[n2++] = c; else g3[n3++] = c;
                    }
#pragma unroll
                for (int i = 0; i < 16; ++i) if (i >= n3) g3[i] = NEG;
            }
            bitonic_sort_desc<16>(g1); bitonic_sort_desc<16>(g2); bitonic_sort_desc<16>(g3);
            { float r1[16], r3[16];
#pragma unroll
              for (int i = 0; i < 16; ++i) { r1[i] = g1[15 - i]; r3[i] = g3[15 - i]; }
              top16_merge(g0, r1); top16_merge(g2, r3);
#pragma unroll
              for (int i = 0; i < 16; ++i) g0[i] = fmaxf(g0[i], g2[15 - i]); }
            float mx = g0[0];
#pragma unroll
            for (int i = 1; i < 16; ++i) mx = fmaxf(mx, g0[i]);
            float ex[16], sm = 0.f; int ee[16];
#pragma unroll
            for (int i = 0; i < 16; ++i) {
                ex[i] = __expf(g0[i] - mx); sm += ex[i];
                const unsigned code = __float_as_uint(g0[i]) & 255u;
                const unsigned i0 = __float_as_uint(*(const LAS float*)(lds + O_SV + ((((tok * 8 + hh) * 2 + 0) * 16) + (code >> 4)) * 4)) & 127u;
                const unsigned i1 = __float_as_uint(*(const LAS float*)(lds + O_SV + ((((tok * 8 + hh) * 2 + 1) * 16) + (code & 15u)) * 4)) & 127u;
                ee[i] = (int)(i0 * 128u + i1);
            }
            const float inv = 1.0f / sm;
            LAS int* eo = (LAS int*)(lds + O_EX) + tok * 128 + hh * 16; LAS float* go = (LAS float*)(lds + O_GT) + tok * 128 + hh * 16;
#pragma unroll
            for (int c4 = 0; c4 < 4; ++c4) {
                *(LAS u32x4*)(eo + 4 * c4) = (u32x4){(unsigned)ee[4 * c4], (unsigned)ee[4 * c4 + 1], (unsigned)ee[4 * c4 + 2], (unsigned)ee[4 * c4 + 3]};
                *(LAS f32x4*)(go + 4 * c4) = (f32x4){ex[4 * c4] * inv, ex[4 * c4 + 1] * inv, ex[4 * c4 + 2] * inv, ex[4 * c4 + 3] * inv};
            }
        }
        BLOCK_SYNC();
#pragma unroll 1
        for (int i = 0; i < 4; ++i) peer_token(P, tok0 + wave * 4 + i, (const LAS int*)(lds + O_EX) + (wave * 4 + i) * 128, (const LAS float*)(lds + O_GT) + (wave * 4 + i) * 128);
        BLOCK_SYNC();
    }
}
#ifndef MK_MULTI
#define MK_MULTI 0
#endif
__global__ __launch_bounds__(512, 2) void hybrid_fwd(Params P) {
    extern __shared__ __attribute__((aligned(16))) unsigned char shm[];
    ldsp lds = (ldsp)shm;
    unsigned char* ws = P.ws;
    volatile LAS unsigned* xst = (volatile LAS unsigned*)(lds + LDS_BYTES - 16);
    if (threadIdx.x == 0) { xst[0] = 0u; xst[1] = 0u; }
    __syncthreads();
    const XcdBarrier xbar = xcd_barrier_post((unsigned*)(ws + WS_BAR), xst);
    const int lo = P.ph_lo, hi = P.ph_hi;
#ifdef DBG_TA
    unsigned long long ts0 = 0, ts1 = 0, ts2 = 0, ts3 = 0, ts4 = 0, ts5 = 0, ts6 = 0, ts7 = 0, ts8 = 0, ts9 = 0, ts10 = 0, ts11 = 0;
#define STAMP(k) ts##k = __builtin_amdgcn_s_memrealtime()
#else
#define STAMP(k) do { } while (0)
#endif
    STAMP(0);
#ifndef REPEAT_PHASE
#define REPEAT_PHASE -1
#define REPEAT_N 1
#endif
#define PHASE(k) if (lo <= (k) && (k) < hi) for (int rep_ = 0; rep_ < ((k) == REPEAT_PHASE ? REPEAT_N : 1); ++rep_)
#define SEAM(k) do { if (lo <= (k) && (k) + 1 < hi) xcd_barrier(xbar); } while (0)
    PHASE(0) phase0(P);
    SEAM(0); STAMP(1);
    PHASE(1) { pg8::EpiBf16<0> E; E.O = (bf16_t*)(ws + WS_P); E.ldc = NPAD; E.bias = nullptr; E.split_cols = 0; E.split_stride = 0;
        run_gemm(lds, (const bf16_t*)(ws + WS_H0B), (const bf16_t*)(ws + WS_WTIN), MROWS, NPAD, 2048, E); }
    SEAM(1); STAMP(2);
    PHASE(2) phase2(P, lds);
    SEAM(2); STAMP(3);
    PHASE(3) phase3(P);
    SEAM(3); STAMP(4);
    PHASE(4) phase3b(P, lds);
    SEAM(4); STAMP(5);
    PHASE(5) {
        { pg8::EpiGate35 E; E.O = (bf16_t*)(ws + WS_MERGED); E.p = (const bf16_t*)(ws + WS_P); E.bgate = P.in[I_BGATE];
          run_gemm(lds, (const bf16_t*)(ws + WS_YAB), (const bf16_t*)(ws + WS_WTAB), NTOK, 2048, LDAB, E); }
    }
    SEAM(5); STAMP(6);
    PHASE(6) { pg8::EpiResidStats E; E.O = (bf16_t*)(ws + WS_X1B); E.h0 = (const bf16_t*)(ws + WS_H0B); E.alpha = DN_ALPHA; E.rsum = (float*)(ws + WS_STAT); E.rsq = (float*)(ws + WS_STAT) + 8192;
        run_gemm(lds, (const bf16_t*)(ws + WS_MERGED), (const bf16_t*)(ws + WS_WTOUT), NTOK, 2048, 2048, E); }
    SEAM(6); STAMP(7);
    PHASE(7) { pg8::EpiQ E; E.O = (bf16_t*)(ws + WS_Q); E.rsum = (const float*)(ws + WS_STAT); E.rsq = (const float*)(ws + WS_STAT) + 8192; E.c1 = (const float*)(ws + WS_STAT) + 16384; E.c2 = (const float*)(ws + WS_STAT) + 18432;
        run_gemm(lds, (const bf16_t*)(ws + WS_X1B), (const bf16_t*)(ws + WS_WTQ), NTOK, 2048, 2048, E); }
    SEAM(7); STAMP(8);
    PHASE(8) phase7(P, lds);
#ifdef DBG_TA
    {
        __threadfence_system(); asm volatile("s_waitcnt vmcnt(0) lgkmcnt(0)" ::: "memory"); __syncthreads(); grid.sync(); __threadfence_system();
        STAMP(11);
        const unsigned long long tt[12] = {ts0, ts1, ts2, ts3, ts4, ts5, ts6, ts7, ts8, ts8, ts8, ts11};
        const float ta = (float)(tt[DBG_TA + 1] - tt[DBG_TA]) * 0.01f, tb = (float)(tt[DBG_TB + 1] - tt[DBG_TB]) * 0.01f;
        if (blockIdx.x == 0) { for (int i = threadIdx.x + 1; i <= 1000000; i += 512) P.out[i] = tb; if (threadIdx.x == 0) P.out[0] = 1000.0f * ta; }
    }
#endif
#ifdef DBG_STOP
    {
        __threadfence_system(); asm volatile("s_waitcnt vmcnt(0) lgkmcnt(0)" ::: "memory"); __syncthreads(); grid.sync(); __threadfence_system();
        const size_t a = DBG_A, b = DBG_B; const unsigned* w = (const unsigned*)(ws + a); const size_t nw = (b - a) / 4, NO = (size_t)NTOK * D;
        for (size_t i = (size_t)blockIdx.x * 512 + threadIdx.x; i < NO; i += (size_t)gridDim.x * 512) {
            unsigned acc = 0; for (size_t j = i; j < nw; j += NO) { const unsigned x = w[j]; acc += (x & 0xffffu) + (x >> 16); }
            P.out[i] = (float)(acc & 0xfffffu);
        }
    }
#endif
#undef PHASE
#undef SEAM
}

extern "C" void kernel_launch(void* const* d_in, const int* in_sizes, int n_in, void* d_out, int out_size, void* d_ws, size_t ws_size, hipStream_t stream) {
    static int grid = 0;
    if (grid == 0) {
        if (n_in != 30 || out_size != NTOK * D || ws_size < WS_END) { fprintf(stderr, "kernel_launch: unexpected shapes (n_in %d, out %d, ws %zu < %zu)\n", n_in, out_size, ws_size, (size_t)WS_END); grid = -1; return; }
        int dev = 0, cus = 0, per_cu = 0;
        if (hipGetDevice(&dev) != hipSuccess || hipDeviceGetAttribute(&cus, hipDeviceAttributeMultiprocessorCount, dev) != hipSuccess) { grid = -1; return; }
        if (hipFuncSetAttribute((const void*)hybrid_fwd, hipFuncAttributeMaxDynamicSharedMemorySize, LDS_BYTES) != hipSuccess) { fprintf(stderr, "kernel_launch: hipFuncSetAttribute failed\n"); grid = -1; return; }
        if (hipOccupancyMaxActiveBlocksPerMultiprocessor(&per_cu, (const void*)hybrid_fwd, 512, LDS_BYTES) != hipSuccess || per_cu < 1) { fprintf(stderr, "kernel_launch: occupancy query says %d\n", per_cu); grid = -1; return; }
        (void)hipGetLastError();
        grid = cus;
    }
    if (grid < 0) return;
    if (hipMemsetAsync((unsigned char*)d_ws + WS_BAR, 0, 16384 + STAT_BYTES, stream) != hipSuccess) { fprintf(stderr, "kernel_launch: memset failed\n"); return; }
    Params p{};
    for (int i = 0; i < 30; ++i) p.in[i] = (const float*)d_in[i];
    p.out = (float*)d_out; p.ws = (unsigned char*)d_ws;
#if MK_MULTI
    for (int ph = 0; ph <= NPHASE; ++ph) { p.ph_lo = ph; p.ph_hi = ph + 1; hipLaunchKernelGGL(hybrid_fwd, dim3(grid), dim3(512), LDS_BYTES, stream, p); }
#else
    p.ph_lo = 0; p.ph_hi = NPHASE + 1;
#ifdef DBG_STOP
    p.ph_hi = DBG_STOP + 1;
#endif
    void* args[] = {&p};
    hipError_t e = hipLaunchCooperativeKernel((const void*)hybrid_fwd, dim3(grid), dim3(512), args, LDS_BYTES, stream);
    if (e != hipSuccess) fprintf(stderr, "kernel_launch: cooperative launch failed: %s (grid %d)\n", hipGetErrorString(e), grid);
#endif
}
```

```cpp
#include <hip/hip_runtime.h>
#include <hip/hip_cooperative_groups.h>
#include <cstdio>
#include <cstdint>
namespace cg = cooperative_groups;
namespace pg8 {
#define PG8_LAS __attribute__((address_space(3)))
typedef unsigned short bf16_t;
typedef short bf16x8 __attribute__((ext_vector_type(8)));
typedef float f32x4 __attribute__((ext_vector_type(4)));
typedef unsigned u32x4 __attribute__((ext_vector_type(4)));
constexpr int BM = 256, BK = 64, HALF = 128, HTB = HALF * BK * 2  , STAGE_BYTES = 8 * HTB, NXCD = 8, WGM = 8;

__host__ __device__ __forceinline__ int lds_byte(int r, int c) { const int st = (r >> 4) * 2 + (c >> 5), rr = r & 15, cc = c & 31, ob = rr * 64 + cc * 2; return st * 1024 + (ob ^ (((ob >> 9) & 1) << 5)); }
__host__ __device__ __forceinline__ void stage_rc(int b, int& R, int& C) { const int st = b / 1024, sb = b % 1024, swz = sb ^ (((sb >> 9) & 1) << 5); R = (st >> 1) * 16 + swz / 64; C = (st & 1) * 32 + (swz % 64) / 2; }
__host__ __device__ __forceinline__ int perm32(int rho) { const int n = rho >> 4, i = rho & 15; return 8 * (i >> 2) + 4 * n + (i & 3); }

struct Unit { int pm, pn; };
struct Gemm { const bf16_t* A; const bf16_t* Bt; int M, N, K; };

struct StaticOrder {
    int nM, nN, nwg, G, c;
    __host__ __device__ void init(int M, int N, int G_, int c_) { nM = M / BM; nN = N / BM; nwg = nM * nN; G = G_; c = c_; }
    __host__ __device__ bool next(int i, Unit& u) const {
        const long L = (long)i * G + c; if (L >= nwg) return false;
        int wgid = (int)L; { const int q = nwg / NXCD, r = nwg % NXCD, xcd = wgid % NXCD, off = wgid / NXCD; wgid = (xcd < r ? xcd * (q + 1) : r * (q + 1) + (xcd - r) * q) + off; }
        const int nig = WGM * nN, gid = wgid / nig, fm = gid * WGM, gsz = (nM - fm) < WGM ? (nM - fm) : WGM;
        u.pm = fm + ((wgid % nig) % gsz); u.pn = (wgid % nig) / gsz; return true;
    }
    __device__ __forceinline__ void a_ready(const Unit&) const {}
    __device__ __forceinline__ void done(const Unit&) const {}
};
struct CountedOrder : StaticOrder {
    const unsigned* ready; unsigned need; unsigned* tmo;
    __device__ __forceinline__ void a_ready(const Unit& u) const {
        if (threadIdx.x < 64) {
            const unsigned long long t0 = __builtin_amdgcn_s_memrealtime(); unsigned polls = 0;
            while ((unsigned)__builtin_amdgcn_readfirstlane(__hip_atomic_load(ready + 64 * u.pm, __ATOMIC_RELAXED, __HIP_MEMORY_SCOPE_AGENT)) < need) {
                if ((++polls & 255u) == 0u && __builtin_amdgcn_readfirstlane(__hip_atomic_load(tmo, __ATOMIC_RELAXED, __HIP_MEMORY_SCOPE_AGENT)) != 0u) break;
                if (__builtin_amdgcn_s_memrealtime() - t0 > 2000000ull) {
                    if (threadIdx.x == 0) { unsigned expect = 0u; __hip_atomic_compare_exchange_strong(tmo + 1, &expect, 0x600u | (unsigned)(u.pm & 0xff), __ATOMIC_RELAXED, __ATOMIC_RELAXED, __HIP_MEMORY_SCOPE_AGENT); __hip_atomic_store(tmo, 1u, __ATOMIC_RELAXED, __HIP_MEMORY_SCOPE_AGENT); }
                    break; }
                __builtin_amdgcn_s_sleep(2); }
            __builtin_amdgcn_fence(__ATOMIC_ACQUIRE, "agent");
            asm volatile("s_waitcnt vmcnt(0)" ::: "memory");
        }
#if !defined(BROKEN_HOOK_NO_BARRIER)
        asm volatile("" ::: "memory"); __builtin_amdgcn_s_barrier(); asm volatile("" ::: "memory");
#endif
    }
};

typedef float cvt_f32x2 __attribute__((ext_vector_type(2))); typedef __bf16 cvt_bf16x2 __attribute__((ext_vector_type(2)));
__device__ __forceinline__ unsigned cvt_pk_bf16(float lo, float hi) { const cvt_f32x2 v = {lo, hi}; const cvt_bf16x2 b = __builtin_convertvector(v, cvt_bf16x2); return __builtin_bit_cast(unsigned, b); }
typedef float f32x2 __attribute__((ext_vector_type(2)));
__device__ __forceinline__ f32x2 gelu_pk(f32x2 v) {
    const f32x2 av = __builtin_elementwise_abs(v), d = av * 0.2316418882f + 1.0f;
    f32x2 t; t.x = __builtin_amdgcn_rcpf(d.x); t.y = __builtin_amdgcn_rcpf(d.y);
    f32x2 q = t * 0.5307027145f + (-0.7265760135f); q = q * t + 0.7107068705f; q = q * t + (-0.142248368f); q = q * t + 0.127414796f; q = q * t;
    const f32x2 s = (v * v) * (-0.72134752044f);
    f32x2 e; e.x = __builtin_amdgcn_exp2f(s.x); e.y = __builtin_amdgcn_exp2f(s.y);
    const f32x2 m = v * (q * e), r = v - m;
    f32x2 o; o.x = v.x < 0.f ? m.x : r.x; o.y = v.y < 0.f ? m.y : r.y; return o;
}

struct EpiF32 {
    static constexpr bool PERM = false, AFTER_DRAIN = false; static constexpr int MID_T = -1;
    float* C; int ldc; const float* bias;
    __device__ __forceinline__ void operator()(const f32x4 (&acc)[2][2][4][2], const Unit& u, int wr, int wc, int fr, int fq) const {
        const int row0 = u.pm * BM + wr * 64 + fr, col0 = u.pn * BM + wc * 32 + 4 * fq;
        f32x4 bv[2][2];
#pragma unroll
        for (int bj = 0; bj < 2; ++bj)
#pragma unroll
            for (int n = 0; n < 2; ++n) bv[bj][n] = bias ? *(const f32x4*)(bias + col0 + bj * HALF + n * 16) : (f32x4){0.f, 0.f, 0.f, 0.f};
#pragma unroll
        for (int ai = 0; ai < 2; ++ai)
#pragma unroll
            for (int m = 0; m < 4; ++m) { float* rowp = C + (size_t)(row0 + ai * HALF + m * 16) * ldc + col0;
#pragma unroll
                for (int bj = 0; bj < 2; ++bj)
#pragma unroll
                    for (int n = 0; n < 2; ++n) *(f32x4*)(rowp + bj * HALF + n * 16) = acc[ai][bj][m][n] + bv[bj][n]; }
    }
};
template <int ACT  > struct EpiBf16 {
    static constexpr bool PERM = true, AFTER_DRAIN = false; static constexpr int MID_T = -1;
    bf16_t* O; int ldc; const float* bias; int split_cols; size_t split_stride;
    __device__ __forceinline__ void operator()(const f32x4 (&acc)[2][2][4][2], const Unit& u, int wr, int wc, int fr, int fq) const {
        const int row0 = u.pm * BM + wr * 64 + fr; int colt = u.pn * BM; bf16_t* base = O;
        if (split_cols) { const int t = colt / split_cols; base += (size_t)t * split_stride; colt -= t * split_cols; }
        const int col0 = colt + wc * 32 + 8 * fq, bcol0 = u.pn * BM + wc * 32 + 8 * fq;
        f32x4 bv[2][2];
#pragma unroll
        for (int bj = 0; bj < 2; ++bj)
#pragma unroll
            for (int n = 0; n < 2; ++n) bv[bj][n] = bias ? *(const f32x4*)(bias + bcol0 + bj * HALF + 4 * n) : (f32x4){0.f, 0.f, 0.f, 0.f};
#pragma unroll
        for (int ai = 0; ai < 2; ++ai)
#pragma unroll
            for (int m = 0; m < 4; ++m) { bf16_t* rowp = base + (size_t)(row0 + ai * HALF + m * 16) * ldc + col0;
#pragma unroll
                for (int bj = 0; bj < 2; ++bj) { f32x4 v0 = acc[ai][bj][m][0] + bv[bj][0], v1 = acc[ai][bj][m][1] + bv[bj][1];
                    if (ACT == 1) { f32x2 a = gelu_pk((f32x2){v0[0], v0[1]}), b = gelu_pk((f32x2){v0[2], v0[3]}), c = gelu_pk((f32x2){v1[0], v1[1]}), d = gelu_pk((f32x2){v1[2], v1[3]});
                        v0 = (f32x4){a.x, a.y, b.x, b.y}; v1 = (f32x4){c.x, c.y, d.x, d.y}; }
                    if (ACT == 2) {
#pragma unroll
                        for (int j = 0; j < 4; ++j) { v0[j] = 0.5f * v0[j] * (1.0f + erff(v0[j] * 0.70710678f)); v1[j] = 0.5f * v1[j] * (1.0f + erff(v1[j] * 0.70710678f)); } }
                    u32x4 w; w.x = cvt_pk_bf16(v0[0], v0[1]); w.y = cvt_pk_bf16(v0[2], v0[3]); w.z = cvt_pk_bf16(v1[0], v1[1]); w.w = cvt_pk_bf16(v1[2], v1[3]);
                    *(u32x4*)(rowp + bj * HALF) = w; } }
    }
};
template <class Epi, class Sched, bool STAMP = false>
__device__ __forceinline__ void gemm_phase(PG8_LAS unsigned char* lds, const Gemm g, const Sched& S, const Epi& E, unsigned long long* stamps) {
    const int tid = threadIdx.x, wid = __builtin_amdgcn_readfirstlane(tid >> 6), lane = tid & 63, wr = wid >> 2, wc = wid & 3, fr = lane & 15, fq = lane >> 4;
    const int K = g.K, nt = K / BK;
    int ts_lo = 0, ts_hi = 0, nts = 0; const unsigned long long rt_entry = STAMP ? (unsigned long long)wall_clock64() : 0ull;
#define PG8_STAMP() do { if (STAMP && wid == 0 && nts < 64) { const unsigned long long _c = (unsigned long long)clock64(); \
        ts_lo = (lane == nts) ? (int)(unsigned)_c : ts_lo; ts_hi = (lane == nts) ? (int)(unsigned)(_c >> 32) : ts_hi; ++nts; } } while (0)
    PG8_STAMP();
    unsigned voffA[2], voffB[2];
#pragma unroll
    for (int i = 0; i < 2; ++i) { int R, C; stage_rc(tid * 16 + i * 8192, R, C); const int Rb = Epi::PERM ? ((R & ~31) + perm32(R & 31)) : R;
        voffA[i] = (unsigned)(R * K + C) * 2u; voffB[i] = (unsigned)(Rb * K + C) * 2u; }
    const size_t kstep = (size_t)(BK * 2);
    const size_t hstep = (size_t)HALF * K * 2;
    const size_t tstep = 2 * hstep;
    const unsigned ldsw = (unsigned)wid * 1024u;
    const int aoff = lds_byte(wr * 64 + fr, fq * 8), boff = lds_byte(wc * 32 + fr, fq * 8);
#define PG8_SA(b, h) (((b) * 2 + (h)) * HTB)
#define PG8_SB(b, h) ((4 + (b) * 2 + (h)) * HTB)
#define PG8_STAGE(bufoff, gbase, voff) do { _Pragma("unroll") for (int _i = 0; _i < 2; ++_i) \
        __builtin_amdgcn_global_load_lds((const unsigned*)((const char*)(gbase) + (voff)[_i]), (PG8_LAS unsigned*)(lds + (bufoff) + ldsw + _i * 8192), 16, 0, 0); } while (0)
#define PG8_LDA(dst, b, h) do { _Pragma("unroll") for (int m = 0; m < 4; ++m) _Pragma("unroll") for (int k = 0; k < 2; ++k) dst[m][k] = *(const PG8_LAS bf16x8*)(lds + PG8_SA(b, h) + aoff + m * 2048 + k * 1024); } while (0)
#define PG8_LDB(dst, b, h) do { _Pragma("unroll") for (int n = 0; n < 2; ++n) _Pragma("unroll") for (int k = 0; k < 2; ++k) dst[n][k] = *(const PG8_LAS bf16x8*)(lds + PG8_SB(b, h) + boff + n * 2048 + k * 1024); } while (0)
#define PG8_MMA(ai, bj, At, Bt) do { __builtin_amdgcn_s_setprio(1); _Pragma("unroll") for (int m = 0; m < 4; ++m) _Pragma("unroll") for (int n = 0; n < 2; ++n) _Pragma("unroll") for (int k = 0; k < 2; ++k) \
        acc[ai][bj][m][n] = __builtin_amdgcn_mfma_f32_16x16x32_bf16(Bt[n][k], At[m][k], acc[ai][bj][m][n], 0, 0, 0); __builtin_amdgcn_s_setprio(0); } while (0)
#define PG8_WAIT_V(n) asm volatile("s_waitcnt vmcnt(" #n ")" ::: "memory")
#define PG8_WAIT_L(n) asm volatile("s_waitcnt lgkmcnt(" #n ")" ::: "memory")
#define PG8_BAR __builtin_amdgcn_s_barrier()
#define PG8_SCHED __builtin_amdgcn_sched_barrier(0)
    Unit cur, nxt; int ui = 0;
    if (!S.next(0, cur)) return;
    f32x4 acc[2][2][4][2];
#pragma unroll
    for (int a = 0; a < 2; ++a)
#pragma unroll
        for (int b = 0; b < 2; ++b)
#pragma unroll
            for (int m = 0; m < 4; ++m)
#pragma unroll
                for (int n = 0; n < 2; ++n) acc[a][b][m][n] = (f32x4){0.f, 0.f, 0.f, 0.f};
    bf16x8 At[4][2], B0[2][2], B1[2][2];
    const char* cA = (const char*)g.A + (size_t)cur.pm * tstep; const char* cB = (const char*)g.Bt + (size_t)cur.pn * tstep;
    S.a_ready(cur);
    PG8_STAGE(PG8_SB(0, 0), cB, voffB); PG8_STAGE(PG8_SA(0, 0), cA, voffA); PG8_STAGE(PG8_SB(0, 1), cB + hstep, voffB); PG8_STAGE(PG8_SA(0, 1), cA + hstep, voffA);
    if (wr == 1) PG8_BAR;
    PG8_WAIT_V(4); PG8_BAR;
    PG8_STAGE(PG8_SB(1, 0), cB + kstep, voffB); PG8_STAGE(PG8_SA(1, 0), cA + kstep, voffA); PG8_STAGE(PG8_SB(1, 1), cB + hstep + kstep, voffB);
    PG8_WAIT_V(6); PG8_BAR;
    PG8_STAMP();
    for (;;) {
        const bool has_next = S.next(ui + 1, nxt);
        const char* nA = has_next ? (const char*)g.A + (size_t)nxt.pm * tstep : cA; const char* nB = has_next ? (const char*)g.Bt + (size_t)nxt.pn * tstep : cB;
        for (int t = 0; t < nt; t += 2) {
            const bool last = (t == nt - 2);
            const char* a1 = cA + (size_t)(t + 1) * kstep;
            const char* a2 = last ? nA : cA + (size_t)(t + 2) * kstep; const char* b2 = last ? nB : cB + (size_t)(t + 2) * kstep;
            const char* a3 = a2 + kstep; const char* b3 = b2 + kstep;
            if (last && has_next) S.a_ready(nxt);
            if constexpr (Epi::MID_T >= 0) { if (t == Epi::MID_T) E.mid(acc, cur, wr, wc, fr, fq); }
            PG8_LDB(B0, 0, 0); PG8_SCHED; PG8_LDA(At, 0, 0); PG8_STAGE(PG8_SA(1, 1), a1 + hstep, voffA);
            PG8_WAIT_L(8); PG8_BAR; PG8_WAIT_L(0); PG8_MMA(0, 0, At, B0); PG8_BAR; PG8_SCHED;
            PG8_LDB(B1, 0, 1); PG8_STAGE(PG8_SB(0, 0), b2, voffB);
            PG8_BAR; PG8_WAIT_L(0); PG8_MMA(0, 1, At, B1); PG8_BAR;
            PG8_LDA(At, 0, 1); PG8_STAGE(PG8_SA(0, 0), a2, voffA);
            PG8_BAR; PG8_WAIT_L(0); PG8_MMA(1, 0, At, B0); PG8_BAR; PG8_SCHED;
            PG8_STAGE(PG8_SB(0, 1), b2 + hstep, voffB);
            PG8_WAIT_V(6); PG8_BAR; PG8_MMA(1, 1, At, B1); PG8_BAR;
            PG8_LDB(B0, 1, 0); PG8_SCHED; PG8_LDA(At, 1, 0); PG8_STAGE(PG8_SA(0, 1), a2 + hstep, voffA);
            PG8_WAIT_L(8); PG8_BAR; PG8_WAIT_L(0); PG8_MMA(0, 0, At, B0); PG8_BAR; PG8_SCHED;
            PG8_LDB(B1, 1, 1); PG8_STAGE(PG8_SB(1, 0), b3, voffB);
            PG8_BAR; PG8_WAIT_L(0); PG8_MMA(0, 1, At, B1); PG8_BAR;
            PG8_LDA(At, 1, 1); PG8_STAGE(PG8_SA(1, 0), a3, voffA);
            PG8_BAR; PG8_WAIT_L(0); PG8_MMA(1, 0, At, B0); PG8_BAR; PG8_SCHED;
            PG8_STAGE(PG8_SB(1, 1), b3 + hstep, voffB);
            PG8_WAIT_V(6); PG8_BAR; PG8_MMA(1, 1, At, B1); PG8_BAR;
        }
        PG8_STAMP();
        if constexpr (!Epi::AFTER_DRAIN) { E(acc, cur, wr, wc, fr, fq); S.done(cur); }
        PG8_STAMP();
        if (!has_next) break;
#pragma unroll
        for (int a = 0; a < 2; ++a)
#pragma unroll
            for (int b = 0; b < 2; ++b)
#pragma unroll
                for (int m = 0; m < 4; ++m)
#pragma unroll
                    for (int n = 0; n < 2; ++n) acc[a][b][m][n] = (f32x4){0.f, 0.f, 0.f, 0.f};
        cur = nxt; cA = nA; cB = nB; ++ui;
    }
    PG8_WAIT_V(0);
    if (wr == 0) PG8_BAR;
    PG8_BAR;
    if constexpr (Epi::AFTER_DRAIN) { E.fused(acc, cur, wr, wc, fr, fq, lds, wid, lane); S.done(cur); }
    PG8_STAMP();
    if (STAMP && wid == 0) { stamps[lane] = lane < nts ? (((unsigned long long)(unsigned)ts_hi << 32) | (unsigned)ts_lo) : 0ull;
        if (lane == 62) stamps[62] = rt_entry; if (lane == 63) stamps[63] = (unsigned long long)wall_clock64(); }
#undef PG8_STAMP
#undef PG8_SA
#undef PG8_SB
#undef PG8_STAGE
#undef PG8_LDA
#undef PG8_LDB
#undef PG8_MMA
#undef PG8_WAIT_V
#undef PG8_WAIT_L
#undef PG8_BAR
#undef PG8_SCHED
}
}
#define LAS __attribute__((address_space(3)))
typedef unsigned short bf16_t;
typedef short bf16x8 __attribute__((ext_vector_type(8)));
typedef float f32x4 __attribute__((ext_vector_type(4)));
typedef float f32x2 __attribute__((ext_vector_type(2)));
typedef unsigned u32x4 __attribute__((ext_vector_type(4)));
typedef unsigned u32x2 __attribute__((ext_vector_type(2)));
typedef LAS unsigned char* ldsp;
typedef float f32x32 __attribute__((ext_vector_type(32)));
typedef float f32x16 __attribute__((ext_vector_type(16)));
typedef unsigned u32x6 __attribute__((ext_vector_type(6)));

constexpr int D = 2048, NTOK = 8192, SEQ = 4096, MROWS = 8448, ROW_META = 8192;
constexpr int INC = 11712, NPAD = 11776;
constexpr int C_R = 0, C_K = 2048, C_V = 4096, C_WL = 6144, C_AL = 6240, C_GL = 6336, C_POOL = 6592, C_G0 = 7616, C_G1 = 9664;
constexpr int NUNITS = 4128;
constexpr float DSCALE = 0.6065306597126334f;
constexpr float DN_ALPHA = 1.189207115002721f;
constexpr float GN_EPS = 64e-5f, LN_EPS = 1e-5f;

constexpr size_t WS_P = 0;
constexpr size_t WS_H0B = 198967296;
constexpr size_t WS_WTAB = WS_H0B + 34603008;
constexpr size_t WS_WTOUT = WS_WTAB + 12582912;
constexpr size_t WS_WTQ = WS_WTOUT + 8388608;
constexpr size_t WS_WTPOOL = WS_WTQ + 8388608;
constexpr size_t WS_WTW2 = WS_WTPOOL + 524288;
constexpr size_t WS_WTA2 = WS_WTW2 + 393216;
constexpr size_t WS_WTG2 = WS_WTA2 + 393216;
constexpr size_t WS_SUBK = WS_WTG2 + 1048576;
constexpr size_t WS_BONUS = WS_SUBK + 65536;
constexpr size_t WS_REGC = WS_BONUS + 1048576;
constexpr size_t WS_WTIN = WS_REGC;
constexpr size_t UNITB = (size_t)NUNITS * 4096 * 2;
constexpr size_t WS_G = WS_REGC;
constexpr size_t WS_H0T = WS_REGC + UNITB;
constexpr size_t WS_RT = WS_REGC + 2 * UNITB;
constexpr size_t WS_Y0 = WS_REGC + 3 * UNITB;
constexpr size_t WS_S0T = WS_REGC + 4 * UNITB;
constexpr size_t WS_YAB = WS_REGC;
constexpr int LDAB = 3072;
constexpr size_t WS_MERGED = WS_REGC + 2 * UNITB;
constexpr size_t WS_X1B = WS_REGC + 3 * UNITB;
constexpr size_t WS_Q = WS_REGC + UNITB;
constexpr size_t TROW = 1536;
constexpr size_t WS_VB = WS_REGC + 5 * UNITB;
constexpr size_t WS_GSIG = WS_VB + 16384 * TROW;
constexpr size_t WS_BAR = WS_GSIG + 4194304;
constexpr size_t WS_STAT = WS_BAR + 16384;
constexpr size_t STAT_BYTES = (8192 * 2 + 2048 * 2) * 4;
constexpr size_t WS_TSC = WS_STAT + STAT_BYTES;
constexpr size_t UROW = 1024;
constexpr size_t WS_UB = WS_TSC + 131072;
constexpr size_t WS_END = WS_UB + 16384 * UROW;
static_assert(WS_YAB + 50331648 <= WS_MERGED, "overlay");

constexpr int LDS_BYTES = 163840;
constexpr int NPHASE = 8;

struct Params {
    const float* in[30];
    float* out;
    unsigned char* ws;
    int ph_lo, ph_hi;
};
enum { I_X = 0, I_META, I_LNIN_G, I_LNIN_B, I_WIN, I_MU, I_W0, I_WW2, I_A0, I_WA2, I_WG2, I_KK, I_KA, I_RK, I_GNG, I_GNB, I_WPOOL, I_PSCALE, I_BGATE,
       I_WBA, I_WBB, I_WOUT, I_LN1G, I_LN1B, I_WQ, I_SUBK, I_UT, I_VT, I_LN2G, I_LN2B };

__device__ __forceinline__ unsigned pk2(float lo, float hi) { return pg8::cvt_pk_bf16(lo, hi); }
__device__ __forceinline__ float bflo(unsigned w) { return __uint_as_float(w << 16); }
__device__ __forceinline__ float bfhi(unsigned w) { return __uint_as_float(w & 0xffff0000u); }
__device__ __forceinline__ float bf1(bf16_t h) { return __uint_as_float(((unsigned)h) << 16); }
__device__ __forceinline__ bf16_t f2bf1(float f) { return (bf16_t)(pk2(f, f) & 0xffffu); }
__device__ __forceinline__ float wave_sum(float v) {
#pragma unroll
    for (int o = 1; o < 64; o <<= 1) v += __shfl_xor(v, o);
    return v;
}
__device__ __forceinline__ float sigmoidf_(float x) { return 1.0f / (1.0f + __expf(-x)); }
__device__ __forceinline__ f32x4 mfma16(bf16x8 a, bf16x8 b, f32x4 c) { return __builtin_amdgcn_mfma_f32_16x16x32_bf16(a, b, c, 0, 0, 0); }
__device__ __forceinline__ void unpack8(const u32x4 w, float* f) {
    f[0] = bflo(w.x); f[1] = bfhi(w.x); f[2] = bflo(w.y); f[3] = bfhi(w.y); f[4] = bflo(w.z); f[5] = bfhi(w.z); f[6] = bflo(w.w); f[7] = bfhi(w.w);
}
__device__ __forceinline__ u32x4 pack8(const float* f) { u32x4 w; w.x = pk2(f[0], f[1]); w.y = pk2(f[2], f[3]); w.z = pk2(f[4], f[5]); w.w = pk2(f[6], f[7]); return w; }
#define DPPF(v, ctrl) __builtin_bit_cast(float, __builtin_amdgcn_update_dpp(0, __builtin_bit_cast(int, (v)), (ctrl), 0xF, 0xF, true))
__device__ __forceinline__ float readlane_f(float v, int l) { return __builtin_bit_cast(float, __builtin_amdgcn_readlane(__builtin_bit_cast(int, v), l)); }
__device__ __forceinline__ float wave_sum_dpp(float v) {
    v += DPPF(v, 0xB1); v += DPPF(v, 0x4E); v += DPPF(v, 0x141); v += DPPF(v, 0x140);
    return (readlane_f(v, 0) + readlane_f(v, 16)) + (readlane_f(v, 32) + readlane_f(v, 48));
}
__device__ __forceinline__ float wave_max_dpp(float v) {
    v = fmaxf(v, DPPF(v, 0xB1)); v = fmaxf(v, DPPF(v, 0x4E)); v = fmaxf(v, DPPF(v, 0x141)); v = fmaxf(v, DPPF(v, 0x140));
    return fmaxf(fmaxf(readlane_f(v, 0), readlane_f(v, 16)), fmaxf(readlane_f(v, 32), readlane_f(v, 48)));
}
#define BLOCK_SYNC() __syncthreads()
#define XB_TMO      128
#define XB_XCNT(j)  (256  + 64 * (j))
#define XB_XSUB(j)  (1280 + 64 * (j))
#define XB_XGEN(j)  (2304 + 64 * (j))
#define XB_TOP      3328
#define XB_TOPGEN   3392
#define XCD_BAR_WORDS 3456
#define XB_SPIN_CAP (1u << 18)

__device__ __forceinline__ unsigned xb_ld(unsigned* p)              { return __hip_atomic_load(p, __ATOMIC_RELAXED, __HIP_MEMORY_SCOPE_AGENT); }
__device__ __forceinline__ unsigned xb_add(unsigned* p, unsigned v) { return __hip_atomic_fetch_add(p, v, __ATOMIC_RELAXED, __HIP_MEMORY_SCOPE_AGENT); }
__device__ __forceinline__ unsigned xb_xcc_id() { return (unsigned)__builtin_amdgcn_s_getreg((3 << 11) | 20) & 0xFu; }
#define XB_SPIN(cond, bar) do { unsigned _sp = 0; while (cond) { __builtin_amdgcn_s_sleep(1); \
    if ((++_sp & 255u) == 0u) { if (xb_ld(&(bar)[XB_TMO])) break; if (_sp > XB_SPIN_CAP) { atomicAdd(&(bar)[XB_TMO], 1u); break; } } } } while (0)

struct XcdBarrier {
    unsigned* bar; unsigned x;
    volatile LAS unsigned* st;
};

__device__ __forceinline__ XcdBarrier xcd_barrier_post(unsigned* bar, volatile LAS unsigned* st) {
    XcdBarrier b; b.bar = bar; b.x = xb_xcc_id(); b.st = st;
    if (threadIdx.x == 0) (void)xb_add(&bar[XB_XCNT(b.x)], 1u);
    return b;
}
__device__ __forceinline__ void xcd_barrier_complete(unsigned* bar, unsigned x, unsigned& nloc, unsigned& nx) {
    const unsigned G = gridDim.x * gridDim.y * gridDim.z;
    unsigned sum, cnt, mine, sp = 0u;
    for (;;) {
        sum = 0u; cnt = 0u; mine = 0u;
#pragma unroll
        for (unsigned j = 0; j < 16; ++j) { const unsigned c = xb_ld(&bar[XB_XCNT(j)]); sum += c; cnt += (c > 0u) ? 1u : 0u; mine = (j == x) ? c : mine; }
        if (sum == G) break;
        __builtin_amdgcn_s_sleep(1);
        if ((++sp & 255u) == 0u) { if (xb_ld(&bar[XB_TMO])) break; if (sp > XB_SPIN_CAP) { atomicAdd(&bar[XB_TMO], 1u); break; } }
    }
    nloc = mine > 0u ? mine : 1u; nx = cnt > 0u ? cnt : 1u;
}

__device__ __forceinline__ void xcd_barrier(const XcdBarrier& b) {
    asm volatile("s_waitcnt vmcnt(0)" ::: "memory");
    __syncthreads();
    if (threadIdx.x == 0) {
        unsigned* bar = b.bar;
        __builtin_amdgcn_s_waitcnt(0);
        unsigned nloc = b.st[0], nx = b.st[1];
        if (nloc == 0u) { xcd_barrier_complete(bar, b.x, nloc, nx); b.st[0] = nloc; b.st[1] = nx; }
        const unsigned old = xb_add(&bar[XB_XSUB(b.x)], 1u);
        const unsigned gen = old / nloc;
        if (old + 1u == (gen + 1u) * nloc) {
            __builtin_amdgcn_fence(__ATOMIC_RELEASE, "agent");
            asm volatile("s_waitcnt vmcnt(0)" ::: "memory");
            const unsigned og = xb_add(&bar[XB_TOP], 1u);
            const unsigned tg = og / nx;
            if (og + 1u == (tg + 1u) * nx) xb_add(&bar[XB_TOPGEN], 1u);
            else XB_SPIN(xb_ld(&bar[XB_TOPGEN]) == tg, bar);
            __builtin_amdgcn_fence(__ATOMIC_ACQUIRE, "agent");
            xb_add(&bar[XB_XGEN(b.x)], 1u);
            asm volatile("s_waitcnt vmcnt(0)" ::: "memory");
        } else {
            XB_SPIN(xb_ld(&bar[XB_XGEN(b.x)]) == gen, bar);
            __builtin_amdgcn_fence(__ATOMIC_ACQUIRE, "agent");
            asm volatile("s_waitcnt vmcnt(0)" ::: "memory");
        }
    }
    __syncthreads();
}

__device__ __forceinline__ void ln_row_bf16(const float* src, const float* g, const float* b, bf16_t* dst, int lane) {
    f32x4 v[8]; float s = 0.f;
#pragma unroll
    for (int j = 0; j < 8; ++j) { v[j] = ((const f32x4*)src)[lane + 64 * j]; s += (v[j].x + v[j].y) + (v[j].z + v[j].w); }
    const float mean = wave_sum(s) * (1.0f / D); float s2 = 0.f;
#pragma unroll
    for (int j = 0; j < 8; ++j) { v[j] = v[j] - mean; s2 += (v[j].x * v[j].x + v[j].y * v[j].y) + (v[j].z * v[j].z + v[j].w * v[j].w); }
    const float rstd = 1.0f / sqrtf(wave_sum(s2) * (1.0f / D) + LN_EPS);
#pragma unroll
    for (int j = 0; j < 8; ++j) {
        const f32x4 gg = ((const f32x4*)g)[lane + 64 * j], bb = ((const f32x4*)b)[lane + 64 * j];
        const f32x4 o = v[j] * rstd * gg + bb;
        u32x2 w; w.x = pk2(o.x, o.y); w.y = pk2(o.z, o.w);
        ((u32x2*)dst)[lane + 64 * j] = w;
    }
}
__device__ __forceinline__ void transpose_item(const float* W, int K, int N, int Npad, bf16_t* Wt, int item, int lane, int ldw = 0) {
    const int nblk = Npad >> 6, kb = item / nblk, nb = item - kb * nblk, n = nb * 64 + lane, k0 = kb * 32;
    float v[32];
    if (n < N) {
#pragma unroll
        for (int i = 0; i < 32; ++i) v[i] = W[(size_t)(k0 + i) * N + n];
    } else {
#pragma unroll
        for (int i = 0; i < 32; ++i) v[i] = 0.f;
    }
    u32x4* o = (u32x4*)(Wt + (size_t)n * (ldw ? ldw : K) + k0);
#pragma unroll
    for (int c = 0; c < 4; ++c) { u32x4 w; w.x = pk2(v[8 * c], v[8 * c + 1]); w.y = pk2(v[8 * c + 2], v[8 * c + 3]); w.z = pk2(v[8 * c + 4], v[8 * c + 5]); w.w = pk2(v[8 * c + 6], v[8 * c + 7]); o[c] = w; }
}
__device__ __forceinline__ void transpose_item_q(const float* W, const float* g, const float* b, bf16_t* Wt, float* c1, float* c2, int item, int lane) {
    const int kb = item >> 5, nb = item & 31, n = nb * 64 + lane, k0 = kb * 32;
    float v[32], s1 = 0.f, s2 = 0.f;
#pragma unroll
    for (int i = 0; i < 32; ++i) { const float w = W[(size_t)(k0 + i) * 2048 + n]; const float gw = g[k0 + i] * w; s1 += gw; s2 += b[k0 + i] * w; v[i] = gw; }
    u32x4* o = (u32x4*)(Wt + (size_t)n * 2048 + k0);
#pragma unroll
    for (int c = 0; c < 4; ++c) { u32x4 w; w.x = pk2(v[8 * c], v[8 * c + 1]); w.y = pk2(v[8 * c + 2], v[8 * c + 3]); w.z = pk2(v[8 * c + 4], v[8 * c + 5]); w.w = pk2(v[8 * c + 6], v[8 * c + 7]); o[c] = w; }
    atomicAdd(c1 + n, s1); atomicAdd(c2 + n, s2);
}
__device__ __forceinline__ void transpose_item64(const float* W, int K, int N, int Npad, bf16_t* Wt, int ldw, int item, int lane) {
    const int nblk = Npad >> 6, kb = item / nblk, nb = item - kb * nblk, n = nb * 64 + lane, k0 = kb * 64;
    float v[64];
    if (n < N) {
#pragma unroll
        for (int i = 0; i < 64; ++i) v[i] = W[(size_t)(k0 + i) * N + n];
    } else {
#pragma unroll
        for (int i = 0; i < 64; ++i) v[i] = 0.f;
    }
    u32x4* o = (u32x4*)(Wt + (size_t)n * ldw + k0);
#pragma unroll
    for (int c = 0; c < 8; ++c) { u32x4 w; w.x = pk2(v[8 * c], v[8 * c + 1]); w.y = pk2(v[8 * c + 2], v[8 * c + 3]); w.z = pk2(v[8 * c + 4], v[8 * c + 5]); w.w = pk2(v[8 * c + 6], v[8 * c + 7]); o[c] = w; }
}
__device__ __forceinline__ void phase0(const Params& P) {
    const int lane = threadIdx.x & 63, wave = threadIdx.x >> 6;
    const int gw = blockIdx.x * 8 + wave, NGW = gridDim.x * 8;
    unsigned char* ws = P.ws;
    constexpr int T_IN = 32 * 184, T_A = 32 * 32, T_B = 16 * 32, T_O = 32 * 32, T_Q = 64 * 32, T_POOL = 4 * 32, T_W2 = 3 * 32, T_A2 = 3 * 32, T_G2 = 8 * 32;
    constexpr int T_LN = MROWS, T_SK = 64;
    constexpr int NIT = T_IN + T_A + T_B + T_O + T_Q + T_POOL + T_W2 + T_A2 + T_G2 + T_LN + T_SK;
    for (int it = gw; it < NIT; it += NGW) {
        int r = it;
        if (r < T_IN) { transpose_item64(P.in[I_WIN], 2048, INC, NPAD, (bf16_t*)(ws + WS_WTIN), 2048, r, lane); continue; } r -= T_IN;
        if (r < T_A) { transpose_item64(P.in[I_WBA], 2048, 2048, 2048, (bf16_t*)(ws + WS_WTAB), LDAB, r, lane); continue; } r -= T_A;
        if (r < T_B) { transpose_item64(P.in[I_WBB], 1024, 2048, 2048, (bf16_t*)(ws + WS_WTAB) + 2048, LDAB, r, lane); continue; } r -= T_B;
        if (r < T_O) { transpose_item64(P.in[I_WOUT], 2048, 2048, 2048, (bf16_t*)(ws + WS_WTOUT), 2048, r, lane); continue; } r -= T_O;
        if (r < T_Q) { float* st = (float*)(ws + WS_STAT); transpose_item_q(P.in[I_WQ], P.in[I_LN1G], P.in[I_LN1B], (bf16_t*)(ws + WS_WTQ), st + 16384, st + 18432, r, lane); continue; } r -= T_Q;
        if (r < T_POOL) { const int g = r >> 5; transpose_item(P.in[I_WPOOL] + g * 65536, 256, 256, 256, (bf16_t*)(ws + WS_WTPOOL) + g * 65536, r & 31, lane); continue; } r -= T_POOL;
        if (r < T_W2) { transpose_item(P.in[I_WW2], 96, 2048, 2048, (bf16_t*)(ws + WS_WTW2), r, lane); continue; } r -= T_W2;
        if (r < T_A2) { transpose_item(P.in[I_WA2], 96, 2048, 2048, (bf16_t*)(ws + WS_WTA2), r, lane); continue; } r -= T_A2;
        if (r < T_G2) { transpose_item(P.in[I_WG2], 256, 2048, 2048, (bf16_t*)(ws + WS_WTG2), r, lane); continue; } r -= T_G2;
        if (r < T_LN) {
            bf16_t* dst = (bf16_t*)(ws + WS_H0B) + (size_t)r * D;
            if (r < NTOK) ln_row_bf16(P.in[I_X] + (size_t)r * D, P.in[I_LNIN_G], P.in[I_LNIN_B], dst, lane);
            else if (r < NTOK + 16) ln_row_bf16(P.in[I_META] + (size_t)(r - NTOK) * D, P.in[I_LNIN_G], P.in[I_LNIN_B], dst, lane);
            else {
#pragma unroll
                for (int j = 0; j < 8; ++j) ((u32x2*)dst)[lane + 64 * j] = (u32x2){0u, 0u};
            }
            continue;
        }
        r -= T_LN;
        {
            const float* s = P.in[I_SUBK] + r * 512 + lane * 8; float f[8];
#pragma unroll
            for (int i = 0; i < 8; ++i) f[i] = s[i];
            *(u32x4*)((bf16_t*)(ws + WS_SUBK) + r * 512 + lane * 8) = pack8(f);
        }
    }
}
namespace pg8 {
constexpr float LN_EPS_ = 1e-5f;
struct EpiGate35 {
    static constexpr bool PERM = false, AFTER_DRAIN = false; static constexpr int MID_T = 32;
    bf16_t* O; const bf16_t* p; const float* bgate;
    __device__ __forceinline__ void mid(f32x4 (&acc)[2][2][4][2], const Unit& u, int wr, int wc, int fr, int fq) const {
        asm volatile("" : "+v"(fr), "+v"(fq));
        const int row0 = u.pm * BM + wr * 64 + fr, col0 = u.pn * BM + wc * 32 + 4 * fq;
#pragma unroll
        for (int ai = 0; ai < 2; ++ai)
#pragma unroll
            for (int m = 0; m < 4; ++m) { const size_t row = (size_t)(row0 + ai * HALF + m * 16);
#pragma unroll
                for (int bj = 0; bj < 2; ++bj)
#pragma unroll
                    for (int n = 0; n < 2; ++n) { const int col = col0 + bj * HALF + n * 16;
                        const u32x2 p0 = *(const u32x2*)(p + row * NPAD + C_G0 + col), p1 = *(const u32x2*)(p + row * NPAD + C_G1 + col);
                        const f32x4 b0 = *(const f32x4*)(bgate + col), b1 = *(const f32x4*)(bgate + D + col);
                        f32x4 r;
                        r.x = (1.0f + __expf(-fmaxf(bflo(p1.x) + b1.x, -80.f))) * __builtin_amdgcn_rcpf(1.0f + __expf(-(bflo(p0.x) + b0.x)));
                        r.y = (1.0f + __expf(-fmaxf(bfhi(p1.x) + b1.y, -80.f))) * __builtin_amdgcn_rcpf(1.0f + __expf(-(bfhi(p0.x) + b0.y)));
                        r.z = (1.0f + __expf(-fmaxf(bflo(p1.y) + b1.z, -80.f))) * __builtin_amdgcn_rcpf(1.0f + __expf(-(bflo(p0.y) + b0.z)));
                        r.w = (1.0f + __expf(-fmaxf(bfhi(p1.y) + b1.w, -80.f))) * __builtin_amdgcn_rcpf(1.0f + __expf(-(bfhi(p0.y) + b0.w)));
                        acc[ai][bj][m][n] = acc[ai][bj][m][n] * r; }
                asm volatile("" ::: "memory"); }
    }
    __device__ __forceinline__ void operator()(const f32x4 (&acc)[2][2][4][2], const Unit& u, int wr, int wc, int fr, int fq) const {
        const int row0 = u.pm * BM + wr * 64 + fr, col0 = u.pn * BM + wc * 32 + 4 * fq;
#pragma unroll
        for (int ai = 0; ai < 2; ++ai)
#pragma unroll
            for (int m = 0; m < 4; ++m) { const size_t row = (size_t)(row0 + ai * HALF + m * 16);
#pragma unroll
                for (int bj = 0; bj < 2; ++bj)
#pragma unroll
                    for (int n = 0; n < 2; ++n) { const int col = col0 + bj * HALF + n * 16;
                        const u32x2 p1 = *(const u32x2*)(p + row * NPAD + C_G1 + col); const f32x4 b1 = *(const f32x4*)(bgate + D + col);
                        f32x4 g;
                        g.x = __builtin_amdgcn_rcpf(1.0f + __expf(-fmaxf(bflo(p1.x) + b1.x, -80.f))); g.y = __builtin_amdgcn_rcpf(1.0f + __expf(-fmaxf(bfhi(p1.x) + b1.y, -80.f)));
                        g.z = __builtin_amdgcn_rcpf(1.0f + __expf(-fmaxf(bflo(p1.y) + b1.z, -80.f))); g.w = __builtin_amdgcn_rcpf(1.0f + __expf(-fmaxf(bfhi(p1.y) + b1.w, -80.f)));
                        const f32x4 o = acc[ai][bj][m][n] * g;
                        u32x2 w; w.x = cvt_pk_bf16(o.x, o.y); w.y = cvt_pk_bf16(o.z, o.w);
                        *(u32x2*)(O + row * D + col) = w; } }
    }
};
struct EpiResidStats {
    static constexpr bool PERM = false, AFTER_DRAIN = false; static constexpr int MID_T = -1;
    bf16_t* O; const bf16_t* h0; float alpha; float* rsum; float* rsq;
    __device__ __forceinline__ void operator()(const f32x4 (&acc)[2][2][4][2], const Unit& u, int wr, int wc, int fr, int fq) const {
        const int row0 = u.pm * BM + wr * 64 + fr, col0 = u.pn * BM + wc * 32 + 4 * fq;
#pragma unroll
        for (int ai = 0; ai < 2; ++ai)
#pragma unroll
            for (int m = 0; m < 4; ++m) { const size_t row = (size_t)(row0 + ai * HALF + m * 16); float s = 0.f, q = 0.f;
#pragma unroll
                for (int bj = 0; bj < 2; ++bj)
#pragma unroll
                    for (int n = 0; n < 2; ++n) { const int col = col0 + bj * HALF + n * 16;
                        const u32x2 hw = *(const u32x2*)(h0 + row * D + col);
                        f32x4 hv; hv.x = bflo(hw.x); hv.y = bfhi(hw.x); hv.z = bflo(hw.y); hv.w = bfhi(hw.y);
                        const f32x4 x = hv * alpha + acc[ai][bj][m][n];
                        s += (x.x + x.y) + (x.z + x.w); q += (x.x * x.x + x.y * x.y) + (x.z * x.z + x.w * x.w);
                        u32x2 w; w.x = cvt_pk_bf16(x.x, x.y); w.y = cvt_pk_bf16(x.z, x.w);
                        *(u32x2*)(O + row * D + col) = w; }
                s += __shfl_xor(s, 16); s += __shfl_xor(s, 32); q += __shfl_xor(q, 16); q += __shfl_xor(q, 32);
                if (fq == 0) { atomicAdd(rsum + row, s); atomicAdd(rsq + row, q); } }
    }
};
struct EpiQ {
    static constexpr bool PERM = true, AFTER_DRAIN = false; static constexpr int MID_T = -1;
    bf16_t* O; const float* rsum; const float* rsq; const float* c1; const float* c2;
    __device__ __forceinline__ void operator()(const f32x4 (&acc)[2][2][4][2], const Unit& u, int wr, int wc, int fr, int fq) const {
        const int row0 = u.pm * BM + wr * 64 + fr, col0 = u.pn * BM + wc * 32 + 8 * fq;
        f32x4 k1[2][2], k2[2][2];
#pragma unroll
        for (int bj = 0; bj < 2; ++bj)
#pragma unroll
            for (int n = 0; n < 2; ++n) { k1[bj][n] = *(const f32x4*)(c1 + col0 + bj * HALF + 4 * n); k2[bj][n] = *(const f32x4*)(c2 + col0 + bj * HALF + 4 * n); }
#pragma unroll
        for (int ai = 0; ai < 2; ++ai)
#pragma unroll
            for (int m = 0; m < 4; ++m) { const int row = row0 + ai * HALF + m * 16;
                const float mean = rsum[row] * (1.0f / D), rstd = 1.0f / sqrtf(fmaxf(rsq[row] * (1.0f / D) - mean * mean, 0.f) + LN_EPS_);
                bf16_t* rowp = O + (size_t)row * D + col0;
#pragma unroll
                for (int bj = 0; bj < 2; ++bj) {
                    const f32x4 v0 = (acc[ai][bj][m][0] - k1[bj][0] * mean) * rstd + k2[bj][0], v1 = (acc[ai][bj][m][1] - k1[bj][1] * mean) * rstd + k2[bj][1];
                    u32x4 w; w.x = cvt_pk_bf16(v0[0], v0[1]); w.y = cvt_pk_bf16(v0[2], v0[3]); w.z = cvt_pk_bf16(v1[0], v1[1]); w.w = cvt_pk_bf16(v1[2], v1[3]);
                    *(u32x4*)(rowp + bj * HALF) = w; } }
    }
};
}
template <class Epi>
__device__ __forceinline__ void run_gemm(ldsp lds, const bf16_t* A, const bf16_t* Bt, int M, int N, int K, const Epi& E) {
    pg8::Gemm g; g.A = A; g.Bt = Bt; g.M = M; g.N = N; g.K = K;
    pg8::StaticOrder S; S.init(M, N, (int)gridDim.x, (int)blockIdx.x);
    pg8::gemm_phase<Epi, pg8::StaticOrder, false>(lds, g, S, E, nullptr);
}
constexpr int CONV_P2_ROWS = 0;
__device__ __forceinline__ void convert_tables(const Params& P, int r0, int rend, int stride) {
    const int lane = threadIdx.x & 63;
    unsigned char* ws = P.ws;
    for (int r = r0; r < rend; r += stride) {
        const float* src = (r < 16384 ? P.in[I_UT] : P.in[I_VT]) + (size_t)(r & 16383) * D;
        f32x4 v[8]; float am = 0.f;
#pragma unroll
        for (int j = 0; j < 8; ++j) { v[j] = ((const f32x4*)src)[lane + 64 * j]; am = fmaxf(am, fmaxf(fmaxf(fabsf(v[j].x), fabsf(v[j].y)), fmaxf(fabsf(v[j].z), fabsf(v[j].w)))); }
        am = wave_max_dpp(am);
        const float qmax = r < 16384 ? 6.0f : 7.5f;
        const float s = am > 0.f ? qmax / am : 1.0f;
        if (r < 16384) {
            unsigned w[4];
#pragma unroll
            for (int j = 0; j < 4; ++j) { unsigned t = 0;
                t = __builtin_amdgcn_cvt_scalef32_pk_fp4_f32(t, v[2 * j].x * s, v[2 * j].y * s, 1.0f, 0); t = __builtin_amdgcn_cvt_scalef32_pk_fp4_f32(t, v[2 * j].z * s, v[2 * j].w * s, 1.0f, 1);
                t = __builtin_amdgcn_cvt_scalef32_pk_fp4_f32(t, v[2 * j + 1].x * s, v[2 * j + 1].y * s, 1.0f, 2); t = __builtin_amdgcn_cvt_scalef32_pk_fp4_f32(t, v[2 * j + 1].z * s, v[2 * j + 1].w * s, 1.0f, 3);
                w[j] = t; }
            *(u32x4*)(ws + WS_UB + (size_t)r * UROW + lane * 16) = (u32x4){w[0], w[1], w[2], w[3]};
        } else {
            unsigned char* dst = ws + WS_VB + (size_t)(r & 16383) * TROW + lane * 24;
            f32x16 ev, od;
#pragma unroll
            for (int j = 0; j < 8; ++j) { ev[2 * j] = v[j].x * s; od[2 * j] = v[j].y * s; ev[2 * j + 1] = v[j].z * s; od[2 * j + 1] = v[j].w * s; }
            const u32x6 p6 = __builtin_amdgcn_cvt_scalef32_2xpk16_fp6_f32(ev, od, 1.0f);
            ((u32x2*)dst)[0] = (u32x2){p6[0], p6[1]}; ((u32x2*)dst)[1] = (u32x2){p6[2], p6[3]}; ((u32x2*)dst)[2] = (u32x2){p6[4], p6[5]};
        }
        if (lane == 0) ((float*)(ws + WS_TSC))[r] = am > 0.f ? am / qmax : 1.0f;
    }
}
constexpr int LD64 = 72, MATB = 64 * LD64 * 2, LDK = 104;
constexpr int O_AB = 0, O_RB = 1 * MATB, O_BH = 2 * MATB, O_KH = 3 * MATB, O_ABT = 4 * MATB, O_BTT = 5 * MATB, O_KTT = 6 * MATB, O_VT = 7 * MATB;
constexpr int O_M0 = 8 * MATB, O_M0T = 9 * MATB, O_M1 = 10 * MATB, O_M1T = 11 * MATB, O_PA = 12 * MATB, O_PB = 13 * MATB, O_MAK = 14 * MATB, O_MRB = 15 * MATB, O_MRK = 16 * MATB;
constexpr int O_ELEND = 17 * MATB, O_WT = O_ELEND + 256;
constexpr int O_WL = 8 * MATB, O_AL = O_WL + 64 * LDK * 2, O_Z = O_AL + 64 * LDK * 2, O_AZ = O_Z + 64 * 68 * 4;
static_assert(O_AZ + 64 * 68 * 4 <= O_ELEND, "lds");
static_assert(O_WT + 2048 <= LDS_BYTES - 16, "lds");

__device__ __forceinline__ bf16x8 ldsfrag(ldsp lds, int off, int ld, int row, int kofs) { return *(const LAS bf16x8*)(lds + off + (row * ld + kofs) * 2); }
__device__ __forceinline__ void st4(ldsp lds, int off, int row, int col, const f32x4 v) {
    u32x2 w; w.x = pk2(v.x, v.y); w.y = pk2(v.z, v.w); *(LAS u32x2*)(lds + off + (row * LD64 + col) * 2) = w; }
__device__ __forceinline__ void st1(ldsp lds, int off, int row, int col, float v) { *(LAS bf16_t*)(lds + off + (row * LD64 + col) * 2) = f2bf1(v); }

__device__ __forceinline__ float fast_rcp(float x) { return __builtin_amdgcn_rcpf(x); }
__device__ __forceinline__ float fast_sigmoid(float x) { return fast_rcp(1.0f + __expf(-x)); }
__device__ __forceinline__ float fast_tanh(float x) { return 1.0f - 2.0f * fast_rcp(1.0f + __expf(2.0f * x)); }
__device__ __forceinline__ u32x4 ld8(const bf16_t* p) { return p ? *(const u32x4*)p : (u32x4){0u, 0u, 0u, 0u}; }
__device__ __forceinline__ void shift8r(const u32x4 cw, const u32x4 pw, const float* mu, float* x) {
    float c[8], q[8]; unpack8(cw, c); unpack8(pw, q);
    const f32x4 m0 = *(const f32x4*)mu, m1 = *(const f32x4*)(mu + 4);
    const float mm[8] = {m0.x, m0.y, m0.z, m0.w, m1.x, m1.y, m1.z, m1.w};
#pragma unroll
    for (int i = 0; i < 8; ++i) x[i] = c[i] + (q[i] - c[i]) * mm[i];
}
__device__ __forceinline__ int tcol(int row, int col) { return ((((col >> 3) ^ (row >> 3)) & 7) << 3) | (col & 7); }
__device__ __forceinline__ bf16x8 ldsfragT(ldsp lds, int off, int row, int kofs) { return *(const LAS bf16x8*)(lds + off + (row * LD64 + tcol(row, kofs)) * 2); }
__device__ __forceinline__ void st1T(ldsp lds, int off, int row, int col, float v) { *(LAS bf16_t*)(lds + off + (row * LD64 + tcol(row, col)) * 2) = f2bf1(v); }
typedef short s16x4 __attribute__((ext_vector_type(4)));
__device__ __forceinline__ bf16x8 ldsfragTR(ldsp lds, int off, int krow0, int col0, int lane) {
    const int g = lane >> 4, q = (lane & 15) >> 2, p = lane & 3;
    const LAS s16x4* a = (const LAS s16x4*)(lds + off + ((krow0 + 8 * g + q) * LD64 + col0) * 2 + 8 * p);
    const s16x4 v0 = __builtin_amdgcn_ds_read_tr16_b64_v4i16((LAS s16x4*)a), v1 = __builtin_amdgcn_ds_read_tr16_b64_v4i16((LAS s16x4*)(a + LD64));
    return (bf16x8){v0[0], v0[1], v0[2], v0[3], v1[0], v1[1], v1[2], v1[3]};
}
__device__ __forceinline__ void shift8(const bf16_t* pcur, const bf16_t* pprev, const float* mu, float* x) {
    float c[8], q[8];
    if (pcur) unpack8(*(const u32x4*)pcur, c); else {
#pragma unroll
        for (int i = 0; i < 8; ++i) c[i] = 0.f; }
    if (pprev) unpack8(*(const u32x4*)pprev, q); else {
#pragma unroll
        for (int i = 0; i < 8; ++i) q[i] = 0.f; }
    const f32x4 m0 = *(const f32x4*)mu, m1 = *(const f32x4*)(mu + 4);
    const float mm[8] = {m0.x, m0.y, m0.z, m0.w, m1.x, m1.y, m1.z, m1.w};
#pragma unroll
    for (int i = 0; i < 8; ++i) x[i] = c[i] + (q[i] - c[i]) * mm[i];
}

template <bool DO_P, bool DO_SQ>
__device__ __forceinline__ void dbl_step(ldsp lds, int sN, int sT, int dN, int dT, int pC, int pN, int tm, int tn0, int fr, int fq) {
    bf16x8 a[2];
#pragma unroll
    for (int ks = 0; ks < 2; ++ks) a[ks] = ldsfragTR(lds, sN, 32 * ks, 16 * tm, 16 * fq + fr);
#pragma unroll
    for (int t2 = 0; t2 < 2; ++t2) {
        const int nt = tn0 + t2, t = 16 * nt + fr, s0 = 16 * tm + 4 * fq;
        if (DO_P) {
            f32x4 acc = {0.f, 0.f, 0.f, 0.f};
#pragma unroll
            for (int ks = 0; ks < 2; ++ks) acc = mfma16(a[ks], ldsfrag(lds, pC, LD64, t, ks * 32 + fq * 8), acc);
            const u32x2 pw = *(const LAS u32x2*)(lds + pC + (t * LD64 + s0) * 2);
            acc.x += bflo(pw.x); acc.y += bfhi(pw.x); acc.z += bflo(pw.y); acc.w += bfhi(pw.y);
            st4(lds, pN, t, s0, acc);
        }
        if (DO_SQ) {
            f32x4 acc = {0.f, 0.f, 0.f, 0.f};
#pragma unroll
            for (int ks = 0; ks < 2; ++ks) acc = mfma16(a[ks], ldsfrag(lds, sN, LD64, t, ks * 32 + fq * 8), acc);
            st4(lds, dN, t, s0, acc);
        }
    }
}


#ifdef DBG_STAGE
constexpr size_t DBG_STRIDE = (size_t)NUNITS * 512 * 4;
__device__ __forceinline__ void dbgsum(const Params& P, ldsp lds, int u, int stage, const int* offs, int nmat) {
    unsigned acc = 0;
    for (int m = 0; m < nmat; ++m)
        for (int k = 0; k < 4; ++k) { const int idx = threadIdx.x + 512 * k, row = idx >> 5, cp = idx & 31; const unsigned x = *(const LAS unsigned*)(lds + offs[m] + row * (LD64 * 2) + cp * 4); acc += (x & 0xffffu) + (x >> 16); }
    ((unsigned*)(P.ws + WS_S0T + (size_t)stage * DBG_STRIDE))[(size_t)u * 512 + threadIdx.x] = acc;
}
#define DBGSUM(stage, ...) do { const int offs_[] = {__VA_ARGS__}; dbgsum(P, lds, u, stage, offs_, (int)(sizeof(offs_) / sizeof(int))); } while (0)
#else
#define DBGSUM(stage, ...) do { } while (0)
#endif
struct PL { u32x4 rc, rq, kc, kq, vc, vq, cw[3], pw[3]; };
__device__ __forceinline__ const bf16_t* unit_rowp(const bf16_t* pp, int u, int tl, int col) {
    int r;
    if (u >= 4096) r = (tl >= 48) ? (ROW_META + tl - 48) : -1;
    else { const int bh = u >> 6, c = u & 63, b = bh >> 5; r = (tl >= 0 || c > 0) ? (b * SEQ + c * 64 + tl) : (ROW_META + 15); }
    return r < 0 ? (const bf16_t*)nullptr : pp + (size_t)r * NPAD + col;
}
__device__ __forceinline__ void pl_load(const Params& P, int u, PL& L) {
    int tid = threadIdx.x; asm volatile("" : "+v"(tid));
    const int lane = tid & 63, wave = tid >> 6, fr = lane & 15, fq = lane >> 4, tm = wave >> 1;
    const bf16_t* pp = (const bf16_t*)(P.ws + WS_P);
    const int h = (u >= 4096) ? (u - 4096) : ((u >> 6) & 31);
    const int t = tid >> 3, hj = h * 64 + 8 * (tid & 7);
    L.rc = ld8(unit_rowp(pp, u, t, C_R + hj)); L.rq = ld8(unit_rowp(pp, u, t - 1, C_R + hj));
    L.kc = ld8(unit_rowp(pp, u, t, C_K + hj)); L.kq = ld8(unit_rowp(pp, u, t - 1, C_K + hj));
    L.vc = ld8(unit_rowp(pp, u, t, C_V + hj)); L.vq = ld8(unit_rowp(pp, u, t - 1, C_V + hj));
#pragma unroll
    for (int it = 0; it < 3; ++it) { const int idx = tid + 512 * it, mat = idx / 768, rem = idx - mat * 768, tt = rem / 12, ch = rem - tt * 12, col = (mat ? C_AL : C_WL) + ch * 8;
        L.cw[it] = ld8(unit_rowp(pp, u, tt, col)); L.pw[it] = ld8(unit_rowp(pp, u, tt - 1, col)); }
}
__device__ __forceinline__ void rwkv_unit(const Params& P, ldsp lds, int u, PL& L, int next_u) {
    int tid = threadIdx.x; asm volatile("" : "+v"(tid));
    const int lane = tid & 63, wave = tid >> 6, fr = lane & 15, fq = lane >> 4, tm = wave >> 1, tn0 = (wave & 1) * 2;
    unsigned char* ws = P.ws;
    const bf16_t* pp = (const bf16_t*)(ws + WS_P);
    const bool meta = u >= 4096;
    int b = 0, h, c = 0;
    if (meta) { h = u - 4096; } else { const int bh = u >> 6; c = u & 63; b = bh >> 5; h = bh & 31; }
    auto rowof = [&](int tl) -> int {
        if (meta) return (tl >= 48) ? (ROW_META + tl - 48) : -1;
        if (tl >= 0 || c > 0) return b * SEQ + c * 64 + tl;
        return ROW_META + 15;
    };
    auto rowp = [&](int tl, int col) -> const bf16_t* { const int r = rowof(tl); return r < 0 ? (const bf16_t*)nullptr : pp + (size_t)r * NPAD + col; };
    const float* mu = P.in[I_MU];
#ifndef RPT_AD
#define RPT_AD 1
#define RPT_E12 1
#define RPT_E35 1
#endif
    float lw[8], av[8], rv[8], kv[8], vv[8], kk[8], km[8];
    const int t = tid >> 3, jq = tid & 7, j0 = 8 * jq, hj = h * 64 + j0;
    const bool nulltok = meta && t < 48;
    for (int rpt_ = 0; rpt_ < RPT_AD; ++rpt_) {
    bf16x8 lAw[3], lAa[3];
    {
        const bf16_t* ww2 = (const bf16_t*)(ws + WS_WTW2) + (size_t)(h * 64 + 16 * tm + fr) * 96 + fq * 8;
        const bf16_t* wa2 = (const bf16_t*)(ws + WS_WTA2) + (size_t)(h * 64 + 16 * tm + fr) * 96 + fq * 8;
#pragma unroll
        for (int ks = 0; ks < 3; ++ks) { lAw[ks] = *(const bf16x8*)(ww2 + ks * 32); lAa[ks] = *(const bf16x8*)(wa2 + ks * 32); }
    }
    {
#pragma unroll
        for (int it = 0; it < 3; ++it) { const int idx = tid + 512 * it, mat = idx / 768, rem = idx - mat * 768, tt = rem / 12, ch = rem - tt * 12, col = (mat ? C_AL : C_WL) + ch * 8;
            float x[8]; shift8r(L.cw[it], L.pw[it], mu + col, x);
            if (mat == 0) {
#pragma unroll
                for (int i = 0; i < 8; ++i) x[i] = fast_tanh(x[i]);
            }
            *(LAS u32x4*)(lds + (mat ? O_AL : O_WL) + (tt * LDK + ch * 8) * 2) = pack8(x); }
    }
    BLOCK_SYNC();
    {
        f32x4 z[2] = {{0.f, 0.f, 0.f, 0.f}, {0.f, 0.f, 0.f, 0.f}}, az[2] = {{0.f, 0.f, 0.f, 0.f}, {0.f, 0.f, 0.f, 0.f}};
#pragma unroll
        for (int ks = 0; ks < 3; ++ks) {
            const bf16x8 aw = lAw[ks], aa = lAa[ks];
#pragma unroll
            for (int t2 = 0; t2 < 2; ++t2) {
                const int t = 16 * (tn0 + t2) + fr;
                z[t2] = mfma16(aw, ldsfrag(lds, O_WL, LDK, t, ks * 32 + fq * 8), z[t2]);
                az[t2] = mfma16(aa, ldsfrag(lds, O_AL, LDK, t, ks * 32 + fq * 8), az[t2]);
            }
        }
#pragma unroll
        for (int t2 = 0; t2 < 2; ++t2) {
            const int t = 16 * (tn0 + t2) + fr, j0 = 16 * tm + 4 * fq;
            *(LAS f32x4*)(lds + O_Z + (t * 68 + j0) * 4) = z[t2];
            *(LAS f32x4*)(lds + O_AZ + (t * 68 + j0) * 4) = az[t2];
        }
    }
    BLOCK_SYNC();
    float cs[8];
    {
        const f32x4 z0 = *(const LAS f32x4*)(lds + O_Z + (t * 68 + j0) * 4), z1 = *(const LAS f32x4*)(lds + O_Z + (t * 68 + j0 + 4) * 4);
        const f32x4 y0 = *(const LAS f32x4*)(lds + O_AZ + (t * 68 + j0) * 4), y1 = *(const LAS f32x4*)(lds + O_AZ + (t * 68 + j0 + 4) * 4);
        const float zz[8] = {z0.x, z0.y, z0.z, z0.w, z1.x, z1.y, z1.z, z1.w}, yy[8] = {y0.x, y0.y, y0.z, y0.w, y1.x, y1.y, y1.z, y1.w};
        const f32x4 w0a = *(const f32x4*)(P.in[I_W0] + hj), w0b = *(const f32x4*)(P.in[I_W0] + hj + 4), a0a = *(const f32x4*)(P.in[I_A0] + hj), a0b = *(const f32x4*)(P.in[I_A0] + hj + 4);
        const float w0[8] = {w0a.x, w0a.y, w0a.z, w0a.w, w0b.x, w0b.y, w0b.z, w0b.w}, a0[8] = {a0a.x, a0a.y, a0a.z, a0a.w, a0b.x, a0b.y, a0b.z, a0b.w};
#pragma unroll
        for (int i = 0; i < 8; ++i) { lw[i] = nulltok ? 0.f : -DSCALE * fast_sigmoid(w0[i] + zz[i]); av[i] = fast_sigmoid(a0[i] + yy[i]); cs[i] = lw[i]; }
#pragma unroll
        for (int d = 8; d < 64; d <<= 1) {
#pragma unroll
            for (int i = 0; i < 8; ++i) { const float o = __shfl_up(cs[i], d); cs[i] += (lane >= d) ? o : 0.f; }
        }
        if (lane >= 56) { *(LAS f32x4*)(lds + O_WT + (wave * 64 + j0) * 4) = (f32x4){cs[0], cs[1], cs[2], cs[3]}; *(LAS f32x4*)(lds + O_WT + (wave * 64 + j0 + 4) * 4) = (f32x4){cs[4], cs[5], cs[6], cs[7]}; }
        shift8r(L.rc, L.rq, mu + C_R + hj, rv); shift8r(L.kc, L.kq, mu + C_K + hj, kv); shift8r(L.vc, L.vq, mu + C_V + hj, vv);
        if (nulltok) {
#pragma unroll
            for (int i = 0; i < 8; ++i) { rv[i] = 0.f; kv[i] = 0.f; vv[i] = 0.f; }
        }
        const f32x4 kka = *(const f32x4*)(P.in[I_KK] + hj), kkb = *(const f32x4*)(P.in[I_KK] + hj + 4), kaa = *(const f32x4*)(P.in[I_KA] + hj), kab = *(const f32x4*)(P.in[I_KA] + hj + 4);
        const f32x4 rka = *(const f32x4*)(P.in[I_RK] + hj), rkb = *(const f32x4*)(P.in[I_RK] + hj + 4);
        const float kkw[8] = {kka.x, kka.y, kka.z, kka.w, kkb.x, kkb.y, kkb.z, kkb.w}, kaw[8] = {kaa.x, kaa.y, kaa.z, kaa.w, kab.x, kab.y, kab.z, kab.w}, rkw[8] = {rka.x, rka.y, rka.z, rka.w, rkb.x, rkb.y, rkb.z, rkb.w};
        float n2 = 0.f, bon = 0.f;
#pragma unroll
        for (int i = 0; i < 8; ++i) { kk[i] = kv[i] * kkw[i]; n2 += kk[i] * kk[i]; km[i] = kv[i] * (1.0f + (av[i] - 1.0f) * kaw[i]); bon += rv[i] * km[i] * rkw[i]; }
        n2 += DPPF(n2, 0xB1); n2 += DPPF(n2, 0x4E); n2 += DPPF(n2, 0x141);
        bon += DPPF(bon, 0xB1); bon += DPPF(bon, 0x4E); bon += DPPF(bon, 0x141);
        const float inv = 1.0f / fmaxf(sqrtf(n2), 1e-12f);
#pragma unroll
        for (int i = 0; i < 8; ++i) kk[i] *= inv;
        if (!meta && jq == 0) ((float*)(ws + WS_BONUS))[(size_t)(b * SEQ + c * 64 + t) * 32 + h] = bon;
    }
    BLOCK_SYNC();
    {
        float Lc[8], Le[8];
#pragma unroll
        for (int i = 0; i < 8; ++i) { Lc[i] = cs[i]; Le[i] = 0.f; }
#pragma unroll
        for (int w = 0; w < 8; ++w) {
            const f32x4 x0 = *(const LAS f32x4*)(lds + O_WT + (w * 64 + j0) * 4), x1 = *(const LAS f32x4*)(lds + O_WT + (w * 64 + j0 + 4) * 4);
            const float xx[8] = {x0.x, x0.y, x0.z, x0.w, x1.x, x1.y, x1.z, x1.w};
            const float msk = w < wave ? 1.0f : 0.0f;
#pragma unroll
            for (int i = 0; i < 8; ++i) { Le[i] += xx[i]; Lc[i] += msk * xx[i]; }
        }
        float Ab[8], Rb[8], Bh[8], Kh[8], Bt[8], Kt[8];
#pragma unroll
        for (int i = 0; i < 8; ++i) {
            const float eP = __expf(Lc[i] - lw[i]), eC = __expf(Lc[i]), eN = __expf(-Lc[i]), eE = __expf(Le[i] - Lc[i]);
            const float ka = kk[i] * av[i];
            Ab[i] = -kk[i] * eP; Rb[i] = rv[i] * eC; Bh[i] = ka * eN; Kh[i] = km[i] * eN; Bt[i] = ka * eE; Kt[i] = km[i] * eE;
        }
        *(LAS u32x4*)(lds + O_AB + (t * LD64 + j0) * 2) = pack8(Ab);
        *(LAS u32x4*)(lds + O_RB + (t * LD64 + j0) * 2) = pack8(Rb);
        *(LAS u32x4*)(lds + O_BH + (t * LD64 + j0) * 2) = pack8(Bh);
        *(LAS u32x4*)(lds + O_KH + (t * LD64 + j0) * 2) = pack8(Kh);
        *(LAS u32x4*)(lds + O_BTT + (t * LD64 + j0) * 2) = pack8(Bt);
        *(LAS u32x4*)(lds + O_KTT + (t * LD64 + j0) * 2) = pack8(Kt);
        *(LAS u32x4*)(lds + O_VT + (t * LD64 + j0) * 2) = pack8(vv);
        if (t == 63) {
#pragma unroll
            for (int i = 0; i < 8; ++i) *(LAS float*)(lds + O_ELEND + (j0 + i) * 4) = __expf(Le[i]);
        }
    }
    BLOCK_SYNC();
    }
    if (next_u >= 0) pl_load(P, next_u, L);
    DBGSUM(0, O_AB, O_RB, O_BH, O_KH, O_ABT, O_BTT, O_KTT, O_VT);
    for (int rpt_ = 0; rpt_ < RPT_E12; ++rpt_) {
    {
        bf16x8 abh[2], akh[2];
#pragma unroll
        for (int ks = 0; ks < 2; ++ks) { abh[ks] = ldsfrag(lds, O_BH, LD64, 16 * tm + fr, ks * 32 + fq * 8); akh[ks] = ldsfrag(lds, O_KH, LD64, 16 * tm + fr, ks * 32 + fq * 8); }
#pragma unroll
        for (int t2 = 0; t2 < 2; ++t2) {
            const int tt = 16 * (tn0 + t2) + fr, s0 = 16 * tm + 4 * fq;
            f32x4 mab = {0.f, 0.f, 0.f, 0.f}, mak = mab, mrb = mab, mrk = mab;
#pragma unroll
            for (int ks = 0; ks < 2; ++ks) {
                const bf16x8 bab = ldsfrag(lds, O_AB, LD64, tt, ks * 32 + fq * 8), brb = ldsfrag(lds, O_RB, LD64, tt, ks * 32 + fq * 8);
                mab = mfma16(abh[ks], bab, mab); mak = mfma16(akh[ks], bab, mak); mrb = mfma16(abh[ks], brb, mrb); mrk = mfma16(akh[ks], brb, mrk);
            }
            float vab[4] = {mab.x, mab.y, mab.z, mab.w}, vak[4] = {mak.x, mak.y, mak.z, mak.w}, vrb[4] = {mrb.x, mrb.y, mrb.z, mrb.w}, vrk[4] = {mrk.x, mrk.y, mrk.z, mrk.w}, vp[4];
#pragma unroll
            for (int r = 0; r < 4; ++r) { const int s = s0 + r; const bool st = s < tt, le = s <= tt;
                vab[r] = st ? vab[r] : 0.f; vak[r] = st ? vak[r] : 0.f; vrb[r] = le ? vrb[r] : 0.f; vrk[r] = le ? vrk[r] : 0.f; vp[r] = vab[r] + (s == tt ? 1.0f : 0.f); }
            st4(lds, O_M0, tt, s0, (f32x4){vab[0], vab[1], vab[2], vab[3]});
            st4(lds, O_PA, tt, s0, (f32x4){vp[0], vp[1], vp[2], vp[3]});
            st4(lds, O_MAK, tt, s0, (f32x4){vak[0], vak[1], vak[2], vak[3]});
            st4(lds, O_MRB, tt, s0, (f32x4){vrb[0], vrb[1], vrb[2], vrb[3]});
            st4(lds, O_MRK, tt, s0, (f32x4){vrk[0], vrk[1], vrk[2], vrk[3]});
        }
    }
    BLOCK_SYNC();
    DBGSUM(1, O_M0, O_M0T, O_PA, O_MAK, O_MRB, O_MRK);
    dbl_step<false, true>(lds, O_M0, O_M0T, O_M1, O_M1T, 0, 0, tm, tn0, fr, fq); BLOCK_SYNC();
    dbl_step<true, true>(lds, O_M1, O_M1T, O_M0, O_M0T, O_PA, O_PB, tm, tn0, fr, fq); BLOCK_SYNC();
    dbl_step<true, true>(lds, O_M0, O_M0T, O_M1, O_M1T, O_PB, O_PA, tm, tn0, fr, fq); BLOCK_SYNC();
    dbl_step<true, true>(lds, O_M1, O_M1T, O_M0, O_M0T, O_PA, O_PB, tm, tn0, fr, fq); BLOCK_SYNC();
    dbl_step<true, true>(lds, O_M0, O_M0T, O_M1, O_M1T, O_PB, O_PA, tm, tn0, fr, fq); BLOCK_SYNC();
    dbl_step<true, false>(lds, O_M1, O_M1T, 0, 0, O_PA, O_PB, tm, tn0, fr, fq); BLOCK_SYNC();
    }
    DBGSUM(2, O_PB);
    const size_t ub = (size_t)u * 4096;
    for (int rpt_ = 0; rpt_ < RPT_E35; ++rpt_) {
    {
        bf16x8 aT[2], aMak[2];
#pragma unroll
        for (int ks = 0; ks < 2; ++ks) { aT[ks] = ldsfrag(lds, O_PB, LD64, 16 * tm + fr, ks * 32 + fq * 8); aMak[ks] = ldsfrag(lds, O_MAK, LD64, 16 * tm + fr, ks * 32 + fq * 8); }
#pragma unroll
        for (int t2 = 0; t2 < 2; ++t2) {
            const int n = 16 * (tn0 + t2) + fr, t0 = 16 * tm + 4 * fq;
            f32x4 at = {0.f, 0.f, 0.f, 0.f}, xt = at;
#pragma unroll
            for (int ks = 0; ks < 2; ++ks) { at = mfma16(aT[ks], ldsfragTR(lds, O_AB, 32 * ks, 16 * (tn0 + t2), 16 * fq + fr), at); xt = mfma16(aMak[ks], ldsfragTR(lds, O_VT, 32 * ks, 16 * (tn0 + t2), 16 * fq + fr), xt); }
            st4(lds, O_M0, n, t0, at); st4(lds, O_M0T, n, t0, xt);
        }
    }
    BLOCK_SYNC();
    DBGSUM(3, O_M0, O_M0T);
    {
        bf16x8 aT[2], aAt[2];
#pragma unroll
        for (int ks = 0; ks < 2; ++ks) { aT[ks] = ldsfrag(lds, O_PB, LD64, 16 * tm + fr, ks * 32 + fq * 8); aAt[ks] = ldsfrag(lds, O_M0, LD64, 16 * tm + fr, ks * 32 + fq * 8); }
        bf16_t* Rt = (bf16_t*)(ws + WS_RT) + ub; bf16_t* Gp = (bf16_t*)(ws + WS_G) + ub;
#pragma unroll
        for (int t2 = 0; t2 < 2; ++t2) {
            const int n = 16 * (tn0 + t2) + fr, m0 = 16 * tm + 4 * fq;
            f32x4 u0 = {0.f, 0.f, 0.f, 0.f}, rt = u0, g = u0;
#pragma unroll
            for (int ks = 0; ks < 2; ++ks) {
                u0 = mfma16(aT[ks], ldsfrag(lds, O_M0T, LD64, n, ks * 32 + fq * 8), u0);
                rt = mfma16(aAt[ks], ldsfrag(lds, O_MRB, LD64, n, ks * 32 + fq * 8), rt);
                g = mfma16(aAt[ks], ldsfragTR(lds, O_BTT, 32 * ks, 16 * (tn0 + t2), 16 * fq + fr), g);
            }
            st4(lds, O_M1, n, m0, u0);
            const u32x2 rw = *(const LAS u32x2*)(lds + O_RB + (n * LD64 + m0) * 2);
            rt.x += bflo(rw.x); rt.y += bfhi(rw.x); rt.z += bflo(rw.y); rt.w += bfhi(rw.y);
            { u32x2 w; w.x = pk2(rt.x, rt.y); w.y = pk2(rt.z, rt.w); *(u32x2*)(Rt + n * 64 + m0) = w; }
            if ((n >> 2) == (m0 >> 2)) { const float e = *(const LAS float*)(lds + O_ELEND + n * 4); const int r = n & 3;
                g.x += (r == 0) ? e : 0.f; g.y += (r == 1) ? e : 0.f; g.z += (r == 2) ? e : 0.f; g.w += (r == 3) ? e : 0.f; }
            { const int pos0 = 32 * (tm >> 1) + 8 * fq + 4 * (tm & 1); u32x2 w; w.x = pk2(g.x, g.y); w.y = pk2(g.z, g.w); *(u32x2*)(Gp + n * 64 + pos0) = w; }
        }
    }
    BLOCK_SYNC();
    DBGSUM(4, O_M1);
    {
        bf16x8 aB[2], aK[2], aU[2], aV[2];
#pragma unroll
        for (int ks = 0; ks < 2; ++ks) { const int row = 16 * tm + fr, ko = ks * 32 + fq * 8;
            aB[ks] = ldsfragTR(lds, O_BTT, 32 * ks, 16 * tm, 16 * fq + fr); aK[ks] = ldsfragTR(lds, O_KTT, 32 * ks, 16 * tm, 16 * fq + fr); aU[ks] = ldsfrag(lds, O_M1, LD64, row, ko); aV[ks] = ldsfragTR(lds, O_VT, 32 * ks, 16 * tm, 16 * fq + fr); }
        bf16_t* H0t = (bf16_t*)(ws + WS_H0T) + ub; bf16_t* Y0s = (bf16_t*)(ws + WS_Y0) + ub;
#pragma unroll
        for (int t2 = 0; t2 < 2; ++t2) {
            const int n = 16 * (tn0 + t2) + fr, m0 = 16 * tm + 4 * fq;
            f32x4 hh = {0.f, 0.f, 0.f, 0.f}, yy = hh;
#pragma unroll
            for (int ks = 0; ks < 2; ++ks) { const int ko = ks * 32 + fq * 8;
                const bf16x8 bU = ldsfrag(lds, O_M1, LD64, n, ko), bV = ldsfragTR(lds, O_VT, 32 * ks, 16 * (tn0 + t2), 16 * fq + fr), bRb = ldsfrag(lds, O_MRB, LD64, n, ko), bRk = ldsfrag(lds, O_MRK, LD64, n, ko);
                hh = mfma16(aB[ks], bU, hh); hh = mfma16(aK[ks], bV, hh);
                yy = mfma16(aU[ks], bRb, yy); yy = mfma16(aV[ks], bRk, yy); }
            { u32x2 w; w.x = pk2(hh.x, hh.y); w.y = pk2(hh.z, hh.w); *(u32x2*)(H0t + n * 64 + m0) = w; }
            { u32x2 w; w.x = pk2(yy.x, yy.y); w.y = pk2(yy.z, yy.w); *(u32x2*)(Y0s + n * 64 + m0) = w; }
        }
    }
    BLOCK_SYNC();
    }
}

constexpr int LDU = 264;
__device__ __forceinline__ void pool_unit(const Params& P, ldsp lds, int pu) {
    int tid = threadIdx.x; asm volatile("" : "+v"(tid));
    const int lane = tid & 63, wave = tid >> 6, fr = lane & 15, fq = lane >> 4;
    unsigned char* ws = P.ws;
    const bf16_t* pp = (const bf16_t*)(ws + WS_P);
    const int g = (pu < 256) ? (pu & 3) : 3 - (pu & 3), tt = pu >> 2, b = tt >> 6, ti0 = (tt & 63) * 64;
    constexpr int O_U = 0, O_PL = 79 * LDU * 2;
    for (int idx = tid; idx < 79 * 32; idx += 512) {
        const int lr = idx >> 5, ch = idx & 31, ti = ti0 + lr - 15;
        const int row = ti >= 0 ? b * SEQ + ti : ROW_META + 16 + ti;
        *(LAS u32x4*)(lds + O_U + (lr * LDU + ch * 8) * 2) = *(const u32x4*)(pp + (size_t)row * NPAD + C_POOL + g * 256 + ch * 8);
    }
    BLOCK_SYNC();
    {
        const int t = tid >> 3, cq = tid & 7, win = 2 << g; const float inv = 1.0f / (float)win;
#pragma unroll
        for (int cc = 0; cc < 4; ++cc) {
            const int c0 = cq * 32 + cc * 8; float s[8], own[8];
            unpack8(*(const LAS u32x4*)(lds + O_U + ((15 + t) * LDU + c0) * 2), own);
#pragma unroll
            for (int i = 0; i < 8; ++i) s[i] = own[i];
            for (int d = 1; d < win; ++d) { float x[8]; unpack8(*(const LAS u32x4*)(lds + O_U + ((15 + t - d) * LDU + c0) * 2), x);
#pragma unroll
                for (int i = 0; i < 8; ++i) s[i] += x[i]; }
#pragma unroll
            for (int i = 0; i < 8; ++i) s[i] = s[i] * inv - own[i];
            *(LAS u32x4*)(lds + O_PL + (t * LDU + c0) * 2) = pack8(s);
        }
    }
    BLOCK_SYNC();
    {
        const bf16_t* wt = (const bf16_t*)(ws + WS_WTPOOL) + (size_t)g * 65536;
        f32x4 acc[2][4];
#pragma unroll
        for (int a = 0; a < 2; ++a)
#pragma unroll
            for (int n = 0; n < 4; ++n) acc[a][n] = (f32x4){0.f, 0.f, 0.f, 0.f};
#pragma unroll 4
        for (int ks = 0; ks < 8; ++ks) {
            bf16x8 af[2];
#pragma unroll
            for (int a = 0; a < 2; ++a) af[a] = *(const bf16x8*)(wt + (size_t)(32 * wave + 16 * a + fr) * 256 + ks * 32 + fq * 8);
#pragma unroll
            for (int n = 0; n < 4; ++n) { const bf16x8 bf = ldsfrag(lds, O_PL, LDU, 16 * n + fr, ks * 32 + fq * 8);
#pragma unroll
                for (int a = 0; a < 2; ++a) acc[a][n] = mfma16(af[a], bf, acc[a][n]); }
        }
        bf16_t* yb = (bf16_t*)(ws + WS_YAB) + 2048;
        const float* psc = P.in[I_PSCALE] + g * 256;
#pragma unroll
        for (int a = 0; a < 2; ++a) { const int d0 = 32 * wave + 16 * a + 4 * fq; const f32x4 sc = *(const f32x4*)(psc + d0);
#pragma unroll
            for (int n = 0; n < 4; ++n) { const int t = 16 * n + fr; const f32x4 o = acc[a][n] * sc;
                u32x2 w; w.x = pk2(o.x, o.y); w.y = pk2(o.z, o.w);
                *(u32x2*)(yb + (size_t)(b * SEQ + ti0 + t) * LDAB + g * 256 + d0) = w; } }
    }
    BLOCK_SYNC();
}
__device__ __forceinline__ void gsig_unit(const Params& P, int gu) {
    int tid = threadIdx.x; asm volatile("" : "+v"(tid));
    const bf16_t* pp = (const bf16_t*)(P.ws + WS_P); bf16_t* gs = (bf16_t*)(P.ws + WS_GSIG);
    const float* mu = P.in[I_MU];
#pragma unroll
    for (int it = 0; it < 4; ++it) {
        const int idx = tid + 512 * it, tl = idx >> 5, ch = idx & 31, col = C_GL + ch * 8;
        const int row = gu * 64 + tl; const int prow = ((row & (SEQ - 1)) == 0) ? (ROW_META + 15) : row - 1;
        float x[8]; shift8r(*(const u32x4*)(pp + (size_t)row * NPAD + col), *(const u32x4*)(pp + (size_t)prow * NPAD + col), mu + col, x);
#pragma unroll
        for (int i = 0; i < 8; ++i) x[i] = fast_sigmoid(x[i]);
        *(u32x4*)(gs + (size_t)row * 256 + ch * 8) = pack8(x);
    }
}
__device__ __forceinline__ void phase2(const Params& P, ldsp lds) {
    PL L;
    if ((int)blockIdx.x < NUNITS) pl_load(P, blockIdx.x, L);
    for (int u = blockIdx.x; u < NUNITS + 128; u += gridDim.x) {
        if (u < NUNITS) { const int nu = u + (int)gridDim.x; rwkv_unit(P, lds, u, L, nu < NUNITS ? nu : -1); }
        else gsig_unit(P, u - NUNITS);
    }

}
__device__ __forceinline__ void phase3(const Params& P) {
    const int lane = threadIdx.x & 63, wave = threadIdx.x >> 6, fr = lane & 15, fq = lane >> 4;
    if (wave != 0) { convert_tables(P, CONV_P2_ROWS + blockIdx.x * 7 + (wave - 1), 32768, gridDim.x * 7); return; }
    unsigned char* ws = P.ws;
    const bf16_t* Gp = (const bf16_t*)(ws + WS_G); const bf16_t* H0t = (const bf16_t*)(ws + WS_H0T); bf16_t* S0t = (bf16_t*)(ws + WS_S0T);
    for (int item = blockIdx.x; item < 256; item += gridDim.x) {
        const int bh = item >> 2, vq = item & 3, h = bh & 31;
        bf16x8 Sb[2];
#pragma unroll
        for (int ks = 0; ks < 2; ++ks)
#pragma unroll
            for (int i = 0; i < 8; ++i) Sb[ks][i] = 0;
        bf16x8 g0[4][2], g1[4][2], g2[4][2], g3[4][2]; u32x2 h0[4], h1[4], h2[4], h3[4];
        auto load = [&](int step, bf16x8 (&ga)[4][2], u32x2 (&hf)[4]) {
            const int u = (step == 0) ? (4096 + h) : (bh * 64 + step - 1);
            const bf16_t* g = Gp + (size_t)u * 4096; const bf16_t* hh = H0t + (size_t)u * 4096;
#pragma unroll
            for (int mt = 0; mt < 4; ++mt) {
#pragma unroll
                for (int ks = 0; ks < 2; ++ks) ga[mt][ks] = *(const bf16x8*)(g + (16 * mt + fr) * 64 + ks * 32 + fq * 8);
                hf[mt] = *(const u32x2*)(hh + (16 * vq + fr) * 64 + 16 * mt + 4 * fq);
            }
        };
        auto apply = [&](int step, const bf16x8 (&ga)[4][2], const u32x2 (&hf)[4]) {
            f32x4 acc[4];
#pragma unroll
            for (int mt = 0; mt < 4; ++mt) {
                acc[mt] = (f32x4){bflo(hf[mt].x), bfhi(hf[mt].x), bflo(hf[mt].y), bfhi(hf[mt].y)};
                acc[mt] = mfma16(ga[mt][0], Sb[0], acc[mt]);
                acc[mt] = mfma16(ga[mt][1], Sb[1], acc[mt]);
            }
            bf16_t* so = S0t + (size_t)(bh * 64 + step) * 4096 + (16 * vq + fr) * 64 + 4 * fq;
            u32x2 w[4];
#pragma unroll
            for (int mt = 0; mt < 4; ++mt) { w[mt].x = pk2(acc[mt].x, acc[mt].y); w[mt].y = pk2(acc[mt].z, acc[mt].w); *(u32x2*)(so + 16 * mt) = w[mt]; }
#pragma unroll
            for (int ks = 0; ks < 2; ++ks) {
                const u32x4 q4 = (u32x4){w[2 * ks].x, w[2 * ks].y, w[2 * ks + 1].x, w[2 * ks + 1].y};
                Sb[ks] = __builtin_bit_cast(bf16x8, q4);
            }
        };
        load(0, g0, h0); load(1, g1, h1); load(2, g2, h2);
#pragma unroll 1
        for (int step = 0; step < 64; step += 4) {
            load(step + 3, g3, h3); apply(step, g0, h0);
            if (step + 4 < 64) load(step + 4, g0, h0);
            apply(step + 1, g1, h1);
            if (step + 5 < 64) load(step + 5, g1, h1);
            apply(step + 2, g2, h2);
            if (step + 6 < 64) load(step + 6, g2, h2);
            apply(step + 3, g3, h3);
        }
    }
}

constexpr int LDG = 264;
__device__ __forceinline__ void phase3b(const Params& P, ldsp lds) {
    int tid = threadIdx.x; asm volatile("" : "+v"(tid));
    const int lane = tid & 63, wave = tid >> 6, fr = lane & 15, fq = lane >> 4, wq = wave & 3;
    unsigned char* ws = P.ws;
    const bf16_t* pp = (const bf16_t*)(ws + WS_P);
    const float* mu = P.in[I_MU];
    constexpr int O_G2 = 0;
    for (int pu = blockIdx.x; pu < 512; pu += gridDim.x) pool_unit(P, lds, pu);
    for (int w = blockIdx.x; w < 256; w += gridDim.x) {
        const int h = w & 31;
        BLOCK_SYNC();
        for (int idx = tid; idx < 64 * 32; idx += 512) { const int row = idx >> 5, ch = idx & 31;
            *(LAS u32x4*)(lds + O_G2 + (row * LDG + ch * 8) * 2) = *(const u32x4*)((const bf16_t*)(ws + WS_WTG2) + (size_t)(h * 64 + row) * 256 + ch * 8); }
        BLOCK_SYNC();
        bf16x8 bG[8], bR[2], aS[4][2]; u32x2 yw[4], vc[4], vp[4]; float bon;
        auto unit_of = [&](int it, int& b, int& c) { const int q = (w >> 5) + 8 * (2 * it + (wave >> 2)); b = q >> 6; c = q & 63; };
        auto issue = [&](int it) {
            int b, c; unit_of(it, b, c); const int u = (b * 32 + h) * 64 + c, trow0 = b * SEQ + c * 64 + 16 * wq;
            const size_t ub = (size_t)u * 4096;
            const bf16_t* S0t = (const bf16_t*)(ws + WS_S0T) + ub; const bf16_t* Rt = (const bf16_t*)(ws + WS_RT) + ub; const bf16_t* Y0s = (const bf16_t*)(ws + WS_Y0) + ub;
            const int row = trow0 + fr; const int prow = (c == 0 && wq == 0 && fr == 0) ? (ROW_META + 15) : row - 1;
            const bf16_t* gsr = (const bf16_t*)(ws + WS_GSIG) + (size_t)row * 256 + fq * 8;
#pragma unroll
            for (int ks = 0; ks < 8; ++ks) bG[ks] = *(const bf16x8*)(gsr + ks * 32);
#pragma unroll
            for (int ks = 0; ks < 2; ++ks) bR[ks] = *(const bf16x8*)(Rt + (16 * wq + fr) * 64 + ks * 32 + fq * 8);
#pragma unroll
            for (int mt = 0; mt < 4; ++mt) {
                yw[mt] = *(const u32x2*)(Y0s + (16 * wq + fr) * 64 + 16 * mt + 4 * fq);
#pragma unroll
                for (int ks = 0; ks < 2; ++ks) aS[mt][ks] = *(const bf16x8*)(S0t + (16 * mt + fr) * 64 + ks * 32 + fq * 8);
                const int hc = h * 64 + 16 * mt + 4 * fq;
                vc[mt] = *(const u32x2*)(pp + (size_t)row * NPAD + C_V + hc); vp[mt] = *(const u32x2*)(pp + (size_t)prow * NPAD + C_V + hc);
            }
            bon = ((const float*)(ws + WS_BONUS))[(size_t)row * 32 + h];
        };
        issue(0);
#pragma unroll 1
        for (int it = 0; it < 8; ++it) {
            int b, c; unit_of(it, b, c);
            const int row = b * SEQ + c * 64 + 16 * wq + fr;
            f32x4 gacc[4];
#pragma unroll
            for (int mt = 0; mt < 4; ++mt) gacc[mt] = (f32x4){0.f, 0.f, 0.f, 0.f};
#pragma unroll
            for (int ks = 0; ks < 8; ++ks)
#pragma unroll
                for (int mt = 0; mt < 4; ++mt) gacc[mt] = mfma16(*(const LAS bf16x8*)(lds + O_G2 + ((16 * mt + fr) * LDG + ks * 32 + fq * 8) * 2), bG[ks], gacc[mt]);
            f32x4 y[4], vv[4]; const float bonc = bon;
#pragma unroll
            for (int mt = 0; mt < 4; ++mt) {
                y[mt] = (f32x4){bflo(yw[mt].x), bfhi(yw[mt].x), bflo(yw[mt].y), bfhi(yw[mt].y)};
#pragma unroll
                for (int ks = 0; ks < 2; ++ks) y[mt] = mfma16(aS[mt][ks], bR[ks], y[mt]);
                const f32x4 mv = *(const f32x4*)(mu + C_V + h * 64 + 16 * mt + 4 * fq);
                const f32x4 cv = (f32x4){bflo(vc[mt].x), bfhi(vc[mt].x), bflo(vc[mt].y), bfhi(vc[mt].y)}, pv = (f32x4){bflo(vp[mt].x), bfhi(vp[mt].x), bflo(vp[mt].y), bfhi(vp[mt].y)};
                vv[mt] = cv + (pv - cv) * mv;
            }
#pragma unroll
            for (int mt = 0; mt < 4; ++mt) asm volatile("" : "+v"(y[mt]), "+v"(vv[mt]), "+v"(gacc[mt]));
            if (it + 1 < 8) issue(it + 1);
            float s = 0.f;
#pragma unroll
            for (int mt = 0; mt < 4; ++mt) s += (y[mt].x + y[mt].y) + (y[mt].z + y[mt].w);
            s += __shfl_xor(s, 16); s += __shfl_xor(s, 32);
            const float mean = s * (1.0f / 64.0f); float qq = 0.f;
#pragma unroll
            for (int mt = 0; mt < 4; ++mt) { y[mt] = y[mt] - mean; qq += (y[mt].x * y[mt].x + y[mt].y * y[mt].y) + (y[mt].z * y[mt].z + y[mt].w * y[mt].w); }
            qq += __shfl_xor(qq, 16); qq += __shfl_xor(qq, 32);
            const float rstd = 1.0f / sqrtf(qq * (1.0f / 64.0f) + GN_EPS);
            bf16_t* ya = (bf16_t*)(ws + WS_YAB) + (size_t)row * LDAB + h * 64;
#pragma unroll
            for (int mt = 0; mt < 4; ++mt) {
                const int i0 = 16 * mt + 4 * fq, hc = h * 64 + i0;
                const f32x4 gg = *(const f32x4*)(P.in[I_GNG] + hc), gb = *(const f32x4*)(P.in[I_GNB] + hc);
                const f32x4 o = (y[mt] * rstd * gg + gb + vv[mt] * bonc) * gacc[mt];
                u32x2 wv; wv.x = pk2(o.x, o.y); wv.y = pk2(o.z, o.w);
                *(u32x2*)(ya + i0) = wv;
            }
        }
    }
}
__device__ __forceinline__ u32x6 ld_row6(const unsigned char* p) { const u32x2 a = ((const u32x2*)p)[0], b = ((const u32x2*)p)[1], c = ((const u32x2*)p)[2]; return (u32x6){a.x, a.y, b.x, b.y, c.x, c.y}; }
__device__ __forceinline__ void peer_token(const Params& P, int tok, const LAS int* eidx, const LAS float* gts) {
    const int lane = threadIdx.x & 63;
    unsigned char* ws = P.ws;
    const unsigned char* Ub = ws + WS_UB; const unsigned char* Vb = ws + WS_VB;
    const float* tsc = (const float*)(ws + WS_TSC);
    {
        int lo = lane; asm volatile("" : "+v"(lo));
        float x[32], o[32];
        {
            const bf16_t* hr = (const bf16_t*)(ws + WS_X1B) + (size_t)tok * D + lo * 4;
#pragma unroll
            for (int j = 0; j < 8; ++j) { const u32x2 w = *(const u32x2*)(hr + 256 * j); x[4 * j] = bflo(w.x); x[4 * j + 1] = bfhi(w.x); x[4 * j + 2] = bflo(w.y); x[4 * j + 3] = bfhi(w.y); }
            const float* st = (const float*)(ws + WS_STAT);
            const float mean1 = st[tok] * (1.0f / D), rstd1 = 1.0f / sqrtf(fmaxf(st[8192 + tok] * (1.0f / D) - mean1 * mean1, 0.f) + LN_EPS);
#pragma unroll
            for (int c = 0; c < 8; ++c) { const f32x4 g1 = *(const f32x4*)(P.in[I_LN1G] + lo * 4 + 256 * c), b1 = *(const f32x4*)(P.in[I_LN1B] + lo * 4 + 256 * c);
                x[4 * c] = (x[4 * c] - mean1) * rstd1 * g1.x + b1.x; x[4 * c + 1] = (x[4 * c + 1] - mean1) * rstd1 * g1.y + b1.y; x[4 * c + 2] = (x[4 * c + 2] - mean1) * rstd1 * g1.z + b1.z; x[4 * c + 3] = (x[4 * c + 3] - mean1) * rstd1 * g1.w + b1.w; }
#pragma unroll
            for (int i = 0; i < 32; ++i) o[i] = 0.f;
        }
        const int e_lo = eidx[lo], e_hi = eidx[64 + lo];
        const float su_lo = tsc[e_lo], su_hi = tsc[e_hi];
        const float gv_lo = gts[lo] * tsc[16384 + e_lo], gv_hi = gts[64 + lo] * tsc[16384 + e_hi];
        u32x4 ua[2], ub[2]; u32x6 va[2], vb[2];
        auto issue = [&](int g, u32x4 (&uu)[2], u32x6 (&vv)[2]) {
            const int ev = (g < 32) ? e_lo : e_hi;
#pragma unroll
            for (int j = 0; j < 2; ++j) {
                const int e = __builtin_amdgcn_readlane(ev, (2 * g + j) & 63);
                uu[j] = *(const u32x4*)(Ub + (size_t)e * UROW + lo * 16); vv[j] = ld_row6(Vb + (size_t)e * TROW + lo * 24);
            }
        };
        auto consume = [&](int g, const u32x4 (&uu)[2], const u32x6 (&vv)[2]) {
            const float suv = (g < 32) ? su_lo : su_hi, gvv = (g < 32) ? gv_lo : gv_hi;
            float dd[2];
#pragma unroll
            for (int j = 0; j < 2; ++j) { float s0 = 0.f, s1 = 0.f; const unsigned ww[4] = {uu[j].x, uu[j].y, uu[j].z, uu[j].w};
#pragma unroll
                for (int q4 = 0; q4 < 4; ++q4) {
                    const f32x2 r0 = __builtin_amdgcn_cvt_scalef32_pk_f32_fp4(ww[q4], 1.0f, 0), r1 = __builtin_amdgcn_cvt_scalef32_pk_f32_fp4(ww[q4], 1.0f, 1), r2 = __builtin_amdgcn_cvt_scalef32_pk_f32_fp4(ww[q4], 1.0f, 2), r3 = __builtin_amdgcn_cvt_scalef32_pk_f32_fp4(ww[q4], 1.0f, 3);
                    s0 += r0.x * x[8 * q4] + r1.x * x[8 * q4 + 2] + r2.x * x[8 * q4 + 4] + r3.x * x[8 * q4 + 6];
                    s1 += r0.y * x[8 * q4 + 1] + r1.y * x[8 * q4 + 3] + r2.y * x[8 * q4 + 5] + r3.y * x[8 * q4 + 7]; }
                dd[j] = s0 + s1; }
#pragma unroll
            for (int j = 0; j < 2; ++j) dd[j] = wave_sum_dpp(dd[j]);
            const int l0 = (2 * g) & 63;
            const pg8::f32x2 ge = pg8::gelu_pk((pg8::f32x2){dd[0] * readlane_f(suv, l0), dd[1] * readlane_f(suv, l0 + 1)});
            const float a0 = ge.x * readlane_f(gvv, l0), a1 = ge.y * readlane_f(gvv, l0 + 1);
            { const f32x32 r = __builtin_amdgcn_cvt_scalef32_pk32_f32_fp6(vv[0], 1.0f);
#pragma unroll
              for (int i = 0; i < 32; ++i) o[i] += a0 * r[i]; }
            { const f32x32 r = __builtin_amdgcn_cvt_scalef32_pk32_f32_fp6(vv[1], 1.0f);
#pragma unroll
              for (int i = 0; i < 32; ++i) o[i] += a1 * r[i]; }
        };
        issue(0, ua, va);
        for (int g = 0; g < 64; g += 2) {
            issue(g + 1, ub, vb);
            consume(g, ua, va);
            if (g + 2 < 64) issue(g + 2, ua, va);
            consume(g + 1, ub, vb);
        }
        float s = 0.f;
#pragma unroll
        for (int i = 0; i < 32; ++i) { o[i] += DN_ALPHA * x[i]; s += o[i]; }
        const float mean = wave_sum_dpp(s) * (1.0f / D); float q = 0.f;
#pragma unroll
        for (int i = 0; i < 32; ++i) { o[i] -= mean; q += o[i] * o[i]; }
        const float rstd = 1.0f / sqrtf(wave_sum_dpp(q) * (1.0f / D) + LN_EPS);
        float* orow = P.out + (size_t)tok * D;
#pragma unroll
        for (int c = 0; c < 8; ++c) {
            const int off = lo * 4 + 256 * c;
            const f32x4 g0 = *(const f32x4*)(P.in[I_LN2G] + off), b0 = *(const f32x4*)(P.in[I_LN2B] + off);
            f32x4 r0;
            r0.x = o[4 * c + 0] * rstd * g0.x + b0.x; r0.y = o[4 * c + 1] * rstd * g0.y + b0.y; r0.z = o[4 * c + 2] * rstd * g0.z + b0.z; r0.w = o[4 * c + 3] * rstd * g0.w + b0.w;
            *(f32x4*)(orow + off) = r0;
        }
    }
}
#define CE_DESC(a, b) do { const float h_ = fmaxf((a), (b)), l_ = fminf((a), (b)); (a) = h_; (b) = l_; } while (0)
template <int N> __device__ __forceinline__ void bitonic_sort_desc(float (&v)[N]) {
#pragma unroll
    for (int k = 2; k <= N; k <<= 1)
#pragma unroll
        for (int j = k >> 1; j > 0; j >>= 1)
#pragma unroll
            for (int i = 0; i < N; ++i) { const int l = i ^ j; if (l > i) { if ((i & k) == 0) CE_DESC(v[i], v[l]); else CE_DESC(v[l], v[i]); } }
}
template <int N> __device__ __forceinline__ void bitonic_merge_desc(float (&v)[N]) {
#pragma unroll
    for (int j = N >> 1; j > 0; j >>= 1)
#pragma unroll
        for (int i = 0; i < N; ++i) { const int l = i ^ j; if (l > i) CE_DESC(v[i], v[l]); }
}
__device__ __forceinline__ void top16_merge(float (&a)[16], const float (&brev)[16]) {
#pragma unroll
    for (int i = 0; i < 16; ++i) a[i] = fmaxf(a[i], brev[i]);
    bitonic_merge_desc<16>(a);
}
__device__ __forceinline__ float embed_bits(float v, unsigned code, unsigned mask) { return __uint_as_float((__float_as_uint(v) & ~mask) | code); }

__device__ __forceinline__ void phase7(const Params& P, ldsp lds) {
    const int tid0 = threadIdx.x;
    unsigned char* ws = P.ws;
    const bf16_t* qb = (const bf16_t*)(ws + WS_Q); const bf16_t* sk = (const bf16_t*)(ws + WS_SUBK);
    constexpr int LDSK = 136, O_SK = 0, O_SV = 2 * 128 * LDSK * 2, O_EX = O_SV + 32768, O_GT = O_EX + 16384;
    for (int idx = tid0; idx < 2 * 128 * 16; idx += 512) { const int row = idx >> 4, ch = idx & 15;
        *(LAS u32x4*)(lds + O_SK + (row * LDSK + ch * 8) * 2) = *(const u32x4*)(sk + row * 128 + ch * 8); }
    BLOCK_SYNC();
    for (int tile = blockIdx.x; tile < 256; tile += gridDim.x) {
        int tid = tid0; asm volatile("" : "+v"(tid));
        const int lane = tid & 63, wave = tid >> 6, fr = lane & 15, fq = lane >> 4, fro = fr, fqo = fq;
        const int tok0 = tile * 32, h = wave;
#pragma unroll 1
        for (int cb = 0; cb < 4; ++cb) {
            const int nt = cb >> 1, p = cb & 1;
            f32x4 acc[8];
#pragma unroll
            for (int mt = 0; mt < 8; ++mt) acc[mt] = (f32x4){0.f, 0.f, 0.f, 0.f};
            const bf16_t* qrow = qb + (size_t)(tok0 + 16 * nt + fro) * D + h * 256 + p * 128 + fqo * 8;
#pragma unroll
            for (int ks = 0; ks < 4; ++ks) {
                const bf16x8 bq = *(const bf16x8*)(qrow + ks * 32);
#pragma unroll
                for (int mt = 0; mt < 8; ++mt) acc[mt] = mfma16(*(const LAS bf16x8*)(lds + O_SK + ((p * 128 + 16 * mt + fro) * LDSK + ks * 32 + fqo * 8) * 2), bq, acc[mt]);
            }
            float a[16], b[16];
#pragma unroll
            for (int mt = 0; mt < 4; ++mt) {
                a[4 * mt + 0] = embed_bits(acc[mt].x, 16 * mt + 4 * fq + 0, 127u); a[4 * mt + 1] = embed_bits(acc[mt].y, 16 * mt + 4 * fq + 1, 127u);
                a[4 * mt + 2] = embed_bits(acc[mt].z, 16 * mt + 4 * fq + 2, 127u); a[4 * mt + 3] = embed_bits(acc[mt].w, 16 * mt + 4 * fq + 3, 127u);
                b[4 * mt + 0] = embed_bits(acc[mt + 4].x, 16 * (mt + 4) + 4 * fq + 0, 127u); b[4 * mt + 1] = embed_bits(acc[mt + 4].y, 16 * (mt + 4) + 4 * fq + 1, 127u);
                b[4 * mt + 2] = embed_bits(acc[mt + 4].z, 16 * (mt + 4) + 4 * fq + 2, 127u); b[4 * mt + 3] = embed_bits(acc[mt + 4].w, 16 * (mt + 4) + 4 * fq + 3, 127u);
            }
            bitonic_sort_desc<16>(a); bitonic_sort_desc<16>(b);
            { float br[16];
#pragma unroll
              for (int i = 0; i < 16; ++i) br[i] = b[15 - i];
              top16_merge(a, br); }
#pragma unroll
            for (int x = 16; x <= 32; x <<= 1) { float br[16];
#pragma unroll
                for (int i = 0; i < 16; ++i) br[i] = __shfl_xor(a[15 - i], x);
                top16_merge(a, br); }
            if (fq == 0) { LAS f32x4* o = (LAS f32x4*)(lds + O_SV + ((((16 * nt + fr) * 8 + h) * 2 + p) * 16) * 4);
                o[0] = (f32x4){a[0], a[1], a[2], a[3]}; o[1] = (f32x4){a[4], a[5], a[6], a[7]}; o[2] = (f32x4){a[8], a[9], a[10], a[11]}; o[3] = (f32x4){a[12], a[13], a[14], a[15]}; }
        }
        BLOCK_SYNC();
        if (tid < 256) {
            const int tok = tid >> 3, hh = tid & 7;
            const LAS f32x4* s = (const LAS f32x4*)(lds + O_SV + (((tok * 8 + hh) * 2) * 16) * 4);
            float s0[16], s1[16];
#pragma unroll
            for (int c4 = 0; c4 < 4; ++c4) { const f32x4 x = s[c4], y = s[4 + c4]; s0[4 * c4] = x.x; s0[4 * c4 + 1] = x.y; s0[4 * c4 + 2] = x.z; s0[4 * c4 + 3] = x.w; s1[4 * c4] = y.x; s1[4 * c4 + 1] = y.y; s1[4 * c4 + 2] = y.z; s1[4 * c4 + 3] = y.w; }
            float g0[16], g1[16], g2[16], g3[16];
            const float NEG = -3.0e38f;
#pragma unroll
            for (int bq = 0; bq < 16; ++bq) g0[bq] = embed_bits(s0[0] + s1[bq], bq, 255u);
            {
                int n1 = 0, n2 = 0, n3 = 0;
#pragma unroll
                for (int aa = 1; aa < 16; ++aa)
#pragma unroll
                    for (int bb = 0; bb < 16; ++bb) if ((aa + 1) * (bb + 1) <= 16) {
                        const float c = embed_bits(s0[aa] + s1[bb], aa * 16 + bb, 255u);
                        if (n1 < 16) g1[n1++] = c; else if (n2 < 16) g2[n2++] = c; else g3[n3++] = c;
                    }
#pragma unroll
                for (int i = 0; i < 16; ++i) if (i >= n3) g3[i] = NEG;
            }
            bitonic_sort_desc<16>(g1); bitonic_sort_desc<16>(g2); bitonic_sort_desc<16>(g3);
            { float r1[16], r3[16];
#pragma unroll
              for (int i = 0; i < 16; ++i) { r1[i] = g1[15 - i]; r3[i] = g3[15 - i]; }
              top16_merge(g0, r1); top16_merge(g2, r3);
#pragma unroll
              for (int i = 0; i < 16; ++i) g0[i] = fmaxf(g0[i], g2[15 - i]); }
            float mx = g0[0];
#pragma unroll
            for (int i = 1; i < 16; ++i) mx = fmaxf(mx, g0[i]);
            float ex[16], sm = 0.f; int ee[16];
#pragma unroll
            for (int i = 0; i < 16; ++i) {
                ex[i] = __expf(g0[i] - mx); sm += ex[i];
                const unsigned code = __float_as_uint(g0[i]) & 255u;
                const unsigned i0 = __float_as_uint(*(const LAS float*)(lds + O_SV + ((((tok * 8 + hh) * 2 + 0) * 16) + (code >> 4)) * 4)) & 127u;
                const unsigned i1 = __float_as_uint(*(const LAS float*)(lds + O_SV + ((((tok * 8 + hh) * 2 + 1) * 16) + (code & 15u)) * 4)) & 127u;
                ee[i] = (int)(i0 * 128u + i1);
            }
            const float inv = 1.0f / sm;
            LAS int* eo = (LAS int*)(lds + O_EX) + tok * 128 + hh * 16; LAS float* go = (LAS float*)(lds + O_GT) + tok * 128 + hh * 16;
#pragma unroll
            for (int c4 = 0; c4 < 4; ++c4) {
                *(LAS u32x4*)(eo + 4 * c4) = (u32x4){(unsigned)ee[4 * c4], (unsigned)ee[4 * c4 + 1], (unsigned)ee[4 * c4 + 2], (unsigned)ee[4 * c4 + 3]};
                *(LAS f32x4*)(go + 4 * c4) = (f32x4){ex[4 * c4] * inv, ex[4 * c4 + 1] * inv, ex[4 * c4 + 2] * inv, ex[4 * c4 + 3] * inv};
            }
        }
        BLOCK_SYNC();
#pragma unroll 1
        for (int i = 0; i < 4; ++i) peer_token(P, tok0 + wave * 4 + i, (const LAS int*)(lds + O_EX) + (wave * 4 + i) * 128, (const LAS float*)(lds + O_GT) + (wave * 4 + i) * 128);
        BLOCK_SYNC();
    }
}
#ifndef MK_MULTI
#define MK_MULTI 0
#endif
__global__ __launch_bounds__(512, 2) void hybrid_fwd(Params P) {
    extern __shared__ __attribute__((aligned(16))) unsigned char shm[];
    ldsp lds = (ldsp)shm;
    unsigned char* ws = P.ws;
    volatile LAS unsigned* xst = (volatile LAS unsigned*)(lds + LDS_BYTES - 16);
    if (threadIdx.x == 0) { xst[0] = 0u; xst[1] = 0u; }
    __syncthreads();
    const XcdBarrier xbar = xcd_barrier_post((unsigned*)(ws + WS_BAR), xst);
    const int lo = P.ph_lo, hi = P.ph_hi;
#ifdef DBG_TA
    unsigned long long ts0 = 0, ts1 = 0, ts2 = 0, ts3 = 0, ts4 = 0, ts5 = 0, ts6 = 0, ts7 = 0, ts8 = 0, ts9 = 0, ts10 = 0, ts11 = 0;
#define STAMP(k) ts##k = __builtin_amdgcn_s_memrealtime()
#else
#define STAMP(k) do { } while (0)
#endif
    STAMP(0);
#ifndef REPEAT_PHASE
#define REPEAT_PHASE -1
#define REPEAT_N 1
#endif
#define PHASE(k) if (lo <= (k) && (k) < hi) for (int rep_ = 0; rep_ < ((k) == REPEAT_PHASE ? REPEAT_N : 1); ++rep_)
#define SEAM(k) do { if (lo <= (k) && (k) + 1 < hi) xcd_barrier(xbar); } while (0)
    PHASE(0) phase0(P);
    SEAM(0); STAMP(1);
    PHASE(1) { pg8::EpiBf16<0> E; E.O = (bf16_t*)(ws + WS_P); E.ldc = NPAD; E.bias = nullptr; E.split_cols = 0; E.split_stride = 0;
        run_gemm(lds, (const bf16_t*)(ws + WS_H0B), (const bf16_t*)(ws + WS_WTIN), MROWS, NPAD, 2048, E); }
    SEAM(1); STAMP(2);
    PHASE(2) phase2(P, lds);
    SEAM(2); STAMP(3);
    PHASE(3) phase3(P);
    SEAM(3); STAMP(4);
    PHASE(4) phase3b(P, lds);
    SEAM(4); STAMP(5);
    PHASE(5) {
        { pg8::EpiGate35 E; E.O = (bf16_t*)(ws + WS_MERGED); E.p = (const bf16_t*)(ws + WS_P); E.bgate = P.in[I_BGATE];
          run_gemm(lds, (const bf16_t*)(ws + WS_YAB), (const bf16_t*)(ws + WS_WTAB), NTOK, 2048, LDAB, E); }
    }
    SEAM(5); STAMP(6);
    PHASE(6) { pg8::EpiResidStats E; E.O = (bf16_t*)(ws + WS_X1B); E.h0 = (const bf16_t*)(ws + WS_H0B); E.alpha = DN_ALPHA; E.rsum = (float*)(ws + WS_STAT); E.rsq = (float*)(ws + WS_STAT) + 8192;
        run_gemm(lds, (const bf16_t*)(ws + WS_MERGED), (const bf16_t*)(ws + WS_WTOUT), NTOK, 2048, 2048, E); }
    SEAM(6); STAMP(7);
    PHASE(7) { pg8::EpiQ E; E.O = (bf16_t*)(ws + WS_Q); E.rsum = (const float*)(ws + WS_STAT); E.rsq = (const float*)(ws + WS_STAT) + 8192; E.c1 = (const float*)(ws + WS_STAT) + 16384; E.c2 = (const float*)(ws + WS_STAT) + 18432;
        run_gemm(lds, (const bf16_t*)(ws + WS_X1B), (const bf16_t*)(ws + WS_WTQ), NTOK, 2048, 2048, E); }
    SEAM(7); STAMP(8);
    PHASE(8) phase7(P, lds);
#ifdef DBG_TA
    {
        __threadfence_system(); asm volatile("s_waitcnt vmcnt(0) lgkmcnt(0)" ::: "memory"); __syncthreads(); grid.sync(); __threadfence_system();
        STAMP(11);
        const unsigned long long tt[12] = {ts0, ts1, ts2, ts3, ts4, ts5, ts6, ts7, ts8, ts8, ts8, ts11};
        const float ta = (float)(tt[DBG_TA + 1] - tt[DBG_TA]) * 0.01f, tb = (float)(tt[DBG_TB + 1] - tt[DBG_TB]) * 0.01f;
        if (blockIdx.x == 0) { for (int i = threadIdx.x + 1; i <= 1000000; i += 512) P.out[i] = tb; if (threadIdx.x == 0) P.out[0] = 1000.0f * ta; }
    }
#endif
#ifdef DBG_STOP
    {
        __threadfence_system(); asm volatile("s_waitcnt vmcnt(0) lgkmcnt(0)" ::: "memory"); __syncthreads(); grid.sync(); __threadfence_system();
        const size_t a = DBG_A, b = DBG_B; const unsigned* w = (const unsigned*)(ws + a); const size_t nw = (b - a) / 4, NO = (size_t)NTOK * D;
        for (size_t i = (size_t)blockIdx.x * 512 + threadIdx.x; i < NO; i += (size_t)gridDim.x * 512) {
            unsigned acc = 0; for (size_t j = i; j < nw; j += NO) { const unsigned x = w[j]; acc += (x & 0xffffu) + (x >> 16); }
            P.out[i] = (float)(acc & 0xfffffu);
        }
    }
#endif
#undef PHASE
#undef SEAM
}

extern "C" void kernel_launch(void* const* d_in, const int* in_sizes, int n_in, void* d_out, int out_size, void* d_ws, size_t ws_size, hipStream_t stream) {
    static int grid = 0;
    if (grid == 0) {
        if (n_in != 30 || out_size != NTOK * D || ws_size < WS_END) { fprintf(stderr, "kernel_launch: unexpected shapes (n_in %d, out %d, ws %zu < %zu)\n", n_in, out_size, ws_size, (size_t)WS_END); grid = -1; return; }
        int dev = 0, cus = 0, per_cu = 0;
        if (hipGetDevice(&dev) != hipSuccess || hipDeviceGetAttribute(&cus, hipDeviceAttributeMultiprocessorCount, dev) != hipSuccess) { grid = -1; return; }
        if (hipFuncSetAttribute((const void*)hybrid_fwd, hipFuncAttributeMaxDynamicSharedMemorySize, LDS_BYTES) != hipSuccess) { fprintf(stderr, "kernel_launch: hipFuncSetAttribute failed\n"); grid = -1; return; }
        if (hipOccupancyMaxActiveBlocksPerMultiprocessor(&per_cu, (const void*)hybrid_fwd, 512, LDS_BYTES) != hipSuccess || per_cu < 1) { fprintf(stderr, "kernel_launch: occupancy query says %d\n", per_cu); grid = -1; return; }
        (void)hipGetLastError();
        grid = cus;
    }
    if (grid < 0) return;
    if (hipMemsetAsync((unsigned char*)d_ws + WS_BAR, 0, 16384 + STAT_BYTES, stream) != hipSuccess) { fprintf(stderr, "kernel_launch: memset failed\n"); return; }
    Params p{};
    for (int i = 0; i < 30; ++i) p.in[i] = (const float*)d_in[i];
    p.out = (float*)d_out; p.ws = (unsigned char*)d_ws;
#if MK_MULTI
    for (int ph = 0; ph <= NPHASE; ++ph) { p.ph_lo = ph; p.ph_hi = ph + 1; hipLaunchKernelGGL(hybrid_fwd, dim3(grid), dim3(512), LDS_BYTES, stream, p); }
#else
    p.ph_lo = 0; p.ph_hi = NPHASE + 1;
#ifdef DBG_STOP
    p.ph_hi = DBG_STOP + 1;
#endif
    void* args[] = {&p};
    hipError_t e = hipLaunchCooperativeKernel((const void*)hybrid_fwd, dim3(grid), dim3(512), args, LDS_BYTES, stream);
    if (e != hipSuccess) fprintf(stderr, "kernel_launch: cooperative launch failed: %s (grid %d)\n", hipGetErrorString(e), grid);
#endif
}
```

```cpp
#include <hip/hip_runtime.h>
#include <hip/hip_cooperative_groups.h>
#include <cstdio>
#include <cstdint>
namespace cg = cooperative_groups;
namespace pg8 {
#define PG8_LAS __attribute__((address_space(3)))
typedef unsigned short bf16_t;
typedef short bf16x8 __attribute__((ext_vector_type(8)));
typedef float f32x4 __attribute__((ext_vector_type(4)));
typedef unsigned u32x4 __attribute__((ext_vector_type(4)));
constexpr int BM = 256, BK = 64, HALF = 128, HTB = HALF * BK * 2  , STAGE_BYTES = 8 * HTB, NXCD = 8, WGM = 8;

__host__ __device__ __forceinline__ int lds_byte(int r, int c) { const int st = (r >> 4) * 2 + (c >> 5), rr = r & 15, cc = c & 31, ob = rr * 64 + cc * 2; return st * 1024 + (ob ^ (((ob >> 9) & 1) << 5)); }
__host__ __device__ __forceinline__ void stage_rc(int b, int& R, int& C) { const int st = b / 1024, sb = b % 1024, swz = sb ^ (((sb >> 9) & 1) << 5); R = (st >> 1) * 16 + swz / 64; C = (st & 1) * 32 + (swz % 64) / 2; }
__host__ __device__ __forceinline__ int perm32(int rho) { const int n = rho >> 4, i = rho & 15; return 8 * (i >> 2) + 4 * n + (i & 3); }

struct Unit { int pm, pn; };
struct Gemm { const bf16_t* A; const bf16_t* Bt; int M, N, K; };

struct StaticOrder {
    int nM, nN, nwg, G, c;
    __host__ __device__ void init(int M, int N, int G_, int c_) { nM = M / BM; nN = N / BM; nwg = nM * nN; G = G_; c = c_; }
    __host__ __device__ bool next(int i, Unit& u) const {
        const long L = (long)i * G + c; if (L >= nwg) return false;
        int wgid = (int)L; { const int q = nwg / NXCD, r = nwg % NXCD, xcd = wgid % NXCD, off = wgid / NXCD; wgid = (xcd < r ? xcd * (q + 1) : r * (q + 1) + (xcd - r) * q) + off; }
        const int nig = WGM * nN, gid = wgid / nig, fm = gid * WGM, gsz = (nM - fm) < WGM ? (nM - fm) : WGM;
        u.pm = fm + ((wgid % nig) % gsz); u.pn = (wgid % nig) / gsz; return true;
    }
    __device__ __forceinline__ void a_ready(const Unit&) const {}
    __device__ __forceinline__ void done(const Unit&) const {}
};
struct CountedOrder : StaticOrder {
    const unsigned* ready; unsigned need; unsigned* tmo;
    __device__ __forceinline__ void a_ready(const Unit& u) const {
        if (threadIdx.x < 64) {
            const unsigned long long t0 = __builtin_amdgcn_s_memrealtime(); unsigned polls = 0;
            while ((unsigned)__builtin_amdgcn_readfirstlane(__hip_atomic_load(ready + 64 * u.pm, __ATOMIC_RELAXED, __HIP_MEMORY_SCOPE_AGENT)) < need) {
                if ((++polls & 255u) == 0u && __builtin_amdgcn_readfirstlane(__hip_atomic_load(tmo, __ATOMIC_RELAXED, __HIP_MEMORY_SCOPE_AGENT)) != 0u) break;
                if (__builtin_amdgcn_s_memrealtime() - t0 > 2000000ull) {
                    if (threadIdx.x == 0) { unsigned expect = 0u; __hip_atomic_compare_exchange_strong(tmo + 1, &expect, 0x600u | (unsigned)(u.pm & 0xff), __ATOMIC_RELAXED, __ATOMIC_RELAXED, __HIP_MEMORY_SCOPE_AGENT); __hip_atomic_store(tmo, 1u, __ATOMIC_RELAXED, __HIP_MEMORY_SCOPE_AGENT); }
                    break; }
                __builtin_amdgcn_s_sleep(2); }
            __builtin_amdgcn_fence(__ATOMIC_ACQUIRE, "agent");
            asm volatile("s_waitcnt vmcnt(0)" ::: "memory");
        }
#if !defined(BROKEN_HOOK_NO_BARRIER)
        asm volatile("" ::: "memory"); __builtin_amdgcn_s_barrier(); asm volatile("" ::: "memory");
#endif
    }
};

typedef float cvt_f32x2 __attribute__((ext_vector_type(2))); typedef __bf16 cvt_bf16x2 __attribute__((ext_vector_type(2)));
__device__ __forceinline__ unsigned cvt_pk_bf16(float lo, float hi) { const cvt_f32x2 v = {lo, hi}; const cvt_bf16x2 b = __builtin_convertvector(v, cvt_bf16x2); return __builtin_bit_cast(unsigned, b); }
typedef float f32x2 __attribute__((ext_vector_type(2)));
__device__ __forceinline__ f32x2 gelu_pk(f32x2 v) {
    const f32x2 av = __builtin_elementwise_abs(v), d = av * 0.2316418882f + 1.0f;
    f32x2 t; t.x = __builtin_amdgcn_rcpf(d.x); t.y = __builtin_amdgcn_rcpf(d.y);
    f32x2 q = t * 0.5307027145f + (-0.7265760135f); q = q * t + 0.7107068705f; q = q * t + (-0.142248368f); q = q * t + 0.127414796f; q = q * t;
    const f32x2 s = (v * v) * (-0.72134752044f);
    f32x2 e; e.x = __builtin_amdgcn_exp2f(s.x); e.y = __builtin_amdgcn_exp2f(s.y);
    const f32x2 m = v * (q * e), r = v - m;
    f32x2 o; o.x = v.x < 0.f ? m.x : r.x; o.y = v.y < 0.f ? m.y : r.y; return o;
}

struct EpiF32 {
    static constexpr bool PERM = false, AFTER_DRAIN = false; static constexpr int MID_T = -1;
    float* C; int ldc; const float* bias;
    __device__ __forceinline__ void operator()(const f32x4 (&acc)[2][2][4][2], const Unit& u, int wr, int wc, int fr, int fq) const {
        const int row0 = u.pm * BM + wr * 64 + fr, col0 = u.pn * BM + wc * 32 + 4 * fq;
        f32x4 bv[2][2];
#pragma unroll
        for (int bj = 0; bj < 2; ++bj)
#pragma unroll
            for (int n = 0; n < 2; ++n) bv[bj][n] = bias ? *(const f32x4*)(bias + col0 + bj * HALF + n * 16) : (f32x4){0.f, 0.f, 0.f, 0.f};
#pragma unroll
        for (int ai = 0; ai < 2; ++ai)
#pragma unroll
            for (int m = 0; m < 4; ++m) { float* rowp = C + (size_t)(row0 + ai * HALF + m * 16) * ldc + col0;
#pragma unroll
                for (int bj = 0; bj < 2; ++bj)
#pragma unroll
                    for (int n = 0; n < 2; ++n) *(f32x4*)(rowp + bj * HALF + n * 16) = acc[ai][bj][m][n] + bv[bj][n]; }
    }
};
template <int ACT  > struct EpiBf16 {
    static constexpr bool PERM = true, AFTER_DRAIN = false; static constexpr int MID_T = -1;
    bf16_t* O; int ldc; const float* bias; int split_cols; size_t split_stride;
    __device__ __forceinline__ void operator()(const f32x4 (&acc)[2][2][4][2], const Unit& u, int wr, int wc, int fr, int fq) const {
        const int row0 = u.pm * BM + wr * 64 + fr; int colt = u.pn * BM; bf16_t* base = O;
        if (split_cols) { const int t = colt / split_cols; base += (size_t)t * split_stride; colt -= t * split_cols; }
        const int col0 = colt + wc * 32 + 8 * fq, bcol0 = u.pn * BM + wc * 32 + 8 * fq;
        f32x4 bv[2][2];
#pragma unroll
        for (int bj = 0; bj < 2; ++bj)
#pragma unroll
            for (int n = 0; n < 2; ++n) bv[bj][n] = bias ? *(const f32x4*)(bias + bcol0 + bj * HALF + 4 * n) : (f32x4){0.f, 0.f, 0.f, 0.f};
#pragma unroll
        for (int ai = 0; ai < 2; ++ai)
#pragma unroll
            for (int m = 0; m < 4; ++m) { bf16_t* rowp = base + (size_t)(row0 + ai * HALF + m * 16) * ldc + col0;
#pragma unroll
                for (int bj = 0; bj < 2; ++bj) { f32x4 v0 = acc[ai][bj][m][0] + bv[bj][0], v1 = acc[ai][bj][m][1] + bv[bj][1];
                    if (ACT == 1) { f32x2 a = gelu_pk((f32x2){v0[0], v0[1]}), b = gelu_pk((f32x2){v0[2], v0[3]}), c = gelu_pk((f32x2){v1[0], v1[1]}), d = gelu_pk((f32x2){v1[2], v1[3]});
                        v0 = (f32x4){a.x, a.y, b.x, b.y}; v1 = (f32x4){c.x, c.y, d.x, d.y}; }
                    if (ACT == 2) {
#pragma unroll
                        for (int j = 0; j < 4; ++j) { v0[j] = 0.5f * v0[j] * (1.0f + erff(v0[j] * 0.70710678f)); v1[j] = 0.5f * v1[j] * (1.0f + erff(v1[j] * 0.70710678f)); } }
                    u32x4 w; w.x = cvt_pk_bf16(v0[0], v0[1]); w.y = cvt_pk_bf16(v0[2], v0[3]); w.z = cvt_pk_bf16(v1[0], v1[1]); w.w = cvt_pk_bf16(v1[2], v1[3]);
                    *(u32x4*)(rowp + bj * HALF) = w; } }
    }
};
template <class Epi, class Sched, bool STAMP = false>
__device__ __forceinline__ void gemm_phase(PG8_LAS unsigned char* lds, const Gemm g, const Sched& S, const Epi& E, unsigned long long* stamps) {
    const int tid = threadIdx.x, wid = __builtin_amdgcn_readfirstlane(tid >> 6), lane = tid & 63, wr = wid >> 2, wc = wid & 3, fr = lane & 15, fq = lane >> 4;
    const int K = g.K, nt = K / BK;
    int ts_lo = 0, ts_hi = 0, nts = 0; const unsigned long long rt_entry = STAMP ? (unsigned long long)wall_clock64() : 0ull;
#define PG8_STAMP() do { if (STAMP && wid == 0 && nts < 64) { const unsigned long long _c = (unsigned long long)clock64(); \
        ts_lo = (lane == nts) ? (int)(unsigned)_c : ts_lo; ts_hi = (lane == nts) ? (int)(unsigned)(_c >> 32) : ts_hi; ++nts; } } while (0)
    PG8_STAMP();
    unsigned voffA[2], voffB[2];
#pragma unroll
    for (int i = 0; i < 2; ++i) { int R, C; stage_rc(tid * 16 + i * 8192, R, C); const int Rb = Epi::PERM ? ((R & ~31) + perm32(R & 31)) : R;
        voffA[i] = (unsigned)(R * K + C) * 2u; voffB[i] = (unsigned)(Rb * K + C) * 2u; }
    const size_t kstep = (size_t)(BK * 2);
    const size_t hstep = (size_t)HALF * K * 2;
    const size_t tstep = 2 * hstep;
    const unsigned ldsw = (unsigned)wid * 1024u;
    const int aoff = lds_byte(wr * 64 + fr, fq * 8), boff = lds_byte(wc * 32 + fr, fq * 8);
#define PG8_SA(b, h) (((b) * 2 + (h)) * HTB)
#define PG8_SB(b, h) ((4 + (b) * 2 + (h)) * HTB)
#define PG8_STAGE(bufoff, gbase, voff) do { _Pragma("unroll") for (int _i = 0; _i < 2; ++_i) \
        __builtin_amdgcn_global_load_lds((const unsigned*)((const char*)(gbase) + (voff)[_i]), (PG8_LAS unsigned*)(lds + (bufoff) + ldsw + _i * 8192), 16, 0, 0); } while (0)
#define PG8_LDA(dst, b, h) do { _Pragma("unroll") for (int m = 0; m < 4; ++m) _Pragma("unroll") for (int k = 0; k < 2; ++k) dst[m][k] = *(const PG8_LAS bf16x8*)(lds + PG8_SA(b, h) + aoff + m * 2048 + k * 1024); } while (0)
#define PG8_LDB(dst, b, h) do { _Pragma("unroll") for (int n = 0; n < 2; ++n) _Pragma("unroll") for (int k = 0; k < 2; ++k) dst[n][k] = *(const PG8_LAS bf16x8*)(lds + PG8_SB(b, h) + boff + n * 2048 + k * 1024); } while (0)
#define PG8_MMA(ai, bj, At, Bt) do { __builtin_amdgcn_s_setprio(1); _Pragma("unroll") for (int m = 0; m < 4; ++m) _Pragma("unroll") for (int n = 0; n < 2; ++n) _Pragma("unroll") for (int k = 0; k < 2; ++k) \
        acc[ai][bj][m][n] = __builtin_amdgcn_mfma_f32_16x16x32_bf16(Bt[n][k], At[m][k], acc[ai][bj][m][n], 0, 0, 0); __builtin_amdgcn_s_setprio(0); } while (0)
#define PG8_WAIT_V(n) asm volatile("s_waitcnt vmcnt(" #n ")" ::: "memory")
#define PG8_WAIT_L(n) asm volatile("s_waitcnt lgkmcnt(" #n ")" ::: "memory")
#define PG8_BAR __builtin_amdgcn_s_barrier()
#define PG8_SCHED __builtin_amdgcn_sched_barrier(0)
    Unit cur, nxt; int ui = 0;
    if (!S.next(0, cur)) return;
    f32x4 acc[2][2][4][2];
#pragma unroll
    for (int a = 0; a < 2; ++a)
#pragma unroll
        for (int b = 0; b < 2; ++b)
#pragma unroll
            for (int m = 0; m < 4; ++m)
#pragma unroll
                for (int n = 0; n < 2; ++n) acc[a][b][m][n] = (f32x4){0.f, 0.f, 0.f, 0.f};
    bf16x8 At[4][2], B0[2][2], B1[2][2];
    const char* cA = (const char*)g.A + (size_t)cur.pm * tstep; const char* cB = (const char*)g.Bt + (size_t)cur.pn * tstep;
    S.a_ready(cur);
    PG8_STAGE(PG8_SB(0, 0), cB, voffB); PG8_STAGE(PG8_SA(0, 0), cA, voffA); PG8_STAGE(PG8_SB(0, 1), cB + hstep, voffB); PG8_STAGE(PG8_SA(0, 1), cA + hstep, voffA);
    if (wr == 1) PG8_BAR;
    PG8_WAIT_V(4); PG8_BAR;
    PG8_STAGE(PG8_SB(1, 0), cB + kstep, voffB); PG8_STAGE(PG8_SA(1, 0), cA + kstep, voffA); PG8_STAGE(PG8_SB(1, 1), cB + hstep + kstep, voffB);
    PG8_WAIT_V(6); PG8_BAR;
    PG8_STAMP();
    for (;;) {
        const bool has_next = S.next(ui + 1, nxt);
        const char* nA = has_next ? (const char*)g.A + (size_t)nxt.pm * tstep : cA; const char* nB = has_next ? (const char*)g.Bt + (size_t)nxt.pn * tstep : cB;
        for (int t = 0; t < nt; t += 2) {
            const bool last = (t == nt - 2);
            const char* a1 = cA + (size_t)(t + 1) * kstep;
            const char* a2 = last ? nA : cA + (size_t)(t + 2) * kstep; const char* b2 = last ? nB : cB + (size_t)(t + 2) * kstep;
            const char* a3 = a2 + kstep; const char* b3 = b2 + kstep;
            if (last && has_next) S.a_ready(nxt);
            if constexpr (Epi::MID_T >= 0) { if (t == Epi::MID_T) E.mid(acc, cur, wr, wc, fr, fq); }
            PG8_LDB(B0, 0, 0); PG8_SCHED; PG8_LDA(At, 0, 0); PG8_STAGE(PG8_SA(1, 1), a1 + hstep, voffA);
            PG8_WAIT_L(8); PG8_BAR; PG8_WAIT_L(0); PG8_MMA(0, 0, At, B0); PG8_BAR; PG8_SCHED;
            PG8_LDB(B1, 0, 1); PG8_STAGE(PG8_SB(0, 0), b2, voffB);
            PG8_BAR; PG8_WAIT_L(0); PG8_MMA(0, 1, At, B1); PG8_BAR;
            PG8_LDA(At, 0, 1); PG8_STAGE(PG8_SA(0, 0), a2, voffA);
            PG8_BAR; PG8_WAIT_L(0); PG8_MMA(1, 0, At, B0); PG8_BAR; PG8_SCHED;
            PG8_STAGE(PG8_SB(0, 1), b2 + hstep, voffB);
            PG8_WAIT_V(6); PG8_BAR; PG8_MMA(1, 1, At, B1); PG8_BAR;
            PG8_LDB(B0, 1, 0); PG8_SCHED; PG8_LDA(At, 1, 0); PG8_STAGE(PG8_SA(0, 1), a2 + hstep, voffA);
            PG8_WAIT_L(8); PG8_BAR; PG8_WAIT_L(0); PG8_MMA(0, 0, At, B0); PG8_BAR; PG8_SCHED;
            PG8_LDB(B1, 1, 1); PG8_STAGE(PG8_SB(1, 0), b3, voffB);
            PG8_BAR; PG8_WAIT_L(0); PG8_MMA(0, 1, At, B1); PG8_BAR;
            PG8_LDA(At, 1, 1); PG8_STAGE(PG8_SA(1, 0), a3, voffA);
            PG8_BAR; PG8_WAIT_L(0); PG8_MMA(1, 0, At, B0); PG8_BAR; PG8_SCHED;
            PG8_STAGE(PG8_SB(1, 1), b3 + hstep, voffB);
            PG8_WAIT_V(6); PG8_BAR; PG8_MMA(1, 1, At, B1); PG8_BAR;
        }
        PG8_STAMP();
        if constexpr (!Epi::AFTER_DRAIN) { E(acc, cur, wr, wc, fr, fq); S.done(cur); }
        PG8_STAMP();
        if (!has_next) break;
#pragma unroll
        for (int a = 0; a < 2; ++a)
#pragma unroll
            for (int b = 0; b < 2; ++b)
#pragma unroll
                for (int m = 0; m < 4; ++m)
#pragma unroll
                    for (int n = 0; n < 2; ++n) acc[a][b][m][n] = (f32x4){0.f, 0.f, 0.f, 0.f};
        cur = nxt; cA = nA; cB = nB; ++ui;
    }
    PG8_WAIT_V(0);
    if (wr == 0) PG8_BAR;
    PG8_BAR;
    if constexpr (Epi::AFTER_DRAIN) { E.fused(acc, cur, wr, wc, fr, fq, lds, wid, lane); S.done(cur); }
    PG8_STAMP();
    if (STAMP && wid == 0) { stamps[lane] = lane < nts ? (((unsigned long long)(unsigned)ts_hi << 32) | (unsigned)ts_lo) : 0ull;
        if (lane == 62) stamps[62] = rt_entry; if (lane == 63) stamps[63] = (unsigned long long)wall_clock64(); }
#undef PG8_STAMP
#undef PG8_SA
#undef PG8_SB
#undef PG8_STAGE
#undef PG8_LDA
#undef PG8_LDB
#undef PG8_MMA
#undef PG8_WAIT_V
#undef PG8_WAIT_L
#undef PG8_BAR
#undef PG8_SCHED
}
}
#define LAS __attribute__((address_space(3)))
typedef unsigned short bf16_t;
typedef short bf16x8 __attribute__((ext_vector_type(8)));
typedef float f32x4 __attribute__((ext_vector_type(4)));
typedef float f32x2 __attribute__((ext_vector_type(2)));
typedef unsigned u32x4 __attribute__((ext_vector_type(4)));
typedef unsigned u32x2 __attribute__((ext_vector_type(2)));
typedef LAS unsigned char* ldsp;
typedef float f32x32 __attribute__((ext_vector_type(32)));
typedef float f32x16 __attribute__((ext_vector_type(16)));
typedef unsigned u32x6 __attribute__((ext_vector_type(6)));

constexpr int D = 2048, NTOK = 8192, SEQ = 4096, MROWS = 8448, ROW_META = 8192;
constexpr int INC = 11712, NPAD = 11776;
constexpr int C_R = 0, C_K = 2048, C_V = 4096, C_WL = 6144, C_AL = 6240, C_GL = 6336, C_POOL = 6592, C_G0 = 7616, C_G1 = 9664;
constexpr int NUNITS = 4128;
constexpr float DSCALE = 0.6065306597126334f;
constexpr float DN_ALPHA = 1.189207115002721f;
constexpr float GN_EPS = 64e-5f, LN_EPS = 1e-5f;

constexpr size_t WS_P = 0;
constexpr size_t WS_H0B = 198967296;
constexpr size_t WS_WTAB = WS_H0B + 34603008;
constexpr size_t WS_WTOUT = WS_WTAB + 12582912;
constexpr size_t WS_WTQ = WS_WTOUT + 8388608;
constexpr size_t WS_WTPOOL = WS_WTQ + 8388608;
constexpr size_t WS_WTW2 = WS_WTPOOL + 524288;
constexpr size_t WS_WTA2 = WS_WTW2 + 393216;
constexpr size_t WS_WTG2 = WS_WTA2 + 393216;
constexpr size_t WS_SUBK = WS_WTG2 + 1048576;
constexpr size_t WS_BONUS = WS_SUBK + 65536;
constexpr size_t WS_REGC = WS_BONUS + 1048576;
constexpr size_t WS_WTIN = WS_REGC;
constexpr size_t UNITB = (size_t)NUNITS * 4096 * 2;
constexpr size_t WS_G = WS_REGC;
constexpr size_t WS_H0T = WS_REGC + UNITB;
constexpr size_t WS_RT = WS_REGC + 2 * UNITB;
constexpr size_t WS_Y0 = WS_REGC + 3 * UNITB;
constexpr size_t WS_S0T = WS_REGC + 4 * UNITB;
constexpr size_t WS_YAB = WS_REGC;
constexpr int LDAB = 3072;
constexpr size_t WS_MERGED = WS_REGC + 2 * UNITB;
constexpr size_t WS_X1B = WS_REGC + 3 * UNITB;
constexpr size_t WS_Q = WS_REGC + UNITB;
constexpr size_t TROW = 1536;
constexpr size_t WS_VB = WS_REGC + 5 * UNITB;
constexpr size_t WS_GSIG = WS_VB + 16384 * TROW;
constexpr size_t WS_BAR = WS_GSIG + 4194304;
constexpr size_t WS_STAT = WS_BAR + 16384;
constexpr size_t STAT_BYTES = (8192 * 2 + 2048 * 2) * 4;
constexpr size_t WS_TSC = WS_STAT + STAT_BYTES;
constexpr size_t UROW = 1024;
constexpr size_t WS_UB = WS_TSC + 131072;
constexpr size_t WS_END = WS_UB + 16384 * UROW;
static_assert(WS_YAB + 50331648 <= WS_MERGED, "overlay");

constexpr int LDS_BYTES = 163840;
constexpr int NPHASE = 8;

struct Params {
    const float* in[30];
    float* out;
    unsigned char* ws;
    int ph_lo, ph_hi;
};
enum { I_X = 0, I_META, I_LNIN_G, I_LNIN_B, I_WIN, I_MU, I_W0, I_WW2, I_A0, I_WA2, I_WG2, I_KK, I_KA, I_RK, I_GNG, I_GNB, I_WPOOL, I_PSCALE, I_BGATE,
       I_WBA, I_WBB, I_WOUT, I_LN1G, I_LN1B, I_WQ, I_SUBK, I_UT, I_VT, I_LN2G, I_LN2B };

__device__ __forceinline__ unsigned pk2(float lo, float hi) { return pg8::cvt_pk_bf16(lo, hi); }
__device__ __forceinline__ float bflo(unsigned w) { return __uint_as_float(w << 16); }
__device__ __forceinline__ float bfhi(unsigned w) { return __uint_as_float(w & 0xffff0000u); }
__device__ __forceinline__ float bf1(bf16_t h) { return __uint_as_float(((unsigned)h) << 16); }
__device__ __forceinline__ bf16_t f2bf1(float f) { return (bf16_t)(pk2(f, f) & 0xffffu); }
__device__ __forceinline__ float wave_sum(float v) {
#pragma unroll
    for (int o = 1; o < 64; o <<= 1) v += __shfl_xor(v, o);
    return v;
}
__device__ __forceinline__ float sigmoidf_(float x) { return 1.0f / (1.0f + __expf(-x)); }
__device__ __forceinline__ f32x4 mfma16(bf16x8 a, bf16x8 b, f32x4 c) { return __builtin_amdgcn_mfma_f32_16x16x32_bf16(a, b, c, 0, 0, 0); }
__device__ __forceinline__ void unpack8(const u32x4 w, float* f) {
    f[0] = bflo(w.x); f[1] = bfhi(w.x); f[2] = bflo(w.y); f[3] = bfhi(w.y); f[4] = bflo(w.z); f[5] = bfhi(w.z); f[6] = bflo(w.w); f[7] = bfhi(w.w);
}
__device__ __forceinline__ u32x4 pack8(const float* f) { u32x4 w; w.x = pk2(f[0], f[1]); w.y = pk2(f[2], f[3]); w.z = pk2(f[4], f[5]); w.w = pk2(f[6], f[7]); return w; }
#define DPPF(v, ctrl) __builtin_bit_cast(float, __builtin_amdgcn_update_dpp(0, __builtin_bit_cast(int, (v)), (ctrl), 0xF, 0xF, true))
__device__ __forceinline__ float readlane_f(float v, int l) { return __builtin_bit_cast(float, __builtin_amdgcn_readlane(__builtin_bit_cast(int, v), l)); }
__device__ __forceinline__ float wave_sum_dpp(float v) {
    v += DPPF(v, 0xB1); v += DPPF(v, 0x4E); v += DPPF(v, 0x141); v += DPPF(v, 0x140);
    return (readlane_f(v, 0) + readlane_f(v, 16)) + (readlane_f(v, 32) + readlane_f(v, 48));
}
__device__ __forceinline__ float wave_max_dpp(float v) {
    v = fmaxf(v, DPPF(v, 0xB1)); v = fmaxf(v, DPPF(v, 0x4E)); v = fmaxf(v, DPPF(v, 0x141)); v = fmaxf(v, DPPF(v, 0x140));
    return fmaxf(fmaxf(readlane_f(v, 0), readlane_f(v, 16)), fmaxf(readlane_f(v, 32), readlane_f(v, 48)));
}
#define BLOCK_SYNC() __syncthreads()
#define XB_TMO      128
#define XB_XCNT(j)  (256  + 64 * (j))
#define XB_XSUB(j)  (1280 + 64 * (j))
#define XB_XGEN(j)  (2304 + 64 * (j))
#define XB_TOP      3328
#define XB_TOPGEN   3392
#define XCD_BAR_WORDS 3456
#define XB_SPIN_CAP (1u << 18)

__device__ __forceinline__ unsigned xb_ld(unsigned* p)              { return __hip_atomic_load(p, __ATOMIC_RELAXED, __HIP_MEMORY_SCOPE_AGENT); }
__device__ __forceinline__ unsigned xb_add(unsigned* p, unsigned v) { return __hip_atomic_fetch_add(p, v, __ATOMIC_RELAXED, __HIP_MEMORY_SCOPE_AGENT); }
__device__ __forceinline__ unsigned xb_xcc_id() { return (unsigned)__builtin_amdgcn_s_getreg((3 << 11) | 20) & 0xFu; }
#define XB_SPIN(cond, bar) do { unsigned _sp = 0; while (cond) { __builtin_amdgcn_s_sleep(1); \
    if ((++_sp & 255u) == 0u) { if (xb_ld(&(bar)[XB_TMO])) break; if (_sp > XB_SPIN_CAP) { atomicAdd(&(bar)[XB_TMO], 1u); break; } } } } while (0)

struct XcdBarrier {
    unsigned* bar; unsigned x;
    volatile LAS unsigned* st;
};

__device__ __forceinline__ XcdBarrier xcd_barrier_post(unsigned* bar, volatile LAS unsigned* st) {
    XcdBarrier b; b.bar = bar; b.x = xb_xcc_id(); b.st = st;
    if (threadIdx.x == 0) (void)xb_add(&bar[XB_XCNT(b.x)], 1u);
    return b;
}
__device__ __forceinline__ void xcd_barrier_complete(unsigned* bar, unsigned x, unsigned& nloc, unsigned& nx) {
    const unsigned G = gridDim.x * gridDim.y * gridDim.z;
    unsigned sum, cnt, mine, sp = 0u;
    for (;;) {
        sum = 0u; cnt = 0u; mine = 0u;
#pragma unroll
        for (unsigned j = 0; j < 16; ++j) { const unsigned c = xb_ld(&bar[XB_XCNT(j)]); sum += c; cnt += (c > 0u) ? 1u : 0u; mine = (j == x) ? c : mine; }
        if (sum == G) break;
        __builtin_amdgcn_s_sleep(1);
        if ((++sp & 255u) == 0u) { if (xb_ld(&bar[XB_TMO])) break; if (sp > XB_SPIN_CAP) { atomicAdd(&bar[XB_TMO], 1u); break; } }
    }
    nloc = mine > 0u ? mine : 1u; nx = cnt > 0u ? cnt : 1u;
}

__device__ __forceinline__ void xcd_barrier(const XcdBarrier& b) {
    asm volatile("s_waitcnt vmcnt(0)" ::: "memory");
    __syncthreads();
    if (threadIdx.x == 0) {
        unsigned* bar = b.bar;
        __builtin_amdgcn_s_waitcnt(0);
        unsigned nloc = b.st[0], nx = b.st[1];
        if (nloc == 0u) { xcd_barrier_complete(bar, b.x, nloc, nx); b.st[0] = nloc; b.st[1] = nx; }
        const unsigned old = xb_add(&bar[XB_XSUB(b.x)], 1u);
        const unsigned gen = old / nloc;
        if (old + 1u == (gen + 1u) * nloc) {
            __builtin_amdgcn_fence(__ATOMIC_RELEASE, "agent");
            asm volatile("s_waitcnt vmcnt(0)" ::: "memory");
            const unsigned og = xb_add(&bar[XB_TOP], 1u);
            const unsigned tg = og / nx;
            if (og + 1u == (tg + 1u) * nx) xb_add(&bar[XB_TOPGEN], 1u);
            else XB_SPIN(xb_ld(&bar[XB_TOPGEN]) == tg, bar);
            __builtin_amdgcn_fence(__ATOMIC_ACQUIRE, "agent");
            xb_add(&bar[XB_XGEN(b.x)], 1u);
            asm volatile("s_waitcnt vmcnt(0)" ::: "memory");
        } else {
            XB_SPIN(xb_ld(&bar[XB_XGEN(b.x)]) == gen, bar);
            __builtin_amdgcn_fence(__ATOMIC_ACQUIRE, "agent");
            asm volatile("s_waitcnt vmcnt(0)" ::: "memory");
        }
    }
    __syncthreads();
}

__device__ __forceinline__ void ln_row_bf16(const float* src, const float* g, const float* b, bf16_t* dst, int lane) {
    f32x4 v[8]; float s = 0.f;
#pragma unroll
    for (int j = 0; j < 8; ++j) { v[j] = ((const f32x4*)src)[lane + 64 * j]; s += (v[j].x + v[j].y) + (v[j].z + v[j].w); }
    const float mean = wave_sum(s) * (1.0f / D); float s2 = 0.f;
#pragma unroll
    for (int j = 0; j < 8; ++j) { v[j] = v[j] - mean; s2 += (v[j].x * v[j].x + v[j].y * v[j].y) + (v[j].z * v[j].z + v[j].w * v[j].w); }
    const float rstd = 1.0f / sqrtf(wave_sum(s2) * (1.0f / D) + LN_EPS);
#pragma unroll
    for (int j = 0; j < 8; ++j) {
        const f32x4 gg = ((const f32x4*)g)[lane + 64 * j], bb = ((const f32x4*)b)[lane + 64 * j];
        const f32x4 o = v[j] * rstd * gg + bb;
        u32x2 w; w.x = pk2(o.x, o.y); w.y = pk2(o.z, o.w);
        ((u32x2*)dst)[lane + 64 * j] = w;
    }
}
__device__ __forceinline__ void transpose_item(const float* W, int K, int N, int Npad, bf16_t* Wt, int item, int lane, int ldw = 0) {
    const int nblk = Npad >> 6, kb = item / nblk, nb = item - kb * nblk, n = nb * 64 + lane, k0 = kb * 32;
    float v[32];
    if (n < N) {
#pragma unroll
        for (int i = 0; i < 32; ++i) v[i] = W[(size_t)(k0 + i) * N + n];
    } else {
#pragma unroll
        for (int i = 0; i < 32; ++i) v[i] = 0.f;
    }
    u32x4* o = (u32x4*)(Wt + (size_t)n * (ldw ? ldw : K) + k0);
#pragma unroll
    for (int c = 0; c < 4; ++c) { u32x4 w; w.x = pk2(v[8 * c], v[8 * c + 1]); w.y = pk2(v[8 * c + 2], v[8 * c + 3]); w.z = pk2(v[8 * c + 4], v[8 * c + 5]); w.w = pk2(v[8 * c + 6], v[8 * c + 7]); o[c] = w; }
}
__device__ __forceinline__ void transpose_item_q(const float* W, const float* g, const float* b, bf16_t* Wt, float* c1, float* c2, int item, int lane) {
    const int kb = item >> 5, nb = item & 31, n = nb * 64 + lane, k0 = kb * 32;
    float v[32], s1 = 0.f, s2 = 0.f;
#pragma unroll
    for (int i = 0; i < 32; ++i) { const float w = W[(size_t)(k0 + i) * 2048 + n]; const float gw = g[k0 + i] * w; s1 += gw; s2 += b[k0 + i] * w; v[i] = gw; }
    u32x4* o = (u32x4*)(Wt + (size_t)n * 2048 + k0);
#pragma unroll
    for (int c = 0; c < 4; ++c) { u32x4 w; w.x = pk2(v[8 * c], v[8 * c + 1]); w.y = pk2(v[8 * c + 2], v[8 * c + 3]); w.z = pk2(v[8 * c + 4], v[8 * c + 5]); w.w = pk2(v[8 * c + 6], v[8 * c + 7]); o[c] = w; }
    atomicAdd(c1 + n, s1); atomicAdd(c2 + n, s2);
}
__device__ __forceinline__ void transpose_item64(const float* W, int K, int N, int Npad, bf16_t* Wt, int ldw, int item, int lane) {
    const int nblk = Npad >> 6, kb = item / nblk, nb = item - kb * nblk, n = nb * 64 + lane, k0 = kb * 64;
    float v[64];
    if (n < N) {
#pragma unroll
        for (int i = 0; i < 64; ++i) v[i] = W[(size_t)(k0 + i) * N + n];
    } else {
#pragma unroll
        for (int i = 0; i < 64; ++i) v[i] = 0.f;
    }
    u32x4* o = (u32x4*)(Wt + (size_t)n * ldw + k0);
#pragma unroll
    for (int c = 0; c < 8; ++c) { u32x4 w; w.x = pk2(v[8 * c], v[8 * c + 1]); w.y = pk2(v[8 * c + 2], v[8 * c + 3]); w.z = pk2(v[8 * c + 4], v[8 * c + 5]); w.w = pk2(v[8 * c + 6], v[8 * c + 7]); o[c] = w; }
}
__device__ __forceinline__ void phase0(const Params& P) {
    const int lane = threadIdx.x & 63, wave = threadIdx.x >> 6;
    const int gw = blockIdx.x * 8 + wave, NGW = gridDim.x * 8;
    unsigned char* ws = P.ws;
    constexpr int T_IN = 32 * 184, T_A = 32 * 32, T_B = 16 * 32, T_O = 32 * 32, T_Q = 64 * 32, T_POOL = 4 * 32, T_W2 = 3 * 32, T_A2 = 3 * 32, T_G2 = 8 * 32;
    constexpr int T_LN = MROWS, T_SK = 64;
    constexpr int NIT = T_IN + T_A + T_B + T_O + T_Q + T_POOL + T_W2 + T_A2 + T_G2 + T_LN + T_SK;
    for (int it = gw; it < NIT; it += NGW) {
        int r = it;
        if (r < T_IN) { transpose_item64(P.in[I_WIN], 2048, INC, NPAD, (bf16_t*)(ws + WS_WTIN), 2048, r, lane); continue; } r -= T_IN;
        if (r < T_A) { transpose_item64(P.in[I_WBA], 2048, 2048, 2048, (bf16_t*)(ws + WS_WTAB), LDAB, r, lane); continue; } r -= T_A;
        if (r < T_B) { transpose_item64(P.in[I_WBB], 1024, 2048, 2048, (bf16_t*)(ws + WS_WTAB) + 2048, LDAB, r, lane); continue; } r -= T_B;
        if (r < T_O) { transpose_item64(P.in[I_WOUT], 2048, 2048, 2048, (bf16_t*)(ws + WS_WTOUT), 2048, r, lane); continue; } r -= T_O;
        if (r < T_Q) { float* st = (float*)(ws + WS_STAT); transpose_item_q(P.in[I_WQ], P.in[I_LN1G], P.in[I_LN1B], (bf16_t*)(ws + WS_WTQ), st + 16384, st + 18432, r, lane); continue; } r -= T_Q;
        if (r < T_POOL) { const int g = r >> 5; transpose_item(P.in[I_WPOOL] + g * 65536, 256, 256, 256, (bf16_t*)(ws + WS_WTPOOL) + g * 65536, r & 31, lane); continue; } r -= T_POOL;
        if (r < T_W2) { transpose_item(P.in[I_WW2], 96, 2048, 2048, (bf16_t*)(ws + WS_WTW2), r, lane); continue; } r -= T_W2;
        if (r < T_A2) { transpose_item(P.in[I_WA2], 96, 2048, 2048, (bf16_t*)(ws + WS_WTA2), r, lane); continue; } r -= T_A2;
        if (r < T_G2) { transpose_item(P.in[I_WG2], 256, 2048, 2048, (bf16_t*)(ws + WS_WTG2), r, lane); continue; } r -= T_G2;
        if (r < T_LN) {
            bf16_t* dst = (bf16_t*)(ws + WS_H0B) + (size_t)r * D;
            if (r < NTOK) ln_row_bf16(P.in[I_X] + (size_t)r * D, P.in[I_LNIN_G], P.in[I_LNIN_B], dst, lane);
            else if (r < NTOK + 16) ln_row_bf16(P.in[I_META] + (size_t)(r - NTOK) * D, P.in[I_LNIN_G], P.in[I_LNIN_B], dst, lane);
            else {
#pragma unroll
                for (int j = 0; j < 8; ++j) ((u32x2*)dst)[lane + 64 * j] = (u32x2){0u, 0u};
            }
            continue;
        }
        r -= T_LN;
        {
            const float* s = P.in[I_SUBK] + r * 512 + lane * 8; float f[8];
#pragma unroll
            for (int i = 0; i < 8; ++i) f[i] = s[i];
            *(u32x4*)((bf16_t*)(ws + WS_SUBK) + r * 512 + lane * 8) = pack8(f);
        }
    }
}
namespace pg8 {
constexpr float LN_EPS_ = 1e-5f;
struct EpiGate35 {
    static constexpr bool PERM = false, AFTER_DRAIN = false; static constexpr int MID_T = 32;
    bf16_t* O; const bf16_t* p; const float* bgate;
    __device__ __forceinline__ void mid(f32x4 (&acc)[2][2][4][2], const Unit& u, int wr, int wc, int fr, int fq) const {
        asm volatile("" : "+v"(fr), "+v"(fq));
        const int row0 = u.pm * BM + wr * 64 + fr, col0 = u.pn * BM + wc * 32 + 4 * fq;
#pragma unroll
        for (int ai = 0; ai < 2; ++ai)
#pragma unroll
            for (int m = 0; m < 4; ++m) { const size_t row = (size_t)(row0 + ai * HALF + m * 16);
#pragma unroll
                for (int bj = 0; bj < 2; ++bj)
#pragma unroll
                    for (int n = 0; n < 2; ++n) { const int col = col0 + bj * HALF + n * 16;
                        const u32x2 p0 = *(const u32x2*)(p + row * NPAD + C_G0 + col), p1 = *(const u32x2*)(p + row * NPAD + C_G1 + col);
                        const f32x4 b0 = *(const f32x4*)(bgate + col), b1 = *(const f32x4*)(bgate + D + col);
                        f32x4 r;
                        r.x = (1.0f + __expf(-fmaxf(bflo(p1.x) + b1.x, -80.f))) * __builtin_amdgcn_rcpf(1.0f + __expf(-(bflo(p0.x) + b0.x)));
                        r.y = (1.0f + __expf(-fmaxf(bfhi(p1.x) + b1.y, -80.f))) * __builtin_amdgcn_rcpf(1.0f + __expf(-(bfhi(p0.x) + b0.y)));
                        r.z = (1.0f + __expf(-fmaxf(bflo(p1.y) + b1.z, -80.f))) * __builtin_amdgcn_rcpf(1.0f + __expf(-(bflo(p0.y) + b0.z)));
                        r.w = (1.0f + __expf(-fmaxf(bfhi(p1.y) + b1.w, -80.f))) * __builtin_amdgcn_rcpf(1.0f + __expf(-(bfhi(p0.y) + b0.w)));
                        acc[ai][bj][m][n] = acc[ai][bj][m][n] * r; }
                asm volatile("" ::: "memory"); }
    }
    __device__ __forceinline__ void operator()(const f32x4 (&acc)[2][2][4][2], const Unit& u, int wr, int wc, int fr, int fq) const {
        const int row0 = u.pm * BM + wr * 64 + fr, col0 = u.pn * BM + wc * 32 + 4 * fq;
#pragma unroll
        for (int ai = 0; ai < 2; ++ai)
#pragma unroll
            for (int m = 0; m < 4; ++m) { const size_t row = (size_t)(row0 + ai * HALF + m * 16);
#pragma unroll
                for (int bj = 0; bj < 2; ++bj)
#pragma unroll
                    for (int n = 0; n < 2; ++n) { const int col = col0 + bj * HALF + n * 16;
                        const u32x2 p1 = *(const u32x2*)(p + row * NPAD + C_G1 + col); const f32x4 b1 = *(const f32x4*)(bgate + D + col);
                        f32x4 g;
                        g.x = __builtin_amdgcn_rcpf(1.0f + __expf(-fmaxf(bflo(p1.x) + b1.x, -80.f))); g.y = __builtin_amdgcn_rcpf(1.0f + __expf(-fmaxf(bfhi(p1.x) + b1.y, -80.f)));
                        g.z = __builtin_amdgcn_rcpf(1.0f + __expf(-fmaxf(bflo(p1.y) + b1.z, -80.f))); g.w = __builtin_amdgcn_rcpf(1.0f + __expf(-fmaxf(bfhi(p1.y) + b1.w, -80.f)));
                        const f32x4 o = acc[ai][bj][m][n] * g;
                        u32x2 w; w.x = cvt_pk_bf16(o.x, o.y); w.y = cvt_pk_bf16(o.z, o.w);
                        *(u32x2*)(O + row * D + col) = w; } }
    }
};
struct EpiResidStats {
    static constexpr bool PERM = false, AFTER_DRAIN = false; static constexpr int MID_T = -1;
    bf16_t* O; const bf16_t* h0; float alpha; float* rsum; float* rsq;
    __device__ __forceinline__ void operator()(const f32x4 (&acc)[2][2][4][2], const Unit& u, int wr, int wc, int fr, int fq) const {
        const int row0 = u.pm * BM + wr * 64 + fr, col0 = u.pn * BM + wc * 32 + 4 * fq;
#pragma unroll
        for (int ai = 0; ai < 2; ++ai)
#pragma unroll
            for (int m = 0; m < 4; ++m) { const size_t row = (size_t)(row0 + ai * HALF + m * 16); float s = 0.f, q = 0.f;
#pragma unroll
                for (int bj = 0; bj < 2; ++bj)
#pragma unroll
                    for (int n = 0; n < 2; ++n) { const int col = col0 + bj * HALF + n * 16;
                        const u32x2 hw = *(const u32x2*)(h0 + row * D + col);
                        f32x4 hv; hv.x = bflo(hw.x); hv.y = bfhi(hw.x); hv.z = bflo(hw.y); hv.w = bfhi(hw.y);
                        const f32x4 x = hv * alpha + acc[ai][bj][m][n];
                        s += (x.x + x.y) + (x.z + x.w); q += (x.x * x.x + x.y * x.y) + (x.z * x.z + x.w * x.w);
                        u32x2 w; w.x = cvt_pk_bf16(x.x, x.y); w.y = cvt_pk_bf16(x.z, x.w);
                        *(u32x2*)(O + row * D + col) = w; }
                s += __shfl_xor(s, 16); s += __shfl_xor(s, 32); q += __shfl_xor(q, 16); q += __shfl_xor(q, 32);
                if (fq == 0) { atomicAdd(rsum + row, s); atomicAdd(rsq + row, q); } }
    }
};
struct EpiQ {
    static constexpr bool PERM = true, AFTER_DRAIN = false; static constexpr int MID_T = -1;
    bf16_t* O; const float* rsum; const float* rsq; const float* c1; const float* c2;
    __device__ __forceinline__ void operator()(const f32x4 (&acc)[2][2][4][2], const Unit& u, int wr, int wc, int fr, int fq) const {
        const int row0 = u.pm * BM + wr * 64 + fr, col0 = u.pn * BM + wc * 32 + 8 * fq;
        f32x4 k1[2][2], k2[2][2];
#pragma unroll
        for (int bj = 0; bj < 2; ++bj)
#pragma unroll
            for (int n = 0; n < 2; ++n) { k1[bj][n] = *(const f32x4*)(c1 + col0 + bj * HALF + 4 * n); k2[bj][n] = *(const f32x4*)(c2 + col0 + bj * HALF + 4 * n); }
#pragma unroll
        for (int ai = 0; ai < 2; ++ai)
#pragma unroll
            for (int m = 0; m < 4; ++m) { const int row = row0 + ai * HALF + m * 16;
                const float mean = rsum[row] * (1.0f / D), rstd = 1.0f / sqrtf(fmaxf(rsq[row] * (1.0f / D) - mean * mean, 0.f) + LN_EPS_);
                bf16_t* rowp = O + (size_t)row * D + col0;
#pragma unroll
                for (int bj = 0; bj < 2; ++bj) {
                    const f32x4 v0 = (acc[ai][bj][m][0] - k1[bj][0] * mean) * rstd + k2[bj][0], v1 = (acc[ai][bj][m][1] - k1[bj][1] * mean) * rstd + k2[bj][1];
                    u32x4 w; w.x = cvt_pk_bf16(v0[0], v0[1]); w.y = cvt_pk_bf16(v0[2], v0[3]); w.z = cvt_pk_bf16(v1[0], v1[1]); w.w = cvt_pk_bf16(v1[2], v1[3]);
                    *(u32x4*)(rowp + bj * HALF) = w; } }
    }
};
}
template <class Epi>
__device__ __forceinline__ void run_gemm(ldsp lds, const bf16_t* A, const bf16_t* Bt, int M, int N, int K, const Epi& E) {
    pg8::Gemm g; g.A = A; g.Bt = Bt; g.M = M; g.N = N; g.K = K;
    pg8::StaticOrder S; S.init(M, N, (int)gridDim.x, (int)blockIdx.x);
    pg8::gemm_phase<Epi, pg8::StaticOrder, false>(lds, g, S, E, nullptr);
}
constexpr int CONV_P2_ROWS = 0;
__device__ __forceinline__ void convert_tables(const Params& P, int r0, int rend, int stride) {
    const int lane = threadIdx.x & 63;
    unsigned char* ws = P.ws;
    for (int r = r0; r < rend; r += stride) {
        const float* src = (r < 16384 ? P.in[I_UT] : P.in[I_VT]) + (size_t)(r & 16383) * D;
        f32x4 v[8]; float am = 0.f;
#pragma unroll
        for (int j = 0; j < 8; ++j) { v[j] = ((const f32x4*)src)[lane + 64 * j]; am = fmaxf(am, fmaxf(fmaxf(fabsf(v[j].x), fabsf(v[j].y)), fmaxf(fabsf(v[j].z), fabsf(v[j].w)))); }
        am = wave_max_dpp(am);
        const float qmax = r < 16384 ? 6.0f : 7.5f;
        const float s = am > 0.f ? qmax / am : 1.0f;
        if (r < 16384) {
            unsigned w[4];
#pragma unroll
            for (int j = 0; j < 4; ++j) { unsigned t = 0;
                t = __builtin_amdgcn_cvt_scalef32_pk_fp4_f32(t, v[2 * j].x * s, v[2 * j].y * s, 1.0f, 0); t = __builtin_amdgcn_cvt_scalef32_pk_fp4_f32(t, v[2 * j].z * s, v[2 * j].w * s, 1.0f, 1);
                t = __builtin_amdgcn_cvt_scalef32_pk_fp4_f32(t, v[2 * j + 1].x * s, v[2 * j + 1].y * s, 1.0f, 2); t = __builtin_amdgcn_cvt_scalef32_pk_fp4_f32(t, v[2 * j + 1].z * s, v[2 * j + 1].w * s, 1.0f, 3);
                w[j] = t; }
            *(u32x4*)(ws + WS_UB + (size_t)r * UROW + lane * 16) = (u32x4){w[0], w[1], w[2], w[3]};
        } else {
            unsigned char* dst = ws + WS_VB + (size_t)(r & 16383) * TROW + lane * 24;
            f32x16 ev, od;
#pragma unroll
            for (int j = 0; j < 8; ++j) { ev[2 * j] = v[j].x * s; od[2 * j] = v[j].y * s; ev[2 * j + 1] = v[j].z * s; od[2 * j + 1] = v[j].w * s; }
            const u32x6 p6 = __builtin_amdgcn_cvt_scalef32_2xpk16_fp6_f32(ev, od, 1.0f);
            ((u32x2*)dst)[0] = (u32x2){p6[0], p6[1]}; ((u32x2*)dst)[1] = (u32x2){p6[2], p6[3]}; ((u32x2*)dst)[2] = (u32x2){p6[4], p6[5]};
        }
        if (lane == 0) ((float*)(ws + WS_TSC))[r] = am > 0.f ? am / qmax : 1.0f;
    }
}
constexpr int LD64 = 72, MATB = 64 * LD64 * 2, LDK = 104;
constexpr int O_AB = 0, O_RB = 1 * MATB, O_BH = 2 * MATB, O_KH = 3 * MATB, O_BTT = 4 * MATB, O_KTT = 5 * MATB, O_VT = 6 * MATB;
constexpr int O_M0 = 7 * MATB, O_M0T = 8 * MATB  , O_M1 = 9 * MATB, O_PA = 10 * MATB, O_PB = 11 * MATB, O_MAK = 12 * MATB, O_MRB = 13 * MATB, O_MRK = 14 * MATB;
constexpr int O_M1T = 0;
constexpr int LDKP = 96;
constexpr int O_WL = 15 * MATB, O_AL = O_WL + 64 * LDKP * 2;
constexpr int O_Z = 7 * MATB, O_AZ = O_Z + 64 * 68 * 4;
static_assert(O_AZ + 64 * 68 * 4 <= O_PB, "lds");
static_assert(O_AL + 64 * LDKP * 2 <= LDS_BYTES - 16, "lds");

__device__ __forceinline__ bf16x8 ldsfrag(ldsp lds, int off, int ld, int row, int kofs) { return *(const LAS bf16x8*)(lds + off + (row * ld + kofs) * 2); }
__device__ __forceinline__ void st4(ldsp lds, int off, int row, int col, const f32x4 v) {
    u32x2 w; w.x = pk2(v.x, v.y); w.y = pk2(v.z, v.w); *(LAS u32x2*)(lds + off + (row * LD64 + col) * 2) = w; }
__device__ __forceinline__ void st1(ldsp lds, int off, int row, int col, float v) { *(LAS bf16_t*)(lds + off + (row * LD64 + col) * 2) = f2bf1(v); }

__device__ __forceinline__ float fast_rcp(float x) { return __builtin_amdgcn_rcpf(x); }
__device__ __forceinline__ float fast_sigmoid(float x) { return fast_rcp(1.0f + __expf(-x)); }
__device__ __forceinline__ float fast_tanh(float x) { return 1.0f - 2.0f * fast_rcp(1.0f + __expf(2.0f * x)); }
__device__ __forceinline__ u32x4 ld8(const bf16_t* p) { return p ? *(const u32x4*)p : (u32x4){0u, 0u, 0u, 0u}; }
__device__ __forceinline__ void shift8r(const u32x4 cw, const u32x4 pw, const float* mu, float* x) {
    float c[8], q[8]; unpack8(cw, c); unpack8(pw, q);
    const f32x4 m0 = *(const f32x4*)mu, m1 = *(const f32x4*)(mu + 4);
    const float mm[8] = {m0.x, m0.y, m0.z, m0.w, m1.x, m1.y, m1.z, m1.w};
#pragma unroll
    for (int i = 0; i < 8; ++i) x[i] = c[i] + (q[i] - c[i]) * mm[i];
}
__device__ __forceinline__ int tcol(int row, int col) { return ((((col >> 3) ^ (row >> 3)) & 7) << 3) | (col & 7); }
__device__ __forceinline__ bf16x8 ldsfragT(ldsp lds, int off, int row, int kofs) { return *(const LAS bf16x8*)(lds + off + (row * LD64 + tcol(row, kofs)) * 2); }
__device__ __forceinline__ void st1T(ldsp lds, int off, int row, int col, float v) { *(LAS bf16_t*)(lds + off + (row * LD64 + tcol(row, col)) * 2) = f2bf1(v); }
typedef short s16x4 __attribute__((ext_vector_type(4)));
__device__ __forceinline__ bf16x8 ldsfragTR(ldsp lds, int off, int krow0, int col0, int lane) {
    const int g = lane >> 4, q = (lane & 15) >> 2, p = lane & 3;
    const LAS s16x4* a = (const LAS s16x4*)(lds + off + ((krow0 + 8 * g + q) * LD64 + col0) * 2 + 8 * p);
    const s16x4 v0 = __builtin_amdgcn_ds_read_tr16_b64_v4i16((LAS s16x4*)a), v1 = __builtin_amdgcn_ds_read_tr16_b64_v4i16((LAS s16x4*)(a + LD64));
    return (bf16x8){v0[0], v0[1], v0[2], v0[3], v1[0], v1[1], v1[2], v1[3]};
}
__device__ __forceinline__ void shift8(const bf16_t* pcur, const bf16_t* pprev, const float* mu, float* x) {
    float c[8], q[8];
    if (pcur) unpack8(*(const u32x4*)pcur, c); else {
#pragma unroll
        for (int i = 0; i < 8; ++i) c[i] = 0.f; }
    if (pprev) unpack8(*(const u32x4*)pprev, q); else {
#pragma unroll
        for (int i = 0; i < 8; ++i) q[i] = 0.f; }
    const f32x4 m0 = *(const f32x4*)mu, m1 = *(const f32x4*)(mu + 4);
    const float mm[8] = {m0.x, m0.y, m0.z, m0.w, m1.x, m1.y, m1.z, m1.w};
#pragma unroll
    for (int i = 0; i < 8; ++i) x[i] = c[i] + (q[i] - c[i]) * mm[i];
}

template <bool DO_P, bool DO_SQ>
__device__ __forceinline__ void dbl_step(ldsp lds, int sN, int sT, int dN, int dT, int pC, int pN, int tm, int tn0, int fr, int fq) {
    bf16x8 a[2];
#pragma unroll
    for (int ks = 0; ks < 2; ++ks) a[ks] = ldsfragTR(lds, sN, 32 * ks, 16 * tm, 16 * fq + fr);
#pragma unroll
    for (int t2 = 0; t2 < 2; ++t2) {
        const int nt = tn0 + t2, t = 16 * nt + fr, s0 = 16 * tm + 4 * fq;
        if (DO_P) {
            f32x4 acc = {0.f, 0.f, 0.f, 0.f};
#pragma unroll
            for (int ks = 0; ks < 2; ++ks) acc = mfma16(a[ks], ldsfrag(lds, pC, LD64, t, ks * 32 + fq * 8), acc);
            const u32x2 pw = *(const LAS u32x2*)(lds + pC + (t * LD64 + s0) * 2);
            acc.x += bflo(pw.x); acc.y += bfhi(pw.x); acc.z += bflo(pw.y); acc.w += bfhi(pw.y);
            st4(lds, pN, t, s0, acc);
        }
        if (DO_SQ) {
            f32x4 acc = {0.f, 0.f, 0.f, 0.f};
#pragma unroll
            for (int ks = 0; ks < 2; ++ks) acc = mfma16(a[ks], ldsfrag(lds, sN, LD64, t, ks * 32 + fq * 8), acc);
            st4(lds, dN, t, s0, acc);
        }
    }
}


#ifdef DBG_STAGE
constexpr size_t DBG_STRIDE = (size_t)NUNITS * 512 * 4;
__device__ __forceinline__ void dbgsum(const Params& P, ldsp lds, int u, int stage, const int* offs, int nmat) {
    unsigned acc = 0;
    for (int m = 0; m < nmat; ++m)
        for (int k = 0; k < 4; ++k) { const int idx = threadIdx.x + 512 * k, row = idx >> 5, cp = idx & 31; const unsigned x = *(const LAS unsigned*)(lds + offs[m] + row * (LD64 * 2) + cp * 4); acc += (x & 0xffffu) + (x >> 16); }
    ((unsigned*)(P.ws + WS_S0T + (size_t)stage * DBG_STRIDE))[(size_t)u * 512 + threadIdx.x] = acc;
}
#define DBGSUM(stage, ...) do { const int offs_[] = {__VA_ARGS__}; dbgsum(P, lds, u, stage, offs_, (int)(sizeof(offs_) / sizeof(int))); } while (0)
#else
#define DBGSUM(stage, ...) do { } while (0)
#endif
struct PL { u32x4 rc, rq, kc, kq, vc, vq; };
__device__ __forceinline__ const bf16_t* unit_rowp(const bf16_t* pp, int u, int tl, int col) {
    int r;
    if (u >= 4096) r = (tl >= 48) ? (ROW_META + tl - 48) : -1;
    else { const int bh = u >> 6, c = u & 63, b = bh >> 5; r = (tl >= 0 || c > 0) ? (b * SEQ + c * 64 + tl) : (ROW_META + 15); }
    return r < 0 ? (const bf16_t*)nullptr : pp + (size_t)r * NPAD + col;
}
__device__ __forceinline__ void pl_load(const Params& P, int u, PL& L) {
    int tid = threadIdx.x; asm volatile("" : "+v"(tid));
    const int lane = tid & 63, wave = tid >> 6, fr = lane & 15, fq = lane >> 4, tm = wave >> 1;
    const bf16_t* pp = (const bf16_t*)(P.ws + WS_P);
    const int h = (u >= 4096) ? (u - 4096) : ((u >> 6) & 31);
    const int t = tid >> 3, hj = h * 64 + 8 * (tid & 7);
    L.rc = ld8(unit_rowp(pp, u, t, C_R + hj)); L.rq = ld8(unit_rowp(pp, u, t - 1, C_R + hj));
    L.kc = ld8(unit_rowp(pp, u, t, C_K + hj)); L.kq = ld8(unit_rowp(pp, u, t - 1, C_K + hj));
    L.vc = ld8(unit_rowp(pp, u, t, C_V + hj)); L.vq = ld8(unit_rowp(pp, u, t - 1, C_V + hj));
}
__device__ __forceinline__ void rwkv_unit(const Params& P, ldsp lds, int u, PL& L, int next_u, bool stage_a) {
    int tid = threadIdx.x; asm volatile("" : "+v"(tid));
    const int lane = tid & 63, wave = tid >> 6, fr = lane & 15, fq = lane >> 4, tm = wave >> 1, tn0 = (wave & 1) * 2;
    unsigned char* ws = P.ws;
    const bf16_t* pp = (const bf16_t*)(ws + WS_P);
    const bool meta = u >= 4096;
    int b = 0, h, c = 0;
    if (meta) { h = u - 4096; } else { const int bh = u >> 6; c = u & 63; b = bh >> 5; h = bh & 31; }
    auto rowof = [&](int tl) -> int {
        if (meta) return (tl >= 48) ? (ROW_META + tl - 48) : -1;
        if (tl >= 0 || c > 0) return b * SEQ + c * 64 + tl;
        return ROW_META + 15;
    };
    auto rowp = [&](int tl, int col) -> const bf16_t* { const int r = rowof(tl); return r < 0 ? (const bf16_t*)nullptr : pp + (size_t)r * NPAD + col; };
    const float* mu = P.in[I_MU];
#ifndef RPT_AD
#define RPT_AD 1
#define RPT_E12 1
#define RPT_E35 1
#endif
    float lw[8], av[8], rv[8], kv[8], vv[8], kk[8], km[8];
    const int t = tid >> 3, jq = tid & 7, j0 = 8 * jq, hj = h * 64 + j0;
    const bool nulltok = meta && t < 48;
    for (int rpt_ = 0; rpt_ < RPT_AD; ++rpt_) {
    bf16x8 lAw[3], lAa[3];
    {
        const bf16_t* ww2 = (const bf16_t*)(ws + WS_WTW2) + (size_t)(h * 64 + 16 * tm + fr) * 96 + fq * 8;
        const bf16_t* wa2 = (const bf16_t*)(ws + WS_WTA2) + (size_t)(h * 64 + 16 * tm + fr) * 96 + fq * 8;
#pragma unroll
        for (int ks = 0; ks < 3; ++ks) { lAw[ks] = *(const bf16x8*)(ww2 + ks * 32); lAa[ks] = *(const bf16x8*)(wa2 + ks * 32); }
    }
    if (stage_a) {
        u32x4 cw[3], pw[3];
#pragma unroll
        for (int it = 0; it < 3; ++it) { const int idx = tid + 512 * it, mat = idx / 768, rem = idx - mat * 768, tt = rem / 12, ch = rem - tt * 12, col = (mat ? C_AL : C_WL) + ch * 8;
            cw[it] = ld8(rowp(tt, col)); pw[it] = ld8(rowp(tt - 1, col)); }
#pragma unroll
        for (int it = 0; it < 3; ++it) { const int idx = tid + 512 * it, mat = idx / 768, rem = idx - mat * 768, tt = rem / 12, ch = rem - tt * 12, col = (mat ? C_AL : C_WL) + ch * 8;
            float x[8]; shift8r(cw[it], pw[it], mu + col, x);
            if (mat == 0) {
#pragma unroll
                for (int i = 0; i < 8; ++i) x[i] = fast_tanh(x[i]);
            }
            *(LAS u32x4*)(lds + (mat ? O_AL : O_WL) + (tt * LDKP + ch * 8) * 2) = pack8(x); }
    }
    BLOCK_SYNC();
    {
        f32x4 z[2] = {{0.f, 0.f, 0.f, 0.f}, {0.f, 0.f, 0.f, 0.f}}, az[2] = {{0.f, 0.f, 0.f, 0.f}, {0.f, 0.f, 0.f, 0.f}};
#pragma unroll
        for (int ks = 0; ks < 3; ++ks) {
            const bf16x8 aw = lAw[ks], aa = lAa[ks];
#pragma unroll
            for (int t2 = 0; t2 < 2; ++t2) {
                const int t = 16 * (tn0 + t2) + fr;
                z[t2] = mfma16(aw, ldsfrag(lds, O_WL, LDKP, t, ks * 32 + fq * 8), z[t2]);
                az[t2] = mfma16(aa, ldsfrag(lds, O_AL, LDKP, t, ks * 32 + fq * 8), az[t2]);
            }
        }
#pragma unroll
        for (int t2 = 0; t2 < 2; ++t2) {
            const int t = 16 * (tn0 + t2) + fr, j0 = 16 * tm + 4 * fq;
            *(LAS f32x4*)(lds + O_Z + (t * 68 + j0) * 4) = z[t2];
            *(LAS f32x4*)(lds + O_AZ + (t * 68 + j0) * 4) = az[t2];
        }
    }
    BLOCK_SYNC();
    float cs[8];
    {
        const f32x4 z0 = *(const LAS f32x4*)(lds + O_Z + (t * 68 + j0) * 4), z1 = *(const LAS f32x4*)(lds + O_Z + (t * 68 + j0 + 4) * 4);
        const f32x4 y0 = *(const LAS f32x4*)(lds + O_AZ + (t * 68 + j0) * 4), y1 = *(const LAS f32x4*)(lds + O_AZ + (t * 68 + j0 + 4) * 4);
        const float zz[8] = {z0.x, z0.y, z0.z, z0.w, z1.x, z1.y, z1.z, z1.w}, yy[8] = {y0.x, y0.y, y0.z, y0.w, y1.x, y1.y, y1.z, y1.w};
        const f32x4 w0a = *(const f32x4*)(P.in[I_W0] + hj), w0b = *(const f32x4*)(P.in[I_W0] + hj + 4), a0a = *(const f32x4*)(P.in[I_A0] + hj), a0b = *(const f32x4*)(P.in[I_A0] + hj + 4);
        const float w0[8] = {w0a.x, w0a.y, w0a.z, w0a.w, w0b.x, w0b.y, w0b.z, w0b.w}, a0[8] = {a0a.x, a0a.y, a0a.z, a0a.w, a0b.x, a0b.y, a0b.z, a0b.w};
#pragma unroll
        for (int i = 0; i < 8; ++i) { lw[i] = nulltok ? 0.f : -DSCALE * fast_sigmoid(w0[i] + zz[i]); av[i] = fast_sigmoid(a0[i] + yy[i]); cs[i] = lw[i]; }
#pragma unroll
        for (int d = 8; d < 64; d <<= 1) {
#pragma unroll
            for (int i = 0; i < 8; ++i) { const float o = __shfl_up(cs[i], d); cs[i] += (lane >= d) ? o : 0.f; }
        }
        if (lane >= 56) {
#pragma unroll
            for (int i = 0; i < 8; ++i) *(LAS float*)(lds + (wave < 4 ? O_BH : O_KH) + ((j0 + i) * LD64 + 64) * 2 + (wave & 3) * 4) = cs[i]; }
        shift8r(L.rc, L.rq, mu + C_R + hj, rv); shift8r(L.kc, L.kq, mu + C_K + hj, kv); shift8r(L.vc, L.vq, mu + C_V + hj, vv);
        if (nulltok) {
#pragma unroll
            for (int i = 0; i < 8; ++i) { rv[i] = 0.f; kv[i] = 0.f; vv[i] = 0.f; }
        }
        const f32x4 kka = *(const f32x4*)(P.in[I_KK] + hj), kkb = *(const f32x4*)(P.in[I_KK] + hj + 4), kaa = *(const f32x4*)(P.in[I_KA] + hj), kab = *(const f32x4*)(P.in[I_KA] + hj + 4);
        const f32x4 rka = *(const f32x4*)(P.in[I_RK] + hj), rkb = *(const f32x4*)(P.in[I_RK] + hj + 4);
        const float kkw[8] = {kka.x, kka.y, kka.z, kka.w, kkb.x, kkb.y, kkb.z, kkb.w}, kaw[8] = {kaa.x, kaa.y, kaa.z, kaa.w, kab.x, kab.y, kab.z, kab.w}, rkw[8] = {rka.x, rka.y, rka.z, rka.w, rkb.x, rkb.y, rkb.z, rkb.w};
        float n2 = 0.f, bon = 0.f;
#pragma unroll
        for (int i = 0; i < 8; ++i) { kk[i] = kv[i] * kkw[i]; n2 += kk[i] * kk[i]; km[i] = kv[i] * (1.0f + (av[i] - 1.0f) * kaw[i]); bon += rv[i] * km[i] * rkw[i]; }
        n2 += DPPF(n2, 0xB1); n2 += DPPF(n2, 0x4E); n2 += DPPF(n2, 0x141);
        bon += DPPF(bon, 0xB1); bon += DPPF(bon, 0x4E); bon += DPPF(bon, 0x141);
        const float inv = 1.0f / fmaxf(sqrtf(n2), 1e-12f);
#pragma unroll
        for (int i = 0; i < 8; ++i) kk[i] *= inv;
        if (!meta && jq == 0) ((float*)(ws + WS_BONUS))[(size_t)(b * SEQ + c * 64 + t) * 32 + h] = bon;
    }
    BLOCK_SYNC();
    {
        float Lc[8], Le[8];
#pragma unroll
        for (int i = 0; i < 8; ++i) { Lc[i] = cs[i]; Le[i] = 0.f; }
#pragma unroll
        for (int i = 0; i < 8; ++i) {
            const f32x4 wa = *(const LAS f32x4*)(lds + O_BH + ((j0 + i) * LD64 + 64) * 2), wb = *(const LAS f32x4*)(lds + O_KH + ((j0 + i) * LD64 + 64) * 2);
            const float ww[8] = {wa.x, wa.y, wa.z, wa.w, wb.x, wb.y, wb.z, wb.w};
#pragma unroll
            for (int w = 0; w < 8; ++w) { Le[i] += ww[w]; Lc[i] += (w < wave) ? ww[w] : 0.f; }
        }
        float Ab[8], Rb[8], Bh[8], Kh[8], Bt[8], Kt[8];
#pragma unroll
        for (int i = 0; i < 8; ++i) {
            const float eP = __expf(Lc[i] - lw[i]), eC = __expf(Lc[i]), eN = __expf(-Lc[i]), eE = __expf(Le[i] - Lc[i]);
            const float ka = kk[i] * av[i];
            Ab[i] = -kk[i] * eP; Rb[i] = rv[i] * eC; Bh[i] = ka * eN; Kh[i] = km[i] * eN; Bt[i] = ka * eE; Kt[i] = km[i] * eE;
        }
        *(LAS u32x4*)(lds + O_AB + (t * LD64 + j0) * 2) = pack8(Ab);
        *(LAS u32x4*)(lds + O_RB + (t * LD64 + j0) * 2) = pack8(Rb);
        *(LAS u32x4*)(lds + O_BH + (t * LD64 + j0) * 2) = pack8(Bh);
        *(LAS u32x4*)(lds + O_KH + (t * LD64 + j0) * 2) = pack8(Kh);
        *(LAS u32x4*)(lds + O_BTT + (t * LD64 + j0) * 2) = pack8(Bt);
        *(LAS u32x4*)(lds + O_KTT + (t * LD64 + j0) * 2) = pack8(Kt);
        *(LAS u32x4*)(lds + O_VT + (t * LD64 + j0) * 2) = pack8(vv);
        if (t == 63) {
#pragma unroll
            for (int i = 0; i < 8; ++i) *(LAS float*)(lds + O_RB + ((j0 + i) * LD64 + 64) * 2) = __expf(Le[i]);
        }
    }
    BLOCK_SYNC();
    }
    if (next_u >= 0) pl_load(P, next_u, L);
    for (int rpt_ = 0; rpt_ < RPT_E12; ++rpt_) {
    {
        bf16x8 abh[2], akh[2];
#pragma unroll
        for (int ks = 0; ks < 2; ++ks) { abh[ks] = ldsfrag(lds, O_BH, LD64, 16 * tm + fr, ks * 32 + fq * 8); akh[ks] = ldsfrag(lds, O_KH, LD64, 16 * tm + fr, ks * 32 + fq * 8); }
#pragma unroll
        for (int t2 = 0; t2 < 2; ++t2) {
            const int tt = 16 * (tn0 + t2) + fr, s0 = 16 * tm + 4 * fq;
            f32x4 mab = {0.f, 0.f, 0.f, 0.f}, mak = mab, mrb = mab, mrk = mab;
#pragma unroll
            for (int ks = 0; ks < 2; ++ks) {
                const bf16x8 bab = ldsfrag(lds, O_AB, LD64, tt, ks * 32 + fq * 8), brb = ldsfrag(lds, O_RB, LD64, tt, ks * 32 + fq * 8);
                mab = mfma16(abh[ks], bab, mab); mak = mfma16(akh[ks], bab, mak); mrb = mfma16(abh[ks], brb, mrb); mrk = mfma16(akh[ks], brb, mrk);
            }
            float vab[4] = {mab.x, mab.y, mab.z, mab.w}, vak[4] = {mak.x, mak.y, mak.z, mak.w}, vrb[4] = {mrb.x, mrb.y, mrb.z, mrb.w}, vrk[4] = {mrk.x, mrk.y, mrk.z, mrk.w}, vp[4];
#pragma unroll
            for (int r = 0; r < 4; ++r) { const int s = s0 + r; const bool st = s < tt, le = s <= tt;
                vab[r] = st ? vab[r] : 0.f; vak[r] = st ? vak[r] : 0.f; vrb[r] = le ? vrb[r] : 0.f; vrk[r] = le ? vrk[r] : 0.f; vp[r] = vab[r] + (s == tt ? 1.0f : 0.f); }
            st4(lds, O_M0, tt, s0, (f32x4){vab[0], vab[1], vab[2], vab[3]});
            st4(lds, O_PA, tt, s0, (f32x4){vp[0], vp[1], vp[2], vp[3]});
            st4(lds, O_MAK, tt, s0, (f32x4){vak[0], vak[1], vak[2], vak[3]});
            st4(lds, O_MRB, tt, s0, (f32x4){vrb[0], vrb[1], vrb[2], vrb[3]});
            st4(lds, O_MRK, tt, s0, (f32x4){vrk[0], vrk[1], vrk[2], vrk[3]});
        }
    }
    BLOCK_SYNC();
    dbl_step<false, true>(lds, O_M0, O_M0T, O_M1, O_M1T, 0, 0, tm, tn0, fr, fq); BLOCK_SYNC();
    dbl_step<true, true>(lds, O_M1, O_M1T, O_M0, O_M0T, O_PA, O_PB, tm, tn0, fr, fq); BLOCK_SYNC();
    dbl_step<true, true>(lds, O_M0, O_M0T, O_M1, O_M1T, O_PB, O_PA, tm, tn0, fr, fq); BLOCK_SYNC();
    dbl_step<true, true>(lds, O_M1, O_M1T, O_M0, O_M0T, O_PA, O_PB, tm, tn0, fr, fq); BLOCK_SYNC();
    dbl_step<true, true>(lds, O_M0, O_M0T, O_M1, O_M1T, O_PB, O_PA, tm, tn0, fr, fq); BLOCK_SYNC();
    dbl_step<true, false>(lds, O_M1, O_M1T, 0, 0, O_PA, O_PB, tm, tn0, fr, fq); BLOCK_SYNC();
    }
    const size_t ub = (size_t)u * 4096;
    for (int rpt_ = 0; rpt_ < RPT_E35; ++rpt_) {
    {
        bf16x8 aT[2], aMak[2];
#pragma unroll
        for (int ks = 0; ks < 2; ++ks) { aT[ks] = ldsfrag(lds, O_PB, LD64, 16 * tm + fr, ks * 32 + fq * 8); aMak[ks] = ldsfrag(lds, O_MAK, LD64, 16 * tm + fr, ks * 32 + fq * 8); }
#pragma unroll
        for (int t2 = 0; t2 < 2; ++t2) {
            const int n = 16 * (tn0 + t2) + fr, t0 = 16 * tm + 4 * fq;
            f32x4 at = {0.f, 0.f, 0.f, 0.f}, xt = at;
#pragma unroll
            for (int ks = 0; ks < 2; ++ks) { at = mfma16(aT[ks], ldsfragTR(lds, O_AB, 32 * ks, 16 * (tn0 + t2), 16 * fq + fr), at); xt = mfma16(aMak[ks], ldsfragTR(lds, O_VT, 32 * ks, 16 * (tn0 + t2), 16 * fq + fr), xt); }
            st4(lds, O_M0, n, t0, at); st4(lds, O_M0T, n, t0, xt);
        }
    }
    BLOCK_SYNC();
    {
        bf16x8 aT[2], aAt[2];
#pragma unroll
        for (int ks = 0; ks < 2; ++ks) { aT[ks] = ldsfrag(lds, O_PB, LD64, 16 * tm + fr, ks * 32 + fq * 8); aAt[ks] = ldsfrag(lds, O_M0, LD64, 16 * tm + fr, ks * 32 + fq * 8); }
        bf16_t* Rt = (bf16_t*)(ws + WS_RT) + ub; bf16_t* Gp = (bf16_t*)(ws + WS_G) + ub;
#pragma unroll
        for (int t2 = 0; t2 < 2; ++t2) {
            const int n = 16 * (tn0 + t2) + fr, m0 = 16 * tm + 4 * fq;
            f32x4 u0 = {0.f, 0.f, 0.f, 0.f}, rt = u0, g = u0;
#pragma unroll
            for (int ks = 0; ks < 2; ++ks) {
                u0 = mfma16(aT[ks], ldsfrag(lds, O_M0T, LD64, n, ks * 32 + fq * 8), u0);
                rt = mfma16(aAt[ks], ldsfrag(lds, O_MRB, LD64, n, ks * 32 + fq * 8), rt);
                g = mfma16(aAt[ks], ldsfragTR(lds, O_BTT, 32 * ks, 16 * (tn0 + t2), 16 * fq + fr), g);
            }
            st4(lds, O_M1, n, m0, u0);
            const u32x2 rw = *(const LAS u32x2*)(lds + O_RB + (n * LD64 + m0) * 2);
            rt.x += bflo(rw.x); rt.y += bfhi(rw.x); rt.z += bflo(rw.y); rt.w += bfhi(rw.y);
            { u32x2 w; w.x = pk2(rt.x, rt.y); w.y = pk2(rt.z, rt.w); *(u32x2*)(Rt + n * 64 + m0) = w; }
            if ((n >> 2) == (m0 >> 2)) { const float e = *(const LAS float*)(lds + O_RB + (n * LD64 + 64) * 2); const int r = n & 3;
                g.x += (r == 0) ? e : 0.f; g.y += (r == 1) ? e : 0.f; g.z += (r == 2) ? e : 0.f; g.w += (r == 3) ? e : 0.f; }
            { const int pos0 = 32 * (tm >> 1) + 8 * fq + 4 * (tm & 1); u32x2 w; w.x = pk2(g.x, g.y); w.y = pk2(g.z, g.w); *(u32x2*)(Gp + n * 64 + pos0) = w; }
        }
    }
    BLOCK_SYNC();
    {
        bf16x8 aB[2], aK[2], aU[2], aV[2];
#pragma unroll
        for (int ks = 0; ks < 2; ++ks) { const int row = 16 * tm + fr, ko = ks * 32 + fq * 8;
            aB[ks] = ldsfragTR(lds, O_BTT, 32 * ks, 16 * tm, 16 * fq + fr); aK[ks] = ldsfragTR(lds, O_KTT, 32 * ks, 16 * tm, 16 * fq + fr); aU[ks] = ldsfrag(lds, O_M1, LD64, row, ko); aV[ks] = ldsfragTR(lds, O_VT, 32 * ks, 16 * tm, 16 * fq + fr); }
        bf16_t* H0t = (bf16_t*)(ws + WS_H0T) + ub; bf16_t* Y0s = (bf16_t*)(ws + WS_Y0) + ub;
#pragma unroll
        for (int t2 = 0; t2 < 2; ++t2) {
            const int n = 16 * (tn0 + t2) + fr, m0 = 16 * tm + 4 * fq;
            f32x4 hh = {0.f, 0.f, 0.f, 0.f}, yy = hh;
#pragma unroll
            for (int ks = 0; ks < 2; ++ks) { const int ko = ks * 32 + fq * 8;
                const bf16x8 bU = ldsfrag(lds, O_M1, LD64, n, ko), bV = ldsfragTR(lds, O_VT, 32 * ks, 16 * (tn0 + t2), 16 * fq + fr), bRb = ldsfrag(lds, O_MRB, LD64, n, ko), bRk = ldsfrag(lds, O_MRK, LD64, n, ko);
                hh = mfma16(aB[ks], bU, hh); hh = mfma16(aK[ks], bV, hh);
                yy = mfma16(aU[ks], bRb, yy); yy = mfma16(aV[ks], bRk, yy); }
            { u32x2 w; w.x = pk2(hh.x, hh.y); w.y = pk2(hh.z, hh.w); *(u32x2*)(H0t + n * 64 + m0) = w; }
            { u32x2 w; w.x = pk2(yy.x, yy.y); w.y = pk2(yy.z, yy.w); *(u32x2*)(Y0s + n * 64 + m0) = w; }
        }
    }
    BLOCK_SYNC();
    }
}

constexpr int LDU = 264;
__device__ __forceinline__ void pool_unit(const Params& P, ldsp lds, int pu) {
    int tid = threadIdx.x; asm volatile("" : "+v"(tid));
    const int lane = tid & 63, wave = tid >> 6, fr = lane & 15, fq = lane >> 4;
    unsigned char* ws = P.ws;
    const bf16_t* pp = (const bf16_t*)(ws + WS_P);
    const int g = (pu < 256) ? (pu & 3) : 3 - (pu & 3), tt = pu >> 2, b = tt >> 6, ti0 = (tt & 63) * 64;
    constexpr int O_U = 0, O_PL = 79 * LDU * 2;
    for (int idx = tid; idx < 79 * 32; idx += 512) {
        const int lr = idx >> 5, ch = idx & 31, ti = ti0 + lr - 15;
        const int row = ti >= 0 ? b * SEQ + ti : ROW_META + 16 + ti;
        *(LAS u32x4*)(lds + O_U + (lr * LDU + ch * 8) * 2) = *(const u32x4*)(pp + (size_t)row * NPAD + C_POOL + g * 256 + ch * 8);
    }
    BLOCK_SYNC();
    {
        const int t = tid >> 3, cq = tid & 7, win = 2 << g; const float inv = 1.0f / (float)win;
#pragma unroll
        for (int cc = 0; cc < 4; ++cc) {
            const int c0 = cq * 32 + cc * 8; float s[8], own[8];
            unpack8(*(const LAS u32x4*)(lds + O_U + ((15 + t) * LDU + c0) * 2), own);
#pragma unroll
            for (int i = 0; i < 8; ++i) s[i] = own[i];
            for (int d = 1; d < win; ++d) { float x[8]; unpack8(*(const LAS u32x4*)(lds + O_U + ((15 + t - d) * LDU + c0) * 2), x);
#pragma unroll
                for (int i = 0; i < 8; ++i) s[i] += x[i]; }
#pragma unroll
            for (int i = 0; i < 8; ++i) s[i] = s[i] * inv - own[i];
            *(LAS u32x4*)(lds + O_PL + (t * LDU + c0) * 2) = pack8(s);
        }
    }
    BLOCK_SYNC();
    {
        const bf16_t* wt = (const bf16_t*)(ws + WS_WTPOOL) + (size_t)g * 65536;
        f32x4 acc[2][4];
#pragma unroll
        for (int a = 0; a < 2; ++a)
#pragma unroll
            for (int n = 0; n < 4; ++n) acc[a][n] = (f32x4){0.f, 0.f, 0.f, 0.f};
#pragma unroll 4
        for (int ks = 0; ks < 8; ++ks) {
            bf16x8 af[2];
#pragma unroll
            for (int a = 0; a < 2; ++a) af[a] = *(const bf16x8*)(wt + (size_t)(32 * wave + 16 * a + fr) * 256 + ks * 32 + fq * 8);
#pragma unroll
            for (int n = 0; n < 4; ++n) { const bf16x8 bf = ldsfrag(lds, O_PL, LDU, 16 * n + fr, ks * 32 + fq * 8);
#pragma unroll
                for (int a = 0; a < 2; ++a) acc[a][n] = mfma16(af[a], bf, acc[a][n]); }
        }
        bf16_t* yb = (bf16_t*)(ws + WS_YAB) + 2048;
        const float* psc = P.in[I_PSCALE] + g * 256;
#pragma unroll
        for (int a = 0; a < 2; ++a) { const int d0 = 32 * wave + 16 * a + 4 * fq; const f32x4 sc = *(const f32x4*)(psc + d0);
#pragma unroll
            for (int n = 0; n < 4; ++n) { const int t = 16 * n + fr; const f32x4 o = acc[a][n] * sc;
                u32x2 w; w.x = pk2(o.x, o.y); w.y = pk2(o.z, o.w);
                *(u32x2*)(yb + (size_t)(b * SEQ + ti0 + t) * LDAB + g * 256 + d0) = w; } }
    }
    BLOCK_SYNC();
}
__device__ __forceinline__ void gsig_unit(const Params& P, int gu) {
    int tid = threadIdx.x; asm volatile("" : "+v"(tid));
    const bf16_t* pp = (const bf16_t*)(P.ws + WS_P); bf16_t* gs = (bf16_t*)(P.ws + WS_GSIG);
    const float* mu = P.in[I_MU];
#pragma unroll
    for (int it = 0; it < 4; ++it) {
        const int idx = tid + 512 * it, tl = idx >> 5, ch = idx & 31, col = C_GL + ch * 8;
        const int row = gu * 64 + tl; const int prow = ((row & (SEQ - 1)) == 0) ? (ROW_META + 15) : row - 1;
        float x[8]; shift8r(*(const u32x4*)(pp + (size_t)row * NPAD + col), *(const u32x4*)(pp + (size_t)prow * NPAD + col), mu + col, x);
#pragma unroll
        for (int i = 0; i < 8; ++i) x[i] = fast_sigmoid(x[i]);
        *(u32x4*)(gs + (size_t)row * 256 + ch * 8) = pack8(x);
    }
}
__device__ __forceinline__ void phase2(const Params& P, ldsp lds) {
    PL L;
    for (int j = blockIdx.x; j < 256 + 32 + 128; j += gridDim.x) {
        if (j < 256) {
            const int b = j >> 7, c = (j >> 1) & 63, h0 = (j & 1) * 16;
            pl_load(P, (b * 32 + h0) * 64 + c, L);
            for (int i = 0; i < 16; ++i) { const int u = (b * 32 + h0 + i) * 64 + c; rwkv_unit(P, lds, u, L, i + 1 < 16 ? u + 64 : -1, i == 0); }
        } else if (j < 288) { pl_load(P, 4096 + (j - 256), L); rwkv_unit(P, lds, 4096 + (j - 256), L, -1, true); }
        else gsig_unit(P, j - 288);
    }
}
__device__ __forceinline__ void phase3(const Params& P) {
    const int lane = threadIdx.x & 63, wave = threadIdx.x >> 6, fr = lane & 15, fq = lane >> 4;
    if (wave != 0) { convert_tables(P, CONV_P2_ROWS + blockIdx.x * 7 + (wave - 1), 32768, gridDim.x * 7); return; }
    unsigned char* ws = P.ws;
    const bf16_t* Gp = (const bf16_t*)(ws + WS_G); const bf16_t* H0t = (const bf16_t*)(ws + WS_H0T); bf16_t* S0t = (bf16_t*)(ws + WS_S0T);
    for (int item = blockIdx.x; item < 256; item += gridDim.x) {
        const int bh = item >> 2, vq = item & 3, h = bh & 31;
        bf16x8 Sb[2];
#pragma unroll
        for (int ks = 0; ks < 2; ++ks)
#pragma unroll
            for (int i = 0; i < 8; ++i) Sb[ks][i] = 0;
        bf16x8 g0[4][2], g1[4][2], g2[4][2], g3[4][2]; u32x2 h0[4], h1[4], h2[4], h3[4];
        auto load = [&](int step, bf16x8 (&ga)[4][2], u32x2 (&hf)[4]) {
            const int u = (step == 0) ? (4096 + h) : (bh * 64 + step - 1);
            const bf16_t* g = Gp + (size_t)u * 4096; const bf16_t* hh = H0t + (size_t)u * 4096;
#pragma unroll
            for (int mt = 0; mt < 4; ++mt) {
#pragma unroll
                for (int ks = 0; ks < 2; ++ks) ga[mt][ks] = *(const bf16x8*)(g + (16 * mt + fr) * 64 + ks * 32 + fq * 8);
                hf[mt] = *(const u32x2*)(hh + (16 * vq + fr) * 64 + 16 * mt + 4 * fq);
            }
        };
        auto apply = [&](int step, const bf16x8 (&ga)[4][2], const u32x2 (&hf)[4]) {
            f32x4 acc[4];
#pragma unroll
            for (int mt = 0; mt < 4; ++mt) {
                acc[mt] = (f32x4){bflo(hf[mt].x), bfhi(hf[mt].x), bflo(hf[mt].y), bfhi(hf[mt].y)};
                acc[mt] = mfma16(ga[mt][0], Sb[0], acc[mt]);
                acc[mt] = mfma16(ga[mt][1], Sb[1], acc[mt]);
            }
            bf16_t* so = S0t + (size_t)(bh * 64 + step) * 4096 + (16 * vq + fr) * 64 + 4 * fq;
            u32x2 w[4];
#pragma unroll
            for (int mt = 0; mt < 4; ++mt) { w[mt].x = pk2(acc[mt].x, acc[mt].y); w[mt].y = pk2(acc[mt].z, acc[mt].w); *(u32x2*)(so + 16 * mt) = w[mt]; }
#pragma unroll
            for (int ks = 0; ks < 2; ++ks) {
                const u32x4 q4 = (u32x4){w[2 * ks].x, w[2 * ks].y, w[2 * ks + 1].x, w[2 * ks + 1].y};
                Sb[ks] = __builtin_bit_cast(bf16x8, q4);
            }
        };
        load(0, g0, h0); load(1, g1, h1); load(2, g2, h2);
#pragma unroll 1
        for (int step = 0; step < 64; step += 4) {
            load(step + 3, g3, h3); apply(step, g0, h0);
            if (step + 4 < 64) load(step + 4, g0, h0);
            apply(step + 1, g1, h1);
            if (step + 5 < 64) load(step + 5, g1, h1);
            apply(step + 2, g2, h2);
            if (step + 6 < 64) load(step + 6, g2, h2);
            apply(step + 3, g3, h3);
        }
    }
}

constexpr int LDG = 264;
__device__ __forceinline__ void phase3b(const Params& P, ldsp lds) {
    int tid = threadIdx.x; asm volatile("" : "+v"(tid));
    const int lane = tid & 63, wave = tid >> 6, fr = lane & 15, fq = lane >> 4, wq = wave & 3;
    unsigned char* ws = P.ws;
    const bf16_t* pp = (const bf16_t*)(ws + WS_P);
    const float* mu = P.in[I_MU];
    constexpr int O_G2 = 0;
    for (int pu = blockIdx.x; pu < 512; pu += gridDim.x) pool_unit(P, lds, pu);
    for (int w = blockIdx.x; w < 256; w += gridDim.x) {
        const int h = w & 31;
        BLOCK_SYNC();
        for (int idx = tid; idx < 64 * 32; idx += 512) { const int row = idx >> 5, ch = idx & 31;
            *(LAS u32x4*)(lds + O_G2 + (row * LDG + ch * 8) * 2) = *(const u32x4*)((const bf16_t*)(ws + WS_WTG2) + (size_t)(h * 64 + row) * 256 + ch * 8); }
        BLOCK_SYNC();
        bf16x8 bG[8], bR[2], aS[4][2]; u32x2 yw[4], vc[4], vp[4]; float bon;
        auto unit_of = [&](int it, int& b, int& c) { const int q = (w >> 5) + 8 * (2 * it + (wave >> 2)); b = q >> 6; c = q & 63; };
        auto issue = [&](int it) {
            int b, c; unit_of(it, b, c); const int u = (b * 32 + h) * 64 + c, trow0 = b * SEQ + c * 64 + 16 * wq;
            const size_t ub = (size_t)u * 4096;
            const bf16_t* S0t = (const bf16_t*)(ws + WS_S0T) + ub; const bf16_t* Rt = (const bf16_t*)(ws + WS_RT) + ub; const bf16_t* Y0s = (const bf16_t*)(ws + WS_Y0) + ub;
            const int row = trow0 + fr; const int prow = (c == 0 && wq == 0 && fr == 0) ? (ROW_META + 15) : row - 1;
            const bf16_t* gsr = (const bf16_t*)(ws + WS_GSIG) + (size_t)row * 256 + fq * 8;
#pragma unroll
            for (int ks = 0; ks < 8; ++ks) bG[ks] = *(const bf16x8*)(gsr + ks * 32);
#pragma unroll
            for (int ks = 0; ks < 2; ++ks) bR[ks] = *(const bf16x8*)(Rt + (16 * wq + fr) * 64 + ks * 32 + fq * 8);
#pragma unroll
            for (int mt = 0; mt < 4; ++mt) {
                yw[mt] = *(const u32x2*)(Y0s + (16 * wq + fr) * 64 + 16 * mt + 4 * fq);
#pragma unroll
                for (int ks = 0; ks < 2; ++ks) aS[mt][ks] = *(const bf16x8*)(S0t + (16 * mt + fr) * 64 + ks * 32 + fq * 8);
                const int hc = h * 64 + 16 * mt + 4 * fq;
                vc[mt] = *(const u32x2*)(pp + (size_t)row * NPAD + C_V + hc); vp[mt] = *(const u32x2*)(pp + (size_t)prow * NPAD + C_V + hc);
            }
            bon = ((const float*)(ws + WS_BONUS))[(size_t)row * 32 + h];
        };
        issue(0);
#pragma unroll 1
        for (int it = 0; it < 8; ++it) {
            int b, c; unit_of(it, b, c);
            const int row = b * SEQ + c * 64 + 16 * wq + fr;
            f32x4 gacc[4];
#pragma unroll
            for (int mt = 0; mt < 4; ++mt) gacc[mt] = (f32x4){0.f, 0.f, 0.f, 0.f};
#pragma unroll
            for (int ks = 0; ks < 8; ++ks)
#pragma unroll
                for (int mt = 0; mt < 4; ++mt) gacc[mt] = mfma16(*(const LAS bf16x8*)(lds + O_G2 + ((16 * mt + fr) * LDG + ks * 32 + fq * 8) * 2), bG[ks], gacc[mt]);
            f32x4 y[4], vv[4]; const float bonc = bon;
#pragma unroll
            for (int mt = 0; mt < 4; ++mt) {
                y[mt] = (f32x4){bflo(yw[mt].x), bfhi(yw[mt].x), bflo(yw[mt].y), bfhi(yw[mt].y)};
#pragma unroll
                for (int ks = 0; ks < 2; ++ks) y[mt] = mfma16(aS[mt][ks], bR[ks], y[mt]);
                const f32x4 mv = *(const f32x4*)(mu + C_V + h * 64 + 16 * mt + 4 * fq);
                const f32x4 cv = (f32x4){bflo(vc[mt].x), bfhi(vc[mt].x), bflo(vc[mt].y), bfhi(vc[mt].y)}, pv = (f32x4){bflo(vp[mt].x), bfhi(vp[mt].x), bflo(vp[mt].y), bfhi(vp[mt].y)};
                vv[mt] = cv + (pv - cv) * mv;
            }
#pragma unroll
            for (int mt = 0; mt < 4; ++mt) asm volatile("" : "+v"(y[mt]), "+v"(vv[mt]), "+v"(gacc[mt]));
            if (it + 1 < 8) issue(it + 1);
            float s = 0.f;
#pragma unroll
            for (int mt = 0; mt < 4; ++mt) s += (y[mt].x + y[mt].y) + (y[mt].z + y[mt].w);
            s += __shfl_xor(s, 16); s += __shfl_xor(s, 32);
            const float mean = s * (1.0f / 64.0f); float qq = 0.f;
#pragma unroll
            for (int mt = 0; mt < 4; ++mt) { y[mt] = y[mt] - mean; qq += (y[mt].x * y[mt].x + y[mt].y * y[mt].y) + (y[mt].z * y[mt].z + y[mt].w * y[mt].w); }
            qq += __shfl_xor(qq, 16); qq += __shfl_xor(qq, 32);
            const float rstd = 1.0f / sqrtf(qq * (1.0f / 64.0f) + GN_EPS);
            bf16_t* ya = (bf16_t*)(ws + WS_YAB) + (size_t)row * LDAB + h * 64;
#pragma unroll
            for (int mt = 0; mt < 4; ++mt) {
                const int i0 = 16 * mt + 4 * fq, hc = h * 64 + i0;
                const f32x4 gg = *(const f32x4*)(P.in[I_GNG] + hc), gb = *(const f32x4*)(P.in[I_GNB] + hc);
                const f32x4 o = (y[mt] * rstd * gg + gb + vv[mt] * bonc) * gacc[mt];
                u32x2 wv; wv.x = pk2(o.x, o.y); wv.y = pk2(o.z, o.w);
                *(u32x2*)(ya + i0) = wv;
            }
        }
    }
}
__device__ __forceinline__ u32x6 ld_row6(const unsigned char* p) { const u32x2 a = ((const u32x2*)p)[0], b = ((const u32x2*)p)[1], c = ((const u32x2*)p)[2]; return (u32x6){a.x, a.y, b.x, b.y, c.x, c.y}; }
__device__ __forceinline__ void peer_token(const Params& P, int tok, const LAS int* eidx, const LAS float* gts) {
    const int lane = threadIdx.x & 63;
    unsigned char* ws = P.ws;
    const unsigned char* Ub = ws + WS_UB; const unsigned char* Vb = ws + WS_VB;
    const float* tsc = (const float*)(ws + WS_TSC);
    {
        int lo = lane; asm volatile("" : "+v"(lo));
        float x[32], o[32];
        {
            const bf16_t* hr = (const bf16_t*)(ws + WS_X1B) + (size_t)tok * D + lo * 4;
#pragma unroll
            for (int j = 0; j < 8; ++j) { const u32x2 w = *(const u32x2*)(hr + 256 * j); x[4 * j] = bflo(w.x); x[4 * j + 1] = bfhi(w.x); x[4 * j + 2] = bflo(w.y); x[4 * j + 3] = bfhi(w.y); }
            const float* st = (const float*)(ws + WS_STAT);
            const float mean1 = st[tok] * (1.0f / D), rstd1 = 1.0f / sqrtf(fmaxf(st[8192 + tok] * (1.0f / D) - mean1 * mean1, 0.f) + LN_EPS);
#pragma unroll
            for (int c = 0; c < 8; ++c) { const f32x4 g1 = *(const f32x4*)(P.in[I_LN1G] + lo * 4 + 256 * c), b1 = *(const f32x4*)(P.in[I_LN1B] + lo * 4 + 256 * c);
                x[4 * c] = (x[4 * c] - mean1) * rstd1 * g1.x + b1.x; x[4 * c + 1] = (x[4 * c + 1] - mean1) * rstd1 * g1.y + b1.y; x[4 * c + 2] = (x[4 * c + 2] - mean1) * rstd1 * g1.z + b1.z; x[4 * c + 3] = (x[4 * c + 3] - mean1) * rstd1 * g1.w + b1.w; }
#pragma unroll
            for (int i = 0; i < 32; ++i) o[i] = 0.f;
        }
        const int e_lo = eidx[lo], e_hi = eidx[64 + lo];
        const float su_lo = tsc[e_lo], su_hi = tsc[e_hi];
        const float gv_lo = gts[lo] * tsc[16384 + e_lo], gv_hi = gts[64 + lo] * tsc[16384 + e_hi];
        u32x4 ua[2], ub[2]; u32x6 va[2], vb[2];
        auto issue = [&](int g, u32x4 (&uu)[2], u32x6 (&vv)[2]) {
            const int ev = (g < 32) ? e_lo : e_hi;
#pragma unroll
            for (int j = 0; j < 2; ++j) {
                const int e = __builtin_amdgcn_readlane(ev, (2 * g + j) & 63);
                uu[j] = *(const u32x4*)(Ub + (size_t)e * UROW + lo * 16); vv[j] = ld_row6(Vb + (size_t)e * TROW + lo * 24);
            }
        };
        auto consume = [&](int g, const u32x4 (&uu)[2], const u32x6 (&vv)[2]) {
            const float suv = (g < 32) ? su_lo : su_hi, gvv = (g < 32) ? gv_lo : gv_hi;
            float dd[2];
#pragma unroll
            for (int j = 0; j < 2; ++j) { float s0 = 0.f, s1 = 0.f; const unsigned ww[4] = {uu[j].x, uu[j].y, uu[j].z, uu[j].w};
#pragma unroll
                for (int q4 = 0; q4 < 4; ++q4) {
                    const f32x2 r0 = __builtin_amdgcn_cvt_scalef32_pk_f32_fp4(ww[q4], 1.0f, 0), r1 = __builtin_amdgcn_cvt_scalef32_pk_f32_fp4(ww[q4], 1.0f, 1), r2 = __builtin_amdgcn_cvt_scalef32_pk_f32_fp4(ww[q4], 1.0f, 2), r3 = __builtin_amdgcn_cvt_scalef32_pk_f32_fp4(ww[q4], 1.0f, 3);
                    s0 += r0.x * x[8 * q4] + r1.x * x[8 * q4 + 2] + r2.x * x[8 * q4 + 4] + r3.x * x[8 * q4 + 6];
                    s1 += r0.y * x[8 * q4 + 1] + r1.y * x[8 * q4 + 3] + r2.y * x[8 * q4 + 5] + r3.y * x[8 * q4 + 7]; }
                dd[j] = s0 + s1; }
#pragma unroll
            for (int j = 0; j < 2; ++j) dd[j] = wave_sum_dpp(dd[j]);
            const int l0 = (2 * g) & 63;
            const pg8::f32x2 ge = pg8::gelu_pk((pg8::f32x2){dd[0] * readlane_f(suv, l0), dd[1] * readlane_f(suv, l0 + 1)});
            const float a0 = ge.x * readlane_f(gvv, l0), a1 = ge.y * readlane_f(gvv, l0 + 1);
            { const f32x32 r = __builtin_amdgcn_cvt_scalef32_pk32_f32_fp6(vv[0], 1.0f);
#pragma unroll
              for (int i = 0; i < 32; ++i) o[i] += a0 * r[i]; }
            { const f32x32 r = __builtin_amdgcn_cvt_scalef32_pk32_f32_fp6(vv[1], 1.0f);
#pragma unroll
              for (int i = 0; i < 32; ++i) o[i] += a1 * r[i]; }
        };
        issue(0, ua, va);
        for (int g = 0; g < 64; g += 2) {
            issue(g + 1, ub, vb);
            consume(g, ua, va);
            if (g + 2 < 64) issue(g + 2, ua, va);
            consume(g + 1, ub, vb);
        }
        float s = 0.f;
#pragma unroll
        for (int i = 0; i < 32; ++i) { o[i] += DN_ALPHA * x[i]; s += o[i]; }
        const float mean = wave_sum_dpp(s) * (1.0f / D); float q = 0.f;
#pragma unroll
        for (int i = 0; i < 32; ++i) { o[i] -= mean; q += o[i] * o[i]; }
        const float rstd = 1.0f / sqrtf(wave_sum_dpp(q) * (1.0f / D) + LN_EPS);
        float* orow = P.out + (size_t)tok * D;
#pragma unroll
        for (int c = 0; c < 8; ++c) {
            const int off = lo * 4 + 256 * c;
            const f32x4 g0 = *(const f32x4*)(P.in[I_LN2G] + off), b0 = *(const f32x4*)(P.in[I_LN2B] + off);
            f32x4 r0;
            r0.x = o[4 * c + 0] * rstd * g0.x + b0.x; r0.y = o[4 * c + 1] * rstd * g0.y + b0.y; r0.z = o[4 * c + 2] * rstd * g0.z + b0.z; r0.w = o[4 * c + 3] * rstd * g0.w + b0.w;
            *(f32x4*)(orow + off) = r0;
        }
    }
}
#define CE_DESC(a, b) do { const float h_ = fmaxf((a), (b)), l_ = fminf((a), (b)); (a) = h_; (b) = l_; } while (0)
template <int N> __device__ __forceinline__ void bitonic_sort_desc(float (&v)[N]) {
#pragma unroll
    for (int k = 2; k <= N; k <<= 1)
#pragma unroll
        for (int j = k >> 1; j > 0; j >>= 1)
#pragma unroll
            for (int i = 0; i < N; ++i) { const int l = i ^ j; if (l > i) { if ((i & k) == 0) CE_DESC(v[i], v[l]); else CE_DESC(v[l], v[i]); } }
}
template <int N> __device__ __forceinline__ void bitonic_merge_desc(float (&v)[N]) {
#pragma unroll
    for (int j = N >> 1; j > 0; j >>= 1)
#pragma unroll
        for (int i = 0; i < N; ++i) { const int l = i ^ j; if (l > i) CE_DESC(v[i], v[l]); }
}
__device__ __forceinline__ void top16_merge(float (&a)[16], const float (&brev)[16]) {
#pragma unroll
    for (int i = 0; i < 16; ++i) a[i] = fmaxf(a[i], brev[i]);
    bitonic_merge_desc<16>(a);
}
__device__ __forceinline__ float embed_bits(float v, unsigned code, unsigned mask) { return __uint_as_float((__float_as_uint(v) & ~mask) | code); }

__device__ __forceinline__ void phase7(const Params& P, ldsp lds) {
    const int tid0 = threadIdx.x;
    unsigned char* ws = P.ws;
    const bf16_t* qb = (const bf16_t*)(ws + WS_Q); const bf16_t* sk = (const bf16_t*)(ws + WS_SUBK);
    constexpr int LDSK = 136, O_SK = 0, O_SV = 2 * 128 * LDSK * 2, O_EX = O_SV + 32768, O_GT = O_EX + 16384;
    for (int idx = tid0; idx < 2 * 128 * 16; idx += 512) { const int row = idx >> 4, ch = idx & 15;
        *(LAS u32x4*)(lds + O_SK + (row * LDSK + ch * 8) * 2) = *(const u32x4*)(sk + row * 128 + ch * 8); }
    BLOCK_SYNC();
    for (int tile = blockIdx.x; tile < 256; tile += gridDim.x) {
        int tid = tid0; asm volatile("" : "+v"(tid));
        const int lane = tid & 63, wave = tid >> 6, fr = lane & 15, fq = lane >> 4, fro = fr, fqo = fq;
        const int tok0 = tile * 32, h = wave;
#pragma unroll 1
        for (int cb = 0; cb < 4; ++cb) {
            const int nt = cb >> 1, p = cb & 1;
            f32x4 acc[8];
#pragma unroll
            for (int mt = 0; mt < 8; ++mt) acc[mt] = (f32x4){0.f, 0.f, 0.f, 0.f};
            const bf16_t* qrow = qb + (size_t)(tok0 + 16 * nt + fro) * D + h * 256 + p * 128 + fqo * 8;
#pragma unroll
            for (int ks = 0; ks < 4; ++ks) {
                const bf16x8 bq = *(const bf16x8*)(qrow + ks * 32);
#pragma unroll
                for (int mt = 0; mt < 8; ++mt) acc[mt] = mfma16(*(const LAS bf16x8*)(lds + O_SK + ((p * 128 + 16 * mt + fro) * LDSK + ks * 32 + fqo * 8) * 2), bq, acc[mt]);
            }
            float a[16], b[16];
#pragma unroll
            for (int mt = 0; mt < 4; ++mt) {
                a[4 * mt + 0] = embed_bits(acc[mt].x, 16 * mt + 4 * fq + 0, 127u); a[4 * mt + 1] = embed_bits(acc[mt].y, 16 * mt + 4 * fq + 1, 127u);
                a[4 * mt + 2] = embed_bits(acc[mt].z, 16 * mt + 4 * fq + 2, 127u); a[4 * mt + 3] = embed_bits(acc[mt].w, 16 * mt + 4 * fq + 3, 127u);
                b[4 * mt + 0] = embed_bits(acc[mt + 4].x, 16 * (mt + 4) + 4 * fq + 0, 127u); b[4 * mt + 1] = embed_bits(acc[mt + 4].y, 16 * (mt + 4) + 4 * fq + 1, 127u);
                b[4 * mt + 2] = embed_bits(acc[mt + 4].z, 16 * (mt + 4) + 4 * fq + 2, 127u); b[4 * mt + 3] = embed_bits(acc[mt + 4].w, 16 * (mt + 4) + 4 * fq + 3, 127u);
            }
            bitonic_sort_desc<16>(a); bitonic_sort_desc<16>(b);
            { float br[16];
#pragma unroll
              for (int i = 0; i < 16; ++i) br[i] = b[15 - i];
              top16_merge(a, br); }
#pragma unroll
            for (int x = 16; x <= 32; x <<= 1) { float br[16];
#pragma unroll
                for (int i = 0; i < 16; ++i) br[i] = __shfl_xor(a[15 - i], x);
                top16_merge(a, br); }
            if (fq == 0) { LAS f32x4* o = (LAS f32x4*)(lds + O_SV + ((((16 * nt + fr) * 8 + h) * 2 + p) * 16) * 4);
                o[0] = (f32x4){a[0], a[1], a[2], a[3]}; o[1] = (f32x4){a[4], a[5], a[6], a[7]}; o[2] = (f32x4){a[8], a[9], a[10], a[11]}; o[3] = (f32x4){a[12], a[13], a[14], a[15]}; }
        }
        BLOCK_SYNC();
        if (tid < 256) {
            const int tok = tid >> 3, hh = tid & 7;
            const LAS f32x4* s = (const LAS f32x4*)(lds + O_SV + (((tok * 8 + hh) * 2) * 16) * 4);
            float s0[16], s1[16];
#pragma unroll
            for (int c4 = 0; c4 < 4; ++c4) { const f32x4 x = s[c4], y = s[4 + c4]; s0[4 * c4] = x.x; s0[4 * c4 + 1] = x.y; s0[4 * c4 + 2] = x.z; s0[4 * c4 + 3] = x.w; s1[4 * c4] = y.x; s1[4 * c4 + 1] = y.y; s1[4 * c4 + 2] = y.z; s1[4 * c4 + 3] = y.w; }
            float g0[16], g1[16], g2[16], g3[16];
            const float NEG = -3.0e38f;
#pragma unroll
            for (int bq = 0; bq < 16; ++bq) g0[bq] = embed_bits(s0[0] + s1[bq], bq, 255u);
            {
                int n1 = 0, n2 = 0, n3 = 0;
#pragma unroll
                for (int aa = 1; aa < 16; ++aa)
#pragma unroll
                    for (int bb = 0; bb < 16; ++bb) if ((aa + 1) * (bb + 1) <= 16) {
                        const float c = embed_bits(s0[aa] + s1[bb], aa * 16 + bb, 255u);
                        if (n1 < 16) g1[n1++] = c; else if (n2 < 16) g2[n2++] = c; else g3[n3++] = c;
                    }
#pragma unroll
                for (int i = 0; i < 16; ++i) if (i >= n3) g3[i] = NEG;
            }
            bitonic_sort_desc<16>(g1); bitonic_sort_desc<16>(g2); bitonic_sort_desc<16>(g3);
            { float r1[16], r3[16];
#pragma unroll
              for (int i = 0; i < 16; ++i) { r1[i] = g1[15 - i]; r3[i] = g3[15 - i]; }
              top16_merge(g0, r1); top16_merge(g2, r3);
#pragma unroll
              for (int i = 0; i < 16; ++i) g0[i] = fmaxf(g0[i], g2[15 - i]); }
            float mx = g0[0];
#pragma unroll
            for (int i = 1; i < 16; ++i) mx = fmaxf(mx, g0[i]);
            float ex[16], sm = 0.f; int ee[16];
#pragma unroll
            for (int i = 0; i < 16; ++i) {
                ex[i] = __expf(g0[i] - mx); sm += ex[i];
                const unsigned code = __float_as_uint(g0[i]) & 255u;
                const unsigned i0 = __float_as_uint(*(const LAS float*)(lds + O_SV + ((((tok * 8 + hh) * 2 + 0) * 16) + (code >> 4)) * 4)) & 127u;
                const unsigned i1 = __float_as_uint(*(const LAS float*)(lds + O_SV + ((((tok * 8 + hh) * 2 + 1) * 16) + (code & 15u)) * 4)) & 127u;
                ee[i] = (int)(i0 * 128u + i1);
            }
            const float inv = 1.0f / sm;
            LAS int* eo = (LAS int*)(lds + O_EX) + tok * 128 + hh * 16; LAS float* go = (LAS float*)(lds + O_GT) + tok * 128 + hh * 16;
#pragma unroll
            for (int c4 = 0; c4 < 4; ++c4) {
                *(LAS u32x4*)(eo + 4 * c4) = (u32x4){(unsigned)ee[4 * c4], (unsigned)ee[4 * c4 + 1], (unsigned)ee[4 * c4 + 2], (unsigned)ee[4 * c4 + 3]};
                *(LAS f32x4*)(go + 4 * c4) = (f32x4){ex[4 * c4] * inv, ex[4 * c4 + 1] * inv, ex[4 * c4 + 2] * inv, ex[4 * c4 + 3] * inv};
            }
        }
        BLOCK_SYNC();
#pragma unroll 1
        for (int i = 0; i < 4; ++i) peer_token(P, tok0 + wave * 4 + i, (const LAS int*)(lds + O_EX) + (wave * 4 + i) * 128, (const LAS float*)(lds + O_GT) + (wave * 4 + i) * 128);
        BLOCK_SYNC();
    }
}
#ifndef MK_MULTI
#define MK_MULTI 0
#endif
__global__ __launch_bounds__(512, 2) void hybrid_fwd(Params P) {
    extern __shared__ __attribute__((aligned(16))) unsigned char shm[];
    ldsp lds = (ldsp)shm;
    unsigned char* ws = P.ws;
    volatile LAS unsigned* xst = (volatile LAS unsigned*)(lds + LDS_BYTES - 16);
    if (threadIdx.x == 0) { xst[0] = 0u; xst[1] = 0u; }
    __syncthreads();
    const XcdBarrier xbar = xcd_barrier_post((unsigned*)(ws + WS_BAR), xst);
    const int lo = P.ph_lo, hi = P.ph_hi;
#ifdef DBG_TA
    unsigned long long ts0 = 0, ts1 = 0, ts2 = 0, ts3 = 0, ts4 = 0, ts5 = 0, ts6 = 0, ts7 = 0, ts8 = 0, ts9 = 0, ts10 = 0, ts11 = 0;
#define STAMP(k) ts##k = __builtin_amdgcn_s_memrealtime()
#else
#define STAMP(k) do { } while (0)
#endif
    STAMP(0);
#ifndef REPEAT_PHASE
#define REPEAT_PHASE -1
#define REPEAT_N 1
#endif
#define PHASE(k) if (lo <= (k) && (k) < hi) for (int rep_ = 0; rep_ < ((k) == REPEAT_PHASE ? REPEAT_N : 1); ++rep_)
#define SEAM(k) do { if (lo <= (k) && (k) + 1 < hi) xcd_barrier(xbar); } while (0)
    PHASE(0) phase0(P);
    SEAM(0); STAMP(1);
    PHASE(1) { pg8::EpiBf16<0> E; E.O = (bf16_t*)(ws + WS_P); E.ldc = NPAD; E.bias = nullptr; E.split_cols = 0; E.split_stride = 0;
        run_gemm(lds, (const bf16_t*)(ws + WS_H0B), (const bf16_t*)(ws + WS_WTIN), MROWS, NPAD, 2048, E); }
    SEAM(1); STAMP(2);
    PHASE(2) phase2(P, lds);
    SEAM(2); STAMP(3);
    PHASE(3) phase3(P);
    SEAM(3); STAMP(4);
    PHASE(4) phase3b(P, lds);
    SEAM(4); STAMP(5);
    PHASE(5) {
        { pg8::EpiGate35 E; E.O = (bf16_t*)(ws + WS_MERGED); E.p = (const bf16_t*)(ws + WS_P); E.bgate = P.in[I_BGATE];
          run_gemm(lds, (const bf16_t*)(ws + WS_YAB), (const bf16_t*)(ws + WS_WTAB), NTOK, 2048, LDAB, E); }
    }
    SEAM(5); STAMP(6);
    PHASE(6) { pg8::EpiResidStats E; E.O = (bf16_t*)(ws + WS_X1B); E.h0 = (const bf16_t*)(ws + WS_H0B); E.alpha = DN_ALPHA; E.rsum = (float*)(ws + WS_STAT); E.rsq = (float*)(ws + WS_STAT) + 8192;
        run_gemm(lds, (const bf16_t*)(ws + WS_MERGED), (const bf16_t*)(ws + WS_WTOUT), NTOK, 2048, 2048, E); }
    SEAM(6); STAMP(7);
    PHASE(7) { pg8::EpiQ E; E.O = (bf16_t*)(ws + WS_Q); E.rsum = (const float*)(ws + WS_STAT); E.rsq = (const float*)(ws + WS_STAT) + 8192; E.c1 = (const float*)(ws + WS_STAT) + 16384; E.c2 = (const float*)(ws + WS_STAT) + 18432;
        run_gemm(lds, (const bf16_t*)(ws + WS_X1B), (const bf16_t*)(ws + WS_WTQ), NTOK, 2048, 2048, E); }
    SEAM(7); STAMP(8);
    PHASE(8) phase7(P, lds);
#ifdef DBG_TA
    {
        __threadfence_system(); asm volatile("s_waitcnt vmcnt(0) lgkmcnt(0)" ::: "memory"); __syncthreads(); grid.sync(); __threadfence_system();
        STAMP(11);
        const unsigned long long tt[12] = {ts0, ts1, ts2, ts3, ts4, ts5, ts6, ts7, ts8, ts8, ts8, ts11};
        const float ta = (float)(tt[DBG_TA + 1] - tt[DBG_TA]) * 0.01f, tb = (float)(tt[DBG_TB + 1] - tt[DBG_TB]) * 0.01f;
        if (blockIdx.x == 0) { for (int i = threadIdx.x + 1; i <= 1000000; i += 512) P.out[i] = tb; if (threadIdx.x == 0) P.out[0] = 1000.0f * ta; }
    }
#endif
#ifdef DBG_STOP
    {
        __threadfence_system(); asm volatile("s_waitcnt vmcnt(0) lgkmcnt(0)" ::: "memory"); __syncthreads(); grid.sync(); __threadfence_system();
        const size_t a = DBG_A, b = DBG_B; const unsigned* w = (const unsigned*)(ws + a); const size_t nw = (b - a) / 4, NO = (size_t)NTOK * D;
        for (size_t i = (size_t)blockIdx.x * 512 + threadIdx.x; i < NO; i += (size_t)gridDim.x * 512) {
            unsigned acc = 0; for (size_t j = i; j < nw; j += NO) { const unsigned x = w[j]; acc += (x & 0xffffu) + (x >> 16); }
            P.out[i] = (float)(acc & 0xfffffu);
        }
    }
#endif
#undef PHASE
#undef SEAM
}

extern "C" void kernel_launch(void* const* d_in, const int* in_sizes, int n_in, void* d_out, int out_size, void* d_ws, size_t ws_size, hipStream_t stream) {
    static int grid = 0;
    if (grid == 0) {
        if (n_in != 30 || out_size != NTOK * D || ws_size < WS_END) { fprintf(stderr, "kernel_launch: unexpected shapes (n_in %d, out %d, ws %zu < %zu)\n", n_in, out_size, ws_size, (size_t)WS_END); grid = -1; return; }
        int dev = 0, cus = 0, per_cu = 0;
        if (hipGetDevice(&dev) != hipSuccess || hipDeviceGetAttribute(&cus, hipDeviceAttributeMultiprocessorCount, dev) != hipSuccess) { grid = -1; return; }
        if (hipFuncSetAttribute((const void*)hybrid_fwd, hipFuncAttributeMaxDynamicSharedMemorySize, LDS_BYTES) != hipSuccess) { fprintf(stderr, "kernel_launch: hipFuncSetAttribute failed\n"); grid = -1; return; }
        if (hipOccupancyMaxActiveBlocksPerMultiprocessor(&per_cu, (const void*)hybrid_fwd, 512, LDS_BYTES) != hipSuccess || per_cu < 1) { fprintf(stderr, "kernel_launch: occupancy query says %d\n", per_cu); grid = -1; return; }
        (void)hipGetLastError();
        grid = cus;
    }
    if (grid < 0) return;
    if (hipMemsetAsync((unsigned char*)d_ws + WS_BAR, 0, 16384 + STAT_BYTES, stream) != hipSuccess) { fprintf(stderr, "kernel_launch: memset failed\n"); return; }
    Params p{};
    for (int i = 0; i < 30; ++i) p.in[i] = (const float*)d_in[i];
    p.out = (float*)d_out; p.ws = (unsigned char*)d_ws;
#if MK_MULTI
    for (int ph = 0; ph <= NPHASE; ++ph) { p.ph_lo = ph; p.ph_hi = ph + 1; hipLaunchKernelGGL(hybrid_fwd, dim3(grid), dim3(512), LDS_BYTES, stream, p); }
#else
    p.ph_lo = 0; p.ph_hi = NPHASE + 1;
#ifdef DBG_STOP
    p.ph_hi = DBG_STOP + 1;
#endif
    void* args[] = {&p};
    hipError_t e = hipLaunchCooperativeKernel((const void*)hybrid_fwd, dim3(grid), dim3(512), args, LDS_BYTES, stream);
    if (e != hipSuccess) fprintf(stderr, "kernel_launch: cooperative launch failed: %s (grid %d)\n", hipGetErrorString(e), grid);
#endif
}
```

```cpp
#include <hip/hip_runtime.h>
#include <hip/hip_cooperative_groups.h>
#include <cstdio>
#include <cstdint>
namespace cg = cooperative_groups;
namespace pg8 {
#define PG8_LAS __attribute__((address_space(3)))
typedef unsigned short bf16_t;
typedef short bf16x8 __attribute__((ext_vector_type(8)));
typedef float f32x4 __attribute__((ext_vector_type(4)));
typedef unsigned u32x4 __attribute__((ext_vector_type(4)));
constexpr int BM = 256, BK = 64, HALF = 128, HTB = HALF * BK * 2  , STAGE_BYTES = 8 * HTB, NXCD = 8, WGM = 8;

__host__ __device__ __forceinline__ int lds_byte(int r, int c) { const int st = (r >> 4) * 2 + (c >> 5), rr = r & 15, cc = c & 31, ob = rr * 64 + cc * 2; return st * 1024 + (ob ^ (((ob >> 9) & 1) << 5)); }
__host__ __device__ __forceinline__ void stage_rc(int b, int& R, int& C) { const int st = b / 1024, sb = b % 1024, swz = sb ^ (((sb >> 9) & 1) << 5); R = (st >> 1) * 16 + swz / 64; C = (st & 1) * 32 + (swz % 64) / 2; }
__host__ __device__ __forceinline__ int perm32(int rho) { const int n = rho >> 4, i = rho & 15; return 8 * (i >> 2) + 4 * n + (i & 3); }

struct Unit { int pm, pn; };
struct Gemm { const bf16_t* A; const bf16_t* Bt; int M, N, K; };

struct StaticOrder {
    int nM, nN, nwg, G, c;
    __host__ __device__ void init(int M, int N, int G_, int c_) { nM = M / BM; nN = N / BM; nwg = nM * nN; G = G_; c = c_; }
    __host__ __device__ bool next(int i, Unit& u) const {
        const long L = (long)i * G + c; if (L >= nwg) return false;
        int wgid = (int)L; { const int q = nwg / NXCD, r = nwg % NXCD, xcd = wgid % NXCD, off = wgid / NXCD; wgid = (xcd < r ? xcd * (q + 1) : r * (q + 1) + (xcd - r) * q) + off; }
        const int nig = WGM * nN, gid = wgid / nig, fm = gid * WGM, gsz = (nM - fm) < WGM ? (nM - fm) : WGM;
        u.pm = fm + ((wgid % nig) % gsz); u.pn = (wgid % nig) / gsz; return true;
    }
    __device__ __forceinline__ void a_ready(const Unit&) const {}
    __device__ __forceinline__ void done(const Unit&) const {}
};
struct CountedOrder : StaticOrder {
    const unsigned* ready; unsigned need; unsigned* tmo;
    __device__ __forceinline__ void a_ready(const Unit& u) const {
        if (threadIdx.x < 64) {
            const unsigned long long t0 = __builtin_amdgcn_s_memrealtime(); unsigned polls = 0;
            while ((unsigned)__builtin_amdgcn_readfirstlane(__hip_atomic_load(ready + 64 * u.pm, __ATOMIC_RELAXED, __HIP_MEMORY_SCOPE_AGENT)) < need) {
                if ((++polls & 255u) == 0u && __builtin_amdgcn_readfirstlane(__hip_atomic_load(tmo, __ATOMIC_RELAXED, __HIP_MEMORY_SCOPE_AGENT)) != 0u) break;
                if (__builtin_amdgcn_s_memrealtime() - t0 > 2000000ull) {
                    if (threadIdx.x == 0) { unsigned expect = 0u; __hip_atomic_compare_exchange_strong(tmo + 1, &expect, 0x600u | (unsigned)(u.pm & 0xff), __ATOMIC_RELAXED, __ATOMIC_RELAXED, __HIP_MEMORY_SCOPE_AGENT); __hip_atomic_store(tmo, 1u, __ATOMIC_RELAXED, __HIP_MEMORY_SCOPE_AGENT); }
                    break; }
                __builtin_amdgcn_s_sleep(2); }
            __builtin_amdgcn_fence(__ATOMIC_ACQUIRE, "agent");
            asm volatile("s_waitcnt vmcnt(0)" ::: "memory");
        }
#if !defined(BROKEN_HOOK_NO_BARRIER)
        asm volatile("" ::: "memory"); __builtin_amdgcn_s_barrier(); asm volatile("" ::: "memory");
#endif
    }
};

typedef float cvt_f32x2 __attribute__((ext_vector_type(2))); typedef __bf16 cvt_bf16x2 __attribute__((ext_vector_type(2)));
__device__ __forceinline__ unsigned cvt_pk_bf16(float lo, float hi) { const cvt_f32x2 v = {lo, hi}; const cvt_bf16x2 b = __builtin_convertvector(v, cvt_bf16x2); return __builtin_bit_cast(unsigned, b); }
typedef float f32x2 __attribute__((ext_vector_type(2)));
__device__ __forceinline__ f32x2 gelu_pk(f32x2 v) {
    const f32x2 av = __builtin_elementwise_abs(v), d = av * 0.2316418882f + 1.0f;
    f32x2 t; t.x = __builtin_amdgcn_rcpf(d.x); t.y = __builtin_amdgcn_rcpf(d.y);
    f32x2 q = t * 0.5307027145f + (-0.7265760135f); q = q * t + 0.7107068705f; q = q * t + (-0.142248368f); q = q * t + 0.127414796f; q = q * t;
    const f32x2 s = (v * v) * (-0.72134752044f);
    f32x2 e; e.x = __builtin_amdgcn_exp2f(s.x); e.y = __builtin_amdgcn_exp2f(s.y);
    const f32x2 m = v * (q * e), r = v - m;
    f32x2 o; o.x = v.x < 0.f ? m.x : r.x; o.y = v.y < 0.f ? m.y : r.y; return o;
}

struct EpiF32 {
    static constexpr bool PERM = false, AFTER_DRAIN = false; static constexpr int MID_T = -1;
    float* C; int ldc; const float* bias;
    __device__ __forceinline__ void operator()(const f32x4 (&acc)[2][2][4][2], const Unit& u, int wr, int wc, int fr, int fq) const {
        const int row0 = u.pm * BM + wr * 64 + fr, col0 = u.pn * BM + wc * 32 + 4 * fq;
        f32x4 bv[2][2];
#pragma unroll
        for (int bj = 0; bj < 2; ++bj)
#pragma unroll
            for (int n = 0; n < 2; ++n) bv[bj][n] = bias ? *(const f32x4*)(bias + col0 + bj * HALF + n * 16) : (f32x4){0.f, 0.f, 0.f, 0.f};
#pragma unroll
        for (int ai = 0; ai < 2; ++ai)
#pragma unroll
            for (int m = 0; m < 4; ++m) { float* rowp = C + (size_t)(row0 + ai * HALF + m * 16) * ldc + col0;
#pragma unroll
                for (int bj = 0; bj < 2; ++bj)
#pragma unroll
                    for (int n = 0; n < 2; ++n) *(f32x4*)(rowp + bj * HALF + n * 16) = acc[ai][bj][m][n] + bv[bj][n]; }
    }
};
template <int ACT  > struct EpiBf16 {
    static constexpr bool PERM = true, AFTER_DRAIN = false; static constexpr int MID_T = -1;
    bf16_t* O; int ldc; const float* bias; int split_cols; size_t split_stride;
    __device__ __forceinline__ void operator()(const f32x4 (&acc)[2][2][4][2], const Unit& u, int wr, int wc, int fr, int fq) const {
        const int row0 = u.pm * BM + wr * 64 + fr; int colt = u.pn * BM; bf16_t* base = O;
        if (split_cols) { const int t = colt / split_cols; base += (size_t)t * split_stride; colt -= t * split_cols; }
        const int col0 = colt + wc * 32 + 8 * fq, bcol0 = u.pn * BM + wc * 32 + 8 * fq;
        f32x4 bv[2][2];
#pragma unroll
        for (int bj = 0; bj < 2; ++bj)
#pragma unroll
            for (int n = 0; n < 2; ++n) bv[bj][n] = bias ? *(const f32x4*)(bias + bcol0 + bj * HALF + 4 * n) : (f32x4){0.f, 0.f, 0.f, 0.f};
#pragma unroll
        for (int ai = 0; ai < 2; ++ai)
#pragma unroll
            for (int m = 0; m < 4; ++m) { bf16_t* rowp = base + (size_t)(row0 + ai * HALF + m * 16) * ldc + col0;
#pragma unroll
                for (int bj = 0; bj < 2; ++bj) { f32x4 v0 = acc[ai][bj][m][0] + bv[bj][0], v1 = acc[ai][bj][m][1] + bv[bj][1];
                    if (ACT == 1) { f32x2 a = gelu_pk((f32x2){v0[0], v0[1]}), b = gelu_pk((f32x2){v0[2], v0[3]}), c = gelu_pk((f32x2){v1[0], v1[1]}), d = gelu_pk((f32x2){v1[2], v1[3]});
                        v0 = (f32x4){a.x, a.y, b.x, b.y}; v1 = (f32x4){c.x, c.y, d.x, d.y}; }
                    if (ACT == 2) {
#pragma unroll
                        for (int j = 0; j < 4; ++j) { v0[j] = 0.5f * v0[j] * (1.0f + erff(v0[j] * 0.70710678f)); v1[j] = 0.5f * v1[j] * (1.0f + erff(v1[j] * 0.70710678f)); } }
                    u32x4 w; w.x = cvt_pk_bf16(v0[0], v0[1]); w.y = cvt_pk_bf16(v0[2], v0[3]); w.z = cvt_pk_bf16(v1[0], v1[1]); w.w = cvt_pk_bf16(v1[2], v1[3]);
                    *(u32x4*)(rowp + bj * HALF) = w; } }
    }
};
template <class Epi, class Sched, bool STAMP = false>
__device__ __forceinline__ void gemm_phase(PG8_LAS unsigned char* lds, const Gemm g, const Sched& S, const Epi& E, unsigned long long* stamps) {
    const int tid = threadIdx.x, wid = __builtin_amdgcn_readfirstlane(tid >> 6), lane = tid & 63, wr = wid >> 2, wc = wid & 3, fr = lane & 15, fq = lane >> 4;
    const int K = g.K, nt = K / BK;
    int ts_lo = 0, ts_hi = 0, nts = 0; const unsigned long long rt_entry = STAMP ? (unsigned long long)wall_clock64() : 0ull;
#define PG8_STAMP() do { if (STAMP && wid == 0 && nts < 64) { const unsigned long long _c = (unsigned long long)clock64(); \
        ts_lo = (lane == nts) ? (int)(unsigned)_c : ts_lo; ts_hi = (lane == nts) ? (int)(unsigned)(_c >> 32) : ts_hi; ++nts; } } while (0)
    PG8_STAMP();
    unsigned voffA[2], voffB[2];
#pragma unroll
    for (int i = 0; i < 2; ++i) { int R, C; stage_rc(tid * 16 + i * 8192, R, C); const int Rb = Epi::PERM ? ((R & ~31) + perm32(R & 31)) : R;
        voffA[i] = (unsigned)(R * K + C) * 2u; voffB[i] = (unsigned)(Rb * K + C) * 2u; }
    const size_t kstep = (size_t)(BK * 2);
    const size_t hstep = (size_t)HALF * K * 2;
    const size_t tstep = 2 * hstep;
    const unsigned ldsw = (unsigned)wid * 1024u;
    const int aoff = lds_byte(wr * 64 + fr, fq * 8), boff = lds_byte(wc * 32 + fr, fq * 8);
#define PG8_SA(b, h) (((b) * 2 + (h)) * HTB)
#define PG8_SB(b, h) ((4 + (b) * 2 + (h)) * HTB)
#define PG8_STAGE(bufoff, gbase, voff) do { _Pragma("unroll") for (int _i = 0; _i < 2; ++_i) \
        __builtin_amdgcn_global_load_lds((const unsigned*)((const char*)(gbase) + (voff)[_i]), (PG8_LAS unsigned*)(lds + (bufoff) + ldsw + _i * 8192), 16, 0, 0); } while (0)
#define PG8_LDA(dst, b, h) do { _Pragma("unroll") for (int m = 0; m < 4; ++m) _Pragma("unroll") for (int k = 0; k < 2; ++k) dst[m][k] = *(const PG8_LAS bf16x8*)(lds + PG8_SA(b, h) + aoff + m * 2048 + k * 1024); } while (0)
#define PG8_LDB(dst, b, h) do { _Pragma("unroll") for (int n = 0; n < 2; ++n) _Pragma("unroll") for (int k = 0; k < 2; ++k) dst[n][k] = *(const PG8_LAS bf16x8*)(lds + PG8_SB(b, h) + boff + n * 2048 + k * 1024); } while (0)
#define PG8_MMA(ai, bj, At, Bt) do { __builtin_amdgcn_s_setprio(1); _Pragma("unroll") for (int m = 0; m < 4; ++m) _Pragma("unroll") for (int n = 0; n < 2; ++n) _Pragma("unroll") for (int k = 0; k < 2; ++k) \
        acc[ai][bj][m][n] = __builtin_amdgcn_mfma_f32_16x16x32_bf16(Bt[n][k], At[m][k], acc[ai][bj][m][n], 0, 0, 0); __builtin_amdgcn_s_setprio(0); } while (0)
#define PG8_WAIT_V(n) asm volatile("s_waitcnt vmcnt(" #n ")" ::: "memory")
#define PG8_WAIT_L(n) asm volatile("s_waitcnt lgkmcnt(" #n ")" ::: "memory")
#define PG8_BAR __builtin_amdgcn_s_barrier()
#define PG8_SCHED __builtin_amdgcn_sched_barrier(0)
    Unit cur, nxt; int ui = 0;
    if (!S.next(0, cur)) return;
    f32x4 acc[2][2][4][2];
#pragma unroll
    for (int a = 0; a < 2; ++a)
#pragma unroll
        for (int b = 0; b < 2; ++b)
#pragma unroll
            for (int m = 0; m < 4; ++m)
#pragma unroll
                for (int n = 0; n < 2; ++n) acc[a][b][m][n] = (f32x4){0.f, 0.f, 0.f, 0.f};
    bf16x8 At[4][2], B0[2][2], B1[2][2];
    const char* cA = (const char*)g.A + (size_t)cur.pm * tstep; const char* cB = (const char*)g.Bt + (size_t)cur.pn * tstep;
    S.a_ready(cur);
    PG8_STAGE(PG8_SB(0, 0), cB, voffB); PG8_STAGE(PG8_SA(0, 0), cA, voffA); PG8_STAGE(PG8_SB(0, 1), cB + hstep, voffB); PG8_STAGE(PG8_SA(0, 1), cA + hstep, voffA);
    if (wr == 1) PG8_BAR;
    PG8_WAIT_V(4); PG8_BAR;
    PG8_STAGE(PG8_SB(1, 0), cB + kstep, voffB); PG8_STAGE(PG8_SA(1, 0), cA + kstep, voffA); PG8_STAGE(PG8_SB(1, 1), cB + hstep + kstep, voffB);
    PG8_WAIT_V(6); PG8_BAR;
    PG8_STAMP();
    for (;;) {
        const bool has_next = S.next(ui + 1, nxt);
        const char* nA = has_next ? (const char*)g.A + (size_t)nxt.pm * tstep : cA; const char* nB = has_next ? (const char*)g.Bt + (size_t)nxt.pn * tstep : cB;
        for (int t = 0; t < nt; t += 2) {
            const bool last = (t == nt - 2);
            const char* a1 = cA + (size_t)(t + 1) * kstep;
            const char* a2 = last ? nA : cA + (size_t)(t + 2) * kstep; const char* b2 = last ? nB : cB + (size_t)(t + 2) * kstep;
            const char* a3 = a2 + kstep; const char* b3 = b2 + kstep;
            if (last && has_next) S.a_ready(nxt);
            if constexpr (Epi::MID_T >= 0) { if (t == Epi::MID_T) E.mid(acc, cur, wr, wc, fr, fq); }
            PG8_LDB(B0, 0, 0); PG8_SCHED; PG8_LDA(At, 0, 0); PG8_STAGE(PG8_SA(1, 1), a1 + hstep, voffA);
            PG8_WAIT_L(8); PG8_BAR; PG8_WAIT_L(0); PG8_MMA(0, 0, At, B0); PG8_BAR; PG8_SCHED;
            PG8_LDB(B1, 0, 1); PG8_STAGE(PG8_SB(0, 0), b2, voffB);
            PG8_BAR; PG8_WAIT_L(0); PG8_MMA(0, 1, At, B1); PG8_BAR;
            PG8_LDA(At, 0, 1); PG8_STAGE(PG8_SA(0, 0), a2, voffA);
            PG8_BAR; PG8_WAIT_L(0); PG8_MMA(1, 0, At, B0); PG8_BAR; PG8_SCHED;
            PG8_STAGE(PG8_SB(0, 1), b2 + hstep, voffB);
            PG8_WAIT_V(6); PG8_BAR; PG8_MMA(1, 1, At, B1); PG8_BAR;
            PG8_LDB(B0, 1, 0); PG8_SCHED; PG8_LDA(At, 1, 0); PG8_STAGE(PG8_SA(0, 1), a2 + hstep, voffA);
            PG8_WAIT_L(8); PG8_BAR; PG8_WAIT_L(0); PG8_MMA(0, 0, At, B0); PG8_BAR; PG8_SCHED;
            PG8_LDB(B1, 1, 1); PG8_STAGE(PG8_SB(1, 0), b3, voffB);
            PG8_BAR; PG8_WAIT_L(0); PG8_MMA(0, 1, At, B1); PG8_BAR;
            PG8_LDA(At, 1, 1); PG8_STAGE(PG8_SA(1, 0), a3, voffA);
            PG8_BAR; PG8_WAIT_L(0); PG8_MMA(1, 0, At, B0); PG8_BAR; PG8_SCHED;
            PG8_STAGE(PG8_SB(1, 1), b3 + hstep, voffB);
            PG8_WAIT_V(6); PG8_BAR; PG8_MMA(1, 1, At, B1); PG8_BAR;
        }
        PG8_STAMP();
        if constexpr (!Epi::AFTER_DRAIN) { E(acc, cur, wr, wc, fr, fq); S.done(cur); }
        PG8_STAMP();
        if (!has_next) break;
#pragma unroll
        for (int a = 0; a < 2; ++a)
#pragma unroll
            for (int b = 0; b < 2; ++b)
#pragma unroll
                for (int m = 0; m < 4; ++m)
#pragma unroll
                    for (int n = 0; n < 2; ++n) acc[a][b][m][n] = (f32x4){0.f, 0.f, 0.f, 0.f};
        cur = nxt; cA = nA; cB = nB; ++ui;
    }
    PG8_WAIT_V(0);
    if (wr == 0) PG8_BAR;
    PG8_BAR;
    if constexpr (Epi::AFTER_DRAIN) { E.fused(acc, cur, wr, wc, fr, fq, lds, wid, lane); S.done(cur); }
    PG8_STAMP();
    if (STAMP && wid == 0) { stamps[lane] = lane < nts ? (((unsigned long long)(unsigned)ts_hi << 32) | (unsigned)ts_lo) : 0ull;
        if (lane == 62) stamps[62] = rt_entry; if (lane == 63) stamps[63] = (unsigned long long)wall_clock64(); }
#undef PG8_STAMP
#undef PG8_SA
#undef PG8_SB
#undef PG8_STAGE
#undef PG8_LDA
#undef PG8_LDB
#undef PG8_MMA
#undef PG8_WAIT_V
#undef PG8_WAIT_L
#undef PG8_BAR
#undef PG8_SCHED
}
}
#define LAS __attribute__((address_space(3)))
typedef unsigned short bf16_t;
typedef short bf16x8 __attribute__((ext_vector_type(8)));
typedef float f32x4 __attribute__((ext_vector_type(4)));
typedef float f32x2 __attribute__((ext_vector_type(2)));
typedef unsigned u32x4 __attribute__((ext_vector_type(4)));
typedef unsigned u32x2 __attribute__((ext_vector_type(2)));
typedef LAS unsigned char* ldsp;
typedef float f32x32 __attribute__((ext_vector_type(32)));
typedef float f32x16 __attribute__((ext_vector_type(16)));
typedef unsigned u32x6 __attribute__((ext_vector_type(6)));

constexpr int D = 2048, NTOK = 8192, SEQ = 4096, MROWS = 8448, ROW_META = 8192;
constexpr int INC = 11712, NPAD = 11776;
constexpr int C_R = 0, C_K = 2048, C_V = 4096, C_WL = 6144, C_AL = 6240, C_GL = 6336, C_POOL = 6592, C_G0 = 7616, C_G1 = 9664;
constexpr int NUNITS = 4128;
constexpr float DSCALE = 0.6065306597126334f;
constexpr float DN_ALPHA = 1.189207115002721f;
constexpr float GN_EPS = 64e-5f, LN_EPS = 1e-5f;

constexpr size_t WS_P = 0;
constexpr size_t WS_H0B = 198967296;
constexpr size_t WS_WTAB = WS_H0B + 34603008;
constexpr size_t WS_WTOUT = WS_WTAB + 12582912;
constexpr size_t WS_WTQ = WS_WTOUT + 8388608;
constexpr size_t WS_WTPOOL = WS_WTQ + 8388608;
constexpr size_t WS_WTW2 = WS_WTPOOL + 524288;
constexpr size_t WS_WTA2 = WS_WTW2 + 393216;
constexpr size_t WS_WTG2 = WS_WTA2 + 393216;
constexpr size_t WS_SUBK = WS_WTG2 + 1048576;
constexpr size_t WS_BONUS = WS_SUBK + 65536;
constexpr size_t WS_REGC = WS_BONUS + 1048576;
constexpr size_t WS_WTIN = WS_REGC;
constexpr size_t UNITB = (size_t)NUNITS * 4096 * 2;
constexpr size_t WS_G = WS_REGC;
constexpr size_t WS_H0T = WS_REGC + UNITB;
constexpr size_t WS_RT = WS_REGC + 2 * UNITB;
constexpr size_t WS_Y0 = WS_REGC + 3 * UNITB;
constexpr size_t WS_S0T = WS_REGC + 4 * UNITB;
constexpr size_t WS_YAB = WS_REGC;
constexpr int LDAB = 3072;
constexpr size_t WS_MERGED = WS_REGC + 2 * UNITB;
constexpr size_t WS_X1B = WS_REGC + 3 * UNITB;
constexpr size_t WS_Q = WS_REGC + UNITB;
constexpr size_t TROW = 1024;
constexpr size_t WS_VB = WS_REGC + 5 * UNITB;
constexpr size_t WS_GSIG = WS_VB + 16384 * TROW;
constexpr size_t WS_BAR = WS_GSIG + 4194304;
constexpr size_t WS_STAT = WS_BAR + 16384;
constexpr size_t STAT_BYTES = (8192 * 2 + 2048 * 2) * 4;
constexpr size_t WS_TSC = WS_STAT + STAT_BYTES;
constexpr size_t UROW = 1024;
constexpr size_t WS_UB = WS_TSC + 131072;
constexpr size_t WS_END = WS_UB + 16384 * UROW;
static_assert(WS_YAB + 50331648 <= WS_MERGED, "overlay");

constexpr int LDS_BYTES = 163840;
constexpr int NPHASE = 8;

struct Params {
    const float* in[30];
    float* out;
    unsigned char* ws;
    int ph_lo, ph_hi;
};
enum { I_X = 0, I_META, I_LNIN_G, I_LNIN_B, I_WIN, I_MU, I_W0, I_WW2, I_A0, I_WA2, I_WG2, I_KK, I_KA, I_RK, I_GNG, I_GNB, I_WPOOL, I_PSCALE, I_BGATE,
       I_WBA, I_WBB, I_WOUT, I_LN1G, I_LN1B, I_WQ, I_SUBK, I_UT, I_VT, I_LN2G, I_LN2B };

__device__ __forceinline__ unsigned pk2(float lo, float hi) { return pg8::cvt_pk_bf16(lo, hi); }
__device__ __forceinline__ float bflo(unsigned w) { return __uint_as_float(w << 16); }
__device__ __forceinline__ float bfhi(unsigned w) { return __uint_as_float(w & 0xffff0000u); }
__device__ __forceinline__ float bf1(bf16_t h) { return __uint_as_float(((unsigned)h) << 16); }
__device__ __forceinline__ bf16_t f2bf1(float f) { return (bf16_t)(pk2(f, f) & 0xffffu); }
__device__ __forceinline__ float wave_sum(float v) {
#pragma unroll
    for (int o = 1; o < 64; o <<= 1) v += __shfl_xor(v, o);
    return v;
}
__device__ __forceinline__ float sigmoidf_(float x) { return 1.0f / (1.0f + __expf(-x)); }
__device__ __forceinline__ f32x4 mfma16(bf16x8 a, bf16x8 b, f32x4 c) { return __builtin_amdgcn_mfma_f32_16x16x32_bf16(a, b, c, 0, 0, 0); }
__device__ __forceinline__ void unpack8(const u32x4 w, float* f) {
    f[0] = bflo(w.x); f[1] = bfhi(w.x); f[2] = bflo(w.y); f[3] = bfhi(w.y); f[4] = bflo(w.z); f[5] = bfhi(w.z); f[6] = bflo(w.w); f[7] = bfhi(w.w);
}
__device__ __forceinline__ u32x4 pack8(const float* f) { u32x4 w; w.x = pk2(f[0], f[1]); w.y = pk2(f[2], f[3]); w.z = pk2(f[4], f[5]); w.w = pk2(f[6], f[7]); return w; }
#define DPPF(v, ctrl) __builtin_bit_cast(float, __builtin_amdgcn_update_dpp(0, __builtin_bit_cast(int, (v)), (ctrl), 0xF, 0xF, true))
__device__ __forceinline__ float readlane_f(float v, int l) { return __builtin_bit_cast(float, __builtin_amdgcn_readlane(__builtin_bit_cast(int, v), l)); }
__device__ __forceinline__ float wave_sum_dpp(float v) {
    v += DPPF(v, 0xB1); v += DPPF(v, 0x4E); v += DPPF(v, 0x141); v += DPPF(v, 0x140);
    return (readlane_f(v, 0) + readlane_f(v, 16)) + (readlane_f(v, 32) + readlane_f(v, 48));
}
__device__ __forceinline__ float wave_max_dpp(float v) {
    v = fmaxf(v, DPPF(v, 0xB1)); v = fmaxf(v, DPPF(v, 0x4E)); v = fmaxf(v, DPPF(v, 0x141)); v = fmaxf(v, DPPF(v, 0x140));
    return fmaxf(fmaxf(readlane_f(v, 0), readlane_f(v, 16)), fmaxf(readlane_f(v, 32), readlane_f(v, 48)));
}
#define BLOCK_SYNC() __syncthreads()
#define XB_TMO      128
#define XB_XCNT(j)  (256  + 64 * (j))
#define XB_XSUB(j)  (1280 + 64 * (j))
#define XB_XGEN(j)  (2304 + 64 * (j))
#define XB_TOP      3328
#define XB_TOPGEN   3392
#define XCD_BAR_WORDS 3456
#define XB_SPIN_CAP (1u << 18)

__device__ __forceinline__ unsigned xb_ld(unsigned* p)              { return __hip_atomic_load(p, __ATOMIC_RELAXED, __HIP_MEMORY_SCOPE_AGENT); }
__device__ __forceinline__ unsigned xb_add(unsigned* p, unsigned v) { return __hip_atomic_fetch_add(p, v, __ATOMIC_RELAXED, __HIP_MEMORY_SCOPE_AGENT); }
__device__ __forceinline__ unsigned xb_xcc_id() { return (unsigned)__builtin_amdgcn_s_getreg((3 << 11) | 20) & 0xFu; }
#define XB_SPIN(cond, bar) do { unsigned _sp = 0; while (cond) { __builtin_amdgcn_s_sleep(1); \
    if ((++_sp & 255u) == 0u) { if (xb_ld(&(bar)[XB_TMO])) break; if (_sp > XB_SPIN_CAP) { atomicAdd(&(bar)[XB_TMO], 1u); break; } } } } while (0)

struct XcdBarrier {
    unsigned* bar; unsigned x;
    volatile LAS unsigned* st;
};

__device__ __forceinline__ XcdBarrier xcd_barrier_post(unsigned* bar, volatile LAS unsigned* st) {
    XcdBarrier b; b.bar = bar; b.x = xb_xcc_id(); b.st = st;
    if (threadIdx.x == 0) (void)xb_add(&bar[XB_XCNT(b.x)], 1u);
    return b;
}
__device__ __forceinline__ void xcd_barrier_complete(unsigned* bar, unsigned x, unsigned& nloc, unsigned& nx) {
    const unsigned G = gridDim.x * gridDim.y * gridDim.z;
    unsigned sum, cnt, mine, sp = 0u;
    for (;;) {
        sum = 0u; cnt = 0u; mine = 0u;
#pragma unroll
        for (unsigned j = 0; j < 16; ++j) { const unsigned c = xb_ld(&bar[XB_XCNT(j)]); sum += c; cnt += (c > 0u) ? 1u : 0u; mine = (j == x) ? c : mine; }
        if (sum == G) break;
        __builtin_amdgcn_s_sleep(1);
        if ((++sp & 255u) == 0u) { if (xb_ld(&bar[XB_TMO])) break; if (sp > XB_SPIN_CAP) { atomicAdd(&bar[XB_TMO], 1u); break; } }
    }
    nloc = mine > 0u ? mine : 1u; nx = cnt > 0u ? cnt : 1u;
}

__device__ __forceinline__ void xcd_barrier(const XcdBarrier& b) {
    asm volatile("s_waitcnt vmcnt(0)" ::: "memory");
    __syncthreads();
    if (threadIdx.x == 0) {
        unsigned* bar = b.bar;
        __builtin_amdgcn_s_waitcnt(0);
        unsigned nloc = b.st[0], nx = b.st[1];
        if (nloc == 0u) { xcd_barrier_complete(bar, b.x, nloc, nx); b.st[0] = nloc; b.st[1] = nx; }
        const unsigned old = xb_add(&bar[XB_XSUB(b.x)], 1u);
        const unsigned gen = old / nloc;
        if (old + 1u == (gen + 1u) * nloc) {
            __builtin_amdgcn_fence(__ATOMIC_RELEASE, "agent");
            asm volatile("s_waitcnt vmcnt(0)" ::: "memory");
            const unsigned og = xb_add(&bar[XB_TOP], 1u);
            const unsigned tg = og / nx;
            if (og + 1u == (tg + 1u) * nx) xb_add(&bar[XB_TOPGEN], 1u);
            else XB_SPIN(xb_ld(&bar[XB_TOPGEN]) == tg, bar);
            __builtin_amdgcn_fence(__ATOMIC_ACQUIRE, "agent");
            xb_add(&bar[XB_XGEN(b.x)], 1u);
            asm volatile("s_waitcnt vmcnt(0)" ::: "memory");
        } else {
            XB_SPIN(xb_ld(&bar[XB_XGEN(b.x)]) == gen, bar);
            __builtin_amdgcn_fence(__ATOMIC_ACQUIRE, "agent");
            asm volatile("s_waitcnt vmcnt(0)" ::: "memory");
        }
    }
    __syncthreads();
}

__device__ __forceinline__ void ln_row_bf16(const float* src, const float* g, const float* b, bf16_t* dst, int lane) {
    f32x4 v[8]; float s = 0.f;
#pragma unroll
    for (int j = 0; j < 8; ++j) { v[j] = ((const f32x4*)src)[lane + 64 * j]; s += (v[j].x + v[j].y) + (v[j].z + v[j].w); }
    const float mean = wave_sum(s) * (1.0f / D); float s2 = 0.f;
#pragma unroll
    for (int j = 0; j < 8; ++j) { v[j] = v[j] - mean; s2 += (v[j].x * v[j].x + v[j].y * v[j].y) + (v[j].z * v[j].z + v[j].w * v[j].w); }
    const float rstd = 1.0f / sqrtf(wave_sum(s2) * (1.0f / D) + LN_EPS);
#pragma unroll
    for (int j = 0; j < 8; ++j) {
        const f32x4 gg = ((const f32x4*)g)[lane + 64 * j], bb = ((const f32x4*)b)[lane + 64 * j];
        const f32x4 o = v[j] * rstd * gg + bb;
        u32x2 w; w.x = pk2(o.x, o.y); w.y = pk2(o.z, o.w);
        ((u32x2*)dst)[lane + 64 * j] = w;
    }
}
__device__ __forceinline__ void transpose_item(const float* W, int K, int N, int Npad, bf16_t* Wt, int item, int lane, int ldw = 0) {
    const int nblk = Npad >> 6, kb = item / nblk, nb = item - kb * nblk, n = nb * 64 + lane, k0 = kb * 32;
    float v[32];
    if (n < N) {
#pragma unroll
        for (int i = 0; i < 32; ++i) v[i] = W[(size_t)(k0 + i) * N + n];
    } else {
#pragma unroll
        for (int i = 0; i < 32; ++i) v[i] = 0.f;
    }
    u32x4* o = (u32x4*)(Wt + (size_t)n * (ldw ? ldw : K) + k0);
#pragma unroll
    for (int c = 0; c < 4; ++c) { u32x4 w; w.x = pk2(v[8 * c], v[8 * c + 1]); w.y = pk2(v[8 * c + 2], v[8 * c + 3]); w.z = pk2(v[8 * c + 4], v[8 * c + 5]); w.w = pk2(v[8 * c + 6], v[8 * c + 7]); o[c] = w; }
}
__device__ __forceinline__ void transpose_item_q(const float* W, const float* g, const float* b, bf16_t* Wt, float* c1, float* c2, int item, int lane) {
    const int kb = item >> 5, nb = item & 31, n = nb * 64 + lane, k0 = kb * 32;
    float v[32], s1 = 0.f, s2 = 0.f;
#pragma unroll
    for (int i = 0; i < 32; ++i) { const float w = W[(size_t)(k0 + i) * 2048 + n]; const float gw = g[k0 + i] * w; s1 += gw; s2 += b[k0 + i] * w; v[i] = gw; }
    u32x4* o = (u32x4*)(Wt + (size_t)n * 2048 + k0);
#pragma unroll
    for (int c = 0; c < 4; ++c) { u32x4 w; w.x = pk2(v[8 * c], v[8 * c + 1]); w.y = pk2(v[8 * c + 2], v[8 * c + 3]); w.z = pk2(v[8 * c + 4], v[8 * c + 5]); w.w = pk2(v[8 * c + 6], v[8 * c + 7]); o[c] = w; }
    atomicAdd(c1 + n, s1); atomicAdd(c2 + n, s2);
}
__device__ __forceinline__ void transpose_item64(const float* W, int K, int N, int Npad, bf16_t* Wt, int ldw, int item, int lane) {
    const int nblk = Npad >> 6, kb = item / nblk, nb = item - kb * nblk, n = nb * 64 + lane, k0 = kb * 64;
    float v[64];
    if (n < N) {
#pragma unroll
        for (int i = 0; i < 64; ++i) v[i] = W[(size_t)(k0 + i) * N + n];
    } else {
#pragma unroll
        for (int i = 0; i < 64; ++i) v[i] = 0.f;
    }
    u32x4* o = (u32x4*)(Wt + (size_t)n * ldw + k0);
#pragma unroll
    for (int c = 0; c < 8; ++c) { u32x4 w; w.x = pk2(v[8 * c], v[8 * c + 1]); w.y = pk2(v[8 * c + 2], v[8 * c + 3]); w.z = pk2(v[8 * c + 4], v[8 * c + 5]); w.w = pk2(v[8 * c + 6], v[8 * c + 7]); o[c] = w; }
}
__device__ __forceinline__ void phase0(const Params& P) {
    const int lane = threadIdx.x & 63, wave = threadIdx.x >> 6;
    const int gw = blockIdx.x * 8 + wave, NGW = gridDim.x * 8;
    unsigned char* ws = P.ws;
    constexpr int T_IN = 32 * 184, T_A = 32 * 32, T_B = 16 * 32, T_O = 32 * 32, T_Q = 64 * 32, T_POOL = 4 * 32, T_W2 = 3 * 32, T_A2 = 3 * 32, T_G2 = 8 * 32;
    constexpr int T_LN = MROWS, T_SK = 64;
    constexpr int NIT = T_IN + T_A + T_B + T_O + T_Q + T_POOL + T_W2 + T_A2 + T_G2 + T_LN + T_SK;
    for (int it = gw; it < NIT; it += NGW) {
        int r = it;
        if (r < T_IN) { transpose_item64(P.in[I_WIN], 2048, INC, NPAD, (bf16_t*)(ws + WS_WTIN), 2048, r, lane); continue; } r -= T_IN;
        if (r < T_A) { transpose_item64(P.in[I_WBA], 2048, 2048, 2048, (bf16_t*)(ws + WS_WTAB), LDAB, r, lane); continue; } r -= T_A;
        if (r < T_B) { transpose_item64(P.in[I_WBB], 1024, 2048, 2048, (bf16_t*)(ws + WS_WTAB) + 2048, LDAB, r, lane); continue; } r -= T_B;
        if (r < T_O) { transpose_item64(P.in[I_WOUT], 2048, 2048, 2048, (bf16_t*)(ws + WS_WTOUT), 2048, r, lane); continue; } r -= T_O;
        if (r < T_Q) { float* st = (float*)(ws + WS_STAT); transpose_item_q(P.in[I_WQ], P.in[I_LN1G], P.in[I_LN1B], (bf16_t*)(ws + WS_WTQ), st + 16384, st + 18432, r, lane); continue; } r -= T_Q;
        if (r < T_POOL) { const int g = r >> 5; transpose_item(P.in[I_WPOOL] + g * 65536, 256, 256, 256, (bf16_t*)(ws + WS_WTPOOL) + g * 65536, r & 31, lane); continue; } r -= T_POOL;
        if (r < T_W2) { transpose_item(P.in[I_WW2], 96, 2048, 2048, (bf16_t*)(ws + WS_WTW2), r, lane); continue; } r -= T_W2;
        if (r < T_A2) { transpose_item(P.in[I_WA2], 96, 2048, 2048, (bf16_t*)(ws + WS_WTA2), r, lane); continue; } r -= T_A2;
        if (r < T_G2) { transpose_item(P.in[I_WG2], 256, 2048, 2048, (bf16_t*)(ws + WS_WTG2), r, lane); continue; } r -= T_G2;
        if (r < T_LN) {
            bf16_t* dst = (bf16_t*)(ws + WS_H0B) + (size_t)r * D;
            if (r < NTOK) ln_row_bf16(P.in[I_X] + (size_t)r * D, P.in[I_LNIN_G], P.in[I_LNIN_B], dst, lane);
            else if (r < NTOK + 16) ln_row_bf16(P.in[I_META] + (size_t)(r - NTOK) * D, P.in[I_LNIN_G], P.in[I_LNIN_B], dst, lane);
            else {
#pragma unroll
                for (int j = 0; j < 8; ++j) ((u32x2*)dst)[lane + 64 * j] = (u32x2){0u, 0u};
            }
            continue;
        }
        r -= T_LN;
        {
            const float* s = P.in[I_SUBK] + r * 512 + lane * 8; float f[8];
#pragma unroll
            for (int i = 0; i < 8; ++i) f[i] = s[i];
            *(u32x4*)((bf16_t*)(ws + WS_SUBK) + r * 512 + lane * 8) = pack8(f);
        }
    }
}
namespace pg8 {
constexpr float LN_EPS_ = 1e-5f;
struct EpiGate35 {
    static constexpr bool PERM = false, AFTER_DRAIN = false; static constexpr int MID_T = 32;
    bf16_t* O; const bf16_t* p; const float* bgate;
    __device__ __forceinline__ void mid(f32x4 (&acc)[2][2][4][2], const Unit& u, int wr, int wc, int fr, int fq) const {
        asm volatile("" : "+v"(fr), "+v"(fq));
        const int row0 = u.pm * BM + wr * 64 + fr, col0 = u.pn * BM + wc * 32 + 4 * fq;
#pragma unroll
        for (int ai = 0; ai < 2; ++ai)
#pragma unroll
            for (int m = 0; m < 4; ++m) { const size_t row = (size_t)(row0 + ai * HALF + m * 16);
#pragma unroll
                for (int bj = 0; bj < 2; ++bj)
#pragma unroll
                    for (int n = 0; n < 2; ++n) { const int col = col0 + bj * HALF + n * 16;
                        const u32x2 p0 = *(const u32x2*)(p + row * NPAD + C_G0 + col), p1 = *(const u32x2*)(p + row * NPAD + C_G1 + col);
                        const f32x4 b0 = *(const f32x4*)(bgate + col), b1 = *(const f32x4*)(bgate + D + col);
                        f32x4 r;
                        r.x = (1.0f + __expf(-fmaxf(bflo(p1.x) + b1.x, -80.f))) * __builtin_amdgcn_rcpf(1.0f + __expf(-(bflo(p0.x) + b0.x)));
                        r.y = (1.0f + __expf(-fmaxf(bfhi(p1.x) + b1.y, -80.f))) * __builtin_amdgcn_rcpf(1.0f + __expf(-(bfhi(p0.x) + b0.y)));
                        r.z = (1.0f + __expf(-fmaxf(bflo(p1.y) + b1.z, -80.f))) * __builtin_amdgcn_rcpf(1.0f + __expf(-(bflo(p0.y) + b0.z)));
                        r.w = (1.0f + __expf(-fmaxf(bfhi(p1.y) + b1.w, -80.f))) * __builtin_amdgcn_rcpf(1.0f + __expf(-(bfhi(p0.y) + b0.w)));
                        acc[ai][bj][m][n] = acc[ai][bj][m][n] * r; }
                asm volatile("" ::: "memory"); }
    }
    __device__ __forceinline__ void operator()(const f32x4 (&acc)[2][2][4][2], const Unit& u, int wr, int wc, int fr, int fq) const {
        const int row0 = u.pm * BM + wr * 64 + fr, col0 = u.pn * BM + wc * 32 + 4 * fq;
#pragma unroll
        for (int ai = 0; ai < 2; ++ai)
#pragma unroll
            for (int m = 0; m < 4; ++m) { const size_t row = (size_t)(row0 + ai * HALF + m * 16);
#pragma unroll
                for (int bj = 0; bj < 2; ++bj)
#pragma unroll
                    for (int n = 0; n < 2; ++n) { const int col = col0 + bj * HALF + n * 16;
                        const u32x2 p1 = *(const u32x2*)(p + row * NPAD + C_G1 + col); const f32x4 b1 = *(const f32x4*)(bgate + D + col);
                        f32x4 g;
                        g.x = __builtin_amdgcn_rcpf(1.0f + __expf(-fmaxf(bflo(p1.x) + b1.x, -80.f))); g.y = __builtin_amdgcn_rcpf(1.0f + __expf(-fmaxf(bfhi(p1.x) + b1.y, -80.f)));
                        g.z = __builtin_amdgcn_rcpf(1.0f + __expf(-fmaxf(bflo(p1.y) + b1.z, -80.f))); g.w = __builtin_amdgcn_rcpf(1.0f + __expf(-fmaxf(bfhi(p1.y) + b1.w, -80.f)));
                        const f32x4 o = acc[ai][bj][m][n] * g;
                        u32x2 w; w.x = cvt_pk_bf16(o.x, o.y); w.y = cvt_pk_bf16(o.z, o.w);
                        *(u32x2*)(O + row * D + col) = w; } }
    }
};
struct EpiResidStats {
    static constexpr bool PERM = false, AFTER_DRAIN = false; static constexpr int MID_T = -1;
    bf16_t* O; const bf16_t* h0; float alpha; float* rsum; float* rsq;
    __device__ __forceinline__ void operator()(const f32x4 (&acc)[2][2][4][2], const Unit& u, int wr, int wc, int fr, int fq) const {
        const int row0 = u.pm * BM + wr * 64 + fr, col0 = u.pn * BM + wc * 32 + 4 * fq;
#pragma unroll
        for (int ai = 0; ai < 2; ++ai)
#pragma unroll
            for (int m = 0; m < 4; ++m) { const size_t row = (size_t)(row0 + ai * HALF + m * 16); float s = 0.f, q = 0.f;
#pragma unroll
                for (int bj = 0; bj < 2; ++bj)
#pragma unroll
                    for (int n = 0; n < 2; ++n) { const int col = col0 + bj * HALF + n * 16;
                        const u32x2 hw = *(const u32x2*)(h0 + row * D + col);
                        f32x4 hv; hv.x = bflo(hw.x); hv.y = bfhi(hw.x); hv.z = bflo(hw.y); hv.w = bfhi(hw.y);
                        const f32x4 x = hv * alpha + acc[ai][bj][m][n];
                        s += (x.x + x.y) + (x.z + x.w); q += (x.x * x.x + x.y * x.y) + (x.z * x.z + x.w * x.w);
                        u32x2 w; w.x = cvt_pk_bf16(x.x, x.y); w.y = cvt_pk_bf16(x.z, x.w);
                        *(u32x2*)(O + row * D + col) = w; }
                s += __shfl_xor(s, 16); s += __shfl_xor(s, 32); q += __shfl_xor(q, 16); q += __shfl_xor(q, 32);
                if (fq == 0) { atomicAdd(rsum + row, s); atomicAdd(rsq + row, q); } }
    }
};
struct EpiQ {
    static constexpr bool PERM = true, AFTER_DRAIN = false; static constexpr int MID_T = -1;
    bf16_t* O; const float* rsum; const float* rsq; const float* c1; const float* c2;
    __device__ __forceinline__ void operator()(const f32x4 (&acc)[2][2][4][2], const Unit& u, int wr, int wc, int fr, int fq) const {
        const int row0 = u.pm * BM + wr * 64 + fr, col0 = u.pn * BM + wc * 32 + 8 * fq;
        f32x4 k1[2][2], k2[2][2];
#pragma unroll
        for (int bj = 0; bj < 2; ++bj)
#pragma unroll
            for (int n = 0; n < 2; ++n) { k1[bj][n] = *(const f32x4*)(c1 + col0 + bj * HALF + 4 * n); k2[bj][n] = *(const f32x4*)(c2 + col0 + bj * HALF + 4 * n); }
#pragma unroll
        for (int ai = 0; ai < 2; ++ai)
#pragma unroll
            for (int m = 0; m < 4; ++m) { const int row = row0 + ai * HALF + m * 16;
                const float mean = rsum[row] * (1.0f / D), rstd = 1.0f / sqrtf(fmaxf(rsq[row] * (1.0f / D) - mean * mean, 0.f) + LN_EPS_);
                bf16_t* rowp = O + (size_t)row * D + col0;
#pragma unroll
                for (int bj = 0; bj < 2; ++bj) {
                    const f32x4 v0 = (acc[ai][bj][m][0] - k1[bj][0] * mean) * rstd + k2[bj][0], v1 = (acc[ai][bj][m][1] - k1[bj][1] * mean) * rstd + k2[bj][1];
                    u32x4 w; w.x = cvt_pk_bf16(v0[0], v0[1]); w.y = cvt_pk_bf16(v0[2], v0[3]); w.z = cvt_pk_bf16(v1[0], v1[1]); w.w = cvt_pk_bf16(v1[2], v1[3]);
                    *(u32x4*)(rowp + bj * HALF) = w; } }
    }
};
}
template <class Epi>
__device__ __forceinline__ void run_gemm(ldsp lds, const bf16_t* A, const bf16_t* Bt, int M, int N, int K, const Epi& E) {
    pg8::Gemm g; g.A = A; g.Bt = Bt; g.M = M; g.N = N; g.K = K;
    pg8::StaticOrder S; S.init(M, N, (int)gridDim.x, (int)blockIdx.x);
    pg8::gemm_phase<Epi, pg8::StaticOrder, false>(lds, g, S, E, nullptr);
}
constexpr int CONV_P2_ROWS = 0;
__device__ __forceinline__ void convert_tables(const Params& P, int r0, int rend, int stride) {
    const int lane = threadIdx.x & 63;
    unsigned char* ws = P.ws;
    for (int r = r0; r < rend; r += stride) {
        const float* src = (r < 16384 ? P.in[I_UT] : P.in[I_VT]) + (size_t)(r & 16383) * D;
        f32x4 v[8]; float am = 0.f;
#pragma unroll
        for (int j = 0; j < 8; ++j) { v[j] = ((const f32x4*)src)[lane + 64 * j]; am = fmaxf(am, fmaxf(fmaxf(fabsf(v[j].x), fabsf(v[j].y)), fmaxf(fabsf(v[j].z), fabsf(v[j].w)))); }
        am = wave_max_dpp(am);
        const float qmax = 6.0f;
        const float s = am > 0.f ? qmax / am : 1.0f;
        {
            unsigned w[4];
#pragma unroll
            for (int j = 0; j < 4; ++j) { unsigned t = 0;
                t = __builtin_amdgcn_cvt_scalef32_pk_fp4_f32(t, v[2 * j].x * s, v[2 * j].y * s, 1.0f, 0); t = __builtin_amdgcn_cvt_scalef32_pk_fp4_f32(t, v[2 * j].z * s, v[2 * j].w * s, 1.0f, 1);
                t = __builtin_amdgcn_cvt_scalef32_pk_fp4_f32(t, v[2 * j + 1].x * s, v[2 * j + 1].y * s, 1.0f, 2); t = __builtin_amdgcn_cvt_scalef32_pk_fp4_f32(t, v[2 * j + 1].z * s, v[2 * j + 1].w * s, 1.0f, 3);
                w[j] = t; }
            *(u32x4*)(ws + (r < 16384 ? WS_UB : WS_VB) + (size_t)(r & 16383) * UROW + lane * 16) = (u32x4){w[0], w[1], w[2], w[3]};
        }
        if (lane == 0) ((float*)(ws + WS_TSC))[r] = am > 0.f ? am / qmax : 1.0f;
    }
}
constexpr int LD64 = 72, MATB = 64 * LD64 * 2, LDK = 104;
constexpr int O_AB = 0, O_RB = 1 * MATB, O_BH = 2 * MATB, O_KH = 3 * MATB, O_BTT = 4 * MATB, O_KTT = 5 * MATB, O_VT = 6 * MATB;
constexpr int O_M0 = 7 * MATB, O_M0T = 8 * MATB  , O_M1 = 9 * MATB, O_PA = 10 * MATB, O_PB = 11 * MATB, O_MAK = 12 * MATB, O_MRB = 13 * MATB, O_MRK = 14 * MATB;
constexpr int O_M1T = 0;
constexpr int LDKP = 96;
constexpr int O_WL = 15 * MATB, O_AL = O_WL + 64 * LDKP * 2;
constexpr int O_Z = 7 * MATB, O_AZ = O_Z + 64 * 68 * 4;
static_assert(O_AZ + 64 * 68 * 4 <= O_PB, "lds");
static_assert(O_AL + 64 * LDKP * 2 <= LDS_BYTES - 16, "lds");

__device__ __forceinline__ bf16x8 ldsfrag(ldsp lds, int off, int ld, int row, int kofs) { return *(const LAS bf16x8*)(lds + off + (row * ld + kofs) * 2); }
__device__ __forceinline__ void st4(ldsp lds, int off, int row, int col, const f32x4 v) {
    u32x2 w; w.x = pk2(v.x, v.y); w.y = pk2(v.z, v.w); *(LAS u32x2*)(lds + off + (row * LD64 + col) * 2) = w; }
__device__ __forceinline__ void st1(ldsp lds, int off, int row, int col, float v) { *(LAS bf16_t*)(lds + off + (row * LD64 + col) * 2) = f2bf1(v); }

__device__ __forceinline__ float fast_rcp(float x) { return __builtin_amdgcn_rcpf(x); }
__device__ __forceinline__ float fast_sigmoid(float x) { return fast_rcp(1.0f + __expf(-x)); }
__device__ __forceinline__ float fast_tanh(float x) { return 1.0f - 2.0f * fast_rcp(1.0f + __expf(2.0f * x)); }
__device__ __forceinline__ u32x4 ld8(const bf16_t* p) { return p ? *(const u32x4*)p : (u32x4){0u, 0u, 0u, 0u}; }
__device__ __forceinline__ void shift8r(const u32x4 cw, const u32x4 pw, const float* mu, float* x) {
    float c[8], q[8]; unpack8(cw, c); unpack8(pw, q);
    const f32x4 m0 = *(const f32x4*)mu, m1 = *(const f32x4*)(mu + 4);
    const float mm[8] = {m0.x, m0.y, m0.z, m0.w, m1.x, m1.y, m1.z, m1.w};
#pragma unroll
    for (int i = 0; i < 8; ++i) x[i] = c[i] + (q[i] - c[i]) * mm[i];
}
__device__ __forceinline__ int tcol(int row, int col) { return ((((col >> 3) ^ (row >> 3)) & 7) << 3) | (col & 7); }
__device__ __forceinline__ bf16x8 ldsfragT(ldsp lds, int off, int row, int kofs) { return *(const LAS bf16x8*)(lds + off + (row * LD64 + tcol(row, kofs)) * 2); }
__device__ __forceinline__ void st1T(ldsp lds, int off, int row, int col, float v) { *(LAS bf16_t*)(lds + off + (row * LD64 + tcol(row, col)) * 2) = f2bf1(v); }
typedef short s16x4 __attribute__((ext_vector_type(4)));
__device__ __forceinline__ bf16x8 ldsfragTR(ldsp lds, int off, int krow0, int col0, int lane) {
    const int g = lane >> 4, q = (lane & 15) >> 2, p = lane & 3;
    const LAS s16x4* a = (const LAS s16x4*)(lds + off + ((krow0 + 8 * g + q) * LD64 + col0) * 2 + 8 * p);
    const s16x4 v0 = __builtin_amdgcn_ds_read_tr16_b64_v4i16((LAS s16x4*)a), v1 = __builtin_amdgcn_ds_read_tr16_b64_v4i16((LAS s16x4*)(a + LD64));
    return (bf16x8){v0[0], v0[1], v0[2], v0[3], v1[0], v1[1], v1[2], v1[3]};
}
__device__ __forceinline__ void shift8(const bf16_t* pcur, const bf16_t* pprev, const float* mu, float* x) {
    float c[8], q[8];
    if (pcur) unpack8(*(const u32x4*)pcur, c); else {
#pragma unroll
        for (int i = 0; i < 8; ++i) c[i] = 0.f; }
    if (pprev) unpack8(*(const u32x4*)pprev, q); else {
#pragma unroll
        for (int i = 0; i < 8; ++i) q[i] = 0.f; }
    const f32x4 m0 = *(const f32x4*)mu, m1 = *(const f32x4*)(mu + 4);
    const float mm[8] = {m0.x, m0.y, m0.z, m0.w, m1.x, m1.y, m1.z, m1.w};
#pragma unroll
    for (int i = 0; i < 8; ++i) x[i] = c[i] + (q[i] - c[i]) * mm[i];
}

template <bool DO_P, bool DO_SQ>
__device__ __forceinline__ void dbl_step(ldsp lds, int sN, int sT, int dN, int dT, int pC, int pN, int tm, int tn0, int fr, int fq) {
    bf16x8 a[2];
#pragma unroll
    for (int ks = 0; ks < 2; ++ks) a[ks] = ldsfragTR(lds, sN, 32 * ks, 16 * tm, 16 * fq + fr);
#pragma unroll
    for (int t2 = 0; t2 < 2; ++t2) {
        const int nt = tn0 + t2, t = 16 * nt + fr, s0 = 16 * tm + 4 * fq;
        if (DO_P) {
            f32x4 acc = {0.f, 0.f, 0.f, 0.f};
#pragma unroll
            for (int ks = 0; ks < 2; ++ks) acc = mfma16(a[ks], ldsfrag(lds, pC, LD64, t, ks * 32 + fq * 8), acc);
            const u32x2 pw = *(const LAS u32x2*)(lds + pC + (t * LD64 + s0) * 2);
            acc.x += bflo(pw.x); acc.y += bfhi(pw.x); acc.z += bflo(pw.y); acc.w += bfhi(pw.y);
            st4(lds, pN, t, s0, acc);
        }
        if (DO_SQ) {
            f32x4 acc = {0.f, 0.f, 0.f, 0.f};
#pragma unroll
            for (int ks = 0; ks < 2; ++ks) acc = mfma16(a[ks], ldsfrag(lds, sN, LD64, t, ks * 32 + fq * 8), acc);
            st4(lds, dN, t, s0, acc);
        }
    }
}


#ifdef DBG_STAGE
constexpr size_t DBG_STRIDE = (size_t)NUNITS * 512 * 4;
__device__ __forceinline__ void dbgsum(const Params& P, ldsp lds, int u, int stage, const int* offs, int nmat) {
    unsigned acc = 0;
    for (int m = 0; m < nmat; ++m)
        for (int k = 0; k < 4; ++k) { const int idx = threadIdx.x + 512 * k, row = idx >> 5, cp = idx & 31; const unsigned x = *(const LAS unsigned*)(lds + offs[m] + row * (LD64 * 2) + cp * 4); acc += (x & 0xffffu) + (x >> 16); }
    ((unsigned*)(P.ws + WS_S0T + (size_t)stage * DBG_STRIDE))[(size_t)u * 512 + threadIdx.x] = acc;
}
#define DBGSUM(stage, ...) do { const int offs_[] = {__VA_ARGS__}; dbgsum(P, lds, u, stage, offs_, (int)(sizeof(offs_) / sizeof(int))); } while (0)
#else
#define DBGSUM(stage, ...) do { } while (0)
#endif
struct PL { u32x4 rc, rq, kc, kq, vc, vq; };
__device__ __forceinline__ const bf16_t* unit_rowp(const bf16_t* pp, int u, int tl, int col) {
    int r;
    if (u >= 4096) r = (tl >= 48) ? (ROW_META + tl - 48) : -1;
    else { const int bh = u >> 6, c = u & 63, b = bh >> 5; r = (tl >= 0 || c > 0) ? (b * SEQ + c * 64 + tl) : (ROW_META + 15); }
    return r < 0 ? (const bf16_t*)nullptr : pp + (size_t)r * NPAD + col;
}
__device__ __forceinline__ void pl_load(const Params& P, int u, PL& L) {
    int tid = threadIdx.x; asm volatile("" : "+v"(tid));
    const int lane = tid & 63, wave = tid >> 6, fr = lane & 15, fq = lane >> 4, tm = wave >> 1;
    const bf16_t* pp = (const bf16_t*)(P.ws + WS_P);
    const int h = (u >= 4096) ? (u - 4096) : ((u >> 6) & 31);
    const int t = tid >> 3, hj = h * 64 + 8 * (tid & 7);
    L.rc = ld8(unit_rowp(pp, u, t, C_R + hj)); L.rq = ld8(unit_rowp(pp, u, t - 1, C_R + hj));
    L.kc = ld8(unit_rowp(pp, u, t, C_K + hj)); L.kq = ld8(unit_rowp(pp, u, t - 1, C_K + hj));
    L.vc = ld8(unit_rowp(pp, u, t, C_V + hj)); L.vq = ld8(unit_rowp(pp, u, t - 1, C_V + hj));
}
__device__ __forceinline__ void rwkv_unit(const Params& P, ldsp lds, int u, PL& L, int next_u, bool stage_a) {
    int tid = threadIdx.x; asm volatile("" : "+v"(tid));
    const int lane = tid & 63, wave = tid >> 6, fr = lane & 15, fq = lane >> 4, tm = wave >> 1, tn0 = (wave & 1) * 2;
    unsigned char* ws = P.ws;
    const bf16_t* pp = (const bf16_t*)(ws + WS_P);
    const bool meta = u >= 4096;
    int b = 0, h, c = 0;
    if (meta) { h = u - 4096; } else { const int bh = u >> 6; c = u & 63; b = bh >> 5; h = bh & 31; }
    auto rowof = [&](int tl) -> int {
        if (meta) return (tl >= 48) ? (ROW_META + tl - 48) : -1;
        if (tl >= 0 || c > 0) return b * SEQ + c * 64 + tl;
        return ROW_META + 15;
    };
    auto rowp = [&](int tl, int col) -> const bf16_t* { const int r = rowof(tl); return r < 0 ? (const bf16_t*)nullptr : pp + (size_t)r * NPAD + col; };
    const float* mu = P.in[I_MU];
#ifndef RPT_AD
#define RPT_AD 1
#define RPT_E12 1
#define RPT_E35 1
#endif
    float lw[8], av[8], rv[8], kv[8], vv[8], kk[8], km[8];
    const int t = tid >> 3, jq = tid & 7, j0 = 8 * jq, hj = h * 64 + j0;
    const bool nulltok = meta && t < 48;
    for (int rpt_ = 0; rpt_ < RPT_AD; ++rpt_) {
    bf16x8 lAw[3], lAa[3];
    {
        const bf16_t* ww2 = (const bf16_t*)(ws + WS_WTW2) + (size_t)(h * 64 + 16 * tm + fr) * 96 + fq * 8;
        const bf16_t* wa2 = (const bf16_t*)(ws + WS_WTA2) + (size_t)(h * 64 + 16 * tm + fr) * 96 + fq * 8;
#pragma unroll
        for (int ks = 0; ks < 3; ++ks) { lAw[ks] = *(const bf16x8*)(ww2 + ks * 32); lAa[ks] = *(const bf16x8*)(wa2 + ks * 32); }
    }
    if (stage_a) {
        u32x4 cw[3], pw[3];
#pragma unroll
        for (int it = 0; it < 3; ++it) { const int idx = tid + 512 * it, mat = idx / 768, rem = idx - mat * 768, tt = rem / 12, ch = rem - tt * 12, col = (mat ? C_AL : C_WL) + ch * 8;
            cw[it] = ld8(rowp(tt, col)); pw[it] = ld8(rowp(tt - 1, col)); }
#pragma unroll
        for (int it = 0; it < 3; ++it) { const int idx = tid + 512 * it, mat = idx / 768, rem = idx - mat * 768, tt = rem / 12, ch = rem - tt * 12, col = (mat ? C_AL : C_WL) + ch * 8;
            float x[8]; shift8r(cw[it], pw[it], mu + col, x);
            if (mat == 0) {
#pragma unroll
                for (int i = 0; i < 8; ++i) x[i] = fast_tanh(x[i]);
            }
            *(LAS u32x4*)(lds + (mat ? O_AL : O_WL) + (tt * LDKP + ch * 8) * 2) = pack8(x); }
    }
    BLOCK_SYNC();
    {
        f32x4 z[2] = {{0.f, 0.f, 0.f, 0.f}, {0.f, 0.f, 0.f, 0.f}}, az[2] = {{0.f, 0.f, 0.f, 0.f}, {0.f, 0.f, 0.f, 0.f}};
#pragma unroll
        for (int ks = 0; ks < 3; ++ks) {
            const bf16x8 aw = lAw[ks], aa = lAa[ks];
#pragma unroll
            for (int t2 = 0; t2 < 2; ++t2) {
                const int t = 16 * (tn0 + t2) + fr;
                z[t2] = mfma16(aw, ldsfrag(lds, O_WL, LDKP, t, ks * 32 + fq * 8), z[t2]);
                az[t2] = mfma16(aa, ldsfrag(lds, O_AL, LDKP, t, ks * 32 + fq * 8), az[t2]);
            }
        }
#pragma unroll
        for (int t2 = 0; t2 < 2; ++t2) {
            const int t = 16 * (tn0 + t2) + fr, j0 = 16 * tm + 4 * fq;
            *(LAS f32x4*)(lds + O_Z + (t * 68 + j0) * 4) = z[t2];
            *(LAS f32x4*)(lds + O_AZ + (t * 68 + j0) * 4) = az[t2];
        }
    }
    BLOCK_SYNC();
    float cs[8];
    {
        const f32x4 z0 = *(const LAS f32x4*)(lds + O_Z + (t * 68 + j0) * 4), z1 = *(const LAS f32x4*)(lds + O_Z + (t * 68 + j0 + 4) * 4);
        const f32x4 y0 = *(const LAS f32x4*)(lds + O_AZ + (t * 68 + j0) * 4), y1 = *(const LAS f32x4*)(lds + O_AZ + (t * 68 + j0 + 4) * 4);
        const float zz[8] = {z0.x, z0.y, z0.z, z0.w, z1.x, z1.y, z1.z, z1.w}, yy[8] = {y0.x, y0.y, y0.z, y0.w, y1.x, y1.y, y1.z, y1.w};
        const f32x4 w0a = *(const f32x4*)(P.in[I_W0] + hj), w0b = *(const f32x4*)(P.in[I_W0] + hj + 4), a0a = *(const f32x4*)(P.in[I_A0] + hj), a0b = *(const f32x4*)(P.in[I_A0] + hj + 4);
        const float w0[8] = {w0a.x, w0a.y, w0a.z, w0a.w, w0b.x, w0b.y, w0b.z, w0b.w}, a0[8] = {a0a.x, a0a.y, a0a.z, a0a.w, a0b.x, a0b.y, a0b.z, a0b.w};
#pragma unroll
        for (int i = 0; i < 8; ++i) { lw[i] = nulltok ? 0.f : -DSCALE * fast_sigmoid(w0[i] + zz[i]); av[i] = fast_sigmoid(a0[i] + yy[i]); cs[i] = lw[i]; }
#pragma unroll
        for (int d = 8; d < 64; d <<= 1) {
#pragma unroll
            for (int i = 0; i < 8; ++i) { const float o = __shfl_up(cs[i], d); cs[i] += (lane >= d) ? o : 0.f; }
        }
        if (lane >= 56) {
#pragma unroll
            for (int i = 0; i < 8; ++i) *(LAS float*)(lds + (wave < 4 ? O_BH : O_KH) + ((j0 + i) * LD64 + 64) * 2 + (wave & 3) * 4) = cs[i]; }
        shift8r(L.rc, L.rq, mu + C_R + hj, rv); shift8r(L.kc, L.kq, mu + C_K + hj, kv); shift8r(L.vc, L.vq, mu + C_V + hj, vv);
        if (nulltok) {
#pragma unroll
            for (int i = 0; i < 8; ++i) { rv[i] = 0.f; kv[i] = 0.f; vv[i] = 0.f; }
        }
        const f32x4 kka = *(const f32x4*)(P.in[I_KK] + hj), kkb = *(const f32x4*)(P.in[I_KK] + hj + 4), kaa = *(const f32x4*)(P.in[I_KA] + hj), kab = *(const f32x4*)(P.in[I_KA] + hj + 4);
        const f32x4 rka = *(const f32x4*)(P.in[I_RK] + hj), rkb = *(const f32x4*)(P.in[I_RK] + hj + 4);
        const float kkw[8] = {kka.x, kka.y, kka.z, kka.w, kkb.x, kkb.y, kkb.z, kkb.w}, kaw[8] = {kaa.x, kaa.y, kaa.z, kaa.w, kab.x, kab.y, kab.z, kab.w}, rkw[8] = {rka.x, rka.y, rka.z, rka.w, rkb.x, rkb.y, rkb.z, rkb.w};
        float n2 = 0.f, bon = 0.f;
#pragma unroll
        for (int i = 0; i < 8; ++i) { kk[i] = kv[i] * kkw[i]; n2 += kk[i] * kk[i]; km[i] = kv[i] * (1.0f + (av[i] - 1.0f) * kaw[i]); bon += rv[i] * km[i] * rkw[i]; }
        n2 += DPPF(n2, 0xB1); n2 += DPPF(n2, 0x4E); n2 += DPPF(n2, 0x141);
        bon += DPPF(bon, 0xB1); bon += DPPF(bon, 0x4E); bon += DPPF(bon, 0x141);
        const float inv = 1.0f / fmaxf(sqrtf(n2), 1e-12f);
#pragma unroll
        for (int i = 0; i < 8; ++i) kk[i] *= inv;
        if (!meta && jq == 0) ((float*)(ws + WS_BONUS))[(size_t)(b * SEQ + c * 64 + t) * 32 + h] = bon;
    }
    BLOCK_SYNC();
    {
        float Lc[8], Le[8];
#pragma unroll
        for (int i = 0; i < 8; ++i) { Lc[i] = cs[i]; Le[i] = 0.f; }
#pragma unroll
        for (int i = 0; i < 8; ++i) {
            const f32x4 wa = *(const LAS f32x4*)(lds + O_BH + ((j0 + i) * LD64 + 64) * 2), wb = *(const LAS f32x4*)(lds + O_KH + ((j0 + i) * LD64 + 64) * 2);
            const float ww[8] = {wa.x, wa.y, wa.z, wa.w, wb.x, wb.y, wb.z, wb.w};
#pragma unroll
            for (int w = 0; w < 8; ++w) { Le[i] += ww[w]; Lc[i] += (w < wave) ? ww[w] : 0.f; }
        }
        float Ab[8], Rb[8], Bh[8], Kh[8], Bt[8], Kt[8];
#pragma unroll
        for (int i = 0; i < 8; ++i) {
            const float eP = __expf(Lc[i] - lw[i]), eC = __expf(Lc[i]), eN = __expf(-Lc[i]), eE = __expf(Le[i] - Lc[i]);
            const float ka = kk[i] * av[i];
            Ab[i] = -kk[i] * eP; Rb[i] = rv[i] * eC; Bh[i] = ka * eN; Kh[i] = km[i] * eN; Bt[i] = ka * eE; Kt[i] = km[i] * eE;
        }
        *(LAS u32x4*)(lds + O_AB + (t * LD64 + j0) * 2) = pack8(Ab);
        *(LAS u32x4*)(lds + O_RB + (t * LD64 + j0) * 2) = pack8(Rb);
        *(LAS u32x4*)(lds + O_BH + (t * LD64 + j0) * 2) = pack8(Bh);
        *(LAS u32x4*)(lds + O_KH + (t * LD64 + j0) * 2) = pack8(Kh);
        *(LAS u32x4*)(lds + O_BTT + (t * LD64 + j0) * 2) = pack8(Bt);
        *(LAS u32x4*)(lds + O_KTT + (t * LD64 + j0) * 2) = pack8(Kt);
        *(LAS u32x4*)(lds + O_VT + (t * LD64 + j0) * 2) = pack8(vv);
        if (t == 63) {
#pragma unroll
            for (int i = 0; i < 8; ++i) *(LAS float*)(lds + O_RB + ((j0 + i) * LD64 + 64) * 2) = __expf(Le[i]);
        }
    }
    BLOCK_SYNC();
    }
    if (next_u >= 0) pl_load(P, next_u, L);
    for (int rpt_ = 0; rpt_ < RPT_E12; ++rpt_) {
    {
        bf16x8 abh[2], akh[2];
#pragma unroll
        for (int ks = 0; ks < 2; ++ks) { abh[ks] = ldsfrag(lds, O_BH, LD64, 16 * tm + fr, ks * 32 + fq * 8); akh[ks] = ldsfrag(lds, O_KH, LD64, 16 * tm + fr, ks * 32 + fq * 8); }
#pragma unroll
        for (int t2 = 0; t2 < 2; ++t2) {
            const int tt = 16 * (tn0 + t2) + fr, s0 = 16 * tm + 4 * fq;
            f32x4 mab = {0.f, 0.f, 0.f, 0.f}, mak = mab, mrb = mab, mrk = mab;
#pragma unroll
            for (int ks = 0; ks < 2; ++ks) {
                const bf16x8 bab = ldsfrag(lds, O_AB, LD64, tt, ks * 32 + fq * 8), brb = ldsfrag(lds, O_RB, LD64, tt, ks * 32 + fq * 8);
                mab = mfma16(abh[ks], bab, mab); mak = mfma16(akh[ks], bab, mak); mrb = mfma16(abh[ks], brb, mrb); mrk = mfma16(akh[ks], brb, mrk);
            }
            float vab[4] = {mab.x, mab.y, mab.z, mab.w}, vak[4] = {mak.x, mak.y, mak.z, mak.w}, vrb[4] = {mrb.x, mrb.y, mrb.z, mrb.w}, vrk[4] = {mrk.x, mrk.y, mrk.z, mrk.w}, vp[4];
#pragma unroll
            for (int r = 0; r < 4; ++r) { const int s = s0 + r; const bool st = s < tt, le = s <= tt;
                vab[r] = st ? vab[r] : 0.f; vak[r] = st ? vak[r] : 0.f; vrb[r] = le ? vrb[r] : 0.f; vrk[r] = le ? vrk[r] : 0.f; vp[r] = vab[r] + (s == tt ? 1.0f : 0.f); }
            st4(lds, O_M0, tt, s0, (f32x4){vab[0], vab[1], vab[2], vab[3]});
            st4(lds, O_PA, tt, s0, (f32x4){vp[0], vp[1], vp[2], vp[3]});
            st4(lds, O_MAK, tt, s0, (f32x4){vak[0], vak[1], vak[2], vak[3]});
            st4(lds, O_MRB, tt, s0, (f32x4){vrb[0], vrb[1], vrb[2], vrb[3]});
            st4(lds, O_MRK, tt, s0, (f32x4){vrk[0], vrk[1], vrk[2], vrk[3]});
        }
    }
    BLOCK_SYNC();
    dbl_step<false, true>(lds, O_M0, O_M0T, O_M1, O_M1T, 0, 0, tm, tn0, fr, fq); BLOCK_SYNC();
    dbl_step<true, true>(lds, O_M1, O_M1T, O_M0, O_M0T, O_PA, O_PB, tm, tn0, fr, fq); BLOCK_SYNC();
    dbl_step<true, true>(lds, O_M0, O_M0T, O_M1, O_M1T, O_PB, O_PA, tm, tn0, fr, fq); BLOCK_SYNC();
    dbl_step<true, true>(lds, O_M1, O_M1T, O_M0, O_M0T, O_PA, O_PB, tm, tn0, fr, fq); BLOCK_SYNC();
    dbl_step<true, true>(lds, O_M0, O_M0T, O_M1, O_M1T, O_PB, O_PA, tm, tn0, fr, fq); BLOCK_SYNC();
    dbl_step<true, false>(lds, O_M1, O_M1T, 0, 0, O_PA, O_PB, tm, tn0, fr, fq); BLOCK_SYNC();
    }
    const size_t ub = (size_t)u * 4096;
    for (int rpt_ = 0; rpt_ < RPT_E35; ++rpt_) {
    {
        bf16x8 aT[2], aMak[2];
#pragma unroll
        for (int ks = 0; ks < 2; ++ks) { aT[ks] = ldsfrag(lds, O_PB, LD64, 16 * tm + fr, ks * 32 + fq * 8); aMak[ks] = ldsfrag(lds, O_MAK, LD64, 16 * tm + fr, ks * 32 + fq * 8); }
#pragma unroll
        for (int t2 = 0; t2 < 2; ++t2) {
            const int n = 16 * (tn0 + t2) + fr, t0 = 16 * tm + 4 * fq;
            f32x4 at = {0.f, 0.f, 0.f, 0.f}, xt = at;
#pragma unroll
            for (int ks = 0; ks < 2; ++ks) { at = mfma16(aT[ks], ldsfragTR(lds, O_AB, 32 * ks, 16 * (tn0 + t2), 16 * fq + fr), at); xt = mfma16(aMak[ks], ldsfragTR(lds, O_VT, 32 * ks, 16 * (tn0 + t2), 16 * fq + fr), xt); }
            st4(lds, O_M0, n, t0, at); st4(lds, O_M0T, n, t0, xt);
        }
    }
    BLOCK_SYNC();
    {
        bf16x8 aT[2], aAt[2];
#pragma unroll
        for (int ks = 0; ks < 2; ++ks) { aT[ks] = ldsfrag(lds, O_PB, LD64, 16 * tm + fr, ks * 32 + fq * 8); aAt[ks] = ldsfrag(lds, O_M0, LD64, 16 * tm + fr, ks * 32 + fq * 8); }
        bf16_t* Rt = (bf16_t*)(ws + WS_RT) + ub; bf16_t* Gp = (bf16_t*)(ws + WS_G) + ub;
#pragma unroll
        for (int t2 = 0; t2 < 2; ++t2) {
            const int n = 16 * (tn0 + t2) + fr, m0 = 16 * tm + 4 * fq;
            f32x4 u0 = {0.f, 0.f, 0.f, 0.f}, rt = u0, g = u0;
#pragma unroll
            for (int ks = 0; ks < 2; ++ks) {
                u0 = mfma16(aT[ks], ldsfrag(lds, O_M0T, LD64, n, ks * 32 + fq * 8), u0);
                rt = mfma16(aAt[ks], ldsfrag(lds, O_MRB, LD64, n, ks * 32 + fq * 8), rt);
                g = mfma16(aAt[ks], ldsfragTR(lds, O_BTT, 32 * ks, 16 * (tn0 + t2), 16 * fq + fr), g);
            }
            st4(lds, O_M1, n, m0, u0);
            const u32x2 rw = *(const LAS u32x2*)(lds + O_RB + (n * LD64 + m0) * 2);
            rt.x += bflo(rw.x); rt.y += bfhi(rw.x); rt.z += bflo(rw.y); rt.w += bfhi(rw.y);
            { u32x2 w; w.x = pk2(rt.x, rt.y); w.y = pk2(rt.z, rt.w); *(u32x2*)(Rt + n * 64 + m0) = w; }
            if ((n >> 2) == (m0 >> 2)) { const float e = *(const LAS float*)(lds + O_RB + (n * LD64 + 64) * 2); const int r = n & 3;
                g.x += (r == 0) ? e : 0.f; g.y += (r == 1) ? e : 0.f; g.z += (r == 2) ? e : 0.f; g.w += (r == 3) ? e : 0.f; }
            { const int pos0 = 32 * (tm >> 1) + 8 * fq + 4 * (tm & 1); u32x2 w; w.x = pk2(g.x, g.y); w.y = pk2(g.z, g.w); *(u32x2*)(Gp + n * 64 + pos0) = w; }
        }
    }
    BLOCK_SYNC();
    {
        bf16x8 aB[2], aK[2], aU[2], aV[2];
#pragma unroll
        for (int ks = 0; ks < 2; ++ks) { const int row = 16 * tm + fr, ko = ks * 32 + fq * 8;
            aB[ks] = ldsfragTR(lds, O_BTT, 32 * ks, 16 * tm, 16 * fq + fr); aK[ks] = ldsfragTR(lds, O_KTT, 32 * ks, 16 * tm, 16 * fq + fr); aU[ks] = ldsfrag(lds, O_M1, LD64, row, ko); aV[ks] = ldsfragTR(lds, O_VT, 32 * ks, 16 * tm, 16 * fq + fr); }
        bf16_t* H0t = (bf16_t*)(ws + WS_H0T) + ub; bf16_t* Y0s = (bf16_t*)(ws + WS_Y0) + ub;
#pragma unroll
        for (int t2 = 0; t2 < 2; ++t2) {
            const int n = 16 * (tn0 + t2) + fr, m0 = 16 * tm + 4 * fq;
            f32x4 hh = {0.f, 0.f, 0.f, 0.f}, yy = hh;
#pragma unroll
            for (int ks = 0; ks < 2; ++ks) { const int ko = ks * 32 + fq * 8;
                const bf16x8 bU = ldsfrag(lds, O_M1, LD64, n, ko), bV = ldsfragTR(lds, O_VT, 32 * ks, 16 * (tn0 + t2), 16 * fq + fr), bRb = ldsfrag(lds, O_MRB, LD64, n, ko), bRk = ldsfrag(lds, O_MRK, LD64, n, ko);
                hh = mfma16(aB[ks], bU, hh); hh = mfma16(aK[ks], bV, hh);
                yy = mfma16(aU[ks], bRb, yy); yy = mfma16(aV[ks], bRk, yy); }
            { u32x2 w; w.x = pk2(hh.x, hh.y); w.y = pk2(hh.z, hh.w); *(u32x2*)(H0t + n * 64 + m0) = w; }
            { u32x2 w; w.x = pk2(yy.x, yy.y); w.y = pk2(yy.z, yy.w); *(u32x2*)(Y0s + n * 64 + m0) = w; }
        }
    }
    BLOCK_SYNC();
    }
}

constexpr int LDU = 264;
__device__ __forceinline__ void pool_unit(const Params& P, ldsp lds, int pu) {
    int tid = threadIdx.x; asm volatile("" : "+v"(tid));
    const int lane = tid & 63, wave = tid >> 6, fr = lane & 15, fq = lane >> 4;
    unsigned char* ws = P.ws;
    const bf16_t* pp = (const bf16_t*)(ws + WS_P);
    const int g = (pu < 256) ? (pu & 3) : 3 - (pu & 3), tt = pu >> 2, b = tt >> 6, ti0 = (tt & 63) * 64;
    constexpr int O_U = 0, O_PL = 79 * LDU * 2;
    for (int idx = tid; idx < 79 * 32; idx += 512) {
        const int lr = idx >> 5, ch = idx & 31, ti = ti0 + lr - 15;
        const int row = ti >= 0 ? b * SEQ + ti : ROW_META + 16 + ti;
        *(LAS u32x4*)(lds + O_U + (lr * LDU + ch * 8) * 2) = *(const u32x4*)(pp + (size_t)row * NPAD + C_POOL + g * 256 + ch * 8);
    }
    BLOCK_SYNC();
    {
        const int t = tid >> 3, cq = tid & 7, win = 2 << g; const float inv = 1.0f / (float)win;
#pragma unroll
        for (int cc = 0; cc < 4; ++cc) {
            const int c0 = cq * 32 + cc * 8; float s[8], own[8];
            unpack8(*(const LAS u32x4*)(lds + O_U + ((15 + t) * LDU + c0) * 2), own);
#pragma unroll
            for (int i = 0; i < 8; ++i) s[i] = own[i];
            for (int d = 1; d < win; ++d) { float x[8]; unpack8(*(const LAS u32x4*)(lds + O_U + ((15 + t - d) * LDU + c0) * 2), x);
#pragma unroll
                for (int i = 0; i < 8; ++i) s[i] += x[i]; }
#pragma unroll
            for (int i = 0; i < 8; ++i) s[i] = s[i] * inv - own[i];
            *(LAS u32x4*)(lds + O_PL + (t * LDU + c0) * 2) = pack8(s);
        }
    }
    BLOCK_SYNC();
    {
        const bf16_t* wt = (const bf16_t*)(ws + WS_WTPOOL) + (size_t)g * 65536;
        f32x4 acc[2][4];
#pragma unroll
        for (int a = 0; a < 2; ++a)
#pragma unroll
            for (int n = 0; n < 4; ++n) acc[a][n] = (f32x4){0.f, 0.f, 0.f, 0.f};
#pragma unroll 4
        for (int ks = 0; ks < 8; ++ks) {
            bf16x8 af[2];
#pragma unroll
            for (int a = 0; a < 2; ++a) af[a] = *(const bf16x8*)(wt + (size_t)(32 * wave + 16 * a + fr) * 256 + ks * 32 + fq * 8);
#pragma unroll
            for (int n = 0; n < 4; ++n) { const bf16x8 bf = ldsfrag(lds, O_PL, LDU, 16 * n + fr, ks * 32 + fq * 8);
#pragma unroll
                for (int a = 0; a < 2; ++a) acc[a][n] = mfma16(af[a], bf, acc[a][n]); }
        }
        bf16_t* yb = (bf16_t*)(ws + WS_YAB) + 2048;
        const float* psc = P.in[I_PSCALE] + g * 256;
#pragma unroll
        for (int a = 0; a < 2; ++a) { const int d0 = 32 * wave + 16 * a + 4 * fq; const f32x4 sc = *(const f32x4*)(psc + d0);
#pragma unroll
            for (int n = 0; n < 4; ++n) { const int t = 16 * n + fr; const f32x4 o = acc[a][n] * sc;
                u32x2 w; w.x = pk2(o.x, o.y); w.y = pk2(o.z, o.w);
                *(u32x2*)(yb + (size_t)(b * SEQ + ti0 + t) * LDAB + g * 256 + d0) = w; } }
    }
    BLOCK_SYNC();
}
__device__ __forceinline__ void gsig_unit(const Params& P, int gu) {
    int tid = threadIdx.x; asm volatile("" : "+v"(tid));
    const bf16_t* pp = (const bf16_t*)(P.ws + WS_P); bf16_t* gs = (bf16_t*)(P.ws + WS_GSIG);
    const float* mu = P.in[I_MU];
#pragma unroll
    for (int it = 0; it < 4; ++it) {
        const int idx = tid + 512 * it, tl = idx >> 5, ch = idx & 31, col = C_GL + ch * 8;
        const int row = gu * 64 + tl; const int prow = ((row & (SEQ - 1)) == 0) ? (ROW_META + 15) : row - 1;
        float x[8]; shift8r(*(const u32x4*)(pp + (size_t)row * NPAD + col), *(const u32x4*)(pp + (size_t)prow * NPAD + col), mu + col, x);
#pragma unroll
        for (int i = 0; i < 8; ++i) x[i] = fast_sigmoid(x[i]);
        *(u32x4*)(gs + (size_t)row * 256 + ch * 8) = pack8(x);
    }
}
__device__ __forceinline__ void phase2(const Params& P, ldsp lds) {
    PL L;
    for (int j = blockIdx.x; j < 256 + 32 + 128; j += gridDim.x) {
        if (j < 256) {
            const int b = j >> 7, c = (j >> 1) & 63, h0 = (j & 1) * 16;
            pl_load(P, (b * 32 + h0) * 64 + c, L);
            for (int i = 0; i < 16; ++i) { const int u = (b * 32 + h0 + i) * 64 + c; rwkv_unit(P, lds, u, L, i + 1 < 16 ? u + 64 : -1, i == 0); }
        } else if (j < 288) { pl_load(P, 4096 + (j - 256), L); rwkv_unit(P, lds, 4096 + (j - 256), L, -1, true); }
        else gsig_unit(P, j - 288);
    }
}
__device__ __forceinline__ void phase3(const Params& P) {
    const int lane = threadIdx.x & 63, wave = threadIdx.x >> 6, fr = lane & 15, fq = lane >> 4;
    if (wave != 0) { convert_tables(P, CONV_P2_ROWS + blockIdx.x * 7 + (wave - 1), 32768, gridDim.x * 7); return; }
    unsigned char* ws = P.ws;
    const bf16_t* Gp = (const bf16_t*)(ws + WS_G); const bf16_t* H0t = (const bf16_t*)(ws + WS_H0T); bf16_t* S0t = (bf16_t*)(ws + WS_S0T);
    for (int item = blockIdx.x; item < 256; item += gridDim.x) {
        const int bh = item >> 2, vq = item & 3, h = bh & 31;
        bf16x8 Sb[2];
#pragma unroll
        for (int ks = 0; ks < 2; ++ks)
#pragma unroll
            for (int i = 0; i < 8; ++i) Sb[ks][i] = 0;
        bf16x8 g0[4][2], g1[4][2], g2[4][2], g3[4][2]; u32x2 h0[4], h1[4], h2[4], h3[4];
        auto load = [&](int step, bf16x8 (&ga)[4][2], u32x2 (&hf)[4]) {
            const int u = (step == 0) ? (4096 + h) : (bh * 64 + step - 1);
            const bf16_t* g = Gp + (size_t)u * 4096; const bf16_t* hh = H0t + (size_t)u * 4096;
#pragma unroll
            for (int mt = 0; mt < 4; ++mt) {
#pragma unroll
                for (int ks = 0; ks < 2; ++ks) ga[mt][ks] = *(const bf16x8*)(g + (16 * mt + fr) * 64 + ks * 32 + fq * 8);
                hf[mt] = *(const u32x2*)(hh + (16 * vq + fr) * 64 + 16 * mt + 4 * fq);
            }
        };
        auto apply = [&](int step, const bf16x8 (&ga)[4][2], const u32x2 (&hf)[4]) {
            f32x4 acc[4];
#pragma unroll
            for (int mt = 0; mt < 4; ++mt) {
                acc[mt] = (f32x4){bflo(hf[mt].x), bfhi(hf[mt].x), bflo(hf[mt].y), bfhi(hf[mt].y)};
                acc[mt] = mfma16(ga[mt][0], Sb[0], acc[mt]);
                acc[mt] = mfma16(ga[mt][1], Sb[1], acc[mt]);
            }
            bf16_t* so = S0t + (size_t)(bh * 64 + step) * 4096 + (16 * vq + fr) * 64 + 4 * fq;
            u32x2 w[4];
#pragma unroll
            for (int mt = 0; mt < 4; ++mt) { w[mt].x = pk2(acc[mt].x, acc[mt].y); w[mt].y = pk2(acc[mt].z, acc[mt].w); *(u32x2*)(so + 16 * mt) = w[mt]; }
#pragma unroll
            for (int ks = 0; ks < 2; ++ks) {
                const u32x4 q4 = (u32x4){w[2 * ks].x, w[2 * ks].y, w[2 * ks + 1].x, w[2 * ks + 1].y};
                Sb[ks] = __builtin_bit_cast(bf16x8, q4);
            }
        };
        load(0, g0, h0); load(1, g1, h1); load(2, g2, h2);
#pragma unroll 1
        for (int step = 0; step < 64; step += 4) {
            load(step + 3, g3, h3); apply(step, g0, h0);
            if (step + 4 < 64) load(step + 4, g0, h0);
            apply(step + 1, g1, h1);
            if (step + 5 < 64) load(step + 5, g1, h1);
            apply(step + 2, g2, h2);
            if (step + 6 < 64) load(step + 6, g2, h2);
            apply(step + 3, g3, h3);
        }
    }
}

constexpr int LDG = 264;
__device__ __forceinline__ void phase3b(const Params& P, ldsp lds) {
    int tid = threadIdx.x; asm volatile("" : "+v"(tid));
    const int lane = tid & 63, wave = tid >> 6, fr = lane & 15, fq = lane >> 4, wq = wave & 3;
    unsigned char* ws = P.ws;
    const bf16_t* pp = (const bf16_t*)(ws + WS_P);
    const float* mu = P.in[I_MU];
    constexpr int O_G2 = 0;
    for (int pu = blockIdx.x; pu < 512; pu += gridDim.x) pool_unit(P, lds, pu);
    for (int w = blockIdx.x; w < 256; w += gridDim.x) {
        const int h = w & 31;
        BLOCK_SYNC();
        for (int idx = tid; idx < 64 * 32; idx += 512) { const int row = idx >> 5, ch = idx & 31;
            *(LAS u32x4*)(lds + O_G2 + (row * LDG + ch * 8) * 2) = *(const u32x4*)((const bf16_t*)(ws + WS_WTG2) + (size_t)(h * 64 + row) * 256 + ch * 8); }
        BLOCK_SYNC();
        bf16x8 bG[8], bR[2], aS[4][2]; u32x2 yw[4], vc[4], vp[4]; float bon;
        auto unit_of = [&](int it, int& b, int& c) { const int q = (w >> 5) + 8 * (2 * it + (wave >> 2)); b = q >> 6; c = q & 63; };
        auto issue = [&](int it) {
            int b, c; unit_of(it, b, c); const int u = (b * 32 + h) * 64 + c, trow0 = b * SEQ + c * 64 + 16 * wq;
            const size_t ub = (size_t)u * 4096;
            const bf16_t* S0t = (const bf16_t*)(ws + WS_S0T) + ub; const bf16_t* Rt = (const bf16_t*)(ws + WS_RT) + ub; const bf16_t* Y0s = (const bf16_t*)(ws + WS_Y0) + ub;
            const int row = trow0 + fr; const int prow = (c == 0 && wq == 0 && fr == 0) ? (ROW_META + 15) : row - 1;
            const bf16_t* gsr = (const bf16_t*)(ws + WS_GSIG) + (size_t)row * 256 + fq * 8;
#pragma unroll
            for (int ks = 0; ks < 8; ++ks) bG[ks] = *(const bf16x8*)(gsr + ks * 32);
#pragma unroll
            for (int ks = 0; ks < 2; ++ks) bR[ks] = *(const bf16x8*)(Rt + (16 * wq + fr) * 64 + ks * 32 + fq * 8);
#pragma unroll
            for (int mt = 0; mt < 4; ++mt) {
                yw[mt] = *(const u32x2*)(Y0s + (16 * wq + fr) * 64 + 16 * mt + 4 * fq);
#pragma unroll
                for (int ks = 0; ks < 2; ++ks) aS[mt][ks] = *(const bf16x8*)(S0t + (16 * mt + fr) * 64 + ks * 32 + fq * 8);
                const int hc = h * 64 + 16 * mt + 4 * fq;
                vc[mt] = *(const u32x2*)(pp + (size_t)row * NPAD + C_V + hc); vp[mt] = *(const u32x2*)(pp + (size_t)prow * NPAD + C_V + hc);
            }
            bon = ((const float*)(ws + WS_BONUS))[(size_t)row * 32 + h];
        };
        issue(0);
#pragma unroll 1
        for (int it = 0; it < 8; ++it) {
            int b, c; unit_of(it, b, c);
            const int row = b * SEQ + c * 64 + 16 * wq + fr;
            f32x4 gacc[4];
#pragma unroll
            for (int mt = 0; mt < 4; ++mt) gacc[mt] = (f32x4){0.f, 0.f, 0.f, 0.f};
#pragma unroll
            for (int ks = 0; ks < 8; ++ks)
#pragma unroll
                for (int mt = 0; mt < 4; ++mt) gacc[mt] = mfma16(*(const LAS bf16x8*)(lds + O_G2 + ((16 * mt + fr) * LDG + ks * 32 + fq * 8) * 2), bG[ks], gacc[mt]);
            f32x4 y[4], vv[4]; const float bonc = bon;
#pragma unroll
            for (int mt = 0; mt < 4; ++mt) {
                y[mt] = (f32x4){bflo(yw[mt].x), bfhi(yw[mt].x), bflo(yw[mt].y), bfhi(yw[mt].y)};
#pragma unroll
                for (int ks = 0; ks < 2; ++ks) y[mt] = mfma16(aS[mt][ks], bR[ks], y[mt]);
                const f32x4 mv = *(const f32x4*)(mu + C_V + h * 64 + 16 * mt + 4 * fq);
                const f32x4 cv = (f32x4){bflo(vc[mt].x), bfhi(vc[mt].x), bflo(vc[mt].y), bfhi(vc[mt].y)}, pv = (f32x4){bflo(vp[mt].x), bfhi(vp[mt].x), bflo(vp[mt].y), bfhi(vp[mt].y)};
                vv[mt] = cv + (pv - cv) * mv;
            }
#pragma unroll
            for (int mt = 0; mt < 4; ++mt) asm volatile("" : "+v"(y[mt]), "+v"(vv[mt]), "+v"(gacc[mt]));
            if (it + 1 < 8) issue(it + 1);
            float s = 0.f;
#pragma unroll
            for (int mt = 0; mt < 4; ++mt) s += (y[mt].x + y[mt].y) + (y[mt].z + y[mt].w);
            s += __shfl_xor(s, 16); s += __shfl_xor(s, 32);
            const float mean = s * (1.0f / 64.0f); float qq = 0.f;
#pragma unroll
            for (int mt = 0; mt < 4; ++mt) { y[mt] = y[mt] - mean; qq += (y[mt].x * y[mt].x + y[mt].y * y[mt].y) + (y[mt].z * y[mt].z + y[mt].w * y[mt].w); }
            qq += __shfl_xor(qq, 16); qq += __shfl_xor(qq, 32);
            const float rstd = 1.0f / sqrtf(qq * (1.0f / 64.0f) + GN_EPS);
            bf16_t* ya = (bf16_t*)(ws + WS_YAB) + (size_t)row * LDAB + h * 64;
#pragma unroll
            for (int mt = 0; mt < 4; ++mt) {
                const int i0 = 16 * mt + 4 * fq, hc = h * 64 + i0;
                const f32x4 gg = *(const f32x4*)(P.in[I_GNG] + hc), gb = *(const f32x4*)(P.in[I_GNB] + hc);
                const f32x4 o = (y[mt] * rstd * gg + gb + vv[mt] * bonc) * gacc[mt];
                u32x2 wv; wv.x = pk2(o.x, o.y); wv.y = pk2(o.z, o.w);
                *(u32x2*)(ya + i0) = wv;
            }
        }
    }
}
__device__ __forceinline__ u32x6 ld_row6(const unsigned char* p) { const u32x2 a = ((const u32x2*)p)[0], b = ((const u32x2*)p)[1], c = ((const u32x2*)p)[2]; return (u32x6){a.x, a.y, b.x, b.y, c.x, c.y}; }
__device__ __forceinline__ void peer_token(const Params& P, int tok, const LAS int* eidx, const LAS float* gts) {
    const int lane = threadIdx.x & 63;
    unsigned char* ws = P.ws;
    const unsigned char* Ub = ws + WS_UB; const unsigned char* Vb = ws + WS_VB;
    const float* tsc = (const float*)(ws + WS_TSC);
    {
        int lo = lane; asm volatile("" : "+v"(lo));
        float x[32], o[32];
        {
            const bf16_t* hr = (const bf16_t*)(ws + WS_X1B) + (size_t)tok * D + lo * 4;
#pragma unroll
            for (int j = 0; j < 8; ++j) { const u32x2 w = *(const u32x2*)(hr + 256 * j); x[4 * j] = bflo(w.x); x[4 * j + 1] = bfhi(w.x); x[4 * j + 2] = bflo(w.y); x[4 * j + 3] = bfhi(w.y); }
            const float* st = (const float*)(ws + WS_STAT);
            const float mean1 = st[tok] * (1.0f / D), rstd1 = 1.0f / sqrtf(fmaxf(st[8192 + tok] * (1.0f / D) - mean1 * mean1, 0.f) + LN_EPS);
#pragma unroll
            for (int c = 0; c < 8; ++c) { const f32x4 g1 = *(const f32x4*)(P.in[I_LN1G] + lo * 4 + 256 * c), b1 = *(const f32x4*)(P.in[I_LN1B] + lo * 4 + 256 * c);
                x[4 * c] = (x[4 * c] - mean1) * rstd1 * g1.x + b1.x; x[4 * c + 1] = (x[4 * c + 1] - mean1) * rstd1 * g1.y + b1.y; x[4 * c + 2] = (x[4 * c + 2] - mean1) * rstd1 * g1.z + b1.z; x[4 * c + 3] = (x[4 * c + 3] - mean1) * rstd1 * g1.w + b1.w; }
#pragma unroll
            for (int i = 0; i < 32; ++i) o[i] = 0.f;
        }
        const int e_lo = eidx[lo], e_hi = eidx[64 + lo];
        const float su_lo = tsc[e_lo], su_hi = tsc[e_hi];
        const float gv_lo = gts[lo] * tsc[16384 + e_lo], gv_hi = gts[64 + lo] * tsc[16384 + e_hi];
        u32x4 ua[2], ub[2], va[2], vb[2];
        auto issue = [&](int g, u32x4 (&uu)[2], u32x4 (&vv)[2]) {
            const int ev = (g < 32) ? e_lo : e_hi;
#pragma unroll
            for (int j = 0; j < 2; ++j) {
                const int e = __builtin_amdgcn_readlane(ev, (2 * g + j) & 63);
                uu[j] = *(const u32x4*)(Ub + (size_t)e * UROW + lo * 16); vv[j] = *(const u32x4*)(Vb + (size_t)e * UROW + lo * 16);
            }
        };
        auto consume = [&](int g, const u32x4 (&uu)[2], const u32x4 (&vv)[2]) {
            const float suv = (g < 32) ? su_lo : su_hi, gvv = (g < 32) ? gv_lo : gv_hi;
            float dd[2];
#pragma unroll
            for (int j = 0; j < 2; ++j) { float s0 = 0.f, s1 = 0.f; const unsigned ww[4] = {uu[j].x, uu[j].y, uu[j].z, uu[j].w};
#pragma unroll
                for (int q4 = 0; q4 < 4; ++q4) {
                    const f32x2 r0 = __builtin_amdgcn_cvt_scalef32_pk_f32_fp4(ww[q4], 1.0f, 0), r1 = __builtin_amdgcn_cvt_scalef32_pk_f32_fp4(ww[q4], 1.0f, 1), r2 = __builtin_amdgcn_cvt_scalef32_pk_f32_fp4(ww[q4], 1.0f, 2), r3 = __builtin_amdgcn_cvt_scalef32_pk_f32_fp4(ww[q4], 1.0f, 3);
                    s0 += r0.x * x[8 * q4] + r1.x * x[8 * q4 + 2] + r2.x * x[8 * q4 + 4] + r3.x * x[8 * q4 + 6];
                    s1 += r0.y * x[8 * q4 + 1] + r1.y * x[8 * q4 + 3] + r2.y * x[8 * q4 + 5] + r3.y * x[8 * q4 + 7]; }
                dd[j] = s0 + s1; }
#pragma unroll
            for (int j = 0; j < 2; ++j) dd[j] = wave_sum_dpp(dd[j]);
            const int l0 = (2 * g) & 63;
            const pg8::f32x2 ge = pg8::gelu_pk((pg8::f32x2){dd[0] * readlane_f(suv, l0), dd[1] * readlane_f(suv, l0 + 1)});
            const float a0 = ge.x * readlane_f(gvv, l0), a1 = ge.y * readlane_f(gvv, l0 + 1);
#pragma unroll
            for (int j = 0; j < 2; ++j) { const float aj = j ? a1 : a0; const unsigned ww[4] = {vv[j].x, vv[j].y, vv[j].z, vv[j].w};
#pragma unroll
                for (int q4 = 0; q4 < 4; ++q4) {
                    const f32x2 r0 = __builtin_amdgcn_cvt_scalef32_pk_f32_fp4(ww[q4], 1.0f, 0), r1 = __builtin_amdgcn_cvt_scalef32_pk_f32_fp4(ww[q4], 1.0f, 1), r2 = __builtin_amdgcn_cvt_scalef32_pk_f32_fp4(ww[q4], 1.0f, 2), r3 = __builtin_amdgcn_cvt_scalef32_pk_f32_fp4(ww[q4], 1.0f, 3);
                    o[8 * q4] += aj * r0.x; o[8 * q4 + 1] += aj * r0.y; o[8 * q4 + 2] += aj * r1.x; o[8 * q4 + 3] += aj * r1.y; o[8 * q4 + 4] += aj * r2.x; o[8 * q4 + 5] += aj * r2.y; o[8 * q4 + 6] += aj * r3.x; o[8 * q4 + 7] += aj * r3.y; } }
        };
        issue(0, ua, va);
        for (int g = 0; g < 64; g += 2) {
            issue(g + 1, ub, vb);
            consume(g, ua, va);
            if (g + 2 < 64) issue(g + 2, ua, va);
            consume(g + 1, ub, vb);
        }
        float s = 0.f;
#pragma unroll
        for (int i = 0; i < 32; ++i) { o[i] += DN_ALPHA * x[i]; s += o[i]; }
        const float mean = wave_sum_dpp(s) * (1.0f / D); float q = 0.f;
#pragma unroll
        for (int i = 0; i < 32; ++i) { o[i] -= mean; q += o[i] * o[i]; }
        const float rstd = 1.0f / sqrtf(wave_sum_dpp(q) * (1.0f / D) + LN_EPS);
        float* orow = P.out + (size_t)tok * D;
#pragma unroll
        for (int c = 0; c < 8; ++c) {
            const int off = lo * 4 + 256 * c;
            const f32x4 g0 = *(const f32x4*)(P.in[I_LN2G] + off), b0 = *(const f32x4*)(P.in[I_LN2B] + off);
            f32x4 r0;
            r0.x = o[4 * c + 0] * rstd * g0.x + b0.x; r0.y = o[4 * c + 1] * rstd * g0.y + b0.y; r0.z = o[4 * c + 2] * rstd * g0.z + b0.z; r0.w = o[4 * c + 3] * rstd * g0.w + b0.w;
            *(f32x4*)(orow + off) = r0;
        }
    }
}
#define CE_DESC(a, b) do { const float h_ = fmaxf((a), (b)), l_ = fminf((a), (b)); (a) = h_; (b) = l_; } while (0)
template <int N> __device__ __forceinline__ void bitonic_sort_desc(float (&v)[N]) {
#pragma unroll
    for (int k = 2; k <= N; k <<= 1)
#pragma unroll
        for (int j = k >> 1; j > 0; j >>= 1)
#pragma unroll
            for (int i = 0; i < N; ++i) { const int l = i ^ j; if (l > i) { if ((i & k) == 0) CE_DESC(v[i], v[l]); else CE_DESC(v[l], v[i]); } }
}
template <int N> __device__ __forceinline__ void bitonic_merge_desc(float (&v)[N]) {
#pragma unroll
    for (int j = N >> 1; j > 0; j >>= 1)
#pragma unroll
        for (int i = 0; i < N; ++i) { const int l = i ^ j; if (l > i) CE_DESC(v[i], v[l]); }
}
__device__ __forceinline__ void top16_merge(float (&a)[16], const float (&brev)[16]) {
#pragma unroll
    for (int i = 0; i < 16; ++i) a[i] = fmaxf(a[i], brev[i]);
    bitonic_merge_desc<16>(a);
}
__device__ __forceinline__ float embed_bits(float v, unsigned code, unsigned mask) { return __uint_as_float((__float_as_uint(v) & ~mask) | code); }

__device__ __forceinline__ void phase7(const Params& P, ldsp lds) {
    const int tid0 = threadIdx.x;
    unsigned char* ws = P.ws;
    const bf16_t* qb = (const bf16_t*)(ws + WS_Q); const bf16_t* sk = (const bf16_t*)(ws + WS_SUBK);
    constexpr int LDSK = 136, O_SK = 0, O_SV = 2 * 128 * LDSK * 2, O_EX = O_SV + 32768, O_GT = O_EX + 16384;
    for (int idx = tid0; idx < 2 * 128 * 16; idx += 512) { const int row = idx >> 4, ch = idx & 15;
        *(LAS u32x4*)(lds + O_SK + (row * LDSK + ch * 8) * 2) = *(const u32x4*)(sk + row * 128 + ch * 8); }
    BLOCK_SYNC();
    for (int tile = blockIdx.x; tile < 256; tile += gridDim.x) {
        int tid = tid0; asm volatile("" : "+v"(tid));
        const int lane = tid & 63, wave = tid >> 6, fr = lane & 15, fq = lane >> 4, fro = fr, fqo = fq;
        const int tok0 = tile * 32, h = wave;
#pragma unroll 1
        for (int cb = 0; cb < 4; ++cb) {
            const int nt = cb >> 1, p = cb & 1;
            f32x4 acc[8];
#pragma unroll
            for (int mt = 0; mt < 8; ++mt) acc[mt] = (f32x4){0.f, 0.f, 0.f, 0.f};
            const bf16_t* qrow = qb + (size_t)(tok0 + 16 * nt + fro) * D + h * 256 + p * 128 + fqo * 8;
#pragma unroll
            for (int ks = 0; ks < 4; ++ks) {
                const bf16x8 bq = *(const bf16x8*)(qrow + ks * 32);
#pragma unroll
                for (int mt = 0; mt < 8; ++mt) acc[mt] = mfma16(*(const LAS bf16x8*)(lds + O_SK + ((p * 128 + 16 * mt + fro) * LDSK + ks * 32 + fqo * 8) * 2), bq, acc[mt]);
            }
            float a[16], b[16];
#pragma unroll
            for (int mt = 0; mt < 4; ++mt) {
                a[4 * mt + 0] = embed_bits(acc[mt].x, 16 * mt + 4 * fq + 0, 127u); a[4 * mt + 1] = embed_bits(acc[mt].y, 16 * mt + 4 * fq + 1, 127u);
                a[4 * mt + 2] = embed_bits(acc[mt].z, 16 * mt + 4 * fq + 2, 127u); a[4 * mt + 3] = embed_bits(acc[mt].w, 16 * mt + 4 * fq + 3, 127u);
                b[4 * mt + 0] = embed_bits(acc[mt + 4].x, 16 * (mt + 4) + 4 * fq + 0, 127u); b[4 * mt + 1] = embed_bits(acc[mt + 4].y, 16 * (mt + 4) + 4 * fq + 1, 127u);
                b[4 * mt + 2] = embed_bits(acc[mt + 4].z, 16 * (mt + 4) + 4 * fq + 2, 127u); b[4 * mt + 3] = embed_bits(acc[mt + 4].w, 16 * (mt + 4) + 4 * fq + 3, 127u);
            }
            bitonic_sort_desc<16>(a); bitonic_sort_desc<16>(b);
            { float br[16];
#pragma unroll
              for (int i = 0; i < 16; ++i) br[i] = b[15 - i];
              top16_merge(a, br); }
#pragma unroll
            for (int x = 16; x <= 32; x <<= 1) { float br[16];
#pragma unroll
                for (int i = 0; i < 16; ++i) br[i] = __shfl_xor(a[15 - i], x);
                top16_merge(a, br); }
            if (fq == 0) { LAS f32x4* o = (LAS f32x4*)(lds + O_SV + ((((16 * nt + fr) * 8 + h) * 2 + p) * 16) * 4);
                o[0] = (f32x4){a[0], a[1], a[2], a[3]}; o[1] = (f32x4){a[4], a[5], a[6], a[7]}; o[2] = (f32x4){a[8], a[9], a[10], a[11]}; o[3] = (f32x4){a[12], a[13], a[14], a[15]}; }
        }
        BLOCK_SYNC();
        if (tid < 256) {
            const int tok = tid >> 3, hh = tid & 7;
            const LAS f32x4* s = (const LAS f32x4*)(lds + O_SV + (((tok * 8 + hh) * 2) * 16) * 4);
            float s0[16], s1[16];
#pragma unroll
            for (int c4 = 0; c4 < 4; ++c4) { const f32x4 x = s[c4], y = s[4 + c4]; s0[4 * c4] = x.x; s0[4 * c4 + 1] = x.y; s0[4 * c4 + 2] = x.z; s0[4 * c4 + 3] = x.w; s1[4 * c4] = y.x; s1[4 * c4 + 1] = y.y; s1[4 * c4 + 2] = y.z; s1[4 * c4 + 3] = y.w; }
            float g0[16], g1[16], g2[16], g3[16];
            const float NEG = -3.0e38f;
#pragma unroll
            for (int bq = 0; bq < 16; ++bq) g0[bq] = embed_bits(s0[0] + s1[bq], bq, 255u);
            {
                int n1 = 0, n2 = 0, n3 = 0;
#pragma unroll
                for (int aa = 1; aa < 16; ++aa)
#pragma unroll
                    for (int bb = 0; bb < 16; ++bb) if ((aa + 1) * (bb + 1) <= 16) {
                        const float c = embed_bits(s0[aa] + s1[bb], aa * 16 + bb, 255u);
                        if (n1 < 16) g1[n1++] = c; else if (n2 < 16) g2[n2++] = c; else g3[n3++] = c;
                    }
#pragma unroll
                for (int i = 0; i < 16; ++i) if (i >= n3) g3[i] = NEG;
            }
            bitonic_sort_desc<16>(g1); bitonic_sort_desc<16>(g2); bitonic_sort_desc<16>(g3);
            { float r1[16], r3[16];
#pragma unroll
              for (int i = 0; i < 16; ++i) { r1[i] = g1[15 - i]; r3[i] = g3[15 - i]; }
              top16_merge(g0, r1); top16_merge(g2, r3);
#pragma unroll
              for (int i = 0; i < 16; ++i) g0[i] = fmaxf(g0[i], g2[15 - i]); }
            float mx = g0[0];
#pragma unroll
            for (int i = 1; i < 16; ++i) mx = fmaxf(mx, g0[i]);
            float ex[16], sm = 0.f; int ee[16];
#pragma unroll
            for (int i = 0; i < 16; ++i) {
                ex[i] = __expf(g0[i] - mx); sm += ex[i];
                const unsigned code = __float_as_uint(g0[i]) & 255u;
                const unsigned i0 = __float_as_uint(*(const LAS float*)(lds + O_SV + ((((tok * 8 + hh) * 2 + 0) * 16) + (code >> 4)) * 4)) & 127u;
                const unsigned i1 = __float_as_uint(*(const LAS float*)(lds + O_SV + ((((tok * 8 + hh) * 2 + 1) * 16) + (code & 15u)) * 4)) & 127u;
                ee[i] = (int)(i0 * 128u + i1);
            }
            const float inv = 1.0f / sm;
            LAS int* eo = (LAS int*)(lds + O_EX) + tok * 128 + hh * 16; LAS float* go = (LAS float*)(lds + O_GT) + tok * 128 + hh * 16;
#pragma unroll
            for (int c4 = 0; c4 < 4; ++c4) {
                *(LAS u32x4*)(eo + 4 * c4) = (u32x4){(unsigned)ee[4 * c4], (unsigned)ee[4 * c4 + 1], (unsigned)ee[4 * c4 + 2], (unsigned)ee[4 * c4 + 3]};
                *(LAS f32x4*)(go + 4 * c4) = (f32x4){ex[4 * c4] * inv, ex[4 * c4 + 1] * inv, ex[4 * c4 + 2] * inv, ex[4 * c4 + 3] * inv};
            }
        }
        BLOCK_SYNC();
#pragma unroll 1
        for (int i = 0; i < 4; ++i) peer_token(P, tok0 + wave * 4 + i, (const LAS int*)(lds + O_EX) + (wave * 4 + i) * 128, (const LAS float*)(lds + O_GT) + (wave * 4 + i) * 128);
        BLOCK_SYNC();
    }
}
#ifndef MK_MULTI
#define MK_MULTI 0
#endif
__global__ __launch_bounds__(512, 2) void hybrid_fwd(Params P) {
    extern __shared__ __attribute__((aligned(16))) unsigned char shm[];
    ldsp lds = (ldsp)shm;
    unsigned char* ws = P.ws;
    volatile LAS unsigned* xst = (volatile LAS unsigned*)(lds + LDS_BYTES - 16);
    if (threadIdx.x == 0) { xst[0] = 0u; xst[1] = 0u; }
    __syncthreads();
    const XcdBarrier xbar = xcd_barrier_post((unsigned*)(ws + WS_BAR), xst);
    const int lo = P.ph_lo, hi = P.ph_hi;
#ifdef DBG_TA
    unsigned long long ts0 = 0, ts1 = 0, ts2 = 0, ts3 = 0, ts4 = 0, ts5 = 0, ts6 = 0, ts7 = 0, ts8 = 0, ts9 = 0, ts10 = 0, ts11 = 0;
#define STAMP(k) ts##k = __builtin_amdgcn_s_memrealtime()
#else
#define STAMP(k) do { } while (0)
#endif
    STAMP(0);
#ifndef REPEAT_PHASE
#define REPEAT_PHASE -1
#define REPEAT_N 1
#endif
#define PHASE(k) if (lo <= (k) && (k) < hi) for (int rep_ = 0; rep_ < ((k) == REPEAT_PHASE ? REPEAT_N : 1); ++rep_)
#define SEAM(k) do { if (lo <= (k) && (k) + 1 < hi) xcd_barrier(xbar); } while (0)
    PHASE(0) phase0(P);
    SEAM(0); STAMP(1);
    PHASE(1) { pg8::EpiBf16<0> E; E.O = (bf16_t*)(ws + WS_P); E.ldc = NPAD; E.bias = nullptr; E.split_cols = 0; E.split_stride = 0;
        run_gemm(lds, (const bf16_t*)(ws + WS_H0B), (const bf16_t*)(ws + WS_WTIN), MROWS, NPAD, 2048, E); }
    SEAM(1); STAMP(2);
    PHASE(2) phase2(P, lds);
    SEAM(2); STAMP(3);
    PHASE(3) phase3(P);
    SEAM(3); STAMP(4);
    PHASE(4) phase3b(P, lds);
    SEAM(4); STAMP(5);
    PHASE(5) {
        { pg8::EpiGate35 E; E.O = (bf16_t*)(ws + WS_MERGED); E.p = (const bf16_t*)(ws + WS_P); E.bgate = P.in[I_BGATE];
          run_gemm(lds, (const bf16_t*)(ws + WS_YAB), (const bf16_t*)(ws + WS_WTAB), NTOK, 2048, LDAB, E); }
    }
    SEAM(5); STAMP(6);
    PHASE(6) { pg8::EpiResidStats E; E.O = (bf16_t*)(ws + WS_X1B); E.h0 = (const bf16_t*)(ws + WS_H0B); E.alpha = DN_ALPHA; E.rsum = (float*)(ws + WS_STAT); E.rsq = (float*)(ws + WS_STAT) + 8192;
        run_gemm(lds, (const bf16_t*)(ws + WS_MERGED), (const bf16_t*)(ws + WS_WTOUT), NTOK, 2048, 2048, E); }
    SEAM(6); STAMP(7);
    PHASE(7) { pg8::EpiQ E; E.O = (bf16_t*)(ws + WS_Q); E.rsum = (const float*)(ws + WS_STAT); E.rsq = (const float*)(ws + WS_STAT) + 8192; E.c1 = (const float*)(ws + WS_STAT) + 16384; E.c2 = (const float*)(ws + WS_STAT) + 18432;
        run_gemm(lds, (const bf16_t*)(ws + WS_X1B), (const bf16_t*)(ws + WS_WTQ), NTOK, 2048, 2048, E); }
    SEAM(7); STAMP(8);
    PHASE(8) phase7(P, lds);
#ifdef DBG_TA
    {
        __threadfence_system(); asm volatile("s_waitcnt vmcnt(0) lgkmcnt(0)" ::: "memory"); __syncthreads(); grid.sync(); __threadfence_system();
        STAMP(11);
        const unsigned long long tt[12] = {ts0, ts1, ts2, ts3, ts4, ts5, ts6, ts7, ts8, ts8, ts8, ts11};
        const float ta = (float)(tt[DBG_TA + 1] - tt[DBG_TA]) * 0.01f, tb = (float)(tt[DBG_TB + 1] - tt[DBG_TB]) * 0.01f;
        if (blockIdx.x == 0) { for (int i = threadIdx.x + 1; i <= 1000000; i += 512) P.out[i] = tb; if (threadIdx.x == 0) P.out[0] = 1000.0f * ta; }
    }
#endif
#ifdef DBG_STOP
    {
        __threadfence_system(); asm volatile("s_waitcnt vmcnt(0) lgkmcnt(0)" ::: "memory"); __syncthreads(); grid.sync(); __threadfence_system();
        const size_t a = DBG_A, b = DBG_B; const unsigned* w = (const unsigned*)(ws + a); const size_t nw = (b - a) / 4, NO = (size_t)NTOK * D;
        for (size_t i = (size_t)blockIdx.x * 512 + threadIdx.x; i < NO; i += (size_t)gridDim.x * 512) {
            unsigned acc = 0; for (size_t j = i; j < nw; j += NO) { const unsigned x = w[j]; acc += (x & 0xffffu) + (x >> 16); }
            P.out[i] = (float)(acc & 0xfffffu);
        }
    }
#endif
#undef PHASE
#undef SEAM
}

extern "C" void kernel_launch(void* const* d_in, const int* in_sizes, int n_in, void* d_out, int out_size, void* d_ws, size_t ws_size, hipStream_t stream) {
    static int grid = 0;
    if (grid == 0) {
        if (n_in != 30 || out_size != NTOK * D || ws_size < WS_END) { fprintf(stderr, "kernel_launch: unexpected shapes (n_in %d, out %d, ws %zu < %zu)\n", n_in, out_size, ws_size, (size_t)WS_END); grid = -1; return; }
        int dev = 0, cus = 0, per_cu = 0;
        if (hipGetDevice(&dev) != hipSuccess || hipDeviceGetAttribute(&cus, hipDeviceAttributeMultiprocessorCount, dev) != hipSuccess) { grid = -1; return; }
        if (hipFuncSetAttribute((const void*)hybrid_fwd, hipFuncAttributeMaxDynamicSharedMemorySize, LDS_BYTES) != hipSuccess) { fprintf(stderr, "kernel_launch: hipFuncSetAttribute failed\n"); grid = -1; return; }
        if (hipOccupancyMaxActiveBlocksPerMultiprocessor(&per_cu, (const void*)hybrid_fwd, 512, LDS_BYTES) != hipSuccess || per_cu < 1) { fprintf(stderr, "kernel_launch: occupancy query says %d\n", per_cu); grid = -1; return; }
        (void)hipGetLastError();
        grid = cus;
    }
    if (grid < 0) return;
    if (hipMemsetAsync((unsigned char*)d_ws + WS_BAR, 0, 16384 + STAT_BYTES, stream) != hipSuccess) { fprintf(stderr, "kernel_launch: memset failed\n"); return; }
    Params p{};
    for (int i = 0; i < 30; ++i) p.in[i] = (const float*)d_in[i];
    p.out = (float*)d_out; p.ws = (unsigned char*)d_ws;
#if MK_MULTI
    for (int ph = 0; ph <= NPHASE; ++ph) { p.ph_lo = ph; p.ph_hi = ph + 1; hipLaunchKernelGGL(hybrid_fwd, dim3(grid), dim3(512), LDS_BYTES, stream, p); }
#else
    p.ph_lo = 0; p.ph_hi = NPHASE + 1;
#ifdef DBG_STOP
    p.ph_hi = DBG_STOP + 1;
#endif
    void* args[] = {&p};
    hipError_t e = hipLaunchCooperativeKernel((const void*)hybrid_fwd, dim3(grid), dim3(512), args, LDS_BYTES, stream);
    if (e != hipSuccess) fprintf(stderr, "kernel_launch: cooperative launch failed: %s (grid %d)\n", hipGetErrorString(e), grid);
#endif
}
```

```cpp
#include <hip/hip_runtime.h>
#include <cstdio>
#include <cstdint>
namespace pg8 {
#define PG8_LAS __attribute__((address_space(3)))
typedef unsigned short bf16_t;
typedef short bf16x8 __attribute__((ext_vector_type(8)));
typedef float f32x4 __attribute__((ext_vector_type(4)));
typedef unsigned u32x4 __attribute__((ext_vector_type(4)));
constexpr int BM = 256, BK = 64, HALF = 128, HTB = HALF * BK * 2  , STAGE_BYTES = 8 * HTB, NXCD = 8, WGM = 8;

__host__ __device__ __forceinline__ int lds_byte(int r, int c) { const int st = (r >> 4) * 2 + (c >> 5), rr = r & 15, cc = c & 31, ob = rr * 64 + cc * 2; return st * 1024 + (ob ^ (((ob >> 9) & 1) << 5)); }
__host__ __device__ __forceinline__ void stage_rc(int b, int& R, int& C) { const int st = b / 1024, sb = b % 1024, swz = sb ^ (((sb >> 9) & 1) << 5); R = (st >> 1) * 16 + swz / 64; C = (st & 1) * 32 + (swz % 64) / 2; }
__host__ __device__ __forceinline__ int perm32(int rho) { const int n = rho >> 4, i = rho & 15; return 8 * (i >> 2) + 4 * n + (i & 3); }

struct Unit { int pm, pn; };
struct Gemm { const bf16_t* A; const bf16_t* Bt; int M, N, K; };

struct StaticOrder {
    int nM, nN, nwg, G, c;
    __host__ __device__ void init(int M, int N, int G_, int c_) { nM = M / BM; nN = N / BM; nwg = nM * nN; G = G_; c = c_; }
    __host__ __device__ bool next(int i, Unit& u) const {
        const long L = (long)i * G + c; if (L >= nwg) return false;
        int wgid = (int)L; { const int q = nwg / NXCD, r = nwg % NXCD, xcd = wgid % NXCD, off = wgid / NXCD; wgid = (xcd < r ? xcd * (q + 1) : r * (q + 1) + (xcd - r) * q) + off; }
        const int nig = WGM * nN, gid = wgid / nig, fm = gid * WGM, gsz = (nM - fm) < WGM ? (nM - fm) : WGM;
        u.pm = fm + ((wgid % nig) % gsz); u.pn = (wgid % nig) / gsz; return true;
    }
    __device__ __forceinline__ void a_ready(const Unit&) const {}
    __device__ __forceinline__ void done(const Unit&) const {}
};
struct CountedOrder : StaticOrder {
    const unsigned* ready; unsigned need; unsigned* tmo;
    __device__ __forceinline__ void a_ready(const Unit& u) const {
        if (threadIdx.x < 64) {
            const unsigned long long t0 = __builtin_amdgcn_s_memrealtime(); unsigned polls = 0;
            while ((unsigned)__builtin_amdgcn_readfirstlane(__hip_atomic_load(ready + 64 * u.pm, __ATOMIC_RELAXED, __HIP_MEMORY_SCOPE_AGENT)) < need) {
                if ((++polls & 255u) == 0u && __builtin_amdgcn_readfirstlane(__hip_atomic_load(tmo, __ATOMIC_RELAXED, __HIP_MEMORY_SCOPE_AGENT)) != 0u) break;
                if (__builtin_amdgcn_s_memrealtime() - t0 > 2000000ull) {
                    if (threadIdx.x == 0) { unsigned expect = 0u; __hip_atomic_compare_exchange_strong(tmo + 1, &expect, 0x600u | (unsigned)(u.pm & 0xff), __ATOMIC_RELAXED, __ATOMIC_RELAXED, __HIP_MEMORY_SCOPE_AGENT); __hip_atomic_store(tmo, 1u, __ATOMIC_RELAXED, __HIP_MEMORY_SCOPE_AGENT); }
                    break; }
                __builtin_amdgcn_s_sleep(2); }
            __builtin_amdgcn_fence(__ATOMIC_ACQUIRE, "agent");
            asm volatile("s_waitcnt vmcnt(0)" ::: "memory");
        }
#if !defined(BROKEN_HOOK_NO_BARRIER)
        asm volatile("" ::: "memory"); __builtin_amdgcn_s_barrier(); asm volatile("" ::: "memory");
#endif
    }
};

typedef float cvt_f32x2 __attribute__((ext_vector_type(2))); typedef __bf16 cvt_bf16x2 __attribute__((ext_vector_type(2)));
__device__ __forceinline__ unsigned cvt_pk_bf16(float lo, float hi) { const cvt_f32x2 v = {lo, hi}; const cvt_bf16x2 b = __builtin_convertvector(v, cvt_bf16x2); return __builtin_bit_cast(unsigned, b); }
typedef float f32x2 __attribute__((ext_vector_type(2)));
__device__ __forceinline__ f32x2 gelu_pk(f32x2 v) {
    const f32x2 av = __builtin_elementwise_abs(v), d = av * 0.2316418882f + 1.0f;
    f32x2 t; t.x = __builtin_amdgcn_rcpf(d.x); t.y = __builtin_amdgcn_rcpf(d.y);
    f32x2 q = t * 0.5307027145f + (-0.7265760135f); q = q * t + 0.7107068705f; q = q * t + (-0.142248368f); q = q * t + 0.127414796f; q = q * t;
    const f32x2 s = (v * v) * (-0.72134752044f);
    f32x2 e; e.x = __builtin_amdgcn_exp2f(s.x); e.y = __builtin_amdgcn_exp2f(s.y);
    const f32x2 m = v * (q * e), r = v - m;
    f32x2 o; o.x = v.x < 0.f ? m.x : r.x; o.y = v.y < 0.f ? m.y : r.y; return o;
}

struct EpiF32 {
    static constexpr bool PERM = false, AFTER_DRAIN = false; static constexpr int MID_T = -1;
    float* C; int ldc; const float* bias;
    __device__ __forceinline__ void operator()(const f32x4 (&acc)[2][2][4][2], const Unit& u, int wr, int wc, int fr, int fq) const {
        const int row0 = u.pm * BM + wr * 64 + fr, col0 = u.pn * BM + wc * 32 + 4 * fq;
        f32x4 bv[2][2];
#pragma unroll
        for (int bj = 0; bj < 2; ++bj)
#pragma unroll
            for (int n = 0; n < 2; ++n) bv[bj][n] = bias ? *(const f32x4*)(bias + col0 + bj * HALF + n * 16) : (f32x4){0.f, 0.f, 0.f, 0.f};
#pragma unroll
        for (int ai = 0; ai < 2; ++ai)
#pragma unroll
            for (int m = 0; m < 4; ++m) { float* rowp = C + (size_t)(row0 + ai * HALF + m * 16) * ldc + col0;
#pragma unroll
                for (int bj = 0; bj < 2; ++bj)
#pragma unroll
                    for (int n = 0; n < 2; ++n) *(f32x4*)(rowp + bj * HALF + n * 16) = acc[ai][bj][m][n] + bv[bj][n]; }
    }
};
template <int ACT  > struct EpiBf16 {
    static constexpr bool PERM = true, AFTER_DRAIN = false; static constexpr int MID_T = -1;
    bf16_t* O; int ldc; const float* bias; int split_cols; size_t split_stride;
    __device__ __forceinline__ void operator()(const f32x4 (&acc)[2][2][4][2], const Unit& u, int wr, int wc, int fr, int fq) const {
        const int row0 = u.pm * BM + wr * 64 + fr; int colt = u.pn * BM; bf16_t* base = O;
        if (split_cols) { const int t = colt / split_cols; base += (size_t)t * split_stride; colt -= t * split_cols; }
        const int col0 = colt + wc * 32 + 8 * fq, bcol0 = u.pn * BM + wc * 32 + 8 * fq;
        f32x4 bv[2][2];
#pragma unroll
        for (int bj = 0; bj < 2; ++bj)
#pragma unroll
            for (int n = 0; n < 2; ++n) bv[bj][n] = bias ? *(const f32x4*)(bias + bcol0 + bj * HALF + 4 * n) : (f32x4){0.f, 0.f, 0.f, 0.f};
#pragma unroll
        for (int ai = 0; ai < 2; ++ai)
#pragma unroll
            for (int m = 0; m < 4; ++m) { bf16_t* rowp = base + (size_t)(row0 + ai * HALF + m * 16) * ldc + col0;
#pragma unroll
                for (int bj = 0; bj < 2; ++bj) { f32x4 v0 = acc[ai][bj][m][0] + bv[bj][0], v1 = acc[ai][bj][m][1] + bv[bj][1];
                    if (ACT == 1) { f32x2 a = gelu_pk((f32x2){v0[0], v0[1]}), b = gelu_pk((f32x2){v0[2], v0[3]}), c = gelu_pk((f32x2){v1[0], v1[1]}), d = gelu_pk((f32x2){v1[2], v1[3]});
                        v0 = (f32x4){a.x, a.y, b.x, b.y}; v1 = (f32x4){c.x, c.y, d.x, d.y}; }
                    if (ACT == 2) {
#pragma unroll
                        for (int j = 0; j < 4; ++j) { v0[j] = 0.5f * v0[j] * (1.0f + erff(v0[j] * 0.70710678f)); v1[j] = 0.5f * v1[j] * (1.0f + erff(v1[j] * 0.70710678f)); } }
                    u32x4 w; w.x = cvt_pk_bf16(v0[0], v0[1]); w.y = cvt_pk_bf16(v0[2], v0[3]); w.z = cvt_pk_bf16(v1[0], v1[1]); w.w = cvt_pk_bf16(v1[2], v1[3]);
                    *(u32x4*)(rowp + bj * HALF) = w; } }
    }
};
template <class Epi, class Sched, bool STAMP = false>
__device__ __forceinline__ void gemm_phase(PG8_LAS unsigned char* lds, const Gemm g, const Sched& S, const Epi& E, unsigned long long* stamps) {
    const int tid = threadIdx.x, wid = __builtin_amdgcn_readfirstlane(tid >> 6), lane = tid & 63, wr = wid >> 2, wc = wid & 3, fr = lane & 15, fq = lane >> 4;
    const int K = g.K, nt = K / BK;
    int ts_lo = 0, ts_hi = 0, nts = 0; const unsigned long long rt_entry = STAMP ? (unsigned long long)wall_clock64() : 0ull;
#define PG8_STAMP() do { if (STAMP && wid == 0 && nts < 64) { const unsigned long long _c = (unsigned long long)clock64(); \
        ts_lo = (lane == nts) ? (int)(unsigned)_c : ts_lo; ts_hi = (lane == nts) ? (int)(unsigned)(_c >> 32) : ts_hi; ++nts; } } while (0)
    PG8_STAMP();
    unsigned voffA[2], voffB[2];
#pragma unroll
    for (int i = 0; i < 2; ++i) { int R, C; stage_rc(tid * 16 + i * 8192, R, C); const int Rb = Epi::PERM ? ((R & ~31) + perm32(R & 31)) : R;
        voffA[i] = (unsigned)(R * K + C) * 2u; voffB[i] = (unsigned)(Rb * K + C) * 2u; }
    const size_t kstep = (size_t)(BK * 2);
    const size_t hstep = (size_t)HALF * K * 2;
    const size_t tstep = 2 * hstep;
    const unsigned ldsw = (unsigned)wid * 1024u;
    const int aoff = lds_byte(wr * 64 + fr, fq * 8), boff = lds_byte(wc * 32 + fr, fq * 8);
#define PG8_SA(b, h) (((b) * 2 + (h)) * HTB)
#define PG8_SB(b, h) ((4 + (b) * 2 + (h)) * HTB)
#define PG8_STAGE(bufoff, gbase, voff) do { _Pragma("unroll") for (int _i = 0; _i < 2; ++_i) \
        __builtin_amdgcn_global_load_lds((const unsigned*)((const char*)(gbase) + (voff)[_i]), (PG8_LAS unsigned*)(lds + (bufoff) + ldsw + _i * 8192), 16, 0, 0); } while (0)
#define PG8_LDA(dst, b, h) do { _Pragma("unroll") for (int m = 0; m < 4; ++m) _Pragma("unroll") for (int k = 0; k < 2; ++k) dst[m][k] = *(const PG8_LAS bf16x8*)(lds + PG8_SA(b, h) + aoff + m * 2048 + k * 1024); } while (0)
#define PG8_LDB(dst, b, h) do { _Pragma("unroll") for (int n = 0; n < 2; ++n) _Pragma("unroll") for (int k = 0; k < 2; ++k) dst[n][k] = *(const PG8_LAS bf16x8*)(lds + PG8_SB(b, h) + boff + n * 2048 + k * 1024); } while (0)
#define PG8_MMA(ai, bj, At, Bt) do { __builtin_amdgcn_s_setprio(1); _Pragma("unroll") for (int m = 0; m < 4; ++m) _Pragma("unroll") for (int n = 0; n < 2; ++n) _Pragma("unroll") for (int k = 0; k < 2; ++k) \
        acc[ai][bj][m][n] = __builtin_amdgcn_mfma_f32_16x16x32_bf16(Bt[n][k], At[m][k], acc[ai][bj][m][n], 0, 0, 0); __builtin_amdgcn_s_setprio(0); } while (0)
#define PG8_WAIT_V(n) asm volatile("s_waitcnt vmcnt(" #n ")" ::: "memory")
#define PG8_WAIT_L(n) asm volatile("s_waitcnt lgkmcnt(" #n ")" ::: "memory")
#define PG8_BAR __builtin_amdgcn_s_barrier()
#define PG8_SCHED __builtin_amdgcn_sched_barrier(0)
    Unit cur, nxt; int ui = 0;
    if (!S.next(0, cur)) return;
    f32x4 acc[2][2][4][2];
#pragma unroll
    for (int a = 0; a < 2; ++a)
#pragma unroll
        for (int b = 0; b < 2; ++b)
#pragma unroll
            for (int m = 0; m < 4; ++m)
#pragma unroll
                for (int n = 0; n < 2; ++n) acc[a][b][m][n] = (f32x4){0.f, 0.f, 0.f, 0.f};
    bf16x8 At[4][2], B0[2][2], B1[2][2];
    const char* cA = (const char*)g.A + (size_t)cur.pm * tstep; const char* cB = (const char*)g.Bt + (size_t)cur.pn * tstep;
    S.a_ready(cur);
    PG8_STAGE(PG8_SB(0, 0), cB, voffB); PG8_STAGE(PG8_SA(0, 0), cA, voffA); PG8_STAGE(PG8_SB(0, 1), cB + hstep, voffB); PG8_STAGE(PG8_SA(0, 1), cA + hstep, voffA);
    if (wr == 1) PG8_BAR;
    PG8_WAIT_V(4); PG8_BAR;
    PG8_STAGE(PG8_SB(1, 0), cB + kstep, voffB); PG8_STAGE(PG8_SA(1, 0), cA + kstep, voffA); PG8_STAGE(PG8_SB(1, 1), cB + hstep + kstep, voffB);
    PG8_WAIT_V(6); PG8_BAR;
    PG8_STAMP();
    for (;;) {
        const bool has_next = S.next(ui + 1, nxt);
        const char* nA = has_next ? (const char*)g.A + (size_t)nxt.pm * tstep : cA; const char* nB = has_next ? (const char*)g.Bt + (size_t)nxt.pn * tstep : cB;
        for (int t = 0; t < nt; t += 2) {
            const bool last = (t == nt - 2);
            const char* a1 = cA + (size_t)(t + 1) * kstep;
            const char* a2 = last ? nA : cA + (size_t)(t + 2) * kstep; const char* b2 = last ? nB : cB + (size_t)(t + 2) * kstep;
            const char* a3 = a2 + kstep; const char* b3 = b2 + kstep;
            if (last && has_next) S.a_ready(nxt);
            if constexpr (Epi::MID_T >= 0) { if (t == Epi::MID_T) E.mid(acc, cur, wr, wc, fr, fq); }
            PG8_LDB(B0, 0, 0); PG8_SCHED; PG8_LDA(At, 0, 0); PG8_STAGE(PG8_SA(1, 1), a1 + hstep, voffA);
            PG8_WAIT_L(8); PG8_BAR; PG8_WAIT_L(0); PG8_MMA(0, 0, At, B0); PG8_BAR; PG8_SCHED;
            PG8_LDB(B1, 0, 1); PG8_STAGE(PG8_SB(0, 0), b2, voffB);
            PG8_BAR; PG8_WAIT_L(0); PG8_MMA(0, 1, At, B1); PG8_BAR;
            PG8_LDA(At, 0, 1); PG8_STAGE(PG8_SA(0, 0), a2, voffA);
            PG8_BAR; PG8_WAIT_L(0); PG8_MMA(1, 0, At, B0); PG8_BAR; PG8_SCHED;
            PG8_STAGE(PG8_SB(0, 1), b2 + hstep, voffB);
            PG8_WAIT_V(6); PG8_BAR; PG8_MMA(1, 1, At, B1); PG8_BAR;
            PG8_LDB(B0, 1, 0); PG8_SCHED; PG8_LDA(At, 1, 0); PG8_STAGE(PG8_SA(0, 1), a2 + hstep, voffA);
            PG8_WAIT_L(8); PG8_BAR; PG8_WAIT_L(0); PG8_MMA(0, 0, At, B0); PG8_BAR; PG8_SCHED;
            PG8_LDB(B1, 1, 1); PG8_STAGE(PG8_SB(1, 0), b3, voffB);
            PG8_BAR; PG8_WAIT_L(0); PG8_MMA(0, 1, At, B1); PG8_BAR;
            PG8_LDA(At, 1, 1); PG8_STAGE(PG8_SA(1, 0), a3, voffA);
            PG8_BAR; PG8_WAIT_L(0); PG8_MMA(1, 0, At, B0); PG8_BAR; PG8_SCHED;
            PG8_STAGE(PG8_SB(1, 1), b3 + hstep, voffB);
            PG8_WAIT_V(6); PG8_BAR; PG8_MMA(1, 1, At, B1); PG8_BAR;
        }
        PG8_STAMP();
        if constexpr (!Epi::AFTER_DRAIN) { E(acc, cur, wr, wc, fr, fq); S.done(cur); }
        PG8_STAMP();
        if (!has_next) break;
#pragma unroll
        for (int a = 0; a < 2; ++a)
#pragma unroll
            for (int b = 0; b < 2; ++b)
#pragma unroll
                for (int m = 0; m < 4; ++m)
#pragma unroll
                    for (int n = 0; n < 2; ++n) acc[a][b][m][n] = (f32x4){0.f, 0.f, 0.f, 0.f};
        cur = nxt; cA = nA; cB = nB; ++ui;
    }
    PG8_WAIT_V(0);
    if (wr == 0) PG8_BAR;
    PG8_BAR;
    if constexpr (Epi::AFTER_DRAIN) { E.fused(acc, cur, wr, wc, fr, fq, lds, wid, lane); S.done(cur); }
    PG8_STAMP();
    if (STAMP && wid == 0) { stamps[lane] = lane < nts ? (((unsigned long long)(unsigned)ts_hi << 32) | (unsigned)ts_lo) : 0ull;
        if (lane == 62) stamps[62] = rt_entry; if (lane == 63) stamps[63] = (unsigned long long)wall_clock64(); }
#undef PG8_STAMP
#undef PG8_SA
#undef PG8_SB
#undef PG8_STAGE
#undef PG8_LDA
#undef PG8_LDB
#undef PG8_MMA
#undef PG8_WAIT_V
#undef PG8_WAIT_L
#undef PG8_BAR
#undef PG8_SCHED
}
}
#define LAS __attribute__((address_space(3)))
typedef unsigned short bf16_t;
typedef short bf16x8 __attribute__((ext_vector_type(8)));
typedef float f32x4 __attribute__((ext_vector_type(4)));
typedef float f32x2 __attribute__((ext_vector_type(2)));
typedef unsigned u32x4 __attribute__((ext_vector_type(4)));
typedef unsigned u32x2 __attribute__((ext_vector_type(2)));
typedef LAS unsigned char* ldsp;
typedef float f32x32 __attribute__((ext_vector_type(32)));
typedef float f32x16 __attribute__((ext_vector_type(16)));
typedef unsigned u32x6 __attribute__((ext_vector_type(6)));

constexpr int D = 2048, NTOK = 8192, SEQ = 4096, MROWS = 8448, ROW_META = 8192;
constexpr int INC = 11712, NPAD = 11776;
constexpr int C_R = 0, C_K = 2048, C_V = 4096, C_WL = 6144, C_AL = 6240, C_GL = 6336, C_POOL = 6592, C_G0 = 7616, C_G1 = 9664;
constexpr int NUNITS = 4128;
constexpr float DSCALE = 0.6065306597126334f;
constexpr float DN_ALPHA = 1.189207115002721f;
constexpr float GN_EPS = 64e-5f, LN_EPS = 1e-5f;

constexpr size_t WS_P = 0;
constexpr size_t WS_H0B = 198967296;
constexpr size_t WS_WTAB = WS_H0B + 34603008;
constexpr size_t WS_WTOUT = WS_WTAB + 12582912;
constexpr size_t WS_WTQ = WS_WTOUT + 8388608;
constexpr size_t WS_WTPOOL = WS_WTQ + 8388608;
constexpr size_t WS_WTW2 = WS_WTPOOL + 524288;
constexpr size_t WS_WTA2 = WS_WTW2 + 393216;
constexpr size_t WS_WTG2 = WS_WTA2 + 393216;
constexpr size_t WS_SUBK = WS_WTG2 + 1048576;
constexpr size_t WS_BONUS = WS_SUBK + 65536;
constexpr size_t WS_REGC = WS_BONUS + 1048576;
constexpr size_t WS_WTIN = WS_REGC;
constexpr size_t UNITB = (size_t)NUNITS * 4096 * 2;
constexpr size_t WS_G = WS_REGC;
constexpr size_t WS_H0T = WS_REGC + UNITB;
constexpr size_t WS_RT = WS_REGC + 2 * UNITB;
constexpr size_t WS_Y0 = WS_REGC + 3 * UNITB;
constexpr size_t WS_S0T = WS_REGC + 4 * UNITB;
constexpr size_t WS_YAB = WS_REGC;
constexpr int LDAB = 3072;
constexpr size_t WS_MERGED = WS_REGC + 2 * UNITB;
constexpr size_t WS_X1B = WS_REGC + 3 * UNITB;
constexpr size_t WS_Q = WS_REGC + UNITB;
constexpr size_t TROW = 1536;
constexpr size_t EROW = 2048;
constexpr size_t WS_VB = WS_REGC + 5 * UNITB;
constexpr size_t WS_GSIG = WS_VB + 16384 * EROW;
constexpr size_t WS_BAR = WS_GSIG + 4194304;
constexpr size_t WS_STAT = WS_BAR + 16384;
constexpr size_t STAT_BYTES = (8192 * 2 + 2048 * 2) * 4 + 4096;
constexpr size_t WS_TSC = WS_STAT + STAT_BYTES;
constexpr size_t UROW = 1024;
constexpr size_t WS_UB = WS_TSC + 131072;
constexpr size_t WS_END = WS_UB;
static_assert(WS_YAB + 50331648 <= WS_MERGED, "overlay");

constexpr int LDS_BYTES = 163840;
constexpr int NPHASE = 8;

struct Params {
    const float* in[30];
    float* out;
    unsigned char* ws;
    int ph_lo, ph_hi;
};
enum { I_X = 0, I_META, I_LNIN_G, I_LNIN_B, I_WIN, I_MU, I_W0, I_WW2, I_A0, I_WA2, I_WG2, I_KK, I_KA, I_RK, I_GNG, I_GNB, I_WPOOL, I_PSCALE, I_BGATE,
       I_WBA, I_WBB, I_WOUT, I_LN1G, I_LN1B, I_WQ, I_SUBK, I_UT, I_VT, I_LN2G, I_LN2B };

__device__ __forceinline__ unsigned pk2(float lo, float hi) { return pg8::cvt_pk_bf16(lo, hi); }
__device__ __forceinline__ float bflo(unsigned w) { return __uint_as_float(w << 16); }
__device__ __forceinline__ float bfhi(unsigned w) { return __uint_as_float(w & 0xffff0000u); }
__device__ __forceinline__ float bf1(bf16_t h) { return __uint_as_float(((unsigned)h) << 16); }
__device__ __forceinline__ bf16_t f2bf1(float f) { return (bf16_t)(pk2(f, f) & 0xffffu); }
__device__ __forceinline__ float wave_sum(float v) {
#pragma unroll
    for (int o = 1; o < 64; o <<= 1) v += __shfl_xor(v, o);
    return v;
}
__device__ __forceinline__ float sigmoidf_(float x) { return 1.0f / (1.0f + __expf(-x)); }
__device__ __forceinline__ f32x4 mfma16(bf16x8 a, bf16x8 b, f32x4 c) { return __builtin_amdgcn_mfma_f32_16x16x32_bf16(a, b, c, 0, 0, 0); }
__device__ __forceinline__ void unpack8(const u32x4 w, float* f) {
    f[0] = bflo(w.x); f[1] = bfhi(w.x); f[2] = bflo(w.y); f[3] = bfhi(w.y); f[4] = bflo(w.z); f[5] = bfhi(w.z); f[6] = bflo(w.w); f[7] = bfhi(w.w);
}
__device__ __forceinline__ u32x4 pack8(const float* f) { u32x4 w; w.x = pk2(f[0], f[1]); w.y = pk2(f[2], f[3]); w.z = pk2(f[4], f[5]); w.w = pk2(f[6], f[7]); return w; }
#define DPPF(v, ctrl) __builtin_bit_cast(float, __builtin_amdgcn_update_dpp(0, __builtin_bit_cast(int, (v)), (ctrl), 0xF, 0xF, true))
__device__ __forceinline__ float readlane_f(float v, int l) { return __builtin_bit_cast(float, __builtin_amdgcn_readlane(__builtin_bit_cast(int, v), l)); }
__device__ __forceinline__ float wave_sum_dpp(float v) {
    v += DPPF(v, 0xB1); v += DPPF(v, 0x4E); v += DPPF(v, 0x141); v += DPPF(v, 0x140);
    return (readlane_f(v, 0) + readlane_f(v, 16)) + (readlane_f(v, 32) + readlane_f(v, 48));
}
__device__ __forceinline__ float wave_max_dpp(float v) {
    v = fmaxf(v, DPPF(v, 0xB1)); v = fmaxf(v, DPPF(v, 0x4E)); v = fmaxf(v, DPPF(v, 0x141)); v = fmaxf(v, DPPF(v, 0x140));
    return fmaxf(fmaxf(readlane_f(v, 0), readlane_f(v, 16)), fmaxf(readlane_f(v, 32), readlane_f(v, 48)));
}
#define BLOCK_SYNC() __syncthreads()
#define XB_TMO      128
#define XB_XCNT(j)  (256  + 64 * (j))
#define XB_XSUB(j)  (1280 + 64 * (j))
#define XB_XGEN(j)  (2304 + 64 * (j))
#define XB_TOP      3328
#define XB_TOPGEN   3392
#define XCD_BAR_WORDS 3456
#define XB_SPIN_CAP (1u << 18)

__device__ __forceinline__ unsigned xb_ld(unsigned* p)              { return __hip_atomic_load(p, __ATOMIC_RELAXED, __HIP_MEMORY_SCOPE_AGENT); }
__device__ __forceinline__ unsigned xb_add(unsigned* p, unsigned v) { return __hip_atomic_fetch_add(p, v, __ATOMIC_RELAXED, __HIP_MEMORY_SCOPE_AGENT); }
__device__ __forceinline__ unsigned xb_xcc_id() { return (unsigned)__builtin_amdgcn_s_getreg((3 << 11) | 20) & 0xFu; }
#define XB_SPIN(cond, bar) do { unsigned _sp = 0; while (cond) { __builtin_amdgcn_s_sleep(1); \
    if ((++_sp & 255u) == 0u) { if (xb_ld(&(bar)[XB_TMO])) break; if (_sp > XB_SPIN_CAP) { atomicAdd(&(bar)[XB_TMO], 1u); break; } } } } while (0)

struct XcdBarrier {
    unsigned* bar; unsigned x;
    volatile LAS unsigned* st;
};

__device__ __forceinline__ XcdBarrier xcd_barrier_post(unsigned* bar, volatile LAS unsigned* st) {
    XcdBarrier b; b.bar = bar; b.x = xb_xcc_id(); b.st = st;
    if (threadIdx.x == 0) (void)xb_add(&bar[XB_XCNT(b.x)], 1u);
    return b;
}
__device__ __forceinline__ void xcd_barrier_complete(unsigned* bar, unsigned x, unsigned& nloc, unsigned& nx) {
    const unsigned G = gridDim.x * gridDim.y * gridDim.z;
    unsigned sum, cnt, mine, sp = 0u;
    for (;;) {
        sum = 0u; cnt = 0u; mine = 0u;
#pragma unroll
        for (unsigned j = 0; j < 16; ++j) { const unsigned c = xb_ld(&bar[XB_XCNT(j)]); sum += c; cnt += (c > 0u) ? 1u : 0u; mine = (j == x) ? c : mine; }
        if (sum == G) break;
        __builtin_amdgcn_s_sleep(1);
        if ((++sp & 255u) == 0u) { if (xb_ld(&bar[XB_TMO])) break; if (sp > XB_SPIN_CAP) { atomicAdd(&bar[XB_TMO], 1u); break; } }
    }
    nloc = mine > 0u ? mine : 1u; nx = cnt > 0u ? cnt : 1u;
}

__device__ __forceinline__ void xcd_barrier(const XcdBarrier& b) {
    asm volatile("s_waitcnt vmcnt(0)" ::: "memory");
    __syncthreads();
    if (threadIdx.x == 0) {
        unsigned* bar = b.bar;
        __builtin_amdgcn_s_waitcnt(0);
        unsigned nloc = b.st[0], nx = b.st[1];
        if (nloc == 0u) { xcd_barrier_complete(bar, b.x, nloc, nx); b.st[0] = nloc; b.st[1] = nx; }
        const unsigned old = xb_add(&bar[XB_XSUB(b.x)], 1u);
        const unsigned gen = old / nloc;
        if (old + 1u == (gen + 1u) * nloc) {
            __builtin_amdgcn_fence(__ATOMIC_RELEASE, "agent");
            asm volatile("s_waitcnt vmcnt(0)" ::: "memory");
            const unsigned og = xb_add(&bar[XB_TOP], 1u);
            const unsigned tg = og / nx;
            if (og + 1u == (tg + 1u) * nx) xb_add(&bar[XB_TOPGEN], 1u);
            else XB_SPIN(xb_ld(&bar[XB_TOPGEN]) == tg, bar);
            __builtin_amdgcn_fence(__ATOMIC_ACQUIRE, "agent");
            xb_add(&bar[XB_XGEN(b.x)], 1u);
            asm volatile("s_waitcnt vmcnt(0)" ::: "memory");
        } else {
            XB_SPIN(xb_ld(&bar[XB_XGEN(b.x)]) == gen, bar);
            __builtin_amdgcn_fence(__ATOMIC_ACQUIRE, "agent");
            asm volatile("s_waitcnt vmcnt(0)" ::: "memory");
        }
    }
    __syncthreads();
}

__device__ __forceinline__ void ln_row_bf16(const float* src, const float* g, const float* b, bf16_t* dst, int lane) {
    f32x4 v[8]; float s = 0.f;
#pragma unroll
    for (int j = 0; j < 8; ++j) { v[j] = ((const f32x4*)src)[lane + 64 * j]; s += (v[j].x + v[j].y) + (v[j].z + v[j].w); }
    const float mean = wave_sum(s) * (1.0f / D); float s2 = 0.f;
#pragma unroll
    for (int j = 0; j < 8; ++j) { v[j] = v[j] - mean; s2 += (v[j].x * v[j].x + v[j].y * v[j].y) + (v[j].z * v[j].z + v[j].w * v[j].w); }
    const float rstd = 1.0f / sqrtf(wave_sum(s2) * (1.0f / D) + LN_EPS);
#pragma unroll
    for (int j = 0; j < 8; ++j) {
        const f32x4 gg = ((const f32x4*)g)[lane + 64 * j], bb = ((const f32x4*)b)[lane + 64 * j];
        const f32x4 o = v[j] * rstd * gg + bb;
        u32x2 w; w.x = pk2(o.x, o.y); w.y = pk2(o.z, o.w);
        ((u32x2*)dst)[lane + 64 * j] = w;
    }
}
__device__ __forceinline__ void transpose_item(const float* W, int K, int N, int Npad, bf16_t* Wt, int item, int lane, int ldw = 0) {
    const int nblk = Npad >> 6, kb = item / nblk, nb = item - kb * nblk, n = nb * 64 + lane, k0 = kb * 32;
    float v[32];
    if (n < N) {
#pragma unroll
        for (int i = 0; i < 32; ++i) v[i] = W[(size_t)(k0 + i) * N + n];
    } else {
#pragma unroll
        for (int i = 0; i < 32; ++i) v[i] = 0.f;
    }
    u32x4* o = (u32x4*)(Wt + (size_t)n * (ldw ? ldw : K) + k0);
#pragma unroll
    for (int c = 0; c < 4; ++c) { u32x4 w; w.x = pk2(v[8 * c], v[8 * c + 1]); w.y = pk2(v[8 * c + 2], v[8 * c + 3]); w.z = pk2(v[8 * c + 4], v[8 * c + 5]); w.w = pk2(v[8 * c + 6], v[8 * c + 7]); o[c] = w; }
}
__device__ __forceinline__ void transpose_item_q(const float* W, const float* g, const float* b, bf16_t* Wt, float* c1, float* c2, int item, int lane) {
    const int kb = item >> 5, nb = item & 31, n = nb * 64 + lane, k0 = kb * 32;
    float v[32], s1 = 0.f, s2 = 0.f;
#pragma unroll
    for (int i = 0; i < 32; ++i) { const float w = W[(size_t)(k0 + i) * 2048 + n]; const float gw = g[k0 + i] * w; s1 += gw; s2 += b[k0 + i] * w; v[i] = gw; }
    u32x4* o = (u32x4*)(Wt + (size_t)n * 2048 + k0);
#pragma unroll
    for (int c = 0; c < 4; ++c) { u32x4 w; w.x = pk2(v[8 * c], v[8 * c + 1]); w.y = pk2(v[8 * c + 2], v[8 * c + 3]); w.z = pk2(v[8 * c + 4], v[8 * c + 5]); w.w = pk2(v[8 * c + 6], v[8 * c + 7]); o[c] = w; }
    atomicAdd(c1 + n, s1); atomicAdd(c2 + n, s2);
}
__device__ __forceinline__ void transpose_item64(const float* W, int K, int N, int Npad, bf16_t* Wt, int ldw, int item, int lane) {
    const int nblk = Npad >> 6, kb = item / nblk, nb = item - kb * nblk, n = nb * 64 + lane, k0 = kb * 64;
    float v[64];
    if (n < N) {
#pragma unroll
        for (int i = 0; i < 64; ++i) v[i] = W[(size_t)(k0 + i) * N + n];
    } else {
#pragma unroll
        for (int i = 0; i < 64; ++i) v[i] = 0.f;
    }
    u32x4* o = (u32x4*)(Wt + (size_t)n * ldw + k0);
#pragma unroll
    for (int c = 0; c < 8; ++c) { u32x4 w; w.x = pk2(v[8 * c], v[8 * c + 1]); w.y = pk2(v[8 * c + 2], v[8 * c + 3]); w.z = pk2(v[8 * c + 4], v[8 * c + 5]); w.w = pk2(v[8 * c + 6], v[8 * c + 7]); o[c] = w; }
}
__device__ __forceinline__ void phase0(const Params& P) {
    const int lane = threadIdx.x & 63, wave = threadIdx.x >> 6;
    const int gw = blockIdx.x * 8 + wave, NGW = gridDim.x * 8;
    unsigned char* ws = P.ws;
    constexpr int T_IN = 32 * 184, T_A = 32 * 32, T_B = 16 * 32, T_O = 32 * 32, T_Q = 64 * 32, T_POOL = 4 * 32, T_W2 = 3 * 32, T_A2 = 3 * 32, T_G2 = 8 * 32;
    constexpr int T_LN = MROWS, T_SK = 64;
    constexpr int NIT = T_IN + T_A + T_B + T_O + T_Q + T_POOL + T_W2 + T_A2 + T_G2 + T_SK;
    for (int it = gw; it < NIT; it += NGW) {
        int r = it;
        if (r < T_IN) { transpose_item64(P.in[I_WIN], 2048, INC, NPAD, (bf16_t*)(ws + WS_WTIN), 2048, r, lane); continue; } r -= T_IN;
        if (r < T_A) { transpose_item64(P.in[I_WBA], 2048, 2048, 2048, (bf16_t*)(ws + WS_WTAB), LDAB, r, lane); continue; } r -= T_A;
        if (r < T_B) { transpose_item64(P.in[I_WBB], 1024, 2048, 2048, (bf16_t*)(ws + WS_WTAB) + 2048, LDAB, r, lane); continue; } r -= T_B;
        if (r < T_O) { transpose_item64(P.in[I_WOUT], 2048, 2048, 2048, (bf16_t*)(ws + WS_WTOUT), 2048, r, lane); continue; } r -= T_O;
        if (r < T_Q) {
#ifdef REPEAT_PHASE
            float* st = (float*)(ws + (P.ph_lo < 0 ? WS_END : WS_STAT));
#else
            float* st = (float*)(ws + WS_STAT);
#endif
            transpose_item_q(P.in[I_WQ], P.in[I_LN1G], P.in[I_LN1B], (bf16_t*)(ws + WS_WTQ), st + 16384, st + 18432, r, lane); continue; } r -= T_Q;
        if (r < T_POOL) { const int g = r >> 5; transpose_item(P.in[I_WPOOL] + g * 65536, 256, 256, 256, (bf16_t*)(ws + WS_WTPOOL) + g * 65536, r & 31, lane); continue; } r -= T_POOL;
        if (r < T_W2) { transpose_item(P.in[I_WW2], 96, 2048, 2048, (bf16_t*)(ws + WS_WTW2), r, lane); continue; } r -= T_W2;
        if (r < T_A2) { transpose_item(P.in[I_WA2], 96, 2048, 2048, (bf16_t*)(ws + WS_WTA2), r, lane); continue; } r -= T_A2;
        if (r < T_G2) { transpose_item(P.in[I_WG2], 256, 2048, 2048, (bf16_t*)(ws + WS_WTG2), r, lane); continue; } r -= T_G2;
        {
            const float* s = P.in[I_SUBK] + r * 512 + lane * 8; float f[8];
#pragma unroll
            for (int i = 0; i < 8; ++i) f[i] = s[i];
            *(u32x4*)((bf16_t*)(ws + WS_SUBK) + r * 512 + lane * 8) = pack8(f);
        }
    }
    {
        f32x4 gg[8], bb[8];
#pragma unroll
        for (int j = 0; j < 8; ++j) { gg[j] = ((const f32x4*)P.in[I_LNIN_G])[lane + 64 * j]; bb[j] = ((const f32x4*)P.in[I_LNIN_B])[lane + 64 * j]; }
        auto srcrow = [&](int r) -> const float* { return r < NTOK ? P.in[I_X] + (size_t)r * D : P.in[I_META] + (size_t)(r - NTOK) * D; };
        auto finish = [&](int r, f32x4 (&v)[8]) {
            float s = 0.f;
#pragma unroll
            for (int j = 0; j < 8; ++j) s += (v[j].x + v[j].y) + (v[j].z + v[j].w);
            const float mean = wave_sum_dpp(s) * (1.0f / D); float s2 = 0.f;
#pragma unroll
            for (int j = 0; j < 8; ++j) { v[j] = v[j] - mean; s2 += (v[j].x * v[j].x + v[j].y * v[j].y) + (v[j].z * v[j].z + v[j].w * v[j].w); }
            const float rstd = 1.0f / sqrtf(wave_sum_dpp(s2) * (1.0f / D) + LN_EPS);
            bf16_t* dst = (bf16_t*)(ws + WS_H0B) + (size_t)r * D;
#pragma unroll
            for (int j = 0; j < 8; ++j) { const f32x4 o = v[j] * rstd * gg[j] + bb[j]; u32x2 w; w.x = pk2(o.x, o.y); w.y = pk2(o.z, o.w); ((u32x2*)dst)[lane + 64 * j] = w; }
        };
        for (int r = gw; r < NTOK + 16; r += 2 * NGW) {
            const int r2 = r + NGW; const bool has2 = r2 < NTOK + 16;
            f32x4 v1[8], v2[8];
#pragma unroll
            for (int j = 0; j < 8; ++j) v1[j] = ((const f32x4*)srcrow(r))[lane + 64 * j];
#pragma unroll
            for (int j = 0; j < 8; ++j) v2[j] = ((const f32x4*)srcrow(has2 ? r2 : r))[lane + 64 * j];
            finish(r, v1); if (has2) finish(r2, v2);
        }
        for (int r = NTOK + 16 + gw; r < MROWS; r += NGW) { bf16_t* dst = (bf16_t*)(ws + WS_H0B) + (size_t)r * D;
#pragma unroll
            for (int j = 0; j < 8; ++j) ((u32x2*)dst)[lane + 64 * j] = (u32x2){0u, 0u}; }
    }
}
namespace pg8 {
constexpr float LN_EPS_ = 1e-5f;
struct EpiGate35 {
    static constexpr bool PERM = false, AFTER_DRAIN = false; static constexpr int MID_T = 32;
    bf16_t* O; const bf16_t* p; const float* bgate;
    __device__ __forceinline__ void mid(f32x4 (&acc)[2][2][4][2], const Unit& u, int wr, int wc, int fr, int fq) const {
        asm volatile("" : "+v"(fr), "+v"(fq));
        const int row0 = u.pm * BM + wr * 64 + fr, col0 = u.pn * BM + wc * 32 + 4 * fq;
        f32x4 b0[2][2], b1[2][2];
#pragma unroll
        for (int bj = 0; bj < 2; ++bj)
#pragma unroll
            for (int n = 0; n < 2; ++n) { const int col = col0 + bj * HALF + n * 16; b0[bj][n] = *(const f32x4*)(bgate + col); b1[bj][n] = *(const f32x4*)(bgate + D + col); }
        u32x2 pa[2][2][2], pb[2][2][2];
        auto ld = [&](int g, u32x2 (&pp)[2][2][2]) { const size_t row = (size_t)(row0 + (g >> 2) * HALF + (g & 3) * 16);
#pragma unroll
            for (int bj = 0; bj < 2; ++bj)
#pragma unroll
                for (int n = 0; n < 2; ++n) { const int col = col0 + bj * HALF + n * 16; pp[bj][n][0] = *(const u32x2*)(p + row * NPAD + C_G0 + col); pp[bj][n][1] = *(const u32x2*)(p + row * NPAD + C_G1 + col); } };
        auto ap = [&](int g, const u32x2 (&pp)[2][2][2]) { const int ai = g >> 2, m = g & 3;
#pragma unroll
            for (int bj = 0; bj < 2; ++bj)
#pragma unroll
                for (int n = 0; n < 2; ++n) { const u32x2 p0 = pp[bj][n][0], p1 = pp[bj][n][1]; const f32x4 c0 = b0[bj][n], c1 = b1[bj][n];
                    f32x4 r;
                    r.x = (1.0f + __expf(-fmaxf(bflo(p1.x) + c1.x, -80.f))) * __builtin_amdgcn_rcpf(1.0f + __expf(-(bflo(p0.x) + c0.x)));
                    r.y = (1.0f + __expf(-fmaxf(bfhi(p1.x) + c1.y, -80.f))) * __builtin_amdgcn_rcpf(1.0f + __expf(-(bfhi(p0.x) + c0.y)));
                    r.z = (1.0f + __expf(-fmaxf(bflo(p1.y) + c1.z, -80.f))) * __builtin_amdgcn_rcpf(1.0f + __expf(-(bflo(p0.y) + c0.z)));
                    r.w = (1.0f + __expf(-fmaxf(bfhi(p1.y) + c1.w, -80.f))) * __builtin_amdgcn_rcpf(1.0f + __expf(-(bfhi(p0.y) + c0.w)));
                    acc[ai][bj][m][n] = acc[ai][bj][m][n] * r; } };
        ld(0, pa);
#pragma unroll
        for (int g = 0; g < 8; g += 2) { ld(g + 1, pb); ap(g, pa); if (g + 2 < 8) ld(g + 2, pa); ap(g + 1, pb); }
    }
    __device__ __forceinline__ void operator()(const f32x4 (&acc)[2][2][4][2], const Unit& u, int wr, int wc, int fr, int fq) const {
        const int row0 = u.pm * BM + wr * 64 + fr, col0 = u.pn * BM + wc * 32 + 4 * fq;
#pragma unroll
        for (int ai = 0; ai < 2; ++ai)
#pragma unroll
            for (int m = 0; m < 4; ++m) { const size_t row = (size_t)(row0 + ai * HALF + m * 16);
#pragma unroll
                for (int bj = 0; bj < 2; ++bj)
#pragma unroll
                    for (int n = 0; n < 2; ++n) { const int col = col0 + bj * HALF + n * 16;
                        const u32x2 p1 = *(const u32x2*)(p + row * NPAD + C_G1 + col); const f32x4 b1 = *(const f32x4*)(bgate + D + col);
                        f32x4 g;
                        g.x = __builtin_amdgcn_rcpf(1.0f + __expf(-fmaxf(bflo(p1.x) + b1.x, -80.f))); g.y = __builtin_amdgcn_rcpf(1.0f + __expf(-fmaxf(bfhi(p1.x) + b1.y, -80.f)));
                        g.z = __builtin_amdgcn_rcpf(1.0f + __expf(-fmaxf(bflo(p1.y) + b1.z, -80.f))); g.w = __builtin_amdgcn_rcpf(1.0f + __expf(-fmaxf(bfhi(p1.y) + b1.w, -80.f)));
                        const f32x4 o = acc[ai][bj][m][n] * g;
                        u32x2 w; w.x = cvt_pk_bf16(o.x, o.y); w.y = cvt_pk_bf16(o.z, o.w);
                        *(u32x2*)(O + row * D + col) = w; } }
    }
};
struct EpiResidStats {
    static constexpr bool PERM = false, AFTER_DRAIN = false; static constexpr int MID_T = -1;
    bf16_t* O; const bf16_t* h0; float alpha; float* rsum; float* rsq;
    __device__ __forceinline__ void operator()(const f32x4 (&acc)[2][2][4][2], const Unit& u, int wr, int wc, int fr, int fq) const {
        const int row0 = u.pm * BM + wr * 64 + fr, col0 = u.pn * BM + wc * 32 + 4 * fq;
#pragma unroll
        for (int ai = 0; ai < 2; ++ai)
#pragma unroll
            for (int m = 0; m < 4; ++m) { const size_t row = (size_t)(row0 + ai * HALF + m * 16); float s = 0.f, q = 0.f;
#pragma unroll
                for (int bj = 0; bj < 2; ++bj)
#pragma unroll
                    for (int n = 0; n < 2; ++n) { const int col = col0 + bj * HALF + n * 16;
                        const u32x2 hw = *(const u32x2*)(h0 + row * D + col);
                        f32x4 hv; hv.x = bflo(hw.x); hv.y = bfhi(hw.x); hv.z = bflo(hw.y); hv.w = bfhi(hw.y);
                        const f32x4 x = hv * alpha + acc[ai][bj][m][n];
                        s += (x.x + x.y) + (x.z + x.w); q += (x.x * x.x + x.y * x.y) + (x.z * x.z + x.w * x.w);
                        u32x2 w; w.x = cvt_pk_bf16(x.x, x.y); w.y = cvt_pk_bf16(x.z, x.w);
                        *(u32x2*)(O + row * D + col) = w; }
                s += __shfl_xor(s, 16); s += __shfl_xor(s, 32); q += __shfl_xor(q, 16); q += __shfl_xor(q, 32);
                if (fq == 0) { atomicAdd(rsum + row, s); atomicAdd(rsq + row, q); } }
    }
};
struct EpiQ {
    static constexpr bool PERM = true, AFTER_DRAIN = false; static constexpr int MID_T = -1;
    bf16_t* O; const float* rsum; const float* rsq; const float* c1; const float* c2;
    __device__ __forceinline__ void operator()(const f32x4 (&acc)[2][2][4][2], const Unit& u, int wr, int wc, int fr, int fq) const {
        const int row0 = u.pm * BM + wr * 64 + fr, col0 = u.pn * BM + wc * 32 + 8 * fq;
        f32x4 k1[2][2], k2[2][2];
#pragma unroll
        for (int bj = 0; bj < 2; ++bj)
#pragma unroll
            for (int n = 0; n < 2; ++n) { k1[bj][n] = *(const f32x4*)(c1 + col0 + bj * HALF + 4 * n); k2[bj][n] = *(const f32x4*)(c2 + col0 + bj * HALF + 4 * n); }
#pragma unroll
        for (int ai = 0; ai < 2; ++ai)
#pragma unroll
            for (int m = 0; m < 4; ++m) { const int row = row0 + ai * HALF + m * 16;
                const float mean = rsum[row] * (1.0f / D), rstd = 1.0f / sqrtf(fmaxf(rsq[row] * (1.0f / D) - mean * mean, 0.f) + LN_EPS_);
                bf16_t* rowp = O + (size_t)row * D + col0;
#pragma unroll
                for (int bj = 0; bj < 2; ++bj) {
                    const f32x4 v0 = (acc[ai][bj][m][0] - k1[bj][0] * mean) * rstd + k2[bj][0], v1 = (acc[ai][bj][m][1] - k1[bj][1] * mean) * rstd + k2[bj][1];
                    u32x4 w; w.x = cvt_pk_bf16(v0[0], v0[1]); w.y = cvt_pk_bf16(v0[2], v0[3]); w.z = cvt_pk_bf16(v1[0], v1[1]); w.w = cvt_pk_bf16(v1[2], v1[3]);
                    *(u32x4*)(rowp + bj * HALF) = w; } }
    }
};
}
template <class Epi>
__device__ __forceinline__ void run_gemm(ldsp lds, const bf16_t* A, const bf16_t* Bt, int M, int N, int K, const Epi& E) {
    pg8::Gemm g; g.A = A; g.Bt = Bt; g.M = M; g.N = N; g.K = K;
    pg8::StaticOrder S; S.init(M, N, (int)gridDim.x, (int)blockIdx.x);
    pg8::gemm_phase<Epi, pg8::StaticOrder, false>(lds, g, S, E, nullptr);
}
constexpr int CONV_P3_END = 16384;
constexpr int CONV_P2_ROWS = 0;
__device__ __forceinline__ void convert_row(unsigned char* ws, int r, int lane, const f32x4 (&v)[8]) {
    float am = 0.f, ss = 0.f;
#pragma unroll
    for (int j = 0; j < 8; ++j) { am = fmaxf(am, fmaxf(fmaxf(fabsf(v[j].x), fabsf(v[j].y)), fmaxf(fabsf(v[j].z), fabsf(v[j].w)))); ss += (v[j].x * v[j].x + v[j].y * v[j].y) + (v[j].z * v[j].z + v[j].w * v[j].w); }
    am = wave_max_dpp(am);
    const float rms = sqrtf(wave_sum_dpp(ss) * (1.0f / D));
    unsigned w[4]; float sc;
    if (r < 16384) {
        const float clip = fminf(am, 2.5f * rms), s = clip > 0.f ? 7.0f / clip : 1.0f; sc = clip > 0.f ? clip * (1.0f / 7.0f) : 1.0f;
#pragma unroll
        for (int j = 0; j < 4; ++j) { unsigned t = 0;
#pragma unroll
            for (int i = 0; i < 8; ++i) { const float f = fminf(fmaxf(v[2 * j + (i >> 2)][i & 3] * s, -7.0f), 7.0f);
                t = __builtin_amdgcn_alignbit(__float_as_uint(f + 12582912.0f), t, 4); }
            w[j] = t; }
    } else {
        const float clip = fminf(am, 3.0f * rms), s = clip > 0.f ? 6.0f / clip : 1.0f; sc = clip > 0.f ? clip * (1.0f / 6.0f) : 1.0f;
#pragma unroll
        for (int j = 0; j < 4; ++j) { unsigned t = 0; float f[8];
#pragma unroll
            for (int i = 0; i < 8; ++i) f[i] = fminf(fmaxf(v[2 * j + (i >> 2)][i & 3] * s, -6.0f), 6.0f);
            t = __builtin_amdgcn_cvt_scalef32_pk_fp4_f32(t, f[0], f[1], 1.0f, 0); t = __builtin_amdgcn_cvt_scalef32_pk_fp4_f32(t, f[2], f[3], 1.0f, 1);
            t = __builtin_amdgcn_cvt_scalef32_pk_fp4_f32(t, f[4], f[5], 1.0f, 2); t = __builtin_amdgcn_cvt_scalef32_pk_fp4_f32(t, f[6], f[7], 1.0f, 3);
            w[j] = t; }
    }
    *(u32x4*)(ws + WS_VB + (size_t)(r & 16383) * EROW + (r < 16384 ? 0 : 1024) + lane * 16) = (u32x4){w[0], w[1], w[2], w[3]};
    if (lane == 0) ((float*)(ws + WS_TSC))[r] = sc;
}
__device__ __forceinline__ void convert_ld(const Params& P, int r, int lane, f32x4 (&v)[8]) {
    const f32x4* src = (const f32x4*)((r < 16384 ? P.in[I_UT] : P.in[I_VT]) + (size_t)(r & 16383) * D) + lane;
#pragma unroll
    for (int j = 0; j < 8; ++j) v[j] = src[64 * j];
}
__device__ __forceinline__ void convert_tables(const Params& P, int r0, int rend, int stride) {
    const int lane = threadIdx.x & 63;
    for (int r = r0; r < rend; r += stride) { f32x4 v[8]; convert_ld(P, r, lane, v); convert_row(P.ws, r, lane, v); }
}
constexpr int LD64 = 72, MATB = 64 * LD64 * 2, LDK = 104;
constexpr int O_AB = 0, O_RB = 1 * MATB, O_BH = 2 * MATB, O_KH = 3 * MATB, O_BTT = 4 * MATB, O_KTT = 5 * MATB, O_VT = 6 * MATB;
constexpr int O_M0 = 7 * MATB, O_M0T = 8 * MATB  , O_M1 = 9 * MATB, O_PA = 10 * MATB, O_PB = 11 * MATB, O_MAK = 12 * MATB, O_MRB = 13 * MATB, O_MRK = 14 * MATB;
constexpr int O_M1T = 0;
constexpr int LDKP = 96;
constexpr int O_WL = 15 * MATB, O_AL = O_WL + 64 * LDKP * 2;
constexpr int O_Z = 7 * MATB, O_AZ = O_Z + 64 * 68 * 4;
static_assert(O_AZ + 64 * 68 * 4 <= O_PB, "lds");
static_assert(O_AL + 64 * LDKP * 2 <= LDS_BYTES - 16, "lds");

__device__ __forceinline__ bf16x8 ldsfrag(ldsp lds, int off, int ld, int row, int kofs) { return *(const LAS bf16x8*)(lds + off + (row * ld + kofs) * 2); }
__device__ __forceinline__ void st4(ldsp lds, int off, int row, int col, const f32x4 v) {
    u32x2 w; w.x = pk2(v.x, v.y); w.y = pk2(v.z, v.w); *(LAS u32x2*)(lds + off + (row * LD64 + col) * 2) = w; }
__device__ __forceinline__ void st1(ldsp lds, int off, int row, int col, float v) { *(LAS bf16_t*)(lds + off + (row * LD64 + col) * 2) = f2bf1(v); }

__device__ __forceinline__ float fast_rcp(float x) { return __builtin_amdgcn_rcpf(x); }
__device__ __forceinline__ float fast_sigmoid(float x) { return fast_rcp(1.0f + __expf(-x)); }
__device__ __forceinline__ float fast_tanh(float x) { return 1.0f - 2.0f * fast_rcp(1.0f + __expf(2.0f * x)); }
__device__ __forceinline__ u32x4 ld8(const bf16_t* p) { return p ? *(const u32x4*)p : (u32x4){0u, 0u, 0u, 0u}; }
__device__ __forceinline__ void shift8r(const u32x4 cw, const u32x4 pw, const float* mu, float* x) {
    float c[8], q[8]; unpack8(cw, c); unpack8(pw, q);
    const f32x4 m0 = *(const f32x4*)mu, m1 = *(const f32x4*)(mu + 4);
    const float mm[8] = {m0.x, m0.y, m0.z, m0.w, m1.x, m1.y, m1.z, m1.w};
#pragma unroll
    for (int i = 0; i < 8; ++i) x[i] = c[i] + (q[i] - c[i]) * mm[i];
}
__device__ __forceinline__ int tcol(int row, int col) { return ((((col >> 3) ^ (row >> 3)) & 7) << 3) | (col & 7); }
__device__ __forceinline__ bf16x8 ldsfragT(ldsp lds, int off, int row, int kofs) { return *(const LAS bf16x8*)(lds + off + (row * LD64 + tcol(row, kofs)) * 2); }
__device__ __forceinline__ void st1T(ldsp lds, int off, int row, int col, float v) { *(LAS bf16_t*)(lds + off + (row * LD64 + tcol(row, col)) * 2) = f2bf1(v); }
typedef short s16x4 __attribute__((ext_vector_type(4)));
__device__ __forceinline__ bf16x8 ldsfragTR(ldsp lds, int off, int krow0, int col0, int lane) {
    const int g = lane >> 4, q = (lane & 15) >> 2, p = lane & 3;
    const LAS s16x4* a = (const LAS s16x4*)(lds + off + ((krow0 + 8 * g + q) * LD64 + col0) * 2 + 8 * p);
    const s16x4 v0 = __builtin_amdgcn_ds_read_tr16_b64_v4i16((LAS s16x4*)a), v1 = __builtin_amdgcn_ds_read_tr16_b64_v4i16((LAS s16x4*)(a + LD64));
    return (bf16x8){v0[0], v0[1], v0[2], v0[3], v1[0], v1[1], v1[2], v1[3]};
}
__device__ __forceinline__ void shift8(const bf16_t* pcur, const bf16_t* pprev, const float* mu, float* x) {
    float c[8], q[8];
    if (pcur) unpack8(*(const u32x4*)pcur, c); else {
#pragma unroll
        for (int i = 0; i < 8; ++i) c[i] = 0.f; }
    if (pprev) unpack8(*(const u32x4*)pprev, q); else {
#pragma unroll
        for (int i = 0; i < 8; ++i) q[i] = 0.f; }
    const f32x4 m0 = *(const f32x4*)mu, m1 = *(const f32x4*)(mu + 4);
    const float mm[8] = {m0.x, m0.y, m0.z, m0.w, m1.x, m1.y, m1.z, m1.w};
#pragma unroll
    for (int i = 0; i < 8; ++i) x[i] = c[i] + (q[i] - c[i]) * mm[i];
}

template <bool DO_P, bool DO_SQ>
__device__ __forceinline__ void dbl_step(ldsp lds, int sN, int sT, int dN, int dT, int pC, int pN, int tm, int tn0, int fr, int fq) {
    bf16x8 a[2];
#pragma unroll
    for (int ks = 0; ks < 2; ++ks) a[ks] = ldsfragTR(lds, sN, 32 * ks, 16 * tm, 16 * fq + fr);
#pragma unroll
    for (int t2 = 0; t2 < 2; ++t2) {
        const int nt = tn0 + t2, t = 16 * nt + fr, s0 = 16 * tm + 4 * fq;
        if (DO_P) {
            f32x4 acc = {0.f, 0.f, 0.f, 0.f};
#pragma unroll
            for (int ks = 0; ks < 2; ++ks) acc = mfma16(a[ks], ldsfrag(lds, pC, LD64, t, ks * 32 + fq * 8), acc);
            const u32x2 pw = *(const LAS u32x2*)(lds + pC + (t * LD64 + s0) * 2);
            acc.x += bflo(pw.x); acc.y += bfhi(pw.x); acc.z += bflo(pw.y); acc.w += bfhi(pw.y);
            st4(lds, pN, t, s0, acc);
        }
        if (DO_SQ) {
            f32x4 acc = {0.f, 0.f, 0.f, 0.f};
#pragma unroll
            for (int ks = 0; ks < 2; ++ks) acc = mfma16(a[ks], ldsfrag(lds, sN, LD64, t, ks * 32 + fq * 8), acc);
            st4(lds, dN, t, s0, acc);
        }
    }
}


struct PL { u32x4 rc, rq, kc, kq, vc, vq; };
__device__ __forceinline__ const bf16_t* unit_rowp(const bf16_t* pp, int u, int tl, int col) {
    int r;
    if (u >= 4096) r = (tl >= 48) ? (ROW_META + tl - 48) : -1;
    else { const int bh = u >> 6, c = u & 63, b = bh >> 5; r = (tl >= 0 || c > 0) ? (b * SEQ + c * 64 + tl) : (ROW_META + 15); }
    return r < 0 ? (const bf16_t*)nullptr : pp + (size_t)r * NPAD + col;
}
__device__ __forceinline__ void pl_load(const Params& P, int u, PL& L) {
    int tid = threadIdx.x; asm volatile("" : "+v"(tid));
    const int lane = tid & 63, wave = tid >> 6, fr = lane & 15, fq = lane >> 4, tm = wave >> 1;
    const bf16_t* pp = (const bf16_t*)(P.ws + WS_P);
    const int h = (u >= 4096) ? (u - 4096) : ((u >> 6) & 31);
    const int t = tid >> 3, hj = h * 64 + 8 * (tid & 7);
    L.rc = ld8(unit_rowp(pp, u, t, C_R + hj)); L.rq = ld8(unit_rowp(pp, u, t - 1, C_R + hj));
    L.kc = ld8(unit_rowp(pp, u, t, C_K + hj)); L.kq = ld8(unit_rowp(pp, u, t - 1, C_K + hj));
    L.vc = ld8(unit_rowp(pp, u, t, C_V + hj)); L.vq = ld8(unit_rowp(pp, u, t - 1, C_V + hj));
}
#define SINGLE_TRIP for (int once_ = 0; once_ < 1; ++once_)
__device__ __forceinline__ void rwkv_unit(const Params& P, ldsp lds, int u, PL& L, int next_u, bool stage_a) {
    int tid = threadIdx.x; asm volatile("" : "+v"(tid));
    const int lane = tid & 63, wave = tid >> 6, fr = lane & 15, fq = lane >> 4, tm = wave >> 1, tn0 = (wave & 1) * 2;
    unsigned char* ws = P.ws;
    const bf16_t* pp = (const bf16_t*)(ws + WS_P);
    const bool meta = u >= 4096;
    int b = 0, h, c = 0;
    if (meta) { h = u - 4096; } else { const int bh = u >> 6; c = u & 63; b = bh >> 5; h = bh & 31; }
    auto rowof = [&](int tl) -> int {
        if (meta) return (tl >= 48) ? (ROW_META + tl - 48) : -1;
        if (tl >= 0 || c > 0) return b * SEQ + c * 64 + tl;
        return ROW_META + 15;
    };
    auto rowp = [&](int tl, int col) -> const bf16_t* { const int r = rowof(tl); return r < 0 ? (const bf16_t*)nullptr : pp + (size_t)r * NPAD + col; };
    const float* mu = P.in[I_MU];
    float lw[8], av[8], rv[8], kv[8], vv[8], kk[8], km[8];
    const int t = tid >> 3, jq = tid & 7, j0 = 8 * jq, hj = h * 64 + j0;
    const bool nulltok = meta && t < 48;
    SINGLE_TRIP {
    bf16x8 lAw[3], lAa[3];
    {
        const bf16_t* ww2 = (const bf16_t*)(ws + WS_WTW2) + (size_t)(h * 64 + 16 * tm + fr) * 96 + fq * 8;
        const bf16_t* wa2 = (const bf16_t*)(ws + WS_WTA2) + (size_t)(h * 64 + 16 * tm + fr) * 96 + fq * 8;
#pragma unroll
        for (int ks = 0; ks < 3; ++ks) { lAw[ks] = *(const bf16x8*)(ww2 + ks * 32); lAa[ks] = *(const bf16x8*)(wa2 + ks * 32); }
    }
    if (stage_a) {
        u32x4 cw[3], pw[3];
#pragma unroll
        for (int it = 0; it < 3; ++it) { const int idx = tid + 512 * it, mat = idx / 768, rem = idx - mat * 768, tt = rem / 12, ch = rem - tt * 12, col = (mat ? C_AL : C_WL) + ch * 8;
            cw[it] = ld8(rowp(tt, col)); pw[it] = ld8(rowp(tt - 1, col)); }
#pragma unroll
        for (int it = 0; it < 3; ++it) { const int idx = tid + 512 * it, mat = idx / 768, rem = idx - mat * 768, tt = rem / 12, ch = rem - tt * 12, col = (mat ? C_AL : C_WL) + ch * 8;
            float x[8]; shift8r(cw[it], pw[it], mu + col, x);
            if (mat == 0) {
#pragma unroll
                for (int i = 0; i < 8; ++i) x[i] = fast_tanh(x[i]);
            }
            *(LAS u32x4*)(lds + (mat ? O_AL : O_WL) + (tt * LDKP + ch * 8) * 2) = pack8(x); }
    }
    BLOCK_SYNC();
    {
        f32x4 z[2] = {{0.f, 0.f, 0.f, 0.f}, {0.f, 0.f, 0.f, 0.f}}, az[2] = {{0.f, 0.f, 0.f, 0.f}, {0.f, 0.f, 0.f, 0.f}};
#pragma unroll
        for (int ks = 0; ks < 3; ++ks) {
            const bf16x8 aw = lAw[ks], aa = lAa[ks];
#pragma unroll
            for (int t2 = 0; t2 < 2; ++t2) {
                const int t = 16 * (tn0 + t2) + fr;
                z[t2] = mfma16(aw, ldsfrag(lds, O_WL, LDKP, t, ks * 32 + fq * 8), z[t2]);
                az[t2] = mfma16(aa, ldsfrag(lds, O_AL, LDKP, t, ks * 32 + fq * 8), az[t2]);
            }
        }
#pragma unroll
        for (int t2 = 0; t2 < 2; ++t2) {
            const int t = 16 * (tn0 + t2) + fr, j0 = 16 * tm + 4 * fq;
            *(LAS f32x4*)(lds + O_Z + (t * 68 + j0) * 4) = z[t2];
            *(LAS f32x4*)(lds + O_AZ + (t * 68 + j0) * 4) = az[t2];
        }
    }
    BLOCK_SYNC();
    float cs[8];
    {
        const f32x4 z0 = *(const LAS f32x4*)(lds + O_Z + (t * 68 + j0) * 4), z1 = *(const LAS f32x4*)(lds + O_Z + (t * 68 + j0 + 4) * 4);
        const f32x4 y0 = *(const LAS f32x4*)(lds + O_AZ + (t * 68 + j0) * 4), y1 = *(const LAS f32x4*)(lds + O_AZ + (t * 68 + j0 + 4) * 4);
        const float zz[8] = {z0.x, z0.y, z0.z, z0.w, z1.x, z1.y, z1.z, z1.w}, yy[8] = {y0.x, y0.y, y0.z, y0.w, y1.x, y1.y, y1.z, y1.w};
        const f32x4 w0a = *(const f32x4*)(P.in[I_W0] + hj), w0b = *(const f32x4*)(P.in[I_W0] + hj + 4), a0a = *(const f32x4*)(P.in[I_A0] + hj), a0b = *(const f32x4*)(P.in[I_A0] + hj + 4);
        const float w0[8] = {w0a.x, w0a.y, w0a.z, w0a.w, w0b.x, w0b.y, w0b.z, w0b.w}, a0[8] = {a0a.x, a0a.y, a0a.z, a0a.w, a0b.x, a0b.y, a0b.z, a0b.w};
#pragma unroll
        for (int i = 0; i < 8; ++i) { lw[i] = nulltok ? 0.f : -DSCALE * fast_sigmoid(w0[i] + zz[i]); av[i] = fast_sigmoid(a0[i] + yy[i]); cs[i] = lw[i]; }
#pragma unroll
        for (int d = 8; d < 64; d <<= 1) {
#pragma unroll
            for (int i = 0; i < 8; ++i) { const float o = __shfl_up(cs[i], d); cs[i] += (lane >= d) ? o : 0.f; }
        }
        if (lane >= 56) {
#pragma unroll
            for (int i = 0; i < 8; ++i) *(LAS float*)(lds + (wave < 4 ? O_BH : O_KH) + ((j0 + i) * LD64 + 64) * 2 + (wave & 3) * 4) = cs[i]; }
        shift8r(L.rc, L.rq, mu + C_R + hj, rv); shift8r(L.kc, L.kq, mu + C_K + hj, kv); shift8r(L.vc, L.vq, mu + C_V + hj, vv);
        if (nulltok) {
#pragma unroll
            for (int i = 0; i < 8; ++i) { rv[i] = 0.f; kv[i] = 0.f; vv[i] = 0.f; }
        }
        const f32x4 kka = *(const f32x4*)(P.in[I_KK] + hj), kkb = *(const f32x4*)(P.in[I_KK] + hj + 4), kaa = *(const f32x4*)(P.in[I_KA] + hj), kab = *(const f32x4*)(P.in[I_KA] + hj + 4);
        const f32x4 rka = *(const f32x4*)(P.in[I_RK] + hj), rkb = *(const f32x4*)(P.in[I_RK] + hj + 4);
        const float kkw[8] = {kka.x, kka.y, kka.z, kka.w, kkb.x, kkb.y, kkb.z, kkb.w}, kaw[8] = {kaa.x, kaa.y, kaa.z, kaa.w, kab.x, kab.y, kab.z, kab.w}, rkw[8] = {rka.x, rka.y, rka.z, rka.w, rkb.x, rkb.y, rkb.z, rkb.w};
        float n2 = 0.f, bon = 0.f;
#pragma unroll
        for (int i = 0; i < 8; ++i) { kk[i] = kv[i] * kkw[i]; n2 += kk[i] * kk[i]; km[i] = kv[i] * (1.0f + (av[i] - 1.0f) * kaw[i]); bon += rv[i] * km[i] * rkw[i]; }
        n2 += DPPF(n2, 0xB1); n2 += DPPF(n2, 0x4E); n2 += DPPF(n2, 0x141);
        bon += DPPF(bon, 0xB1); bon += DPPF(bon, 0x4E); bon += DPPF(bon, 0x141);
        const float inv = 1.0f / fmaxf(sqrtf(n2), 1e-12f);
#pragma unroll
        for (int i = 0; i < 8; ++i) kk[i] *= inv;
        if (!meta && jq == 0) ((float*)(ws + WS_BONUS))[(size_t)(b * SEQ + c * 64 + t) * 32 + h] = bon;
    }
    BLOCK_SYNC();
    {
        float Lc[8], Le[8];
#pragma unroll
        for (int i = 0; i < 8; ++i) { Lc[i] = cs[i]; Le[i] = 0.f; }
#pragma unroll
        for (int i = 0; i < 8; ++i) {
            const f32x4 wa = *(const LAS f32x4*)(lds + O_BH + ((j0 + i) * LD64 + 64) * 2), wb = *(const LAS f32x4*)(lds + O_KH + ((j0 + i) * LD64 + 64) * 2);
            const float ww[8] = {wa.x, wa.y, wa.z, wa.w, wb.x, wb.y, wb.z, wb.w};
#pragma unroll
            for (int w = 0; w < 8; ++w) { Le[i] += ww[w]; Lc[i] += (w < wave) ? ww[w] : 0.f; }
        }
        float Ab[8], Rb[8], Bh[8], Kh[8], Bt[8], Kt[8];
#pragma unroll
        for (int i = 0; i < 8; ++i) {
            const float eP = __expf(Lc[i] - lw[i]), eC = __expf(Lc[i]), eN = __expf(-Lc[i]), eE = __expf(Le[i] - Lc[i]);
            const float ka = kk[i] * av[i];
            Ab[i] = -kk[i] * eP; Rb[i] = rv[i] * eC; Bh[i] = ka * eN; Kh[i] = km[i] * eN; Bt[i] = ka * eE; Kt[i] = km[i] * eE;
        }
        *(LAS u32x4*)(lds + O_AB + (t * LD64 + j0) * 2) = pack8(Ab);
        *(LAS u32x4*)(lds + O_RB + (t * LD64 + j0) * 2) = pack8(Rb);
        *(LAS u32x4*)(lds + O_BH + (t * LD64 + j0) * 2) = pack8(Bh);
        *(LAS u32x4*)(lds + O_KH + (t * LD64 + j0) * 2) = pack8(Kh);
        *(LAS u32x4*)(lds + O_BTT + (t * LD64 + j0) * 2) = pack8(Bt);
        *(LAS u32x4*)(lds + O_KTT + (t * LD64 + j0) * 2) = pack8(Kt);
        *(LAS u32x4*)(lds + O_VT + (t * LD64 + j0) * 2) = pack8(vv);
        if (t == 63) {
#pragma unroll
            for (int i = 0; i < 8; ++i) *(LAS float*)(lds + O_RB + ((j0 + i) * LD64 + 64) * 2) = __expf(Le[i]);
        }
    }
    BLOCK_SYNC();
    }
    if (next_u >= 0) pl_load(P, next_u, L);
    SINGLE_TRIP {
    {
        bf16x8 abh[2], akh[2];
#pragma unroll
        for (int ks = 0; ks < 2; ++ks) { abh[ks] = ldsfrag(lds, O_BH, LD64, 16 * tm + fr, ks * 32 + fq * 8); akh[ks] = ldsfrag(lds, O_KH, LD64, 16 * tm + fr, ks * 32 + fq * 8); }
#pragma unroll
        for (int t2 = 0; t2 < 2; ++t2) {
            const int tt = 16 * (tn0 + t2) + fr, s0 = 16 * tm + 4 * fq;
            f32x4 mab = {0.f, 0.f, 0.f, 0.f}, mak = mab, mrb = mab, mrk = mab;
#pragma unroll
            for (int ks = 0; ks < 2; ++ks) {
                const bf16x8 bab = ldsfrag(lds, O_AB, LD64, tt, ks * 32 + fq * 8), brb = ldsfrag(lds, O_RB, LD64, tt, ks * 32 + fq * 8);
                mab = mfma16(abh[ks], bab, mab); mak = mfma16(akh[ks], bab, mak); mrb = mfma16(abh[ks], brb, mrb); mrk = mfma16(akh[ks], brb, mrk);
            }
            float vab[4] = {mab.x, mab.y, mab.z, mab.w}, vak[4] = {mak.x, mak.y, mak.z, mak.w}, vrb[4] = {mrb.x, mrb.y, mrb.z, mrb.w}, vrk[4] = {mrk.x, mrk.y, mrk.z, mrk.w}, vp[4];
#pragma unroll
            for (int r = 0; r < 4; ++r) { const int s = s0 + r; const bool st = s < tt, le = s <= tt;
                vab[r] = st ? vab[r] : 0.f; vak[r] = st ? vak[r] : 0.f; vrb[r] = le ? vrb[r] : 0.f; vrk[r] = le ? vrk[r] : 0.f; vp[r] = vab[r] + (s == tt ? 1.0f : 0.f); }
            st4(lds, O_M0, tt, s0, (f32x4){vab[0], vab[1], vab[2], vab[3]});
            st4(lds, O_PA, tt, s0, (f32x4){vp[0], vp[1], vp[2], vp[3]});
            st4(lds, O_MAK, tt, s0, (f32x4){vak[0], vak[1], vak[2], vak[3]});
            st4(lds, O_MRB, tt, s0, (f32x4){vrb[0], vrb[1], vrb[2], vrb[3]});
            st4(lds, O_MRK, tt, s0, (f32x4){vrk[0], vrk[1], vrk[2], vrk[3]});
        }
    }
    BLOCK_SYNC();
    dbl_step<false, true>(lds, O_M0, O_M0T, O_M1, O_M1T, 0, 0, tm, tn0, fr, fq); BLOCK_SYNC();
    dbl_step<true, true>(lds, O_M1, O_M1T, O_M0, O_M0T, O_PA, O_PB, tm, tn0, fr, fq); BLOCK_SYNC();
    dbl_step<true, true>(lds, O_M0, O_M0T, O_M1, O_M1T, O_PB, O_PA, tm, tn0, fr, fq); BLOCK_SYNC();
    dbl_step<true, true>(lds, O_M1, O_M1T, O_M0, O_M0T, O_PA, O_PB, tm, tn0, fr, fq); BLOCK_SYNC();
    if (!meta) {
    dbl_step<true, true>(lds, O_M0, O_M0T, O_M1, O_M1T, O_PB, O_PA, tm, tn0, fr, fq); BLOCK_SYNC();
    dbl_step<true, false>(lds, O_M1, O_M1T, 0, 0, O_PA, O_PB, tm, tn0, fr, fq); BLOCK_SYNC();
    }
    }
    const size_t ub = (size_t)u * 4096;
    SINGLE_TRIP {
    {
        bf16x8 aT[2], aMak[2];
#pragma unroll
        for (int ks = 0; ks < 2; ++ks) { aT[ks] = ldsfrag(lds, O_PB, LD64, 16 * tm + fr, ks * 32 + fq * 8); aMak[ks] = ldsfrag(lds, O_MAK, LD64, 16 * tm + fr, ks * 32 + fq * 8); }
#pragma unroll
        for (int t2 = 0; t2 < 2; ++t2) {
            const int n = 16 * (tn0 + t2) + fr, t0 = 16 * tm + 4 * fq;
            f32x4 at = {0.f, 0.f, 0.f, 0.f}, xt = at;
#pragma unroll
            for (int ks = 0; ks < 2; ++ks) { at = mfma16(aT[ks], ldsfragTR(lds, O_AB, 32 * ks, 16 * (tn0 + t2), 16 * fq + fr), at); xt = mfma16(aMak[ks], ldsfragTR(lds, O_VT, 32 * ks, 16 * (tn0 + t2), 16 * fq + fr), xt); }
            st4(lds, O_M0, n, t0, at); st4(lds, O_M0T, n, t0, xt);
        }
    }
    BLOCK_SYNC();
    {
        bf16x8 aT[2], aAt[2];
#pragma unroll
        for (int ks = 0; ks < 2; ++ks) { aT[ks] = ldsfrag(lds, O_PB, LD64, 16 * tm + fr, ks * 32 + fq * 8); aAt[ks] = ldsfrag(lds, O_M0, LD64, 16 * tm + fr, ks * 32 + fq * 8); }
        bf16_t* Rt = (bf16_t*)(ws + WS_RT) + ub; bf16_t* Gp = (bf16_t*)(ws + WS_G) + ub;
#pragma unroll
        for (int t2 = 0; t2 < 2; ++t2) {
            const int n = 16 * (tn0 + t2) + fr, m0 = 16 * tm + 4 * fq;
            f32x4 u0 = {0.f, 0.f, 0.f, 0.f}, rt = u0, g = u0;
#pragma unroll
            for (int ks = 0; ks < 2; ++ks) {
                u0 = mfma16(aT[ks], ldsfrag(lds, O_M0T, LD64, n, ks * 32 + fq * 8), u0);
                rt = mfma16(aAt[ks], ldsfrag(lds, O_MRB, LD64, n, ks * 32 + fq * 8), rt);
                g = mfma16(aAt[ks], ldsfragTR(lds, O_BTT, 32 * ks, 16 * (tn0 + t2), 16 * fq + fr), g);
            }
            st4(lds, O_M1, n, m0, u0);
            const u32x2 rw = *(const LAS u32x2*)(lds + O_RB + (n * LD64 + m0) * 2);
            rt.x += bflo(rw.x); rt.y += bfhi(rw.x); rt.z += bflo(rw.y); rt.w += bfhi(rw.y);
            { u32x2 w; w.x = pk2(rt.x, rt.y); w.y = pk2(rt.z, rt.w); *(u32x2*)(Rt + n * 64 + m0) = w; }
            if ((n >> 2) == (m0 >> 2)) { const float e = *(const LAS float*)(lds + O_RB + (n * LD64 + 64) * 2); const int r = n & 3;
                g.x += (r == 0) ? e : 0.f; g.y += (r == 1) ? e : 0.f; g.z += (r == 2) ? e : 0.f; g.w += (r == 3) ? e : 0.f; }
            { const int pos0 = 32 * (tm >> 1) + 8 * fq + 4 * (tm & 1); u32x2 w; w.x = pk2(g.x, g.y); w.y = pk2(g.z, g.w); *(u32x2*)(Gp + n * 64 + pos0) = w; }
        }
    }
    BLOCK_SYNC();
    {
        bf16x8 aB[2], aK[2], aU[2], aV[2];
#pragma unroll
        for (int ks = 0; ks < 2; ++ks) { const int row = 16 * tm + fr, ko = ks * 32 + fq * 8;
            aB[ks] = ldsfragTR(lds, O_BTT, 32 * ks, 16 * tm, 16 * fq + fr); aK[ks] = ldsfragTR(lds, O_KTT, 32 * ks, 16 * tm, 16 * fq + fr); aU[ks] = ldsfrag(lds, O_M1, LD64, row, ko); aV[ks] = ldsfragTR(lds, O_VT, 32 * ks, 16 * tm, 16 * fq + fr); }
        bf16_t* H0t = (bf16_t*)(ws + WS_H0T) + ub; bf16_t* Y0s = (bf16_t*)(ws + WS_Y0) + ub;
#pragma unroll
        for (int t2 = 0; t2 < 2; ++t2) {
            const int n = 16 * (tn0 + t2) + fr, m0 = 16 * tm + 4 * fq;
            f32x4 hh = {0.f, 0.f, 0.f, 0.f}, yy = hh;
#pragma unroll
            for (int ks = 0; ks < 2; ++ks) { const int ko = ks * 32 + fq * 8;
                const bf16x8 bU = ldsfrag(lds, O_M1, LD64, n, ko), bV = ldsfragTR(lds, O_VT, 32 * ks, 16 * (tn0 + t2), 16 * fq + fr), bRb = ldsfrag(lds, O_MRB, LD64, n, ko), bRk = ldsfrag(lds, O_MRK, LD64, n, ko);
                hh = mfma16(aB[ks], bU, hh); hh = mfma16(aK[ks], bV, hh);
                yy = mfma16(aU[ks], bRb, yy); yy = mfma16(aV[ks], bRk, yy); }
            { u32x2 w; w.x = pk2(hh.x, hh.y); w.y = pk2(hh.z, hh.w); *(u32x2*)(H0t + n * 64 + m0) = w; }
            { u32x2 w; w.x = pk2(yy.x, yy.y); w.y = pk2(yy.z, yy.w); *(u32x2*)(Y0s + n * 64 + m0) = w; }
        }
    }
    BLOCK_SYNC();
    }
}

constexpr int LDU = 264;
__device__ __forceinline__ void pool_load(const Params& P, int pu, u32x4 (&raw)[5]) {
    int tid = threadIdx.x; asm volatile("" : "+v"(tid));
    const bf16_t* pp = (const bf16_t*)(P.ws + WS_P);
    const int g = (pu < 256) ? (pu & 3) : 3 - (pu & 3), tt = pu >> 2, b = tt >> 6, ti0 = (tt & 63) * 64;
#pragma unroll
    for (int k = 0; k < 5; ++k) { const int idx = tid + 512 * k;
        if (idx < 79 * 32) { const int lr = idx >> 5, ch = idx & 31, ti = ti0 + lr - 15; const int row = ti >= 0 ? b * SEQ + ti : ROW_META + 16 + ti;
            raw[k] = *(const u32x4*)(pp + (size_t)row * NPAD + C_POOL + g * 256 + ch * 8); } }
}
__device__ __forceinline__ void pool_unit(const Params& P, ldsp lds, int pu, const u32x4 (&raw)[5]) {
    int tid = threadIdx.x; asm volatile("" : "+v"(tid));
    const int lane = tid & 63, wave = tid >> 6, fr = lane & 15, fq = lane >> 4;
    unsigned char* ws = P.ws;
    const bf16_t* pp = (const bf16_t*)(ws + WS_P);
    const int g = (pu < 256) ? (pu & 3) : 3 - (pu & 3), tt = pu >> 2, b = tt >> 6, ti0 = (tt & 63) * 64;
    constexpr int O_U = 0, O_PL = 79 * LDU * 2;
#pragma unroll
    for (int k = 0; k < 5; ++k) { const int idx = tid + 512 * k; if (idx < 79 * 32) *(LAS u32x4*)(lds + O_U + ((idx >> 5) * LDU + (idx & 31) * 8) * 2) = raw[k]; }
    BLOCK_SYNC();
    {
        const int c0 = (tid & 31) * 8, t0 = (tid >> 5) * 4, win = 2 << g; const float inv = 1.0f / (float)win;
        float s[8], nw[8];
        unpack8(*(const LAS u32x4*)(lds + O_U + ((15 + t0) * LDU + c0) * 2), nw);
#pragma unroll
        for (int i = 0; i < 8; ++i) s[i] = nw[i];
        for (int d = 1; d < win; ++d) { float x[8]; unpack8(*(const LAS u32x4*)(lds + O_U + ((15 + t0 - d) * LDU + c0) * 2), x);
#pragma unroll
            for (int i = 0; i < 8; ++i) s[i] += x[i]; }
#pragma unroll
        for (int k = 0; k < 4; ++k) {
            if (k > 0) { float od[8]; unpack8(*(const LAS u32x4*)(lds + O_U + ((15 + t0 + k) * LDU + c0) * 2), nw); unpack8(*(const LAS u32x4*)(lds + O_U + ((15 + t0 + k - win) * LDU + c0) * 2), od);
#pragma unroll
                for (int i = 0; i < 8; ++i) s[i] += nw[i] - od[i]; }
            float o[8];
#pragma unroll
            for (int i = 0; i < 8; ++i) o[i] = s[i] * inv - nw[i];
            *(LAS u32x4*)(lds + O_PL + ((t0 + k) * LDU + c0) * 2) = pack8(o);
        }
    }
    BLOCK_SYNC();
    {
        const bf16_t* wt = (const bf16_t*)(ws + WS_WTPOOL) + (size_t)g * 65536;
        f32x4 acc[2][4];
#pragma unroll
        for (int a = 0; a < 2; ++a)
#pragma unroll
            for (int n = 0; n < 4; ++n) acc[a][n] = (f32x4){0.f, 0.f, 0.f, 0.f};
#pragma unroll 4
        for (int ks = 0; ks < 8; ++ks) {
            bf16x8 af[2];
#pragma unroll
            for (int a = 0; a < 2; ++a) af[a] = *(const bf16x8*)(wt + (size_t)(32 * wave + 16 * a + fr) * 256 + ks * 32 + fq * 8);
#pragma unroll
            for (int n = 0; n < 4; ++n) { const bf16x8 bf = ldsfrag(lds, O_PL, LDU, 16 * n + fr, ks * 32 + fq * 8);
#pragma unroll
                for (int a = 0; a < 2; ++a) acc[a][n] = mfma16(af[a], bf, acc[a][n]); }
        }
        bf16_t* yb = (bf16_t*)(ws + WS_YAB) + 2048;
        const float* psc = P.in[I_PSCALE] + g * 256;
#pragma unroll
        for (int a = 0; a < 2; ++a) { const int d0 = 32 * wave + 16 * a + 4 * fq; const f32x4 sc = *(const f32x4*)(psc + d0);
#pragma unroll
            for (int n = 0; n < 4; ++n) { const int t = 16 * n + fr; const f32x4 o = acc[a][n] * sc;
                u32x2 w; w.x = pk2(o.x, o.y); w.y = pk2(o.z, o.w);
                *(u32x2*)(yb + (size_t)(b * SEQ + ti0 + t) * LDAB + g * 256 + d0) = w; } }
    }
    BLOCK_SYNC();
}
__device__ __forceinline__ void gsig_unit(const Params& P, int gu) {
    int tid = threadIdx.x; asm volatile("" : "+v"(tid));
    const bf16_t* pp = (const bf16_t*)(P.ws + WS_P); bf16_t* gs = (bf16_t*)(P.ws + WS_GSIG);
    const float* mu = P.in[I_MU];
#pragma unroll
    for (int it = 0; it < 4; ++it) {
        const int idx = tid + 512 * it, tl = idx >> 5, ch = idx & 31, col = C_GL + ch * 8;
        const int row = gu * 64 + tl; const int prow = ((row & (SEQ - 1)) == 0) ? (ROW_META + 15) : row - 1;
        float x[8]; shift8r(*(const u32x4*)(pp + (size_t)row * NPAD + col), *(const u32x4*)(pp + (size_t)prow * NPAD + col), mu + col, x);
#pragma unroll
        for (int i = 0; i < 8; ++i) x[i] = fast_sigmoid(x[i]);
        *(u32x4*)(gs + (size_t)row * 256 + ch * 8) = pack8(x);
    }
}
__device__ __forceinline__ void phase2(const Params& P, ldsp lds) {
    PL L;
    for (int j = blockIdx.x; j < 256 + 32 + 128; j += gridDim.x) {
        if (j < 256) {
            const int b = j >> 7, c = (j >> 1) & 63, h0 = (j & 1) * 16;
            pl_load(P, (b * 32 + h0) * 64 + c, L);
            for (int i = 0; i < 16; ++i) { const int u = (b * 32 + h0 + i) * 64 + c; rwkv_unit(P, lds, u, L, i + 1 < 16 ? u + 64 : -1, i == 0); }
        } else if (j < 288) { pl_load(P, 4096 + (j - 256), L); rwkv_unit(P, lds, 4096 + (j - 256), L, -1, true); }
        else gsig_unit(P, j - 288);
    }
}
__device__ __forceinline__ void phase3(const Params& P) {
    const int lane = threadIdx.x & 63, wave = threadIdx.x >> 6, fr = lane & 15, fq = lane >> 4;
    if (wave != 0) { convert_tables(P, blockIdx.x * 7 + (wave - 1), CONV_P3_END, gridDim.x * 7); return; }
    unsigned char* ws = P.ws;
    const bf16_t* Gp = (const bf16_t*)(ws + WS_G); const bf16_t* H0t = (const bf16_t*)(ws + WS_H0T); bf16_t* S0t = (bf16_t*)(ws + WS_S0T);
    for (int item = blockIdx.x; item < 256; item += gridDim.x) {
        const int bh = item >> 2, vq = item & 3, h = bh & 31;
        bf16x8 Sb[2];
#pragma unroll
        for (int ks = 0; ks < 2; ++ks)
#pragma unroll
            for (int i = 0; i < 8; ++i) Sb[ks][i] = 0;
        bf16x8 g0[4][2], g1[4][2], g2[4][2], g3[4][2]; u32x2 h0[4], h1[4], h2[4], h3[4];
        auto load = [&](int step, bf16x8 (&ga)[4][2], u32x2 (&hf)[4]) {
            const int u = (step == 0) ? (4096 + h) : (bh * 64 + step - 1);
            const bf16_t* g = Gp + (size_t)u * 4096; const bf16_t* hh = H0t + (size_t)u * 4096;
#pragma unroll
            for (int mt = 0; mt < 4; ++mt) {
#pragma unroll
                for (int ks = 0; ks < 2; ++ks) ga[mt][ks] = *(const bf16x8*)(g + (16 * mt + fr) * 64 + ks * 32 + fq * 8);
                hf[mt] = *(const u32x2*)(hh + (16 * vq + fr) * 64 + 16 * mt + 4 * fq);
            }
        };
        auto apply = [&](int step, const bf16x8 (&ga)[4][2], const u32x2 (&hf)[4]) {
            f32x4 acc[4];
#pragma unroll
            for (int mt = 0; mt < 4; ++mt) {
                acc[mt] = (f32x4){bflo(hf[mt].x), bfhi(hf[mt].x), bflo(hf[mt].y), bfhi(hf[mt].y)};
                acc[mt] = mfma16(ga[mt][0], Sb[0], acc[mt]);
                acc[mt] = mfma16(ga[mt][1], Sb[1], acc[mt]);
            }
            bf16_t* so = S0t + (size_t)(bh * 64 + step) * 4096 + (16 * vq + fr) * 64 + 4 * fq;
            u32x2 w[4];
#pragma unroll
            for (int mt = 0; mt < 4; ++mt) { w[mt].x = pk2(acc[mt].x, acc[mt].y); w[mt].y = pk2(acc[mt].z, acc[mt].w); *(u32x2*)(so + 16 * mt) = w[mt]; }
#pragma unroll
            for (int ks = 0; ks < 2; ++ks) {
                const u32x4 q4 = (u32x4){w[2 * ks].x, w[2 * ks].y, w[2 * ks + 1].x, w[2 * ks + 1].y};
                Sb[ks] = __builtin_bit_cast(bf16x8, q4);
            }
        };
        load(0, g0, h0); load(1, g1, h1); load(2, g2, h2);
#pragma unroll 1
        for (int step = 0; step < 64; step += 4) {
            load(step + 3, g3, h3); apply(step, g0, h0);
            if (step + 4 < 64) load(step + 4, g0, h0);
            apply(step + 1, g1, h1);
            if (step + 5 < 64) load(step + 5, g1, h1);
            apply(step + 2, g2, h2);
            if (step + 6 < 64) load(step + 6, g2, h2);
            apply(step + 3, g3, h3);
        }
    }
}

constexpr int LDG = 264;
__device__ __forceinline__ void phase3b(const Params& P, ldsp lds) {
    int tid = threadIdx.x; asm volatile("" : "+v"(tid));
    const int lane = tid & 63, wave = tid >> 6, fr = lane & 15, fq = lane >> 4, wq = wave & 3;
    unsigned char* ws = P.ws;
    const bf16_t* pp = (const bf16_t*)(ws + WS_P);
    const float* mu = P.in[I_MU];
    constexpr int O_G2 = 0, O_HP = 64 * LDG * 2;
    {
        u32x4 ra[5], rb[5]; int pu = blockIdx.x;
        if (pu < 512) pool_load(P, pu, ra);
        for (; pu < 512; pu += gridDim.x) {
            const int pn = pu + gridDim.x;
            if (pn < 512) pool_load(P, pn, rb);
            pool_unit(P, lds, pu, ra);
#pragma unroll
            for (int k = 0; k < 5; ++k) ra[k] = rb[k];
        }
    }
    for (int w = blockIdx.x; w < 256; w += gridDim.x) {
        const int h = w & 31;
        BLOCK_SYNC();
        for (int idx = tid; idx < 64 * 32; idx += 512) { const int row = idx >> 5, ch = idx & 31;
            *(LAS u32x4*)(lds + O_G2 + (row * LDG + ch * 8) * 2) = *(const u32x4*)((const bf16_t*)(ws + WS_WTG2) + (size_t)(h * 64 + row) * 256 + ch * 8); }
        if (tid < 48) { const int a = tid >> 4, q4 = tid & 15; const float* src = a == 0 ? P.in[I_GNG] + h * 64 : a == 1 ? P.in[I_GNB] + h * 64 : mu + C_V + h * 64;
            *(LAS f32x4*)(lds + O_HP + a * 256 + q4 * 16) = *(const f32x4*)(src + q4 * 4); }
        BLOCK_SYNC();
        bf16x8 bG[8], bR[2], aS[4][2]; u32x2 yw[4], vc[4], vp[4]; float bon;
        auto unit_of = [&](int it, int& b, int& c) { const int q = (w >> 5) + 8 * (2 * it + (wave >> 2)); b = q >> 6; c = q & 63; };
        auto issue = [&](int it) {
            int b, c; unit_of(it, b, c); const int u = (b * 32 + h) * 64 + c, trow0 = b * SEQ + c * 64 + 16 * wq;
            const size_t ub = (size_t)u * 4096;
            const bf16_t* S0t = (const bf16_t*)(ws + WS_S0T) + ub; const bf16_t* Rt = (const bf16_t*)(ws + WS_RT) + ub; const bf16_t* Y0s = (const bf16_t*)(ws + WS_Y0) + ub;
            const int row = trow0 + fr; const int prow = (c == 0 && wq == 0 && fr == 0) ? (ROW_META + 15) : row - 1;
            const bf16_t* gsr = (const bf16_t*)(ws + WS_GSIG) + (size_t)row * 256 + fq * 8;
#pragma unroll
            for (int ks = 0; ks < 8; ++ks) bG[ks] = *(const bf16x8*)(gsr + ks * 32);
#pragma unroll
            for (int ks = 0; ks < 2; ++ks) bR[ks] = *(const bf16x8*)(Rt + (16 * wq + fr) * 64 + ks * 32 + fq * 8);
#pragma unroll
            for (int mt = 0; mt < 4; ++mt) {
                yw[mt] = *(const u32x2*)(Y0s + (16 * wq + fr) * 64 + 16 * mt + 4 * fq);
#pragma unroll
                for (int ks = 0; ks < 2; ++ks) aS[mt][ks] = *(const bf16x8*)(S0t + (16 * mt + fr) * 64 + ks * 32 + fq * 8);
                const int hc = h * 64 + 16 * mt + 4 * fq;
                vc[mt] = *(const u32x2*)(pp + (size_t)row * NPAD + C_V + hc); vp[mt] = *(const u32x2*)(pp + (size_t)prow * NPAD + C_V + hc);
            }
            bon = ((const float*)(ws + WS_BONUS))[(size_t)row * 32 + h];
        };
        issue(0);
#pragma unroll 1
        for (int it = 0; it < 8; ++it) {
            const int crow = CONV_P3_END + (w * 8 + it) * 8 + wave; f32x4 tv[8];
            if (crow < 32768) convert_ld(P, crow, lane, tv);
            int b, c; unit_of(it, b, c);
            const int row = b * SEQ + c * 64 + 16 * wq + fr;
            f32x4 gacc[4];
#pragma unroll
            for (int mt = 0; mt < 4; ++mt) gacc[mt] = (f32x4){0.f, 0.f, 0.f, 0.f};
#pragma unroll
            for (int ks = 0; ks < 8; ++ks)
#pragma unroll
                for (int mt = 0; mt < 4; ++mt) gacc[mt] = mfma16(*(const LAS bf16x8*)(lds + O_G2 + ((16 * mt + fr) * LDG + ks * 32 + fq * 8) * 2), bG[ks], gacc[mt]);
            f32x4 y[4], vv[4]; const float bonc = bon;
#pragma unroll
            for (int mt = 0; mt < 4; ++mt) {
                y[mt] = (f32x4){bflo(yw[mt].x), bfhi(yw[mt].x), bflo(yw[mt].y), bfhi(yw[mt].y)};
#pragma unroll
                for (int ks = 0; ks < 2; ++ks) y[mt] = mfma16(aS[mt][ks], bR[ks], y[mt]);
                const f32x4 mv = *(const LAS f32x4*)(lds + O_HP + 512 + (16 * mt + 4 * fq) * 4);
                const f32x4 cv = (f32x4){bflo(vc[mt].x), bfhi(vc[mt].x), bflo(vc[mt].y), bfhi(vc[mt].y)}, pv = (f32x4){bflo(vp[mt].x), bfhi(vp[mt].x), bflo(vp[mt].y), bfhi(vp[mt].y)};
                vv[mt] = cv + (pv - cv) * mv;
            }
#pragma unroll
            for (int mt = 0; mt < 4; ++mt) asm volatile("" : "+v"(y[mt]), "+v"(vv[mt]), "+v"(gacc[mt]));
            if (it + 1 < 8) issue(it + 1);
            float s = 0.f;
#pragma unroll
            for (int mt = 0; mt < 4; ++mt) s += (y[mt].x + y[mt].y) + (y[mt].z + y[mt].w);
            s += __shfl_xor(s, 16); s += __shfl_xor(s, 32);
            const float mean = s * (1.0f / 64.0f); float qq = 0.f;
#pragma unroll
            for (int mt = 0; mt < 4; ++mt) { y[mt] = y[mt] - mean; qq += (y[mt].x * y[mt].x + y[mt].y * y[mt].y) + (y[mt].z * y[mt].z + y[mt].w * y[mt].w); }
            qq += __shfl_xor(qq, 16); qq += __shfl_xor(qq, 32);
            const float rstd = 1.0f / sqrtf(qq * (1.0f / 64.0f) + GN_EPS);
            bf16_t* ya = (bf16_t*)(ws + WS_YAB) + (size_t)row * LDAB + h * 64;
#pragma unroll
            for (int mt = 0; mt < 4; ++mt) {
                const int i0 = 16 * mt + 4 * fq, hc = h * 64 + i0;
                const f32x4 gg = *(const LAS f32x4*)(lds + O_HP + i0 * 4), gb = *(const LAS f32x4*)(lds + O_HP + 256 + i0 * 4);
                const f32x4 o = (y[mt] * rstd * gg + gb + vv[mt] * bonc) * gacc[mt];
                u32x2 wv; wv.x = pk2(o.x, o.y); wv.y = pk2(o.z, o.w);
                *(u32x2*)(ya + i0) = wv;
            }
            if (crow < 32768) convert_row(ws, crow, lane, tv);
        }
    }
}
__device__ __forceinline__ u32x6 ld_row6(const unsigned char* p) { const u32x2 a = ((const u32x2*)p)[0], b = ((const u32x2*)p)[1], c = ((const u32x2*)p)[2]; return (u32x6){a.x, a.y, b.x, b.y, c.x, c.y}; }
__device__ __forceinline__ void peer_load_x(const Params& P, ldsp lds, int o_par, int tok, int lo, float (&x)[32]) {
    unsigned char* ws = P.ws;
    const bf16_t* hr = (const bf16_t*)(ws + WS_X1B) + (size_t)tok * D + lo * 4;
#pragma unroll
    for (int j = 0; j < 8; ++j) { const u32x2 w = *(const u32x2*)(hr + 256 * j); x[4 * j] = bflo(w.x); x[4 * j + 1] = bfhi(w.x); x[4 * j + 2] = bflo(w.y); x[4 * j + 3] = bfhi(w.y); }
    const float* st = (const float*)(ws + WS_STAT);
    const float mean1 = st[tok] * (1.0f / D), rstd1 = 1.0f / sqrtf(fmaxf(st[8192 + tok] * (1.0f / D) - mean1 * mean1, 0.f) + LN_EPS);
#pragma unroll
    for (int c = 0; c < 8; ++c) { const f32x4 g1 = *(const LAS f32x4*)(lds + o_par + (lo * 4 + 256 * c) * 4), b1 = *(const LAS f32x4*)(lds + o_par + 8192 + (lo * 4 + 256 * c) * 4);
        x[4 * c] = (x[4 * c] - mean1) * rstd1 * g1.x + b1.x; x[4 * c + 1] = (x[4 * c + 1] - mean1) * rstd1 * g1.y + b1.y; x[4 * c + 2] = (x[4 * c + 2] - mean1) * rstd1 * g1.z + b1.z; x[4 * c + 3] = (x[4 * c + 3] - mean1) * rstd1 * g1.w + b1.w; }
}
__device__ __forceinline__ void peer_finish(const Params& P, ldsp lds, int o_par, int tok, int lo, float (&o)[32]) {
    float x[32]; peer_load_x(P, lds, o_par, tok, lo, x);
    float s = 0.f;
#pragma unroll
    for (int i = 0; i < 32; ++i) { o[i] += DN_ALPHA * x[i]; s += o[i]; }
    const float mean = wave_sum_dpp(s) * (1.0f / D); float q = 0.f;
#pragma unroll
    for (int i = 0; i < 32; ++i) { o[i] -= mean; q += o[i] * o[i]; }
    const float rstd = 1.0f / sqrtf(wave_sum_dpp(q) * (1.0f / D) + LN_EPS);
    float* orow = P.out + (size_t)tok * D;
#pragma unroll
    for (int c = 0; c < 8; ++c) {
        const int off = lo * 4 + 256 * c;
        const f32x4 g0 = *(const LAS f32x4*)(lds + o_par + 16384 + off * 4), b0 = *(const LAS f32x4*)(lds + o_par + 24576 + off * 4);
        f32x4 r0;
        r0.x = o[4 * c + 0] * rstd * g0.x + b0.x; r0.y = o[4 * c + 1] * rstd * g0.y + b0.y; r0.z = o[4 * c + 2] * rstd * g0.z + b0.z; r0.w = o[4 * c + 3] * rstd * g0.w + b0.w;
        *(f32x4*)(orow + off) = r0;
    }
}
__device__ __forceinline__ float peer_dot(const u32x4 uu, const unsigned (&xd0)[4], const unsigned (&xd1)[4]) {
    int a0 = 0, a1 = 0; const unsigned ww[4] = {uu.x, uu.y, uu.z, uu.w};
#pragma unroll
    for (int q4 = 0; q4 < 4; ++q4) { a0 = __builtin_amdgcn_sdot8((int)ww[q4], (int)xd0[q4], a0, false); a1 = __builtin_amdgcn_sdot8((int)ww[q4], (int)xd1[q4], a1, false); }
    return (float)(a0 + (a1 << 4));
}
__device__ __forceinline__ void peer_axpy(const u32x4 vv, float a, float (&o)[32]) {
    const f32x2 a2 = {a, a}; const unsigned ww[4] = {vv.x, vv.y, vv.z, vv.w};
#pragma unroll
    for (int q4 = 0; q4 < 4; ++q4) {
        const f32x2 r0 = __builtin_amdgcn_cvt_scalef32_pk_f32_fp4(ww[q4], 1.0f, 0), r1 = __builtin_amdgcn_cvt_scalef32_pk_f32_fp4(ww[q4], 1.0f, 1), r2 = __builtin_amdgcn_cvt_scalef32_pk_f32_fp4(ww[q4], 1.0f, 2), r3 = __builtin_amdgcn_cvt_scalef32_pk_f32_fp4(ww[q4], 1.0f, 3);
        f32x2 t;
        t = __builtin_elementwise_fma(a2, r0, (f32x2){o[8 * q4], o[8 * q4 + 1]}); o[8 * q4] = t.x; o[8 * q4 + 1] = t.y;
        t = __builtin_elementwise_fma(a2, r1, (f32x2){o[8 * q4 + 2], o[8 * q4 + 3]}); o[8 * q4 + 2] = t.x; o[8 * q4 + 3] = t.y;
        t = __builtin_elementwise_fma(a2, r2, (f32x2){o[8 * q4 + 4], o[8 * q4 + 5]}); o[8 * q4 + 4] = t.x; o[8 * q4 + 5] = t.y;
        t = __builtin_elementwise_fma(a2, r3, (f32x2){o[8 * q4 + 6], o[8 * q4 + 7]}); o[8 * q4 + 6] = t.x; o[8 * q4 + 7] = t.y; }
}
__device__ __forceinline__ void peer_round(const Params& P, ldsp lds, int o_ex, int o_gt, int o_list, int o_par, int tok, int tl) {
    int lo = threadIdx.x & 63; asm volatile("" : "+v"(lo));
    const int wave = threadIdx.x >> 6;
    unsigned char* ws = P.ws;
    const unsigned char* Ub = ws + WS_UB; const unsigned char* Vb = ws + WS_VB;
    const float* tsc = (const float*)(ws + WS_TSC);
    float o[32]; unsigned xd0[4], xd1[4]; float sxi;
    {
        float x[32]; peer_load_x(P, lds, o_par, tok, lo, x);
        float ax = 0.f;
#pragma unroll
        for (int i = 0; i < 32; ++i) ax = fmaxf(ax, fabsf(x[i]));
        ax = wave_max_dpp(ax);
        const float sx = ax > 0.f ? 119.0f / ax : 0.f; sxi = ax * (1.0f / 119.0f);
#pragma unroll
        for (int jw = 0; jw < 4; ++jw) { unsigned w0 = 0, w1 = 0;
#pragma unroll
            for (int i = 0; i < 8; ++i) { const unsigned b = __float_as_uint(fmaf(x[8 * jw + i], sx, 12582912.0f));
                w0 = __builtin_amdgcn_alignbit(b, w0, 4); w1 = __builtin_amdgcn_alignbit((b + 8u) >> 4, w1, 4); }
            xd0[jw] = w0; xd1[jw] = w1; }
    }
#pragma unroll
    for (int i = 0; i < 32; ++i) o[i] = 0.f;
    const LAS int* ex = (const LAS int*)(lds + o_ex) + tl * 128; const LAS float* gt = (const LAS float*)(lds + o_gt) + tl * 128;
    const int el = ex[lo], eh = ex[64 + lo];
    const float sul = tsc[el] * sxi, suh = tsc[eh] * sxi;
    const float gvl = gt[lo] * tsc[16384 + el], gvh = gt[64 + lo] * tsc[16384 + eh];
    LAS unsigned* lE = (LAS unsigned*)(lds + o_list) + wave * 384; LAS float* lS = (LAS float*)(lE + 128); LAS float* lG = (LAS float*)(lE + 256);
    {
        const int sl = el >> 10, sh = eh >> 10; int base = 0, pl = 0, ph = 0;
#define LT_COUNT(m) ((int)__builtin_amdgcn_mbcnt_hi((unsigned)((m) >> 32), __builtin_amdgcn_mbcnt_lo((unsigned)(m), 0u)))
#pragma unroll
        for (int s = 0; s < 16; ++s) {
            const unsigned long long ml = __ballot(sl == s), mh = __ballot(sh == s);
            const int cl = __popcll(ml);
            pl = (sl == s) ? base + LT_COUNT(ml) : pl; ph = (sh == s) ? base + cl + LT_COUNT(mh) : ph;
            base += cl + __popcll(mh);
        }
#undef LT_COUNT
        lE[pl] = (unsigned)el; lS[pl] = sul; lG[pl] = gvl; lE[ph] = (unsigned)eh; lS[ph] = suh; lG[ph] = gvh;
        asm volatile("s_waitcnt lgkmcnt(0)" ::: "memory");
    }
    u32x4 ua[4], ub[4]; u32x4 va[4], vb[4];
    auto issue = [&](int gi, u32x4 (&uu)[4], u32x4 (&vv)[4]) {
        const u32x4 e4 = *(const LAS u32x4*)(lE + 4 * gi);
        const unsigned ee[4] = {(unsigned)__builtin_amdgcn_readfirstlane((int)e4.x), (unsigned)__builtin_amdgcn_readfirstlane((int)e4.y), (unsigned)__builtin_amdgcn_readfirstlane((int)e4.z), (unsigned)__builtin_amdgcn_readfirstlane((int)e4.w)};
#pragma unroll
        for (int j = 0; j < 4; ++j) { uu[j] = *(const u32x4*)(Vb + (size_t)ee[j] * EROW + lo * 16); vv[j] = *(const u32x4*)(Vb + (size_t)ee[j] * EROW + 1024 + lo * 16); }
    };
    auto consume = [&](int gi, const u32x4 (&uu)[4], const u32x4 (&vv)[4]) {
        float dd[4];
#pragma unroll
        for (int j = 0; j < 4; ++j) dd[j] = peer_dot(uu[j], xd0, xd1);
        const bool b0 = (lo & 1) != 0, b1 = (lo & 2) != 0;
        const float r01 = (b0 ? dd[1] : dd[0]) + DPPF(b0 ? dd[0] : dd[1], 0xB1), r23 = (b0 ? dd[3] : dd[2]) + DPPF(b0 ? dd[2] : dd[3], 0xB1);
        float r = (b1 ? r23 : r01) + DPPF(b1 ? r01 : r23, 0x4E);
        r += DPPF(r, 0x124); r += DPPF(r, 0x128);
        { auto sw = __builtin_amdgcn_permlane16_swap(__float_as_uint(r), __float_as_uint(r), false, false); r = __uint_as_float(sw[0]) + __uint_as_float(sw[1]); }
        { auto sw = __builtin_amdgcn_permlane32_swap(__float_as_uint(r), __float_as_uint(r), false, false); r = __uint_as_float(sw[0]) + __uint_as_float(sw[1]); }
        const float su = lS[4 * gi + (lo & 3)], gv = lG[4 * gi + (lo & 3)];
        const float hh = r * su;
        const float a = pg8::gelu_pk((pg8::f32x2){hh, hh}).x * gv;
        peer_axpy(vv[0], DPPF(a, 0x00), o); peer_axpy(vv[1], DPPF(a, 0x55), o); peer_axpy(vv[2], DPPF(a, 0xAA), o); peer_axpy(vv[3], DPPF(a, 0xFF), o);
    };
    issue(0, ua, va);
#pragma unroll 1
    for (int gi = 0; gi < 30; gi += 2) {
        issue(gi + 1, ub, vb);
        consume(gi, ua, va);
        issue(gi + 2, ua, va);
        consume(gi + 1, ub, vb);
        if ((gi & 6) == 6) BLOCK_SYNC();
    }
    issue(31, ub, vb);
    consume(30, ua, va);
    consume(31, ub, vb);
    BLOCK_SYNC();
    peer_finish(P, lds, o_par, tok, lo, o);
}
#define CE_DESC(a, b) do { const float h_ = fmaxf((a), (b)), l_ = fminf((a), (b)); (a) = h_; (b) = l_; } while (0)
template <int N> __device__ __forceinline__ void bitonic_sort_desc(float (&v)[N]) {
#pragma unroll
    for (int k = 2; k <= N; k <<= 1)
#pragma unroll
        for (int j = k >> 1; j > 0; j >>= 1)
#pragma unroll
            for (int i = 0; i < N; ++i) { const int l = i ^ j; if (l > i) { if ((i & k) == 0) CE_DESC(v[i], v[l]); else CE_DESC(v[l], v[i]); } }
}
template <int N> __device__ __forceinline__ void bitonic_merge_desc(float (&v)[N]) {
#pragma unroll
    for (int j = N >> 1; j > 0; j >>= 1)
#pragma unroll
        for (int i = 0; i < N; ++i) { const int l = i ^ j; if (l > i) CE_DESC(v[i], v[l]); }
}
__device__ __forceinline__ void top16_merge(float (&a)[16], const float (&brev)[16]) {
#pragma unroll
    for (int i = 0; i < 16; ++i) a[i] = fmaxf(a[i], brev[i]);
    bitonic_merge_desc<16>(a);
}
__device__ __forceinline__ float embed_bits(float v, unsigned code, unsigned mask) { return __uint_as_float((__float_as_uint(v) & ~mask) | code); }

__device__ __forceinline__ void phase7(const Params& P, ldsp lds) {
    const int tid0 = threadIdx.x;
    unsigned char* ws = P.ws;
    const bf16_t* qb = (const bf16_t*)(ws + WS_Q); const bf16_t* sk = (const bf16_t*)(ws + WS_SUBK);
    constexpr int LDSK = 136, O_SK = 0, O_SV = 2 * 128 * LDSK * 2, O_EX = O_SV + 32768, O_GT = O_EX + 16384, O_LIST = O_GT + 16384;
    static_assert(O_LIST + 8 * 384 * 4 <= LDS_BYTES - 16, "lds");
    int titer = 0;
    for (int tile = blockIdx.x; tile < 256; tile += gridDim.x, ++titer) {
        int tid = tid0; asm volatile("" : "+v"(tid));
        const int lane = tid & 63, wave = tid >> 6, fr = lane & 15, fq = lane >> 4, fro = fr, fqo = fq;
        const int tok0 = tile * 32, h = wave;
        bf16x8 qn[4];
        auto ldq = [&](int cb) { const bf16_t* qrow = qb + (size_t)(tok0 + 16 * (cb >> 1) + fro) * D + h * 256 + (cb & 1) * 128 + fqo * 8;
#pragma unroll
            for (int ks = 0; ks < 4; ++ks) qn[ks] = *(const bf16x8*)(qrow + ks * 32); };
        ldq(0);
        for (int idx = tid; idx < 2 * 128 * 16; idx += 512) { const int row = idx >> 4, ch = idx & 15;
            *(LAS u32x4*)(lds + O_SK + (row * LDSK + ch * 8) * 2) = *(const u32x4*)(sk + row * 128 + ch * 8); }
        BLOCK_SYNC();
#pragma unroll 1
        for (int cb = 0; cb < 4; ++cb) {
            const int nt = cb >> 1, p = cb & 1;
            f32x4 acc[8];
#pragma unroll
            for (int mt = 0; mt < 8; ++mt) acc[mt] = (f32x4){0.f, 0.f, 0.f, 0.f};
            bf16x8 qc[4];
#pragma unroll
            for (int ks = 0; ks < 4; ++ks) qc[ks] = qn[ks];
            if (cb + 1 < 4) ldq(cb + 1);
#pragma unroll
            for (int ks = 0; ks < 4; ++ks) {
                const bf16x8 bq = qc[ks];
#pragma unroll
                for (int mt = 0; mt < 8; ++mt) acc[mt] = mfma16(*(const LAS bf16x8*)(lds + O_SK + ((p * 128 + 16 * mt + fro) * LDSK + ks * 32 + fqo * 8) * 2), bq, acc[mt]);
            }
            float a[16], b[16];
#pragma unroll
            for (int mt = 0; mt < 4; ++mt) {
                a[4 * mt + 0] = embed_bits(acc[mt].x, 16 * mt + 4 * fq + 0, 127u); a[4 * mt + 1] = embed_bits(acc[mt].y, 16 * mt + 4 * fq + 1, 127u);
                a[4 * mt + 2] = embed_bits(acc[mt].z, 16 * mt + 4 * fq + 2, 127u); a[4 * mt + 3] = embed_bits(acc[mt].w, 16 * mt + 4 * fq + 3, 127u);
                b[4 * mt + 0] = embed_bits(acc[mt + 4].x, 16 * (mt + 4) + 4 * fq + 0, 127u); b[4 * mt + 1] = embed_bits(acc[mt + 4].y, 16 * (mt + 4) + 4 * fq + 1, 127u);
                b[4 * mt + 2] = embed_bits(acc[mt + 4].z, 16 * (mt + 4) + 4 * fq + 2, 127u); b[4 * mt + 3] = embed_bits(acc[mt + 4].w, 16 * (mt + 4) + 4 * fq + 3, 127u);
            }
            bitonic_sort_desc<16>(a); bitonic_sort_desc<16>(b);
            { float br[16];
#pragma unroll
              for (int i = 0; i < 16; ++i) br[i] = b[15 - i];
              top16_merge(a, br); }
#pragma unroll
            for (int x = 16; x <= 32; x <<= 1) { float br[16];
#pragma unroll
                for (int i = 0; i < 16; ++i) br[i] = __shfl_xor(a[15 - i], x);
                top16_merge(a, br); }
            if (fq == 0) { LAS f32x4* o = (LAS f32x4*)(lds + O_SV + ((((16 * nt + fr) * 8 + h) * 2 + p) * 16) * 4);
                o[0] = (f32x4){a[0], a[1], a[2], a[3]}; o[1] = (f32x4){a[4], a[5], a[6], a[7]}; o[2] = (f32x4){a[8], a[9], a[10], a[11]}; o[3] = (f32x4){a[12], a[13], a[14], a[15]}; }
        }
        BLOCK_SYNC();
        if (tid < 256) {
            const int tok = tid >> 3, hh = tid & 7;
            const LAS f32x4* s = (const LAS f32x4*)(lds + O_SV + (((tok * 8 + hh) * 2) * 16) * 4);
            float s0[16], s1[16];
#pragma unroll
            for (int c4 = 0; c4 < 4; ++c4) { const f32x4 x = s[c4], y = s[4 + c4]; s0[4 * c4] = x.x; s0[4 * c4 + 1] = x.y; s0[4 * c4 + 2] = x.z; s0[4 * c4 + 3] = x.w; s1[4 * c4] = y.x; s1[4 * c4 + 1] = y.y; s1[4 * c4 + 2] = y.z; s1[4 * c4 + 3] = y.w; }
            float g0[16], g1[16], g2[16], g3[16];
            const float NEG = -3.0e38f;
#pragma unroll
            for (int bq = 0; bq < 16; ++bq) g0[bq] = embed_bits(s0[0] + s1[bq], bq, 255u);
            {
                int n1 = 0, n2 = 0, n3 = 0;
#pragma unroll
                for (int aa = 1; aa < 16; ++aa)
#pragma unroll
                    for (int bb = 0; bb < 16; ++bb) if ((aa + 1) * (bb + 1) <= 16) {
                        const float c = embed_bits(s0[aa] + s1[bb], aa * 16 + bb, 255u);
                        if (n1 < 16) g1[n1++] = c; else if (n2 < 16) g2[n2++] = c; else g3[n3++] = c;
                    }
#pragma unroll
                for (int i = 0; i < 16; ++i) if (i >= n3) g3[i] = NEG;
            }
            bitonic_sort_desc<16>(g1); bitonic_sort_desc<16>(g2); bitonic_sort_desc<16>(g3);
            { float r1[16], r3[16];
#pragma unroll
              for (int i = 0; i < 16; ++i) { r1[i] = g1[15 - i]; r3[i] = g3[15 - i]; }
              top16_merge(g0, r1); top16_merge(g2, r3);
#pragma unroll
              for (int i = 0; i < 16; ++i) g0[i] = fmaxf(g0[i], g2[15 - i]); }
            float mx = g0[0];
#pragma unroll
            for (int i = 1; i < 16; ++i) mx = fmaxf(mx, g0[i]);
            float ex[16], sm = 0.f; int ee[16];
#pragma unroll
            for (int i = 0; i < 16; ++i) {
                ex[i] = __expf(g0[i] - mx); sm += ex[i];
                const unsigned code = __float_as_uint(g0[i]) & 255u;
                const unsigned i0 = __float_as_uint(*(const LAS float*)(lds + O_SV + ((((tok * 8 + hh) * 2 + 0) * 16) + (code >> 4)) * 4)) & 127u;
                const unsigned i1 = __float_as_uint(*(const LAS float*)(lds + O_SV + ((((tok * 8 + hh) * 2 + 1) * 16) + (code & 15u)) * 4)) & 127u;
                ee[i] = (int)(i0 * 128u + i1);
            }
            const float inv = 1.0f / sm;
            LAS int* eo = (LAS int*)(lds + O_EX) + tok * 128 + hh * 16; LAS float* go = (LAS float*)(lds + O_GT) + tok * 128 + hh * 16;
#pragma unroll
            for (int c4 = 0; c4 < 4; ++c4) {
                *(LAS u32x4*)(eo + 4 * c4) = (u32x4){(unsigned)ee[4 * c4], (unsigned)ee[4 * c4 + 1], (unsigned)ee[4 * c4 + 2], (unsigned)ee[4 * c4 + 3]};
                *(LAS f32x4*)(go + 4 * c4) = (f32x4){ex[4 * c4] * inv, ex[4 * c4 + 1] * inv, ex[4 * c4 + 2] * inv, ex[4 * c4 + 3] * inv};
            }
        }
        BLOCK_SYNC();
        for (int idx = tid; idx < 2048; idx += 512) { const int a = idx >> 9, q4 = idx & 511; const float* src = P.in[a == 0 ? I_LN1G : a == 1 ? I_LN1B : a == 2 ? I_LN2G : I_LN2B];
            *(LAS f32x4*)(lds + O_SK + a * 8192 + q4 * 16) = *(const f32x4*)(src + q4 * 4); }
        BLOCK_SYNC();
#pragma unroll 1
        for (int r = 0; r < 4; ++r) {
            peer_round(P, lds, O_EX, O_GT, O_LIST, O_SK, tok0 + r * 8 + wave, r * 8 + wave);
        }
        BLOCK_SYNC();
    }
}
__global__ __launch_bounds__(512, 2) void hybrid_fwd(Params P) {
    extern __shared__ __attribute__((aligned(16))) unsigned char shm[];
    ldsp lds = (ldsp)shm;
    unsigned char* ws = P.ws;
    volatile LAS unsigned* xst = (volatile LAS unsigned*)(lds + LDS_BYTES - 16);
    if (threadIdx.x == 0) { xst[0] = 0u; xst[1] = 0u; }
    __syncthreads();
    const XcdBarrier xbar = xcd_barrier_post((unsigned*)(ws + WS_BAR), xst);
    const int lo = P.ph_lo, hi = P.ph_hi;
#ifdef REPEAT_PHASE
#define PHASE(k) if (lo <= (k) && (k) < hi) for (int once_ = 0; once_ < ((k) == REPEAT_PHASE ? 2 : 1); ++once_)
#else
#define PHASE(k) if (lo <= (k) && (k) < hi) for (int once_ = 0; once_ < 1; ++once_)
#endif
#ifdef DOUBLE_SEAMS
#define SEAM(k) do { if (lo <= (k) && (k) + 1 < hi) { xcd_barrier(xbar); xcd_barrier(xbar); } } while (0)
#else
#define SEAM(k) do { if (lo <= (k) && (k) + 1 < hi) xcd_barrier(xbar); } while (0)
#endif
#if defined(REPEAT_PHASE) && REPEAT_PHASE == 0
    PHASE(0) { Params Q = P; if (once_) Q.ph_lo = -1; phase0(Q); }
#else
    PHASE(0) phase0(P);
#endif
    SEAM(0);
    PHASE(1) { pg8::EpiBf16<0> E; E.O = (bf16_t*)(ws + WS_P); E.ldc = NPAD; E.bias = nullptr; E.split_cols = 0; E.split_stride = 0;
        run_gemm(lds, (const bf16_t*)(ws + WS_H0B), (const bf16_t*)(ws + WS_WTIN), MROWS, NPAD, 2048, E); }
    SEAM(1);
    PHASE(2) phase2(P, lds);
    SEAM(2);
    PHASE(3) phase3(P);
    SEAM(3);
    PHASE(4) phase3b(P, lds);
    SEAM(4);
    PHASE(5) {
        { pg8::EpiGate35 E; E.O = (bf16_t*)(ws + WS_MERGED); E.p = (const bf16_t*)(ws + WS_P); E.bgate = P.in[I_BGATE];
          run_gemm(lds, (const bf16_t*)(ws + WS_YAB), (const bf16_t*)(ws + WS_WTAB), NTOK, 2048, LDAB, E); }
    }
#if defined(DUP_PHASE) && DUP_PHASE == 5
    SEAM(4);
    PHASE(5) {
        { pg8::EpiGate35 E; E.O = (bf16_t*)(ws + WS_MERGED); E.p = (const bf16_t*)(ws + WS_P); E.bgate = P.in[I_BGATE];
          run_gemm(lds, (const bf16_t*)(ws + WS_YAB), (const bf16_t*)(ws + WS_WTAB), NTOK, 2048, LDAB, E); }
    }
#endif
    SEAM(5);
    PHASE(6) { pg8::EpiResidStats E; E.O = (bf16_t*)(ws + WS_X1B); E.h0 = (const bf16_t*)(ws + WS_H0B); E.alpha = DN_ALPHA; E.rsum = (float*)(ws + WS_STAT); E.rsq = (float*)(ws + WS_STAT) + 8192;
        run_gemm(lds, (const bf16_t*)(ws + WS_MERGED), (const bf16_t*)(ws + WS_WTOUT), NTOK, 2048, 2048, E); }
#if defined(DUP_PHASE) && DUP_PHASE == 6
    SEAM(5);
    PHASE(6) { pg8::EpiResidStats E; E.O = (bf16_t*)(ws + WS_X1B); E.h0 = (const bf16_t*)(ws + WS_H0B); E.alpha = DN_ALPHA; E.rsum = (float*)(ws + WS_END); E.rsq = (float*)(ws + WS_END) + 8192;
        run_gemm(lds, (const bf16_t*)(ws + WS_MERGED), (const bf16_t*)(ws + WS_WTOUT), NTOK, 2048, 2048, E); }
#endif
    SEAM(6);
    PHASE(7) { pg8::EpiQ E; E.O = (bf16_t*)(ws + WS_Q); E.rsum = (const float*)(ws + WS_STAT); E.rsq = (const float*)(ws + WS_STAT) + 8192; E.c1 = (const float*)(ws + WS_STAT) + 16384; E.c2 = (const float*)(ws + WS_STAT) + 18432;
        run_gemm(lds, (const bf16_t*)(ws + WS_X1B), (const bf16_t*)(ws + WS_WTQ), NTOK, 2048, 2048, E); }
#if defined(DUP_PHASE) && DUP_PHASE == 7
    SEAM(6);
    PHASE(7) { pg8::EpiQ E; E.O = (bf16_t*)(ws + WS_Q); E.rsum = (const float*)(ws + WS_STAT); E.rsq = (const float*)(ws + WS_STAT) + 8192; E.c1 = (const float*)(ws + WS_STAT) + 16384; E.c2 = (const float*)(ws + WS_STAT) + 18432;
        run_gemm(lds, (const bf16_t*)(ws + WS_X1B), (const bf16_t*)(ws + WS_WTQ), NTOK, 2048, 2048, E); }
#endif
    SEAM(7);
    PHASE(8) phase7(P, lds);
#undef PHASE
#undef SEAM
}

extern "C" void kernel_launch(void* const* d_in, const int* in_sizes, int n_in, void* d_out, int out_size, void* d_ws, size_t ws_size, hipStream_t stream) {
    static int grid = 0;
    if (grid == 0) {
        if (n_in != 30 || out_size != NTOK * D || ws_size < WS_END) { fprintf(stderr, "kernel_launch: unexpected shapes (n_in %d, out %d, ws %zu < %zu)\n", n_in, out_size, ws_size, (size_t)WS_END); grid = -1; return; }
        int dev = 0, cus = 0, per_cu = 0;
        if (hipGetDevice(&dev) != hipSuccess || hipDeviceGetAttribute(&cus, hipDeviceAttributeMultiprocessorCount, dev) != hipSuccess) { grid = -1; return; }
        if (hipFuncSetAttribute((const void*)hybrid_fwd, hipFuncAttributeMaxDynamicSharedMemorySize, LDS_BYTES) != hipSuccess) { fprintf(stderr, "kernel_launch: hipFuncSetAttribute failed\n"); grid = -1; return; }
        if (hipOccupancyMaxActiveBlocksPerMultiprocessor(&per_cu, (const void*)hybrid_fwd, 512, LDS_BYTES) != hipSuccess || per_cu < 1) { fprintf(stderr, "kernel_launch: occupancy query says %d\n", per_cu); grid = -1; return; }
        (void)hipGetLastError();
        grid = cus;
    }
    if (grid < 0) return;
    if (hipMemsetAsync((unsigned char*)d_ws + WS_BAR, 0, 16384 + STAT_BYTES, stream) != hipSuccess) { fprintf(stderr, "kernel_launch: memset failed\n"); return; }
    Params p{};
    for (int i = 0; i < 30; ++i) p.in[i] = (const float*)d_in[i];
    p.out = (float*)d_out; p.ws = (unsigned char*)d_ws;
    p.ph_lo = 0; p.ph_hi = NPHASE + 1;
    void* args[] = {&p};
    hipError_t e = hipLaunchCooperativeKernel((const void*)hybrid_fwd, dim3(grid), dim3(512), args, LDS_BYTES, stream);
    if (e != hipSuccess) fprintf(stderr, "kernel_launch: cooperative launch failed: %s (grid %d)\n", hipGetErrorString(e), grid);
}
```

```cpp
#include <hip/hip_runtime.h>
#include <cstdio>
#include <cstdint>
namespace pg8 {
#define PG8_LAS __attribute__((address_space(3)))
typedef unsigned short bf16_t;
typedef short bf16x8 __attribute__((ext_vector_type(8)));
typedef float f32x4 __attribute__((ext_vector_type(4)));
typedef unsigned u32x4 __attribute__((ext_vector_type(4)));
typedef int i32x4f __attribute__((ext_vector_type(4)));
constexpr int BM = 256, BK = 64, HALF = 128, HTB = HALF * BK * 2  , STAGE_BYTES = 8 * HTB, NXCD = 8, WGM = 8;

__host__ __device__ __forceinline__ int lds_byte(int r, int c) { const int st = (r >> 4) * 2 + (c >> 5), rr = r & 15, cc = c & 31, ob = rr * 64 + cc * 2; return st * 1024 + (ob ^ (((ob >> 9) & 1) << 5)); }
__host__ __device__ __forceinline__ void stage_rc(int b, int& R, int& C) { const int st = b / 1024, sb = b % 1024, swz = sb ^ (((sb >> 9) & 1) << 5); R = (st >> 1) * 16 + swz / 64; C = (st & 1) * 32 + (swz % 64) / 2; }
__host__ __device__ __forceinline__ int perm32(int rho) { const int n = rho >> 4, i = rho & 15; return 8 * (i >> 2) + 4 * n + (i & 3); }

struct Unit { int pm, pn; };
struct Gemm { const bf16_t* A; const bf16_t* Bt; int M, N, K; };

struct StaticOrder {
    int nM, nN, nwg, G, c;
    __host__ __device__ void init(int M, int N, int G_, int c_) { nM = M / BM; nN = N / BM; nwg = nM * nN; G = G_; c = c_; }
    __host__ __device__ bool next(int i, Unit& u) const {
        const long L = (long)i * G + c; if (L >= nwg) return false;
        int wgid = (int)L; { const int q = nwg / NXCD, r = nwg % NXCD, xcd = wgid % NXCD, off = wgid / NXCD; wgid = (xcd < r ? xcd * (q + 1) : r * (q + 1) + (xcd - r) * q) + off; }
        const int nig = WGM * nN, gid = wgid / nig, fm = gid * WGM, gsz = (nM - fm) < WGM ? (nM - fm) : WGM;
        u.pm = fm + ((wgid % nig) % gsz); u.pn = (wgid % nig) / gsz; return true;
    }
    __device__ __forceinline__ void a_ready(const Unit&) const {}
    __device__ __forceinline__ void done(const Unit&) const {}
};
struct CountedOrder : StaticOrder {
    const unsigned* ready; unsigned need; unsigned* tmo;
    __device__ __forceinline__ void a_ready(const Unit& u) const {
        if (threadIdx.x < 64) {
            const unsigned long long t0 = __builtin_amdgcn_s_memrealtime(); unsigned polls = 0;
            while ((unsigned)__builtin_amdgcn_readfirstlane(__hip_atomic_load(ready + 64 * u.pm, __ATOMIC_RELAXED, __HIP_MEMORY_SCOPE_AGENT)) < need) {
                if ((++polls & 255u) == 0u && __builtin_amdgcn_readfirstlane(__hip_atomic_load(tmo, __ATOMIC_RELAXED, __HIP_MEMORY_SCOPE_AGENT)) != 0u) break;
                if (__builtin_amdgcn_s_memrealtime() - t0 > 2000000ull) {
                    if (threadIdx.x == 0) { unsigned expect = 0u; __hip_atomic_compare_exchange_strong(tmo + 1, &expect, 0x600u | (unsigned)(u.pm & 0xff), __ATOMIC_RELAXED, __ATOMIC_RELAXED, __HIP_MEMORY_SCOPE_AGENT); __hip_atomic_store(tmo, 1u, __ATOMIC_RELAXED, __HIP_MEMORY_SCOPE_AGENT); }
                    break; }
                __builtin_amdgcn_s_sleep(2); }
            __builtin_amdgcn_fence(__ATOMIC_ACQUIRE, "agent");
            asm volatile("s_waitcnt vmcnt(0)" ::: "memory");
        }
#if !defined(BROKEN_HOOK_NO_BARRIER)
        asm volatile("" ::: "memory"); __builtin_amdgcn_s_barrier(); asm volatile("" ::: "memory");
#endif
    }
};

typedef float cvt_f32x2 __attribute__((ext_vector_type(2))); typedef __bf16 cvt_bf16x2 __attribute__((ext_vector_type(2)));
__device__ __forceinline__ unsigned cvt_pk_bf16(float lo, float hi) { const cvt_f32x2 v = {lo, hi}; const cvt_bf16x2 b = __builtin_convertvector(v, cvt_bf16x2); return __builtin_bit_cast(unsigned, b); }
typedef float f32x2 __attribute__((ext_vector_type(2)));
__device__ __forceinline__ f32x2 gelu_pk(f32x2 v) {
    const f32x2 av = __builtin_elementwise_abs(v), d = av * 0.2316418882f + 1.0f;
    f32x2 t; t.x = __builtin_amdgcn_rcpf(d.x); t.y = __builtin_amdgcn_rcpf(d.y);
    f32x2 q = t * 0.5307027145f + (-0.7265760135f); q = q * t + 0.7107068705f; q = q * t + (-0.142248368f); q = q * t + 0.127414796f; q = q * t;
    const f32x2 s = (v * v) * (-0.72134752044f);
    f32x2 e; e.x = __builtin_amdgcn_exp2f(s.x); e.y = __builtin_amdgcn_exp2f(s.y);
    const f32x2 m = v * (q * e), r = v - m;
    f32x2 o; o.x = v.x < 0.f ? m.x : r.x; o.y = v.y < 0.f ? m.y : r.y; return o;
}

struct EpiF32 {
    static constexpr bool PERM = false, AFTER_DRAIN = false; static constexpr int MID_T = -1;
    float* C; int ldc; const float* bias;
    __device__ __forceinline__ void operator()(const f32x4 (&acc)[2][2][4][2], const Unit& u, int wr, int wc, int fr, int fq) const {
        const int row0 = u.pm * BM + wr * 64 + fr, col0 = u.pn * BM + wc * 32 + 4 * fq;
        f32x4 bv[2][2];
#pragma unroll
        for (int bj = 0; bj < 2; ++bj)
#pragma unroll
            for (int n = 0; n < 2; ++n) bv[bj][n] = bias ? *(const f32x4*)(bias + col0 + bj * HALF + n * 16) : (f32x4){0.f, 0.f, 0.f, 0.f};
#pragma unroll
        for (int ai = 0; ai < 2; ++ai)
#pragma unroll
            for (int m = 0; m < 4; ++m) { float* rowp = C + (size_t)(row0 + ai * HALF + m * 16) * ldc + col0;
#pragma unroll
                for (int bj = 0; bj < 2; ++bj)
#pragma unroll
                    for (int n = 0; n < 2; ++n) *(f32x4*)(rowp + bj * HALF + n * 16) = acc[ai][bj][m][n] + bv[bj][n]; }
    }
};
template <int ACT  > struct EpiBf16 {
    static constexpr bool PERM = true, AFTER_DRAIN = false; static constexpr int MID_T = -1;
    bf16_t* O; int ldc; const float* bias; int split_cols; size_t split_stride;
    __device__ __forceinline__ void operator()(const f32x4 (&acc)[2][2][4][2], const Unit& u, int wr, int wc, int fr, int fq) const {
        const int row0 = u.pm * BM + wr * 64 + fr; int colt = u.pn * BM; bf16_t* base = O;
        if (split_cols) { const int t = colt / split_cols; base += (size_t)t * split_stride; colt -= t * split_cols; }
        const int col0 = colt + wc * 32 + 8 * fq, bcol0 = u.pn * BM + wc * 32 + 8 * fq;
        f32x4 bv[2][2];
#pragma unroll
        for (int bj = 0; bj < 2; ++bj)
#pragma unroll
            for (int n = 0; n < 2; ++n) bv[bj][n] = bias ? *(const f32x4*)(bias + bcol0 + bj * HALF + 4 * n) : (f32x4){0.f, 0.f, 0.f, 0.f};
#pragma unroll
        for (int ai = 0; ai < 2; ++ai)
#pragma unroll
            for (int m = 0; m < 4; ++m) { bf16_t* rowp = base + (size_t)(row0 + ai * HALF + m * 16) * ldc + col0;
#pragma unroll
                for (int bj = 0; bj < 2; ++bj) { f32x4 v0 = acc[ai][bj][m][0] + bv[bj][0], v1 = acc[ai][bj][m][1] + bv[bj][1];
                    if (ACT == 1) { f32x2 a = gelu_pk((f32x2){v0[0], v0[1]}), b = gelu_pk((f32x2){v0[2], v0[3]}), c = gelu_pk((f32x2){v1[0], v1[1]}), d = gelu_pk((f32x2){v1[2], v1[3]});
                        v0 = (f32x4){a.x, a.y, b.x, b.y}; v1 = (f32x4){c.x, c.y, d.x, d.y}; }
                    if (ACT == 2) {
#pragma unroll
                        for (int j = 0; j < 4; ++j) { v0[j] = 0.5f * v0[j] * (1.0f + erff(v0[j] * 0.70710678f)); v1[j] = 0.5f * v1[j] * (1.0f + erff(v1[j] * 0.70710678f)); } }
                    u32x4 w; w.x = cvt_pk_bf16(v0[0], v0[1]); w.y = cvt_pk_bf16(v0[2], v0[3]); w.z = cvt_pk_bf16(v1[0], v1[1]); w.w = cvt_pk_bf16(v1[2], v1[3]);
                    *(u32x4*)(rowp + bj * HALF) = w; } }
    }
};
template <class Epi, class Sched, bool STAMP = false, bool F8 = false>
__device__ __forceinline__ void gemm_phase(PG8_LAS unsigned char* lds, const Gemm g, const Sched& S, const Epi& E, unsigned long long* stamps) {
    const int tid = threadIdx.x, wid = __builtin_amdgcn_readfirstlane(tid >> 6), lane = tid & 63, wr = wid >> 2, wc = wid & 3, fr = lane & 15, fq = lane >> 4;
    const int K = g.K, nt = K / BK;
    int ts_lo = 0, ts_hi = 0, nts = 0; const unsigned long long rt_entry = STAMP ? (unsigned long long)wall_clock64() : 0ull;
#define PG8_STAMP() do { if (STAMP && wid == 0 && nts < 64) { const unsigned long long _c = (unsigned long long)clock64(); \
        ts_lo = (lane == nts) ? (int)(unsigned)_c : ts_lo; ts_hi = (lane == nts) ? (int)(unsigned)(_c >> 32) : ts_hi; ++nts; } } while (0)
    PG8_STAMP();
    unsigned voffA[2], voffB[2];
#pragma unroll
    for (int i = 0; i < 2; ++i) { int R, C; stage_rc(tid * 16 + i * 8192, R, C); const int Rb = Epi::PERM ? ((R & ~31) + perm32(R & 31)) : R;
        voffA[i] = (unsigned)(R * K + C) * 2u; voffB[i] = (unsigned)(Rb * K + C) * 2u; }
    const size_t kstep = (size_t)(BK * 2);
    const size_t hstep = (size_t)HALF * K * 2;
    const size_t tstep = 2 * hstep;
    const unsigned ldsw = (unsigned)wid * 1024u;
    const int aoff = lds_byte(wr * 64 + fr, fq * 8), boff = lds_byte(wc * 32 + fr, fq * 8);
#define PG8_SA(b, h) (((b) * 2 + (h)) * HTB)
#define PG8_SB(b, h) ((4 + (b) * 2 + (h)) * HTB)
#define PG8_STAGE(bufoff, gbase, voff) do { _Pragma("unroll") for (int _i = 0; _i < 2; ++_i) \
        __builtin_amdgcn_global_load_lds((const unsigned*)((const char*)(gbase) + (voff)[_i]), (PG8_LAS unsigned*)(lds + (bufoff) + ldsw + _i * 8192), 16, 0, 0); } while (0)
#define PG8_LDA(dst, b, h) do { if constexpr (F8) { _Pragma("unroll") for (int m = 0; m < 4; ++m) { dst##8[m].lo = *(const PG8_LAS bf16x8*)(lds + PG8_SA(b, h) + aoff + m * 2048); dst##8[m].hi = *(const PG8_LAS bf16x8*)(lds + PG8_SA(b, h) + aoff + m * 2048 + 1024); } } \
    else { _Pragma("unroll") for (int m = 0; m < 4; ++m) _Pragma("unroll") for (int k = 0; k < 2; ++k) dst[m][k] = *(const PG8_LAS bf16x8*)(lds + PG8_SA(b, h) + aoff + m * 2048 + k * 1024); } } while (0)
#define PG8_LDB(dst, b, h) do { if constexpr (F8) { _Pragma("unroll") for (int n = 0; n < 2; ++n) { dst##8[n].lo = *(const PG8_LAS bf16x8*)(lds + PG8_SB(b, h) + boff + n * 2048); dst##8[n].hi = *(const PG8_LAS bf16x8*)(lds + PG8_SB(b, h) + boff + n * 2048 + 1024); } } \
    else { _Pragma("unroll") for (int n = 0; n < 2; ++n) _Pragma("unroll") for (int k = 0; k < 2; ++k) dst[n][k] = *(const PG8_LAS bf16x8*)(lds + PG8_SB(b, h) + boff + n * 2048 + k * 1024); } } while (0)
typedef int i32x8f __attribute__((ext_vector_type(8)));
#define PG8_MMA(ai, bj, At, Bt) do { __builtin_amdgcn_s_setprio(1); \
        if constexpr (F8) { _Pragma("unroll") for (int m = 0; m < 4; ++m) _Pragma("unroll") for (int n = 0; n < 2; ++n) \
            asm volatile("v_mfma_f32_16x16x128_f8f6f4 %0, %1, %2, %0" : "+v"(acc[ai][bj][m][n]) : "v"(Bt##8[n]), "v"(At##8[m])); } \
        else { _Pragma("unroll") for (int m = 0; m < 4; ++m) _Pragma("unroll") for (int n = 0; n < 2; ++n) _Pragma("unroll") for (int k = 0; k < 2; ++k) \
            acc[ai][bj][m][n] = __builtin_amdgcn_mfma_f32_16x16x32_bf16(Bt[n][k], At[m][k], acc[ai][bj][m][n], 0, 0, 0); } \
        __builtin_amdgcn_s_setprio(0); } while (0)
#define PG8_WAIT_V(n) asm volatile("s_waitcnt vmcnt(" #n ")" ::: "memory")
#define PG8_WAIT_L(n) asm volatile("s_waitcnt lgkmcnt(" #n ")" ::: "memory")
#define PG8_BAR __builtin_amdgcn_s_barrier()
#define PG8_SCHED __builtin_amdgcn_sched_barrier(0)
    Unit cur, nxt; int ui = 0;
    if (!S.next(0, cur)) return;
    f32x4 acc[2][2][4][2];
#pragma unroll
    for (int a = 0; a < 2; ++a)
#pragma unroll
        for (int b = 0; b < 2; ++b)
#pragma unroll
            for (int m = 0; m < 4; ++m)
#pragma unroll
                for (int n = 0; n < 2; ++n) acc[a][b][m][n] = (f32x4){0.f, 0.f, 0.f, 0.f};
    bf16x8 At[4][2], B0[2][2], B1[2][2];
    typedef short bf16x16f __attribute__((ext_vector_type(16)));
    bf16x16f At8[4], B08[2], B18[2];
    const char* cA = (const char*)g.A + (size_t)cur.pm * tstep; const char* cB = (const char*)g.Bt + (size_t)cur.pn * tstep;
    S.a_ready(cur);
    PG8_STAGE(PG8_SB(0, 0), cB, voffB); PG8_STAGE(PG8_SA(0, 0), cA, voffA); PG8_STAGE(PG8_SB(0, 1), cB + hstep, voffB); PG8_STAGE(PG8_SA(0, 1), cA + hstep, voffA);
    if (wr == 1) PG8_BAR;
    PG8_WAIT_V(4); PG8_BAR;
    PG8_STAGE(PG8_SB(1, 0), cB + kstep, voffB); PG8_STAGE(PG8_SA(1, 0), cA + kstep, voffA); PG8_STAGE(PG8_SB(1, 1), cB + hstep + kstep, voffB);
    PG8_WAIT_V(6); PG8_BAR;
    PG8_STAMP();
    for (;;) {
        const bool has_next = S.next(ui + 1, nxt);
        const char* nA = has_next ? (const char*)g.A + (size_t)nxt.pm * tstep : cA; const char* nB = has_next ? (const char*)g.Bt + (size_t)nxt.pn * tstep : cB;
        for (int t = 0; t < nt; t += 2) {
            const bool last = (t == nt - 2);
            const char* a1 = cA + (size_t)(t + 1) * kstep;
            const char* a2 = last ? nA : cA + (size_t)(t + 2) * kstep; const char* b2 = last ? nB : cB + (size_t)(t + 2) * kstep;
            const char* a3 = a2 + kstep; const char* b3 = b2 + kstep;
            if (last && has_next) S.a_ready(nxt);
            if constexpr (Epi::MID_T >= 0) { if (t == Epi::MID_T) E.mid(acc, cur, wr, wc, fr, fq); }
            PG8_LDB(B0, 0, 0); PG8_SCHED; PG8_LDA(At, 0, 0); PG8_STAGE(PG8_SA(1, 1), a1 + hstep, voffA);
            PG8_WAIT_L(8); PG8_BAR; PG8_WAIT_L(0); PG8_MMA(0, 0, At, B0); PG8_BAR; PG8_SCHED;
            PG8_LDB(B1, 0, 1); PG8_STAGE(PG8_SB(0, 0), b2, voffB);
            PG8_BAR; PG8_WAIT_L(0); PG8_MMA(0, 1, At, B1); PG8_BAR;
            PG8_LDA(At, 0, 1); PG8_STAGE(PG8_SA(0, 0), a2, voffA);
            PG8_BAR; PG8_WAIT_L(0); PG8_MMA(1, 0, At, B0); PG8_BAR; PG8_SCHED;
            PG8_STAGE(PG8_SB(0, 1), b2 + hstep, voffB);
            PG8_WAIT_V(6); PG8_BAR; PG8_MMA(1, 1, At, B1); PG8_BAR;
            PG8_LDB(B0, 1, 0); PG8_SCHED; PG8_LDA(At, 1, 0); PG8_STAGE(PG8_SA(0, 1), a2 + hstep, voffA);
            PG8_WAIT_L(8); PG8_BAR; PG8_WAIT_L(0); PG8_MMA(0, 0, At, B0); PG8_BAR; PG8_SCHED;
            PG8_LDB(B1, 1, 1); PG8_STAGE(PG8_SB(1, 0), b3, voffB);
            PG8_BAR; PG8_WAIT_L(0); PG8_MMA(0, 1, At, B1); PG8_BAR;
            PG8_LDA(At, 1, 1); PG8_STAGE(PG8_SA(1, 0), a3, voffA);
            PG8_BAR; PG8_WAIT_L(0); PG8_MMA(1, 0, At, B0); PG8_BAR; PG8_SCHED;
            PG8_STAGE(PG8_SB(1, 1), b3 + hstep, voffB);
            PG8_WAIT_V(6); PG8_BAR; PG8_MMA(1, 1, At, B1); PG8_BAR;
        }
        PG8_STAMP();
        if constexpr (F8) asm volatile("s_nop 15\n\ts_nop 15" ::: "memory");
        if constexpr (!Epi::AFTER_DRAIN) { E(acc, cur, wr, wc, fr, fq); S.done(cur); }
        PG8_STAMP();
        if (!has_next) break;
#pragma unroll
        for (int a = 0; a < 2; ++a)
#pragma unroll
            for (int b = 0; b < 2; ++b)
#pragma unroll
                for (int m = 0; m < 4; ++m)
#pragma unroll
                    for (int n = 0; n < 2; ++n) acc[a][b][m][n] = (f32x4){0.f, 0.f, 0.f, 0.f};
        cur = nxt; cA = nA; cB = nB; ++ui;
    }
    PG8_WAIT_V(0);
    if (wr == 0) PG8_BAR;
    PG8_BAR;
    if constexpr (Epi::AFTER_DRAIN) { E.fused(acc, cur, wr, wc, fr, fq, lds, wid, lane); S.done(cur); }
    PG8_STAMP();
    if (STAMP && wid == 0) { stamps[lane] = lane < nts ? (((unsigned long long)(unsigned)ts_hi << 32) | (unsigned)ts_lo) : 0ull;
        if (lane == 62) stamps[62] = rt_entry; if (lane == 63) stamps[63] = (unsigned long long)wall_clock64(); }
#undef PG8_STAMP
#undef PG8_SA
#undef PG8_SB
#undef PG8_STAGE
#undef PG8_LDA
#undef PG8_LDB
#undef PG8_MMA
#undef PG8_WAIT_V
#undef PG8_WAIT_L
#undef PG8_BAR
#undef PG8_SCHED
}
}
#define LAS __attribute__((address_space(3)))
typedef unsigned short bf16_t;
typedef short bf16x8 __attribute__((ext_vector_type(8)));
typedef float f32x4 __attribute__((ext_vector_type(4)));
typedef float f32x2 __attribute__((ext_vector_type(2)));
typedef unsigned u32x4 __attribute__((ext_vector_type(4)));
typedef unsigned u32x2 __attribute__((ext_vector_type(2)));
typedef LAS unsigned char* ldsp;
typedef float f32x32 __attribute__((ext_vector_type(32)));
typedef float f32x16 __attribute__((ext_vector_type(16)));
typedef unsigned u32x6 __attribute__((ext_vector_type(6)));

constexpr int D = 2048, NTOK = 8192, SEQ = 4096, MROWS = 8448, ROW_META = 8192;
constexpr int INC = 11712, NPAD = 11776;
constexpr int C_R = 0, C_K = 2048, C_V = 4096, C_WL = 6144, C_AL = 6240, C_GL = 6336, C_POOL = 6592, C_G0 = 7616, C_G1 = 9664;
constexpr int NUNITS = 4128;
constexpr float DSCALE = 0.6065306597126334f;
constexpr float DN_ALPHA = 1.189207115002721f;
constexpr float GN_EPS = 64e-5f, LN_EPS = 1e-5f;

constexpr size_t WS_P = 0;
constexpr size_t WS_H0B = 198967296;
constexpr size_t WS_WTAB = WS_H0B + 34603008;
constexpr size_t WS_WTOUT = WS_WTAB + 12582912;
constexpr size_t WS_WTQ = WS_WTOUT + 8388608;
constexpr size_t WS_WTPOOL = WS_WTQ + 8388608;
constexpr size_t WS_WTW2 = WS_WTPOOL + 524288;
constexpr size_t WS_WTA2 = WS_WTW2 + 393216;
constexpr size_t WS_WTG2 = WS_WTA2 + 393216;
constexpr size_t WS_SUBK = WS_WTG2 + 1048576;
constexpr size_t WS_BONUS = WS_SUBK + 65536;
constexpr size_t WS_REGC = WS_BONUS + 1048576;
constexpr size_t WS_WTIN = WS_REGC;
constexpr size_t UNITB = (size_t)NUNITS * 4096 * 2;
constexpr size_t WS_G = WS_REGC;
constexpr size_t WS_H0T = WS_REGC + UNITB;
constexpr size_t WS_RT = WS_REGC + 2 * UNITB;
constexpr size_t WS_Y0 = WS_REGC + 3 * UNITB;
constexpr size_t WS_S0T = WS_REGC + 4 * UNITB;
constexpr size_t WS_YAB = WS_REGC;
constexpr int LDAB = 3072;
constexpr size_t WS_MERGED = WS_REGC + 2 * UNITB;
constexpr size_t WS_X1B = WS_REGC + 3 * UNITB;
constexpr size_t WS_Q = WS_REGC + UNITB;
constexpr size_t TROW = 1536;
constexpr size_t EROW = 2048;
constexpr size_t WS_VB = WS_REGC + 5 * UNITB;
constexpr size_t WS_GSIG = WS_VB + 16384 * EROW;
constexpr size_t WS_BAR = WS_GSIG + 4194304;
constexpr size_t WS_STAT = WS_BAR + 16384;
constexpr size_t STAT_BYTES = (8192 * 2 + 2048 * 2) * 4 + 4096;
constexpr size_t WS_TSC = WS_STAT + STAT_BYTES;
constexpr size_t UROW = 1024;
constexpr size_t WS_UB = WS_TSC + 131072;
constexpr int N_BF = 6656, N_F8 = NPAD - N_BF;
constexpr size_t WS_H0B8 = WS_UB;
constexpr size_t WS_WT8 = WS_H0B8 + (size_t)MROWS * 2048;
constexpr size_t WS_END = WS_WT8 + (size_t)N_F8 * 2048;
static_assert(WS_YAB + 50331648 <= WS_MERGED, "overlay");

constexpr int LDS_BYTES = 163840;
constexpr int NPHASE = 8;

struct Params {
    const float* in[30];
    float* out;
    unsigned char* ws;
    int ph_lo, ph_hi;
};
enum { I_X = 0, I_META, I_LNIN_G, I_LNIN_B, I_WIN, I_MU, I_W0, I_WW2, I_A0, I_WA2, I_WG2, I_KK, I_KA, I_RK, I_GNG, I_GNB, I_WPOOL, I_PSCALE, I_BGATE,
       I_WBA, I_WBB, I_WOUT, I_LN1G, I_LN1B, I_WQ, I_SUBK, I_UT, I_VT, I_LN2G, I_LN2B };

__device__ __forceinline__ unsigned pk2(float lo, float hi) { return pg8::cvt_pk_bf16(lo, hi); }
__device__ __forceinline__ float bflo(unsigned w) { return __uint_as_float(w << 16); }
__device__ __forceinline__ float bfhi(unsigned w) { return __uint_as_float(w & 0xffff0000u); }
__device__ __forceinline__ float bf1(bf16_t h) { return __uint_as_float(((unsigned)h) << 16); }
__device__ __forceinline__ bf16_t f2bf1(float f) { return (bf16_t)(pk2(f, f) & 0xffffu); }
__device__ __forceinline__ float wave_sum(float v) {
#pragma unroll
    for (int o = 1; o < 64; o <<= 1) v += __shfl_xor(v, o);
    return v;
}
__device__ __forceinline__ float sigmoidf_(float x) { return 1.0f / (1.0f + __expf(-x)); }
__device__ __forceinline__ f32x4 mfma16(bf16x8 a, bf16x8 b, f32x4 c) { return __builtin_amdgcn_mfma_f32_16x16x32_bf16(a, b, c, 0, 0, 0); }
__device__ __forceinline__ void unpack8(const u32x4 w, float* f) {
    f[0] = bflo(w.x); f[1] = bfhi(w.x); f[2] = bflo(w.y); f[3] = bfhi(w.y); f[4] = bflo(w.z); f[5] = bfhi(w.z); f[6] = bflo(w.w); f[7] = bfhi(w.w);
}
__device__ __forceinline__ u32x4 pack8(const float* f) { u32x4 w; w.x = pk2(f[0], f[1]); w.y = pk2(f[2], f[3]); w.z = pk2(f[4], f[5]); w.w = pk2(f[6], f[7]); return w; }
#define DPPF(v, ctrl) __builtin_bit_cast(float, __builtin_amdgcn_update_dpp(0, __builtin_bit_cast(int, (v)), (ctrl), 0xF, 0xF, true))
__device__ __forceinline__ float readlane_f(float v, int l) { return __builtin_bit_cast(float, __builtin_amdgcn_readlane(__builtin_bit_cast(int, v), l)); }
__device__ __forceinline__ float wave_sum_dpp(float v) {
    v += DPPF(v, 0xB1); v += DPPF(v, 0x4E); v += DPPF(v, 0x141); v += DPPF(v, 0x140);
    return (readlane_f(v, 0) + readlane_f(v, 16)) + (readlane_f(v, 32) + readlane_f(v, 48));
}
__device__ __forceinline__ float wave_max_dpp(float v) {
    v = fmaxf(v, DPPF(v, 0xB1)); v = fmaxf(v, DPPF(v, 0x4E)); v = fmaxf(v, DPPF(v, 0x141)); v = fmaxf(v, DPPF(v, 0x140));
    return fmaxf(fmaxf(readlane_f(v, 0), readlane_f(v, 16)), fmaxf(readlane_f(v, 32), readlane_f(v, 48)));
}
#define BLOCK_SYNC() __syncthreads()
#define XB_TMO      128
#define XB_XCNT(j)  (256  + 64 * (j))
#define XB_XSUB(j)  (1280 + 64 * (j))
#define XB_XGEN(j)  (2304 + 64 * (j))
#define XB_TOP      3328
#define XB_TOPGEN   3392
#define XCD_BAR_WORDS 3456
#define XB_SPIN_CAP (1u << 18)

__device__ __forceinline__ unsigned xb_ld(unsigned* p)              { return __hip_atomic_load(p, __ATOMIC_RELAXED, __HIP_MEMORY_SCOPE_AGENT); }
__device__ __forceinline__ unsigned xb_add(unsigned* p, unsigned v) { return __hip_atomic_fetch_add(p, v, __ATOMIC_RELAXED, __HIP_MEMORY_SCOPE_AGENT); }
__device__ __forceinline__ unsigned xb_xcc_id() { return (unsigned)__builtin_amdgcn_s_getreg((3 << 11) | 20) & 0xFu; }
#define XB_SPIN(cond, bar) do { unsigned _sp = 0; while (cond) { __builtin_amdgcn_s_sleep(1); \
    if ((++_sp & 255u) == 0u) { if (xb_ld(&(bar)[XB_TMO])) break; if (_sp > XB_SPIN_CAP) { atomicAdd(&(bar)[XB_TMO], 1u); break; } } } } while (0)

struct XcdBarrier {
    unsigned* bar; unsigned x;
    volatile LAS unsigned* st;
};

__device__ __forceinline__ XcdBarrier xcd_barrier_post(unsigned* bar, volatile LAS unsigned* st) {
    XcdBarrier b; b.bar = bar; b.x = xb_xcc_id(); b.st = st;
    if (threadIdx.x == 0) (void)xb_add(&bar[XB_XCNT(b.x)], 1u);
    return b;
}
__device__ __forceinline__ void xcd_barrier_complete(unsigned* bar, unsigned x, unsigned& nloc, unsigned& nx) {
    const unsigned G = gridDim.x * gridDim.y * gridDim.z;
    unsigned sum, cnt, mine, sp = 0u;
    for (;;) {
        sum = 0u; cnt = 0u; mine = 0u;
#pragma unroll
        for (unsigned j = 0; j < 16; ++j) { const unsigned c = xb_ld(&bar[XB_XCNT(j)]); sum += c; cnt += (c > 0u) ? 1u : 0u; mine = (j == x) ? c : mine; }
        if (sum == G) break;
        __builtin_amdgcn_s_sleep(1);
        if ((++sp & 255u) == 0u) { if (xb_ld(&bar[XB_TMO])) break; if (sp > XB_SPIN_CAP) { atomicAdd(&bar[XB_TMO], 1u); break; } }
    }
    nloc = mine > 0u ? mine : 1u; nx = cnt > 0u ? cnt : 1u;
}

__device__ __forceinline__ void xcd_barrier(const XcdBarrier& b) {
    asm volatile("s_waitcnt vmcnt(0)" ::: "memory");
    __syncthreads();
    if (threadIdx.x == 0) {
        unsigned* bar = b.bar;
        __builtin_amdgcn_s_waitcnt(0);
        unsigned nloc = b.st[0], nx = b.st[1];
        if (nloc == 0u) { xcd_barrier_complete(bar, b.x, nloc, nx); b.st[0] = nloc; b.st[1] = nx; }
        const unsigned old = xb_add(&bar[XB_XSUB(b.x)], 1u);
        const unsigned gen = old / nloc;
        if (old + 1u == (gen + 1u) * nloc) {
            __builtin_amdgcn_fence(__ATOMIC_RELEASE, "agent");
            asm volatile("s_waitcnt vmcnt(0)" ::: "memory");
            const unsigned og = xb_add(&bar[XB_TOP], 1u);
            const unsigned tg = og / nx;
            if (og + 1u == (tg + 1u) * nx) xb_add(&bar[XB_TOPGEN], 1u);
            else XB_SPIN(xb_ld(&bar[XB_TOPGEN]) == tg, bar);
            __builtin_amdgcn_fence(__ATOMIC_ACQUIRE, "agent");
            xb_add(&bar[XB_XGEN(b.x)], 1u);
            asm volatile("s_waitcnt vmcnt(0)" ::: "memory");
        } else {
            XB_SPIN(xb_ld(&bar[XB_XGEN(b.x)]) == gen, bar);
            __builtin_amdgcn_fence(__ATOMIC_ACQUIRE, "agent");
            asm volatile("s_waitcnt vmcnt(0)" ::: "memory");
        }
    }
    __syncthreads();
}

__device__ __forceinline__ void ln_row_bf16(const float* src, const float* g, const float* b, bf16_t* dst, int lane) {
    f32x4 v[8]; float s = 0.f;
#pragma unroll
    for (int j = 0; j < 8; ++j) { v[j] = ((const f32x4*)src)[lane + 64 * j]; s += (v[j].x + v[j].y) + (v[j].z + v[j].w); }
    const float mean = wave_sum(s) * (1.0f / D); float s2 = 0.f;
#pragma unroll
    for (int j = 0; j < 8; ++j) { v[j] = v[j] - mean; s2 += (v[j].x * v[j].x + v[j].y * v[j].y) + (v[j].z * v[j].z + v[j].w * v[j].w); }
    const float rstd = 1.0f / sqrtf(wave_sum(s2) * (1.0f / D) + LN_EPS);
#pragma unroll
    for (int j = 0; j < 8; ++j) {
        const f32x4 gg = ((const f32x4*)g)[lane + 64 * j], bb = ((const f32x4*)b)[lane + 64 * j];
        const f32x4 o = v[j] * rstd * gg + bb;
        u32x2 w; w.x = pk2(o.x, o.y); w.y = pk2(o.z, o.w);
        ((u32x2*)dst)[lane + 64 * j] = w;
    }
}
__device__ __forceinline__ void transpose_item(const float* W, int K, int N, int Npad, bf16_t* Wt, int item, int lane, int ldw = 0) {
    const int nblk = Npad >> 6, kb = item / nblk, nb = item - kb * nblk, n = nb * 64 + lane, k0 = kb * 32;
    float v[32];
    if (n < N) {
#pragma unroll
        for (int i = 0; i < 32; ++i) v[i] = W[(size_t)(k0 + i) * N + n];
    } else {
#pragma unroll
        for (int i = 0; i < 32; ++i) v[i] = 0.f;
    }
    u32x4* o = (u32x4*)(Wt + (size_t)n * (ldw ? ldw : K) + k0);
#pragma unroll
    for (int c = 0; c < 4; ++c) { u32x4 w; w.x = pk2(v[8 * c], v[8 * c + 1]); w.y = pk2(v[8 * c + 2], v[8 * c + 3]); w.z = pk2(v[8 * c + 4], v[8 * c + 5]); w.w = pk2(v[8 * c + 6], v[8 * c + 7]); o[c] = w; }
}
__device__ __forceinline__ void transpose_item_q(const float* W, const float* g, const float* b, bf16_t* Wt, float* c1, float* c2, int item, int lane) {
    const int kb = item >> 5, nb = item & 31, n = nb * 64 + lane, k0 = kb * 32;
    float v[32], s1 = 0.f, s2 = 0.f;
#pragma unroll
    for (int i = 0; i < 32; ++i) { const float w = W[(size_t)(k0 + i) * 2048 + n]; const float gw = g[k0 + i] * w; s1 += gw; s2 += b[k0 + i] * w; v[i] = gw; }
    u32x4* o = (u32x4*)(Wt + (size_t)n * 2048 + k0);
#pragma unroll
    for (int c = 0; c < 4; ++c) { u32x4 w; w.x = pk2(v[8 * c], v[8 * c + 1]); w.y = pk2(v[8 * c + 2], v[8 * c + 3]); w.z = pk2(v[8 * c + 4], v[8 * c + 5]); w.w = pk2(v[8 * c + 6], v[8 * c + 7]); o[c] = w; }
    atomicAdd(c1 + n, s1); atomicAdd(c2 + n, s2);
}
__device__ __forceinline__ unsigned pk4_fp8(float a, float b, float c, float d) {
    int w = __builtin_amdgcn_cvt_pk_fp8_f32(a, b, 0, false); w = __builtin_amdgcn_cvt_pk_fp8_f32(c, d, w, true); return (unsigned)w; }
__device__ __forceinline__ void transpose_item64(const float* W, int K, int N, int Npad, bf16_t* Wt, int ldw, int item, int lane, unsigned char* Wt8 = nullptr, int n8 = 1 << 30) {
    const int nblk = Npad >> 6, kb = item / nblk, nb = item - kb * nblk, n = nb * 64 + lane, k0 = kb * 64;
    float v[64];
    if (n < N) {
#pragma unroll
        for (int i = 0; i < 64; ++i) v[i] = W[(size_t)(k0 + i) * N + n];
    } else {
#pragma unroll
        for (int i = 0; i < 64; ++i) v[i] = 0.f;
    }
    if (n >= n8) {
        u32x4* o8 = (u32x4*)(Wt8 + (size_t)(n - n8) * 2048 + k0);
#pragma unroll
        for (int c = 0; c < 4; ++c) { u32x4 w; w.x = pk4_fp8(64.f * v[16 * c], 64.f * v[16 * c + 1], 64.f * v[16 * c + 2], 64.f * v[16 * c + 3]); w.y = pk4_fp8(64.f * v[16 * c + 4], 64.f * v[16 * c + 5], 64.f * v[16 * c + 6], 64.f * v[16 * c + 7]);
            w.z = pk4_fp8(64.f * v[16 * c + 8], 64.f * v[16 * c + 9], 64.f * v[16 * c + 10], 64.f * v[16 * c + 11]); w.w = pk4_fp8(64.f * v[16 * c + 12], 64.f * v[16 * c + 13], 64.f * v[16 * c + 14], 64.f * v[16 * c + 15]); o8[c] = w; }
        return;
    }
    u32x4* o = (u32x4*)(Wt + (size_t)n * ldw + k0);
#pragma unroll
    for (int c = 0; c < 8; ++c) { u32x4 w; w.x = pk2(v[8 * c], v[8 * c + 1]); w.y = pk2(v[8 * c + 2], v[8 * c + 3]); w.z = pk2(v[8 * c + 4], v[8 * c + 5]); w.w = pk2(v[8 * c + 6], v[8 * c + 7]); o[c] = w; }
}
__device__ __forceinline__ void phase0(const Params& P) {
    const int lane = threadIdx.x & 63, wave = threadIdx.x >> 6;
    const int gw = blockIdx.x * 8 + wave, NGW = gridDim.x * 8;
    unsigned char* ws = P.ws;
    constexpr int T_IN = 32 * 184, T_A = 32 * 32, T_B = 16 * 32, T_O = 32 * 32, T_Q = 64 * 32, T_POOL = 4 * 32, T_W2 = 3 * 32, T_A2 = 3 * 32, T_G2 = 8 * 32;
    constexpr int T_LN = MROWS, T_SK = 64;
    constexpr int NIT = T_IN + T_A + T_B + T_O + T_Q + T_POOL + T_W2 + T_A2 + T_G2 + T_SK;
    for (int it = gw; it < NIT; it += NGW) {
        int r = it;
        if (r < T_IN) { transpose_item64(P.in[I_WIN], 2048, INC, NPAD, (bf16_t*)(ws + WS_WTIN), 2048, r, lane, ws + WS_WT8, N_BF); continue; } r -= T_IN;
        if (r < T_A) { transpose_item64(P.in[I_WBA], 2048, 2048, 2048, (bf16_t*)(ws + WS_WTAB), LDAB, r, lane); continue; } r -= T_A;
        if (r < T_B) { transpose_item64(P.in[I_WBB], 1024, 2048, 2048, (bf16_t*)(ws + WS_WTAB) + 2048, LDAB, r, lane); continue; } r -= T_B;
        if (r < T_O) { transpose_item64(P.in[I_WOUT], 2048, 2048, 2048, (bf16_t*)(ws + WS_WTOUT), 2048, r, lane); continue; } r -= T_O;
        if (r < T_Q) {
#ifdef REPEAT_PHASE
            float* st = (float*)(ws + (P.ph_lo < 0 ? WS_END : WS_STAT));
#else
            float* st = (float*)(ws + WS_STAT);
#endif
            transpose_item_q(P.in[I_WQ], P.in[I_LN1G], P.in[I_LN1B], (bf16_t*)(ws + WS_WTQ), st + 16384, st + 18432, r, lane); continue; } r -= T_Q;
        if (r < T_POOL) { const int g = r >> 5; transpose_item(P.in[I_WPOOL] + g * 65536, 256, 256, 256, (bf16_t*)(ws + WS_WTPOOL) + g * 65536, r & 31, lane); continue; } r -= T_POOL;
        if (r < T_W2) { transpose_item(P.in[I_WW2], 96, 2048, 2048, (bf16_t*)(ws + WS_WTW2), r, lane); continue; } r -= T_W2;
        if (r < T_A2) { transpose_item(P.in[I_WA2], 96, 2048, 2048, (bf16_t*)(ws + WS_WTA2), r, lane); continue; } r -= T_A2;
        if (r < T_G2) { transpose_item(P.in[I_WG2], 256, 2048, 2048, (bf16_t*)(ws + WS_WTG2), r, lane); continue; } r -= T_G2;
        {
            const float* s = P.in[I_SUBK] + r * 512 + lane * 8; float f[8];
#pragma unroll
            for (int i = 0; i < 8; ++i) f[i] = s[i];
            *(u32x4*)((bf16_t*)(ws + WS_SUBK) + r * 512 + lane * 8) = pack8(f);
        }
    }
    {
        f32x4 gg[8], bb[8];
#pragma unroll
        for (int j = 0; j < 8; ++j) { gg[j] = ((const f32x4*)P.in[I_LNIN_G])[lane + 64 * j]; bb[j] = ((const f32x4*)P.in[I_LNIN_B])[lane + 64 * j]; }
        auto srcrow = [&](int r) -> const float* { return r < NTOK ? P.in[I_X] + (size_t)r * D : P.in[I_META] + (size_t)(r - NTOK) * D; };
        auto finish = [&](int r, f32x4 (&v)[8]) {
            float s = 0.f;
#pragma unroll
            for (int j = 0; j < 8; ++j) s += (v[j].x + v[j].y) + (v[j].z + v[j].w);
            const float mean = wave_sum_dpp(s) * (1.0f / D); float s2 = 0.f;
#pragma unroll
            for (int j = 0; j < 8; ++j) { v[j] = v[j] - mean; s2 += (v[j].x * v[j].x + v[j].y * v[j].y) + (v[j].z * v[j].z + v[j].w * v[j].w); }
            const float rstd = 1.0f / sqrtf(wave_sum_dpp(s2) * (1.0f / D) + LN_EPS);
            bf16_t* dst = (bf16_t*)(ws + WS_H0B) + (size_t)r * D;
            unsigned* dst8 = (unsigned*)(ws + WS_H0B8 + (size_t)r * 2048);
#pragma unroll
            for (int j = 0; j < 8; ++j) { const f32x4 o = v[j] * rstd * gg[j] + bb[j]; u32x2 w; w.x = pk2(o.x, o.y); w.y = pk2(o.z, o.w); ((u32x2*)dst)[lane + 64 * j] = w;
                dst8[lane + 64 * j] = pk4_fp8(o.x, o.y, o.z, o.w); }
        };
        for (int r = gw; r < NTOK + 16; r += 2 * NGW) {
            const int r2 = r + NGW; const bool has2 = r2 < NTOK + 16;
            f32x4 v1[8], v2[8];
#pragma unroll
            for (int j = 0; j < 8; ++j) v1[j] = ((const f32x4*)srcrow(r))[lane + 64 * j];
#pragma unroll
            for (int j = 0; j < 8; ++j) v2[j] = ((const f32x4*)srcrow(has2 ? r2 : r))[lane + 64 * j];
            finish(r, v1); if (has2) finish(r2, v2);
        }
        for (int r = NTOK + 16 + gw; r < MROWS; r += NGW) { bf16_t* dst = (bf16_t*)(ws + WS_H0B) + (size_t)r * D; unsigned* dst8 = (unsigned*)(ws + WS_H0B8 + (size_t)r * 2048);
#pragma unroll
            for (int j = 0; j < 8; ++j) { ((u32x2*)dst)[lane + 64 * j] = (u32x2){0u, 0u}; dst8[lane + 64 * j] = 0u; } }
    }
}
namespace pg8 {
constexpr float LN_EPS_ = 1e-5f;
struct EpiBf16S {
    static constexpr bool PERM = true, AFTER_DRAIN = false; static constexpr int MID_T = -1;
    bf16_t* O; int ldc; float scale;
    __device__ __forceinline__ void operator()(const f32x4 (&acc)[2][2][4][2], const Unit& u, int wr, int wc, int fr, int fq) const {
        const int row0 = u.pm * BM + wr * 64 + fr, col0 = u.pn * BM + wc * 32 + 8 * fq;
#pragma unroll
        for (int ai = 0; ai < 2; ++ai)
#pragma unroll
            for (int m = 0; m < 4; ++m) { bf16_t* rowp = O + (size_t)(row0 + ai * HALF + m * 16) * ldc + col0;
#pragma unroll
                for (int bj = 0; bj < 2; ++bj) { const f32x4 v0 = acc[ai][bj][m][0] * scale, v1 = acc[ai][bj][m][1] * scale;
                    u32x4 w; w.x = cvt_pk_bf16(v0[0], v0[1]); w.y = cvt_pk_bf16(v0[2], v0[3]); w.z = cvt_pk_bf16(v1[0], v1[1]); w.w = cvt_pk_bf16(v1[2], v1[3]);
                    *(u32x4*)(rowp + bj * HALF) = w; } }
    }
};
struct EpiGate35 {
    static constexpr bool PERM = false, AFTER_DRAIN = false; static constexpr int MID_T = 32;
    bf16_t* O; const bf16_t* p; const float* bgate;
    __device__ __forceinline__ void mid(f32x4 (&acc)[2][2][4][2], const Unit& u, int wr, int wc, int fr, int fq) const {
        asm volatile("" : "+v"(fr), "+v"(fq));
        const int row0 = u.pm * BM + wr * 64 + fr, col0 = u.pn * BM + wc * 32 + 4 * fq;
        f32x4 b0[2][2], b1[2][2];
#pragma unroll
        for (int bj = 0; bj < 2; ++bj)
#pragma unroll
            for (int n = 0; n < 2; ++n) { const int col = col0 + bj * HALF + n * 16; b0[bj][n] = *(const f32x4*)(bgate + col); b1[bj][n] = *(const f32x4*)(bgate + D + col); }
        u32x2 pa[2][2][2], pb[2][2][2];
        auto ld = [&](int g, u32x2 (&pp)[2][2][2]) { const size_t row = (size_t)(row0 + (g >> 2) * HALF + (g & 3) * 16);
#pragma unroll
            for (int bj = 0; bj < 2; ++bj)
#pragma unroll
                for (int n = 0; n < 2; ++n) { const int col = col0 + bj * HALF + n * 16; pp[bj][n][0] = *(const u32x2*)(p + row * NPAD + C_G0 + col); pp[bj][n][1] = *(const u32x2*)(p + row * NPAD + C_G1 + col); } };
        auto ap = [&](int g, const u32x2 (&pp)[2][2][2]) { const int ai = g >> 2, m = g & 3;
#pragma unroll
            for (int bj = 0; bj < 2; ++bj)
#pragma unroll
                for (int n = 0; n < 2; ++n) { const u32x2 p0 = pp[bj][n][0], p1 = pp[bj][n][1]; const f32x4 c0 = b0[bj][n], c1 = b1[bj][n];
                    f32x4 r;
                    r.x = (1.0f + __expf(-fmaxf(bflo(p1.x) + c1.x, -80.f))) * __builtin_amdgcn_rcpf(1.0f + __expf(-(bflo(p0.x) + c0.x)));
                    r.y = (1.0f + __expf(-fmaxf(bfhi(p1.x) + c1.y, -80.f))) * __builtin_amdgcn_rcpf(1.0f + __expf(-(bfhi(p0.x) + c0.y)));
                    r.z = (1.0f + __expf(-fmaxf(bflo(p1.y) + c1.z, -80.f))) * __builtin_amdgcn_rcpf(1.0f + __expf(-(bflo(p0.y) + c0.z)));
                    r.w = (1.0f + __expf(-fmaxf(bfhi(p1.y) + c1.w, -80.f))) * __builtin_amdgcn_rcpf(1.0f + __expf(-(bfhi(p0.y) + c0.w)));
                    acc[ai][bj][m][n] = acc[ai][bj][m][n] * r; } };
        ld(0, pa);
#pragma unroll
        for (int g = 0; g < 8; g += 2) { ld(g + 1, pb); ap(g, pa); if (g + 2 < 8) ld(g + 2, pa); ap(g + 1, pb); }
    }
    __device__ __forceinline__ void operator()(const f32x4 (&acc)[2][2][4][2], const Unit& u, int wr, int wc, int fr, int fq) const {
        const int row0 = u.pm * BM + wr * 64 + fr, col0 = u.pn * BM + wc * 32 + 4 * fq;
#pragma unroll
        for (int ai = 0; ai < 2; ++ai)
#pragma unroll
            for (int m = 0; m < 4; ++m) { const size_t row = (size_t)(row0 + ai * HALF + m * 16);
#pragma unroll
                for (int bj = 0; bj < 2; ++bj)
#pragma unroll
                    for (int n = 0; n < 2; ++n) { const int col = col0 + bj * HALF + n * 16;
                        const u32x2 p1 = *(const u32x2*)(p + row * NPAD + C_G1 + col); const f32x4 b1 = *(const f32x4*)(bgate + D + col);
                        f32x4 g;
                        g.x = __builtin_amdgcn_rcpf(1.0f + __expf(-fmaxf(bflo(p1.x) + b1.x, -80.f))); g.y = __builtin_amdgcn_rcpf(1.0f + __expf(-fmaxf(bfhi(p1.x) + b1.y, -80.f)));
                        g.z = __builtin_amdgcn_rcpf(1.0f + __expf(-fmaxf(bflo(p1.y) + b1.z, -80.f))); g.w = __builtin_amdgcn_rcpf(1.0f + __expf(-fmaxf(bfhi(p1.y) + b1.w, -80.f)));
                        const f32x4 o = acc[ai][bj][m][n] * g;
                        u32x2 w; w.x = cvt_pk_bf16(o.x, o.y); w.y = cvt_pk_bf16(o.z, o.w);
                        *(u32x2*)(O + row * D + col) = w; } }
    }
};
struct EpiResidStats {
    static constexpr bool PERM = false, AFTER_DRAIN = false; static constexpr int MID_T = -1;
    bf16_t* O; const bf16_t* h0; float alpha; float* rsum; float* rsq;
    __device__ __forceinline__ void operator()(const f32x4 (&acc)[2][2][4][2], const Unit& u, int wr, int wc, int fr, int fq) const {
        const int row0 = u.pm * BM + wr * 64 + fr, col0 = u.pn * BM + wc * 32 + 4 * fq;
#pragma unroll
        for (int ai = 0; ai < 2; ++ai)
#pragma unroll
            for (int m = 0; m < 4; ++m) { const size_t row = (size_t)(row0 + ai * HALF + m * 16); float s = 0.f, q = 0.f;
#pragma unroll
                for (int bj = 0; bj < 2; ++bj)
#pragma unroll
                    for (int n = 0; n < 2; ++n) { const int col = col0 + bj * HALF + n * 16;
                        const u32x2 hw = *(const u32x2*)(h0 + row * D + col);
                        f32x4 hv; hv.x = bflo(hw.x); hv.y = bfhi(hw.x); hv.z = bflo(hw.y); hv.w = bfhi(hw.y);
                        const f32x4 x = hv * alpha + acc[ai][bj][m][n];
                        s += (x.x + x.y) + (x.z + x.w); q += (x.x * x.x + x.y * x.y) + (x.z * x.z + x.w * x.w);
                        u32x2 w; w.x = cvt_pk_bf16(x.x, x.y); w.y = cvt_pk_bf16(x.z, x.w);
                        *(u32x2*)(O + row * D + col) = w; }
                s += __shfl_xor(s, 16); s += __shfl_xor(s, 32); q += __shfl_xor(q, 16); q += __shfl_xor(q, 32);
                if (fq == 0) { atomicAdd(rsum + row, s); atomicAdd(rsq + row, q); } }
    }
};
struct EpiQ {
    static constexpr bool PERM = true, AFTER_DRAIN = false; static constexpr int MID_T = -1;
    bf16_t* O; const float* rsum; const float* rsq; const float* c1; const float* c2;
    __device__ __forceinline__ void operator()(const f32x4 (&acc)[2][2][4][2], const Unit& u, int wr, int wc, int fr, int fq) const {
        const int row0 = u.pm * BM + wr * 64 + fr, col0 = u.pn * BM + wc * 32 + 8 * fq;
        f32x4 k1[2][2], k2[2][2];
#pragma unroll
        for (int bj = 0; bj < 2; ++bj)
#pragma unroll
            for (int n = 0; n < 2; ++n) { k1[bj][n] = *(const f32x4*)(c1 + col0 + bj * HALF + 4 * n); k2[bj][n] = *(const f32x4*)(c2 + col0 + bj * HALF + 4 * n); }
#pragma unroll
        for (int ai = 0; ai < 2; ++ai)
#pragma unroll
            for (int m = 0; m < 4; ++m) { const int row = row0 + ai * HALF + m * 16;
                const float mean = rsum[row] * (1.0f / D), rstd = 1.0f / sqrtf(fmaxf(rsq[row] * (1.0f / D) - mean * mean, 0.f) + LN_EPS_);
                bf16_t* rowp = O + (size_t)row * D + col0;
#pragma unroll
                for (int bj = 0; bj < 2; ++bj) {
                    const f32x4 v0 = (acc[ai][bj][m][0] - k1[bj][0] * mean) * rstd + k2[bj][0], v1 = (acc[ai][bj][m][1] - k1[bj][1] * mean) * rstd + k2[bj][1];
                    u32x4 w; w.x = cvt_pk_bf16(v0[0], v0[1]); w.y = cvt_pk_bf16(v0[2], v0[3]); w.z = cvt_pk_bf16(v1[0], v1[1]); w.w = cvt_pk_bf16(v1[2], v1[3]);
                    *(u32x4*)(rowp + bj * HALF) = w; } }
    }
};
}
template <class Epi>
__device__ __forceinline__ void run_gemm(ldsp lds, const bf16_t* A, const bf16_t* Bt, int M, int N, int K, const Epi& E) {
    pg8::Gemm g; g.A = A; g.Bt = Bt; g.M = M; g.N = N; g.K = K;
    pg8::StaticOrder S; S.init(M, N, (int)gridDim.x, (int)blockIdx.x);
    pg8::gemm_phase<Epi, pg8::StaticOrder, false>(lds, g, S, E, nullptr);
}

template <class Epi>
__device__ __forceinline__ void run_gemm8(ldsp lds, const unsigned char* A8, const unsigned char* Bt8, int M, int N, int K, const Epi& E, int wg) {
    pg8::Gemm g; g.A = (const bf16_t*)A8; g.Bt = (const bf16_t*)Bt8; g.M = M; g.N = N; g.K = K / 2;
    pg8::StaticOrder S; S.init(M, N, (int)gridDim.x, wg);
    pg8::gemm_phase<Epi, pg8::StaticOrder, false, true>(lds, g, S, E, nullptr);
}
constexpr int CONV_P3_END = 16384;
constexpr int CONV_P2_ROWS = 0;
__device__ __forceinline__ void convert_row(unsigned char* ws, int r, int lane, const f32x4 (&v)[8]) {
    float am = 0.f, ss = 0.f;
#pragma unroll
    for (int j = 0; j < 8; ++j) { am = fmaxf(am, fmaxf(fmaxf(fabsf(v[j].x), fabsf(v[j].y)), fmaxf(fabsf(v[j].z), fabsf(v[j].w)))); ss += (v[j].x * v[j].x + v[j].y * v[j].y) + (v[j].z * v[j].z + v[j].w * v[j].w); }
    am = wave_max_dpp(am);
    const float rms = sqrtf(wave_sum_dpp(ss) * (1.0f / D));
    unsigned w[4]; float sc;
    if (r < 16384) {
        const float clip = fminf(am, 2.5f * rms), s = clip > 0.f ? 7.0f / clip : 1.0f; sc = clip > 0.f ? clip * (1.0f / 7.0f) : 1.0f;
#pragma unroll
        for (int j = 0; j < 4; ++j) { unsigned t = 0;
#pragma unroll
            for (int i = 0; i < 8; ++i) { const float f = fminf(fmaxf(v[2 * j + (i >> 2)][i & 3] * s, -7.0f), 7.0f);
                t = __builtin_amdgcn_alignbit(__float_as_uint(f + 12582912.0f), t, 4); }
            w[j] = t; }
    } else {
        const float clip = fminf(am, 3.0f * rms), s = clip > 0.f ? 6.0f / clip : 1.0f; sc = clip > 0.f ? clip * (1.0f / 6.0f) : 1.0f;
#pragma unroll
        for (int j = 0; j < 4; ++j) { unsigned t = 0; float f[8];
#pragma unroll
            for (int i = 0; i < 8; ++i) f[i] = fminf(fmaxf(v[2 * j + (i >> 2)][i & 3] * s, -6.0f), 6.0f);
            t = __builtin_amdgcn_cvt_scalef32_pk_fp4_f32(t, f[0], f[1], 1.0f, 0); t = __builtin_amdgcn_cvt_scalef32_pk_fp4_f32(t, f[2], f[3], 1.0f, 1);
            t = __builtin_amdgcn_cvt_scalef32_pk_fp4_f32(t, f[4], f[5], 1.0f, 2); t = __builtin_amdgcn_cvt_scalef32_pk_fp4_f32(t, f[6], f[7], 1.0f, 3);
            w[j] = t; }
    }
    *(u32x4*)(ws + WS_VB + (size_t)(r & 16383) * EROW + (r < 16384 ? 0 : 1024) + lane * 16) = (u32x4){w[0], w[1], w[2], w[3]};
    if (lane == 0) ((float*)(ws + WS_TSC))[r] = sc;
}
__device__ __forceinline__ void convert_ld(const Params& P, int r, int lane, f32x4 (&v)[8]) {
    const f32x4* src = (const f32x4*)((r < 16384 ? P.in[I_UT] : P.in[I_VT]) + (size_t)(r & 16383) * D) + lane;
#pragma unroll
    for (int j = 0; j < 8; ++j) v[j] = src[64 * j];
}
__device__ __forceinline__ void convert_tables(const Params& P, int r0, int rend, int stride) {
    const int lane = threadIdx.x & 63;
    for (int r = r0; r < rend; r += stride) { f32x4 v[8]; convert_ld(P, r, lane, v); convert_row(P.ws, r, lane, v); }
}
constexpr int LD64 = 72, MATB = 64 * LD64 * 2, LDK = 104;
constexpr int O_AB = 0, O_RB = 1 * MATB, O_BH = 2 * MATB, O_KH = 3 * MATB, O_BTT = 4 * MATB, O_KTT = 5 * MATB, O_VT = 6 * MATB;
constexpr int O_M0 = 7 * MATB, O_M0T = 8 * MATB  , O_M1 = 9 * MATB, O_PA = 10 * MATB, O_PB = 11 * MATB, O_MAK = 12 * MATB, O_MRB = 13 * MATB, O_MRK = 14 * MATB;
constexpr int O_M1T = 0;
constexpr int LDKP = 96;
constexpr int O_WL = 15 * MATB, O_AL = O_WL + 64 * LDKP * 2;
constexpr int O_Z = 7 * MATB, O_AZ = O_Z + 64 * 68 * 4;
static_assert(O_AZ + 64 * 68 * 4 <= O_PB, "lds");
static_assert(O_AL + 64 * LDKP * 2 <= LDS_BYTES - 16, "lds");

__device__ __forceinline__ bf16x8 ldsfrag(ldsp lds, int off, int ld, int row, int kofs) { return *(const LAS bf16x8*)(lds + off + (row * ld + kofs) * 2); }
__device__ __forceinline__ void st4(ldsp lds, int off, int row, int col, const f32x4 v) {
    u32x2 w; w.x = pk2(v.x, v.y); w.y = pk2(v.z, v.w); *(LAS u32x2*)(lds + off + (row * LD64 + col) * 2) = w; }
__device__ __forceinline__ void st1(ldsp lds, int off, int row, int col, float v) { *(LAS bf16_t*)(lds + off + (row * LD64 + col) * 2) = f2bf1(v); }

__device__ __forceinline__ float fast_rcp(float x) { return __builtin_amdgcn_rcpf(x); }
__device__ __forceinline__ float fast_sigmoid(float x) { return fast_rcp(1.0f + __expf(-x)); }
__device__ __forceinline__ float fast_tanh(float x) { return 1.0f - 2.0f * fast_rcp(1.0f + __expf(2.0f * x)); }
__device__ __forceinline__ u32x4 ld8(const bf16_t* p) { return p ? *(const u32x4*)p : (u32x4){0u, 0u, 0u, 0u}; }
__device__ __forceinline__ void shift8r(const u32x4 cw, const u32x4 pw, const float* mu, float* x) {
    float c[8], q[8]; unpack8(cw, c); unpack8(pw, q);
    const f32x4 m0 = *(const f32x4*)mu, m1 = *(const f32x4*)(mu + 4);
    const float mm[8] = {m0.x, m0.y, m0.z, m0.w, m1.x, m1.y, m1.z, m1.w};
#pragma unroll
    for (int i = 0; i < 8; ++i) x[i] = c[i] + (q[i] - c[i]) * mm[i];
}
__device__ __forceinline__ int tcol(int row, int col) { return ((((col >> 3) ^ (row >> 3)) & 7) << 3) | (col & 7); }
__device__ __forceinline__ bf16x8 ldsfragT(ldsp lds, int off, int row, int kofs) { return *(const LAS bf16x8*)(lds + off + (row * LD64 + tcol(row, kofs)) * 2); }
__device__ __forceinline__ void st1T(ldsp lds, int off, int row, int col, float v) { *(LAS bf16_t*)(lds + off + (row * LD64 + tcol(row, col)) * 2) = f2bf1(v); }
typedef short s16x4 __attribute__((ext_vector_type(4)));
__device__ __forceinline__ bf16x8 ldsfragTR(ldsp lds, int off, int krow0, int col0, int lane) {
    const int g = lane >> 4, q = (lane & 15) >> 2, p = lane & 3;
    const LAS s16x4* a = (const LAS s16x4*)(lds + off + ((krow0 + 8 * g + q) * LD64 + col0) * 2 + 8 * p);
    const s16x4 v0 = __builtin_amdgcn_ds_read_tr16_b64_v4i16((LAS s16x4*)a), v1 = __builtin_amdgcn_ds_read_tr16_b64_v4i16((LAS s16x4*)(a + LD64));
    return (bf16x8){v0[0], v0[1], v0[2], v0[3], v1[0], v1[1], v1[2], v1[3]};
}
__device__ __forceinline__ void shift8(const bf16_t* pcur, const bf16_t* pprev, const float* mu, float* x) {
    float c[8], q[8];
    if (pcur) unpack8(*(const u32x4*)pcur, c); else {
#pragma unroll
        for (int i = 0; i < 8; ++i) c[i] = 0.f; }
    if (pprev) unpack8(*(const u32x4*)pprev, q); else {
#pragma unroll
        for (int i = 0; i < 8; ++i) q[i] = 0.f; }
    const f32x4 m0 = *(const f32x4*)mu, m1 = *(const f32x4*)(mu + 4);
    const float mm[8] = {m0.x, m0.y, m0.z, m0.w, m1.x, m1.y, m1.z, m1.w};
#pragma unroll
    for (int i = 0; i < 8; ++i) x[i] = c[i] + (q[i] - c[i]) * mm[i];
}

template <bool DO_P, bool DO_SQ>
__device__ __forceinline__ void dbl_step(ldsp lds, int sN, int sT, int dN, int dT, int pC, int pN, int tm, int tn0, int fr, int fq) {
    bf16x8 a[2];
#pragma unroll
    for (int ks = 0; ks < 2; ++ks) a[ks] = ldsfragTR(lds, sN, 32 * ks, 16 * tm, 16 * fq + fr);
#pragma unroll
    for (int t2 = 0; t2 < 2; ++t2) {
        const int nt = tn0 + t2, t = 16 * nt + fr, s0 = 16 * tm + 4 * fq;
        if (DO_P) {
            f32x4 acc = {0.f, 0.f, 0.f, 0.f};
#pragma unroll
            for (int ks = 0; ks < 2; ++ks) acc = mfma16(a[ks], ldsfrag(lds, pC, LD64, t, ks * 32 + fq * 8), acc);
            const u32x2 pw = *(const LAS u32x2*)(lds + pC + (t * LD64 + s0) * 2);
            acc.x += bflo(pw.x); acc.y += bfhi(pw.x); acc.z += bflo(pw.y); acc.w += bfhi(pw.y);
            st4(lds, pN, t, s0, acc);
        }
        if (DO_SQ) {
            f32x4 acc = {0.f, 0.f, 0.f, 0.f};
#pragma unroll
            for (int ks = 0; ks < 2; ++ks) acc = mfma16(a[ks], ldsfrag(lds, sN, LD64, t, ks * 32 + fq * 8), acc);
            st4(lds, dN, t, s0, acc);
        }
    }
}


struct PL { u32x4 rc, rq, kc, kq, vc, vq; };
__device__ __forceinline__ const bf16_t* unit_rowp(const bf16_t* pp, int u, int tl, int col) {
    int r;
    if (u >= 4096) r = (tl >= 48) ? (ROW_META + tl - 48) : -1;
    else { const int bh = u >> 6, c = u & 63, b = bh >> 5; r = (tl >= 0 || c > 0) ? (b * SEQ + c * 64 + tl) : (ROW_META + 15); }
    return r < 0 ? (const bf16_t*)nullptr : pp + (size_t)r * NPAD + col;
}
__device__ __forceinline__ void pl_load(const Params& P, int u, PL& L) {
    int tid = threadIdx.x; asm volatile("" : "+v"(tid));
    const int lane = tid & 63, wave = tid >> 6, fr = lane & 15, fq = lane >> 4, tm = wave >> 1;
    const bf16_t* pp = (const bf16_t*)(P.ws + WS_P);
    const int h = (u >= 4096) ? (u - 4096) : ((u >> 6) & 31);
    const int t = tid >> 3, hj = h * 64 + 8 * (tid & 7);
    L.rc = ld8(unit_rowp(pp, u, t, C_R + hj)); L.rq = ld8(unit_rowp(pp, u, t - 1, C_R + hj));
    L.kc = ld8(unit_rowp(pp, u, t, C_K + hj)); L.kq = ld8(unit_rowp(pp, u, t - 1, C_K + hj));
    L.vc = ld8(unit_rowp(pp, u, t, C_V + hj)); L.vq = ld8(unit_rowp(pp, u, t - 1, C_V + hj));
}
#define SINGLE_TRIP for (int once_ = 0; once_ < 1; ++once_)
__device__ __forceinline__ void rwkv_unit(const Params& P, ldsp lds, int u, PL& L, int next_u, bool stage_a) {
    int tid = threadIdx.x; asm volatile("" : "+v"(tid));
    const int lane = tid & 63, wave = tid >> 6, fr = lane & 15, fq = lane >> 4, tm = wave >> 1, tn0 = (wave & 1) * 2;
    unsigned char* ws = P.ws;
    const bf16_t* pp = (const bf16_t*)(ws + WS_P);
    const bool meta = u >= 4096;
    int b = 0, h, c = 0;
    if (meta) { h = u - 4096; } else { const int bh = u >> 6; c = u & 63; b = bh >> 5; h = bh & 31; }
    auto rowof = [&](int tl) -> int {
        if (meta) return (tl >= 48) ? (ROW_META + tl - 48) : -1;
        if (tl >= 0 || c > 0) return b * SEQ + c * 64 + tl;
        return ROW_META + 15;
    };
    auto rowp = [&](int tl, int col) -> const bf16_t* { const int r = rowof(tl); return r < 0 ? (const bf16_t*)nullptr : pp + (size_t)r * NPAD + col; };
    const float* mu = P.in[I_MU];
    float lw[8], av[8], rv[8], kv[8], vv[8], kk[8], km[8];
    const int t = tid >> 3, jq = tid & 7, j0 = 8 * jq, hj = h * 64 + j0;
    const bool nulltok = meta && t < 48;
    SINGLE_TRIP {
    bf16x8 lAw[3], lAa[3];
    {
        const bf16_t* ww2 = (const bf16_t*)(ws + WS_WTW2) + (size_t)(h * 64 + 16 * tm + fr) * 96 + fq * 8;
        const bf16_t* wa2 = (const bf16_t*)(ws + WS_WTA2) + (size_t)(h * 64 + 16 * tm + fr) * 96 + fq * 8;
#pragma unroll
        for (int ks = 0; ks < 3; ++ks) { lAw[ks] = *(const bf16x8*)(ww2 + ks * 32); lAa[ks] = *(const bf16x8*)(wa2 + ks * 32); }
    }
    if (stage_a) {
        u32x4 cw[3], pw[3];
#pragma unroll
        for (int it = 0; it < 3; ++it) { const int idx = tid + 512 * it, mat = idx / 768, rem = idx - mat * 768, tt = rem / 12, ch = rem - tt * 12, col = (mat ? C_AL : C_WL) + ch * 8;
            cw[it] = ld8(rowp(tt, col)); pw[it] = ld8(rowp(tt - 1, col)); }
#pragma unroll
        for (int it = 0; it < 3; ++it) { const int idx = tid + 512 * it, mat = idx / 768, rem = idx - mat * 768, tt = rem / 12, ch = rem - tt * 12, col = (mat ? C_AL : C_WL) + ch * 8;
            float x[8]; shift8r(cw[it], pw[it], mu + col, x);
            if (mat == 0) {
#pragma unroll
                for (int i = 0; i < 8; ++i) x[i] = fast_tanh(x[i]);
            }
            *(LAS u32x4*)(lds + (mat ? O_AL : O_WL) + (tt * LDKP + ch * 8) * 2) = pack8(x); }
    }
    BLOCK_SYNC();
    {
        f32x4 z[2] = {{0.f, 0.f, 0.f, 0.f}, {0.f, 0.f, 0.f, 0.f}}, az[2] = {{0.f, 0.f, 0.f, 0.f}, {0.f, 0.f, 0.f, 0.f}};
#pragma unroll
        for (int ks = 0; ks < 3; ++ks) {
            const bf16x8 aw = lAw[ks], aa = lAa[ks];
#pragma unroll
            for (int t2 = 0; t2 < 2; ++t2) {
                const int t = 16 * (tn0 + t2) + fr;
                z[t2] = mfma16(aw, ldsfrag(lds, O_WL, LDKP, t, ks * 32 + fq * 8), z[t2]);
                az[t2] = mfma16(aa, ldsfrag(lds, O_AL, LDKP, t, ks * 32 + fq * 8), az[t2]);
            }
        }
#pragma unroll
        for (int t2 = 0; t2 < 2; ++t2) {
            const int t = 16 * (tn0 + t2) + fr, j0 = 16 * tm + 4 * fq;
            *(LAS f32x4*)(lds + O_Z + (t * 68 + j0) * 4) = z[t2];
            *(LAS f32x4*)(lds + O_AZ + (t * 68 + j0) * 4) = az[t2];
        }
    }
    BLOCK_SYNC();
    float cs[8];
    {
        const f32x4 z0 = *(const LAS f32x4*)(lds + O_Z + (t * 68 + j0) * 4), z1 = *(const LAS f32x4*)(lds + O_Z + (t * 68 + j0 + 4) * 4);
        const f32x4 y0 = *(const LAS f32x4*)(lds + O_AZ + (t * 68 + j0) * 4), y1 = *(const LAS f32x4*)(lds + O_AZ + (t * 68 + j0 + 4) * 4);
        const float zz[8] = {z0.x, z0.y, z0.z, z0.w, z1.x, z1.y, z1.z, z1.w}, yy[8] = {y0.x, y0.y, y0.z, y0.w, y1.x, y1.y, y1.z, y1.w};
        const f32x4 w0a = *(const f32x4*)(P.in[I_W0] + hj), w0b = *(const f32x4*)(P.in[I_W0] + hj + 4), a0a = *(const f32x4*)(P.in[I_A0] + hj), a0b = *(const f32x4*)(P.in[I_A0] + hj + 4);
        const float w0[8] = {w0a.x, w0a.y, w0a.z, w0a.w, w0b.x, w0b.y, w0b.z, w0b.w}, a0[8] = {a0a.x, a0a.y, a0a.z, a0a.w, a0b.x, a0b.y, a0b.z, a0b.w};
#pragma unroll
        for (int i = 0; i < 8; ++i) { lw[i] = nulltok ? 0.f : -DSCALE * fast_sigmoid(w0[i] + zz[i]); av[i] = fast_sigmoid(a0[i] + yy[i]); cs[i] = lw[i]; }
#pragma unroll
        for (int d = 8; d < 64; d <<= 1) {
#pragma unroll
            for (int i = 0; i < 8; ++i) { const float o = __shfl_up(cs[i], d); cs[i] += (lane >= d) ? o : 0.f; }
        }
        if (lane >= 56) {
#pragma unroll
            for (int i = 0; i < 8; ++i) *(LAS float*)(lds + (wave < 4 ? O_BH : O_KH) + ((j0 + i) * LD64 + 64) * 2 + (wave & 3) * 4) = cs[i]; }
        shift8r(L.rc, L.rq, mu + C_R + hj, rv); shift8r(L.kc, L.kq, mu + C_K + hj, kv); shift8r(L.vc, L.vq, mu + C_V + hj, vv);
        if (nulltok) {
#pragma unroll
            for (int i = 0; i < 8; ++i) { rv[i] = 0.f; kv[i] = 0.f; vv[i] = 0.f; }
        }
        const f32x4 kka = *(const f32x4*)(P.in[I_KK] + hj), kkb = *(const f32x4*)(P.in[I_KK] + hj + 4), kaa = *(const f32x4*)(P.in[I_KA] + hj), kab = *(const f32x4*)(P.in[I_KA] + hj + 4);
        const f32x4 rka = *(const f32x4*)(P.in[I_RK] + hj), rkb = *(const f32x4*)(P.in[I_RK] + hj + 4);
        const float kkw[8] = {kka.x, kka.y, kka.z, kka.w, kkb.x, kkb.y, kkb.z, kkb.w}, kaw[8] = {kaa.x, kaa.y, kaa.z, kaa.w, kab.x, kab.y, kab.z, kab.w}, rkw[8] = {rka.x, rka.y, rka.z, rka.w, rkb.x, rkb.y, rkb.z, rkb.w};
        float n2 = 0.f, bon = 0.f;
#pragma unroll
        for (int i = 0; i < 8; ++i) { kk[i] = kv[i] * kkw[i]; n2 += kk[i] * kk[i]; km[i] = kv[i] * (1.0f + (av[i] - 1.0f) * kaw[i]); bon += rv[i] * km[i] * rkw[i]; }
        n2 += DPPF(n2, 0xB1); n2 += DPPF(n2, 0x4E); n2 += DPPF(n2, 0x141);
        bon += DPPF(bon, 0xB1); bon += DPPF(bon, 0x4E); bon += DPPF(bon, 0x141);
        const float inv = 1.0f / fmaxf(sqrtf(n2), 1e-12f);
#pragma unroll
        for (int i = 0; i < 8; ++i) kk[i] *= inv;
        if (!meta && jq == 0) ((float*)(ws + WS_BONUS))[(size_t)(b * SEQ + c * 64 + t) * 32 + h] = bon;
    }
    BLOCK_SYNC();
    {
        float Lc[8], Le[8];
#pragma unroll
        for (int i = 0; i < 8; ++i) { Lc[i] = cs[i]; Le[i] = 0.f; }
#pragma unroll
        for (int i = 0; i < 8; ++i) {
            const f32x4 wa = *(const LAS f32x4*)(lds + O_BH + ((j0 + i) * LD64 + 64) * 2), wb = *(const LAS f32x4*)(lds + O_KH + ((j0 + i) * LD64 + 64) * 2);
            const float ww[8] = {wa.x, wa.y, wa.z, wa.w, wb.x, wb.y, wb.z, wb.w};
#pragma unroll
            for (int w = 0; w < 8; ++w) { Le[i] += ww[w]; Lc[i] += (w < wave) ? ww[w] : 0.f; }
        }
        float Ab[8], Rb[8], Bh[8], Kh[8], Bt[8], Kt[8];
#pragma unroll
        for (int i = 0; i < 8; ++i) {
            const float eP = __expf(Lc[i] - lw[i]), eC = __expf(Lc[i]), eN = __expf(-Lc[i]), eE = __expf(Le[i] - Lc[i]);
            const float ka = kk[i] * av[i];
            Ab[i] = -kk[i] * eP; Rb[i] = rv[i] * eC; Bh[i] = ka * eN; Kh[i] = km[i] * eN; Bt[i] = ka * eE; Kt[i] = km[i] * eE;
        }
        *(LAS u32x4*)(lds + O_AB + (t * LD64 + j0) * 2) = pack8(Ab);
        *(LAS u32x4*)(lds + O_RB + (t * LD64 + j0) * 2) = pack8(Rb);
        *(LAS u32x4*)(lds + O_BH + (t * LD64 + j0) * 2) = pack8(Bh);
        *(LAS u32x4*)(lds + O_KH + (t * LD64 + j0) * 2) = pack8(Kh);
        *(LAS u32x4*)(lds + O_BTT + (t * LD64 + j0) * 2) = pack8(Bt);
        *(LAS u32x4*)(lds + O_KTT + (t * LD64 + j0) * 2) = pack8(Kt);
        *(LAS u32x4*)(lds + O_VT + (t * LD64 + j0) * 2) = pack8(vv);
        if (t == 63) {
#pragma unroll
            for (int i = 0; i < 8; ++i) *(LAS float*)(lds + O_RB + ((j0 + i) * LD64 + 64) * 2) = __expf(Le[i]);
        }
    }
    BLOCK_SYNC();
    }
    if (next_u >= 0) pl_load(P, next_u, L);
    SINGLE_TRIP {
    {
        bf16x8 abh[2], akh[2];
#pragma unroll
        for (int ks = 0; ks < 2; ++ks) { abh[ks] = ldsfrag(lds, O_BH, LD64, 16 * tm + fr, ks * 32 + fq * 8); akh[ks] = ldsfrag(lds, O_KH, LD64, 16 * tm + fr, ks * 32 + fq * 8); }
#pragma unroll
        for (int t2 = 0; t2 < 2; ++t2) {
            const int tt = 16 * (tn0 + t2) + fr, s0 = 16 * tm + 4 * fq;
            f32x4 mab = {0.f, 0.f, 0.f, 0.f}, mak = mab, mrb = mab, mrk = mab;
#pragma unroll
            for (int ks = 0; ks < 2; ++ks) {
                const bf16x8 bab = ldsfrag(lds, O_AB, LD64, tt, ks * 32 + fq * 8), brb = ldsfrag(lds, O_RB, LD64, tt, ks * 32 + fq * 8);
                mab = mfma16(abh[ks], bab, mab); mak = mfma16(akh[ks], bab, mak); mrb = mfma16(abh[ks], brb, mrb); mrk = mfma16(akh[ks], brb, mrk);
            }
            float vab[4] = {mab.x, mab.y, mab.z, mab.w}, vak[4] = {mak.x, mak.y, mak.z, mak.w}, vrb[4] = {mrb.x, mrb.y, mrb.z, mrb.w}, vrk[4] = {mrk.x, mrk.y, mrk.z, mrk.w}, vp[4];
#pragma unroll
            for (int r = 0; r < 4; ++r) { const int s = s0 + r; const bool st = s < tt, le = s <= tt;
                vab[r] = st ? vab[r] : 0.f; vak[r] = st ? vak[r] : 0.f; vrb[r] = le ? vrb[r] : 0.f; vrk[r] = le ? vrk[r] : 0.f; vp[r] = vab[r] + (s == tt ? 1.0f : 0.f); }
            st4(lds, O_M0, tt, s0, (f32x4){vab[0], vab[1], vab[2], vab[3]});
            st4(lds, O_PA, tt, s0, (f32x4){vp[0], vp[1], vp[2], vp[3]});
            st4(lds, O_MAK, tt, s0, (f32x4){vak[0], vak[1], vak[2], vak[3]});
            st4(lds, O_MRB, tt, s0, (f32x4){vrb[0], vrb[1], vrb[2], vrb[3]});
            st4(lds, O_MRK, tt, s0, (f32x4){vrk[0], vrk[1], vrk[2], vrk[3]});
        }
    }
    BLOCK_SYNC();
    dbl_step<false, true>(lds, O_M0, O_M0T, O_M1, O_M1T, 0, 0, tm, tn0, fr, fq); BLOCK_SYNC();
    dbl_step<true, true>(lds, O_M1, O_M1T, O_M0, O_M0T, O_PA, O_PB, tm, tn0, fr, fq); BLOCK_SYNC();
    dbl_step<true, true>(lds, O_M0, O_M0T, O_M1, O_M1T, O_PB, O_PA, tm, tn0, fr, fq); BLOCK_SYNC();
    dbl_step<true, true>(lds, O_M1, O_M1T, O_M0, O_M0T, O_PA, O_PB, tm, tn0, fr, fq); BLOCK_SYNC();
    if (!meta) {
    dbl_step<true, true>(lds, O_M0, O_M0T, O_M1, O_M1T, O_PB, O_PA, tm, tn0, fr, fq); BLOCK_SYNC();
    dbl_step<true, false>(lds, O_M1, O_M1T, 0, 0, O_PA, O_PB, tm, tn0, fr, fq); BLOCK_SYNC();
    }
    }
    const size_t ub = (size_t)u * 4096;
    SINGLE_TRIP {
    {
        bf16x8 aT[2], aMak[2];
#pragma unroll
        for (int ks = 0; ks < 2; ++ks) { aT[ks] = ldsfrag(lds, O_PB, LD64, 16 * tm + fr, ks * 32 + fq * 8); aMak[ks] = ldsfrag(lds, O_MAK, LD64, 16 * tm + fr, ks * 32 + fq * 8); }
#pragma unroll
        for (int t2 = 0; t2 < 2; ++t2) {
            const int n = 16 * (tn0 + t2) + fr, t0 = 16 * tm + 4 * fq;
            f32x4 at = {0.f, 0.f, 0.f, 0.f}, xt = at;
#pragma unroll
            for (int ks = 0; ks < 2; ++ks) { at = mfma16(aT[ks], ldsfragTR(lds, O_AB, 32 * ks, 16 * (tn0 + t2), 16 * fq + fr), at); xt = mfma16(aMak[ks], ldsfragTR(lds, O_VT, 32 * ks, 16 * (tn0 + t2), 16 * fq + fr), xt); }
            st4(lds, O_M0, n, t0, at); st4(lds, O_M0T, n, t0, xt);
        }
    }
    BLOCK_SYNC();
    {
        bf16x8 aT[2], aAt[2];
#pragma unroll
        for (int ks = 0; ks < 2; ++ks) { aT[ks] = ldsfrag(lds, O_PB, LD64, 16 * tm + fr, ks * 32 + fq * 8); aAt[ks] = ldsfrag(lds, O_M0, LD64, 16 * tm + fr, ks * 32 + fq * 8); }
        bf16_t* Rt = (bf16_t*)(ws + WS_RT) + ub; bf16_t* Gp = (bf16_t*)(ws + WS_G) + ub;
#pragma unroll
        for (int t2 = 0; t2 < 2; ++t2) {
            const int n = 16 * (tn0 + t2) + fr, m0 = 16 * tm + 4 * fq;
            f32x4 u0 = {0.f, 0.f, 0.f, 0.f}, rt = u0, g = u0;
#pragma unroll
            for (int ks = 0; ks < 2; ++ks) {
                u0 = mfma16(aT[ks], ldsfrag(lds, O_M0T, LD64, n, ks * 32 + fq * 8), u0);
                rt = mfma16(aAt[ks], ldsfrag(lds, O_MRB, LD64, n, ks * 32 + fq * 8), rt);
                g = mfma16(aAt[ks], ldsfragTR(lds, O_BTT, 32 * ks, 16 * (tn0 + t2), 16 * fq + fr), g);
            }
            st4(lds, O_M1, n, m0, u0);
            const u32x2 rw = *(const LAS u32x2*)(lds + O_RB + (n * LD64 + m0) * 2);
            rt.x += bflo(rw.x); rt.y += bfhi(rw.x); rt.z += bflo(rw.y); rt.w += bfhi(rw.y);
            { u32x2 w; w.x = pk2(rt.x, rt.y); w.y = pk2(rt.z, rt.w); *(u32x2*)(Rt + n * 64 + m0) = w; }
            if ((n >> 2) == (m0 >> 2)) { const float e = *(const LAS float*)(lds + O_RB + (n * LD64 + 64) * 2); const int r = n & 3;
                g.x += (r == 0) ? e : 0.f; g.y += (r == 1) ? e : 0.f; g.z += (r == 2) ? e : 0.f; g.w += (r == 3) ? e : 0.f; }
            { const int pos0 = 32 * (tm >> 1) + 8 * fq + 4 * (tm & 1); u32x2 w; w.x = pk2(g.x, g.y); w.y = pk2(g.z, g.w); *(u32x2*)(Gp + n * 64 + pos0) = w; }
        }
    }
    BLOCK_SYNC();
    {
        bf16x8 aB[2], aK[2], aU[2], aV[2];
#pragma unroll
        for (int ks = 0; ks < 2; ++ks) { const int row = 16 * tm + fr, ko = ks * 32 + fq * 8;
            aB[ks] = ldsfragTR(lds, O_BTT, 32 * ks, 16 * tm, 16 * fq + fr); aK[ks] = ldsfragTR(lds, O_KTT, 32 * ks, 16 * tm, 16 * fq + fr); aU[ks] = ldsfrag(lds, O_M1, LD64, row, ko); aV[ks] = ldsfragTR(lds, O_VT, 32 * ks, 16 * tm, 16 * fq + fr); }
        bf16_t* H0t = (bf16_t*)(ws + WS_H0T) + ub; bf16_t* Y0s = (bf16_t*)(ws + WS_Y0) + ub;
#pragma unroll
        for (int t2 = 0; t2 < 2; ++t2) {
            const int n = 16 * (tn0 + t2) + fr, m0 = 16 * tm + 4 * fq;
            f32x4 hh = {0.f, 0.f, 0.f, 0.f}, yy = hh;
#pragma unroll
            for (int ks = 0; ks < 2; ++ks) { const int ko = ks * 32 + fq * 8;
                const bf16x8 bU = ldsfrag(lds, O_M1, LD64, n, ko), bV = ldsfragTR(lds, O_VT, 32 * ks, 16 * (tn0 + t2), 16 * fq + fr), bRb = ldsfrag(lds, O_MRB, LD64, n, ko), bRk = ldsfrag(lds, O_MRK, LD64, n, ko);
                hh = mfma16(aB[ks], bU, hh); hh = mfma16(aK[ks], bV, hh);
                yy = mfma16(aU[ks], bRb, yy); yy = mfma16(aV[ks], bRk, yy); }
            { u32x2 w; w.x = pk2(hh.x, hh.y); w.y = pk2(hh.z, hh.w); *(u32x2*)(H0t + n * 64 + m0) = w; }
            { u32x2 w; w.x = pk2(yy.x, yy.y); w.y = pk2(yy.z, yy.w); *(u32x2*)(Y0s + n * 64 + m0) = w; }
        }
    }
    BLOCK_SYNC();
    }
}

constexpr int LDU = 264;
__device__ __forceinline__ void pool_load(const Params& P, int pu, u32x4 (&raw)[5]) {
    int tid = threadIdx.x; asm volatile("" : "+v"(tid));
    const bf16_t* pp = (const bf16_t*)(P.ws + WS_P);
    const int g = (pu < 256) ? (pu & 3) : 3 - (pu & 3), tt = pu >> 2, b = tt >> 6, ti0 = (tt & 63) * 64;
#pragma unroll
    for (int k = 0; k < 5; ++k) { const int idx = tid + 512 * k;
        if (idx < 79 * 32) { const int lr = idx >> 5, ch = idx & 31, ti = ti0 + lr - 15; const int row = ti >= 0 ? b * SEQ + ti : ROW_META + 16 + ti;
            raw[k] = *(const u32x4*)(pp + (size_t)row * NPAD + C_POOL + g * 256 + ch * 8); } }
}
__device__ __forceinline__ void pool_unit(const Params& P, ldsp lds, int pu, const u32x4 (&raw)[5]) {
    int tid = threadIdx.x; asm volatile("" : "+v"(tid));
    const int lane = tid & 63, wave = tid >> 6, fr = lane & 15, fq = lane >> 4;
    unsigned char* ws = P.ws;
    const bf16_t* pp = (const bf16_t*)(ws + WS_P);
    const int g = (pu < 256) ? (pu & 3) : 3 - (pu & 3), tt = pu >> 2, b = tt >> 6, ti0 = (tt & 63) * 64;
    constexpr int O_U = 0, O_PL = 79 * LDU * 2;
#pragma unroll
    for (int k = 0; k < 5; ++k) { const int idx = tid + 512 * k; if (idx < 79 * 32) *(LAS u32x4*)(lds + O_U + ((idx >> 5) * LDU + (idx & 31) * 8) * 2) = raw[k]; }
    BLOCK_SYNC();
    {
        const int c0 = (tid & 31) * 8, t0 = (tid >> 5) * 4, win = 2 << g; const float inv = 1.0f / (float)win;
        float s[8], nw[8];
        unpack8(*(const LAS u32x4*)(lds + O_U + ((15 + t0) * LDU + c0) * 2), nw);
#pragma unroll
        for (int i = 0; i < 8; ++i) s[i] = nw[i];
        for (int d = 1; d < win; ++d) { float x[8]; unpack8(*(const LAS u32x4*)(lds + O_U + ((15 + t0 - d) * LDU + c0) * 2), x);
#pragma unroll
            for (int i = 0; i < 8; ++i) s[i] += x[i]; }
#pragma unroll
        for (int k = 0; k < 4; ++k) {
            if (k > 0) { float od[8]; unpack8(*(const LAS u32x4*)(lds + O_U + ((15 + t0 + k) * LDU + c0) * 2), nw); unpack8(*(const LAS u32x4*)(lds + O_U + ((15 + t0 + k - win) * LDU + c0) * 2), od);
#pragma unroll
                for (int i = 0; i < 8; ++i) s[i] += nw[i] - od[i]; }
            float o[8];
#pragma unroll
            for (int i = 0; i < 8; ++i) o[i] = s[i] * inv - nw[i];
            *(LAS u32x4*)(lds + O_PL + ((t0 + k) * LDU + c0) * 2) = pack8(o);
        }
    }
    BLOCK_SYNC();
    {
        const bf16_t* wt = (const bf16_t*)(ws + WS_WTPOOL) + (size_t)g * 65536;
        f32x4 acc[2][4];
#pragma unroll
        for (int a = 0; a < 2; ++a)
#pragma unroll
            for (int n = 0; n < 4; ++n) acc[a][n] = (f32x4){0.f, 0.f, 0.f, 0.f};
#pragma unroll 4
        for (int ks = 0; ks < 8; ++ks) {
            bf16x8 af[2];
#pragma unroll
            for (int a = 0; a < 2; ++a) af[a] = *(const bf16x8*)(wt + (size_t)(32 * wave + 16 * a + fr) * 256 + ks * 32 + fq * 8);
#pragma unroll
            for (int n = 0; n < 4; ++n) { const bf16x8 bf = ldsfrag(lds, O_PL, LDU, 16 * n + fr, ks * 32 + fq * 8);
#pragma unroll
                for (int a = 0; a < 2; ++a) acc[a][n] = mfma16(af[a], bf, acc[a][n]); }
        }
        bf16_t* yb = (bf16_t*)(ws + WS_YAB) + 2048;
        const float* psc = P.in[I_PSCALE] + g * 256;
#pragma unroll
        for (int a = 0; a < 2; ++a) { const int d0 = 32 * wave + 16 * a + 4 * fq; const f32x4 sc = *(const f32x4*)(psc + d0);
#pragma unroll
            for (int n = 0; n < 4; ++n) { const int t = 16 * n + fr; const f32x4 o = acc[a][n] * sc;
                u32x2 w; w.x = pk2(o.x, o.y); w.y = pk2(o.z, o.w);
                *(u32x2*)(yb + (size_t)(b * SEQ + ti0 + t) * LDAB + g * 256 + d0) = w; } }
    }
    BLOCK_SYNC();
}
__device__ __forceinline__ void gsig_unit(const Params& P, int gu) {
    int tid = threadIdx.x; asm volatile("" : "+v"(tid));
    const bf16_t* pp = (const bf16_t*)(P.ws + WS_P); bf16_t* gs = (bf16_t*)(P.ws + WS_GSIG);
    const float* mu = P.in[I_MU];
#pragma unroll
    for (int it = 0; it < 4; ++it) {
        const int idx = tid + 512 * it, tl = idx >> 5, ch = idx & 31, col = C_GL + ch * 8;
        const int row = gu * 64 + tl; const int prow = ((row & (SEQ - 1)) == 0) ? (ROW_META + 15) : row - 1;
        float x[8]; shift8r(*(const u32x4*)(pp + (size_t)row * NPAD + col), *(const u32x4*)(pp + (size_t)prow * NPAD + col), mu + col, x);
#pragma unroll
        for (int i = 0; i < 8; ++i) x[i] = fast_sigmoid(x[i]);
        *(u32x4*)(gs + (size_t)row * 256 + ch * 8) = pack8(x);
    }
}
__device__ __forceinline__ void phase2(const Params& P, ldsp lds) {
    PL L;
    for (int j = blockIdx.x; j < 256 + 32 + 128; j += gridDim.x) {
        if (j < 256) {
            const int b = j >> 7, c = (j >> 1) & 63, h0 = (j & 1) * 16;
            pl_load(P, (b * 32 + h0) * 64 + c, L);
            for (int i = 0; i < 16; ++i) { const int u = (b * 32 + h0 + i) * 64 + c; rwkv_unit(P, lds, u, L, i + 1 < 16 ? u + 64 : -1, i == 0); }
        } else if (j < 288) { pl_load(P, 4096 + (j - 256), L); rwkv_unit(P, lds, 4096 + (j - 256), L, -1, true); }
        else gsig_unit(P, j - 288);
    }
}
__device__ __forceinline__ void phase3(const Params& P) {
    const int lane = threadIdx.x & 63, wave = threadIdx.x >> 6, fr = lane & 15, fq = lane >> 4;
    if (wave != 0) { convert_tables(P, blockIdx.x * 7 + (wave - 1), CONV_P3_END, gridDim.x * 7); return; }
    unsigned char* ws = P.ws;
    const bf16_t* Gp = (const bf16_t*)(ws + WS_G); const bf16_t* H0t = (const bf16_t*)(ws + WS_H0T); bf16_t* S0t = (bf16_t*)(ws + WS_S0T);
    for (int item = blockIdx.x; item < 256; item += gridDim.x) {
        const int bh = item >> 2, vq = item & 3, h = bh & 31;
        bf16x8 Sb[2];
#pragma unroll
        for (int ks = 0; ks < 2; ++ks)
#pragma unroll
            for (int i = 0; i < 8; ++i) Sb[ks][i] = 0;
        bf16x8 g0[4][2], g1[4][2], g2[4][2], g3[4][2]; u32x2 h0[4], h1[4], h2[4], h3[4];
        auto load = [&](int step, bf16x8 (&ga)[4][2], u32x2 (&hf)[4]) {
            const int u = (step == 0) ? (4096 + h) : (bh * 64 + step - 1);
            const bf16_t* g = Gp + (size_t)u * 4096; const bf16_t* hh = H0t + (size_t)u * 4096;
#pragma unroll
            for (int mt = 0; mt < 4; ++mt) {
#pragma unroll
                for (int ks = 0; ks < 2; ++ks) ga[mt][ks] = *(const bf16x8*)(g + (16 * mt + fr) * 64 + ks * 32 + fq * 8);
                hf[mt] = *(const u32x2*)(hh + (16 * vq + fr) * 64 + 16 * mt + 4 * fq);
            }
        };
        auto apply = [&](int step, const bf16x8 (&ga)[4][2], const u32x2 (&hf)[4]) {
            f32x4 acc[4];
#pragma unroll
            for (int mt = 0; mt < 4; ++mt) {
                acc[mt] = (f32x4){bflo(hf[mt].x), bfhi(hf[mt].x), bflo(hf[mt].y), bfhi(hf[mt].y)};
                acc[mt] = mfma16(ga[mt][0], Sb[0], acc[mt]);
                acc[mt] = mfma16(ga[mt][1], Sb[1], acc[mt]);
            }
            bf16_t* so = S0t + (size_t)(bh * 64 + step) * 4096 + (16 * vq + fr) * 64 + 4 * fq;
            u32x2 w[4];
#pragma unroll
            for (int mt = 0; mt < 4; ++mt) { w[mt].x = pk2(acc[mt].x, acc[mt].y); w[mt].y = pk2(acc[mt].z, acc[mt].w); *(u32x2*)(so + 16 * mt) = w[mt]; }
#pragma unroll
            for (int ks = 0; ks < 2; ++ks) {
                const u32x4 q4 = (u32x4){w[2 * ks].x, w[2 * ks].y, w[2 * ks + 1].x, w[2 * ks + 1].y};
                Sb[ks] = __builtin_bit_cast(bf16x8, q4);
            }
        };
        load(0, g0, h0); load(1, g1, h1); load(2, g2, h2);
#pragma unroll 1
        for (int step = 0; step < 64; step += 4) {
            load(step + 3, g3, h3); apply(step, g0, h0);
            if (step + 4 < 64) load(step + 4, g0, h0);
            apply(step + 1, g1, h1);
            if (step + 5 < 64) load(step + 5, g1, h1);
            apply(step + 2, g2, h2);
            if (step + 6 < 64) load(step + 6, g2, h2);
            apply(step + 3, g3, h3);
        }
    }
}

constexpr int LDG = 264;
__device__ __forceinline__ void phase3b(const Params& P, ldsp lds) {
    int tid = threadIdx.x; asm volatile("" : "+v"(tid));
    const int lane = tid & 63, wave = tid >> 6, fr = lane & 15, fq = lane >> 4, wq = wave & 3;
    unsigned char* ws = P.ws;
    const bf16_t* pp = (const bf16_t*)(ws + WS_P);
    const float* mu = P.in[I_MU];
    constexpr int O_G2 = 0, O_HP = 64 * LDG * 2;
    {
        u32x4 ra[5], rb[5]; int pu = blockIdx.x;
        if (pu < 512) pool_load(P, pu, ra);
        for (; pu < 512; pu += gridDim.x) {
            const int pn = pu + gridDim.x;
            if (pn < 512) pool_load(P, pn, rb);
            pool_unit(P, lds, pu, ra);
#pragma unroll
            for (int k = 0; k < 5; ++k) ra[k] = rb[k];
        }
    }
    for (int w = blockIdx.x; w < 256; w += gridDim.x) {
        const int h = w & 31;
        BLOCK_SYNC();
        for (int idx = tid; idx < 64 * 32; idx += 512) { const int row = idx >> 5, ch = idx & 31;
            *(LAS u32x4*)(lds + O_G2 + (row * LDG + ch * 8) * 2) = *(const u32x4*)((const bf16_t*)(ws + WS_WTG2) + (size_t)(h * 64 + row) * 256 + ch * 8); }
        if (tid < 48) { const int a = tid >> 4, q4 = tid & 15; const float* src = a == 0 ? P.in[I_GNG] + h * 64 : a == 1 ? P.in[I_GNB] + h * 64 : mu + C_V + h * 64;
            *(LAS f32x4*)(lds + O_HP + a * 256 + q4 * 16) = *(const f32x4*)(src + q4 * 4); }
        BLOCK_SYNC();
        bf16x8 bG[8], bR[2], aS[4][2]; u32x2 yw[4], vc[4], vp[4]; float bon;
        auto unit_of = [&](int it, int& b, int& c) { const int q = (w >> 5) + 8 * (2 * it + (wave >> 2)); b = q >> 6; c = q & 63; };
        auto issue = [&](int it) {
            int b, c; unit_of(it, b, c); const int u = (b * 32 + h) * 64 + c, trow0 = b * SEQ + c * 64 + 16 * wq;
            const size_t ub = (size_t)u * 4096;
            const bf16_t* S0t = (const bf16_t*)(ws + WS_S0T) + ub; const bf16_t* Rt = (const bf16_t*)(ws + WS_RT) + ub; const bf16_t* Y0s = (const bf16_t*)(ws + WS_Y0) + ub;
            const int row = trow0 + fr; const int prow = (c == 0 && wq == 0 && fr == 0) ? (ROW_META + 15) : row - 1;
            const bf16_t* gsr = (const bf16_t*)(ws + WS_GSIG) + (size_t)row * 256 + fq * 8;
#pragma unroll
            for (int ks = 0; ks < 8; ++ks) bG[ks] = *(const bf16x8*)(gsr + ks * 32);
#pragma unroll
            for (int ks = 0; ks < 2; ++ks) bR[ks] = *(const bf16x8*)(Rt + (16 * wq + fr) * 64 + ks * 32 + fq * 8);
#pragma unroll
            for (int mt = 0; mt < 4; ++mt) {
                yw[mt] = *(const u32x2*)(Y0s + (16 * wq + fr) * 64 + 16 * mt + 4 * fq);
#pragma unroll
                for (int ks = 0; ks < 2; ++ks) aS[mt][ks] = *(const bf16x8*)(S0t + (16 * mt + fr) * 64 + ks * 32 + fq * 8);
                const int hc = h * 64 + 16 * mt + 4 * fq;
                vc[mt] = *(const u32x2*)(pp + (size_t)row * NPAD + C_V + hc); vp[mt] = *(const u32x2*)(pp + (size_t)prow * NPAD + C_V + hc);
            }
            bon = ((const float*)(ws + WS_BONUS))[(size_t)row * 32 + h];
        };
        issue(0);
#pragma unroll 1
        for (int it = 0; it < 8; ++it) {
            const int crow = CONV_P3_END + (w * 8 + it) * 8 + wave; f32x4 tv[8];
            if (crow < 32768) convert_ld(P, crow, lane, tv);
            int b, c; unit_of(it, b, c);
            const int row = b * SEQ + c * 64 + 16 * wq + fr;
            f32x4 gacc[4];
#pragma unroll
            for (int mt = 0; mt < 4; ++mt) gacc[mt] = (f32x4){0.f, 0.f, 0.f, 0.f};
#pragma unroll
            for (int ks = 0; ks < 8; ++ks)
#pragma unroll
                for (int mt = 0; mt < 4; ++mt) gacc[mt] = mfma16(*(const LAS bf16x8*)(lds + O_G2 + ((16 * mt + fr) * LDG + ks * 32 + fq * 8) * 2), bG[ks], gacc[mt]);
            f32x4 y[4], vv[4]; const float bonc = bon;
#pragma unroll
            for (int mt = 0; mt < 4; ++mt) {
                y[mt] = (f32x4){bflo(yw[mt].x), bfhi(yw[mt].x), bflo(yw[mt].y), bfhi(yw[mt].y)};
#pragma unroll
                for (int ks = 0; ks < 2; ++ks) y[mt] = mfma16(aS[mt][ks], bR[ks], y[mt]);
                const f32x4 mv = *(const LAS f32x4*)(lds + O_HP + 512 + (16 * mt + 4 * fq) * 4);
                const f32x4 cv = (f32x4){bflo(vc[mt].x), bfhi(vc[mt].x), bflo(vc[mt].y), bfhi(vc[mt].y)}, pv = (f32x4){bflo(vp[mt].x), bfhi(vp[mt].x), bflo(vp[mt].y), bfhi(vp[mt].y)};
                vv[mt] = cv + (pv - cv) * mv;
            }
#pragma unroll
            for (int mt = 0; mt < 4; ++mt) asm volatile("" : "+v"(y[mt]), "+v"(vv[mt]), "+v"(gacc[mt]));
            if (it + 1 < 8) issue(it + 1);
            float s = 0.f;
#pragma unroll
            for (int mt = 0; mt < 4; ++mt) s += (y[mt].x + y[mt].y) + (y[mt].z + y[mt].w);
            s += __shfl_xor(s, 16); s += __shfl_xor(s, 32);
            const float mean = s * (1.0f / 64.0f); float qq = 0.f;
#pragma unroll
            for (int mt = 0; mt < 4; ++mt) { y[mt] = y[mt] - mean; qq += (y[mt].x * y[mt].x + y[mt].y * y[mt].y) + (y[mt].z * y[mt].z + y[mt].w * y[mt].w); }
            qq += __shfl_xor(qq, 16); qq += __shfl_xor(qq, 32);
            const float rstd = 1.0f / sqrtf(qq * (1.0f / 64.0f) + GN_EPS);
            bf16_t* ya = (bf16_t*)(ws + WS_YAB) + (size_t)row * LDAB + h * 64;
#pragma unroll
            for (int mt = 0; mt < 4; ++mt) {
                const int i0 = 16 * mt + 4 * fq, hc = h * 64 + i0;
                const f32x4 gg = *(const LAS f32x4*)(lds + O_HP + i0 * 4), gb = *(const LAS f32x4*)(lds + O_HP + 256 + i0 * 4);
                const f32x4 o = (y[mt] * rstd * gg + gb + vv[mt] * bonc) * gacc[mt];
                u32x2 wv; wv.x = pk2(o.x, o.y); wv.y = pk2(o.z, o.w);
                *(u32x2*)(ya + i0) = wv;
            }
            if (crow < 32768) convert_row(ws, crow, lane, tv);
        }
    }
}
__device__ __forceinline__ u32x6 ld_row6(const unsigned char* p) { const u32x2 a = ((const u32x2*)p)[0], b = ((const u32x2*)p)[1], c = ((const u32x2*)p)[2]; return (u32x6){a.x, a.y, b.x, b.y, c.x, c.y}; }
__device__ __forceinline__ void peer_load_x(const Params& P, ldsp lds, int o_par, int tok, int lo, float (&x)[32]) {
    unsigned char* ws = P.ws;
    const bf16_t* hr = (const bf16_t*)(ws + WS_X1B) + (size_t)tok * D + lo * 4;
#pragma unroll
    for (int j = 0; j < 8; ++j) { const u32x2 w = *(const u32x2*)(hr + 256 * j); x[4 * j] = bflo(w.x); x[4 * j + 1] = bfhi(w.x); x[4 * j + 2] = bflo(w.y); x[4 * j + 3] = bfhi(w.y); }
    const float* st = (const float*)(ws + WS_STAT);
    const float mean1 = st[tok] * (1.0f / D), rstd1 = 1.0f / sqrtf(fmaxf(st[8192 + tok] * (1.0f / D) - mean1 * mean1, 0.f) + LN_EPS);
#pragma unroll
    for (int c = 0; c < 8; ++c) { const f32x4 g1 = *(const LAS f32x4*)(lds + o_par + (lo * 4 + 256 * c) * 4), b1 = *(const LAS f32x4*)(lds + o_par + 8192 + (lo * 4 + 256 * c) * 4);
        x[4 * c] = (x[4 * c] - mean1) * rstd1 * g1.x + b1.x; x[4 * c + 1] = (x[4 * c + 1] - mean1) * rstd1 * g1.y + b1.y; x[4 * c + 2] = (x[4 * c + 2] - mean1) * rstd1 * g1.z + b1.z; x[4 * c + 3] = (x[4 * c + 3] - mean1) * rstd1 * g1.w + b1.w; }
}
__device__ __forceinline__ void peer_finish(const Params& P, ldsp lds, int o_par, int tok, int lo, float (&o)[32]) {
    float x[32]; peer_load_x(P, lds, o_par, tok, lo, x);
    float s = 0.f;
#pragma unroll
    for (int i = 0; i < 32; ++i) { o[i] += DN_ALPHA * x[i]; s += o[i]; }
    const float mean = wave_sum_dpp(s) * (1.0f / D); float q = 0.f;
#pragma unroll
    for (int i = 0; i < 32; ++i) { o[i] -= mean; q += o[i] * o[i]; }
    const float rstd = 1.0f / sqrtf(wave_sum_dpp(q) * (1.0f / D) + LN_EPS);
    float* orow = P.out + (size_t)tok * D;
#pragma unroll
    for (int c = 0; c < 8; ++c) {
        const int off = lo * 4 + 256 * c;
        const f32x4 g0 = *(const LAS f32x4*)(lds + o_par + 16384 + off * 4), b0 = *(const LAS f32x4*)(lds + o_par + 24576 + off * 4);
        f32x4 r0;
        r0.x = o[4 * c + 0] * rstd * g0.x + b0.x; r0.y = o[4 * c + 1] * rstd * g0.y + b0.y; r0.z = o[4 * c + 2] * rstd * g0.z + b0.z; r0.w = o[4 * c + 3] * rstd * g0.w + b0.w;
        *(f32x4*)(orow + off) = r0;
    }
}
__device__ __forceinline__ float peer_dot(const u32x4 uu, const unsigned (&xd0)[4], const unsigned (&xd1)[4]) {
    int a0 = 0, a1 = 0; const unsigned ww[4] = {uu.x, uu.y, uu.z, uu.w};
#pragma unroll
    for (int q4 = 0; q4 < 4; ++q4) { a0 = __builtin_amdgcn_sdot8((int)ww[q4], (int)xd0[q4], a0, false); a1 = __builtin_amdgcn_sdot8((int)ww[q4], (int)xd1[q4], a1, false); }
    return (float)(a0 + (a1 << 4));
}
__device__ __forceinline__ void peer_axpy(const u32x4 vv, float a, float (&o)[32]) {
    const f32x2 a2 = {a, a}; const unsigned ww[4] = {vv.x, vv.y, vv.z, vv.w};
#pragma unroll
    for (int q4 = 0; q4 < 4; ++q4) {
        const f32x2 r0 = __builtin_amdgcn_cvt_scalef32_pk_f32_fp4(ww[q4], 1.0f, 0), r1 = __builtin_amdgcn_cvt_scalef32_pk_f32_fp4(ww[q4], 1.0f, 1), r2 = __builtin_amdgcn_cvt_scalef32_pk_f32_fp4(ww[q4], 1.0f, 2), r3 = __builtin_amdgcn_cvt_scalef32_pk_f32_fp4(ww[q4], 1.0f, 3);
        f32x2 t;
        t = __builtin_elementwise_fma(a2, r0, (f32x2){o[8 * q4], o[8 * q4 + 1]}); o[8 * q4] = t.x; o[8 * q4 + 1] = t.y;
        t = __builtin_elementwise_fma(a2, r1, (f32x2){o[8 * q4 + 2], o[8 * q4 + 3]}); o[8 * q4 + 2] = t.x; o[8 * q4 + 3] = t.y;
        t = __builtin_elementwise_fma(a2, r2, (f32x2){o[8 * q4 + 4], o[8 * q4 + 5]}); o[8 * q4 + 4] = t.x; o[8 * q4 + 5] = t.y;
        t = __builtin_elementwise_fma(a2, r3, (f32x2){o[8 * q4 + 6], o[8 * q4 + 7]}); o[8 * q4 + 6] = t.x; o[8 * q4 + 7] = t.y; }
}
__device__ __forceinline__ void peer_round(const Params& P, ldsp lds, int o_ex, int o_gt, int o_list, int o_par, int tok, int tl) {
    int lo = threadIdx.x & 63; asm volatile("" : "+v"(lo));
    const int wave = threadIdx.x >> 6;
    unsigned char* ws = P.ws;
    const unsigned char* Ub = ws + WS_UB; const unsigned char* Vb = ws + WS_VB;
    const float* tsc = (const float*)(ws + WS_TSC);
    float o[32]; unsigned xd0[4], xd1[4]; float sxi;
    {
        float x[32]; peer_load_x(P, lds, o_par, tok, lo, x);
        float ax = 0.f;
#pragma unroll
        for (int i = 0; i < 32; ++i) ax = fmaxf(ax, fabsf(x[i]));
        ax = wave_max_dpp(ax);
        const float sx = ax > 0.f ? 119.0f / ax : 0.f; sxi = ax * (1.0f / 119.0f);
#pragma unroll
        for (int jw = 0; jw < 4; ++jw) { unsigned w0 = 0, w1 = 0;
#pragma unroll
            for (int i = 0; i < 8; ++i) { const unsigned b = __float_as_uint(fmaf(x[8 * jw + i], sx, 12582912.0f));
                w0 = __builtin_amdgcn_alignbit(b, w0, 4); w1 = __builtin_amdgcn_alignbit((b + 8u) >> 4, w1, 4); }
            xd0[jw] = w0; xd1[jw] = w1; }
    }
#pragma unroll
    for (int i = 0; i < 32; ++i) o[i] = 0.f;
    const LAS int* ex = (const LAS int*)(lds + o_ex) + tl * 128; const LAS float* gt = (const LAS float*)(lds + o_gt) + tl * 128;
    const int el = ex[lo], eh = ex[64 + lo];
    const float sul = tsc[el] * sxi, suh = tsc[eh] * sxi;
    const float gvl = gt[lo] * tsc[16384 + el], gvh = gt[64 + lo] * tsc[16384 + eh];
    LAS unsigned* lE = (LAS unsigned*)(lds + o_list) + wave * 384; LAS float* lS = (LAS float*)(lE + 128); LAS float* lG = (LAS float*)(lE + 256);
    {
        const int sl = el >> 10, sh = eh >> 10; int base = 0, pl = 0, ph = 0;
#define LT_COUNT(m) ((int)__builtin_amdgcn_mbcnt_hi((unsigned)((m) >> 32), __builtin_amdgcn_mbcnt_lo((unsigned)(m), 0u)))
#pragma unroll
        for (int s = 0; s < 16; ++s) {
            const unsigned long long ml = __ballot(sl == s), mh = __ballot(sh == s);
            const int cl = __popcll(ml);
            pl = (sl == s) ? base + LT_COUNT(ml) : pl; ph = (sh == s) ? base + cl + LT_COUNT(mh) : ph;
            base += cl + __popcll(mh);
        }
#undef LT_COUNT
        lE[pl] = (unsigned)el; lS[pl] = sul; lG[pl] = gvl; lE[ph] = (unsigned)eh; lS[ph] = suh; lG[ph] = gvh;
        asm volatile("s_waitcnt lgkmcnt(0)" ::: "memory");
    }
    u32x4 ua[4], ub[4]; u32x4 va[4], vb[4];
    auto issue = [&](int gi, u32x4 (&uu)[4], u32x4 (&vv)[4]) {
        const u32x4 e4 = *(const LAS u32x4*)(lE + 4 * gi);
        const unsigned ee[4] = {(unsigned)__builtin_amdgcn_readfirstlane((int)e4.x), (unsigned)__builtin_amdgcn_readfirstlane((int)e4.y), (unsigned)__builtin_amdgcn_readfirstlane((int)e4.z), (unsigned)__builtin_amdgcn_readfirstlane((int)e4.w)};
#pragma unroll
        for (int j = 0; j < 4; ++j) { uu[j] = *(const u32x4*)(Vb + (size_t)ee[j] * EROW + lo * 16); vv[j] = *(const u32x4*)(Vb + (size_t)ee[j] * EROW + 1024 + lo * 16); }
    };
    auto consume = [&](int gi, const u32x4 (&uu)[4], const u32x4 (&vv)[4]) {
        float dd[4];
#pragma unroll
        for (int j = 0; j < 4; ++j) dd[j] = peer_dot(uu[j], xd0, xd1);
        const bool b0 = (lo & 1) != 0, b1 = (lo & 2) != 0;
        const float r01 = (b0 ? dd[1] : dd[0]) + DPPF(b0 ? dd[0] : dd[1], 0xB1), r23 = (b0 ? dd[3] : dd[2]) + DPPF(b0 ? dd[2] : dd[3], 0xB1);
        float r = (b1 ? r23 : r01) + DPPF(b1 ? r01 : r23, 0x4E);
        r += DPPF(r, 0x124); r += DPPF(r, 0x128);
        { auto sw = __builtin_amdgcn_permlane16_swap(__float_as_uint(r), __float_as_uint(r), false, false); r = __uint_as_float(sw[0]) + __uint_as_float(sw[1]); }
        { auto sw = __builtin_amdgcn_permlane32_swap(__float_as_uint(r), __float_as_uint(r), false, false); r = __uint_as_float(sw[0]) + __uint_as_float(sw[1]); }
        const float su = lS[4 * gi + (lo & 3)], gv = lG[4 * gi + (lo & 3)];
        const float hh = r * su;
        const float a = pg8::gelu_pk((pg8::f32x2){hh, hh}).x * gv;
        peer_axpy(vv[0], DPPF(a, 0x00), o); peer_axpy(vv[1], DPPF(a, 0x55), o); peer_axpy(vv[2], DPPF(a, 0xAA), o); peer_axpy(vv[3], DPPF(a, 0xFF), o);
    };
    issue(0, ua, va);
#pragma unroll 1
    for (int gi = 0; gi < 30; gi += 2) {
        issue(gi + 1, ub, vb);
        consume(gi, ua, va);
        issue(gi + 2, ua, va);
        consume(gi + 1, ub, vb);
        if ((gi & 6) == 6) BLOCK_SYNC();
    }
    issue(31, ub, vb);
    consume(30, ua, va);
    consume(31, ub, vb);
    BLOCK_SYNC();
    peer_finish(P, lds, o_par, tok, lo, o);
}
#define CE_DESC(a, b) do { const float h_ = fmaxf((a), (b)), l_ = fminf((a), (b)); (a) = h_; (b) = l_; } while (0)
template <int N> __device__ __forceinline__ void bitonic_sort_desc(float (&v)[N]) {
#pragma unroll
    for (int k = 2; k <= N; k <<= 1)
#pragma unroll
        for (int j = k >> 1; j > 0; j >>= 1)
#pragma unroll
            for (int i = 0; i < N; ++i) { const int l = i ^ j; if (l > i) { if ((i & k) == 0) CE_DESC(v[i], v[l]); else CE_DESC(v[l], v[i]); } }
}
template <int N> __device__ __forceinline__ void bitonic_merge_desc(float (&v)[N]) {
#pragma unroll
    for (int j = N >> 1; j > 0; j >>= 1)
#pragma unroll
        for (int i = 0; i < N; ++i) { const int l = i ^ j; if (l > i) CE_DESC(v[i], v[l]); }
}
__device__ __forceinline__ void top16_merge(float (&a)[16], const float (&brev)[16]) {
#pragma unroll
    for (int i = 0; i < 16; ++i) a[i] = fmaxf(a[i], brev[i]);
    bitonic_merge_desc<16>(a);
}
__device__ __forceinline__ float embed_bits(float v, unsigned code, unsigned mask) { return __uint_as_float((__float_as_uint(v) & ~mask) | code); }

__device__ __forceinline__ void phase7(const Params& P, ldsp lds) {
    const int tid0 = threadIdx.x;
    unsigned char* ws = P.ws;
    const bf16_t* qb = (const bf16_t*)(ws + WS_Q); const bf16_t* sk = (const bf16_t*)(ws + WS_SUBK);
    constexpr int LDSK = 136, O_SK = 0, O_SV = 2 * 128 * LDSK * 2, O_EX = O_SV + 32768, O_GT = O_EX + 16384, O_LIST = O_GT + 16384;
    static_assert(O_LIST + 8 * 384 * 4 <= LDS_BYTES - 16, "lds");
    int titer = 0;
    for (int tile = blockIdx.x; tile < 256; tile += gridDim.x, ++titer) {
        int tid = tid0; asm volatile("" : "+v"(tid));
        const int lane = tid & 63, wave = tid >> 6, fr = lane & 15, fq = lane >> 4, fro = fr, fqo = fq;
        const int tok0 = tile * 32, h = wave;
        bf16x8 qn[4];
        auto ldq = [&](int cb) { const bf16_t* qrow = qb + (size_t)(tok0 + 16 * (cb >> 1) + fro) * D + h * 256 + (cb & 1) * 128 + fqo * 8;
#pragma unroll
            for (int ks = 0; ks < 4; ++ks) qn[ks] = *(const bf16x8*)(qrow + ks * 32); };
        ldq(0);
        for (int idx = tid; idx < 2 * 128 * 16; idx += 512) { const int row = idx >> 4, ch = idx & 15;
            *(LAS u32x4*)(lds + O_SK + (row * LDSK + ch * 8) * 2) = *(const u32x4*)(sk + row * 128 + ch * 8); }
        BLOCK_SYNC();
#pragma unroll 1
        for (int cb = 0; cb < 4; ++cb) {
            const int nt = cb >> 1, p = cb & 1;
            f32x4 acc[8];
#pragma unroll
            for (int mt = 0; mt < 8; ++mt) acc[mt] = (f32x4){0.f, 0.f, 0.f, 0.f};
            bf16x8 qc[4];
#pragma unroll
            for (int ks = 0; ks < 4; ++ks) qc[ks] = qn[ks];
            if (cb + 1 < 4) ldq(cb + 1);
#pragma unroll
            for (int ks = 0; ks < 4; ++ks) {
                const bf16x8 bq = qc[ks];
#pragma unroll
                for (int mt = 0; mt < 8; ++mt) acc[mt] = mfma16(*(const LAS bf16x8*)(lds + O_SK + ((p * 128 + 16 * mt + fro) * LDSK + ks * 32 + fqo * 8) * 2), bq, acc[mt]);
            }
            float a[16], b[16];
#pragma unroll
            for (int mt = 0; mt < 4; ++mt) {
                a[4 * mt + 0] = embed_bits(acc[mt].x, 16 * mt + 4 * fq + 0, 127u); a[4 * mt + 1] = embed_bits(acc[mt].y, 16 * mt + 4 * fq + 1, 127u);
                a[4 * mt + 2] = embed_bits(acc[mt].z, 16 * mt + 4 * fq + 2, 127u); a[4 * mt + 3] = embed_bits(acc[mt].w, 16 * mt + 4 * fq + 3, 127u);
                b[4 * mt + 0] = embed_bits(acc[mt + 4].x, 16 * (mt + 4) + 4 * fq + 0, 127u); b[4 * mt + 1] = embed_bits(acc[mt + 4].y, 16 * (mt + 4) + 4 * fq + 1, 127u);
                b[4 * mt + 2] = embed_bits(acc[mt + 4].z, 16 * (mt + 4) + 4 * fq + 2, 127u); b[4 * mt + 3] = embed_bits(acc[mt + 4].w, 16 * (mt + 4) + 4 * fq + 3, 127u);
            }
            bitonic_sort_desc<16>(a); bitonic_sort_desc<16>(b);
            { float br[16];
#pragma unroll
              for (int i = 0; i < 16; ++i) br[i] = b[15 - i];
              top16_merge(a, br); }
#pragma unroll
            for (int x = 16; x <= 32; x <<= 1) { float br[16];
#pragma unroll
                for (int i = 0; i < 16; ++i) br[i] = __shfl_xor(a[15 - i], x);
                top16_merge(a, br); }
            if (fq == 0) { LAS f32x4* o = (LAS f32x4*)(lds + O_SV + ((((16 * nt + fr) * 8 + h) * 2 + p) * 16) * 4);
                o[0] = (f32x4){a[0], a[1], a[2], a[3]}; o[1] = (f32x4){a[4], a[5], a[6], a[7]}; o[2] = (f32x4){a[8], a[9], a[10], a[11]}; o[3] = (f32x4){a[12], a[13], a[14], a[15]}; }
        }
        BLOCK_SYNC();
        if (tid < 256) {
            const int tok = tid >> 3, hh = tid & 7;
            const LAS f32x4* s = (const LAS f32x4*)(lds + O_SV + (((tok * 8 + hh) * 2) * 16) * 4);
            float s0[16], s1[16];
#pragma unroll
            for (int c4 = 0; c4 < 4; ++c4) { const f32x4 x = s[c4], y = s[4 + c4]; s0[4 * c4] = x.x; s0[4 * c4 + 1] = x.y; s0[4 * c4 + 2] = x.z; s0[4 * c4 + 3] = x.w; s1[4 * c4] = y.x; s1[4 * c4 + 1] = y.y; s1[4 * c4 + 2] = y.z; s1[4 * c4 + 3] = y.w; }
            float g0[16], g1[16], g2[16], g3[16];
            const float NEG = -3.0e38f;
#pragma unroll
            for (int bq = 0; bq < 16; ++bq) g0[bq] = embed_bits(s0[0] + s1[bq], bq, 255u);
            {
                int n1 = 0, n2 = 0, n3 = 0;
#pragma unroll
                for (int aa = 1; aa < 16; ++aa)
#pragma unroll
                    for (int bb = 0; bb < 16; ++bb) if ((aa + 1) * (bb + 1) <= 16) {
                        const float c = embed_bits(s0[aa] + s1[bb], aa * 16 + bb, 255u);
                        if (n1 < 16) g1[n1++] = c; else if (n2 < 16) g2[n2++] = c; else g3[n3++] = c;
                    }
#pragma unroll
                for (int i = 0; i < 16; ++i) if (i >= n3) g3[i] = NEG;
            }
            bitonic_sort_desc<16>(g1); bitonic_sort_desc<16>(g2); bitonic_sort_desc<16>(g3);
            { float r1[16], r3[16];
#pragma unroll
              for (int i = 0; i < 16; ++i) { r1[i] = g1[15 - i]; r3[i] = g3[15 - i]; }
              top16_merge(g0, r1); top16_merge(g2, r3);
#pragma unroll
              for (int i = 0; i < 16; ++i) g0[i] = fmaxf(g0[i], g2[15 - i]); }
            float mx = g0[0];
#pragma unroll
            for (int i = 1; i < 16; ++i) mx = fmaxf(mx, g0[i]);
            float ex[16], sm = 0.f; int ee[16];
#pragma unroll
            for (int i = 0; i < 16; ++i) {
                ex[i] = __expf(g0[i] - mx); sm += ex[i];
                const unsigned code = __float_as_uint(g0[i]) & 255u;
                const unsigned i0 = __float_as_uint(*(const LAS float*)(lds + O_SV + ((((tok * 8 + hh) * 2 + 0) * 16) + (code >> 4)) * 4)) & 127u;
                const unsigned i1 = __float_as_uint(*(const LAS float*)(lds + O_SV + ((((tok * 8 + hh) * 2 + 1) * 16) + (code & 15u)) * 4)) & 127u;
                ee[i] = (int)(i0 * 128u + i1);
            }
            const float inv = 1.0f / sm;
            LAS int* eo = (LAS int*)(lds + O_EX) + tok * 128 + hh * 16; LAS float* go = (LAS float*)(lds + O_GT) + tok * 128 + hh * 16;
#pragma unroll
            for (int c4 = 0; c4 < 4; ++c4) {
                *(LAS u32x4*)(eo + 4 * c4) = (u32x4){(unsigned)ee[4 * c4], (unsigned)ee[4 * c4 + 1], (unsigned)ee[4 * c4 + 2], (unsigned)ee[4 * c4 + 3]};
                *(LAS f32x4*)(go + 4 * c4) = (f32x4){ex[4 * c4] * inv, ex[4 * c4 + 1] * inv, ex[4 * c4 + 2] * inv, ex[4 * c4 + 3] * inv};
            }
        }
        BLOCK_SYNC();
        for (int idx = tid; idx < 2048; idx += 512) { const int a = idx >> 9, q4 = idx & 511; const float* src = P.in[a == 0 ? I_LN1G : a == 1 ? I_LN1B : a == 2 ? I_LN2G : I_LN2B];
            *(LAS f32x4*)(lds + O_SK + a * 8192 + q4 * 16) = *(const f32x4*)(src + q4 * 4); }
        BLOCK_SYNC();
#pragma unroll 1
        for (int r = 0; r < 4; ++r) {
            peer_round(P, lds, O_EX, O_GT, O_LIST, O_SK, tok0 + r * 8 + wave, r * 8 + wave);
        }
        BLOCK_SYNC();
    }
}
__global__ __launch_bounds__(512, 2) void hybrid_fwd(Params P) {
    extern __shared__ __attribute__((aligned(16))) unsigned char shm[];
    ldsp lds = (ldsp)shm;
    unsigned char* ws = P.ws;
    volatile LAS unsigned* xst = (volatile LAS unsigned*)(lds + LDS_BYTES - 16);
    if (threadIdx.x == 0) { xst[0] = 0u; xst[1] = 0u; }
    __syncthreads();
    const XcdBarrier xbar = xcd_barrier_post((unsigned*)(ws + WS_BAR), xst);
    const int lo = P.ph_lo, hi = P.ph_hi;
#ifdef REPEAT_PHASE
#define PHASE(k) if (lo <= (k) && (k) < hi) for (int once_ = 0; once_ < ((k) == REPEAT_PHASE ? 2 : 1); ++once_)
#else
#define PHASE(k) if (lo <= (k) && (k) < hi) for (int once_ = 0; once_ < 1; ++once_)
#endif
#ifdef DOUBLE_SEAMS
#define SEAM(k) do { if (lo <= (k) && (k) + 1 < hi) { xcd_barrier(xbar); xcd_barrier(xbar); } } while (0)
#else
#define SEAM(k) do { if (lo <= (k) && (k) + 1 < hi) xcd_barrier(xbar); } while (0)
#endif
#if defined(REPEAT_PHASE) && REPEAT_PHASE == 0
    PHASE(0) { Params Q = P; if (once_) Q.ph_lo = -1; phase0(Q); }
#else
    PHASE(0) phase0(P);
#endif
    SEAM(0);
    PHASE(1) { pg8::EpiBf16<0> E; E.O = (bf16_t*)(ws + WS_P); E.ldc = NPAD; E.bias = nullptr; E.split_cols = 0; E.split_stride = 0;
        run_gemm(lds, (const bf16_t*)(ws + WS_H0B), (const bf16_t*)(ws + WS_WTIN), MROWS, N_BF, 2048, E);
        const int G = (int)gridDim.x, r1 = ((MROWS / 256) * (N_BF / 256)) % G;
        pg8::EpiBf16S E8; E8.O = (bf16_t*)(ws + WS_P) + N_BF; E8.ldc = NPAD; E8.scale = 1.0f / 64.0f;
        run_gemm8(lds, ws + WS_H0B8, ws + WS_WT8, MROWS, N_F8, 2048, E8, (int)((blockIdx.x + G - r1) % G)); }
    SEAM(1);
    PHASE(2) phase2(P, lds);
    SEAM(2);
    PHASE(3) phase3(P);
    SEAM(3);
    PHASE(4) phase3b(P, lds);
    SEAM(4);
    PHASE(5) {
        { pg8::EpiGate35 E; E.O = (bf16_t*)(ws + WS_MERGED); E.p = (const bf16_t*)(ws + WS_P); E.bgate = P.in[I_BGATE];
          run_gemm(lds, (const bf16_t*)(ws + WS_YAB), (const bf16_t*)(ws + WS_WTAB), NTOK, 2048, LDAB, E); }
    }
#if defined(DUP_PHASE) && DUP_PHASE == 5
    SEAM(4);
    PHASE(5) {
        { pg8::EpiGate35 E; E.O = (bf16_t*)(ws + WS_MERGED); E.p = (const bf16_t*)(ws + WS_P); E.bgate = P.in[I_BGATE];
          run_gemm(lds, (const bf16_t*)(ws + WS_YAB), (const bf16_t*)(ws + WS_WTAB), NTOK, 2048, LDAB, E); }
    }
#endif
    SEAM(5);
    PHASE(6) { pg8::EpiResidStats E; E.O = (bf16_t*)(ws + WS_X1B); E.h0 = (const bf16_t*)(ws + WS_H0B); E.alpha = DN_ALPHA; E.rsum = (float*)(ws + WS_STAT); E.rsq = (float*)(ws + WS_STAT) + 8192;
        run_gemm(lds, (const bf16_t*)(ws + WS_MERGED), (const bf16_t*)(ws + WS_WTOUT), NTOK, 2048, 2048, E); }
#if defined(DUP_PHASE) && DUP_PHASE == 6
    SEAM(5);
    PHASE(6) { pg8::EpiResidStats E; E.O = (bf16_t*)(ws + WS_X1B); E.h0 = (const bf16_t*)(ws + WS_H0B); E.alpha = DN_ALPHA; E.rsum = (float*)(ws + WS_END); E.rsq = (float*)(ws + WS_END) + 8192;
        run_gemm(lds, (const bf16_t*)(ws + WS_MERGED), (const bf16_t*)(ws + WS_WTOUT), NTOK, 2048, 2048, E); }
#endif
    SEAM(6);
    PHASE(7) { pg8::EpiQ E; E.O = (bf16_t*)(ws + WS_Q); E.rsum = (const float*)(ws + WS_STAT); E.rsq = (const float*)(ws + WS_STAT) + 8192; E.c1 = (const float*)(ws + WS_STAT) + 16384; E.c2 = (const float*)(ws + WS_STAT) + 18432;
        run_gemm(lds, (const bf16_t*)(ws + WS_X1B), (const bf16_t*)(ws + WS_WTQ), NTOK, 2048, 2048, E); }
#if defined(DUP_PHASE) && DUP_PHASE == 7
    SEAM(6);
    PHASE(7) { pg8::EpiQ E; E.O = (bf16_t*)(ws + WS_Q); E.rsum = (const float*)(ws + WS_STAT); E.rsq = (const float*)(ws + WS_STAT) + 8192; E.c1 = (const float*)(ws + WS_STAT) + 16384; E.c2 = (const float*)(ws + WS_STAT) + 18432;
        run_gemm(lds, (const bf16_t*)(ws + WS_X1B), (const bf16_t*)(ws + WS_WTQ), NTOK, 2048, 2048, E); }
#endif
    SEAM(7);
    PHASE(8) phase7(P, lds);
#undef PHASE
#undef SEAM
}

extern "C" void kernel_launch(void* const* d_in, const int* in_sizes, int n_in, void* d_out, int out_size, void* d_ws, size_t ws_size, hipStream_t stream) {
    static int grid = 0;
    if (grid == 0) {
        if (n_in != 30 || out_size != NTOK * D || ws_size < WS_END) { fprintf(stderr, "kernel_launch: unexpected shapes (n_in %d, out %d, ws %zu < %zu)\n", n_in, out_size, ws_size, (size_t)WS_END); grid = -1; return; }
        int dev = 0, cus = 0, per_cu = 0;
        if (hipGetDevice(&dev) != hipSuccess || hipDeviceGetAttribute(&cus, hipDeviceAttributeMultiprocessorCount, dev) != hipSuccess) { grid = -1; return; }
        if (hipFuncSetAttribute((const void*)hybrid_fwd, hipFuncAttributeMaxDynamicSharedMemorySize, LDS_BYTES) != hipSuccess) { fprintf(stderr, "kernel_launch: hipFuncSetAttribute failed\n"); grid = -1; return; }
        if (hipOccupancyMaxActiveBlocksPerMultiprocessor(&per_cu, (const void*)hybrid_fwd, 512, LDS_BYTES) != hipSuccess || per_cu < 1) { fprintf(stderr, "kernel_launch: occupancy query says %d\n", per_cu); grid = -1; return; }
        (void)hipGetLastError();
        grid = cus;
    }
    if (grid < 0) return;
    if (hipMemsetAsync((unsigned char*)d_ws + WS_BAR, 0, 16384 + STAT_BYTES, stream) != hipSuccess) { fprintf(stderr, "kernel_launch: memset failed\n"); return; }
    Params p{};
    for (int i = 0; i < 30; ++i) p.in[i] = (const float*)d_in[i];
    p.out = (float*)d_out; p.ws = (unsigned char*)d_ws;
    p.ph_lo = 0; p.ph_hi = NPHASE + 1;
    void* args[] = {&p};
    hipError_t e = hipLaunchCooperativeKernel((const void*)hybrid_fwd, dim3(grid), dim3(512), args, LDS_BYTES, stream);
    if (e != hipSuccess) fprintf(stderr, "kernel_launch: cooperative launch failed: %s (grid %d)\n", hipGetErrorString(e), grid);
}
```

```cpp
#include <hip/hip_runtime.h>
#include <cstdio>
#include <cstdint>
namespace pg8 {
#define PG8_LAS __attribute__((address_space(3)))
typedef unsigned short bf16_t;
typedef short bf16x8 __attribute__((ext_vector_type(8)));
typedef float f32x4 __attribute__((ext_vector_type(4)));
typedef unsigned u32x4 __attribute__((ext_vector_type(4)));
typedef int i32x4f __attribute__((ext_vector_type(4)));
constexpr int BM = 256, BK = 64, HALF = 128, HTB = HALF * BK * 2  , STAGE_BYTES = 8 * HTB, NXCD = 8, WGM = 8;

__host__ __device__ __forceinline__ int lds_byte(int r, int c) { const int st = (r >> 4) * 2 + (c >> 5), rr = r & 15, cc = c & 31, ob = rr * 64 + cc * 2; return st * 1024 + (ob ^ (((ob >> 9) & 1) << 5)); }
__host__ __device__ __forceinline__ void stage_rc(int b, int& R, int& C) { const int st = b / 1024, sb = b % 1024, swz = sb ^ (((sb >> 9) & 1) << 5); R = (st >> 1) * 16 + swz / 64; C = (st & 1) * 32 + (swz % 64) / 2; }
__host__ __device__ __forceinline__ int perm32(int rho) { const int n = rho >> 4, i = rho & 15; return 8 * (i >> 2) + 4 * n + (i & 3); }

struct Unit { int pm, pn; };
struct Gemm { const bf16_t* A; const bf16_t* Bt; int M, N, K; };

struct StaticOrder {
    int nM, nN, nwg, G, c;
    __host__ __device__ void init(int M, int N, int G_, int c_) { nM = M / BM; nN = N / BM; nwg = nM * nN; G = G_; c = c_; }
    __host__ __device__ bool next(int i, Unit& u) const {
        const long L = (long)i * G + c; if (L >= nwg) return false;
        int wgid = (int)L; { const int q = nwg / NXCD, r = nwg % NXCD, xcd = wgid % NXCD, off = wgid / NXCD; wgid = (xcd < r ? xcd * (q + 1) : r * (q + 1) + (xcd - r) * q) + off; }
        const int nig = WGM * nN, gid = wgid / nig, fm = gid * WGM, gsz = (nM - fm) < WGM ? (nM - fm) : WGM;
        u.pm = fm + ((wgid % nig) % gsz); u.pn = (wgid % nig) / gsz; return true;
    }
    __device__ __forceinline__ void a_ready(const Unit&) const {}
    __device__ __forceinline__ void done(const Unit&) const {}
};
struct CountedOrder : StaticOrder {
    const unsigned* ready; unsigned need; unsigned* tmo;
    __device__ __forceinline__ void a_ready(const Unit& u) const {
        if (threadIdx.x < 64) {
            const unsigned long long t0 = __builtin_amdgcn_s_memrealtime(); unsigned polls = 0;
            while ((unsigned)__builtin_amdgcn_readfirstlane(__hip_atomic_load(ready + 64 * u.pm, __ATOMIC_RELAXED, __HIP_MEMORY_SCOPE_AGENT)) < need) {
                if ((++polls & 255u) == 0u && __builtin_amdgcn_readfirstlane(__hip_atomic_load(tmo, __ATOMIC_RELAXED, __HIP_MEMORY_SCOPE_AGENT)) != 0u) break;
                if (__builtin_amdgcn_s_memrealtime() - t0 > 2000000ull) {
                    if (threadIdx.x == 0) { unsigned expect = 0u; __hip_atomic_compare_exchange_strong(tmo + 1, &expect, 0x600u | (unsigned)(u.pm & 0xff), __ATOMIC_RELAXED, __ATOMIC_RELAXED, __HIP_MEMORY_SCOPE_AGENT); __hip_atomic_store(tmo, 1u, __ATOMIC_RELAXED, __HIP_MEMORY_SCOPE_AGENT); }
                    break; }
                __builtin_amdgcn_s_sleep(2); }
            __builtin_amdgcn_fence(__ATOMIC_ACQUIRE, "agent");
            asm volatile("s_waitcnt vmcnt(0)" ::: "memory");
        }
#if !defined(BROKEN_HOOK_NO_BARRIER)
        asm volatile("" ::: "memory"); __builtin_amdgcn_s_barrier(); asm volatile("" ::: "memory");
#endif
    }
};

typedef float cvt_f32x2 __attribute__((ext_vector_type(2))); typedef __bf16 cvt_bf16x2 __attribute__((ext_vector_type(2)));
__device__ __forceinline__ unsigned cvt_pk_bf16(float lo, float hi) { const cvt_f32x2 v = {lo, hi}; const cvt_bf16x2 b = __builtin_convertvector(v, cvt_bf16x2); return __builtin_bit_cast(unsigned, b); }
typedef float f32x2 __attribute__((ext_vector_type(2)));
__device__ __forceinline__ f32x2 gelu_pk(f32x2 v) {
    const f32x2 av = __builtin_elementwise_abs(v), d = av * 0.2316418882f + 1.0f;
    f32x2 t; t.x = __builtin_amdgcn_rcpf(d.x); t.y = __builtin_amdgcn_rcpf(d.y);
    f32x2 q = t * 0.5307027145f + (-0.7265760135f); q = q * t + 0.7107068705f; q = q * t + (-0.142248368f); q = q * t + 0.127414796f; q = q * t;
    const f32x2 s = (v * v) * (-0.72134752044f);
    f32x2 e; e.x = __builtin_amdgcn_exp2f(s.x); e.y = __builtin_amdgcn_exp2f(s.y);
    const f32x2 m = v * (q * e), r = v - m;
    f32x2 o; o.x = v.x < 0.f ? m.x : r.x; o.y = v.y < 0.f ? m.y : r.y; return o;
}

struct EpiF32 {
    static constexpr bool PERM = false, AFTER_DRAIN = false; static constexpr int MID_T = -1;
    float* C; int ldc; const float* bias;
    __device__ __forceinline__ void operator()(const f32x4 (&acc)[2][2][4][2], const Unit& u, int wr, int wc, int fr, int fq) const {
        const int row0 = u.pm * BM + wr * 64 + fr, col0 = u.pn * BM + wc * 32 + 4 * fq;
        f32x4 bv[2][2];
#pragma unroll
        for (int bj = 0; bj < 2; ++bj)
#pragma unroll
            for (int n = 0; n < 2; ++n) bv[bj][n] = bias ? *(const f32x4*)(bias + col0 + bj * HALF + n * 16) : (f32x4){0.f, 0.f, 0.f, 0.f};
#pragma unroll
        for (int ai = 0; ai < 2; ++ai)
#pragma unroll
            for (int m = 0; m < 4; ++m) { float* rowp = C + (size_t)(row0 + ai * HALF + m * 16) * ldc + col0;
#pragma unroll
                for (int bj = 0; bj < 2; ++bj)
#pragma unroll
                    for (int n = 0; n < 2; ++n) *(f32x4*)(rowp + bj * HALF + n * 16) = acc[ai][bj][m][n] + bv[bj][n]; }
    }
};
template <int ACT  > struct EpiBf16 {
    static constexpr bool PERM = true, AFTER_DRAIN = false; static constexpr int MID_T = -1;
    bf16_t* O; int ldc; const float* bias; int split_cols; size_t split_stride;
    __device__ __forceinline__ void operator()(const f32x4 (&acc)[2][2][4][2], const Unit& u, int wr, int wc, int fr, int fq) const {
        const int row0 = u.pm * BM + wr * 64 + fr; int colt = u.pn * BM; bf16_t* base = O;
        if (split_cols) { const int t = colt / split_cols; base += (size_t)t * split_stride; colt -= t * split_cols; }
        const int col0 = colt + wc * 32 + 8 * fq, bcol0 = u.pn * BM + wc * 32 + 8 * fq;
        f32x4 bv[2][2];
#pragma unroll
        for (int bj = 0; bj < 2; ++bj)
#pragma unroll
            for (int n = 0; n < 2; ++n) bv[bj][n] = bias ? *(const f32x4*)(bias + bcol0 + bj * HALF + 4 * n) : (f32x4){0.f, 0.f, 0.f, 0.f};
#pragma unroll
        for (int ai = 0; ai < 2; ++ai)
#pragma unroll
            for (int m = 0; m < 4; ++m) { bf16_t* rowp = base + (size_t)(row0 + ai * HALF + m * 16) * ldc + col0;
#pragma unroll
                for (int bj = 0; bj < 2; ++bj) { f32x4 v0 = acc[ai][bj][m][0] + bv[bj][0], v1 = acc[ai][bj][m][1] + bv[bj][1];
                    if (ACT == 1) { f32x2 a = gelu_pk((f32x2){v0[0], v0[1]}), b = gelu_pk((f32x2){v0[2], v0[3]}), c = gelu_pk((f32x2){v1[0], v1[1]}), d = gelu_pk((f32x2){v1[2], v1[3]});
                        v0 = (f32x4){a.x, a.y, b.x, b.y}; v1 = (f32x4){c.x, c.y, d.x, d.y}; }
                    if (ACT == 2) {
#pragma unroll
                        for (int j = 0; j < 4; ++j) { v0[j] = 0.5f * v0[j] * (1.0f + erff(v0[j] * 0.70710678f)); v1[j] = 0.5f * v1[j] * (1.0f + erff(v1[j] * 0.70710678f)); } }
                    u32x4 w; w.x = cvt_pk_bf16(v0[0], v0[1]); w.y = cvt_pk_bf16(v0[2], v0[3]); w.z = cvt_pk_bf16(v1[0], v1[1]); w.w = cvt_pk_bf16(v1[2], v1[3]);
                    *(u32x4*)(rowp + bj * HALF) = w; } }
    }
};
template <class Epi, class Sched, bool STAMP = false, bool F8 = false>
__device__ __forceinline__ void gemm_phase(PG8_LAS unsigned char* lds, const Gemm g, const Sched& S, const Epi& E, unsigned long long* stamps) {
    const int tid = threadIdx.x, wid = __builtin_amdgcn_readfirstlane(tid >> 6), lane = tid & 63, wr = wid >> 2, wc = wid & 3, fr = lane & 15, fq = lane >> 4;
    const int K = g.K, nt = K / BK;
    int ts_lo = 0, ts_hi = 0, nts = 0; const unsigned long long rt_entry = STAMP ? (unsigned long long)wall_clock64() : 0ull;
#define PG8_STAMP() do { if (STAMP && wid == 0 && nts < 64) { const unsigned long long _c = (unsigned long long)clock64(); \
        ts_lo = (lane == nts) ? (int)(unsigned)_c : ts_lo; ts_hi = (lane == nts) ? (int)(unsigned)(_c >> 32) : ts_hi; ++nts; } } while (0)
    PG8_STAMP();
    unsigned voffA[2], voffB[2];
#pragma unroll
    for (int i = 0; i < 2; ++i) { int R, C; stage_rc(tid * 16 + i * 8192, R, C); const int Rb = Epi::PERM ? ((R & ~31) + perm32(R & 31)) : R;
        voffA[i] = (unsigned)(R * K + C) * 2u; voffB[i] = (unsigned)(Rb * K + C) * 2u; }
    const size_t kstep = (size_t)(BK * 2);
    const size_t hstep = (size_t)HALF * K * 2;
    const size_t tstep = 2 * hstep;
    const unsigned ldsw = (unsigned)wid * 1024u;
    const int aoff = lds_byte(wr * 64 + fr, fq * 8), boff = lds_byte(wc * 32 + fr, fq * 8);
#define PG8_SA(b, h) (((b) * 2 + (h)) * HTB)
#define PG8_SB(b, h) ((4 + (b) * 2 + (h)) * HTB)
#define PG8_STAGE(bufoff, gbase, voff) do { _Pragma("unroll") for (int _i = 0; _i < 2; ++_i) \
        __builtin_amdgcn_global_load_lds((const unsigned*)((const char*)(gbase) + (voff)[_i]), (PG8_LAS unsigned*)(lds + (bufoff) + ldsw + _i * 8192), 16, 0, 0); } while (0)
#define PG8_LDA(dst, b, h) do { if constexpr (F8) { _Pragma("unroll") for (int m = 0; m < 4; ++m) { dst##8[m].lo = *(const PG8_LAS bf16x8*)(lds + PG8_SA(b, h) + aoff + m * 2048); dst##8[m].hi = *(const PG8_LAS bf16x8*)(lds + PG8_SA(b, h) + aoff + m * 2048 + 1024); } } \
    else { _Pragma("unroll") for (int m = 0; m < 4; ++m) _Pragma("unroll") for (int k = 0; k < 2; ++k) dst[m][k] = *(const PG8_LAS bf16x8*)(lds + PG8_SA(b, h) + aoff + m * 2048 + k * 1024); } } while (0)
#define PG8_LDB(dst, b, h) do { if constexpr (F8) { _Pragma("unroll") for (int n = 0; n < 2; ++n) { dst##8[n].lo = *(const PG8_LAS bf16x8*)(lds + PG8_SB(b, h) + boff + n * 2048); dst##8[n].hi = *(const PG8_LAS bf16x8*)(lds + PG8_SB(b, h) + boff + n * 2048 + 1024); } } \
    else { _Pragma("unroll") for (int n = 0; n < 2; ++n) _Pragma("unroll") for (int k = 0; k < 2; ++k) dst[n][k] = *(const PG8_LAS bf16x8*)(lds + PG8_SB(b, h) + boff + n * 2048 + k * 1024); } } while (0)
typedef int i32x8f __attribute__((ext_vector_type(8)));
#define PG8_MMA(ai, bj, At, Bt) do { __builtin_amdgcn_s_setprio(1); \
        if constexpr (F8) { _Pragma("unroll") for (int m = 0; m < 4; ++m) _Pragma("unroll") for (int n = 0; n < 2; ++n) \
            asm volatile("v_mfma_f32_16x16x128_f8f6f4 %0, %1, %2, %0" : "+v"(acc[ai][bj][m][n]) : "v"(Bt##8[n]), "v"(At##8[m])); } \
        else { _Pragma("unroll") for (int m = 0; m < 4; ++m) _Pragma("unroll") for (int n = 0; n < 2; ++n) _Pragma("unroll") for (int k = 0; k < 2; ++k) \
            acc[ai][bj][m][n] = __builtin_amdgcn_mfma_f32_16x16x32_bf16(Bt[n][k], At[m][k], acc[ai][bj][m][n], 0, 0, 0); } \
        __builtin_amdgcn_s_setprio(0); } while (0)
#define PG8_WAIT_V(n) asm volatile("s_waitcnt vmcnt(" #n ")" ::: "memory")
#define PG8_WAIT_L(n) asm volatile("s_waitcnt lgkmcnt(" #n ")" ::: "memory")
#define PG8_BAR __builtin_amdgcn_s_barrier()
#define PG8_SCHED __builtin_amdgcn_sched_barrier(0)
    Unit cur, nxt; int ui = 0;
    if (!S.next(0, cur)) return;
    f32x4 acc[2][2][4][2];
#pragma unroll
    for (int a = 0; a < 2; ++a)
#pragma unroll
        for (int b = 0; b < 2; ++b)
#pragma unroll
            for (int m = 0; m < 4; ++m)
#pragma unroll
                for (int n = 0; n < 2; ++n) acc[a][b][m][n] = (f32x4){0.f, 0.f, 0.f, 0.f};
    bf16x8 At[4][2], B0[2][2], B1[2][2];
    typedef short bf16x16f __attribute__((ext_vector_type(16)));
    bf16x16f At8[4], B08[2], B18[2];
    const char* cA = (const char*)g.A + (size_t)cur.pm * tstep; const char* cB = (const char*)g.Bt + (size_t)cur.pn * tstep;
    S.a_ready(cur);
    PG8_STAGE(PG8_SB(0, 0), cB, voffB); PG8_STAGE(PG8_SA(0, 0), cA, voffA); PG8_STAGE(PG8_SB(0, 1), cB + hstep, voffB); PG8_STAGE(PG8_SA(0, 1), cA + hstep, voffA);
    if (wr == 1) PG8_BAR;
    PG8_WAIT_V(4); PG8_BAR;
    PG8_STAGE(PG8_SB(1, 0), cB + kstep, voffB); PG8_STAGE(PG8_SA(1, 0), cA + kstep, voffA); PG8_STAGE(PG8_SB(1, 1), cB + hstep + kstep, voffB);
    PG8_WAIT_V(6); PG8_BAR;
    PG8_STAMP();
    for (;;) {
        const bool has_next = S.next(ui + 1, nxt);
        const char* nA = has_next ? (const char*)g.A + (size_t)nxt.pm * tstep : cA; const char* nB = has_next ? (const char*)g.Bt + (size_t)nxt.pn * tstep : cB;
        for (int t = 0; t < nt; t += 2) {
            const bool last = (t == nt - 2);
            const char* a1 = cA + (size_t)(t + 1) * kstep;
            const char* a2 = last ? nA : cA + (size_t)(t + 2) * kstep; const char* b2 = last ? nB : cB + (size_t)(t + 2) * kstep;
            const char* a3 = a2 + kstep; const char* b3 = b2 + kstep;
            if (last && has_next) S.a_ready(nxt);
            if constexpr (Epi::MID_T >= 0) { if (t == Epi::MID_T) { if constexpr (F8) asm volatile("s_nop 15\n\ts_nop 15" ::: "memory"); E.mid(acc, cur, wr, wc, fr, fq); } }
            PG8_LDB(B0, 0, 0); PG8_SCHED; PG8_LDA(At, 0, 0); PG8_STAGE(PG8_SA(1, 1), a1 + hstep, voffA);
            PG8_WAIT_L(8); PG8_BAR; PG8_WAIT_L(0); PG8_MMA(0, 0, At, B0); PG8_BAR; PG8_SCHED;
            PG8_LDB(B1, 0, 1); PG8_STAGE(PG8_SB(0, 0), b2, voffB);
            PG8_BAR; PG8_WAIT_L(0); PG8_MMA(0, 1, At, B1); PG8_BAR;
            PG8_LDA(At, 0, 1); PG8_STAGE(PG8_SA(0, 0), a2, voffA);
            PG8_BAR; PG8_WAIT_L(0); PG8_MMA(1, 0, At, B0); PG8_BAR; PG8_SCHED;
            PG8_STAGE(PG8_SB(0, 1), b2 + hstep, voffB);
            PG8_WAIT_V(6); PG8_BAR; PG8_MMA(1, 1, At, B1); PG8_BAR;
            PG8_LDB(B0, 1, 0); PG8_SCHED; PG8_LDA(At, 1, 0); PG8_STAGE(PG8_SA(0, 1), a2 + hstep, voffA);
            PG8_WAIT_L(8); PG8_BAR; PG8_WAIT_L(0); PG8_MMA(0, 0, At, B0); PG8_BAR; PG8_SCHED;
            PG8_LDB(B1, 1, 1); PG8_STAGE(PG8_SB(1, 0), b3, voffB);
            PG8_BAR; PG8_WAIT_L(0); PG8_MMA(0, 1, At, B1); PG8_BAR;
            PG8_LDA(At, 1, 1); PG8_STAGE(PG8_SA(1, 0), a3, voffA);
            PG8_BAR; PG8_WAIT_L(0); PG8_MMA(1, 0, At, B0); PG8_BAR; PG8_SCHED;
            PG8_STAGE(PG8_SB(1, 1), b3 + hstep, voffB);
            PG8_WAIT_V(6); PG8_BAR; PG8_MMA(1, 1, At, B1); PG8_BAR;
        }
        PG8_STAMP();
        if constexpr (F8) asm volatile("s_nop 15\n\ts_nop 15" ::: "memory");
        if constexpr (!Epi::AFTER_DRAIN) { E(acc, cur, wr, wc, fr, fq); S.done(cur); }
        PG8_STAMP();
        if (!has_next) break;
#pragma unroll
        for (int a = 0; a < 2; ++a)
#pragma unroll
            for (int b = 0; b < 2; ++b)
#pragma unroll
                for (int m = 0; m < 4; ++m)
#pragma unroll
                    for (int n = 0; n < 2; ++n) acc[a][b][m][n] = (f32x4){0.f, 0.f, 0.f, 0.f};
        cur = nxt; cA = nA; cB = nB; ++ui;
    }
    PG8_WAIT_V(0);
    if (wr == 0) PG8_BAR;
    PG8_BAR;
    if constexpr (Epi::AFTER_DRAIN) { E.fused(acc, cur, wr, wc, fr, fq, lds, wid, lane); S.done(cur); }
    PG8_STAMP();
    if (STAMP && wid == 0) { stamps[lane] = lane < nts ? (((unsigned long long)(unsigned)ts_hi << 32) | (unsigned)ts_lo) : 0ull;
        if (lane == 62) stamps[62] = rt_entry; if (lane == 63) stamps[63] = (unsigned long long)wall_clock64(); }
#undef PG8_STAMP
#undef PG8_SA
#undef PG8_SB
#undef PG8_STAGE
#undef PG8_LDA
#undef PG8_LDB
#undef PG8_MMA
#undef PG8_WAIT_V
#undef PG8_WAIT_L
#undef PG8_BAR
#undef PG8_SCHED
}
}
#define LAS __attribute__((address_space(3)))
typedef unsigned short bf16_t;
typedef short bf16x8 __attribute__((ext_vector_type(8)));
typedef float f32x4 __attribute__((ext_vector_type(4)));
typedef float f32x2 __attribute__((ext_vector_type(2)));
typedef unsigned u32x4 __attribute__((ext_vector_type(4)));
typedef unsigned u32x2 __attribute__((ext_vector_type(2)));
typedef LAS unsigned char* ldsp;
typedef float f32x32 __attribute__((ext_vector_type(32)));
typedef float f32x16 __attribute__((ext_vector_type(16)));
typedef unsigned u32x6 __attribute__((ext_vector_type(6)));

constexpr int D = 2048, NTOK = 8192, SEQ = 4096, MROWS = 8448, ROW_META = 8192;
constexpr int INC = 11712, NPAD = 11776;
constexpr int C_R = 0, C_K = 2048, C_V = 4096, C_WL = 6144, C_AL = 6240, C_GL = 6336, C_POOL = 6592, C_G0 = 7616, C_G1 = 9664;
constexpr int NUNITS = 4128;
constexpr float DSCALE = 0.6065306597126334f;
constexpr float DN_ALPHA = 1.189207115002721f;
constexpr float GN_EPS = 64e-5f, LN_EPS = 1e-5f;

constexpr size_t WS_P = 0;
constexpr size_t WS_H0B = 198967296;
constexpr size_t WS_WTAB = WS_H0B + 34603008;
constexpr size_t WS_WTOUT = WS_WTAB + 12582912;
constexpr size_t WS_WTQ = WS_WTOUT + 8388608;
constexpr size_t WS_WTPOOL = WS_WTQ + 8388608;
constexpr size_t WS_WTW2 = WS_WTPOOL + 524288;
constexpr size_t WS_WTA2 = WS_WTW2 + 393216;
constexpr size_t WS_WTG2 = WS_WTA2 + 393216;
constexpr size_t WS_SUBK = WS_WTG2 + 1048576;
constexpr size_t WS_BONUS = WS_SUBK + 65536;
constexpr size_t WS_REGC = WS_BONUS + 1048576;
constexpr size_t WS_WTIN = WS_REGC;
constexpr size_t UNITB = (size_t)NUNITS * 4096 * 2;
constexpr size_t WS_G = WS_REGC;
constexpr size_t WS_H0T = WS_REGC + UNITB;
constexpr size_t WS_RT = WS_REGC + 2 * UNITB;
constexpr size_t WS_Y0 = WS_REGC + 3 * UNITB;
constexpr size_t WS_S0T = WS_REGC + 4 * UNITB;
constexpr size_t WS_YAB = WS_REGC;
constexpr int LDAB = 3072;
constexpr size_t WS_MERGED = WS_REGC + 2 * UNITB;
constexpr size_t WS_X1B = WS_REGC + 3 * UNITB;
constexpr size_t WS_Q = WS_REGC + UNITB;
constexpr size_t TROW = 1536;
constexpr size_t EROW = 2048;
constexpr size_t WS_VB = WS_REGC + 5 * UNITB;
constexpr size_t WS_GSIG = WS_VB + 16384 * EROW;
constexpr size_t WS_BAR = WS_GSIG + 4194304;
constexpr size_t WS_STAT = WS_BAR + 16384;
constexpr size_t STAT_BYTES = (8192 * 2 + 2048 * 2) * 4 + 4096;
constexpr size_t WS_TSC = WS_STAT + STAT_BYTES;
constexpr size_t UROW = 1024;
constexpr size_t WS_UB = WS_TSC + 131072;
constexpr int N_BF = 6656, N_F8 = NPAD - N_BF;
constexpr size_t WS_H0B8 = WS_UB;
constexpr size_t WS_WT8 = WS_H0B8 + (size_t)MROWS * 2048;
constexpr size_t WS_WTAB8 = WS_WT8 + (size_t)N_F8 * 2048;
constexpr size_t WS_END = WS_WTAB8 + (size_t)2048 * 3072;
#define P5_F8 1
static_assert(WS_YAB + 50331648 <= WS_MERGED, "overlay");

constexpr int LDS_BYTES = 163840;
constexpr int NPHASE = 8;

struct Params {
    const float* in[30];
    float* out;
    unsigned char* ws;
    int ph_lo, ph_hi;
};
enum { I_X = 0, I_META, I_LNIN_G, I_LNIN_B, I_WIN, I_MU, I_W0, I_WW2, I_A0, I_WA2, I_WG2, I_KK, I_KA, I_RK, I_GNG, I_GNB, I_WPOOL, I_PSCALE, I_BGATE,
       I_WBA, I_WBB, I_WOUT, I_LN1G, I_LN1B, I_WQ, I_SUBK, I_UT, I_VT, I_LN2G, I_LN2B };

__device__ __forceinline__ unsigned pk2(float lo, float hi) { return pg8::cvt_pk_bf16(lo, hi); }
__device__ __forceinline__ float bflo(unsigned w) { return __uint_as_float(w << 16); }
__device__ __forceinline__ float bfhi(unsigned w) { return __uint_as_float(w & 0xffff0000u); }
__device__ __forceinline__ float bf1(bf16_t h) { return __uint_as_float(((unsigned)h) << 16); }
__device__ __forceinline__ bf16_t f2bf1(float f) { return (bf16_t)(pk2(f, f) & 0xffffu); }
__device__ __forceinline__ float wave_sum(float v) {
#pragma unroll
    for (int o = 1; o < 64; o <<= 1) v += __shfl_xor(v, o);
    return v;
}
__device__ __forceinline__ float sigmoidf_(float x) { return 1.0f / (1.0f + __expf(-x)); }
__device__ __forceinline__ f32x4 mfma16(bf16x8 a, bf16x8 b, f32x4 c) { return __builtin_amdgcn_mfma_f32_16x16x32_bf16(a, b, c, 0, 0, 0); }
__device__ __forceinline__ void unpack8(const u32x4 w, float* f) {
    f[0] = bflo(w.x); f[1] = bfhi(w.x); f[2] = bflo(w.y); f[3] = bfhi(w.y); f[4] = bflo(w.z); f[5] = bfhi(w.z); f[6] = bflo(w.w); f[7] = bfhi(w.w);
}
__device__ __forceinline__ u32x4 pack8(const float* f) { u32x4 w; w.x = pk2(f[0], f[1]); w.y = pk2(f[2], f[3]); w.z = pk2(f[4], f[5]); w.w = pk2(f[6], f[7]); return w; }
#define DPPF(v, ctrl) __builtin_bit_cast(float, __builtin_amdgcn_update_dpp(0, __builtin_bit_cast(int, (v)), (ctrl), 0xF, 0xF, true))
__device__ __forceinline__ float readlane_f(float v, int l) { return __builtin_bit_cast(float, __builtin_amdgcn_readlane(__builtin_bit_cast(int, v), l)); }
__device__ __forceinline__ float wave_sum_dpp(float v) {
    v += DPPF(v, 0xB1); v += DPPF(v, 0x4E); v += DPPF(v, 0x141); v += DPPF(v, 0x140);
    return (readlane_f(v, 0) + readlane_f(v, 16)) + (readlane_f(v, 32) + readlane_f(v, 48));
}
__device__ __forceinline__ float wave_max_dpp(float v) {
    v = fmaxf(v, DPPF(v, 0xB1)); v = fmaxf(v, DPPF(v, 0x4E)); v = fmaxf(v, DPPF(v, 0x141)); v = fmaxf(v, DPPF(v, 0x140));
    return fmaxf(fmaxf(readlane_f(v, 0), readlane_f(v, 16)), fmaxf(readlane_f(v, 32), readlane_f(v, 48)));
}
#define BLOCK_SYNC() __syncthreads()

#ifdef FP8_EMU
__device__ __forceinline__ void emu8(float& a, float& b, float sc) { const int pk = __builtin_amdgcn_cvt_pk_fp8_f32(a * sc, b * sc, 0, false); const auto r = __builtin_amdgcn_cvt_pk_f32_fp8(pk, false); a = r[0] / sc; b = r[1] / sc; }
__device__ __forceinline__ void emu8v(f32x4& o, float sc) { float a = o.x, b = o.y, c = o.z, d = o.w; emu8(a, b, sc); emu8(c, d, sc); o = (f32x4){a, b, c, d}; }
#endif
#define XB_TMO      128
#define XB_XCNT(j)  (256  + 64 * (j))
#define XB_XSUB(j)  (1280 + 64 * (j))
#define XB_XGEN(j)  (2304 + 64 * (j))
#define XB_TOP      3328
#define XB_TOPGEN   3392
#define XCD_BAR_WORDS 3456
#define XB_SPIN_CAP (1u << 18)

__device__ __forceinline__ unsigned xb_ld(unsigned* p)              { return __hip_atomic_load(p, __ATOMIC_RELAXED, __HIP_MEMORY_SCOPE_AGENT); }
__device__ __forceinline__ unsigned xb_add(unsigned* p, unsigned v) { return __hip_atomic_fetch_add(p, v, __ATOMIC_RELAXED, __HIP_MEMORY_SCOPE_AGENT); }
__device__ __forceinline__ unsigned xb_xcc_id() { return (unsigned)__builtin_amdgcn_s_getreg((3 << 11) | 20) & 0xFu; }
#define XB_SPIN(cond, bar) do { unsigned _sp = 0; while (cond) { __builtin_amdgcn_s_sleep(1); \
    if ((++_sp & 255u) == 0u) { if (xb_ld(&(bar)[XB_TMO])) break; if (_sp > XB_SPIN_CAP) { atomicAdd(&(bar)[XB_TMO], 1u); break; } } } } while (0)

struct XcdBarrier {
    unsigned* bar; unsigned x;
    volatile LAS unsigned* st;
};

__device__ __forceinline__ XcdBarrier xcd_barrier_post(unsigned* bar, volatile LAS unsigned* st) {
    XcdBarrier b; b.bar = bar; b.x = xb_xcc_id(); b.st = st;
    if (threadIdx.x == 0) (void)xb_add(&bar[XB_XCNT(b.x)], 1u);
    return b;
}
__device__ __forceinline__ void xcd_barrier_complete(unsigned* bar, unsigned x, unsigned& nloc, unsigned& nx) {
    const unsigned G = gridDim.x * gridDim.y * gridDim.z;
    unsigned sum, cnt, mine, sp = 0u;
    for (;;) {
        sum = 0u; cnt = 0u; mine = 0u;
#pragma unroll
        for (unsigned j = 0; j < 16; ++j) { const unsigned c = xb_ld(&bar[XB_XCNT(j)]); sum += c; cnt += (c > 0u) ? 1u : 0u; mine = (j == x) ? c : mine; }
        if (sum == G) break;
        __builtin_amdgcn_s_sleep(1);
        if ((++sp & 255u) == 0u) { if (xb_ld(&bar[XB_TMO])) break; if (sp > XB_SPIN_CAP) { atomicAdd(&bar[XB_TMO], 1u); break; } }
    }
    nloc = mine > 0u ? mine : 1u; nx = cnt > 0u ? cnt : 1u;
}

__device__ __forceinline__ void xcd_barrier(const XcdBarrier& b) {
    asm volatile("s_waitcnt vmcnt(0)" ::: "memory");
    __syncthreads();
    if (threadIdx.x == 0) {
        unsigned* bar = b.bar;
        __builtin_amdgcn_s_waitcnt(0);
        unsigned nloc = b.st[0], nx = b.st[1];
        if (nloc == 0u) { xcd_barrier_complete(bar, b.x, nloc, nx); b.st[0] = nloc; b.st[1] = nx; }
        const unsigned old = xb_add(&bar[XB_XSUB(b.x)], 1u);
        const unsigned gen = old / nloc;
        if (old + 1u == (gen + 1u) * nloc) {
            __builtin_amdgcn_fence(__ATOMIC_RELEASE, "agent");
            asm volatile("s_waitcnt vmcnt(0)" ::: "memory");
            const unsigned og = xb_add(&bar[XB_TOP], 1u);
            const unsigned tg = og / nx;
            if (og + 1u == (tg + 1u) * nx) xb_add(&bar[XB_TOPGEN], 1u);
            else XB_SPIN(xb_ld(&bar[XB_TOPGEN]) == tg, bar);
            __builtin_amdgcn_fence(__ATOMIC_ACQUIRE, "agent");
            xb_add(&bar[XB_XGEN(b.x)], 1u);
            asm volatile("s_waitcnt vmcnt(0)" ::: "memory");
        } else {
            XB_SPIN(xb_ld(&bar[XB_XGEN(b.x)]) == gen, bar);
            __builtin_amdgcn_fence(__ATOMIC_ACQUIRE, "agent");
            asm volatile("s_waitcnt vmcnt(0)" ::: "memory");
        }
    }
    __syncthreads();
}

#ifdef FP8_EMU
#define EMU_W5 ((FP8_EMU & 1) != 0)
#define EMU_W6 ((FP8_EMU & 2) != 0)
#else
#define EMU_W5 false
#define EMU_W6 false
#endif
__device__ __forceinline__ void ln_row_bf16(const float* src, const float* g, const float* b, bf16_t* dst, int lane) {
    f32x4 v[8]; float s = 0.f;
#pragma unroll
    for (int j = 0; j < 8; ++j) { v[j] = ((const f32x4*)src)[lane + 64 * j]; s += (v[j].x + v[j].y) + (v[j].z + v[j].w); }
    const float mean = wave_sum(s) * (1.0f / D); float s2 = 0.f;
#pragma unroll
    for (int j = 0; j < 8; ++j) { v[j] = v[j] - mean; s2 += (v[j].x * v[j].x + v[j].y * v[j].y) + (v[j].z * v[j].z + v[j].w * v[j].w); }
    const float rstd = 1.0f / sqrtf(wave_sum(s2) * (1.0f / D) + LN_EPS);
#pragma unroll
    for (int j = 0; j < 8; ++j) {
        const f32x4 gg = ((const f32x4*)g)[lane + 64 * j], bb = ((const f32x4*)b)[lane + 64 * j];
        const f32x4 o = v[j] * rstd * gg + bb;
        u32x2 w; w.x = pk2(o.x, o.y); w.y = pk2(o.z, o.w);
        ((u32x2*)dst)[lane + 64 * j] = w;
    }
}
__device__ __forceinline__ void transpose_item(const float* W, int K, int N, int Npad, bf16_t* Wt, int item, int lane, int ldw = 0) {
    const int nblk = Npad >> 6, kb = item / nblk, nb = item - kb * nblk, n = nb * 64 + lane, k0 = kb * 32;
    float v[32];
    if (n < N) {
#pragma unroll
        for (int i = 0; i < 32; ++i) v[i] = W[(size_t)(k0 + i) * N + n];
    } else {
#pragma unroll
        for (int i = 0; i < 32; ++i) v[i] = 0.f;
    }
    u32x4* o = (u32x4*)(Wt + (size_t)n * (ldw ? ldw : K) + k0);
#pragma unroll
    for (int c = 0; c < 4; ++c) { u32x4 w; w.x = pk2(v[8 * c], v[8 * c + 1]); w.y = pk2(v[8 * c + 2], v[8 * c + 3]); w.z = pk2(v[8 * c + 4], v[8 * c + 5]); w.w = pk2(v[8 * c + 6], v[8 * c + 7]); o[c] = w; }
}
__device__ __forceinline__ void transpose_item_q(const float* W, const float* g, const float* b, bf16_t* Wt, float* c1, float* c2, int item, int lane) {
    const int kb = item >> 5, nb = item & 31, n = nb * 64 + lane, k0 = kb * 32;
    float v[32], s1 = 0.f, s2 = 0.f;
#pragma unroll
    for (int i = 0; i < 32; ++i) { const float w = W[(size_t)(k0 + i) * 2048 + n]; const float gw = g[k0 + i] * w; s1 += gw; s2 += b[k0 + i] * w; v[i] = gw; }
    u32x4* o = (u32x4*)(Wt + (size_t)n * 2048 + k0);
#pragma unroll
    for (int c = 0; c < 4; ++c) { u32x4 w; w.x = pk2(v[8 * c], v[8 * c + 1]); w.y = pk2(v[8 * c + 2], v[8 * c + 3]); w.z = pk2(v[8 * c + 4], v[8 * c + 5]); w.w = pk2(v[8 * c + 6], v[8 * c + 7]); o[c] = w; }
    atomicAdd(c1 + n, s1); atomicAdd(c2 + n, s2);
}
__device__ __forceinline__ unsigned pk4_fp8(float a, float b, float c, float d) {
    int w = __builtin_amdgcn_cvt_pk_fp8_f32(a, b, 0, false); w = __builtin_amdgcn_cvt_pk_fp8_f32(c, d, w, true); return (unsigned)w; }
__device__ __forceinline__ void transpose_item64(const float* W, int K, int N, int Npad, bf16_t* Wt, int ldw, int item, int lane, unsigned char* Wt8 = nullptr, int n8 = 1 << 30, bool emu = false, int ld8 = 2048) {
    const int nblk = Npad >> 6, kb = item / nblk, nb = item - kb * nblk, n = nb * 64 + lane, k0 = kb * 64;
    float v[64];
    if (n < N) {
#pragma unroll
        for (int i = 0; i < 64; ++i) v[i] = W[(size_t)(k0 + i) * N + n];
    } else {
#pragma unroll
        for (int i = 0; i < 64; ++i) v[i] = 0.f;
    }
#ifdef FP8_EMU
    if (emu) {
#pragma unroll
        for (int i = 0; i < 64; i += 2) emu8(v[i], v[i + 1], 64.0f); }
#endif
    if (n >= n8) {
        u32x4* o8 = (u32x4*)(Wt8 + (size_t)(n - n8) * ld8 + k0);
#pragma unroll
        for (int c = 0; c < 4; ++c) { u32x4 w; w.x = pk4_fp8(64.f * v[16 * c], 64.f * v[16 * c + 1], 64.f * v[16 * c + 2], 64.f * v[16 * c + 3]); w.y = pk4_fp8(64.f * v[16 * c + 4], 64.f * v[16 * c + 5], 64.f * v[16 * c + 6], 64.f * v[16 * c + 7]);
            w.z = pk4_fp8(64.f * v[16 * c + 8], 64.f * v[16 * c + 9], 64.f * v[16 * c + 10], 64.f * v[16 * c + 11]); w.w = pk4_fp8(64.f * v[16 * c + 12], 64.f * v[16 * c + 13], 64.f * v[16 * c + 14], 64.f * v[16 * c + 15]); o8[c] = w; }
        return;
    }
    u32x4* o = (u32x4*)(Wt + (size_t)n * ldw + k0);
#pragma unroll
    for (int c = 0; c < 8; ++c) { u32x4 w; w.x = pk2(v[8 * c], v[8 * c + 1]); w.y = pk2(v[8 * c + 2], v[8 * c + 3]); w.z = pk2(v[8 * c + 4], v[8 * c + 5]); w.w = pk2(v[8 * c + 6], v[8 * c + 7]); o[c] = w; }
}
__device__ __forceinline__ void phase0(const Params& P) {
    const int lane = threadIdx.x & 63, wave = threadIdx.x >> 6;
    const int gw = blockIdx.x * 8 + wave, NGW = gridDim.x * 8;
    unsigned char* ws = P.ws;
    constexpr int T_IN = 32 * 184, T_A = 32 * 32, T_B = 16 * 32, T_O = 32 * 32, T_Q = 64 * 32, T_POOL = 4 * 32, T_W2 = 3 * 32, T_A2 = 3 * 32, T_G2 = 8 * 32;
    constexpr int T_LN = MROWS, T_SK = 64;
    constexpr int NIT = T_IN + T_A + T_B + T_O + T_Q + T_POOL + T_W2 + T_A2 + T_G2 + T_SK;
    for (int it = gw; it < NIT; it += NGW) {
        int r = it;
        if (r < T_IN) { transpose_item64(P.in[I_WIN], 2048, INC, NPAD, (bf16_t*)(ws + WS_WTIN), 2048, r, lane, ws + WS_WT8, N_BF); continue; } r -= T_IN;
        if (r < T_A) {
#ifdef P5_F8
            transpose_item64(P.in[I_WBA], 2048, 2048, 2048, nullptr, LDAB, r, lane, ws + WS_WTAB8, 0, false, LDAB); continue; }
#else
            transpose_item64(P.in[I_WBA], 2048, 2048, 2048, (bf16_t*)(ws + WS_WTAB), LDAB, r, lane, nullptr, 1 << 30, EMU_W5); continue; }
#endif
        r -= T_A;
        if (r < T_B) {
#ifdef P5_F8
            transpose_item64(P.in[I_WBB], 1024, 2048, 2048, nullptr, LDAB, r, lane, ws + WS_WTAB8 + 2048, 0, false, LDAB); continue; }
#else
            transpose_item64(P.in[I_WBB], 1024, 2048, 2048, (bf16_t*)(ws + WS_WTAB) + 2048, LDAB, r, lane, nullptr, 1 << 30, EMU_W5); continue; }
#endif
        r -= T_B;
        if (r < T_O) { transpose_item64(P.in[I_WOUT], 2048, 2048, 2048, (bf16_t*)(ws + WS_WTOUT), 2048, r, lane, nullptr, 1 << 30, EMU_W6); continue; } r -= T_O;
        if (r < T_Q) {
#ifdef REPEAT_PHASE
            float* st = (float*)(ws + (P.ph_lo < 0 ? WS_END : WS_STAT));
#else
            float* st = (float*)(ws + WS_STAT);
#endif
            transpose_item_q(P.in[I_WQ], P.in[I_LN1G], P.in[I_LN1B], (bf16_t*)(ws + WS_WTQ), st + 16384, st + 18432, r, lane); continue; } r -= T_Q;
        if (r < T_POOL) { const int g = r >> 5; transpose_item(P.in[I_WPOOL] + g * 65536, 256, 256, 256, (bf16_t*)(ws + WS_WTPOOL) + g * 65536, r & 31, lane); continue; } r -= T_POOL;
        if (r < T_W2) { transpose_item(P.in[I_WW2], 96, 2048, 2048, (bf16_t*)(ws + WS_WTW2), r, lane); continue; } r -= T_W2;
        if (r < T_A2) { transpose_item(P.in[I_WA2], 96, 2048, 2048, (bf16_t*)(ws + WS_WTA2), r, lane); continue; } r -= T_A2;
        if (r < T_G2) { transpose_item(P.in[I_WG2], 256, 2048, 2048, (bf16_t*)(ws + WS_WTG2), r, lane); continue; } r -= T_G2;
        {
            const float* s = P.in[I_SUBK] + r * 512 + lane * 8; float f[8];
#pragma unroll
            for (int i = 0; i < 8; ++i) f[i] = s[i];
            *(u32x4*)((bf16_t*)(ws + WS_SUBK) + r * 512 + lane * 8) = pack8(f);
        }
    }
    {
        f32x4 gg[8], bb[8];
#pragma unroll
        for (int j = 0; j < 8; ++j) { gg[j] = ((const f32x4*)P.in[I_LNIN_G])[lane + 64 * j]; bb[j] = ((const f32x4*)P.in[I_LNIN_B])[lane + 64 * j]; }
        auto srcrow = [&](int r) -> const float* { return r < NTOK ? P.in[I_X] + (size_t)r * D : P.in[I_META] + (size_t)(r - NTOK) * D; };
        auto finish = [&](int r, f32x4 (&v)[8]) {
            float s = 0.f;
#pragma unroll
            for (int j = 0; j < 8; ++j) s += (v[j].x + v[j].y) + (v[j].z + v[j].w);
            const float mean = wave_sum_dpp(s) * (1.0f / D); float s2 = 0.f;
#pragma unroll
            for (int j = 0; j < 8; ++j) { v[j] = v[j] - mean; s2 += (v[j].x * v[j].x + v[j].y * v[j].y) + (v[j].z * v[j].z + v[j].w * v[j].w); }
            const float rstd = 1.0f / sqrtf(wave_sum_dpp(s2) * (1.0f / D) + LN_EPS);
            bf16_t* dst = (bf16_t*)(ws + WS_H0B) + (size_t)r * D;
            unsigned* dst8 = (unsigned*)(ws + WS_H0B8 + (size_t)r * 2048);
#pragma unroll
            for (int j = 0; j < 8; ++j) { const f32x4 o = v[j] * rstd * gg[j] + bb[j]; u32x2 w; w.x = pk2(o.x, o.y); w.y = pk2(o.z, o.w); ((u32x2*)dst)[lane + 64 * j] = w;
                dst8[lane + 64 * j] = pk4_fp8(o.x, o.y, o.z, o.w); }
        };
        for (int r = gw; r < NTOK + 16; r += 2 * NGW) {
            const int r2 = r + NGW; const bool has2 = r2 < NTOK + 16;
            f32x4 v1[8], v2[8];
#pragma unroll
            for (int j = 0; j < 8; ++j) v1[j] = ((const f32x4*)srcrow(r))[lane + 64 * j];
#pragma unroll
            for (int j = 0; j < 8; ++j) v2[j] = ((const f32x4*)srcrow(has2 ? r2 : r))[lane + 64 * j];
            finish(r, v1); if (has2) finish(r2, v2);
        }
        for (int r = NTOK + 16 + gw; r < MROWS; r += NGW) { bf16_t* dst = (bf16_t*)(ws + WS_H0B) + (size_t)r * D; unsigned* dst8 = (unsigned*)(ws + WS_H0B8 + (size_t)r * 2048);
#pragma unroll
            for (int j = 0; j < 8; ++j) { ((u32x2*)dst)[lane + 64 * j] = (u32x2){0u, 0u}; dst8[lane + 64 * j] = 0u; } }
    }
}
namespace pg8 {
constexpr float LN_EPS_ = 1e-5f;
struct EpiBf16S {
    static constexpr bool PERM = true, AFTER_DRAIN = false; static constexpr int MID_T = -1;
    bf16_t* O; int ldc; float scale;
    __device__ __forceinline__ void operator()(const f32x4 (&acc)[2][2][4][2], const Unit& u, int wr, int wc, int fr, int fq) const {
        const int row0 = u.pm * BM + wr * 64 + fr, col0 = u.pn * BM + wc * 32 + 8 * fq;
#pragma unroll
        for (int ai = 0; ai < 2; ++ai)
#pragma unroll
            for (int m = 0; m < 4; ++m) { bf16_t* rowp = O + (size_t)(row0 + ai * HALF + m * 16) * ldc + col0;
#pragma unroll
                for (int bj = 0; bj < 2; ++bj) { const f32x4 v0 = acc[ai][bj][m][0] * scale, v1 = acc[ai][bj][m][1] * scale;
                    u32x4 w; w.x = cvt_pk_bf16(v0[0], v0[1]); w.y = cvt_pk_bf16(v0[2], v0[3]); w.z = cvt_pk_bf16(v1[0], v1[1]); w.w = cvt_pk_bf16(v1[2], v1[3]);
                    *(u32x4*)(rowp + bj * HALF) = w; } }
    }
};
template <int MIDT> struct EpiGate35T {
    static constexpr bool PERM = false, AFTER_DRAIN = false; static constexpr int MID_T = MIDT;
    bf16_t* O; const bf16_t* p; const float* bgate; float oscale;
    __device__ __forceinline__ void mid(f32x4 (&acc)[2][2][4][2], const Unit& u, int wr, int wc, int fr, int fq) const {
        asm volatile("" : "+v"(fr), "+v"(fq));
        const int row0 = u.pm * BM + wr * 64 + fr, col0 = u.pn * BM + wc * 32 + 4 * fq;
        f32x4 b0[2][2], b1[2][2];
#pragma unroll
        for (int bj = 0; bj < 2; ++bj)
#pragma unroll
            for (int n = 0; n < 2; ++n) { const int col = col0 + bj * HALF + n * 16; b0[bj][n] = *(const f32x4*)(bgate + col); b1[bj][n] = *(const f32x4*)(bgate + D + col); }
        u32x2 pa[2][2][2], pb[2][2][2];
        auto ld = [&](int g, u32x2 (&pp)[2][2][2]) { const size_t row = (size_t)(row0 + (g >> 2) * HALF + (g & 3) * 16);
#pragma unroll
            for (int bj = 0; bj < 2; ++bj)
#pragma unroll
                for (int n = 0; n < 2; ++n) { const int col = col0 + bj * HALF + n * 16; pp[bj][n][0] = *(const u32x2*)(p + row * NPAD + C_G0 + col); pp[bj][n][1] = *(const u32x2*)(p + row * NPAD + C_G1 + col); } };
        auto ap = [&](int g, const u32x2 (&pp)[2][2][2]) { const int ai = g >> 2, m = g & 3;
#pragma unroll
            for (int bj = 0; bj < 2; ++bj)
#pragma unroll
                for (int n = 0; n < 2; ++n) { const u32x2 p0 = pp[bj][n][0], p1 = pp[bj][n][1]; const f32x4 c0 = b0[bj][n], c1 = b1[bj][n];
                    f32x4 r;
                    r.x = (1.0f + __expf(-fmaxf(bflo(p1.x) + c1.x, -80.f))) * __builtin_amdgcn_rcpf(1.0f + __expf(-(bflo(p0.x) + c0.x)));
                    r.y = (1.0f + __expf(-fmaxf(bfhi(p1.x) + c1.y, -80.f))) * __builtin_amdgcn_rcpf(1.0f + __expf(-(bfhi(p0.x) + c0.y)));
                    r.z = (1.0f + __expf(-fmaxf(bflo(p1.y) + c1.z, -80.f))) * __builtin_amdgcn_rcpf(1.0f + __expf(-(bflo(p0.y) + c0.z)));
                    r.w = (1.0f + __expf(-fmaxf(bfhi(p1.y) + c1.w, -80.f))) * __builtin_amdgcn_rcpf(1.0f + __expf(-(bfhi(p0.y) + c0.w)));
                    acc[ai][bj][m][n] = acc[ai][bj][m][n] * r; } };
        ld(0, pa);
#pragma unroll
        for (int g = 0; g < 8; g += 2) { ld(g + 1, pb); ap(g, pa); if (g + 2 < 8) ld(g + 2, pa); ap(g + 1, pb); }
    }
    __device__ __forceinline__ void operator()(const f32x4 (&acc)[2][2][4][2], const Unit& u, int wr, int wc, int fr, int fq) const {
        const int row0 = u.pm * BM + wr * 64 + fr, col0 = u.pn * BM + wc * 32 + 4 * fq;
#pragma unroll
        for (int ai = 0; ai < 2; ++ai)
#pragma unroll
            for (int m = 0; m < 4; ++m) { const size_t row = (size_t)(row0 + ai * HALF + m * 16);
#pragma unroll
                for (int bj = 0; bj < 2; ++bj)
#pragma unroll
                    for (int n = 0; n < 2; ++n) { const int col = col0 + bj * HALF + n * 16;
                        const u32x2 p1 = *(const u32x2*)(p + row * NPAD + C_G1 + col); const f32x4 b1 = *(const f32x4*)(bgate + D + col);
                        f32x4 g;
                        g.x = __builtin_amdgcn_rcpf(1.0f + __expf(-fmaxf(bflo(p1.x) + b1.x, -80.f))); g.y = __builtin_amdgcn_rcpf(1.0f + __expf(-fmaxf(bfhi(p1.x) + b1.y, -80.f)));
                        g.z = __builtin_amdgcn_rcpf(1.0f + __expf(-fmaxf(bflo(p1.y) + b1.z, -80.f))); g.w = __builtin_amdgcn_rcpf(1.0f + __expf(-fmaxf(bfhi(p1.y) + b1.w, -80.f)));
                        const f32x4 o = acc[ai][bj][m][n] * (g * oscale);

                        u32x2 w; w.x = cvt_pk_bf16(o.x, o.y); w.y = cvt_pk_bf16(o.z, o.w);
                        *(u32x2*)(O + row * D + col) = w; } }
    }
};
typedef EpiGate35T<32> EpiGate35;
struct EpiResidStats {
    static constexpr bool PERM = false, AFTER_DRAIN = false; static constexpr int MID_T = -1;
    bf16_t* O; const bf16_t* h0; float alpha; float* rsum; float* rsq;
    __device__ __forceinline__ void operator()(const f32x4 (&acc)[2][2][4][2], const Unit& u, int wr, int wc, int fr, int fq) const {
        const int row0 = u.pm * BM + wr * 64 + fr, col0 = u.pn * BM + wc * 32 + 4 * fq;
#pragma unroll
        for (int ai = 0; ai < 2; ++ai)
#pragma unroll
            for (int m = 0; m < 4; ++m) { const size_t row = (size_t)(row0 + ai * HALF + m * 16); float s = 0.f, q = 0.f;
#pragma unroll
                for (int bj = 0; bj < 2; ++bj)
#pragma unroll
                    for (int n = 0; n < 2; ++n) { const int col = col0 + bj * HALF + n * 16;
                        const u32x2 hw = *(const u32x2*)(h0 + row * D + col);
                        f32x4 hv; hv.x = bflo(hw.x); hv.y = bfhi(hw.x); hv.z = bflo(hw.y); hv.w = bfhi(hw.y);
                        const f32x4 x = hv * alpha + acc[ai][bj][m][n];
                        s += (x.x + x.y) + (x.z + x.w); q += (x.x * x.x + x.y * x.y) + (x.z * x.z + x.w * x.w);
                        u32x2 w; w.x = cvt_pk_bf16(x.x, x.y); w.y = cvt_pk_bf16(x.z, x.w);
                        *(u32x2*)(O + row * D + col) = w; }
                s += __shfl_xor(s, 16); s += __shfl_xor(s, 32); q += __shfl_xor(q, 16); q += __shfl_xor(q, 32);
                if (fq == 0) { atomicAdd(rsum + row, s); atomicAdd(rsq + row, q); } }
    }
};
struct EpiQ {
    static constexpr bool PERM = true, AFTER_DRAIN = false; static constexpr int MID_T = -1;
    bf16_t* O; const float* rsum; const float* rsq; const float* c1; const float* c2;
    __device__ __forceinline__ void operator()(const f32x4 (&acc)[2][2][4][2], const Unit& u, int wr, int wc, int fr, int fq) const {
        const int row0 = u.pm * BM + wr * 64 + fr, col0 = u.pn * BM + wc * 32 + 8 * fq;
        f32x4 k1[2][2], k2[2][2];
#pragma unroll
        for (int bj = 0; bj < 2; ++bj)
#pragma unroll
            for (int n = 0; n < 2; ++n) { k1[bj][n] = *(const f32x4*)(c1 + col0 + bj * HALF + 4 * n); k2[bj][n] = *(const f32x4*)(c2 + col0 + bj * HALF + 4 * n); }
#pragma unroll
        for (int ai = 0; ai < 2; ++ai)
#pragma unroll
            for (int m = 0; m < 4; ++m) { const int row = row0 + ai * HALF + m * 16;
                const float mean = rsum[row] * (1.0f / D), rstd = 1.0f / sqrtf(fmaxf(rsq[row] * (1.0f / D) - mean * mean, 0.f) + LN_EPS_);
                bf16_t* rowp = O + (size_t)row * D + col0;
#pragma unroll
                for (int bj = 0; bj < 2; ++bj) {
                    const f32x4 v0 = (acc[ai][bj][m][0] - k1[bj][0] * mean) * rstd + k2[bj][0], v1 = (acc[ai][bj][m][1] - k1[bj][1] * mean) * rstd + k2[bj][1];
                    u32x4 w; w.x = cvt_pk_bf16(v0[0], v0[1]); w.y = cvt_pk_bf16(v0[2], v0[3]); w.z = cvt_pk_bf16(v1[0], v1[1]); w.w = cvt_pk_bf16(v1[2], v1[3]);
                    *(u32x4*)(rowp + bj * HALF) = w; } }
    }
};
}
template <class Epi>
__device__ __forceinline__ void run_gemm(ldsp lds, const bf16_t* A, const bf16_t* Bt, int M, int N, int K, const Epi& E) {
    pg8::Gemm g; g.A = A; g.Bt = Bt; g.M = M; g.N = N; g.K = K;
    pg8::StaticOrder S; S.init(M, N, (int)gridDim.x, (int)blockIdx.x);
    pg8::gemm_phase<Epi, pg8::StaticOrder, false>(lds, g, S, E, nullptr);
}

template <class Epi>
__device__ __forceinline__ void run_gemm8(ldsp lds, const unsigned char* A8, const unsigned char* Bt8, int M, int N, int K, const Epi& E, int wg) {
    pg8::Gemm g; g.A = (const bf16_t*)A8; g.Bt = (const bf16_t*)Bt8; g.M = M; g.N = N; g.K = K / 2;
    pg8::StaticOrder S; S.init(M, N, (int)gridDim.x, wg);
    pg8::gemm_phase<Epi, pg8::StaticOrder, false, true>(lds, g, S, E, nullptr);
}
constexpr int CONV_P3_END = 16384;
constexpr int CONV_P2_ROWS = 0;
__device__ __forceinline__ void convert_row(unsigned char* ws, int r, int lane, const f32x4 (&v)[8]) {
    float am = 0.f, ss = 0.f;
#pragma unroll
    for (int j = 0; j < 8; ++j) { am = fmaxf(am, fmaxf(fmaxf(fabsf(v[j].x), fabsf(v[j].y)), fmaxf(fabsf(v[j].z), fabsf(v[j].w)))); ss += (v[j].x * v[j].x + v[j].y * v[j].y) + (v[j].z * v[j].z + v[j].w * v[j].w); }
    am = wave_max_dpp(am);
    const float rms = sqrtf(wave_sum_dpp(ss) * (1.0f / D));
    unsigned w[4]; float sc;
    if (r < 16384) {
        const float clip = fminf(am, 2.5f * rms), s = clip > 0.f ? 7.0f / clip : 1.0f; sc = clip > 0.f ? clip * (1.0f / 7.0f) : 1.0f;
#pragma unroll
        for (int j = 0; j < 4; ++j) { unsigned t = 0;
#pragma unroll
            for (int i = 0; i < 8; ++i) { const float f = fminf(fmaxf(v[2 * j + (i >> 2)][i & 3] * s, -7.0f), 7.0f);
                t = __builtin_amdgcn_alignbit(__float_as_uint(f + 12582912.0f), t, 4); }
            w[j] = t; }
    } else {
        const float clip = fminf(am, 3.0f * rms), s = clip > 0.f ? 6.0f / clip : 1.0f; sc = clip > 0.f ? clip * (1.0f / 6.0f) : 1.0f;
#pragma unroll
        for (int j = 0; j < 4; ++j) { unsigned t = 0; float f[8];
#pragma unroll
            for (int i = 0; i < 8; ++i) f[i] = fminf(fmaxf(v[2 * j + (i >> 2)][i & 3] * s, -6.0f), 6.0f);
            t = __builtin_amdgcn_cvt_scalef32_pk_fp4_f32(t, f[0], f[1], 1.0f, 0); t = __builtin_amdgcn_cvt_scalef32_pk_fp4_f32(t, f[2], f[3], 1.0f, 1);
            t = __builtin_amdgcn_cvt_scalef32_pk_fp4_f32(t, f[4], f[5], 1.0f, 2); t = __builtin_amdgcn_cvt_scalef32_pk_fp4_f32(t, f[6], f[7], 1.0f, 3);
            w[j] = t; }
    }
    *(u32x4*)(ws + WS_VB + (size_t)(r & 16383) * EROW + (r < 16384 ? 0 : 1024) + lane * 16) = (u32x4){w[0], w[1], w[2], w[3]};
    if (lane == 0) ((float*)(ws + WS_TSC))[r] = sc;
}
__device__ __forceinline__ void convert_ld(const Params& P, int r, int lane, f32x4 (&v)[8]) {
    const f32x4* src = (const f32x4*)((r < 16384 ? P.in[I_UT] : P.in[I_VT]) + (size_t)(r & 16383) * D) + lane;
#pragma unroll
    for (int j = 0; j < 8; ++j) v[j] = src[64 * j];
}
__device__ __forceinline__ void convert_tables(const Params& P, int r0, int rend, int stride) {
    const int lane = threadIdx.x & 63;
    for (int r = r0; r < rend; r += stride) { f32x4 v[8]; convert_ld(P, r, lane, v); convert_row(P.ws, r, lane, v); }
}
constexpr int LD64 = 72, MATB = 64 * LD64 * 2, LDK = 104;
constexpr int O_AB = 0, O_RB = 1 * MATB, O_BH = 2 * MATB, O_KH = 3 * MATB, O_BTT = 4 * MATB, O_KTT = 5 * MATB, O_VT = 6 * MATB;
constexpr int O_M0 = 7 * MATB, O_M0T = 8 * MATB  , O_M1 = 9 * MATB, O_PA = 10 * MATB, O_PB = 11 * MATB, O_MAK = 12 * MATB, O_MRB = 13 * MATB, O_MRK = 14 * MATB;
constexpr int O_M1T = 0;
constexpr int LDKP = 96;
constexpr int O_WL = 15 * MATB, O_AL = O_WL + 64 * LDKP * 2;
constexpr int O_Z = 7 * MATB, O_AZ = O_Z + 64 * 68 * 4;
static_assert(O_AZ + 64 * 68 * 4 <= O_PB, "lds");
static_assert(O_AL + 64 * LDKP * 2 <= LDS_BYTES - 16, "lds");

__device__ __forceinline__ bf16x8 ldsfrag(ldsp lds, int off, int ld, int row, int kofs) { return *(const LAS bf16x8*)(lds + off + (row * ld + kofs) * 2); }
__device__ __forceinline__ void st4(ldsp lds, int off, int row, int col, const f32x4 v) {
    u32x2 w; w.x = pk2(v.x, v.y); w.y = pk2(v.z, v.w); *(LAS u32x2*)(lds + off + (row * LD64 + col) * 2) = w; }
__device__ __forceinline__ void st1(ldsp lds, int off, int row, int col, float v) { *(LAS bf16_t*)(lds + off + (row * LD64 + col) * 2) = f2bf1(v); }

__device__ __forceinline__ float fast_rcp(float x) { return __builtin_amdgcn_rcpf(x); }
__device__ __forceinline__ float fast_sigmoid(float x) { return fast_rcp(1.0f + __expf(-x)); }
__device__ __forceinline__ float fast_tanh(float x) { return 1.0f - 2.0f * fast_rcp(1.0f + __expf(2.0f * x)); }
__device__ __forceinline__ u32x4 ld8(const bf16_t* p) { return p ? *(const u32x4*)p : (u32x4){0u, 0u, 0u, 0u}; }
__device__ __forceinline__ void shift8r(const u32x4 cw, const u32x4 pw, const float* mu, float* x) {
    float c[8], q[8]; unpack8(cw, c); unpack8(pw, q);
    const f32x4 m0 = *(const f32x4*)mu, m1 = *(const f32x4*)(mu + 4);
    const float mm[8] = {m0.x, m0.y, m0.z, m0.w, m1.x, m1.y, m1.z, m1.w};
#pragma unroll
    for (int i = 0; i < 8; ++i) x[i] = c[i] + (q[i] - c[i]) * mm[i];
}
__device__ __forceinline__ int tcol(int row, int col) { return ((((col >> 3) ^ (row >> 3)) & 7) << 3) | (col & 7); }
__device__ __forceinline__ bf16x8 ldsfragT(ldsp lds, int off, int row, int kofs) { return *(const LAS bf16x8*)(lds + off + (row * LD64 + tcol(row, kofs)) * 2); }
__device__ __forceinline__ void st1T(ldsp lds, int off, int row, int col, float v) { *(LAS bf16_t*)(lds + off + (row * LD64 + tcol(row, col)) * 2) = f2bf1(v); }
typedef short s16x4 __attribute__((ext_vector_type(4)));
__device__ __forceinline__ bf16x8 ldsfragTR(ldsp lds, int off, int krow0, int col0, int lane) {
    const int g = lane >> 4, q = (lane & 15) >> 2, p = lane & 3;
    const LAS s16x4* a = (const LAS s16x4*)(lds + off + ((krow0 + 8 * g + q) * LD64 + col0) * 2 + 8 * p);
    const s16x4 v0 = __builtin_amdgcn_ds_read_tr16_b64_v4i16((LAS s16x4*)a), v1 = __builtin_amdgcn_ds_read_tr16_b64_v4i16((LAS s16x4*)(a + LD64));
    return (bf16x8){v0[0], v0[1], v0[2], v0[3], v1[0], v1[1], v1[2], v1[3]};
}
__device__ __forceinline__ void shift8(const bf16_t* pcur, const bf16_t* pprev, const float* mu, float* x) {
    float c[8], q[8];
    if (pcur) unpack8(*(const u32x4*)pcur, c); else {
#pragma unroll
        for (int i = 0; i < 8; ++i) c[i] = 0.f; }
    if (pprev) unpack8(*(const u32x4*)pprev, q); else {
#pragma unroll
        for (int i = 0; i < 8; ++i) q[i] = 0.f; }
    const f32x4 m0 = *(const f32x4*)mu, m1 = *(const f32x4*)(mu + 4);
    const float mm[8] = {m0.x, m0.y, m0.z, m0.w, m1.x, m1.y, m1.z, m1.w};
#pragma unroll
    for (int i = 0; i < 8; ++i) x[i] = c[i] + (q[i] - c[i]) * mm[i];
}

template <bool DO_P, bool DO_SQ>
__device__ __forceinline__ void dbl_step(ldsp lds, int sN, int sT, int dN, int dT, int pC, int pN, int tm, int tn0, int fr, int fq) {
    bf16x8 a[2];
#pragma unroll
    for (int ks = 0; ks < 2; ++ks) a[ks] = ldsfragTR(lds, sN, 32 * ks, 16 * tm, 16 * fq + fr);
#pragma unroll
    for (int t2 = 0; t2 < 2; ++t2) {
        const int nt = tn0 + t2, t = 16 * nt + fr, s0 = 16 * tm + 4 * fq;
        if (DO_P) {
            f32x4 acc = {0.f, 0.f, 0.f, 0.f};
#pragma unroll
            for (int ks = 0; ks < 2; ++ks) acc = mfma16(a[ks], ldsfrag(lds, pC, LD64, t, ks * 32 + fq * 8), acc);
            const u32x2 pw = *(const LAS u32x2*)(lds + pC + (t * LD64 + s0) * 2);
            acc.x += bflo(pw.x); acc.y += bfhi(pw.x); acc.z += bflo(pw.y); acc.w += bfhi(pw.y);
            st4(lds, pN, t, s0, acc);
        }
        if (DO_SQ) {
            f32x4 acc = {0.f, 0.f, 0.f, 0.f};
#pragma unroll
            for (int ks = 0; ks < 2; ++ks) acc = mfma16(a[ks], ldsfrag(lds, sN, LD64, t, ks * 32 + fq * 8), acc);
            st4(lds, dN, t, s0, acc);
        }
    }
}


struct PL { u32x4 rc, rq, kc, kq, vc, vq; };
__device__ __forceinline__ const bf16_t* unit_rowp(const bf16_t* pp, int u, int tl, int col) {
    int r;
    if (u >= 4096) r = (tl >= 48) ? (ROW_META + tl - 48) : -1;
    else { const int bh = u >> 6, c = u & 63, b = bh >> 5; r = (tl >= 0 || c > 0) ? (b * SEQ + c * 64 + tl) : (ROW_META + 15); }
    return r < 0 ? (const bf16_t*)nullptr : pp + (size_t)r * NPAD + col;
}
__device__ __forceinline__ void pl_load(const Params& P, int u, PL& L) {
    int tid = threadIdx.x; asm volatile("" : "+v"(tid));
    const int lane = tid & 63, wave = tid >> 6, fr = lane & 15, fq = lane >> 4, tm = wave >> 1;
    const bf16_t* pp = (const bf16_t*)(P.ws + WS_P);
    const int h = (u >= 4096) ? (u - 4096) : ((u >> 6) & 31);
    const int t = tid >> 3, hj = h * 64 + 8 * (tid & 7);
    L.rc = ld8(unit_rowp(pp, u, t, C_R + hj)); L.rq = ld8(unit_rowp(pp, u, t - 1, C_R + hj));
    L.kc = ld8(unit_rowp(pp, u, t, C_K + hj)); L.kq = ld8(unit_rowp(pp, u, t - 1, C_K + hj));
    L.vc = ld8(unit_rowp(pp, u, t, C_V + hj)); L.vq = ld8(unit_rowp(pp, u, t - 1, C_V + hj));
}
#define SINGLE_TRIP for (int once_ = 0; once_ < 1; ++once_)
__device__ __forceinline__ void rwkv_unit(const Params& P, ldsp lds, int u, PL& L, int next_u, bool stage_a) {
    int tid = threadIdx.x; asm volatile("" : "+v"(tid));
    const int lane = tid & 63, wave = tid >> 6, fr = lane & 15, fq = lane >> 4, tm = wave >> 1, tn0 = (wave & 1) * 2;
    unsigned char* ws = P.ws;
    const bf16_t* pp = (const bf16_t*)(ws + WS_P);
    const bool meta = u >= 4096;
    int b = 0, h, c = 0;
    if (meta) { h = u - 4096; } else { const int bh = u >> 6; c = u & 63; b = bh >> 5; h = bh & 31; }
    auto rowof = [&](int tl) -> int {
        if (meta) return (tl >= 48) ? (ROW_META + tl - 48) : -1;
        if (tl >= 0 || c > 0) return b * SEQ + c * 64 + tl;
        return ROW_META + 15;
    };
    auto rowp = [&](int tl, int col) -> const bf16_t* { const int r = rowof(tl); return r < 0 ? (const bf16_t*)nullptr : pp + (size_t)r * NPAD + col; };
    const float* mu = P.in[I_MU];
    float lw[8], av[8], rv[8], kv[8], vv[8], kk[8], km[8];
    const int t = tid >> 3, jq = tid & 7, j0 = 8 * jq, hj = h * 64 + j0;
    const bool nulltok = meta && t < 48;
    SINGLE_TRIP {
    bf16x8 lAw[3], lAa[3];
    {
        const bf16_t* ww2 = (const bf16_t*)(ws + WS_WTW2) + (size_t)(h * 64 + 16 * tm + fr) * 96 + fq * 8;
        const bf16_t* wa2 = (const bf16_t*)(ws + WS_WTA2) + (size_t)(h * 64 + 16 * tm + fr) * 96 + fq * 8;
#pragma unroll
        for (int ks = 0; ks < 3; ++ks) { lAw[ks] = *(const bf16x8*)(ww2 + ks * 32); lAa[ks] = *(const bf16x8*)(wa2 + ks * 32); }
    }
    if (stage_a) {
        u32x4 cw[3], pw[3];
#pragma unroll
        for (int it = 0; it < 3; ++it) { const int idx = tid + 512 * it, mat = idx / 768, rem = idx - mat * 768, tt = rem / 12, ch = rem - tt * 12, col = (mat ? C_AL : C_WL) + ch * 8;
            cw[it] = ld8(rowp(tt, col)); pw[it] = ld8(rowp(tt - 1, col)); }
#pragma unroll
        for (int it = 0; it < 3; ++it) { const int idx = tid + 512 * it, mat = idx / 768, rem = idx - mat * 768, tt = rem / 12, ch = rem - tt * 12, col = (mat ? C_AL : C_WL) + ch * 8;
            float x[8]; shift8r(cw[it], pw[it], mu + col, x);
            if (mat == 0) {
#pragma unroll
                for (int i = 0; i < 8; ++i) x[i] = fast_tanh(x[i]);
            }
            *(LAS u32x4*)(lds + (mat ? O_AL : O_WL) + (tt * LDKP + ch * 8) * 2) = pack8(x); }
    }
    BLOCK_SYNC();
    {
        f32x4 z[2] = {{0.f, 0.f, 0.f, 0.f}, {0.f, 0.f, 0.f, 0.f}}, az[2] = {{0.f, 0.f, 0.f, 0.f}, {0.f, 0.f, 0.f, 0.f}};
#pragma unroll
        for (int ks = 0; ks < 3; ++ks) {
            const bf16x8 aw = lAw[ks], aa = lAa[ks];
#pragma unroll
            for (int t2 = 0; t2 < 2; ++t2) {
                const int t = 16 * (tn0 + t2) + fr;
                z[t2] = mfma16(aw, ldsfrag(lds, O_WL, LDKP, t, ks * 32 + fq * 8), z[t2]);
                az[t2] = mfma16(aa, ldsfrag(lds, O_AL, LDKP, t, ks * 32 + fq * 8), az[t2]);
            }
        }
#pragma unroll
        for (int t2 = 0; t2 < 2; ++t2) {
            const int t = 16 * (tn0 + t2) + fr, j0 = 16 * tm + 4 * fq;
            *(LAS f32x4*)(lds + O_Z + (t * 68 + j0) * 4) = z[t2];
            *(LAS f32x4*)(lds + O_AZ + (t * 68 + j0) * 4) = az[t2];
        }
    }
    BLOCK_SYNC();
    float cs[8];
    {
        const f32x4 z0 = *(const LAS f32x4*)(lds + O_Z + (t * 68 + j0) * 4), z1 = *(const LAS f32x4*)(lds + O_Z + (t * 68 + j0 + 4) * 4);
        const f32x4 y0 = *(const LAS f32x4*)(lds + O_AZ + (t * 68 + j0) * 4), y1 = *(const LAS f32x4*)(lds + O_AZ + (t * 68 + j0 + 4) * 4);
        const float zz[8] = {z0.x, z0.y, z0.z, z0.w, z1.x, z1.y, z1.z, z1.w}, yy[8] = {y0.x, y0.y, y0.z, y0.w, y1.x, y1.y, y1.z, y1.w};
        const f32x4 w0a = *(const f32x4*)(P.in[I_W0] + hj), w0b = *(const f32x4*)(P.in[I_W0] + hj + 4), a0a = *(const f32x4*)(P.in[I_A0] + hj), a0b = *(const f32x4*)(P.in[I_A0] + hj + 4);
        const float w0[8] = {w0a.x, w0a.y, w0a.z, w0a.w, w0b.x, w0b.y, w0b.z, w0b.w}, a0[8] = {a0a.x, a0a.y, a0a.z, a0a.w, a0b.x, a0b.y, a0b.z, a0b.w};
#pragma unroll
        for (int i = 0; i < 8; ++i) { lw[i] = nulltok ? 0.f : -DSCALE * fast_sigmoid(w0[i] + zz[i]); av[i] = fast_sigmoid(a0[i] + yy[i]); cs[i] = lw[i]; }
#pragma unroll
        for (int d = 8; d < 64; d <<= 1) {
#pragma unroll
            for (int i = 0; i < 8; ++i) { const float o = __shfl_up(cs[i], d); cs[i] += (lane >= d) ? o : 0.f; }
        }
        if (lane >= 56) {
#pragma unroll
            for (int i = 0; i < 8; ++i) *(LAS float*)(lds + (wave < 4 ? O_BH : O_KH) + ((j0 + i) * LD64 + 64) * 2 + (wave & 3) * 4) = cs[i]; }
        shift8r(L.rc, L.rq, mu + C_R + hj, rv); shift8r(L.kc, L.kq, mu + C_K + hj, kv); shift8r(L.vc, L.vq, mu + C_V + hj, vv);
        if (nulltok) {
#pragma unroll
            for (int i = 0; i < 8; ++i) { rv[i] = 0.f; kv[i] = 0.f; vv[i] = 0.f; }
        }
        const f32x4 kka = *(const f32x4*)(P.in[I_KK] + hj), kkb = *(const f32x4*)(P.in[I_KK] + hj + 4), kaa = *(const f32x4*)(P.in[I_KA] + hj), kab = *(const f32x4*)(P.in[I_KA] + hj + 4);
        const f32x4 rka = *(const f32x4*)(P.in[I_RK] + hj), rkb = *(const f32x4*)(P.in[I_RK] + hj + 4);
        const float kkw[8] = {kka.x, kka.y, kka.z, kka.w, kkb.x, kkb.y, kkb.z, kkb.w}, kaw[8] = {kaa.x, kaa.y, kaa.z, kaa.w, kab.x, kab.y, kab.z, kab.w}, rkw[8] = {rka.x, rka.y, rka.z, rka.w, rkb.x, rkb.y, rkb.z, rkb.w};
        float n2 = 0.f, bon = 0.f;
#pragma unroll
        for (int i = 0; i < 8; ++i) { kk[i] = kv[i] * kkw[i]; n2 += kk[i] * kk[i]; km[i] = kv[i] * (1.0f + (av[i] - 1.0f) * kaw[i]); bon += rv[i] * km[i] * rkw[i]; }
        n2 += DPPF(n2, 0xB1); n2 += DPPF(n2, 0x4E); n2 += DPPF(n2, 0x141);
        bon += DPPF(bon, 0xB1); bon += DPPF(bon, 0x4E); bon += DPPF(bon, 0x141);
        const float inv = 1.0f / fmaxf(sqrtf(n2), 1e-12f);
#pragma unroll
        for (int i = 0; i < 8; ++i) kk[i] *= inv;
        if (!meta && jq == 0) ((float*)(ws + WS_BONUS))[(size_t)(b * SEQ + c * 64 + t) * 32 + h] = bon;
    }
    BLOCK_SYNC();
    {
        float Lc[8], Le[8];
#pragma unroll
        for (int i = 0; i < 8; ++i) { Lc[i] = cs[i]; Le[i] = 0.f; }
#pragma unroll
        for (int i = 0; i < 8; ++i) {
            const f32x4 wa = *(const LAS f32x4*)(lds + O_BH + ((j0 + i) * LD64 + 64) * 2), wb = *(const LAS f32x4*)(lds + O_KH + ((j0 + i) * LD64 + 64) * 2);
            const float ww[8] = {wa.x, wa.y, wa.z, wa.w, wb.x, wb.y, wb.z, wb.w};
#pragma unroll
            for (int w = 0; w < 8; ++w) { Le[i] += ww[w]; Lc[i] += (w < wave) ? ww[w] : 0.f; }
        }
        float Ab[8], Rb[8], Bh[8], Kh[8], Bt[8], Kt[8];
#pragma unroll
        for (int i = 0; i < 8; ++i) {
            const float eP = __expf(Lc[i] - lw[i]), eC = __expf(Lc[i]), eN = __expf(-Lc[i]), eE = __expf(Le[i] - Lc[i]);
            const float ka = kk[i] * av[i];
            Ab[i] = -kk[i] * eP; Rb[i] = rv[i] * eC; Bh[i] = ka * eN; Kh[i] = km[i] * eN; Bt[i] = ka * eE; Kt[i] = km[i] * eE;
        }
        *(LAS u32x4*)(lds + O_AB + (t * LD64 + j0) * 2) = pack8(Ab);
        *(LAS u32x4*)(lds + O_RB + (t * LD64 + j0) * 2) = pack8(Rb);
        *(LAS u32x4*)(lds + O_BH + (t * LD64 + j0) * 2) = pack8(Bh);
        *(LAS u32x4*)(lds + O_KH + (t * LD64 + j0) * 2) = pack8(Kh);
        *(LAS u32x4*)(lds + O_BTT + (t * LD64 + j0) * 2) = pack8(Bt);
        *(LAS u32x4*)(lds + O_KTT + (t * LD64 + j0) * 2) = pack8(Kt);
        *(LAS u32x4*)(lds + O_VT + (t * LD64 + j0) * 2) = pack8(vv);
        if (t == 63) {
#pragma unroll
            for (int i = 0; i < 8; ++i) *(LAS float*)(lds + O_RB + ((j0 + i) * LD64 + 64) * 2) = __expf(Le[i]);
        }
    }
    BLOCK_SYNC();
    }
    if (next_u >= 0) pl_load(P, next_u, L);
    SINGLE_TRIP {
    {
        bf16x8 abh[2], akh[2];
#pragma unroll
        for (int ks = 0; ks < 2; ++ks) { abh[ks] = ldsfrag(lds, O_BH, LD64, 16 * tm + fr, ks * 32 + fq * 8); akh[ks] = ldsfrag(lds, O_KH, LD64, 16 * tm + fr, ks * 32 + fq * 8); }
#pragma unroll
        for (int t2 = 0; t2 < 2; ++t2) {
            const int tt = 16 * (tn0 + t2) + fr, s0 = 16 * tm + 4 * fq;
            f32x4 mab = {0.f, 0.f, 0.f, 0.f}, mak = mab, mrb = mab, mrk = mab;
#pragma unroll
            for (int ks = 0; ks < 2; ++ks) {
                const bf16x8 bab = ldsfrag(lds, O_AB, LD64, tt, ks * 32 + fq * 8), brb = ldsfrag(lds, O_RB, LD64, tt, ks * 32 + fq * 8);
                mab = mfma16(abh[ks], bab, mab); mak = mfma16(akh[ks], bab, mak); mrb = mfma16(abh[ks], brb, mrb); mrk = mfma16(akh[ks], brb, mrk);
            }
            float vab[4] = {mab.x, mab.y, mab.z, mab.w}, vak[4] = {mak.x, mak.y, mak.z, mak.w}, vrb[4] = {mrb.x, mrb.y, mrb.z, mrb.w}, vrk[4] = {mrk.x, mrk.y, mrk.z, mrk.w}, vp[4];
#pragma unroll
            for (int r = 0; r < 4; ++r) { const int s = s0 + r; const bool st = s < tt, le = s <= tt;
                vab[r] = st ? vab[r] : 0.f; vak[r] = st ? vak[r] : 0.f; vrb[r] = le ? vrb[r] : 0.f; vrk[r] = le ? vrk[r] : 0.f; vp[r] = vab[r] + (s == tt ? 1.0f : 0.f); }
            st4(lds, O_M0, tt, s0, (f32x4){vab[0], vab[1], vab[2], vab[3]});
            st4(lds, O_PA, tt, s0, (f32x4){vp[0], vp[1], vp[2], vp[3]});
            st4(lds, O_MAK, tt, s0, (f32x4){vak[0], vak[1], vak[2], vak[3]});
            st4(lds, O_MRB, tt, s0, (f32x4){vrb[0], vrb[1], vrb[2], vrb[3]});
            st4(lds, O_MRK, tt, s0, (f32x4){vrk[0], vrk[1], vrk[2], vrk[3]});
        }
    }
    BLOCK_SYNC();
    dbl_step<false, true>(lds, O_M0, O_M0T, O_M1, O_M1T, 0, 0, tm, tn0, fr, fq); BLOCK_SYNC();
    dbl_step<true, true>(lds, O_M1, O_M1T, O_M0, O_M0T, O_PA, O_PB, tm, tn0, fr, fq); BLOCK_SYNC();
    dbl_step<true, true>(lds, O_M0, O_M0T, O_M1, O_M1T, O_PB, O_PA, tm, tn0, fr, fq); BLOCK_SYNC();
    dbl_step<true, true>(lds, O_M1, O_M1T, O_M0, O_M0T, O_PA, O_PB, tm, tn0, fr, fq); BLOCK_SYNC();
    if (!meta) {
    dbl_step<true, true>(lds, O_M0, O_M0T, O_M1, O_M1T, O_PB, O_PA, tm, tn0, fr, fq); BLOCK_SYNC();
    dbl_step<true, false>(lds, O_M1, O_M1T, 0, 0, O_PA, O_PB, tm, tn0, fr, fq); BLOCK_SYNC();
    }
    }
    const size_t ub = (size_t)u * 4096;
    SINGLE_TRIP {
    {
        bf16x8 aT[2], aMak[2];
#pragma unroll
        for (int ks = 0; ks < 2; ++ks) { aT[ks] = ldsfrag(lds, O_PB, LD64, 16 * tm + fr, ks * 32 + fq * 8); aMak[ks] = ldsfrag(lds, O_MAK, LD64, 16 * tm + fr, ks * 32 + fq * 8); }
#pragma unroll
        for (int t2 = 0; t2 < 2; ++t2) {
            const int n = 16 * (tn0 + t2) + fr, t0 = 16 * tm + 4 * fq;
            f32x4 at = {0.f, 0.f, 0.f, 0.f}, xt = at;
#pragma unroll
            for (int ks = 0; ks < 2; ++ks) { at = mfma16(aT[ks], ldsfragTR(lds, O_AB, 32 * ks, 16 * (tn0 + t2), 16 * fq + fr), at); xt = mfma16(aMak[ks], ldsfragTR(lds, O_VT, 32 * ks, 16 * (tn0 + t2), 16 * fq + fr), xt); }
            st4(lds, O_M0, n, t0, at); st4(lds, O_M0T, n, t0, xt);
        }
    }
    BLOCK_SYNC();
    {
        bf16x8 aT[2], aAt[2];
#pragma unroll
        for (int ks = 0; ks < 2; ++ks) { aT[ks] = ldsfrag(lds, O_PB, LD64, 16 * tm + fr, ks * 32 + fq * 8); aAt[ks] = ldsfrag(lds, O_M0, LD64, 16 * tm + fr, ks * 32 + fq * 8); }
        bf16_t* Rt = (bf16_t*)(ws + WS_RT) + ub; bf16_t* Gp = (bf16_t*)(ws + WS_G) + ub;
#pragma unroll
        for (int t2 = 0; t2 < 2; ++t2) {
            const int n = 16 * (tn0 + t2) + fr, m0 = 16 * tm + 4 * fq;
            f32x4 u0 = {0.f, 0.f, 0.f, 0.f}, rt = u0, g = u0;
#pragma unroll
            for (int ks = 0; ks < 2; ++ks) {
                u0 = mfma16(aT[ks], ldsfrag(lds, O_M0T, LD64, n, ks * 32 + fq * 8), u0);
                rt = mfma16(aAt[ks], ldsfrag(lds, O_MRB, LD64, n, ks * 32 + fq * 8), rt);
                g = mfma16(aAt[ks], ldsfragTR(lds, O_BTT, 32 * ks, 16 * (tn0 + t2), 16 * fq + fr), g);
            }
            st4(lds, O_M1, n, m0, u0);
            const u32x2 rw = *(const LAS u32x2*)(lds + O_RB + (n * LD64 + m0) * 2);
            rt.x += bflo(rw.x); rt.y += bfhi(rw.x); rt.z += bflo(rw.y); rt.w += bfhi(rw.y);
            { u32x2 w; w.x = pk2(rt.x, rt.y); w.y = pk2(rt.z, rt.w); *(u32x2*)(Rt + n * 64 + m0) = w; }
            if ((n >> 2) == (m0 >> 2)) { const float e = *(const LAS float*)(lds + O_RB + (n * LD64 + 64) * 2); const int r = n & 3;
                g.x += (r == 0) ? e : 0.f; g.y += (r == 1) ? e : 0.f; g.z += (r == 2) ? e : 0.f; g.w += (r == 3) ? e : 0.f; }
            { const int pos0 = 32 * (tm >> 1) + 8 * fq + 4 * (tm & 1); u32x2 w; w.x = pk2(g.x, g.y); w.y = pk2(g.z, g.w); *(u32x2*)(Gp + n * 64 + pos0) = w; }
        }
    }
    BLOCK_SYNC();
    {
        bf16x8 aB[2], aK[2], aU[2], aV[2];
#pragma unroll
        for (int ks = 0; ks < 2; ++ks) { const int row = 16 * tm + fr, ko = ks * 32 + fq * 8;
            aB[ks] = ldsfragTR(lds, O_BTT, 32 * ks, 16 * tm, 16 * fq + fr); aK[ks] = ldsfragTR(lds, O_KTT, 32 * ks, 16 * tm, 16 * fq + fr); aU[ks] = ldsfrag(lds, O_M1, LD64, row, ko); aV[ks] = ldsfragTR(lds, O_VT, 32 * ks, 16 * tm, 16 * fq + fr); }
        bf16_t* H0t = (bf16_t*)(ws + WS_H0T) + ub; bf16_t* Y0s = (bf16_t*)(ws + WS_Y0) + ub;
#pragma unroll
        for (int t2 = 0; t2 < 2; ++t2) {
            const int n = 16 * (tn0 + t2) + fr, m0 = 16 * tm + 4 * fq;
            f32x4 hh = {0.f, 0.f, 0.f, 0.f}, yy = hh;
#pragma unroll
            for (int ks = 0; ks < 2; ++ks) { const int ko = ks * 32 + fq * 8;
                const bf16x8 bU = ldsfrag(lds, O_M1, LD64, n, ko), bV = ldsfragTR(lds, O_VT, 32 * ks, 16 * (tn0 + t2), 16 * fq + fr), bRb = ldsfrag(lds, O_MRB, LD64, n, ko), bRk = ldsfrag(lds, O_MRK, LD64, n, ko);
                hh = mfma16(aB[ks], bU, hh); hh = mfma16(aK[ks], bV, hh);
                yy = mfma16(aU[ks], bRb, yy); yy = mfma16(aV[ks], bRk, yy); }
            { u32x2 w; w.x = pk2(hh.x, hh.y); w.y = pk2(hh.z, hh.w); *(u32x2*)(H0t + n * 64 + m0) = w; }
            { u32x2 w; w.x = pk2(yy.x, yy.y); w.y = pk2(yy.z, yy.w); *(u32x2*)(Y0s + n * 64 + m0) = w; }
        }
    }
    BLOCK_SYNC();
    }
}

constexpr int LDU = 264;
__device__ __forceinline__ void pool_load(const Params& P, int pu, u32x4 (&raw)[5]) {
    int tid = threadIdx.x; asm volatile("" : "+v"(tid));
    const bf16_t* pp = (const bf16_t*)(P.ws + WS_P);
    const int g = (pu < 256) ? (pu & 3) : 3 - (pu & 3), tt = pu >> 2, b = tt >> 6, ti0 = (tt & 63) * 64;
#pragma unroll
    for (int k = 0; k < 5; ++k) { const int idx = tid + 512 * k;
        if (idx < 79 * 32) { const int lr = idx >> 5, ch = idx & 31, ti = ti0 + lr - 15; const int row = ti >= 0 ? b * SEQ + ti : ROW_META + 16 + ti;
            raw[k] = *(const u32x4*)(pp + (size_t)row * NPAD + C_POOL + g * 256 + ch * 8); } }
}
__device__ __forceinline__ void pool_unit(const Params& P, ldsp lds, int pu, const u32x4 (&raw)[5]) {
    int tid = threadIdx.x; asm volatile("" : "+v"(tid));
    const int lane = tid & 63, wave = tid >> 6, fr = lane & 15, fq = lane >> 4;
    unsigned char* ws = P.ws;
    const bf16_t* pp = (const bf16_t*)(ws + WS_P);
    const int g = (pu < 256) ? (pu & 3) : 3 - (pu & 3), tt = pu >> 2, b = tt >> 6, ti0 = (tt & 63) * 64;
    constexpr int O_U = 0, O_PL = 79 * LDU * 2;
#pragma unroll
    for (int k = 0; k < 5; ++k) { const int idx = tid + 512 * k; if (idx < 79 * 32) *(LAS u32x4*)(lds + O_U + ((idx >> 5) * LDU + (idx & 31) * 8) * 2) = raw[k]; }
    BLOCK_SYNC();
    {
        const int c0 = (tid & 31) * 8, t0 = (tid >> 5) * 4, win = 2 << g; const float inv = 1.0f / (float)win;
        float s[8], nw[8];
        unpack8(*(const LAS u32x4*)(lds + O_U + ((15 + t0) * LDU + c0) * 2), nw);
#pragma unroll
        for (int i = 0; i < 8; ++i) s[i] = nw[i];
        for (int d = 1; d < win; ++d) { float x[8]; unpack8(*(const LAS u32x4*)(lds + O_U + ((15 + t0 - d) * LDU + c0) * 2), x);
#pragma unroll
            for (int i = 0; i < 8; ++i) s[i] += x[i]; }
#pragma unroll
        for (int k = 0; k < 4; ++k) {
            if (k > 0) { float od[8]; unpack8(*(const LAS u32x4*)(lds + O_U + ((15 + t0 + k) * LDU + c0) * 2), nw); unpack8(*(const LAS u32x4*)(lds + O_U + ((15 + t0 + k - win) * LDU + c0) * 2), od);
#pragma unroll
                for (int i = 0; i < 8; ++i) s[i] += nw[i] - od[i]; }
            float o[8];
#pragma unroll
            for (int i = 0; i < 8; ++i) o[i] = s[i] * inv - nw[i];
            *(LAS u32x4*)(lds + O_PL + ((t0 + k) * LDU + c0) * 2) = pack8(o);
        }
    }
    BLOCK_SYNC();
    {
        const bf16_t* wt = (const bf16_t*)(ws + WS_WTPOOL) + (size_t)g * 65536;
        f32x4 acc[2][4];
#pragma unroll
        for (int a = 0; a < 2; ++a)
#pragma unroll
            for (int n = 0; n < 4; ++n) acc[a][n] = (f32x4){0.f, 0.f, 0.f, 0.f};
#pragma unroll 4
        for (int ks = 0; ks < 8; ++ks) {
            bf16x8 af[2];
#pragma unroll
            for (int a = 0; a < 2; ++a) af[a] = *(const bf16x8*)(wt + (size_t)(32 * wave + 16 * a + fr) * 256 + ks * 32 + fq * 8);
#pragma unroll
            for (int n = 0; n < 4; ++n) { const bf16x8 bf = ldsfrag(lds, O_PL, LDU, 16 * n + fr, ks * 32 + fq * 8);
#pragma unroll
                for (int a = 0; a < 2; ++a) acc[a][n] = mfma16(af[a], bf, acc[a][n]); }
        }
#ifdef P5_F8
        unsigned char* yb = ws + WS_YAB + 2048;
#else
        bf16_t* yb = (bf16_t*)(ws + WS_YAB) + 2048;
#endif
        const float* psc = P.in[I_PSCALE] + g * 256;
#pragma unroll
        for (int a = 0; a < 2; ++a) { const int d0 = 32 * wave + 16 * a + 4 * fq; const f32x4 sc = *(const f32x4*)(psc + d0);
#pragma unroll
            for (int n = 0; n < 4; ++n) { const int t = 16 * n + fr; const f32x4 o = acc[a][n] * sc;
#ifdef P5_F8
                *(unsigned*)(yb + (size_t)(b * SEQ + ti0 + t) * LDAB + g * 256 + d0) = pk4_fp8(o.x, o.y, o.z, o.w); } }
#else
                u32x2 w; w.x = pk2(o.x, o.y); w.y = pk2(o.z, o.w);
                *(u32x2*)(yb + (size_t)(b * SEQ + ti0 + t) * LDAB + g * 256 + d0) = w; } }
#endif
    }
    BLOCK_SYNC();
}
__device__ __forceinline__ void gsig_unit(const Params& P, int gu) {
    int tid = threadIdx.x; asm volatile("" : "+v"(tid));
    const bf16_t* pp = (const bf16_t*)(P.ws + WS_P); bf16_t* gs = (bf16_t*)(P.ws + WS_GSIG);
    const float* mu = P.in[I_MU];
#pragma unroll
    for (int it = 0; it < 4; ++it) {
        const int idx = tid + 512 * it, tl = idx >> 5, ch = idx & 31, col = C_GL + ch * 8;
        const int row = gu * 64 + tl; const int prow = ((row & (SEQ - 1)) == 0) ? (ROW_META + 15) : row - 1;
        float x[8]; shift8r(*(const u32x4*)(pp + (size_t)row * NPAD + col), *(const u32x4*)(pp + (size_t)prow * NPAD + col), mu + col, x);
#pragma unroll
        for (int i = 0; i < 8; ++i) x[i] = fast_sigmoid(x[i]);
        *(u32x4*)(gs + (size_t)row * 256 + ch * 8) = pack8(x);
    }
}
__device__ __forceinline__ void phase2(const Params& P, ldsp lds) {
    PL L;
    for (int j = blockIdx.x; j < 256 + 32 + 128; j += gridDim.x) {
        if (j < 256) {
            const int b = j >> 7, c = (j >> 1) & 63, h0 = (j & 1) * 16;
            pl_load(P, (b * 32 + h0) * 64 + c, L);
            for (int i = 0; i < 16; ++i) { const int u = (b * 32 + h0 + i) * 64 + c; rwkv_unit(P, lds, u, L, i + 1 < 16 ? u + 64 : -1, i == 0); }
        } else if (j < 288) { pl_load(P, 4096 + (j - 256), L); rwkv_unit(P, lds, 4096 + (j - 256), L, -1, true); }
        else gsig_unit(P, j - 288);
    }
}
__device__ __forceinline__ void phase3(const Params& P) {
    const int lane = threadIdx.x & 63, wave = threadIdx.x >> 6, fr = lane & 15, fq = lane >> 4;
    if (wave != 0) { convert_tables(P, blockIdx.x * 7 + (wave - 1), CONV_P3_END, gridDim.x * 7); return; }
    unsigned char* ws = P.ws;
    const bf16_t* Gp = (const bf16_t*)(ws + WS_G); const bf16_t* H0t = (const bf16_t*)(ws + WS_H0T); bf16_t* S0t = (bf16_t*)(ws + WS_S0T);
    for (int item = blockIdx.x; item < 256; item += gridDim.x) {
        const int bh = item >> 2, vq = item & 3, h = bh & 31;
        bf16x8 Sb[2];
#pragma unroll
        for (int ks = 0; ks < 2; ++ks)
#pragma unroll
            for (int i = 0; i < 8; ++i) Sb[ks][i] = 0;
        bf16x8 g0[4][2], g1[4][2], g2[4][2], g3[4][2]; u32x2 h0[4], h1[4], h2[4], h3[4];
        auto load = [&](int step, bf16x8 (&ga)[4][2], u32x2 (&hf)[4]) {
            const int u = (step == 0) ? (4096 + h) : (bh * 64 + step - 1);
            const bf16_t* g = Gp + (size_t)u * 4096; const bf16_t* hh = H0t + (size_t)u * 4096;
#pragma unroll
            for (int mt = 0; mt < 4; ++mt) {
#pragma unroll
                for (int ks = 0; ks < 2; ++ks) ga[mt][ks] = *(const bf16x8*)(g + (16 * mt + fr) * 64 + ks * 32 + fq * 8);
                hf[mt] = *(const u32x2*)(hh + (16 * vq + fr) * 64 + 16 * mt + 4 * fq);
            }
        };
        auto apply = [&](int step, const bf16x8 (&ga)[4][2], const u32x2 (&hf)[4]) {
            f32x4 acc[4];
#pragma unroll
            for (int mt = 0; mt < 4; ++mt) {
                acc[mt] = (f32x4){bflo(hf[mt].x), bfhi(hf[mt].x), bflo(hf[mt].y), bfhi(hf[mt].y)};
                acc[mt] = mfma16(ga[mt][0], Sb[0], acc[mt]);
                acc[mt] = mfma16(ga[mt][1], Sb[1], acc[mt]);
            }
            bf16_t* so = S0t + (size_t)(bh * 64 + step) * 4096 + (16 * vq + fr) * 64 + 4 * fq;
            u32x2 w[4];
#pragma unroll
            for (int mt = 0; mt < 4; ++mt) { w[mt].x = pk2(acc[mt].x, acc[mt].y); w[mt].y = pk2(acc[mt].z, acc[mt].w); *(u32x2*)(so + 16 * mt) = w[mt]; }
#pragma unroll
            for (int ks = 0; ks < 2; ++ks) {
                const u32x4 q4 = (u32x4){w[2 * ks].x, w[2 * ks].y, w[2 * ks + 1].x, w[2 * ks + 1].y};
                Sb[ks] = __builtin_bit_cast(bf16x8, q4);
            }
        };
        load(0, g0, h0); load(1, g1, h1); load(2, g2, h2);
#pragma unroll 1
        for (int step = 0; step < 64; step += 4) {
            load(step + 3, g3, h3); apply(step, g0, h0);
            if (step + 4 < 64) load(step + 4, g0, h0);
            apply(step + 1, g1, h1);
            if (step + 5 < 64) load(step + 5, g1, h1);
            apply(step + 2, g2, h2);
            if (step + 6 < 64) load(step + 6, g2, h2);
            apply(step + 3, g3, h3);
        }
    }
}

constexpr int LDG = 264;
__device__ __forceinline__ void phase3b(const Params& P, ldsp lds) {
    int tid = threadIdx.x; asm volatile("" : "+v"(tid));
    const int lane = tid & 63, wave = tid >> 6, fr = lane & 15, fq = lane >> 4, wq = wave & 3;
    unsigned char* ws = P.ws;
    const bf16_t* pp = (const bf16_t*)(ws + WS_P);
    const float* mu = P.in[I_MU];
    constexpr int O_G2 = 0, O_HP = 64 * LDG * 2;
    {
        u32x4 ra[5], rb[5]; int pu = blockIdx.x;
        if (pu < 512) pool_load(P, pu, ra);
        for (; pu < 512; pu += gridDim.x) {
            const int pn = pu + gridDim.x;
            if (pn < 512) pool_load(P, pn, rb);
            pool_unit(P, lds, pu, ra);
#pragma unroll
            for (int k = 0; k < 5; ++k) ra[k] = rb[k];
        }
    }
    for (int w = blockIdx.x; w < 256; w += gridDim.x) {
        const int h = w & 31;
        BLOCK_SYNC();
        for (int idx = tid; idx < 64 * 32; idx += 512) { const int row = idx >> 5, ch = idx & 31;
            *(LAS u32x4*)(lds + O_G2 + (row * LDG + ch * 8) * 2) = *(const u32x4*)((const bf16_t*)(ws + WS_WTG2) + (size_t)(h * 64 + row) * 256 + ch * 8); }
        if (tid < 48) { const int a = tid >> 4, q4 = tid & 15; const float* src = a == 0 ? P.in[I_GNG] + h * 64 : a == 1 ? P.in[I_GNB] + h * 64 : mu + C_V + h * 64;
            *(LAS f32x4*)(lds + O_HP + a * 256 + q4 * 16) = *(const f32x4*)(src + q4 * 4); }
        BLOCK_SYNC();
        bf16x8 bG[8], bR[2], aS[4][2]; u32x2 yw[4], vc[4], vp[4]; float bon;
        auto unit_of = [&](int it, int& b, int& c) { const int q = (w >> 5) + 8 * (2 * it + (wave >> 2)); b = q >> 6; c = q & 63; };
        auto issue = [&](int it) {
            int b, c; unit_of(it, b, c); const int u = (b * 32 + h) * 64 + c, trow0 = b * SEQ + c * 64 + 16 * wq;
            const size_t ub = (size_t)u * 4096;
            const bf16_t* S0t = (const bf16_t*)(ws + WS_S0T) + ub; const bf16_t* Rt = (const bf16_t*)(ws + WS_RT) + ub; const bf16_t* Y0s = (const bf16_t*)(ws + WS_Y0) + ub;
            const int row = trow0 + fr; const int prow = (c == 0 && wq == 0 && fr == 0) ? (ROW_META + 15) : row - 1;
            const bf16_t* gsr = (const bf16_t*)(ws + WS_GSIG) + (size_t)row * 256 + fq * 8;
#pragma unroll
            for (int ks = 0; ks < 8; ++ks) bG[ks] = *(const bf16x8*)(gsr + ks * 32);
#pragma unroll
            for (int ks = 0; ks < 2; ++ks) bR[ks] = *(const bf16x8*)(Rt + (16 * wq + fr) * 64 + ks * 32 + fq * 8);
#pragma unroll
            for (int mt = 0; mt < 4; ++mt) {
                yw[mt] = *(const u32x2*)(Y0s + (16 * wq + fr) * 64 + 16 * mt + 4 * fq);
#pragma unroll
                for (int ks = 0; ks < 2; ++ks) aS[mt][ks] = *(const bf16x8*)(S0t + (16 * mt + fr) * 64 + ks * 32 + fq * 8);
                const int hc = h * 64 + 16 * mt + 4 * fq;
                vc[mt] = *(const u32x2*)(pp + (size_t)row * NPAD + C_V + hc); vp[mt] = *(const u32x2*)(pp + (size_t)prow * NPAD + C_V + hc);
            }
            bon = ((const float*)(ws + WS_BONUS))[(size_t)row * 32 + h];
        };
        issue(0);
#pragma unroll 1
        for (int it = 0; it < 8; ++it) {
            const int crow = CONV_P3_END + (w * 8 + it) * 8 + wave; f32x4 tv[8];
            if (crow < 32768) convert_ld(P, crow, lane, tv);
            int b, c; unit_of(it, b, c);
            const int row = b * SEQ + c * 64 + 16 * wq + fr;
            f32x4 gacc[4];
#pragma unroll
            for (int mt = 0; mt < 4; ++mt) gacc[mt] = (f32x4){0.f, 0.f, 0.f, 0.f};
#pragma unroll
            for (int ks = 0; ks < 8; ++ks)
#pragma unroll
                for (int mt = 0; mt < 4; ++mt) gacc[mt] = mfma16(*(const LAS bf16x8*)(lds + O_G2 + ((16 * mt + fr) * LDG + ks * 32 + fq * 8) * 2), bG[ks], gacc[mt]);
            f32x4 y[4], vv[4]; const float bonc = bon;
#pragma unroll
            for (int mt = 0; mt < 4; ++mt) {
                y[mt] = (f32x4){bflo(yw[mt].x), bfhi(yw[mt].x), bflo(yw[mt].y), bfhi(yw[mt].y)};
#pragma unroll
                for (int ks = 0; ks < 2; ++ks) y[mt] = mfma16(aS[mt][ks], bR[ks], y[mt]);
                const f32x4 mv = *(const LAS f32x4*)(lds + O_HP + 512 + (16 * mt + 4 * fq) * 4);
                const f32x4 cv = (f32x4){bflo(vc[mt].x), bfhi(vc[mt].x), bflo(vc[mt].y), bfhi(vc[mt].y)}, pv = (f32x4){bflo(vp[mt].x), bfhi(vp[mt].x), bflo(vp[mt].y), bfhi(vp[mt].y)};
                vv[mt] = cv + (pv - cv) * mv;
            }
#pragma unroll
            for (int mt = 0; mt < 4; ++mt) asm volatile("" : "+v"(y[mt]), "+v"(vv[mt]), "+v"(gacc[mt]));
            if (it + 1 < 8) issue(it + 1);
            float s = 0.f;
#pragma unroll
            for (int mt = 0; mt < 4; ++mt) s += (y[mt].x + y[mt].y) + (y[mt].z + y[mt].w);
            s += __shfl_xor(s, 16); s += __shfl_xor(s, 32);
            const float mean = s * (1.0f / 64.0f); float qq = 0.f;
#pragma unroll
            for (int mt = 0; mt < 4; ++mt) { y[mt] = y[mt] - mean; qq += (y[mt].x * y[mt].x + y[mt].y * y[mt].y) + (y[mt].z * y[mt].z + y[mt].w * y[mt].w); }
            qq += __shfl_xor(qq, 16); qq += __shfl_xor(qq, 32);
            const float rstd = 1.0f / sqrtf(qq * (1.0f / 64.0f) + GN_EPS);
#ifdef P5_F8
            unsigned char* ya = ws + WS_YAB + (size_t)row * LDAB + h * 64;
#else
            bf16_t* ya = (bf16_t*)(ws + WS_YAB) + (size_t)row * LDAB + h * 64;
#endif
#pragma unroll
            for (int mt = 0; mt < 4; ++mt) {
                const int i0 = 16 * mt + 4 * fq, hc = h * 64 + i0;
                const f32x4 gg = *(const LAS f32x4*)(lds + O_HP + i0 * 4), gb = *(const LAS f32x4*)(lds + O_HP + 256 + i0 * 4);
                const f32x4 o = (y[mt] * rstd * gg + gb + vv[mt] * bonc) * gacc[mt];
#ifdef P5_F8
                *(unsigned*)(ya + i0) = pk4_fp8(o.x, o.y, o.z, o.w);
#else
                u32x2 wv; wv.x = pk2(o.x, o.y); wv.y = pk2(o.z, o.w);
                *(u32x2*)(ya + i0) = wv;
#endif
            }
            if (crow < 32768) convert_row(ws, crow, lane, tv);
        }
    }
}
__device__ __forceinline__ u32x6 ld_row6(const unsigned char* p) { const u32x2 a = ((const u32x2*)p)[0], b = ((const u32x2*)p)[1], c = ((const u32x2*)p)[2]; return (u32x6){a.x, a.y, b.x, b.y, c.x, c.y}; }
__device__ __forceinline__ void peer_load_x(const Params& P, ldsp lds, int o_par, int tok, int lo, float (&x)[32]) {
    unsigned char* ws = P.ws;
    const bf16_t* hr = (const bf16_t*)(ws + WS_X1B) + (size_t)tok * D + lo * 4;
#pragma unroll
    for (int j = 0; j < 8; ++j) { const u32x2 w = *(const u32x2*)(hr + 256 * j); x[4 * j] = bflo(w.x); x[4 * j + 1] = bfhi(w.x); x[4 * j + 2] = bflo(w.y); x[4 * j + 3] = bfhi(w.y); }
    const float* st = (const float*)(ws + WS_STAT);
    const float mean1 = st[tok] * (1.0f / D), rstd1 = 1.0f / sqrtf(fmaxf(st[8192 + tok] * (1.0f / D) - mean1 * mean1, 0.f) + LN_EPS);
#pragma unroll
    for (int c = 0; c < 8; ++c) { const f32x4 g1 = *(const LAS f32x4*)(lds + o_par + (lo * 4 + 256 * c) * 4), b1 = *(const LAS f32x4*)(lds + o_par + 8192 + (lo * 4 + 256 * c) * 4);
        x[4 * c] = (x[4 * c] - mean1) * rstd1 * g1.x + b1.x; x[4 * c + 1] = (x[4 * c + 1] - mean1) * rstd1 * g1.y + b1.y; x[4 * c + 2] = (x[4 * c + 2] - mean1) * rstd1 * g1.z + b1.z; x[4 * c + 3] = (x[4 * c + 3] - mean1) * rstd1 * g1.w + b1.w; }
}
__device__ __forceinline__ void peer_finish(const Params& P, ldsp lds, int o_par, int tok, int lo, float (&o)[32]) {
    float x[32]; peer_load_x(P, lds, o_par, tok, lo, x);
    float s = 0.f;
#pragma unroll
    for (int i = 0; i < 32; ++i) { o[i] += DN_ALPHA * x[i]; s += o[i]; }
    const float mean = wave_sum_dpp(s) * (1.0f / D); float q = 0.f;
#pragma unroll
    for (int i = 0; i < 32; ++i) { o[i] -= mean; q += o[i] * o[i]; }
    const float rstd = 1.0f / sqrtf(wave_sum_dpp(q) * (1.0f / D) + LN_EPS);
    float* orow = P.out + (size_t)tok * D;
#pragma unroll
    for (int c = 0; c < 8; ++c) {
        const int off = lo * 4 + 256 * c;
        const f32x4 g0 = *(const LAS f32x4*)(lds + o_par + 16384 + off * 4), b0 = *(const LAS f32x4*)(lds + o_par + 24576 + off * 4);
        f32x4 r0;
        r0.x = o[4 * c + 0] * rstd * g0.x + b0.x; r0.y = o[4 * c + 1] * rstd * g0.y + b0.y; r0.z = o[4 * c + 2] * rstd * g0.z + b0.z; r0.w = o[4 * c + 3] * rstd * g0.w + b0.w;
        *(f32x4*)(orow + off) = r0;
    }
}
__device__ __forceinline__ float peer_dot(const u32x4 uu, const unsigned (&xd0)[4], const unsigned (&xd1)[4]) {
    int a0 = 0, a1 = 0; const unsigned ww[4] = {uu.x, uu.y, uu.z, uu.w};
#pragma unroll
    for (int q4 = 0; q4 < 4; ++q4) { a0 = __builtin_amdgcn_sdot8((int)ww[q4], (int)xd0[q4], a0, false); a1 = __builtin_amdgcn_sdot8((int)ww[q4], (int)xd1[q4], a1, false); }
    return (float)(a0 + (a1 << 4));
}
__device__ __forceinline__ void peer_axpy(const u32x4 vv, float a, float (&o)[32]) {
    const f32x2 a2 = {a, a}; const unsigned ww[4] = {vv.x, vv.y, vv.z, vv.w};
#pragma unroll
    for (int q4 = 0; q4 < 4; ++q4) {
        const f32x2 r0 = __builtin_amdgcn_cvt_scalef32_pk_f32_fp4(ww[q4], 1.0f, 0), r1 = __builtin_amdgcn_cvt_scalef32_pk_f32_fp4(ww[q4], 1.0f, 1), r2 = __builtin_amdgcn_cvt_scalef32_pk_f32_fp4(ww[q4], 1.0f, 2), r3 = __builtin_amdgcn_cvt_scalef32_pk_f32_fp4(ww[q4], 1.0f, 3);
        f32x2 t;
        t = __builtin_elementwise_fma(a2, r0, (f32x2){o[8 * q4], o[8 * q4 + 1]}); o[8 * q4] = t.x; o[8 * q4 + 1] = t.y;
        t = __builtin_elementwise_fma(a2, r1, (f32x2){o[8 * q4 + 2], o[8 * q4 + 3]}); o[8 * q4 + 2] = t.x; o[8 * q4 + 3] = t.y;
        t = __builtin_elementwise_fma(a2, r2, (f32x2){o[8 * q4 + 4], o[8 * q4 + 5]}); o[8 * q4 + 4] = t.x; o[8 * q4 + 5] = t.y;
        t = __builtin_elementwise_fma(a2, r3, (f32x2){o[8 * q4 + 6], o[8 * q4 + 7]}); o[8 * q4 + 6] = t.x; o[8 * q4 + 7] = t.y; }
}
__device__ __forceinline__ void peer_round(const Params& P, ldsp lds, int o_ex, int o_gt, int o_list, int o_par, int tok, int tl) {
    int lo = threadIdx.x & 63; asm volatile("" : "+v"(lo));
    const int wave = threadIdx.x >> 6;
    unsigned char* ws = P.ws;
    const unsigned char* Ub = ws + WS_UB; const unsigned char* Vb = ws + WS_VB;
    const float* tsc = (const float*)(ws + WS_TSC);
    float o[32]; unsigned xd0[4], xd1[4]; float sxi;
    {
        float x[32]; peer_load_x(P, lds, o_par, tok, lo, x);
        float ax = 0.f;
#pragma unroll
        for (int i = 0; i < 32; ++i) ax = fmaxf(ax, fabsf(x[i]));
        ax = wave_max_dpp(ax);
        const float sx = ax > 0.f ? 119.0f / ax : 0.f; sxi = ax * (1.0f / 119.0f);
#pragma unroll
        for (int jw = 0; jw < 4; ++jw) { unsigned w0 = 0, w1 = 0;
#pragma unroll
            for (int i = 0; i < 8; ++i) { const unsigned b = __float_as_uint(fmaf(x[8 * jw + i], sx, 12582912.0f));
                w0 = __builtin_amdgcn_alignbit(b, w0, 4); w1 = __builtin_amdgcn_alignbit((b + 8u) >> 4, w1, 4); }
            xd0[jw] = w0; xd1[jw] = w1; }
    }
#pragma unroll
    for (int i = 0; i < 32; ++i) o[i] = 0.f;
    const LAS int* ex = (const LAS int*)(lds + o_ex) + tl * 128; const LAS float* gt = (const LAS float*)(lds + o_gt) + tl * 128;
    const int el = ex[lo], eh = ex[64 + lo];
    const float sul = tsc[el] * sxi, suh = tsc[eh] * sxi;
    const float gvl = gt[lo] * tsc[16384 + el], gvh = gt[64 + lo] * tsc[16384 + eh];
    LAS unsigned* lE = (LAS unsigned*)(lds + o_list) + wave * 384; LAS float* lS = (LAS float*)(lE + 128); LAS float* lG = (LAS float*)(lE + 256);
    {
        const int sl = el >> 10, sh = eh >> 10; int base = 0, pl = 0, ph = 0;
#define LT_COUNT(m) ((int)__builtin_amdgcn_mbcnt_hi((unsigned)((m) >> 32), __builtin_amdgcn_mbcnt_lo((unsigned)(m), 0u)))
#pragma unroll
        for (int s = 0; s < 16; ++s) {
            const unsigned long long ml = __ballot(sl == s), mh = __ballot(sh == s);
            const int cl = __popcll(ml);
            pl = (sl == s) ? base + LT_COUNT(ml) : pl; ph = (sh == s) ? base + cl + LT_COUNT(mh) : ph;
            base += cl + __popcll(mh);
        }
#undef LT_COUNT
        lE[pl] = (unsigned)el; lS[pl] = sul; lG[pl] = gvl; lE[ph] = (unsigned)eh; lS[ph] = suh; lG[ph] = gvh;
        asm volatile("s_waitcnt lgkmcnt(0)" ::: "memory");
    }
    u32x4 ua[4], ub[4]; u32x4 va[4], vb[4];
    auto issue = [&](int gi, u32x4 (&uu)[4], u32x4 (&vv)[4]) {
        const u32x4 e4 = *(const LAS u32x4*)(lE + 4 * gi);
        const unsigned ee[4] = {(unsigned)__builtin_amdgcn_readfirstlane((int)e4.x), (unsigned)__builtin_amdgcn_readfirstlane((int)e4.y), (unsigned)__builtin_amdgcn_readfirstlane((int)e4.z), (unsigned)__builtin_amdgcn_readfirstlane((int)e4.w)};
#pragma unroll
        for (int j = 0; j < 4; ++j) { uu[j] = *(const u32x4*)(Vb + (size_t)ee[j] * EROW + lo * 16); vv[j] = *(const u32x4*)(Vb + (size_t)ee[j] * EROW + 1024 + lo * 16); }
    };
    auto consume = [&](int gi, const u32x4 (&uu)[4], const u32x4 (&vv)[4]) {
        float dd[4];
#pragma unroll
        for (int j = 0; j < 4; ++j) dd[j] = peer_dot(uu[j], xd0, xd1);
        const bool b0 = (lo & 1) != 0, b1 = (lo & 2) != 0;
        const float r01 = (b0 ? dd[1] : dd[0]) + DPPF(b0 ? dd[0] : dd[1], 0xB1), r23 = (b0 ? dd[3] : dd[2]) + DPPF(b0 ? dd[2] : dd[3], 0xB1);
        float r = (b1 ? r23 : r01) + DPPF(b1 ? r01 : r23, 0x4E);
        r += DPPF(r, 0x124); r += DPPF(r, 0x128);
        { auto sw = __builtin_amdgcn_permlane16_swap(__float_as_uint(r), __float_as_uint(r), false, false); r = __uint_as_float(sw[0]) + __uint_as_float(sw[1]); }
        { auto sw = __builtin_amdgcn_permlane32_swap(__float_as_uint(r), __float_as_uint(r), false, false); r = __uint_as_float(sw[0]) + __uint_as_float(sw[1]); }
        const float su = lS[4 * gi + (lo & 3)], gv = lG[4 * gi + (lo & 3)];
        const float hh = r * su;
        const float a = pg8::gelu_pk((pg8::f32x2){hh, hh}).x * gv;
        peer_axpy(vv[0], DPPF(a, 0x00), o); peer_axpy(vv[1], DPPF(a, 0x55), o); peer_axpy(vv[2], DPPF(a, 0xAA), o); peer_axpy(vv[3], DPPF(a, 0xFF), o);
    };
    issue(0, ua, va);
#pragma unroll 1
    for (int gi = 0; gi < 30; gi += 2) {
        issue(gi + 1, ub, vb);
        consume(gi, ua, va);
        issue(gi + 2, ua, va);
        consume(gi + 1, ub, vb);
        if ((gi & 6) == 6) BLOCK_SYNC();
    }
    issue(31, ub, vb);
    consume(30, ua, va);
    consume(31, ub, vb);
    BLOCK_SYNC();
    peer_finish(P, lds, o_par, tok, lo, o);
}
#define CE_DESC(a, b) do { const float h_ = fmaxf((a), (b)), l_ = fminf((a), (b)); (a) = h_; (b) = l_; } while (0)
template <int N> __device__ __forceinline__ void bitonic_sort_desc(float (&v)[N]) {
#pragma unroll
    for (int k = 2; k <= N; k <<= 1)
#pragma unroll
        for (int j = k >> 1; j > 0; j >>= 1)
#pragma unroll
            for (int i = 0; i < N; ++i) { const int l = i ^ j; if (l > i) { if ((i & k) == 0) CE_DESC(v[i], v[l]); else CE_DESC(v[l], v[i]); } }
}
template <int N> __device__ __forceinline__ void bitonic_merge_desc(float (&v)[N]) {
#pragma unroll
    for (int j = N >> 1; j > 0; j >>= 1)
#pragma unroll
        for (int i = 0; i < N; ++i) { const int l = i ^ j; if (l > i) CE_DESC(v[i], v[l]); }
}
__device__ __forceinline__ void top16_merge(float (&a)[16], const float (&brev)[16]) {
#pragma unroll
    for (int i = 0; i < 16; ++i) a[i] = fmaxf(a[i], brev[i]);
    bitonic_merge_desc<16>(a);
}
__device__ __forceinline__ float embed_bits(float v, unsigned code, unsigned mask) { return __uint_as_float((__float_as_uint(v) & ~mask) | code); }

__device__ __forceinline__ void phase7(const Params& P, ldsp lds) {
    const int tid0 = threadIdx.x;
    unsigned char* ws = P.ws;
    const bf16_t* qb = (const bf16_t*)(ws + WS_Q); const bf16_t* sk = (const bf16_t*)(ws + WS_SUBK);
    constexpr int LDSK = 136, O_SK = 0, O_SV = 2 * 128 * LDSK * 2, O_EX = O_SV + 32768, O_GT = O_EX + 16384, O_LIST = O_GT + 16384;
    static_assert(O_LIST + 8 * 384 * 4 <= LDS_BYTES - 16, "lds");
    int titer = 0;
    for (int tile = blockIdx.x; tile < 256; tile += gridDim.x, ++titer) {
        int tid = tid0; asm volatile("" : "+v"(tid));
        const int lane = tid & 63, wave = tid >> 6, fr = lane & 15, fq = lane >> 4, fro = fr, fqo = fq;
        const int tok0 = tile * 32, h = wave;
        bf16x8 qn[4];
        auto ldq = [&](int cb) { const bf16_t* qrow = qb + (size_t)(tok0 + 16 * (cb >> 1) + fro) * D + h * 256 + (cb & 1) * 128 + fqo * 8;
#pragma unroll
            for (int ks = 0; ks < 4; ++ks) qn[ks] = *(const bf16x8*)(qrow + ks * 32); };
        ldq(0);
        for (int idx = tid; idx < 2 * 128 * 16; idx += 512) { const int row = idx >> 4, ch = idx & 15;
            *(LAS u32x4*)(lds + O_SK + (row * LDSK + ch * 8) * 2) = *(const u32x4*)(sk + row * 128 + ch * 8); }
        BLOCK_SYNC();
#pragma unroll 1
        for (int cb = 0; cb < 4; ++cb) {
            const int nt = cb >> 1, p = cb & 1;
            f32x4 acc[8];
#pragma unroll
            for (int mt = 0; mt < 8; ++mt) acc[mt] = (f32x4){0.f, 0.f, 0.f, 0.f};
            bf16x8 qc[4];
#pragma unroll
            for (int ks = 0; ks < 4; ++ks) qc[ks] = qn[ks];
            if (cb + 1 < 4) ldq(cb + 1);
#pragma unroll
            for (int ks = 0; ks < 4; ++ks) {
                const bf16x8 bq = qc[ks];
#pragma unroll
                for (int mt = 0; mt < 8; ++mt) acc[mt] = mfma16(*(const LAS bf16x8*)(lds + O_SK + ((p * 128 + 16 * mt + fro) * LDSK + ks * 32 + fqo * 8) * 2), bq, acc[mt]);
            }
            float a[16], b[16];
#pragma unroll
            for (int mt = 0; mt < 4; ++mt) {
                a[4 * mt + 0] = embed_bits(acc[mt].x, 16 * mt + 4 * fq + 0, 127u); a[4 * mt + 1] = embed_bits(acc[mt].y, 16 * mt + 4 * fq + 1, 127u);
                a[4 * mt + 2] = embed_bits(acc[mt].z, 16 * mt + 4 * fq + 2, 127u); a[4 * mt + 3] = embed_bits(acc[mt].w, 16 * mt + 4 * fq + 3, 127u);
                b[4 * mt + 0] = embed_bits(acc[mt + 4].x, 16 * (mt + 4) + 4 * fq + 0, 127u); b[4 * mt + 1] = embed_bits(acc[mt + 4].y, 16 * (mt + 4) + 4 * fq + 1, 127u);
                b[4 * mt + 2] = embed_bits(acc[mt + 4].z, 16 * (mt + 4) + 4 * fq + 2, 127u); b[4 * mt + 3] = embed_bits(acc[mt + 4].w, 16 * (mt + 4) + 4 * fq + 3, 127u);
            }
            bitonic_sort_desc<16>(a); bitonic_sort_desc<16>(b);
            { float br[16];
#pragma unroll
              for (int i = 0; i < 16; ++i) br[i] = b[15 - i];
              top16_merge(a, br); }
#pragma unroll
            for (int x = 16; x <= 32; x <<= 1) { float br[16];
#pragma unroll
                for (int i = 0; i < 16; ++i) br[i] = __shfl_xor(a[15 - i], x);
                top16_merge(a, br); }
            if (fq == 0) { LAS f32x4* o = (LAS f32x4*)(lds + O_SV + ((((16 * nt + fr) * 8 + h) * 2 + p) * 16) * 4);
                o[0] = (f32x4){a[0], a[1], a[2], a[3]}; o[1] = (f32x4){a[4], a[5], a[6], a[7]}; o[2] = (f32x4){a[8], a[9], a[10], a[11]}; o[3] = (f32x4){a[12], a[13], a[14], a[15]}; }
        }
        BLOCK_SYNC();
        if (tid < 256) {
            const int tok = tid >> 3, hh = tid & 7;
            const LAS f32x4* s = (const LAS f32x4*)(lds + O_SV + (((tok * 8 + hh) * 2) * 16) * 4);
            float s0[16], s1[16];
#pragma unroll
            for (int c4 = 0; c4 < 4; ++c4) { const f32x4 x = s[c4], y = s[4 + c4]; s0[4 * c4] = x.x; s0[4 * c4 + 1] = x.y; s0[4 * c4 + 2] = x.z; s0[4 * c4 + 3] = x.w; s1[4 * c4] = y.x; s1[4 * c4 + 1] = y.y; s1[4 * c4 + 2] = y.z; s1[4 * c4 + 3] = y.w; }
            float g0[16], g1[16], g2[16], g3[16];
            const float NEG = -3.0e38f;
#pragma unroll
            for (int bq = 0; bq < 16; ++bq) g0[bq] = embed_bits(s0[0] + s1[bq], bq, 255u);
            {
                int n1 = 0, n2 = 0, n3 = 0;
#pragma unroll
                for (int aa = 1; aa < 16; ++aa)
#pragma unroll
                    for (int bb = 0; bb < 16; ++bb) if ((aa + 1) * (bb + 1) <= 16) {
                        const float c = embed_bits(s0[aa] + s1[bb], aa * 16 + bb, 255u);
                        if (n1 < 16) g1[n1++] = c; else if (n2 < 16) g2[n2++] = c; else g3[n3++] = c;
                    }
#pragma unroll
                for (int i = 0; i < 16; ++i) if (i >= n3) g3[i] = NEG;
            }
            bitonic_sort_desc<16>(g1); bitonic_sort_desc<16>(g2); bitonic_sort_desc<16>(g3);
            { float r1[16], r3[16];
#pragma unroll
              for (int i = 0; i < 16; ++i) { r1[i] = g1[15 - i]; r3[i] = g3[15 - i]; }
              top16_merge(g0, r1); top16_merge(g2, r3);
#pragma unroll
              for (int i = 0; i < 16; ++i) g0[i] = fmaxf(g0[i], g2[15 - i]); }
            float mx = g0[0];
#pragma unroll
            for (int i = 1; i < 16; ++i) mx = fmaxf(mx, g0[i]);
            float ex[16], sm = 0.f; int ee[16];
#pragma unroll
            for (int i = 0; i < 16; ++i) {
                ex[i] = __expf(g0[i] - mx); sm += ex[i];
                const unsigned code = __float_as_uint(g0[i]) & 255u;
                const unsigned i0 = __float_as_uint(*(const LAS float*)(lds + O_SV + ((((tok * 8 + hh) * 2 + 0) * 16) + (code >> 4)) * 4)) & 127u;
                const unsigned i1 = __float_as_uint(*(const LAS float*)(lds + O_SV + ((((tok * 8 + hh) * 2 + 1) * 16) + (code & 15u)) * 4)) & 127u;
                ee[i] = (int)(i0 * 128u + i1);
            }
            const float inv = 1.0f / sm;
            LAS int* eo = (LAS int*)(lds + O_EX) + tok * 128 + hh * 16; LAS float* go = (LAS float*)(lds + O_GT) + tok * 128 + hh * 16;
#pragma unroll
            for (int c4 = 0; c4 < 4; ++c4) {
                *(LAS u32x4*)(eo + 4 * c4) = (u32x4){(unsigned)ee[4 * c4], (unsigned)ee[4 * c4 + 1], (unsigned)ee[4 * c4 + 2], (unsigned)ee[4 * c4 + 3]};
                *(LAS f32x4*)(go + 4 * c4) = (f32x4){ex[4 * c4] * inv, ex[4 * c4 + 1] * inv, ex[4 * c4 + 2] * inv, ex[4 * c4 + 3] * inv};
            }
        }
        BLOCK_SYNC();
        for (int idx = tid; idx < 2048; idx += 512) { const int a = idx >> 9, q4 = idx & 511; const float* src = P.in[a == 0 ? I_LN1G : a == 1 ? I_LN1B : a == 2 ? I_LN2G : I_LN2B];
            *(LAS f32x4*)(lds + O_SK + a * 8192 + q4 * 16) = *(const f32x4*)(src + q4 * 4); }
        BLOCK_SYNC();
#pragma unroll 1
        for (int r = 0; r < 4; ++r) {
            peer_round(P, lds, O_EX, O_GT, O_LIST, O_SK, tok0 + r * 8 + wave, r * 8 + wave);
        }
        BLOCK_SYNC();
    }
}
__global__ __launch_bounds__(512, 2) void hybrid_fwd(Params P) {
    extern __shared__ __attribute__((aligned(16))) unsigned char shm[];
    ldsp lds = (ldsp)shm;
    unsigned char* ws = P.ws;
    volatile LAS unsigned* xst = (volatile LAS unsigned*)(lds + LDS_BYTES - 16);
    if (threadIdx.x == 0) { xst[0] = 0u; xst[1] = 0u; }
    __syncthreads();
    const XcdBarrier xbar = xcd_barrier_post((unsigned*)(ws + WS_BAR), xst);
    const int lo = P.ph_lo, hi = P.ph_hi;
#ifdef REPEAT_PHASE
#define PHASE(k) if (lo <= (k) && (k) < hi) for (int once_ = 0; once_ < ((k) == REPEAT_PHASE ? 2 : 1); ++once_)
#else
#define PHASE(k) if (lo <= (k) && (k) < hi) for (int once_ = 0; once_ < 1; ++once_)
#endif
#ifdef DOUBLE_SEAMS
#define SEAM(k) do { if (lo <= (k) && (k) + 1 < hi) { xcd_barrier(xbar); xcd_barrier(xbar); } } while (0)
#else
#define SEAM(k) do { if (lo <= (k) && (k) + 1 < hi) xcd_barrier(xbar); } while (0)
#endif
#if defined(REPEAT_PHASE) && REPEAT_PHASE == 0
    PHASE(0) { Params Q = P; if (once_) Q.ph_lo = -1; phase0(Q); }
#else
    PHASE(0) phase0(P);
#endif
    SEAM(0);
    PHASE(1) { pg8::EpiBf16<0> E; E.O = (bf16_t*)(ws + WS_P); E.ldc = NPAD; E.bias = nullptr; E.split_cols = 0; E.split_stride = 0;
        run_gemm(lds, (const bf16_t*)(ws + WS_H0B), (const bf16_t*)(ws + WS_WTIN), MROWS, N_BF, 2048, E);
        const int G = (int)gridDim.x, r1 = ((MROWS / 256) * (N_BF / 256)) % G;
        pg8::EpiBf16S E8; E8.O = (bf16_t*)(ws + WS_P) + N_BF; E8.ldc = NPAD; E8.scale = 1.0f / 64.0f;
        run_gemm8(lds, ws + WS_H0B8, ws + WS_WT8, MROWS, N_F8, 2048, E8, (int)((blockIdx.x + G - r1) % G)); }
    SEAM(1);
    PHASE(2) phase2(P, lds);
    SEAM(2);
    PHASE(3) phase3(P);
    SEAM(3);
    PHASE(4) phase3b(P, lds);
    SEAM(4);
    PHASE(5) {
#ifdef P5_F8
        { pg8::EpiGate35T<16> E; E.O = (bf16_t*)(ws + WS_MERGED); E.p = (const bf16_t*)(ws + WS_P); E.bgate = P.in[I_BGATE]; E.oscale = 1.0f / 64.0f;
          run_gemm8(lds, ws + WS_YAB, ws + WS_WTAB8, NTOK, 2048, LDAB, E, (int)blockIdx.x); }
#else
        { pg8::EpiGate35 E; E.O = (bf16_t*)(ws + WS_MERGED); E.p = (const bf16_t*)(ws + WS_P); E.bgate = P.in[I_BGATE]; E.oscale = 1.0f;
          run_gemm(lds, (const bf16_t*)(ws + WS_YAB), (const bf16_t*)(ws + WS_WTAB), NTOK, 2048, LDAB, E); }
#endif
    }
#if defined(DUP_PHASE) && DUP_PHASE == 5
    SEAM(4);
    PHASE(5) {
#ifdef P5_F8
        { pg8::EpiGate35T<16> E; E.O = (bf16_t*)(ws + WS_MERGED); E.p = (const bf16_t*)(ws + WS_P); E.bgate = P.in[I_BGATE]; E.oscale = 1.0f / 64.0f;
          run_gemm8(lds, ws + WS_YAB, ws + WS_WTAB8, NTOK, 2048, LDAB, E, (int)blockIdx.x); }
#else
        { pg8::EpiGate35 E; E.O = (bf16_t*)(ws + WS_MERGED); E.p = (const bf16_t*)(ws + WS_P); E.bgate = P.in[I_BGATE]; E.oscale = 1.0f;
          run_gemm(lds, (const bf16_t*)(ws + WS_YAB), (const bf16_t*)(ws + WS_WTAB), NTOK, 2048, LDAB, E); }
#endif
    }
#endif
    SEAM(5);
    PHASE(6) { pg8::EpiResidStats E; E.O = (bf16_t*)(ws + WS_X1B); E.h0 = (const bf16_t*)(ws + WS_H0B); E.alpha = DN_ALPHA; E.rsum = (float*)(ws + WS_STAT); E.rsq = (float*)(ws + WS_STAT) + 8192;
        run_gemm(lds, (const bf16_t*)(ws + WS_MERGED), (const bf16_t*)(ws + WS_WTOUT), NTOK, 2048, 2048, E); }
#if defined(DUP_PHASE) && DUP_PHASE == 6
    SEAM(5);
    PHASE(6) { pg8::EpiResidStats E; E.O = (bf16_t*)(ws + WS_X1B); E.h0 = (const bf16_t*)(ws + WS_H0B); E.alpha = DN_ALPHA; E.rsum = (float*)(ws + WS_END); E.rsq = (float*)(ws + WS_END) + 8192;
        run_gemm(lds, (const bf16_t*)(ws + WS_MERGED), (const bf16_t*)(ws + WS_WTOUT), NTOK, 2048, 2048, E); }
#endif
    SEAM(6);
    PHASE(7) { pg8::EpiQ E; E.O = (bf16_t*)(ws + WS_Q); E.rsum = (const float*)(ws + WS_STAT); E.rsq = (const float*)(ws + WS_STAT) + 8192; E.c1 = (const float*)(ws + WS_STAT) + 16384; E.c2 = (const float*)(ws + WS_STAT) + 18432;
        run_gemm(lds, (const bf16_t*)(ws + WS_X1B), (const bf16_t*)(ws + WS_WTQ), NTOK, 2048, 2048, E); }
#if defined(DUP_PHASE) && DUP_PHASE == 7
    SEAM(6);
    PHASE(7) { pg8::EpiQ E; E.O = (bf16_t*)(ws + WS_Q); E.rsum = (const float*)(ws + WS_STAT); E.rsq = (const float*)(ws + WS_STAT) + 8192; E.c1 = (const float*)(ws + WS_STAT) + 16384; E.c2 = (const float*)(ws + WS_STAT) + 18432;
        run_gemm(lds, (const bf16_t*)(ws + WS_X1B), (const bf16_t*)(ws + WS_WTQ), NTOK, 2048, 2048, E); }
#endif
    SEAM(7);
    PHASE(8) phase7(P, lds);
#undef PHASE
#undef SEAM
}

extern "C" void kernel_launch(void* const* d_in, const int* in_sizes, int n_in, void* d_out, int out_size, void* d_ws, size_t ws_size, hipStream_t stream) {
    static int grid = 0;
    if (grid == 0) {
        if (n_in != 30 || out_size != NTOK * D || ws_size < WS_END) { fprintf(stderr, "kernel_launch: unexpected shapes (n_in %d, out %d, ws %zu < %zu)\n", n_in, out_size, ws_size, (size_t)WS_END); grid = -1; return; }
        int dev = 0, cus = 0, per_cu = 0;
        if (hipGetDevice(&dev) != hipSuccess || hipDeviceGetAttribute(&cus, hipDeviceAttributeMultiprocessorCount, dev) != hipSuccess) { grid = -1; return; }
        if (hipFuncSetAttribute((const void*)hybrid_fwd, hipFuncAttributeMaxDynamicSharedMemorySize, LDS_BYTES) != hipSuccess) { fprintf(stderr, "kernel_launch: hipFuncSetAttribute failed\n"); grid = -1; return; }
        if (hipOccupancyMaxActiveBlocksPerMultiprocessor(&per_cu, (const void*)hybrid_fwd, 512, LDS_BYTES) != hipSuccess || per_cu < 1) { fprintf(stderr, "kernel_launch: occupancy query says %d\n", per_cu); grid = -1; return; }
        (void)hipGetLastError();
        grid = cus;
    }
    if (grid < 0) return;
    if (hipMemsetAsync((unsigned char*)d_ws + WS_BAR, 0, 16384 + STAT_BYTES, stream) != hipSuccess) { fprintf(stderr, "kernel_launch: memset failed\n"); return; }
    Params p{};
    for (int i = 0; i < 30; ++i) p.in[i] = (const float*)d_in[i];
    p.out = (float*)d_out; p.ws = (unsigned char*)d_ws;
    p.ph_lo = 0; p.ph_hi = NPHASE + 1;
    void* args[] = {&p};
    hipError_t e = hipLaunchCooperativeKernel((const void*)hybrid_fwd, dim3(grid), dim3(512), args, LDS_BYTES, stream);
    if (e != hipSuccess) fprintf(stderr, "kernel_launch: cooperative launch failed: %s (grid %d)\n", hipGetErrorString(e), grid);
}
```

```cpp
#include <hip/hip_runtime.h>
#include <cstdio>
#include <cstdint>
namespace pg8 {
#define PG8_LAS __attribute__((address_space(3)))
typedef unsigned short bf16_t;
typedef short bf16x8 __attribute__((ext_vector_type(8)));
typedef float f32x4 __attribute__((ext_vector_type(4)));
typedef unsigned u32x4 __attribute__((ext_vector_type(4)));
typedef int i32x4f __attribute__((ext_vector_type(4)));
constexpr int BM = 256, BK = 64, HALF = 128, HTB = HALF * BK * 2  , STAGE_BYTES = 8 * HTB, NXCD = 8, WGM = 8;

__host__ __device__ __forceinline__ int lds_byte(int r, int c) { const int st = (r >> 4) * 2 + (c >> 5), rr = r & 15, cc = c & 31, ob = rr * 64 + cc * 2; return st * 1024 + (ob ^ (((ob >> 9) & 1) << 5)); }
__host__ __device__ __forceinline__ void stage_rc(int b, int& R, int& C) { const int st = b / 1024, sb = b % 1024, swz = sb ^ (((sb >> 9) & 1) << 5); R = (st >> 1) * 16 + swz / 64; C = (st & 1) * 32 + (swz % 64) / 2; }
__host__ __device__ __forceinline__ int perm32(int rho) { const int n = rho >> 4, i = rho & 15; return 8 * (i >> 2) + 4 * n + (i & 3); }

struct Unit { int pm, pn; };
struct Gemm { const bf16_t* A; const bf16_t* Bt; int M, N, K; };

struct StaticOrder {
    int nM, nN, nwg, G, c;
    __host__ __device__ void init(int M, int N, int G_, int c_) { nM = M / BM; nN = N / BM; nwg = nM * nN; G = G_; c = c_; }
    __host__ __device__ bool next(int i, Unit& u) const {
        const long L = (long)i * G + c; if (L >= nwg) return false;
        int wgid = (int)L; { const int q = nwg / NXCD, r = nwg % NXCD, xcd = wgid % NXCD, off = wgid / NXCD; wgid = (xcd < r ? xcd * (q + 1) : r * (q + 1) + (xcd - r) * q) + off; }
        const int nig = WGM * nN, gid = wgid / nig, fm = gid * WGM, gsz = (nM - fm) < WGM ? (nM - fm) : WGM;
        u.pm = fm + ((wgid % nig) % gsz); u.pn = (wgid % nig) / gsz; return true;
    }
    __device__ __forceinline__ void a_ready(const Unit&) const {}
    __device__ __forceinline__ void done(const Unit&) const {}
};
struct CountedOrder : StaticOrder {
    const unsigned* ready; unsigned need; unsigned* tmo;
    __device__ __forceinline__ void a_ready(const Unit& u) const {
        if (threadIdx.x < 64) {
            const unsigned long long t0 = __builtin_amdgcn_s_memrealtime(); unsigned polls = 0;
            while ((unsigned)__builtin_amdgcn_readfirstlane(__hip_atomic_load(ready + 64 * u.pm, __ATOMIC_RELAXED, __HIP_MEMORY_SCOPE_AGENT)) < need) {
                if ((++polls & 255u) == 0u && __builtin_amdgcn_readfirstlane(__hip_atomic_load(tmo, __ATOMIC_RELAXED, __HIP_MEMORY_SCOPE_AGENT)) != 0u) break;
                if (__builtin_amdgcn_s_memrealtime() - t0 > 2000000ull) {
                    if (threadIdx.x == 0) { unsigned expect = 0u; __hip_atomic_compare_exchange_strong(tmo + 1, &expect, 0x600u | (unsigned)(u.pm & 0xff), __ATOMIC_RELAXED, __ATOMIC_RELAXED, __HIP_MEMORY_SCOPE_AGENT); __hip_atomic_store(tmo, 1u, __ATOMIC_RELAXED, __HIP_MEMORY_SCOPE_AGENT); }
                    break; }
                __builtin_amdgcn_s_sleep(2); }
            __builtin_amdgcn_fence(__ATOMIC_ACQUIRE, "agent");
            asm volatile("s_waitcnt vmcnt(0)" ::: "memory");
        }
#if !defined(BROKEN_HOOK_NO_BARRIER)
        asm volatile("" ::: "memory"); __builtin_amdgcn_s_barrier(); asm volatile("" ::: "memory");
#endif
    }
};

typedef float cvt_f32x2 __attribute__((ext_vector_type(2))); typedef __bf16 cvt_bf16x2 __attribute__((ext_vector_type(2)));
__device__ __forceinline__ unsigned cvt_pk_bf16(float lo, float hi) { const cvt_f32x2 v = {lo, hi}; const cvt_bf16x2 b = __builtin_convertvector(v, cvt_bf16x2); return __builtin_bit_cast(unsigned, b); }
typedef float f32x2 __attribute__((ext_vector_type(2)));
__device__ __forceinline__ f32x2 gelu_pk(f32x2 v) {
    const f32x2 av = __builtin_elementwise_abs(v), d = av * 0.2316418882f + 1.0f;
    f32x2 t; t.x = __builtin_amdgcn_rcpf(d.x); t.y = __builtin_amdgcn_rcpf(d.y);
    f32x2 q = t * 0.5307027145f + (-0.7265760135f); q = q * t + 0.7107068705f; q = q * t + (-0.142248368f); q = q * t + 0.127414796f; q = q * t;
    const f32x2 s = (v * v) * (-0.72134752044f);
    f32x2 e; e.x = __builtin_amdgcn_exp2f(s.x); e.y = __builtin_amdgcn_exp2f(s.y);
    const f32x2 m = v * (q * e), r = v - m;
    f32x2 o; o.x = v.x < 0.f ? m.x : r.x; o.y = v.y < 0.f ? m.y : r.y; return o;
}

struct EpiF32 {
    static constexpr bool PERM = false, AFTER_DRAIN = false; static constexpr int MID_T = -1;
    float* C; int ldc; const float* bias;
    __device__ __forceinline__ void operator()(const f32x4 (&acc)[2][2][4][2], const Unit& u, int wr, int wc, int fr, int fq) const {
        const int row0 = u.pm * BM + wr * 64 + fr, col0 = u.pn * BM + wc * 32 + 4 * fq;
        f32x4 bv[2][2];
#pragma unroll
        for (int bj = 0; bj < 2; ++bj)
#pragma unroll
            for (int n = 0; n < 2; ++n) bv[bj][n] = bias ? *(const f32x4*)(bias + col0 + bj * HALF + n * 16) : (f32x4){0.f, 0.f, 0.f, 0.f};
#pragma unroll
        for (int ai = 0; ai < 2; ++ai)
#pragma unroll
            for (int m = 0; m < 4; ++m) { float* rowp = C + (size_t)(row0 + ai * HALF + m * 16) * ldc + col0;
#pragma unroll
                for (int bj = 0; bj < 2; ++bj)
#pragma unroll
                    for (int n = 0; n < 2; ++n) *(f32x4*)(rowp + bj * HALF + n * 16) = acc[ai][bj][m][n] + bv[bj][n]; }
    }
};
template <int ACT  > struct EpiBf16 {
    static constexpr bool PERM = true, AFTER_DRAIN = false; static constexpr int MID_T = -1;
    bf16_t* O; int ldc; const float* bias; int split_cols; size_t split_stride;
    __device__ __forceinline__ void operator()(const f32x4 (&acc)[2][2][4][2], const Unit& u, int wr, int wc, int fr, int fq) const {
        const int row0 = u.pm * BM + wr * 64 + fr; int colt = u.pn * BM; bf16_t* base = O;
        if (split_cols) { const int t = colt / split_cols; base += (size_t)t * split_stride; colt -= t * split_cols; }
        const int col0 = colt + wc * 32 + 8 * fq, bcol0 = u.pn * BM + wc * 32 + 8 * fq;
        f32x4 bv[2][2];
#pragma unroll
        for (int bj = 0; bj < 2; ++bj)
#pragma unroll
            for (int n = 0; n < 2; ++n) bv[bj][n] = bias ? *(const f32x4*)(bias + bcol0 + bj * HALF + 4 * n) : (f32x4){0.f, 0.f, 0.f, 0.f};
#pragma unroll
        for (int ai = 0; ai < 2; ++ai)
#pragma unroll
            for (int m = 0; m < 4; ++m) { bf16_t* rowp = base + (size_t)(row0 + ai * HALF + m * 16) * ldc + col0;
#pragma unroll
                for (int bj = 0; bj < 2; ++bj) { f32x4 v0 = acc[ai][bj][m][0] + bv[bj][0], v1 = acc[ai][bj][m][1] + bv[bj][1];
                    if (ACT == 1) { f32x2 a = gelu_pk((f32x2){v0[0], v0[1]}), b = gelu_pk((f32x2){v0[2], v0[3]}), c = gelu_pk((f32x2){v1[0], v1[1]}), d = gelu_pk((f32x2){v1[2], v1[3]});
                        v0 = (f32x4){a.x, a.y, b.x, b.y}; v1 = (f32x4){c.x, c.y, d.x, d.y}; }
                    if (ACT == 2) {
#pragma unroll
                        for (int j = 0; j < 4; ++j) { v0[j] = 0.5f * v0[j] * (1.0f + erff(v0[j] * 0.70710678f)); v1[j] = 0.5f * v1[j] * (1.0f + erff(v1[j] * 0.70710678f)); } }
                    u32x4 w; w.x = cvt_pk_bf16(v0[0], v0[1]); w.y = cvt_pk_bf16(v0[2], v0[3]); w.z = cvt_pk_bf16(v1[0], v1[1]); w.w = cvt_pk_bf16(v1[2], v1[3]);
                    *(u32x4*)(rowp + bj * HALF) = w; } }
    }
};
template <class Epi, class Sched, bool STAMP = false, bool F8 = false>
__device__ __forceinline__ void gemm_phase(PG8_LAS unsigned char* lds, const Gemm g, const Sched& S, const Epi& E, unsigned long long* stamps) {
    const int tid = threadIdx.x, wid = __builtin_amdgcn_readfirstlane(tid >> 6), lane = tid & 63, wr = wid >> 2, wc = wid & 3, fr = lane & 15, fq = lane >> 4;
    const int K = g.K, nt = K / BK;
    int ts_lo = 0, ts_hi = 0, nts = 0; const unsigned long long rt_entry = STAMP ? (unsigned long long)wall_clock64() : 0ull;
#define PG8_STAMP() do { if (STAMP && wid == 0 && nts < 64) { const unsigned long long _c = (unsigned long long)clock64(); \
        ts_lo = (lane == nts) ? (int)(unsigned)_c : ts_lo; ts_hi = (lane == nts) ? (int)(unsigned)(_c >> 32) : ts_hi; ++nts; } } while (0)
    PG8_STAMP();
    unsigned voffA[2], voffB[2];
#pragma unroll
    for (int i = 0; i < 2; ++i) { int R, C; stage_rc(tid * 16 + i * 8192, R, C); const int Rb = Epi::PERM ? ((R & ~31) + perm32(R & 31)) : R;
        voffA[i] = (unsigned)(R * K + C) * 2u; voffB[i] = (unsigned)(Rb * K + C) * 2u; }
    const size_t kstep = (size_t)(BK * 2);
    const size_t hstep = (size_t)HALF * K * 2;
    const size_t tstep = 2 * hstep;
    const unsigned ldsw = (unsigned)wid * 1024u;
    const int aoff = lds_byte(wr * 64 + fr, fq * 8), boff = lds_byte(wc * 32 + fr, fq * 8);
#define PG8_SA(b, h) (((b) * 2 + (h)) * HTB)
#define PG8_SB(b, h) ((4 + (b) * 2 + (h)) * HTB)
#define PG8_STAGE(bufoff, gbase, voff) do { _Pragma("unroll") for (int _i = 0; _i < 2; ++_i) \
        __builtin_amdgcn_global_load_lds((const unsigned*)((const char*)(gbase) + (voff)[_i]), (PG8_LAS unsigned*)(lds + (bufoff) + ldsw + _i * 8192), 16, 0, 0); } while (0)
#define PG8_LDA(dst, b, h) do { if constexpr (F8) { _Pragma("unroll") for (int m = 0; m < 4; ++m) { dst##8[m].lo = *(const PG8_LAS bf16x8*)(lds + PG8_SA(b, h) + aoff + m * 2048); dst##8[m].hi = *(const PG8_LAS bf16x8*)(lds + PG8_SA(b, h) + aoff + m * 2048 + 1024); } } \
    else { _Pragma("unroll") for (int m = 0; m < 4; ++m) _Pragma("unroll") for (int k = 0; k < 2; ++k) dst[m][k] = *(const PG8_LAS bf16x8*)(lds + PG8_SA(b, h) + aoff + m * 2048 + k * 1024); } } while (0)
#define PG8_LDB(dst, b, h) do { if constexpr (F8) { _Pragma("unroll") for (int n = 0; n < 2; ++n) { dst##8[n].lo = *(const PG8_LAS bf16x8*)(lds + PG8_SB(b, h) + boff + n * 2048); dst##8[n].hi = *(const PG8_LAS bf16x8*)(lds + PG8_SB(b, h) + boff + n * 2048 + 1024); } } \
    else { _Pragma("unroll") for (int n = 0; n < 2; ++n) _Pragma("unroll") for (int k = 0; k < 2; ++k) dst[n][k] = *(const PG8_LAS bf16x8*)(lds + PG8_SB(b, h) + boff + n * 2048 + k * 1024); } } while (0)
typedef int i32x8f __attribute__((ext_vector_type(8)));
#define PG8_MMA(ai, bj, At, Bt) do { __builtin_amdgcn_s_setprio(1); \
        if constexpr (F8) { _Pragma("unroll") for (int m = 0; m < 4; ++m) _Pragma("unroll") for (int n = 0; n < 2; ++n) \
            asm volatile("v_mfma_f32_16x16x128_f8f6f4 %0, %1, %2, %0" : "+v"(acc[ai][bj][m][n]) : "v"(Bt##8[n]), "v"(At##8[m])); } \
        else { _Pragma("unroll") for (int m = 0; m < 4; ++m) _Pragma("unroll") for (int n = 0; n < 2; ++n) _Pragma("unroll") for (int k = 0; k < 2; ++k) \
            acc[ai][bj][m][n] = __builtin_amdgcn_mfma_f32_16x16x32_bf16(Bt[n][k], At[m][k], acc[ai][bj][m][n], 0, 0, 0); } \
        __builtin_amdgcn_s_setprio(0); } while (0)
#define PG8_WAIT_V(n) asm volatile("s_waitcnt vmcnt(" #n ")" ::: "memory")
#define PG8_WAIT_L(n) asm volatile("s_waitcnt lgkmcnt(" #n ")" ::: "memory")
#define PG8_BAR __builtin_amdgcn_s_barrier()
#define PG8_SCHED __builtin_amdgcn_sched_barrier(0)
    Unit cur, nxt; int ui = 0;
    if (!S.next(0, cur)) return;
    f32x4 acc[2][2][4][2];
#pragma unroll
    for (int a = 0; a < 2; ++a)
#pragma unroll
        for (int b = 0; b < 2; ++b)
#pragma unroll
            for (int m = 0; m < 4; ++m)
#pragma unroll
                for (int n = 0; n < 2; ++n) acc[a][b][m][n] = (f32x4){0.f, 0.f, 0.f, 0.f};
    bf16x8 At[4][2], B0[2][2], B1[2][2];
    typedef short bf16x16f __attribute__((ext_vector_type(16)));
    bf16x16f At8[4], B08[2], B18[2];
    const char* cA = (const char*)g.A + (size_t)cur.pm * tstep; const char* cB = (const char*)g.Bt + (size_t)cur.pn * tstep;
    S.a_ready(cur);
    PG8_STAGE(PG8_SB(0, 0), cB, voffB); PG8_STAGE(PG8_SA(0, 0), cA, voffA); PG8_STAGE(PG8_SB(0, 1), cB + hstep, voffB); PG8_STAGE(PG8_SA(0, 1), cA + hstep, voffA);
    if (wr == 1) PG8_BAR;
    PG8_WAIT_V(4); PG8_BAR;
    PG8_STAGE(PG8_SB(1, 0), cB + kstep, voffB); PG8_STAGE(PG8_SA(1, 0), cA + kstep, voffA); PG8_STAGE(PG8_SB(1, 1), cB + hstep + kstep, voffB);
    PG8_WAIT_V(6); PG8_BAR;
    PG8_STAMP();
    for (;;) {
        const bool has_next = S.next(ui + 1, nxt);
        const char* nA = has_next ? (const char*)g.A + (size_t)nxt.pm * tstep : cA; const char* nB = has_next ? (const char*)g.Bt + (size_t)nxt.pn * tstep : cB;
        for (int t = 0; t < nt; t += 2) {
            const bool last = (t == nt - 2);
            const char* a1 = cA + (size_t)(t + 1) * kstep;
            const char* a2 = last ? nA : cA + (size_t)(t + 2) * kstep; const char* b2 = last ? nB : cB + (size_t)(t + 2) * kstep;
            const char* a3 = a2 + kstep; const char* b3 = b2 + kstep;
            if (last && has_next) S.a_ready(nxt);
            if constexpr (Epi::MID_T >= 0) { if (t == Epi::MID_T) { if constexpr (F8) asm volatile("s_nop 15\n\ts_nop 15" ::: "memory"); E.mid(acc, cur, wr, wc, fr, fq); } }
            PG8_LDB(B0, 0, 0); PG8_SCHED; PG8_LDA(At, 0, 0); PG8_STAGE(PG8_SA(1, 1), a1 + hstep, voffA);
            PG8_WAIT_L(8); PG8_BAR; PG8_WAIT_L(0); PG8_MMA(0, 0, At, B0); PG8_BAR; PG8_SCHED;
            PG8_LDB(B1, 0, 1); PG8_STAGE(PG8_SB(0, 0), b2, voffB);
            PG8_BAR; PG8_WAIT_L(0); PG8_MMA(0, 1, At, B1); PG8_BAR;
            PG8_LDA(At, 0, 1); PG8_STAGE(PG8_SA(0, 0), a2, voffA);
            PG8_BAR; PG8_WAIT_L(0); PG8_MMA(1, 0, At, B0); PG8_BAR; PG8_SCHED;
            PG8_STAGE(PG8_SB(0, 1), b2 + hstep, voffB);
            PG8_WAIT_V(6); PG8_BAR; PG8_MMA(1, 1, At, B1); PG8_BAR;
            PG8_LDB(B0, 1, 0); PG8_SCHED; PG8_LDA(At, 1, 0); PG8_STAGE(PG8_SA(0, 1), a2 + hstep, voffA);
            PG8_WAIT_L(8); PG8_BAR; PG8_WAIT_L(0); PG8_MMA(0, 0, At, B0); PG8_BAR; PG8_SCHED;
            PG8_LDB(B1, 1, 1); PG8_STAGE(PG8_SB(1, 0), b3, voffB);
            PG8_BAR; PG8_WAIT_L(0); PG8_MMA(0, 1, At, B1); PG8_BAR;
            PG8_LDA(At, 1, 1); PG8_STAGE(PG8_SA(1, 0), a3, voffA);
            PG8_BAR; PG8_WAIT_L(0); PG8_MMA(1, 0, At, B0); PG8_BAR; PG8_SCHED;
            PG8_STAGE(PG8_SB(1, 1), b3 + hstep, voffB);
            PG8_WAIT_V(6); PG8_BAR; PG8_MMA(1, 1, At, B1); PG8_BAR;
        }
        PG8_STAMP();
        if constexpr (F8) asm volatile("s_nop 15\n\ts_nop 15" ::: "memory");
        if constexpr (!Epi::AFTER_DRAIN) { E(acc, cur, wr, wc, fr, fq); S.done(cur); }
        PG8_STAMP();
        if (!has_next) break;
#pragma unroll
        for (int a = 0; a < 2; ++a)
#pragma unroll
            for (int b = 0; b < 2; ++b)
#pragma unroll
                for (int m = 0; m < 4; ++m)
#pragma unroll
                    for (int n = 0; n < 2; ++n) acc[a][b][m][n] = (f32x4){0.f, 0.f, 0.f, 0.f};
        cur = nxt; cA = nA; cB = nB; ++ui;
    }
    PG8_WAIT_V(0);
    if (wr == 0) PG8_BAR;
    PG8_BAR;
    if constexpr (Epi::AFTER_DRAIN) { E.fused(acc, cur, wr, wc, fr, fq, lds, wid, lane); S.done(cur); }
    PG8_STAMP();
    if (STAMP && wid == 0) { stamps[lane] = lane < nts ? (((unsigned long long)(unsigned)ts_hi << 32) | (unsigned)ts_lo) : 0ull;
        if (lane == 62) stamps[62] = rt_entry; if (lane == 63) stamps[63] = (unsigned long long)wall_clock64(); }
#undef PG8_STAMP
#undef PG8_SA
#undef PG8_SB
#undef PG8_STAGE
#undef PG8_LDA
#undef PG8_LDB
#undef PG8_MMA
#undef PG8_WAIT_V
#undef PG8_WAIT_L
#undef PG8_BAR
#undef PG8_SCHED
}
}
#define LAS __attribute__((address_space(3)))
typedef unsigned short bf16_t;
typedef short bf16x8 __attribute__((ext_vector_type(8)));
typedef float f32x4 __attribute__((ext_vector_type(4)));
typedef float f32x2 __attribute__((ext_vector_type(2)));
typedef unsigned u32x4 __attribute__((ext_vector_type(4)));
typedef unsigned u32x2 __attribute__((ext_vector_type(2)));
typedef LAS unsigned char* ldsp;
typedef float f32x32 __attribute__((ext_vector_type(32)));
typedef float f32x16 __attribute__((ext_vector_type(16)));
typedef unsigned u32x6 __attribute__((ext_vector_type(6)));

constexpr int D = 2048, NTOK = 8192, SEQ = 4096, MROWS = 8448, ROW_META = 8192;
constexpr int INC = 11712, NPAD = 11776;
constexpr int C_R = 0, C_K = 2048, C_V = 4096, C_WL = 6144, C_AL = 6240, C_GL = 6336, C_POOL = 6592, C_G0 = 7616, C_G1 = 9664;
constexpr int NUNITS = 4128;
constexpr float DSCALE = 0.6065306597126334f;
constexpr float DN_ALPHA = 1.189207115002721f;
constexpr float GN_EPS = 64e-5f, LN_EPS = 1e-5f;

constexpr size_t WS_P = 0;
constexpr size_t WS_H0B = 198967296;
constexpr size_t WS_WTAB = WS_H0B + 34603008;
constexpr size_t WS_WTOUT = WS_WTAB + 12582912;
constexpr size_t WS_WTQ = WS_WTOUT + 8388608;
constexpr size_t WS_WTPOOL = WS_WTQ + 8388608;
constexpr size_t WS_WTW2 = WS_WTPOOL + 524288;
constexpr size_t WS_WTA2 = WS_WTW2 + 393216;
constexpr size_t WS_WTG2 = WS_WTA2 + 393216;
constexpr size_t WS_SUBK = WS_WTG2 + 1048576;
constexpr size_t WS_BONUS = WS_SUBK + 65536;
constexpr size_t WS_REGC = WS_BONUS + 1048576;
constexpr size_t WS_WTIN = WS_REGC;
constexpr size_t UNITB = (size_t)NUNITS * 4096 * 2;
constexpr size_t WS_G = WS_REGC;
constexpr size_t WS_H0T = WS_REGC + UNITB;
constexpr size_t WS_RT = WS_REGC + 2 * UNITB;
constexpr size_t WS_Y0 = WS_REGC + 3 * UNITB;
constexpr size_t WS_S0T = WS_REGC + 4 * UNITB;
constexpr size_t WS_YAB = WS_REGC;
constexpr int LDAB = 3072;
constexpr size_t WS_MERGED = WS_REGC + 2 * UNITB;
constexpr size_t WS_X1B = WS_REGC + 3 * UNITB;
constexpr size_t WS_Q = WS_REGC + UNITB;
constexpr size_t TROW = 1536;
constexpr size_t EROW = 2048;
constexpr size_t WS_VB = WS_REGC + 5 * UNITB;
constexpr size_t WS_GSIG = WS_VB + 16384 * EROW;
constexpr size_t WS_BAR = WS_GSIG + 4194304;
constexpr size_t WS_STAT = WS_BAR + 16384;
constexpr size_t STAT_BYTES = (8192 * 2 + 2048 * 2) * 4 + 4096;
constexpr size_t WS_TSC = WS_STAT + STAT_BYTES;
constexpr size_t UROW = 1024;
constexpr size_t WS_UB = WS_TSC + 131072;
constexpr int N_BF = 6656, N_F8 = NPAD - N_BF;
constexpr size_t WS_H0B8 = WS_UB;
constexpr size_t WS_WT8 = WS_H0B8 + (size_t)MROWS * 2048;
constexpr size_t WS_WTAB8 = WS_WT8 + (size_t)N_F8 * 2048;
constexpr size_t WS_WTOUT8 = WS_WTAB8 + (size_t)2048 * 3072;
constexpr size_t WS_END = WS_WTOUT8 + (size_t)2048 * 2048;
#define P6_F8 1
#define P5_F8 1
static_assert(WS_YAB + 50331648 <= WS_MERGED, "overlay");

constexpr int LDS_BYTES = 163840;
constexpr int NPHASE = 8;

struct Params {
    const float* in[30];
    float* out;
    unsigned char* ws;
    int ph_lo, ph_hi;
};
enum { I_X = 0, I_META, I_LNIN_G, I_LNIN_B, I_WIN, I_MU, I_W0, I_WW2, I_A0, I_WA2, I_WG2, I_KK, I_KA, I_RK, I_GNG, I_GNB, I_WPOOL, I_PSCALE, I_BGATE,
       I_WBA, I_WBB, I_WOUT, I_LN1G, I_LN1B, I_WQ, I_SUBK, I_UT, I_VT, I_LN2G, I_LN2B };

__device__ __forceinline__ unsigned pk2(float lo, float hi) { return pg8::cvt_pk_bf16(lo, hi); }
__device__ __forceinline__ float bflo(unsigned w) { return __uint_as_float(w << 16); }
__device__ __forceinline__ float bfhi(unsigned w) { return __uint_as_float(w & 0xffff0000u); }
__device__ __forceinline__ float bf1(bf16_t h) { return __uint_as_float(((unsigned)h) << 16); }
__device__ __forceinline__ bf16_t f2bf1(float f) { return (bf16_t)(pk2(f, f) & 0xffffu); }
__device__ __forceinline__ float wave_sum(float v) {
#pragma unroll
    for (int o = 1; o < 64; o <<= 1) v += __shfl_xor(v, o);
    return v;
}
__device__ __forceinline__ float sigmoidf_(float x) { return 1.0f / (1.0f + __expf(-x)); }
__device__ __forceinline__ f32x4 mfma16(bf16x8 a, bf16x8 b, f32x4 c) { return __builtin_amdgcn_mfma_f32_16x16x32_bf16(a, b, c, 0, 0, 0); }
__device__ __forceinline__ void unpack8(const u32x4 w, float* f) {
    f[0] = bflo(w.x); f[1] = bfhi(w.x); f[2] = bflo(w.y); f[3] = bfhi(w.y); f[4] = bflo(w.z); f[5] = bfhi(w.z); f[6] = bflo(w.w); f[7] = bfhi(w.w);
}
__device__ __forceinline__ u32x4 pack8(const float* f) { u32x4 w; w.x = pk2(f[0], f[1]); w.y = pk2(f[2], f[3]); w.z = pk2(f[4], f[5]); w.w = pk2(f[6], f[7]); return w; }
#define DPPF(v, ctrl) __builtin_bit_cast(float, __builtin_amdgcn_update_dpp(0, __builtin_bit_cast(int, (v)), (ctrl), 0xF, 0xF, true))
__device__ __forceinline__ float readlane_f(float v, int l) { return __builtin_bit_cast(float, __builtin_amdgcn_readlane(__builtin_bit_cast(int, v), l)); }
__device__ __forceinline__ float wave_sum_dpp(float v) {
    v += DPPF(v, 0xB1); v += DPPF(v, 0x4E); v += DPPF(v, 0x141); v += DPPF(v, 0x140);
    return (readlane_f(v, 0) + readlane_f(v, 16)) + (readlane_f(v, 32) + readlane_f(v, 48));
}
__device__ __forceinline__ float wave_max_dpp(float v) {
    v = fmaxf(v, DPPF(v, 0xB1)); v = fmaxf(v, DPPF(v, 0x4E)); v = fmaxf(v, DPPF(v, 0x141)); v = fmaxf(v, DPPF(v, 0x140));
    return fmaxf(fmaxf(readlane_f(v, 0), readlane_f(v, 16)), fmaxf(readlane_f(v, 32), readlane_f(v, 48)));
}
#define BLOCK_SYNC() __syncthreads()

#ifdef FP8_EMU
__device__ __forceinline__ void emu8(float& a, float& b, float sc) { const int pk = __builtin_amdgcn_cvt_pk_fp8_f32(a * sc, b * sc, 0, false); const auto r = __builtin_amdgcn_cvt_pk_f32_fp8(pk, false); a = r[0] / sc; b = r[1] / sc; }
__device__ __forceinline__ void emu8v(f32x4& o, float sc) { float a = o.x, b = o.y, c = o.z, d = o.w; emu8(a, b, sc); emu8(c, d, sc); o = (f32x4){a, b, c, d}; }
#endif
#define XB_TMO      128
#define XB_XCNT(j)  (256  + 64 * (j))
#define XB_XSUB(j)  (1280 + 64 * (j))
#define XB_XGEN(j)  (2304 + 64 * (j))
#define XB_TOP      3328
#define XB_TOPGEN   3392
#define XCD_BAR_WORDS 3456
#define XB_SPIN_CAP (1u << 18)

__device__ __forceinline__ unsigned xb_ld(unsigned* p)              { return __hip_atomic_load(p, __ATOMIC_RELAXED, __HIP_MEMORY_SCOPE_AGENT); }
__device__ __forceinline__ unsigned xb_add(unsigned* p, unsigned v) { return __hip_atomic_fetch_add(p, v, __ATOMIC_RELAXED, __HIP_MEMORY_SCOPE_AGENT); }
__device__ __forceinline__ unsigned xb_xcc_id() { return (unsigned)__builtin_amdgcn_s_getreg((3 << 11) | 20) & 0xFu; }
#define XB_SPIN(cond, bar) do { unsigned _sp = 0; while (cond) { __builtin_amdgcn_s_sleep(1); \
    if ((++_sp & 255u) == 0u) { if (xb_ld(&(bar)[XB_TMO])) break; if (_sp > XB_SPIN_CAP) { atomicAdd(&(bar)[XB_TMO], 1u); break; } } } } while (0)

struct XcdBarrier {
    unsigned* bar; unsigned x;
    volatile LAS unsigned* st;
};

__device__ __forceinline__ XcdBarrier xcd_barrier_post(unsigned* bar, volatile LAS unsigned* st) {
    XcdBarrier b; b.bar = bar; b.x = xb_xcc_id(); b.st = st;
    if (threadIdx.x == 0) (void)xb_add(&bar[XB_XCNT(b.x)], 1u);
    return b;
}
__device__ __forceinline__ void xcd_barrier_complete(unsigned* bar, unsigned x, unsigned& nloc, unsigned& nx) {
    const unsigned G = gridDim.x * gridDim.y * gridDim.z;
    unsigned sum, cnt, mine, sp = 0u;
    for (;;) {
        sum = 0u; cnt = 0u; mine = 0u;
#pragma unroll
        for (unsigned j = 0; j < 16; ++j) { const unsigned c = xb_ld(&bar[XB_XCNT(j)]); sum += c; cnt += (c > 0u) ? 1u : 0u; mine = (j == x) ? c : mine; }
        if (sum == G) break;
        __builtin_amdgcn_s_sleep(1);
        if ((++sp & 255u) == 0u) { if (xb_ld(&bar[XB_TMO])) break; if (sp > XB_SPIN_CAP) { atomicAdd(&bar[XB_TMO], 1u); break; } }
    }
    nloc = mine > 0u ? mine : 1u; nx = cnt > 0u ? cnt : 1u;
}

__device__ __forceinline__ void xcd_barrier(const XcdBarrier& b) {
    asm volatile("s_waitcnt vmcnt(0)" ::: "memory");
    __syncthreads();
    if (threadIdx.x == 0) {
        unsigned* bar = b.bar;
        __builtin_amdgcn_s_waitcnt(0);
        unsigned nloc = b.st[0], nx = b.st[1];
        if (nloc == 0u) { xcd_barrier_complete(bar, b.x, nloc, nx); b.st[0] = nloc; b.st[1] = nx; }
        const unsigned old = xb_add(&bar[XB_XSUB(b.x)], 1u);
        const unsigned gen = old / nloc;
        if (old + 1u == (gen + 1u) * nloc) {
            __builtin_amdgcn_fence(__ATOMIC_RELEASE, "agent");
            asm volatile("s_waitcnt vmcnt(0)" ::: "memory");
            const unsigned og = xb_add(&bar[XB_TOP], 1u);
            const unsigned tg = og / nx;
            if (og + 1u == (tg + 1u) * nx) xb_add(&bar[XB_TOPGEN], 1u);
            else XB_SPIN(xb_ld(&bar[XB_TOPGEN]) == tg, bar);
            __builtin_amdgcn_fence(__ATOMIC_ACQUIRE, "agent");
            xb_add(&bar[XB_XGEN(b.x)], 1u);
            asm volatile("s_waitcnt vmcnt(0)" ::: "memory");
        } else {
            XB_SPIN(xb_ld(&bar[XB_XGEN(b.x)]) == gen, bar);
            __builtin_amdgcn_fence(__ATOMIC_ACQUIRE, "agent");
            asm volatile("s_waitcnt vmcnt(0)" ::: "memory");
        }
    }
    __syncthreads();
}

#ifdef FP8_EMU
#define EMU_W5 ((FP8_EMU & 1) != 0)
#define EMU_W6 ((FP8_EMU & 2) != 0)
#else
#define EMU_W5 false
#define EMU_W6 false
#endif
__device__ __forceinline__ void ln_row_bf16(const float* src, const float* g, const float* b, bf16_t* dst, int lane) {
    f32x4 v[8]; float s = 0.f;
#pragma unroll
    for (int j = 0; j < 8; ++j) { v[j] = ((const f32x4*)src)[lane + 64 * j]; s += (v[j].x + v[j].y) + (v[j].z + v[j].w); }
    const float mean = wave_sum(s) * (1.0f / D); float s2 = 0.f;
#pragma unroll
    for (int j = 0; j < 8; ++j) { v[j] = v[j] - mean; s2 += (v[j].x * v[j].x + v[j].y * v[j].y) + (v[j].z * v[j].z + v[j].w * v[j].w); }
    const float rstd = 1.0f / sqrtf(wave_sum(s2) * (1.0f / D) + LN_EPS);
#pragma unroll
    for (int j = 0; j < 8; ++j) {
        const f32x4 gg = ((const f32x4*)g)[lane + 64 * j], bb = ((const f32x4*)b)[lane + 64 * j];
        const f32x4 o = v[j] * rstd * gg + bb;
        u32x2 w; w.x = pk2(o.x, o.y); w.y = pk2(o.z, o.w);
        ((u32x2*)dst)[lane + 64 * j] = w;
    }
}
__device__ __forceinline__ void transpose_item(const float* W, int K, int N, int Npad, bf16_t* Wt, int item, int lane, int ldw = 0) {
    const int nblk = Npad >> 6, kb = item / nblk, nb = item - kb * nblk, n = nb * 64 + lane, k0 = kb * 32;
    float v[32];
    if (n < N) {
#pragma unroll
        for (int i = 0; i < 32; ++i) v[i] = W[(size_t)(k0 + i) * N + n];
    } else {
#pragma unroll
        for (int i = 0; i < 32; ++i) v[i] = 0.f;
    }
    u32x4* o = (u32x4*)(Wt + (size_t)n * (ldw ? ldw : K) + k0);
#pragma unroll
    for (int c = 0; c < 4; ++c) { u32x4 w; w.x = pk2(v[8 * c], v[8 * c + 1]); w.y = pk2(v[8 * c + 2], v[8 * c + 3]); w.z = pk2(v[8 * c + 4], v[8 * c + 5]); w.w = pk2(v[8 * c + 6], v[8 * c + 7]); o[c] = w; }
}
__device__ __forceinline__ void transpose_item_q(const float* W, const float* g, const float* b, bf16_t* Wt, float* c1, float* c2, int item, int lane) {
    const int kb = item >> 5, nb = item & 31, n = nb * 64 + lane, k0 = kb * 32;
    float v[32], s1 = 0.f, s2 = 0.f;
#pragma unroll
    for (int i = 0; i < 32; ++i) { const float w = W[(size_t)(k0 + i) * 2048 + n]; const float gw = g[k0 + i] * w; s1 += gw; s2 += b[k0 + i] * w; v[i] = gw; }
    u32x4* o = (u32x4*)(Wt + (size_t)n * 2048 + k0);
#pragma unroll
    for (int c = 0; c < 4; ++c) { u32x4 w; w.x = pk2(v[8 * c], v[8 * c + 1]); w.y = pk2(v[8 * c + 2], v[8 * c + 3]); w.z = pk2(v[8 * c + 4], v[8 * c + 5]); w.w = pk2(v[8 * c + 6], v[8 * c + 7]); o[c] = w; }
    atomicAdd(c1 + n, s1); atomicAdd(c2 + n, s2);
}
__device__ __forceinline__ unsigned pk4_fp8(float a, float b, float c, float d) {
    int w = __builtin_amdgcn_cvt_pk_fp8_f32(a, b, 0, false); w = __builtin_amdgcn_cvt_pk_fp8_f32(c, d, w, true); return (unsigned)w; }
__device__ __forceinline__ void transpose_item64(const float* W, int K, int N, int Npad, bf16_t* Wt, int ldw, int item, int lane, unsigned char* Wt8 = nullptr, int n8 = 1 << 30, bool emu = false, int ld8 = 2048) {
    const int nblk = Npad >> 6, kb = item / nblk, nb = item - kb * nblk, n = nb * 64 + lane, k0 = kb * 64;
    float v[64];
    if (n < N) {
#pragma unroll
        for (int i = 0; i < 64; ++i) v[i] = W[(size_t)(k0 + i) * N + n];
    } else {
#pragma unroll
        for (int i = 0; i < 64; ++i) v[i] = 0.f;
    }
#ifdef FP8_EMU
    if (emu) {
#pragma unroll
        for (int i = 0; i < 64; i += 2) emu8(v[i], v[i + 1], 64.0f); }
#endif
    if (n >= n8) {
        u32x4* o8 = (u32x4*)(Wt8 + (size_t)(n - n8) * ld8 + k0);
#pragma unroll
        for (int c = 0; c < 4; ++c) { u32x4 w; w.x = pk4_fp8(64.f * v[16 * c], 64.f * v[16 * c + 1], 64.f * v[16 * c + 2], 64.f * v[16 * c + 3]); w.y = pk4_fp8(64.f * v[16 * c + 4], 64.f * v[16 * c + 5], 64.f * v[16 * c + 6], 64.f * v[16 * c + 7]);
            w.z = pk4_fp8(64.f * v[16 * c + 8], 64.f * v[16 * c + 9], 64.f * v[16 * c + 10], 64.f * v[16 * c + 11]); w.w = pk4_fp8(64.f * v[16 * c + 12], 64.f * v[16 * c + 13], 64.f * v[16 * c + 14], 64.f * v[16 * c + 15]); o8[c] = w; }
        return;
    }
    u32x4* o = (u32x4*)(Wt + (size_t)n * ldw + k0);
#pragma unroll
    for (int c = 0; c < 8; ++c) { u32x4 w; w.x = pk2(v[8 * c], v[8 * c + 1]); w.y = pk2(v[8 * c + 2], v[8 * c + 3]); w.z = pk2(v[8 * c + 4], v[8 * c + 5]); w.w = pk2(v[8 * c + 6], v[8 * c + 7]); o[c] = w; }
}
__device__ __forceinline__ void phase0(const Params& P) {
    const int lane = threadIdx.x & 63, wave = threadIdx.x >> 6;
    const int gw = blockIdx.x * 8 + wave, NGW = gridDim.x * 8;
    unsigned char* ws = P.ws;
    constexpr int T_IN = 32 * 184, T_A = 32 * 32, T_B = 16 * 32, T_O = 32 * 32, T_Q = 64 * 32, T_POOL = 4 * 32, T_W2 = 3 * 32, T_A2 = 3 * 32, T_G2 = 8 * 32;
    constexpr int T_LN = MROWS, T_SK = 64;
    constexpr int NIT = T_IN + T_A + T_B + T_O + T_Q + T_POOL + T_W2 + T_A2 + T_G2 + T_SK;
    for (int it = gw; it < NIT; it += NGW) {
        int r = it;
        if (r < T_IN) { transpose_item64(P.in[I_WIN], 2048, INC, NPAD, (bf16_t*)(ws + WS_WTIN), 2048, r, lane, ws + WS_WT8, N_BF); continue; } r -= T_IN;
        if (r < T_A) {
#ifdef P5_F8
            transpose_item64(P.in[I_WBA], 2048, 2048, 2048, nullptr, LDAB, r, lane, ws + WS_WTAB8, 0, false, LDAB); continue; }
#else
            transpose_item64(P.in[I_WBA], 2048, 2048, 2048, (bf16_t*)(ws + WS_WTAB), LDAB, r, lane, nullptr, 1 << 30, EMU_W5); continue; }
#endif
        r -= T_A;
        if (r < T_B) {
#ifdef P5_F8
            transpose_item64(P.in[I_WBB], 1024, 2048, 2048, nullptr, LDAB, r, lane, ws + WS_WTAB8 + 2048, 0, false, LDAB); continue; }
#else
            transpose_item64(P.in[I_WBB], 1024, 2048, 2048, (bf16_t*)(ws + WS_WTAB) + 2048, LDAB, r, lane, nullptr, 1 << 30, EMU_W5); continue; }
#endif
        r -= T_B;
        if (r < T_O) {
#ifdef P6_F8
            transpose_item64(P.in[I_WOUT], 2048, 2048, 2048, nullptr, 2048, r, lane, ws + WS_WTOUT8, 0, false, 2048); continue; }
#else
            transpose_item64(P.in[I_WOUT], 2048, 2048, 2048, (bf16_t*)(ws + WS_WTOUT), 2048, r, lane, nullptr, 1 << 30, EMU_W6); continue; }
#endif
        r -= T_O;
        if (r < T_Q) {
#ifdef REPEAT_PHASE
            float* st = (float*)(ws + (P.ph_lo < 0 ? WS_END : WS_STAT));
#else
            float* st = (float*)(ws + WS_STAT);
#endif
            transpose_item_q(P.in[I_WQ], P.in[I_LN1G], P.in[I_LN1B], (bf16_t*)(ws + WS_WTQ), st + 16384, st + 18432, r, lane); continue; } r -= T_Q;
        if (r < T_POOL) { const int g = r >> 5; transpose_item(P.in[I_WPOOL] + g * 65536, 256, 256, 256, (bf16_t*)(ws + WS_WTPOOL) + g * 65536, r & 31, lane); continue; } r -= T_POOL;
        if (r < T_W2) { transpose_item(P.in[I_WW2], 96, 2048, 2048, (bf16_t*)(ws + WS_WTW2), r, lane); continue; } r -= T_W2;
        if (r < T_A2) { transpose_item(P.in[I_WA2], 96, 2048, 2048, (bf16_t*)(ws + WS_WTA2), r, lane); continue; } r -= T_A2;
        if (r < T_G2) { transpose_item(P.in[I_WG2], 256, 2048, 2048, (bf16_t*)(ws + WS_WTG2), r, lane); continue; } r -= T_G2;
        {
            const float* s = P.in[I_SUBK] + r * 512 + lane * 8; float f[8];
#pragma unroll
            for (int i = 0; i < 8; ++i) f[i] = s[i];
            *(u32x4*)((bf16_t*)(ws + WS_SUBK) + r * 512 + lane * 8) = pack8(f);
        }
    }
    {
        f32x4 gg[8], bb[8];
#pragma unroll
        for (int j = 0; j < 8; ++j) { gg[j] = ((const f32x4*)P.in[I_LNIN_G])[lane + 64 * j]; bb[j] = ((const f32x4*)P.in[I_LNIN_B])[lane + 64 * j]; }
        auto srcrow = [&](int r) -> const float* { return r < NTOK ? P.in[I_X] + (size_t)r * D : P.in[I_META] + (size_t)(r - NTOK) * D; };
        auto finish = [&](int r, f32x4 (&v)[8]) {
            float s = 0.f;
#pragma unroll
            for (int j = 0; j < 8; ++j) s += (v[j].x + v[j].y) + (v[j].z + v[j].w);
            const float mean = wave_sum_dpp(s) * (1.0f / D); float s2 = 0.f;
#pragma unroll
            for (int j = 0; j < 8; ++j) { v[j] = v[j] - mean; s2 += (v[j].x * v[j].x + v[j].y * v[j].y) + (v[j].z * v[j].z + v[j].w * v[j].w); }
            const float rstd = 1.0f / sqrtf(wave_sum_dpp(s2) * (1.0f / D) + LN_EPS);
            bf16_t* dst = (bf16_t*)(ws + WS_H0B) + (size_t)r * D;
            unsigned* dst8 = (unsigned*)(ws + WS_H0B8 + (size_t)r * 2048);
#pragma unroll
            for (int j = 0; j < 8; ++j) { const f32x4 o = v[j] * rstd * gg[j] + bb[j]; u32x2 w; w.x = pk2(o.x, o.y); w.y = pk2(o.z, o.w); ((u32x2*)dst)[lane + 64 * j] = w;
                dst8[lane + 64 * j] = pk4_fp8(o.x, o.y, o.z, o.w); }
        };
        for (int r = gw; r < NTOK + 16; r += 2 * NGW) {
            const int r2 = r + NGW; const bool has2 = r2 < NTOK + 16;
            f32x4 v1[8], v2[8];
#pragma unroll
            for (int j = 0; j < 8; ++j) v1[j] = ((const f32x4*)srcrow(r))[lane + 64 * j];
#pragma unroll
            for (int j = 0; j < 8; ++j) v2[j] = ((const f32x4*)srcrow(has2 ? r2 : r))[lane + 64 * j];
            finish(r, v1); if (has2) finish(r2, v2);
        }
        for (int r = NTOK + 16 + gw; r < MROWS; r += NGW) { bf16_t* dst = (bf16_t*)(ws + WS_H0B) + (size_t)r * D; unsigned* dst8 = (unsigned*)(ws + WS_H0B8 + (size_t)r * 2048);
#pragma unroll
            for (int j = 0; j < 8; ++j) { ((u32x2*)dst)[lane + 64 * j] = (u32x2){0u, 0u}; dst8[lane + 64 * j] = 0u; } }
    }
}
namespace pg8 {
constexpr float LN_EPS_ = 1e-5f;
struct EpiBf16S {
    static constexpr bool PERM = true, AFTER_DRAIN = false; static constexpr int MID_T = -1;
    bf16_t* O; int ldc; float scale;
    __device__ __forceinline__ void operator()(const f32x4 (&acc)[2][2][4][2], const Unit& u, int wr, int wc, int fr, int fq) const {
        const int row0 = u.pm * BM + wr * 64 + fr, col0 = u.pn * BM + wc * 32 + 8 * fq;
#pragma unroll
        for (int ai = 0; ai < 2; ++ai)
#pragma unroll
            for (int m = 0; m < 4; ++m) { bf16_t* rowp = O + (size_t)(row0 + ai * HALF + m * 16) * ldc + col0;
#pragma unroll
                for (int bj = 0; bj < 2; ++bj) { const f32x4 v0 = acc[ai][bj][m][0] * scale, v1 = acc[ai][bj][m][1] * scale;
                    u32x4 w; w.x = cvt_pk_bf16(v0[0], v0[1]); w.y = cvt_pk_bf16(v0[2], v0[3]); w.z = cvt_pk_bf16(v1[0], v1[1]); w.w = cvt_pk_bf16(v1[2], v1[3]);
                    *(u32x4*)(rowp + bj * HALF) = w; } }
    }
};
template <int MIDT> struct EpiGate35T {
    static constexpr bool PERM = false, AFTER_DRAIN = false; static constexpr int MID_T = MIDT;
    bf16_t* O; const bf16_t* p; const float* bgate; float oscale;
    __device__ __forceinline__ void mid(f32x4 (&acc)[2][2][4][2], const Unit& u, int wr, int wc, int fr, int fq) const {
        asm volatile("" : "+v"(fr), "+v"(fq));
        const int row0 = u.pm * BM + wr * 64 + fr, col0 = u.pn * BM + wc * 32 + 4 * fq;
        f32x4 b0[2][2], b1[2][2];
#pragma unroll
        for (int bj = 0; bj < 2; ++bj)
#pragma unroll
            for (int n = 0; n < 2; ++n) { const int col = col0 + bj * HALF + n * 16; b0[bj][n] = *(const f32x4*)(bgate + col); b1[bj][n] = *(const f32x4*)(bgate + D + col); }
        u32x2 pa[2][2][2], pb[2][2][2];
        auto ld = [&](int g, u32x2 (&pp)[2][2][2]) { const size_t row = (size_t)(row0 + (g >> 2) * HALF + (g & 3) * 16);
#pragma unroll
            for (int bj = 0; bj < 2; ++bj)
#pragma unroll
                for (int n = 0; n < 2; ++n) { const int col = col0 + bj * HALF + n * 16; pp[bj][n][0] = *(const u32x2*)(p + row * NPAD + C_G0 + col); pp[bj][n][1] = *(const u32x2*)(p + row * NPAD + C_G1 + col); } };
        auto ap = [&](int g, const u32x2 (&pp)[2][2][2]) { const int ai = g >> 2, m = g & 3;
#pragma unroll
            for (int bj = 0; bj < 2; ++bj)
#pragma unroll
                for (int n = 0; n < 2; ++n) { const u32x2 p0 = pp[bj][n][0], p1 = pp[bj][n][1]; const f32x4 c0 = b0[bj][n], c1 = b1[bj][n];
                    f32x4 r;
                    r.x = (1.0f + __expf(-fmaxf(bflo(p1.x) + c1.x, -80.f))) * __builtin_amdgcn_rcpf(1.0f + __expf(-(bflo(p0.x) + c0.x)));
                    r.y = (1.0f + __expf(-fmaxf(bfhi(p1.x) + c1.y, -80.f))) * __builtin_amdgcn_rcpf(1.0f + __expf(-(bfhi(p0.x) + c0.y)));
                    r.z = (1.0f + __expf(-fmaxf(bflo(p1.y) + c1.z, -80.f))) * __builtin_amdgcn_rcpf(1.0f + __expf(-(bflo(p0.y) + c0.z)));
                    r.w = (1.0f + __expf(-fmaxf(bfhi(p1.y) + c1.w, -80.f))) * __builtin_amdgcn_rcpf(1.0f + __expf(-(bfhi(p0.y) + c0.w)));
                    acc[ai][bj][m][n] = acc[ai][bj][m][n] * r; } };
        ld(0, pa);
#pragma unroll
        for (int g = 0; g < 8; g += 2) { ld(g + 1, pb); ap(g, pa); if (g + 2 < 8) ld(g + 2, pa); ap(g + 1, pb); }
    }
    __device__ __forceinline__ void operator()(const f32x4 (&acc)[2][2][4][2], const Unit& u, int wr, int wc, int fr, int fq) const {
        const int row0 = u.pm * BM + wr * 64 + fr, col0 = u.pn * BM + wc * 32 + 4 * fq;
#pragma unroll
        for (int ai = 0; ai < 2; ++ai)
#pragma unroll
            for (int m = 0; m < 4; ++m) { const size_t row = (size_t)(row0 + ai * HALF + m * 16);
#pragma unroll
                for (int bj = 0; bj < 2; ++bj)
#pragma unroll
                    for (int n = 0; n < 2; ++n) { const int col = col0 + bj * HALF + n * 16;
                        const u32x2 p1 = *(const u32x2*)(p + row * NPAD + C_G1 + col); const f32x4 b1 = *(const f32x4*)(bgate + D + col);
                        f32x4 g;
                        g.x = __builtin_amdgcn_rcpf(1.0f + __expf(-fmaxf(bflo(p1.x) + b1.x, -80.f))); g.y = __builtin_amdgcn_rcpf(1.0f + __expf(-fmaxf(bfhi(p1.x) + b1.y, -80.f)));
                        g.z = __builtin_amdgcn_rcpf(1.0f + __expf(-fmaxf(bflo(p1.y) + b1.z, -80.f))); g.w = __builtin_amdgcn_rcpf(1.0f + __expf(-fmaxf(bfhi(p1.y) + b1.w, -80.f)));
                        const f32x4 o = acc[ai][bj][m][n] * (g * oscale);
#ifdef P6_F8
                        *(unsigned*)((unsigned char*)O + row * D + col) = pk4_fp8(o.x, o.y, o.z, o.w); } }
#else
                        u32x2 w; w.x = cvt_pk_bf16(o.x, o.y); w.y = cvt_pk_bf16(o.z, o.w);
                        *(u32x2*)(O + row * D + col) = w; } }
#endif
    }
};
typedef EpiGate35T<32> EpiGate35;
struct EpiResidStats {
    static constexpr bool PERM = false, AFTER_DRAIN = false; static constexpr int MID_T = -1;
    bf16_t* O; const bf16_t* h0; float alpha; float* rsum; float* rsq; float ascale;
    __device__ __forceinline__ void operator()(const f32x4 (&acc)[2][2][4][2], const Unit& u, int wr, int wc, int fr, int fq) const {
        const int row0 = u.pm * BM + wr * 64 + fr, col0 = u.pn * BM + wc * 32 + 4 * fq;
#pragma unroll
        for (int ai = 0; ai < 2; ++ai)
#pragma unroll
            for (int m = 0; m < 4; ++m) { const size_t row = (size_t)(row0 + ai * HALF + m * 16); float s = 0.f, q = 0.f;
#pragma unroll
                for (int bj = 0; bj < 2; ++bj)
#pragma unroll
                    for (int n = 0; n < 2; ++n) { const int col = col0 + bj * HALF + n * 16;
                        const u32x2 hw = *(const u32x2*)(h0 + row * D + col);
                        f32x4 hv; hv.x = bflo(hw.x); hv.y = bfhi(hw.x); hv.z = bflo(hw.y); hv.w = bfhi(hw.y);
                        const f32x4 x = hv * alpha + acc[ai][bj][m][n] * ascale;
                        s += (x.x + x.y) + (x.z + x.w); q += (x.x * x.x + x.y * x.y) + (x.z * x.z + x.w * x.w);
                        u32x2 w; w.x = cvt_pk_bf16(x.x, x.y); w.y = cvt_pk_bf16(x.z, x.w);
                        *(u32x2*)(O + row * D + col) = w; }
                s += __shfl_xor(s, 16); s += __shfl_xor(s, 32); q += __shfl_xor(q, 16); q += __shfl_xor(q, 32);
                if (fq == 0) { atomicAdd(rsum + row, s); atomicAdd(rsq + row, q); } }
    }
};
struct EpiQ {
    static constexpr bool PERM = true, AFTER_DRAIN = false; static constexpr int MID_T = -1;
    bf16_t* O; const float* rsum; const float* rsq; const float* c1; const float* c2;
    __device__ __forceinline__ void operator()(const f32x4 (&acc)[2][2][4][2], const Unit& u, int wr, int wc, int fr, int fq) const {
        const int row0 = u.pm * BM + wr * 64 + fr, col0 = u.pn * BM + wc * 32 + 8 * fq;
        f32x4 k1[2][2], k2[2][2];
#pragma unroll
        for (int bj = 0; bj < 2; ++bj)
#pragma unroll
            for (int n = 0; n < 2; ++n) { k1[bj][n] = *(const f32x4*)(c1 + col0 + bj * HALF + 4 * n); k2[bj][n] = *(const f32x4*)(c2 + col0 + bj * HALF + 4 * n); }
#pragma unroll
        for (int ai = 0; ai < 2; ++ai)
#pragma unroll
            for (int m = 0; m < 4; ++m) { const int row = row0 + ai * HALF + m * 16;
                const float mean = rsum[row] * (1.0f / D), rstd = 1.0f / sqrtf(fmaxf(rsq[row] * (1.0f / D) - mean * mean, 0.f) + LN_EPS_);
                bf16_t* rowp = O + (size_t)row * D + col0;
#pragma unroll
                for (int bj = 0; bj < 2; ++bj) {
                    const f32x4 v0 = (acc[ai][bj][m][0] - k1[bj][0] * mean) * rstd + k2[bj][0], v1 = (acc[ai][bj][m][1] - k1[bj][1] * mean) * rstd + k2[bj][1];
                    u32x4 w; w.x = cvt_pk_bf16(v0[0], v0[1]); w.y = cvt_pk_bf16(v0[2], v0[3]); w.z = cvt_pk_bf16(v1[0], v1[1]); w.w = cvt_pk_bf16(v1[2], v1[3]);
                    *(u32x4*)(rowp + bj * HALF) = w; } }
    }
};
}
template <class Epi>
__device__ __forceinline__ void run_gemm(ldsp lds, const bf16_t* A, const bf16_t* Bt, int M, int N, int K, const Epi& E) {
    pg8::Gemm g; g.A = A; g.Bt = Bt; g.M = M; g.N = N; g.K = K;
    pg8::StaticOrder S; S.init(M, N, (int)gridDim.x, (int)blockIdx.x);
    pg8::gemm_phase<Epi, pg8::StaticOrder, false>(lds, g, S, E, nullptr);
}

template <class Epi>
__device__ __forceinline__ void run_gemm8(ldsp lds, const unsigned char* A8, const unsigned char* Bt8, int M, int N, int K, const Epi& E, int wg) {
    pg8::Gemm g; g.A = (const bf16_t*)A8; g.Bt = (const bf16_t*)Bt8; g.M = M; g.N = N; g.K = K / 2;
    pg8::StaticOrder S; S.init(M, N, (int)gridDim.x, wg);
    pg8::gemm_phase<Epi, pg8::StaticOrder, false, true>(lds, g, S, E, nullptr);
}
constexpr int CONV_P3_END = 16384;
constexpr int CONV_P2_ROWS = 0;
__device__ __forceinline__ void convert_row(unsigned char* ws, int r, int lane, const f32x4 (&v)[8]) {
    float am = 0.f, ss = 0.f;
#pragma unroll
    for (int j = 0; j < 8; ++j) { am = fmaxf(am, fmaxf(fmaxf(fabsf(v[j].x), fabsf(v[j].y)), fmaxf(fabsf(v[j].z), fabsf(v[j].w)))); ss += (v[j].x * v[j].x + v[j].y * v[j].y) + (v[j].z * v[j].z + v[j].w * v[j].w); }
    am = wave_max_dpp(am);
    const float rms = sqrtf(wave_sum_dpp(ss) * (1.0f / D));
    unsigned w[4]; float sc;
    if (r < 16384) {
        const float clip = fminf(am, 2.5f * rms), s = clip > 0.f ? 7.0f / clip : 1.0f; sc = clip > 0.f ? clip * (1.0f / 7.0f) : 1.0f;
#pragma unroll
        for (int j = 0; j < 4; ++j) { unsigned t = 0;
#pragma unroll
            for (int i = 0; i < 8; ++i) { const float f = fminf(fmaxf(v[2 * j + (i >> 2)][i & 3] * s, -7.0f), 7.0f);
                t = __builtin_amdgcn_alignbit(__float_as_uint(f + 12582912.0f), t, 4); }
            w[j] = t; }
    } else {
        const float clip = fminf(am, 3.0f * rms), s = clip > 0.f ? 6.0f / clip : 1.0f; sc = clip > 0.f ? clip * (1.0f / 6.0f) : 1.0f;
#pragma unroll
        for (int j = 0; j < 4; ++j) { unsigned t = 0; float f[8];
#pragma unroll
            for (int i = 0; i < 8; ++i) f[i] = fminf(fmaxf(v[2 * j + (i >> 2)][i & 3] * s, -6.0f), 6.0f);
            t = __builtin_amdgcn_cvt_scalef32_pk_fp4_f32(t, f[0], f[1], 1.0f, 0); t = __builtin_amdgcn_cvt_scalef32_pk_fp4_f32(t, f[2], f[3], 1.0f, 1);
            t = __builtin_amdgcn_cvt_scalef32_pk_fp4_f32(t, f[4], f[5], 1.0f, 2); t = __builtin_amdgcn_cvt_scalef32_pk_fp4_f32(t, f[6], f[7], 1.0f, 3);
            w[j] = t; }
    }
    *(u32x4*)(ws + WS_VB + (size_t)(r & 16383) * EROW + (r < 16384 ? 0 : 1024) + lane * 16) = (u32x4){w[0], w[1], w[2], w[3]};
    if (lane == 0) ((float*)(ws + WS_TSC))[r] = sc;
}
__device__ __forceinline__ void convert_ld(const Params& P, int r, int lane, f32x4 (&v)[8]) {
    const f32x4* src = (const f32x4*)((r < 16384 ? P.in[I_UT] : P.in[I_VT]) + (size_t)(r & 16383) * D) + lane;
#pragma unroll
    for (int j = 0; j < 8; ++j) v[j] = src[64 * j];
}
__device__ __forceinline__ void convert_tables(const Params& P, int r0, int rend, int stride) {
    const int lane = threadIdx.x & 63;
    for (int r = r0; r < rend; r += stride) { f32x4 v[8]; convert_ld(P, r, lane, v); convert_row(P.ws, r, lane, v); }
}
constexpr int LD64 = 72, MATB = 64 * LD64 * 2, LDK = 104;
constexpr int O_AB = 0, O_RB = 1 * MATB, O_BH = 2 * MATB, O_KH = 3 * MATB, O_BTT = 4 * MATB, O_KTT = 5 * MATB, O_VT = 6 * MATB;
constexpr int O_M0 = 7 * MATB, O_M0T = 8 * MATB  , O_M1 = 9 * MATB, O_PA = 10 * MATB, O_PB = 11 * MATB, O_MAK = 12 * MATB, O_MRB = 13 * MATB, O_MRK = 14 * MATB;
constexpr int O_M1T = 0;
constexpr int LDKP = 96;
constexpr int O_WL = 15 * MATB, O_AL = O_WL + 64 * LDKP * 2;
constexpr int O_Z = 7 * MATB, O_AZ = O_Z + 64 * 68 * 4;
static_assert(O_AZ + 64 * 68 * 4 <= O_PB, "lds");
static_assert(O_AL + 64 * LDKP * 2 <= LDS_BYTES - 16, "lds");

__device__ __forceinline__ bf16x8 ldsfrag(ldsp lds, int off, int ld, int row, int kofs) { return *(const LAS bf16x8*)(lds + off + (row * ld + kofs) * 2); }
__device__ __forceinline__ void st4(ldsp lds, int off, int row, int col, const f32x4 v) {
    u32x2 w; w.x = pk2(v.x, v.y); w.y = pk2(v.z, v.w); *(LAS u32x2*)(lds + off + (row * LD64 + col) * 2) = w; }
__device__ __forceinline__ void st1(ldsp lds, int off, int row, int col, float v) { *(LAS bf16_t*)(lds + off + (row * LD64 + col) * 2) = f2bf1(v); }

__device__ __forceinline__ float fast_rcp(float x) { return __builtin_amdgcn_rcpf(x); }
__device__ __forceinline__ float fast_sigmoid(float x) { return fast_rcp(1.0f + __expf(-x)); }
__device__ __forceinline__ float fast_tanh(float x) { return 1.0f - 2.0f * fast_rcp(1.0f + __expf(2.0f * x)); }
__device__ __forceinline__ u32x4 ld8(const bf16_t* p) { return p ? *(const u32x4*)p : (u32x4){0u, 0u, 0u, 0u}; }
__device__ __forceinline__ void shift8r(const u32x4 cw, const u32x4 pw, const float* mu, float* x) {
    float c[8], q[8]; unpack8(cw, c); unpack8(pw, q);
    const f32x4 m0 = *(const f32x4*)mu, m1 = *(const f32x4*)(mu + 4);
    const float mm[8] = {m0.x, m0.y, m0.z, m0.w, m1.x, m1.y, m1.z, m1.w};
#pragma unroll
    for (int i = 0; i < 8; ++i) x[i] = c[i] + (q[i] - c[i]) * mm[i];
}
__device__ __forceinline__ int tcol(int row, int col) { return ((((col >> 3) ^ (row >> 3)) & 7) << 3) | (col & 7); }
__device__ __forceinline__ bf16x8 ldsfragT(ldsp lds, int off, int row, int kofs) { return *(const LAS bf16x8*)(lds + off + (row * LD64 + tcol(row, kofs)) * 2); }
__device__ __forceinline__ void st1T(ldsp lds, int off, int row, int col, float v) { *(LAS bf16_t*)(lds + off + (row * LD64 + tcol(row, col)) * 2) = f2bf1(v); }
typedef short s16x4 __attribute__((ext_vector_type(4)));
__device__ __forceinline__ bf16x8 ldsfragTR(ldsp lds, int off, int krow0, int col0, int lane) {
    const int g = lane >> 4, q = (lane & 15) >> 2, p = lane & 3;
    const LAS s16x4* a = (const LAS s16x4*)(lds + off + ((krow0 + 8 * g + q) * LD64 + col0) * 2 + 8 * p);
    const s16x4 v0 = __builtin_amdgcn_ds_read_tr16_b64_v4i16((LAS s16x4*)a), v1 = __builtin_amdgcn_ds_read_tr16_b64_v4i16((LAS s16x4*)(a + LD64));
    return (bf16x8){v0[0], v0[1], v0[2], v0[3], v1[0], v1[1], v1[2], v1[3]};
}
__device__ __forceinline__ void shift8(const bf16_t* pcur, const bf16_t* pprev, const float* mu, float* x) {
    float c[8], q[8];
    if (pcur) unpack8(*(const u32x4*)pcur, c); else {
#pragma unroll
        for (int i = 0; i < 8; ++i) c[i] = 0.f; }
    if (pprev) unpack8(*(const u32x4*)pprev, q); else {
#pragma unroll
        for (int i = 0; i < 8; ++i) q[i] = 0.f; }
    const f32x4 m0 = *(const f32x4*)mu, m1 = *(const f32x4*)(mu + 4);
    const float mm[8] = {m0.x, m0.y, m0.z, m0.w, m1.x, m1.y, m1.z, m1.w};
#pragma unroll
    for (int i = 0; i < 8; ++i) x[i] = c[i] + (q[i] - c[i]) * mm[i];
}

template <bool DO_P, bool DO_SQ>
__device__ __forceinline__ void dbl_step(ldsp lds, int sN, int sT, int dN, int dT, int pC, int pN, int tm, int tn0, int fr, int fq) {
    bf16x8 a[2];
#pragma unroll
    for (int ks = 0; ks < 2; ++ks) a[ks] = ldsfragTR(lds, sN, 32 * ks, 16 * tm, 16 * fq + fr);
#pragma unroll
    for (int t2 = 0; t2 < 2; ++t2) {
        const int nt = tn0 + t2, t = 16 * nt + fr, s0 = 16 * tm + 4 * fq;
        if (DO_P) {
            f32x4 acc = {0.f, 0.f, 0.f, 0.f};
#pragma unroll
            for (int ks = 0; ks < 2; ++ks) acc = mfma16(a[ks], ldsfrag(lds, pC, LD64, t, ks * 32 + fq * 8), acc);
            const u32x2 pw = *(const LAS u32x2*)(lds + pC + (t * LD64 + s0) * 2);
            acc.x += bflo(pw.x); acc.y += bfhi(pw.x); acc.z += bflo(pw.y); acc.w += bfhi(pw.y);
            st4(lds, pN, t, s0, acc);
        }
        if (DO_SQ) {
            f32x4 acc = {0.f, 0.f, 0.f, 0.f};
#pragma unroll
            for (int ks = 0; ks < 2; ++ks) acc = mfma16(a[ks], ldsfrag(lds, sN, LD64, t, ks * 32 + fq * 8), acc);
            st4(lds, dN, t, s0, acc);
        }
    }
}


struct PL { u32x4 rc, rq, kc, kq, vc, vq; };
__device__ __forceinline__ const bf16_t* unit_rowp(const bf16_t* pp, int u, int tl, int col) {
    int r;
    if (u >= 4096) r = (tl >= 48) ? (ROW_META + tl - 48) : -1;
    else { const int bh = u >> 6, c = u & 63, b = bh >> 5; r = (tl >= 0 || c > 0) ? (b * SEQ + c * 64 + tl) : (ROW_META + 15); }
    return r < 0 ? (const bf16_t*)nullptr : pp + (size_t)r * NPAD + col;
}
__device__ __forceinline__ void pl_load(const Params& P, int u, PL& L) {
    int tid = threadIdx.x; asm volatile("" : "+v"(tid));
    const int lane = tid & 63, wave = tid >> 6, fr = lane & 15, fq = lane >> 4, tm = wave >> 1;
    const bf16_t* pp = (const bf16_t*)(P.ws + WS_P);
    const int h = (u >= 4096) ? (u - 4096) : ((u >> 6) & 31);
    const int t = tid >> 3, hj = h * 64 + 8 * (tid & 7);
    L.rc = ld8(unit_rowp(pp, u, t, C_R + hj)); L.rq = ld8(unit_rowp(pp, u, t - 1, C_R + hj));
    L.kc = ld8(unit_rowp(pp, u, t, C_K + hj)); L.kq = ld8(unit_rowp(pp, u, t - 1, C_K + hj));
    L.vc = ld8(unit_rowp(pp, u, t, C_V + hj)); L.vq = ld8(unit_rowp(pp, u, t - 1, C_V + hj));
}
#define SINGLE_TRIP for (int once_ = 0; once_ < 1; ++once_)
__device__ __forceinline__ void rwkv_unit(const Params& P, ldsp lds, int u, PL& L, int next_u, bool stage_a) {
    int tid = threadIdx.x; asm volatile("" : "+v"(tid));
    const int lane = tid & 63, wave = tid >> 6, fr = lane & 15, fq = lane >> 4, tm = wave >> 1, tn0 = (wave & 1) * 2;
    unsigned char* ws = P.ws;
    const bf16_t* pp = (const bf16_t*)(ws + WS_P);
    const bool meta = u >= 4096;
    int b = 0, h, c = 0;
    if (meta) { h = u - 4096; } else { const int bh = u >> 6; c = u & 63; b = bh >> 5; h = bh & 31; }
    auto rowof = [&](int tl) -> int {
        if (meta) return (tl >= 48) ? (ROW_META + tl - 48) : -1;
        if (tl >= 0 || c > 0) return b * SEQ + c * 64 + tl;
        return ROW_META + 15;
    };
    auto rowp = [&](int tl, int col) -> const bf16_t* { const int r = rowof(tl); return r < 0 ? (const bf16_t*)nullptr : pp + (size_t)r * NPAD + col; };
    const float* mu = P.in[I_MU];
    float lw[8], av[8], rv[8], kv[8], vv[8], kk[8], km[8];
    const int t = tid >> 3, jq = tid & 7, j0 = 8 * jq, hj = h * 64 + j0;
    const bool nulltok = meta && t < 48;
    SINGLE_TRIP {
    bf16x8 lAw[3], lAa[3];
    {
        const bf16_t* ww2 = (const bf16_t*)(ws + WS_WTW2) + (size_t)(h * 64 + 16 * tm + fr) * 96 + fq * 8;
        const bf16_t* wa2 = (const bf16_t*)(ws + WS_WTA2) + (size_t)(h * 64 + 16 * tm + fr) * 96 + fq * 8;
#pragma unroll
        for (int ks = 0; ks < 3; ++ks) { lAw[ks] = *(const bf16x8*)(ww2 + ks * 32); lAa[ks] = *(const bf16x8*)(wa2 + ks * 32); }
    }
    if (stage_a) {
        u32x4 cw[3], pw[3];
#pragma unroll
        for (int it = 0; it < 3; ++it) { const int idx = tid + 512 * it, mat = idx / 768, rem = idx - mat * 768, tt = rem / 12, ch = rem - tt * 12, col = (mat ? C_AL : C_WL) + ch * 8;
            cw[it] = ld8(rowp(tt, col)); pw[it] = ld8(rowp(tt - 1, col)); }
#pragma unroll
        for (int it = 0; it < 3; ++it) { const int idx = tid + 512 * it, mat = idx / 768, rem = idx - mat * 768, tt = rem / 12, ch = rem - tt * 12, col = (mat ? C_AL : C_WL) + ch * 8;
            float x[8]; shift8r(cw[it], pw[it], mu + col, x);
            if (mat == 0) {
#pragma unroll
                for (int i = 0; i < 8; ++i) x[i] = fast_tanh(x[i]);
            }
            *(LAS u32x4*)(lds + (mat ? O_AL : O_WL) + (tt * LDKP + ch * 8) * 2) = pack8(x); }
    }
    BLOCK_SYNC();
    {
        f32x4 z[2] = {{0.f, 0.f, 0.f, 0.f}, {0.f, 0.f, 0.f, 0.f}}, az[2] = {{0.f, 0.f, 0.f, 0.f}, {0.f, 0.f, 0.f, 0.f}};
#pragma unroll
        for (int ks = 0; ks < 3; ++ks) {
            const bf16x8 aw = lAw[ks], aa = lAa[ks];
#pragma unroll
            for (int t2 = 0; t2 < 2; ++t2) {
                const int t = 16 * (tn0 + t2) + fr;
                z[t2] = mfma16(aw, ldsfrag(lds, O_WL, LDKP, t, ks * 32 + fq * 8), z[t2]);
                az[t2] = mfma16(aa, ldsfrag(lds, O_AL, LDKP, t, ks * 32 + fq * 8), az[t2]);
            }
        }
#pragma unroll
        for (int t2 = 0; t2 < 2; ++t2) {
            const int t = 16 * (tn0 + t2) + fr, j0 = 16 * tm + 4 * fq;
            *(LAS f32x4*)(lds + O_Z + (t * 68 + j0) * 4) = z[t2];
            *(LAS f32x4*)(lds + O_AZ + (t * 68 + j0) * 4) = az[t2];
        }
    }
    BLOCK_SYNC();
    float cs[8];
    {
        const f32x4 z0 = *(const LAS f32x4*)(lds + O_Z + (t * 68 + j0) * 4), z1 = *(const LAS f32x4*)(lds + O_Z + (t * 68 + j0 + 4) * 4);
        const f32x4 y0 = *(const LAS f32x4*)(lds + O_AZ + (t * 68 + j0) * 4), y1 = *(const LAS f32x4*)(lds + O_AZ + (t * 68 + j0 + 4) * 4);
        const float zz[8] = {z0.x, z0.y, z0.z, z0.w, z1.x, z1.y, z1.z, z1.w}, yy[8] = {y0.x, y0.y, y0.z, y0.w, y1.x, y1.y, y1.z, y1.w};
        const f32x4 w0a = *(const f32x4*)(P.in[I_W0] + hj), w0b = *(const f32x4*)(P.in[I_W0] + hj + 4), a0a = *(const f32x4*)(P.in[I_A0] + hj), a0b = *(const f32x4*)(P.in[I_A0] + hj + 4);
        const float w0[8] = {w0a.x, w0a.y, w0a.z, w0a.w, w0b.x, w0b.y, w0b.z, w0b.w}, a0[8] = {a0a.x, a0a.y, a0a.z, a0a.w, a0b.x, a0b.y, a0b.z, a0b.w};
#pragma unroll
        for (int i = 0; i < 8; ++i) { lw[i] = nulltok ? 0.f : -DSCALE * fast_sigmoid(w0[i] + zz[i]); av[i] = fast_sigmoid(a0[i] + yy[i]); cs[i] = lw[i]; }
#pragma unroll
        for (int d = 8; d < 64; d <<= 1) {
#pragma unroll
            for (int i = 0; i < 8; ++i) { const float o = __shfl_up(cs[i], d); cs[i] += (lane >= d) ? o : 0.f; }
        }
        if (lane >= 56) {
#pragma unroll
            for (int i = 0; i < 8; ++i) *(LAS float*)(lds + (wave < 4 ? O_BH : O_KH) + ((j0 + i) * LD64 + 64) * 2 + (wave & 3) * 4) = cs[i]; }
        shift8r(L.rc, L.rq, mu + C_R + hj, rv); shift8r(L.kc, L.kq, mu + C_K + hj, kv); shift8r(L.vc, L.vq, mu + C_V + hj, vv);
        if (nulltok) {
#pragma unroll
            for (int i = 0; i < 8; ++i) { rv[i] = 0.f; kv[i] = 0.f; vv[i] = 0.f; }
        }
        const f32x4 kka = *(const f32x4*)(P.in[I_KK] + hj), kkb = *(const f32x4*)(P.in[I_KK] + hj + 4), kaa = *(const f32x4*)(P.in[I_KA] + hj), kab = *(const f32x4*)(P.in[I_KA] + hj + 4);
        const f32x4 rka = *(const f32x4*)(P.in[I_RK] + hj), rkb = *(const f32x4*)(P.in[I_RK] + hj + 4);
        const float kkw[8] = {kka.x, kka.y, kka.z, kka.w, kkb.x, kkb.y, kkb.z, kkb.w}, kaw[8] = {kaa.x, kaa.y, kaa.z, kaa.w, kab.x, kab.y, kab.z, kab.w}, rkw[8] = {rka.x, rka.y, rka.z, rka.w, rkb.x, rkb.y, rkb.z, rkb.w};
        float n2 = 0.f, bon = 0.f;
#pragma unroll
        for (int i = 0; i < 8; ++i) { kk[i] = kv[i] * kkw[i]; n2 += kk[i] * kk[i]; km[i] = kv[i] * (1.0f + (av[i] - 1.0f) * kaw[i]); bon += rv[i] * km[i] * rkw[i]; }
        n2 += DPPF(n2, 0xB1); n2 += DPPF(n2, 0x4E); n2 += DPPF(n2, 0x141);
        bon += DPPF(bon, 0xB1); bon += DPPF(bon, 0x4E); bon += DPPF(bon, 0x141);
        const float inv = 1.0f / fmaxf(sqrtf(n2), 1e-12f);
#pragma unroll
        for (int i = 0; i < 8; ++i) kk[i] *= inv;
        if (!meta && jq == 0) ((float*)(ws + WS_BONUS))[(size_t)(b * SEQ + c * 64 + t) * 32 + h] = bon;
    }
    BLOCK_SYNC();
    {
        float Lc[8], Le[8];
#pragma unroll
        for (int i = 0; i < 8; ++i) { Lc[i] = cs[i]; Le[i] = 0.f; }
#pragma unroll
        for (int i = 0; i < 8; ++i) {
            const f32x4 wa = *(const LAS f32x4*)(lds + O_BH + ((j0 + i) * LD64 + 64) * 2), wb = *(const LAS f32x4*)(lds + O_KH + ((j0 + i) * LD64 + 64) * 2);
            const float ww[8] = {wa.x, wa.y, wa.z, wa.w, wb.x, wb.y, wb.z, wb.w};
#pragma unroll
            for (int w = 0; w < 8; ++w) { Le[i] += ww[w]; Lc[i] += (w < wave) ? ww[w] : 0.f; }
        }
        float Ab[8], Rb[8], Bh[8], Kh[8], Bt[8], Kt[8];
#pragma unroll
        for (int i = 0; i < 8; ++i) {
            const float eP = __expf(Lc[i] - lw[i]), eC = __expf(Lc[i]), eN = __expf(-Lc[i]), eE = __expf(Le[i] - Lc[i]);
            const float ka = kk[i] * av[i];
            Ab[i] = -kk[i] * eP; Rb[i] = rv[i] * eC; Bh[i] = ka * eN; Kh[i] = km[i] * eN; Bt[i] = ka * eE; Kt[i] = km[i] * eE;
        }
        *(LAS u32x4*)(lds + O_AB + (t * LD64 + j0) * 2) = pack8(Ab);
        *(LAS u32x4*)(lds + O_RB + (t * LD64 + j0) * 2) = pack8(Rb);
        *(LAS u32x4*)(lds + O_BH + (t * LD64 + j0) * 2) = pack8(Bh);
        *(LAS u32x4*)(lds + O_KH + (t * LD64 + j0) * 2) = pack8(Kh);
        *(LAS u32x4*)(lds + O_BTT + (t * LD64 + j0) * 2) = pack8(Bt);
        *(LAS u32x4*)(lds + O_KTT + (t * LD64 + j0) * 2) = pack8(Kt);
        *(LAS u32x4*)(lds + O_VT + (t * LD64 + j0) * 2) = pack8(vv);
        if (t == 63) {
#pragma unroll
            for (int i = 0; i < 8; ++i) *(LAS float*)(lds + O_RB + ((j0 + i) * LD64 + 64) * 2) = __expf(Le[i]);
        }
    }
    BLOCK_SYNC();
    }
    if (next_u >= 0) pl_load(P, next_u, L);
    SINGLE_TRIP {
    {
        bf16x8 abh[2], akh[2];
#pragma unroll
        for (int ks = 0; ks < 2; ++ks) { abh[ks] = ldsfrag(lds, O_BH, LD64, 16 * tm + fr, ks * 32 + fq * 8); akh[ks] = ldsfrag(lds, O_KH, LD64, 16 * tm + fr, ks * 32 + fq * 8); }
#pragma unroll
        for (int t2 = 0; t2 < 2; ++t2) {
            const int tt = 16 * (tn0 + t2) + fr, s0 = 16 * tm + 4 * fq;
            f32x4 mab = {0.f, 0.f, 0.f, 0.f}, mak = mab, mrb = mab, mrk = mab;
#pragma unroll
            for (int ks = 0; ks < 2; ++ks) {
                const bf16x8 bab = ldsfrag(lds, O_AB, LD64, tt, ks * 32 + fq * 8), brb = ldsfrag(lds, O_RB, LD64, tt, ks * 32 + fq * 8);
                mab = mfma16(abh[ks], bab, mab); mak = mfma16(akh[ks], bab, mak); mrb = mfma16(abh[ks], brb, mrb); mrk = mfma16(akh[ks], brb, mrk);
            }
            float vab[4] = {mab.x, mab.y, mab.z, mab.w}, vak[4] = {mak.x, mak.y, mak.z, mak.w}, vrb[4] = {mrb.x, mrb.y, mrb.z, mrb.w}, vrk[4] = {mrk.x, mrk.y, mrk.z, mrk.w}, vp[4];
#pragma unroll
            for (int r = 0; r < 4; ++r) { const int s = s0 + r; const bool st = s < tt, le = s <= tt;
                vab[r] = st ? vab[r] : 0.f; vak[r] = st ? vak[r] : 0.f; vrb[r] = le ? vrb[r] : 0.f; vrk[r] = le ? vrk[r] : 0.f; vp[r] = vab[r] + (s == tt ? 1.0f : 0.f); }
            st4(lds, O_M0, tt, s0, (f32x4){vab[0], vab[1], vab[2], vab[3]});
            st4(lds, O_PA, tt, s0, (f32x4){vp[0], vp[1], vp[2], vp[3]});
            st4(lds, O_MAK, tt, s0, (f32x4){vak[0], vak[1], vak[2], vak[3]});
            st4(lds, O_MRB, tt, s0, (f32x4){vrb[0], vrb[1], vrb[2], vrb[3]});
            st4(lds, O_MRK, tt, s0, (f32x4){vrk[0], vrk[1], vrk[2], vrk[3]});
        }
    }
    BLOCK_SYNC();
    dbl_step<false, true>(lds, O_M0, O_M0T, O_M1, O_M1T, 0, 0, tm, tn0, fr, fq); BLOCK_SYNC();
    dbl_step<true, true>(lds, O_M1, O_M1T, O_M0, O_M0T, O_PA, O_PB, tm, tn0, fr, fq); BLOCK_SYNC();
    dbl_step<true, true>(lds, O_M0, O_M0T, O_M1, O_M1T, O_PB, O_PA, tm, tn0, fr, fq); BLOCK_SYNC();
    dbl_step<true, true>(lds, O_M1, O_M1T, O_M0, O_M0T, O_PA, O_PB, tm, tn0, fr, fq); BLOCK_SYNC();
    if (!meta) {
    dbl_step<true, true>(lds, O_M0, O_M0T, O_M1, O_M1T, O_PB, O_PA, tm, tn0, fr, fq); BLOCK_SYNC();
    dbl_step<true, false>(lds, O_M1, O_M1T, 0, 0, O_PA, O_PB, tm, tn0, fr, fq); BLOCK_SYNC();
    }
    }
    const size_t ub = (size_t)u * 4096;
    SINGLE_TRIP {
    {
        bf16x8 aT[2], aMak[2];
#pragma unroll
        for (int ks = 0; ks < 2; ++ks) { aT[ks] = ldsfrag(lds, O_PB, LD64, 16 * tm + fr, ks * 32 + fq * 8); aMak[ks] = ldsfrag(lds, O_MAK, LD64, 16 * tm + fr, ks * 32 + fq * 8); }
#pragma unroll
        for (int t2 = 0; t2 < 2; ++t2) {
            const int n = 16 * (tn0 + t2) + fr, t0 = 16 * tm + 4 * fq;
            f32x4 at = {0.f, 0.f, 0.f, 0.f}, xt = at;
#pragma unroll
            for (int ks = 0; ks < 2; ++ks) { at = mfma16(aT[ks], ldsfragTR(lds, O_AB, 32 * ks, 16 * (tn0 + t2), 16 * fq + fr), at); xt = mfma16(aMak[ks], ldsfragTR(lds, O_VT, 32 * ks, 16 * (tn0 + t2), 16 * fq + fr), xt); }
            st4(lds, O_M0, n, t0, at); st4(lds, O_M0T, n, t0, xt);
        }
    }
    BLOCK_SYNC();
    {
        bf16x8 aT[2], aAt[2];
#pragma unroll
        for (int ks = 0; ks < 2; ++ks) { aT[ks] = ldsfrag(lds, O_PB, LD64, 16 * tm + fr, ks * 32 + fq * 8); aAt[ks] = ldsfrag(lds, O_M0, LD64, 16 * tm + fr, ks * 32 + fq * 8); }
        bf16_t* Rt = (bf16_t*)(ws + WS_RT) + ub; bf16_t* Gp = (bf16_t*)(ws + WS_G) + ub;
#pragma unroll
        for (int t2 = 0; t2 < 2; ++t2) {
            const int n = 16 * (tn0 + t2) + fr, m0 = 16 * tm + 4 * fq;
            f32x4 u0 = {0.f, 0.f, 0.f, 0.f}, rt = u0, g = u0;
#pragma unroll
            for (int ks = 0; ks < 2; ++ks) {
                u0 = mfma16(aT[ks], ldsfrag(lds, O_M0T, LD64, n, ks * 32 + fq * 8), u0);
                rt = mfma16(aAt[ks], ldsfrag(lds, O_MRB, LD64, n, ks * 32 + fq * 8), rt);
                g = mfma16(aAt[ks], ldsfragTR(lds, O_BTT, 32 * ks, 16 * (tn0 + t2), 16 * fq + fr), g);
            }
            st4(lds, O_M1, n, m0, u0);
            const u32x2 rw = *(const LAS u32x2*)(lds + O_RB + (n * LD64 + m0) * 2);
            rt.x += bflo(rw.x); rt.y += bfhi(rw.x); rt.z += bflo(rw.y); rt.w += bfhi(rw.y);
            { u32x2 w; w.x = pk2(rt.x, rt.y); w.y = pk2(rt.z, rt.w); *(u32x2*)(Rt + n * 64 + m0) = w; }
            if ((n >> 2) == (m0 >> 2)) { const float e = *(const LAS float*)(lds + O_RB + (n * LD64 + 64) * 2); const int r = n & 3;
                g.x += (r == 0) ? e : 0.f; g.y += (r == 1) ? e : 0.f; g.z += (r == 2) ? e : 0.f; g.w += (r == 3) ? e : 0.f; }
            { const int pos0 = 32 * (tm >> 1) + 8 * fq + 4 * (tm & 1); u32x2 w; w.x = pk2(g.x, g.y); w.y = pk2(g.z, g.w); *(u32x2*)(Gp + n * 64 + pos0) = w; }
        }
    }
    BLOCK_SYNC();
    {
        bf16x8 aB[2], aK[2], aU[2], aV[2];
#pragma unroll
        for (int ks = 0; ks < 2; ++ks) { const int row = 16 * tm + fr, ko = ks * 32 + fq * 8;
            aB[ks] = ldsfragTR(lds, O_BTT, 32 * ks, 16 * tm, 16 * fq + fr); aK[ks] = ldsfragTR(lds, O_KTT, 32 * ks, 16 * tm, 16 * fq + fr); aU[ks] = ldsfrag(lds, O_M1, LD64, row, ko); aV[ks] = ldsfragTR(lds, O_VT, 32 * ks, 16 * tm, 16 * fq + fr); }
        bf16_t* H0t = (bf16_t*)(ws + WS_H0T) + ub; bf16_t* Y0s = (bf16_t*)(ws + WS_Y0) + ub;
#pragma unroll
        for (int t2 = 0; t2 < 2; ++t2) {
            const int n = 16 * (tn0 + t2) + fr, m0 = 16 * tm + 4 * fq;
            f32x4 hh = {0.f, 0.f, 0.f, 0.f}, yy = hh;
#pragma unroll
            for (int ks = 0; ks < 2; ++ks) { const int ko = ks * 32 + fq * 8;
                const bf16x8 bU = ldsfrag(lds, O_M1, LD64, n, ko), bV = ldsfragTR(lds, O_VT, 32 * ks, 16 * (tn0 + t2), 16 * fq + fr), bRb = ldsfrag(lds, O_MRB, LD64, n, ko), bRk = ldsfrag(lds, O_MRK, LD64, n, ko);
                hh = mfma16(aB[ks], bU, hh); hh = mfma16(aK[ks], bV, hh);
                yy = mfma16(aU[ks], bRb, yy); yy = mfma16(aV[ks], bRk, yy); }
            { u32x2 w; w.x = pk2(hh.x, hh.y); w.y = pk2(hh.z, hh.w); *(u32x2*)(H0t + n * 64 + m0) = w; }
            { u32x2 w; w.x = pk2(yy.x, yy.y); w.y = pk2(yy.z, yy.w); *(u32x2*)(Y0s + n * 64 + m0) = w; }
        }
    }
    BLOCK_SYNC();
    }
}

constexpr int LDU = 264;
__device__ __forceinline__ void pool_load(const Params& P, int pu, u32x4 (&raw)[5]) {
    int tid = threadIdx.x; asm volatile("" : "+v"(tid));
    const bf16_t* pp = (const bf16_t*)(P.ws + WS_P);
    const int g = (pu < 256) ? (pu & 3) : 3 - (pu & 3), tt = pu >> 2, b = tt >> 6, ti0 = (tt & 63) * 64;
#pragma unroll
    for (int k = 0; k < 5; ++k) { const int idx = tid + 512 * k;
        if (idx < 79 * 32) { const int lr = idx >> 5, ch = idx & 31, ti = ti0 + lr - 15; const int row = ti >= 0 ? b * SEQ + ti : ROW_META + 16 + ti;
            raw[k] = *(const u32x4*)(pp + (size_t)row * NPAD + C_POOL + g * 256 + ch * 8); } }
}
__device__ __forceinline__ void pool_unit(const Params& P, ldsp lds, int pu, const u32x4 (&raw)[5]) {
    int tid = threadIdx.x; asm volatile("" : "+v"(tid));
    const int lane = tid & 63, wave = tid >> 6, fr = lane & 15, fq = lane >> 4;
    unsigned char* ws = P.ws;
    const bf16_t* pp = (const bf16_t*)(ws + WS_P);
    const int g = (pu < 256) ? (pu & 3) : 3 - (pu & 3), tt = pu >> 2, b = tt >> 6, ti0 = (tt & 63) * 64;
    constexpr int O_U = 0, O_PL = 79 * LDU * 2;
#pragma unroll
    for (int k = 0; k < 5; ++k) { const int idx = tid + 512 * k; if (idx < 79 * 32) *(LAS u32x4*)(lds + O_U + ((idx >> 5) * LDU + (idx & 31) * 8) * 2) = raw[k]; }
    BLOCK_SYNC();
    {
        const int c0 = (tid & 31) * 8, t0 = (tid >> 5) * 4, win = 2 << g; const float inv = 1.0f / (float)win;
        float s[8], nw[8];
        unpack8(*(const LAS u32x4*)(lds + O_U + ((15 + t0) * LDU + c0) * 2), nw);
#pragma unroll
        for (int i = 0; i < 8; ++i) s[i] = nw[i];
        for (int d = 1; d < win; ++d) { float x[8]; unpack8(*(const LAS u32x4*)(lds + O_U + ((15 + t0 - d) * LDU + c0) * 2), x);
#pragma unroll
            for (int i = 0; i < 8; ++i) s[i] += x[i]; }
#pragma unroll
        for (int k = 0; k < 4; ++k) {
            if (k > 0) { float od[8]; unpack8(*(const LAS u32x4*)(lds + O_U + ((15 + t0 + k) * LDU + c0) * 2), nw); unpack8(*(const LAS u32x4*)(lds + O_U + ((15 + t0 + k - win) * LDU + c0) * 2), od);
#pragma unroll
                for (int i = 0; i < 8; ++i) s[i] += nw[i] - od[i]; }
            float o[8];
#pragma unroll
            for (int i = 0; i < 8; ++i) o[i] = s[i] * inv - nw[i];
            *(LAS u32x4*)(lds + O_PL + ((t0 + k) * LDU + c0) * 2) = pack8(o);
        }
    }
    BLOCK_SYNC();
    {
        const bf16_t* wt = (const bf16_t*)(ws + WS_WTPOOL) + (size_t)g * 65536;
        f32x4 acc[2][4];
#pragma unroll
        for (int a = 0; a < 2; ++a)
#pragma unroll
            for (int n = 0; n < 4; ++n) acc[a][n] = (f32x4){0.f, 0.f, 0.f, 0.f};
#pragma unroll 4
        for (int ks = 0; ks < 8; ++ks) {
            bf16x8 af[2];
#pragma unroll
            for (int a = 0; a < 2; ++a) af[a] = *(const bf16x8*)(wt + (size_t)(32 * wave + 16 * a + fr) * 256 + ks * 32 + fq * 8);
#pragma unroll
            for (int n = 0; n < 4; ++n) { const bf16x8 bf = ldsfrag(lds, O_PL, LDU, 16 * n + fr, ks * 32 + fq * 8);
#pragma unroll
                for (int a = 0; a < 2; ++a) acc[a][n] = mfma16(af[a], bf, acc[a][n]); }
        }
#ifdef P5_F8
        unsigned char* yb = ws + WS_YAB + 2048;
#else
        bf16_t* yb = (bf16_t*)(ws + WS_YAB) + 2048;
#endif
        const float* psc = P.in[I_PSCALE] + g * 256;
#pragma unroll
        for (int a = 0; a < 2; ++a) { const int d0 = 32 * wave + 16 * a + 4 * fq; const f32x4 sc = *(const f32x4*)(psc + d0);
#pragma unroll
            for (int n = 0; n < 4; ++n) { const int t = 16 * n + fr; const f32x4 o = acc[a][n] * sc;
#ifdef P5_F8
                *(unsigned*)(yb + (size_t)(b * SEQ + ti0 + t) * LDAB + g * 256 + d0) = pk4_fp8(o.x, o.y, o.z, o.w); } }
#else
                u32x2 w; w.x = pk2(o.x, o.y); w.y = pk2(o.z, o.w);
                *(u32x2*)(yb + (size_t)(b * SEQ + ti0 + t) * LDAB + g * 256 + d0) = w; } }
#endif
    }
    BLOCK_SYNC();
}
__device__ __forceinline__ void gsig_unit(const Params& P, int gu) {
    int tid = threadIdx.x; asm volatile("" : "+v"(tid));
    const bf16_t* pp = (const bf16_t*)(P.ws + WS_P); bf16_t* gs = (bf16_t*)(P.ws + WS_GSIG);
    const float* mu = P.in[I_MU];
#pragma unroll
    for (int it = 0; it < 4; ++it) {
        const int idx = tid + 512 * it, tl = idx >> 5, ch = idx & 31, col = C_GL + ch * 8;
        const int row = gu * 64 + tl; const int prow = ((row & (SEQ - 1)) == 0) ? (ROW_META + 15) : row - 1;
        float x[8]; shift8r(*(const u32x4*)(pp + (size_t)row * NPAD + col), *(const u32x4*)(pp + (size_t)prow * NPAD + col), mu + col, x);
#pragma unroll
        for (int i = 0; i < 8; ++i) x[i] = fast_sigmoid(x[i]);
        *(u32x4*)(gs + (size_t)row * 256 + ch * 8) = pack8(x);
    }
}
__device__ __forceinline__ void phase2(const Params& P, ldsp lds) {
    PL L;
    for (int j = blockIdx.x; j < 256 + 32 + 128; j += gridDim.x) {
        if (j < 256) {
            const int b = j >> 7, c = (j >> 1) & 63, h0 = (j & 1) * 16;
            pl_load(P, (b * 32 + h0) * 64 + c, L);
            for (int i = 0; i < 16; ++i) { const int u = (b * 32 + h0 + i) * 64 + c; rwkv_unit(P, lds, u, L, i + 1 < 16 ? u + 64 : -1, i == 0); }
        } else if (j < 288) { pl_load(P, 4096 + (j - 256), L); rwkv_unit(P, lds, 4096 + (j - 256), L, -1, true); }
        else gsig_unit(P, j - 288);
    }
}
__device__ __forceinline__ void phase3(const Params& P) {
    const int lane = threadIdx.x & 63, wave = threadIdx.x >> 6, fr = lane & 15, fq = lane >> 4;
    if (wave != 0) { convert_tables(P, blockIdx.x * 7 + (wave - 1), CONV_P3_END, gridDim.x * 7); return; }
    unsigned char* ws = P.ws;
    const bf16_t* Gp = (const bf16_t*)(ws + WS_G); const bf16_t* H0t = (const bf16_t*)(ws + WS_H0T); bf16_t* S0t = (bf16_t*)(ws + WS_S0T);
    for (int item = blockIdx.x; item < 256; item += gridDim.x) {
        const int bh = item >> 2, vq = item & 3, h = bh & 31;
        bf16x8 Sb[2];
#pragma unroll
        for (int ks = 0; ks < 2; ++ks)
#pragma unroll
            for (int i = 0; i < 8; ++i) Sb[ks][i] = 0;
        bf16x8 g0[4][2], g1[4][2], g2[4][2], g3[4][2]; u32x2 h0[4], h1[4], h2[4], h3[4];
        auto load = [&](int step, bf16x8 (&ga)[4][2], u32x2 (&hf)[4]) {
            const int u = (step == 0) ? (4096 + h) : (bh * 64 + step - 1);
            const bf16_t* g = Gp + (size_t)u * 4096; const bf16_t* hh = H0t + (size_t)u * 4096;
#pragma unroll
            for (int mt = 0; mt < 4; ++mt) {
#pragma unroll
                for (int ks = 0; ks < 2; ++ks) ga[mt][ks] = *(const bf16x8*)(g + (16 * mt + fr) * 64 + ks * 32 + fq * 8);
                hf[mt] = *(const u32x2*)(hh + (16 * vq + fr) * 64 + 16 * mt + 4 * fq);
            }
        };
        auto apply = [&](int step, const bf16x8 (&ga)[4][2], const u32x2 (&hf)[4]) {
            f32x4 acc[4];
#pragma unroll
            for (int mt = 0; mt < 4; ++mt) {
                acc[mt] = (f32x4){bflo(hf[mt].x), bfhi(hf[mt].x), bflo(hf[mt].y), bfhi(hf[mt].y)};
                acc[mt] = mfma16(ga[mt][0], Sb[0], acc[mt]);
                acc[mt] = mfma16(ga[mt][1], Sb[1], acc[mt]);
            }
            bf16_t* so = S0t + (size_t)(bh * 64 + step) * 4096 + (16 * vq + fr) * 64 + 4 * fq;
            u32x2 w[4];
#pragma unroll
            for (int mt = 0; mt < 4; ++mt) { w[mt].x = pk2(acc[mt].x, acc[mt].y); w[mt].y = pk2(acc[mt].z, acc[mt].w); *(u32x2*)(so + 16 * mt) = w[mt]; }
#pragma unroll
            for (int ks = 0; ks < 2; ++ks) {
                const u32x4 q4 = (u32x4){w[2 * ks].x, w[2 * ks].y, w[2 * ks + 1].x, w[2 * ks + 1].y};
                Sb[ks] = __builtin_bit_cast(bf16x8, q4);
            }
        };
        load(0, g0, h0); load(1, g1, h1); load(2, g2, h2);
#pragma unroll 1
        for (int step = 0; step < 64; step += 4) {
            load(step + 3, g3, h3); apply(step, g0, h0);
            if (step + 4 < 64) load(step + 4, g0, h0);
            apply(step + 1, g1, h1);
            if (step + 5 < 64) load(step + 5, g1, h1);
            apply(step + 2, g2, h2);
            if (step + 6 < 64) load(step + 6, g2, h2);
            apply(step + 3, g3, h3);
        }
    }
}

constexpr int LDG = 264;
__device__ __forceinline__ void phase3b(const Params& P, ldsp lds) {
    int tid = threadIdx.x; asm volatile("" : "+v"(tid));
    const int lane = tid & 63, wave = tid >> 6, fr = lane & 15, fq = lane >> 4, wq = wave & 3;
    unsigned char* ws = P.ws;
    const bf16_t* pp = (const bf16_t*)(ws + WS_P);
    const float* mu = P.in[I_MU];
    constexpr int O_G2 = 0, O_HP = 64 * LDG * 2;
    {
        u32x4 ra[5], rb[5]; int pu = blockIdx.x;
        if (pu < 512) pool_load(P, pu, ra);
        for (; pu < 512; pu += gridDim.x) {
            const int pn = pu + gridDim.x;
            if (pn < 512) pool_load(P, pn, rb);
            pool_unit(P, lds, pu, ra);
#pragma unroll
            for (int k = 0; k < 5; ++k) ra[k] = rb[k];
        }
    }
    for (int w = blockIdx.x; w < 256; w += gridDim.x) {
        const int h = w & 31;
        BLOCK_SYNC();
        for (int idx = tid; idx < 64 * 32; idx += 512) { const int row = idx >> 5, ch = idx & 31;
            *(LAS u32x4*)(lds + O_G2 + (row * LDG + ch * 8) * 2) = *(const u32x4*)((const bf16_t*)(ws + WS_WTG2) + (size_t)(h * 64 + row) * 256 + ch * 8); }
        if (tid < 48) { const int a = tid >> 4, q4 = tid & 15; const float* src = a == 0 ? P.in[I_GNG] + h * 64 : a == 1 ? P.in[I_GNB] + h * 64 : mu + C_V + h * 64;
            *(LAS f32x4*)(lds + O_HP + a * 256 + q4 * 16) = *(const f32x4*)(src + q4 * 4); }
        BLOCK_SYNC();
        bf16x8 bG[8], bR[2], aS[4][2]; u32x2 yw[4], vc[4], vp[4]; float bon;
        auto unit_of = [&](int it, int& b, int& c) { const int q = (w >> 5) + 8 * (2 * it + (wave >> 2)); b = q >> 6; c = q & 63; };
        auto issue = [&](int it) {
            int b, c; unit_of(it, b, c); const int u = (b * 32 + h) * 64 + c, trow0 = b * SEQ + c * 64 + 16 * wq;
            const size_t ub = (size_t)u * 4096;
            const bf16_t* S0t = (const bf16_t*)(ws + WS_S0T) + ub; const bf16_t* Rt = (const bf16_t*)(ws + WS_RT) + ub; const bf16_t* Y0s = (const bf16_t*)(ws + WS_Y0) + ub;
            const int row = trow0 + fr; const int prow = (c == 0 && wq == 0 && fr == 0) ? (ROW_META + 15) : row - 1;
            const bf16_t* gsr = (const bf16_t*)(ws + WS_GSIG) + (size_t)row * 256 + fq * 8;
#pragma unroll
            for (int ks = 0; ks < 8; ++ks) bG[ks] = *(const bf16x8*)(gsr + ks * 32);
#pragma unroll
            for (int ks = 0; ks < 2; ++ks) bR[ks] = *(const bf16x8*)(Rt + (16 * wq + fr) * 64 + ks * 32 + fq * 8);
#pragma unroll
            for (int mt = 0; mt < 4; ++mt) {
                yw[mt] = *(const u32x2*)(Y0s + (16 * wq + fr) * 64 + 16 * mt + 4 * fq);
#pragma unroll
                for (int ks = 0; ks < 2; ++ks) aS[mt][ks] = *(const bf16x8*)(S0t + (16 * mt + fr) * 64 + ks * 32 + fq * 8);
                const int hc = h * 64 + 16 * mt + 4 * fq;
                vc[mt] = *(const u32x2*)(pp + (size_t)row * NPAD + C_V + hc); vp[mt] = *(const u32x2*)(pp + (size_t)prow * NPAD + C_V + hc);
            }
            bon = ((const float*)(ws + WS_BONUS))[(size_t)row * 32 + h];
        };
        issue(0);
#pragma unroll 1
        for (int it = 0; it < 8; ++it) {
            const int crow = CONV_P3_END + (w * 8 + it) * 8 + wave; f32x4 tv[8];
            if (crow < 32768) convert_ld(P, crow, lane, tv);
            int b, c; unit_of(it, b, c);
            const int row = b * SEQ + c * 64 + 16 * wq + fr;
            f32x4 gacc[4];
#pragma unroll
            for (int mt = 0; mt < 4; ++mt) gacc[mt] = (f32x4){0.f, 0.f, 0.f, 0.f};
#pragma unroll
            for (int ks = 0; ks < 8; ++ks)
#pragma unroll
                for (int mt = 0; mt < 4; ++mt) gacc[mt] = mfma16(*(const LAS bf16x8*)(lds + O_G2 + ((16 * mt + fr) * LDG + ks * 32 + fq * 8) * 2), bG[ks], gacc[mt]);
            f32x4 y[4], vv[4]; const float bonc = bon;
#pragma unroll
            for (int mt = 0; mt < 4; ++mt) {
                y[mt] = (f32x4){bflo(yw[mt].x), bfhi(yw[mt].x), bflo(yw[mt].y), bfhi(yw[mt].y)};
#pragma unroll
                for (int ks = 0; ks < 2; ++ks) y[mt] = mfma16(aS[mt][ks], bR[ks], y[mt]);
                const f32x4 mv = *(const LAS f32x4*)(lds + O_HP + 512 + (16 * mt + 4 * fq) * 4);
                const f32x4 cv = (f32x4){bflo(vc[mt].x), bfhi(vc[mt].x), bflo(vc[mt].y), bfhi(vc[mt].y)}, pv = (f32x4){bflo(vp[mt].x), bfhi(vp[mt].x), bflo(vp[mt].y), bfhi(vp[mt].y)};
                vv[mt] = cv + (pv - cv) * mv;
            }
#pragma unroll
            for (int mt = 0; mt < 4; ++mt) asm volatile("" : "+v"(y[mt]), "+v"(vv[mt]), "+v"(gacc[mt]));
            if (it + 1 < 8) issue(it + 1);
            float s = 0.f;
#pragma unroll
            for (int mt = 0; mt < 4; ++mt) s += (y[mt].x + y[mt].y) + (y[mt].z + y[mt].w);
            s += __shfl_xor(s, 16); s += __shfl_xor(s, 32);
            const float mean = s * (1.0f / 64.0f); float qq = 0.f;
#pragma unroll
            for (int mt = 0; mt < 4; ++mt) { y[mt] = y[mt] - mean; qq += (y[mt].x * y[mt].x + y[mt].y * y[mt].y) + (y[mt].z * y[mt].z + y[mt].w * y[mt].w); }
            qq += __shfl_xor(qq, 16); qq += __shfl_xor(qq, 32);
            const float rstd = 1.0f / sqrtf(qq * (1.0f / 64.0f) + GN_EPS);
#ifdef P5_F8
            unsigned char* ya = ws + WS_YAB + (size_t)row * LDAB + h * 64;
#else
            bf16_t* ya = (bf16_t*)(ws + WS_YAB) + (size_t)row * LDAB + h * 64;
#endif
#pragma unroll
            for (int mt = 0; mt < 4; ++mt) {
                const int i0 = 16 * mt + 4 * fq, hc = h * 64 + i0;
                const f32x4 gg = *(const LAS f32x4*)(lds + O_HP + i0 * 4), gb = *(const LAS f32x4*)(lds + O_HP + 256 + i0 * 4);
                const f32x4 o = (y[mt] * rstd * gg + gb + vv[mt] * bonc) * gacc[mt];
#ifdef P5_F8
                *(unsigned*)(ya + i0) = pk4_fp8(o.x, o.y, o.z, o.w);
#else
                u32x2 wv; wv.x = pk2(o.x, o.y); wv.y = pk2(o.z, o.w);
                *(u32x2*)(ya + i0) = wv;
#endif
            }
            if (crow < 32768) convert_row(ws, crow, lane, tv);
        }
    }
}
__device__ __forceinline__ u32x6 ld_row6(const unsigned char* p) { const u32x2 a = ((const u32x2*)p)[0], b = ((const u32x2*)p)[1], c = ((const u32x2*)p)[2]; return (u32x6){a.x, a.y, b.x, b.y, c.x, c.y}; }
__device__ __forceinline__ void peer_load_x(const Params& P, ldsp lds, int o_par, int tok, int lo, float (&x)[32]) {
    unsigned char* ws = P.ws;
    const bf16_t* hr = (const bf16_t*)(ws + WS_X1B) + (size_t)tok * D + lo * 4;
#pragma unroll
    for (int j = 0; j < 8; ++j) { const u32x2 w = *(const u32x2*)(hr + 256 * j); x[4 * j] = bflo(w.x); x[4 * j + 1] = bfhi(w.x); x[4 * j + 2] = bflo(w.y); x[4 * j + 3] = bfhi(w.y); }
    const float* st = (const float*)(ws + WS_STAT);
    const float mean1 = st[tok] * (1.0f / D), rstd1 = 1.0f / sqrtf(fmaxf(st[8192 + tok] * (1.0f / D) - mean1 * mean1, 0.f) + LN_EPS);
#pragma unroll
    for (int c = 0; c < 8; ++c) { const f32x4 g1 = *(const LAS f32x4*)(lds + o_par + (lo * 4 + 256 * c) * 4), b1 = *(const LAS f32x4*)(lds + o_par + 8192 + (lo * 4 + 256 * c) * 4);
        x[4 * c] = (x[4 * c] - mean1) * rstd1 * g1.x + b1.x; x[4 * c + 1] = (x[4 * c + 1] - mean1) * rstd1 * g1.y + b1.y; x[4 * c + 2] = (x[4 * c + 2] - mean1) * rstd1 * g1.z + b1.z; x[4 * c + 3] = (x[4 * c + 3] - mean1) * rstd1 * g1.w + b1.w; }
}
__device__ __forceinline__ void peer_finish(const Params& P, ldsp lds, int o_par, int tok, int lo, float (&o)[32]) {
    float x[32]; peer_load_x(P, lds, o_par, tok, lo, x);
    float s = 0.f;
#pragma unroll
    for (int i = 0; i < 32; ++i) { o[i] += DN_ALPHA * x[i]; s += o[i]; }
    const float mean = wave_sum_dpp(s) * (1.0f / D); float q = 0.f;
#pragma unroll
    for (int i = 0; i < 32; ++i) { o[i] -= mean; q += o[i] * o[i]; }
    const float rstd = 1.0f / sqrtf(wave_sum_dpp(q) * (1.0f / D) + LN_EPS);
    float* orow = P.out + (size_t)tok * D;
#pragma unroll
    for (int c = 0; c < 8; ++c) {
        const int off = lo * 4 + 256 * c;
        const f32x4 g0 = *(const LAS f32x4*)(lds + o_par + 16384 + off * 4), b0 = *(const LAS f32x4*)(lds + o_par + 24576 + off * 4);
        f32x4 r0;
        r0.x = o[4 * c + 0] * rstd * g0.x + b0.x; r0.y = o[4 * c + 1] * rstd * g0.y + b0.y; r0.z = o[4 * c + 2] * rstd * g0.z + b0.z; r0.w = o[4 * c + 3] * rstd * g0.w + b0.w;
        *(f32x4*)(orow + off) = r0;
    }
}
__device__ __forceinline__ float peer_dot(const u32x4 uu, const unsigned (&xd0)[4], const unsigned (&xd1)[4]) {
    int a0 = 0, a1 = 0; const unsigned ww[4] = {uu.x, uu.y, uu.z, uu.w};
#pragma unroll
    for (int q4 = 0; q4 < 4; ++q4) { a0 = __builtin_amdgcn_sdot8((int)ww[q4], (int)xd0[q4], a0, false); a1 = __builtin_amdgcn_sdot8((int)ww[q4], (int)xd1[q4], a1, false); }
    return (float)(a0 + (a1 << 4));
}
__device__ __forceinline__ void peer_axpy(const u32x4 vv, float a, float (&o)[32]) {
    const f32x2 a2 = {a, a}; const unsigned ww[4] = {vv.x, vv.y, vv.z, vv.w};
#pragma unroll
    for (int q4 = 0; q4 < 4; ++q4) {
        const f32x2 r0 = __builtin_amdgcn_cvt_scalef32_pk_f32_fp4(ww[q4], 1.0f, 0), r1 = __builtin_amdgcn_cvt_scalef32_pk_f32_fp4(ww[q4], 1.0f, 1), r2 = __builtin_amdgcn_cvt_scalef32_pk_f32_fp4(ww[q4], 1.0f, 2), r3 = __builtin_amdgcn_cvt_scalef32_pk_f32_fp4(ww[q4], 1.0f, 3);
        f32x2 t;
        t = __builtin_elementwise_fma(a2, r0, (f32x2){o[8 * q4], o[8 * q4 + 1]}); o[8 * q4] = t.x; o[8 * q4 + 1] = t.y;
        t = __builtin_elementwise_fma(a2, r1, (f32x2){o[8 * q4 + 2], o[8 * q4 + 3]}); o[8 * q4 + 2] = t.x; o[8 * q4 + 3] = t.y;
        t = __builtin_elementwise_fma(a2, r2, (f32x2){o[8 * q4 + 4], o[8 * q4 + 5]}); o[8 * q4 + 4] = t.x; o[8 * q4 + 5] = t.y;
        t = __builtin_elementwise_fma(a2, r3, (f32x2){o[8 * q4 + 6], o[8 * q4 + 7]}); o[8 * q4 + 6] = t.x; o[8 * q4 + 7] = t.y; }
}
__device__ __forceinline__ void peer_round(const Params& P, ldsp lds, int o_ex, int o_gt, int o_list, int o_par, int tok, int tl) {
    int lo = threadIdx.x & 63; asm volatile("" : "+v"(lo));
    const int wave = threadIdx.x >> 6;
    unsigned char* ws = P.ws;
    const unsigned char* Ub = ws + WS_UB; const unsigned char* Vb = ws + WS_VB;
    const float* tsc = (const float*)(ws + WS_TSC);
    float o[32]; unsigned xd0[4], xd1[4]; float sxi;
    {
        float x[32]; peer_load_x(P, lds, o_par, tok, lo, x);
        float ax = 0.f;
#pragma unroll
        for (int i = 0; i < 32; ++i) ax = fmaxf(ax, fabsf(x[i]));
        ax = wave_max_dpp(ax);
        const float sx = ax > 0.f ? 119.0f / ax : 0.f; sxi = ax * (1.0f / 119.0f);
#pragma unroll
        for (int jw = 0; jw < 4; ++jw) { unsigned w0 = 0, w1 = 0;
#pragma unroll
            for (int i = 0; i < 8; ++i) { const unsigned b = __float_as_uint(fmaf(x[8 * jw + i], sx, 12582912.0f));
                w0 = __builtin_amdgcn_alignbit(b, w0, 4); w1 = __builtin_amdgcn_alignbit((b + 8u) >> 4, w1, 4); }
            xd0[jw] = w0; xd1[jw] = w1; }
    }
#pragma unroll
    for (int i = 0; i < 32; ++i) o[i] = 0.f;
    const LAS int* ex = (const LAS int*)(lds + o_ex) + tl * 128; const LAS float* gt = (const LAS float*)(lds + o_gt) + tl * 128;
    const int el = ex[lo], eh = ex[64 + lo];
    const float sul = tsc[el] * sxi, suh = tsc[eh] * sxi;
    const float gvl = gt[lo] * tsc[16384 + el], gvh = gt[64 + lo] * tsc[16384 + eh];
    LAS unsigned* lE = (LAS unsigned*)(lds + o_list) + wave * 384; LAS float* lS = (LAS float*)(lE + 128); LAS float* lG = (LAS float*)(lE + 256);
    {
        const int sl = el >> 10, sh = eh >> 10; int base = 0, pl = 0, ph = 0;
#define LT_COUNT(m) ((int)__builtin_amdgcn_mbcnt_hi((unsigned)((m) >> 32), __builtin_amdgcn_mbcnt_lo((unsigned)(m), 0u)))
#pragma unroll
        for (int s = 0; s < 16; ++s) {
            const unsigned long long ml = __ballot(sl == s), mh = __ballot(sh == s);
            const int cl = __popcll(ml);
            pl = (sl == s) ? base + LT_COUNT(ml) : pl; ph = (sh == s) ? base + cl + LT_COUNT(mh) : ph;
            base += cl + __popcll(mh);
        }
#undef LT_COUNT
        lE[pl] = (unsigned)el; lS[pl] = sul; lG[pl] = gvl; lE[ph] = (unsigned)eh; lS[ph] = suh; lG[ph] = gvh;
        asm volatile("s_waitcnt lgkmcnt(0)" ::: "memory");
    }
    u32x4 ua[4], ub[4]; u32x4 va[4], vb[4];
    auto issue = [&](int gi, u32x4 (&uu)[4], u32x4 (&vv)[4]) {
        const u32x4 e4 = *(const LAS u32x4*)(lE + 4 * gi);
        const unsigned ee[4] = {(unsigned)__builtin_amdgcn_readfirstlane((int)e4.x), (unsigned)__builtin_amdgcn_readfirstlane((int)e4.y), (unsigned)__builtin_amdgcn_readfirstlane((int)e4.z), (unsigned)__builtin_amdgcn_readfirstlane((int)e4.w)};
#pragma unroll
        for (int j = 0; j < 4; ++j) { uu[j] = *(const u32x4*)(Vb + (size_t)ee[j] * EROW + lo * 16); vv[j] = *(const u32x4*)(Vb + (size_t)ee[j] * EROW + 1024 + lo * 16); }
    };
    auto consume = [&](int gi, const u32x4 (&uu)[4], const u32x4 (&vv)[4]) {
        float dd[4];
#pragma unroll
        for (int j = 0; j < 4; ++j) dd[j] = peer_dot(uu[j], xd0, xd1);
        const bool b0 = (lo & 1) != 0, b1 = (lo & 2) != 0;
        const float r01 = (b0 ? dd[1] : dd[0]) + DPPF(b0 ? dd[0] : dd[1], 0xB1), r23 = (b0 ? dd[3] : dd[2]) + DPPF(b0 ? dd[2] : dd[3], 0xB1);
        float r = (b1 ? r23 : r01) + DPPF(b1 ? r01 : r23, 0x4E);
        r += DPPF(r, 0x124); r += DPPF(r, 0x128);
        { auto sw = __builtin_amdgcn_permlane16_swap(__float_as_uint(r), __float_as_uint(r), false, false); r = __uint_as_float(sw[0]) + __uint_as_float(sw[1]); }
        { auto sw = __builtin_amdgcn_permlane32_swap(__float_as_uint(r), __float_as_uint(r), false, false); r = __uint_as_float(sw[0]) + __uint_as_float(sw[1]); }
        const float su = lS[4 * gi + (lo & 3)], gv = lG[4 * gi + (lo & 3)];
        const float hh = r * su;
        const float a = pg8::gelu_pk((pg8::f32x2){hh, hh}).x * gv;
        peer_axpy(vv[0], DPPF(a, 0x00), o); peer_axpy(vv[1], DPPF(a, 0x55), o); peer_axpy(vv[2], DPPF(a, 0xAA), o); peer_axpy(vv[3], DPPF(a, 0xFF), o);
    };
    issue(0, ua, va);
#pragma unroll 1
    for (int gi = 0; gi < 30; gi += 2) {
        issue(gi + 1, ub, vb);
        consume(gi, ua, va);
        issue(gi + 2, ua, va);
        consume(gi + 1, ub, vb);
        if ((gi & 6) == 6) BLOCK_SYNC();
    }
    issue(31, ub, vb);
    consume(30, ua, va);
    consume(31, ub, vb);
    BLOCK_SYNC();
    peer_finish(P, lds, o_par, tok, lo, o);
}
#define CE_DESC(a, b) do { const float h_ = fmaxf((a), (b)), l_ = fminf((a), (b)); (a) = h_; (b) = l_; } while (0)
template <int N> __device__ __forceinline__ void bitonic_sort_desc(float (&v)[N]) {
#pragma unroll
    for (int k = 2; k <= N; k <<= 1)
#pragma unroll
        for (int j = k >> 1; j > 0; j >>= 1)
#pragma unroll
            for (int i = 0; i < N; ++i) { const int l = i ^ j; if (l > i) { if ((i & k) == 0) CE_DESC(v[i], v[l]); else CE_DESC(v[l], v[i]); } }
}
template <int N> __device__ __forceinline__ void bitonic_merge_desc(float (&v)[N]) {
#pragma unroll
    for (int j = N >> 1; j > 0; j >>= 1)
#pragma unroll
        for (int i = 0; i < N; ++i) { const int l = i ^ j; if (l > i) CE_DESC(v[i], v[l]); }
}
__device__ __forceinline__ void top16_merge(float (&a)[16], const float (&brev)[16]) {
#pragma unroll
    for (int i = 0; i < 16; ++i) a[i] = fmaxf(a[i], brev[i]);
    bitonic_merge_desc<16>(a);
}
__device__ __forceinline__ float embed_bits(float v, unsigned code, unsigned mask) { return __uint_as_float((__float_as_uint(v) & ~mask) | code); }

__device__ __forceinline__ void phase7(const Params& P, ldsp lds) {
    const int tid0 = threadIdx.x;
    unsigned char* ws = P.ws;
    const bf16_t* qb = (const bf16_t*)(ws + WS_Q); const bf16_t* sk = (const bf16_t*)(ws + WS_SUBK);
    constexpr int LDSK = 136, O_SK = 0, O_SV = 2 * 128 * LDSK * 2, O_EX = O_SV + 32768, O_GT = O_EX + 16384, O_LIST = O_GT + 16384;
    static_assert(O_LIST + 8 * 384 * 4 <= LDS_BYTES - 16, "lds");
    int titer = 0;
    for (int tile = blockIdx.x; tile < 256; tile += gridDim.x, ++titer) {
        int tid = tid0; asm volatile("" : "+v"(tid));
        const int lane = tid & 63, wave = tid >> 6, fr = lane & 15, fq = lane >> 4, fro = fr, fqo = fq;
        const int tok0 = tile * 32, h = wave;
        bf16x8 qn[4];
        auto ldq = [&](int cb) { const bf16_t* qrow = qb + (size_t)(tok0 + 16 * (cb >> 1) + fro) * D + h * 256 + (cb & 1) * 128 + fqo * 8;
#pragma unroll
            for (int ks = 0; ks < 4; ++ks) qn[ks] = *(const bf16x8*)(qrow + ks * 32); };
        ldq(0);
        for (int idx = tid; idx < 2 * 128 * 16; idx += 512) { const int row = idx >> 4, ch = idx & 15;
            *(LAS u32x4*)(lds + O_SK + (row * LDSK + ch * 8) * 2) = *(const u32x4*)(sk + row * 128 + ch * 8); }
        BLOCK_SYNC();
#pragma unroll 1
        for (int cb = 0; cb < 4; ++cb) {
            const int nt = cb >> 1, p = cb & 1;
            f32x4 acc[8];
#pragma unroll
            for (int mt = 0; mt < 8; ++mt) acc[mt] = (f32x4){0.f, 0.f, 0.f, 0.f};
            bf16x8 qc[4];
#pragma unroll
            for (int ks = 0; ks < 4; ++ks) qc[ks] = qn[ks];
            if (cb + 1 < 4) ldq(cb + 1);
#pragma unroll
            for (int ks = 0; ks < 4; ++ks) {
                const bf16x8 bq = qc[ks];
#pragma unroll
                for (int mt = 0; mt < 8; ++mt) acc[mt] = mfma16(*(const LAS bf16x8*)(lds + O_SK + ((p * 128 + 16 * mt + fro) * LDSK + ks * 32 + fqo * 8) * 2), bq, acc[mt]);
            }
            float a[16], b[16];
#pragma unroll
            for (int mt = 0; mt < 4; ++mt) {
                a[4 * mt + 0] = embed_bits(acc[mt].x, 16 * mt + 4 * fq + 0, 127u); a[4 * mt + 1] = embed_bits(acc[mt].y, 16 * mt + 4 * fq + 1, 127u);
                a[4 * mt + 2] = embed_bits(acc[mt].z, 16 * mt + 4 * fq + 2, 127u); a[4 * mt + 3] = embed_bits(acc[mt].w, 16 * mt + 4 * fq + 3, 127u);
                b[4 * mt + 0] = embed_bits(acc[mt + 4].x, 16 * (mt + 4) + 4 * fq + 0, 127u); b[4 * mt + 1] = embed_bits(acc[mt + 4].y, 16 * (mt + 4) + 4 * fq + 1, 127u);
                b[4 * mt + 2] = embed_bits(acc[mt + 4].z, 16 * (mt + 4) + 4 * fq + 2, 127u); b[4 * mt + 3] = embed_bits(acc[mt + 4].w, 16 * (mt + 4) + 4 * fq + 3, 127u);
            }
            bitonic_sort_desc<16>(a); bitonic_sort_desc<16>(b);
            { float br[16];
#pragma unroll
              for (int i = 0; i < 16; ++i) br[i] = b[15 - i];
              top16_merge(a, br); }
#pragma unroll
            for (int x = 16; x <= 32; x <<= 1) { float br[16];
#pragma unroll
                for (int i = 0; i < 16; ++i) br[i] = __shfl_xor(a[15 - i], x);
                top16_merge(a, br); }
            if (fq == 0) { LAS f32x4* o = (LAS f32x4*)(lds + O_SV + ((((16 * nt + fr) * 8 + h) * 2 + p) * 16) * 4);
                o[0] = (f32x4){a[0], a[1], a[2], a[3]}; o[1] = (f32x4){a[4], a[5], a[6], a[7]}; o[2] = (f32x4){a[8], a[9], a[10], a[11]}; o[3] = (f32x4){a[12], a[13], a[14], a[15]}; }
        }
        BLOCK_SYNC();
        if (tid < 256) {
            const int tok = tid >> 3, hh = tid & 7;
            const LAS f32x4* s = (const LAS f32x4*)(lds + O_SV + (((tok * 8 + hh) * 2) * 16) * 4);
            float s0[16], s1[16];
#pragma unroll
            for (int c4 = 0; c4 < 4; ++c4) { const f32x4 x = s[c4], y = s[4 + c4]; s0[4 * c4] = x.x; s0[4 * c4 + 1] = x.y; s0[4 * c4 + 2] = x.z; s0[4 * c4 + 3] = x.w; s1[4 * c4] = y.x; s1[4 * c4 + 1] = y.y; s1[4 * c4 + 2] = y.z; s1[4 * c4 + 3] = y.w; }
            float g0[16], g1[16], g2[16], g3[16];
            const float NEG = -3.0e38f;
#pragma unroll
            for (int bq = 0; bq < 16; ++bq) g0[bq] = embed_bits(s0[0] + s1[bq], bq, 255u);
            {
                int n1 = 0, n2 = 0, n3 = 0;
#pragma unroll
                for (int aa = 1; aa < 16; ++aa)
#pragma unroll
                    for (int bb = 0; bb < 16; ++bb) if ((aa + 1) * (bb + 1) <= 16) {
                        const float c = embed_bits(s0[aa] + s1[bb], aa * 16 + bb, 255u);
                        if (n1 < 16) g1[n1++] = c; else if (n2 < 16) g2[n2++] = c; else g3[n3++] = c;
                    }
#pragma unroll
                for (int i = 0; i < 16; ++i) if (i >= n3) g3[i] = NEG;
            }
            bitonic_sort_desc<16>(g1); bitonic_sort_desc<16>(g2); bitonic_sort_desc<16>(g3);
            { float r1[16], r3[16];
#pragma unroll
              for (int i = 0; i < 16; ++i) { r1[i] = g1[15 - i]; r3[i] = g3[15 - i]; }
              top16_merge(g0, r1); top16_merge(g2, r3);
#pragma unroll
              for (int i = 0; i < 16; ++i) g0[i] = fmaxf(g0[i], g2[15 - i]); }
            float mx = g0[0];
#pragma unroll
            for (int i = 1; i < 16; ++i) mx = fmaxf(mx, g0[i]);
            float ex[16], sm = 0.f; int ee[16];
#pragma unroll
            for (int i = 0; i < 16; ++i) {
                ex[i] = __expf(g0[i] - mx); sm += ex[i];
                const unsigned code = __float_as_uint(g0[i]) & 255u;
                const unsigned i0 = __float_as_uint(*(const LAS float*)(lds + O_SV + ((((tok * 8 + hh) * 2 + 0) * 16) + (code >> 4)) * 4)) & 127u;
                const unsigned i1 = __float_as_uint(*(const LAS float*)(lds + O_SV + ((((tok * 8 + hh) * 2 + 1) * 16) + (code & 15u)) * 4)) & 127u;
                ee[i] = (int)(i0 * 128u + i1);
            }
            const float inv = 1.0f / sm;
            LAS int* eo = (LAS int*)(lds + O_EX) + tok * 128 + hh * 16; LAS float* go = (LAS float*)(lds + O_GT) + tok * 128 + hh * 16;
#pragma unroll
            for (int c4 = 0; c4 < 4; ++c4) {
                *(LAS u32x4*)(eo + 4 * c4) = (u32x4){(unsigned)ee[4 * c4], (unsigned)ee[4 * c4 + 1], (unsigned)ee[4 * c4 + 2], (unsigned)ee[4 * c4 + 3]};
                *(LAS f32x4*)(go + 4 * c4) = (f32x4){ex[4 * c4] * inv, ex[4 * c4 + 1] * inv, ex[4 * c4 + 2] * inv, ex[4 * c4 + 3] * inv};
            }
        }
        BLOCK_SYNC();
        for (int idx = tid; idx < 2048; idx += 512) { const int a = idx >> 9, q4 = idx & 511; const float* src = P.in[a == 0 ? I_LN1G : a == 1 ? I_LN1B : a == 2 ? I_LN2G : I_LN2B];
            *(LAS f32x4*)(lds + O_SK + a * 8192 + q4 * 16) = *(const f32x4*)(src + q4 * 4); }
        BLOCK_SYNC();
#pragma unroll 1
        for (int r = 0; r < 4; ++r) {
            peer_round(P, lds, O_EX, O_GT, O_LIST, O_SK, tok0 + r * 8 + wave, r * 8 + wave);
        }
        BLOCK_SYNC();
    }
}
__global__ __launch_bounds__(512, 2) void hybrid_fwd(Params P) {
    extern __shared__ __attribute__((aligned(16))) unsigned char shm[];
    ldsp lds = (ldsp)shm;
    unsigned char* ws = P.ws;
    volatile LAS unsigned* xst = (volatile LAS unsigned*)(lds + LDS_BYTES - 16);
    if (threadIdx.x == 0) { xst[0] = 0u; xst[1] = 0u; }
    __syncthreads();
    const XcdBarrier xbar = xcd_barrier_post((unsigned*)(ws + WS_BAR), xst);
    const int lo = P.ph_lo, hi = P.ph_hi;
#ifdef REPEAT_PHASE
#define PHASE(k) if (lo <= (k) && (k) < hi) for (int once_ = 0; once_ < ((k) == REPEAT_PHASE ? 2 : 1); ++once_)
#else
#define PHASE(k) if (lo <= (k) && (k) < hi) for (int once_ = 0; once_ < 1; ++once_)
#endif
#ifdef DOUBLE_SEAMS
#define SEAM(k) do { if (lo <= (k) && (k) + 1 < hi) { xcd_barrier(xbar); xcd_barrier(xbar); } } while (0)
#else
#define SEAM(k) do { if (lo <= (k) && (k) + 1 < hi) xcd_barrier(xbar); } while (0)
#endif
#if defined(REPEAT_PHASE) && REPEAT_PHASE == 0
    PHASE(0) { Params Q = P; if (once_) Q.ph_lo = -1; phase0(Q); }
#else
    PHASE(0) phase0(P);
#endif
    SEAM(0);
    PHASE(1) { pg8::EpiBf16<0> E; E.O = (bf16_t*)(ws + WS_P); E.ldc = NPAD; E.bias = nullptr; E.split_cols = 0; E.split_stride = 0;
        run_gemm(lds, (const bf16_t*)(ws + WS_H0B), (const bf16_t*)(ws + WS_WTIN), MROWS, N_BF, 2048, E);
        const int G = (int)gridDim.x, r1 = ((MROWS / 256) * (N_BF / 256)) % G;
        pg8::EpiBf16S E8; E8.O = (bf16_t*)(ws + WS_P) + N_BF; E8.ldc = NPAD; E8.scale = 1.0f / 64.0f;
        run_gemm8(lds, ws + WS_H0B8, ws + WS_WT8, MROWS, N_F8, 2048, E8, (int)((blockIdx.x + G - r1) % G)); }
    SEAM(1);
    PHASE(2) phase2(P, lds);
    SEAM(2);
    PHASE(3) phase3(P);
    SEAM(3);
    PHASE(4) phase3b(P, lds);
    SEAM(4);
    PHASE(5) {
#ifdef P5_F8
        { pg8::EpiGate35T<16> E; E.O = (bf16_t*)(ws + WS_MERGED); E.p = (const bf16_t*)(ws + WS_P); E.bgate = P.in[I_BGATE]; E.oscale = 1.0f / 64.0f;
          run_gemm8(lds, ws + WS_YAB, ws + WS_WTAB8, NTOK, 2048, LDAB, E, (int)blockIdx.x); }
#else
        { pg8::EpiGate35 E; E.O = (bf16_t*)(ws + WS_MERGED); E.p = (const bf16_t*)(ws + WS_P); E.bgate = P.in[I_BGATE]; E.oscale = 1.0f;
          run_gemm(lds, (const bf16_t*)(ws + WS_YAB), (const bf16_t*)(ws + WS_WTAB), NTOK, 2048, LDAB, E); }
#endif
    }
#if defined(DUP_PHASE) && DUP_PHASE == 5
    SEAM(4);
    PHASE(5) {
#ifdef P5_F8
        { pg8::EpiGate35T<16> E; E.O = (bf16_t*)(ws + WS_MERGED); E.p = (const bf16_t*)(ws + WS_P); E.bgate = P.in[I_BGATE]; E.oscale = 1.0f / 64.0f;
          run_gemm8(lds, ws + WS_YAB, ws + WS_WTAB8, NTOK, 2048, LDAB, E, (int)blockIdx.x); }
#else
        { pg8::EpiGate35 E; E.O = (bf16_t*)(ws + WS_MERGED); E.p = (const bf16_t*)(ws + WS_P); E.bgate = P.in[I_BGATE]; E.oscale = 1.0f;
          run_gemm(lds, (const bf16_t*)(ws + WS_YAB), (const bf16_t*)(ws + WS_WTAB), NTOK, 2048, LDAB, E); }
#endif
    }
#endif
    SEAM(5);
    PHASE(6) { pg8::EpiResidStats E; E.O = (bf16_t*)(ws + WS_X1B); E.h0 = (const bf16_t*)(ws + WS_H0B); E.alpha = DN_ALPHA; E.rsum = (float*)(ws + WS_STAT); E.rsq = (float*)(ws + WS_STAT) + 8192;
#ifdef P6_F8
        E.ascale = 1.0f / 64.0f; run_gemm8(lds, ws + WS_MERGED, ws + WS_WTOUT8, NTOK, 2048, 2048, E, (int)blockIdx.x); }
#else
        E.ascale = 1.0f; run_gemm(lds, (const bf16_t*)(ws + WS_MERGED), (const bf16_t*)(ws + WS_WTOUT), NTOK, 2048, 2048, E); }
#endif
#if defined(DUP_PHASE) && DUP_PHASE == 6
    SEAM(5);
    PHASE(6) { pg8::EpiResidStats E; E.O = (bf16_t*)(ws + WS_X1B); E.h0 = (const bf16_t*)(ws + WS_H0B); E.alpha = DN_ALPHA; E.rsum = (float*)(ws + WS_END); E.rsq = (float*)(ws + WS_END) + 8192;
        run_gemm(lds, (const bf16_t*)(ws + WS_MERGED), (const bf16_t*)(ws + WS_WTOUT), NTOK, 2048, 2048, E); }
#endif
    SEAM(6);
    PHASE(7) { pg8::EpiQ E; E.O = (bf16_t*)(ws + WS_Q); E.rsum = (const float*)(ws + WS_STAT); E.rsq = (const float*)(ws + WS_STAT) + 8192; E.c1 = (const float*)(ws + WS_STAT) + 16384; E.c2 = (const float*)(ws + WS_STAT) + 18432;
        run_gemm(lds, (const bf16_t*)(ws + WS_X1B), (const bf16_t*)(ws + WS_WTQ), NTOK, 2048, 2048, E); }
#if defined(DUP_PHASE) && DUP_PHASE == 7
    SEAM(6);
    PHASE(7) { pg8::EpiQ E; E.O = (bf16_t*)(ws + WS_Q); E.rsum = (const float*)(ws + WS_STAT); E.rsq = (const float*)(ws + WS_STAT) + 8192; E.c1 = (const float*)(ws + WS_STAT) + 16384; E.c2 = (const float*)(ws + WS_STAT) + 18432;
        run_gemm(lds, (const bf16_t*)(ws + WS_X1B), (const bf16_t*)(ws + WS_WTQ), NTOK, 2048, 2048, E); }
#endif
    SEAM(7);
    PHASE(8) phase7(P, lds);
#undef PHASE
#undef SEAM
}

extern "C" void kernel_launch(void* const* d_in, const int* in_sizes, int n_in, void* d_out, int out_size, void* d_ws, size_t ws_size, hipStream_t stream) {
    static int grid = 0;
    if (grid == 0) {
        if (n_in != 30 || out_size != NTOK * D || ws_size < WS_END) { fprintf(stderr, "kernel_launch: unexpected shapes (n_in %d, out %d, ws %zu < %zu)\n", n_in, out_size, ws_size, (size_t)WS_END); grid = -1; return; }
        int dev = 0, cus = 0, per_cu = 0;
        if (hipGetDevice(&dev) != hipSuccess || hipDeviceGetAttribute(&cus, hipDeviceAttributeMultiprocessorCount, dev) != hipSuccess) { grid = -1; return; }
        if (hipFuncSetAttribute((const void*)hybrid_fwd, hipFuncAttributeMaxDynamicSharedMemorySize, LDS_BYTES) != hipSuccess) { fprintf(stderr, "kernel_launch: hipFuncSetAttribute failed\n"); grid = -1; return; }
        if (hipOccupancyMaxActiveBlocksPerMultiprocessor(&per_cu, (const void*)hybrid_fwd, 512, LDS_BYTES) != hipSuccess || per_cu < 1) { fprintf(stderr, "kernel_launch: occupancy query says %d\n", per_cu); grid = -1; return; }
        (void)hipGetLastError();
        grid = cus;
    }
    if (grid < 0) return;
    if (hipMemsetAsync((unsigned char*)d_ws + WS_BAR, 0, 16384 + STAT_BYTES, stream) != hipSuccess) { fprintf(stderr, "kernel_launch: memset failed\n"); return; }
    Params p{};
    for (int i = 0; i < 30; ++i) p.in[i] = (const float*)d_in[i];
    p.out = (float*)d_out; p.ws = (unsigned char*)d_ws;
    p.ph_lo = 0; p.ph_hi = NPHASE + 1;
    void* args[] = {&p};
    hipError_t e = hipLaunchCooperativeKernel((const void*)hybrid_fwd, dim3(grid), dim3(512), args, LDS_BYTES, stream);
    if (e != hipSuccess) fprintf(stderr, "kernel_launch: cooperative launch failed: %s (grid %d)\n", hipGetErrorString(e), grid);
}
```

```cpp
#include <hip/hip_runtime.h>
#include <cstdio>
#include <cstdint>
namespace pg8 {
#define PG8_LAS __attribute__((address_space(3)))
typedef unsigned short bf16_t;
typedef short bf16x8 __attribute__((ext_vector_type(8)));
typedef float f32x4 __attribute__((ext_vector_type(4)));
typedef unsigned u32x4 __attribute__((ext_vector_type(4)));
typedef int i32x4f __attribute__((ext_vector_type(4)));
constexpr int BM = 256, BK = 64, HALF = 128, HTB = HALF * BK * 2  , STAGE_BYTES = 8 * HTB, NXCD = 8, WGM = 8;

__host__ __device__ __forceinline__ int lds_byte(int r, int c) { const int st = (r >> 4) * 2 + (c >> 5), rr = r & 15, cc = c & 31, ob = rr * 64 + cc * 2; return st * 1024 + (ob ^ (((ob >> 9) & 1) << 5)); }
__host__ __device__ __forceinline__ void stage_rc(int b, int& R, int& C) { const int st = b / 1024, sb = b % 1024, swz = sb ^ (((sb >> 9) & 1) << 5); R = (st >> 1) * 16 + swz / 64; C = (st & 1) * 32 + (swz % 64) / 2; }
__host__ __device__ __forceinline__ int perm32(int rho) { const int n = rho >> 4, i = rho & 15; return 8 * (i >> 2) + 4 * n + (i & 3); }

struct Unit { int pm, pn; };
struct Gemm { const bf16_t* A; const bf16_t* Bt; int M, N, K; };

struct StaticOrder {
    int nM, nN, nwg, G, c;
    __host__ __device__ void init(int M, int N, int G_, int c_) { nM = M / BM; nN = N / BM; nwg = nM * nN; G = G_; c = c_; }
    __host__ __device__ bool next(int i, Unit& u) const {
        const long L = (long)i * G + c; if (L >= nwg) return false;
        int wgid = (int)L; { const int q = nwg / NXCD, r = nwg % NXCD, xcd = wgid % NXCD, off = wgid / NXCD; wgid = (xcd < r ? xcd * (q + 1) : r * (q + 1) + (xcd - r) * q) + off; }
        const int nig = WGM * nN, gid = wgid / nig, fm = gid * WGM, gsz = (nM - fm) < WGM ? (nM - fm) : WGM;
        u.pm = fm + ((wgid % nig) % gsz); u.pn = (wgid % nig) / gsz; return true;
    }
    __device__ __forceinline__ void a_ready(const Unit&) const {}
    __device__ __forceinline__ void done(const Unit&) const {}
};
struct CountedOrder : StaticOrder {
    const unsigned* ready; unsigned need; unsigned* tmo;
    __device__ __forceinline__ void a_ready(const Unit& u) const {
        if (threadIdx.x < 64) {
            const unsigned long long t0 = __builtin_amdgcn_s_memrealtime(); unsigned polls = 0;
            while ((unsigned)__builtin_amdgcn_readfirstlane(__hip_atomic_load(ready + 64 * u.pm, __ATOMIC_RELAXED, __HIP_MEMORY_SCOPE_AGENT)) < need) {
                if ((++polls & 255u) == 0u && __builtin_amdgcn_readfirstlane(__hip_atomic_load(tmo, __ATOMIC_RELAXED, __HIP_MEMORY_SCOPE_AGENT)) != 0u) break;
                if (__builtin_amdgcn_s_memrealtime() - t0 > 2000000ull) {
                    if (threadIdx.x == 0) { unsigned expect = 0u; __hip_atomic_compare_exchange_strong(tmo + 1, &expect, 0x600u | (unsigned)(u.pm & 0xff), __ATOMIC_RELAXED, __ATOMIC_RELAXED, __HIP_MEMORY_SCOPE_AGENT); __hip_atomic_store(tmo, 1u, __ATOMIC_RELAXED, __HIP_MEMORY_SCOPE_AGENT); }
                    break; }
                __builtin_amdgcn_s_sleep(2); }
            __builtin_amdgcn_fence(__ATOMIC_ACQUIRE, "agent");
            asm volatile("s_waitcnt vmcnt(0)" ::: "memory");
        }
#if !defined(BROKEN_HOOK_NO_BARRIER)
        asm volatile("" ::: "memory"); __builtin_amdgcn_s_barrier(); asm volatile("" ::: "memory");
#endif
    }
};

typedef float cvt_f32x2 __attribute__((ext_vector_type(2))); typedef __bf16 cvt_bf16x2 __attribute__((ext_vector_type(2)));
__device__ __forceinline__ unsigned cvt_pk_bf16(float lo, float hi) { const cvt_f32x2 v = {lo, hi}; const cvt_bf16x2 b = __builtin_convertvector(v, cvt_bf16x2); return __builtin_bit_cast(unsigned, b); }
typedef float f32x2 __attribute__((ext_vector_type(2)));
__device__ __forceinline__ f32x2 gelu_pk(f32x2 v) {
    const f32x2 av = __builtin_elementwise_abs(v), d = av * 0.2316418882f + 1.0f;
    f32x2 t; t.x = __builtin_amdgcn_rcpf(d.x); t.y = __builtin_amdgcn_rcpf(d.y);
    f32x2 q = t * 0.5307027145f + (-0.7265760135f); q = q * t + 0.7107068705f; q = q * t + (-0.142248368f); q = q * t + 0.127414796f; q = q * t;
    const f32x2 s = (v * v) * (-0.72134752044f);
    f32x2 e; e.x = __builtin_amdgcn_exp2f(s.x); e.y = __builtin_amdgcn_exp2f(s.y);
    const f32x2 m = v * (q * e), r = v - m;
    f32x2 o; o.x = v.x < 0.f ? m.x : r.x; o.y = v.y < 0.f ? m.y : r.y; return o;
}

struct EpiF32 {
    static constexpr bool PERM = false, AFTER_DRAIN = false; static constexpr int MID_T = -1;
    float* C; int ldc; const float* bias;
    __device__ __forceinline__ void operator()(const f32x4 (&acc)[2][2][4][2], const Unit& u, int wr, int wc, int fr, int fq) const {
        const int row0 = u.pm * BM + wr * 64 + fr, col0 = u.pn * BM + wc * 32 + 4 * fq;
        f32x4 bv[2][2];
#pragma unroll
        for (int bj = 0; bj < 2; ++bj)
#pragma unroll
            for (int n = 0; n < 2; ++n) bv[bj][n] = bias ? *(const f32x4*)(bias + col0 + bj * HALF + n * 16) : (f32x4){0.f, 0.f, 0.f, 0.f};
#pragma unroll
        for (int ai = 0; ai < 2; ++ai)
#pragma unroll
            for (int m = 0; m < 4; ++m) { float* rowp = C + (size_t)(row0 + ai * HALF + m * 16) * ldc + col0;
#pragma unroll
                for (int bj = 0; bj < 2; ++bj)
#pragma unroll
                    for (int n = 0; n < 2; ++n) *(f32x4*)(rowp + bj * HALF + n * 16) = acc[ai][bj][m][n] + bv[bj][n]; }
    }
};
template <int ACT  > struct EpiBf16 {
    static constexpr bool PERM = true, AFTER_DRAIN = false; static constexpr int MID_T = -1;
    bf16_t* O; int ldc; const float* bias; int split_cols; size_t split_stride;
    __device__ __forceinline__ void operator()(const f32x4 (&acc)[2][2][4][2], const Unit& u, int wr, int wc, int fr, int fq) const {
        const int row0 = u.pm * BM + wr * 64 + fr; int colt = u.pn * BM; bf16_t* base = O;
        if (split_cols) { const int t = colt / split_cols; base += (size_t)t * split_stride; colt -= t * split_cols; }
        const int col0 = colt + wc * 32 + 8 * fq, bcol0 = u.pn * BM + wc * 32 + 8 * fq;
        f32x4 bv[2][2];
#pragma unroll
        for (int bj = 0; bj < 2; ++bj)
#pragma unroll
            for (int n = 0; n < 2; ++n) bv[bj][n] = bias ? *(const f32x4*)(bias + bcol0 + bj * HALF + 4 * n) : (f32x4){0.f, 0.f, 0.f, 0.f};
#pragma unroll
        for (int ai = 0; ai < 2; ++ai)
#pragma unroll
            for (int m = 0; m < 4; ++m) { bf16_t* rowp = base + (size_t)(row0 + ai * HALF + m * 16) * ldc + col0;
#pragma unroll
                for (int bj = 0; bj < 2; ++bj) { f32x4 v0 = acc[ai][bj][m][0] + bv[bj][0], v1 = acc[ai][bj][m][1] + bv[bj][1];
                    if (ACT == 1) { f32x2 a = gelu_pk((f32x2){v0[0], v0[1]}), b = gelu_pk((f32x2){v0[2], v0[3]}), c = gelu_pk((f32x2){v1[0], v1[1]}), d = gelu_pk((f32x2){v1[2], v1[3]});
                        v0 = (f32x4){a.x, a.y, b.x, b.y}; v1 = (f32x4){c.x, c.y, d.x, d.y}; }
                    if (ACT == 2) {
#pragma unroll
                        for (int j = 0; j < 4; ++j) { v0[j] = 0.5f * v0[j] * (1.0f + erff(v0[j] * 0.70710678f)); v1[j] = 0.5f * v1[j] * (1.0f + erff(v1[j] * 0.70710678f)); } }
                    u32x4 w; w.x = cvt_pk_bf16(v0[0], v0[1]); w.y = cvt_pk_bf16(v0[2], v0[3]); w.z = cvt_pk_bf16(v1[0], v1[1]); w.w = cvt_pk_bf16(v1[2], v1[3]);
                    *(u32x4*)(rowp + bj * HALF) = w; } }
    }
};
template <class Epi, class Sched, bool STAMP = false, bool F8 = false>
__device__ __forceinline__ void gemm_phase(PG8_LAS unsigned char* lds, const Gemm g, const Sched& S, const Epi& E, unsigned long long* stamps) {
    const int tid = threadIdx.x, wid = __builtin_amdgcn_readfirstlane(tid >> 6), lane = tid & 63, wr = wid >> 2, wc = wid & 3, fr = lane & 15, fq = lane >> 4;
    const int K = g.K, nt = K / BK;
    int ts_lo = 0, ts_hi = 0, nts = 0; const unsigned long long rt_entry = STAMP ? (unsigned long long)wall_clock64() : 0ull;
#define PG8_STAMP() do { if (STAMP && wid == 0 && nts < 64) { const unsigned long long _c = (unsigned long long)clock64(); \
        ts_lo = (lane == nts) ? (int)(unsigned)_c : ts_lo; ts_hi = (lane == nts) ? (int)(unsigned)(_c >> 32) : ts_hi; ++nts; } } while (0)
    PG8_STAMP();
    unsigned voffA[2], voffB[2];
#pragma unroll
    for (int i = 0; i < 2; ++i) { int R, C; stage_rc(tid * 16 + i * 8192, R, C); const int Rb = Epi::PERM ? ((R & ~31) + perm32(R & 31)) : R;
        voffA[i] = (unsigned)(R * K + C) * 2u; voffB[i] = (unsigned)(Rb * K + C) * 2u; }
    const size_t kstep = (size_t)(BK * 2);
    const size_t hstep = (size_t)HALF * K * 2;
    const size_t tstep = 2 * hstep;
    const unsigned ldsw = (unsigned)wid * 1024u;
    const int aoff = lds_byte(wr * 64 + fr, fq * 8), boff = lds_byte(wc * 32 + fr, fq * 8);
#define PG8_SA(b, h) (((b) * 2 + (h)) * HTB)
#define PG8_SB(b, h) ((4 + (b) * 2 + (h)) * HTB)
#define PG8_STAGE(bufoff, gbase, voff) do { _Pragma("unroll") for (int _i = 0; _i < 2; ++_i) \
        __builtin_amdgcn_global_load_lds((const unsigned*)((const char*)(gbase) + (voff)[_i]), (PG8_LAS unsigned*)(lds + (bufoff) + ldsw + _i * 8192), 16, 0, 0); } while (0)
#define PG8_LDA(dst, b, h) do { if constexpr (F8) { _Pragma("unroll") for (int m = 0; m < 4; ++m) { dst##8[m].lo = *(const PG8_LAS bf16x8*)(lds + PG8_SA(b, h) + aoff + m * 2048); dst##8[m].hi = *(const PG8_LAS bf16x8*)(lds + PG8_SA(b, h) + aoff + m * 2048 + 1024); } } \
    else { _Pragma("unroll") for (int m = 0; m < 4; ++m) _Pragma("unroll") for (int k = 0; k < 2; ++k) dst[m][k] = *(const PG8_LAS bf16x8*)(lds + PG8_SA(b, h) + aoff + m * 2048 + k * 1024); } } while (0)
#define PG8_LDB(dst, b, h) do { if constexpr (F8) { _Pragma("unroll") for (int n = 0; n < 2; ++n) { dst##8[n].lo = *(const PG8_LAS bf16x8*)(lds + PG8_SB(b, h) + boff + n * 2048); dst##8[n].hi = *(const PG8_LAS bf16x8*)(lds + PG8_SB(b, h) + boff + n * 2048 + 1024); } } \
    else { _Pragma("unroll") for (int n = 0; n < 2; ++n) _Pragma("unroll") for (int k = 0; k < 2; ++k) dst[n][k] = *(const PG8_LAS bf16x8*)(lds + PG8_SB(b, h) + boff + n * 2048 + k * 1024); } } while (0)
typedef int i32x8f __attribute__((ext_vector_type(8)));
#define PG8_MMA(ai, bj, At, Bt) do { __builtin_amdgcn_s_setprio(1); \
        if constexpr (F8) { _Pragma("unroll") for (int m = 0; m < 4; ++m) _Pragma("unroll") for (int n = 0; n < 2; ++n) \
            asm volatile("v_mfma_f32_16x16x128_f8f6f4 %0, %1, %2, %0" : "+v"(acc[ai][bj][m][n]) : "v"(Bt##8[n]), "v"(At##8[m])); } \
        else { _Pragma("unroll") for (int m = 0; m < 4; ++m) _Pragma("unroll") for (int n = 0; n < 2; ++n) _Pragma("unroll") for (int k = 0; k < 2; ++k) \
            acc[ai][bj][m][n] = __builtin_amdgcn_mfma_f32_16x16x32_bf16(Bt[n][k], At[m][k], acc[ai][bj][m][n], 0, 0, 0); } \
        __builtin_amdgcn_s_setprio(0); } while (0)
#define PG8_WAIT_V(n) asm volatile("s_waitcnt vmcnt(" #n ")" ::: "memory")
#define PG8_WAIT_L(n) asm volatile("s_waitcnt lgkmcnt(" #n ")" ::: "memory")
#define PG8_BAR __builtin_amdgcn_s_barrier()
#define PG8_SCHED __builtin_amdgcn_sched_barrier(0)
    Unit cur, nxt; int ui = 0;
    if (!S.next(0, cur)) return;
    f32x4 acc[2][2][4][2];
#pragma unroll
    for (int a = 0; a < 2; ++a)
#pragma unroll
        for (int b = 0; b < 2; ++b)
#pragma unroll
            for (int m = 0; m < 4; ++m)
#pragma unroll
                for (int n = 0; n < 2; ++n) acc[a][b][m][n] = (f32x4){0.f, 0.f, 0.f, 0.f};
    bf16x8 At[4][2], B0[2][2], B1[2][2];
    typedef short bf16x16f __attribute__((ext_vector_type(16)));
    bf16x16f At8[4], B08[2], B18[2];
    const char* cA = (const char*)g.A + (size_t)cur.pm * tstep; const char* cB = (const char*)g.Bt + (size_t)cur.pn * tstep;
    S.a_ready(cur);
    PG8_STAGE(PG8_SB(0, 0), cB, voffB); PG8_STAGE(PG8_SA(0, 0), cA, voffA); PG8_STAGE(PG8_SB(0, 1), cB + hstep, voffB); PG8_STAGE(PG8_SA(0, 1), cA + hstep, voffA);
    if (wr == 1) PG8_BAR;
    PG8_WAIT_V(4); PG8_BAR;
    PG8_STAGE(PG8_SB(1, 0), cB + kstep, voffB); PG8_STAGE(PG8_SA(1, 0), cA + kstep, voffA); PG8_STAGE(PG8_SB(1, 1), cB + hstep + kstep, voffB);
    PG8_WAIT_V(6); PG8_BAR;
    PG8_STAMP();
    for (;;) {
        const bool has_next = S.next(ui + 1, nxt);
        const char* nA = has_next ? (const char*)g.A + (size_t)nxt.pm * tstep : cA; const char* nB = has_next ? (const char*)g.Bt + (size_t)nxt.pn * tstep : cB;
        for (int t = 0; t < nt; t += 2) {
            const bool last = (t == nt - 2);
            const char* a1 = cA + (size_t)(t + 1) * kstep;
            const char* a2 = last ? nA : cA + (size_t)(t + 2) * kstep; const char* b2 = last ? nB : cB + (size_t)(t + 2) * kstep;
            const char* a3 = a2 + kstep; const char* b3 = b2 + kstep;
            if (last && has_next) S.a_ready(nxt);
            if constexpr (Epi::MID_T >= 0) { if (t == Epi::MID_T) { if constexpr (F8) asm volatile("s_nop 15\n\ts_nop 15" ::: "memory"); E.mid(acc, cur, wr, wc, fr, fq); } }
            PG8_LDB(B0, 0, 0); PG8_SCHED; PG8_LDA(At, 0, 0); PG8_STAGE(PG8_SA(1, 1), a1 + hstep, voffA);
            PG8_WAIT_L(8); PG8_BAR; PG8_WAIT_L(0); PG8_MMA(0, 0, At, B0); PG8_BAR; PG8_SCHED;
            PG8_LDB(B1, 0, 1); PG8_STAGE(PG8_SB(0, 0), b2, voffB);
            PG8_BAR; PG8_WAIT_L(0); PG8_MMA(0, 1, At, B1); PG8_BAR;
            PG8_LDA(At, 0, 1); PG8_STAGE(PG8_SA(0, 0), a2, voffA);
            PG8_BAR; PG8_WAIT_L(0); PG8_MMA(1, 0, At, B0); PG8_BAR; PG8_SCHED;
            PG8_STAGE(PG8_SB(0, 1), b2 + hstep, voffB);
            PG8_WAIT_V(6); PG8_BAR; PG8_MMA(1, 1, At, B1); PG8_BAR;
            PG8_LDB(B0, 1, 0); PG8_SCHED; PG8_LDA(At, 1, 0); PG8_STAGE(PG8_SA(0, 1), a2 + hstep, voffA);
            PG8_WAIT_L(8); PG8_BAR; PG8_WAIT_L(0); PG8_MMA(0, 0, At, B0); PG8_BAR; PG8_SCHED;
            PG8_LDB(B1, 1, 1); PG8_STAGE(PG8_SB(1, 0), b3, voffB);
            PG8_BAR; PG8_WAIT_L(0); PG8_MMA(0, 1, At, B1); PG8_BAR;
            PG8_LDA(At, 1, 1); PG8_STAGE(PG8_SA(1, 0), a3, voffA);
            PG8_BAR; PG8_WAIT_L(0); PG8_MMA(1, 0, At, B0); PG8_BAR; PG8_SCHED;
            PG8_STAGE(PG8_SB(1, 1), b3 + hstep, voffB);
            PG8_WAIT_V(6); PG8_BAR; PG8_MMA(1, 1, At, B1); PG8_BAR;
        }
        PG8_STAMP();
        if constexpr (F8) asm volatile("s_nop 15\n\ts_nop 15" ::: "memory");
        if constexpr (!Epi::AFTER_DRAIN) { E(acc, cur, wr, wc, fr, fq); S.done(cur); }
        PG8_STAMP();
        if (!has_next) break;
#pragma unroll
        for (int a = 0; a < 2; ++a)
#pragma unroll
            for (int b = 0; b < 2; ++b)
#pragma unroll
                for (int m = 0; m < 4; ++m)
#pragma unroll
                    for (int n = 0; n < 2; ++n) acc[a][b][m][n] = (f32x4){0.f, 0.f, 0.f, 0.f};
        cur = nxt; cA = nA; cB = nB; ++ui;
    }
    PG8_WAIT_V(0);
    if (wr == 0) PG8_BAR;
    PG8_BAR;
    if constexpr (Epi::AFTER_DRAIN) { E.fused(acc, cur, wr, wc, fr, fq, lds, wid, lane); S.done(cur); }
    PG8_STAMP();
    if (STAMP && wid == 0) { stamps[lane] = lane < nts ? (((unsigned long long)(unsigned)ts_hi << 32) | (unsigned)ts_lo) : 0ull;
        if (lane == 62) stamps[62] = rt_entry; if (lane == 63) stamps[63] = (unsigned long long)wall_clock64(); }
#undef PG8_STAMP
#undef PG8_SA
#undef PG8_SB
#undef PG8_STAGE
#undef PG8_LDA
#undef PG8_LDB
#undef PG8_MMA
#undef PG8_WAIT_V
#undef PG8_WAIT_L
#undef PG8_BAR
#undef PG8_SCHED
}
}
#define LAS __attribute__((address_space(3)))
typedef unsigned short bf16_t;
typedef short bf16x8 __attribute__((ext_vector_type(8)));
typedef float f32x4 __attribute__((ext_vector_type(4)));
typedef float f32x2 __attribute__((ext_vector_type(2)));
typedef unsigned u32x4 __attribute__((ext_vector_type(4)));
typedef unsigned u32x2 __attribute__((ext_vector_type(2)));
typedef LAS unsigned char* ldsp;
typedef float f32x32 __attribute__((ext_vector_type(32)));
typedef float f32x16 __attribute__((ext_vector_type(16)));
typedef unsigned u32x6 __attribute__((ext_vector_type(6)));

constexpr int D = 2048, NTOK = 8192, SEQ = 4096, MROWS = 8448, ROW_META = 8192;
constexpr int INC = 11712, NPAD = 11776;
constexpr int M_R = 0, M_K = 2048, M_V = 4096, M_WL = 6144, M_AL = 6240, M_GL = 6336;
constexpr int C_R = 0, C_K = 2048, C_WL = 4096, C_AL = 4192, C_GL = 4288, C_V = 4608, C_POOL = 6656, C_G0 = 7680, C_G1 = 9728;
constexpr int NUNITS = 4128;
constexpr float DSCALE = 0.6065306597126334f;
constexpr float DN_ALPHA = 1.189207115002721f;
constexpr float GN_EPS = 64e-5f, LN_EPS = 1e-5f;

constexpr size_t WS_P = 0;
constexpr size_t WS_H0B = 198967296;
constexpr size_t WS_WTAB = WS_H0B + 34603008;
constexpr size_t WS_WTOUT = WS_WTAB + 12582912;
constexpr size_t WS_WTQ = WS_WTOUT + 8388608;
constexpr size_t WS_WTPOOL = WS_WTQ + 8388608;
constexpr size_t WS_WTW2 = WS_WTPOOL + 524288;
constexpr size_t WS_WTA2 = WS_WTW2 + 393216;
constexpr size_t WS_WTG2 = WS_WTA2 + 393216;
constexpr size_t WS_SUBK = WS_WTG2 + 1048576;
constexpr size_t WS_BONUS = WS_SUBK + 65536;
constexpr size_t WS_REGC = WS_BONUS + 1048576;
constexpr size_t WS_WTIN = WS_REGC;
constexpr size_t UNITB = (size_t)NUNITS * 4096 * 2;
constexpr size_t WS_G = WS_REGC;
constexpr size_t WS_H0T = WS_REGC + UNITB;
constexpr size_t WS_RT = WS_REGC + 2 * UNITB;
constexpr size_t WS_Y0 = WS_REGC + 3 * UNITB;
constexpr size_t WS_S0T = WS_REGC + 4 * UNITB;
constexpr size_t WS_YAB = WS_REGC;
constexpr int LDAB = 3072;
constexpr size_t WS_MERGED = WS_REGC + 2 * UNITB;
constexpr size_t WS_X1B = WS_REGC + 3 * UNITB;
constexpr size_t WS_Q = WS_REGC + UNITB;
constexpr size_t TROW = 1536;
constexpr size_t EROW = 2048;
constexpr size_t WS_VB = WS_REGC + 5 * UNITB;
constexpr size_t WS_GSIG = WS_VB + 16384 * EROW;
constexpr size_t WS_BAR = WS_GSIG + 4194304;
constexpr size_t WS_STAT = WS_BAR + 16384;
constexpr size_t STAT_BYTES = (8192 * 2 + 2048 * 2) * 4 + 4096;
constexpr size_t WS_TSC = WS_STAT + STAT_BYTES;
constexpr size_t UROW = 1024;
constexpr size_t WS_UB = WS_TSC + 131072;
constexpr int N_BF = 4608, N_F8 = NPAD - N_BF;
constexpr size_t WS_H0B8 = WS_UB;
constexpr size_t WS_WT8 = WS_H0B8 + (size_t)MROWS * 2048;
constexpr size_t WS_WTAB8 = WS_WT8 + (size_t)N_F8 * 2048;
constexpr size_t WS_WTOUT8 = WS_WTAB8 + (size_t)2048 * 3072;
constexpr size_t WS_WTQ8 = WS_WTOUT8 + (size_t)2048 * 2048;
constexpr size_t WS_X1B8 = WS_YAB;
constexpr size_t WS_END = WS_WTQ8 + (size_t)2048 * 2048;
#define P6_F8 1
#define P5_F8 1
static_assert(WS_YAB + 50331648 <= WS_MERGED, "overlay");

constexpr int LDS_BYTES = 163840;
constexpr int NPHASE = 8;

struct Params {
    const float* in[30];
    float* out;
    unsigned char* ws;
    int ph_lo, ph_hi;
};
enum { I_X = 0, I_META, I_LNIN_G, I_LNIN_B, I_WIN, I_MU, I_W0, I_WW2, I_A0, I_WA2, I_WG2, I_KK, I_KA, I_RK, I_GNG, I_GNB, I_WPOOL, I_PSCALE, I_BGATE,
       I_WBA, I_WBB, I_WOUT, I_LN1G, I_LN1B, I_WQ, I_SUBK, I_UT, I_VT, I_LN2G, I_LN2B };

__device__ __forceinline__ unsigned pk2(float lo, float hi) { return pg8::cvt_pk_bf16(lo, hi); }
__device__ __forceinline__ float bflo(unsigned w) { return __uint_as_float(w << 16); }
__device__ __forceinline__ float bfhi(unsigned w) { return __uint_as_float(w & 0xffff0000u); }
__device__ __forceinline__ float bf1(bf16_t h) { return __uint_as_float(((unsigned)h) << 16); }
__device__ __forceinline__ bf16_t f2bf1(float f) { return (bf16_t)(pk2(f, f) & 0xffffu); }
__device__ __forceinline__ float wave_sum(float v) {
#pragma unroll
    for (int o = 1; o < 64; o <<= 1) v += __shfl_xor(v, o);
    return v;
}
__device__ __forceinline__ float sigmoidf_(float x) { return 1.0f / (1.0f + __expf(-x)); }
__device__ __forceinline__ f32x4 mfma16(bf16x8 a, bf16x8 b, f32x4 c) { return __builtin_amdgcn_mfma_f32_16x16x32_bf16(a, b, c, 0, 0, 0); }
__device__ __forceinline__ void unpack8(const u32x4 w, float* f) {
    f[0] = bflo(w.x); f[1] = bfhi(w.x); f[2] = bflo(w.y); f[3] = bfhi(w.y); f[4] = bflo(w.z); f[5] = bfhi(w.z); f[6] = bflo(w.w); f[7] = bfhi(w.w);
}
__device__ __forceinline__ u32x4 pack8(const float* f) { u32x4 w; w.x = pk2(f[0], f[1]); w.y = pk2(f[2], f[3]); w.z = pk2(f[4], f[5]); w.w = pk2(f[6], f[7]); return w; }
#define DPPF(v, ctrl) __builtin_bit_cast(float, __builtin_amdgcn_update_dpp(0, __builtin_bit_cast(int, (v)), (ctrl), 0xF, 0xF, true))
__device__ __forceinline__ float readlane_f(float v, int l) { return __builtin_bit_cast(float, __builtin_amdgcn_readlane(__builtin_bit_cast(int, v), l)); }
__device__ __forceinline__ float wave_sum_dpp(float v) {
    v += DPPF(v, 0xB1); v += DPPF(v, 0x4E); v += DPPF(v, 0x141); v += DPPF(v, 0x140);
    return (readlane_f(v, 0) + readlane_f(v, 16)) + (readlane_f(v, 32) + readlane_f(v, 48));
}
__device__ __forceinline__ float wave_max_dpp(float v) {
    v = fmaxf(v, DPPF(v, 0xB1)); v = fmaxf(v, DPPF(v, 0x4E)); v = fmaxf(v, DPPF(v, 0x141)); v = fmaxf(v, DPPF(v, 0x140));
    return fmaxf(fmaxf(readlane_f(v, 0), readlane_f(v, 16)), fmaxf(readlane_f(v, 32), readlane_f(v, 48)));
}
#define BLOCK_SYNC() __syncthreads()

#ifdef FP8_EMU
__device__ __forceinline__ void emu8(float& a, float& b, float sc) { const int pk = __builtin_amdgcn_cvt_pk_fp8_f32(a * sc, b * sc, 0, false); const auto r = __builtin_amdgcn_cvt_pk_f32_fp8(pk, false); a = r[0] / sc; b = r[1] / sc; }
__device__ __forceinline__ void emu8v(f32x4& o, float sc) { float a = o.x, b = o.y, c = o.z, d = o.w; emu8(a, b, sc); emu8(c, d, sc); o = (f32x4){a, b, c, d}; }
#endif
#define XB_TMO      128
#define XB_XCNT(j)  (256  + 64 * (j))
#define XB_XSUB(j)  (1280 + 64 * (j))
#define XB_XGEN(j)  (2304 + 64 * (j))
#define XB_TOP      3328
#define XB_TOPGEN   3392
#define XCD_BAR_WORDS 3456
#define XB_SPIN_CAP (1u << 18)

__device__ __forceinline__ unsigned xb_ld(unsigned* p)              { return __hip_atomic_load(p, __ATOMIC_RELAXED, __HIP_MEMORY_SCOPE_AGENT); }
__device__ __forceinline__ unsigned xb_add(unsigned* p, unsigned v) { return __hip_atomic_fetch_add(p, v, __ATOMIC_RELAXED, __HIP_MEMORY_SCOPE_AGENT); }
__device__ __forceinline__ unsigned xb_xcc_id() { return (unsigned)__builtin_amdgcn_s_getreg((3 << 11) | 20) & 0xFu; }
#define XB_SPIN(cond, bar) do { unsigned _sp = 0; while (cond) { __builtin_amdgcn_s_sleep(1); \
    if ((++_sp & 255u) == 0u) { if (xb_ld(&(bar)[XB_TMO])) break; if (_sp > XB_SPIN_CAP) { atomicAdd(&(bar)[XB_TMO], 1u); break; } } } } while (0)

struct XcdBarrier {
    unsigned* bar; unsigned x;
    volatile LAS unsigned* st;
};

__device__ __forceinline__ XcdBarrier xcd_barrier_post(unsigned* bar, volatile LAS unsigned* st) {
    XcdBarrier b; b.bar = bar; b.x = xb_xcc_id(); b.st = st;
    if (threadIdx.x == 0) (void)xb_add(&bar[XB_XCNT(b.x)], 1u);
    return b;
}
__device__ __forceinline__ void xcd_barrier_complete(unsigned* bar, unsigned x, unsigned& nloc, unsigned& nx) {
    const unsigned G = gridDim.x * gridDim.y * gridDim.z;
    unsigned sum, cnt, mine, sp = 0u;
    for (;;) {
        sum = 0u; cnt = 0u; mine = 0u;
#pragma unroll
        for (unsigned j = 0; j < 16; ++j) { const unsigned c = xb_ld(&bar[XB_XCNT(j)]); sum += c; cnt += (c > 0u) ? 1u : 0u; mine = (j == x) ? c : mine; }
        if (sum == G) break;
        __builtin_amdgcn_s_sleep(1);
        if ((++sp & 255u) == 0u) { if (xb_ld(&bar[XB_TMO])) break; if (sp > XB_SPIN_CAP) { atomicAdd(&bar[XB_TMO], 1u); break; } }
    }
    nloc = mine > 0u ? mine : 1u; nx = cnt > 0u ? cnt : 1u;
}

__device__ __forceinline__ void xcd_barrier(const XcdBarrier& b) {
    asm volatile("s_waitcnt vmcnt(0)" ::: "memory");
    __syncthreads();
    if (threadIdx.x == 0) {
        unsigned* bar = b.bar;
        __builtin_amdgcn_s_waitcnt(0);
        unsigned nloc = b.st[0], nx = b.st[1];
        if (nloc == 0u) { xcd_barrier_complete(bar, b.x, nloc, nx); b.st[0] = nloc; b.st[1] = nx; }
        const unsigned old = xb_add(&bar[XB_XSUB(b.x)], 1u);
        const unsigned gen = old / nloc;
        if (old + 1u == (gen + 1u) * nloc) {
            __builtin_amdgcn_fence(__ATOMIC_RELEASE, "agent");
            asm volatile("s_waitcnt vmcnt(0)" ::: "memory");
            const unsigned og = xb_add(&bar[XB_TOP], 1u);
            const unsigned tg = og / nx;
            if (og + 1u == (tg + 1u) * nx) xb_add(&bar[XB_TOPGEN], 1u);
            else XB_SPIN(xb_ld(&bar[XB_TOPGEN]) == tg, bar);
            __builtin_amdgcn_fence(__ATOMIC_ACQUIRE, "agent");
            xb_add(&bar[XB_XGEN(b.x)], 1u);
            asm volatile("s_waitcnt vmcnt(0)" ::: "memory");
        } else {
            XB_SPIN(xb_ld(&bar[XB_XGEN(b.x)]) == gen, bar);
            __builtin_amdgcn_fence(__ATOMIC_ACQUIRE, "agent");
            asm volatile("s_waitcnt vmcnt(0)" ::: "memory");
        }
    }
    __syncthreads();
}

#ifdef FP8_EMU
#define EMU_W5 ((FP8_EMU & 1) != 0)
#define EMU_W6 ((FP8_EMU & 2) != 0)
#else
#define EMU_W5 false
#define EMU_W6 false
#endif
__device__ __forceinline__ void ln_row_bf16(const float* src, const float* g, const float* b, bf16_t* dst, int lane) {
    f32x4 v[8]; float s = 0.f;
#pragma unroll
    for (int j = 0; j < 8; ++j) { v[j] = ((const f32x4*)src)[lane + 64 * j]; s += (v[j].x + v[j].y) + (v[j].z + v[j].w); }
    const float mean = wave_sum(s) * (1.0f / D); float s2 = 0.f;
#pragma unroll
    for (int j = 0; j < 8; ++j) { v[j] = v[j] - mean; s2 += (v[j].x * v[j].x + v[j].y * v[j].y) + (v[j].z * v[j].z + v[j].w * v[j].w); }
    const float rstd = 1.0f / sqrtf(wave_sum(s2) * (1.0f / D) + LN_EPS);
#pragma unroll
    for (int j = 0; j < 8; ++j) {
        const f32x4 gg = ((const f32x4*)g)[lane + 64 * j], bb = ((const f32x4*)b)[lane + 64 * j];
        const f32x4 o = v[j] * rstd * gg + bb;
        u32x2 w; w.x = pk2(o.x, o.y); w.y = pk2(o.z, o.w);
        ((u32x2*)dst)[lane + 64 * j] = w;
    }
}
__device__ __forceinline__ void transpose_item(const float* W, int K, int N, int Npad, bf16_t* Wt, int item, int lane, int ldw = 0) {
    const int nblk = Npad >> 6, kb = item / nblk, nb = item - kb * nblk, n = nb * 64 + lane, k0 = kb * 32;
    float v[32];
    if (n < N) {
#pragma unroll
        for (int i = 0; i < 32; ++i) v[i] = W[(size_t)(k0 + i) * N + n];
    } else {
#pragma unroll
        for (int i = 0; i < 32; ++i) v[i] = 0.f;
    }
    u32x4* o = (u32x4*)(Wt + (size_t)n * (ldw ? ldw : K) + k0);
#pragma unroll
    for (int c = 0; c < 4; ++c) { u32x4 w; w.x = pk2(v[8 * c], v[8 * c + 1]); w.y = pk2(v[8 * c + 2], v[8 * c + 3]); w.z = pk2(v[8 * c + 4], v[8 * c + 5]); w.w = pk2(v[8 * c + 6], v[8 * c + 7]); o[c] = w; }
}
__device__ __forceinline__ unsigned pk4_fp8(float a, float b, float c, float d);
__device__ __forceinline__ void transpose_item_q(const float* W, const float* g, const float* b, bf16_t* Wt, float* c1, float* c2, int item, int lane, unsigned char* Wt8 = nullptr) {
    const int kb = item >> 5, nb = item & 31, n = nb * 64 + lane, k0 = kb * 32;
    float v[32], s1 = 0.f, s2 = 0.f;
#pragma unroll
    for (int i = 0; i < 32; ++i) { const float w = W[(size_t)(k0 + i) * 2048 + n]; const float gw = g[k0 + i] * w; s1 += gw; s2 += b[k0 + i] * w; v[i] = gw; }
    if (Wt8) {
        unsigned w[8]; s1 = 0.f;
#pragma unroll
        for (int c = 0; c < 8; ++c) { w[c] = pk4_fp8(64.f * v[4 * c], 64.f * v[4 * c + 1], 64.f * v[4 * c + 2], 64.f * v[4 * c + 3]);
            const auto lo2 = __builtin_amdgcn_cvt_pk_f32_fp8((int)w[c], false), hi2 = __builtin_amdgcn_cvt_pk_f32_fp8((int)w[c], true); s1 += (lo2[0] + lo2[1]) + (hi2[0] + hi2[1]); }
        s1 *= (1.0f / 64.0f);
        u32x4* o8 = (u32x4*)(Wt8 + (size_t)n * 2048 + k0);
        o8[0] = (u32x4){w[0], w[1], w[2], w[3]}; o8[1] = (u32x4){w[4], w[5], w[6], w[7]};
    } else {
    u32x4* o = (u32x4*)(Wt + (size_t)n * 2048 + k0);
#pragma unroll
    for (int c = 0; c < 4; ++c) { u32x4 w; w.x = pk2(v[8 * c], v[8 * c + 1]); w.y = pk2(v[8 * c + 2], v[8 * c + 3]); w.z = pk2(v[8 * c + 4], v[8 * c + 5]); w.w = pk2(v[8 * c + 6], v[8 * c + 7]); o[c] = w; }
    }
    atomicAdd(c1 + n, s1); atomicAdd(c2 + n, s2);
}
__device__ __forceinline__ unsigned pk4_fp8(float a, float b, float c, float d) {
    int w = __builtin_amdgcn_cvt_pk_fp8_f32(a, b, 0, false); w = __builtin_amdgcn_cvt_pk_fp8_f32(c, d, w, true); return (unsigned)w; }
__device__ __forceinline__ void transpose_item64(const float* W, int K, int N, int Npad, bf16_t* Wt, int ldw, int item, int lane, unsigned char* Wt8 = nullptr, int n8 = 1 << 30, bool emu = false, int ld8 = 2048, int ldsrc = 0) {
    const int nblk = Npad >> 6, kb = item / nblk, nb = item - kb * nblk, n = nb * 64 + lane, k0 = kb * 64;
    float v[64];
    if (n < N) {
#pragma unroll
        for (int i = 0; i < 64; ++i) v[i] = W[(size_t)(k0 + i) * (ldsrc ? ldsrc : N) + n];
    } else {
#pragma unroll
        for (int i = 0; i < 64; ++i) v[i] = 0.f;
    }
#ifdef FP8_EMU
    if (emu) {
#pragma unroll
        for (int i = 0; i < 64; i += 2) emu8(v[i], v[i + 1], 64.0f); }
#endif
    if (n >= n8) {
        u32x4* o8 = (u32x4*)(Wt8 + (size_t)(n - n8) * ld8 + k0);
#pragma unroll
        for (int c = 0; c < 4; ++c) { u32x4 w; w.x = pk4_fp8(64.f * v[16 * c], 64.f * v[16 * c + 1], 64.f * v[16 * c + 2], 64.f * v[16 * c + 3]); w.y = pk4_fp8(64.f * v[16 * c + 4], 64.f * v[16 * c + 5], 64.f * v[16 * c + 6], 64.f * v[16 * c + 7]);
            w.z = pk4_fp8(64.f * v[16 * c + 8], 64.f * v[16 * c + 9], 64.f * v[16 * c + 10], 64.f * v[16 * c + 11]); w.w = pk4_fp8(64.f * v[16 * c + 12], 64.f * v[16 * c + 13], 64.f * v[16 * c + 14], 64.f * v[16 * c + 15]); o8[c] = w; }
        return;
    }
    u32x4* o = (u32x4*)(Wt + (size_t)n * ldw + k0);
#pragma unroll
    for (int c = 0; c < 8; ++c) { u32x4 w; w.x = pk2(v[8 * c], v[8 * c + 1]); w.y = pk2(v[8 * c + 2], v[8 * c + 3]); w.z = pk2(v[8 * c + 4], v[8 * c + 5]); w.w = pk2(v[8 * c + 6], v[8 * c + 7]); o[c] = w; }
}
__device__ __forceinline__ void phase0(const Params& P) {
    const int lane = threadIdx.x & 63, wave = threadIdx.x >> 6;
    const int gw = blockIdx.x * 8 + wave, NGW = gridDim.x * 8;
    unsigned char* ws = P.ws;
    constexpr int T_IN = 32 * 184, T_A = 32 * 32, T_B = 16 * 32, T_O = 32 * 32, T_Q = 64 * 32, T_POOL = 4 * 32, T_W2 = 3 * 32, T_A2 = 3 * 32, T_G2 = 8 * 32;
    constexpr int T_LN = MROWS, T_SK = 64;
    constexpr int NIT = T_IN + T_A + T_B + T_O + T_Q + T_POOL + T_W2 + T_A2 + T_G2 + T_SK;
    for (int it = gw; it < NIT; it += NGW) {
        int r = it;
        if (r < T_IN) {
            const int nb = r % (NPAD >> 6), n0 = nb * 64;
            const int coff = n0 < 4096 ? 0 : n0 < 4544 ? 2048 : n0 < 4608 ? -(1 << 20) : n0 < 6656 ? -512 : -64;
            transpose_item64(P.in[I_WIN] + (coff > -(1 << 20) ? coff : 0), 2048, coff > -(1 << 20) ? INC - coff : 0, NPAD, (bf16_t*)(ws + WS_WTIN), 2048, r, lane, ws + WS_WT8, N_BF, false, 2048, INC); continue; }
        r -= T_IN;
        if (r < T_A) {
#ifdef P5_F8
            transpose_item64(P.in[I_WBA], 2048, 2048, 2048, nullptr, LDAB, r, lane, ws + WS_WTAB8, 0, false, LDAB); continue; }
#else
            transpose_item64(P.in[I_WBA], 2048, 2048, 2048, (bf16_t*)(ws + WS_WTAB), LDAB, r, lane, nullptr, 1 << 30, EMU_W5); continue; }
#endif
        r -= T_A;
        if (r < T_B) {
#ifdef P5_F8
            transpose_item64(P.in[I_WBB], 1024, 2048, 2048, nullptr, LDAB, r, lane, ws + WS_WTAB8 + 2048, 0, false, LDAB); continue; }
#else
            transpose_item64(P.in[I_WBB], 1024, 2048, 2048, (bf16_t*)(ws + WS_WTAB) + 2048, LDAB, r, lane, nullptr, 1 << 30, EMU_W5); continue; }
#endif
        r -= T_B;
        if (r < T_O) {
#ifdef P6_F8
            transpose_item64(P.in[I_WOUT], 2048, 2048, 2048, nullptr, 2048, r, lane, ws + WS_WTOUT8, 0, false, 2048); continue; }
#else
            transpose_item64(P.in[I_WOUT], 2048, 2048, 2048, (bf16_t*)(ws + WS_WTOUT), 2048, r, lane, nullptr, 1 << 30, EMU_W6); continue; }
#endif
        r -= T_O;
        if (r < T_Q) {
#ifdef REPEAT_PHASE
            float* st = (float*)(ws + (P.ph_lo < 0 ? WS_END : WS_STAT));
#else
            float* st = (float*)(ws + WS_STAT);
#endif
#ifdef P7_F8
            transpose_item_q(P.in[I_WQ], P.in[I_LN1G], P.in[I_LN1B], nullptr, st + 16384, st + 18432, r, lane, ws + WS_WTQ8); continue; }
#else
            transpose_item_q(P.in[I_WQ], P.in[I_LN1G], P.in[I_LN1B], (bf16_t*)(ws + WS_WTQ), st + 16384, st + 18432, r, lane); continue; }
#endif
        r -= T_Q;
        if (r < T_POOL) { const int g = r >> 5; transpose_item(P.in[I_WPOOL] + g * 65536, 256, 256, 256, (bf16_t*)(ws + WS_WTPOOL) + g * 65536, r & 31, lane); continue; } r -= T_POOL;
        if (r < T_W2) { transpose_item(P.in[I_WW2], 96, 2048, 2048, (bf16_t*)(ws + WS_WTW2), r, lane); continue; } r -= T_W2;
        if (r < T_A2) { transpose_item(P.in[I_WA2], 96, 2048, 2048, (bf16_t*)(ws + WS_WTA2), r, lane); continue; } r -= T_A2;
        if (r < T_G2) { transpose_item(P.in[I_WG2], 256, 2048, 2048, (bf16_t*)(ws + WS_WTG2), r, lane); continue; } r -= T_G2;
        {
            const float* s = P.in[I_SUBK] + r * 512 + lane * 8; float f[8];
#pragma unroll
            for (int i = 0; i < 8; ++i) f[i] = s[i];
            *(u32x4*)((bf16_t*)(ws + WS_SUBK) + r * 512 + lane * 8) = pack8(f);
        }
    }
    {
        f32x4 gg[8], bb[8];
#pragma unroll
        for (int j = 0; j < 8; ++j) { gg[j] = ((const f32x4*)P.in[I_LNIN_G])[lane + 64 * j]; bb[j] = ((const f32x4*)P.in[I_LNIN_B])[lane + 64 * j]; }
        auto srcrow = [&](int r) -> const float* { return r < NTOK ? P.in[I_X] + (size_t)r * D : P.in[I_META] + (size_t)(r - NTOK) * D; };
        auto finish = [&](int r, f32x4 (&v)[8]) {
            float s = 0.f;
#pragma unroll
            for (int j = 0; j < 8; ++j) s += (v[j].x + v[j].y) + (v[j].z + v[j].w);
            const float mean = wave_sum_dpp(s) * (1.0f / D); float s2 = 0.f;
#pragma unroll
            for (int j = 0; j < 8; ++j) { v[j] = v[j] - mean; s2 += (v[j].x * v[j].x + v[j].y * v[j].y) + (v[j].z * v[j].z + v[j].w * v[j].w); }
            const float rstd = 1.0f / sqrtf(wave_sum_dpp(s2) * (1.0f / D) + LN_EPS);
            bf16_t* dst = (bf16_t*)(ws + WS_H0B) + (size_t)r * D;
            unsigned* dst8 = (unsigned*)(ws + WS_H0B8 + (size_t)r * 2048);
#pragma unroll
            for (int j = 0; j < 8; ++j) { const f32x4 o = v[j] * rstd * gg[j] + bb[j]; u32x2 w; w.x = pk2(o.x, o.y); w.y = pk2(o.z, o.w); ((u32x2*)dst)[lane + 64 * j] = w;
                dst8[lane + 64 * j] = pk4_fp8(o.x, o.y, o.z, o.w); }
        };
        for (int r = gw; r < NTOK + 16; r += 2 * NGW) {
            const int r2 = r + NGW; const bool has2 = r2 < NTOK + 16;
            f32x4 v1[8], v2[8];
#pragma unroll
            for (int j = 0; j < 8; ++j) v1[j] = ((const f32x4*)srcrow(r))[lane + 64 * j];
#pragma unroll
            for (int j = 0; j < 8; ++j) v2[j] = ((const f32x4*)srcrow(has2 ? r2 : r))[lane + 64 * j];
            finish(r, v1); if (has2) finish(r2, v2);
        }
        for (int r = NTOK + 16 + gw; r < MROWS; r += NGW) { bf16_t* dst = (bf16_t*)(ws + WS_H0B) + (size_t)r * D; unsigned* dst8 = (unsigned*)(ws + WS_H0B8 + (size_t)r * 2048);
#pragma unroll
            for (int j = 0; j < 8; ++j) { ((u32x2*)dst)[lane + 64 * j] = (u32x2){0u, 0u}; dst8[lane + 64 * j] = 0u; } }
    }
}
namespace pg8 {
constexpr float LN_EPS_ = 1e-5f;
struct EpiBf16S {
    static constexpr bool PERM = true, AFTER_DRAIN = false; static constexpr int MID_T = -1;
    bf16_t* O; int ldc; float scale;
    __device__ __forceinline__ void operator()(const f32x4 (&acc)[2][2][4][2], const Unit& u, int wr, int wc, int fr, int fq) const {
        const int row0 = u.pm * BM + wr * 64 + fr, col0 = u.pn * BM + wc * 32 + 8 * fq;
#pragma unroll
        for (int ai = 0; ai < 2; ++ai)
#pragma unroll
            for (int m = 0; m < 4; ++m) { bf16_t* rowp = O + (size_t)(row0 + ai * HALF + m * 16) * ldc + col0;
#pragma unroll
                for (int bj = 0; bj < 2; ++bj) { const f32x4 v0 = acc[ai][bj][m][0] * scale, v1 = acc[ai][bj][m][1] * scale;
                    u32x4 w; w.x = cvt_pk_bf16(v0[0], v0[1]); w.y = cvt_pk_bf16(v0[2], v0[3]); w.z = cvt_pk_bf16(v1[0], v1[1]); w.w = cvt_pk_bf16(v1[2], v1[3]);
                    *(u32x4*)(rowp + bj * HALF) = w; } }
    }
};
template <int MIDT> struct EpiGate35T {
    static constexpr bool PERM = false, AFTER_DRAIN = false; static constexpr int MID_T = MIDT;
    bf16_t* O; const bf16_t* p; const float* bgate; float oscale;
    __device__ __forceinline__ void mid(f32x4 (&acc)[2][2][4][2], const Unit& u, int wr, int wc, int fr, int fq) const {
        asm volatile("" : "+v"(fr), "+v"(fq));
        const int row0 = u.pm * BM + wr * 64 + fr, col0 = u.pn * BM + wc * 32 + 4 * fq;
        f32x4 b0[2][2], b1[2][2];
#pragma unroll
        for (int bj = 0; bj < 2; ++bj)
#pragma unroll
            for (int n = 0; n < 2; ++n) { const int col = col0 + bj * HALF + n * 16; b0[bj][n] = *(const f32x4*)(bgate + col); b1[bj][n] = *(const f32x4*)(bgate + D + col); }
        u32x2 pa[2][2][2], pb[2][2][2];
        auto ld = [&](int g, u32x2 (&pp)[2][2][2]) { const size_t row = (size_t)(row0 + (g >> 2) * HALF + (g & 3) * 16);
#pragma unroll
            for (int bj = 0; bj < 2; ++bj)
#pragma unroll
                for (int n = 0; n < 2; ++n) { const int col = col0 + bj * HALF + n * 16; pp[bj][n][0] = *(const u32x2*)(p + row * NPAD + C_G0 + col); pp[bj][n][1] = *(const u32x2*)(p + row * NPAD + C_G1 + col); } };
        auto ap = [&](int g, const u32x2 (&pp)[2][2][2]) { const int ai = g >> 2, m = g & 3;
#pragma unroll
            for (int bj = 0; bj < 2; ++bj)
#pragma unroll
                for (int n = 0; n < 2; ++n) { const u32x2 p0 = pp[bj][n][0], p1 = pp[bj][n][1]; const f32x4 c0 = b0[bj][n], c1 = b1[bj][n];
                    f32x4 r;
                    r.x = (1.0f + __expf(-fmaxf(bflo(p1.x) + c1.x, -80.f))) * __builtin_amdgcn_rcpf(1.0f + __expf(-(bflo(p0.x) + c0.x)));
                    r.y = (1.0f + __expf(-fmaxf(bfhi(p1.x) + c1.y, -80.f))) * __builtin_amdgcn_rcpf(1.0f + __expf(-(bfhi(p0.x) + c0.y)));
                    r.z = (1.0f + __expf(-fmaxf(bflo(p1.y) + c1.z, -80.f))) * __builtin_amdgcn_rcpf(1.0f + __expf(-(bflo(p0.y) + c0.z)));
                    r.w = (1.0f + __expf(-fmaxf(bfhi(p1.y) + c1.w, -80.f))) * __builtin_amdgcn_rcpf(1.0f + __expf(-(bfhi(p0.y) + c0.w)));
                    acc[ai][bj][m][n] = acc[ai][bj][m][n] * r; } };
        ld(0, pa);
#pragma unroll
        for (int g = 0; g < 8; g += 2) { ld(g + 1, pb); ap(g, pa); if (g + 2 < 8) ld(g + 2, pa); ap(g + 1, pb); }
    }
    __device__ __forceinline__ void operator()(const f32x4 (&acc)[2][2][4][2], const Unit& u, int wr, int wc, int fr, int fq) const {
        const int row0 = u.pm * BM + wr * 64 + fr, col0 = u.pn * BM + wc * 32 + 4 * fq;
#pragma unroll
        for (int ai = 0; ai < 2; ++ai)
#pragma unroll
            for (int m = 0; m < 4; ++m) { const size_t row = (size_t)(row0 + ai * HALF + m * 16);
#pragma unroll
                for (int bj = 0; bj < 2; ++bj)
#pragma unroll
                    for (int n = 0; n < 2; ++n) { const int col = col0 + bj * HALF + n * 16;
                        const u32x2 p1 = *(const u32x2*)(p + row * NPAD + C_G1 + col); const f32x4 b1 = *(const f32x4*)(bgate + D + col);
                        f32x4 g;
                        g.x = __builtin_amdgcn_rcpf(1.0f + __expf(-fmaxf(bflo(p1.x) + b1.x, -80.f))); g.y = __builtin_amdgcn_rcpf(1.0f + __expf(-fmaxf(bfhi(p1.x) + b1.y, -80.f)));
                        g.z = __builtin_amdgcn_rcpf(1.0f + __expf(-fmaxf(bflo(p1.y) + b1.z, -80.f))); g.w = __builtin_amdgcn_rcpf(1.0f + __expf(-fmaxf(bfhi(p1.y) + b1.w, -80.f)));
                        const f32x4 o = acc[ai][bj][m][n] * (g * oscale);
#ifdef P6_F8
                        *(unsigned*)((unsigned char*)O + row * D + col) = pk4_fp8(o.x, o.y, o.z, o.w); } }
#else
                        u32x2 w; w.x = cvt_pk_bf16(o.x, o.y); w.y = cvt_pk_bf16(o.z, o.w);
                        *(u32x2*)(O + row * D + col) = w; } }
#endif
    }
};
typedef EpiGate35T<32> EpiGate35;
struct EpiResidStats {
    static constexpr bool PERM = false, AFTER_DRAIN = false; static constexpr int MID_T = -1;
    bf16_t* O; const bf16_t* h0; float alpha; float* rsum; float* rsq; float ascale; unsigned char* O8;
    __device__ __forceinline__ void operator()(const f32x4 (&acc)[2][2][4][2], const Unit& u, int wr, int wc, int fr, int fq) const {
        const int row0 = u.pm * BM + wr * 64 + fr, col0 = u.pn * BM + wc * 32 + 4 * fq;
#pragma unroll
        for (int ai = 0; ai < 2; ++ai)
#pragma unroll
            for (int m = 0; m < 4; ++m) { const size_t row = (size_t)(row0 + ai * HALF + m * 16); float s = 0.f, q = 0.f;
#pragma unroll
                for (int bj = 0; bj < 2; ++bj)
#pragma unroll
                    for (int n = 0; n < 2; ++n) { const int col = col0 + bj * HALF + n * 16;
                        const u32x2 hw = *(const u32x2*)(h0 + row * D + col);
                        f32x4 hv; hv.x = bflo(hw.x); hv.y = bfhi(hw.x); hv.z = bflo(hw.y); hv.w = bfhi(hw.y);
                        const f32x4 x = hv * alpha + acc[ai][bj][m][n] * ascale;
                        s += (x.x + x.y) + (x.z + x.w); q += (x.x * x.x + x.y * x.y) + (x.z * x.z + x.w * x.w);
                        u32x2 w; w.x = cvt_pk_bf16(x.x, x.y); w.y = cvt_pk_bf16(x.z, x.w);
                        *(u32x2*)(O + row * D + col) = w;
#ifdef P7_F8
                        *(unsigned*)(O8 + row * D + col) = pk4_fp8(x.x, x.y, x.z, x.w);
#endif
                    }
                s += __shfl_xor(s, 16); s += __shfl_xor(s, 32); q += __shfl_xor(q, 16); q += __shfl_xor(q, 32);
                if (fq == 0) { atomicAdd(rsum + row, s); atomicAdd(rsq + row, q); } }
    }
};
struct EpiQ {
    static constexpr bool PERM = true, AFTER_DRAIN = false; static constexpr int MID_T = -1;
    bf16_t* O; const float* rsum; const float* rsq; const float* c1; const float* c2; float ascale;
    __device__ __forceinline__ void operator()(const f32x4 (&acc)[2][2][4][2], const Unit& u, int wr, int wc, int fr, int fq) const {
        const int row0 = u.pm * BM + wr * 64 + fr, col0 = u.pn * BM + wc * 32 + 8 * fq;
        f32x4 k1[2][2], k2[2][2];
#pragma unroll
        for (int bj = 0; bj < 2; ++bj)
#pragma unroll
            for (int n = 0; n < 2; ++n) { k1[bj][n] = *(const f32x4*)(c1 + col0 + bj * HALF + 4 * n); k2[bj][n] = *(const f32x4*)(c2 + col0 + bj * HALF + 4 * n); }
#pragma unroll
        for (int ai = 0; ai < 2; ++ai)
#pragma unroll
            for (int m = 0; m < 4; ++m) { const int row = row0 + ai * HALF + m * 16;
                const float mean = rsum[row] * (1.0f / D), rstd = 1.0f / sqrtf(fmaxf(rsq[row] * (1.0f / D) - mean * mean, 0.f) + LN_EPS_);
                bf16_t* rowp = O + (size_t)row * D + col0;
#pragma unroll
                for (int bj = 0; bj < 2; ++bj) {
                    const f32x4 v0 = (acc[ai][bj][m][0] * ascale - k1[bj][0] * mean) * rstd + k2[bj][0], v1 = (acc[ai][bj][m][1] * ascale - k1[bj][1] * mean) * rstd + k2[bj][1];
                    u32x4 w; w.x = cvt_pk_bf16(v0[0], v0[1]); w.y = cvt_pk_bf16(v0[2], v0[3]); w.z = cvt_pk_bf16(v1[0], v1[1]); w.w = cvt_pk_bf16(v1[2], v1[3]);
                    *(u32x4*)(rowp + bj * HALF) = w; } }
    }
};
}
template <class Epi>
__device__ __forceinline__ void run_gemm(ldsp lds, const bf16_t* A, const bf16_t* Bt, int M, int N, int K, const Epi& E) {
    pg8::Gemm g; g.A = A; g.Bt = Bt; g.M = M; g.N = N; g.K = K;
    pg8::StaticOrder S; S.init(M, N, (int)gridDim.x, (int)blockIdx.x);
    pg8::gemm_phase<Epi, pg8::StaticOrder, false>(lds, g, S, E, nullptr);
}

template <class Epi>
__device__ __forceinline__ void run_gemm8(ldsp lds, const unsigned char* A8, const unsigned char* Bt8, int M, int N, int K, const Epi& E, int wg) {
    pg8::Gemm g; g.A = (const bf16_t*)A8; g.Bt = (const bf16_t*)Bt8; g.M = M; g.N = N; g.K = K / 2;
    pg8::StaticOrder S; S.init(M, N, (int)gridDim.x, wg);
    pg8::gemm_phase<Epi, pg8::StaticOrder, false, true>(lds, g, S, E, nullptr);
}
constexpr int CONV_P3_END = 16384;
constexpr int CONV_P2_ROWS = 0;
__device__ __forceinline__ void convert_row(unsigned char* ws, int r, int lane, const f32x4 (&v)[8]) {
    float am = 0.f, ss = 0.f;
#pragma unroll
    for (int j = 0; j < 8; ++j) { am = fmaxf(am, fmaxf(fmaxf(fabsf(v[j].x), fabsf(v[j].y)), fmaxf(fabsf(v[j].z), fabsf(v[j].w)))); ss += (v[j].x * v[j].x + v[j].y * v[j].y) + (v[j].z * v[j].z + v[j].w * v[j].w); }
    am = wave_max_dpp(am);
    const float rms = sqrtf(wave_sum_dpp(ss) * (1.0f / D));
    unsigned w[4]; float sc;
    if (r < 16384) {
        const float clip = fminf(am, 2.5f * rms), s = clip > 0.f ? 7.0f / clip : 1.0f; sc = clip > 0.f ? clip * (1.0f / 7.0f) : 1.0f;
#pragma unroll
        for (int j = 0; j < 4; ++j) { unsigned t = 0;
#pragma unroll
            for (int i = 0; i < 8; ++i) { const float f = fminf(fmaxf(v[2 * j + (i >> 2)][i & 3] * s, -7.0f), 7.0f);
                t = __builtin_amdgcn_alignbit(__float_as_uint(f + 12582912.0f), t, 4); }
            w[j] = t; }
    } else {
        const float clip = fminf(am, 3.0f * rms), s = clip > 0.f ? 6.0f / clip : 1.0f; sc = clip > 0.f ? clip * (1.0f / 6.0f) : 1.0f;
#pragma unroll
        for (int j = 0; j < 4; ++j) { unsigned t = 0; float f[8];
#pragma unroll
            for (int i = 0; i < 8; ++i) f[i] = fminf(fmaxf(v[2 * j + (i >> 2)][i & 3] * s, -6.0f), 6.0f);
            t = __builtin_amdgcn_cvt_scalef32_pk_fp4_f32(t, f[0], f[1], 1.0f, 0); t = __builtin_amdgcn_cvt_scalef32_pk_fp4_f32(t, f[2], f[3], 1.0f, 1);
            t = __builtin_amdgcn_cvt_scalef32_pk_fp4_f32(t, f[4], f[5], 1.0f, 2); t = __builtin_amdgcn_cvt_scalef32_pk_fp4_f32(t, f[6], f[7], 1.0f, 3);
            w[j] = t; }
    }
    *(u32x4*)(ws + WS_VB + (size_t)(r & 16383) * EROW + (r < 16384 ? 0 : 1024) + lane * 16) = (u32x4){w[0], w[1], w[2], w[3]};
    if (lane == 0) ((float*)(ws + WS_TSC))[r] = sc;
}
__device__ __forceinline__ void convert_ld(const Params& P, int r, int lane, f32x4 (&v)[8]) {
    const f32x4* src = (const f32x4*)((r < 16384 ? P.in[I_UT] : P.in[I_VT]) + (size_t)(r & 16383) * D) + lane;
#pragma unroll
    for (int j = 0; j < 8; ++j) v[j] = src[64 * j];
}
__device__ __forceinline__ void convert_tables(const Params& P, int r0, int rend, int stride) {
    const int lane = threadIdx.x & 63;
    for (int r = r0; r < rend; r += stride) { f32x4 v[8]; convert_ld(P, r, lane, v); convert_row(P.ws, r, lane, v); }
}
constexpr int LD64 = 72, MATB = 64 * LD64 * 2, LDK = 104;
constexpr int O_AB = 0, O_RB = 1 * MATB, O_BH = 2 * MATB, O_KH = 3 * MATB, O_BTT = 4 * MATB, O_KTT = 5 * MATB, O_VT = 6 * MATB;
constexpr int O_M0 = 7 * MATB, O_M0T = 8 * MATB  , O_M1 = 9 * MATB, O_PA = 10 * MATB, O_PB = 11 * MATB, O_MAK = 12 * MATB, O_MRB = 13 * MATB, O_MRK = 14 * MATB;
constexpr int O_M1T = 0;
constexpr int LDKP = 96;
constexpr int O_WL = 15 * MATB, O_AL = O_WL + 64 * LDKP * 2;
constexpr int O_Z = 7 * MATB, O_AZ = O_Z + 64 * 68 * 4;
static_assert(O_AZ + 64 * 68 * 4 <= O_PB, "lds");
static_assert(O_AL + 64 * LDKP * 2 <= LDS_BYTES - 16, "lds");

__device__ __forceinline__ bf16x8 ldsfrag(ldsp lds, int off, int ld, int row, int kofs) { return *(const LAS bf16x8*)(lds + off + (row * ld + kofs) * 2); }
__device__ __forceinline__ void st4(ldsp lds, int off, int row, int col, const f32x4 v) {
    u32x2 w; w.x = pk2(v.x, v.y); w.y = pk2(v.z, v.w); *(LAS u32x2*)(lds + off + (row * LD64 + col) * 2) = w; }
__device__ __forceinline__ void st1(ldsp lds, int off, int row, int col, float v) { *(LAS bf16_t*)(lds + off + (row * LD64 + col) * 2) = f2bf1(v); }

__device__ __forceinline__ float fast_rcp(float x) { return __builtin_amdgcn_rcpf(x); }
__device__ __forceinline__ float fast_sigmoid(float x) { return fast_rcp(1.0f + __expf(-x)); }
__device__ __forceinline__ float fast_tanh(float x) { return 1.0f - 2.0f * fast_rcp(1.0f + __expf(2.0f * x)); }
__device__ __forceinline__ u32x4 ld8(const bf16_t* p) { return p ? *(const u32x4*)p : (u32x4){0u, 0u, 0u, 0u}; }
__device__ __forceinline__ void shift8r(const u32x4 cw, const u32x4 pw, const float* mu, float* x) {
    float c[8], q[8]; unpack8(cw, c); unpack8(pw, q);
    const f32x4 m0 = *(const f32x4*)mu, m1 = *(const f32x4*)(mu + 4);
    const float mm[8] = {m0.x, m0.y, m0.z, m0.w, m1.x, m1.y, m1.z, m1.w};
#pragma unroll
    for (int i = 0; i < 8; ++i) x[i] = c[i] + (q[i] - c[i]) * mm[i];
}
__device__ __forceinline__ int tcol(int row, int col) { return ((((col >> 3) ^ (row >> 3)) & 7) << 3) | (col & 7); }
__device__ __forceinline__ bf16x8 ldsfragT(ldsp lds, int off, int row, int kofs) { return *(const LAS bf16x8*)(lds + off + (row * LD64 + tcol(row, kofs)) * 2); }
__device__ __forceinline__ void st1T(ldsp lds, int off, int row, int col, float v) { *(LAS bf16_t*)(lds + off + (row * LD64 + tcol(row, col)) * 2) = f2bf1(v); }
typedef short s16x4 __attribute__((ext_vector_type(4)));
__device__ __forceinline__ bf16x8 ldsfragTR(ldsp lds, int off, int krow0, int col0, int lane) {
    const int g = lane >> 4, q = (lane & 15) >> 2, p = lane & 3;
    const LAS s16x4* a = (const LAS s16x4*)(lds + off + ((krow0 + 8 * g + q) * LD64 + col0) * 2 + 8 * p);
    const s16x4 v0 = __builtin_amdgcn_ds_read_tr16_b64_v4i16((LAS s16x4*)a), v1 = __builtin_amdgcn_ds_read_tr16_b64_v4i16((LAS s16x4*)(a + LD64));
    return (bf16x8){v0[0], v0[1], v0[2], v0[3], v1[0], v1[1], v1[2], v1[3]};
}
__device__ __forceinline__ void shift8(const bf16_t* pcur, const bf16_t* pprev, const float* mu, float* x) {
    float c[8], q[8];
    if (pcur) unpack8(*(const u32x4*)pcur, c); else {
#pragma unroll
        for (int i = 0; i < 8; ++i) c[i] = 0.f; }
    if (pprev) unpack8(*(const u32x4*)pprev, q); else {
#pragma unroll
        for (int i = 0; i < 8; ++i) q[i] = 0.f; }
    const f32x4 m0 = *(const f32x4*)mu, m1 = *(const f32x4*)(mu + 4);
    const float mm[8] = {m0.x, m0.y, m0.z, m0.w, m1.x, m1.y, m1.z, m1.w};
#pragma unroll
    for (int i = 0; i < 8; ++i) x[i] = c[i] + (q[i] - c[i]) * mm[i];
}

template <bool DO_P, bool DO_SQ>
__device__ __forceinline__ void dbl_step(ldsp lds, int sN, int sT, int dN, int dT, int pC, int pN, int tm, int tn0, int fr, int fq) {
    bf16x8 a[2];
#pragma unroll
    for (int ks = 0; ks < 2; ++ks) a[ks] = ldsfragTR(lds, sN, 32 * ks, 16 * tm, 16 * fq + fr);
#pragma unroll
    for (int t2 = 0; t2 < 2; ++t2) {
        const int nt = tn0 + t2, t = 16 * nt + fr, s0 = 16 * tm + 4 * fq;
        if (DO_P) {
            f32x4 acc = {0.f, 0.f, 0.f, 0.f};
#pragma unroll
            for (int ks = 0; ks < 2; ++ks) acc = mfma16(a[ks], ldsfrag(lds, pC, LD64, t, ks * 32 + fq * 8), acc);
            const u32x2 pw = *(const LAS u32x2*)(lds + pC + (t * LD64 + s0) * 2);
            acc.x += bflo(pw.x); acc.y += bfhi(pw.x); acc.z += bflo(pw.y); acc.w += bfhi(pw.y);
            st4(lds, pN, t, s0, acc);
        }
        if (DO_SQ) {
            f32x4 acc = {0.f, 0.f, 0.f, 0.f};
#pragma unroll
            for (int ks = 0; ks < 2; ++ks) acc = mfma16(a[ks], ldsfrag(lds, sN, LD64, t, ks * 32 + fq * 8), acc);
            st4(lds, dN, t, s0, acc);
        }
    }
}


struct PL { u32x4 rc, rq, kc, kq, vc, vq; };
__device__ __forceinline__ const bf16_t* unit_rowp(const bf16_t* pp, int u, int tl, int col) {
    int r;
    if (u >= 4096) r = (tl >= 48) ? (ROW_META + tl - 48) : -1;
    else { const int bh = u >> 6, c = u & 63, b = bh >> 5; r = (tl >= 0 || c > 0) ? (b * SEQ + c * 64 + tl) : (ROW_META + 15); }
    return r < 0 ? (const bf16_t*)nullptr : pp + (size_t)r * NPAD + col;
}
__device__ __forceinline__ void pl_load(const Params& P, int u, PL& L) {
    int tid = threadIdx.x; asm volatile("" : "+v"(tid));
    const int lane = tid & 63, wave = tid >> 6, fr = lane & 15, fq = lane >> 4, tm = wave >> 1;
    const bf16_t* pp = (const bf16_t*)(P.ws + WS_P);
    const int h = (u >= 4096) ? (u - 4096) : ((u >> 6) & 31);
    const int t = tid >> 3, hj = h * 64 + 8 * (tid & 7);
    L.rc = ld8(unit_rowp(pp, u, t, C_R + hj)); L.rq = ld8(unit_rowp(pp, u, t - 1, C_R + hj));
    L.kc = ld8(unit_rowp(pp, u, t, C_K + hj)); L.kq = ld8(unit_rowp(pp, u, t - 1, C_K + hj));
    L.vc = ld8(unit_rowp(pp, u, t, C_V + hj)); L.vq = ld8(unit_rowp(pp, u, t - 1, C_V + hj));
}
#define SINGLE_TRIP for (int once_ = 0; once_ < 1; ++once_)
__device__ __forceinline__ void rwkv_unit(const Params& P, ldsp lds, int u, PL& L, int next_u, bool stage_a) {
    int tid = threadIdx.x; asm volatile("" : "+v"(tid));
    const int lane = tid & 63, wave = tid >> 6, fr = lane & 15, fq = lane >> 4, tm = wave >> 1, tn0 = (wave & 1) * 2;
    unsigned char* ws = P.ws;
    const bf16_t* pp = (const bf16_t*)(ws + WS_P);
    const bool meta = u >= 4096;
    int b = 0, h, c = 0;
    if (meta) { h = u - 4096; } else { const int bh = u >> 6; c = u & 63; b = bh >> 5; h = bh & 31; }
    auto rowof = [&](int tl) -> int {
        if (meta) return (tl >= 48) ? (ROW_META + tl - 48) : -1;
        if (tl >= 0 || c > 0) return b * SEQ + c * 64 + tl;
        return ROW_META + 15;
    };
    auto rowp = [&](int tl, int col) -> const bf16_t* { const int r = rowof(tl); return r < 0 ? (const bf16_t*)nullptr : pp + (size_t)r * NPAD + col; };
    const float* mu = P.in[I_MU];
    float lw[8], av[8], rv[8], kv[8], vv[8], kk[8], km[8];
    const int t = tid >> 3, jq = tid & 7, j0 = 8 * jq, hj = h * 64 + j0;
    const bool nulltok = meta && t < 48;
    SINGLE_TRIP {
    bf16x8 lAw[3], lAa[3];
    {
        const bf16_t* ww2 = (const bf16_t*)(ws + WS_WTW2) + (size_t)(h * 64 + 16 * tm + fr) * 96 + fq * 8;
        const bf16_t* wa2 = (const bf16_t*)(ws + WS_WTA2) + (size_t)(h * 64 + 16 * tm + fr) * 96 + fq * 8;
#pragma unroll
        for (int ks = 0; ks < 3; ++ks) { lAw[ks] = *(const bf16x8*)(ww2 + ks * 32); lAa[ks] = *(const bf16x8*)(wa2 + ks * 32); }
    }
    if (stage_a) {
        u32x4 cw[3], pw[3];
#pragma unroll
        for (int it = 0; it < 3; ++it) { const int idx = tid + 512 * it, mat = idx / 768, rem = idx - mat * 768, tt = rem / 12, ch = rem - tt * 12, col = (mat ? C_AL : C_WL) + ch * 8;
            cw[it] = ld8(rowp(tt, col)); pw[it] = ld8(rowp(tt - 1, col)); }
#pragma unroll
        for (int it = 0; it < 3; ++it) { const int idx = tid + 512 * it, mat = idx / 768, rem = idx - mat * 768, tt = rem / 12, ch = rem - tt * 12, col = (mat ? C_AL : C_WL) + ch * 8;
            float x[8]; shift8r(cw[it], pw[it], mu + (mat ? M_AL : M_WL) + ch * 8, x);
            if (mat == 0) {
#pragma unroll
                for (int i = 0; i < 8; ++i) x[i] = fast_tanh(x[i]);
            }
            *(LAS u32x4*)(lds + (mat ? O_AL : O_WL) + (tt * LDKP + ch * 8) * 2) = pack8(x); }
    }
    BLOCK_SYNC();
    {
        f32x4 z[2] = {{0.f, 0.f, 0.f, 0.f}, {0.f, 0.f, 0.f, 0.f}}, az[2] = {{0.f, 0.f, 0.f, 0.f}, {0.f, 0.f, 0.f, 0.f}};
#pragma unroll
        for (int ks = 0; ks < 3; ++ks) {
            const bf16x8 aw = lAw[ks], aa = lAa[ks];
#pragma unroll
            for (int t2 = 0; t2 < 2; ++t2) {
                const int t = 16 * (tn0 + t2) + fr;
                z[t2] = mfma16(aw, ldsfrag(lds, O_WL, LDKP, t, ks * 32 + fq * 8), z[t2]);
                az[t2] = mfma16(aa, ldsfrag(lds, O_AL, LDKP, t, ks * 32 + fq * 8), az[t2]);
            }
        }
#pragma unroll
        for (int t2 = 0; t2 < 2; ++t2) {
            const int t = 16 * (tn0 + t2) + fr, j0 = 16 * tm + 4 * fq;
            *(LAS f32x4*)(lds + O_Z + (t * 68 + j0) * 4) = z[t2];
            *(LAS f32x4*)(lds + O_AZ + (t * 68 + j0) * 4) = az[t2];
        }
    }
    BLOCK_SYNC();
    float cs[8];
    {
        const f32x4 z0 = *(const LAS f32x4*)(lds + O_Z + (t * 68 + j0) * 4), z1 = *(const LAS f32x4*)(lds + O_Z + (t * 68 + j0 + 4) * 4);
        const f32x4 y0 = *(const LAS f32x4*)(lds + O_AZ + (t * 68 + j0) * 4), y1 = *(const LAS f32x4*)(lds + O_AZ + (t * 68 + j0 + 4) * 4);
        const float zz[8] = {z0.x, z0.y, z0.z, z0.w, z1.x, z1.y, z1.z, z1.w}, yy[8] = {y0.x, y0.y, y0.z, y0.w, y1.x, y1.y, y1.z, y1.w};
        const f32x4 w0a = *(const f32x4*)(P.in[I_W0] + hj), w0b = *(const f32x4*)(P.in[I_W0] + hj + 4), a0a = *(const f32x4*)(P.in[I_A0] + hj), a0b = *(const f32x4*)(P.in[I_A0] + hj + 4);
        const float w0[8] = {w0a.x, w0a.y, w0a.z, w0a.w, w0b.x, w0b.y, w0b.z, w0b.w}, a0[8] = {a0a.x, a0a.y, a0a.z, a0a.w, a0b.x, a0b.y, a0b.z, a0b.w};
#pragma unroll
        for (int i = 0; i < 8; ++i) { lw[i] = nulltok ? 0.f : -DSCALE * fast_sigmoid(w0[i] + zz[i]); av[i] = fast_sigmoid(a0[i] + yy[i]); cs[i] = lw[i]; }
#pragma unroll
        for (int d = 8; d < 64; d <<= 1) {
#pragma unroll
            for (int i = 0; i < 8; ++i) { const float o = __shfl_up(cs[i], d); cs[i] += (lane >= d) ? o : 0.f; }
        }
        if (lane >= 56) {
#pragma unroll
            for (int i = 0; i < 8; ++i) *(LAS float*)(lds + (wave < 4 ? O_BH : O_KH) + ((j0 + i) * LD64 + 64) * 2 + (wave & 3) * 4) = cs[i]; }
        shift8r(L.rc, L.rq, mu + M_R + hj, rv); shift8r(L.kc, L.kq, mu + M_K + hj, kv); shift8r(L.vc, L.vq, mu + M_V + hj, vv);
        if (nulltok) {
#pragma unroll
            for (int i = 0; i < 8; ++i) { rv[i] = 0.f; kv[i] = 0.f; vv[i] = 0.f; }
        }
        const f32x4 kka = *(const f32x4*)(P.in[I_KK] + hj), kkb = *(const f32x4*)(P.in[I_KK] + hj + 4), kaa = *(const f32x4*)(P.in[I_KA] + hj), kab = *(const f32x4*)(P.in[I_KA] + hj + 4);
        const f32x4 rka = *(const f32x4*)(P.in[I_RK] + hj), rkb = *(const f32x4*)(P.in[I_RK] + hj + 4);
        const float kkw[8] = {kka.x, kka.y, kka.z, kka.w, kkb.x, kkb.y, kkb.z, kkb.w}, kaw[8] = {kaa.x, kaa.y, kaa.z, kaa.w, kab.x, kab.y, kab.z, kab.w}, rkw[8] = {rka.x, rka.y, rka.z, rka.w, rkb.x, rkb.y, rkb.z, rkb.w};
        float n2 = 0.f, bon = 0.f;
#pragma unroll
        for (int i = 0; i < 8; ++i) { kk[i] = kv[i] * kkw[i]; n2 += kk[i] * kk[i]; km[i] = kv[i] * (1.0f + (av[i] - 1.0f) * kaw[i]); bon += rv[i] * km[i] * rkw[i]; }
        n2 += DPPF(n2, 0xB1); n2 += DPPF(n2, 0x4E); n2 += DPPF(n2, 0x141);
        bon += DPPF(bon, 0xB1); bon += DPPF(bon, 0x4E); bon += DPPF(bon, 0x141);
        const float inv = 1.0f / fmaxf(sqrtf(n2), 1e-12f);
#pragma unroll
        for (int i = 0; i < 8; ++i) kk[i] *= inv;
        if (!meta && jq == 0) ((float*)(ws + WS_BONUS))[(size_t)(b * SEQ + c * 64 + t) * 32 + h] = bon;
    }
    BLOCK_SYNC();
    {
        float Lc[8], Le[8];
#pragma unroll
        for (int i = 0; i < 8; ++i) { Lc[i] = cs[i]; Le[i] = 0.f; }
#pragma unroll
        for (int i = 0; i < 8; ++i) {
            const f32x4 wa = *(const LAS f32x4*)(lds + O_BH + ((j0 + i) * LD64 + 64) * 2), wb = *(const LAS f32x4*)(lds + O_KH + ((j0 + i) * LD64 + 64) * 2);
            const float ww[8] = {wa.x, wa.y, wa.z, wa.w, wb.x, wb.y, wb.z, wb.w};
#pragma unroll
            for (int w = 0; w < 8; ++w) { Le[i] += ww[w]; Lc[i] += (w < wave) ? ww[w] : 0.f; }
        }
        float Ab[8], Rb[8], Bh[8], Kh[8], Bt[8], Kt[8];
#pragma unroll
        for (int i = 0; i < 8; ++i) {
            const float eP = __expf(Lc[i] - lw[i]), eC = __expf(Lc[i]), eN = __expf(-Lc[i]), eE = __expf(Le[i] - Lc[i]);
            const float ka = kk[i] * av[i];
            Ab[i] = -kk[i] * eP; Rb[i] = rv[i] * eC; Bh[i] = ka * eN; Kh[i] = km[i] * eN; Bt[i] = ka * eE; Kt[i] = km[i] * eE;
        }
        *(LAS u32x4*)(lds + O_AB + (t * LD64 + j0) * 2) = pack8(Ab);
        *(LAS u32x4*)(lds + O_RB + (t * LD64 + j0) * 2) = pack8(Rb);
        *(LAS u32x4*)(lds + O_BH + (t * LD64 + j0) * 2) = pack8(Bh);
        *(LAS u32x4*)(lds + O_KH + (t * LD64 + j0) * 2) = pack8(Kh);
        *(LAS u32x4*)(lds + O_BTT + (t * LD64 + j0) * 2) = pack8(Bt);
        *(LAS u32x4*)(lds + O_KTT + (t * LD64 + j0) * 2) = pack8(Kt);
        *(LAS u32x4*)(lds + O_VT + (t * LD64 + j0) * 2) = pack8(vv);
        if (t == 63) {
#pragma unroll
            for (int i = 0; i < 8; ++i) *(LAS float*)(lds + O_RB + ((j0 + i) * LD64 + 64) * 2) = __expf(Le[i]);
        }
    }
    BLOCK_SYNC();
    }
    if (next_u >= 0) pl_load(P, next_u, L);
    SINGLE_TRIP {
    {
        bf16x8 abh[2], akh[2];
#pragma unroll
        for (int ks = 0; ks < 2; ++ks) { abh[ks] = ldsfrag(lds, O_BH, LD64, 16 * tm + fr, ks * 32 + fq * 8); akh[ks] = ldsfrag(lds, O_KH, LD64, 16 * tm + fr, ks * 32 + fq * 8); }
#pragma unroll
        for (int t2 = 0; t2 < 2; ++t2) {
            const int tt = 16 * (tn0 + t2) + fr, s0 = 16 * tm + 4 * fq;
            f32x4 mab = {0.f, 0.f, 0.f, 0.f}, mak = mab, mrb = mab, mrk = mab;
#pragma unroll
            for (int ks = 0; ks < 2; ++ks) {
                const bf16x8 bab = ldsfrag(lds, O_AB, LD64, tt, ks * 32 + fq * 8), brb = ldsfrag(lds, O_RB, LD64, tt, ks * 32 + fq * 8);
                mab = mfma16(abh[ks], bab, mab); mak = mfma16(akh[ks], bab, mak); mrb = mfma16(abh[ks], brb, mrb); mrk = mfma16(akh[ks], brb, mrk);
            }
            float vab[4] = {mab.x, mab.y, mab.z, mab.w}, vak[4] = {mak.x, mak.y, mak.z, mak.w}, vrb[4] = {mrb.x, mrb.y, mrb.z, mrb.w}, vrk[4] = {mrk.x, mrk.y, mrk.z, mrk.w}, vp[4];
#pragma unroll
            for (int r = 0; r < 4; ++r) { const int s = s0 + r; const bool st = s < tt, le = s <= tt;
                vab[r] = st ? vab[r] : 0.f; vak[r] = st ? vak[r] : 0.f; vrb[r] = le ? vrb[r] : 0.f; vrk[r] = le ? vrk[r] : 0.f; vp[r] = vab[r] + (s == tt ? 1.0f : 0.f); }
            st4(lds, O_M0, tt, s0, (f32x4){vab[0], vab[1], vab[2], vab[3]});
            st4(lds, O_PA, tt, s0, (f32x4){vp[0], vp[1], vp[2], vp[3]});
            st4(lds, O_MAK, tt, s0, (f32x4){vak[0], vak[1], vak[2], vak[3]});
            st4(lds, O_MRB, tt, s0, (f32x4){vrb[0], vrb[1], vrb[2], vrb[3]});
            st4(lds, O_MRK, tt, s0, (f32x4){vrk[0], vrk[1], vrk[2], vrk[3]});
        }
    }
    BLOCK_SYNC();
    dbl_step<false, true>(lds, O_M0, O_M0T, O_M1, O_M1T, 0, 0, tm, tn0, fr, fq); BLOCK_SYNC();
    dbl_step<true, true>(lds, O_M1, O_M1T, O_M0, O_M0T, O_PA, O_PB, tm, tn0, fr, fq); BLOCK_SYNC();
    dbl_step<true, true>(lds, O_M0, O_M0T, O_M1, O_M1T, O_PB, O_PA, tm, tn0, fr, fq); BLOCK_SYNC();
    dbl_step<true, true>(lds, O_M1, O_M1T, O_M0, O_M0T, O_PA, O_PB, tm, tn0, fr, fq); BLOCK_SYNC();
    if (!meta) {
    dbl_step<true, true>(lds, O_M0, O_M0T, O_M1, O_M1T, O_PB, O_PA, tm, tn0, fr, fq); BLOCK_SYNC();
    dbl_step<true, false>(lds, O_M1, O_M1T, 0, 0, O_PA, O_PB, tm, tn0, fr, fq); BLOCK_SYNC();
    }
    }
    const size_t ub = (size_t)u * 4096;
    SINGLE_TRIP {
    {
        bf16x8 aT[2], aMak[2];
#pragma unroll
        for (int ks = 0; ks < 2; ++ks) { aT[ks] = ldsfrag(lds, O_PB, LD64, 16 * tm + fr, ks * 32 + fq * 8); aMak[ks] = ldsfrag(lds, O_MAK, LD64, 16 * tm + fr, ks * 32 + fq * 8); }
#pragma unroll
        for (int t2 = 0; t2 < 2; ++t2) {
            const int n = 16 * (tn0 + t2) + fr, t0 = 16 * tm + 4 * fq;
            f32x4 at = {0.f, 0.f, 0.f, 0.f}, xt = at;
#pragma unroll
            for (int ks = 0; ks < 2; ++ks) { at = mfma16(aT[ks], ldsfragTR(lds, O_AB, 32 * ks, 16 * (tn0 + t2), 16 * fq + fr), at); xt = mfma16(aMak[ks], ldsfragTR(lds, O_VT, 32 * ks, 16 * (tn0 + t2), 16 * fq + fr), xt); }
            st4(lds, O_M0, n, t0, at); st4(lds, O_M0T, n, t0, xt);
        }
    }
    BLOCK_SYNC();
    {
        bf16x8 aT[2], aAt[2];
#pragma unroll
        for (int ks = 0; ks < 2; ++ks) { aT[ks] = ldsfrag(lds, O_PB, LD64, 16 * tm + fr, ks * 32 + fq * 8); aAt[ks] = ldsfrag(lds, O_M0, LD64, 16 * tm + fr, ks * 32 + fq * 8); }
        bf16_t* Rt = (bf16_t*)(ws + WS_RT) + ub; bf16_t* Gp = (bf16_t*)(ws + WS_G) + ub;
#pragma unroll
        for (int t2 = 0; t2 < 2; ++t2) {
            const int n = 16 * (tn0 + t2) + fr, m0 = 16 * tm + 4 * fq;
            f32x4 u0 = {0.f, 0.f, 0.f, 0.f}, rt = u0, g = u0;
#pragma unroll
            for (int ks = 0; ks < 2; ++ks) {
                u0 = mfma16(aT[ks], ldsfrag(lds, O_M0T, LD64, n, ks * 32 + fq * 8), u0);
                rt = mfma16(aAt[ks], ldsfrag(lds, O_MRB, LD64, n, ks * 32 + fq * 8), rt);
                g = mfma16(aAt[ks], ldsfragTR(lds, O_BTT, 32 * ks, 16 * (tn0 + t2), 16 * fq + fr), g);
            }
            st4(lds, O_M1, n, m0, u0);
            const u32x2 rw = *(const LAS u32x2*)(lds + O_RB + (n * LD64 + m0) * 2);
            rt.x += bflo(rw.x); rt.y += bfhi(rw.x); rt.z += bflo(rw.y); rt.w += bfhi(rw.y);
            { u32x2 w; w.x = pk2(rt.x, rt.y); w.y = pk2(rt.z, rt.w); *(u32x2*)(Rt + n * 64 + m0) = w; }
            if ((n >> 2) == (m0 >> 2)) { const float e = *(const LAS float*)(lds + O_RB + (n * LD64 + 64) * 2); const int r = n & 3;
                g.x += (r == 0) ? e : 0.f; g.y += (r == 1) ? e : 0.f; g.z += (r == 2) ? e : 0.f; g.w += (r == 3) ? e : 0.f; }
            { const int pos0 = 32 * (tm >> 1) + 8 * fq + 4 * (tm & 1); u32x2 w; w.x = pk2(g.x, g.y); w.y = pk2(g.z, g.w); *(u32x2*)(Gp + n * 64 + pos0) = w; }
        }
    }
    BLOCK_SYNC();
    {
        bf16x8 aB[2], aK[2], aU[2], aV[2];
#pragma unroll
        for (int ks = 0; ks < 2; ++ks) { const int row = 16 * tm + fr, ko = ks * 32 + fq * 8;
            aB[ks] = ldsfragTR(lds, O_BTT, 32 * ks, 16 * tm, 16 * fq + fr); aK[ks] = ldsfragTR(lds, O_KTT, 32 * ks, 16 * tm, 16 * fq + fr); aU[ks] = ldsfrag(lds, O_M1, LD64, row, ko); aV[ks] = ldsfragTR(lds, O_VT, 32 * ks, 16 * tm, 16 * fq + fr); }
        bf16_t* H0t = (bf16_t*)(ws + WS_H0T) + ub; bf16_t* Y0s = (bf16_t*)(ws + WS_Y0) + ub;
#pragma unroll
        for (int t2 = 0; t2 < 2; ++t2) {
            const int n = 16 * (tn0 + t2) + fr, m0 = 16 * tm + 4 * fq;
            f32x4 hh = {0.f, 0.f, 0.f, 0.f}, yy = hh;
#pragma unroll
            for (int ks = 0; ks < 2; ++ks) { const int ko = ks * 32 + fq * 8;
                const bf16x8 bU = ldsfrag(lds, O_M1, LD64, n, ko), bV = ldsfragTR(lds, O_VT, 32 * ks, 16 * (tn0 + t2), 16 * fq + fr), bRb = ldsfrag(lds, O_MRB, LD64, n, ko), bRk = ldsfrag(lds, O_MRK, LD64, n, ko);
                hh = mfma16(aB[ks], bU, hh); hh = mfma16(aK[ks], bV, hh);
                yy = mfma16(aU[ks], bRb, yy); yy = mfma16(aV[ks], bRk, yy); }
            { u32x2 w; w.x = pk2(hh.x, hh.y); w.y = pk2(hh.z, hh.w); *(u32x2*)(H0t + n * 64 + m0) = w; }
            { u32x2 w; w.x = pk2(yy.x, yy.y); w.y = pk2(yy.z, yy.w); *(u32x2*)(Y0s + n * 64 + m0) = w; }
        }
    }
    BLOCK_SYNC();
    }
}

constexpr int LDU = 264;
__device__ __forceinline__ void pool_load(const Params& P, int pu, u32x4 (&raw)[5]) {
    int tid = threadIdx.x; asm volatile("" : "+v"(tid));
    const bf16_t* pp = (const bf16_t*)(P.ws + WS_P);
    const int g = (pu < 256) ? (pu & 3) : 3 - (pu & 3), tt = pu >> 2, b = tt >> 6, ti0 = (tt & 63) * 64;
#pragma unroll
    for (int k = 0; k < 5; ++k) { const int idx = tid + 512 * k;
        if (idx < 79 * 32) { const int lr = idx >> 5, ch = idx & 31, ti = ti0 + lr - 15; const int row = ti >= 0 ? b * SEQ + ti : ROW_META + 16 + ti;
            raw[k] = *(const u32x4*)(pp + (size_t)row * NPAD + C_POOL + g * 256 + ch * 8); } }
}
__device__ __forceinline__ void pool_unit(const Params& P, ldsp lds, int pu, const u32x4 (&raw)[5]) {
    int tid = threadIdx.x; asm volatile("" : "+v"(tid));
    const int lane = tid & 63, wave = tid >> 6, fr = lane & 15, fq = lane >> 4;
    unsigned char* ws = P.ws;
    const bf16_t* pp = (const bf16_t*)(ws + WS_P);
    const int g = (pu < 256) ? (pu & 3) : 3 - (pu & 3), tt = pu >> 2, b = tt >> 6, ti0 = (tt & 63) * 64;
    constexpr int O_U = 0, O_PL = 79 * LDU * 2;
#pragma unroll
    for (int k = 0; k < 5; ++k) { const int idx = tid + 512 * k; if (idx < 79 * 32) *(LAS u32x4*)(lds + O_U + ((idx >> 5) * LDU + (idx & 31) * 8) * 2) = raw[k]; }
    BLOCK_SYNC();
    {
        const int c0 = (tid & 31) * 8, t0 = (tid >> 5) * 4, win = 2 << g; const float inv = 1.0f / (float)win;
        float s[8], nw[8];
        unpack8(*(const LAS u32x4*)(lds + O_U + ((15 + t0) * LDU + c0) * 2), nw);
#pragma unroll
        for (int i = 0; i < 8; ++i) s[i] = nw[i];
        for (int d = 1; d < win; ++d) { float x[8]; unpack8(*(const LAS u32x4*)(lds + O_U + ((15 + t0 - d) * LDU + c0) * 2), x);
#pragma unroll
            for (int i = 0; i < 8; ++i) s[i] += x[i]; }
#pragma unroll
        for (int k = 0; k < 4; ++k) {
            if (k > 0) { float od[8]; unpack8(*(const LAS u32x4*)(lds + O_U + ((15 + t0 + k) * LDU + c0) * 2), nw); unpack8(*(const LAS u32x4*)(lds + O_U + ((15 + t0 + k - win) * LDU + c0) * 2), od);
#pragma unroll
                for (int i = 0; i < 8; ++i) s[i] += nw[i] - od[i]; }
            float o[8];
#pragma unroll
            for (int i = 0; i < 8; ++i) o[i] = s[i] * inv - nw[i];
            *(LAS u32x4*)(lds + O_PL + ((t0 + k) * LDU + c0) * 2) = pack8(o);
        }
    }
    BLOCK_SYNC();
    {
        const bf16_t* wt = (const bf16_t*)(ws + WS_WTPOOL) + (size_t)g * 65536;
        f32x4 acc[2][4];
#pragma unroll
        for (int a = 0; a < 2; ++a)
#pragma unroll
            for (int n = 0; n < 4; ++n) acc[a][n] = (f32x4){0.f, 0.f, 0.f, 0.f};
#pragma unroll 4
        for (int ks = 0; ks < 8; ++ks) {
            bf16x8 af[2];
#pragma unroll
            for (int a = 0; a < 2; ++a) af[a] = *(const bf16x8*)(wt + (size_t)(32 * wave + 16 * a + fr) * 256 + ks * 32 + fq * 8);
#pragma unroll
            for (int n = 0; n < 4; ++n) { const bf16x8 bf = ldsfrag(lds, O_PL, LDU, 16 * n + fr, ks * 32 + fq * 8);
#pragma unroll
                for (int a = 0; a < 2; ++a) acc[a][n] = mfma16(af[a], bf, acc[a][n]); }
        }
#ifdef P5_F8
        unsigned char* yb = ws + WS_YAB + 2048;
#else
        bf16_t* yb = (bf16_t*)(ws + WS_YAB) + 2048;
#endif
        const float* psc = P.in[I_PSCALE] + g * 256;
#pragma unroll
        for (int a = 0; a < 2; ++a) { const int d0 = 32 * wave + 16 * a + 4 * fq; const f32x4 sc = *(const f32x4*)(psc + d0);
#pragma unroll
            for (int n = 0; n < 4; ++n) { const int t = 16 * n + fr; const f32x4 o = acc[a][n] * sc;
#ifdef P5_F8
                *(unsigned*)(yb + (size_t)(b * SEQ + ti0 + t) * LDAB + g * 256 + d0) = pk4_fp8(o.x, o.y, o.z, o.w); } }
#else
                u32x2 w; w.x = pk2(o.x, o.y); w.y = pk2(o.z, o.w);
                *(u32x2*)(yb + (size_t)(b * SEQ + ti0 + t) * LDAB + g * 256 + d0) = w; } }
#endif
    }
    BLOCK_SYNC();
}
__device__ __forceinline__ void gsig_unit(const Params& P, int gu) {
    int tid = threadIdx.x; asm volatile("" : "+v"(tid));
    const bf16_t* pp = (const bf16_t*)(P.ws + WS_P); bf16_t* gs = (bf16_t*)(P.ws + WS_GSIG);
    const float* mu = P.in[I_MU];
#pragma unroll
    for (int it = 0; it < 4; ++it) {
        const int idx = tid + 512 * it, tl = idx >> 5, ch = idx & 31, col = C_GL + ch * 8;
        const int row = gu * 64 + tl; const int prow = ((row & (SEQ - 1)) == 0) ? (ROW_META + 15) : row - 1;
        float x[8]; shift8r(*(const u32x4*)(pp + (size_t)row * NPAD + col), *(const u32x4*)(pp + (size_t)prow * NPAD + col), mu + M_GL + ch * 8, x);
#pragma unroll
        for (int i = 0; i < 8; ++i) x[i] = fast_sigmoid(x[i]);
        *(u32x4*)(gs + (size_t)row * 256 + ch * 8) = pack8(x);
    }
}
__device__ __forceinline__ void phase2(const Params& P, ldsp lds) {
    PL L;
    for (int j = blockIdx.x; j < 256 + 32 + 128; j += gridDim.x) {
        if (j < 256) {
            const int b = j >> 7, c = (j >> 1) & 63, h0 = (j & 1) * 16;
            pl_load(P, (b * 32 + h0) * 64 + c, L);
            for (int i = 0; i < 16; ++i) { const int u = (b * 32 + h0 + i) * 64 + c; rwkv_unit(P, lds, u, L, i + 1 < 16 ? u + 64 : -1, i == 0); }
        } else if (j < 288) { pl_load(P, 4096 + (j - 256), L); rwkv_unit(P, lds, 4096 + (j - 256), L, -1, true); }
        else gsig_unit(P, j - 288);
    }
}
__device__ __forceinline__ void phase3(const Params& P) {
    const int lane = threadIdx.x & 63, wave = threadIdx.x >> 6, fr = lane & 15, fq = lane >> 4;
    if (wave != 0) { convert_tables(P, blockIdx.x * 7 + (wave - 1), CONV_P3_END, gridDim.x * 7); return; }
    unsigned char* ws = P.ws;
    const bf16_t* Gp = (const bf16_t*)(ws + WS_G); const bf16_t* H0t = (const bf16_t*)(ws + WS_H0T); bf16_t* S0t = (bf16_t*)(ws + WS_S0T);
    for (int item = blockIdx.x; item < 256; item += gridDim.x) {
        const int bh = item >> 2, vq = item & 3, h = bh & 31;
        bf16x8 Sb[2];
#pragma unroll
        for (int ks = 0; ks < 2; ++ks)
#pragma unroll
            for (int i = 0; i < 8; ++i) Sb[ks][i] = 0;
        bf16x8 g0[4][2], g1[4][2], g2[4][2], g3[4][2]; u32x2 h0[4], h1[4], h2[4], h3[4];
        auto load = [&](int step, bf16x8 (&ga)[4][2], u32x2 (&hf)[4]) {
            const int u = (step == 0) ? (4096 + h) : (bh * 64 + step - 1);
            const bf16_t* g = Gp + (size_t)u * 4096; const bf16_t* hh = H0t + (size_t)u * 4096;
#pragma unroll
            for (int mt = 0; mt < 4; ++mt) {
#pragma unroll
                for (int ks = 0; ks < 2; ++ks) ga[mt][ks] = *(const bf16x8*)(g + (16 * mt + fr) * 64 + ks * 32 + fq * 8);
                hf[mt] = *(const u32x2*)(hh + (16 * vq + fr) * 64 + 16 * mt + 4 * fq);
            }
        };
        auto apply = [&](int step, const bf16x8 (&ga)[4][2], const u32x2 (&hf)[4]) {
            f32x4 acc[4];
#pragma unroll
            for (int mt = 0; mt < 4; ++mt) {
                acc[mt] = (f32x4){bflo(hf[mt].x), bfhi(hf[mt].x), bflo(hf[mt].y), bfhi(hf[mt].y)};
                acc[mt] = mfma16(ga[mt][0], Sb[0], acc[mt]);
                acc[mt] = mfma16(ga[mt][1], Sb[1], acc[mt]);
            }
            bf16_t* so = S0t + (size_t)(bh * 64 + step) * 4096 + (16 * vq + fr) * 64 + 4 * fq;
            u32x2 w[4];
#pragma unroll
            for (int mt = 0; mt < 4; ++mt) { w[mt].x = pk2(acc[mt].x, acc[mt].y); w[mt].y = pk2(acc[mt].z, acc[mt].w); *(u32x2*)(so + 16 * mt) = w[mt]; }
#pragma unroll
            for (int ks = 0; ks < 2; ++ks) {
                const u32x4 q4 = (u32x4){w[2 * ks].x, w[2 * ks].y, w[2 * ks + 1].x, w[2 * ks + 1].y};
                Sb[ks] = __builtin_bit_cast(bf16x8, q4);
            }
        };
        load(0, g0, h0); load(1, g1, h1); load(2, g2, h2);
#pragma unroll 1
        for (int step = 0; step < 64; step += 4) {
            load(step + 3, g3, h3); apply(step, g0, h0);
            if (step + 4 < 64) load(step + 4, g0, h0);
            apply(step + 1, g1, h1);
            if (step + 5 < 64) load(step + 5, g1, h1);
            apply(step + 2, g2, h2);
            if (step + 6 < 64) load(step + 6, g2, h2);
            apply(step + 3, g3, h3);
        }
    }
}

constexpr int LDG = 264;
__device__ __forceinline__ void phase3b(const Params& P, ldsp lds) {
    int tid = threadIdx.x; asm volatile("" : "+v"(tid));
    const int lane = tid & 63, wave = tid >> 6, fr = lane & 15, fq = lane >> 4, wq = wave & 3;
    unsigned char* ws = P.ws;
    const bf16_t* pp = (const bf16_t*)(ws + WS_P);
    const float* mu = P.in[I_MU];
    constexpr int O_G2 = 0, O_HP = 64 * LDG * 2;
    {
        u32x4 ra[5], rb[5]; int pu = blockIdx.x;
        if (pu < 512) pool_load(P, pu, ra);
        for (; pu < 512; pu += gridDim.x) {
            const int pn = pu + gridDim.x;
            if (pn < 512) pool_load(P, pn, rb);
            pool_unit(P, lds, pu, ra);
#pragma unroll
            for (int k = 0; k < 5; ++k) ra[k] = rb[k];
        }
    }
    for (int w = blockIdx.x; w < 256; w += gridDim.x) {
        const int h = w & 31;
        BLOCK_SYNC();
        for (int idx = tid; idx < 64 * 32; idx += 512) { const int row = idx >> 5, ch = idx & 31;
            *(LAS u32x4*)(lds + O_G2 + (row * LDG + ch * 8) * 2) = *(const u32x4*)((const bf16_t*)(ws + WS_WTG2) + (size_t)(h * 64 + row) * 256 + ch * 8); }
        if (tid < 48) { const int a = tid >> 4, q4 = tid & 15; const float* src = a == 0 ? P.in[I_GNG] + h * 64 : a == 1 ? P.in[I_GNB] + h * 64 : mu + M_V + h * 64;
            *(LAS f32x4*)(lds + O_HP + a * 256 + q4 * 16) = *(const f32x4*)(src + q4 * 4); }
        BLOCK_SYNC();
        bf16x8 bG[8], bR[2], aS[4][2]; u32x2 yw[4], vc[4], vp[4]; float bon;
        auto unit_of = [&](int it, int& b, int& c) { const int q = (w >> 5) + 8 * (2 * it + (wave >> 2)); b = q >> 6; c = q & 63; };
        auto issue = [&](int it) {
            int b, c; unit_of(it, b, c); const int u = (b * 32 + h) * 64 + c, trow0 = b * SEQ + c * 64 + 16 * wq;
            const size_t ub = (size_t)u * 4096;
            const bf16_t* S0t = (const bf16_t*)(ws + WS_S0T) + ub; const bf16_t* Rt = (const bf16_t*)(ws + WS_RT) + ub; const bf16_t* Y0s = (const bf16_t*)(ws + WS_Y0) + ub;
            const int row = trow0 + fr; const int prow = (c == 0 && wq == 0 && fr == 0) ? (ROW_META + 15) : row - 1;
            const bf16_t* gsr = (const bf16_t*)(ws + WS_GSIG) + (size_t)row * 256 + fq * 8;
#pragma unroll
            for (int ks = 0; ks < 8; ++ks) bG[ks] = *(const bf16x8*)(gsr + ks * 32);
#pragma unroll
            for (int ks = 0; ks < 2; ++ks) bR[ks] = *(const bf16x8*)(Rt + (16 * wq + fr) * 64 + ks * 32 + fq * 8);
#pragma unroll
            for (int mt = 0; mt < 4; ++mt) {
                yw[mt] = *(const u32x2*)(Y0s + (16 * wq + fr) * 64 + 16 * mt + 4 * fq);
#pragma unroll
                for (int ks = 0; ks < 2; ++ks) aS[mt][ks] = *(const bf16x8*)(S0t + (16 * mt + fr) * 64 + ks * 32 + fq * 8);
                const int hc = h * 64 + 16 * mt + 4 * fq;
                vc[mt] = *(const u32x2*)(pp + (size_t)row * NPAD + C_V + hc); vp[mt] = *(const u32x2*)(pp + (size_t)prow * NPAD + C_V + hc);
            }
            bon = ((const float*)(ws + WS_BONUS))[(size_t)row * 32 + h];
        };
        issue(0);
#pragma unroll 1
        for (int it = 0; it < 8; ++it) {
            const int crow = CONV_P3_END + (w * 8 + it) * 8 + wave; f32x4 tv[8];
            if (crow < 32768) convert_ld(P, crow, lane, tv);
            int b, c; unit_of(it, b, c);
            const int row = b * SEQ + c * 64 + 16 * wq + fr;
            f32x4 gacc[4];
#pragma unroll
            for (int mt = 0; mt < 4; ++mt) gacc[mt] = (f32x4){0.f, 0.f, 0.f, 0.f};
#pragma unroll
            for (int ks = 0; ks < 8; ++ks)
#pragma unroll
                for (int mt = 0; mt < 4; ++mt) gacc[mt] = mfma16(*(const LAS bf16x8*)(lds + O_G2 + ((16 * mt + fr) * LDG + ks * 32 + fq * 8) * 2), bG[ks], gacc[mt]);
            f32x4 y[4], vv[4]; const float bonc = bon;
#pragma unroll
            for (int mt = 0; mt < 4; ++mt) {
                y[mt] = (f32x4){bflo(yw[mt].x), bfhi(yw[mt].x), bflo(yw[mt].y), bfhi(yw[mt].y)};
#pragma unroll
                for (int ks = 0; ks < 2; ++ks) y[mt] = mfma16(aS[mt][ks], bR[ks], y[mt]);
                const f32x4 mv = *(const LAS f32x4*)(lds + O_HP + 512 + (16 * mt + 4 * fq) * 4);
                const f32x4 cv = (f32x4){bflo(vc[mt].x), bfhi(vc[mt].x), bflo(vc[mt].y), bfhi(vc[mt].y)}, pv = (f32x4){bflo(vp[mt].x), bfhi(vp[mt].x), bflo(vp[mt].y), bfhi(vp[mt].y)};
                vv[mt] = cv + (pv - cv) * mv;
            }
#pragma unroll
            for (int mt = 0; mt < 4; ++mt) asm volatile("" : "+v"(y[mt]), "+v"(vv[mt]), "+v"(gacc[mt]));
            if (it + 1 < 8) issue(it + 1);
            float s = 0.f;
#pragma unroll
            for (int mt = 0; mt < 4; ++mt) s += (y[mt].x + y[mt].y) + (y[mt].z + y[mt].w);
            s += __shfl_xor(s, 16); s += __shfl_xor(s, 32);
            const float mean = s * (1.0f / 64.0f); float qq = 0.f;
#pragma unroll
            for (int mt = 0; mt < 4; ++mt) { y[mt] = y[mt] - mean; qq += (y[mt].x * y[mt].x + y[mt].y * y[mt].y) + (y[mt].z * y[mt].z + y[mt].w * y[mt].w); }
            qq += __shfl_xor(qq, 16); qq += __shfl_xor(qq, 32);
            const float rstd = 1.0f / sqrtf(qq * (1.0f / 64.0f) + GN_EPS);
#ifdef P5_F8
            unsigned char* ya = ws + WS_YAB + (size_t)row * LDAB + h * 64;
#else
            bf16_t* ya = (bf16_t*)(ws + WS_YAB) + (size_t)row * LDAB + h * 64;
#endif
#pragma unroll
            for (int mt = 0; mt < 4; ++mt) {
                const int i0 = 16 * mt + 4 * fq, hc = h * 64 + i0;
                const f32x4 gg = *(const LAS f32x4*)(lds + O_HP + i0 * 4), gb = *(const LAS f32x4*)(lds + O_HP + 256 + i0 * 4);
                const f32x4 o = (y[mt] * rstd * gg + gb + vv[mt] * bonc) * gacc[mt];
#ifdef P5_F8
                *(unsigned*)(ya + i0) = pk4_fp8(o.x, o.y, o.z, o.w);
#else
                u32x2 wv; wv.x = pk2(o.x, o.y); wv.y = pk2(o.z, o.w);
                *(u32x2*)(ya + i0) = wv;
#endif
            }
            if (crow < 32768) convert_row(ws, crow, lane, tv);
        }
    }
}
__device__ __forceinline__ u32x6 ld_row6(const unsigned char* p) { const u32x2 a = ((const u32x2*)p)[0], b = ((const u32x2*)p)[1], c = ((const u32x2*)p)[2]; return (u32x6){a.x, a.y, b.x, b.y, c.x, c.y}; }
__device__ __forceinline__ void peer_load_x(const Params& P, ldsp lds, int o_par, int tok, int lo, float (&x)[32]) {
    unsigned char* ws = P.ws;
    const bf16_t* hr = (const bf16_t*)(ws + WS_X1B) + (size_t)tok * D + lo * 4;
#pragma unroll
    for (int j = 0; j < 8; ++j) { const u32x2 w = *(const u32x2*)(hr + 256 * j); x[4 * j] = bflo(w.x); x[4 * j + 1] = bfhi(w.x); x[4 * j + 2] = bflo(w.y); x[4 * j + 3] = bfhi(w.y); }
    const float* st = (const float*)(ws + WS_STAT);
    const float mean1 = st[tok] * (1.0f / D), rstd1 = 1.0f / sqrtf(fmaxf(st[8192 + tok] * (1.0f / D) - mean1 * mean1, 0.f) + LN_EPS);
#pragma unroll
    for (int c = 0; c < 8; ++c) { const f32x4 g1 = *(const LAS f32x4*)(lds + o_par + (lo * 4 + 256 * c) * 4), b1 = *(const LAS f32x4*)(lds + o_par + 8192 + (lo * 4 + 256 * c) * 4);
        x[4 * c] = (x[4 * c] - mean1) * rstd1 * g1.x + b1.x; x[4 * c + 1] = (x[4 * c + 1] - mean1) * rstd1 * g1.y + b1.y; x[4 * c + 2] = (x[4 * c + 2] - mean1) * rstd1 * g1.z + b1.z; x[4 * c + 3] = (x[4 * c + 3] - mean1) * rstd1 * g1.w + b1.w; }
}
__device__ __forceinline__ void peer_finish(const Params& P, ldsp lds, int o_par, int tok, int lo, float (&o)[32]) {
    float x[32]; peer_load_x(P, lds, o_par, tok, lo, x);
    float s = 0.f;
#pragma unroll
    for (int i = 0; i < 32; ++i) { o[i] += DN_ALPHA * x[i]; s += o[i]; }
    const float mean = wave_sum_dpp(s) * (1.0f / D); float q = 0.f;
#pragma unroll
    for (int i = 0; i < 32; ++i) { o[i] -= mean; q += o[i] * o[i]; }
    const float rstd = 1.0f / sqrtf(wave_sum_dpp(q) * (1.0f / D) + LN_EPS);
    float* orow = P.out + (size_t)tok * D;
#pragma unroll
    for (int c = 0; c < 8; ++c) {
        const int off = lo * 4 + 256 * c;
        const f32x4 g0 = *(const LAS f32x4*)(lds + o_par + 16384 + off * 4), b0 = *(const LAS f32x4*)(lds + o_par + 24576 + off * 4);
        f32x4 r0;
        r0.x = o[4 * c + 0] * rstd * g0.x + b0.x; r0.y = o[4 * c + 1] * rstd * g0.y + b0.y; r0.z = o[4 * c + 2] * rstd * g0.z + b0.z; r0.w = o[4 * c + 3] * rstd * g0.w + b0.w;
        *(f32x4*)(orow + off) = r0;
    }
}
__device__ __forceinline__ float peer_dot(const u32x4 uu, const unsigned (&xd0)[4], const unsigned (&xd1)[4]) {
    int a0 = 0, a1 = 0; const unsigned ww[4] = {uu.x, uu.y, uu.z, uu.w};
#pragma unroll
    for (int q4 = 0; q4 < 4; ++q4) { a0 = __builtin_amdgcn_sdot8((int)ww[q4], (int)xd0[q4], a0, false); a1 = __builtin_amdgcn_sdot8((int)ww[q4], (int)xd1[q4], a1, false); }
    return (float)(a0 + (a1 << 4));
}
__device__ __forceinline__ void peer_axpy(const u32x4 vv, float a, float (&o)[32]) {
    const f32x2 a2 = {a, a}; const unsigned ww[4] = {vv.x, vv.y, vv.z, vv.w};
#pragma unroll
    for (int q4 = 0; q4 < 4; ++q4) {
        const f32x2 r0 = __builtin_amdgcn_cvt_scalef32_pk_f32_fp4(ww[q4], 1.0f, 0), r1 = __builtin_amdgcn_cvt_scalef32_pk_f32_fp4(ww[q4], 1.0f, 1), r2 = __builtin_amdgcn_cvt_scalef32_pk_f32_fp4(ww[q4], 1.0f, 2), r3 = __builtin_amdgcn_cvt_scalef32_pk_f32_fp4(ww[q4], 1.0f, 3);
        f32x2 t;
        t = __builtin_elementwise_fma(a2, r0, (f32x2){o[8 * q4], o[8 * q4 + 1]}); o[8 * q4] = t.x; o[8 * q4 + 1] = t.y;
        t = __builtin_elementwise_fma(a2, r1, (f32x2){o[8 * q4 + 2], o[8 * q4 + 3]}); o[8 * q4 + 2] = t.x; o[8 * q4 + 3] = t.y;
        t = __builtin_elementwise_fma(a2, r2, (f32x2){o[8 * q4 + 4], o[8 * q4 + 5]}); o[8 * q4 + 4] = t.x; o[8 * q4 + 5] = t.y;
        t = __builtin_elementwise_fma(a2, r3, (f32x2){o[8 * q4 + 6], o[8 * q4 + 7]}); o[8 * q4 + 6] = t.x; o[8 * q4 + 7] = t.y; }
}
__device__ __forceinline__ void peer_round(const Params& P, ldsp lds, int o_ex, int o_gt, int o_list, int o_par, int tok, int tl) {
    int lo = threadIdx.x & 63; asm volatile("" : "+v"(lo));
    const int wave = threadIdx.x >> 6;
    unsigned char* ws = P.ws;
    const unsigned char* Ub = ws + WS_UB; const unsigned char* Vb = ws + WS_VB;
    const float* tsc = (const float*)(ws + WS_TSC);
    float o[32]; unsigned xd0[4], xd1[4]; float sxi;
    {
        float x[32]; peer_load_x(P, lds, o_par, tok, lo, x);
        float ax = 0.f;
#pragma unroll
        for (int i = 0; i < 32; ++i) ax = fmaxf(ax, fabsf(x[i]));
        ax = wave_max_dpp(ax);
        const float sx = ax > 0.f ? 119.0f / ax : 0.f; sxi = ax * (1.0f / 119.0f);
#pragma unroll
        for (int jw = 0; jw < 4; ++jw) { unsigned w0 = 0, w1 = 0;
#pragma unroll
            for (int i = 0; i < 8; ++i) { const unsigned b = __float_as_uint(fmaf(x[8 * jw + i], sx, 12582912.0f));
                w0 = __builtin_amdgcn_alignbit(b, w0, 4); w1 = __builtin_amdgcn_alignbit((b + 8u) >> 4, w1, 4); }
            xd0[jw] = w0; xd1[jw] = w1; }
    }
#pragma unroll
    for (int i = 0; i < 32; ++i) o[i] = 0.f;
    const LAS int* ex = (const LAS int*)(lds + o_ex) + tl * 128; const LAS float* gt = (const LAS float*)(lds + o_gt) + tl * 128;
    const int el = ex[lo], eh = ex[64 + lo];
    const float sul = tsc[el] * sxi, suh = tsc[eh] * sxi;
    const float gvl = gt[lo] * tsc[16384 + el], gvh = gt[64 + lo] * tsc[16384 + eh];
    LAS unsigned* lE = (LAS unsigned*)(lds + o_list) + wave * 384; LAS float* lS = (LAS float*)(lE + 128); LAS float* lG = (LAS float*)(lE + 256);
    {
        const int sl = el >> 10, sh = eh >> 10; int base = 0, pl = 0, ph = 0;
#define LT_COUNT(m) ((int)__builtin_amdgcn_mbcnt_hi((unsigned)((m) >> 32), __builtin_amdgcn_mbcnt_lo((unsigned)(m), 0u)))
#pragma unroll
        for (int s = 0; s < 16; ++s) {
            const unsigned long long ml = __ballot(sl == s), mh = __ballot(sh == s);
            const int cl = __popcll(ml);
            pl = (sl == s) ? base + LT_COUNT(ml) : pl; ph = (sh == s) ? base + cl + LT_COUNT(mh) : ph;
            base += cl + __popcll(mh);
        }
#undef LT_COUNT
        lE[pl] = (unsigned)el; lS[pl] = sul; lG[pl] = gvl; lE[ph] = (unsigned)eh; lS[ph] = suh; lG[ph] = gvh;
        asm volatile("s_waitcnt lgkmcnt(0)" ::: "memory");
    }
    u32x4 ua[4], ub[4]; u32x4 va[4], vb[4];
    auto issue = [&](int gi, u32x4 (&uu)[4], u32x4 (&vv)[4]) {
        const u32x4 e4 = *(const LAS u32x4*)(lE + 4 * gi);
        const unsigned ee[4] = {(unsigned)__builtin_amdgcn_readfirstlane((int)e4.x), (unsigned)__builtin_amdgcn_readfirstlane((int)e4.y), (unsigned)__builtin_amdgcn_readfirstlane((int)e4.z), (unsigned)__builtin_amdgcn_readfirstlane((int)e4.w)};
#pragma unroll
        for (int j = 0; j < 4; ++j) { uu[j] = *(const u32x4*)(Vb + (size_t)ee[j] * EROW + lo * 16); vv[j] = *(const u32x4*)(Vb + (size_t)ee[j] * EROW + 1024 + lo * 16); }
    };
    auto consume = [&](int gi, const u32x4 (&uu)[4], const u32x4 (&vv)[4]) {
        float dd[4];
#pragma unroll
        for (int j = 0; j < 4; ++j) dd[j] = peer_dot(uu[j], xd0, xd1);
        const bool b0 = (lo & 1) != 0, b1 = (lo & 2) != 0;
        const float r01 = (b0 ? dd[1] : dd[0]) + DPPF(b0 ? dd[0] : dd[1], 0xB1), r23 = (b0 ? dd[3] : dd[2]) + DPPF(b0 ? dd[2] : dd[3], 0xB1);
        float r = (b1 ? r23 : r01) + DPPF(b1 ? r01 : r23, 0x4E);
        r += DPPF(r, 0x124); r += DPPF(r, 0x128);
        { auto sw = __builtin_amdgcn_permlane16_swap(__float_as_uint(r), __float_as_uint(r), false, false); r = __uint_as_float(sw[0]) + __uint_as_float(sw[1]); }
        { auto sw = __builtin_amdgcn_permlane32_swap(__float_as_uint(r), __float_as_uint(r), false, false); r = __uint_as_float(sw[0]) + __uint_as_float(sw[1]); }
        const float su = lS[4 * gi + (lo & 3)], gv = lG[4 * gi + (lo & 3)];
        const float hh = r * su;
        const float a = pg8::gelu_pk((pg8::f32x2){hh, hh}).x * gv;
        peer_axpy(vv[0], DPPF(a, 0x00), o); peer_axpy(vv[1], DPPF(a, 0x55), o); peer_axpy(vv[2], DPPF(a, 0xAA), o); peer_axpy(vv[3], DPPF(a, 0xFF), o);
    };
    issue(0, ua, va);
#pragma unroll 1
    for (int gi = 0; gi < 30; gi += 2) {
        issue(gi + 1, ub, vb);
        consume(gi, ua, va);
        issue(gi + 2, ua, va);
        consume(gi + 1, ub, vb);
        if ((gi & 6) == 6) BLOCK_SYNC();
    }
    issue(31, ub, vb);
    consume(30, ua, va);
    consume(31, ub, vb);
    BLOCK_SYNC();
    peer_finish(P, lds, o_par, tok, lo, o);
}
#define CE_DESC(a, b) do { const float h_ = fmaxf((a), (b)), l_ = fminf((a), (b)); (a) = h_; (b) = l_; } while (0)
template <int N> __device__ __forceinline__ void bitonic_sort_desc(float (&v)[N]) {
#pragma unroll
    for (int k = 2; k <= N; k <<= 1)
#pragma unroll
        for (int j = k >> 1; j > 0; j >>= 1)
#pragma unroll
            for (int i = 0; i < N; ++i) { const int l = i ^ j; if (l > i) { if ((i & k) == 0) CE_DESC(v[i], v[l]); else CE_DESC(v[l], v[i]); } }
}
template <int N> __device__ __forceinline__ void bitonic_merge_desc(float (&v)[N]) {
#pragma unroll
    for (int j = N >> 1; j > 0; j >>= 1)
#pragma unroll
        for (int i = 0; i < N; ++i) { const int l = i ^ j; if (l > i) CE_DESC(v[i], v[l]); }
}
__device__ __forceinline__ void top16_merge(float (&a)[16], const float (&brev)[16]) {
#pragma unroll
    for (int i = 0; i < 16; ++i) a[i] = fmaxf(a[i], brev[i]);
    bitonic_merge_desc<16>(a);
}
__device__ __forceinline__ float embed_bits(float v, unsigned code, unsigned mask) { return __uint_as_float((__float_as_uint(v) & ~mask) | code); }

__device__ __forceinline__ void phase7(const Params& P, ldsp lds) {
    const int tid0 = threadIdx.x;
    unsigned char* ws = P.ws;
    const bf16_t* qb = (const bf16_t*)(ws + WS_Q); const bf16_t* sk = (const bf16_t*)(ws + WS_SUBK);
    constexpr int LDSK = 136, O_SK = 0, O_SV = 2 * 128 * LDSK * 2, O_EX = O_SV + 32768, O_GT = O_EX + 16384, O_LIST = O_GT + 16384;
    static_assert(O_LIST + 8 * 384 * 4 <= LDS_BYTES - 16, "lds");
    int titer = 0;
    for (int tile = blockIdx.x; tile < 256; tile += gridDim.x, ++titer) {
        int tid = tid0; asm volatile("" : "+v"(tid));
        const int lane = tid & 63, wave = tid >> 6, fr = lane & 15, fq = lane >> 4, fro = fr, fqo = fq;
        const int tok0 = tile * 32, h = wave;
        bf16x8 qn[4];
        auto ldq = [&](int cb) { const bf16_t* qrow = qb + (size_t)(tok0 + 16 * (cb >> 1) + fro) * D + h * 256 + (cb & 1) * 128 + fqo * 8;
#pragma unroll
            for (int ks = 0; ks < 4; ++ks) qn[ks] = *(const bf16x8*)(qrow + ks * 32); };
        ldq(0);
        for (int idx = tid; idx < 2 * 128 * 16; idx += 512) { const int row = idx >> 4, ch = idx & 15;
            *(LAS u32x4*)(lds + O_SK + (row * LDSK + ch * 8) * 2) = *(const u32x4*)(sk + row * 128 + ch * 8); }
        BLOCK_SYNC();
#pragma unroll 1
        for (int cb = 0; cb < 4; ++cb) {
            const int nt = cb >> 1, p = cb & 1;
            f32x4 acc[8];
#pragma unroll
            for (int mt = 0; mt < 8; ++mt) acc[mt] = (f32x4){0.f, 0.f, 0.f, 0.f};
            bf16x8 qc[4];
#pragma unroll
            for (int ks = 0; ks < 4; ++ks) qc[ks] = qn[ks];
            if (cb + 1 < 4) ldq(cb + 1);
#pragma unroll
            for (int ks = 0; ks < 4; ++ks) {
                const bf16x8 bq = qc[ks];
#pragma unroll
                for (int mt = 0; mt < 8; ++mt) acc[mt] = mfma16(*(const LAS bf16x8*)(lds + O_SK + ((p * 128 + 16 * mt + fro) * LDSK + ks * 32 + fqo * 8) * 2), bq, acc[mt]);
            }
            float a[16], b[16];
#pragma unroll
            for (int mt = 0; mt < 4; ++mt) {
                a[4 * mt + 0] = embed_bits(acc[mt].x, 16 * mt + 4 * fq + 0, 127u); a[4 * mt + 1] = embed_bits(acc[mt].y, 16 * mt + 4 * fq + 1, 127u);
                a[4 * mt + 2] = embed_bits(acc[mt].z, 16 * mt + 4 * fq + 2, 127u); a[4 * mt + 3] = embed_bits(acc[mt].w, 16 * mt + 4 * fq + 3, 127u);
                b[4 * mt + 0] = embed_bits(acc[mt + 4].x, 16 * (mt + 4) + 4 * fq + 0, 127u); b[4 * mt + 1] = embed_bits(acc[mt + 4].y, 16 * (mt + 4) + 4 * fq + 1, 127u);
                b[4 * mt + 2] = embed_bits(acc[mt + 4].z, 16 * (mt + 4) + 4 * fq + 2, 127u); b[4 * mt + 3] = embed_bits(acc[mt + 4].w, 16 * (mt + 4) + 4 * fq + 3, 127u);
            }
            bitonic_sort_desc<16>(a); bitonic_sort_desc<16>(b);
            { float br[16];
#pragma unroll
              for (int i = 0; i < 16; ++i) br[i] = b[15 - i];
              top16_merge(a, br); }
#pragma unroll
            for (int x = 16; x <= 32; x <<= 1) { float br[16];
#pragma unroll
                for (int i = 0; i < 16; ++i) br[i] = __shfl_xor(a[15 - i], x);
                top16_merge(a, br); }
            if (fq == 0) { LAS f32x4* o = (LAS f32x4*)(lds + O_SV + ((((16 * nt + fr) * 8 + h) * 2 + p) * 16) * 4);
                o[0] = (f32x4){a[0], a[1], a[2], a[3]}; o[1] = (f32x4){a[4], a[5], a[6], a[7]}; o[2] = (f32x4){a[8], a[9], a[10], a[11]}; o[3] = (f32x4){a[12], a[13], a[14], a[15]}; }
        }
        BLOCK_SYNC();
        if (tid < 256) {
            const int tok = tid >> 3, hh = tid & 7;
            const LAS f32x4* s = (const LAS f32x4*)(lds + O_SV + (((tok * 8 + hh) * 2) * 16) * 4);
            float s0[16], s1[16];
#pragma unroll
            for (int c4 = 0; c4 < 4; ++c4) { const f32x4 x = s[c4], y = s[4 + c4]; s0[4 * c4] = x.x; s0[4 * c4 + 1] = x.y; s0[4 * c4 + 2] = x.z; s0[4 * c4 + 3] = x.w; s1[4 * c4] = y.x; s1[4 * c4 + 1] = y.y; s1[4 * c4 + 2] = y.z; s1[4 * c4 + 3] = y.w; }
            float g0[16], g1[16], g2[16], g3[16];
            const float NEG = -3.0e38f;
#pragma unroll
            for (int bq = 0; bq < 16; ++bq) g0[bq] = embed_bits(s0[0] + s1[bq], bq, 255u);
            {
                int n1 = 0, n2 = 0, n3 = 0;
#pragma unroll
                for (int aa = 1; aa < 16; ++aa)
#pragma unroll
                    for (int bb = 0; bb < 16; ++bb) if ((aa + 1) * (bb + 1) <= 16) {
                        const float c = embed_bits(s0[aa] + s1[bb], aa * 16 + bb, 255u);
                        if (n1 < 16) g1[n1++] = c; else if (n2 < 16) g2[n2++] = c; else g3[n3++] = c;
                    }
#pragma unroll
                for (int i = 0; i < 16; ++i) if (i >= n3) g3[i] = NEG;
            }
            bitonic_sort_desc<16>(g1); bitonic_sort_desc<16>(g2); bitonic_sort_desc<16>(g3);
            { float r1[16], r3[16];
#pragma unroll
              for (int i = 0; i < 16; ++i) { r1[i] = g1[15 - i]; r3[i] = g3[15 - i]; }
              top16_merge(g0, r1); top16_merge(g2, r3);
#pragma unroll
              for (int i = 0; i < 16; ++i) g0[i] = fmaxf(g0[i], g2[15 - i]); }
            float mx = g0[0];
#pragma unroll
            for (int i = 1; i < 16; ++i) mx = fmaxf(mx, g0[i]);
            float ex[16], sm = 0.f; int ee[16];
#pragma unroll
            for (int i = 0; i < 16; ++i) {
                ex[i] = __expf(g0[i] - mx); sm += ex[i];
                const unsigned code = __float_as_uint(g0[i]) & 255u;
                const unsigned i0 = __float_as_uint(*(const LAS float*)(lds + O_SV + ((((tok * 8 + hh) * 2 + 0) * 16) + (code >> 4)) * 4)) & 127u;
                const unsigned i1 = __float_as_uint(*(const LAS float*)(lds + O_SV + ((((tok * 8 + hh) * 2 + 1) * 16) + (code & 15u)) * 4)) & 127u;
                ee[i] = (int)(i0 * 128u + i1);
            }
            const float inv = 1.0f / sm;
            LAS int* eo = (LAS int*)(lds + O_EX) + tok * 128 + hh * 16; LAS float* go = (LAS float*)(lds + O_GT) + tok * 128 + hh * 16;
#pragma unroll
            for (int c4 = 0; c4 < 4; ++c4) {
                *(LAS u32x4*)(eo + 4 * c4) = (u32x4){(unsigned)ee[4 * c4], (unsigned)ee[4 * c4 + 1], (unsigned)ee[4 * c4 + 2], (unsigned)ee[4 * c4 + 3]};
                *(LAS f32x4*)(go + 4 * c4) = (f32x4){ex[4 * c4] * inv, ex[4 * c4 + 1] * inv, ex[4 * c4 + 2] * inv, ex[4 * c4 + 3] * inv};
            }
        }
        BLOCK_SYNC();
        for (int idx = tid; idx < 2048; idx += 512) { const int a = idx >> 9, q4 = idx & 511; const float* src = P.in[a == 0 ? I_LN1G : a == 1 ? I_LN1B : a == 2 ? I_LN2G : I_LN2B];
            *(LAS f32x4*)(lds + O_SK + a * 8192 + q4 * 16) = *(const f32x4*)(src + q4 * 4); }
        BLOCK_SYNC();
#pragma unroll 1
        for (int r = 0; r < 4; ++r) {
            peer_round(P, lds, O_EX, O_GT, O_LIST, O_SK, tok0 + r * 8 + wave, r * 8 + wave);
        }
        BLOCK_SYNC();
    }
}
__global__ __launch_bounds__(512, 2) void hybrid_fwd(Params P) {
    extern __shared__ __attribute__((aligned(16))) unsigned char shm[];
    ldsp lds = (ldsp)shm;
    unsigned char* ws = P.ws;
    volatile LAS unsigned* xst = (volatile LAS unsigned*)(lds + LDS_BYTES - 16);
    if (threadIdx.x == 0) { xst[0] = 0u; xst[1] = 0u; }
    __syncthreads();
    const XcdBarrier xbar = xcd_barrier_post((unsigned*)(ws + WS_BAR), xst);
    const int lo = P.ph_lo, hi = P.ph_hi;
#ifdef REPEAT_PHASE
#define PHASE(k) if (lo <= (k) && (k) < hi) for (int once_ = 0; once_ < ((k) == REPEAT_PHASE ? 2 : 1); ++once_)
#else
#define PHASE(k) if (lo <= (k) && (k) < hi) for (int once_ = 0; once_ < 1; ++once_)
#endif
#ifdef DOUBLE_SEAMS
#define SEAM(k) do { if (lo <= (k) && (k) + 1 < hi) { xcd_barrier(xbar); xcd_barrier(xbar); } } while (0)
#else
#define SEAM(k) do { if (lo <= (k) && (k) + 1 < hi) xcd_barrier(xbar); } while (0)
#endif
#if defined(REPEAT_PHASE) && REPEAT_PHASE == 0
    PHASE(0) { Params Q = P; if (once_) Q.ph_lo = -1; phase0(Q); }
#else
    PHASE(0) phase0(P);
#endif
    SEAM(0);
    PHASE(1) { pg8::EpiBf16<0> E; E.O = (bf16_t*)(ws + WS_P); E.ldc = NPAD; E.bias = nullptr; E.split_cols = 0; E.split_stride = 0;
        run_gemm(lds, (const bf16_t*)(ws + WS_H0B), (const bf16_t*)(ws + WS_WTIN), MROWS, N_BF, 2048, E);
        const int G = (int)gridDim.x, r1 = ((MROWS / 256) * (N_BF / 256)) % G;
        pg8::EpiBf16S E8; E8.O = (bf16_t*)(ws + WS_P) + N_BF; E8.ldc = NPAD; E8.scale = 1.0f / 64.0f;
        run_gemm8(lds, ws + WS_H0B8, ws + WS_WT8, MROWS, N_F8, 2048, E8, (int)((blockIdx.x + G - r1) % G)); }
    SEAM(1);
    PHASE(2) phase2(P, lds);
    SEAM(2);
    PHASE(3) phase3(P);
    SEAM(3);
    PHASE(4) phase3b(P, lds);
    SEAM(4);
    PHASE(5) {
#ifdef P5_F8
        { pg8::EpiGate35T<16> E; E.O = (bf16_t*)(ws + WS_MERGED); E.p = (const bf16_t*)(ws + WS_P); E.bgate = P.in[I_BGATE]; E.oscale = 1.0f / 64.0f;
          run_gemm8(lds, ws + WS_YAB, ws + WS_WTAB8, NTOK, 2048, LDAB, E, (int)blockIdx.x); }
#else
        { pg8::EpiGate35 E; E.O = (bf16_t*)(ws + WS_MERGED); E.p = (const bf16_t*)(ws + WS_P); E.bgate = P.in[I_BGATE]; E.oscale = 1.0f;
          run_gemm(lds, (const bf16_t*)(ws + WS_YAB), (const bf16_t*)(ws + WS_WTAB), NTOK, 2048, LDAB, E); }
#endif
    }
#if defined(DUP_PHASE) && DUP_PHASE == 5
    SEAM(4);
    PHASE(5) {
#ifdef P5_F8
        { pg8::EpiGate35T<16> E; E.O = (bf16_t*)(ws + WS_MERGED); E.p = (const bf16_t*)(ws + WS_P); E.bgate = P.in[I_BGATE]; E.oscale = 1.0f / 64.0f;
          run_gemm8(lds, ws + WS_YAB, ws + WS_WTAB8, NTOK, 2048, LDAB, E, (int)blockIdx.x); }
#else
        { pg8::EpiGate35 E; E.O = (bf16_t*)(ws + WS_MERGED); E.p = (const bf16_t*)(ws + WS_P); E.bgate = P.in[I_BGATE]; E.oscale = 1.0f;
          run_gemm(lds, (const bf16_t*)(ws + WS_YAB), (const bf16_t*)(ws + WS_WTAB), NTOK, 2048, LDAB, E); }
#endif
    }
#endif
    SEAM(5);
    PHASE(6) { pg8::EpiResidStats E; E.O = (bf16_t*)(ws + WS_X1B); E.h0 = (const bf16_t*)(ws + WS_H0B); E.alpha = DN_ALPHA; E.rsum = (float*)(ws + WS_STAT); E.rsq = (float*)(ws + WS_STAT) + 8192;
        E.O8 = ws + WS_X1B8;
#ifdef P6_F8
        E.ascale = 1.0f / 64.0f; run_gemm8(lds, ws + WS_MERGED, ws + WS_WTOUT8, NTOK, 2048, 2048, E, (int)blockIdx.x); }
#else
        E.ascale = 1.0f; run_gemm(lds, (const bf16_t*)(ws + WS_MERGED), (const bf16_t*)(ws + WS_WTOUT), NTOK, 2048, 2048, E); }
#endif
#if defined(DUP_PHASE) && DUP_PHASE == 6
    SEAM(5);
    PHASE(6) { pg8::EpiResidStats E; E.O = (bf16_t*)(ws + WS_X1B); E.h0 = (const bf16_t*)(ws + WS_H0B); E.alpha = DN_ALPHA; E.rsum = (float*)(ws + WS_END); E.rsq = (float*)(ws + WS_END) + 8192;
        run_gemm(lds, (const bf16_t*)(ws + WS_MERGED), (const bf16_t*)(ws + WS_WTOUT), NTOK, 2048, 2048, E); }
#endif
    SEAM(6);
    PHASE(7) { pg8::EpiQ E; E.O = (bf16_t*)(ws + WS_Q); E.rsum = (const float*)(ws + WS_STAT); E.rsq = (const float*)(ws + WS_STAT) + 8192; E.c1 = (const float*)(ws + WS_STAT) + 16384; E.c2 = (const float*)(ws + WS_STAT) + 18432;
#ifdef P7_F8
        E.ascale = 1.0f / 64.0f; run_gemm8(lds, ws + WS_X1B8, ws + WS_WTQ8, NTOK, 2048, 2048, E, (int)blockIdx.x); }
#else
        E.ascale = 1.0f; run_gemm(lds, (const bf16_t*)(ws + WS_X1B), (const bf16_t*)(ws + WS_WTQ), NTOK, 2048, 2048, E); }
#endif
#if defined(DUP_PHASE) && DUP_PHASE == 7
    SEAM(6);
    PHASE(7) { pg8::EpiQ E; E.O = (bf16_t*)(ws + WS_Q); E.rsum = (const float*)(ws + WS_STAT); E.rsq = (const float*)(ws + WS_STAT) + 8192; E.c1 = (const float*)(ws + WS_STAT) + 16384; E.c2 = (const float*)(ws + WS_STAT) + 18432;
        run_gemm(lds, (const bf16_t*)(ws + WS_X1B), (const bf16_t*)(ws + WS_WTQ), NTOK, 2048, 2048, E); }
#endif
    SEAM(7);
    PHASE(8) phase7(P, lds);
#undef PHASE
#undef SEAM
}

extern "C" void kernel_launch(void* const* d_in, const int* in_sizes, int n_in, void* d_out, int out_size, void* d_ws, size_t ws_size, hipStream_t stream) {
    static int grid = 0;
    if (grid == 0) {
        if (n_in != 30 || out_size != NTOK * D || ws_size < WS_END) { fprintf(stderr, "kernel_launch: unexpected shapes (n_in %d, out %d, ws %zu < %zu)\n", n_in, out_size, ws_size, (size_t)WS_END); grid = -1; return; }
        int dev = 0, cus = 0, per_cu = 0;
        if (hipGetDevice(&dev) != hipSuccess || hipDeviceGetAttribute(&cus, hipDeviceAttributeMultiprocessorCount, dev) != hipSuccess) { grid = -1; return; }
        if (hipFuncSetAttribute((const void*)hybrid_fwd, hipFuncAttributeMaxDynamicSharedMemorySize, LDS_BYTES) != hipSuccess) { fprintf(stderr, "kernel_launch: hipFuncSetAttribute failed\n"); grid = -1; return; }
        if (hipOccupancyMaxActiveBlocksPerMultiprocessor(&per_cu, (const void*)hybrid_fwd, 512, LDS_BYTES) != hipSuccess || per_cu < 1) { fprintf(stderr, "kernel_launch: occupancy query says %d\n", per_cu); grid = -1; return; }
        (void)hipGetLastError();
        grid = cus;
    }
    if (grid < 0) return;
    if (hipMemsetAsync((unsigned char*)d_ws + WS_BAR, 0, 16384 + STAT_BYTES, stream) != hipSuccess) { fprintf(stderr, "kernel_launch: memset failed\n"); return; }
    Params p{};
    for (int i = 0; i < 30; ++i) p.in[i] = (const float*)d_in[i];
    p.out = (float*)d_out; p.ws = (unsigned char*)d_ws;
    p.ph_lo = 0; p.ph_hi = NPHASE + 1;
    void* args[] = {&p};
    hipError_t e = hipLaunchCooperativeKernel((const void*)hybrid_fwd, dim3(grid), dim3(512), args, LDS_BYTES, stream);
    if (e != hipSuccess) fprintf(stderr, "kernel_launch: cooperative launch failed: %s (grid %d)\n", hipGetErrorString(e), grid);
}
```

```cpp
#include <hip/hip_runtime.h>
#include <cstdio>
#include <cstdint>
namespace pg8 {
#define PG8_LAS __attribute__((address_space(3)))
typedef unsigned short bf16_t;
typedef short bf16x8 __attribute__((ext_vector_type(8)));
typedef float f32x4 __attribute__((ext_vector_type(4)));
typedef unsigned u32x4 __attribute__((ext_vector_type(4)));
typedef int i32x4f __attribute__((ext_vector_type(4)));
constexpr int BM = 256, BK = 64, HALF = 128, HTB = HALF * BK * 2  , STAGE_BYTES = 8 * HTB, NXCD = 8, WGM = 8;

__host__ __device__ __forceinline__ int lds_byte(int r, int c) { const int st = (r >> 4) * 2 + (c >> 5), rr = r & 15, cc = c & 31, ob = rr * 64 + cc * 2; return st * 1024 + (ob ^ (((ob >> 9) & 1) << 5)); }
__host__ __device__ __forceinline__ void stage_rc(int b, int& R, int& C) { const int st = b / 1024, sb = b % 1024, swz = sb ^ (((sb >> 9) & 1) << 5); R = (st >> 1) * 16 + swz / 64; C = (st & 1) * 32 + (swz % 64) / 2; }
__host__ __device__ __forceinline__ int perm32(int rho) { const int n = rho >> 4, i = rho & 15; return 8 * (i >> 2) + 4 * n + (i & 3); }

struct Unit { int pm, pn; };
struct Gemm { const bf16_t* A; const bf16_t* Bt; int M, N, K; };

struct StaticOrder {
    int nM, nN, nwg, G, c;
    __host__ __device__ void init(int M, int N, int G_, int c_) { nM = M / BM; nN = N / BM; nwg = nM * nN; G = G_; c = c_; }
    __host__ __device__ bool next(int i, Unit& u) const {
        const long L = (long)i * G + c; if (L >= nwg) return false;
        int wgid = (int)L; { const int q = nwg / NXCD, r = nwg % NXCD, xcd = wgid % NXCD, off = wgid / NXCD; wgid = (xcd < r ? xcd * (q + 1) : r * (q + 1) + (xcd - r) * q) + off; }
        const int nig = WGM * nN, gid = wgid / nig, fm = gid * WGM, gsz = (nM - fm) < WGM ? (nM - fm) : WGM;
        u.pm = fm + ((wgid % nig) % gsz); u.pn = (wgid % nig) / gsz; return true;
    }
    __device__ __forceinline__ void a_ready(const Unit&) const {}
    __device__ __forceinline__ void done(const Unit&) const {}
};
struct CountedOrder : StaticOrder {
    const unsigned* ready; unsigned need; unsigned* tmo;
    __device__ __forceinline__ void a_ready(const Unit& u) const {
        if (threadIdx.x < 64) {
            const unsigned long long t0 = __builtin_amdgcn_s_memrealtime(); unsigned polls = 0;
            while ((unsigned)__builtin_amdgcn_readfirstlane(__hip_atomic_load(ready + 64 * u.pm, __ATOMIC_RELAXED, __HIP_MEMORY_SCOPE_AGENT)) < need) {
                if ((++polls & 255u) == 0u && __builtin_amdgcn_readfirstlane(__hip_atomic_load(tmo, __ATOMIC_RELAXED, __HIP_MEMORY_SCOPE_AGENT)) != 0u) break;
                if (__builtin_amdgcn_s_memrealtime() - t0 > 2000000ull) {
                    if (threadIdx.x == 0) { unsigned expect = 0u; __hip_atomic_compare_exchange_strong(tmo + 1, &expect, 0x600u | (unsigned)(u.pm & 0xff), __ATOMIC_RELAXED, __ATOMIC_RELAXED, __HIP_MEMORY_SCOPE_AGENT); __hip_atomic_store(tmo, 1u, __ATOMIC_RELAXED, __HIP_MEMORY_SCOPE_AGENT); }
                    break; }
                __builtin_amdgcn_s_sleep(2); }
            __builtin_amdgcn_fence(__ATOMIC_ACQUIRE, "agent");
            asm volatile("s_waitcnt vmcnt(0)" ::: "memory");
        }
#if !defined(BROKEN_HOOK_NO_BARRIER)
        asm volatile("" ::: "memory"); __builtin_amdgcn_s_barrier(); asm volatile("" ::: "memory");
#endif
    }
};

typedef float cvt_f32x2 __attribute__((ext_vector_type(2))); typedef __bf16 cvt_bf16x2 __attribute__((ext_vector_type(2)));
__device__ __forceinline__ unsigned cvt_pk_bf16(float lo, float hi) { const cvt_f32x2 v = {lo, hi}; const cvt_bf16x2 b = __builtin_convertvector(v, cvt_bf16x2); return __builtin_bit_cast(unsigned, b); }
typedef float f32x2 __attribute__((ext_vector_type(2)));
__device__ __forceinline__ f32x2 gelu_pk(f32x2 v) {
    const f32x2 av = __builtin_elementwise_abs(v), d = av * 0.2316418882f + 1.0f;
    f32x2 t; t.x = __builtin_amdgcn_rcpf(d.x); t.y = __builtin_amdgcn_rcpf(d.y);
    f32x2 q = t * 0.5307027145f + (-0.7265760135f); q = q * t + 0.7107068705f; q = q * t + (-0.142248368f); q = q * t + 0.127414796f; q = q * t;
    const f32x2 s = (v * v) * (-0.72134752044f);
    f32x2 e; e.x = __builtin_amdgcn_exp2f(s.x); e.y = __builtin_amdgcn_exp2f(s.y);
    const f32x2 m = v * (q * e), r = v - m;
    f32x2 o; o.x = v.x < 0.f ? m.x : r.x; o.y = v.y < 0.f ? m.y : r.y; return o;
}

struct EpiF32 {
    static constexpr bool PERM = false, AFTER_DRAIN = false; static constexpr int MID_T = -1;
    float* C; int ldc; const float* bias;
    __device__ __forceinline__ void operator()(const f32x4 (&acc)[2][2][4][2], const Unit& u, int wr, int wc, int fr, int fq) const {
        const int row0 = u.pm * BM + wr * 64 + fr, col0 = u.pn * BM + wc * 32 + 4 * fq;
        f32x4 bv[2][2];
#pragma unroll
        for (int bj = 0; bj < 2; ++bj)
#pragma unroll
            for (int n = 0; n < 2; ++n) bv[bj][n] = bias ? *(const f32x4*)(bias + col0 + bj * HALF + n * 16) : (f32x4){0.f, 0.f, 0.f, 0.f};
#pragma unroll
        for (int ai = 0; ai < 2; ++ai)
#pragma unroll
            for (int m = 0; m < 4; ++m) { float* rowp = C + (size_t)(row0 + ai * HALF + m * 16) * ldc + col0;
#pragma unroll
                for (int bj = 0; bj < 2; ++bj)
#pragma unroll
                    for (int n = 0; n < 2; ++n) *(f32x4*)(rowp + bj * HALF + n * 16) = acc[ai][bj][m][n] + bv[bj][n]; }
    }
};
template <int ACT  > struct EpiBf16 {
    static constexpr bool PERM = true, AFTER_DRAIN = false; static constexpr int MID_T = -1;
    bf16_t* O; int ldc; const float* bias; int split_cols; size_t split_stride;
    __device__ __forceinline__ void operator()(const f32x4 (&acc)[2][2][4][2], const Unit& u, int wr, int wc, int fr, int fq) const {
        const int row0 = u.pm * BM + wr * 64 + fr; int colt = u.pn * BM; bf16_t* base = O;
        if (split_cols) { const int t = colt / split_cols; base += (size_t)t * split_stride; colt -= t * split_cols; }
        const int col0 = colt + wc * 32 + 8 * fq, bcol0 = u.pn * BM + wc * 32 + 8 * fq;
        f32x4 bv[2][2];
#pragma unroll
        for (int bj = 0; bj < 2; ++bj)
#pragma unroll
            for (int n = 0; n < 2; ++n) bv[bj][n] = bias ? *(const f32x4*)(bias + bcol0 + bj * HALF + 4 * n) : (f32x4){0.f, 0.f, 0.f, 0.f};
#pragma unroll
        for (int ai = 0; ai < 2; ++ai)
#pragma unroll
            for (int m = 0; m < 4; ++m) { bf16_t* rowp = base + (size_t)(row0 + ai * HALF + m * 16) * ldc + col0;
#pragma unroll
                for (int bj = 0; bj < 2; ++bj) { f32x4 v0 = acc[ai][bj][m][0] + bv[bj][0], v1 = acc[ai][bj][m][1] + bv[bj][1];
                    if (ACT == 1) { f32x2 a = gelu_pk((f32x2){v0[0], v0[1]}), b = gelu_pk((f32x2){v0[2], v0[3]}), c = gelu_pk((f32x2){v1[0], v1[1]}), d = gelu_pk((f32x2){v1[2], v1[3]});
                        v0 = (f32x4){a.x, a.y, b.x, b.y}; v1 = (f32x4){c.x, c.y, d.x, d.y}; }
                    if (ACT == 2) {
#pragma unroll
                        for (int j = 0; j < 4; ++j) { v0[j] = 0.5f * v0[j] * (1.0f + erff(v0[j] * 0.70710678f)); v1[j] = 0.5f * v1[j] * (1.0f + erff(v1[j] * 0.70710678f)); } }
                    u32x4 w; w.x = cvt_pk_bf16(v0[0], v0[1]); w.y = cvt_pk_bf16(v0[2], v0[3]); w.z = cvt_pk_bf16(v1[0], v1[1]); w.w = cvt_pk_bf16(v1[2], v1[3]);
                    *(u32x4*)(rowp + bj * HALF) = w; } }
    }
};
template <class Epi, class Sched, bool STAMP = false, bool F8 = false>
__device__ __forceinline__ void gemm_phase(PG8_LAS unsigned char* lds, const Gemm g, const Sched& S, const Epi& E, unsigned long long* stamps) {
    const int tid = threadIdx.x, wid = __builtin_amdgcn_readfirstlane(tid >> 6), lane = tid & 63, wr = wid >> 2, wc = wid & 3, fr = lane & 15, fq = lane >> 4;
    const int K = g.K, nt = K / BK;
    int ts_lo = 0, ts_hi = 0, nts = 0; const unsigned long long rt_entry = STAMP ? (unsigned long long)wall_clock64() : 0ull;
#define PG8_STAMP() do { if (STAMP && wid == 0 && nts < 64) { const unsigned long long _c = (unsigned long long)clock64(); \
        ts_lo = (lane == nts) ? (int)(unsigned)_c : ts_lo; ts_hi = (lane == nts) ? (int)(unsigned)(_c >> 32) : ts_hi; ++nts; } } while (0)
    PG8_STAMP();
    unsigned voffA[2], voffB[2];
#pragma unroll
    for (int i = 0; i < 2; ++i) { int R, C; stage_rc(tid * 16 + i * 8192, R, C); const int Rb = Epi::PERM ? ((R & ~31) + perm32(R & 31)) : R;
        voffA[i] = (unsigned)(R * K + C) * 2u; voffB[i] = (unsigned)(Rb * K + C) * 2u; }
    const size_t kstep = (size_t)(BK * 2);
    const size_t hstep = (size_t)HALF * K * 2;
    const size_t tstep = 2 * hstep;
    const unsigned ldsw = (unsigned)wid * 1024u;
    const int aoff = lds_byte(wr * 64 + fr, fq * 8), boff = lds_byte(wc * 32 + fr, fq * 8);
#define PG8_SA(b, h) (((b) * 2 + (h)) * HTB)
#define PG8_SB(b, h) ((4 + (b) * 2 + (h)) * HTB)
#define PG8_STAGE(bufoff, gbase, voff) do { _Pragma("unroll") for (int _i = 0; _i < 2; ++_i) \
        __builtin_amdgcn_global_load_lds((const unsigned*)((const char*)(gbase) + (voff)[_i]), (PG8_LAS unsigned*)(lds + (bufoff) + ldsw + _i * 8192), 16, 0, 0); } while (0)
#define PG8_LDA(dst, b, h) do { if constexpr (F8) { _Pragma("unroll") for (int m = 0; m < 4; ++m) { dst##8[m].lo = *(const PG8_LAS bf16x8*)(lds + PG8_SA(b, h) + aoff + m * 2048); dst##8[m].hi = *(const PG8_LAS bf16x8*)(lds + PG8_SA(b, h) + aoff + m * 2048 + 1024); } } \
    else { _Pragma("unroll") for (int m = 0; m < 4; ++m) _Pragma("unroll") for (int k = 0; k < 2; ++k) dst[m][k] = *(const PG8_LAS bf16x8*)(lds + PG8_SA(b, h) + aoff + m * 2048 + k * 1024); } } while (0)
#define PG8_LDB(dst, b, h) do { if constexpr (F8) { _Pragma("unroll") for (int n = 0; n < 2; ++n) { dst##8[n].lo = *(const PG8_LAS bf16x8*)(lds + PG8_SB(b, h) + boff + n * 2048); dst##8[n].hi = *(const PG8_LAS bf16x8*)(lds + PG8_SB(b, h) + boff + n * 2048 + 1024); } } \
    else { _Pragma("unroll") for (int n = 0; n < 2; ++n) _Pragma("unroll") for (int k = 0; k < 2; ++k) dst[n][k] = *(const PG8_LAS bf16x8*)(lds + PG8_SB(b, h) + boff + n * 2048 + k * 1024); } } while (0)
typedef int i32x8f __attribute__((ext_vector_type(8)));
#define PG8_MMA(ai, bj, At, Bt) do { __builtin_amdgcn_s_setprio(1); \
        if constexpr (F8) { _Pragma("unroll") for (int m = 0; m < 4; ++m) _Pragma("unroll") for (int n = 0; n < 2; ++n) \
            asm volatile("v_mfma_f32_16x16x128_f8f6f4 %0, %1, %2, %0" : "+v"(acc[ai][bj][m][n]) : "v"(Bt##8[n]), "v"(At##8[m])); } \
        else { _Pragma("unroll") for (int m = 0; m < 4; ++m) _Pragma("unroll") for (int n = 0; n < 2; ++n) _Pragma("unroll") for (int k = 0; k < 2; ++k) \
            acc[ai][bj][m][n] = __builtin_amdgcn_mfma_f32_16x16x32_bf16(Bt[n][k], At[m][k], acc[ai][bj][m][n], 0, 0, 0); } \
        __builtin_amdgcn_s_setprio(0); } while (0)
#define PG8_WAIT_V(n) asm volatile("s_waitcnt vmcnt(" #n ")" ::: "memory")
#define PG8_WAIT_L(n) asm volatile("s_waitcnt lgkmcnt(" #n ")" ::: "memory")
#define PG8_BAR __builtin_amdgcn_s_barrier()
#define PG8_SCHED __builtin_amdgcn_sched_barrier(0)
    Unit cur, nxt; int ui = 0;
    if (!S.next(0, cur)) return;
    f32x4 acc[2][2][4][2];
#pragma unroll
    for (int a = 0; a < 2; ++a)
#pragma unroll
        for (int b = 0; b < 2; ++b)
#pragma unroll
            for (int m = 0; m < 4; ++m)
#pragma unroll
                for (int n = 0; n < 2; ++n) acc[a][b][m][n] = (f32x4){0.f, 0.f, 0.f, 0.f};
    bf16x8 At[4][2], B0[2][2], B1[2][2];
    typedef short bf16x16f __attribute__((ext_vector_type(16)));
    bf16x16f At8[4], B08[2], B18[2];
    const char* cA = (const char*)g.A + (size_t)cur.pm * tstep; const char* cB = (const char*)g.Bt + (size_t)cur.pn * tstep;
    S.a_ready(cur);
    PG8_STAGE(PG8_SB(0, 0), cB, voffB); PG8_STAGE(PG8_SA(0, 0), cA, voffA); PG8_STAGE(PG8_SB(0, 1), cB + hstep, voffB); PG8_STAGE(PG8_SA(0, 1), cA + hstep, voffA);
    if (wr == 1) PG8_BAR;
    PG8_WAIT_V(4); PG8_BAR;
    PG8_STAGE(PG8_SB(1, 0), cB + kstep, voffB); PG8_STAGE(PG8_SA(1, 0), cA + kstep, voffA); PG8_STAGE(PG8_SB(1, 1), cB + hstep + kstep, voffB);
    PG8_WAIT_V(6); PG8_BAR;
    PG8_STAMP();
    for (;;) {
        const bool has_next = S.next(ui + 1, nxt);
        const char* nA = has_next ? (const char*)g.A + (size_t)nxt.pm * tstep : cA; const char* nB = has_next ? (const char*)g.Bt + (size_t)nxt.pn * tstep : cB;
        for (int t = 0; t < nt; t += 2) {
            const bool last = (t == nt - 2);
            const char* a1 = cA + (size_t)(t + 1) * kstep;
            const char* a2 = last ? nA : cA + (size_t)(t + 2) * kstep; const char* b2 = last ? nB : cB + (size_t)(t + 2) * kstep;
            const char* a3 = a2 + kstep; const char* b3 = b2 + kstep;
            if (last && has_next) S.a_ready(nxt);
            if constexpr (Epi::MID_T >= 0) { if (t == Epi::MID_T) { if constexpr (F8) asm volatile("s_nop 15\n\ts_nop 15" ::: "memory"); E.mid(acc, cur, wr, wc, fr, fq); } }
            PG8_LDB(B0, 0, 0); PG8_SCHED; PG8_LDA(At, 0, 0); PG8_STAGE(PG8_SA(1, 1), a1 + hstep, voffA);
            PG8_WAIT_L(8); PG8_BAR; PG8_WAIT_L(0); PG8_MMA(0, 0, At, B0); PG8_BAR; PG8_SCHED;
            PG8_LDB(B1, 0, 1); PG8_STAGE(PG8_SB(0, 0), b2, voffB);
            PG8_BAR; PG8_WAIT_L(0); PG8_MMA(0, 1, At, B1); PG8_BAR;
            PG8_LDA(At, 0, 1); PG8_STAGE(PG8_SA(0, 0), a2, voffA);
            PG8_BAR; PG8_WAIT_L(0); PG8_MMA(1, 0, At, B0); PG8_BAR; PG8_SCHED;
            PG8_STAGE(PG8_SB(0, 1), b2 + hstep, voffB);
            PG8_WAIT_V(6); PG8_BAR; PG8_MMA(1, 1, At, B1); PG8_BAR;
            PG8_LDB(B0, 1, 0); PG8_SCHED; PG8_LDA(At, 1, 0); PG8_STAGE(PG8_SA(0, 1), a2 + hstep, voffA);
            PG8_WAIT_L(8); PG8_BAR; PG8_WAIT_L(0); PG8_MMA(0, 0, At, B0); PG8_BAR; PG8_SCHED;
            PG8_LDB(B1, 1, 1); PG8_STAGE(PG8_SB(1, 0), b3, voffB);
            PG8_BAR; PG8_WAIT_L(0); PG8_MMA(0, 1, At, B1); PG8_BAR;
            PG8_LDA(At, 1, 1); PG8_STAGE(PG8_SA(1, 0), a3, voffA);
            PG8_BAR; PG8_WAIT_L(0); PG8_MMA(1, 0, At, B0); PG8_BAR; PG8_SCHED;
            PG8_STAGE(PG8_SB(1, 1), b3 + hstep, voffB);
            PG8_WAIT_V(6); PG8_BAR; PG8_MMA(1, 1, At, B1); PG8_BAR;
        }
        PG8_STAMP();
        if constexpr (F8) asm volatile("s_nop 15\n\ts_nop 15" ::: "memory");
        if constexpr (!Epi::AFTER_DRAIN) { E(acc, cur, wr, wc, fr, fq); S.done(cur); }
        PG8_STAMP();
        if (!has_next) break;
#pragma unroll
        for (int a = 0; a < 2; ++a)
#pragma unroll
            for (int b = 0; b < 2; ++b)
#pragma unroll
                for (int m = 0; m < 4; ++m)
#pragma unroll
                    for (int n = 0; n < 2; ++n) acc[a][b][m][n] = (f32x4){0.f, 0.f, 0.f, 0.f};
        cur = nxt; cA = nA; cB = nB; ++ui;
    }
    PG8_WAIT_V(0);
    if (wr == 0) PG8_BAR;
    PG8_BAR;
    if constexpr (Epi::AFTER_DRAIN) { E.fused(acc, cur, wr, wc, fr, fq, lds, wid, lane); S.done(cur); }
    PG8_STAMP();
    if (STAMP && wid == 0) { stamps[lane] = lane < nts ? (((unsigned long long)(unsigned)ts_hi << 32) | (unsigned)ts_lo) : 0ull;
        if (lane == 62) stamps[62] = rt_entry; if (lane == 63) stamps[63] = (unsigned long long)wall_clock64(); }
#undef PG8_STAMP
#undef PG8_SA
#undef PG8_SB
#undef PG8_STAGE
#undef PG8_LDA
#undef PG8_LDB
#undef PG8_MMA
#undef PG8_WAIT_V
#undef PG8_WAIT_L
#undef PG8_BAR
#undef PG8_SCHED
}
}
#define LAS __attribute__((address_space(3)))
typedef unsigned short bf16_t;
typedef short bf16x8 __attribute__((ext_vector_type(8)));
typedef float f32x4 __attribute__((ext_vector_type(4)));
typedef float f32x2 __attribute__((ext_vector_type(2)));
typedef unsigned u32x4 __attribute__((ext_vector_type(4)));
typedef unsigned u32x2 __attribute__((ext_vector_type(2)));
typedef LAS unsigned char* ldsp;
typedef float f32x32 __attribute__((ext_vector_type(32)));
typedef float f32x16 __attribute__((ext_vector_type(16)));
typedef unsigned u32x6 __attribute__((ext_vector_type(6)));

constexpr int D = 2048, NTOK = 8192, SEQ = 4096, MROWS = 8448, ROW_META = 8192;
constexpr int INC = 11712, NPAD = 11776;
constexpr int M_R = 0, M_K = 2048, M_V = 4096, M_WL = 6144, M_AL = 6240, M_GL = 6336;
constexpr int C_K = 0, C_WL = 2048, C_AL = 2144, C_GL = 2240, C_R = 2560, C_V = 4608, C_POOL = 6656, C_G0 = 7680, C_G1 = 9728;
constexpr int NUNITS = 4128;
constexpr float DSCALE = 0.6065306597126334f;
constexpr float DN_ALPHA = 1.189207115002721f;
constexpr float GN_EPS = 64e-5f, LN_EPS = 1e-5f;

constexpr size_t WS_P = 0;
constexpr size_t WS_H0B = 198967296;
constexpr size_t WS_WTAB = WS_H0B + 34603008;
constexpr size_t WS_WTOUT = WS_WTAB + 12582912;
constexpr size_t WS_WTQ = WS_WTOUT + 8388608;
constexpr size_t WS_WTPOOL = WS_WTQ + 8388608;
constexpr size_t WS_WTW2 = WS_WTPOOL + 524288;
constexpr size_t WS_WTA2 = WS_WTW2 + 393216;
constexpr size_t WS_WTG2 = WS_WTA2 + 393216;
constexpr size_t WS_SUBK = WS_WTG2 + 1048576;
constexpr size_t WS_BONUS = WS_SUBK + 65536;
constexpr size_t WS_REGC = WS_BONUS + 1048576;
constexpr size_t WS_WTIN = WS_REGC;
constexpr size_t UNITB = (size_t)NUNITS * 4096 * 2;
constexpr size_t WS_G = WS_REGC;
constexpr size_t WS_H0T = WS_REGC + UNITB;
constexpr size_t WS_RT = WS_REGC + 2 * UNITB;
constexpr size_t WS_Y0 = WS_REGC + 3 * UNITB;
constexpr size_t WS_S0T = WS_REGC + 4 * UNITB;
constexpr size_t WS_YAB = WS_REGC;
constexpr int LDAB = 3072;
constexpr size_t WS_MERGED = WS_REGC + 2 * UNITB;
constexpr size_t WS_X1B = WS_REGC + 3 * UNITB;
constexpr size_t WS_Q = WS_REGC + UNITB;
constexpr size_t TROW = 1536;
constexpr size_t EROW = 2048;
constexpr size_t WS_VB = WS_REGC + 5 * UNITB;
constexpr size_t WS_GSIG = WS_VB + 16384 * EROW;
constexpr size_t WS_BAR = WS_GSIG + 4194304;
constexpr size_t WS_STAT = WS_BAR + 16384;
constexpr size_t STAT_BYTES = (8192 * 2 + 2048 * 2) * 4 + 4096;
constexpr size_t WS_TSC = WS_STAT + STAT_BYTES;
constexpr size_t UROW = 1024;
constexpr size_t WS_UB = WS_TSC + 131072;
constexpr int N_BF = 2560, N_F8 = NPAD - N_BF;
constexpr size_t WS_H0B8 = WS_UB;
constexpr size_t WS_WT8 = WS_H0B8 + (size_t)MROWS * 2048;
constexpr size_t WS_WTAB8 = WS_WT8 + (size_t)N_F8 * 2048;
constexpr size_t WS_WTOUT8 = WS_WTAB8 + (size_t)2048 * 3072;
constexpr size_t WS_WTQ8 = WS_WTOUT8 + (size_t)2048 * 2048;
constexpr size_t WS_X1B8 = WS_YAB;
constexpr size_t WS_END = WS_WTQ8 + (size_t)2048 * 2048;
#define P6_F8 1
#define P5_F8 1
static_assert(WS_YAB + 50331648 <= WS_MERGED, "overlay");

constexpr int LDS_BYTES = 163840;
constexpr int NPHASE = 8;

struct Params {
    const float* in[30];
    float* out;
    unsigned char* ws;
    int ph_lo, ph_hi;
};
enum { I_X = 0, I_META, I_LNIN_G, I_LNIN_B, I_WIN, I_MU, I_W0, I_WW2, I_A0, I_WA2, I_WG2, I_KK, I_KA, I_RK, I_GNG, I_GNB, I_WPOOL, I_PSCALE, I_BGATE,
       I_WBA, I_WBB, I_WOUT, I_LN1G, I_LN1B, I_WQ, I_SUBK, I_UT, I_VT, I_LN2G, I_LN2B };

__device__ __forceinline__ unsigned pk2(float lo, float hi) { return pg8::cvt_pk_bf16(lo, hi); }
__device__ __forceinline__ float bflo(unsigned w) { return __uint_as_float(w << 16); }
__device__ __forceinline__ float bfhi(unsigned w) { return __uint_as_float(w & 0xffff0000u); }
__device__ __forceinline__ float bf1(bf16_t h) { return __uint_as_float(((unsigned)h) << 16); }
__device__ __forceinline__ bf16_t f2bf1(float f) { return (bf16_t)(pk2(f, f) & 0xffffu); }
__device__ __forceinline__ float wave_sum(float v) {
#pragma unroll
    for (int o = 1; o < 64; o <<= 1) v += __shfl_xor(v, o);
    return v;
}
__device__ __forceinline__ float sigmoidf_(float x) { return 1.0f / (1.0f + __expf(-x)); }
__device__ __forceinline__ f32x4 mfma16(bf16x8 a, bf16x8 b, f32x4 c) { return __builtin_amdgcn_mfma_f32_16x16x32_bf16(a, b, c, 0, 0, 0); }
__device__ __forceinline__ void unpack8(const u32x4 w, float* f) {
    f[0] = bflo(w.x); f[1] = bfhi(w.x); f[2] = bflo(w.y); f[3] = bfhi(w.y); f[4] = bflo(w.z); f[5] = bfhi(w.z); f[6] = bflo(w.w); f[7] = bfhi(w.w);
}
__device__ __forceinline__ u32x4 pack8(const float* f) { u32x4 w; w.x = pk2(f[0], f[1]); w.y = pk2(f[2], f[3]); w.z = pk2(f[4], f[5]); w.w = pk2(f[6], f[7]); return w; }
#define DPPF(v, ctrl) __builtin_bit_cast(float, __builtin_amdgcn_update_dpp(0, __builtin_bit_cast(int, (v)), (ctrl), 0xF, 0xF, true))
__device__ __forceinline__ float readlane_f(float v, int l) { return __builtin_bit_cast(float, __builtin_amdgcn_readlane(__builtin_bit_cast(int, v), l)); }
__device__ __forceinline__ float wave_sum_dpp(float v) {
    v += DPPF(v, 0xB1); v += DPPF(v, 0x4E); v += DPPF(v, 0x141); v += DPPF(v, 0x140);
    return (readlane_f(v, 0) + readlane_f(v, 16)) + (readlane_f(v, 32) + readlane_f(v, 48));
}
__device__ __forceinline__ float wave_max_dpp(float v) {
    v = fmaxf(v, DPPF(v, 0xB1)); v = fmaxf(v, DPPF(v, 0x4E)); v = fmaxf(v, DPPF(v, 0x141)); v = fmaxf(v, DPPF(v, 0x140));
    return fmaxf(fmaxf(readlane_f(v, 0), readlane_f(v, 16)), fmaxf(readlane_f(v, 32), readlane_f(v, 48)));
}
#define BLOCK_SYNC() __syncthreads()

#ifdef FP8_EMU
__device__ __forceinline__ void emu8(float& a, float& b, float sc) { const int pk = __builtin_amdgcn_cvt_pk_fp8_f32(a * sc, b * sc, 0, false); const auto r = __builtin_amdgcn_cvt_pk_f32_fp8(pk, false); a = r[0] / sc; b = r[1] / sc; }
__device__ __forceinline__ void emu8v(f32x4& o, float sc) { float a = o.x, b = o.y, c = o.z, d = o.w; emu8(a, b, sc); emu8(c, d, sc); o = (f32x4){a, b, c, d}; }
#endif
#define XB_TMO      128
#define XB_XCNT(j)  (256  + 64 * (j))
#define XB_XSUB(j)  (1280 + 64 * (j))
#define XB_XGEN(j)  (2304 + 64 * (j))
#define XB_TOP      3328
#define XB_TOPGEN   3392
#define XCD_BAR_WORDS 3456
#define XB_SPIN_CAP (1u << 18)

__device__ __forceinline__ unsigned xb_ld(unsigned* p)              { return __hip_atomic_load(p, __ATOMIC_RELAXED, __HIP_MEMORY_SCOPE_AGENT); }
__device__ __forceinline__ unsigned xb_add(unsigned* p, unsigned v) { return __hip_atomic_fetch_add(p, v, __ATOMIC_RELAXED, __HIP_MEMORY_SCOPE_AGENT); }
__device__ __forceinline__ unsigned xb_xcc_id() { return (unsigned)__builtin_amdgcn_s_getreg((3 << 11) | 20) & 0xFu; }
#define XB_SPIN(cond, bar) do { unsigned _sp = 0; while (cond) { __builtin_amdgcn_s_sleep(1); \
    if ((++_sp & 255u) == 0u) { if (xb_ld(&(bar)[XB_TMO])) break; if (_sp > XB_SPIN_CAP) { atomicAdd(&(bar)[XB_TMO], 1u); break; } } } } while (0)

struct XcdBarrier {
    unsigned* bar; unsigned x;
    volatile LAS unsigned* st;
};

__device__ __forceinline__ XcdBarrier xcd_barrier_post(unsigned* bar, volatile LAS unsigned* st) {
    XcdBarrier b; b.bar = bar; b.x = xb_xcc_id(); b.st = st;
    if (threadIdx.x == 0) (void)xb_add(&bar[XB_XCNT(b.x)], 1u);
    return b;
}
__device__ __forceinline__ void xcd_barrier_complete(unsigned* bar, unsigned x, unsigned& nloc, unsigned& nx) {
    const unsigned G = gridDim.x * gridDim.y * gridDim.z;
    unsigned sum, cnt, mine, sp = 0u;
    for (;;) {
        sum = 0u; cnt = 0u; mine = 0u;
#pragma unroll
        for (unsigned j = 0; j < 16; ++j) { const unsigned c = xb_ld(&bar[XB_XCNT(j)]); sum += c; cnt += (c > 0u) ? 1u : 0u; mine = (j == x) ? c : mine; }
        if (sum == G) break;
        __builtin_amdgcn_s_sleep(1);
        if ((++sp & 255u) == 0u) { if (xb_ld(&bar[XB_TMO])) break; if (sp > XB_SPIN_CAP) { atomicAdd(&bar[XB_TMO], 1u); break; } }
    }
    nloc = mine > 0u ? mine : 1u; nx = cnt > 0u ? cnt : 1u;
}

__device__ __forceinline__ void xcd_barrier(const XcdBarrier& b) {
    asm volatile("s_waitcnt vmcnt(0)" ::: "memory");
    __syncthreads();
    if (threadIdx.x == 0) {
        unsigned* bar = b.bar;
        __builtin_amdgcn_s_waitcnt(0);
        unsigned nloc = b.st[0], nx = b.st[1];
        if (nloc == 0u) { xcd_barrier_complete(bar, b.x, nloc, nx); b.st[0] = nloc; b.st[1] = nx; }
        const unsigned old = xb_add(&bar[XB_XSUB(b.x)], 1u);
        const unsigned gen = old / nloc;
        if (old + 1u == (gen + 1u) * nloc) {
            __builtin_amdgcn_fence(__ATOMIC_RELEASE, "agent");
            asm volatile("s_waitcnt vmcnt(0)" ::: "memory");
            const unsigned og = xb_add(&bar[XB_TOP], 1u);
            const unsigned tg = og / nx;
            if (og + 1u == (tg + 1u) * nx) xb_add(&bar[XB_TOPGEN], 1u);
            else XB_SPIN(xb_ld(&bar[XB_TOPGEN]) == tg, bar);
            __builtin_amdgcn_fence(__ATOMIC_ACQUIRE, "agent");
            xb_add(&bar[XB_XGEN(b.x)], 1u);
            asm volatile("s_waitcnt vmcnt(0)" ::: "memory");
        } else {
            XB_SPIN(xb_ld(&bar[XB_XGEN(b.x)]) == gen, bar);
            __builtin_amdgcn_fence(__ATOMIC_ACQUIRE, "agent");
            asm volatile("s_waitcnt vmcnt(0)" ::: "memory");
        }
    }
    __syncthreads();
}

#ifdef FP8_EMU
#define EMU_W5 ((FP8_EMU & 1) != 0)
#define EMU_W6 ((FP8_EMU & 2) != 0)
#else
#define EMU_W5 false
#define EMU_W6 false
#endif
__device__ __forceinline__ void ln_row_bf16(const float* src, const float* g, const float* b, bf16_t* dst, int lane) {
    f32x4 v[8]; float s = 0.f;
#pragma unroll
    for (int j = 0; j < 8; ++j) { v[j] = ((const f32x4*)src)[lane + 64 * j]; s += (v[j].x + v[j].y) + (v[j].z + v[j].w); }
    const float mean = wave_sum(s) * (1.0f / D); float s2 = 0.f;
#pragma unroll
    for (int j = 0; j < 8; ++j) { v[j] = v[j] - mean; s2 += (v[j].x * v[j].x + v[j].y * v[j].y) + (v[j].z * v[j].z + v[j].w * v[j].w); }
    const float rstd = 1.0f / sqrtf(wave_sum(s2) * (1.0f / D) + LN_EPS);
#pragma unroll
    for (int j = 0; j < 8; ++j) {
        const f32x4 gg = ((const f32x4*)g)[lane + 64 * j], bb = ((const f32x4*)b)[lane + 64 * j];
        const f32x4 o = v[j] * rstd * gg + bb;
        u32x2 w; w.x = pk2(o.x, o.y); w.y = pk2(o.z, o.w);
        ((u32x2*)dst)[lane + 64 * j] = w;
    }
}
__device__ __forceinline__ void transpose_item(const float* W, int K, int N, int Npad, bf16_t* Wt, int item, int lane, int ldw = 0) {
    const int nblk = Npad >> 6, kb = item / nblk, nb = item - kb * nblk, n = nb * 64 + lane, k0 = kb * 32;
    float v[32];
    if (n < N) {
#pragma unroll
        for (int i = 0; i < 32; ++i) v[i] = W[(size_t)(k0 + i) * N + n];
    } else {
#pragma unroll
        for (int i = 0; i < 32; ++i) v[i] = 0.f;
    }
    u32x4* o = (u32x4*)(Wt + (size_t)n * (ldw ? ldw : K) + k0);
#pragma unroll
    for (int c = 0; c < 4; ++c) { u32x4 w; w.x = pk2(v[8 * c], v[8 * c + 1]); w.y = pk2(v[8 * c + 2], v[8 * c + 3]); w.z = pk2(v[8 * c + 4], v[8 * c + 5]); w.w = pk2(v[8 * c + 6], v[8 * c + 7]); o[c] = w; }
}
__device__ __forceinline__ unsigned pk4_fp8(float a, float b, float c, float d);
__device__ __forceinline__ void transpose_item_q(const float* W, const float* g, const float* b, bf16_t* Wt, float* c1, float* c2, int item, int lane, unsigned char* Wt8 = nullptr) {
    const int kb = item >> 5, nb = item & 31, n = nb * 64 + lane, k0 = kb * 32;
    float v[32], s1 = 0.f, s2 = 0.f;
#pragma unroll
    for (int i = 0; i < 32; ++i) { const float w = W[(size_t)(k0 + i) * 2048 + n]; const float gw = g[k0 + i] * w; s1 += gw; s2 += b[k0 + i] * w; v[i] = gw; }
    if (Wt8) {
        unsigned w[8]; s1 = 0.f;
#pragma unroll
        for (int c = 0; c < 8; ++c) { w[c] = pk4_fp8(64.f * v[4 * c], 64.f * v[4 * c + 1], 64.f * v[4 * c + 2], 64.f * v[4 * c + 3]);
            const auto lo2 = __builtin_amdgcn_cvt_pk_f32_fp8((int)w[c], false), hi2 = __builtin_amdgcn_cvt_pk_f32_fp8((int)w[c], true); s1 += (lo2[0] + lo2[1]) + (hi2[0] + hi2[1]); }
        s1 *= (1.0f / 64.0f);
        u32x4* o8 = (u32x4*)(Wt8 + (size_t)n * 2048 + k0);
        o8[0] = (u32x4){w[0], w[1], w[2], w[3]}; o8[1] = (u32x4){w[4], w[5], w[6], w[7]};
    } else {
    u32x4* o = (u32x4*)(Wt + (size_t)n * 2048 + k0);
#pragma unroll
    for (int c = 0; c < 4; ++c) { u32x4 w; w.x = pk2(v[8 * c], v[8 * c + 1]); w.y = pk2(v[8 * c + 2], v[8 * c + 3]); w.z = pk2(v[8 * c + 4], v[8 * c + 5]); w.w = pk2(v[8 * c + 6], v[8 * c + 7]); o[c] = w; }
    }
    atomicAdd(c1 + n, s1); atomicAdd(c2 + n, s2);
}
__device__ __forceinline__ unsigned pk4_fp8(float a, float b, float c, float d) {
    int w = __builtin_amdgcn_cvt_pk_fp8_f32(a, b, 0, false); w = __builtin_amdgcn_cvt_pk_fp8_f32(c, d, w, true); return (unsigned)w; }
__device__ __forceinline__ void transpose_item64(const float* W, int K, int N, int Npad, bf16_t* Wt, int ldw, int item, int lane, unsigned char* Wt8 = nullptr, int n8 = 1 << 30, bool emu = false, int ld8 = 2048, int ldsrc = 0) {
    const int nblk = Npad >> 6, kb = item / nblk, nb = item - kb * nblk, n = nb * 64 + lane, k0 = kb * 64;
    float v[64];
    if (n < N) {
#pragma unroll
        for (int i = 0; i < 64; ++i) v[i] = W[(size_t)(k0 + i) * (ldsrc ? ldsrc : N) + n];
    } else {
#pragma unroll
        for (int i = 0; i < 64; ++i) v[i] = 0.f;
    }
#ifdef FP8_EMU
    if (emu) {
#pragma unroll
        for (int i = 0; i < 64; i += 2) emu8(v[i], v[i + 1], 64.0f); }
#endif
    if (n >= n8) {
        u32x4* o8 = (u32x4*)(Wt8 + (size_t)(n - n8) * ld8 + k0);
#pragma unroll
        for (int c = 0; c < 4; ++c) { u32x4 w; w.x = pk4_fp8(64.f * v[16 * c], 64.f * v[16 * c + 1], 64.f * v[16 * c + 2], 64.f * v[16 * c + 3]); w.y = pk4_fp8(64.f * v[16 * c + 4], 64.f * v[16 * c + 5], 64.f * v[16 * c + 6], 64.f * v[16 * c + 7]);
            w.z = pk4_fp8(64.f * v[16 * c + 8], 64.f * v[16 * c + 9], 64.f * v[16 * c + 10], 64.f * v[16 * c + 11]); w.w = pk4_fp8(64.f * v[16 * c + 12], 64.f * v[16 * c + 13], 64.f * v[16 * c + 14], 64.f * v[16 * c + 15]); o8[c] = w; }
        return;
    }
    u32x4* o = (u32x4*)(Wt + (size_t)n * ldw + k0);
#pragma unroll
    for (int c = 0; c < 8; ++c) { u32x4 w; w.x = pk2(v[8 * c], v[8 * c + 1]); w.y = pk2(v[8 * c + 2], v[8 * c + 3]); w.z = pk2(v[8 * c + 4], v[8 * c + 5]); w.w = pk2(v[8 * c + 6], v[8 * c + 7]); o[c] = w; }
}
__device__ __forceinline__ void phase0(const Params& P) {
    const int lane = threadIdx.x & 63, wave = threadIdx.x >> 6;
    const int gw = blockIdx.x * 8 + wave, NGW = gridDim.x * 8;
    unsigned char* ws = P.ws;
    constexpr int T_IN = 32 * 184, T_A = 32 * 32, T_B = 16 * 32, T_O = 32 * 32, T_Q = 64 * 32, T_POOL = 4 * 32, T_W2 = 3 * 32, T_A2 = 3 * 32, T_G2 = 8 * 32;
    constexpr int T_LN = MROWS, T_SK = 64;
    constexpr int NIT = T_IN + T_A + T_B + T_O + T_Q + T_POOL + T_W2 + T_A2 + T_G2 + T_SK;
    for (int it = gw; it < NIT; it += NGW) {
        int r = it;
        if (r < T_IN) {
            const int nb = r % (NPAD >> 6), n0 = nb * 64;
            const int coff = n0 < 2048 ? 2048 : n0 < 2496 ? 4096 : n0 < 2560 ? -(1 << 20) : n0 < 4608 ? -2560 : n0 < 6656 ? -512 : -64;
            transpose_item64(P.in[I_WIN] + (coff > -(1 << 20) ? coff : 0), 2048, coff > -(1 << 20) ? INC - coff : 0, NPAD, (bf16_t*)(ws + WS_WTIN), 2048, r, lane, ws + WS_WT8, N_BF, false, 2048, INC); continue; }
        r -= T_IN;
        if (r < T_A) {
#ifdef P5_F8
            transpose_item64(P.in[I_WBA], 2048, 2048, 2048, nullptr, LDAB, r, lane, ws + WS_WTAB8, 0, false, LDAB); continue; }
#else
            transpose_item64(P.in[I_WBA], 2048, 2048, 2048, (bf16_t*)(ws + WS_WTAB), LDAB, r, lane, nullptr, 1 << 30, EMU_W5); continue; }
#endif
        r -= T_A;
        if (r < T_B) {
#ifdef P5_F8
            transpose_item64(P.in[I_WBB], 1024, 2048, 2048, nullptr, LDAB, r, lane, ws + WS_WTAB8 + 2048, 0, false, LDAB); continue; }
#else
            transpose_item64(P.in[I_WBB], 1024, 2048, 2048, (bf16_t*)(ws + WS_WTAB) + 2048, LDAB, r, lane, nullptr, 1 << 30, EMU_W5); continue; }
#endif
        r -= T_B;
        if (r < T_O) {
#ifdef P6_F8
            transpose_item64(P.in[I_WOUT], 2048, 2048, 2048, nullptr, 2048, r, lane, ws + WS_WTOUT8, 0, false, 2048); continue; }
#else
            transpose_item64(P.in[I_WOUT], 2048, 2048, 2048, (bf16_t*)(ws + WS_WTOUT), 2048, r, lane, nullptr, 1 << 30, EMU_W6); continue; }
#endif
        r -= T_O;
        if (r < T_Q) {
#ifdef REPEAT_PHASE
            float* st = (float*)(ws + (P.ph_lo < 0 ? WS_END : WS_STAT));
#else
            float* st = (float*)(ws + WS_STAT);
#endif
#ifdef P7_F8
            transpose_item_q(P.in[I_WQ], P.in[I_LN1G], P.in[I_LN1B], nullptr, st + 16384, st + 18432, r, lane, ws + WS_WTQ8); continue; }
#else
            transpose_item_q(P.in[I_WQ], P.in[I_LN1G], P.in[I_LN1B], (bf16_t*)(ws + WS_WTQ), st + 16384, st + 18432, r, lane); continue; }
#endif
        r -= T_Q;
        if (r < T_POOL) { const int g = r >> 5; transpose_item(P.in[I_WPOOL] + g * 65536, 256, 256, 256, (bf16_t*)(ws + WS_WTPOOL) + g * 65536, r & 31, lane); continue; } r -= T_POOL;
        if (r < T_W2) { transpose_item(P.in[I_WW2], 96, 2048, 2048, (bf16_t*)(ws + WS_WTW2), r, lane); continue; } r -= T_W2;
        if (r < T_A2) { transpose_item(P.in[I_WA2], 96, 2048, 2048, (bf16_t*)(ws + WS_WTA2), r, lane); continue; } r -= T_A2;
        if (r < T_G2) { transpose_item(P.in[I_WG2], 256, 2048, 2048, (bf16_t*)(ws + WS_WTG2), r, lane); continue; } r -= T_G2;
        {
            const float* s = P.in[I_SUBK] + r * 512 + lane * 8; float f[8];
#pragma unroll
            for (int i = 0; i < 8; ++i) f[i] = s[i];
            *(u32x4*)((bf16_t*)(ws + WS_SUBK) + r * 512 + lane * 8) = pack8(f);
        }
    }
    {
        f32x4 gg[8], bb[8];
#pragma unroll
        for (int j = 0; j < 8; ++j) { gg[j] = ((const f32x4*)P.in[I_LNIN_G])[lane + 64 * j]; bb[j] = ((const f32x4*)P.in[I_LNIN_B])[lane + 64 * j]; }
        auto srcrow = [&](int r) -> const float* { return r < NTOK ? P.in[I_X] + (size_t)r * D : P.in[I_META] + (size_t)(r - NTOK) * D; };
        auto finish = [&](int r, f32x4 (&v)[8]) {
            float s = 0.f;
#pragma unroll
            for (int j = 0; j < 8; ++j) s += (v[j].x + v[j].y) + (v[j].z + v[j].w);
            const float mean = wave_sum_dpp(s) * (1.0f / D); float s2 = 0.f;
#pragma unroll
            for (int j = 0; j < 8; ++j) { v[j] = v[j] - mean; s2 += (v[j].x * v[j].x + v[j].y * v[j].y) + (v[j].z * v[j].z + v[j].w * v[j].w); }
            const float rstd = 1.0f / sqrtf(wave_sum_dpp(s2) * (1.0f / D) + LN_EPS);
            bf16_t* dst = (bf16_t*)(ws + WS_H0B) + (size_t)r * D;
            unsigned* dst8 = (unsigned*)(ws + WS_H0B8 + (size_t)r * 2048);
#pragma unroll
            for (int j = 0; j < 8; ++j) { const f32x4 o = v[j] * rstd * gg[j] + bb[j]; u32x2 w; w.x = pk2(o.x, o.y); w.y = pk2(o.z, o.w); ((u32x2*)dst)[lane + 64 * j] = w;
                dst8[lane + 64 * j] = pk4_fp8(o.x, o.y, o.z, o.w); }
        };
        for (int r = gw; r < NTOK + 16; r += 2 * NGW) {
            const int r2 = r + NGW; const bool has2 = r2 < NTOK + 16;
            f32x4 v1[8], v2[8];
#pragma unroll
            for (int j = 0; j < 8; ++j) v1[j] = ((const f32x4*)srcrow(r))[lane + 64 * j];
#pragma unroll
            for (int j = 0; j < 8; ++j) v2[j] = ((const f32x4*)srcrow(has2 ? r2 : r))[lane + 64 * j];
            finish(r, v1); if (has2) finish(r2, v2);
        }
        for (int r = NTOK + 16 + gw; r < MROWS; r += NGW) { bf16_t* dst = (bf16_t*)(ws + WS_H0B) + (size_t)r * D; unsigned* dst8 = (unsigned*)(ws + WS_H0B8 + (size_t)r * 2048);
#pragma unroll
            for (int j = 0; j < 8; ++j) { ((u32x2*)dst)[lane + 64 * j] = (u32x2){0u, 0u}; dst8[lane + 64 * j] = 0u; } }
    }
}
namespace pg8 {
constexpr float LN_EPS_ = 1e-5f;
struct EpiBf16S {
    static constexpr bool PERM = true, AFTER_DRAIN = false; static constexpr int MID_T = -1;
    bf16_t* O; int ldc; float scale;
    __device__ __forceinline__ void operator()(const f32x4 (&acc)[2][2][4][2], const Unit& u, int wr, int wc, int fr, int fq) const {
        const int row0 = u.pm * BM + wr * 64 + fr, col0 = u.pn * BM + wc * 32 + 8 * fq;
#pragma unroll
        for (int ai = 0; ai < 2; ++ai)
#pragma unroll
            for (int m = 0; m < 4; ++m) { bf16_t* rowp = O + (size_t)(row0 + ai * HALF + m * 16) * ldc + col0;
#pragma unroll
                for (int bj = 0; bj < 2; ++bj) { const f32x4 v0 = acc[ai][bj][m][0] * scale, v1 = acc[ai][bj][m][1] * scale;
                    u32x4 w; w.x = cvt_pk_bf16(v0[0], v0[1]); w.y = cvt_pk_bf16(v0[2], v0[3]); w.z = cvt_pk_bf16(v1[0], v1[1]); w.w = cvt_pk_bf16(v1[2], v1[3]);
                    *(u32x4*)(rowp + bj * HALF) = w; } }
    }
};
template <int MIDT> struct EpiGate35T {
    static constexpr bool PERM = false, AFTER_DRAIN = false; static constexpr int MID_T = MIDT;
    bf16_t* O; const bf16_t* p; const float* bgate; float oscale;
    __device__ __forceinline__ void mid(f32x4 (&acc)[2][2][4][2], const Unit& u, int wr, int wc, int fr, int fq) const {
        asm volatile("" : "+v"(fr), "+v"(fq));
        const int row0 = u.pm * BM + wr * 64 + fr, col0 = u.pn * BM + wc * 32 + 4 * fq;
        f32x4 b0[2][2], b1[2][2];
#pragma unroll
        for (int bj = 0; bj < 2; ++bj)
#pragma unroll
            for (int n = 0; n < 2; ++n) { const int col = col0 + bj * HALF + n * 16; b0[bj][n] = *(const f32x4*)(bgate + col); b1[bj][n] = *(const f32x4*)(bgate + D + col); }
        u32x2 pa[2][2][2], pb[2][2][2];
        auto ld = [&](int g, u32x2 (&pp)[2][2][2]) { const size_t row = (size_t)(row0 + (g >> 2) * HALF + (g & 3) * 16);
#pragma unroll
            for (int bj = 0; bj < 2; ++bj)
#pragma unroll
                for (int n = 0; n < 2; ++n) { const int col = col0 + bj * HALF + n * 16; pp[bj][n][0] = *(const u32x2*)(p + row * NPAD + C_G0 + col); pp[bj][n][1] = *(const u32x2*)(p + row * NPAD + C_G1 + col); } };
        auto ap = [&](int g, const u32x2 (&pp)[2][2][2]) { const int ai = g >> 2, m = g & 3;
#pragma unroll
            for (int bj = 0; bj < 2; ++bj)
#pragma unroll
                for (int n = 0; n < 2; ++n) { const u32x2 p0 = pp[bj][n][0], p1 = pp[bj][n][1]; const f32x4 c0 = b0[bj][n], c1 = b1[bj][n];
                    f32x4 r;
                    r.x = (1.0f + __expf(-fmaxf(bflo(p1.x) + c1.x, -80.f))) * __builtin_amdgcn_rcpf(1.0f + __expf(-(bflo(p0.x) + c0.x)));
                    r.y = (1.0f + __expf(-fmaxf(bfhi(p1.x) + c1.y, -80.f))) * __builtin_amdgcn_rcpf(1.0f + __expf(-(bfhi(p0.x) + c0.y)));
                    r.z = (1.0f + __expf(-fmaxf(bflo(p1.y) + c1.z, -80.f))) * __builtin_amdgcn_rcpf(1.0f + __expf(-(bflo(p0.y) + c0.z)));
                    r.w = (1.0f + __expf(-fmaxf(bfhi(p1.y) + c1.w, -80.f))) * __builtin_amdgcn_rcpf(1.0f + __expf(-(bfhi(p0.y) + c0.w)));
                    acc[ai][bj][m][n] = acc[ai][bj][m][n] * r; } };
        ld(0, pa);
#pragma unroll
        for (int g = 0; g < 8; g += 2) { ld(g + 1, pb); ap(g, pa); if (g + 2 < 8) ld(g + 2, pa); ap(g + 1, pb); }
    }
    __device__ __forceinline__ void operator()(const f32x4 (&acc)[2][2][4][2], const Unit& u, int wr, int wc, int fr, int fq) const {
        const int row0 = u.pm * BM + wr * 64 + fr, col0 = u.pn * BM + wc * 32 + 4 * fq;
#pragma unroll
        for (int ai = 0; ai < 2; ++ai)
#pragma unroll
            for (int m = 0; m < 4; ++m) { const size_t row = (size_t)(row0 + ai * HALF + m * 16);
#pragma unroll
                for (int bj = 0; bj < 2; ++bj)
#pragma unroll
                    for (int n = 0; n < 2; ++n) { const int col = col0 + bj * HALF + n * 16;
                        const u32x2 p1 = *(const u32x2*)(p + row * NPAD + C_G1 + col); const f32x4 b1 = *(const f32x4*)(bgate + D + col);
                        f32x4 g;
                        g.x = __builtin_amdgcn_rcpf(1.0f + __expf(-fmaxf(bflo(p1.x) + b1.x, -80.f))); g.y = __builtin_amdgcn_rcpf(1.0f + __expf(-fmaxf(bfhi(p1.x) + b1.y, -80.f)));
                        g.z = __builtin_amdgcn_rcpf(1.0f + __expf(-fmaxf(bflo(p1.y) + b1.z, -80.f))); g.w = __builtin_amdgcn_rcpf(1.0f + __expf(-fmaxf(bfhi(p1.y) + b1.w, -80.f)));
                        const f32x4 o = acc[ai][bj][m][n] * (g * oscale);
#ifdef P6_F8
                        *(unsigned*)((unsigned char*)O + row * D + col) = pk4_fp8(o.x, o.y, o.z, o.w); } }
#else
                        u32x2 w; w.x = cvt_pk_bf16(o.x, o.y); w.y = cvt_pk_bf16(o.z, o.w);
                        *(u32x2*)(O + row * D + col) = w; } }
#endif
    }
};
typedef EpiGate35T<32> EpiGate35;
struct EpiResidStats {
    static constexpr bool PERM = false, AFTER_DRAIN = false; static constexpr int MID_T = -1;
    bf16_t* O; const bf16_t* h0; float alpha; float* rsum; float* rsq; float ascale; unsigned char* O8;
    __device__ __forceinline__ void operator()(const f32x4 (&acc)[2][2][4][2], const Unit& u, int wr, int wc, int fr, int fq) const {
        const int row0 = u.pm * BM + wr * 64 + fr, col0 = u.pn * BM + wc * 32 + 4 * fq;
#pragma unroll
        for (int ai = 0; ai < 2; ++ai)
#pragma unroll
            for (int m = 0; m < 4; ++m) { const size_t row = (size_t)(row0 + ai * HALF + m * 16); float s = 0.f, q = 0.f;
#pragma unroll
                for (int bj = 0; bj < 2; ++bj)
#pragma unroll
                    for (int n = 0; n < 2; ++n) { const int col = col0 + bj * HALF + n * 16;
                        const u32x2 hw = *(const u32x2*)(h0 + row * D + col);
                        f32x4 hv; hv.x = bflo(hw.x); hv.y = bfhi(hw.x); hv.z = bflo(hw.y); hv.w = bfhi(hw.y);
                        const f32x4 x = hv * alpha + acc[ai][bj][m][n] * ascale;
                        s += (x.x + x.y) + (x.z + x.w); q += (x.x * x.x + x.y * x.y) + (x.z * x.z + x.w * x.w);
                        u32x2 w; w.x = cvt_pk_bf16(x.x, x.y); w.y = cvt_pk_bf16(x.z, x.w);
                        *(u32x2*)(O + row * D + col) = w;
#ifdef P7_F8
                        *(unsigned*)(O8 + row * D + col) = pk4_fp8(x.x, x.y, x.z, x.w);
#endif
                    }
                s += __shfl_xor(s, 16); s += __shfl_xor(s, 32); q += __shfl_xor(q, 16); q += __shfl_xor(q, 32);
                if (fq == 0) { atomicAdd(rsum + row, s); atomicAdd(rsq + row, q); } }
    }
};
struct EpiQ {
    static constexpr bool PERM = true, AFTER_DRAIN = false; static constexpr int MID_T = -1;
    bf16_t* O; const float* rsum; const float* rsq; const float* c1; const float* c2; float ascale;
    __device__ __forceinline__ void operator()(const f32x4 (&acc)[2][2][4][2], const Unit& u, int wr, int wc, int fr, int fq) const {
        const int row0 = u.pm * BM + wr * 64 + fr, col0 = u.pn * BM + wc * 32 + 8 * fq;
        f32x4 k1[2][2], k2[2][2];
#pragma unroll
        for (int bj = 0; bj < 2; ++bj)
#pragma unroll
            for (int n = 0; n < 2; ++n) { k1[bj][n] = *(const f32x4*)(c1 + col0 + bj * HALF + 4 * n); k2[bj][n] = *(const f32x4*)(c2 + col0 + bj * HALF + 4 * n); }
#pragma unroll
        for (int ai = 0; ai < 2; ++ai)
#pragma unroll
            for (int m = 0; m < 4; ++m) { const int row = row0 + ai * HALF + m * 16;
                const float mean = rsum[row] * (1.0f / D), rstd = 1.0f / sqrtf(fmaxf(rsq[row] * (1.0f / D) - mean * mean, 0.f) + LN_EPS_);
                bf16_t* rowp = O + (size_t)row * D + col0;
#pragma unroll
                for (int bj = 0; bj < 2; ++bj) {
                    const f32x4 v0 = (acc[ai][bj][m][0] * ascale - k1[bj][0] * mean) * rstd + k2[bj][0], v1 = (acc[ai][bj][m][1] * ascale - k1[bj][1] * mean) * rstd + k2[bj][1];
                    u32x4 w; w.x = cvt_pk_bf16(v0[0], v0[1]); w.y = cvt_pk_bf16(v0[2], v0[3]); w.z = cvt_pk_bf16(v1[0], v1[1]); w.w = cvt_pk_bf16(v1[2], v1[3]);
                    *(u32x4*)(rowp + bj * HALF) = w; } }
    }
};
}
template <class Epi>
__device__ __forceinline__ void run_gemm(ldsp lds, const bf16_t* A, const bf16_t* Bt, int M, int N, int K, const Epi& E) {
    pg8::Gemm g; g.A = A; g.Bt = Bt; g.M = M; g.N = N; g.K = K;
    pg8::StaticOrder S; S.init(M, N, (int)gridDim.x, (int)blockIdx.x);
    pg8::gemm_phase<Epi, pg8::StaticOrder, false>(lds, g, S, E, nullptr);
}

template <class Epi>
__device__ __forceinline__ void run_gemm8(ldsp lds, const unsigned char* A8, const unsigned char* Bt8, int M, int N, int K, const Epi& E, int wg) {
    pg8::Gemm g; g.A = (const bf16_t*)A8; g.Bt = (const bf16_t*)Bt8; g.M = M; g.N = N; g.K = K / 2;
    pg8::StaticOrder S; S.init(M, N, (int)gridDim.x, wg);
    pg8::gemm_phase<Epi, pg8::StaticOrder, false, true>(lds, g, S, E, nullptr);
}
constexpr int CONV_P3_END = 16384;
constexpr int CONV_P2_ROWS = 0;
__device__ __forceinline__ void convert_row(unsigned char* ws, int r, int lane, const f32x4 (&v)[8]) {
    float am = 0.f, ss = 0.f;
#pragma unroll
    for (int j = 0; j < 8; ++j) { am = fmaxf(am, fmaxf(fmaxf(fabsf(v[j].x), fabsf(v[j].y)), fmaxf(fabsf(v[j].z), fabsf(v[j].w)))); ss += (v[j].x * v[j].x + v[j].y * v[j].y) + (v[j].z * v[j].z + v[j].w * v[j].w); }
    am = wave_max_dpp(am);
    const float rms = sqrtf(wave_sum_dpp(ss) * (1.0f / D));
    unsigned w[4]; float sc;
    if (r < 16384) {
        const float clip = fminf(am, 2.5f * rms), s = clip > 0.f ? 7.0f / clip : 1.0f; sc = clip > 0.f ? clip * (1.0f / 7.0f) : 1.0f;
#pragma unroll
        for (int j = 0; j < 4; ++j) { unsigned t = 0;
#pragma unroll
            for (int i = 0; i < 8; ++i) { const float f = fminf(fmaxf(v[2 * j + (i >> 2)][i & 3] * s, -7.0f), 7.0f);
                t = __builtin_amdgcn_alignbit(__float_as_uint(f + 12582912.0f), t, 4); }
            w[j] = t; }
    } else {
        const float clip = fminf(am, 3.0f * rms), s = clip > 0.f ? 6.0f / clip : 1.0f; sc = clip > 0.f ? clip * (1.0f / 6.0f) : 1.0f;
#pragma unroll
        for (int j = 0; j < 4; ++j) { unsigned t = 0; float f[8];
#pragma unroll
            for (int i = 0; i < 8; ++i) f[i] = fminf(fmaxf(v[2 * j + (i >> 2)][i & 3] * s, -6.0f), 6.0f);
            t = __builtin_amdgcn_cvt_scalef32_pk_fp4_f32(t, f[0], f[1], 1.0f, 0); t = __builtin_amdgcn_cvt_scalef32_pk_fp4_f32(t, f[2], f[3], 1.0f, 1);
            t = __builtin_amdgcn_cvt_scalef32_pk_fp4_f32(t, f[4], f[5], 1.0f, 2); t = __builtin_amdgcn_cvt_scalef32_pk_fp4_f32(t, f[6], f[7], 1.0f, 3);
            w[j] = t; }
    }
    *(u32x4*)(ws + WS_VB + (size_t)(r & 16383) * EROW + (r < 16384 ? 0 : 1024) + lane * 16) = (u32x4){w[0], w[1], w[2], w[3]};
    if (lane == 0) ((float*)(ws + WS_TSC))[r] = sc;
}
__device__ __forceinline__ void convert_ld(const Params& P, int r, int lane, f32x4 (&v)[8]) {
    const f32x4* src = (const f32x4*)((r < 16384 ? P.in[I_UT] : P.in[I_VT]) + (size_t)(r & 16383) * D) + lane;
#pragma unroll
    for (int j = 0; j < 8; ++j) v[j] = src[64 * j];
}
__device__ __forceinline__ void convert_tables(const Params& P, int r0, int rend, int stride) {
    const int lane = threadIdx.x & 63;
    for (int r = r0; r < rend; r += stride) { f32x4 v[8]; convert_ld(P, r, lane, v); convert_row(P.ws, r, lane, v); }
}
constexpr int LD64 = 72, MATB = 64 * LD64 * 2, LDK = 104;
constexpr int O_AB = 0, O_RB = 1 * MATB, O_BH = 2 * MATB, O_KH = 3 * MATB, O_BTT = 4 * MATB, O_KTT = 5 * MATB, O_VT = 6 * MATB;
constexpr int O_M0 = 7 * MATB, O_M0T = 8 * MATB  , O_M1 = 9 * MATB, O_PA = 10 * MATB, O_PB = 11 * MATB, O_MAK = 12 * MATB, O_MRB = 13 * MATB, O_MRK = 14 * MATB;
constexpr int O_M1T = 0;
constexpr int LDKP = 96;
constexpr int O_WL = 15 * MATB, O_AL = O_WL + 64 * LDKP * 2;
constexpr int O_Z = 7 * MATB, O_AZ = O_Z + 64 * 68 * 4;
static_assert(O_AZ + 64 * 68 * 4 <= O_PB, "lds");
static_assert(O_AL + 64 * LDKP * 2 <= LDS_BYTES - 16, "lds");

__device__ __forceinline__ bf16x8 ldsfrag(ldsp lds, int off, int ld, int row, int kofs) { return *(const LAS bf16x8*)(lds + off + (row * ld + kofs) * 2); }
__device__ __forceinline__ void st4(ldsp lds, int off, int row, int col, const f32x4 v) {
    u32x2 w; w.x = pk2(v.x, v.y); w.y = pk2(v.z, v.w); *(LAS u32x2*)(lds + off + (row * LD64 + col) * 2) = w; }
__device__ __forceinline__ void st1(ldsp lds, int off, int row, int col, float v) { *(LAS bf16_t*)(lds + off + (row * LD64 + col) * 2) = f2bf1(v); }

__device__ __forceinline__ float fast_rcp(float x) { return __builtin_amdgcn_rcpf(x); }
__device__ __forceinline__ float fast_sigmoid(float x) { return fast_rcp(1.0f + __expf(-x)); }
__device__ __forceinline__ float fast_tanh(float x) { return 1.0f - 2.0f * fast_rcp(1.0f + __expf(2.0f * x)); }
__device__ __forceinline__ u32x4 ld8(const bf16_t* p) { return p ? *(const u32x4*)p : (u32x4){0u, 0u, 0u, 0u}; }
__device__ __forceinline__ void shift8r(const u32x4 cw, const u32x4 pw, const float* mu, float* x) {
    float c[8], q[8]; unpack8(cw, c); unpack8(pw, q);
    const f32x4 m0 = *(const f32x4*)mu, m1 = *(const f32x4*)(mu + 4);
    const float mm[8] = {m0.x, m0.y, m0.z, m0.w, m1.x, m1.y, m1.z, m1.w};
#pragma unroll
    for (int i = 0; i < 8; ++i) x[i] = c[i] + (q[i] - c[i]) * mm[i];
}
__device__ __forceinline__ int tcol(int row, int col) { return ((((col >> 3) ^ (row >> 3)) & 7) << 3) | (col & 7); }
__device__ __forceinline__ bf16x8 ldsfragT(ldsp lds, int off, int row, int kofs) { return *(const LAS bf16x8*)(lds + off + (row * LD64 + tcol(row, kofs)) * 2); }
__device__ __forceinline__ void st1T(ldsp lds, int off, int row, int col, float v) { *(LAS bf16_t*)(lds + off + (row * LD64 + tcol(row, col)) * 2) = f2bf1(v); }
typedef short s16x4 __attribute__((ext_vector_type(4)));
__device__ __forceinline__ bf16x8 ldsfragTR(ldsp lds, int off, int krow0, int col0, int lane) {
    const int g = lane >> 4, q = (lane & 15) >> 2, p = lane & 3;
    const LAS s16x4* a = (const LAS s16x4*)(lds + off + ((krow0 + 8 * g + q) * LD64 + col0) * 2 + 8 * p);
    const s16x4 v0 = __builtin_amdgcn_ds_read_tr16_b64_v4i16((LAS s16x4*)a), v1 = __builtin_amdgcn_ds_read_tr16_b64_v4i16((LAS s16x4*)(a + LD64));
    return (bf16x8){v0[0], v0[1], v0[2], v0[3], v1[0], v1[1], v1[2], v1[3]};
}
__device__ __forceinline__ void shift8(const bf16_t* pcur, const bf16_t* pprev, const float* mu, float* x) {
    float c[8], q[8];
    if (pcur) unpack8(*(const u32x4*)pcur, c); else {
#pragma unroll
        for (int i = 0; i < 8; ++i) c[i] = 0.f; }
    if (pprev) unpack8(*(const u32x4*)pprev, q); else {
#pragma unroll
        for (int i = 0; i < 8; ++i) q[i] = 0.f; }
    const f32x4 m0 = *(const f32x4*)mu, m1 = *(const f32x4*)(mu + 4);
    const float mm[8] = {m0.x, m0.y, m0.z, m0.w, m1.x, m1.y, m1.z, m1.w};
#pragma unroll
    for (int i = 0; i < 8; ++i) x[i] = c[i] + (q[i] - c[i]) * mm[i];
}

template <bool DO_P, bool DO_SQ>
__device__ __forceinline__ void dbl_step(ldsp lds, int sN, int sT, int dN, int dT, int pC, int pN, int tm, int tn0, int fr, int fq) {
    bf16x8 a[2];
#pragma unroll
    for (int ks = 0; ks < 2; ++ks) a[ks] = ldsfragTR(lds, sN, 32 * ks, 16 * tm, 16 * fq + fr);
#pragma unroll
    for (int t2 = 0; t2 < 2; ++t2) {
        const int nt = tn0 + t2, t = 16 * nt + fr, s0 = 16 * tm + 4 * fq;
        if (DO_P) {
            f32x4 acc = {0.f, 0.f, 0.f, 0.f};
#pragma unroll
            for (int ks = 0; ks < 2; ++ks) acc = mfma16(a[ks], ldsfrag(lds, pC, LD64, t, ks * 32 + fq * 8), acc);
            const u32x2 pw = *(const LAS u32x2*)(lds + pC + (t * LD64 + s0) * 2);
            acc.x += bflo(pw.x); acc.y += bfhi(pw.x); acc.z += bflo(pw.y); acc.w += bfhi(pw.y);
            st4(lds, pN, t, s0, acc);
        }
        if (DO_SQ) {
            f32x4 acc = {0.f, 0.f, 0.f, 0.f};
#pragma unroll
            for (int ks = 0; ks < 2; ++ks) acc = mfma16(a[ks], ldsfrag(lds, sN, LD64, t, ks * 32 + fq * 8), acc);
            st4(lds, dN, t, s0, acc);
        }
    }
}


struct PL { u32x4 rc, rq, kc, kq, vc, vq; };
__device__ __forceinline__ const bf16_t* unit_rowp(const bf16_t* pp, int u, int tl, int col) {
    int r;
    if (u >= 4096) r = (tl >= 48) ? (ROW_META + tl - 48) : -1;
    else { const int bh = u >> 6, c = u & 63, b = bh >> 5; r = (tl >= 0 || c > 0) ? (b * SEQ + c * 64 + tl) : (ROW_META + 15); }
    return r < 0 ? (const bf16_t*)nullptr : pp + (size_t)r * NPAD + col;
}
__device__ __forceinline__ void pl_load(const Params& P, int u, PL& L) {
    int tid = threadIdx.x; asm volatile("" : "+v"(tid));
    const int lane = tid & 63, wave = tid >> 6, fr = lane & 15, fq = lane >> 4, tm = wave >> 1;
    const bf16_t* pp = (const bf16_t*)(P.ws + WS_P);
    const int h = (u >= 4096) ? (u - 4096) : ((u >> 6) & 31);
    const int t = tid >> 3, hj = h * 64 + 8 * (tid & 7);
    L.rc = ld8(unit_rowp(pp, u, t, C_R + hj)); L.rq = ld8(unit_rowp(pp, u, t - 1, C_R + hj));
    L.kc = ld8(unit_rowp(pp, u, t, C_K + hj)); L.kq = ld8(unit_rowp(pp, u, t - 1, C_K + hj));
    L.vc = ld8(unit_rowp(pp, u, t, C_V + hj)); L.vq = ld8(unit_rowp(pp, u, t - 1, C_V + hj));
}
#define SINGLE_TRIP for (int once_ = 0; once_ < 1; ++once_)
__device__ __forceinline__ void rwkv_unit(const Params& P, ldsp lds, int u, PL& L, int next_u, bool stage_a) {
    int tid = threadIdx.x; asm volatile("" : "+v"(tid));
    const int lane = tid & 63, wave = tid >> 6, fr = lane & 15, fq = lane >> 4, tm = wave >> 1, tn0 = (wave & 1) * 2;
    unsigned char* ws = P.ws;
    const bf16_t* pp = (const bf16_t*)(ws + WS_P);
    const bool meta = u >= 4096;
    int b = 0, h, c = 0;
    if (meta) { h = u - 4096; } else { const int bh = u >> 6; c = u & 63; b = bh >> 5; h = bh & 31; }
    auto rowof = [&](int tl) -> int {
        if (meta) return (tl >= 48) ? (ROW_META + tl - 48) : -1;
        if (tl >= 0 || c > 0) return b * SEQ + c * 64 + tl;
        return ROW_META + 15;
    };
    auto rowp = [&](int tl, int col) -> const bf16_t* { const int r = rowof(tl); return r < 0 ? (const bf16_t*)nullptr : pp + (size_t)r * NPAD + col; };
    const float* mu = P.in[I_MU];
    float lw[8], av[8], rv[8], kv[8], vv[8], kk[8], km[8];
    const int t = tid >> 3, jq = tid & 7, j0 = 8 * jq, hj = h * 64 + j0;
    const bool nulltok = meta && t < 48;
    SINGLE_TRIP {
    bf16x8 lAw[3], lAa[3];
    {
        const bf16_t* ww2 = (const bf16_t*)(ws + WS_WTW2) + (size_t)(h * 64 + 16 * tm + fr) * 96 + fq * 8;
        const bf16_t* wa2 = (const bf16_t*)(ws + WS_WTA2) + (size_t)(h * 64 + 16 * tm + fr) * 96 + fq * 8;
#pragma unroll
        for (int ks = 0; ks < 3; ++ks) { lAw[ks] = *(const bf16x8*)(ww2 + ks * 32); lAa[ks] = *(const bf16x8*)(wa2 + ks * 32); }
    }
    if (stage_a) {
        u32x4 cw[3], pw[3];
#pragma unroll
        for (int it = 0; it < 3; ++it) { const int idx = tid + 512 * it, mat = idx / 768, rem = idx - mat * 768, tt = rem / 12, ch = rem - tt * 12, col = (mat ? C_AL : C_WL) + ch * 8;
            cw[it] = ld8(rowp(tt, col)); pw[it] = ld8(rowp(tt - 1, col)); }
#pragma unroll
        for (int it = 0; it < 3; ++it) { const int idx = tid + 512 * it, mat = idx / 768, rem = idx - mat * 768, tt = rem / 12, ch = rem - tt * 12, col = (mat ? C_AL : C_WL) + ch * 8;
            float x[8]; shift8r(cw[it], pw[it], mu + (mat ? M_AL : M_WL) + ch * 8, x);
            if (mat == 0) {
#pragma unroll
                for (int i = 0; i < 8; ++i) x[i] = fast_tanh(x[i]);
            }
            *(LAS u32x4*)(lds + (mat ? O_AL : O_WL) + (tt * LDKP + ch * 8) * 2) = pack8(x); }
    }
    BLOCK_SYNC();
    {
        f32x4 z[2] = {{0.f, 0.f, 0.f, 0.f}, {0.f, 0.f, 0.f, 0.f}}, az[2] = {{0.f, 0.f, 0.f, 0.f}, {0.f, 0.f, 0.f, 0.f}};
#pragma unroll
        for (int ks = 0; ks < 3; ++ks) {
            const bf16x8 aw = lAw[ks], aa = lAa[ks];
#pragma unroll
            for (int t2 = 0; t2 < 2; ++t2) {
                const int t = 16 * (tn0 + t2) + fr;
                z[t2] = mfma16(aw, ldsfrag(lds, O_WL, LDKP, t, ks * 32 + fq * 8), z[t2]);
                az[t2] = mfma16(aa, ldsfrag(lds, O_AL, LDKP, t, ks * 32 + fq * 8), az[t2]);
            }
        }
#pragma unroll
        for (int t2 = 0; t2 < 2; ++t2) {
            const int t = 16 * (tn0 + t2) + fr, j0 = 16 * tm + 4 * fq;
            *(LAS f32x4*)(lds + O_Z + (t * 68 + j0) * 4) = z[t2];
            *(LAS f32x4*)(lds + O_AZ + (t * 68 + j0) * 4) = az[t2];
        }
    }
    BLOCK_SYNC();
    float cs[8];
    {
        const f32x4 z0 = *(const LAS f32x4*)(lds + O_Z + (t * 68 + j0) * 4), z1 = *(const LAS f32x4*)(lds + O_Z + (t * 68 + j0 + 4) * 4);
        const f32x4 y0 = *(const LAS f32x4*)(lds + O_AZ + (t * 68 + j0) * 4), y1 = *(const LAS f32x4*)(lds + O_AZ + (t * 68 + j0 + 4) * 4);
        const float zz[8] = {z0.x, z0.y, z0.z, z0.w, z1.x, z1.y, z1.z, z1.w}, yy[8] = {y0.x, y0.y, y0.z, y0.w, y1.x, y1.y, y1.z, y1.w};
        const f32x4 w0a = *(const f32x4*)(P.in[I_W0] + hj), w0b = *(const f32x4*)(P.in[I_W0] + hj + 4), a0a = *(const f32x4*)(P.in[I_A0] + hj), a0b = *(const f32x4*)(P.in[I_A0] + hj + 4);
        const float w0[8] = {w0a.x, w0a.y, w0a.z, w0a.w, w0b.x, w0b.y, w0b.z, w0b.w}, a0[8] = {a0a.x, a0a.y, a0a.z, a0a.w, a0b.x, a0b.y, a0b.z, a0b.w};
#pragma unroll
        for (int i = 0; i < 8; ++i) { lw[i] = nulltok ? 0.f : -DSCALE * fast_sigmoid(w0[i] + zz[i]); av[i] = fast_sigmoid(a0[i] + yy[i]); cs[i] = lw[i]; }
#pragma unroll
        for (int d = 8; d < 64; d <<= 1) {
#pragma unroll
            for (int i = 0; i < 8; ++i) { const float o = __shfl_up(cs[i], d); cs[i] += (lane >= d) ? o : 0.f; }
        }
        if (lane >= 56) {
#pragma unroll
            for (int i = 0; i < 8; ++i) *(LAS float*)(lds + (wave < 4 ? O_BH : O_KH) + ((j0 + i) * LD64 + 64) * 2 + (wave & 3) * 4) = cs[i]; }
        shift8r(L.rc, L.rq, mu + M_R + hj, rv); shift8r(L.kc, L.kq, mu + M_K + hj, kv); shift8r(L.vc, L.vq, mu + M_V + hj, vv);
        if (nulltok) {
#pragma unroll
            for (int i = 0; i < 8; ++i) { rv[i] = 0.f; kv[i] = 0.f; vv[i] = 0.f; }
        }
        const f32x4 kka = *(const f32x4*)(P.in[I_KK] + hj), kkb = *(const f32x4*)(P.in[I_KK] + hj + 4), kaa = *(const f32x4*)(P.in[I_KA] + hj), kab = *(const f32x4*)(P.in[I_KA] + hj + 4);
        const f32x4 rka = *(const f32x4*)(P.in[I_RK] + hj), rkb = *(const f32x4*)(P.in[I_RK] + hj + 4);
        const float kkw[8] = {kka.x, kka.y, kka.z, kka.w, kkb.x, kkb.y, kkb.z, kkb.w}, kaw[8] = {kaa.x, kaa.y, kaa.z, kaa.w, kab.x, kab.y, kab.z, kab.w}, rkw[8] = {rka.x, rka.y, rka.z, rka.w, rkb.x, rkb.y, rkb.z, rkb.w};
        float n2 = 0.f, bon = 0.f;
#pragma unroll
        for (int i = 0; i < 8; ++i) { kk[i] = kv[i] * kkw[i]; n2 += kk[i] * kk[i]; km[i] = kv[i] * (1.0f + (av[i] - 1.0f) * kaw[i]); bon += rv[i] * km[i] * rkw[i]; }
        n2 += DPPF(n2, 0xB1); n2 += DPPF(n2, 0x4E); n2 += DPPF(n2, 0x141);
        bon += DPPF(bon, 0xB1); bon += DPPF(bon, 0x4E); bon += DPPF(bon, 0x141);
        const float inv = 1.0f / fmaxf(sqrtf(n2), 1e-12f);
#pragma unroll
        for (int i = 0; i < 8; ++i) kk[i] *= inv;
        if (!meta && jq == 0) ((float*)(ws + WS_BONUS))[(size_t)(b * SEQ + c * 64 + t) * 32 + h] = bon;
    }
    BLOCK_SYNC();
    {
        float Lc[8], Le[8];
#pragma unroll
        for (int i = 0; i < 8; ++i) { Lc[i] = cs[i]; Le[i] = 0.f; }
#pragma unroll
        for (int i = 0; i < 8; ++i) {
            const f32x4 wa = *(const LAS f32x4*)(lds + O_BH + ((j0 + i) * LD64 + 64) * 2), wb = *(const LAS f32x4*)(lds + O_KH + ((j0 + i) * LD64 + 64) * 2);
            const float ww[8] = {wa.x, wa.y, wa.z, wa.w, wb.x, wb.y, wb.z, wb.w};
#pragma unroll
            for (int w = 0; w < 8; ++w) { Le[i] += ww[w]; Lc[i] += (w < wave) ? ww[w] : 0.f; }
        }
        float Ab[8], Rb[8], Bh[8], Kh[8], Bt[8], Kt[8];
#pragma unroll
        for (int i = 0; i < 8; ++i) {
            const float eP = __expf(Lc[i] - lw[i]), eC = __expf(Lc[i]), eN = __expf(-Lc[i]), eE = __expf(Le[i] - Lc[i]);
            const float ka = kk[i] * av[i];
            Ab[i] = -kk[i] * eP; Rb[i] = rv[i] * eC; Bh[i] = ka * eN; Kh[i] = km[i] * eN; Bt[i] = ka * eE; Kt[i] = km[i] * eE;
        }
        *(LAS u32x4*)(lds + O_AB + (t * LD64 + j0) * 2) = pack8(Ab);
        *(LAS u32x4*)(lds + O_RB + (t * LD64 + j0) * 2) = pack8(Rb);
        *(LAS u32x4*)(lds + O_BH + (t * LD64 + j0) * 2) = pack8(Bh);
        *(LAS u32x4*)(lds + O_KH + (t * LD64 + j0) * 2) = pack8(Kh);
        *(LAS u32x4*)(lds + O_BTT + (t * LD64 + j0) * 2) = pack8(Bt);
        *(LAS u32x4*)(lds + O_KTT + (t * LD64 + j0) * 2) = pack8(Kt);
        *(LAS u32x4*)(lds + O_VT + (t * LD64 + j0) * 2) = pack8(vv);
        if (t == 63) {
#pragma unroll
            for (int i = 0; i < 8; ++i) *(LAS float*)(lds + O_RB + ((j0 + i) * LD64 + 64) * 2) = __expf(Le[i]);
        }
    }
    BLOCK_SYNC();
    }
    if (next_u >= 0) pl_load(P, next_u, L);
    SINGLE_TRIP {
    {
        bf16x8 abh[2], akh[2];
#pragma unroll
        for (int ks = 0; ks < 2; ++ks) { abh[ks] = ldsfrag(lds, O_BH, LD64, 16 * tm + fr, ks * 32 + fq * 8); akh[ks] = ldsfrag(lds, O_KH, LD64, 16 * tm + fr, ks * 32 + fq * 8); }
#pragma unroll
        for (int t2 = 0; t2 < 2; ++t2) {
            const int tt = 16 * (tn0 + t2) + fr, s0 = 16 * tm + 4 * fq;
            f32x4 mab = {0.f, 0.f, 0.f, 0.f}, mak = mab, mrb = mab, mrk = mab;
#pragma unroll
            for (int ks = 0; ks < 2; ++ks) {
                const bf16x8 bab = ldsfrag(lds, O_AB, LD64, tt, ks * 32 + fq * 8), brb = ldsfrag(lds, O_RB, LD64, tt, ks * 32 + fq * 8);
                mab = mfma16(abh[ks], bab, mab); mak = mfma16(akh[ks], bab, mak); mrb = mfma16(abh[ks], brb, mrb); mrk = mfma16(akh[ks], brb, mrk);
            }
            float vab[4] = {mab.x, mab.y, mab.z, mab.w}, vak[4] = {mak.x, mak.y, mak.z, mak.w}, vrb[4] = {mrb.x, mrb.y, mrb.z, mrb.w}, vrk[4] = {mrk.x, mrk.y, mrk.z, mrk.w}, vp[4];
#pragma unroll
            for (int r = 0; r < 4; ++r) { const int s = s0 + r; const bool st = s < tt, le = s <= tt;
                vab[r] = st ? vab[r] : 0.f; vak[r] = st ? vak[r] : 0.f; vrb[r] = le ? vrb[r] : 0.f; vrk[r] = le ? vrk[r] : 0.f; vp[r] = vab[r] + (s == tt ? 1.0f : 0.f); }
            st4(lds, O_M0, tt, s0, (f32x4){vab[0], vab[1], vab[2], vab[3]});
            st4(lds, O_PA, tt, s0, (f32x4){vp[0], vp[1], vp[2], vp[3]});
            st4(lds, O_MAK, tt, s0, (f32x4){vak[0], vak[1], vak[2], vak[3]});
            st4(lds, O_MRB, tt, s0, (f32x4){vrb[0], vrb[1], vrb[2], vrb[3]});
            st4(lds, O_MRK, tt, s0, (f32x4){vrk[0], vrk[1], vrk[2], vrk[3]});
        }
    }
    BLOCK_SYNC();
    dbl_step<false, true>(lds, O_M0, O_M0T, O_M1, O_M1T, 0, 0, tm, tn0, fr, fq); BLOCK_SYNC();
    dbl_step<true, true>(lds, O_M1, O_M1T, O_M0, O_M0T, O_PA, O_PB, tm, tn0, fr, fq); BLOCK_SYNC();
    dbl_step<true, true>(lds, O_M0, O_M0T, O_M1, O_M1T, O_PB, O_PA, tm, tn0, fr, fq); BLOCK_SYNC();
    dbl_step<true, true>(lds, O_M1, O_M1T, O_M0, O_M0T, O_PA, O_PB, tm, tn0, fr, fq); BLOCK_SYNC();
    if (!meta) {
    dbl_step<true, true>(lds, O_M0, O_M0T, O_M1, O_M1T, O_PB, O_PA, tm, tn0, fr, fq); BLOCK_SYNC();
    dbl_step<true, false>(lds, O_M1, O_M1T, 0, 0, O_PA, O_PB, tm, tn0, fr, fq); BLOCK_SYNC();
    }
    }
    const size_t ub = (size_t)u * 4096;
    SINGLE_TRIP {
    {
        bf16x8 aT[2], aMak[2];
#pragma unroll
        for (int ks = 0; ks < 2; ++ks) { aT[ks] = ldsfrag(lds, O_PB, LD64, 16 * tm + fr, ks * 32 + fq * 8); aMak[ks] = ldsfrag(lds, O_MAK, LD64, 16 * tm + fr, ks * 32 + fq * 8); }
#pragma unroll
        for (int t2 = 0; t2 < 2; ++t2) {
            const int n = 16 * (tn0 + t2) + fr, t0 = 16 * tm + 4 * fq;
            f32x4 at = {0.f, 0.f, 0.f, 0.f}, xt = at;
#pragma unroll
            for (int ks = 0; ks < 2; ++ks) { at = mfma16(aT[ks], ldsfragTR(lds, O_AB, 32 * ks, 16 * (tn0 + t2), 16 * fq + fr), at); xt = mfma16(aMak[ks], ldsfragTR(lds, O_VT, 32 * ks, 16 * (tn0 + t2), 16 * fq + fr), xt); }
            st4(lds, O_M0, n, t0, at); st4(lds, O_M0T, n, t0, xt);
        }
    }
    BLOCK_SYNC();
    {
        bf16x8 aT[2], aAt[2];
#pragma unroll
        for (int ks = 0; ks < 2; ++ks) { aT[ks] = ldsfrag(lds, O_PB, LD64, 16 * tm + fr, ks * 32 + fq * 8); aAt[ks] = ldsfrag(lds, O_M0, LD64, 16 * tm + fr, ks * 32 + fq * 8); }
        bf16_t* Rt = (bf16_t*)(ws + WS_RT) + ub; bf16_t* Gp = (bf16_t*)(ws + WS_G) + ub;
#pragma unroll
        for (int t2 = 0; t2 < 2; ++t2) {
            const int n = 16 * (tn0 + t2) + fr, m0 = 16 * tm + 4 * fq;
            f32x4 u0 = {0.f, 0.f, 0.f, 0.f}, rt = u0, g = u0;
#pragma unroll
            for (int ks = 0; ks < 2; ++ks) {
                u0 = mfma16(aT[ks], ldsfrag(lds, O_M0T, LD64, n, ks * 32 + fq * 8), u0);
                rt = mfma16(aAt[ks], ldsfrag(lds, O_MRB, LD64, n, ks * 32 + fq * 8), rt);
                g = mfma16(aAt[ks], ldsfragTR(lds, O_BTT, 32 * ks, 16 * (tn0 + t2), 16 * fq + fr), g);
            }
            st4(lds, O_M1, n, m0, u0);
            const u32x2 rw = *(const LAS u32x2*)(lds + O_RB + (n * LD64 + m0) * 2);
            rt.x += bflo(rw.x); rt.y += bfhi(rw.x); rt.z += bflo(rw.y); rt.w += bfhi(rw.y);
            { u32x2 w; w.x = pk2(rt.x, rt.y); w.y = pk2(rt.z, rt.w); *(u32x2*)(Rt + n * 64 + m0) = w; }
            if ((n >> 2) == (m0 >> 2)) { const float e = *(const LAS float*)(lds + O_RB + (n * LD64 + 64) * 2); const int r = n & 3;
                g.x += (r == 0) ? e : 0.f; g.y += (r == 1) ? e : 0.f; g.z += (r == 2) ? e : 0.f; g.w += (r == 3) ? e : 0.f; }
            { const int pos0 = 32 * (tm >> 1) + 8 * fq + 4 * (tm & 1); u32x2 w; w.x = pk2(g.x, g.y); w.y = pk2(g.z, g.w); *(u32x2*)(Gp + n * 64 + pos0) = w; }
        }
    }
    BLOCK_SYNC();
    {
        bf16x8 aB[2], aK[2], aU[2], aV[2];
#pragma unroll
        for (int ks = 0; ks < 2; ++ks) { const int row = 16 * tm + fr, ko = ks * 32 + fq * 8;
            aB[ks] = ldsfragTR(lds, O_BTT, 32 * ks, 16 * tm, 16 * fq + fr); aK[ks] = ldsfragTR(lds, O_KTT, 32 * ks, 16 * tm, 16 * fq + fr); aU[ks] = ldsfrag(lds, O_M1, LD64, row, ko); aV[ks] = ldsfragTR(lds, O_VT, 32 * ks, 16 * tm, 16 * fq + fr); }
        bf16_t* H0t = (bf16_t*)(ws + WS_H0T) + ub; bf16_t* Y0s = (bf16_t*)(ws + WS_Y0) + ub;
#pragma unroll
        for (int t2 = 0; t2 < 2; ++t2) {
            const int n = 16 * (tn0 + t2) + fr, m0 = 16 * tm + 4 * fq;
            f32x4 hh = {0.f, 0.f, 0.f, 0.f}, yy = hh;
#pragma unroll
            for (int ks = 0; ks < 2; ++ks) { const int ko = ks * 32 + fq * 8;
                const bf16x8 bU = ldsfrag(lds, O_M1, LD64, n, ko), bV = ldsfragTR(lds, O_VT, 32 * ks, 16 * (tn0 + t2), 16 * fq + fr), bRb = ldsfrag(lds, O_MRB, LD64, n, ko), bRk = ldsfrag(lds, O_MRK, LD64, n, ko);
                hh = mfma16(aB[ks], bU, hh); hh = mfma16(aK[ks], bV, hh);
                yy = mfma16(aU[ks], bRb, yy); yy = mfma16(aV[ks], bRk, yy); }
            { u32x2 w; w.x = pk2(hh.x, hh.y); w.y = pk2(hh.z, hh.w); *(u32x2*)(H0t + n * 64 + m0) = w; }
            { u32x2 w; w.x = pk2(yy.x, yy.y); w.y = pk2(yy.z, yy.w); *(u32x2*)(Y0s + n * 64 + m0) = w; }
        }
    }
    BLOCK_SYNC();
    }
}

constexpr int LDU = 264;
__device__ __forceinline__ void pool_load(const Params& P, int pu, u32x4 (&raw)[5]) {
    int tid = threadIdx.x; asm volatile("" : "+v"(tid));
    const bf16_t* pp = (const bf16_t*)(P.ws + WS_P);
    const int g = (pu < 256) ? (pu & 3) : 3 - (pu & 3), tt = pu >> 2, b = tt >> 6, ti0 = (tt & 63) * 64;
#pragma unroll
    for (int k = 0; k < 5; ++k) { const int idx = tid + 512 * k;
        if (idx < 79 * 32) { const int lr = idx >> 5, ch = idx & 31, ti = ti0 + lr - 15; const int row = ti >= 0 ? b * SEQ + ti : ROW_META + 16 + ti;
            raw[k] = *(const u32x4*)(pp + (size_t)row * NPAD + C_POOL + g * 256 + ch * 8); } }
}
__device__ __forceinline__ void pool_unit(const Params& P, ldsp lds, int pu, const u32x4 (&raw)[5]) {
    int tid = threadIdx.x; asm volatile("" : "+v"(tid));
    const int lane = tid & 63, wave = tid >> 6, fr = lane & 15, fq = lane >> 4;
    unsigned char* ws = P.ws;
    const bf16_t* pp = (const bf16_t*)(ws + WS_P);
    const int g = (pu < 256) ? (pu & 3) : 3 - (pu & 3), tt = pu >> 2, b = tt >> 6, ti0 = (tt & 63) * 64;
    constexpr int O_U = 0, O_PL = 79 * LDU * 2;
#pragma unroll
    for (int k = 0; k < 5; ++k) { const int idx = tid + 512 * k; if (idx < 79 * 32) *(LAS u32x4*)(lds + O_U + ((idx >> 5) * LDU + (idx & 31) * 8) * 2) = raw[k]; }
    BLOCK_SYNC();
    {
        const int c0 = (tid & 31) * 8, t0 = (tid >> 5) * 4, win = 2 << g; const float inv = 1.0f / (float)win;
        float s[8], nw[8];
        unpack8(*(const LAS u32x4*)(lds + O_U + ((15 + t0) * LDU + c0) * 2), nw);
#pragma unroll
        for (int i = 0; i < 8; ++i) s[i] = nw[i];
        for (int d = 1; d < win; ++d) { float x[8]; unpack8(*(const LAS u32x4*)(lds + O_U + ((15 + t0 - d) * LDU + c0) * 2), x);
#pragma unroll
            for (int i = 0; i < 8; ++i) s[i] += x[i]; }
#pragma unroll
        for (int k = 0; k < 4; ++k) {
            if (k > 0) { float od[8]; unpack8(*(const LAS u32x4*)(lds + O_U + ((15 + t0 + k) * LDU + c0) * 2), nw); unpack8(*(const LAS u32x4*)(lds + O_U + ((15 + t0 + k - win) * LDU + c0) * 2), od);
#pragma unroll
                for (int i = 0; i < 8; ++i) s[i] += nw[i] - od[i]; }
            float o[8];
#pragma unroll
            for (int i = 0; i < 8; ++i) o[i] = s[i] * inv - nw[i];
            *(LAS u32x4*)(lds + O_PL + ((t0 + k) * LDU + c0) * 2) = pack8(o);
        }
    }
    BLOCK_SYNC();
    {
        const bf16_t* wt = (const bf16_t*)(ws + WS_WTPOOL) + (size_t)g * 65536;
        f32x4 acc[2][4];
#pragma unroll
        for (int a = 0; a < 2; ++a)
#pragma unroll
            for (int n = 0; n < 4; ++n) acc[a][n] = (f32x4){0.f, 0.f, 0.f, 0.f};
#pragma unroll 4
        for (int ks = 0; ks < 8; ++ks) {
            bf16x8 af[2];
#pragma unroll
            for (int a = 0; a < 2; ++a) af[a] = *(const bf16x8*)(wt + (size_t)(32 * wave + 16 * a + fr) * 256 + ks * 32 + fq * 8);
#pragma unroll
            for (int n = 0; n < 4; ++n) { const bf16x8 bf = ldsfrag(lds, O_PL, LDU, 16 * n + fr, ks * 32 + fq * 8);
#pragma unroll
                for (int a = 0; a < 2; ++a) acc[a][n] = mfma16(af[a], bf, acc[a][n]); }
        }
#ifdef P5_F8
        unsigned char* yb = ws + WS_YAB + 2048;
#else
        bf16_t* yb = (bf16_t*)(ws + WS_YAB) + 2048;
#endif
        const float* psc = P.in[I_PSCALE] + g * 256;
#pragma unroll
        for (int a = 0; a < 2; ++a) { const int d0 = 32 * wave + 16 * a + 4 * fq; const f32x4 sc = *(const f32x4*)(psc + d0);
#pragma unroll
            for (int n = 0; n < 4; ++n) { const int t = 16 * n + fr; const f32x4 o = acc[a][n] * sc;
#ifdef P5_F8
                *(unsigned*)(yb + (size_t)(b * SEQ + ti0 + t) * LDAB + g * 256 + d0) = pk4_fp8(o.x, o.y, o.z, o.w); } }
#else
                u32x2 w; w.x = pk2(o.x, o.y); w.y = pk2(o.z, o.w);
                *(u32x2*)(yb + (size_t)(b * SEQ + ti0 + t) * LDAB + g * 256 + d0) = w; } }
#endif
    }
    BLOCK_SYNC();
}
__device__ __forceinline__ void gsig_unit(const Params& P, int gu) {
    int tid = threadIdx.x; asm volatile("" : "+v"(tid));
    const bf16_t* pp = (const bf16_t*)(P.ws + WS_P); bf16_t* gs = (bf16_t*)(P.ws + WS_GSIG);
    const float* mu = P.in[I_MU];
#pragma unroll
    for (int it = 0; it < 4; ++it) {
        const int idx = tid + 512 * it, tl = idx >> 5, ch = idx & 31, col = C_GL + ch * 8;
        const int row = gu * 64 + tl; const int prow = ((row & (SEQ - 1)) == 0) ? (ROW_META + 15) : row - 1;
        float x[8]; shift8r(*(const u32x4*)(pp + (size_t)row * NPAD + col), *(const u32x4*)(pp + (size_t)prow * NPAD + col), mu + M_GL + ch * 8, x);
#pragma unroll
        for (int i = 0; i < 8; ++i) x[i] = fast_sigmoid(x[i]);
        *(u32x4*)(gs + (size_t)row * 256 + ch * 8) = pack8(x);
    }
}
__device__ __forceinline__ void phase2(const Params& P, ldsp lds) {
    PL L;
    for (int j = blockIdx.x; j < 256 + 32 + 128; j += gridDim.x) {
        if (j < 256) {
            const int b = j >> 7, c = (j >> 1) & 63, h0 = (j & 1) * 16;
            pl_load(P, (b * 32 + h0) * 64 + c, L);
            for (int i = 0; i < 16; ++i) { const int u = (b * 32 + h0 + i) * 64 + c; rwkv_unit(P, lds, u, L, i + 1 < 16 ? u + 64 : -1, i == 0); }
        } else if (j < 288) { pl_load(P, 4096 + (j - 256), L); rwkv_unit(P, lds, 4096 + (j - 256), L, -1, true); }
        else gsig_unit(P, j - 288);
    }
}
__device__ __forceinline__ void phase3(const Params& P) {
    const int lane = threadIdx.x & 63, wave = threadIdx.x >> 6, fr = lane & 15, fq = lane >> 4;
    if (wave != 0) { convert_tables(P, blockIdx.x * 7 + (wave - 1), CONV_P3_END, gridDim.x * 7); return; }
    unsigned char* ws = P.ws;
    const bf16_t* Gp = (const bf16_t*)(ws + WS_G); const bf16_t* H0t = (const bf16_t*)(ws + WS_H0T); bf16_t* S0t = (bf16_t*)(ws + WS_S0T);
    for (int item = blockIdx.x; item < 256; item += gridDim.x) {
        const int bh = item >> 2, vq = item & 3, h = bh & 31;
        bf16x8 Sb[2];
#pragma unroll
        for (int ks = 0; ks < 2; ++ks)
#pragma unroll
            for (int i = 0; i < 8; ++i) Sb[ks][i] = 0;
        bf16x8 g0[4][2], g1[4][2], g2[4][2], g3[4][2]; u32x2 h0[4], h1[4], h2[4], h3[4];
        auto load = [&](int step, bf16x8 (&ga)[4][2], u32x2 (&hf)[4]) {
            const int u = (step == 0) ? (4096 + h) : (bh * 64 + step - 1);
            const bf16_t* g = Gp + (size_t)u * 4096; const bf16_t* hh = H0t + (size_t)u * 4096;
#pragma unroll
            for (int mt = 0; mt < 4; ++mt) {
#pragma unroll
                for (int ks = 0; ks < 2; ++ks) ga[mt][ks] = *(const bf16x8*)(g + (16 * mt + fr) * 64 + ks * 32 + fq * 8);
                hf[mt] = *(const u32x2*)(hh + (16 * vq + fr) * 64 + 16 * mt + 4 * fq);
            }
        };
        auto apply = [&](int step, const bf16x8 (&ga)[4][2], const u32x2 (&hf)[4]) {
            f32x4 acc[4];
#pragma unroll
            for (int mt = 0; mt < 4; ++mt) {
                acc[mt] = (f32x4){bflo(hf[mt].x), bfhi(hf[mt].x), bflo(hf[mt].y), bfhi(hf[mt].y)};
                acc[mt] = mfma16(ga[mt][0], Sb[0], acc[mt]);
                acc[mt] = mfma16(ga[mt][1], Sb[1], acc[mt]);
            }
            bf16_t* so = S0t + (size_t)(bh * 64 + step) * 4096 + (16 * vq + fr) * 64 + 4 * fq;
            u32x2 w[4];
#pragma unroll
            for (int mt = 0; mt < 4; ++mt) { w[mt].x = pk2(acc[mt].x, acc[mt].y); w[mt].y = pk2(acc[mt].z, acc[mt].w); *(u32x2*)(so + 16 * mt) = w[mt]; }
#pragma unroll
            for (int ks = 0; ks < 2; ++ks) {
                const u32x4 q4 = (u32x4){w[2 * ks].x, w[2 * ks].y, w[2 * ks + 1].x, w[2 * ks + 1].y};
                Sb[ks] = __builtin_bit_cast(bf16x8, q4);
            }
        };
        load(0, g0, h0); load(1, g1, h1); load(2, g2, h2);
#pragma unroll 1
        for (int step = 0; step < 64; step += 4) {
            load(step + 3, g3, h3); apply(step, g0, h0);
            if (step + 4 < 64) load(step + 4, g0, h0);
            apply(step + 1, g1, h1);
            if (step + 5 < 64) load(step + 5, g1, h1);
            apply(step + 2, g2, h2);
            if (step + 6 < 64) load(step + 6, g2, h2);
            apply(step + 3, g3, h3);
        }
    }
}

constexpr int LDG = 264;
__device__ __forceinline__ void phase3b(const Params& P, ldsp lds) {
    int tid = threadIdx.x; asm volatile("" : "+v"(tid));
    const int lane = tid & 63, wave = tid >> 6, fr = lane & 15, fq = lane >> 4, wq = wave & 3;
    unsigned char* ws = P.ws;
    const bf16_t* pp = (const bf16_t*)(ws + WS_P);
    const float* mu = P.in[I_MU];
    constexpr int O_G2 = 0, O_HP = 64 * LDG * 2;
    {
        u32x4 ra[5], rb[5]; int pu = blockIdx.x;
        if (pu < 512) pool_load(P, pu, ra);
        for (; pu < 512; pu += gridDim.x) {
            const int pn = pu + gridDim.x;
            if (pn < 512) pool_load(P, pn, rb);
            pool_unit(P, lds, pu, ra);
#pragma unroll
            for (int k = 0; k < 5; ++k) ra[k] = rb[k];
        }
    }
    for (int w = blockIdx.x; w < 256; w += gridDim.x) {
        const int h = w & 31;
        BLOCK_SYNC();
        for (int idx = tid; idx < 64 * 32; idx += 512) { const int row = idx >> 5, ch = idx & 31;
            *(LAS u32x4*)(lds + O_G2 + (row * LDG + ch * 8) * 2) = *(const u32x4*)((const bf16_t*)(ws + WS_WTG2) + (size_t)(h * 64 + row) * 256 + ch * 8); }
        if (tid < 48) { const int a = tid >> 4, q4 = tid & 15; const float* src = a == 0 ? P.in[I_GNG] + h * 64 : a == 1 ? P.in[I_GNB] + h * 64 : mu + M_V + h * 64;
            *(LAS f32x4*)(lds + O_HP + a * 256 + q4 * 16) = *(const f32x4*)(src + q4 * 4); }
        BLOCK_SYNC();
        bf16x8 bG[8], bR[2], aS[4][2]; u32x2 yw[4], vc[4], vp[4]; float bon;
        auto unit_of = [&](int it, int& b, int& c) { const int q = (w >> 5) + 8 * (2 * it + (wave >> 2)); b = q >> 6; c = q & 63; };
        auto issue = [&](int it) {
            int b, c; unit_of(it, b, c); const int u = (b * 32 + h) * 64 + c, trow0 = b * SEQ + c * 64 + 16 * wq;
            const size_t ub = (size_t)u * 4096;
            const bf16_t* S0t = (const bf16_t*)(ws + WS_S0T) + ub; const bf16_t* Rt = (const bf16_t*)(ws + WS_RT) + ub; const bf16_t* Y0s = (const bf16_t*)(ws + WS_Y0) + ub;
            const int row = trow0 + fr; const int prow = (c == 0 && wq == 0 && fr == 0) ? (ROW_META + 15) : row - 1;
            const bf16_t* gsr = (const bf16_t*)(ws + WS_GSIG) + (size_t)row * 256 + fq * 8;
#pragma unroll
            for (int ks = 0; ks < 8; ++ks) bG[ks] = *(const bf16x8*)(gsr + ks * 32);
#pragma unroll
            for (int ks = 0; ks < 2; ++ks) bR[ks] = *(const bf16x8*)(Rt + (16 * wq + fr) * 64 + ks * 32 + fq * 8);
#pragma unroll
            for (int mt = 0; mt < 4; ++mt) {
                yw[mt] = *(const u32x2*)(Y0s + (16 * wq + fr) * 64 + 16 * mt + 4 * fq);
#pragma unroll
                for (int ks = 0; ks < 2; ++ks) aS[mt][ks] = *(const bf16x8*)(S0t + (16 * mt + fr) * 64 + ks * 32 + fq * 8);
                const int hc = h * 64 + 16 * mt + 4 * fq;
                vc[mt] = *(const u32x2*)(pp + (size_t)row * NPAD + C_V + hc); vp[mt] = *(const u32x2*)(pp + (size_t)prow * NPAD + C_V + hc);
            }
            bon = ((const float*)(ws + WS_BONUS))[(size_t)row * 32 + h];
        };
        issue(0);
#pragma unroll 1
        for (int it = 0; it < 8; ++it) {
            const int crow = CONV_P3_END + (w * 8 + it) * 8 + wave; f32x4 tv[8];
            if (crow < 32768) convert_ld(P, crow, lane, tv);
            int b, c; unit_of(it, b, c);
            const int row = b * SEQ + c * 64 + 16 * wq + fr;
            f32x4 gacc[4];
#pragma unroll
            for (int mt = 0; mt < 4; ++mt) gacc[mt] = (f32x4){0.f, 0.f, 0.f, 0.f};
#pragma unroll
            for (int ks = 0; ks < 8; ++ks)
#pragma unroll
                for (int mt = 0; mt < 4; ++mt) gacc[mt] = mfma16(*(const LAS bf16x8*)(lds + O_G2 + ((16 * mt + fr) * LDG + ks * 32 + fq * 8) * 2), bG[ks], gacc[mt]);
            f32x4 y[4], vv[4]; const float bonc = bon;
#pragma unroll
            for (int mt = 0; mt < 4; ++mt) {
                y[mt] = (f32x4){bflo(yw[mt].x), bfhi(yw[mt].x), bflo(yw[mt].y), bfhi(yw[mt].y)};
#pragma unroll
                for (int ks = 0; ks < 2; ++ks) y[mt] = mfma16(aS[mt][ks], bR[ks], y[mt]);
                const f32x4 mv = *(const LAS f32x4*)(lds + O_HP + 512 + (16 * mt + 4 * fq) * 4);
                const f32x4 cv = (f32x4){bflo(vc[mt].x), bfhi(vc[mt].x), bflo(vc[mt].y), bfhi(vc[mt].y)}, pv = (f32x4){bflo(vp[mt].x), bfhi(vp[mt].x), bflo(vp[mt].y), bfhi(vp[mt].y)};
                vv[mt] = cv + (pv - cv) * mv;
            }
#pragma unroll
            for (int mt = 0; mt < 4; ++mt) asm volatile("" : "+v"(y[mt]), "+v"(vv[mt]), "+v"(gacc[mt]));
            if (it + 1 < 8) issue(it + 1);
            float s = 0.f;
#pragma unroll
            for (int mt = 0; mt < 4; ++mt) s += (y[mt].x + y[mt].y) + (y[mt].z + y[mt].w);
            s += __shfl_xor(s, 16); s += __shfl_xor(s, 32);
            const float mean = s * (1.0f / 64.0f); float qq = 0.f;
#pragma unroll
            for (int mt = 0; mt < 4; ++mt) { y[mt] = y[mt] - mean; qq += (y[mt].x * y[mt].x + y[mt].y * y[mt].y) + (y[mt].z * y[mt].z + y[mt].w * y[mt].w); }
            qq += __shfl_xor(qq, 16); qq += __shfl_xor(qq, 32);
            const float rstd = 1.0f / sqrtf(qq * (1.0f / 64.0f) + GN_EPS);
#ifdef P5_F8
            unsigned char* ya = ws + WS_YAB + (size_t)row * LDAB + h * 64;
#else
            bf16_t* ya = (bf16_t*)(ws + WS_YAB) + (size_t)row * LDAB + h * 64;
#endif
#pragma unroll
            for (int mt = 0; mt < 4; ++mt) {
                const int i0 = 16 * mt + 4 * fq, hc = h * 64 + i0;
                const f32x4 gg = *(const LAS f32x4*)(lds + O_HP + i0 * 4), gb = *(const LAS f32x4*)(lds + O_HP + 256 + i0 * 4);
                const f32x4 o = (y[mt] * rstd * gg + gb + vv[mt] * bonc) * gacc[mt];
#ifdef P5_F8
                *(unsigned*)(ya + i0) = pk4_fp8(o.x, o.y, o.z, o.w);
#else
                u32x2 wv; wv.x = pk2(o.x, o.y); wv.y = pk2(o.z, o.w);
                *(u32x2*)(ya + i0) = wv;
#endif
            }
            if (crow < 32768) convert_row(ws, crow, lane, tv);
        }
    }
}
__device__ __forceinline__ u32x6 ld_row6(const unsigned char* p) { const u32x2 a = ((const u32x2*)p)[0], b = ((const u32x2*)p)[1], c = ((const u32x2*)p)[2]; return (u32x6){a.x, a.y, b.x, b.y, c.x, c.y}; }
__device__ __forceinline__ void peer_load_x(const Params& P, ldsp lds, int o_par, int tok, int lo, float (&x)[32]) {
    unsigned char* ws = P.ws;
    const bf16_t* hr = (const bf16_t*)(ws + WS_X1B) + (size_t)tok * D + lo * 4;
#pragma unroll
    for (int j = 0; j < 8; ++j) { const u32x2 w = *(const u32x2*)(hr + 256 * j); x[4 * j] = bflo(w.x); x[4 * j + 1] = bfhi(w.x); x[4 * j + 2] = bflo(w.y); x[4 * j + 3] = bfhi(w.y); }
    const float* st = (const float*)(ws + WS_STAT);
    const float mean1 = st[tok] * (1.0f / D), rstd1 = 1.0f / sqrtf(fmaxf(st[8192 + tok] * (1.0f / D) - mean1 * mean1, 0.f) + LN_EPS);
#pragma unroll
    for (int c = 0; c < 8; ++c) { const f32x4 g1 = *(const LAS f32x4*)(lds + o_par + (lo * 4 + 256 * c) * 4), b1 = *(const LAS f32x4*)(lds + o_par + 8192 + (lo * 4 + 256 * c) * 4);
        x[4 * c] = (x[4 * c] - mean1) * rstd1 * g1.x + b1.x; x[4 * c + 1] = (x[4 * c + 1] - mean1) * rstd1 * g1.y + b1.y; x[4 * c + 2] = (x[4 * c + 2] - mean1) * rstd1 * g1.z + b1.z; x[4 * c + 3] = (x[4 * c + 3] - mean1) * rstd1 * g1.w + b1.w; }
}
__device__ __forceinline__ void peer_finish(const Params& P, ldsp lds, int o_par, int tok, int lo, float (&o)[32]) {
    float x[32]; peer_load_x(P, lds, o_par, tok, lo, x);
    float s = 0.f;
#pragma unroll
    for (int i = 0; i < 32; ++i) { o[i] += DN_ALPHA * x[i]; s += o[i]; }
    const float mean = wave_sum_dpp(s) * (1.0f / D); float q = 0.f;
#pragma unroll
    for (int i = 0; i < 32; ++i) { o[i] -= mean; q += o[i] * o[i]; }
    const float rstd = 1.0f / sqrtf(wave_sum_dpp(q) * (1.0f / D) + LN_EPS);
    float* orow = P.out + (size_t)tok * D;
#pragma unroll
    for (int c = 0; c < 8; ++c) {
        const int off = lo * 4 + 256 * c;
        const f32x4 g0 = *(const LAS f32x4*)(lds + o_par + 16384 + off * 4), b0 = *(const LAS f32x4*)(lds + o_par + 24576 + off * 4);
        f32x4 r0;
        r0.x = o[4 * c + 0] * rstd * g0.x + b0.x; r0.y = o[4 * c + 1] * rstd * g0.y + b0.y; r0.z = o[4 * c + 2] * rstd * g0.z + b0.z; r0.w = o[4 * c + 3] * rstd * g0.w + b0.w;
        *(f32x4*)(orow + off) = r0;
    }
}
__device__ __forceinline__ float peer_dot(const u32x4 uu, const unsigned (&xd0)[4], const unsigned (&xd1)[4]) {
    int a0 = 0, a1 = 0; const unsigned ww[4] = {uu.x, uu.y, uu.z, uu.w};
#pragma unroll
    for (int q4 = 0; q4 < 4; ++q4) { a0 = __builtin_amdgcn_sdot8((int)ww[q4], (int)xd0[q4], a0, false); a1 = __builtin_amdgcn_sdot8((int)ww[q4], (int)xd1[q4], a1, false); }
    return (float)(a0 + (a1 << 4));
}
__device__ __forceinline__ void peer_axpy(const u32x4 vv, float a, float (&o)[32]) {
    const f32x2 a2 = {a, a}; const unsigned ww[4] = {vv.x, vv.y, vv.z, vv.w};
#pragma unroll
    for (int q4 = 0; q4 < 4; ++q4) {
        const f32x2 r0 = __builtin_amdgcn_cvt_scalef32_pk_f32_fp4(ww[q4], 1.0f, 0), r1 = __builtin_amdgcn_cvt_scalef32_pk_f32_fp4(ww[q4], 1.0f, 1), r2 = __builtin_amdgcn_cvt_scalef32_pk_f32_fp4(ww[q4], 1.0f, 2), r3 = __builtin_amdgcn_cvt_scalef32_pk_f32_fp4(ww[q4], 1.0f, 3);
        f32x2 t;
        t = __builtin_elementwise_fma(a2, r0, (f32x2){o[8 * q4], o[8 * q4 + 1]}); o[8 * q4] = t.x; o[8 * q4 + 1] = t.y;
        t = __builtin_elementwise_fma(a2, r1, (f32x2){o[8 * q4 + 2], o[8 * q4 + 3]}); o[8 * q4 + 2] = t.x; o[8 * q4 + 3] = t.y;
        t = __builtin_elementwise_fma(a2, r2, (f32x2){o[8 * q4 + 4], o[8 * q4 + 5]}); o[8 * q4 + 4] = t.x; o[8 * q4 + 5] = t.y;
        t = __builtin_elementwise_fma(a2, r3, (f32x2){o[8 * q4 + 6], o[8 * q4 + 7]}); o[8 * q4 + 6] = t.x; o[8 * q4 + 7] = t.y; }
}
__device__ __forceinline__ void peer_round(const Params& P, ldsp lds, int o_ex, int o_gt, int o_list, int o_par, int tok, int tl) {
    int lo = threadIdx.x & 63; asm volatile("" : "+v"(lo));
    const int wave = threadIdx.x >> 6;
    unsigned char* ws = P.ws;
    const unsigned char* Ub = ws + WS_UB; const unsigned char* Vb = ws + WS_VB;
    const float* tsc = (const float*)(ws + WS_TSC);
    float o[32]; unsigned xd0[4], xd1[4]; float sxi;
    {
        float x[32]; peer_load_x(P, lds, o_par, tok, lo, x);
        float ax = 0.f;
#pragma unroll
        for (int i = 0; i < 32; ++i) ax = fmaxf(ax, fabsf(x[i]));
        ax = wave_max_dpp(ax);
        const float sx = ax > 0.f ? 119.0f / ax : 0.f; sxi = ax * (1.0f / 119.0f);
#pragma unroll
        for (int jw = 0; jw < 4; ++jw) { unsigned w0 = 0, w1 = 0;
#pragma unroll
            for (int i = 0; i < 8; ++i) { const unsigned b = __float_as_uint(fmaf(x[8 * jw + i], sx, 12582912.0f));
                w0 = __builtin_amdgcn_alignbit(b, w0, 4); w1 = __builtin_amdgcn_alignbit((b + 8u) >> 4, w1, 4); }
            xd0[jw] = w0; xd1[jw] = w1; }
    }
#pragma unroll
    for (int i = 0; i < 32; ++i) o[i] = 0.f;
    const LAS int* ex = (const LAS int*)(lds + o_ex) + tl * 128; const LAS float* gt = (const LAS float*)(lds + o_gt) + tl * 128;
    const int el = ex[lo], eh = ex[64 + lo];
    const float sul = tsc[el] * sxi, suh = tsc[eh] * sxi;
    const float gvl = gt[lo] * tsc[16384 + el], gvh = gt[64 + lo] * tsc[16384 + eh];
    LAS unsigned* lE = (LAS unsigned*)(lds + o_list) + wave * 384; LAS float* lS = (LAS float*)(lE + 128); LAS float* lG = (LAS float*)(lE + 256);
    {
        const int sl = el >> 10, sh = eh >> 10; int base = 0, pl = 0, ph = 0;
#define LT_COUNT(m) ((int)__builtin_amdgcn_mbcnt_hi((unsigned)((m) >> 32), __builtin_amdgcn_mbcnt_lo((unsigned)(m), 0u)))
#pragma unroll
        for (int s = 0; s < 16; ++s) {
            const unsigned long long ml = __ballot(sl == s), mh = __ballot(sh == s);
            const int cl = __popcll(ml);
            pl = (sl == s) ? base + LT_COUNT(ml) : pl; ph = (sh == s) ? base + cl + LT_COUNT(mh) : ph;
            base += cl + __popcll(mh);
        }
#undef LT_COUNT
        lE[pl] = (unsigned)el; lS[pl] = sul; lG[pl] = gvl; lE[ph] = (unsigned)eh; lS[ph] = suh; lG[ph] = gvh;
        asm volatile("s_waitcnt lgkmcnt(0)" ::: "memory");
    }
    u32x4 ua[4], ub[4]; u32x4 va[4], vb[4];
    auto issue = [&](int gi, u32x4 (&uu)[4], u32x4 (&vv)[4]) {
        const u32x4 e4 = *(const LAS u32x4*)(lE + 4 * gi);
        const unsigned ee[4] = {(unsigned)__builtin_amdgcn_readfirstlane((int)e4.x), (unsigned)__builtin_amdgcn_readfirstlane((int)e4.y), (unsigned)__builtin_amdgcn_readfirstlane((int)e4.z), (unsigned)__builtin_amdgcn_readfirstlane((int)e4.w)};
#pragma unroll
        for (int j = 0; j < 4; ++j) { uu[j] = *(const u32x4*)(Vb + (size_t)ee[j] * EROW + lo * 16); vv[j] = *(const u32x4*)(Vb + (size_t)ee[j] * EROW + 1024 + lo * 16); }
    };
    auto consume = [&](int gi, const u32x4 (&uu)[4], const u32x4 (&vv)[4]) {
        float dd[4];
#pragma unroll
        for (int j = 0; j < 4; ++j) dd[j] = peer_dot(uu[j], xd0, xd1);
        const bool b0 = (lo & 1) != 0, b1 = (lo & 2) != 0;
        const float r01 = (b0 ? dd[1] : dd[0]) + DPPF(b0 ? dd[0] : dd[1], 0xB1), r23 = (b0 ? dd[3] : dd[2]) + DPPF(b0 ? dd[2] : dd[3], 0xB1);
        float r = (b1 ? r23 : r01) + DPPF(b1 ? r01 : r23, 0x4E);
        r += DPPF(r, 0x124); r += DPPF(r, 0x128);
        { auto sw = __builtin_amdgcn_permlane16_swap(__float_as_uint(r), __float_as_uint(r), false, false); r = __uint_as_float(sw[0]) + __uint_as_float(sw[1]); }
        { auto sw = __builtin_amdgcn_permlane32_swap(__float_as_uint(r), __float_as_uint(r), false, false); r = __uint_as_float(sw[0]) + __uint_as_float(sw[1]); }
        const float su = lS[4 * gi + (lo & 3)], gv = lG[4 * gi + (lo & 3)];
        const float hh = r * su;
        const float a = pg8::gelu_pk((pg8::f32x2){hh, hh}).x * gv;
        peer_axpy(vv[0], DPPF(a, 0x00), o); peer_axpy(vv[1], DPPF(a, 0x55), o); peer_axpy(vv[2], DPPF(a, 0xAA), o); peer_axpy(vv[3], DPPF(a, 0xFF), o);
    };
    issue(0, ua, va);
#pragma unroll 1
    for (int gi = 0; gi < 30; gi += 2) {
        issue(gi + 1, ub, vb);
        consume(gi, ua, va);
        issue(gi + 2, ua, va);
        consume(gi + 1, ub, vb);
        if ((gi & 6) == 6) BLOCK_SYNC();
    }
    issue(31, ub, vb);
    consume(30, ua, va);
    consume(31, ub, vb);
    BLOCK_SYNC();
    peer_finish(P, lds, o_par, tok, lo, o);
}
#define CE_DESC(a, b) do { const float h_ = fmaxf((a), (b)), l_ = fminf((a), (b)); (a) = h_; (b) = l_; } while (0)
template <int N> __device__ __forceinline__ void bitonic_sort_desc(float (&v)[N]) {
#pragma unroll
    for (int k = 2; k <= N; k <<= 1)
#pragma unroll
        for (int j = k >> 1; j > 0; j >>= 1)
#pragma unroll
            for (int i = 0; i < N; ++i) { const int l = i ^ j; if (l > i) { if ((i & k) == 0) CE_DESC(v[i], v[l]); else CE_DESC(v[l], v[i]); } }
}
template <int N> __device__ __forceinline__ void bitonic_merge_desc(float (&v)[N]) {
#pragma unroll
    for (int j = N >> 1; j > 0; j >>= 1)
#pragma unroll
        for (int i = 0; i < N; ++i) { const int l = i ^ j; if (l > i) CE_DESC(v[i], v[l]); }
}
__device__ __forceinline__ void top16_merge(float (&a)[16], const float (&brev)[16]) {
#pragma unroll
    for (int i = 0; i < 16; ++i) a[i] = fmaxf(a[i], brev[i]);
    bitonic_merge_desc<16>(a);
}
__device__ __forceinline__ float embed_bits(float v, unsigned code, unsigned mask) { return __uint_as_float((__float_as_uint(v) & ~mask) | code); }

__device__ __forceinline__ void phase7(const Params& P, ldsp lds) {
    const int tid0 = threadIdx.x;
    unsigned char* ws = P.ws;
    const bf16_t* qb = (const bf16_t*)(ws + WS_Q); const bf16_t* sk = (const bf16_t*)(ws + WS_SUBK);
    constexpr int LDSK = 136, O_SK = 0, O_SV = 2 * 128 * LDSK * 2, O_EX = O_SV + 32768, O_GT = O_EX + 16384, O_LIST = O_GT + 16384;
    static_assert(O_LIST + 8 * 384 * 4 <= LDS_BYTES - 16, "lds");
    int titer = 0;
    for (int tile = blockIdx.x; tile < 256; tile += gridDim.x, ++titer) {
        int tid = tid0; asm volatile("" : "+v"(tid));
        const int lane = tid & 63, wave = tid >> 6, fr = lane & 15, fq = lane >> 4, fro = fr, fqo = fq;
        const int tok0 = tile * 32, h = wave;
        bf16x8 qn[4];
        auto ldq = [&](int cb) { const bf16_t* qrow = qb + (size_t)(tok0 + 16 * (cb >> 1) + fro) * D + h * 256 + (cb & 1) * 128 + fqo * 8;
#pragma unroll
            for (int ks = 0; ks < 4; ++ks) qn[ks] = *(const bf16x8*)(qrow + ks * 32); };
        ldq(0);
        for (int idx = tid; idx < 2 * 128 * 16; idx += 512) { const int row = idx >> 4, ch = idx & 15;
            *(LAS u32x4*)(lds + O_SK + (row * LDSK + ch * 8) * 2) = *(const u32x4*)(sk + row * 128 + ch * 8); }
        BLOCK_SYNC();
#pragma unroll 1
        for (int cb = 0; cb < 4; ++cb) {
            const int nt = cb >> 1, p = cb & 1;
            f32x4 acc[8];
#pragma unroll
            for (int mt = 0; mt < 8; ++mt) acc[mt] = (f32x4){0.f, 0.f, 0.f, 0.f};
            bf16x8 qc[4];
#pragma unroll
            for (int ks = 0; ks < 4; ++ks) qc[ks] = qn[ks];
            if (cb + 1 < 4) ldq(cb + 1);
#pragma unroll
            for (int ks = 0; ks < 4; ++ks) {
                const bf16x8 bq = qc[ks];
#pragma unroll
                for (int mt = 0; mt < 8; ++mt) acc[mt] = mfma16(*(const LAS bf16x8*)(lds + O_SK + ((p * 128 + 16 * mt + fro) * LDSK + ks * 32 + fqo * 8) * 2), bq, acc[mt]);
            }
            float a[16], b[16];
#pragma unroll
            for (int mt = 0; mt < 4; ++mt) {
                a[4 * mt + 0] = embed_bits(acc[mt].x, 16 * mt + 4 * fq + 0, 127u); a[4 * mt + 1] = embed_bits(acc[mt].y, 16 * mt + 4 * fq + 1, 127u);
                a[4 * mt + 2] = embed_bits(acc[mt].z, 16 * mt + 4 * fq + 2, 127u); a[4 * mt + 3] = embed_bits(acc[mt].w, 16 * mt + 4 * fq + 3, 127u);
                b[4 * mt + 0] = embed_bits(acc[mt + 4].x, 16 * (mt + 4) + 4 * fq + 0, 127u); b[4 * mt + 1] = embed_bits(acc[mt + 4].y, 16 * (mt + 4) + 4 * fq + 1, 127u);
                b[4 * mt + 2] = embed_bits(acc[mt + 4].z, 16 * (mt + 4) + 4 * fq + 2, 127u); b[4 * mt + 3] = embed_bits(acc[mt + 4].w, 16 * (mt + 4) + 4 * fq + 3, 127u);
            }
            bitonic_sort_desc<16>(a); bitonic_sort_desc<16>(b);
            { float br[16];
#pragma unroll
              for (int i = 0; i < 16; ++i) br[i] = b[15 - i];
              top16_merge(a, br); }
#pragma unroll
            for (int x = 16; x <= 32; x <<= 1) { float br[16];
#pragma unroll
                for (int i = 0; i < 16; ++i) br[i] = __shfl_xor(a[15 - i], x);
                top16_merge(a, br); }
            if (fq == 0) { LAS f32x4* o = (LAS f32x4*)(lds + O_SV + ((((16 * nt + fr) * 8 + h) * 2 + p) * 16) * 4);
                o[0] = (f32x4){a[0], a[1], a[2], a[3]}; o[1] = (f32x4){a[4], a[5], a[6], a[7]}; o[2] = (f32x4){a[8], a[9], a[10], a[11]}; o[3] = (f32x4){a[12], a[13], a[14], a[15]}; }
        }
        BLOCK_SYNC();
        if (tid < 256) {
            const int tok = tid >> 3, hh = tid & 7;
            const LAS f32x4* s = (const LAS f32x4*)(lds + O_SV + (((tok * 8 + hh) * 2) * 16) * 4);
            float s0[16], s1[16];
#pragma unroll
            for (int c4 = 0; c4 < 4; ++c4) { const f32x4 x = s[c4], y = s[4 + c4]; s0[4 * c4] = x.x; s0[4 * c4 + 1] = x.y; s0[4 * c4 + 2] = x.z; s0[4 * c4 + 3] = x.w; s1[4 * c4] = y.x; s1[4 * c4 + 1] = y.y; s1[4 * c4 + 2] = y.z; s1[4 * c4 + 3] = y.w; }
            float g0[16], g1[16], g2[16], g3[16];
            const float NEG = -3.0e38f;
#pragma unroll
            for (int bq = 0; bq < 16; ++bq) g0[bq] = embed_bits(s0[0] + s1[bq], bq, 255u);
            {
                int n1 = 0, n2 = 0, n3 = 0;
#pragma unroll
                for (int aa = 1; aa < 16; ++aa)
#pragma unroll
                    for (int bb = 0; bb < 16; ++bb) if ((aa + 1) * (bb + 1) <= 16) {
                        const float c = embed_bits(s0[aa] + s1[bb], aa * 16 + bb, 255u);
                        if (n1 < 16) g1[n1++] = c; else if (n2 < 16) g2[n2++] = c; else g3[n3++] = c;
                    }
#pragma unroll
                for (int i = 0; i < 16; ++i) if (i >= n3) g3[i] = NEG;
            }
            bitonic_sort_desc<16>(g1); bitonic_sort_desc<16>(g2); bitonic_sort_desc<16>(g3);
            { float r1[16], r3[16];
#pragma unroll
              for (int i = 0; i < 16; ++i) { r1[i] = g1[15 - i]; r3[i] = g3[15 - i]; }
              top16_merge(g0, r1); top16_merge(g2, r3);
#pragma unroll
              for (int i = 0; i < 16; ++i) g0[i] = fmaxf(g0[i], g2[15 - i]); }
            float mx = g0[0];
#pragma unroll
            for (int i = 1; i < 16; ++i) mx = fmaxf(mx, g0[i]);
            float ex[16], sm = 0.f; int ee[16];
#pragma unroll
            for (int i = 0; i < 16; ++i) {
                ex[i] = __expf(g0[i] - mx); sm += ex[i];
                const unsigned code = __float_as_uint(g0[i]) & 255u;
                const unsigned i0 = __float_as_uint(*(const LAS float*)(lds + O_SV + ((((tok * 8 + hh) * 2 + 0) * 16) + (code >> 4)) * 4)) & 127u;
                const unsigned i1 = __float_as_uint(*(const LAS float*)(lds + O_SV + ((((tok * 8 + hh) * 2 + 1) * 16) + (code & 15u)) * 4)) & 127u;
                ee[i] = (int)(i0 * 128u + i1);
            }
            const float inv = 1.0f / sm;
            LAS int* eo = (LAS int*)(lds + O_EX) + tok * 128 + hh * 16; LAS float* go = (LAS float*)(lds + O_GT) + tok * 128 + hh * 16;
#pragma unroll
            for (int c4 = 0; c4 < 4; ++c4) {
                *(LAS u32x4*)(eo + 4 * c4) = (u32x4){(unsigned)ee[4 * c4], (unsigned)ee[4 * c4 + 1], (unsigned)ee[4 * c4 + 2], (unsigned)ee[4 * c4 + 3]};
                *(LAS f32x4*)(go + 4 * c4) = (f32x4){ex[4 * c4] * inv, ex[4 * c4 + 1] * inv, ex[4 * c4 + 2] * inv, ex[4 * c4 + 3] * inv};
            }
        }
        BLOCK_SYNC();
        for (int idx = tid; idx < 2048; idx += 512) { const int a = idx >> 9, q4 = idx & 511; const float* src = P.in[a == 0 ? I_LN1G : a == 1 ? I_LN1B : a == 2 ? I_LN2G : I_LN2B];
            *(LAS f32x4*)(lds + O_SK + a * 8192 + q4 * 16) = *(const f32x4*)(src + q4 * 4); }
        BLOCK_SYNC();
#pragma unroll 1
        for (int r = 0; r < 4; ++r) {
            peer_round(P, lds, O_EX, O_GT, O_LIST, O_SK, tok0 + r * 8 + wave, r * 8 + wave);
        }
        BLOCK_SYNC();
    }
}
__global__ __launch_bounds__(512, 2) void hybrid_fwd(Params P) {
    extern __shared__ __attribute__((aligned(16))) unsigned char shm[];
    ldsp lds = (ldsp)shm;
    unsigned char* ws = P.ws;
    volatile LAS unsigned* xst = (volatile LAS unsigned*)(lds + LDS_BYTES - 16);
    if (threadIdx.x == 0) { xst[0] = 0u; xst[1] = 0u; }
    __syncthreads();
    const XcdBarrier xbar = xcd_barrier_post((unsigned*)(ws + WS_BAR), xst);
    const int lo = P.ph_lo, hi = P.ph_hi;
#ifdef REPEAT_PHASE
#define PHASE(k) if (lo <= (k) && (k) < hi) for (int once_ = 0; once_ < ((k) == REPEAT_PHASE ? 2 : 1); ++once_)
#else
#define PHASE(k) if (lo <= (k) && (k) < hi) for (int once_ = 0; once_ < 1; ++once_)
#endif
#ifdef DOUBLE_SEAMS
#define SEAM(k) do { if (lo <= (k) && (k) + 1 < hi) { xcd_barrier(xbar); xcd_barrier(xbar); } } while (0)
#else
#define SEAM(k) do { if (lo <= (k) && (k) + 1 < hi) xcd_barrier(xbar); } while (0)
#endif
#if defined(REPEAT_PHASE) && REPEAT_PHASE == 0
    PHASE(0) { Params Q = P; if (once_) Q.ph_lo = -1; phase0(Q); }
#else
    PHASE(0) phase0(P);
#endif
    SEAM(0);
    PHASE(1) { pg8::EpiBf16<0> E; E.O = (bf16_t*)(ws + WS_P); E.ldc = NPAD; E.bias = nullptr; E.split_cols = 0; E.split_stride = 0;
        run_gemm(lds, (const bf16_t*)(ws + WS_H0B), (const bf16_t*)(ws + WS_WTIN), MROWS, N_BF, 2048, E);
        const int G = (int)gridDim.x, r1 = ((MROWS / 256) * (N_BF / 256)) % G;
        pg8::EpiBf16S E8; E8.O = (bf16_t*)(ws + WS_P) + N_BF; E8.ldc = NPAD; E8.scale = 1.0f / 64.0f;
        run_gemm8(lds, ws + WS_H0B8, ws + WS_WT8, MROWS, N_F8, 2048, E8, (int)((blockIdx.x + G - r1) % G)); }
    SEAM(1);
    PHASE(2) phase2(P, lds);
    SEAM(2);
    PHASE(3) phase3(P);
    SEAM(3);
    PHASE(4) phase3b(P, lds);
    SEAM(4);
    PHASE(5) {
#ifdef P5_F8
        { pg8::EpiGate35T<16> E; E.O = (bf16_t*)(ws + WS_MERGED); E.p = (const bf16_t*)(ws + WS_P); E.bgate = P.in[I_BGATE]; E.oscale = 1.0f / 64.0f;
          run_gemm8(lds, ws + WS_YAB, ws + WS_WTAB8, NTOK, 2048, LDAB, E, (int)blockIdx.x); }
#else
        { pg8::EpiGate35 E; E.O = (bf16_t*)(ws + WS_MERGED); E.p = (const bf16_t*)(ws + WS_P); E.bgate = P.in[I_BGATE]; E.oscale = 1.0f;
          run_gemm(lds, (const bf16_t*)(ws + WS_YAB), (const bf16_t*)(ws + WS_WTAB), NTOK, 2048, LDAB, E); }
#endif
    }
#if defined(DUP_PHASE) && DUP_PHASE == 5
    SEAM(4);
    PHASE(5) {
#ifdef P5_F8
        { pg8::EpiGate35T<16> E; E.O = (bf16_t*)(ws + WS_MERGED); E.p = (const bf16_t*)(ws + WS_P); E.bgate = P.in[I_BGATE]; E.oscale = 1.0f / 64.0f;
          run_gemm8(lds, ws + WS_YAB, ws + WS_WTAB8, NTOK, 2048, LDAB, E, (int)blockIdx.x); }
#else
        { pg8::EpiGate35 E; E.O = (bf16_t*)(ws + WS_MERGED); E.p = (const bf16_t*)(ws + WS_P); E.bgate = P.in[I_BGATE]; E.oscale = 1.0f;
          run_gemm(lds, (const bf16_t*)(ws + WS_YAB), (const bf16_t*)(ws + WS_WTAB), NTOK, 2048, LDAB, E); }
#endif
    }
#endif
    SEAM(5);
    PHASE(6) { pg8::EpiResidStats E; E.O = (bf16_t*)(ws + WS_X1B); E.h0 = (const bf16_t*)(ws + WS_H0B); E.alpha = DN_ALPHA; E.rsum = (float*)(ws + WS_STAT); E.rsq = (float*)(ws + WS_STAT) + 8192;
        E.O8 = ws + WS_X1B8;
#ifdef P6_F8
        E.ascale = 1.0f / 64.0f; run_gemm8(lds, ws + WS_MERGED, ws + WS_WTOUT8, NTOK, 2048, 2048, E, (int)blockIdx.x); }
#else
        E.ascale = 1.0f; run_gemm(lds, (const bf16_t*)(ws + WS_MERGED), (const bf16_t*)(ws + WS_WTOUT), NTOK, 2048, 2048, E); }
#endif
#if defined(DUP_PHASE) && DUP_PHASE == 6
    SEAM(5);
    PHASE(6) { pg8::EpiResidStats E; E.O = (bf16_t*)(ws + WS_X1B); E.h0 = (const bf16_t*)(ws + WS_H0B); E.alpha = DN_ALPHA; E.rsum = (float*)(ws + WS_END); E.rsq = (float*)(ws + WS_END) + 8192;
        run_gemm(lds, (const bf16_t*)(ws + WS_MERGED), (const bf16_t*)(ws + WS_WTOUT), NTOK, 2048, 2048, E); }
#endif
    SEAM(6);
    PHASE(7) { pg8::EpiQ E; E.O = (bf16_t*)(ws + WS_Q); E.rsum = (const float*)(ws + WS_STAT); E.rsq = (const float*)(ws + WS_STAT) + 8192; E.c1 = (const float*)(ws + WS_STAT) + 16384; E.c2 = (const float*)(ws + WS_STAT) + 18432;
#ifdef P7_F8
        E.ascale = 1.0f / 64.0f; run_gemm8(lds, ws + WS_X1B8, ws + WS_WTQ8, NTOK, 2048, 2048, E, (int)blockIdx.x); }
#else
        E.ascale = 1.0f; run_gemm(lds, (const bf16_t*)(ws + WS_X1B), (const bf16_t*)(ws + WS_WTQ), NTOK, 2048, 2048, E); }
#endif
#if defined(DUP_PHASE) && DUP_PHASE == 7
    SEAM(6);
    PHASE(7) { pg8::EpiQ E; E.O = (bf16_t*)(ws + WS_Q); E.rsum = (const float*)(ws + WS_STAT); E.rsq = (const float*)(ws + WS_STAT) + 8192; E.c1 = (const float*)(ws + WS_STAT) + 16384; E.c2 = (const float*)(ws + WS_STAT) + 18432;
        run_gemm(lds, (const bf16_t*)(ws + WS_X1B), (const bf16_t*)(ws + WS_WTQ), NTOK, 2048, 2048, E); }
#endif
    SEAM(7);
    PHASE(8) phase7(P, lds);
#undef PHASE
#undef SEAM
}

extern "C" void kernel_launch(void* const* d_in, const int* in_sizes, int n_in, void* d_out, int out_size, void* d_ws, size_t ws_size, hipStream_t stream) {
    static int grid = 0;
    if (grid == 0) {
        if (n_in != 30 || out_size != NTOK * D || ws_size < WS_END) { fprintf(stderr, "kernel_launch: unexpected shapes (n_in %d, out %d, ws %zu < %zu)\n", n_in, out_size, ws_size, (size_t)WS_END); grid = -1; return; }
        int dev = 0, cus = 0, per_cu = 0;
        if (hipGetDevice(&dev) != hipSuccess || hipDeviceGetAttribute(&cus, hipDeviceAttributeMultiprocessorCount, dev) != hipSuccess) { grid = -1; return; }
        if (hipFuncSetAttribute((const void*)hybrid_fwd, hipFuncAttributeMaxDynamicSharedMemorySize, LDS_BYTES) != hipSuccess) { fprintf(stderr, "kernel_launch: hipFuncSetAttribute failed\n"); grid = -1; return; }
        if (hipOccupancyMaxActiveBlocksPerMultiprocessor(&per_cu, (const void*)hybrid_fwd, 512, LDS_BYTES) != hipSuccess || per_cu < 1) { fprintf(stderr, "kernel_launch: occupancy query says %d\n", per_cu); grid = -1; return; }
        (void)hipGetLastError();
        grid = cus;
    }
    if (grid < 0) return;
    if (hipMemsetAsync((unsigned char*)d_ws + WS_BAR, 0, 16384 + STAT_BYTES, stream) != hipSuccess) { fprintf(stderr, "kernel_launch: memset failed\n"); return; }
    Params p{};
    for (int i = 0; i < 30; ++i) p.in[i] = (const float*)d_in[i];
    p.out = (float*)d_out; p.ws = (unsigned char*)d_ws;
    p.ph_lo = 0; p.ph_hi = NPHASE + 1;
    void* args[] = {&p};
    hipError_t e = hipLaunchCooperativeKernel((const void*)hybrid_fwd, dim3(grid), dim3(512), args, LDS_BYTES, stream);
    if (e != hipSuccess) fprintf(stderr, "kernel_launch: cooperative launch failed: %s (grid %d)\n", hipGetErrorString(e), grid);
}
```
